# Optimizing an MI355X kernel written in HIP

```python
import jax, jax.numpy as jnp
from jax import lax
import numpy as np

D_MODEL = 1024
BATCH = 2
SEQ = 8192
DEPTH = 1

GRID_W = 64
CTX_LEN = 256

HEAD_DIM = 64
RWKV_WIDTH = D_MODEL
RWKV_HEADS = RWKV_WIDTH // HEAD_DIM
DECAY_LORA = 64
ICLR_LORA = 64
GATE_LORA = 128
GN_EPS = 64e-5
NORM_EPS = 1e-12
CONV_WIDTH = D_MODEL
CONV_GROUPS = CONV_WIDTH // HEAD_DIM
CONV_K = 3
N_EXPERTS = 32
TOP_K = 4
D_FF = D_MODEL
SWIGLU_LIMIT = 7.0
SWIGLU_ALPHA = 1.702
MOE_BLOCK = 256
RMS_EPS = 1e-6

K_OFF = 0
V_OFF = K_OFF + RWKV_WIDTH
DECAY_OFF = V_OFF + RWKV_WIDTH
ICLR_OFF = DECAY_OFF + 2 * DECAY_LORA
STATE_COLS = ICLR_OFF + 2 * ICLR_LORA
R_OFF = STATE_COLS
GLORA_OFF = R_OFF + RWKV_WIDTH
SHIFT_COLS = GLORA_OFF + GATE_LORA
CONV_OFF = SHIFT_COLS
GATE_OFF = CONV_OFF + 3 * CONV_WIDTH
N_IN = GATE_OFF + 2 * D_MODEL

kernel_name = 'hybrid_rwkv7_shortconv_moe_diffusion_block'


def _rmsnorm(x, g):
    xf = x.astype(jnp.float32)
    y = xf * lax.rsqrt(jnp.mean(xf * xf, axis=-1, keepdims=True) + RMS_EPS)
    return (y * g.astype(jnp.float32)).astype(x.dtype)


def _shift(z, axis, step):
    n = z.shape[axis]
    pad = [(0, 0)] * z.ndim
    if step > 0:
        body = lax.slice_in_dim(z, 0, n - step, axis=axis)
        pad[axis] = (step, 0)
    else:
        body = lax.slice_in_dim(z, -step, n, axis=axis)
        pad[axis] = (0, -step)
    return jnp.pad(body, pad)


def _qshift_grid(z, mu):
    b, t, ch = z.shape
    rows = t // GRID_W
    zg = z.reshape(b, rows, GRID_W, ch // 4, 4)
    shifted = jnp.stack([
        _shift(zg[..., 0], 2, 1),
        _shift(zg[..., 1], 2, -1),
        _shift(zg[..., 2], 1, 1),
        _shift(zg[..., 3], 1, -1),
    ], axis=-1).reshape(b, t, ch)
    return z + mu * (shifted - z)


def _qshift_seq(z, mu):
    b, t, ch = z.shape
    zg = z.reshape(b, t, ch // 4, 4)
    shifted = jnp.stack([
        _shift(zg[..., 0], 1, 1),
        _shift(zg[..., 1], 1, -1),
        _shift(zg[..., 2], 1, 1),
        _shift(zg[..., 3], 1, -1),
    ], axis=-1).reshape(b, t, ch)
    return z + mu * (shifted - z)


def _heads(u):
    return u.reshape(u.shape[0], u.shape[1], RWKV_HEADS, HEAD_DIM).astype(jnp.float32)


def _rwkv_state_terms(zs, w0, w_decay_up, a0, w_iclr_up, k_k, k_a):
    f32 = jnp.float32
    k = zs[..., K_OFF:K_OFF + RWKV_WIDTH]
    v = zs[..., V_OFF:V_OFF + RWKV_WIDTH]
    kk = _heads(k * k_k)
    kk = kk / jnp.maximum(jnp.sqrt(jnp.sum(kk * kk, axis=-1, keepdims=True)), NORM_EPS)
    dirs = []
    for d in range(2):
        lw = zs[..., DECAY_OFF + d * DECAY_LORA:DECAY_OFF + (d + 1) * DECAY_LORA]
        la = zs[..., ICLR_OFF + d * ICLR_LORA:ICLR_OFF + (d + 1) * ICLR_LORA]
        w_log = -jax.nn.softplus(-(w0[d] + jnp.tanh(lw) @ w_decay_up[d]).astype(f32)) - 0.5
        decay = jnp.exp(-jnp.exp(w_log))
        a = jax.nn.sigmoid((a0[d] + la @ w_iclr_up[d]).astype(f32))
        k_dir = k.astype(f32) * (1.0 + (a - 1.0) * k_a.astype(f32))
        dirs.append((_heads(decay), _heads(k_dir), kk * _heads(a)))
    return _heads(v), kk, dirs


def _wkv_scan(s0, decay, k, v, kk, kka, r, reverse):
    seq = [decay, k, v, kk, kka] + ([] if r is None else [r])
    xs = tuple(jnp.moveaxis(u, 1, 0) for u in seq)

    def step(s, inp):
        w_t, k_t, v_t, kk_t, kka_t = inp[:5]
        sa = jnp.einsum('bhvk,bhk->bhv', s, kk_t)
        s = (s * w_t[:, :, None, :] - sa[..., None] * kka_t[:, :, None, :]
             + v_t[..., None] * k_t[:, :, None, :])
        y = jnp.einsum('bhvk,bhk->bhv', s, inp[5]) if len(inp) == 6 else None
        return s, y

    s_fin, ys = lax.scan(step, s0, xs, reverse=reverse)
    return s_fin, (None if r is None else jnp.moveaxis(ys, 0, 1))


def _conv3(u, w):
    return lax.conv_general_dilated(
        u, w[:, None, :].astype(u.dtype), window_strides=(1,), padding=((1, 1),),
        dimension_numbers=('NWC', 'WIO', 'NWC'), feature_group_count=u.shape[-1])


def _merge_branches(z, r, lg, y, k_bonus, v, r_k, ln_x_w, ln_x_b, w_gate_up, conv_w, w_out):
    b, t, _ = z.shape
    mean = jnp.mean(y, axis=-1, keepdims=True)
    var = jnp.mean(jnp.square(y - mean), axis=-1, keepdims=True)
    yn = ((y - mean) * lax.rsqrt(var + GN_EPS)).reshape(b, t, RWKV_WIDTH) * ln_x_w + ln_x_b
    bonus = (jnp.sum(r * k_bonus * r_k, axis=-1, keepdims=True) * v).reshape(b, t, RWKV_WIDTH)
    g = jax.nn.sigmoid(lg) @ w_gate_up
    y_rwkv = ((yn + bonus) * g).astype(z.dtype)
    gb = z[..., CONV_OFF:CONV_OFF + CONV_WIDTH]
    gc = z[..., CONV_OFF + CONV_WIDTH:CONV_OFF + 2 * CONV_WIDTH]
    xin = z[..., CONV_OFF + 2 * CONV_WIDTH:CONV_OFF + 3 * CONV_WIDTH]
    y_conv = gb * _conv3(gc * xin, conv_w)
    ga = z[..., GATE_OFF:GATE_OFF + D_MODEL]
    gbr = z[..., GATE_OFF + D_MODEL:GATE_OFF + 2 * D_MODEL]
    merged = jax.nn.sigmoid(ga) * y_rwkv + jax.nn.sigmoid(gbr) * y_conv
    return merged @ w_out


def _moe(h, w_router, b_router, w_exp_in, b_exp_in, w_exp_out, b_exp_out):
    n, d = h.shape
    logits = (h @ w_router + b_router).astype(jnp.float32)
    top_val, top_idx = lax.top_k(logits, TOP_K)
    gates = jax.nn.softmax(top_val, axis=-1)
    nk = n * TOP_K
    flat_e = top_idx.reshape(-1).astype(jnp.int32)
    flat_tok = jnp.arange(nk, dtype=jnp.int32) // TOP_K
    flat_g = gates.reshape(-1)
    order = jnp.argsort(flat_e)
    e_sorted, tok_sorted, g_sorted = flat_e[order], flat_tok[order], flat_g[order]
    counts = jnp.bincount(flat_e, length=N_EXPERTS).astype(jnp.int32)
    starts = jnp.cumsum(counts) - counts
    padded = (counts + MOE_BLOCK - 1) // MOE_BLOCK * MOE_BLOCK
    pad_ends = jnp.cumsum(padded)
    pad_starts = pad_ends - padded
    dest = pad_starts[e_sorted] + jnp.arange(nk, dtype=jnp.int32) - starts[e_sorted]
    n_blocks = -(-(nk + N_EXPERTS * (MOE_BLOCK - 1)) // MOE_BLOCK)
    n_rows = n_blocks * MOE_BLOCK
    row_tok = jnp.zeros((n_rows,), jnp.int32).at[dest].set(tok_sorted)
    row_g = jnp.zeros((n_rows,), jnp.float32).at[dest].set(g_sorted)
    block_e = jnp.minimum(
        jnp.searchsorted(pad_ends, jnp.arange(n_blocks, dtype=jnp.int32) * MOE_BLOCK, side='right'),
        N_EXPERTS - 1)
    xb = h[row_tok].reshape(n_blocks, MOE_BLOCK, d)

    def expert_block(args):
        xblk, e = args
        gu = xblk @ w_exp_in[e] + b_exp_in[e]
        gate = jnp.minimum(gu[:, :D_FF], SWIGLU_LIMIT)
        up = jnp.clip(gu[:, D_FF:], -SWIGLU_LIMIT, SWIGLU_LIMIT)
        act = (up + 1.0) * gate * jax.nn.sigmoid(SWIGLU_ALPHA * gate)
        return act @ w_exp_out[e] + b_exp_out[e]

    yb = lax.map(expert_block, (xb, block_e)).reshape(n_rows, d)
    return jax.ops.segment_sum(yb * row_g[:, None].astype(yb.dtype), row_tok, num_segments=n)


def setup_inputs(seed: int = 0) -> dict:
    key = jax.random.key(seed)
    ks = jax.random.split(key, 30)
    f32 = jnp.float32
    L, D = DEPTH, D_MODEL

    def nrm(i, shape, scale):
        return jax.random.normal(ks[i], shape, f32) * scale

    def unif(i, shape, lo, hi):
        return jax.random.uniform(ks[i], shape, f32, lo, hi)

    return {
        'x': nrm(0, (BATCH, SEQ, D), 1.0),
        'c': nrm(1, (BATCH, D), 1.0),
        'ctx': nrm(2, (BATCH, CTX_LEN, D), 1.0),
        'c_ctx': nrm(3, (D,), 1.0),
        'w_ada': nrm(4, (L, D, 6 * D), 0.5 * D ** -0.5),
        'b_ada': nrm(5, (L, 6 * D), 0.01),
        'norm_pre_mix': 1.0 + nrm(6, (L, D), 0.02),
        'norm_post_mix': 1.0 + nrm(7, (L, D), 0.02),
        'norm_pre_ffn': 1.0 + nrm(8, (L, D), 0.02),
        'norm_post_ffn': 1.0 + nrm(9, (L, D), 0.02),
        'w_in': nrm(10, (L, D, N_IN), D ** -0.5),
        'mu_shift': unif(11, (L, SHIFT_COLS), 0.0, 0.5),
        'w0': unif(12, (L, 2, RWKV_WIDTH), -6.0, -1.0),
        'w_decay_up': nrm(13, (L, 2, DECAY_LORA, RWKV_WIDTH), 0.1),
        'a0': nrm(14, (L, 2, RWKV_WIDTH), 0.1),
        'w_iclr_up': nrm(15, (L, 2, ICLR_LORA, RWKV_WIDTH), ICLR_LORA ** -0.5),
        'k_k': 0.85 + nrm(16, (L, RWKV_WIDTH), 0.05),
        'k_a': 1.0 + nrm(17, (L, RWKV_WIDTH), 0.05),
        'r_k': nrm(18, (L, RWKV_HEADS, HEAD_DIM), 0.1),
        'w_gate_up': nrm(19, (L, GATE_LORA, RWKV_WIDTH), GATE_LORA ** -0.5),
        'ln_x_w': 1.0 + nrm(20, (L, RWKV_WIDTH), 0.02),
        'ln_x_b': nrm(21, (L, RWKV_WIDTH), 0.01),
        'conv_w': nrm(22, (L, CONV_K, CONV_WIDTH), CONV_K ** -0.5),
        'w_out': nrm(23, (L, D, D), D ** -0.5),
        'w_router': nrm(24, (L, D, N_EXPERTS), D ** -0.5),
        'b_router': nrm(25, (L, N_EXPERTS), 0.01),
        'w_exp_in': nrm(26, (L, N_EXPERTS, D, 2 * D_FF), D ** -0.5),
        'b_exp_in': nrm(27, (L, N_EXPERTS, 2 * D_FF), 0.01),
        'w_exp_out': nrm(28, (L, N_EXPERTS, D_FF, D), D_FF ** -0.5),
        'b_exp_out': nrm(29, (L, N_EXPERTS, D), 0.01),
    }


def reference(x, c, ctx, c_ctx, w_ada, b_ada, norm_pre_mix, norm_post_mix, norm_pre_ffn, norm_post_ffn,
              w_in, mu_shift, w0, w_decay_up, a0, w_iclr_up, k_k, k_a, r_k, w_gate_up, ln_x_w, ln_x_b,
              conv_w, w_out, w_router, b_router, w_exp_in, b_exp_in, w_exp_out, b_exp_out):
    xc = ctx
    b = x.shape[0]
    for l in range(DEPTH):
        last = l == DEPTH - 1
        mod = jax.nn.silu(c) @ w_ada[l] + b_ada[l]
        mod_c = jax.nn.silu(c_ctx) @ w_ada[l] + b_ada[l]
        sh1, sc1, g1, sh2, sc2, g2 = jnp.split(mod[:, None, :], 6, axis=-1)
        csh1, csc1, cg1, csh2, csc2, cg2 = jnp.split(mod_c, 6)
        rw_state = (w0[l], w_decay_up[l], a0[l], w_iclr_up[l], k_k[l], k_a[l])
        rw_read = (r_k[l], ln_x_w[l], ln_x_b[l], w_gate_up[l], conv_w[l], w_out[l])

        h = _rmsnorm(x, norm_pre_mix[l]) * (1.0 + sc1) + sh1
        hc = _rmsnorm(xc, norm_pre_mix[l]) * (1.0 + csc1) + csh1
        z = h @ w_in[l]
        zs = _qshift_grid(z[..., :SHIFT_COLS], mu_shift[l])
        n_ctx = STATE_COLS if last else N_IN
        n_ctx_shift = STATE_COLS if last else SHIFT_COLS
        zc = hc @ w_in[l][:, :n_ctx]
        zcs = _qshift_seq(zc[..., :n_ctx_shift], mu_shift[l][:n_ctx_shift])

        v, kk, dirs = _rwkv_state_terms(zs[..., :STATE_COLS], *rw_state)
        vc, kkc, dirs_c = _rwkv_state_terms(zcs[..., :STATE_COLS], *rw_state)
        r = _heads(zs[..., R_OFF:R_OFF + RWKV_WIDTH])
        rc = None if last else _heads(zcs[..., R_OFF:R_OFF + RWKV_WIDTH])
        s0 = jnp.zeros((b, RWKV_HEADS, HEAD_DIM, HEAD_DIM), jnp.float32)
        y_dirs, yc_dirs = [], []
        for d in range(2):
            dec_c, k_c, kka_c = dirs_c[d]
            s_ctx, yc_d = _wkv_scan(s0, dec_c, k_c, vc, kkc, kka_c, rc, d == 1)
            dec, k_d, kka = dirs[d]
            _, y_d = _wkv_scan(s_ctx, dec, k_d, v, kk, kka, r, d == 1)
            y_dirs.append(y_d)
            yc_dirs.append(yc_d)
        y = y_dirs[0] + y_dirs[1]
        k_bonus = 0.5 * (dirs[0][1] + dirs[1][1])
        mix = _merge_branches(z, r, zs[..., GLORA_OFF:SHIFT_COLS], y, k_bonus, v, *rw_read)
        x = x + g1 * _rmsnorm(mix, norm_post_mix[l])
        if not last:
            yc = yc_dirs[0] + yc_dirs[1]
            kc_bonus = 0.5 * (dirs_c[0][1] + dirs_c[1][1])
            mix_c = _merge_branches(zc, rc, zcs[..., GLORA_OFF:SHIFT_COLS], yc, kc_bonus, vc, *rw_read)
            xc = xc + cg1 * _rmsnorm(mix_c, norm_post_mix[l])

        moe_p = (w_router[l], b_router[l], w_exp_in[l], b_exp_in[l], w_exp_out[l], b_exp_out[l])
        h2 = (_rmsnorm(x, norm_pre_ffn[l]) * (1.0 + sc2) + sh2).reshape(-1, D_MODEL)
        if last:
            f = _moe(h2, *moe_p)
        else:
            h2c = (_rmsnorm(xc, norm_pre_ffn[l]) * (1.0 + csc2) + csh2).reshape(-1, D_MODEL)
            f_all = _moe(jnp.concatenate([h2, h2c], axis=0), *moe_p)
            f = f_all[:h2.shape[0]]
            xc = xc + cg2 * _rmsnorm(f_all[h2.shape[0]:].reshape(xc.shape), norm_post_ffn[l])
        x = x + g2 * _rmsnorm(f.reshape(x.shape), norm_post_ffn[l])
    return x
```

```cpp
#include <hip/hip_runtime.h>
#include <cstdio>
#include <cstdint>

namespace pg8 {
#define PG8_LAS __attribute__((address_space(3)))
typedef unsigned short bf16_t;
typedef short bf16x8 __attribute__((ext_vector_type(8)));
typedef float f32x4 __attribute__((ext_vector_type(4)));
typedef unsigned u32x4 __attribute__((ext_vector_type(4)));
constexpr int BM = 256, BK = 64, HALF = 128, HTB = HALF * BK * 2  , STAGE_BYTES = 8 * HTB, NXCD = 8, WGM = 8;

__host__ __device__ __forceinline__ int lds_byte(int r, int c) { const int st = (r >> 4) * 2 + (c >> 5), rr = r & 15, cc = c & 31, ob = rr * 64 + cc * 2; return st * 1024 + (ob ^ (((ob >> 9) & 1) << 5)); }
__host__ __device__ __forceinline__ void stage_rc(int b, int& R, int& C) { const int st = b / 1024, sb = b % 1024, swz = sb ^ (((sb >> 9) & 1) << 5); R = (st >> 1) * 16 + swz / 64; C = (st & 1) * 32 + (swz % 64) / 2; }
__host__ __device__ __forceinline__ int perm32(int rho) { const int n = rho >> 4, i = rho & 15; return 8 * (i >> 2) + 4 * n + (i & 3); }

struct Unit { int pm, pn, pb, e; };
struct Gemm { const bf16_t* A; const bf16_t* Bt; int M, N, K; };

struct StaticOrder {
    int nM, nN, nwg, G, c;
    __host__ __device__ void init(int M, int N, int G_, int c_) { nM = M / BM; nN = N / BM; nwg = nM * nN; G = G_; c = c_; }
    __host__ __device__ bool next(int i, Unit& u) const {
        const long L = (long)i * G + c; if (L >= nwg) return false;
        int wgid = (int)L; { const int q = nwg / NXCD, r = nwg % NXCD, xcd = wgid % NXCD, off = wgid / NXCD; wgid = (xcd < r ? xcd * (q + 1) : r * (q + 1) + (xcd - r) * q) + off; }
        const int nig = WGM * nN, gid = wgid / nig, fm = gid * WGM, gsz = (nM - fm) < WGM ? (nM - fm) : WGM;
        u.pm = fm + ((wgid % nig) % gsz); u.pn = (wgid % nig) / gsz; u.pb = u.pn; u.e = 0; return true;
    }
    __device__ __forceinline__ void a_ready(const Unit&) const {}
    __device__ __forceinline__ void done(const Unit&) const {}
};
template <int NT> struct MoeOrder {
    const int* blk_e; int nunits, G, c;
    __device__ bool next(int i, Unit& u) const {
        const long L = (long)i * G + c; if (L >= nunits) return false;
        const int blk = (int)L / NT, pn = (int)L % NT; const int e = __hip_atomic_load(blk_e + blk, __ATOMIC_RELAXED, __HIP_MEMORY_SCOPE_AGENT);
        u.pm = blk; u.pn = pn; u.pb = e * NT + pn; u.e = e; return true;
    }
    __device__ __forceinline__ void a_ready(const Unit&) const {}
    __device__ __forceinline__ void done(const Unit&) const {}
};

__device__ __forceinline__ unsigned cvt_pk_bf16(float lo, float hi) { unsigned r; asm volatile("v_cvt_pk_bf16_f32 %0, %1, %2" : "=v"(r) : "v"(lo), "v"(hi)); return r; }

struct EpiF32 {
    static constexpr bool PERM = false, AFTER_DRAIN = false;
    float* C; int ldc;
    __device__ __forceinline__ void operator()(const f32x4 (&acc)[2][2][4][2], const Unit& u, int wr, int wc, int fr, int fq) const {
        const int row0 = u.pm * BM + wr * 64 + fr, col0 = u.pn * BM + wc * 32 + 4 * fq;
#pragma unroll
        for (int ai = 0; ai < 2; ++ai)
#pragma unroll
            for (int m = 0; m < 4; ++m) { float* rowp = C + (size_t)(row0 + ai * HALF + m * 16) * ldc + col0;
#pragma unroll
                for (int bj = 0; bj < 2; ++bj)
#pragma unroll
                    for (int n = 0; n < 2; ++n) *(f32x4*)(rowp + bj * HALF + n * 16) = acc[ai][bj][m][n]; }
    }
};
struct EpiBf16 {
    static constexpr bool PERM = true, AFTER_DRAIN = false;
    bf16_t* O; int ldc; const float* bias; int bias_estride;
    __device__ __forceinline__ void operator()(const f32x4 (&acc)[2][2][4][2], const Unit& u, int wr, int wc, int fr, int fq) const {
        const int row0 = u.pm * BM + wr * 64 + fr; const int col0 = u.pn * BM + wc * 32 + 8 * fq;
        const float* bp = bias ? bias + (size_t)u.e * bias_estride + col0 : nullptr;
        f32x4 bv[2][2];
#pragma unroll
        for (int bj = 0; bj < 2; ++bj)
#pragma unroll
            for (int n = 0; n < 2; ++n) bv[bj][n] = bp ? *(const f32x4*)(bp + bj * HALF + 4 * n) : (f32x4){0.f, 0.f, 0.f, 0.f};
#pragma unroll
        for (int ai = 0; ai < 2; ++ai)
#pragma unroll
            for (int m = 0; m < 4; ++m) { bf16_t* rowp = O + (size_t)(row0 + ai * HALF + m * 16) * ldc + col0;
#pragma unroll
                for (int bj = 0; bj < 2; ++bj) { const f32x4 v0 = acc[ai][bj][m][0] + bv[bj][0], v1 = acc[ai][bj][m][1] + bv[bj][1];
                    u32x4 w; w.x = cvt_pk_bf16(v0[0], v0[1]); w.y = cvt_pk_bf16(v0[2], v0[3]); w.z = cvt_pk_bf16(v1[0], v1[1]); w.w = cvt_pk_bf16(v1[2], v1[3]);
                    *(u32x4*)(rowp + bj * HALF) = w; } }
    }
};
struct EpiSwiglu {
    static constexpr bool PERM = true, AFTER_DRAIN = false;
    bf16_t* O; const float* bias;
    __device__ __forceinline__ float act1(float g, float up) const {
        g = fminf(g, 7.0f); up = fminf(fmaxf(up, -7.0f), 7.0f);
        const float sg = 1.0f / (1.0f + __expf(-1.702f * g));
        return (up + 1.0f) * g * sg;
    }
    __device__ __forceinline__ void operator()(const f32x4 (&acc)[2][2][4][2], const Unit& u, int wr, int wc, int fr, int fq) const {
        const int row0 = u.pm * BM + wr * 64 + fr; const int col0 = u.pn * HALF + wc * 32 + 8 * fq;
        const float* bp = bias + (size_t)u.e * 2048 + col0;
        f32x4 bg[2], bu[2];
#pragma unroll
        for (int n = 0; n < 2; ++n) { bg[n] = *(const f32x4*)(bp + 4 * n); bu[n] = *(const f32x4*)(bp + 1024 + 4 * n); }
#pragma unroll
        for (int ai = 0; ai < 2; ++ai)
#pragma unroll
            for (int m = 0; m < 4; ++m) { bf16_t* rowp = O + (size_t)(row0 + ai * HALF + m * 16) * 1024 + col0;
                const f32x4 g0 = acc[ai][0][m][0] + bg[0], g1 = acc[ai][0][m][1] + bg[1], u0 = acc[ai][1][m][0] + bu[0], u1 = acc[ai][1][m][1] + bu[1];
                u32x4 w; w.x = cvt_pk_bf16(act1(g0[0], u0[0]), act1(g0[1], u0[1])); w.y = cvt_pk_bf16(act1(g0[2], u0[2]), act1(g0[3], u0[3]));
                w.z = cvt_pk_bf16(act1(g1[0], u1[0]), act1(g1[1], u1[1])); w.w = cvt_pk_bf16(act1(g1[2], u1[2]), act1(g1[3], u1[3]));
                *(u32x4*)rowp = w; }
    }
};


typedef int i32x4 __attribute__((ext_vector_type(4)));
struct EpiBf16I8 {
    static constexpr bool PERM = true, AFTER_DRAIN = false;
    bf16_t* O; int ldc; const float* rs; const float* cs;
    __device__ __forceinline__ void operator()(const i32x4 (&acc)[2][2][4][2], const Unit& u, int wr, int wc, int fr, int fq) const {
        const int row0 = u.pm * BM + wr * 64 + fr; const int col0 = u.pn * BM + wc * 32 + 8 * fq;
        const float* cp = cs + (size_t)u.pb * BM + wc * 32 + 8 * fq;
        f32x4 cv[2][2];
#pragma unroll
        for (int bj = 0; bj < 2; ++bj)
#pragma unroll
            for (int n = 0; n < 2; ++n) cv[bj][n] = *(const f32x4*)(cp + bj * HALF + 4 * n);
#pragma unroll
        for (int ai = 0; ai < 2; ++ai)
#pragma unroll
            for (int m = 0; m < 4; ++m) { const int row = row0 + ai * HALF + m * 16; const float r = rs[row]; bf16_t* rowp = O + (size_t)row * ldc + col0;
#pragma unroll
                for (int bj = 0; bj < 2; ++bj) { const i32x4 a0 = acc[ai][bj][m][0], a1 = acc[ai][bj][m][1];
                    const f32x4 v0 = (f32x4){(float)a0[0], (float)a0[1], (float)a0[2], (float)a0[3]} * cv[bj][0] * r, v1 = (f32x4){(float)a1[0], (float)a1[1], (float)a1[2], (float)a1[3]} * cv[bj][1] * r;
                    u32x4 w; w.x = cvt_pk_bf16(v0[0], v0[1]); w.y = cvt_pk_bf16(v0[2], v0[3]); w.z = cvt_pk_bf16(v1[0], v1[1]); w.w = cvt_pk_bf16(v1[2], v1[3]);
                    *(u32x4*)(rowp + bj * HALF) = w; } }
    }
};
struct EpiSwigluI8 {
    static constexpr bool PERM = true, AFTER_DRAIN = false;
    bf16_t* O; const float* bias; const float* rs; const float* cs;
    __device__ __forceinline__ float act1(float g, float up) const {
        g = fminf(g, 7.0f); up = fminf(fmaxf(up, -7.0f), 7.0f);
        const float sg = __builtin_amdgcn_rcpf(1.0f + __expf(-1.702f * g));
        return (up + 1.0f) * g * sg;
    }
    __device__ __forceinline__ void operator()(const i32x4 (&acc)[2][2][4][2], const Unit& u, int wr, int wc, int fr, int fq) const {
        const int row0 = u.pm * BM + wr * 64 + fr; const int col0 = u.pn * HALF + wc * 32 + 8 * fq;
        const float* bp = bias + (size_t)u.e * 2048 + col0;
        const float* cp = cs + (size_t)u.pb * BM + wc * 32 + 8 * fq;
        f32x4 bg[2], bu[2], cg[2], cu[2];
#pragma unroll
        for (int n = 0; n < 2; ++n) { bg[n] = *(const f32x4*)(bp + 4 * n); bu[n] = *(const f32x4*)(bp + 1024 + 4 * n); cg[n] = *(const f32x4*)(cp + 4 * n); cu[n] = *(const f32x4*)(cp + HALF + 4 * n); }
#pragma unroll
        for (int ai = 0; ai < 2; ++ai)
#pragma unroll
            for (int m = 0; m < 4; ++m) { const int row = row0 + ai * HALF + m * 16; const float r = rs[row]; bf16_t* rowp = O + (size_t)row * 1024 + col0;
                f32x4 g[2], up[2];
#pragma unroll
                for (int n = 0; n < 2; ++n) { const i32x4 ag = acc[ai][0][m][n], au = acc[ai][1][m][n];
                    g[n] = (f32x4){(float)ag[0], (float)ag[1], (float)ag[2], (float)ag[3]} * cg[n] * r + bg[n];
                    up[n] = (f32x4){(float)au[0], (float)au[1], (float)au[2], (float)au[3]} * cu[n] * r + bu[n]; }
                u32x4 w; w.x = cvt_pk_bf16(act1(g[0][0], up[0][0]), act1(g[0][1], up[0][1])); w.y = cvt_pk_bf16(act1(g[0][2], up[0][2]), act1(g[0][3], up[0][3]));
                w.z = cvt_pk_bf16(act1(g[1][0], up[1][0]), act1(g[1][1], up[1][1])); w.w = cvt_pk_bf16(act1(g[1][2], up[1][2]), act1(g[1][3], up[1][3]));
                *(u32x4*)rowp = w; }
    }
};
template <class Epi, class Sched, bool ALIGN_EPI = false, bool SP2 = false>
__device__ __forceinline__ void gemm_phase(PG8_LAS unsigned char* lds, const Gemm g, const Sched& S, const Epi& E) {
    const int tid = threadIdx.x, wid = __builtin_amdgcn_readfirstlane(tid >> 6), lane = tid & 63, wr = wid >> 2, wc = wid & 3, fr = lane & 15, fq = lane >> 4;
    const int K = g.K, nt = K / BK;
    unsigned voffA[2], voffB[2];
#pragma unroll
    for (int i = 0; i < 2; ++i) { int R, C; stage_rc(tid * 16 + i * 8192, R, C); const int Rb = Epi::PERM ? ((R & ~31) + perm32(R & 31)) : R;
        voffA[i] = (unsigned)(R * K + C) * 2u; voffB[i] = (unsigned)(Rb * K + C) * 2u; }
    const size_t kstep = (size_t)(BK * 2);
    const size_t hstep = (size_t)HALF * K * 2;
    const size_t tstep = 2 * hstep;
    const unsigned ldsw = (unsigned)wid * 1024u;
    const int aoff = lds_byte(wr * 64 + fr, fq * 8), boff = lds_byte(wc * 32 + fr, fq * 8);
#define PG8_SA(b, h) (((b) * 2 + (h)) * HTB)
#define PG8_SB(b, h) ((4 + (b) * 2 + (h)) * HTB)
#define PG8_STAGE(bufoff, gbase, voff) do { _Pragma("unroll") for (int _i = 0; _i < 2; ++_i) \
        __builtin_amdgcn_global_load_lds((const unsigned*)((const char*)(gbase) + (voff)[_i]), (PG8_LAS unsigned*)(lds + (bufoff) + ldsw + _i * 8192), 16, 0, 0); } while (0)
#define PG8_LDA(dst, b, h) do { _Pragma("unroll") for (int m = 0; m < 4; ++m) _Pragma("unroll") for (int k = 0; k < 2; ++k) dst[m][k] = *(const PG8_LAS bf16x8*)(lds + PG8_SA(b, h) + aoff + m * 2048 + k * 1024); } while (0)
#define PG8_LDB(dst, b, h) do { _Pragma("unroll") for (int n = 0; n < 2; ++n) _Pragma("unroll") for (int k = 0; k < 2; ++k) dst[n][k] = *(const PG8_LAS bf16x8*)(lds + PG8_SB(b, h) + boff + n * 2048 + k * 1024); } while (0)
#define PG8_MMA(ai, bj, At, Bt) do { __builtin_amdgcn_s_setprio(1); _Pragma("unroll") for (int m = 0; m < 4; ++m) _Pragma("unroll") for (int n = 0; n < 2; ++n) _Pragma("unroll") for (int k = 0; k < 2; ++k) \
        acc[ai][bj][m][n] = __builtin_amdgcn_mfma_f32_16x16x32_bf16(Bt[n][k], At[m][k], acc[ai][bj][m][n], 0, 0, 0); __builtin_amdgcn_s_setprio(0); } while (0)
#define PG8_WAIT_V(n) asm volatile("s_waitcnt vmcnt(" #n ")" ::: "memory")
#define PG8_WAIT_L(n) asm volatile("s_waitcnt lgkmcnt(" #n ")" ::: "memory")
#define PG8_BAR __builtin_amdgcn_s_barrier()
#define PG8_SCHED __builtin_amdgcn_sched_barrier(0)
    Unit cur, nxt; int ui = 0;
    if (!S.next(0, cur)) return;
    f32x4 acc[2][2][4][2];
#pragma unroll
    for (int a = 0; a < 2; ++a)
#pragma unroll
        for (int b = 0; b < 2; ++b)
#pragma unroll
            for (int m = 0; m < 4; ++m)
#pragma unroll
                for (int n = 0; n < 2; ++n) acc[a][b][m][n] = (f32x4){0.f, 0.f, 0.f, 0.f};
    bf16x8 At[4][2], B0[2][2], B1[2][2];
    const char* cA = (const char*)g.A + (size_t)cur.pm * tstep; const char* cB = (const char*)g.Bt + (size_t)cur.pb * tstep;
    S.a_ready(cur);
    if constexpr (SP2) {
        PG8_STAGE(PG8_SB(0, 0), cB, voffB); PG8_STAGE(PG8_SB(0, 1), cB + hstep, voffB); PG8_STAGE(PG8_SA(0, 0), cA, voffA); PG8_STAGE(PG8_SA(0, 1), cA + hstep, voffA);
        if (wr == 1) PG8_BAR;
        PG8_WAIT_V(2); PG8_BAR;
        PG8_STAGE(PG8_SB(1, 0), cB + kstep, voffB); PG8_STAGE(PG8_SA(1, 0), cA + kstep, voffA); PG8_STAGE(PG8_SB(1, 1), cB + hstep + kstep, voffB);
        PG8_WAIT_V(6); PG8_BAR;
    } else {
        PG8_STAGE(PG8_SB(0, 0), cB, voffB); PG8_STAGE(PG8_SA(0, 0), cA, voffA); PG8_STAGE(PG8_SB(0, 1), cB + hstep, voffB); PG8_STAGE(PG8_SA(0, 1), cA + hstep, voffA);
        if (wr == 1) PG8_BAR;
        PG8_WAIT_V(4); PG8_BAR;
        PG8_STAGE(PG8_SB(1, 0), cB + kstep, voffB); PG8_STAGE(PG8_SA(1, 0), cA + kstep, voffA); PG8_STAGE(PG8_SB(1, 1), cB + hstep + kstep, voffB);
        PG8_WAIT_V(6); PG8_BAR;
    }
    for (;;) {
        const bool has_next = S.next(ui + 1, nxt);
        const char* nA = has_next ? (const char*)g.A + (size_t)nxt.pm * tstep : cA; const char* nB = has_next ? (const char*)g.Bt + (size_t)nxt.pb * tstep : cB;
        for (int t = 0; t < nt; t += 2) {
            const bool last = (t == nt - 2);
            const char* a1 = cA + (size_t)(t + 1) * kstep;
            const char* a2 = last ? nA : cA + (size_t)(t + 2) * kstep; const char* b2 = last ? nB : cB + (size_t)(t + 2) * kstep;
            const char* a3 = a2 + kstep; const char* b3 = b2 + kstep;
            if (last && has_next) S.a_ready(nxt);
            if constexpr (SP2) {
            PG8_LDB(B0, 0, 0); PG8_LDB(B1, 0, 1); PG8_SCHED; PG8_LDA(At, 0, 0); PG8_STAGE(PG8_SA(1, 1), a1 + hstep, voffA);
            PG8_WAIT_V(8); PG8_WAIT_L(0); PG8_BAR; PG8_MMA(0, 0, At, B0); PG8_MMA(0, 1, At, B1); PG8_BAR; PG8_SCHED;
            PG8_LDA(At, 0, 1); PG8_STAGE(PG8_SB(0, 0), b2, voffB); PG8_STAGE(PG8_SB(0, 1), b2 + hstep, voffB); PG8_STAGE(PG8_SA(0, 0), a2, voffA);
            PG8_WAIT_V(8); PG8_WAIT_L(0); PG8_BAR; PG8_MMA(1, 0, At, B0); PG8_MMA(1, 1, At, B1); PG8_BAR; PG8_SCHED;
            PG8_LDB(B0, 1, 0); PG8_LDB(B1, 1, 1); PG8_SCHED; PG8_LDA(At, 1, 0); PG8_STAGE(PG8_SA(0, 1), a2 + hstep, voffA);
            PG8_WAIT_V(8); PG8_WAIT_L(0); PG8_BAR; PG8_MMA(0, 0, At, B0); PG8_MMA(0, 1, At, B1); PG8_BAR; PG8_SCHED;
            PG8_LDA(At, 1, 1); PG8_STAGE(PG8_SB(1, 0), b3, voffB); PG8_STAGE(PG8_SB(1, 1), b3 + hstep, voffB); PG8_STAGE(PG8_SA(1, 0), a3, voffA);
            PG8_WAIT_V(8); PG8_WAIT_L(0); PG8_BAR; PG8_MMA(1, 0, At, B0); PG8_MMA(1, 1, At, B1); PG8_BAR; PG8_SCHED;
            } else {
            PG8_LDB(B0, 0, 0); PG8_SCHED; PG8_LDA(At, 0, 0); PG8_STAGE(PG8_SA(1, 1), a1 + hstep, voffA);
            PG8_WAIT_L(8); PG8_BAR; PG8_WAIT_L(0); PG8_MMA(0, 0, At, B0); PG8_BAR; PG8_SCHED;
            PG8_LDB(B1, 0, 1); PG8_STAGE(PG8_SB(0, 0), b2, voffB);
            PG8_BAR; PG8_WAIT_L(0); PG8_MMA(0, 1, At, B1); PG8_BAR;
            PG8_LDA(At, 0, 1); PG8_STAGE(PG8_SA(0, 0), a2, voffA);
            PG8_BAR; PG8_WAIT_L(0); PG8_MMA(1, 0, At, B0); PG8_BAR; PG8_SCHED;
            PG8_STAGE(PG8_SB(0, 1), b2 + hstep, voffB);
            PG8_WAIT_V(6); PG8_BAR; PG8_MMA(1, 1, At, B1); PG8_BAR;
            PG8_LDB(B0, 1, 0); PG8_SCHED; PG8_LDA(At, 1, 0); PG8_STAGE(PG8_SA(0, 1), a2 + hstep, voffA);
            PG8_WAIT_L(8); PG8_BAR; PG8_WAIT_L(0); PG8_MMA(0, 0, At, B0); PG8_BAR; PG8_SCHED;
            PG8_LDB(B1, 1, 1); PG8_STAGE(PG8_SB(1, 0), b3, voffB);
            PG8_BAR; PG8_WAIT_L(0); PG8_MMA(0, 1, At, B1); PG8_BAR;
            PG8_LDA(At, 1, 1); PG8_STAGE(PG8_SA(1, 0), a3, voffA);
            PG8_BAR; PG8_WAIT_L(0); PG8_MMA(1, 0, At, B0); PG8_BAR; PG8_SCHED;
            PG8_STAGE(PG8_SB(1, 1), b3 + hstep, voffB);
            PG8_WAIT_V(6); PG8_BAR; PG8_MMA(1, 1, At, B1); PG8_BAR;
            }
        }
        if constexpr (ALIGN_EPI) { if (wr == 0) PG8_BAR; }
        if constexpr (!Epi::AFTER_DRAIN) { E(acc, cur, wr, wc, fr, fq); S.done(cur); }
        if (!has_next) break;
#pragma unroll
        for (int a = 0; a < 2; ++a)
#pragma unroll
            for (int b = 0; b < 2; ++b)
#pragma unroll
                for (int m = 0; m < 4; ++m)
#pragma unroll
                    for (int n = 0; n < 2; ++n) acc[a][b][m][n] = (f32x4){0.f, 0.f, 0.f, 0.f};
        cur = nxt; cA = nA; cB = nB; ++ui;
        if constexpr (ALIGN_EPI) { if (wr == 1) PG8_BAR; }
    }
    PG8_WAIT_V(0);
    if constexpr (!ALIGN_EPI) { if (wr == 0) PG8_BAR; }
    PG8_BAR;
    if constexpr (Epi::AFTER_DRAIN) { E.fused(acc, cur, wr, wc, fr, fq, lds, wid, lane); S.done(cur); }
#undef PG8_SA
#undef PG8_SB
#undef PG8_STAGE
#undef PG8_LDA
#undef PG8_LDB
#undef PG8_MMA
#undef PG8_WAIT_V
#undef PG8_WAIT_L
#undef PG8_BAR
#undef PG8_SCHED
}
template <class Epi, class Sched, bool ALIGN_EPI = false, bool SP2 = false>
__device__ __forceinline__ void gemm_phase_i8(PG8_LAS unsigned char* lds, const Gemm g, const Sched& S, const Epi& E) {
    const int tid = threadIdx.x, wid = __builtin_amdgcn_readfirstlane(tid >> 6), lane = tid & 63, wr = wid >> 2, wc = wid & 3, fr = lane & 15, fq = lane >> 4;
    const int K = g.K, nt = K / 128;
    unsigned voffA[2], voffB[2];
#pragma unroll
    for (int i = 0; i < 2; ++i) { int R, C; stage_rc(tid * 16 + i * 8192, R, C); const int Rb = Epi::PERM ? ((R & ~31) + perm32(R & 31)) : R;
        voffA[i] = (unsigned)(R * K + C * 2); voffB[i] = (unsigned)(Rb * K + C * 2); }
    const size_t kstep = (size_t)(BK * 2);
    const size_t hstep = (size_t)HALF * K;
    const size_t tstep = 2 * hstep;
    const unsigned ldsw = (unsigned)wid * 1024u;
    const int aoff = lds_byte(wr * 64 + fr, fq * 8), boff = lds_byte(wc * 32 + fr, fq * 8);
#define PG8_SA(b, h) (((b) * 2 + (h)) * HTB)
#define PG8_SB(b, h) ((4 + (b) * 2 + (h)) * HTB)
#define PG8_STAGE(bufoff, gbase, voff) do { _Pragma("unroll") for (int _i = 0; _i < 2; ++_i) \
        __builtin_amdgcn_global_load_lds((const unsigned*)((const char*)(gbase) + (voff)[_i]), (PG8_LAS unsigned*)(lds + (bufoff) + ldsw + _i * 8192), 16, 0, 0); } while (0)
#define PG8_LDA(dst, b, h) do { _Pragma("unroll") for (int m = 0; m < 4; ++m) _Pragma("unroll") for (int k = 0; k < 2; ++k) dst[m][k] = *(const PG8_LAS bf16x8*)(lds + PG8_SA(b, h) + aoff + m * 2048 + k * 1024); } while (0)
#define PG8_LDB(dst, b, h) do { _Pragma("unroll") for (int n = 0; n < 2; ++n) _Pragma("unroll") for (int k = 0; k < 2; ++k) dst[n][k] = *(const PG8_LAS bf16x8*)(lds + PG8_SB(b, h) + boff + n * 2048 + k * 1024); } while (0)
#define PG8_MMA(ai, bj, At, Bt) do { __builtin_amdgcn_s_setprio(1); _Pragma("unroll") for (int m = 0; m < 4; ++m) _Pragma("unroll") for (int n = 0; n < 2; ++n) _Pragma("unroll") for (int k = 0; k < 2; ++k) \
        acc[ai][bj][m][n] = __builtin_amdgcn_mfma_i32_16x16x64_i8(__builtin_bit_cast(i32x4, Bt[n][k]), __builtin_bit_cast(i32x4, At[m][k]), acc[ai][bj][m][n], 0, 0, 0); __builtin_amdgcn_s_setprio(0); } while (0)
#define PG8_WAIT_V(n) asm volatile("s_waitcnt vmcnt(" #n ")" ::: "memory")
#define PG8_WAIT_L(n) asm volatile("s_waitcnt lgkmcnt(" #n ")" ::: "memory")
#define PG8_BAR __builtin_amdgcn_s_barrier()
#define PG8_SCHED __builtin_amdgcn_sched_barrier(0)
    Unit cur, nxt; int ui = 0;
    if (!S.next(0, cur)) return;
    i32x4 acc[2][2][4][2];
#pragma unroll
    for (int a = 0; a < 2; ++a)
#pragma unroll
        for (int b = 0; b < 2; ++b)
#pragma unroll
            for (int m = 0; m < 4; ++m)
#pragma unroll
                for (int n = 0; n < 2; ++n) acc[a][b][m][n] = (i32x4){0, 0, 0, 0};
    bf16x8 At[4][2], B0[2][2], B1[2][2];
    const char* cA = (const char*)g.A + (size_t)cur.pm * tstep; const char* cB = (const char*)g.Bt + (size_t)cur.pb * tstep;
    S.a_ready(cur);
    if constexpr (SP2) {
        PG8_STAGE(PG8_SB(0, 0), cB, voffB); PG8_STAGE(PG8_SB(0, 1), cB + hstep, voffB); PG8_STAGE(PG8_SA(0, 0), cA, voffA); PG8_STAGE(PG8_SA(0, 1), cA + hstep, voffA);
        if (wr == 1) PG8_BAR;
        PG8_WAIT_V(2); PG8_BAR;
        PG8_STAGE(PG8_SB(1, 0), cB + kstep, voffB); PG8_STAGE(PG8_SA(1, 0), cA + kstep, voffA); PG8_STAGE(PG8_SB(1, 1), cB + hstep + kstep, voffB);
        PG8_WAIT_V(6); PG8_BAR;
    } else {
        PG8_STAGE(PG8_SB(0, 0), cB, voffB); PG8_STAGE(PG8_SA(0, 0), cA, voffA); PG8_STAGE(PG8_SB(0, 1), cB + hstep, voffB); PG8_STAGE(PG8_SA(0, 1), cA + hstep, voffA);
        if (wr == 1) PG8_BAR;
        PG8_WAIT_V(4); PG8_BAR;
        PG8_STAGE(PG8_SB(1, 0), cB + kstep, voffB); PG8_STAGE(PG8_SA(1, 0), cA + kstep, voffA); PG8_STAGE(PG8_SB(1, 1), cB + hstep + kstep, voffB);
        PG8_WAIT_V(6); PG8_BAR;
    }
    for (;;) {
        const bool has_next = S.next(ui + 1, nxt);
        const char* nA = has_next ? (const char*)g.A + (size_t)nxt.pm * tstep : cA; const char* nB = has_next ? (const char*)g.Bt + (size_t)nxt.pb * tstep : cB;
        for (int t = 0; t < nt; t += 2) {
            const bool last = (t == nt - 2);
            const char* a1 = cA + (size_t)(t + 1) * kstep;
            const char* a2 = last ? nA : cA + (size_t)(t + 2) * kstep; const char* b2 = last ? nB : cB + (size_t)(t + 2) * kstep;
            const char* a3 = a2 + kstep; const char* b3 = b2 + kstep;
            if (last && has_next) S.a_ready(nxt);
            if constexpr (SP2) {
            PG8_LDB(B0, 0, 0); PG8_LDB(B1, 0, 1); PG8_SCHED; PG8_LDA(At, 0, 0); PG8_STAGE(PG8_SA(1, 1), a1 + hstep, voffA);
            PG8_WAIT_V(8); PG8_WAIT_L(0); PG8_BAR; PG8_MMA(0, 0, At, B0); PG8_MMA(0, 1, At, B1); PG8_BAR; PG8_SCHED;
            PG8_LDA(At, 0, 1); PG8_STAGE(PG8_SB(0, 0), b2, voffB); PG8_STAGE(PG8_SB(0, 1), b2 + hstep, voffB); PG8_STAGE(PG8_SA(0, 0), a2, voffA);
            PG8_WAIT_V(8); PG8_WAIT_L(0); PG8_BAR; PG8_MMA(1, 0, At, B0); PG8_MMA(1, 1, At, B1); PG8_BAR; PG8_SCHED;
            PG8_LDB(B0, 1, 0); PG8_LDB(B1, 1, 1); PG8_SCHED; PG8_LDA(At, 1, 0); PG8_STAGE(PG8_SA(0, 1), a2 + hstep, voffA);
            PG8_WAIT_V(8); PG8_WAIT_L(0); PG8_BAR; PG8_MMA(0, 0, At, B0); PG8_MMA(0, 1, At, B1); PG8_BAR; PG8_SCHED;
            PG8_LDA(At, 1, 1); PG8_STAGE(PG8_SB(1, 0), b3, voffB); PG8_STAGE(PG8_SB(1, 1), b3 + hstep, voffB); PG8_STAGE(PG8_SA(1, 0), a3, voffA);
            PG8_WAIT_V(8); PG8_WAIT_L(0); PG8_BAR; PG8_MMA(1, 0, At, B0); PG8_MMA(1, 1, At, B1); PG8_BAR; PG8_SCHED;
            } else {
            PG8_LDB(B0, 0, 0); PG8_SCHED; PG8_LDA(At, 0, 0); PG8_STAGE(PG8_SA(1, 1), a1 + hstep, voffA);
            PG8_WAIT_L(8); PG8_BAR; PG8_WAIT_L(0); PG8_MMA(0, 0, At, B0); PG8_BAR; PG8_SCHED;
            PG8_LDB(B1, 0, 1); PG8_STAGE(PG8_SB(0, 0), b2, voffB);
            PG8_BAR; PG8_WAIT_L(0); PG8_MMA(0, 1, At, B1); PG8_BAR;
            PG8_LDA(At, 0, 1); PG8_STAGE(PG8_SA(0, 0), a2, voffA);
            PG8_BAR; PG8_WAIT_L(0); PG8_MMA(1, 0, At, B0); PG8_BAR; PG8_SCHED;
            PG8_STAGE(PG8_SB(0, 1), b2 + hstep, voffB);
            PG8_WAIT_V(6); PG8_BAR; PG8_MMA(1, 1, At, B1); PG8_BAR;
            PG8_LDB(B0, 1, 0); PG8_SCHED; PG8_LDA(At, 1, 0); PG8_STAGE(PG8_SA(0, 1), a2 + hstep, voffA);
            PG8_WAIT_L(8); PG8_BAR; PG8_WAIT_L(0); PG8_MMA(0, 0, At, B0); PG8_BAR; PG8_SCHED;
            PG8_LDB(B1, 1, 1); PG8_STAGE(PG8_SB(1, 0), b3, voffB);
            PG8_BAR; PG8_WAIT_L(0); PG8_MMA(0, 1, At, B1); PG8_BAR;
            PG8_LDA(At, 1, 1); PG8_STAGE(PG8_SA(1, 0), a3, voffA);
            PG8_BAR; PG8_WAIT_L(0); PG8_MMA(1, 0, At, B0); PG8_BAR; PG8_SCHED;
            PG8_STAGE(PG8_SB(1, 1), b3 + hstep, voffB);
            PG8_WAIT_V(6); PG8_BAR; PG8_MMA(1, 1, At, B1); PG8_BAR;
            }
        }
        if constexpr (ALIGN_EPI) { if (wr == 0) PG8_BAR; }
        if constexpr (!Epi::AFTER_DRAIN) { E(acc, cur, wr, wc, fr, fq); S.done(cur); }
        if (!has_next) break;
#pragma unroll
        for (int a = 0; a < 2; ++a)
#pragma unroll
            for (int b = 0; b < 2; ++b)
#pragma unroll
                for (int m = 0; m < 4; ++m)
#pragma unroll
                    for (int n = 0; n < 2; ++n) acc[a][b][m][n] = (i32x4){0, 0, 0, 0};
        cur = nxt; cA = nA; cB = nB; ++ui;
        if constexpr (ALIGN_EPI) { if (wr == 1) PG8_BAR; }
    }
    PG8_WAIT_V(0);
    if constexpr (!ALIGN_EPI) { if (wr == 0) PG8_BAR; }
    PG8_BAR;
    if constexpr (Epi::AFTER_DRAIN) { E.fused(acc, cur, wr, wc, fr, fq, lds, wid, lane); S.done(cur); }
#undef PG8_SA
#undef PG8_SB
#undef PG8_STAGE
#undef PG8_LDA
#undef PG8_LDB
#undef PG8_MMA
#undef PG8_WAIT_V
#undef PG8_WAIT_L
#undef PG8_BAR
#undef PG8_SCHED
}

}

constexpr int NWAVES = 8;
constexpr int D = 1024, BATCH = 2, T = 8192, TC = 256, NH = 16;
constexpr int ML = BATCH * T;
constexpr int MC = BATCH * TC;
constexpr int MT = ML + MC;
constexpr int N_IN = 8576, NZ = 8704;
constexpr int K_OFF = 0, V_OFF = 1024, DECAY_OFF = 2048, ICLR_OFF = 2176, STATE_COLS = 2304, R_OFF = 2304, GLORA_OFF = 3328, SHIFT_COLS = 3456;
constexpr int CONV_OFF = 3456, GATE_OFF = 6528;
constexpr int NE = 32, TOPK = 4, DFF = 1024;
constexpr int NL = 5120, KL = 384;
constexpr int MAXBLK = 288;
constexpr int NROWS = MAXBLK * 256;
constexpr int KSPLIT = 16;

constexpr size_t MiB = 1u << 20;
constexpr size_t WS_CTL = 0, CTL_ZERO_BYTES = 1 * MiB;
constexpr size_t WS_MODP = 1 * MiB;
constexpr size_t WS_WLORA = 3 * MiB;
constexpr size_t WS_WROUT = 7 * MiB;
constexpr size_t WS_WOUT = 8 * MiB;
constexpr size_t WS_WIN = 10 * MiB;
constexpr size_t WS_A0 = 28 * MiB;
constexpr size_t WS_MISC = 61 * MiB;
constexpr size_t WS_Z = 64 * MiB;
constexpr size_t WS_AL = 345 * MiB;
constexpr size_t WS_LORA = 358 * MiB;
constexpr size_t WS_SCAN = 523 * MiB;
constexpr size_t WS_Y = 886 * MiB;
constexpr size_t WS_END = 1014 * MiB;
constexpr size_t WS_PQ = WS_SCAN;
constexpr size_t WS_TKN = WS_PQ + 132 * MiB;
constexpr size_t WS_UPRE = WS_TKN + 66 * MiB;
constexpr size_t WS_H0T = WS_UPRE + 66 * MiB;
static_assert(WS_H0T + 64 * MiB <= WS_Y, "scan region");
constexpr size_t WS_MIX = WS_LORA, WS_X1 = WS_LORA + 64 * MiB, WS_H2 = WS_LORA + 128 * MiB;
constexpr size_t WS_LOGIT = WS_SCAN, WS_XB = WS_SCAN + 16 * MiB, WS_ACT = WS_XB + 144 * MiB;
constexpr size_t WS_Y2 = WS_Z, WS_WEIN = WS_Y, WS_WEOUT = WS_Z + 144 * MiB;
static_assert(WS_ACT + 144 * MiB <= WS_Y && WS_WEIN + 128 * MiB <= WS_END && WS_WEOUT + 64 * MiB <= WS_AL, "late regions");
constexpr size_t MI_SELE = WS_MISC, MI_SELP = MI_SELE + (size_t)ML * 4 * 4, MI_GATE = MI_SELP + (size_t)ML * 4 * 4, MI_DEST = MI_GATE + (size_t)ML * 4 * 4, MI_BLKE = MI_DEST + (size_t)ML * 4 * 4;
constexpr size_t MI_RSH = MI_BLKE + 4096;
constexpr size_t MI_CSWIN = MI_RSH + (size_t)MT * 4;
constexpr size_t MI_RSH2 = MI_CSWIN + (size_t)NZ * 4;
constexpr size_t MI_RSXB = MI_RSH2 + (size_t)ML * 4;
constexpr size_t MI_CSWEI = MI_RSXB + (size_t)NROWS * 4;
static_assert(MI_CSWEI + (size_t)NE * 2048 * 4 <= WS_Z && MI_RSH % 16 == 0 && MI_CSWIN % 16 == 0 && MI_CSWEI % 16 == 0, "misc");
constexpr size_t WS_H2Q = WS_A0;
constexpr int CW_BAR = 4096;
constexpr int CW_CNT = 16384;
constexpr int CW_FB = 8192;
constexpr int CW_Q6 = CW_CNT + 64 * 40;

constexpr int RING_OFF = 0, RING_BYTES = 131072;
constexpr int LDSCTL_OFF = 147456, MISC_OFF = LDSCTL_OFF + 320;
constexpr int LDS_X_OFF = LDSCTL_OFF + 512;
constexpr int LDS_BYTES = 163840;

#define GAS __attribute__((address_space(1)))
#define LAS __attribute__((address_space(3)))
typedef unsigned short bf16;
typedef unsigned v4u __attribute__((ext_vector_type(4)));
typedef unsigned v2u __attribute__((ext_vector_type(2)));
typedef float f32x4 __attribute__((ext_vector_type(4)));
#define LDS_WAIT() asm volatile("s_waitcnt lgkmcnt(0)" ::: "memory")
#define VM_WAIT() asm volatile("s_waitcnt vmcnt(0)" ::: "memory")
__device__ __forceinline__ unsigned f2bf(float f) { unsigned u = __builtin_bit_cast(unsigned, f); return (u + 0x7fffu + ((u >> 16) & 1u)) >> 16; }
__device__ __forceinline__ unsigned pk2(float lo, float hi) { return f2bf(lo) | (f2bf(hi) << 16); }
__device__ __forceinline__ float bflo(unsigned w) { return __builtin_bit_cast(float, w << 16); }
__device__ __forceinline__ float bfhi(unsigned w) { return __builtin_bit_cast(float, w & 0xffff0000u); }
__device__ __forceinline__ float bf1(bf16 h) { return __builtin_bit_cast(float, (unsigned)h << 16); }
__device__ __forceinline__ void ld16bf(const bf16* p, float (&o)[16]) {
    const v4u a = *(const v4u*)p, b = *(const v4u*)(p + 8);
    o[0] = bflo(a.x); o[1] = bfhi(a.x); o[2] = bflo(a.y); o[3] = bfhi(a.y); o[4] = bflo(a.z); o[5] = bfhi(a.z); o[6] = bflo(a.w); o[7] = bfhi(a.w);
    o[8] = bflo(b.x); o[9] = bfhi(b.x); o[10] = bflo(b.y); o[11] = bfhi(b.y); o[12] = bflo(b.z); o[13] = bfhi(b.z); o[14] = bflo(b.w); o[15] = bfhi(b.w);
}
__device__ __forceinline__ void st16bf(bf16* p, const float (&o)[16]) {
    v4u a, b; a.x = pk2(o[0], o[1]); a.y = pk2(o[2], o[3]); a.z = pk2(o[4], o[5]); a.w = pk2(o[6], o[7]);
    b.x = pk2(o[8], o[9]); b.y = pk2(o[10], o[11]); b.z = pk2(o[12], o[13]); b.w = pk2(o[14], o[15]);
    *(v4u*)p = a; *(v4u*)(p + 8) = b;
}
__device__ __forceinline__ void ld16f(const float* p, float (&o)[16]) {
#pragma unroll
    for (int q = 0; q < 4; ++q) { const f32x4 v = *(const f32x4*)(p + 4 * q); o[4 * q] = v.x; o[4 * q + 1] = v.y; o[4 * q + 2] = v.z; o[4 * q + 3] = v.w; }
}
__device__ __forceinline__ void ld16f_lds(const LAS float* p, float (&o)[16]) {
#pragma unroll
    for (int q = 0; q < 4; ++q) { const f32x4 v = *(const LAS f32x4*)(p + 4 * q); o[4 * q] = v.x; o[4 * q + 1] = v.y; o[4 * q + 2] = v.z; o[4 * q + 3] = v.w; }
}
__device__ __forceinline__ void st16f(float* p, const float (&o)[16]) {
#pragma unroll
    for (int q = 0; q < 4; ++q) *(f32x4*)(p + 4 * q) = (f32x4){o[4 * q], o[4 * q + 1], o[4 * q + 2], o[4 * q + 3]};
}
__device__ __forceinline__ float sigmoidf_(float x) { return 1.0f / (1.0f + __expf(-x)); }
__device__ __forceinline__ float wave_sum(float v) {
#pragma unroll
    for (int o = 1; o < 64; o <<= 1) v += __shfl_xor(v, o);
    return v;
}
__device__ __forceinline__ float wave_max(float v) {
#pragma unroll
    for (int o = 1; o < 64; o <<= 1) v = fmaxf(v, __shfl_xor(v, o));
    return v;
}
__device__ __forceinline__ unsigned pack_q4(float a, float b, float c, float d) {
    const int qa = __float2int_rn(a), qb = __float2int_rn(b), qc = __float2int_rn(c), qd = __float2int_rn(d);
    return (unsigned)(qa & 255) | ((unsigned)(qb & 255) << 8) | ((unsigned)(qc & 255) << 16) | ((unsigned)qd << 24);
}
__device__ __forceinline__ float quad_sum(float v) { v += __shfl_xor(v, 1); v += __shfl_xor(v, 2); return v; }

#define XB_TMO      128
#define XB_XCNT(j)  (256  + 64 * (j))
#define XB_XSUB(j)  (1280 + 64 * (j))
#define XB_XGEN(j)  (2304 + 64 * (j))
#define XB_TOP      3328
#define XB_TOPGEN   3392
#define XCD_BAR_WORDS 3456
#define XB_SPIN_CAP (1u << 18)

__device__ __forceinline__ unsigned xb_ld(unsigned* p)              { return __hip_atomic_load(p, __ATOMIC_RELAXED, __HIP_MEMORY_SCOPE_AGENT); }
__device__ __forceinline__ unsigned xb_add(unsigned* p, unsigned v) { return __hip_atomic_fetch_add(p, v, __ATOMIC_RELAXED, __HIP_MEMORY_SCOPE_AGENT); }
__device__ __forceinline__ unsigned xb_xcc_id() { return (unsigned)__builtin_amdgcn_s_getreg((3 << 11) | 20) & 0xFu; }
#define XB_SPIN(cond, bar) do { unsigned _sp = 0; while (cond) { __builtin_amdgcn_s_sleep(1); \
    if ((++_sp & 255u) == 0u) { if (xb_ld(&(bar)[XB_TMO])) break; if (_sp > XB_SPIN_CAP) { atomicAdd(&(bar)[XB_TMO], 1u); break; } } } } while (0)

struct XcdBarrier { unsigned* bar; unsigned x; volatile LAS unsigned* st; };

__device__ __forceinline__ XcdBarrier xcd_barrier_post(unsigned* bar, volatile LAS unsigned* st) {
    XcdBarrier b; b.bar = bar; b.x = xb_xcc_id(); b.st = st;
    if (threadIdx.x == 0) (void)xb_add(&bar[XB_XCNT(b.x)], 1u);
    return b;
}
__device__ __forceinline__ void xcd_barrier_complete(unsigned* bar, unsigned x, unsigned& nloc, unsigned& nx) {
    const unsigned G = gridDim.x * gridDim.y * gridDim.z;
    unsigned sum, cnt, mine, sp = 0u;
    for (;;) {
        sum = 0u; cnt = 0u; mine = 0u;
#pragma unroll
        for (unsigned j = 0; j < 16; ++j) { const unsigned c = xb_ld(&bar[XB_XCNT(j)]); sum += c; cnt += (c > 0u) ? 1u : 0u; mine = (j == x) ? c : mine; }
        if (sum == G) break;
        __builtin_amdgcn_s_sleep(1);
        if ((++sp & 255u) == 0u) { if (xb_ld(&bar[XB_TMO])) break; if (sp > XB_SPIN_CAP) { atomicAdd(&bar[XB_TMO], 1u); break; } }
    }
    nloc = mine > 0u ? mine : 1u; nx = cnt > 0u ? cnt : 1u;
}
__device__ __forceinline__ void xcd_barrier(const XcdBarrier& b) {
    asm volatile("s_waitcnt vmcnt(0)" ::: "memory");
    __syncthreads();
    if (threadIdx.x == 0) {
        unsigned* bar = b.bar;
        __builtin_amdgcn_s_waitcnt(0);
        unsigned nloc = b.st[0], nx = b.st[1];
        if (nloc == 0u) { xcd_barrier_complete(bar, b.x, nloc, nx); b.st[0] = nloc; b.st[1] = nx; }
        const unsigned old = xb_add(&bar[XB_XSUB(b.x)], 1u);
        const unsigned gen = old / nloc;
        if (old + 1u == (gen + 1u) * nloc) {
            __builtin_amdgcn_fence(__ATOMIC_RELEASE, "agent");
            asm volatile("s_waitcnt vmcnt(0)" ::: "memory");
            const unsigned og = xb_add(&bar[XB_TOP], 1u);
            const unsigned tg = og / nx;
            if (og + 1u == (tg + 1u) * nx) xb_add(&bar[XB_TOPGEN], 1u);
            else XB_SPIN(xb_ld(&bar[XB_TOPGEN]) == tg, bar);
            __builtin_amdgcn_fence(__ATOMIC_ACQUIRE, "agent");
            xb_add(&bar[XB_XGEN(b.x)], 1u);
            asm volatile("s_waitcnt vmcnt(0)" ::: "memory");
        } else {
            XB_SPIN(xb_ld(&bar[XB_XGEN(b.x)]) == gen, bar);
            __builtin_amdgcn_fence(__ATOMIC_ACQUIRE, "agent");
            asm volatile("s_waitcnt vmcnt(0)" ::: "memory");
        }
    }
    __syncthreads();
}

#define XB_DONE(j)  (3456 + 64 * (j))
__device__ __forceinline__ void xcd_barrier2(const XcdBarrier& b) {
    asm volatile("s_waitcnt vmcnt(0)" ::: "memory");
    __syncthreads();
    if (threadIdx.x == 0) {
        unsigned* bar = b.bar;
        __builtin_amdgcn_s_waitcnt(0);
        unsigned nloc = b.st[0], nx = b.st[1];
        if (nloc == 0u) { xcd_barrier_complete(bar, b.x, nloc, nx); b.st[0] = nloc; b.st[1] = nx; }
        const unsigned old = xb_add(&bar[XB_XSUB(b.x)], 1u);
        const unsigned gen = old / nloc;
        if (old + 1u == (gen + 1u) * nloc) {
            __builtin_amdgcn_fence(__ATOMIC_RELEASE, "agent");
            asm volatile("s_waitcnt vmcnt(0)" ::: "memory");
#pragma unroll
            for (unsigned j = 0; j < 16; ++j) (void)xb_add(&bar[XB_DONE(j)], 1u);
        }
        XB_SPIN(xb_ld(&bar[XB_DONE(b.x)]) < (gen + 1u) * nx, bar);
        __builtin_amdgcn_fence(__ATOMIC_ACQUIRE, "agent");
        asm volatile("s_waitcnt vmcnt(0)" ::: "memory");
    }
    __syncthreads();
}

#define FB_WORD(j) (64 * (j))
#define FB_TMO 640
__device__ __forceinline__ void flat_barrier(unsigned* fb, unsigned epoch) {
    asm volatile("s_waitcnt vmcnt(0)" ::: "memory");
    __syncthreads();
    if (threadIdx.x == 0) {
        __builtin_amdgcn_s_waitcnt(0);
        __builtin_amdgcn_fence(__ATOMIC_RELEASE, "agent");
        asm volatile("s_waitcnt vmcnt(0)" ::: "memory");
        (void)xb_add(&fb[FB_WORD(blockIdx.x & 7u)], 1u);
        const unsigned want = epoch * gridDim.x; unsigned sp = 0u;
        for (;;) {
            unsigned s = 0u;
#pragma unroll
            for (int j = 0; j < 8; ++j) s += xb_ld(&fb[FB_WORD(j)]);
            if (s >= want) break;
            __builtin_amdgcn_s_sleep(1);
            if ((++sp & 255u) == 0u) { if (xb_ld(&fb[FB_TMO])) break; if (sp > XB_SPIN_CAP) { atomicAdd(&fb[FB_TMO], 1u); break; } }
        }
        __builtin_amdgcn_fence(__ATOMIC_ACQUIRE, "agent");
        asm volatile("s_waitcnt vmcnt(0)" ::: "memory");
    }
    __syncthreads();
}

struct Frame {
    LAS unsigned char* lds;
    volatile LAS unsigned* MISC;
    unsigned* ctl;
    int tid, lane, wave, G, gw, NGW;
    float* out;
    unsigned char* ws;
};
enum { I_X = 0, I_C, I_CTX, I_CCTX, I_WADA, I_BADA, I_NPM, I_NQM, I_NPF, I_NQF, I_WIN, I_MU, I_W0, I_WDU, I_A0, I_WIU, I_KK, I_KA, I_RK, I_WGU, I_LNW, I_LNB, I_CONVW,
       I_WOUT, I_WR, I_BR, I_WEI, I_BEI, I_WEO, I_BEO };


typedef const float* fptr_t;
__device__ __forceinline__ fptr_t kin_ptr(int i) { const volatile __attribute__((address_space(4))) fptr_t* ka = (const volatile __attribute__((address_space(4))) fptr_t*)__builtin_amdgcn_kernarg_segment_ptr(); return ka[i]; }
#define KIN(i) kin_ptr(i)
__device__ __forceinline__ void transpose_item(const float* W, int N, int k0, int n0, bf16* WT, int ldk, int rowbase, LAS float* scr, int lane) {
#pragma unroll 8
    for (int i = 0; i < 32; ++i) { const int kk = 2 * i + (lane >> 5); scr[kk * 33 + (lane & 31)] = W[(size_t)(k0 + kk) * N + n0 + (lane & 31)]; }
    LDS_WAIT(); asm volatile("" ::: "memory");
    const int c = lane & 7;
#pragma unroll
    for (int j = 0; j < 4; ++j) { const int n = (lane >> 3) + 8 * j; const LAS float* s = scr + (8 * c) * 33 + n;
        v4u o; o.x = pk2(s[0 * 33], s[1 * 33]); o.y = pk2(s[2 * 33], s[3 * 33]); o.z = pk2(s[4 * 33], s[5 * 33]); o.w = pk2(s[6 * 33], s[7 * 33]);
        *(v4u*)(WT + (size_t)(rowbase + n) * ldk + k0 + 8 * c) = o; }
    LDS_WAIT(); asm volatile("" ::: "memory");
}

__device__ __forceinline__ unsigned pack_q4c(float a, float b, float c, float d) {
    const int qa = __float2int_rn(fminf(fmaxf(a, -127.f), 127.f)), qb = __float2int_rn(fminf(fmaxf(b, -127.f), 127.f)), qc = __float2int_rn(fminf(fmaxf(c, -127.f), 127.f)), qd = __float2int_rn(fminf(fmaxf(d, -127.f), 127.f));
    return (unsigned)(qa & 255) | ((unsigned)(qb & 255) << 8) | ((unsigned)(qc & 255) << 16) | ((unsigned)qd << 24);
}
__device__ __forceinline__ void q8_item(const float* W, int N, int n0, signed char* WT, float* cs, int rowbase, LAS float* scr, int lane, int kb0 = 0, int kb1 = 16) {
    const int r8 = lane >> 3, c4 = lane & 7;
    const float* p0 = W + (size_t)r8 * N + n0 + 4 * c4;
    f32x4 ss = {0.f, 0.f, 0.f, 0.f};
#pragma unroll 8
    for (int i = 0; i < 32; ++i) { const f32x4 v = *(const f32x4*)(p0 + (size_t)(8 * i) * N); ss += v * v; }
#pragma unroll
    for (int o = 8; o < 64; o <<= 1) { ss.x += __shfl_xor(ss.x, o); ss.y += __shfl_xor(ss.y, o); ss.z += __shfl_xor(ss.z, o); ss.w += __shfl_xor(ss.w, o); }
    if (lane < 8) {
#pragma unroll
        for (int q = 0; q < 4; ++q) { const float m = 6.0f * sqrtf(ss[q] * (1.0f / 256.0f)); cs[rowbase + 4 * lane + q] = m * (1.0f / 127.0f); scr[2112 + 4 * lane + q] = m > 0.f ? 127.0f / m : 0.f; } }
    LDS_WAIT(); asm volatile("" ::: "memory");
    f32x4 cur[8];
#pragma unroll
    for (int i = 0; i < 8; ++i) cur[i] = *(const f32x4*)(p0 + (size_t)(64 * kb0 + 8 * i) * N);
    for (int kb = kb0; kb < kb1; ++kb) {
        f32x4 nxt[8];
        const int kn = kb < kb1 - 1 ? kb + 1 : kb;
#pragma unroll
        for (int i = 0; i < 8; ++i) nxt[i] = *(const f32x4*)(p0 + (size_t)(64 * kn + 8 * i) * N);
#pragma unroll
        for (int i = 0; i < 8; ++i) { LAS float* s = scr + (r8 + 8 * i) * 33 + 4 * c4; s[0] = cur[i].x; s[1] = cur[i].y; s[2] = cur[i].z; s[3] = cur[i].w; }
        LDS_WAIT(); asm volatile("" ::: "memory");
        const int c = lane & 3;
#pragma unroll
        for (int j = 0; j < 2; ++j) { const int n = (lane >> 2) + 16 * j; const float iv = scr[2112 + n]; const LAS float* s = scr + (16 * c) * 33 + n;
            v4u o; o.x = pack_q4c(s[0] * iv, s[33] * iv, s[66] * iv, s[99] * iv); o.y = pack_q4c(s[132] * iv, s[165] * iv, s[198] * iv, s[231] * iv);
            o.z = pack_q4c(s[264] * iv, s[297] * iv, s[330] * iv, s[363] * iv); o.w = pack_q4c(s[396] * iv, s[429] * iv, s[462] * iv, s[495] * iv);
            *(v4u*)(WT + (size_t)(rowbase + n) * 1024 + 64 * kb + 16 * c) = o; }
        LDS_WAIT(); asm volatile("" ::: "memory");
#pragma unroll
        for (int i = 0; i < 8; ++i) cur[i] = nxt[i];
    }
}

__device__ __forceinline__ float mod_val(const float* modp, const float* b_ada, int vec, int j) {
    float s = b_ada[j];
#pragma unroll
    for (int ks = 0; ks < KSPLIT; ++ks) s += modp[((size_t)ks * 3 + vec) * 6144 + j];
    return s;
}
__device__ __forceinline__ int nbr_row(int row, int j) {
    if (row < ML) { const int t = row & (T - 1), gc = t & 63, gr = t >> 6;
        if (j == 0) return gc > 0 ? row - 1 : -1; if (j == 1) return gc < 63 ? row + 1 : -1; if (j == 2) return gr > 0 ? row - 64 : -1; return gr < 127 ? row + 64 : -1; }
    const int tc = (row - ML) & (TC - 1);
    if ((j & 1) == 0) return tc > 0 ? row - 1 : -1; return tc < TC - 1 ? row + 1 : -1;
}
__device__ __forceinline__ void load_shift16(const bf16* z, int row, int col0, const LAS float* mu, float (&out)[16]) {
    float s[16]; ld16bf(z + (size_t)row * NZ + col0, s);
    float m[16]; ld16f_lds(mu, m);
#pragma unroll
    for (int j = 0; j < 4; ++j) {
        const int nr = nbr_row(row, j); float t[16];
        if (nr >= 0) ld16bf(z + (size_t)nr * NZ + col0, t); else {
#pragma unroll
            for (int i = 0; i < 16; ++i) t[i] = 0.f; }
#pragma unroll
        for (int i = j; i < 16; i += 4) out[i] = s[i] + m[i] * (t[i] - s[i]);
    }
}

__device__ __forceinline__ void phase_prologue(Frame& F) {
    LAS float* scr = (LAS float*)(F.lds + RING_OFF + F.wave * 16384);
    LAS float* sil = (LAS float*)(F.lds + LDS_X_OFF);
    for (int i = F.tid; i < 3 * D; i += NWAVES * 64) { const int v = i / D, j = i % D; const float c = v < 2 ? KIN(I_C)[v * D + j] : KIN(I_CCTX)[j]; sil[i] = c / (1.0f + __expf(-c)); }
    __syncthreads();
    bf16* WoutT = (bf16*)(F.ws + WS_WOUT);
    constexpr int IT_WIN = N_IN / 32, IT_WOUT = (D / 64) * (D / 32), IT_ADA = 24 * KSPLIT;
    constexpr int NITEMS = IT_ADA + IT_WIN + IT_WOUT;
    float* modp = (float*)(F.ws + WS_MODP);
    for (int it = F.gw; it < NITEMS; it += F.NGW) {
        int r = it;
        if (r < IT_ADA) {
            const int cc = r % 24, ks = r / 24, col = cc * 256 + F.lane * 4;
            f32x4 a0 = {0.f, 0.f, 0.f, 0.f}, a1 = a0, a2 = a0;
            const float* wp = KIN(I_WADA) + (size_t)(ks * 64) * 6144 + col;
#pragma unroll 8
            for (int k = 0; k < 64; ++k) { const f32x4 w = *(const f32x4*)(wp + (size_t)k * 6144); const int kk = ks * 64 + k;
                a0 += w * sil[kk]; a1 += w * sil[D + kk]; a2 += w * sil[2 * D + kk]; }
            *(f32x4*)(modp + ((size_t)ks * 3 + 0) * 6144 + col) = a0; *(f32x4*)(modp + ((size_t)ks * 3 + 1) * 6144 + col) = a1; *(f32x4*)(modp + ((size_t)ks * 3 + 2) * 6144 + col) = a2;
            continue; }
        r -= IT_ADA;
        if (r < IT_WIN) { q8_item(KIN(I_WIN), N_IN, 32 * r, (signed char*)(F.ws + WS_WIN), (float*)(F.ws + MI_CSWIN), 32 * r, scr, F.lane); continue; }
        r -= IT_WIN;
        { const int nb = D / 32, kb = r / nb, n0 = 32 * (r % nb); transpose_item(KIN(I_WOUT), D, 64 * kb, n0, WoutT, D, n0, scr, F.lane); }
    }
    const int gt = blockIdx.x * (NWAVES * 64) + F.tid, NGT = F.G * NWAVES * 64;
    for (int i = gt; i < (NZ - N_IN) * D / 16; i += NGT) *(v4u*)(F.ws + WS_WIN + (size_t)N_IN * D + (size_t)i * 16) = (v4u){0u, 0u, 0u, 0u};
    for (int i = gt; i < NZ - N_IN; i += NGT) ((float*)(F.ws + MI_CSWIN))[N_IN + i] = 0.f;
    bf16* WL = (bf16*)(F.ws + WS_WLORA);
    for (int i = gt; i < NL * (KL / 8); i += NGT) {
        const int c8 = i / NL, row = i % NL, blk = row >> 10, n = row & 1023, col = c8 * 8, g = col >> 6;
        const float* src = nullptr; int kofs = 0;
        if (blk < 2) { if (g == blk) { src = KIN(I_WDU) + (size_t)blk * 64 * D; kofs = col - 64 * blk; } }
        else if (blk < 4) { if (g == blk) { src = KIN(I_WIU) + (size_t)(blk - 2) * 64 * D; kofs = col - 64 * blk; } }
        else { if (g >= 4) { src = KIN(I_WGU); kofs = col - 256; } }
        v4u o = {0u, 0u, 0u, 0u};
        if (src) { float v[8];
#pragma unroll
            for (int q = 0; q < 8; ++q) v[q] = src[(size_t)(kofs + q) * D + n];
            o.x = pk2(v[0], v[1]); o.y = pk2(v[2], v[3]); o.z = pk2(v[4], v[5]); o.w = pk2(v[6], v[7]); }
        *(v4u*)(WL + (size_t)row * KL + col) = o;
    }
    bf16* WR = (bf16*)(F.ws + WS_WROUT);
    for (int i = gt; i < 256 * (D / 8); i += NGT) {
        const int row = i % 256, c8 = i / 256; v4u o = {0u, 0u, 0u, 0u};
        if (row < NE) { float v[8];
#pragma unroll
            for (int q = 0; q < 8; ++q) v[q] = KIN(I_WR)[(size_t)(c8 * 8 + q) * NE + row];
            o.x = pk2(v[0], v[1]); o.y = pk2(v[2], v[3]); o.z = pk2(v[4], v[5]); o.w = pk2(v[6], v[7]); }
        *(v4u*)(WR + (size_t)row * D + c8 * 8) = o;
    }
}

__device__ __forceinline__ void phase_hrows(Frame& F) {
    LAS float* LA = (LAS float*)(F.lds);
    LAS float* LB = LA + 3 * D;
    const float* modp = (const float*)(F.ws + WS_MODP);
    for (int i = F.tid; i < 3 * D; i += NWAVES * 64) { const int v = i / D, j = i % D;
        LA[i] = KIN(I_NPM)[j] * (1.0f + mod_val(modp, KIN(I_BADA), v, 1024 + j)); LB[i] = mod_val(modp, KIN(I_BADA), v, j); }
    __syncthreads();
    signed char* A0q = (signed char*)(F.ws + WS_A0);
    for (int row = F.gw; row < MT; row += F.NGW) {
        const float* xr; int vec;
        if (row < ML) { xr = KIN(I_X) + (size_t)row * D; vec = row >> 13; } else { xr = KIN(I_CTX) + (size_t)(row - ML) * D; vec = 2; }
        f32x4 v[4]; float s = 0.f;
#pragma unroll
        for (int j = 0; j < 4; ++j) { v[j] = *(const f32x4*)(xr + 4 * F.lane + 256 * j); s += (v[j].x * v[j].x + v[j].y * v[j].y) + (v[j].z * v[j].z + v[j].w * v[j].w); }
        const float rstd = 1.0f / sqrtf(wave_sum(s) * (1.0f / D) + 1e-6f);
        f32x4 hq[4]; float mx = 0.f;
#pragma unroll
        for (int j = 0; j < 4; ++j) { const int c = 4 * F.lane + 256 * j; const f32x4 a = *(const LAS f32x4*)(LA + vec * D + c), b = *(const LAS f32x4*)(LB + vec * D + c);
            hq[j] = v[j] * rstd * a + b; mx = fmaxf(mx, fmaxf(fmaxf(fabsf(hq[j].x), fabsf(hq[j].y)), fmaxf(fabsf(hq[j].z), fabsf(hq[j].w)))); }
        mx = wave_max(mx);
        const float iv = mx > 0.f ? 127.0f / mx : 0.f;
        if (F.lane == 0) ((float*)(F.ws + MI_RSH))[row] = mx * (1.0f / 127.0f);
        unsigned* o4 = (unsigned*)(A0q + (size_t)row * D) + F.lane;
#pragma unroll
        for (int j = 0; j < 4; ++j) o4[64 * j] = pack_q4(hq[j].x * iv, hq[j].y * iv, hq[j].z * iv, hq[j].w * iv);
    }
}

__device__ __forceinline__ void phase_lora_in(Frame& F) {
    const bf16* z = (const bf16*)(F.ws + WS_Z); bf16* AL = (bf16*)(F.ws + WS_AL);
    const int gt = blockIdx.x * (NWAVES * 64) + F.tid, NGT = F.G * NWAVES * 64;
    for (int i = gt; i < MT * (KL / 4); i += NGT) {
        const int row = i / (KL / 4), q = i % (KL / 4), j0 = 4 * q;
        const int zc = j0 < 256 ? DECAY_OFF + j0 : GLORA_OFF + (j0 - 256);
        float o[4];
        if (j0 >= 256 && row >= ML) { o[0] = o[1] = o[2] = o[3] = 0.f; }
        else {
            const uint2 sv = *(const uint2*)(z + (size_t)row * NZ + zc); const float s[4] = {bflo(sv.x), bfhi(sv.x), bflo(sv.y), bfhi(sv.y)};
#pragma unroll
            for (int j = 0; j < 4; ++j) { const int nr = nbr_row(row, j); float t = 0.f;
                if (nr >= 0) t = bf1(z[(size_t)nr * NZ + zc + j]);
                const float v = s[j] + KIN(I_MU)[zc + j] * (t - s[j]);
                o[j] = j0 < 128 ? tanhf(v) : (j0 < 256 ? v : sigmoidf_(v)); }
        }
        *(uint2*)(AL + (size_t)row * KL + j0) = make_uint2(pk2(o[0], o[1]), pk2(o[2], o[3]));
    }
}


namespace ck {
typedef short bf16x8 __attribute__((ext_vector_type(8)));
constexpr int TILE = 8192;
constexpr int NU_L = BATCH * (T / 64) * NH;
constexpr int NU_ALL = NU_L + BATCH * (TC / 64) * NH;
__device__ __forceinline__ int swz(int row) { return (row ^ (row >> 3)) & 7; }
__device__ __forceinline__ int toff(int row, int col) { return row * 128 + ((col * 2) ^ (swz(row) << 4)); }
__device__ __forceinline__ bf16x8 ldfrag(const LAS unsigned char* t, int row, int chunk) { return *(const LAS bf16x8*)(t + row * 128 + ((chunk ^ swz(row)) << 4)); }
typedef __bf16 bf16v2_t __attribute__((ext_vector_type(2)));
__device__ __forceinline__ unsigned cvtpk(float lo, float hi) { const bf16v2_t v = {(__bf16)lo, (__bf16)hi}; return __builtin_bit_cast(unsigned, v); }
#define CK_MFMA(a, b, c) __builtin_amdgcn_mfma_f32_16x16x32_bf16(a, b, c, 0, 0, 0)
template <bool MASKDIAG>
__device__ __forceinline__ void mm64(f32x4 (&acc)[4], const LAS unsigned char* Lt, const LAS unsigned char* Rt, int wq, int lane) {
    const int lr = lane & 15, g = lane >> 4;
    const bf16x8 l0 = ldfrag(Lt, 16 * wq + lr, g), l1 = ldfrag(Lt, 16 * wq + lr, 4 + g);
#pragma unroll
    for (int n = 0; n < 4; ++n) {
        bf16x8 r0 = ldfrag(Rt, 16 * n + lr, g), r1 = ldfrag(Rt, 16 * n + lr, 4 + g);
        if (MASKDIAG) { const bf16x8 zz = {0, 0, 0, 0, 0, 0, 0, 0}; if ((g >> 1) == n) r0 = zz; if (2 + (g >> 1) == n) r1 = zz; }
        acc[n] = CK_MFMA(l0, r0, acc[n]); acc[n] = CK_MFMA(l1, r1, acc[n]);
    }
}
__device__ __forceinline__ void zero4(f32x4 (&a)[4]) {
#pragma unroll
    for (int n = 0; n < 4; ++n) a[n] = (f32x4){0.f, 0.f, 0.f, 0.f};
}
__device__ __forceinline__ void storeT(LAS unsigned char* t, const f32x4 (&v)[4], int wq, int lane) {
    const int lr = lane & 15, g = lane >> 4;
#pragma unroll
    for (int n = 0; n < 4; ++n) *(LAS v2u*)(t + toff(16 * n + lr, 16 * wq + 4 * g)) = (v2u){cvtpk(v[n][0], v[n][1]), cvtpk(v[n][2], v[n][3])};
}
__device__ __forceinline__ void storeN(LAS unsigned char* t, const f32x4 (&v)[4], int wq, int lane) {
    const int lr = lane & 15, g = lane >> 4;
#pragma unroll
    for (int n = 0; n < 4; ++n)
#pragma unroll
        for (int i = 0; i < 4; ++i) *(LAS unsigned short*)(t + toff(16 * wq + 4 * g + i, 16 * n + lr)) = (unsigned short)f2bf(v[n][i]);
}
__device__ __forceinline__ void loadT(f32x4 (&v)[4], const LAS unsigned char* t, int wq, int lane) {
    const int lr = lane & 15, g = lane >> 4;
#pragma unroll
    for (int n = 0; n < 4; ++n) { const v2u w = *(const LAS v2u*)(t + toff(16 * n + lr, 16 * wq + 4 * g)); v[n] = (f32x4){bflo(w.x), bfhi(w.x), bflo(w.y), bfhi(w.y)}; }
}
__device__ __forceinline__ void unit_decode(int unit, int& b, int& h, int& rowbase) {
    if (unit < NU_L) { h = unit & 15; const int blk = (unit >> 4) & 127; b = unit >> 11; rowbase = b * T + blk * 64; }
    else { const int u = unit - NU_L; h = u & 15; const int cb = (u >> 4) & 3; b = u >> 6; rowbase = ML + b * TC + cb * 64; }
}
__device__ __forceinline__ void pack8(LAS unsigned char* t, int row, int chunk, const float (&v)[8], bool rev) {
    v4u o;
    if (!rev) { o.x = cvtpk(v[0], v[1]); o.y = cvtpk(v[2], v[3]); o.z = cvtpk(v[4], v[5]); o.w = cvtpk(v[6], v[7]); }
    else { o.x = cvtpk(v[7], v[6]); o.y = cvtpk(v[5], v[4]); o.z = cvtpk(v[3], v[2]); o.w = cvtpk(v[1], v[0]); }
    *(LAS v4u*)(t + row * 128 + ((chunk ^ swz(row)) << 4)) = o;
}

__device__ __forceinline__ void unpack8(const v4u p, float (&o)[8]) {
    o[0] = bflo(p.x); o[1] = bfhi(p.x); o[2] = bflo(p.y); o[3] = bfhi(p.y); o[4] = bflo(p.z); o[5] = bfhi(p.z); o[6] = bflo(p.w); o[7] = bfhi(p.w);
}
__device__ __forceinline__ void ld8f(const float* p, float (&o)[8]) {
    const f32x4 a = *(const f32x4*)p, b = *(const f32x4*)(p + 4); o[0] = a.x; o[1] = a.y; o[2] = a.z; o[3] = a.w; o[4] = b.x; o[5] = b.y; o[6] = b.z; o[7] = b.w;
}
__device__ __forceinline__ float fsig(float x) { return __builtin_amdgcn_rcpf(1.0f + __expf(-x)); }
template <bool IS_CO> struct EPre { v4u k[5], v[5], r[IS_CO ? 5 : 1], lo[4]; };
template <bool IS_CO>
__device__ __forceinline__ void epre_load(EPre<IS_CO>& P, const bf16* z, const bf16* LO, int unit, int wave, int lane) {
    int b, h, rowbase; unit_decode(unit, b, h, rowbase);
    const int row = rowbase + 8 * wave + (lane >> 3), c0 = h * 64 + 8 * (lane & 7);
    const v4u zz = {0u, 0u, 0u, 0u};
    const bf16* zr = z + (size_t)row * NZ;
    P.k[0] = *(const v4u*)(zr + K_OFF + c0); P.v[0] = *(const v4u*)(zr + V_OFF + c0); if (IS_CO) P.r[0] = *(const v4u*)(zr + R_OFF + c0);
#pragma unroll
    for (int j = 0; j < 4; ++j) { const int nr = nbr_row(row, j); const bf16* zn = z + (size_t)(nr >= 0 ? nr : row) * NZ;
        const v4u a = *(const v4u*)(zn + K_OFF + c0), bq = *(const v4u*)(zn + V_OFF + c0);
        P.k[1 + j] = nr >= 0 ? a : zz; P.v[1 + j] = nr >= 0 ? bq : zz;
        if (IS_CO) { const v4u cq = *(const v4u*)(zn + R_OFF + c0); P.r[1 + j] = nr >= 0 ? cq : zz; } }
    const bf16* lr_ = LO + (size_t)row * NL + c0;
    P.lo[0] = *(const v4u*)(lr_); P.lo[1] = *(const v4u*)(lr_ + 1024); P.lo[2] = *(const v4u*)(lr_ + 2048); P.lo[3] = *(const v4u*)(lr_ + 3072);
}
__device__ __forceinline__ void shift8(const v4u (&q)[5], const float* mu, float (&out)[8]) {
    const v4u s = q[0], n0 = q[1], n1 = q[2], n2 = q[3], n3 = q[4];
    float m[8]; ld8f(mu, m);
    out[0] = bflo(s.x) + m[0] * (bflo(n0.x) - bflo(s.x)); out[1] = bfhi(s.x) + m[1] * (bfhi(n1.x) - bfhi(s.x));
    out[2] = bflo(s.y) + m[2] * (bflo(n2.y) - bflo(s.y)); out[3] = bfhi(s.y) + m[3] * (bfhi(n3.y) - bfhi(s.y));
    out[4] = bflo(s.z) + m[4] * (bflo(n0.z) - bflo(s.z)); out[5] = bfhi(s.z) + m[5] * (bfhi(n1.z) - bfhi(s.z));
    out[6] = bflo(s.w) + m[6] * (bflo(n2.w) - bflo(s.w)); out[7] = bfhi(s.w) + m[7] * (bfhi(n3.w) - bfhi(s.w));
}
__device__ __forceinline__ void putN(LAS unsigned char* t, int tau, int oct, const float (&v)[8]) {
    v4u o; o.x = cvtpk(v[0], v[1]); o.y = cvtpk(v[2], v[3]); o.z = cvtpk(v[4], v[5]); o.w = cvtpk(v[6], v[7]);
    *(LAS v4u*)(t + tau * 128 + ((oct ^ swz(tau)) << 4)) = o;
}
__device__ __forceinline__ void putT(LAS unsigned char* t, int tau, int ch0, const float (&v)[8]) {
#pragma unroll
    for (int i = 0; i < 8; ++i) *(LAS unsigned short*)(t + toff(ch0 + i, tau)) = (unsigned short)f2bf(v[i]);
}

template <bool IS_CO, bool STAGES = true>
__device__ __forceinline__ void phase_chunk(Frame& F) {
    const int wave = F.wave;
    const int dgrp = wave >> 2, wq = wave & 3;
    LAS unsigned char* tl = F.lds + dgrp * 9 * TILE;
#define SL(k) (tl + (k) * TILE)
    LAS float* SEG = (LAS float*)(F.lds + LDS_X_OFF);
    LAS float* GAM = SEG + 1024;
    LAS float* LW0 = (LAS float*)(F.lds + 7 * TILE);
    LAS float* LW1 = (LAS float*)(F.lds + 16 * TILE);
    const bf16* z = (const bf16*)(F.ws + WS_Z); const bf16* LO = (const bf16*)(F.ws + WS_LORA);
    unsigned char* PQ = F.ws + WS_PQ; unsigned char* TKN = F.ws + WS_TKN; unsigned char* UPRE = F.ws + WS_UPRE; unsigned char* H0T = F.ws + WS_H0T;
    bf16* MG = (bf16*)(F.ws + WS_A0);
    const float* p_mu = KIN(I_MU); const float* p_kk = KIN(I_KK); const float* p_ka = KIN(I_KA); const float* p_w0 = KIN(I_W0); const float* p_a0 = KIN(I_A0);
    const int NU = IS_CO ? NU_L : NU_ALL;
    EPre<IS_CO> PF;
    if ((int)blockIdx.x < NU) epre_load<IS_CO>(PF, z, LO, (int)blockIdx.x, wave, F.lane);
    for (int unit = blockIdx.x; unit < NU; unit += F.G) {
        int lane = F.lane; asm volatile("" : "+v"(lane));
        const int lr = lane & 15, g = lane >> 4;
        int b, h, rowbase; unit_decode(unit, b, h, rowbase);
        const int tok = 8 * wave + (lane >> 3), oct = lane & 7, ch0 = 8 * oct, c0 = h * 64 + ch0, row = rowbase + tok;
        float ks[8], vs[8], rs[8], kkp[8], lw0[8], lw1[8], kd0[8], kd1[8], a_0[8], a_1[8], ssq;
        {
            shift8(PF.k, p_mu + K_OFF + c0, ks);
            shift8(PF.v, p_mu + V_OFF + c0, vs);
            if (IS_CO) { v4u rr[5];
#pragma unroll
                for (int j = 0; j < 5; ++j) rr[j] = PF.r[IS_CO ? j : 0];
                shift8(rr, p_mu + R_OFF + c0, rs); }
            else {
#pragma unroll
                for (int i = 0; i < 8; ++i) rs[i] = 0.f; }
            float xw0[8], xw1[8], xa0[8], xa1[8];
            unpack8(PF.lo[0], xw0); unpack8(PF.lo[1], xw1); unpack8(PF.lo[2], xa0); unpack8(PF.lo[3], xa1);
            float kkk[8], kaa[8], w0a[8], w0b[8], a0a[8], a0b[8];
            ld8f(p_kk + c0, kkk); ld8f(p_ka + c0, kaa); ld8f(p_w0 + c0, w0a); ld8f(p_w0 + D + c0, w0b); ld8f(p_a0 + c0, a0a); ld8f(p_a0 + D + c0, a0b);
            float ss = 0.f;
#pragma unroll
            for (int i = 0; i < 8; ++i) {
                kkp[i] = ks[i] * kkk[i]; ss += kkp[i] * kkp[i];
                lw0[i] = -0.6065306597126334f * fsig(w0a[i] + xw0[i]); lw1[i] = -0.6065306597126334f * fsig(w0b[i] + xw1[i]);
                a_0[i] = fsig(a0a[i] + xa0[i]); a_1[i] = fsig(a0b[i] + xa1[i]);
                kd0[i] = ks[i] * (1.0f + (a_0[i] - 1.0f) * kaa[i]); kd1[i] = ks[i] * (1.0f + (a_1[i] - 1.0f) * kaa[i]);
                const int ch = ch0 + i, sw = tok ^ (4 * ((ch & 15) ^ (2 * (ch >> 4))));
                LW0[ch * 64 + sw] = lw0[i]; LW1[ch * 64 + sw] = lw1[i];
            }
            ss += __shfl_xor(ss, 1); ss += __shfl_xor(ss, 2); ss += __shfl_xor(ss, 4);
            ssq = ss;
        }
        __syncthreads();
        {
            const int ch2 = lane, seg = wave, sw = 4 * ((ch2 & 15) ^ (2 * (ch2 >> 4)));
            LAS f32x4* p0a = (LAS f32x4*)(LW0 + ch2 * 64 + ((8 * seg) ^ sw)); LAS f32x4* p0b = (LAS f32x4*)(LW0 + ch2 * 64 + ((8 * seg + 4) ^ sw));
            LAS f32x4* p1a = (LAS f32x4*)(LW1 + ch2 * 64 + ((8 * seg) ^ sw)); LAS f32x4* p1b = (LAS f32x4*)(LW1 + ch2 * 64 + ((8 * seg + 4) ^ sw));
            f32x4 a = *p0a, bq = *p0b, c = *p1a, d = *p1b;
            a.y += a.x; a.z += a.y; a.w += a.z; bq.x += a.w; bq.y += bq.x; bq.z += bq.y; bq.w += bq.z;
            d.z += d.w; d.y += d.z; d.x += d.y; c.w += d.x; c.z += c.w; c.y += c.z; c.x += c.y;
            SEG[seg * 64 + ch2] = bq.w; SEG[(8 + seg) * 64 + ch2] = c.x;
            __syncthreads();
            float off0 = 0.f, off1 = 0.f;
#pragma unroll
            for (int s2 = 0; s2 < 8; ++s2) { const float t0 = SEG[s2 * 64 + ch2], t1 = SEG[(8 + s2) * 64 + ch2]; off0 += (s2 < seg) ? t0 : 0.f; off1 += (s2 > seg) ? t1 : 0.f; }
            *p0a = a + off0; *p0b = bq + off0; *p1a = c + off1; *p1b = d + off1;
        }
        __syncthreads();
        {
            const float inv = 1.0f / fmaxf(sqrtf(ssq), 1e-12f);
            float t8[8], u8[8], w8[8];
            {
                LAS unsigned char* t0 = F.lds; const int tau = tok;
                float e1[8], ei[8];
#pragma unroll
                for (int i = 0; i < 8; ++i) { const int ch = ch0 + i; const float cm = LW0[ch * 64 + (tok ^ (4 * ((ch & 15) ^ (2 * (ch >> 4)))))]; e1[i] = __expf(cm); ei[i] = __builtin_amdgcn_rcpf(e1[i]); t8[i] = kkp[i] * inv * __expf(cm - lw0[i]); }
                if (tok == 63) {
#pragma unroll
                    for (int i = 0; i < 8; ++i) GAM[ch0 + i] = e1[i]; }
#pragma unroll
                for (int i = 0; i < 8; ++i) { u8[i] = kkp[i] * inv * a_0[i] * ei[i]; w8[i] = kd0[i] * ei[i]; }
                if (!IS_CO) { putN(t0 + 0 * TILE, tau, oct, t8); putT(t0 + 1 * TILE, tau, ch0, t8); putN(t0 + 2 * TILE, tau, oct, u8); putT(t0 + 3 * TILE, tau, ch0, u8);
                    putN(t0 + 4 * TILE, tau, oct, w8); putT(t0 + 5 * TILE, tau, ch0, w8); putT(t0 + 6 * TILE, tau, ch0, vs); }
                else {
#pragma unroll
                    for (int i = 0; i < 8; ++i) t8[i] = rs[i] * e1[i];
                    putN(t0 + 0 * TILE, tau, oct, w8); putN(t0 + 1 * TILE, tau, oct, u8); putN(t0 + 2 * TILE, tau, oct, t8); putT(t0 + 3 * TILE, tau, ch0, vs); }
            }
            {
                LAS unsigned char* t1 = F.lds + 9 * TILE; const int tau = 63 - tok;
                float e1[8], ei[8];
#pragma unroll
                for (int i = 0; i < 8; ++i) { const int ch = ch0 + i; const float cm = LW1[ch * 64 + (tok ^ (4 * ((ch & 15) ^ (2 * (ch >> 4)))))]; e1[i] = __expf(cm); ei[i] = __builtin_amdgcn_rcpf(e1[i]); t8[i] = kkp[i] * inv * __expf(cm - lw1[i]); }
                if (tok == 0) {
#pragma unroll
                    for (int i = 0; i < 8; ++i) GAM[64 + ch0 + i] = e1[i]; }
#pragma unroll
                for (int i = 0; i < 8; ++i) { u8[i] = kkp[i] * inv * a_1[i] * ei[i]; w8[i] = kd1[i] * ei[i]; }
                if (!IS_CO) { putN(t1 + 0 * TILE, tau, oct, t8); putT(t1 + 1 * TILE, tau, ch0, t8); putN(t1 + 2 * TILE, tau, oct, u8); putT(t1 + 3 * TILE, tau, ch0, u8);
                    putN(t1 + 4 * TILE, tau, oct, w8); putT(t1 + 5 * TILE, tau, ch0, w8); putT(t1 + 6 * TILE, tau, ch0, vs); }
                else {
#pragma unroll
                    for (int i = 0; i < 8; ++i) t8[i] = rs[i] * e1[i];
                    putN(t1 + 0 * TILE, tau, oct, w8); putN(t1 + 1 * TILE, tau, oct, u8); putN(t1 + 2 * TILE, tau, oct, t8); putT(t1 + 3 * TILE, tau, ch0, vs); }
            }
        }
        if (!STAGES) { __syncthreads(); continue; }
        const size_t inst = (size_t)unit * 2 + dgrp;
        const int t2 = (wq << 6) | lane;
        if (IS_CO) {
#pragma unroll
            for (int rep = 0; rep < 2; ++rep) { const int cidx = t2 + 256 * rep, row = cidx >> 3, ch = cidx & 7;
                const v4u a = *(const v4u*)(TKN + inst * 8192 + (size_t)(row * 64 + ch * 8) * 2), hh = *(const v4u*)(H0T + inst * 8192 + (size_t)(row * 64 + ch * 8) * 2);
                *(LAS v4u*)(SL(4) + row * 128 + ((ch ^ swz(row)) << 4)) = a; *(LAS v4u*)(SL(5) + row * 128 + ((ch ^ swz(row)) << 4)) = hh; }
        }
        v4u upre0 = {0u, 0u, 0u, 0u}, upre1 = upre0;
        if (IS_CO) { const unsigned char* up = UPRE + inst * 8192 + (size_t)((wq * 64 + lane) * 32); upre0 = *(const v4u*)up; upre1 = *(const v4u*)(up + 16); }
        if (unit + F.G < NU) epre_load<IS_CO>(PF, z, LO, unit + F.G, wave, lane);
        __syncthreads();
        f32x4 acc[4], acc2[4];
        if (!IS_CO) {
            zero4(acc); mm64<false>(acc, SL(0), SL(2), wq, lane);
#pragma unroll
            for (int n = 0; n < 4; ++n)
#pragma unroll
                for (int q = 0; q < 4; ++q) acc[n][q] = (16 * n + lr < 16 * wq + 4 * g + q) ? acc[n][q] : 0.f;
            storeT(SL(7), acc, wq, lane);
            __syncthreads();
            zero4(acc); mm64<false>(acc, SL(4), SL(0), wq, lane);
#pragma unroll
            for (int n = 0; n < 4; ++n)
#pragma unroll
                for (int q = 0; q < 4; ++q) acc[n][q] = (16 * wq + 4 * g + q < 16 * n + lr) ? acc[n][q] : 0.f;
            storeT(SL(2), acc, wq, lane);
            __syncthreads();
            if (wq == 0) {
                const int bb = lane >> 4, jj = lane & 15;
                float X[16];
#pragma unroll
                for (int t = 0; t < 16; ++t) X[t] = (t == jj) ? 1.f : 0.f;
#pragma unroll
                for (int s = 0; s < 15; ++s) {
                    float col[16];
                    { const int row = 16 * bb + s; const v4u p0 = *(const LAS v4u*)(SL(7) + row * 128 + (((2 * bb) ^ swz(row)) << 4)), p1 = *(const LAS v4u*)(SL(7) + row * 128 + (((2 * bb + 1) ^ swz(row)) << 4));
                      col[0] = bflo(p0.x); col[1] = bfhi(p0.x); col[2] = bflo(p0.y); col[3] = bfhi(p0.y); col[4] = bflo(p0.z); col[5] = bfhi(p0.z); col[6] = bflo(p0.w); col[7] = bfhi(p0.w);
                      col[8] = bflo(p1.x); col[9] = bfhi(p1.x); col[10] = bflo(p1.y); col[11] = bfhi(p1.y); col[12] = bflo(p1.z); col[13] = bfhi(p1.z); col[14] = bflo(p1.w); col[15] = bfhi(p1.w); }
#pragma unroll
                    for (int t = s + 1; t < 16; ++t) X[t] -= col[t] * X[s];
                }
#pragma unroll
                for (int t = 0; t < 16; ++t) *(LAS unsigned short*)(SL(0) + toff(16 * bb + t, 16 * bb + jj)) = (unsigned short)f2bf(X[t]);
                { const int row = 16 * bb + jj; v4u o0, o1;
                  o0.x = cvtpk(X[0], X[1]); o0.y = cvtpk(X[2], X[3]); o0.z = cvtpk(X[4], X[5]); o0.w = cvtpk(X[6], X[7]);
                  o1.x = cvtpk(X[8], X[9]); o1.y = cvtpk(X[10], X[11]); o1.z = cvtpk(X[12], X[13]); o1.w = cvtpk(X[14], X[15]);
                  *(LAS v4u*)(SL(4) + row * 128 + (((2 * bb) ^ swz(row)) << 4)) = o0; *(LAS v4u*)(SL(4) + row * 128 + (((2 * bb + 1) ^ swz(row)) << 4)) = o1; }
            } else {
                for (int cidx = (wq - 1) * 64 + lane; cidx < 512; cidx += 192) { const int row = cidx >> 3, ch = cidx & 7;
                    if ((row >> 4) != (ch >> 1)) { const int o = row * 128 + ((ch ^ swz(row)) << 4); *(LAS v4u*)(SL(0) + o) = (v4u){0u, 0u, 0u, 0u}; *(LAS v4u*)(SL(4) + o) = (v4u){0u, 0u, 0u, 0u}; } }
            }
            __syncthreads();
            zero4(acc); mm64<true>(acc, SL(0), SL(7), wq, lane); storeN(SL(8), acc, wq, lane);
            __syncthreads();
            { f32x4 di[4]; loadT(di, SL(4), wq, lane); zero4(acc); mm64<false>(acc, SL(8), SL(4), wq, lane);
#pragma unroll
              for (int n = 0; n < 4; ++n) acc[n] = di[n] - acc[n];
              zero4(acc2); mm64<false>(acc2, SL(2), SL(6), wq, lane);
              storeT(SL(7), acc, wq, lane); storeT(SL(0), acc2, wq, lane); }
            __syncthreads();
            { f32x4 di[4]; loadT(di, SL(4), wq, lane); zero4(acc); mm64<false>(acc, SL(8), SL(7), wq, lane);
#pragma unroll
              for (int n = 0; n < 4; ++n) acc[n] = di[n] - acc[n];
              storeT(SL(2), acc, wq, lane); }
            __syncthreads();
            { f32x4 di[4]; loadT(di, SL(4), wq, lane); zero4(acc); mm64<false>(acc, SL(8), SL(2), wq, lane);
#pragma unroll
              for (int n = 0; n < 4; ++n) acc[n] = di[n] - acc[n];
              storeN(SL(7), acc, wq, lane); }
            __syncthreads();
            { f32x4 a3[4];
              zero4(acc); mm64<false>(acc, SL(7), SL(1), wq, lane);
              zero4(acc2); mm64<false>(acc2, SL(1), SL(7), wq, lane);
              zero4(a3); mm64<false>(a3, SL(7), SL(0), wq, lane);
              storeT(SL(8), acc, wq, lane); storeT(SL(2), acc2, wq, lane); storeT(SL(4), a3, wq, lane);
              unsigned char* up = UPRE + inst * 8192 + (size_t)((wq * 64 + lane) * 32);
              v4u o0, o1; o0.x = cvtpk(a3[0][0], a3[0][1]); o0.y = cvtpk(a3[0][2], a3[0][3]); o0.z = cvtpk(a3[1][0], a3[1][1]); o0.w = cvtpk(a3[1][2], a3[1][3]);
              o1.x = cvtpk(a3[2][0], a3[2][1]); o1.y = cvtpk(a3[2][2], a3[2][3]); o1.z = cvtpk(a3[3][0], a3[3][1]); o1.w = cvtpk(a3[3][2], a3[3][3]);
              *(v4u*)up = o0; *(v4u*)(up + 16) = o1; }
            __syncthreads();
            { zero4(acc); mm64<false>(acc, SL(8), SL(3), wq, lane);
              unsigned char* pb = PQ + inst * 16384;
#pragma unroll
              for (int n = 0; n < 4; ++n) { const int k = 16 * n + lr; const float gm = GAM[dgrp * 64 + k]; float p[4];
#pragma unroll
                  for (int q = 0; q < 4; ++q) p[q] = gm * (((16 * wq + 4 * g + q) == k ? 1.f : 0.f) - acc[n][q]);
                  *(uint2*)(pb + (size_t)(((n * 2 + (wq >> 1)) * 64 + lane) * 16 + (wq & 1) * 8)) = make_uint2(cvtpk(p[0], p[1]), cvtpk(p[2], p[3])); }
              zero4(acc); mm64<false>(acc, SL(5), SL(6), wq, lane); zero4(acc2); mm64<false>(acc2, SL(3), SL(4), wq, lane);
              const f32x4 gm4 = *(const LAS f32x4*)(GAM + dgrp * 64 + 16 * wq + 4 * g);
#pragma unroll
              for (int n = 0; n < 4; ++n) { const f32x4 qv = (acc[n] - acc2[n]) * gm4;
                  *(uint2*)(pb + 8192 + (size_t)(((n * 64 + lane) * 4 + wq) * 8)) = make_uint2(cvtpk(qv[0], qv[1]), cvtpk(qv[2], qv[3])); }
#pragma unroll
              for (int rep = 0; rep < 2; ++rep) { const int cidx = t2 + 256 * rep, row = cidx >> 3, ch = cidx & 7;
                  *(v4u*)(TKN + inst * 8192 + (size_t)(row * 64 + ch * 8) * 2) = *(const LAS v4u*)(SL(2) + row * 128 + ((ch ^ swz(row)) << 4)); }
            }
        } else {
            zero4(acc); mm64<false>(acc, SL(0), SL(2), wq, lane);
#pragma unroll
            for (int n = 0; n < 4; ++n)
#pragma unroll
                for (int q = 0; q < 4; ++q) acc[n][q] = (16 * wq + 4 * g + q <= 16 * n + lr) ? acc[n][q] : 0.f;
            storeT(SL(6), acc, wq, lane);
            zero4(acc); mm64<false>(acc, SL(1), SL(2), wq, lane);
#pragma unroll
            for (int n = 0; n < 4; ++n)
#pragma unroll
                for (int q = 0; q < 4; ++q) acc[n][q] = (16 * wq + 4 * g + q <= 16 * n + lr) ? -acc[n][q] : 0.f;
            storeT(SL(7), acc, wq, lane);
            { const v4u o0 = upre0, o1 = upre1;
              acc[0] = (f32x4){bflo(o0.x), bfhi(o0.x), bflo(o0.y), bfhi(o0.y)}; acc[1] = (f32x4){bflo(o0.z), bfhi(o0.z), bflo(o0.w), bfhi(o0.w)};
              acc[2] = (f32x4){bflo(o1.x), bfhi(o1.x), bflo(o1.y), bfhi(o1.y)}; acc[3] = (f32x4){bflo(o1.z), bfhi(o1.z), bflo(o1.w), bfhi(o1.w)}; }
            mm64<false>(acc, SL(4), SL(5), wq, lane);
            storeT(SL(8), acc, wq, lane);
            __syncthreads();
            zero4(acc); mm64<false>(acc, SL(2), SL(5), wq, lane); mm64<false>(acc, SL(6), SL(3), wq, lane); mm64<false>(acc, SL(7), SL(8), wq, lane);
            __syncthreads();
            { LAS float* Yf = (LAS float*)(tl);
#pragma unroll
              for (int n = 0; n < 4; ++n)
#pragma unroll
                  for (int q = 0; q < 4; ++q) { const int tau = 16 * wq + 4 * g + q; Yf[tau * 64 + ((16 * n + lr) ^ (4 * (tau & 15)))] = acc[n][q]; } }
            __syncthreads();
            { const LAS float* Y0 = (const LAS float*)(F.lds); const LAS float* Y1 = (const LAS float*)(F.lds + 9 * TILE);
              const int t = row & (T - 1);
              const bf16* zr = z + (size_t)row * NZ;
              const v4u zz = {0u, 0u, 0u, 0u};
              const v4u q_g = *(const v4u*)(LO + (size_t)row * NL + 4096 + c0);
              const v4u q_gb = *(const v4u*)(zr + CONV_OFF + c0), q_c0 = *(const v4u*)(zr + CONV_OFF + 1024 + c0), q_x0 = *(const v4u*)(zr + CONV_OFF + 2048 + c0);
              const v4u q_cm = t > 0 ? *(const v4u*)(zr - NZ + CONV_OFF + 1024 + c0) : zz, q_xm = t > 0 ? *(const v4u*)(zr - NZ + CONV_OFF + 2048 + c0) : zz;
              const v4u q_cp = t < T - 1 ? *(const v4u*)(zr + NZ + CONV_OFF + 1024 + c0) : zz, q_xp = t < T - 1 ? *(const v4u*)(zr + NZ + CONV_OFF + 2048 + c0) : zz;
              const v4u q_ga = *(const v4u*)(zr + GATE_OFF + c0), q_gr = *(const v4u*)(zr + GATE_OFF + 1024 + c0);
              float y[8];
              { const int s0 = 4 * (tok & 15), s1 = 4 * ((63 - tok) & 15);
                const f32x4 a0 = *(const LAS f32x4*)(Y0 + tok * 64 + (ch0 ^ s0)), a1 = *(const LAS f32x4*)(Y0 + tok * 64 + ((ch0 + 4) ^ s0));
                const f32x4 b0 = *(const LAS f32x4*)(Y1 + (63 - tok) * 64 + (ch0 ^ s1)), b1 = *(const LAS f32x4*)(Y1 + (63 - tok) * 64 + ((ch0 + 4) ^ s1));
                y[0] = a0.x + b0.x; y[1] = a0.y + b0.y; y[2] = a0.z + b0.z; y[3] = a0.w + b0.w; y[4] = a1.x + b1.x; y[5] = a1.y + b1.y; y[6] = a1.z + b1.z; y[7] = a1.w + b1.w; }
              float rk[8]; ld8f(KIN(I_RK) + c0, rk);
              float s1 = 0.f, s2 = 0.f, s3 = 0.f;
#pragma unroll
              for (int i = 0; i < 8; ++i) { s1 += y[i]; s2 += y[i] * y[i]; s3 += rs[i] * 0.5f * (kd0[i] + kd1[i]) * rk[i]; }
              s1 += __shfl_xor(s1, 1); s2 += __shfl_xor(s2, 1); s3 += __shfl_xor(s3, 1); s1 += __shfl_xor(s1, 2); s2 += __shfl_xor(s2, 2); s3 += __shfl_xor(s3, 2);
              s1 += __shfl_xor(s1, 4); s2 += __shfl_xor(s2, 4); s3 += __shfl_xor(s3, 4);
              const float S1 = s1, S2 = s2, S3 = s3;
              const float mean = S1 * (1.0f / 64.0f), var = fmaxf(S2 * (1.0f / 64.0f) - mean * mean, 0.f), rstd = __builtin_amdgcn_rsqf(var + 64e-5f);
              float lnw[8], lnb[8], cw0[8], cw1[8], cw2[8];
              ld8f(KIN(I_LNW) + c0, lnw); ld8f(KIN(I_LNB) + c0, lnb); ld8f(KIN(I_CONVW) + c0, cw0); ld8f(KIN(I_CONVW) + D + c0, cw1); ld8f(KIN(I_CONVW) + 2 * D + c0, cw2);
              float gg[8], gb[8], cc[8], xx[8], cm[8], xm[8], cp[8], xp[8], ga[8], gr[8];
              unpack8(q_g, gg); unpack8(q_gb, gb); unpack8(q_c0, cc); unpack8(q_x0, xx); unpack8(q_cm, cm); unpack8(q_xm, xm); unpack8(q_cp, cp); unpack8(q_xp, xp); unpack8(q_ga, ga); unpack8(q_gr, gr);
              float o[8];
#pragma unroll
              for (int i = 0; i < 8; ++i) {
                  const float yn = (y[i] - mean) * rstd * lnw[i] + lnb[i];
                  const float yr = (yn + S3 * vs[i]) * gg[i];
                  const float yc = gb[i] * (cw0[i] * (cm[i] * xm[i]) + cw1[i] * (cc[i] * xx[i]) + cw2[i] * (cp[i] * xp[i]));
                  o[i] = fsig(ga[i]) * yr + fsig(gr[i]) * yc;
              }
              v4u ov; ov.x = cvtpk(o[0], o[1]); ov.y = cvtpk(o[2], o[3]); ov.z = cvtpk(o[4], o[5]); ov.w = cvtpk(o[6], o[7]);
              *(v4u*)(MG + (size_t)row * D + c0) = ov;
            }
        }
        __syncthreads();
    }
#undef SL
}

struct SSIn { v4u a[8]; v4u q[2]; };
__device__ __forceinline__ size_t ss_inst(int step, int b, int h, int d) {
    int unit;
    if (step < 4) { const int cb = d ? 3 - step : step; unit = NU_L + (b * 4 + cb) * 16 + h; }
    else { const int blk = d ? 127 - (step - 4) : step - 4; unit = (b * 128 + blk) * 16 + h; }
    return (size_t)unit * 2 + d;
}
__device__ __forceinline__ void ss_load(SSIn& I, const unsigned char* PQ, size_t inst, int wv, int lane) {
    const unsigned char* pb = PQ + inst * 16384;
#pragma unroll
    for (int f = 0; f < 8; ++f) I.a[f] = *(const v4u*)(pb + (size_t)((f * 64 + lane) * 16));
    I.q[0] = *(const v4u*)(pb + 8192 + (size_t)((wv * 64 + lane) * 32)); I.q[1] = *(const v4u*)(pb + 8192 + (size_t)((wv * 64 + lane) * 32 + 16));
}
__device__ __forceinline__ void ss_step(f32x4 (&H)[4], const SSIn& cur, unsigned char* H0T, size_t inst, bool store_h0, int wv, int lr, int g) {
    const unsigned p00 = cvtpk(H[0][0], H[0][1]), p01 = cvtpk(H[0][2], H[0][3]), p10 = cvtpk(H[1][0], H[1][1]), p11 = cvtpk(H[1][2], H[1][3]);
    const unsigned p20 = cvtpk(H[2][0], H[2][1]), p21 = cvtpk(H[2][2], H[2][3]), p30 = cvtpk(H[3][0], H[3][1]), p31 = cvtpk(H[3][2], H[3][3]);
    if (store_h0) { unsigned char* hb = H0T + inst * 8192 + (size_t)((16 * wv + lr) * 64 + 4 * g) * 2;
        *(uint2*)(hb) = make_uint2(p00, p01); *(uint2*)(hb + 32) = make_uint2(p10, p11); *(uint2*)(hb + 64) = make_uint2(p20, p21); *(uint2*)(hb + 96) = make_uint2(p30, p31); }
    const bf16x8 b0 = __builtin_bit_cast(bf16x8, ((v4u){p00, p01, p10, p11})), b1 = __builtin_bit_cast(bf16x8, ((v4u){p20, p21, p30, p31}));
    H[0] = (f32x4){bflo(cur.q[0].x), bfhi(cur.q[0].x), bflo(cur.q[0].y), bfhi(cur.q[0].y)}; H[1] = (f32x4){bflo(cur.q[0].z), bfhi(cur.q[0].z), bflo(cur.q[0].w), bfhi(cur.q[0].w)};
    H[2] = (f32x4){bflo(cur.q[1].x), bfhi(cur.q[1].x), bflo(cur.q[1].y), bfhi(cur.q[1].y)}; H[3] = (f32x4){bflo(cur.q[1].z), bfhi(cur.q[1].z), bflo(cur.q[1].w), bfhi(cur.q[1].w)};
#pragma unroll
    for (int m = 0; m < 4; ++m) { H[m] = CK_MFMA(__builtin_bit_cast(bf16x8, cur.a[2 * m]), b0, H[m]); H[m] = CK_MFMA(__builtin_bit_cast(bf16x8, cur.a[2 * m + 1]), b1, H[m]); }
}
__device__ __forceinline__ void phase_ss(Frame& F) {
    const unsigned char* PQ = F.ws + WS_PQ; unsigned char* H0T = F.ws + WS_H0T;
    const int lane = F.lane, lr = lane & 15, g = lane >> 4;
    for (int task = (int)blockIdx.x; task < 256; task += F.G) {
        const int chain = task >> 2, wv = task & 3, b = chain >> 5, h = (chain >> 1) & 15, d = chain & 1;
        f32x4 H[4]; zero4(H);
        constexpr int NS = 4 + T / 64;
        static_assert(NS % 4 == 0, "unrolled by four");
        SSIn b0, b1, b2, b3;
        ss_load(b0, PQ, ss_inst(0, b, h, d), wv, lane); ss_load(b1, PQ, ss_inst(1, b, h, d), wv, lane); ss_load(b2, PQ, ss_inst(2, b, h, d), wv, lane); ss_load(b3, PQ, ss_inst(3, b, h, d), wv, lane);
        for (int step = 0; step < NS; step += 4) {
            const int n0 = step + 4 < NS ? step + 4 : NS - 1, n1 = step + 5 < NS ? step + 5 : NS - 1, n2 = step + 6 < NS ? step + 6 : NS - 1, n3 = step + 7 < NS ? step + 7 : NS - 1;
            ss_step(H, b0, H0T, ss_inst(step, b, h, d), step >= 4, wv, lr, g);     ss_load(b0, PQ, ss_inst(n0, b, h, d), wv, lane);
            ss_step(H, b1, H0T, ss_inst(step + 1, b, h, d), step >= 4, wv, lr, g); ss_load(b1, PQ, ss_inst(n1, b, h, d), wv, lane);
            ss_step(H, b2, H0T, ss_inst(step + 2, b, h, d), step >= 4, wv, lr, g); ss_load(b2, PQ, ss_inst(n2, b, h, d), wv, lane);
            ss_step(H, b3, H0T, ss_inst(step + 3, b, h, d), step >= 4, wv, lr, g); ss_load(b3, PQ, ss_inst(n3, b, h, d), wv, lane);
        }
    }
}
}
template <int PART>
__device__ __forceinline__ void phase_moe_weights(Frame& F) {
    LAS float* scr = (LAS float*)(F.lds + RING_OFF + F.wave * 16384);
    bf16* WEO = (bf16*)(F.ws + WS_WEOUT);
    constexpr int IT_IN = (D / 64) * (2048 / 32), IT_OUT = (D / 64) * (D / 32);
    if (PART == 0) {
        const float* wei = KIN(I_WEI);
        const int nstat = F.G * 7;
        int it = (int)blockIdx.x * 7 + F.wave - 1;
        while (it < NE * 128) {
            const int half = it & 1, r = it >> 1, e = r >> 6, n0 = 32 * (r & 63);
            const int c = n0 & 1023, rowbase = (c >> 7) * 256 + (n0 >= 1024 ? 128 : 0) + (c & 127);
            q8_item(wei + (size_t)e * D * 2048, 2048, n0, (signed char*)(F.ws + WS_WEIN) + (size_t)e * 2048 * D, (float*)(F.ws + MI_CSWEI) + (size_t)e * 2048, rowbase, scr, F.lane, 8 * half, 8 * half + 8);
            int nx = 0; if (F.lane == 0) nx = (int)__hip_atomic_fetch_add(F.ctl + CW_Q6, 1u, __ATOMIC_RELAXED, __HIP_MEMORY_SCOPE_AGENT);
            it = nstat + __builtin_amdgcn_readfirstlane(nx);
        }
    } else {
        const float* weo = KIN(I_WEO);
        for (int r = F.gw; r < NE * IT_OUT; r += F.NGW) { const int e = r / IT_OUT, q = r % IT_OUT, kb = q / 32, n0 = 32 * (q % 32);
            transpose_item(weo + (size_t)e * D * D, D, 64 * kb, n0, WEO + (size_t)e * D * D, D, n0, scr, F.lane); }
    }
}

__device__ __forceinline__ void phase_x1_h2(Frame& F) {
    LAS float* LG = (LAS float*)(F.lds);
    LAS float* LA = LG + 2 * D; LAS float* LB = LA + 2 * D;
    const float* modp = (const float*)(F.ws + WS_MODP);
    for (int i = F.tid; i < 2 * D; i += NWAVES * 64) { const int v = i / D, j = i % D;
        LG[i] = mod_val(modp, KIN(I_BADA), v, 2048 + j) * KIN(I_NQM)[j];
        LA[i] = KIN(I_NPF)[j] * (1.0f + mod_val(modp, KIN(I_BADA), v, 4096 + j)); LB[i] = mod_val(modp, KIN(I_BADA), v, 3072 + j); }
    __syncthreads();
    const float* mix = (const float*)(F.ws + WS_MIX); float* x1 = (float*)(F.ws + WS_X1); bf16* h2 = (bf16*)(F.ws + WS_H2);
    for (int row = F.gw; row < ML; row += F.NGW) {
        const int vec = row >> 13;
        f32x4 m[4], x[4]; float s = 0.f;
#pragma unroll
        for (int j = 0; j < 4; ++j) { m[j] = *(const f32x4*)(mix + (size_t)row * D + 4 * F.lane + 256 * j); x[j] = *(const f32x4*)(KIN(I_X) + (size_t)row * D + 4 * F.lane + 256 * j);
            s += (m[j].x * m[j].x + m[j].y * m[j].y) + (m[j].z * m[j].z + m[j].w * m[j].w); }
        const float rstd = 1.0f / sqrtf(wave_sum(s) * (1.0f / D) + 1e-6f);
        float s2 = 0.f;
#pragma unroll
        for (int j = 0; j < 4; ++j) { const int c = 4 * F.lane + 256 * j; const f32x4 g = *(const LAS f32x4*)(LG + vec * D + c);
            x[j] = x[j] + g * (m[j] * rstd); *(f32x4*)(x1 + (size_t)row * D + c) = x[j];
            s2 += (x[j].x * x[j].x + x[j].y * x[j].y) + (x[j].z * x[j].z + x[j].w * x[j].w); }
        const float rstd2 = 1.0f / sqrtf(wave_sum(s2) * (1.0f / D) + 1e-6f);
        unsigned long long* o8 = (unsigned long long*)(h2 + (size_t)row * D) + F.lane;
        f32x4 hq[4]; float mx = 0.f;
#pragma unroll
        for (int j = 0; j < 4; ++j) { const int c = 4 * F.lane + 256 * j; const f32x4 a = *(const LAS f32x4*)(LA + vec * D + c), b = *(const LAS f32x4*)(LB + vec * D + c);
            const f32x4 h = x[j] * rstd2 * a + b; hq[j] = h;
            mx = fmaxf(mx, fmaxf(fmaxf(fabsf(h.x), fabsf(h.y)), fmaxf(fabsf(h.z), fabsf(h.w))));
            o8[64 * j] = (unsigned long long)pk2(h.x, h.y) | ((unsigned long long)pk2(h.z, h.w) << 32); }
        mx = wave_max(mx);
        const float iv = mx > 0.f ? 127.0f / mx : 0.f;
        if (F.lane == 0) ((float*)(F.ws + MI_RSH2))[row] = mx * (1.0f / 127.0f);
        unsigned* o4 = (unsigned*)(F.ws + WS_H2Q + (size_t)row * D) + F.lane;
#pragma unroll
        for (int j = 0; j < 4; ++j) o4[64 * j] = pack_q4(hq[j].x * iv, hq[j].y * iv, hq[j].z * iv, hq[j].w * iv);
    }
}

__device__ __forceinline__ void phase_route(Frame& F) {
    const float* LG = (const float*)(F.ws + WS_LOGIT);
    int* selE = (int*)(F.ws + MI_SELE); int* selP = (int*)(F.ws + MI_SELP); float* gate = (float*)(F.ws + MI_GATE);
    for (int task = F.gw; task < ML / 64; task += F.NGW) {
        const int row = task * 64 + F.lane;
        float v[NE];
#pragma unroll
        for (int q = 0; q < NE / 4; ++q) { const f32x4 x = *(const f32x4*)(LG + (size_t)row * 256 + 4 * q); const f32x4 bb = *(const f32x4*)(KIN(I_BR) + 4 * q);
            v[4 * q] = x.x + bb.x; v[4 * q + 1] = x.y + bb.y; v[4 * q + 2] = x.z + bb.z; v[4 * q + 3] = x.w + bb.w; }
        int se[4]; float sv[4];
#pragma unroll
        for (int k = 0; k < 4; ++k) { float best = -3.0e38f; int bi = 0;
#pragma unroll
            for (int e = 0; e < NE; ++e) if (v[e] > best) { best = v[e]; bi = e; }
#pragma unroll
            for (int e = 0; e < NE; ++e) v[e] = (e == bi) ? -3.0e38f : v[e];
            se[k] = bi; sv[k] = best; }
        float ex[4], sum = 0.f;
#pragma unroll
        for (int k = 0; k < 4; ++k) { ex[k] = __expf(sv[k] - sv[0]); sum += ex[k]; }
        const float inv = 1.0f / sum;
        int sp[4] = {0, 0, 0, 0};
        int myn = 0;
#pragma unroll
        for (int e = 0; e < NE; ++e) { const bool p = (se[0] == e) | (se[1] == e) | (se[2] == e) | (se[3] == e); const int n = __popcll(__ballot(p)); myn = (F.lane == e) ? n : myn; }
        int mybase = 0;
        if (F.lane < NE && myn > 0) mybase = (int)__hip_atomic_fetch_add(F.ctl + CW_CNT + 64 * F.lane, (unsigned)myn, __ATOMIC_RELAXED, __HIP_MEMORY_SCOPE_AGENT);
#pragma unroll
        for (int e = 0; e < NE; ++e) {
            const bool p = (se[0] == e) | (se[1] == e) | (se[2] == e) | (se[3] == e);
            const unsigned long long mask = __ballot(p);
            const int base = __shfl(mybase, e);
            const int pos = base + __popcll(mask & ((1ull << F.lane) - 1ull));
#pragma unroll
            for (int k = 0; k < 4; ++k) if (se[k] == e) sp[k] = pos;
        }
        *(int4*)(selE + (size_t)row * 4) = make_int4(se[0], se[1], se[2], se[3]);
        *(int4*)(selP + (size_t)row * 4) = make_int4(sp[0], sp[1], sp[2], sp[3]);
        *(f32x4*)(gate + (size_t)row * 4) = (f32x4){ex[0] * inv, ex[1] * inv, ex[2] * inv, ex[3] * inv};
    }
}

__device__ __forceinline__ void phase_x1h2_route(Frame& F) {
    constexpr int HS_STRIDE = 2064;
    LAS unsigned char* Hs = F.lds;
    LAS float* LG = (LAS float*)(F.lds + 132096);
    LAS float* LA = LG + D; LAS float* LB = LA + D;
    LAS float* LGT = (LAS float*)(F.lds + LDS_X_OFF);
    const float* modp = (const float*)(F.ws + WS_MODP);
    const float* mix = (const float*)(F.ws + WS_MIX); float* x1 = (float*)(F.ws + WS_X1);
    const float* xin = KIN(I_X); const float* b_ada = KIN(I_BADA); const float* nqm = KIN(I_NQM); const float* npf = KIN(I_NPF);
    const bf16* WR = (const bf16*)(F.ws + WS_WROUT);
    int* selE = (int*)(F.ws + MI_SELE); int* selP = (int*)(F.ws + MI_SELP); float* gate = (float*)(F.ws + MI_GATE);
    for (int rb = blockIdx.x; rb < ML / 64; rb += F.G) {
        const int vec = (rb * 64) >> 13;
        __syncthreads();
        for (int i = F.tid; i < D; i += NWAVES * 64) {
            LG[i] = mod_val(modp, b_ada, vec, 2048 + i) * nqm[i];
            LA[i] = npf[i] * (1.0f + mod_val(modp, b_ada, vec, 4096 + i)); LB[i] = mod_val(modp, b_ada, vec, 3072 + i); }
        __syncthreads();
        for (int rr = 0; rr < 8; ++rr) {
            const int lrow = F.wave * 8 + rr, row = rb * 64 + lrow;
            f32x4 m[4], x[4]; float s = 0.f;
#pragma unroll
            for (int j = 0; j < 4; ++j) { m[j] = *(const f32x4*)(mix + (size_t)row * D + 4 * F.lane + 256 * j); x[j] = *(const f32x4*)(xin + (size_t)row * D + 4 * F.lane + 256 * j);
                s += (m[j].x * m[j].x + m[j].y * m[j].y) + (m[j].z * m[j].z + m[j].w * m[j].w); }
            const float rstd = 1.0f / sqrtf(wave_sum(s) * (1.0f / D) + 1e-6f);
            float s2 = 0.f;
#pragma unroll
            for (int j = 0; j < 4; ++j) { const int c = 4 * F.lane + 256 * j; const f32x4 g = *(const LAS f32x4*)(LG + c);
                x[j] = x[j] + g * (m[j] * rstd); *(f32x4*)(x1 + (size_t)row * D + c) = x[j];
                s2 += (x[j].x * x[j].x + x[j].y * x[j].y) + (x[j].z * x[j].z + x[j].w * x[j].w); }
            const float rstd2 = 1.0f / sqrtf(wave_sum(s2) * (1.0f / D) + 1e-6f);
            f32x4 hq[4]; float mx = 0.f;
#pragma unroll
            for (int j = 0; j < 4; ++j) { const int c = 4 * F.lane + 256 * j; const f32x4 a = *(const LAS f32x4*)(LA + c), b = *(const LAS f32x4*)(LB + c);
                const f32x4 h = x[j] * rstd2 * a + b; hq[j] = h;
                mx = fmaxf(mx, fmaxf(fmaxf(fabsf(h.x), fabsf(h.y)), fmaxf(fabsf(h.z), fabsf(h.w))));
                *(LAS v2u*)(Hs + lrow * HS_STRIDE + c * 2) = (v2u){pk2(h.x, h.y), pk2(h.z, h.w)}; }
            mx = wave_max(mx);
            const float iv = mx > 0.f ? 127.0f / mx : 0.f;
            if (F.lane == 0) ((float*)(F.ws + MI_RSH2))[row] = mx * (1.0f / 127.0f);
            unsigned* o4 = (unsigned*)(F.ws + WS_H2Q + (size_t)row * D) + F.lane;
#pragma unroll
            for (int j = 0; j < 4; ++j) o4[64 * j] = pack_q4(hq[j].x * iv, hq[j].y * iv, hq[j].z * iv, hq[j].w * iv);
        }
        __syncthreads();
        {
            const int rt = F.wave & 3, et = F.wave >> 2, lr = F.lane & 15, g = F.lane >> 4;
            typedef short bf16x8_t __attribute__((ext_vector_type(8)));
            f32x4 acc = {0.f, 0.f, 0.f, 0.f};
            const LAS unsigned char* ap = Hs + (16 * rt + lr) * HS_STRIDE + 16 * g; const bf16* bp = WR + (size_t)(16 * et + lr) * D + 8 * g;
#pragma unroll 8
            for (int s = 0; s < 32; ++s) { const bf16x8_t a = *(const LAS bf16x8_t*)(ap + 64 * s); const bf16x8_t b = *(const bf16x8_t*)(bp + 32 * s);
                acc = __builtin_amdgcn_mfma_f32_16x16x32_bf16(a, b, acc, 0, 0, 0); }
#pragma unroll
            for (int i = 0; i < 4; ++i) LGT[(16 * rt + 4 * g + i) * 33 + 16 * et + lr] = acc[i];
        }
        __syncthreads();
        if (F.wave == 0) {
            const int row = rb * 64 + F.lane;
            const float* br = KIN(I_BR);
            float v[NE];
#pragma unroll
            for (int e = 0; e < NE; ++e) v[e] = LGT[F.lane * 33 + e] + br[e];
            int se[4]; float sv[4];
#pragma unroll
            for (int k = 0; k < 4; ++k) { float best = -3.0e38f; int bi = 0;
#pragma unroll
                for (int e = 0; e < NE; ++e) if (v[e] > best) { best = v[e]; bi = e; }
#pragma unroll
                for (int e = 0; e < NE; ++e) v[e] = (e == bi) ? -3.0e38f : v[e];
                se[k] = bi; sv[k] = best; }
            float ex[4], sum = 0.f;
#pragma unroll
            for (int k = 0; k < 4; ++k) { ex[k] = __expf(sv[k] - sv[0]); sum += ex[k]; }
            const float inv = 1.0f / sum;
            int sp[4] = {0, 0, 0, 0};
            int myn = 0;
#pragma unroll
            for (int e = 0; e < NE; ++e) { const bool p = (se[0] == e) | (se[1] == e) | (se[2] == e) | (se[3] == e); const int n = __popcll(__ballot(p)); myn = (F.lane == e) ? n : myn; }
            int mybase = 0;
            if (F.lane < NE && myn > 0) mybase = (int)__hip_atomic_fetch_add(F.ctl + CW_CNT + 64 * F.lane, (unsigned)myn, __ATOMIC_RELAXED, __HIP_MEMORY_SCOPE_AGENT);
#pragma unroll
            for (int e = 0; e < NE; ++e) {
                const bool p = (se[0] == e) | (se[1] == e) | (se[2] == e) | (se[3] == e);
                const unsigned long long mask = __ballot(p);
                const int base = __shfl(mybase, e);
                const int pos = base + __popcll(mask & ((1ull << F.lane) - 1ull));
#pragma unroll
                for (int k = 0; k < 4; ++k) if (se[k] == e) sp[k] = pos;
            }
            *(int4*)(selE + (size_t)row * 4) = make_int4(se[0], se[1], se[2], se[3]);
            *(int4*)(selP + (size_t)row * 4) = make_int4(sp[0], sp[1], sp[2], sp[3]);
            *(f32x4*)(gate + (size_t)row * 4) = (f32x4){ex[0] * inv, ex[1] * inv, ex[2] * inv, ex[3] * inv};
        }
    }
    __syncthreads();
}

__device__ __forceinline__ void phase_scatter(Frame& F) {
    LAS int* PS = (LAS int*)(F.lds);
    if (F.tid == 0) { int acc = 0;
        for (int e = 0; e < NE; ++e) { const int c = (int)__hip_atomic_load(F.ctl + CW_CNT + 64 * e, __ATOMIC_RELAXED, __HIP_MEMORY_SCOPE_AGENT); PS[e] = acc; PS[64 + e] = c; acc += (c + 255) / 256 * 256; }
        PS[NE] = acc; }
    __syncthreads();
    int* blkE = (int*)(F.ws + MI_BLKE);
    if (blockIdx.x == 0) {
        for (int b = F.tid; b < MAXBLK; b += NWAVES * 64) { int e = NE - 1;
            for (int q = 0; q < NE; ++q) if (b * 256 >= PS[q] && b * 256 < PS[q + 1]) e = q;
            blkE[b] = e; }
        if (F.tid == 0) blkE[MAXBLK] = PS[NE] / 256;
    }
    const int* selE = (const int*)(F.ws + MI_SELE); const int* selP = (const int*)(F.ws + MI_SELP); int* dest = (int*)(F.ws + MI_DEST);
    const unsigned char* h2q = F.ws + WS_H2Q; unsigned char* xb = F.ws + WS_XB; const float* rsh2 = (const float*)(F.ws + MI_RSH2); float* rsxb = (float*)(F.ws + MI_RSXB);
    for (int row = F.gw; row < ML; row += F.NGW) {
        const int4 se = *(const int4*)(selE + (size_t)row * 4), sp = *(const int4*)(selP + (size_t)row * 4);
        const int d0 = PS[se.x] + sp.x, d1 = PS[se.y] + sp.y, d2 = PS[se.z] + sp.z, d3 = PS[se.w] + sp.w;
        const float rsc = rsh2[row];
        if (F.lane == 0) { *(int4*)(dest + (size_t)row * 4) = make_int4(d0, d1, d2, d3); rsxb[d0] = rsc; rsxb[d1] = rsc; rsxb[d2] = rsc; rsxb[d3] = rsc; }
        const v4u a = *(const v4u*)(h2q + (size_t)row * D + 16 * F.lane);
        *(v4u*)(xb + (size_t)d0 * D + 16 * F.lane) = a; *(v4u*)(xb + (size_t)d1 * D + 16 * F.lane) = a;
        *(v4u*)(xb + (size_t)d2 * D + 16 * F.lane) = a; *(v4u*)(xb + (size_t)d3 * D + 16 * F.lane) = a;
    }
    for (int p = F.gw; p < NE * 256; p += F.NGW) {
        const int e = p >> 8, r = p & 255, c = PS[64 + e], padded = (c + 255) / 256 * 256;
        if (c + r < padded) { unsigned char* dst = xb + (size_t)(PS[e] + c + r) * D; *(v4u*)(dst + 16 * F.lane) = (v4u){0u, 0u, 0u, 0u}; if (F.lane == 0) rsxb[PS[e] + c + r] = 0.f; }
    }
}

__device__ __forceinline__ void phase_combine(Frame& F) {
    LAS float* LG = (LAS float*)(F.lds);
    const float* modp = (const float*)(F.ws + WS_MODP);
    for (int i = F.tid; i < 2 * D; i += NWAVES * 64) { const int v = i / D, j = i % D; LG[i] = mod_val(modp, KIN(I_BADA), v, 5120 + j) * KIN(I_NQF)[j]; }
    __syncthreads();
    const int* dest = (const int*)(F.ws + MI_DEST); const float* gate = (const float*)(F.ws + MI_GATE);
    const bf16* y2 = (const bf16*)(F.ws + WS_Y2); const float* x1 = (const float*)(F.ws + WS_X1);
    for (int row = F.gw; row < ML; row += F.NGW) {
        const int vec = row >> 13;
        const int4 dd = *(const int4*)(dest + (size_t)row * 4); const f32x4 gg = *(const f32x4*)(gate + (size_t)row * 4);
        const int dk[4] = {dd.x, dd.y, dd.z, dd.w}; const float gk[4] = {gg.x, gg.y, gg.z, gg.w};
        float f[16];
#pragma unroll
        for (int i = 0; i < 16; ++i) f[i] = 0.f;
#pragma unroll
        for (int k = 0; k < 4; ++k) { float t[16]; ld16bf(y2 + (size_t)dk[k] * D + 16 * F.lane, t);
#pragma unroll
            for (int i = 0; i < 16; ++i) f[i] += gk[k] * t[i]; }
        float s = 0.f;
#pragma unroll
        for (int i = 0; i < 16; ++i) s += f[i] * f[i];
        const float rstd = 1.0f / sqrtf(wave_sum(s) * (1.0f / D) + 1e-6f);
        float xv[16], g[16], o[16]; ld16f(x1 + (size_t)row * D + 16 * F.lane, xv); ld16f_lds(LG + vec * D + 16 * F.lane, g);
#pragma unroll
        for (int i = 0; i < 16; ++i) o[i] = xv[i] + g[i] * (f[i] * rstd);
        st16f(F.out + (size_t)row * D + 16 * F.lane, o);
    }
}

constexpr int N_PHASES = 14;
#ifndef PROBE_MASK
#define PROBE_MASK 0
#endif
#ifndef USE_FLAT_BAR
#define USE_FLAT_BAR 0
#endif
struct Args { const float* in[30]; float* out; unsigned char* ws; int ph_lo, ph_hi; };
__global__ void __launch_bounds__(NWAVES * 64, 2) fwd(Args args) {
    extern __shared__ __attribute__((aligned(16))) unsigned char lds[];
    Frame F;
    F.lds = (LAS unsigned char*)lds;
    F.MISC = (volatile LAS unsigned*)(F.lds + MISC_OFF);
    F.tid = threadIdx.x; F.lane = F.tid & 63; F.wave = __builtin_amdgcn_readfirstlane(F.tid >> 6);
    F.G = gridDim.x; F.gw = blockIdx.x * NWAVES + F.wave; F.NGW = F.G * NWAVES;
    F.ws = args.ws; F.ctl = (unsigned*)(args.ws + WS_CTL); F.out = args.out;
    for (int u = F.tid; u < (LDS_X_OFF - LDSCTL_OFF) / 4; u += NWAVES * 64) ((LAS unsigned*)(F.lds + LDSCTL_OFF))[u] = 0u;
    __syncthreads();
    const int lo = args.ph_lo, hi = args.ph_hi;
    const bool use_bar = (hi - lo) > 1;
    XcdBarrier bar; bar.bar = F.ctl + CW_BAR; bar.x = 0; bar.st = nullptr;
    if (use_bar && !USE_FLAT_BAR) bar = xcd_barrier_post(F.ctl + CW_BAR, F.MISC + 8);
#define IN(k) (lo <= (k) && (k) < hi)
    unsigned fb_extra = 0u;
#define SEAM(k) do { if (IN(k) && IN((k) + 1)) { if (USE_FLAT_BAR) flat_barrier(F.ctl + CW_FB, (unsigned)((k) - lo + 1) + fb_extra); else xcd_barrier2(bar); } else __syncthreads(); } while (0)

#define DUP(k) ((PROBE_MASK >> (k)) & 1)
    if (IN(0)) { phase_prologue(F); if (DUP(0)) { __syncthreads(); phase_prologue(F); } SEAM(0); }
    if (DUP(20)) { for (int q = 0; q < 10; ++q) { if (USE_FLAT_BAR) { ++fb_extra; flat_barrier(F.ctl + CW_FB, 1u + fb_extra); } else xcd_barrier2(bar); } }
    if (IN(1)) { phase_hrows(F); if (DUP(1)) { __syncthreads(); phase_hrows(F); } SEAM(1); }
    if (IN(2)) {
        {         pg8::Gemm g{(const bf16*)(F.ws + WS_A0), (const bf16*)(F.ws + WS_WIN), MT, NZ, D}; pg8::StaticOrder S; S.init(MT, NZ, F.G, (int)blockIdx.x);
        pg8::EpiBf16I8 E{(bf16*)(F.ws + WS_Z), NZ, (const float*)(F.ws + MI_RSH), (const float*)(F.ws + MI_CSWIN)};
        pg8::gemm_phase_i8<pg8::EpiBf16I8, pg8::StaticOrder, true, true>(F.lds + RING_OFF, g, S, E); __syncthreads(); }
        if (DUP(2)) {         pg8::Gemm g{(const bf16*)(F.ws + WS_A0), (const bf16*)(F.ws + WS_WIN), MT, NZ, D}; pg8::StaticOrder S; S.init(MT, NZ, F.G, (int)blockIdx.x);
        pg8::EpiBf16I8 E{(bf16*)(F.ws + WS_Z), NZ, (const float*)(F.ws + MI_RSH), (const float*)(F.ws + MI_CSWIN)};
        pg8::gemm_phase_i8<pg8::EpiBf16I8, pg8::StaticOrder, true, true>(F.lds + RING_OFF, g, S, E); __syncthreads(); }
        SEAM(2); }
    if (IN(3)) { phase_lora_in(F); if (DUP(3)) { __syncthreads(); phase_lora_in(F); } SEAM(3); }
    if (IN(4)) {
        {         int kl_ = KL; asm volatile("" : "+s"(kl_)); pg8::Gemm g{(const bf16*)(F.ws + WS_AL), (const bf16*)(F.ws + WS_WLORA), MT, NL, kl_}; pg8::StaticOrder S; S.init(MT, NL, F.G, (int)blockIdx.x);
        pg8::EpiBf16 E{(bf16*)(F.ws + WS_LORA), NL, nullptr, 0};
        pg8::gemm_phase<pg8::EpiBf16, pg8::StaticOrder, true, true>(F.lds + RING_OFF, g, S, E); __syncthreads(); }
        if (DUP(4)) {         int kl_ = KL; asm volatile("" : "+s"(kl_)); pg8::Gemm g{(const bf16*)(F.ws + WS_AL), (const bf16*)(F.ws + WS_WLORA), MT, NL, kl_}; pg8::StaticOrder S; S.init(MT, NL, F.G, (int)blockIdx.x);
        pg8::EpiBf16 E{(bf16*)(F.ws + WS_LORA), NL, nullptr, 0};
        pg8::gemm_phase<pg8::EpiBf16, pg8::StaticOrder, true, true>(F.lds + RING_OFF, g, S, E); __syncthreads(); }
        SEAM(4); }
    if (IN(5)) { ck::phase_chunk<false>(F); if (DUP(5)) { __syncthreads(); ck::phase_chunk<false>(F); } SEAM(5); }
    if (IN(6)) { if (F.wave == 0) ck::phase_ss(F); else phase_moe_weights<0>(F); if (DUP(6)) { __syncthreads(); if (F.wave == 0) ck::phase_ss(F); else phase_moe_weights<0>(F); } if (DUP(17)) { __syncthreads(); if (F.wave == 0) ck::phase_ss(F); } SEAM(6); }
    if (IN(7)) { ck::phase_chunk<true>(F); if (DUP(7)) { __syncthreads(); ck::phase_chunk<true>(F); } SEAM(7); }
    if (IN(8)) {
        {         pg8::Gemm g{(const bf16*)(F.ws + WS_A0), (const bf16*)(F.ws + WS_WOUT), ML, D, D}; pg8::StaticOrder S; S.init(ML, D, F.G, (int)blockIdx.x);
        pg8::EpiF32 E{(float*)(F.ws + WS_MIX), D};
        pg8::gemm_phase<pg8::EpiF32, pg8::StaticOrder, true, true>(F.lds + RING_OFF, g, S, E);
        __syncthreads(); }
        if (DUP(8)) {         pg8::Gemm g{(const bf16*)(F.ws + WS_A0), (const bf16*)(F.ws + WS_WOUT), ML, D, D}; pg8::StaticOrder S; S.init(ML, D, F.G, (int)blockIdx.x);
        pg8::EpiF32 E{(float*)(F.ws + WS_MIX), D};
        pg8::gemm_phase<pg8::EpiF32, pg8::StaticOrder, true, true>(F.lds + RING_OFF, g, S, E);
        __syncthreads(); }
        SEAM(8); }
    if (IN(9)) { phase_x1h2_route(F); phase_moe_weights<1>(F); if (DUP(18)) { __syncthreads(); phase_moe_weights<1>(F); } SEAM(9); }
    if (IN(10)) { phase_scatter(F); if (DUP(12)) { __syncthreads(); phase_scatter(F); } SEAM(10); }
    if (IN(11)) {
        {         const int* blkE = (const int*)(F.ws + MI_BLKE);
        pg8::Gemm g{(const bf16*)(F.ws + WS_XB), (const bf16*)(F.ws + WS_WEIN), NROWS, 2048, D};
        pg8::MoeOrder<8> S{blkE, __hip_atomic_load(blkE + MAXBLK, __ATOMIC_RELAXED, __HIP_MEMORY_SCOPE_AGENT) * 8, F.G, (int)blockIdx.x};
        pg8::EpiSwigluI8 E{(bf16*)(F.ws + WS_ACT), KIN(I_BEI), (const float*)(F.ws + MI_RSXB), (const float*)(F.ws + MI_CSWEI)};
        pg8::gemm_phase_i8<pg8::EpiSwigluI8, pg8::MoeOrder<8>, true, true>(F.lds + RING_OFF, g, S, E); __syncthreads(); }
        if (DUP(13)) {         const int* blkE = (const int*)(F.ws + MI_BLKE);
        pg8::Gemm g{(const bf16*)(F.ws + WS_XB), (const bf16*)(F.ws + WS_WEIN), NROWS, 2048, D};
        pg8::MoeOrder<8> S{blkE, __hip_atomic_load(blkE + MAXBLK, __ATOMIC_RELAXED, __HIP_MEMORY_SCOPE_AGENT) * 8, F.G, (int)blockIdx.x};
        pg8::EpiSwigluI8 E{(bf16*)(F.ws + WS_ACT), KIN(I_BEI), (const float*)(F.ws + MI_RSXB), (const float*)(F.ws + MI_CSWEI)};
        pg8::gemm_phase_i8<pg8::EpiSwigluI8, pg8::MoeOrder<8>, true, true>(F.lds + RING_OFF, g, S, E); __syncthreads(); }
        SEAM(11); }
    if (IN(12)) {
        {         const int* blkE = (const int*)(F.ws + MI_BLKE);
        pg8::Gemm g{(const bf16*)(F.ws + WS_ACT), (const bf16*)(F.ws + WS_WEOUT), NROWS, D, D};
        pg8::MoeOrder<4> S{blkE, __hip_atomic_load(blkE + MAXBLK, __ATOMIC_RELAXED, __HIP_MEMORY_SCOPE_AGENT) * 4, F.G, (int)blockIdx.x};
        pg8::EpiBf16 E{(bf16*)(F.ws + WS_Y2), D, KIN(I_BEO), D};
        pg8::gemm_phase<pg8::EpiBf16, pg8::MoeOrder<4>, true, true>(F.lds + RING_OFF, g, S, E); __syncthreads(); }
        if (DUP(14)) {         const int* blkE = (const int*)(F.ws + MI_BLKE);
        pg8::Gemm g{(const bf16*)(F.ws + WS_ACT), (const bf16*)(F.ws + WS_WEOUT), NROWS, D, D};
        pg8::MoeOrder<4> S{blkE, __hip_atomic_load(blkE + MAXBLK, __ATOMIC_RELAXED, __HIP_MEMORY_SCOPE_AGENT) * 4, F.G, (int)blockIdx.x};
        pg8::EpiBf16 E{(bf16*)(F.ws + WS_Y2), D, KIN(I_BEO), D};
        pg8::gemm_phase<pg8::EpiBf16, pg8::MoeOrder<4>, true, true>(F.lds + RING_OFF, g, S, E); __syncthreads(); }
        SEAM(12); }
    if (IN(13)) { phase_combine(F); if (DUP(15)) { __syncthreads(); phase_combine(F); } }
#undef IN
#undef SEAM
}

#ifndef MK_N_LAUNCHES
#define MK_N_LAUNCHES 1
#endif
extern "C" void kernel_launch(void* const* d_in, const int* in_sizes, int n_in, void* d_out, int out_size, void* d_ws, size_t ws_size, hipStream_t stream) {
    static int grid = 0;
    if (grid == 0) {
        if (n_in != 30 || out_size != ML * D || ws_size < WS_END) { fprintf(stderr, "kernel_launch: unexpected shapes (n_in %d out %d ws %zu, need %zu); nothing launched\n", n_in, out_size, ws_size, (size_t)WS_END); grid = -1; return; }
        int dev = 0, cus = 0, per_cu = 0;
        if (hipGetDevice(&dev) != hipSuccess || hipDeviceGetAttribute(&cus, hipDeviceAttributeMultiprocessorCount, dev) != hipSuccess) { grid = -1; return; }
        if (hipFuncSetAttribute((const void*)fwd, hipFuncAttributeMaxDynamicSharedMemorySize, LDS_BYTES) != hipSuccess) { fprintf(stderr, "kernel_launch: hipFuncSetAttribute failed\n"); grid = -1; return; }
        if (hipOccupancyMaxActiveBlocksPerMultiprocessor(&per_cu, (const void*)fwd, NWAVES * 64, LDS_BYTES) != hipSuccess || per_cu < 1)
            fprintf(stderr, "kernel_launch: note: occupancy query reports %d workgroups per CU\n", per_cu);
        (void)hipGetLastError();
        grid = cus;
    }
    if (grid < 0) return;
    if (hipMemsetAsync((char*)d_ws + WS_CTL, 0, CTL_ZERO_BYTES, stream) != hipSuccess) return;
    Args a{};
    for (int i = 0; i < 30; ++i) a.in[i] = (const float*)d_in[i];
    a.out = (float*)d_out; a.ws = (unsigned char*)d_ws;
    if (MK_N_LAUNCHES == 1) { a.ph_lo = 0; a.ph_hi = N_PHASES; hipLaunchKernelGGL(fwd, dim3(grid), dim3(NWAVES * 64), LDS_BYTES, stream, a); }
    else for (int p = 0; p < N_PHASES; ++p) { a.ph_lo = p; a.ph_hi = p + 1; hipLaunchKernelGGL(fwd, dim3(grid), dim3(NWAVES * 64), LDS_BYTES, stream, a); }
}
```

```cpp
#include <hip/hip_runtime.h>
#include <cstdio>
#include <cstdint>

namespace pg8 {
#define PG8_LAS __attribute__((address_space(3)))
typedef unsigned short bf16_t;
typedef short bf16x8 __attribute__((ext_vector_type(8)));
typedef float f32x4 __attribute__((ext_vector_type(4)));
typedef unsigned u32x4 __attribute__((ext_vector_type(4)));
constexpr int BM = 256, BK = 64, HALF = 128, HTB = HALF * BK * 2  , STAGE_BYTES = 8 * HTB, NXCD = 8, WGM = 8;

__host__ __device__ __forceinline__ int lds_byte(int r, int c) { const int st = (r >> 4) * 2 + (c >> 5), rr = r & 15, cc = c & 31, ob = rr * 64 + cc * 2; return st * 1024 + (ob ^ (((ob >> 9) & 1) << 5)); }
__host__ __device__ __forceinline__ void stage_rc(int b, int& R, int& C) { const int st = b / 1024, sb = b % 1024, swz = sb ^ (((sb >> 9) & 1) << 5); R = (st >> 1) * 16 + swz / 64; C = (st & 1) * 32 + (swz % 64) / 2; }
__host__ __device__ __forceinline__ int perm32(int rho) { const int n = rho >> 4, i = rho & 15; return 8 * (i >> 2) + 4 * n + (i & 3); }

struct Unit { int pm, pn, pb, e; };
struct Gemm { const bf16_t* A; const bf16_t* Bt; int M, N, K; };

struct StaticOrder {
    int nM, nN, nwg, G, c;
    __host__ __device__ void init(int M, int N, int G_, int c_) { nM = M / BM; nN = N / BM; nwg = nM * nN; G = G_; c = c_; }
    __host__ __device__ bool next(int i, Unit& u) const {
        const long L = (long)i * G + c; if (L >= nwg) return false;
        int wgid = (int)L; { const int q = nwg / NXCD, r = nwg % NXCD, xcd = wgid % NXCD, off = wgid / NXCD; wgid = (xcd < r ? xcd * (q + 1) : r * (q + 1) + (xcd - r) * q) + off; }
        const int nig = WGM * nN, gid = wgid / nig, fm = gid * WGM, gsz = (nM - fm) < WGM ? (nM - fm) : WGM;
        u.pm = fm + ((wgid % nig) % gsz); u.pn = (wgid % nig) / gsz; u.pb = u.pn; u.e = 0; return true;
    }
    __device__ __forceinline__ void a_ready(const Unit&) const {}
    __device__ __forceinline__ void done(const Unit&) const {}
};
template <int NT> struct MoeOrder {
    const int* blk_e; int nunits, G, c;
    __device__ bool next(int i, Unit& u) const {
        const long L = (long)i * G + c; if (L >= nunits) return false;
        const int blk = (int)L / NT, pn = (int)L % NT; const int e = __hip_atomic_load(blk_e + blk, __ATOMIC_RELAXED, __HIP_MEMORY_SCOPE_AGENT);
        u.pm = blk; u.pn = pn; u.pb = e * NT + pn; u.e = e; return true;
    }
    __device__ __forceinline__ void a_ready(const Unit&) const {}
    __device__ __forceinline__ void done(const Unit&) const {}
};

__device__ __forceinline__ unsigned cvt_pk_bf16(float lo, float hi) { unsigned r; asm volatile("v_cvt_pk_bf16_f32 %0, %1, %2" : "=v"(r) : "v"(lo), "v"(hi)); return r; }

struct EpiF32 {
    static constexpr bool PERM = false, AFTER_DRAIN = false;
    float* C; int ldc;
    __device__ __forceinline__ void operator()(const f32x4 (&acc)[2][2][4][2], const Unit& u, int wr, int wc, int fr, int fq) const {
        const int row0 = u.pm * BM + wr * 64 + fr, col0 = u.pn * BM + wc * 32 + 4 * fq;
#pragma unroll
        for (int ai = 0; ai < 2; ++ai)
#pragma unroll
            for (int m = 0; m < 4; ++m) { float* rowp = C + (size_t)(row0 + ai * HALF + m * 16) * ldc + col0;
#pragma unroll
                for (int bj = 0; bj < 2; ++bj)
#pragma unroll
                    for (int n = 0; n < 2; ++n) *(f32x4*)(rowp + bj * HALF + n * 16) = acc[ai][bj][m][n]; }
    }
};
struct EpiBf16 {
    static constexpr bool PERM = true, AFTER_DRAIN = false;
    bf16_t* O; int ldc; const float* bias; int bias_estride;
    __device__ __forceinline__ void operator()(const f32x4 (&acc)[2][2][4][2], const Unit& u, int wr, int wc, int fr, int fq) const {
        const int row0 = u.pm * BM + wr * 64 + fr; const int col0 = u.pn * BM + wc * 32 + 8 * fq;
        const float* bp = bias ? bias + (size_t)u.e * bias_estride + col0 : nullptr;
        f32x4 bv[2][2];
#pragma unroll
        for (int bj = 0; bj < 2; ++bj)
#pragma unroll
            for (int n = 0; n < 2; ++n) bv[bj][n] = bp ? *(const f32x4*)(bp + bj * HALF + 4 * n) : (f32x4){0.f, 0.f, 0.f, 0.f};
#pragma unroll
        for (int ai = 0; ai < 2; ++ai)
#pragma unroll
            for (int m = 0; m < 4; ++m) { bf16_t* rowp = O + (size_t)(row0 + ai * HALF + m * 16) * ldc + col0;
#pragma unroll
                for (int bj = 0; bj < 2; ++bj) { const f32x4 v0 = acc[ai][bj][m][0] + bv[bj][0], v1 = acc[ai][bj][m][1] + bv[bj][1];
                    u32x4 w; w.x = cvt_pk_bf16(v0[0], v0[1]); w.y = cvt_pk_bf16(v0[2], v0[3]); w.z = cvt_pk_bf16(v1[0], v1[1]); w.w = cvt_pk_bf16(v1[2], v1[3]);
                    *(u32x4*)(rowp + bj * HALF) = w; } }
    }
};
struct EpiSwiglu {
    static constexpr bool PERM = true, AFTER_DRAIN = false;
    bf16_t* O; const float* bias;
    __device__ __forceinline__ float act1(float g, float up) const {
        g = fminf(g, 7.0f); up = fminf(fmaxf(up, -7.0f), 7.0f);
        const float sg = 1.0f / (1.0f + __expf(-1.702f * g));
        return (up + 1.0f) * g * sg;
    }
    __device__ __forceinline__ void operator()(const f32x4 (&acc)[2][2][4][2], const Unit& u, int wr, int wc, int fr, int fq) const {
        const int row0 = u.pm * BM + wr * 64 + fr; const int col0 = u.pn * HALF + wc * 32 + 8 * fq;
        const float* bp = bias + (size_t)u.e * 2048 + col0;
        f32x4 bg[2], bu[2];
#pragma unroll
        for (int n = 0; n < 2; ++n) { bg[n] = *(const f32x4*)(bp + 4 * n); bu[n] = *(const f32x4*)(bp + 1024 + 4 * n); }
#pragma unroll
        for (int ai = 0; ai < 2; ++ai)
#pragma unroll
            for (int m = 0; m < 4; ++m) { bf16_t* rowp = O + (size_t)(row0 + ai * HALF + m * 16) * 1024 + col0;
                const f32x4 g0 = acc[ai][0][m][0] + bg[0], g1 = acc[ai][0][m][1] + bg[1], u0 = acc[ai][1][m][0] + bu[0], u1 = acc[ai][1][m][1] + bu[1];
                u32x4 w; w.x = cvt_pk_bf16(act1(g0[0], u0[0]), act1(g0[1], u0[1])); w.y = cvt_pk_bf16(act1(g0[2], u0[2]), act1(g0[3], u0[3]));
                w.z = cvt_pk_bf16(act1(g1[0], u1[0]), act1(g1[1], u1[1])); w.w = cvt_pk_bf16(act1(g1[2], u1[2]), act1(g1[3], u1[3]));
                *(u32x4*)rowp = w; }
    }
};


typedef int i32x4 __attribute__((ext_vector_type(4)));
struct EpiBf16I8 {
    static constexpr bool PERM = true, AFTER_DRAIN = false;
    bf16_t* O; int ldc; const float* rs; const float* cs;
    __device__ __forceinline__ void operator()(const i32x4 (&acc)[2][2][4][2], const Unit& u, int wr, int wc, int fr, int fq) const {
        const int row0 = u.pm * BM + wr * 64 + fr; const int col0 = u.pn * BM + wc * 32 + 8 * fq;
        const float* cp = cs + (size_t)u.pb * BM + wc * 32 + 8 * fq;
        f32x4 cv[2][2];
#pragma unroll
        for (int bj = 0; bj < 2; ++bj)
#pragma unroll
            for (int n = 0; n < 2; ++n) cv[bj][n] = *(const f32x4*)(cp + bj * HALF + 4 * n);
#pragma unroll
        for (int ai = 0; ai < 2; ++ai)
#pragma unroll
            for (int m = 0; m < 4; ++m) { const int row = row0 + ai * HALF + m * 16; const float r = rs[row]; bf16_t* rowp = O + (size_t)row * ldc + col0;
#pragma unroll
                for (int bj = 0; bj < 2; ++bj) { const i32x4 a0 = acc[ai][bj][m][0], a1 = acc[ai][bj][m][1];
                    const f32x4 v0 = (f32x4){(float)a0[0], (float)a0[1], (float)a0[2], (float)a0[3]} * cv[bj][0] * r, v1 = (f32x4){(float)a1[0], (float)a1[1], (float)a1[2], (float)a1[3]} * cv[bj][1] * r;
                    u32x4 w; w.x = cvt_pk_bf16(v0[0], v0[1]); w.y = cvt_pk_bf16(v0[2], v0[3]); w.z = cvt_pk_bf16(v1[0], v1[1]); w.w = cvt_pk_bf16(v1[2], v1[3]);
                    *(u32x4*)(rowp + bj * HALF) = w; } }
    }
};
struct EpiSwigluI8 {
    static constexpr bool PERM = true, AFTER_DRAIN = false;
    bf16_t* O; const float* bias; const float* rs; const float* cs;
    __device__ __forceinline__ float act1(float g, float up) const {
        g = fminf(g, 7.0f); up = fminf(fmaxf(up, -7.0f), 7.0f);
        const float sg = __builtin_amdgcn_rcpf(1.0f + __expf(-1.702f * g));
        return (up + 1.0f) * g * sg;
    }
    __device__ __forceinline__ void operator()(const i32x4 (&acc)[2][2][4][2], const Unit& u, int wr, int wc, int fr, int fq) const {
        const int row0 = u.pm * BM + wr * 64 + fr; const int col0 = u.pn * HALF + wc * 32 + 8 * fq;
        const float* bp = bias + (size_t)u.e * 2048 + col0;
        const float* cp = cs + (size_t)u.pb * BM + wc * 32 + 8 * fq;
        f32x4 bg[2], bu[2], cg[2], cu[2];
#pragma unroll
        for (int n = 0; n < 2; ++n) { bg[n] = *(const f32x4*)(bp + 4 * n); bu[n] = *(const f32x4*)(bp + 1024 + 4 * n); cg[n] = *(const f32x4*)(cp + 4 * n); cu[n] = *(const f32x4*)(cp + HALF + 4 * n); }
#pragma unroll
        for (int ai = 0; ai < 2; ++ai)
#pragma unroll
            for (int m = 0; m < 4; ++m) { const int row = row0 + ai * HALF + m * 16; const float r = rs[row]; bf16_t* rowp = O + (size_t)row * 1024 + col0;
                f32x4 g[2], up[2];
#pragma unroll
                for (int n = 0; n < 2; ++n) { const i32x4 ag = acc[ai][0][m][n], au = acc[ai][1][m][n];
                    g[n] = (f32x4){(float)ag[0], (float)ag[1], (float)ag[2], (float)ag[3]} * cg[n] * r + bg[n];
                    up[n] = (f32x4){(float)au[0], (float)au[1], (float)au[2], (float)au[3]} * cu[n] * r + bu[n]; }
                u32x4 w; w.x = cvt_pk_bf16(act1(g[0][0], up[0][0]), act1(g[0][1], up[0][1])); w.y = cvt_pk_bf16(act1(g[0][2], up[0][2]), act1(g[0][3], up[0][3]));
                w.z = cvt_pk_bf16(act1(g[1][0], up[1][0]), act1(g[1][1], up[1][1])); w.w = cvt_pk_bf16(act1(g[1][2], up[1][2]), act1(g[1][3], up[1][3]));
                *(u32x4*)rowp = w; }
    }
};
template <class Epi, class Sched, bool ALIGN_EPI = false, bool SP2 = false>
__device__ __forceinline__ void gemm_phase(PG8_LAS unsigned char* lds, const Gemm g, const Sched& S, const Epi& E) {
    const int tid = threadIdx.x, wid = __builtin_amdgcn_readfirstlane(tid >> 6), lane = tid & 63, wr = wid >> 2, wc = wid & 3, fr = lane & 15, fq = lane >> 4;
    const int K = g.K, nt = K / BK;
    unsigned voffA[2], voffB[2];
#pragma unroll
    for (int i = 0; i < 2; ++i) { int R, C; stage_rc(tid * 16 + i * 8192, R, C); const int Rb = Epi::PERM ? ((R & ~31) + perm32(R & 31)) : R;
        voffA[i] = (unsigned)(R * K + C) * 2u; voffB[i] = (unsigned)(Rb * K + C) * 2u; }
    const size_t kstep = (size_t)(BK * 2);
    const size_t hstep = (size_t)HALF * K * 2;
    const size_t tstep = 2 * hstep;
    const unsigned ldsw = (unsigned)wid * 1024u;
    const int aoff = lds_byte(wr * 64 + fr, fq * 8), boff = lds_byte(wc * 32 + fr, fq * 8);
#define PG8_SA(b, h) (((b) * 2 + (h)) * HTB)
#define PG8_SB(b, h) ((4 + (b) * 2 + (h)) * HTB)
#define PG8_STAGE(bufoff, gbase, voff) do { _Pragma("unroll") for (int _i = 0; _i < 2; ++_i) \
        __builtin_amdgcn_global_load_lds((const unsigned*)((const char*)(gbase) + (voff)[_i]), (PG8_LAS unsigned*)(lds + (bufoff) + ldsw + _i * 8192), 16, 0, 0); } while (0)
#define PG8_LDA(dst, b, h) do { _Pragma("unroll") for (int m = 0; m < 4; ++m) _Pragma("unroll") for (int k = 0; k < 2; ++k) dst[m][k] = *(const PG8_LAS bf16x8*)(lds + PG8_SA(b, h) + aoff + m * 2048 + k * 1024); } while (0)
#define PG8_LDB(dst, b, h) do { _Pragma("unroll") for (int n = 0; n < 2; ++n) _Pragma("unroll") for (int k = 0; k < 2; ++k) dst[n][k] = *(const PG8_LAS bf16x8*)(lds + PG8_SB(b, h) + boff + n * 2048 + k * 1024); } while (0)
#define PG8_MMA(ai, bj, At, Bt) do { __builtin_amdgcn_s_setprio(1); _Pragma("unroll") for (int m = 0; m < 4; ++m) _Pragma("unroll") for (int n = 0; n < 2; ++n) _Pragma("unroll") for (int k = 0; k < 2; ++k) \
        acc[ai][bj][m][n] = __builtin_amdgcn_mfma_f32_16x16x32_bf16(Bt[n][k], At[m][k], acc[ai][bj][m][n], 0, 0, 0); __builtin_amdgcn_s_setprio(0); } while (0)
#define PG8_WAIT_V(n) asm volatile("s_waitcnt vmcnt(" #n ")" ::: "memory")
#define PG8_WAIT_L(n) asm volatile("s_waitcnt lgkmcnt(" #n ")" ::: "memory")
#define PG8_BAR __builtin_amdgcn_s_barrier()
#define PG8_SCHED __builtin_amdgcn_sched_barrier(0)
    Unit cur, nxt; int ui = 0;
    if (!S.next(0, cur)) return;
    f32x4 acc[2][2][4][2];
#pragma unroll
    for (int a = 0; a < 2; ++a)
#pragma unroll
        for (int b = 0; b < 2; ++b)
#pragma unroll
            for (int m = 0; m < 4; ++m)
#pragma unroll
                for (int n = 0; n < 2; ++n) acc[a][b][m][n] = (f32x4){0.f, 0.f, 0.f, 0.f};
    bf16x8 At[4][2], B0[2][2], B1[2][2];
    const char* cA = (const char*)g.A + (size_t)cur.pm * tstep; const char* cB = (const char*)g.Bt + (size_t)cur.pb * tstep;
    S.a_ready(cur);
    if constexpr (SP2) {
        PG8_STAGE(PG8_SB(0, 0), cB, voffB); PG8_STAGE(PG8_SB(0, 1), cB + hstep, voffB); PG8_STAGE(PG8_SA(0, 0), cA, voffA); PG8_STAGE(PG8_SA(0, 1), cA + hstep, voffA);
        if (wr == 1) PG8_BAR;
        PG8_WAIT_V(2); PG8_BAR;
        PG8_STAGE(PG8_SB(1, 0), cB + kstep, voffB); PG8_STAGE(PG8_SA(1, 0), cA + kstep, voffA); PG8_STAGE(PG8_SB(1, 1), cB + hstep + kstep, voffB);
        PG8_WAIT_V(6); PG8_BAR;
    } else {
        PG8_STAGE(PG8_SB(0, 0), cB, voffB); PG8_STAGE(PG8_SA(0, 0), cA, voffA); PG8_STAGE(PG8_SB(0, 1), cB + hstep, voffB); PG8_STAGE(PG8_SA(0, 1), cA + hstep, voffA);
        if (wr == 1) PG8_BAR;
        PG8_WAIT_V(4); PG8_BAR;
        PG8_STAGE(PG8_SB(1, 0), cB + kstep, voffB); PG8_STAGE(PG8_SA(1, 0), cA + kstep, voffA); PG8_STAGE(PG8_SB(1, 1), cB + hstep + kstep, voffB);
        PG8_WAIT_V(6); PG8_BAR;
    }
    for (;;) {
        const bool has_next = S.next(ui + 1, nxt);
        const char* nA = has_next ? (const char*)g.A + (size_t)nxt.pm * tstep : cA; const char* nB = has_next ? (const char*)g.Bt + (size_t)nxt.pb * tstep : cB;
        for (int t = 0; t < nt; t += 2) {
            const bool last = (t == nt - 2);
            const char* a1 = cA + (size_t)(t + 1) * kstep;
            const char* a2 = last ? nA : cA + (size_t)(t + 2) * kstep; const char* b2 = last ? nB : cB + (size_t)(t + 2) * kstep;
            const char* a3 = a2 + kstep; const char* b3 = b2 + kstep;
            if (last && has_next) S.a_ready(nxt);
            if constexpr (SP2) {
            PG8_LDB(B0, 0, 0); PG8_LDB(B1, 0, 1); PG8_SCHED; PG8_LDA(At, 0, 0); PG8_STAGE(PG8_SA(1, 1), a1 + hstep, voffA);
            PG8_WAIT_V(8); PG8_WAIT_L(0); PG8_BAR; PG8_MMA(0, 0, At, B0); PG8_MMA(0, 1, At, B1); PG8_BAR; PG8_SCHED;
            PG8_LDA(At, 0, 1); PG8_STAGE(PG8_SB(0, 0), b2, voffB); PG8_STAGE(PG8_SB(0, 1), b2 + hstep, voffB); PG8_STAGE(PG8_SA(0, 0), a2, voffA);
            PG8_WAIT_V(8); PG8_WAIT_L(0); PG8_BAR; PG8_MMA(1, 0, At, B0); PG8_MMA(1, 1, At, B1); PG8_BAR; PG8_SCHED;
            PG8_LDB(B0, 1, 0); PG8_LDB(B1, 1, 1); PG8_SCHED; PG8_LDA(At, 1, 0); PG8_STAGE(PG8_SA(0, 1), a2 + hstep, voffA);
            PG8_WAIT_V(8); PG8_WAIT_L(0); PG8_BAR; PG8_MMA(0, 0, At, B0); PG8_MMA(0, 1, At, B1); PG8_BAR; PG8_SCHED;
            PG8_LDA(At, 1, 1); PG8_STAGE(PG8_SB(1, 0), b3, voffB); PG8_STAGE(PG8_SB(1, 1), b3 + hstep, voffB); PG8_STAGE(PG8_SA(1, 0), a3, voffA);
            PG8_WAIT_V(8); PG8_WAIT_L(0); PG8_BAR; PG8_MMA(1, 0, At, B0); PG8_MMA(1, 1, At, B1); PG8_BAR; PG8_SCHED;
            } else {
            PG8_LDB(B0, 0, 0); PG8_SCHED; PG8_LDA(At, 0, 0); PG8_STAGE(PG8_SA(1, 1), a1 + hstep, voffA);
            PG8_WAIT_L(8); PG8_BAR; PG8_WAIT_L(0); PG8_MMA(0, 0, At, B0); PG8_BAR; PG8_SCHED;
            PG8_LDB(B1, 0, 1); PG8_STAGE(PG8_SB(0, 0), b2, voffB);
            PG8_BAR; PG8_WAIT_L(0); PG8_MMA(0, 1, At, B1); PG8_BAR;
            PG8_LDA(At, 0, 1); PG8_STAGE(PG8_SA(0, 0), a2, voffA);
            PG8_BAR; PG8_WAIT_L(0); PG8_MMA(1, 0, At, B0); PG8_BAR; PG8_SCHED;
            PG8_STAGE(PG8_SB(0, 1), b2 + hstep, voffB);
            PG8_WAIT_V(6); PG8_BAR; PG8_MMA(1, 1, At, B1); PG8_BAR;
            PG8_LDB(B0, 1, 0); PG8_SCHED; PG8_LDA(At, 1, 0); PG8_STAGE(PG8_SA(0, 1), a2 + hstep, voffA);
            PG8_WAIT_L(8); PG8_BAR; PG8_WAIT_L(0); PG8_MMA(0, 0, At, B0); PG8_BAR; PG8_SCHED;
            PG8_LDB(B1, 1, 1); PG8_STAGE(PG8_SB(1, 0), b3, voffB);
            PG8_BAR; PG8_WAIT_L(0); PG8_MMA(0, 1, At, B1); PG8_BAR;
            PG8_LDA(At, 1, 1); PG8_STAGE(PG8_SA(1, 0), a3, voffA);
            PG8_BAR; PG8_WAIT_L(0); PG8_MMA(1, 0, At, B0); PG8_BAR; PG8_SCHED;
            PG8_STAGE(PG8_SB(1, 1), b3 + hstep, voffB);
            PG8_WAIT_V(6); PG8_BAR; PG8_MMA(1, 1, At, B1); PG8_BAR;
            }
        }
        if constexpr (ALIGN_EPI) { if (wr == 0) PG8_BAR; }
        if constexpr (!Epi::AFTER_DRAIN) { E(acc, cur, wr, wc, fr, fq); S.done(cur); }
        if (!has_next) break;
#pragma unroll
        for (int a = 0; a < 2; ++a)
#pragma unroll
            for (int b = 0; b < 2; ++b)
#pragma unroll
                for (int m = 0; m < 4; ++m)
#pragma unroll
                    for (int n = 0; n < 2; ++n) acc[a][b][m][n] = (f32x4){0.f, 0.f, 0.f, 0.f};
        cur = nxt; cA = nA; cB = nB; ++ui;
        if constexpr (ALIGN_EPI) { if (wr == 1) PG8_BAR; }
    }
    PG8_WAIT_V(0);
    if constexpr (!ALIGN_EPI) { if (wr == 0) PG8_BAR; }
    PG8_BAR;
    if constexpr (Epi::AFTER_DRAIN) { E.fused(acc, cur, wr, wc, fr, fq, lds, wid, lane); S.done(cur); }
#undef PG8_SA
#undef PG8_SB
#undef PG8_STAGE
#undef PG8_LDA
#undef PG8_LDB
#undef PG8_MMA
#undef PG8_WAIT_V
#undef PG8_WAIT_L
#undef PG8_BAR
#undef PG8_SCHED
}
template <class Epi, class Sched, bool ALIGN_EPI = false, bool SP2 = false>
__device__ __forceinline__ void gemm_phase_i8(PG8_LAS unsigned char* lds, const Gemm g, const Sched& S, const Epi& E) {
    const int tid = threadIdx.x, wid = __builtin_amdgcn_readfirstlane(tid >> 6), lane = tid & 63, wr = wid >> 2, wc = wid & 3, fr = lane & 15, fq = lane >> 4;
    const int K = g.K, nt = K / 128;
    unsigned voffA[2], voffB[2];
#pragma unroll
    for (int i = 0; i < 2; ++i) { int R, C; stage_rc(tid * 16 + i * 8192, R, C); const int Rb = Epi::PERM ? ((R & ~31) + perm32(R & 31)) : R;
        voffA[i] = (unsigned)(R * K + C * 2); voffB[i] = (unsigned)(Rb * K + C * 2); }
    const size_t kstep = (size_t)(BK * 2);
    const size_t hstep = (size_t)HALF * K;
    const size_t tstep = 2 * hstep;
    const unsigned ldsw = (unsigned)wid * 1024u;
    const int aoff = lds_byte(wr * 64 + fr, fq * 8), boff = lds_byte(wc * 32 + fr, fq * 8);
#define PG8_SA(b, h) (((b) * 2 + (h)) * HTB)
#define PG8_SB(b, h) ((4 + (b) * 2 + (h)) * HTB)
#define PG8_STAGE(bufoff, gbase, voff) do { _Pragma("unroll") for (int _i = 0; _i < 2; ++_i) \
        __builtin_amdgcn_global_load_lds((const unsigned*)((const char*)(gbase) + (voff)[_i]), (PG8_LAS unsigned*)(lds + (bufoff) + ldsw + _i * 8192), 16, 0, 0); } while (0)
#define PG8_LDA(dst, b, h) do { _Pragma("unroll") for (int m = 0; m < 4; ++m) _Pragma("unroll") for (int k = 0; k < 2; ++k) dst[m][k] = *(const PG8_LAS bf16x8*)(lds + PG8_SA(b, h) + aoff + m * 2048 + k * 1024); } while (0)
#define PG8_LDB(dst, b, h) do { _Pragma("unroll") for (int n = 0; n < 2; ++n) _Pragma("unroll") for (int k = 0; k < 2; ++k) dst[n][k] = *(const PG8_LAS bf16x8*)(lds + PG8_SB(b, h) + boff + n * 2048 + k * 1024); } while (0)
#define PG8_MMA(ai, bj, At, Bt) do { __builtin_amdgcn_s_setprio(1); _Pragma("unroll") for (int m = 0; m < 4; ++m) _Pragma("unroll") for (int n = 0; n < 2; ++n) _Pragma("unroll") for (int k = 0; k < 2; ++k) \
        acc[ai][bj][m][n] = __builtin_amdgcn_mfma_i32_16x16x64_i8(__builtin_bit_cast(i32x4, Bt[n][k]), __builtin_bit_cast(i32x4, At[m][k]), acc[ai][bj][m][n], 0, 0, 0); __builtin_amdgcn_s_setprio(0); } while (0)
#define PG8_WAIT_V(n) asm volatile("s_waitcnt vmcnt(" #n ")" ::: "memory")
#define PG8_WAIT_L(n) asm volatile("s_waitcnt lgkmcnt(" #n ")" ::: "memory")
#define PG8_BAR __builtin_amdgcn_s_barrier()
#define PG8_SCHED __builtin_amdgcn_sched_barrier(0)
    Unit cur, nxt; int ui = 0;
    if (!S.next(0, cur)) return;
    i32x4 acc[2][2][4][2];
#pragma unroll
    for (int a = 0; a < 2; ++a)
#pragma unroll
        for (int b = 0; b < 2; ++b)
#pragma unroll
            for (int m = 0; m < 4; ++m)
#pragma unroll
                for (int n = 0; n < 2; ++n) acc[a][b][m][n] = (i32x4){0, 0, 0, 0};
    bf16x8 At[4][2], B0[2][2], B1[2][2];
    const char* cA = (const char*)g.A + (size_t)cur.pm * tstep; const char* cB = (const char*)g.Bt + (size_t)cur.pb * tstep;
    S.a_ready(cur);
    if constexpr (SP2) {
        PG8_STAGE(PG8_SB(0, 0), cB, voffB); PG8_STAGE(PG8_SB(0, 1), cB + hstep, voffB); PG8_STAGE(PG8_SA(0, 0), cA, voffA); PG8_STAGE(PG8_SA(0, 1), cA + hstep, voffA);
        if (wr == 1) PG8_BAR;
        PG8_WAIT_V(2); PG8_BAR;
        PG8_STAGE(PG8_SB(1, 0), cB + kstep, voffB); PG8_STAGE(PG8_SA(1, 0), cA + kstep, voffA); PG8_STAGE(PG8_SB(1, 1), cB + hstep + kstep, voffB);
        PG8_WAIT_V(6); PG8_BAR;
    } else {
        PG8_STAGE(PG8_SB(0, 0), cB, voffB); PG8_STAGE(PG8_SA(0, 0), cA, voffA); PG8_STAGE(PG8_SB(0, 1), cB + hstep, voffB); PG8_STAGE(PG8_SA(0, 1), cA + hstep, voffA);
        if (wr == 1) PG8_BAR;
        PG8_WAIT_V(4); PG8_BAR;
        PG8_STAGE(PG8_SB(1, 0), cB + kstep, voffB); PG8_STAGE(PG8_SA(1, 0), cA + kstep, voffA); PG8_STAGE(PG8_SB(1, 1), cB + hstep + kstep, voffB);
        PG8_WAIT_V(6); PG8_BAR;
    }
    for (;;) {
        const bool has_next = S.next(ui + 1, nxt);
        const char* nA = has_next ? (const char*)g.A + (size_t)nxt.pm * tstep : cA; const char* nB = has_next ? (const char*)g.Bt + (size_t)nxt.pb * tstep : cB;
        for (int t = 0; t < nt; t += 2) {
            const bool last = (t == nt - 2);
            const char* a1 = cA + (size_t)(t + 1) * kstep;
            const char* a2 = last ? nA : cA + (size_t)(t + 2) * kstep; const char* b2 = last ? nB : cB + (size_t)(t + 2) * kstep;
            const char* a3 = a2 + kstep; const char* b3 = b2 + kstep;
            if (last && has_next) S.a_ready(nxt);
            if constexpr (SP2) {
            PG8_LDB(B0, 0, 0); PG8_LDB(B1, 0, 1); PG8_SCHED; PG8_LDA(At, 0, 0); PG8_STAGE(PG8_SA(1, 1), a1 + hstep, voffA);
            PG8_WAIT_V(8); PG8_WAIT_L(0); PG8_BAR; PG8_MMA(0, 0, At, B0); PG8_MMA(0, 1, At, B1); PG8_BAR; PG8_SCHED;
            PG8_LDA(At, 0, 1); PG8_STAGE(PG8_SB(0, 0), b2, voffB); PG8_STAGE(PG8_SB(0, 1), b2 + hstep, voffB); PG8_STAGE(PG8_SA(0, 0), a2, voffA);
            PG8_WAIT_V(8); PG8_WAIT_L(0); PG8_BAR; PG8_MMA(1, 0, At, B0); PG8_MMA(1, 1, At, B1); PG8_BAR; PG8_SCHED;
            PG8_LDB(B0, 1, 0); PG8_LDB(B1, 1, 1); PG8_SCHED; PG8_LDA(At, 1, 0); PG8_STAGE(PG8_SA(0, 1), a2 + hstep, voffA);
            PG8_WAIT_V(8); PG8_WAIT_L(0); PG8_BAR; PG8_MMA(0, 0, At, B0); PG8_MMA(0, 1, At, B1); PG8_BAR; PG8_SCHED;
            PG8_LDA(At, 1, 1); PG8_STAGE(PG8_SB(1, 0), b3, voffB); PG8_STAGE(PG8_SB(1, 1), b3 + hstep, voffB); PG8_STAGE(PG8_SA(1, 0), a3, voffA);
            PG8_WAIT_V(8); PG8_WAIT_L(0); PG8_BAR; PG8_MMA(1, 0, At, B0); PG8_MMA(1, 1, At, B1); PG8_BAR; PG8_SCHED;
            } else {
            PG8_LDB(B0, 0, 0); PG8_SCHED; PG8_LDA(At, 0, 0); PG8_STAGE(PG8_SA(1, 1), a1 + hstep, voffA);
            PG8_WAIT_L(8); PG8_BAR; PG8_WAIT_L(0); PG8_MMA(0, 0, At, B0); PG8_BAR; PG8_SCHED;
            PG8_LDB(B1, 0, 1); PG8_STAGE(PG8_SB(0, 0), b2, voffB);
            PG8_BAR; PG8_WAIT_L(0); PG8_MMA(0, 1, At, B1); PG8_BAR;
            PG8_LDA(At, 0, 1); PG8_STAGE(PG8_SA(0, 0), a2, voffA);
            PG8_BAR; PG8_WAIT_L(0); PG8_MMA(1, 0, At, B0); PG8_BAR; PG8_SCHED;
            PG8_STAGE(PG8_SB(0, 1), b2 + hstep, voffB);
            PG8_WAIT_V(6); PG8_BAR; PG8_MMA(1, 1, At, B1); PG8_BAR;
            PG8_LDB(B0, 1, 0); PG8_SCHED; PG8_LDA(At, 1, 0); PG8_STAGE(PG8_SA(0, 1), a2 + hstep, voffA);
            PG8_WAIT_L(8); PG8_BAR; PG8_WAIT_L(0); PG8_MMA(0, 0, At, B0); PG8_BAR; PG8_SCHED;
            PG8_LDB(B1, 1, 1); PG8_STAGE(PG8_SB(1, 0), b3, voffB);
            PG8_BAR; PG8_WAIT_L(0); PG8_MMA(0, 1, At, B1); PG8_BAR;
            PG8_LDA(At, 1, 1); PG8_STAGE(PG8_SA(1, 0), a3, voffA);
            PG8_BAR; PG8_WAIT_L(0); PG8_MMA(1, 0, At, B0); PG8_BAR; PG8_SCHED;
            PG8_STAGE(PG8_SB(1, 1), b3 + hstep, voffB);
            PG8_WAIT_V(6); PG8_BAR; PG8_MMA(1, 1, At, B1); PG8_BAR;
            }
        }
        if constexpr (ALIGN_EPI) { if (wr == 0) PG8_BAR; }
        if constexpr (!Epi::AFTER_DRAIN) { E(acc, cur, wr, wc, fr, fq); S.done(cur); }
        if (!has_next) break;
#pragma unroll
        for (int a = 0; a < 2; ++a)
#pragma unroll
            for (int b = 0; b < 2; ++b)
#pragma unroll
                for (int m = 0; m < 4; ++m)
#pragma unroll
                    for (int n = 0; n < 2; ++n) acc[a][b][m][n] = (i32x4){0, 0, 0, 0};
        cur = nxt; cA = nA; cB = nB; ++ui;
        if constexpr (ALIGN_EPI) { if (wr == 1) PG8_BAR; }
    }
    PG8_WAIT_V(0);
    if constexpr (!ALIGN_EPI) { if (wr == 0) PG8_BAR; }
    PG8_BAR;
    if constexpr (Epi::AFTER_DRAIN) { E.fused(acc, cur, wr, wc, fr, fq, lds, wid, lane); S.done(cur); }
#undef PG8_SA
#undef PG8_SB
#undef PG8_STAGE
#undef PG8_LDA
#undef PG8_LDB
#undef PG8_MMA
#undef PG8_WAIT_V
#undef PG8_WAIT_L
#undef PG8_BAR
#undef PG8_SCHED
}

}
#ifndef STAGE_REP
#define STAGE_REP 0
#endif

constexpr int NWAVES = 8;
constexpr int D = 1024, BATCH = 2, T = 8192, TC = 256, NH = 16;
constexpr int ML = BATCH * T;
constexpr int MC = BATCH * TC;
constexpr int MT = ML + MC;
constexpr int N_IN = 8576, NZ = 8704;
constexpr int K_OFF = 0, V_OFF = 1024, DECAY_OFF = 2048, ICLR_OFF = 2176, STATE_COLS = 2304, R_OFF = 2304, GLORA_OFF = 3328, SHIFT_COLS = 3456;
constexpr int CONV_OFF = 3456, GATE_OFF = 6528;
constexpr int NE = 32, TOPK = 4, DFF = 1024;
constexpr int NL = 5120, KL = 384;
constexpr int MAXBLK = 288;
constexpr int NROWS = MAXBLK * 256;
constexpr int KSPLIT = 16;

constexpr size_t MiB = 1u << 20;
constexpr size_t WS_CTL = 0, CTL_ZERO_BYTES = 1 * MiB;
constexpr size_t WS_MODP = 1 * MiB;
constexpr size_t WS_WLORA = 3 * MiB;
constexpr size_t WS_WROUT = 7 * MiB;
constexpr size_t WS_WOUT = 8 * MiB;
constexpr size_t WS_WIN = 10 * MiB;
constexpr size_t WS_A0 = 28 * MiB;
constexpr size_t WS_MISC = 61 * MiB;
constexpr size_t WS_Z = 64 * MiB;
constexpr size_t WS_AL = 345 * MiB;
constexpr size_t WS_LORA = 358 * MiB;
constexpr size_t WS_SCAN = 523 * MiB;
constexpr size_t WS_Y = 886 * MiB;
constexpr size_t WS_END = 1014 * MiB;
constexpr size_t WS_PQ = WS_SCAN;
constexpr size_t WS_TKN = WS_PQ + 132 * MiB;
constexpr size_t WS_UPRE = WS_TKN + 66 * MiB;
constexpr size_t WS_H0T = WS_UPRE + 66 * MiB;
static_assert(WS_H0T + 64 * MiB <= WS_Y, "scan region");
constexpr size_t WS_MIX = WS_LORA, WS_X1 = WS_LORA + 64 * MiB, WS_H2 = WS_LORA + 128 * MiB;
constexpr size_t WS_LOGIT = WS_SCAN, WS_XB = WS_SCAN + 16 * MiB, WS_ACT = WS_XB + 144 * MiB;
constexpr size_t WS_Y2 = WS_Z, WS_WEIN = WS_Y, WS_WEOUT = WS_Y + 64 * MiB;
static_assert(WS_ACT + 144 * MiB <= WS_Y && WS_WEIN + 64 * MiB <= WS_WEOUT && WS_WEOUT + 64 * MiB <= WS_END, "late regions");
constexpr size_t MI_SELE = WS_MISC, MI_SELP = MI_SELE + (size_t)ML * 4 * 4, MI_GATE = MI_SELP + (size_t)ML * 4 * 4, MI_DEST = MI_GATE + (size_t)ML * 4 * 4, MI_BLKE = MI_DEST + (size_t)ML * 4 * 4;
constexpr size_t MI_RSH = MI_BLKE + 4096;
constexpr size_t MI_CSWIN = MI_RSH + (size_t)MT * 4;
constexpr size_t MI_RSH2 = MI_CSWIN + (size_t)NZ * 4;
constexpr size_t MI_RSXB = MI_RSH2 + (size_t)ML * 4;
constexpr size_t MI_CSWEI = MI_RSXB + (size_t)NROWS * 4;
static_assert(MI_CSWEI + (size_t)NE * 2048 * 4 <= WS_Z && MI_RSH % 16 == 0 && MI_CSWIN % 16 == 0 && MI_CSWEI % 16 == 0, "misc");
constexpr size_t WS_H2Q = WS_A0;
constexpr int CW_BAR = 4096;
constexpr int CW_CNT = 16384;
constexpr int CW_FB = 8192;
constexpr int CW_Q6 = CW_CNT + 64 * 40;

constexpr int RING_OFF = 0, RING_BYTES = 131072;
constexpr int LDSCTL_OFF = 147456, MISC_OFF = LDSCTL_OFF + 320;
constexpr int LDS_X_OFF = LDSCTL_OFF + 512;
constexpr int LDS_BYTES = 163840;

#define GAS __attribute__((address_space(1)))
#define LAS __attribute__((address_space(3)))
typedef unsigned short bf16;
typedef unsigned v4u __attribute__((ext_vector_type(4)));
typedef unsigned v2u __attribute__((ext_vector_type(2)));
typedef float f32x4 __attribute__((ext_vector_type(4)));
#define LDS_WAIT() asm volatile("s_waitcnt lgkmcnt(0)" ::: "memory")
#define VM_WAIT() asm volatile("s_waitcnt vmcnt(0)" ::: "memory")
__device__ __forceinline__ unsigned f2bf(float f) { unsigned u = __builtin_bit_cast(unsigned, f); return (u + 0x7fffu + ((u >> 16) & 1u)) >> 16; }
__device__ __forceinline__ unsigned pk2(float lo, float hi) { return f2bf(lo) | (f2bf(hi) << 16); }
__device__ __forceinline__ float bflo(unsigned w) { return __builtin_bit_cast(float, w << 16); }
__device__ __forceinline__ float bfhi(unsigned w) { return __builtin_bit_cast(float, w & 0xffff0000u); }
__device__ __forceinline__ float bf1(bf16 h) { return __builtin_bit_cast(float, (unsigned)h << 16); }
__device__ __forceinline__ void ld16bf(const bf16* p, float (&o)[16]) {
    const v4u a = *(const v4u*)p, b = *(const v4u*)(p + 8);
    o[0] = bflo(a.x); o[1] = bfhi(a.x); o[2] = bflo(a.y); o[3] = bfhi(a.y); o[4] = bflo(a.z); o[5] = bfhi(a.z); o[6] = bflo(a.w); o[7] = bfhi(a.w);
    o[8] = bflo(b.x); o[9] = bfhi(b.x); o[10] = bflo(b.y); o[11] = bfhi(b.y); o[12] = bflo(b.z); o[13] = bfhi(b.z); o[14] = bflo(b.w); o[15] = bfhi(b.w);
}
__device__ __forceinline__ void st16bf(bf16* p, const float (&o)[16]) {
    v4u a, b; a.x = pk2(o[0], o[1]); a.y = pk2(o[2], o[3]); a.z = pk2(o[4], o[5]); a.w = pk2(o[6], o[7]);
    b.x = pk2(o[8], o[9]); b.y = pk2(o[10], o[11]); b.z = pk2(o[12], o[13]); b.w = pk2(o[14], o[15]);
    *(v4u*)p = a; *(v4u*)(p + 8) = b;
}
__device__ __forceinline__ void ld16f(const float* p, float (&o)[16]) {
#pragma unroll
    for (int q = 0; q < 4; ++q) { const f32x4 v = *(const f32x4*)(p + 4 * q); o[4 * q] = v.x; o[4 * q + 1] = v.y; o[4 * q + 2] = v.z; o[4 * q + 3] = v.w; }
}
__device__ __forceinline__ void ld16f_lds(const LAS float* p, float (&o)[16]) {
#pragma unroll
    for (int q = 0; q < 4; ++q) { const f32x4 v = *(const LAS f32x4*)(p + 4 * q); o[4 * q] = v.x; o[4 * q + 1] = v.y; o[4 * q + 2] = v.z; o[4 * q + 3] = v.w; }
}
__device__ __forceinline__ void st16f(float* p, const float (&o)[16]) {
#pragma unroll
    for (int q = 0; q < 4; ++q) *(f32x4*)(p + 4 * q) = (f32x4){o[4 * q], o[4 * q + 1], o[4 * q + 2], o[4 * q + 3]};
}
__device__ __forceinline__ float sigmoidf_(float x) { return 1.0f / (1.0f + __expf(-x)); }
__device__ __forceinline__ float wave_sum(float v) {
#pragma unroll
    for (int o = 1; o < 64; o <<= 1) v += __shfl_xor(v, o);
    return v;
}
__device__ __forceinline__ float wave_max(float v) {
#pragma unroll
    for (int o = 1; o < 64; o <<= 1) v = fmaxf(v, __shfl_xor(v, o));
    return v;
}
__device__ __forceinline__ unsigned pack_q4(float a, float b, float c, float d) {
    const int qa = __float2int_rn(a), qb = __float2int_rn(b), qc = __float2int_rn(c), qd = __float2int_rn(d);
    return (unsigned)(qa & 255) | ((unsigned)(qb & 255) << 8) | ((unsigned)(qc & 255) << 16) | ((unsigned)qd << 24);
}
__device__ __forceinline__ float quad_sum(float v) { v += __shfl_xor(v, 1); v += __shfl_xor(v, 2); return v; }

#define XB_TMO      128
#define XB_XCNT(j)  (256  + 64 * (j))
#define XB_XSUB(j)  (1280 + 64 * (j))
#define XB_XGEN(j)  (2304 + 64 * (j))
#define XB_TOP      3328
#define XB_TOPGEN   3392
#define XCD_BAR_WORDS 3456
#define XB_SPIN_CAP (1u << 18)

__device__ __forceinline__ unsigned xb_ld(unsigned* p)              { return __hip_atomic_load(p, __ATOMIC_RELAXED, __HIP_MEMORY_SCOPE_AGENT); }
__device__ __forceinline__ unsigned xb_add(unsigned* p, unsigned v) { return __hip_atomic_fetch_add(p, v, __ATOMIC_RELAXED, __HIP_MEMORY_SCOPE_AGENT); }
__device__ __forceinline__ unsigned xb_xcc_id() { return (unsigned)__builtin_amdgcn_s_getreg((3 << 11) | 20) & 0xFu; }
#define XB_SPIN(cond, bar) do { unsigned _sp = 0; while (cond) { __builtin_amdgcn_s_sleep(1); \
    if ((++_sp & 255u) == 0u) { if (xb_ld(&(bar)[XB_TMO])) break; if (_sp > XB_SPIN_CAP) { atomicAdd(&(bar)[XB_TMO], 1u); break; } } } } while (0)

struct XcdBarrier { unsigned* bar; unsigned x; volatile LAS unsigned* st; };

__device__ __forceinline__ XcdBarrier xcd_barrier_post(unsigned* bar, volatile LAS unsigned* st) {
    XcdBarrier b; b.bar = bar; b.x = xb_xcc_id(); b.st = st;
    if (threadIdx.x == 0) (void)xb_add(&bar[XB_XCNT(b.x)], 1u);
    return b;
}
__device__ __forceinline__ void xcd_barrier_complete(unsigned* bar, unsigned x, unsigned& nloc, unsigned& nx) {
    const unsigned G = gridDim.x * gridDim.y * gridDim.z;
    unsigned sum, cnt, mine, sp = 0u;
    for (;;) {
        sum = 0u; cnt = 0u; mine = 0u;
#pragma unroll
        for (unsigned j = 0; j < 16; ++j) { const unsigned c = xb_ld(&bar[XB_XCNT(j)]); sum += c; cnt += (c > 0u) ? 1u : 0u; mine = (j == x) ? c : mine; }
        if (sum == G) break;
        __builtin_amdgcn_s_sleep(1);
        if ((++sp & 255u) == 0u) { if (xb_ld(&bar[XB_TMO])) break; if (sp > XB_SPIN_CAP) { atomicAdd(&bar[XB_TMO], 1u); break; } }
    }
    nloc = mine > 0u ? mine : 1u; nx = cnt > 0u ? cnt : 1u;
}
__device__ __forceinline__ void xcd_barrier(const XcdBarrier& b) {
    asm volatile("s_waitcnt vmcnt(0)" ::: "memory");
    __syncthreads();
    if (threadIdx.x == 0) {
        unsigned* bar = b.bar;
        __builtin_amdgcn_s_waitcnt(0);
        unsigned nloc = b.st[0], nx = b.st[1];
        if (nloc == 0u) { xcd_barrier_complete(bar, b.x, nloc, nx); b.st[0] = nloc; b.st[1] = nx; }
        const unsigned old = xb_add(&bar[XB_XSUB(b.x)], 1u);
        const unsigned gen = old / nloc;
        if (old + 1u == (gen + 1u) * nloc) {
            __builtin_amdgcn_fence(__ATOMIC_RELEASE, "agent");
            asm volatile("s_waitcnt vmcnt(0)" ::: "memory");
            const unsigned og = xb_add(&bar[XB_TOP], 1u);
            const unsigned tg = og / nx;
            if (og + 1u == (tg + 1u) * nx) xb_add(&bar[XB_TOPGEN], 1u);
            else XB_SPIN(xb_ld(&bar[XB_TOPGEN]) == tg, bar);
            __builtin_amdgcn_fence(__ATOMIC_ACQUIRE, "agent");
            xb_add(&bar[XB_XGEN(b.x)], 1u);
            asm volatile("s_waitcnt vmcnt(0)" ::: "memory");
        } else {
            XB_SPIN(xb_ld(&bar[XB_XGEN(b.x)]) == gen, bar);
            __builtin_amdgcn_fence(__ATOMIC_ACQUIRE, "agent");
            asm volatile("s_waitcnt vmcnt(0)" ::: "memory");
        }
    }
    __syncthreads();
}

#define XB_DONE(j)  (3456 + 64 * (j))
__device__ __forceinline__ void xcd_barrier2(const XcdBarrier& b) {
    asm volatile("s_waitcnt vmcnt(0)" ::: "memory");
    __syncthreads();
    if (threadIdx.x == 0) {
        unsigned* bar = b.bar;
        __builtin_amdgcn_s_waitcnt(0);
        unsigned nloc = b.st[0], nx = b.st[1];
        if (nloc == 0u) { xcd_barrier_complete(bar, b.x, nloc, nx); b.st[0] = nloc; b.st[1] = nx; }
        const unsigned old = xb_add(&bar[XB_XSUB(b.x)], 1u);
        const unsigned gen = old / nloc;
        if (old + 1u == (gen + 1u) * nloc) {
            __builtin_amdgcn_fence(__ATOMIC_RELEASE, "agent");
            asm volatile("s_waitcnt vmcnt(0)" ::: "memory");
#pragma unroll
            for (unsigned j = 0; j < 16; ++j) (void)xb_add(&bar[XB_DONE(j)], 1u);
        }
        XB_SPIN(xb_ld(&bar[XB_DONE(b.x)]) < (gen + 1u) * nx, bar);
        __builtin_amdgcn_fence(__ATOMIC_ACQUIRE, "agent");
        asm volatile("s_waitcnt vmcnt(0)" ::: "memory");
    }
    __syncthreads();
}

#define FB_WORD(j) (64 * (j))
#define FB_TMO 640
__device__ __forceinline__ void flat_barrier(unsigned* fb, unsigned epoch) {
    asm volatile("s_waitcnt vmcnt(0)" ::: "memory");
    __syncthreads();
    if (threadIdx.x == 0) {
        __builtin_amdgcn_s_waitcnt(0);
        __builtin_amdgcn_fence(__ATOMIC_RELEASE, "agent");
        asm volatile("s_waitcnt vmcnt(0)" ::: "memory");
        (void)xb_add(&fb[FB_WORD(blockIdx.x & 7u)], 1u);
        const unsigned want = epoch * gridDim.x; unsigned sp = 0u;
        for (;;) {
            unsigned s = 0u;
#pragma unroll
            for (int j = 0; j < 8; ++j) s += xb_ld(&fb[FB_WORD(j)]);
            if (s >= want) break;
            __builtin_amdgcn_s_sleep(1);
            if ((++sp & 255u) == 0u) { if (xb_ld(&fb[FB_TMO])) break; if (sp > XB_SPIN_CAP) { atomicAdd(&fb[FB_TMO], 1u); break; } }
        }
        __builtin_amdgcn_fence(__ATOMIC_ACQUIRE, "agent");
        asm volatile("s_waitcnt vmcnt(0)" ::: "memory");
    }
    __syncthreads();
}

struct Frame {
    LAS unsigned char* lds;
    volatile LAS unsigned* MISC;
    unsigned* ctl;
    int tid, lane, wave, G, gw, NGW;
    float* out;
    unsigned char* ws;
};
enum { I_X = 0, I_C, I_CTX, I_CCTX, I_WADA, I_BADA, I_NPM, I_NQM, I_NPF, I_NQF, I_WIN, I_MU, I_W0, I_WDU, I_A0, I_WIU, I_KK, I_KA, I_RK, I_WGU, I_LNW, I_LNB, I_CONVW,
       I_WOUT, I_WR, I_BR, I_WEI, I_BEI, I_WEO, I_BEO };


typedef const float* fptr_t;
__device__ __forceinline__ fptr_t kin_ptr(int i) { const volatile __attribute__((address_space(4))) fptr_t* ka = (const volatile __attribute__((address_space(4))) fptr_t*)__builtin_amdgcn_kernarg_segment_ptr(); return ka[i]; }
#define KIN(i) kin_ptr(i)
__device__ __forceinline__ void transpose_item(const float* W, int N, int k0, int n0, bf16* WT, int ldk, int rowbase, LAS float* scr, int lane) {
#pragma unroll 8
    for (int i = 0; i < 32; ++i) { const int kk = 2 * i + (lane >> 5); scr[kk * 33 + (lane & 31)] = W[(size_t)(k0 + kk) * N + n0 + (lane & 31)]; }
    LDS_WAIT(); asm volatile("" ::: "memory");
    const int c = lane & 7;
#pragma unroll
    for (int j = 0; j < 4; ++j) { const int n = (lane >> 3) + 8 * j; const LAS float* s = scr + (8 * c) * 33 + n;
        v4u o; o.x = pk2(s[0 * 33], s[1 * 33]); o.y = pk2(s[2 * 33], s[3 * 33]); o.z = pk2(s[4 * 33], s[5 * 33]); o.w = pk2(s[6 * 33], s[7 * 33]);
        *(v4u*)(WT + (size_t)(rowbase + n) * ldk + k0 + 8 * c) = o; }
    LDS_WAIT(); asm volatile("" ::: "memory");
}

__device__ __forceinline__ unsigned pack_q4c(float a, float b, float c, float d) {
    const int qa = __float2int_rn(fminf(fmaxf(a, -127.f), 127.f)), qb = __float2int_rn(fminf(fmaxf(b, -127.f), 127.f)), qc = __float2int_rn(fminf(fmaxf(c, -127.f), 127.f)), qd = __float2int_rn(fminf(fmaxf(d, -127.f), 127.f));
    return (unsigned)(qa & 255) | ((unsigned)(qb & 255) << 8) | ((unsigned)(qc & 255) << 16) | ((unsigned)qd << 24);
}
__device__ __forceinline__ void q8_item(const float* W, int N, int n0, signed char* WT, float* cs, int rowbase, LAS float* scr, int lane, int kb0 = 0, int kb1 = 16) {
    const int r8 = lane >> 3, c4 = lane & 7;
    const float* p0 = W + (size_t)r8 * N + n0 + 4 * c4;
    f32x4 ss = {0.f, 0.f, 0.f, 0.f};
#pragma unroll 8
    for (int i = 0; i < 32; ++i) { const f32x4 v = *(const f32x4*)(p0 + (size_t)(8 * i) * N); ss += v * v; }
#pragma unroll
    for (int o = 8; o < 64; o <<= 1) { ss.x += __shfl_xor(ss.x, o); ss.y += __shfl_xor(ss.y, o); ss.z += __shfl_xor(ss.z, o); ss.w += __shfl_xor(ss.w, o); }
    if (lane < 8) {
#pragma unroll
        for (int q = 0; q < 4; ++q) { const float m = 6.0f * sqrtf(ss[q] * (1.0f / 256.0f)); cs[rowbase + 4 * lane + q] = m * (1.0f / 127.0f); scr[2112 + 4 * lane + q] = m > 0.f ? 127.0f / m : 0.f; } }
    LDS_WAIT(); asm volatile("" ::: "memory");
    f32x4 cur[8];
#pragma unroll
    for (int i = 0; i < 8; ++i) cur[i] = *(const f32x4*)(p0 + (size_t)(64 * kb0 + 8 * i) * N);
    for (int kb = kb0; kb < kb1; ++kb) {
        f32x4 nxt[8];
        const int kn = kb < kb1 - 1 ? kb + 1 : kb;
#pragma unroll
        for (int i = 0; i < 8; ++i) nxt[i] = *(const f32x4*)(p0 + (size_t)(64 * kn + 8 * i) * N);
#pragma unroll
        for (int i = 0; i < 8; ++i) { LAS float* s = scr + (r8 + 8 * i) * 33 + 4 * c4; s[0] = cur[i].x; s[1] = cur[i].y; s[2] = cur[i].z; s[3] = cur[i].w; }
        LDS_WAIT(); asm volatile("" ::: "memory");
        const int c = lane & 3;
#pragma unroll
        for (int j = 0; j < 2; ++j) { const int n = (lane >> 2) + 16 * j; const float iv = scr[2112 + n]; const LAS float* s = scr + (16 * c) * 33 + n;
            v4u o; o.x = pack_q4c(s[0] * iv, s[33] * iv, s[66] * iv, s[99] * iv); o.y = pack_q4c(s[132] * iv, s[165] * iv, s[198] * iv, s[231] * iv);
            o.z = pack_q4c(s[264] * iv, s[297] * iv, s[330] * iv, s[363] * iv); o.w = pack_q4c(s[396] * iv, s[429] * iv, s[462] * iv, s[495] * iv);
            *(v4u*)(WT + (size_t)(rowbase + n) * 1024 + 64 * kb + 16 * c) = o; }
        LDS_WAIT(); asm volatile("" ::: "memory");
#pragma unroll
        for (int i = 0; i < 8; ++i) cur[i] = nxt[i];
    }
}

__device__ __forceinline__ float mod_val(const float* modp, const float* b_ada, int vec, int j) {
    float s = b_ada[j];
#pragma unroll
    for (int ks = 0; ks < KSPLIT; ++ks) s += modp[((size_t)ks * 3 + vec) * 6144 + j];
    return s;
}
__device__ __forceinline__ int nbr_row(int row, int j) {
    if (row < ML) { const int t = row & (T - 1), gc = t & 63, gr = t >> 6;
        if (j == 0) return gc > 0 ? row - 1 : -1; if (j == 1) return gc < 63 ? row + 1 : -1; if (j == 2) return gr > 0 ? row - 64 : -1; return gr < 127 ? row + 64 : -1; }
    const int tc = (row - ML) & (TC - 1);
    if ((j & 1) == 0) return tc > 0 ? row - 1 : -1; return tc < TC - 1 ? row + 1 : -1;
}
__device__ __forceinline__ void load_shift16(const bf16* z, int row, int col0, const LAS float* mu, float (&out)[16]) {
    float s[16]; ld16bf(z + (size_t)row * NZ + col0, s);
    float m[16]; ld16f_lds(mu, m);
#pragma unroll
    for (int j = 0; j < 4; ++j) {
        const int nr = nbr_row(row, j); float t[16];
        if (nr >= 0) ld16bf(z + (size_t)nr * NZ + col0, t); else {
#pragma unroll
            for (int i = 0; i < 16; ++i) t[i] = 0.f; }
#pragma unroll
        for (int i = j; i < 16; i += 4) out[i] = s[i] + m[i] * (t[i] - s[i]);
    }
}

__device__ __forceinline__ void phase_prologue(Frame& F) {
    LAS float* scr = (LAS float*)(F.lds + RING_OFF + F.wave * 16384);
    LAS float* sil = (LAS float*)(F.lds + LDS_X_OFF);
    for (int i = F.tid; i < 3 * D; i += NWAVES * 64) { const int v = i / D, j = i % D; const float c = v < 2 ? KIN(I_C)[v * D + j] : KIN(I_CCTX)[j]; sil[i] = c / (1.0f + __expf(-c)); }
    __syncthreads();
    bf16* WoutT = (bf16*)(F.ws + WS_WOUT);
    constexpr int IT_WIN = (N_IN / 32) * 4, IT_WOUT = (D / 64) * (D / 32), IT_ADA = 24 * KSPLIT;
    constexpr int NITEMS = IT_ADA + IT_WIN + IT_WOUT;
    float* modp = (float*)(F.ws + WS_MODP);
    for (int it = F.gw; it < NITEMS; it += F.NGW) {
        int r = it;
        if (r < IT_ADA) {
            const int cc = r % 24, ks = r / 24, col = cc * 256 + F.lane * 4;
            f32x4 a0 = {0.f, 0.f, 0.f, 0.f}, a1 = a0, a2 = a0;
            const float* wp = KIN(I_WADA) + (size_t)(ks * 64) * 6144 + col;
#pragma unroll 8
            for (int k = 0; k < 64; ++k) { const f32x4 w = *(const f32x4*)(wp + (size_t)k * 6144); const int kk = ks * 64 + k;
                a0 += w * sil[kk]; a1 += w * sil[D + kk]; a2 += w * sil[2 * D + kk]; }
            *(f32x4*)(modp + ((size_t)ks * 3 + 0) * 6144 + col) = a0; *(f32x4*)(modp + ((size_t)ks * 3 + 1) * 6144 + col) = a1; *(f32x4*)(modp + ((size_t)ks * 3 + 2) * 6144 + col) = a2;
            continue; }
        r -= IT_ADA;
        if (r < IT_WIN) { const int st = r >> 2, qq = r & 3; q8_item(KIN(I_WIN), N_IN, 32 * st, (signed char*)(F.ws + WS_WIN), (float*)(F.ws + MI_CSWIN), 32 * st, scr, F.lane, 4 * qq, 4 * qq + 4); continue; }
        r -= IT_WIN;
        { const int nb = D / 32, kb = r / nb, n0 = 32 * (r % nb); transpose_item(KIN(I_WOUT), D, 64 * kb, n0, WoutT, D, n0, scr, F.lane); }
    }
    const int gt = blockIdx.x * (NWAVES * 64) + F.tid, NGT = F.G * NWAVES * 64;
    for (int i = gt; i < (NZ - N_IN) * D / 16; i += NGT) *(v4u*)(F.ws + WS_WIN + (size_t)N_IN * D + (size_t)i * 16) = (v4u){0u, 0u, 0u, 0u};
    for (int i = gt; i < NZ - N_IN; i += NGT) ((float*)(F.ws + MI_CSWIN))[N_IN + i] = 0.f;
    bf16* WL = (bf16*)(F.ws + WS_WLORA);
    for (int i = gt; i < NL * (KL / 8); i += NGT) {
        const int c8 = i / NL, row = i % NL, blk = row >> 10, n = row & 1023, col = c8 * 8, g = col >> 6;
        const float* src = nullptr; int kofs = 0;
        if (blk < 2) { if (g == blk) { src = KIN(I_WDU) + (size_t)blk * 64 * D; kofs = col - 64 * blk; } }
        else if (blk < 4) { if (g == blk) { src = KIN(I_WIU) + (size_t)(blk - 2) * 64 * D; kofs = col - 64 * blk; } }
        else { if (g >= 4) { src = KIN(I_WGU); kofs = col - 256; } }
        v4u o = {0u, 0u, 0u, 0u};
        if (src) { float v[8];
#pragma unroll
            for (int q = 0; q < 8; ++q) v[q] = src[(size_t)(kofs + q) * D + n];
            o.x = pk2(v[0], v[1]); o.y = pk2(v[2], v[3]); o.z = pk2(v[4], v[5]); o.w = pk2(v[6], v[7]); }
        *(v4u*)(WL + (size_t)row * KL + col) = o;
    }
    bf16* WR = (bf16*)(F.ws + WS_WROUT);
    for (int i = gt; i < 256 * (D / 8); i += NGT) {
        const int row = i % 256, c8 = i / 256; v4u o = {0u, 0u, 0u, 0u};
        if (row < NE) { float v[8];
#pragma unroll
            for (int q = 0; q < 8; ++q) v[q] = KIN(I_WR)[(size_t)(c8 * 8 + q) * NE + row];
            o.x = pk2(v[0], v[1]); o.y = pk2(v[2], v[3]); o.z = pk2(v[4], v[5]); o.w = pk2(v[6], v[7]); }
        *(v4u*)(WR + (size_t)row * D + c8 * 8) = o;
    }
}

__device__ __forceinline__ void phase_hrows(Frame& F) {
    LAS float* LA = (LAS float*)(F.lds);
    LAS float* LB = LA + 3 * D;
    const float* modp = (const float*)(F.ws + WS_MODP);
    for (int i = F.tid; i < 3 * D; i += NWAVES * 64) { const int v = i / D, j = i % D;
        LA[i] = KIN(I_NPM)[j] * (1.0f + mod_val(modp, KIN(I_BADA), v, 1024 + j)); LB[i] = mod_val(modp, KIN(I_BADA), v, j); }
    __syncthreads();
    signed char* A0q = (signed char*)(F.ws + WS_A0);
    for (int row = F.gw; row < MT; row += F.NGW) {
        const float* xr; int vec;
        if (row < ML) { xr = KIN(I_X) + (size_t)row * D; vec = row >> 13; } else { xr = KIN(I_CTX) + (size_t)(row - ML) * D; vec = 2; }
        f32x4 v[4]; float s = 0.f;
#pragma unroll
        for (int j = 0; j < 4; ++j) { v[j] = *(const f32x4*)(xr + 4 * F.lane + 256 * j); s += (v[j].x * v[j].x + v[j].y * v[j].y) + (v[j].z * v[j].z + v[j].w * v[j].w); }
        const float rstd = 1.0f / sqrtf(wave_sum(s) * (1.0f / D) + 1e-6f);
        f32x4 hq[4]; float mx = 0.f;
#pragma unroll
        for (int j = 0; j < 4; ++j) { const int c = 4 * F.lane + 256 * j; const f32x4 a = *(const LAS f32x4*)(LA + vec * D + c), b = *(const LAS f32x4*)(LB + vec * D + c);
            hq[j] = v[j] * rstd * a + b; mx = fmaxf(mx, fmaxf(fmaxf(fabsf(hq[j].x), fabsf(hq[j].y)), fmaxf(fabsf(hq[j].z), fabsf(hq[j].w)))); }
        mx = wave_max(mx);
        const float iv = mx > 0.f ? 127.0f / mx : 0.f;
        if (F.lane == 0) ((float*)(F.ws + MI_RSH))[row] = mx * (1.0f / 127.0f);
        unsigned* o4 = (unsigned*)(A0q + (size_t)row * D) + F.lane;
#pragma unroll
        for (int j = 0; j < 4; ++j) o4[64 * j] = pack_q4(hq[j].x * iv, hq[j].y * iv, hq[j].z * iv, hq[j].w * iv);
    }
}

__device__ __forceinline__ void phase_lora_in(Frame& F) {
    const bf16* z = (const bf16*)(F.ws + WS_Z); bf16* AL = (bf16*)(F.ws + WS_AL);
    const int gt = blockIdx.x * (NWAVES * 64) + F.tid, NGT = F.G * NWAVES * 64;
    for (int i = gt; i < MT * (KL / 4); i += NGT) {
        const int row = i / (KL / 4), q = i % (KL / 4), j0 = 4 * q;
        const int zc = j0 < 256 ? DECAY_OFF + j0 : GLORA_OFF + (j0 - 256);
        float o[4];
        if (j0 >= 256 && row >= ML) { o[0] = o[1] = o[2] = o[3] = 0.f; }
        else {
            const uint2 sv = *(const uint2*)(z + (size_t)row * NZ + zc); const float s[4] = {bflo(sv.x), bfhi(sv.x), bflo(sv.y), bfhi(sv.y)};
#pragma unroll
            for (int j = 0; j < 4; ++j) { const int nr = nbr_row(row, j); float t = 0.f;
                if (nr >= 0) t = bf1(z[(size_t)nr * NZ + zc + j]);
                const float v = s[j] + KIN(I_MU)[zc + j] * (t - s[j]);
                o[j] = j0 < 128 ? tanhf(v) : (j0 < 256 ? v : sigmoidf_(v)); }
        }
        *(uint2*)(AL + (size_t)row * KL + j0) = make_uint2(pk2(o[0], o[1]), pk2(o[2], o[3]));
    }
}


namespace ck {
typedef short bf16x8 __attribute__((ext_vector_type(8)));
constexpr int TILE = 8192;
constexpr int NU_L = BATCH * (T / 64) * NH;
constexpr int NU_ALL = NU_L + BATCH * (TC / 64) * NH;
__device__ __forceinline__ int swz(int row) { return (row ^ (row >> 3)) & 7; }
__device__ __forceinline__ int toff(int row, int col) { return row * 128 + ((col * 2) ^ (swz(row) << 4)); }
__device__ __forceinline__ bf16x8 ldfrag(const LAS unsigned char* t, int row, int chunk) { return *(const LAS bf16x8*)(t + row * 128 + ((chunk ^ swz(row)) << 4)); }
typedef __bf16 bf16v2_t __attribute__((ext_vector_type(2)));
__device__ __forceinline__ unsigned cvtpk(float lo, float hi) { const bf16v2_t v = {(__bf16)lo, (__bf16)hi}; return __builtin_bit_cast(unsigned, v); }
#define CK_MFMA(a, b, c) __builtin_amdgcn_mfma_f32_16x16x32_bf16(a, b, c, 0, 0, 0)
template <bool MASKDIAG>
__device__ __forceinline__ void mm64(f32x4 (&acc)[4], const LAS unsigned char* Lt, const LAS unsigned char* Rt, int wq, int lane) {
    const int lr = lane & 15, g = lane >> 4;
    const bf16x8 l0 = ldfrag(Lt, 16 * wq + lr, g), l1 = ldfrag(Lt, 16 * wq + lr, 4 + g);
#pragma unroll
    for (int n = 0; n < 4; ++n) {
        bf16x8 r0 = ldfrag(Rt, 16 * n + lr, g), r1 = ldfrag(Rt, 16 * n + lr, 4 + g);
        if (MASKDIAG) { const bf16x8 zz = {0, 0, 0, 0, 0, 0, 0, 0}; if ((g >> 1) == n) r0 = zz; if (2 + (g >> 1) == n) r1 = zz; }
        acc[n] = CK_MFMA(l0, r0, acc[n]); acc[n] = CK_MFMA(l1, r1, acc[n]);
    }
}
__device__ __forceinline__ void zero4(f32x4 (&a)[4]) {
#pragma unroll
    for (int n = 0; n < 4; ++n) a[n] = (f32x4){0.f, 0.f, 0.f, 0.f};
}
__device__ __forceinline__ void storeT(LAS unsigned char* t, const f32x4 (&v)[4], int wq, int lane) {
    const int lr = lane & 15, g = lane >> 4;
#pragma unroll
    for (int n = 0; n < 4; ++n) *(LAS v2u*)(t + toff(16 * n + lr, 16 * wq + 4 * g)) = (v2u){cvtpk(v[n][0], v[n][1]), cvtpk(v[n][2], v[n][3])};
}
__device__ __forceinline__ void storeN(LAS unsigned char* t, const f32x4 (&v)[4], int wq, int lane) {
    const int lr = lane & 15, g = lane >> 4;
#pragma unroll
    for (int n = 0; n < 4; ++n)
#pragma unroll
        for (int i = 0; i < 4; ++i) *(LAS unsigned short*)(t + toff(16 * wq + 4 * g + i, 16 * n + lr)) = (unsigned short)f2bf(v[n][i]);
}
__device__ __forceinline__ void loadT(f32x4 (&v)[4], const LAS unsigned char* t, int wq, int lane) {
    const int lr = lane & 15, g = lane >> 4;
#pragma unroll
    for (int n = 0; n < 4; ++n) { const v2u w = *(const LAS v2u*)(t + toff(16 * n + lr, 16 * wq + 4 * g)); v[n] = (f32x4){bflo(w.x), bfhi(w.x), bflo(w.y), bfhi(w.y)}; }
}
__device__ __forceinline__ void unit_decode(int unit, int& b, int& h, int& rowbase) {
    if (unit < NU_L) { h = unit & 15; const int blk = (unit >> 4) & 127; b = unit >> 11; rowbase = b * T + blk * 64; }
    else { const int u = unit - NU_L; h = u & 15; const int cb = (u >> 4) & 3; b = u >> 6; rowbase = ML + b * TC + cb * 64; }
}
__device__ __forceinline__ void pack8(LAS unsigned char* t, int row, int chunk, const float (&v)[8], bool rev) {
    v4u o;
    if (!rev) { o.x = cvtpk(v[0], v[1]); o.y = cvtpk(v[2], v[3]); o.z = cvtpk(v[4], v[5]); o.w = cvtpk(v[6], v[7]); }
    else { o.x = cvtpk(v[7], v[6]); o.y = cvtpk(v[5], v[4]); o.z = cvtpk(v[3], v[2]); o.w = cvtpk(v[1], v[0]); }
    *(LAS v4u*)(t + row * 128 + ((chunk ^ swz(row)) << 4)) = o;
}

__device__ __forceinline__ void unpack8(const v4u p, float (&o)[8]) {
    o[0] = bflo(p.x); o[1] = bfhi(p.x); o[2] = bflo(p.y); o[3] = bfhi(p.y); o[4] = bflo(p.z); o[5] = bfhi(p.z); o[6] = bflo(p.w); o[7] = bfhi(p.w);
}
__device__ __forceinline__ void ld8f(const float* p, float (&o)[8]) {
    const f32x4 a = *(const f32x4*)p, b = *(const f32x4*)(p + 4); o[0] = a.x; o[1] = a.y; o[2] = a.z; o[3] = a.w; o[4] = b.x; o[5] = b.y; o[6] = b.z; o[7] = b.w;
}
__device__ __forceinline__ float fsig(float x) { return __builtin_amdgcn_rcpf(1.0f + __expf(-x)); }
template <bool IS_CO> struct EPre { v4u k[5], v[5], r[IS_CO ? 5 : 1], lo[4]; };
template <bool IS_CO>
__device__ __forceinline__ void epre_load(EPre<IS_CO>& P, const bf16* z, const bf16* LO, int unit, int wave, int lane) {
    int b, h, rowbase; unit_decode(unit, b, h, rowbase);
    const int row = rowbase + 8 * wave + (lane >> 3), c0 = h * 64 + 8 * (lane & 7);
    const v4u zz = {0u, 0u, 0u, 0u};
    const bf16* zr = z + (size_t)row * NZ;
    P.k[0] = *(const v4u*)(zr + K_OFF + c0); P.v[0] = *(const v4u*)(zr + V_OFF + c0); if (IS_CO) P.r[0] = *(const v4u*)(zr + R_OFF + c0);
#pragma unroll
    for (int j = 0; j < 4; ++j) { const int nr = nbr_row(row, j); const bf16* zn = z + (size_t)(nr >= 0 ? nr : row) * NZ;
        const v4u a = *(const v4u*)(zn + K_OFF + c0), bq = *(const v4u*)(zn + V_OFF + c0);
        P.k[1 + j] = nr >= 0 ? a : zz; P.v[1 + j] = nr >= 0 ? bq : zz;
        if (IS_CO) { const v4u cq = *(const v4u*)(zn + R_OFF + c0); P.r[1 + j] = nr >= 0 ? cq : zz; } }
    const bf16* lr_ = LO + (size_t)row * NL + c0;
    P.lo[0] = *(const v4u*)(lr_); P.lo[1] = *(const v4u*)(lr_ + 1024); P.lo[2] = *(const v4u*)(lr_ + 2048); P.lo[3] = *(const v4u*)(lr_ + 3072);
}
__device__ __forceinline__ void shift8(const v4u (&q)[5], const float* mu, float (&out)[8]) {
    const v4u s = q[0], n0 = q[1], n1 = q[2], n2 = q[3], n3 = q[4];
    float m[8]; ld8f(mu, m);
    out[0] = bflo(s.x) + m[0] * (bflo(n0.x) - bflo(s.x)); out[1] = bfhi(s.x) + m[1] * (bfhi(n1.x) - bfhi(s.x));
    out[2] = bflo(s.y) + m[2] * (bflo(n2.y) - bflo(s.y)); out[3] = bfhi(s.y) + m[3] * (bfhi(n3.y) - bfhi(s.y));
    out[4] = bflo(s.z) + m[4] * (bflo(n0.z) - bflo(s.z)); out[5] = bfhi(s.z) + m[5] * (bfhi(n1.z) - bfhi(s.z));
    out[6] = bflo(s.w) + m[6] * (bflo(n2.w) - bflo(s.w)); out[7] = bfhi(s.w) + m[7] * (bfhi(n3.w) - bfhi(s.w));
}
__device__ __forceinline__ void putN(LAS unsigned char* t, int tau, int oct, const float (&v)[8]) {
    v4u o; o.x = cvtpk(v[0], v[1]); o.y = cvtpk(v[2], v[3]); o.z = cvtpk(v[4], v[5]); o.w = cvtpk(v[6], v[7]);
    *(LAS v4u*)(t + tau * 128 + ((oct ^ swz(tau)) << 4)) = o;
}
__device__ __forceinline__ void putT(LAS unsigned char* t, int tau, int ch0, const float (&v)[8]) {
#pragma unroll
    for (int i = 0; i < 8; ++i) *(LAS unsigned short*)(t + toff(ch0 + i, tau)) = (unsigned short)f2bf(v[i]);
}

template <bool IS_CO, bool STAGES = true>
__device__ __forceinline__ void phase_chunk(Frame& F) {
    const int wave = F.wave;
    const int dgrp = wave >> 2, wq = wave & 3;
    LAS unsigned char* tl = F.lds + dgrp * 9 * TILE;
#define SL(k) (tl + (k) * TILE)
    LAS float* SEG = (LAS float*)(F.lds + LDS_X_OFF);
    LAS float* GAM = SEG + 1024;
    LAS float* LW0 = (LAS float*)(F.lds + 7 * TILE);
    LAS float* LW1 = (LAS float*)(F.lds + 16 * TILE);
    const bf16* z = (const bf16*)(F.ws + WS_Z); const bf16* LO = (const bf16*)(F.ws + WS_LORA);
    unsigned char* PQ = F.ws + WS_PQ; unsigned char* TKN = F.ws + WS_TKN; unsigned char* UPRE = F.ws + WS_UPRE; unsigned char* H0T = F.ws + WS_H0T;
    bf16* MG = (bf16*)(F.ws + WS_A0);
    const float* p_mu = KIN(I_MU); const float* p_kk = KIN(I_KK); const float* p_ka = KIN(I_KA); const float* p_w0 = KIN(I_W0); const float* p_a0 = KIN(I_A0);
    const int NU = IS_CO ? NU_L : NU_ALL;
    EPre<IS_CO> PF;
    if ((int)blockIdx.x < NU) epre_load<IS_CO>(PF, z, LO, (int)blockIdx.x, wave, F.lane);
    for (int unit = blockIdx.x; unit < NU; unit += F.G) {
        int lane = F.lane; asm volatile("" : "+v"(lane));
        const int lr = lane & 15, g = lane >> 4;
        int b, h, rowbase; unit_decode(unit, b, h, rowbase);
        const int tok = 8 * wave + (lane >> 3), oct = lane & 7, ch0 = 8 * oct, c0 = h * 64 + ch0, row = rowbase + tok;
        float ks[8], vs[8], rs[8], kkp[8], lw0[8], lw1[8], kd0[8], kd1[8], a_0[8], a_1[8], ssq;
        {
            shift8(PF.k, p_mu + K_OFF + c0, ks);
            shift8(PF.v, p_mu + V_OFF + c0, vs);
            if (IS_CO) { v4u rr[5];
#pragma unroll
                for (int j = 0; j < 5; ++j) rr[j] = PF.r[IS_CO ? j : 0];
                shift8(rr, p_mu + R_OFF + c0, rs); }
            else {
#pragma unroll
                for (int i = 0; i < 8; ++i) rs[i] = 0.f; }
            float xw0[8], xw1[8], xa0[8], xa1[8];
            unpack8(PF.lo[0], xw0); unpack8(PF.lo[1], xw1); unpack8(PF.lo[2], xa0); unpack8(PF.lo[3], xa1);
            float kkk[8], kaa[8], w0a[8], w0b[8], a0a[8], a0b[8];
            ld8f(p_kk + c0, kkk); ld8f(p_ka + c0, kaa); ld8f(p_w0 + c0, w0a); ld8f(p_w0 + D + c0, w0b); ld8f(p_a0 + c0, a0a); ld8f(p_a0 + D + c0, a0b);
            float ss = 0.f;
#pragma unroll
            for (int i = 0; i < 8; ++i) {
                kkp[i] = ks[i] * kkk[i]; ss += kkp[i] * kkp[i];
                lw0[i] = -0.6065306597126334f * fsig(w0a[i] + xw0[i]); lw1[i] = -0.6065306597126334f * fsig(w0b[i] + xw1[i]);
                a_0[i] = fsig(a0a[i] + xa0[i]); a_1[i] = fsig(a0b[i] + xa1[i]);
                kd0[i] = ks[i] * (1.0f + (a_0[i] - 1.0f) * kaa[i]); kd1[i] = ks[i] * (1.0f + (a_1[i] - 1.0f) * kaa[i]);
                const int ch = ch0 + i, sw = tok ^ (4 * ((ch & 15) ^ (2 * (ch >> 4))));
                LW0[ch * 64 + sw] = lw0[i]; LW1[ch * 64 + sw] = lw1[i];
            }
            ss += __shfl_xor(ss, 1); ss += __shfl_xor(ss, 2); ss += __shfl_xor(ss, 4);
            ssq = ss;
        }
        __syncthreads();
        {
            const int ch2 = lane, seg = wave, sw = 4 * ((ch2 & 15) ^ (2 * (ch2 >> 4)));
            LAS f32x4* p0a = (LAS f32x4*)(LW0 + ch2 * 64 + ((8 * seg) ^ sw)); LAS f32x4* p0b = (LAS f32x4*)(LW0 + ch2 * 64 + ((8 * seg + 4) ^ sw));
            LAS f32x4* p1a = (LAS f32x4*)(LW1 + ch2 * 64 + ((8 * seg) ^ sw)); LAS f32x4* p1b = (LAS f32x4*)(LW1 + ch2 * 64 + ((8 * seg + 4) ^ sw));
            f32x4 a = *p0a, bq = *p0b, c = *p1a, d = *p1b;
            a.y += a.x; a.z += a.y; a.w += a.z; bq.x += a.w; bq.y += bq.x; bq.z += bq.y; bq.w += bq.z;
            d.z += d.w; d.y += d.z; d.x += d.y; c.w += d.x; c.z += c.w; c.y += c.z; c.x += c.y;
            SEG[seg * 64 + ch2] = bq.w; SEG[(8 + seg) * 64 + ch2] = c.x;
            __syncthreads();
            float off0 = 0.f, off1 = 0.f;
#pragma unroll
            for (int s2 = 0; s2 < 8; ++s2) { const float t0 = SEG[s2 * 64 + ch2], t1 = SEG[(8 + s2) * 64 + ch2]; off0 += (s2 < seg) ? t0 : 0.f; off1 += (s2 > seg) ? t1 : 0.f; }
            *p0a = a + off0; *p0b = bq + off0; *p1a = c + off1; *p1b = d + off1;
        }
        __syncthreads();
        {
            const float inv = 1.0f / fmaxf(sqrtf(ssq), 1e-12f);
            float t8[8], u8[8], w8[8];
            {
                LAS unsigned char* t0 = F.lds; const int tau = tok;
                float e1[8], ei[8];
#pragma unroll
                for (int i = 0; i < 8; ++i) { const int ch = ch0 + i; const float cm = LW0[ch * 64 + (tok ^ (4 * ((ch & 15) ^ (2 * (ch >> 4)))))]; e1[i] = __expf(cm); ei[i] = __builtin_amdgcn_rcpf(e1[i]); t8[i] = kkp[i] * inv * __expf(cm - lw0[i]); }
                if (tok == 63) {
#pragma unroll
                    for (int i = 0; i < 8; ++i) GAM[ch0 + i] = e1[i]; }
#pragma unroll
                for (int i = 0; i < 8; ++i) { u8[i] = kkp[i] * inv * a_0[i] * ei[i]; w8[i] = kd0[i] * ei[i]; }
                if (!IS_CO) { putN(t0 + 0 * TILE, tau, oct, t8); putT(t0 + 1 * TILE, tau, ch0, t8); putN(t0 + 2 * TILE, tau, oct, u8); putT(t0 + 3 * TILE, tau, ch0, u8);
                    putN(t0 + 4 * TILE, tau, oct, w8); putT(t0 + 5 * TILE, tau, ch0, w8); putT(t0 + 6 * TILE, tau, ch0, vs); }
                else {
#pragma unroll
                    for (int i = 0; i < 8; ++i) t8[i] = rs[i] * e1[i];
                    putN(t0 + 0 * TILE, tau, oct, w8); putN(t0 + 1 * TILE, tau, oct, u8); putN(t0 + 2 * TILE, tau, oct, t8); putT(t0 + 3 * TILE, tau, ch0, vs); }
            }
            {
                LAS unsigned char* t1 = F.lds + 9 * TILE; const int tau = 63 - tok;
                float e1[8], ei[8];
#pragma unroll
                for (int i = 0; i < 8; ++i) { const int ch = ch0 + i; const float cm = LW1[ch * 64 + (tok ^ (4 * ((ch & 15) ^ (2 * (ch >> 4)))))]; e1[i] = __expf(cm); ei[i] = __builtin_amdgcn_rcpf(e1[i]); t8[i] = kkp[i] * inv * __expf(cm - lw1[i]); }
                if (tok == 0) {
#pragma unroll
                    for (int i = 0; i < 8; ++i) GAM[64 + ch0 + i] = e1[i]; }
#pragma unroll
                for (int i = 0; i < 8; ++i) { u8[i] = kkp[i] * inv * a_1[i] * ei[i]; w8[i] = kd1[i] * ei[i]; }
                if (!IS_CO) { putN(t1 + 0 * TILE, tau, oct, t8); putT(t1 + 1 * TILE, tau, ch0, t8); putN(t1 + 2 * TILE, tau, oct, u8); putT(t1 + 3 * TILE, tau, ch0, u8);
                    putN(t1 + 4 * TILE, tau, oct, w8); putT(t1 + 5 * TILE, tau, ch0, w8); putT(t1 + 6 * TILE, tau, ch0, vs); }
                else {
#pragma unroll
                    for (int i = 0; i < 8; ++i) t8[i] = rs[i] * e1[i];
                    putN(t1 + 0 * TILE, tau, oct, w8); putN(t1 + 1 * TILE, tau, oct, u8); putN(t1 + 2 * TILE, tau, oct, t8); putT(t1 + 3 * TILE, tau, ch0, vs); }
            }
        }
        if (!STAGES) { __syncthreads(); continue; }
        const size_t inst = (size_t)unit * 2 + dgrp;
        const int t2 = (wq << 6) | lane;
        if (IS_CO) {
#pragma unroll
            for (int rep = 0; rep < 2; ++rep) { const int cidx = t2 + 256 * rep, row = cidx >> 3, ch = cidx & 7;
                const v4u a = *(const v4u*)(TKN + inst * 8192 + (size_t)(row * 64 + ch * 8) * 2), hh = *(const v4u*)(H0T + inst * 8192 + (size_t)(row * 64 + ch * 8) * 2);
                *(LAS v4u*)(SL(4) + row * 128 + ((ch ^ swz(row)) << 4)) = a; *(LAS v4u*)(SL(5) + row * 128 + ((ch ^ swz(row)) << 4)) = hh; }
        }
        v4u upre0 = {0u, 0u, 0u, 0u}, upre1 = upre0;
        if (IS_CO) { const unsigned char* up = UPRE + inst * 8192 + (size_t)((wq * 64 + lane) * 32); upre0 = *(const v4u*)up; upre1 = *(const v4u*)(up + 16); }
        if (unit + F.G < NU) epre_load<IS_CO>(PF, z, LO, unit + F.G, wave, lane);
        __syncthreads();
        f32x4 acc[4], acc2[4];
        if (!IS_CO) {
            zero4(acc); mm64<false>(acc, SL(0), SL(2), wq, lane);
#pragma unroll
            for (int n = 0; n < 4; ++n)
#pragma unroll
                for (int q = 0; q < 4; ++q) acc[n][q] = (16 * n + lr < 16 * wq + 4 * g + q) ? acc[n][q] : 0.f;
            storeT(SL(7), acc, wq, lane);
            __syncthreads();
            zero4(acc); mm64<false>(acc, SL(4), SL(0), wq, lane);
#pragma unroll
            for (int n = 0; n < 4; ++n)
#pragma unroll
                for (int q = 0; q < 4; ++q) acc[n][q] = (16 * wq + 4 * g + q < 16 * n + lr) ? acc[n][q] : 0.f;
            storeT(SL(2), acc, wq, lane);
            __syncthreads();
            for (int rr_ = 0; rr_ < (STAGE_REP == 2 ? 5 : 1); ++rr_) {
            if (wq == 0) {
                const int bb = lane >> 4, jj = lane & 15;
                float X[16];
#pragma unroll
                for (int t = 0; t < 16; ++t) X[t] = (t == jj) ? 1.f : 0.f;
                v4u P0[15], P1[15];
#pragma unroll
                for (int s = 0; s < 15; ++s) { const int row = 16 * bb + s; P0[s] = *(const LAS v4u*)(SL(7) + row * 128 + (((2 * bb) ^ swz(row)) << 4)); P1[s] = *(const LAS v4u*)(SL(7) + row * 128 + (((2 * bb + 1) ^ swz(row)) << 4)); }
#pragma unroll
                for (int s = 0; s < 15; ++s) {
                    float col[16];
                    { const v4u p0 = P0[s], p1 = P1[s];
                      col[0] = bflo(p0.x); col[1] = bfhi(p0.x); col[2] = bflo(p0.y); col[3] = bfhi(p0.y); col[4] = bflo(p0.z); col[5] = bfhi(p0.z); col[6] = bflo(p0.w); col[7] = bfhi(p0.w);
                      col[8] = bflo(p1.x); col[9] = bfhi(p1.x); col[10] = bflo(p1.y); col[11] = bfhi(p1.y); col[12] = bflo(p1.z); col[13] = bfhi(p1.z); col[14] = bflo(p1.w); col[15] = bfhi(p1.w); }
#pragma unroll
                    for (int t = s + 1; t < 16; ++t) X[t] -= col[t] * X[s];
                }
#pragma unroll
                for (int t = 0; t < 16; ++t) *(LAS unsigned short*)(SL(0) + toff(16 * bb + t, 16 * bb + jj)) = (unsigned short)f2bf(X[t]);
                { const int row = 16 * bb + jj; v4u o0, o1;
                  o0.x = cvtpk(X[0], X[1]); o0.y = cvtpk(X[2], X[3]); o0.z = cvtpk(X[4], X[5]); o0.w = cvtpk(X[6], X[7]);
                  o1.x = cvtpk(X[8], X[9]); o1.y = cvtpk(X[10], X[11]); o1.z = cvtpk(X[12], X[13]); o1.w = cvtpk(X[14], X[15]);
                  *(LAS v4u*)(SL(4) + row * 128 + (((2 * bb) ^ swz(row)) << 4)) = o0; *(LAS v4u*)(SL(4) + row * 128 + (((2 * bb + 1) ^ swz(row)) << 4)) = o1; }
            } else {
                for (int cidx = (wq - 1) * 64 + lane; cidx < 512; cidx += 192) { const int row = cidx >> 3, ch = cidx & 7;
                    if ((row >> 4) != (ch >> 1)) { const int o = row * 128 + ((ch ^ swz(row)) << 4); *(LAS v4u*)(SL(0) + o) = (v4u){0u, 0u, 0u, 0u}; *(LAS v4u*)(SL(4) + o) = (v4u){0u, 0u, 0u, 0u}; } }
            }
            __syncthreads(); }
            for (int rr_ = 0; rr_ < (STAGE_REP == 3 ? 5 : 1); ++rr_) {
            zero4(acc); mm64<true>(acc, SL(0), SL(7), wq, lane); storeN(SL(8), acc, wq, lane);
            __syncthreads(); }
            { f32x4 di[4]; loadT(di, SL(4), wq, lane); zero4(acc); mm64<false>(acc, SL(8), SL(4), wq, lane);
#pragma unroll
              for (int n = 0; n < 4; ++n) acc[n] = di[n] - acc[n];
              zero4(acc2); mm64<false>(acc2, SL(2), SL(6), wq, lane);
              storeT(SL(7), acc, wq, lane); storeT(SL(0), acc2, wq, lane); }
            __syncthreads();
            for (int rr_ = 0; rr_ < (STAGE_REP == 5 ? 5 : 1); ++rr_)
            { f32x4 di[4]; loadT(di, SL(4), wq, lane); zero4(acc); mm64<false>(acc, SL(8), SL(7), wq, lane);
#pragma unroll
              for (int n = 0; n < 4; ++n) acc[n] = di[n] - acc[n];
              storeT(SL(2), acc, wq, lane);
            __syncthreads(); }
            { f32x4 di[4]; loadT(di, SL(4), wq, lane); zero4(acc); mm64<false>(acc, SL(8), SL(2), wq, lane);
#pragma unroll
              for (int n = 0; n < 4; ++n) acc[n] = di[n] - acc[n];
              storeN(SL(7), acc, wq, lane); }
            __syncthreads();
            { f32x4 a3[4];
              zero4(acc); mm64<false>(acc, SL(7), SL(1), wq, lane);
              zero4(acc2); mm64<false>(acc2, SL(1), SL(7), wq, lane);
              zero4(a3); mm64<false>(a3, SL(7), SL(0), wq, lane);
              storeT(SL(8), acc, wq, lane); storeT(SL(2), acc2, wq, lane); storeT(SL(4), a3, wq, lane);
              unsigned char* up = UPRE + inst * 8192 + (size_t)((wq * 64 + lane) * 32);
              v4u o0, o1; o0.x = cvtpk(a3[0][0], a3[0][1]); o0.y = cvtpk(a3[0][2], a3[0][3]); o0.z = cvtpk(a3[1][0], a3[1][1]); o0.w = cvtpk(a3[1][2], a3[1][3]);
              o1.x = cvtpk(a3[2][0], a3[2][1]); o1.y = cvtpk(a3[2][2], a3[2][3]); o1.z = cvtpk(a3[3][0], a3[3][1]); o1.w = cvtpk(a3[3][2], a3[3][3]);
              *(v4u*)up = o0; *(v4u*)(up + 16) = o1; }
            __syncthreads();
            { zero4(acc); mm64<false>(acc, SL(8), SL(3), wq, lane);
              unsigned char* pb = PQ + inst * 16384;
#pragma unroll
              for (int n = 0; n < 4; ++n) { const int k = 16 * n + lr; const float gm = GAM[dgrp * 64 + k]; float p[4];
#pragma unroll
                  for (int q = 0; q < 4; ++q) p[q] = gm * (((16 * wq + 4 * g + q) == k ? 1.f : 0.f) - acc[n][q]);
                  *(uint2*)(pb + (size_t)(((n * 2 + (wq >> 1)) * 64 + lane) * 16 + (wq & 1) * 8)) = make_uint2(cvtpk(p[0], p[1]), cvtpk(p[2], p[3])); }
              zero4(acc); mm64<false>(acc, SL(5), SL(6), wq, lane); zero4(acc2); mm64<false>(acc2, SL(3), SL(4), wq, lane);
              const f32x4 gm4 = *(const LAS f32x4*)(GAM + dgrp * 64 + 16 * wq + 4 * g);
#pragma unroll
              for (int n = 0; n < 4; ++n) { const f32x4 qv = (acc[n] - acc2[n]) * gm4;
                  *(uint2*)(pb + 8192 + (size_t)(((n * 64 + lane) * 4 + wq) * 8)) = make_uint2(cvtpk(qv[0], qv[1]), cvtpk(qv[2], qv[3])); }
#pragma unroll
              for (int rep = 0; rep < 2; ++rep) { const int cidx = t2 + 256 * rep, row = cidx >> 3, ch = cidx & 7;
                  *(v4u*)(TKN + inst * 8192 + (size_t)(row * 64 + ch * 8) * 2) = *(const LAS v4u*)(SL(2) + row * 128 + ((ch ^ swz(row)) << 4)); }
            }
        } else {
            zero4(acc); mm64<false>(acc, SL(0), SL(2), wq, lane);
#pragma unroll
            for (int n = 0; n < 4; ++n)
#pragma unroll
                for (int q = 0; q < 4; ++q) acc[n][q] = (16 * wq + 4 * g + q <= 16 * n + lr) ? acc[n][q] : 0.f;
            storeT(SL(6), acc, wq, lane);
            zero4(acc); mm64<false>(acc, SL(1), SL(2), wq, lane);
#pragma unroll
            for (int n = 0; n < 4; ++n)
#pragma unroll
                for (int q = 0; q < 4; ++q) acc[n][q] = (16 * wq + 4 * g + q <= 16 * n + lr) ? -acc[n][q] : 0.f;
            storeT(SL(7), acc, wq, lane);
            { const v4u o0 = upre0, o1 = upre1;
              acc[0] = (f32x4){bflo(o0.x), bfhi(o0.x), bflo(o0.y), bfhi(o0.y)}; acc[1] = (f32x4){bflo(o0.z), bfhi(o0.z), bflo(o0.w), bfhi(o0.w)};
              acc[2] = (f32x4){bflo(o1.x), bfhi(o1.x), bflo(o1.y), bfhi(o1.y)}; acc[3] = (f32x4){bflo(o1.z), bfhi(o1.z), bflo(o1.w), bfhi(o1.w)}; }
            mm64<false>(acc, SL(4), SL(5), wq, lane);
            storeT(SL(8), acc, wq, lane);
            __syncthreads();
            zero4(acc); mm64<false>(acc, SL(2), SL(5), wq, lane); mm64<false>(acc, SL(6), SL(3), wq, lane); mm64<false>(acc, SL(7), SL(8), wq, lane);
            __syncthreads();
            { LAS float* Yf = (LAS float*)(tl);
#pragma unroll
              for (int n = 0; n < 4; ++n)
#pragma unroll
                  for (int q = 0; q < 4; ++q) { const int tau = 16 * wq + 4 * g + q; Yf[tau * 64 + ((16 * n + lr) ^ (4 * (tau & 15)))] = acc[n][q]; } }
            __syncthreads();
            { const LAS float* Y0 = (const LAS float*)(F.lds); const LAS float* Y1 = (const LAS float*)(F.lds + 9 * TILE);
              const int t = row & (T - 1);
              const bf16* zr = z + (size_t)row * NZ;
              const v4u zz = {0u, 0u, 0u, 0u};
              const v4u q_g = *(const v4u*)(LO + (size_t)row * NL + 4096 + c0);
              const v4u q_gb = *(const v4u*)(zr + CONV_OFF + c0), q_c0 = *(const v4u*)(zr + CONV_OFF + 1024 + c0), q_x0 = *(const v4u*)(zr + CONV_OFF + 2048 + c0);
              const v4u q_cm = t > 0 ? *(const v4u*)(zr - NZ + CONV_OFF + 1024 + c0) : zz, q_xm = t > 0 ? *(const v4u*)(zr - NZ + CONV_OFF + 2048 + c0) : zz;
              const v4u q_cp = t < T - 1 ? *(const v4u*)(zr + NZ + CONV_OFF + 1024 + c0) : zz, q_xp = t < T - 1 ? *(const v4u*)(zr + NZ + CONV_OFF + 2048 + c0) : zz;
              const v4u q_ga = *(const v4u*)(zr + GATE_OFF + c0), q_gr = *(const v4u*)(zr + GATE_OFF + 1024 + c0);
              float y[8];
              { const int s0 = 4 * (tok & 15), s1 = 4 * ((63 - tok) & 15);
                const f32x4 a0 = *(const LAS f32x4*)(Y0 + tok * 64 + (ch0 ^ s0)), a1 = *(const LAS f32x4*)(Y0 + tok * 64 + ((ch0 + 4) ^ s0));
                const f32x4 b0 = *(const LAS f32x4*)(Y1 + (63 - tok) * 64 + (ch0 ^ s1)), b1 = *(const LAS f32x4*)(Y1 + (63 - tok) * 64 + ((ch0 + 4) ^ s1));
                y[0] = a0.x + b0.x; y[1] = a0.y + b0.y; y[2] = a0.z + b0.z; y[3] = a0.w + b0.w; y[4] = a1.x + b1.x; y[5] = a1.y + b1.y; y[6] = a1.z + b1.z; y[7] = a1.w + b1.w; }
              float rk[8]; ld8f(KIN(I_RK) + c0, rk);
              float s1 = 0.f, s2 = 0.f, s3 = 0.f;
#pragma unroll
              for (int i = 0; i < 8; ++i) { s1 += y[i]; s2 += y[i] * y[i]; s3 += rs[i] * 0.5f * (kd0[i] + kd1[i]) * rk[i]; }
              s1 += __shfl_xor(s1, 1); s2 += __shfl_xor(s2, 1); s3 += __shfl_xor(s3, 1); s1 += __shfl_xor(s1, 2); s2 += __shfl_xor(s2, 2); s3 += __shfl_xor(s3, 2);
              s1 += __shfl_xor(s1, 4); s2 += __shfl_xor(s2, 4); s3 += __shfl_xor(s3, 4);
              const float S1 = s1, S2 = s2, S3 = s3;
              const float mean = S1 * (1.0f / 64.0f), var = fmaxf(S2 * (1.0f / 64.0f) - mean * mean, 0.f), rstd = __builtin_amdgcn_rsqf(var + 64e-5f);
              float lnw[8], lnb[8], cw0[8], cw1[8], cw2[8];
              ld8f(KIN(I_LNW) + c0, lnw); ld8f(KIN(I_LNB) + c0, lnb); ld8f(KIN(I_CONVW) + c0, cw0); ld8f(KIN(I_CONVW) + D + c0, cw1); ld8f(KIN(I_CONVW) + 2 * D + c0, cw2);
              float gg[8], gb[8], cc[8], xx[8], cm[8], xm[8], cp[8], xp[8], ga[8], gr[8];
              unpack8(q_g, gg); unpack8(q_gb, gb); unpack8(q_c0, cc); unpack8(q_x0, xx); unpack8(q_cm, cm); unpack8(q_xm, xm); unpack8(q_cp, cp); unpack8(q_xp, xp); unpack8(q_ga, ga); unpack8(q_gr, gr);
              float o[8];
#pragma unroll
              for (int i = 0; i < 8; ++i) {
                  const float yn = (y[i] - mean) * rstd * lnw[i] + lnb[i];
                  const float yr = (yn + S3 * vs[i]) * gg[i];
                  const float yc = gb[i] * (cw0[i] * (cm[i] * xm[i]) + cw1[i] * (cc[i] * xx[i]) + cw2[i] * (cp[i] * xp[i]));
                  o[i] = fsig(ga[i]) * yr + fsig(gr[i]) * yc;
              }
              v4u ov; ov.x = cvtpk(o[0], o[1]); ov.y = cvtpk(o[2], o[3]); ov.z = cvtpk(o[4], o[5]); ov.w = cvtpk(o[6], o[7]);
              *(v4u*)(MG + (size_t)row * D + c0) = ov;
            }
        }
        __syncthreads();
    }
#undef SL
}

struct SSIn { v4u a[8]; v4u q[2]; };
__device__ __forceinline__ size_t ss_inst(int step, int b, int h, int d) {
    int unit;
    if (step < 4) { const int cb = d ? 3 - step : step; unit = NU_L + (b * 4 + cb) * 16 + h; }
    else { const int blk = d ? 127 - (step - 4) : step - 4; unit = (b * 128 + blk) * 16 + h; }
    return (size_t)unit * 2 + d;
}
__device__ __forceinline__ void ss_load(SSIn& I, const unsigned char* PQ, size_t inst, int wv, int lane) {
    const unsigned char* pb = PQ + inst * 16384;
#pragma unroll
    for (int f = 0; f < 8; ++f) I.a[f] = *(const v4u*)(pb + (size_t)((f * 64 + lane) * 16));
    I.q[0] = *(const v4u*)(pb + 8192 + (size_t)((wv * 64 + lane) * 32)); I.q[1] = *(const v4u*)(pb + 8192 + (size_t)((wv * 64 + lane) * 32 + 16));
}
__device__ __forceinline__ void ss_step(f32x4 (&H)[4], const SSIn& cur, unsigned char* H0T, size_t inst, bool store_h0, int wv, int lr, int g) {
    const unsigned p00 = cvtpk(H[0][0], H[0][1]), p01 = cvtpk(H[0][2], H[0][3]), p10 = cvtpk(H[1][0], H[1][1]), p11 = cvtpk(H[1][2], H[1][3]);
    const unsigned p20 = cvtpk(H[2][0], H[2][1]), p21 = cvtpk(H[2][2], H[2][3]), p30 = cvtpk(H[3][0], H[3][1]), p31 = cvtpk(H[3][2], H[3][3]);
    if (store_h0) { unsigned char* hb = H0T + inst * 8192 + (size_t)((16 * wv + lr) * 64 + 4 * g) * 2;
        *(uint2*)(hb) = make_uint2(p00, p01); *(uint2*)(hb + 32) = make_uint2(p10, p11); *(uint2*)(hb + 64) = make_uint2(p20, p21); *(uint2*)(hb + 96) = make_uint2(p30, p31); }
    const bf16x8 b0 = __builtin_bit_cast(bf16x8, ((v4u){p00, p01, p10, p11})), b1 = __builtin_bit_cast(bf16x8, ((v4u){p20, p21, p30, p31}));
    H[0] = (f32x4){bflo(cur.q[0].x), bfhi(cur.q[0].x), bflo(cur.q[0].y), bfhi(cur.q[0].y)}; H[1] = (f32x4){bflo(cur.q[0].z), bfhi(cur.q[0].z), bflo(cur.q[0].w), bfhi(cur.q[0].w)};
    H[2] = (f32x4){bflo(cur.q[1].x), bfhi(cur.q[1].x), bflo(cur.q[1].y), bfhi(cur.q[1].y)}; H[3] = (f32x4){bflo(cur.q[1].z), bfhi(cur.q[1].z), bflo(cur.q[1].w), bfhi(cur.q[1].w)};
#pragma unroll
    for (int m = 0; m < 4; ++m) { H[m] = CK_MFMA(__builtin_bit_cast(bf16x8, cur.a[2 * m]), b0, H[m]); H[m] = CK_MFMA(__builtin_bit_cast(bf16x8, cur.a[2 * m + 1]), b1, H[m]); }
}
__device__ __forceinline__ void phase_ss(Frame& F) {
    const unsigned char* PQ = F.ws + WS_PQ; unsigned char* H0T = F.ws + WS_H0T;
    const int lane = F.lane, lr = lane & 15, g = lane >> 4;
    for (int task = (int)blockIdx.x; task < 256; task += F.G) {
        const int chain = task >> 2, wv = task & 3, b = chain >> 5, h = (chain >> 1) & 15, d = chain & 1;
        f32x4 H[4]; zero4(H);
        constexpr int NS = 4 + T / 64;
        static_assert(NS % 4 == 0, "unrolled by four");
        SSIn b0, b1, b2, b3;
        ss_load(b0, PQ, ss_inst(0, b, h, d), wv, lane); ss_load(b1, PQ, ss_inst(1, b, h, d), wv, lane); ss_load(b2, PQ, ss_inst(2, b, h, d), wv, lane); ss_load(b3, PQ, ss_inst(3, b, h, d), wv, lane);
        for (int step = 0; step < NS; step += 4) {
            const int n0 = step + 4 < NS ? step + 4 : NS - 1, n1 = step + 5 < NS ? step + 5 : NS - 1, n2 = step + 6 < NS ? step + 6 : NS - 1, n3 = step + 7 < NS ? step + 7 : NS - 1;
            ss_step(H, b0, H0T, ss_inst(step, b, h, d), step >= 4, wv, lr, g);     ss_load(b0, PQ, ss_inst(n0, b, h, d), wv, lane);
            ss_step(H, b1, H0T, ss_inst(step + 1, b, h, d), step >= 4, wv, lr, g); ss_load(b1, PQ, ss_inst(n1, b, h, d), wv, lane);
            ss_step(H, b2, H0T, ss_inst(step + 2, b, h, d), step >= 4, wv, lr, g); ss_load(b2, PQ, ss_inst(n2, b, h, d), wv, lane);
            ss_step(H, b3, H0T, ss_inst(step + 3, b, h, d), step >= 4, wv, lr, g); ss_load(b3, PQ, ss_inst(n3, b, h, d), wv, lane);
        }
    }
}

__device__ __forceinline__ void lora_atile(const bf16* z, const float* p_mu, LAS unsigned char* lds, int r0, int gi, int wave, int lane) {
    const int tok = 8 * wave + (lane >> 3), oct = lane & 7, row = r0 + tok;
    const v4u zz = {0u, 0u, 0u, 0u};
    const int col = (gi < 4 ? DECAY_OFF + 64 * gi : GLORA_OFF + 64 * (gi - 4)) + 8 * oct;
    v4u q[5]; q[0] = *(const v4u*)(z + (size_t)row * NZ + col);
#pragma unroll
    for (int j = 0; j < 4; ++j) { const int nr = nbr_row(row, j); q[1 + j] = nr >= 0 ? *(const v4u*)(z + (size_t)nr * NZ + col) : zz; }
    float v[8]; shift8(q, p_mu + col, v);
#pragma unroll
    for (int i = 0; i < 8; ++i) v[i] = gi < 2 ? 1.0f - 2.0f * __builtin_amdgcn_rcpf(1.0f + __expf(2.0f * v[i])) : (gi < 4 ? v[i] : fsig(v[i]));
    putN(lds + gi * TILE, tok, oct, v);
}
template <int KS> struct LoraB { bf16x8 w[KS][4]; };
template <int KS>
__device__ __forceinline__ void lora_bload(LoraB<KS>& B, const bf16* WL, int q, int lr, int g) {
    const int blkid = q >> 4, h = q & 15;
    const bf16* wrow = WL + (size_t)(blkid * 1024 + h * 64 + 8 * (lr >> 2) + (lr & 3)) * KL + blkid * 64 + 8 * g;
#pragma unroll
    for (int s = 0; s < KS; ++s)
#pragma unroll
        for (int n = 0; n < 4; ++n) B.w[s][n] = *(const bf16x8*)(wrow + (size_t)(32 * (n >> 1) + 4 * (n & 1)) * KL + 32 * s);
}
template <int KS>
__device__ __forceinline__ void lora_product(const LoraB<KS>& B, const LAS unsigned char* At, bf16* LO, int r0, int q, int lr, int g) {
    const int blkid = q >> 4, h = q & 15;
    f32x4 acc[4][4];
#pragma unroll
    for (int n = 0; n < 4; ++n)
#pragma unroll
        for (int m = 0; m < 4; ++m) acc[n][m] = (f32x4){0.f, 0.f, 0.f, 0.f};
#pragma unroll
    for (int s = 0; s < KS; ++s) {
        bf16x8 af[4];
#pragma unroll
        for (int m = 0; m < 4; ++m) af[m] = ldfrag(At + (s >> 1) * TILE, 16 * m + lr, 4 * (s & 1) + g);
#pragma unroll
        for (int n = 0; n < 4; ++n)
#pragma unroll
            for (int m = 0; m < 4; ++m) acc[n][m] = CK_MFMA(B.w[s][n], af[m], acc[n][m]);
    }
    bf16* ob = LO + (size_t)(r0 + lr) * NL + blkid * 1024 + h * 64 + 8 * g;
#pragma unroll
    for (int m = 0; m < 4; ++m)
#pragma unroll
        for (int p = 0; p < 2; ++p) { v4u o; o.x = cvtpk(acc[2 * p][m][0], acc[2 * p][m][1]); o.y = cvtpk(acc[2 * p][m][2], acc[2 * p][m][3]);
            o.z = cvtpk(acc[2 * p + 1][m][0], acc[2 * p + 1][m][1]); o.w = cvtpk(acc[2 * p + 1][m][2], acc[2 * p + 1][m][3]);
            *(v4u*)(ob + (size_t)(16 * m) * NL + 32 * p) = o; }
}
__device__ __forceinline__ void phase_lora(Frame& F) {
    const bf16* z = (const bf16*)(F.ws + WS_Z); bf16* LO = (bf16*)(F.ws + WS_LORA); const bf16* WL = (const bf16*)(F.ws + WS_WLORA);
    const float* p_mu = KIN(I_MU);
    for (int unit = blockIdx.x; unit < ML / 64; unit += F.G) {
        int lane = F.lane; asm volatile("" : "+v"(lane));
        const int lr = lane & 15, g = lane >> 4, r0 = unit * 64;
#pragma unroll
        for (int gi = 0; gi < 6; ++gi) lora_atile(z, p_mu, F.lds, r0, gi, F.wave, lane);
        __syncthreads();
        LoraB<2> b0, b1;
        lora_bload<2>(b0, WL, F.wave, lr, g);
#pragma unroll
        for (int i = 0; i < 8; i += 2) {
            lora_bload<2>(b1, WL, F.wave + 8 * (i + 1), lr, g);
            lora_product<2>(b0, F.lds + ((F.wave + 8 * i) >> 4) * TILE, LO, r0, F.wave + 8 * i, lr, g);
            if (i + 2 < 8) lora_bload<2>(b0, WL, F.wave + 8 * (i + 2), lr, g);
            lora_product<2>(b1, F.lds + ((F.wave + 8 * (i + 1)) >> 4) * TILE, LO, r0, F.wave + 8 * (i + 1), lr, g);
        }
        { LoraB<4> c0; lora_bload<4>(c0, WL, 64 + F.wave, lr, g); lora_product<4>(c0, F.lds + 4 * TILE, LO, r0, 64 + F.wave, lr, g);
          lora_bload<4>(c0, WL, 72 + F.wave, lr, g); lora_product<4>(c0, F.lds + 4 * TILE, LO, r0, 72 + F.wave, lr, g); }
        __syncthreads();
    }
    for (int t = blockIdx.x; t < (MC / 64) * 32; t += F.G) {
        int lane = F.lane; asm volatile("" : "+v"(lane));
        const int lr = lane & 15, g = lane >> 4, r0 = ML + (t >> 5) * 64, q0 = 2 * (t & 31), gi = q0 >> 4;
        lora_atile(z, p_mu, F.lds, r0, gi, F.wave, lane);
        __syncthreads();
        if (F.wave < 2) { LoraB<2> b0; lora_bload<2>(b0, WL, q0 + F.wave, lr, g); lora_product<2>(b0, F.lds + gi * TILE, LO, r0, q0 + F.wave, lr, g); }
        __syncthreads();
    }
}
}
template <int PART>
__device__ __forceinline__ void phase_moe_weights(Frame& F) {
    LAS float* scr = (LAS float*)(F.lds + RING_OFF + F.wave * 16384);
    bf16* WEO = (bf16*)(F.ws + WS_WEOUT);
    constexpr int IT_IN = (D / 64) * (2048 / 32), IT_OUT = (D / 64) * (D / 32);
    if (PART == 0) {
        const float* wei = KIN(I_WEI);
        const int nstat = F.G * 7;
        int it = (int)blockIdx.x * 7 + F.wave - 1;
        while (it < NE * 128) {
            const int half = it & 1, r = it >> 1, e = r >> 6, n0 = 32 * (r & 63);
            const int c = n0 & 1023, rowbase = (c >> 7) * 256 + (n0 >= 1024 ? 128 : 0) + (c & 127);
            q8_item(wei + (size_t)e * D * 2048, 2048, n0, (signed char*)(F.ws + WS_WEIN) + (size_t)e * 2048 * D, (float*)(F.ws + MI_CSWEI) + (size_t)e * 2048, rowbase, scr, F.lane, 8 * half, 8 * half + 8);
            int nx = 0; if (F.lane == 0) nx = (int)__hip_atomic_fetch_add(F.ctl + CW_Q6, 1u, __ATOMIC_RELAXED, __HIP_MEMORY_SCOPE_AGENT);
            it = nstat + __builtin_amdgcn_readfirstlane(nx);
        }
    } else {
        const float* weo = KIN(I_WEO);
        for (int r = (int)blockIdx.x * 7 + F.wave - 1; r < NE * IT_OUT; r += F.G * 7) { const int e = r / IT_OUT, q = r % IT_OUT, kb = q / 32, n0 = 32 * (q % 32);
            transpose_item(weo + (size_t)e * D * D, D, 64 * kb, n0, WEO + (size_t)e * D * D, D, n0, scr, F.lane); }
    }
}

__device__ __forceinline__ void phase_x1_h2(Frame& F) {
    LAS float* LG = (LAS float*)(F.lds);
    LAS float* LA = LG + 2 * D; LAS float* LB = LA + 2 * D;
    const float* modp = (const float*)(F.ws + WS_MODP);
    for (int i = F.tid; i < 2 * D; i += NWAVES * 64) { const int v = i / D, j = i % D;
        LG[i] = mod_val(modp, KIN(I_BADA), v, 2048 + j) * KIN(I_NQM)[j];
        LA[i] = KIN(I_NPF)[j] * (1.0f + mod_val(modp, KIN(I_BADA), v, 4096 + j)); LB[i] = mod_val(modp, KIN(I_BADA), v, 3072 + j); }
    __syncthreads();
    const float* mix = (const float*)(F.ws + WS_MIX); float* x1 = (float*)(F.ws + WS_X1); bf16* h2 = (bf16*)(F.ws + WS_H2);
    for (int row = F.gw; row < ML; row += F.NGW) {
        const int vec = row >> 13;
        f32x4 m[4], x[4]; float s = 0.f;
#pragma unroll
        for (int j = 0; j < 4; ++j) { m[j] = *(const f32x4*)(mix + (size_t)row * D + 4 * F.lane + 256 * j); x[j] = *(const f32x4*)(KIN(I_X) + (size_t)row * D + 4 * F.lane + 256 * j);
            s += (m[j].x * m[j].x + m[j].y * m[j].y) + (m[j].z * m[j].z + m[j].w * m[j].w); }
        const float rstd = 1.0f / sqrtf(wave_sum(s) * (1.0f / D) + 1e-6f);
        float s2 = 0.f;
#pragma unroll
        for (int j = 0; j < 4; ++j) { const int c = 4 * F.lane + 256 * j; const f32x4 g = *(const LAS f32x4*)(LG + vec * D + c);
            x[j] = x[j] + g * (m[j] * rstd); *(f32x4*)(x1 + (size_t)row * D + c) = x[j];
            s2 += (x[j].x * x[j].x + x[j].y * x[j].y) + (x[j].z * x[j].z + x[j].w * x[j].w); }
        const float rstd2 = 1.0f / sqrtf(wave_sum(s2) * (1.0f / D) + 1e-6f);
        unsigned long long* o8 = (unsigned long long*)(h2 + (size_t)row * D) + F.lane;
        f32x4 hq[4]; float mx = 0.f;
#pragma unroll
        for (int j = 0; j < 4; ++j) { const int c = 4 * F.lane + 256 * j; const f32x4 a = *(const LAS f32x4*)(LA + vec * D + c), b = *(const LAS f32x4*)(LB + vec * D + c);
            const f32x4 h = x[j] * rstd2 * a + b; hq[j] = h;
            mx = fmaxf(mx, fmaxf(fmaxf(fabsf(h.x), fabsf(h.y)), fmaxf(fabsf(h.z), fabsf(h.w))));
            o8[64 * j] = (unsigned long long)pk2(h.x, h.y) | ((unsigned long long)pk2(h.z, h.w) << 32); }
        mx = wave_max(mx);
        const float iv = mx > 0.f ? 127.0f / mx : 0.f;
        if (F.lane == 0) ((float*)(F.ws + MI_RSH2))[row] = mx * (1.0f / 127.0f);
        unsigned* o4 = (unsigned*)(F.ws + WS_H2Q + (size_t)row * D) + F.lane;
#pragma unroll
        for (int j = 0; j < 4; ++j) o4[64 * j] = pack_q4(hq[j].x * iv, hq[j].y * iv, hq[j].z * iv, hq[j].w * iv);
    }
}

__device__ __forceinline__ void phase_route(Frame& F) {
    const float* LG = (const float*)(F.ws + WS_LOGIT);
    int* selE = (int*)(F.ws + MI_SELE); int* selP = (int*)(F.ws + MI_SELP); float* gate = (float*)(F.ws + MI_GATE);
    for (int task = F.gw; task < ML / 64; task += F.NGW) {
        const int row = task * 64 + F.lane;
        float v[NE];
#pragma unroll
        for (int q = 0; q < NE / 4; ++q) { const f32x4 x = *(const f32x4*)(LG + (size_t)row * 256 + 4 * q); const f32x4 bb = *(const f32x4*)(KIN(I_BR) + 4 * q);
            v[4 * q] = x.x + bb.x; v[4 * q + 1] = x.y + bb.y; v[4 * q + 2] = x.z + bb.z; v[4 * q + 3] = x.w + bb.w; }
        int se[4]; float sv[4];
#pragma unroll
        for (int k = 0; k < 4; ++k) { float best = -3.0e38f; int bi = 0;
#pragma unroll
            for (int e = 0; e < NE; ++e) if (v[e] > best) { best = v[e]; bi = e; }
#pragma unroll
            for (int e = 0; e < NE; ++e) v[e] = (e == bi) ? -3.0e38f : v[e];
            se[k] = bi; sv[k] = best; }
        float ex[4], sum = 0.f;
#pragma unroll
        for (int k = 0; k < 4; ++k) { ex[k] = __expf(sv[k] - sv[0]); sum += ex[k]; }
        const float inv = 1.0f / sum;
        int sp[4] = {0, 0, 0, 0};
        int myn = 0;
#pragma unroll
        for (int e = 0; e < NE; ++e) { const bool p = (se[0] == e) | (se[1] == e) | (se[2] == e) | (se[3] == e); const int n = __popcll(__ballot(p)); myn = (F.lane == e) ? n : myn; }
        int mybase = 0;
        if (F.lane < NE && myn > 0) mybase = (int)__hip_atomic_fetch_add(F.ctl + CW_CNT + 64 * F.lane, (unsigned)myn, __ATOMIC_RELAXED, __HIP_MEMORY_SCOPE_AGENT);
#pragma unroll
        for (int e = 0; e < NE; ++e) {
            const bool p = (se[0] == e) | (se[1] == e) | (se[2] == e) | (se[3] == e);
            const unsigned long long mask = __ballot(p);
            const int base = __shfl(mybase, e);
            const int pos = base + __popcll(mask & ((1ull << F.lane) - 1ull));
#pragma unroll
            for (int k = 0; k < 4; ++k) if (se[k] == e) sp[k] = pos;
        }
        *(int4*)(selE + (size_t)row * 4) = make_int4(se[0], se[1], se[2], se[3]);
        *(int4*)(selP + (size_t)row * 4) = make_int4(sp[0], sp[1], sp[2], sp[3]);
        *(f32x4*)(gate + (size_t)row * 4) = (f32x4){ex[0] * inv, ex[1] * inv, ex[2] * inv, ex[3] * inv};
    }
}

__device__ __forceinline__ void phase_x1h2_route(Frame& F) {
    constexpr int HS_STRIDE = 2064;
    LAS unsigned char* Hs = F.lds;
    LAS float* LG = (LAS float*)(F.lds + 132096);
    LAS float* LA = LG + D; LAS float* LB = LA + D;
    LAS float* LGT = (LAS float*)(F.lds + LDS_X_OFF);
    const float* modp = (const float*)(F.ws + WS_MODP);
    const float* mix = (const float*)(F.ws + WS_MIX); float* x1 = (float*)(F.ws + WS_X1);
    const float* xin = KIN(I_X); const float* b_ada = KIN(I_BADA); const float* nqm = KIN(I_NQM); const float* npf = KIN(I_NPF);
    const bf16* WR = (const bf16*)(F.ws + WS_WROUT);
    int* selE = (int*)(F.ws + MI_SELE); int* selP = (int*)(F.ws + MI_SELP); float* gate = (float*)(F.ws + MI_GATE);
    for (int rb = blockIdx.x; rb < ML / 64; rb += F.G) {
        const int vec = (rb * 64) >> 13;
        __syncthreads();
        for (int i = F.tid; i < D; i += NWAVES * 64) {
            LG[i] = mod_val(modp, b_ada, vec, 2048 + i) * nqm[i];
            LA[i] = npf[i] * (1.0f + mod_val(modp, b_ada, vec, 4096 + i)); LB[i] = mod_val(modp, b_ada, vec, 3072 + i); }
        __syncthreads();
        for (int rr = 0; rr < 8; ++rr) {
            const int lrow = F.wave * 8 + rr, row = rb * 64 + lrow;
            f32x4 m[4], x[4]; float s = 0.f;
#pragma unroll
            for (int j = 0; j < 4; ++j) { m[j] = *(const f32x4*)(mix + (size_t)row * D + 4 * F.lane + 256 * j); x[j] = *(const f32x4*)(xin + (size_t)row * D + 4 * F.lane + 256 * j);
                s += (m[j].x * m[j].x + m[j].y * m[j].y) + (m[j].z * m[j].z + m[j].w * m[j].w); }
            const float rstd = 1.0f / sqrtf(wave_sum(s) * (1.0f / D) + 1e-6f);
            float s2 = 0.f;
#pragma unroll
            for (int j = 0; j < 4; ++j) { const int c = 4 * F.lane + 256 * j; const f32x4 g = *(const LAS f32x4*)(LG + c);
                x[j] = x[j] + g * (m[j] * rstd); *(f32x4*)(x1 + (size_t)row * D + c) = x[j];
                s2 += (x[j].x * x[j].x + x[j].y * x[j].y) + (x[j].z * x[j].z + x[j].w * x[j].w); }
            const float rstd2 = 1.0f / sqrtf(wave_sum(s2) * (1.0f / D) + 1e-6f);
            f32x4 hq[4]; float mx = 0.f;
#pragma unroll
            for (int j = 0; j < 4; ++j) { const int c = 4 * F.lane + 256 * j; const f32x4 a = *(const LAS f32x4*)(LA + c), b = *(const LAS f32x4*)(LB + c);
                const f32x4 h = x[j] * rstd2 * a + b; hq[j] = h;
                mx = fmaxf(mx, fmaxf(fmaxf(fabsf(h.x), fabsf(h.y)), fmaxf(fabsf(h.z), fabsf(h.w))));
                *(LAS v2u*)(Hs + lrow * HS_STRIDE + c * 2) = (v2u){pk2(h.x, h.y), pk2(h.z, h.w)}; }
            mx = wave_max(mx);
            const float iv = mx > 0.f ? 127.0f / mx : 0.f;
            if (F.lane == 0) ((float*)(F.ws + MI_RSH2))[row] = mx * (1.0f / 127.0f);
            unsigned* o4 = (unsigned*)(F.ws + WS_H2Q + (size_t)row * D) + F.lane;
#pragma unroll
            for (int j = 0; j < 4; ++j) o4[64 * j] = pack_q4(hq[j].x * iv, hq[j].y * iv, hq[j].z * iv, hq[j].w * iv);
        }
        __syncthreads();
        {
            const int rt = F.wave & 3, et = F.wave >> 2, lr = F.lane & 15, g = F.lane >> 4;
            typedef short bf16x8_t __attribute__((ext_vector_type(8)));
            f32x4 acc = {0.f, 0.f, 0.f, 0.f};
            const LAS unsigned char* ap = Hs + (16 * rt + lr) * HS_STRIDE + 16 * g; const bf16* bp = WR + (size_t)(16 * et + lr) * D + 8 * g;
#pragma unroll 8
            for (int s = 0; s < 32; ++s) { const bf16x8_t a = *(const LAS bf16x8_t*)(ap + 64 * s); const bf16x8_t b = *(const bf16x8_t*)(bp + 32 * s);
                acc = __builtin_amdgcn_mfma_f32_16x16x32_bf16(a, b, acc, 0, 0, 0); }
#pragma unroll
            for (int i = 0; i < 4; ++i) LGT[(16 * rt + 4 * g + i) * 33 + 16 * et + lr] = acc[i];
        }
        __syncthreads();
        if (F.wave == 0) {
            const int row = rb * 64 + F.lane;
            const float* br = KIN(I_BR);
            float v[NE];
#pragma unroll
            for (int e = 0; e < NE; ++e) v[e] = LGT[F.lane * 33 + e] + br[e];
            int se[4]; float sv[4];
#pragma unroll
            for (int k = 0; k < 4; ++k) { float best = -3.0e38f; int bi = 0;
#pragma unroll
                for (int e = 0; e < NE; ++e) if (v[e] > best) { best = v[e]; bi = e; }
#pragma unroll
                for (int e = 0; e < NE; ++e) v[e] = (e == bi) ? -3.0e38f : v[e];
                se[k] = bi; sv[k] = best; }
            float ex[4], sum = 0.f;
#pragma unroll
            for (int k = 0; k < 4; ++k) { ex[k] = __expf(sv[k] - sv[0]); sum += ex[k]; }
            const float inv = 1.0f / sum;
            int sp[4] = {0, 0, 0, 0};
            int myn = 0;
#pragma unroll
            for (int e = 0; e < NE; ++e) { const bool p = (se[0] == e) | (se[1] == e) | (se[2] == e) | (se[3] == e); const int n = __popcll(__ballot(p)); myn = (F.lane == e) ? n : myn; }
            int mybase = 0;
            if (F.lane < NE && myn > 0) mybase = (int)__hip_atomic_fetch_add(F.ctl + CW_CNT + 64 * F.lane, (unsigned)myn, __ATOMIC_RELAXED, __HIP_MEMORY_SCOPE_AGENT);
#pragma unroll
            for (int e = 0; e < NE; ++e) {
                const bool p = (se[0] == e) | (se[1] == e) | (se[2] == e) | (se[3] == e);
                const unsigned long long mask = __ballot(p);
                const int base = __shfl(mybase, e);
                const int pos = base + __popcll(mask & ((1ull << F.lane) - 1ull));
#pragma unroll
                for (int k = 0; k < 4; ++k) if (se[k] == e) sp[k] = pos;
            }
            *(int4*)(selE + (size_t)row * 4) = make_int4(se[0], se[1], se[2], se[3]);
            *(int4*)(selP + (size_t)row * 4) = make_int4(sp[0], sp[1], sp[2], sp[3]);
            *(f32x4*)(gate + (size_t)row * 4) = (f32x4){ex[0] * inv, ex[1] * inv, ex[2] * inv, ex[3] * inv};
        }
    }
    __syncthreads();
}

__device__ __forceinline__ void phase_scatter(Frame& F) {
    LAS int* PS = (LAS int*)(F.lds);
    if (F.tid == 0) { int acc = 0;
        for (int e = 0; e < NE; ++e) { const int c = (int)__hip_atomic_load(F.ctl + CW_CNT + 64 * e, __ATOMIC_RELAXED, __HIP_MEMORY_SCOPE_AGENT); PS[e] = acc; PS[64 + e] = c; acc += (c + 255) / 256 * 256; }
        PS[NE] = acc; }
    __syncthreads();
    int* blkE = (int*)(F.ws + MI_BLKE);
    if (blockIdx.x == 0) {
        for (int b = F.tid; b < MAXBLK; b += NWAVES * 64) { int e = NE - 1;
            for (int q = 0; q < NE; ++q) if (b * 256 >= PS[q] && b * 256 < PS[q + 1]) e = q;
            blkE[b] = e; }
        if (F.tid == 0) blkE[MAXBLK] = PS[NE] / 256;
    }
    const int* selE = (const int*)(F.ws + MI_SELE); const int* selP = (const int*)(F.ws + MI_SELP); int* dest = (int*)(F.ws + MI_DEST);
    const unsigned char* h2q = F.ws + WS_H2Q; unsigned char* xb = F.ws + WS_XB; const float* rsh2 = (const float*)(F.ws + MI_RSH2); float* rsxb = (float*)(F.ws + MI_RSXB);
    for (int row = F.gw; row < ML; row += F.NGW) {
        const int4 se = *(const int4*)(selE + (size_t)row * 4), sp = *(const int4*)(selP + (size_t)row * 4);
        const int d0 = PS[se.x] + sp.x, d1 = PS[se.y] + sp.y, d2 = PS[se.z] + sp.z, d3 = PS[se.w] + sp.w;
        const float rsc = rsh2[row];
        if (F.lane == 0) { *(int4*)(dest + (size_t)row * 4) = make_int4(d0, d1, d2, d3); rsxb[d0] = rsc; rsxb[d1] = rsc; rsxb[d2] = rsc; rsxb[d3] = rsc; }
        const v4u a = *(const v4u*)(h2q + (size_t)row * D + 16 * F.lane);
        *(v4u*)(xb + (size_t)d0 * D + 16 * F.lane) = a; *(v4u*)(xb + (size_t)d1 * D + 16 * F.lane) = a;
        *(v4u*)(xb + (size_t)d2 * D + 16 * F.lane) = a; *(v4u*)(xb + (size_t)d3 * D + 16 * F.lane) = a;
    }
    for (int p = F.gw; p < NE * 256; p += F.NGW) {
        const int e = p >> 8, r = p & 255, c = PS[64 + e], padded = (c + 255) / 256 * 256;
        if (c + r < padded) { unsigned char* dst = xb + (size_t)(PS[e] + c + r) * D; *(v4u*)(dst + 16 * F.lane) = (v4u){0u, 0u, 0u, 0u}; if (F.lane == 0) rsxb[PS[e] + c + r] = 0.f; }
    }
}

__device__ __forceinline__ void phase_combine(Frame& F) {
    LAS float* LG = (LAS float*)(F.lds);
    const float* modp = (const float*)(F.ws + WS_MODP);
    for (int i = F.tid; i < 2 * D; i += NWAVES * 64) { const int v = i / D, j = i % D; LG[i] = mod_val(modp, KIN(I_BADA), v, 5120 + j) * KIN(I_NQF)[j]; }
    __syncthreads();
    const int* dest = (const int*)(F.ws + MI_DEST); const float* gate = (const float*)(F.ws + MI_GATE);
    const bf16* y2 = (const bf16*)(F.ws + WS_Y2); const float* x1 = (const float*)(F.ws + WS_X1);
    for (int row = F.gw; row < ML; row += F.NGW) {
        const int vec = row >> 13;
        const int4 dd = *(const int4*)(dest + (size_t)row * 4); const f32x4 gg = *(const f32x4*)(gate + (size_t)row * 4);
        const int dk[4] = {dd.x, dd.y, dd.z, dd.w}; const float gk[4] = {gg.x, gg.y, gg.z, gg.w};
        float f[16];
#pragma unroll
        for (int i = 0; i < 16; ++i) f[i] = 0.f;
#pragma unroll
        for (int k = 0; k < 4; ++k) { float t[16]; ld16bf(y2 + (size_t)dk[k] * D + 16 * F.lane, t);
#pragma unroll
            for (int i = 0; i < 16; ++i) f[i] += gk[k] * t[i]; }
        float s = 0.f;
#pragma unroll
        for (int i = 0; i < 16; ++i) s += f[i] * f[i];
        const float rstd = 1.0f / sqrtf(wave_sum(s) * (1.0f / D) + 1e-6f);
        float xv[16], g[16], o[16]; ld16f(x1 + (size_t)row * D + 16 * F.lane, xv); ld16f_lds(LG + vec * D + 16 * F.lane, g);
#pragma unroll
        for (int i = 0; i < 16; ++i) o[i] = xv[i] + g[i] * (f[i] * rstd);
        st16f(F.out + (size_t)row * D + 16 * F.lane, o);
    }
}

constexpr int N_PHASES = 13;
#ifndef PROBE_MASK
#define PROBE_MASK 0
#endif
#ifndef STAGE_REP
#define STAGE_REP 0
#endif
#ifndef USE_FLAT_BAR
#define USE_FLAT_BAR 0
#endif
struct Args { const float* in[30]; float* out; unsigned char* ws; int ph_lo, ph_hi; };
__global__ void __launch_bounds__(NWAVES * 64, 2) fwd(Args args) {
    extern __shared__ __attribute__((aligned(16))) unsigned char lds[];
    Frame F;
    F.lds = (LAS unsigned char*)lds;
    F.MISC = (volatile LAS unsigned*)(F.lds + MISC_OFF);
    F.tid = threadIdx.x; F.lane = F.tid & 63; F.wave = __builtin_amdgcn_readfirstlane(F.tid >> 6);
    F.G = gridDim.x; F.gw = blockIdx.x * NWAVES + F.wave; F.NGW = F.G * NWAVES;
    F.ws = args.ws; F.ctl = (unsigned*)(args.ws + WS_CTL); F.out = args.out;
    for (int u = F.tid; u < (LDS_X_OFF - LDSCTL_OFF) / 4; u += NWAVES * 64) ((LAS unsigned*)(F.lds + LDSCTL_OFF))[u] = 0u;
    __syncthreads();
    const int lo = args.ph_lo, hi = args.ph_hi;
    const bool use_bar = (hi - lo) > 1;
    XcdBarrier bar; bar.bar = F.ctl + CW_BAR; bar.x = 0; bar.st = nullptr;
    if (use_bar && !USE_FLAT_BAR) bar = xcd_barrier_post(F.ctl + CW_BAR, F.MISC + 8);
#define IN(k) (lo <= (k) && (k) < hi)
    unsigned fb_extra = 0u;
#define SEAM(k) do { if (IN(k) && IN((k) + 1)) { if (USE_FLAT_BAR) flat_barrier(F.ctl + CW_FB, (unsigned)((k) - lo + 1) + fb_extra); else xcd_barrier2(bar); } else __syncthreads(); } while (0)

#define DUP(k) ((PROBE_MASK >> (k)) & 1)
    if (IN(0)) { phase_prologue(F); if (DUP(0)) { __syncthreads(); phase_prologue(F); } SEAM(0); }
    if (DUP(20)) { for (int q = 0; q < 10; ++q) { if (USE_FLAT_BAR) { ++fb_extra; flat_barrier(F.ctl + CW_FB, 1u + fb_extra); } else xcd_barrier2(bar); } }
    if (IN(1)) { phase_hrows(F); if (DUP(1)) { __syncthreads(); phase_hrows(F); } SEAM(1); }
    if (IN(2)) {
        {         pg8::Gemm g{(const bf16*)(F.ws + WS_A0), (const bf16*)(F.ws + WS_WIN), MT, NZ, D}; pg8::StaticOrder S; S.init(MT, NZ, F.G, (int)blockIdx.x);
        pg8::EpiBf16I8 E{(bf16*)(F.ws + WS_Z), NZ, (const float*)(F.ws + MI_RSH), (const float*)(F.ws + MI_CSWIN)};
        pg8::gemm_phase_i8<pg8::EpiBf16I8, pg8::StaticOrder, true, true>(F.lds + RING_OFF, g, S, E); __syncthreads(); }
        if (DUP(2)) {         pg8::Gemm g{(const bf16*)(F.ws + WS_A0), (const bf16*)(F.ws + WS_WIN), MT, NZ, D}; pg8::StaticOrder S; S.init(MT, NZ, F.G, (int)blockIdx.x);
        pg8::EpiBf16I8 E{(bf16*)(F.ws + WS_Z), NZ, (const float*)(F.ws + MI_RSH), (const float*)(F.ws + MI_CSWIN)};
        pg8::gemm_phase_i8<pg8::EpiBf16I8, pg8::StaticOrder, true, true>(F.lds + RING_OFF, g, S, E); __syncthreads(); }
        SEAM(2); }
    if (IN(3)) { ck::phase_lora(F); SEAM(3); }
    if (IN(4)) { ck::phase_chunk<false>(F); if (DUP(5)) { __syncthreads(); ck::phase_chunk<false>(F); } if (DUP(21)) { __syncthreads(); ck::phase_chunk<false, false>(F); } if (DUP(22)) { __syncthreads(); ck::phase_lora(F); } SEAM(4); }
    if (IN(5)) { if (F.wave == 0) ck::phase_ss(F); else { phase_moe_weights<0>(F); phase_moe_weights<1>(F); } if (DUP(6)) { __syncthreads(); if (F.wave == 0) ck::phase_ss(F); else phase_moe_weights<0>(F); } if (DUP(17)) { __syncthreads(); if (F.wave == 0) ck::phase_ss(F); } SEAM(5); }
    if (IN(6)) { ck::phase_chunk<true>(F); if (DUP(7)) { __syncthreads(); ck::phase_chunk<true>(F); } SEAM(6); }
    if (IN(7)) {
        {         pg8::Gemm g{(const bf16*)(F.ws + WS_A0), (const bf16*)(F.ws + WS_WOUT), ML, D, D}; pg8::StaticOrder S; S.init(ML, D, F.G, (int)blockIdx.x);
        pg8::EpiF32 E{(float*)(F.ws + WS_MIX), D};
        pg8::gemm_phase<pg8::EpiF32, pg8::StaticOrder, true, true>(F.lds + RING_OFF, g, S, E);
        __syncthreads(); }
        if (DUP(8)) {         pg8::Gemm g{(const bf16*)(F.ws + WS_A0), (const bf16*)(F.ws + WS_WOUT), ML, D, D}; pg8::StaticOrder S; S.init(ML, D, F.G, (int)blockIdx.x);
        pg8::EpiF32 E{(float*)(F.ws + WS_MIX), D};
        pg8::gemm_phase<pg8::EpiF32, pg8::StaticOrder, true, true>(F.lds + RING_OFF, g, S, E);
        __syncthreads(); }
        SEAM(7); }
    if (IN(8)) { phase_x1h2_route(F); SEAM(8); }
    if (IN(9)) { phase_scatter(F); if (DUP(12)) { __syncthreads(); phase_scatter(F); } SEAM(9); }
    if (IN(10)) {
        {         const int* blkE = (const int*)(F.ws + MI_BLKE);
        pg8::Gemm g{(const bf16*)(F.ws + WS_XB), (const bf16*)(F.ws + WS_WEIN), NROWS, 2048, D};
        pg8::MoeOrder<8> S{blkE, __hip_atomic_load(blkE + MAXBLK, __ATOMIC_RELAXED, __HIP_MEMORY_SCOPE_AGENT) * 8, F.G, (int)blockIdx.x};
        pg8::EpiSwigluI8 E{(bf16*)(F.ws + WS_ACT), KIN(I_BEI), (const float*)(F.ws + MI_RSXB), (const float*)(F.ws + MI_CSWEI)};
        pg8::gemm_phase_i8<pg8::EpiSwigluI8, pg8::MoeOrder<8>, true, true>(F.lds + RING_OFF, g, S, E); __syncthreads(); }
        if (DUP(13)) {         const int* blkE = (const int*)(F.ws + MI_BLKE);
        pg8::Gemm g{(const bf16*)(F.ws + WS_XB), (const bf16*)(F.ws + WS_WEIN), NROWS, 2048, D};
        pg8::MoeOrder<8> S{blkE, __hip_atomic_load(blkE + MAXBLK, __ATOMIC_RELAXED, __HIP_MEMORY_SCOPE_AGENT) * 8, F.G, (int)blockIdx.x};
        pg8::EpiSwigluI8 E{(bf16*)(F.ws + WS_ACT), KIN(I_BEI), (const float*)(F.ws + MI_RSXB), (const float*)(F.ws + MI_CSWEI)};
        pg8::gemm_phase_i8<pg8::EpiSwigluI8, pg8::MoeOrder<8>, true, true>(F.lds + RING_OFF, g, S, E); __syncthreads(); }
        SEAM(10); }
    if (IN(11)) {
        {         const int* blkE = (const int*)(F.ws + MI_BLKE);
        pg8::Gemm g{(const bf16*)(F.ws + WS_ACT), (const bf16*)(F.ws + WS_WEOUT), NROWS, D, D};
        pg8::MoeOrder<4> S{blkE, __hip_atomic_load(blkE + MAXBLK, __ATOMIC_RELAXED, __HIP_MEMORY_SCOPE_AGENT) * 4, F.G, (int)blockIdx.x};
        pg8::EpiBf16 E{(bf16*)(F.ws + WS_Y2), D, KIN(I_BEO), D};
        pg8::gemm_phase<pg8::EpiBf16, pg8::MoeOrder<4>, true, true>(F.lds + RING_OFF, g, S, E); __syncthreads(); }
        if (DUP(14)) {         const int* blkE = (const int*)(F.ws + MI_BLKE);
        pg8::Gemm g{(const bf16*)(F.ws + WS_ACT), (const bf16*)(F.ws + WS_WEOUT), NROWS, D, D};
        pg8::MoeOrder<4> S{blkE, __hip_atomic_load(blkE + MAXBLK, __ATOMIC_RELAXED, __HIP_MEMORY_SCOPE_AGENT) * 4, F.G, (int)blockIdx.x};
        pg8::EpiBf16 E{(bf16*)(F.ws + WS_Y2), D, KIN(I_BEO), D};
        pg8::gemm_phase<pg8::EpiBf16, pg8::MoeOrder<4>, true, true>(F.lds + RING_OFF, g, S, E); __syncthreads(); }
        SEAM(11); }
    if (IN(12)) { phase_combine(F); if (DUP(15)) { __syncthreads(); phase_combine(F); } }
#undef IN
#undef SEAM
}

#ifndef MK_N_LAUNCHES
#define MK_N_LAUNCHES 1
#endif
extern "C" void kernel_launch(void* const* d_in, const int* in_sizes, int n_in, void* d_out, int out_size, void* d_ws, size_t ws_size, hipStream_t stream) {
    static int grid = 0;
    if (grid == 0) {
        if (n_in != 30 || out_size != ML * D || ws_size < WS_END) { fprintf(stderr, "kernel_launch: unexpected shapes (n_in %d out %d ws %zu, need %zu); nothing launched\n", n_in, out_size, ws_size, (size_t)WS_END); grid = -1; return; }
        int dev = 0, cus = 0, per_cu = 0;
        if (hipGetDevice(&dev) != hipSuccess || hipDeviceGetAttribute(&cus, hipDeviceAttributeMultiprocessorCount, dev) != hipSuccess) { grid = -1; return; }
        if (hipFuncSetAttribute((const void*)fwd, hipFuncAttributeMaxDynamicSharedMemorySize, LDS_BYTES) != hipSuccess) { fprintf(stderr, "kernel_launch: hipFuncSetAttribute failed\n"); grid = -1; return; }
        if (hipOccupancyMaxActiveBlocksPerMultiprocessor(&per_cu, (const void*)fwd, NWAVES * 64, LDS_BYTES) != hipSuccess || per_cu < 1)
            fprintf(stderr, "kernel_launch: note: occupancy query reports %d workgroups per CU\n", per_cu);
        (void)hipGetLastError();
        grid = cus;
    }
    if (grid < 0) return;
    if (hipMemsetAsync((char*)d_ws + WS_CTL, 0, CTL_ZERO_BYTES, stream) != hipSuccess) return;
    Args a{};
    for (int i = 0; i < 30; ++i) a.in[i] = (const float*)d_in[i];
    a.out = (float*)d_out; a.ws = (unsigned char*)d_ws;
    if (MK_N_LAUNCHES == 1) { a.ph_lo = 0; a.ph_hi = N_PHASES; hipLaunchKernelGGL(fwd, dim3(grid), dim3(NWAVES * 64), LDS_BYTES, stream, a); }
    else for (int p = 0; p < N_PHASES; ++p) { a.ph_lo = p; a.ph_hi = p + 1; hipLaunchKernelGGL(fwd, dim3(grid), dim3(NWAVES * 64), LDS_BYTES, stream, a); }
}
```

```cpp
#include <hip/hip_runtime.h>
#include <cstdio>
#include <cstdint>

namespace pg8 {
#define PG8_LAS __attribute__((address_space(3)))
typedef unsigned short bf16_t;
typedef short bf16x8 __attribute__((ext_vector_type(8)));
typedef float f32x4 __attribute__((ext_vector_type(4)));
typedef unsigned u32x4 __attribute__((ext_vector_type(4)));
constexpr int BM = 256, BK = 64, HALF = 128, HTB = HALF * BK * 2  , STAGE_BYTES = 8 * HTB, NXCD = 8, WGM = 8;

__host__ __device__ __forceinline__ int lds_byte(int r, int c) { const int st = (r >> 4) * 2 + (c >> 5), rr = r & 15, cc = c & 31, ob = rr * 64 + cc * 2; return st * 1024 + (ob ^ (((ob >> 9) & 1) << 5)); }
__host__ __device__ __forceinline__ void stage_rc(int b, int& R, int& C) { const int st = b / 1024, sb = b % 1024, swz = sb ^ (((sb >> 9) & 1) << 5); R = (st >> 1) * 16 + swz / 64; C = (st & 1) * 32 + (swz % 64) / 2; }
__host__ __device__ __forceinline__ int perm32(int rho) { const int n = rho >> 4, i = rho & 15; return 8 * (i >> 2) + 4 * n + (i & 3); }

struct Unit { int pm, pn, pb, e; };
struct Gemm { const bf16_t* A; const bf16_t* Bt; int M, N, K; };

struct StaticOrder {
    int nM, nN, nwg, G, c;
    __host__ __device__ void init(int M, int N, int G_, int c_) { nM = M / BM; nN = N / BM; nwg = nM * nN; G = G_; c = c_; }
    __host__ __device__ bool next(int i, Unit& u) const {
        const long L = (long)i * G + c; if (L >= nwg) return false;
        int wgid = (int)L; { const int q = nwg / NXCD, r = nwg % NXCD, xcd = wgid % NXCD, off = wgid / NXCD; wgid = (xcd < r ? xcd * (q + 1) : r * (q + 1) + (xcd - r) * q) + off; }
        const int nig = WGM * nN, gid = wgid / nig, fm = gid * WGM, gsz = (nM - fm) < WGM ? (nM - fm) : WGM;
        u.pm = fm + ((wgid % nig) % gsz); u.pn = (wgid % nig) / gsz; u.pb = u.pn; u.e = 0; return true;
    }
    __device__ __forceinline__ void a_ready(const Unit&) const {}
    __device__ __forceinline__ void done(const Unit&) const {}
};
template <int NT> struct MoeOrder {
    const int* blk_e; int nunits, G, c;
    __device__ bool next(int i, Unit& u) const {
        const long L = (long)i * G + c; if (L >= nunits) return false;
        const int blk = (int)L / NT, pn = (int)L % NT; const int e = __hip_atomic_load(blk_e + blk, __ATOMIC_RELAXED, __HIP_MEMORY_SCOPE_AGENT);
        u.pm = blk; u.pn = pn; u.pb = e * NT + pn; u.e = e; return true;
    }
    __device__ __forceinline__ void a_ready(const Unit&) const {}
    __device__ __forceinline__ void done(const Unit&) const {}
};

__device__ __forceinline__ unsigned cvt_pk_bf16(float lo, float hi) { unsigned r; asm volatile("v_cvt_pk_bf16_f32 %0, %1, %2" : "=v"(r) : "v"(lo), "v"(hi)); return r; }

struct EpiF32 {
    static constexpr bool PERM = false, AFTER_DRAIN = false;
    float* C; int ldc;
    __device__ __forceinline__ void operator()(const f32x4 (&acc)[2][2][4][2], const Unit& u, int wr, int wc, int fr, int fq) const {
        const int row0 = u.pm * BM + wr * 64 + fr, col0 = u.pn * BM + wc * 32 + 4 * fq;
#pragma unroll
        for (int ai = 0; ai < 2; ++ai)
#pragma unroll
            for (int m = 0; m < 4; ++m) { float* rowp = C + (size_t)(row0 + ai * HALF + m * 16) * ldc + col0;
#pragma unroll
                for (int bj = 0; bj < 2; ++bj)
#pragma unroll
                    for (int n = 0; n < 2; ++n) *(f32x4*)(rowp + bj * HALF + n * 16) = acc[ai][bj][m][n]; }
    }
};
struct EpiBf16 {
    static constexpr bool PERM = true, AFTER_DRAIN = false;
    bf16_t* O; int ldc; const float* bias; int bias_estride;
    __device__ __forceinline__ void operator()(const f32x4 (&acc)[2][2][4][2], const Unit& u, int wr, int wc, int fr, int fq) const {
        const int row0 = u.pm * BM + wr * 64 + fr; const int col0 = u.pn * BM + wc * 32 + 8 * fq;
        const float* bp = bias ? bias + (size_t)u.e * bias_estride + col0 : nullptr;
        f32x4 bv[2][2];
#pragma unroll
        for (int bj = 0; bj < 2; ++bj)
#pragma unroll
            for (int n = 0; n < 2; ++n) bv[bj][n] = bp ? *(const f32x4*)(bp + bj * HALF + 4 * n) : (f32x4){0.f, 0.f, 0.f, 0.f};
#pragma unroll
        for (int ai = 0; ai < 2; ++ai)
#pragma unroll
            for (int m = 0; m < 4; ++m) { bf16_t* rowp = O + (size_t)(row0 + ai * HALF + m * 16) * ldc + col0;
#pragma unroll
                for (int bj = 0; bj < 2; ++bj) { const f32x4 v0 = acc[ai][bj][m][0] + bv[bj][0], v1 = acc[ai][bj][m][1] + bv[bj][1];
                    u32x4 w; w.x = cvt_pk_bf16(v0[0], v0[1]); w.y = cvt_pk_bf16(v0[2], v0[3]); w.z = cvt_pk_bf16(v1[0], v1[1]); w.w = cvt_pk_bf16(v1[2], v1[3]);
                    *(u32x4*)(rowp + bj * HALF) = w; } }
    }
};
struct EpiSwiglu {
    static constexpr bool PERM = true, AFTER_DRAIN = false;
    bf16_t* O; const float* bias;
    __device__ __forceinline__ float act1(float g, float up) const {
        g = fminf(g, 7.0f); up = fminf(fmaxf(up, -7.0f), 7.0f);
        const float sg = 1.0f / (1.0f + __expf(-1.702f * g));
        return (up + 1.0f) * g * sg;
    }
    __device__ __forceinline__ void operator()(const f32x4 (&acc)[2][2][4][2], const Unit& u, int wr, int wc, int fr, int fq) const {
        const int row0 = u.pm * BM + wr * 64 + fr; const int col0 = u.pn * HALF + wc * 32 + 8 * fq;
        const float* bp = bias + (size_t)u.e * 2048 + col0;
        f32x4 bg[2], bu[2];
#pragma unroll
        for (int n = 0; n < 2; ++n) { bg[n] = *(const f32x4*)(bp + 4 * n); bu[n] = *(const f32x4*)(bp + 1024 + 4 * n); }
#pragma unroll
        for (int ai = 0; ai < 2; ++ai)
#pragma unroll
            for (int m = 0; m < 4; ++m) { bf16_t* rowp = O + (size_t)(row0 + ai * HALF + m * 16) * 1024 + col0;
                const f32x4 g0 = acc[ai][0][m][0] + bg[0], g1 = acc[ai][0][m][1] + bg[1], u0 = acc[ai][1][m][0] + bu[0], u1 = acc[ai][1][m][1] + bu[1];
                u32x4 w; w.x = cvt_pk_bf16(act1(g0[0], u0[0]), act1(g0[1], u0[1])); w.y = cvt_pk_bf16(act1(g0[2], u0[2]), act1(g0[3], u0[3]));
                w.z = cvt_pk_bf16(act1(g1[0], u1[0]), act1(g1[1], u1[1])); w.w = cvt_pk_bf16(act1(g1[2], u1[2]), act1(g1[3], u1[3]));
                *(u32x4*)rowp = w; }
    }
};


typedef int i32x4 __attribute__((ext_vector_type(4)));
struct EpiBf16I8 {
    static constexpr bool PERM = true, AFTER_DRAIN = false;
    bf16_t* O; int ldc; const float* rs; const float* cs;
    __device__ __forceinline__ void operator()(const i32x4 (&acc)[2][2][4][2], const Unit& u, int wr, int wc, int fr, int fq) const {
        const int row0 = u.pm * BM + wr * 64 + fr; const int col0 = u.pn * BM + wc * 32 + 8 * fq;
        const float* cp = cs + (size_t)u.pb * BM + wc * 32 + 8 * fq;
        f32x4 cv[2][2];
#pragma unroll
        for (int bj = 0; bj < 2; ++bj)
#pragma unroll
            for (int n = 0; n < 2; ++n) cv[bj][n] = *(const f32x4*)(cp + bj * HALF + 4 * n);
#pragma unroll
        for (int ai = 0; ai < 2; ++ai)
#pragma unroll
            for (int m = 0; m < 4; ++m) { const int row = row0 + ai * HALF + m * 16; const float r = rs[row]; bf16_t* rowp = O + (size_t)row * ldc + col0;
#pragma unroll
                for (int bj = 0; bj < 2; ++bj) { const i32x4 a0 = acc[ai][bj][m][0], a1 = acc[ai][bj][m][1];
                    const f32x4 v0 = (f32x4){(float)a0[0], (float)a0[1], (float)a0[2], (float)a0[3]} * cv[bj][0] * r, v1 = (f32x4){(float)a1[0], (float)a1[1], (float)a1[2], (float)a1[3]} * cv[bj][1] * r;
                    u32x4 w; w.x = cvt_pk_bf16(v0[0], v0[1]); w.y = cvt_pk_bf16(v0[2], v0[3]); w.z = cvt_pk_bf16(v1[0], v1[1]); w.w = cvt_pk_bf16(v1[2], v1[3]);
                    *(u32x4*)(rowp + bj * HALF) = w; } }
    }
};
struct EpiSwigluI8 {
    static constexpr bool PERM = true, AFTER_DRAIN = false;
    bf16_t* O; const float* bias; const float* rs; const float* cs;
    __device__ __forceinline__ float act1(float g, float up) const {
        g = fminf(g, 7.0f); up = fminf(fmaxf(up, -7.0f), 7.0f);
        const float sg = __builtin_amdgcn_rcpf(1.0f + __expf(-1.702f * g));
        return (up + 1.0f) * g * sg;
    }
    __device__ __forceinline__ void operator()(const i32x4 (&acc)[2][2][4][2], const Unit& u, int wr, int wc, int fr, int fq) const {
        const int row0 = u.pm * BM + wr * 64 + fr; const int col0 = u.pn * HALF + wc * 32 + 8 * fq;
        const float* bp = bias + (size_t)u.e * 2048 + col0;
        const float* cp = cs + (size_t)u.pb * BM + wc * 32 + 8 * fq;
        f32x4 bg[2], bu[2], cg[2], cu[2];
#pragma unroll
        for (int n = 0; n < 2; ++n) { bg[n] = *(const f32x4*)(bp + 4 * n); bu[n] = *(const f32x4*)(bp + 1024 + 4 * n); cg[n] = *(const f32x4*)(cp + 4 * n); cu[n] = *(const f32x4*)(cp + HALF + 4 * n); }
#pragma unroll
        for (int ai = 0; ai < 2; ++ai)
#pragma unroll
            for (int m = 0; m < 4; ++m) { const int row = row0 + ai * HALF + m * 16; const float r = rs[row]; bf16_t* rowp = O + (size_t)row * 1024 + col0;
                f32x4 g[2], up[2];
#pragma unroll
                for (int n = 0; n < 2; ++n) { const i32x4 ag = acc[ai][0][m][n], au = acc[ai][1][m][n];
                    g[n] = (f32x4){(float)ag[0], (float)ag[1], (float)ag[2], (float)ag[3]} * cg[n] * r + bg[n];
                    up[n] = (f32x4){(float)au[0], (float)au[1], (float)au[2], (float)au[3]} * cu[n] * r + bu[n]; }
                u32x4 w; w.x = cvt_pk_bf16(act1(g[0][0], up[0][0]), act1(g[0][1], up[0][1])); w.y = cvt_pk_bf16(act1(g[0][2], up[0][2]), act1(g[0][3], up[0][3]));
                w.z = cvt_pk_bf16(act1(g[1][0], up[1][0]), act1(g[1][1], up[1][1])); w.w = cvt_pk_bf16(act1(g[1][2], up[1][2]), act1(g[1][3], up[1][3]));
                *(u32x4*)rowp = w; }
    }
};
template <class Epi, class Sched, bool ALIGN_EPI = false, bool SP2 = false>
__device__ __forceinline__ void gemm_phase(PG8_LAS unsigned char* lds, const Gemm g, const Sched& S, const Epi& E) {
    const int tid = threadIdx.x, wid = __builtin_amdgcn_readfirstlane(tid >> 6), lane = tid & 63, wr = wid >> 2, wc = wid & 3, fr = lane & 15, fq = lane >> 4;
    const int K = g.K, nt = K / BK;
    unsigned voffA[2], voffB[2];
#pragma unroll
    for (int i = 0; i < 2; ++i) { int R, C; stage_rc(tid * 16 + i * 8192, R, C); const int Rb = Epi::PERM ? ((R & ~31) + perm32(R & 31)) : R;
        voffA[i] = (unsigned)(R * K + C) * 2u; voffB[i] = (unsigned)(Rb * K + C) * 2u; }
    const size_t kstep = (size_t)(BK * 2);
    const size_t hstep = (size_t)HALF * K * 2;
    const size_t tstep = 2 * hstep;
    const unsigned ldsw = (unsigned)wid * 1024u;
    const int aoff = lds_byte(wr * 64 + fr, fq * 8), boff = lds_byte(wc * 32 + fr, fq * 8);
#define PG8_SA(b, h) (((b) * 2 + (h)) * HTB)
#define PG8_SB(b, h) ((4 + (b) * 2 + (h)) * HTB)
#define PG8_STAGE(bufoff, gbase, voff) do { _Pragma("unroll") for (int _i = 0; _i < 2; ++_i) \
        __builtin_amdgcn_global_load_lds((const unsigned*)((const char*)(gbase) + (voff)[_i]), (PG8_LAS unsigned*)(lds + (bufoff) + ldsw + _i * 8192), 16, 0, 0); } while (0)
#define PG8_LDA(dst, b, h) do { _Pragma("unroll") for (int m = 0; m < 4; ++m) _Pragma("unroll") for (int k = 0; k < 2; ++k) dst[m][k] = *(const PG8_LAS bf16x8*)(lds + PG8_SA(b, h) + aoff + m * 2048 + k * 1024); } while (0)
#define PG8_LDB(dst, b, h) do { _Pragma("unroll") for (int n = 0; n < 2; ++n) _Pragma("unroll") for (int k = 0; k < 2; ++k) dst[n][k] = *(const PG8_LAS bf16x8*)(lds + PG8_SB(b, h) + boff + n * 2048 + k * 1024); } while (0)
#define PG8_MMA(ai, bj, At, Bt) do { __builtin_amdgcn_s_setprio(1); _Pragma("unroll") for (int m = 0; m < 4; ++m) _Pragma("unroll") for (int n = 0; n < 2; ++n) _Pragma("unroll") for (int k = 0; k < 2; ++k) \
        acc[ai][bj][m][n] = __builtin_amdgcn_mfma_f32_16x16x32_bf16(Bt[n][k], At[m][k], acc[ai][bj][m][n], 0, 0, 0); __builtin_amdgcn_s_setprio(0); } while (0)
#define PG8_WAIT_V(n) asm volatile("s_waitcnt vmcnt(" #n ")" ::: "memory")
#define PG8_WAIT_L(n) asm volatile("s_waitcnt lgkmcnt(" #n ")" ::: "memory")
#define PG8_BAR __builtin_amdgcn_s_barrier()
#define PG8_SCHED __builtin_amdgcn_sched_barrier(0)
    Unit cur, nxt; int ui = 0;
    if (!S.next(0, cur)) return;
    f32x4 acc[2][2][4][2];
#pragma unroll
    for (int a = 0; a < 2; ++a)
#pragma unroll
        for (int b = 0; b < 2; ++b)
#pragma unroll
            for (int m = 0; m < 4; ++m)
#pragma unroll
                for (int n = 0; n < 2; ++n) acc[a][b][m][n] = (f32x4){0.f, 0.f, 0.f, 0.f};
    bf16x8 At[4][2], B0[2][2], B1[2][2];
    const char* cA = (const char*)g.A + (size_t)cur.pm * tstep; const char* cB = (const char*)g.Bt + (size_t)cur.pb * tstep;
    S.a_ready(cur);
    if constexpr (SP2) {
        PG8_STAGE(PG8_SB(0, 0), cB, voffB); PG8_STAGE(PG8_SB(0, 1), cB + hstep, voffB); PG8_STAGE(PG8_SA(0, 0), cA, voffA); PG8_STAGE(PG8_SA(0, 1), cA + hstep, voffA);
        if (wr == 1) PG8_BAR;
        PG8_WAIT_V(2); PG8_BAR;
        PG8_STAGE(PG8_SB(1, 0), cB + kstep, voffB); PG8_STAGE(PG8_SA(1, 0), cA + kstep, voffA); PG8_STAGE(PG8_SB(1, 1), cB + hstep + kstep, voffB);
        PG8_WAIT_V(6); PG8_BAR;
    } else {
        PG8_STAGE(PG8_SB(0, 0), cB, voffB); PG8_STAGE(PG8_SA(0, 0), cA, voffA); PG8_STAGE(PG8_SB(0, 1), cB + hstep, voffB); PG8_STAGE(PG8_SA(0, 1), cA + hstep, voffA);
        if (wr == 1) PG8_BAR;
        PG8_WAIT_V(4); PG8_BAR;
        PG8_STAGE(PG8_SB(1, 0), cB + kstep, voffB); PG8_STAGE(PG8_SA(1, 0), cA + kstep, voffA); PG8_STAGE(PG8_SB(1, 1), cB + hstep + kstep, voffB);
        PG8_WAIT_V(6); PG8_BAR;
    }
    for (;;) {
        const bool has_next = S.next(ui + 1, nxt);
        const char* nA = has_next ? (const char*)g.A + (size_t)nxt.pm * tstep : cA; const char* nB = has_next ? (const char*)g.Bt + (size_t)nxt.pb * tstep : cB;
        for (int t = 0; t < nt; t += 2) {
            const bool last = (t == nt - 2);
            const char* a1 = cA + (size_t)(t + 1) * kstep;
            const char* a2 = last ? nA : cA + (size_t)(t + 2) * kstep; const char* b2 = last ? nB : cB + (size_t)(t + 2) * kstep;
            const char* a3 = a2 + kstep; const char* b3 = b2 + kstep;
            if (last && has_next) S.a_ready(nxt);
            if constexpr (SP2) {
            PG8_LDB(B0, 0, 0); PG8_LDB(B1, 0, 1); PG8_SCHED; PG8_LDA(At, 0, 0); PG8_STAGE(PG8_SA(1, 1), a1 + hstep, voffA);
            PG8_WAIT_V(8); PG8_WAIT_L(0); PG8_BAR; PG8_MMA(0, 0, At, B0); PG8_MMA(0, 1, At, B1); PG8_BAR; PG8_SCHED;
            PG8_LDA(At, 0, 1); PG8_STAGE(PG8_SB(0, 0), b2, voffB); PG8_STAGE(PG8_SB(0, 1), b2 + hstep, voffB); PG8_STAGE(PG8_SA(0, 0), a2, voffA);
            PG8_WAIT_V(8); PG8_WAIT_L(0); PG8_BAR; PG8_MMA(1, 0, At, B0); PG8_MMA(1, 1, At, B1); PG8_BAR; PG8_SCHED;
            PG8_LDB(B0, 1, 0); PG8_LDB(B1, 1, 1); PG8_SCHED; PG8_LDA(At, 1, 0); PG8_STAGE(PG8_SA(0, 1), a2 + hstep, voffA);
            PG8_WAIT_V(8); PG8_WAIT_L(0); PG8_BAR; PG8_MMA(0, 0, At, B0); PG8_MMA(0, 1, At, B1); PG8_BAR; PG8_SCHED;
            PG8_LDA(At, 1, 1); PG8_STAGE(PG8_SB(1, 0), b3, voffB); PG8_STAGE(PG8_SB(1, 1), b3 + hstep, voffB); PG8_STAGE(PG8_SA(1, 0), a3, voffA);
            PG8_WAIT_V(8); PG8_WAIT_L(0); PG8_BAR; PG8_MMA(1, 0, At, B0); PG8_MMA(1, 1, At, B1); PG8_BAR; PG8_SCHED;
            } else {
            PG8_LDB(B0, 0, 0); PG8_SCHED; PG8_LDA(At, 0, 0); PG8_STAGE(PG8_SA(1, 1), a1 + hstep, voffA);
            PG8_WAIT_L(8); PG8_BAR; PG8_WAIT_L(0); PG8_MMA(0, 0, At, B0); PG8_BAR; PG8_SCHED;
            PG8_LDB(B1, 0, 1); PG8_STAGE(PG8_SB(0, 0), b2, voffB);
            PG8_BAR; PG8_WAIT_L(0); PG8_MMA(0, 1, At, B1); PG8_BAR;
            PG8_LDA(At, 0, 1); PG8_STAGE(PG8_SA(0, 0), a2, voffA);
            PG8_BAR; PG8_WAIT_L(0); PG8_MMA(1, 0, At, B0); PG8_BAR; PG8_SCHED;
            PG8_STAGE(PG8_SB(0, 1), b2 + hstep, voffB);
            PG8_WAIT_V(6); PG8_BAR; PG8_MMA(1, 1, At, B1); PG8_BAR;
            PG8_LDB(B0, 1, 0); PG8_SCHED; PG8_LDA(At, 1, 0); PG8_STAGE(PG8_SA(0, 1), a2 + hstep, voffA);
            PG8_WAIT_L(8); PG8_BAR; PG8_WAIT_L(0); PG8_MMA(0, 0, At, B0); PG8_BAR; PG8_SCHED;
            PG8_LDB(B1, 1, 1); PG8_STAGE(PG8_SB(1, 0), b3, voffB);
            PG8_BAR; PG8_WAIT_L(0); PG8_MMA(0, 1, At, B1); PG8_BAR;
            PG8_LDA(At, 1, 1); PG8_STAGE(PG8_SA(1, 0), a3, voffA);
            PG8_BAR; PG8_WAIT_L(0); PG8_MMA(1, 0, At, B0); PG8_BAR; PG8_SCHED;
            PG8_STAGE(PG8_SB(1, 1), b3 + hstep, voffB);
            PG8_WAIT_V(6); PG8_BAR; PG8_MMA(1, 1, At, B1); PG8_BAR;
            }
        }
        if constexpr (ALIGN_EPI) { if (wr == 0) PG8_BAR; }
        if constexpr (!Epi::AFTER_DRAIN) { E(acc, cur, wr, wc, fr, fq); S.done(cur); }
        if (!has_next) break;
#pragma unroll
        for (int a = 0; a < 2; ++a)
#pragma unroll
            for (int b = 0; b < 2; ++b)
#pragma unroll
                for (int m = 0; m < 4; ++m)
#pragma unroll
                    for (int n = 0; n < 2; ++n) acc[a][b][m][n] = (f32x4){0.f, 0.f, 0.f, 0.f};
        cur = nxt; cA = nA; cB = nB; ++ui;
        if constexpr (ALIGN_EPI) { if (wr == 1) PG8_BAR; }
    }
    PG8_WAIT_V(0);
    if constexpr (!ALIGN_EPI) { if (wr == 0) PG8_BAR; }
    PG8_BAR;
    if constexpr (Epi::AFTER_DRAIN) { E.fused(acc, cur, wr, wc, fr, fq, lds, wid, lane); S.done(cur); }
#undef PG8_SA
#undef PG8_SB
#undef PG8_STAGE
#undef PG8_LDA
#undef PG8_LDB
#undef PG8_MMA
#undef PG8_WAIT_V
#undef PG8_WAIT_L
#undef PG8_BAR
#undef PG8_SCHED
}
template <class Epi, class Sched, bool ALIGN_EPI = false, bool SP2 = false>
__device__ __forceinline__ void gemm_phase_i8(PG8_LAS unsigned char* lds, const Gemm g, const Sched& S, const Epi& E) {
    const int tid = threadIdx.x, wid = __builtin_amdgcn_readfirstlane(tid >> 6), lane = tid & 63, wr = wid >> 2, wc = wid & 3, fr = lane & 15, fq = lane >> 4;
    const int K = g.K, nt = K / 128;
    unsigned voffA[2], voffB[2];
#pragma unroll
    for (int i = 0; i < 2; ++i) { int R, C; stage_rc(tid * 16 + i * 8192, R, C); const int Rb = Epi::PERM ? ((R & ~31) + perm32(R & 31)) : R;
        voffA[i] = (unsigned)(R * K + C * 2); voffB[i] = (unsigned)(Rb * K + C * 2); }
    const size_t kstep = (size_t)(BK * 2);
    const size_t hstep = (size_t)HALF * K;
    const size_t tstep = 2 * hstep;
    const unsigned ldsw = (unsigned)wid * 1024u;
    const int aoff = lds_byte(wr * 64 + fr, fq * 8), boff = lds_byte(wc * 32 + fr, fq * 8);
#define PG8_SA(b, h) (((b) * 2 + (h)) * HTB)
#define PG8_SB(b, h) ((4 + (b) * 2 + (h)) * HTB)
#define PG8_STAGE(bufoff, gbase, voff) do { _Pragma("unroll") for (int _i = 0; _i < 2; ++_i) \
        __builtin_amdgcn_global_load_lds((const unsigned*)((const char*)(gbase) + (voff)[_i]), (PG8_LAS unsigned*)(lds + (bufoff) + ldsw + _i * 8192), 16, 0, 0); } while (0)
#define PG8_LDA(dst, b, h) do { _Pragma("unroll") for (int m = 0; m < 4; ++m) _Pragma("unroll") for (int k = 0; k < 2; ++k) dst[m][k] = *(const PG8_LAS bf16x8*)(lds + PG8_SA(b, h) + aoff + m * 2048 + k * 1024); } while (0)
#define PG8_LDB(dst, b, h) do { _Pragma("unroll") for (int n = 0; n < 2; ++n) _Pragma("unroll") for (int k = 0; k < 2; ++k) dst[n][k] = *(const PG8_LAS bf16x8*)(lds + PG8_SB(b, h) + boff + n * 2048 + k * 1024); } while (0)
#define PG8_MMA(ai, bj, At, Bt) do { __builtin_amdgcn_s_setprio(1); _Pragma("unroll") for (int m = 0; m < 4; ++m) _Pragma("unroll") for (int n = 0; n < 2; ++n) _Pragma("unroll") for (int k = 0; k < 2; ++k) \
        acc[ai][bj][m][n] = __builtin_amdgcn_mfma_i32_16x16x64_i8(__builtin_bit_cast(i32x4, Bt[n][k]), __builtin_bit_cast(i32x4, At[m][k]), acc[ai][bj][m][n], 0, 0, 0); __builtin_amdgcn_s_setprio(0); } while (0)
#define PG8_WAIT_V(n) asm volatile("s_waitcnt vmcnt(" #n ")" ::: "memory")
#define PG8_WAIT_L(n) asm volatile("s_waitcnt lgkmcnt(" #n ")" ::: "memory")
#define PG8_BAR __builtin_amdgcn_s_barrier()
#define PG8_SCHED __builtin_amdgcn_sched_barrier(0)
    Unit cur, nxt; int ui = 0;
    if (!S.next(0, cur)) return;
    i32x4 acc[2][2][4][2];
#pragma unroll
    for (int a = 0; a < 2; ++a)
#pragma unroll
        for (int b = 0; b < 2; ++b)
#pragma unroll
            for (int m = 0; m < 4; ++m)
#pragma unroll
                for (int n = 0; n < 2; ++n) acc[a][b][m][n] = (i32x4){0, 0, 0, 0};
    bf16x8 At[4][2], B0[2][2], B1[2][2];
    const char* cA = (const char*)g.A + (size_t)cur.pm * tstep; const char* cB = (const char*)g.Bt + (size_t)cur.pb * tstep;
    S.a_ready(cur);
    if constexpr (SP2) {
        PG8_STAGE(PG8_SB(0, 0), cB, voffB); PG8_STAGE(PG8_SB(0, 1), cB + hstep, voffB); PG8_STAGE(PG8_SA(0, 0), cA, voffA); PG8_STAGE(PG8_SA(0, 1), cA + hstep, voffA);
        if (wr == 1) PG8_BAR;
        PG8_WAIT_V(2); PG8_BAR;
        PG8_STAGE(PG8_SB(1, 0), cB + kstep, voffB); PG8_STAGE(PG8_SA(1, 0), cA + kstep, voffA); PG8_STAGE(PG8_SB(1, 1), cB + hstep + kstep, voffB);
        PG8_WAIT_V(6); PG8_BAR;
    } else {
        PG8_STAGE(PG8_SB(0, 0), cB, voffB); PG8_STAGE(PG8_SA(0, 0), cA, voffA); PG8_STAGE(PG8_SB(0, 1), cB + hstep, voffB); PG8_STAGE(PG8_SA(0, 1), cA + hstep, voffA);
        if (wr == 1) PG8_BAR;
        PG8_WAIT_V(4); PG8_BAR;
        PG8_STAGE(PG8_SB(1, 0), cB + kstep, voffB); PG8_STAGE(PG8_SA(1, 0), cA + kstep, voffA); PG8_STAGE(PG8_SB(1, 1), cB + hstep + kstep, voffB);
        PG8_WAIT_V(6); PG8_BAR;
    }
    for (;;) {
        const bool has_next = S.next(ui + 1, nxt);
        const char* nA = has_next ? (const char*)g.A + (size_t)nxt.pm * tstep : cA; const char* nB = has_next ? (const char*)g.Bt + (size_t)nxt.pb * tstep : cB;
        for (int t = 0; t < nt; t += 2) {
            const bool last = (t == nt - 2);
            const char* a1 = cA + (size_t)(t + 1) * kstep;
            const char* a2 = last ? nA : cA + (size_t)(t + 2) * kstep; const char* b2 = last ? nB : cB + (size_t)(t + 2) * kstep;
            const char* a3 = a2 + kstep; const char* b3 = b2 + kstep;
            if (last && has_next) S.a_ready(nxt);
            if constexpr (SP2) {
            PG8_LDB(B0, 0, 0); PG8_LDB(B1, 0, 1); PG8_SCHED; PG8_LDA(At, 0, 0); PG8_STAGE(PG8_SA(1, 1), a1 + hstep, voffA);
            PG8_WAIT_V(8); PG8_WAIT_L(0); PG8_BAR; PG8_MMA(0, 0, At, B0); PG8_MMA(0, 1, At, B1); PG8_BAR; PG8_SCHED;
            PG8_LDA(At, 0, 1); PG8_STAGE(PG8_SB(0, 0), b2, voffB); PG8_STAGE(PG8_SB(0, 1), b2 + hstep, voffB); PG8_STAGE(PG8_SA(0, 0), a2, voffA);
            PG8_WAIT_V(8); PG8_WAIT_L(0); PG8_BAR; PG8_MMA(1, 0, At, B0); PG8_MMA(1, 1, At, B1); PG8_BAR; PG8_SCHED;
            PG8_LDB(B0, 1, 0); PG8_LDB(B1, 1, 1); PG8_SCHED; PG8_LDA(At, 1, 0); PG8_STAGE(PG8_SA(0, 1), a2 + hstep, voffA);
            PG8_WAIT_V(8); PG8_WAIT_L(0); PG8_BAR; PG8_MMA(0, 0, At, B0); PG8_MMA(0, 1, At, B1); PG8_BAR; PG8_SCHED;
            PG8_LDA(At, 1, 1); PG8_STAGE(PG8_SB(1, 0), b3, voffB); PG8_STAGE(PG8_SB(1, 1), b3 + hstep, voffB); PG8_STAGE(PG8_SA(1, 0), a3, voffA);
            PG8_WAIT_V(8); PG8_WAIT_L(0); PG8_BAR; PG8_MMA(1, 0, At, B0); PG8_MMA(1, 1, At, B1); PG8_BAR; PG8_SCHED;
            } else {
            PG8_LDB(B0, 0, 0); PG8_SCHED; PG8_LDA(At, 0, 0); PG8_STAGE(PG8_SA(1, 1), a1 + hstep, voffA);
            PG8_WAIT_L(8); PG8_BAR; PG8_WAIT_L(0); PG8_MMA(0, 0, At, B0); PG8_BAR; PG8_SCHED;
            PG8_LDB(B1, 0, 1); PG8_STAGE(PG8_SB(0, 0), b2, voffB);
            PG8_BAR; PG8_WAIT_L(0); PG8_MMA(0, 1, At, B1); PG8_BAR;
            PG8_LDA(At, 0, 1); PG8_STAGE(PG8_SA(0, 0), a2, voffA);
            PG8_BAR; PG8_WAIT_L(0); PG8_MMA(1, 0, At, B0); PG8_BAR; PG8_SCHED;
            PG8_STAGE(PG8_SB(0, 1), b2 + hstep, voffB);
            PG8_WAIT_V(6); PG8_BAR; PG8_MMA(1, 1, At, B1); PG8_BAR;
            PG8_LDB(B0, 1, 0); PG8_SCHED; PG8_LDA(At, 1, 0); PG8_STAGE(PG8_SA(0, 1), a2 + hstep, voffA);
            PG8_WAIT_L(8); PG8_BAR; PG8_WAIT_L(0); PG8_MMA(0, 0, At, B0); PG8_BAR; PG8_SCHED;
            PG8_LDB(B1, 1, 1); PG8_STAGE(PG8_SB(1, 0), b3, voffB);
            PG8_BAR; PG8_WAIT_L(0); PG8_MMA(0, 1, At, B1); PG8_BAR;
            PG8_LDA(At, 1, 1); PG8_STAGE(PG8_SA(1, 0), a3, voffA);
            PG8_BAR; PG8_WAIT_L(0); PG8_MMA(1, 0, At, B0); PG8_BAR; PG8_SCHED;
            PG8_STAGE(PG8_SB(1, 1), b3 + hstep, voffB);
            PG8_WAIT_V(6); PG8_BAR; PG8_MMA(1, 1, At, B1); PG8_BAR;
            }
        }
        if constexpr (ALIGN_EPI) { if (wr == 0) PG8_BAR; }
        if constexpr (!Epi::AFTER_DRAIN) { E(acc, cur, wr, wc, fr, fq); S.done(cur); }
        if (!has_next) break;
#pragma unroll
        for (int a = 0; a < 2; ++a)
#pragma unroll
            for (int b = 0; b < 2; ++b)
#pragma unroll
                for (int m = 0; m < 4; ++m)
#pragma unroll
                    for (int n = 0; n < 2; ++n) acc[a][b][m][n] = (i32x4){0, 0, 0, 0};
        cur = nxt; cA = nA; cB = nB; ++ui;
        if constexpr (ALIGN_EPI) { if (wr == 1) PG8_BAR; }
    }
    PG8_WAIT_V(0);
    if constexpr (!ALIGN_EPI) { if (wr == 0) PG8_BAR; }
    PG8_BAR;
    if constexpr (Epi::AFTER_DRAIN) { E.fused(acc, cur, wr, wc, fr, fq, lds, wid, lane); S.done(cur); }
#undef PG8_SA
#undef PG8_SB
#undef PG8_STAGE
#undef PG8_LDA
#undef PG8_LDB
#undef PG8_MMA
#undef PG8_WAIT_V
#undef PG8_WAIT_L
#undef PG8_BAR
#undef PG8_SCHED
}

}
#ifndef STAGE_REP
#define STAGE_REP 0
#endif

constexpr int NWAVES = 8;
constexpr int D = 1024, BATCH = 2, T = 8192, TC = 256, NH = 16;
constexpr int ML = BATCH * T;
constexpr int MC = BATCH * TC;
constexpr int MT = ML + MC;
constexpr int N_IN = 8576, NZ = 8704;
constexpr int K_OFF = 0, V_OFF = 1024, DECAY_OFF = 2048, ICLR_OFF = 2176, STATE_COLS = 2304, R_OFF = 2304, GLORA_OFF = 3328, SHIFT_COLS = 3456;
constexpr int CONV_OFF = 3456, GATE_OFF = 6528;
constexpr int NE = 32, TOPK = 4, DFF = 1024;
constexpr int NL = 5120, KL = 384;
constexpr int MAXBLK = 288;
constexpr int NROWS = MAXBLK * 256;
constexpr int KSPLIT = 16;

constexpr size_t MiB = 1u << 20;
constexpr size_t WS_CTL = 0, CTL_ZERO_BYTES = 1 * MiB;
constexpr size_t WS_MODP = 1 * MiB;
constexpr size_t WS_WLORA = 3 * MiB;
constexpr size_t WS_WROUT = 7 * MiB;
constexpr size_t WS_WOUT = 8 * MiB;
constexpr size_t WS_WIN = 10 * MiB;
constexpr size_t WS_A0 = 28 * MiB;
constexpr size_t WS_MISC = 61 * MiB;
constexpr size_t WS_Z = 64 * MiB;
constexpr size_t WS_AL = 345 * MiB;
constexpr size_t WS_LORA = 358 * MiB;
constexpr size_t WS_SCAN = 523 * MiB;
constexpr size_t WS_Y = 886 * MiB;
constexpr size_t WS_END = 1014 * MiB;
constexpr size_t WS_PQ = WS_SCAN;
constexpr size_t WS_TKN = WS_PQ + 132 * MiB;
constexpr size_t WS_UPRE = WS_TKN + 66 * MiB;
constexpr size_t WS_H0T = WS_UPRE + 66 * MiB;
static_assert(WS_H0T + 64 * MiB <= WS_Y, "scan region");
constexpr size_t WS_MIX = WS_LORA, WS_X1 = WS_LORA + 64 * MiB, WS_H2 = WS_LORA + 128 * MiB;
constexpr size_t WS_LOGIT = WS_SCAN, WS_XB = WS_SCAN + 16 * MiB, WS_ACT = WS_XB + 144 * MiB;
constexpr size_t WS_Y2 = WS_Z, WS_WEIN = WS_Y, WS_WEOUT = WS_Y + 64 * MiB;
static_assert(WS_ACT + 144 * MiB <= WS_Y && WS_WEIN + 64 * MiB <= WS_WEOUT && WS_WEOUT + 64 * MiB <= WS_END, "late regions");
constexpr size_t MI_SELE = WS_MISC, MI_SELP = MI_SELE + (size_t)ML * 4 * 4, MI_GATE = MI_SELP + (size_t)ML * 4 * 4, MI_DEST = MI_GATE + (size_t)ML * 4 * 4, MI_BLKE = MI_DEST + (size_t)ML * 4 * 4;
constexpr size_t MI_RSH = MI_BLKE + 4096;
constexpr size_t MI_CSWIN = MI_RSH + (size_t)MT * 4;
constexpr size_t MI_RSH2 = MI_CSWIN + (size_t)NZ * 4;
constexpr size_t MI_RSXB = MI_RSH2 + (size_t)ML * 4;
constexpr size_t MI_CSWEI = MI_RSXB + (size_t)NROWS * 4;
static_assert(MI_CSWEI + (size_t)NE * 2048 * 4 <= WS_Z && MI_RSH % 16 == 0 && MI_CSWIN % 16 == 0 && MI_CSWEI % 16 == 0, "misc");
constexpr size_t WS_H2Q = WS_A0;
constexpr int CW_BAR = 4096;
constexpr int CW_CNT = 16384;
constexpr int CW_FB = 8192;
constexpr int CW_Q6 = CW_CNT + 64 * 40;

constexpr int RING_OFF = 0, RING_BYTES = 131072;
constexpr int LDSCTL_OFF = 147456, MISC_OFF = LDSCTL_OFF + 320;
constexpr int LDS_X_OFF = LDSCTL_OFF + 512;
constexpr int LDS_BYTES = 163840;

#define GAS __attribute__((address_space(1)))
#define LAS __attribute__((address_space(3)))
typedef unsigned short bf16;
typedef unsigned v4u __attribute__((ext_vector_type(4)));
typedef unsigned v2u __attribute__((ext_vector_type(2)));
typedef float f32x4 __attribute__((ext_vector_type(4)));
#define LDS_WAIT() asm volatile("s_waitcnt lgkmcnt(0)" ::: "memory")
#define VM_WAIT() asm volatile("s_waitcnt vmcnt(0)" ::: "memory")
__device__ __forceinline__ unsigned f2bf(float f) { unsigned u = __builtin_bit_cast(unsigned, f); return (u + 0x7fffu + ((u >> 16) & 1u)) >> 16; }
__device__ __forceinline__ unsigned pk2(float lo, float hi) { return f2bf(lo) | (f2bf(hi) << 16); }
__device__ __forceinline__ float bflo(unsigned w) { return __builtin_bit_cast(float, w << 16); }
__device__ __forceinline__ float bfhi(unsigned w) { return __builtin_bit_cast(float, w & 0xffff0000u); }
__device__ __forceinline__ float bf1(bf16 h) { return __builtin_bit_cast(float, (unsigned)h << 16); }
__device__ __forceinline__ void ld16bf(const bf16* p, float (&o)[16]) {
    const v4u a = *(const v4u*)p, b = *(const v4u*)(p + 8);
    o[0] = bflo(a.x); o[1] = bfhi(a.x); o[2] = bflo(a.y); o[3] = bfhi(a.y); o[4] = bflo(a.z); o[5] = bfhi(a.z); o[6] = bflo(a.w); o[7] = bfhi(a.w);
    o[8] = bflo(b.x); o[9] = bfhi(b.x); o[10] = bflo(b.y); o[11] = bfhi(b.y); o[12] = bflo(b.z); o[13] = bfhi(b.z); o[14] = bflo(b.w); o[15] = bfhi(b.w);
}
__device__ __forceinline__ void st16bf(bf16* p, const float (&o)[16]) {
    v4u a, b; a.x = pk2(o[0], o[1]); a.y = pk2(o[2], o[3]); a.z = pk2(o[4], o[5]); a.w = pk2(o[6], o[7]);
    b.x = pk2(o[8], o[9]); b.y = pk2(o[10], o[11]); b.z = pk2(o[12], o[13]); b.w = pk2(o[14], o[15]);
    *(v4u*)p = a; *(v4u*)(p + 8) = b;
}
__device__ __forceinline__ void ld16f(const float* p, float (&o)[16]) {
#pragma unroll
    for (int q = 0; q < 4; ++q) { const f32x4 v = *(const f32x4*)(p + 4 * q); o[4 * q] = v.x; o[4 * q + 1] = v.y; o[4 * q + 2] = v.z; o[4 * q + 3] = v.w; }
}
__device__ __forceinline__ void ld16f_lds(const LAS float* p, float (&o)[16]) {
#pragma unroll
    for (int q = 0; q < 4; ++q) { const f32x4 v = *(const LAS f32x4*)(p + 4 * q); o[4 * q] = v.x; o[4 * q + 1] = v.y; o[4 * q + 2] = v.z; o[4 * q + 3] = v.w; }
}
__device__ __forceinline__ void st16f(float* p, const float (&o)[16]) {
#pragma unroll
    for (int q = 0; q < 4; ++q) *(f32x4*)(p + 4 * q) = (f32x4){o[4 * q], o[4 * q + 1], o[4 * q + 2], o[4 * q + 3]};
}
__device__ __forceinline__ float sigmoidf_(float x) { return 1.0f / (1.0f + __expf(-x)); }
__device__ __forceinline__ float wave_sum(float v) {
#pragma unroll
    for (int o = 1; o < 64; o <<= 1) v += __shfl_xor(v, o);
    return v;
}
__device__ __forceinline__ float wave_max(float v) {
#pragma unroll
    for (int o = 1; o < 64; o <<= 1) v = fmaxf(v, __shfl_xor(v, o));
    return v;
}
__device__ __forceinline__ unsigned pack_q4(float a, float b, float c, float d) {
    const int qa = __float2int_rn(a), qb = __float2int_rn(b), qc = __float2int_rn(c), qd = __float2int_rn(d);
    return (unsigned)(qa & 255) | ((unsigned)(qb & 255) << 8) | ((unsigned)(qc & 255) << 16) | ((unsigned)qd << 24);
}
__device__ __forceinline__ float quad_sum(float v) { v += __shfl_xor(v, 1); v += __shfl_xor(v, 2); return v; }

#define XB_TMO      128
#define XB_XCNT(j)  (256  + 64 * (j))
#define XB_XSUB(j)  (1280 + 64 * (j))
#define XB_XGEN(j)  (2304 + 64 * (j))
#define XB_TOP      3328
#define XB_TOPGEN   3392
#define XCD_BAR_WORDS 3456
#define XB_SPIN_CAP (1u << 18)

__device__ __forceinline__ unsigned xb_ld(unsigned* p)              { return __hip_atomic_load(p, __ATOMIC_RELAXED, __HIP_MEMORY_SCOPE_AGENT); }
__device__ __forceinline__ unsigned xb_add(unsigned* p, unsigned v) { return __hip_atomic_fetch_add(p, v, __ATOMIC_RELAXED, __HIP_MEMORY_SCOPE_AGENT); }
__device__ __forceinline__ unsigned xb_xcc_id() { return (unsigned)__builtin_amdgcn_s_getreg((3 << 11) | 20) & 0xFu; }
#define XB_SPIN(cond, bar) do { unsigned _sp = 0; while (cond) { __builtin_amdgcn_s_sleep(1); \
    if ((++_sp & 255u) == 0u) { if (xb_ld(&(bar)[XB_TMO])) break; if (_sp > XB_SPIN_CAP) { atomicAdd(&(bar)[XB_TMO], 1u); break; } } } } while (0)

struct XcdBarrier { unsigned* bar; unsigned x; volatile LAS unsigned* st; };

__device__ __forceinline__ XcdBarrier xcd_barrier_post(unsigned* bar, volatile LAS unsigned* st) {
    XcdBarrier b; b.bar = bar; b.x = xb_xcc_id(); b.st = st;
    if (threadIdx.x == 0) (void)xb_add(&bar[XB_XCNT(b.x)], 1u);
    return b;
}
__device__ __forceinline__ void xcd_barrier_complete(unsigned* bar, unsigned x, unsigned& nloc, unsigned& nx) {
    const unsigned G = gridDim.x * gridDim.y * gridDim.z;
    unsigned sum, cnt, mine, sp = 0u;
    for (;;) {
        sum = 0u; cnt = 0u; mine = 0u;
#pragma unroll
        for (unsigned j = 0; j < 16; ++j) { const unsigned c = xb_ld(&bar[XB_XCNT(j)]); sum += c; cnt += (c > 0u) ? 1u : 0u; mine = (j == x) ? c : mine; }
        if (sum == G) break;
        __builtin_amdgcn_s_sleep(1);
        if ((++sp & 255u) == 0u) { if (xb_ld(&bar[XB_TMO])) break; if (sp > XB_SPIN_CAP) { atomicAdd(&bar[XB_TMO], 1u); break; } }
    }
    nloc = mine > 0u ? mine : 1u; nx = cnt > 0u ? cnt : 1u;
}
__device__ __forceinline__ void xcd_barrier(const XcdBarrier& b) {
    asm volatile("s_waitcnt vmcnt(0)" ::: "memory");
    __syncthreads();
    if (threadIdx.x == 0) {
        unsigned* bar = b.bar;
        __builtin_amdgcn_s_waitcnt(0);
        unsigned nloc = b.st[0], nx = b.st[1];
        if (nloc == 0u) { xcd_barrier_complete(bar, b.x, nloc, nx); b.st[0] = nloc; b.st[1] = nx; }
        const unsigned old = xb_add(&bar[XB_XSUB(b.x)], 1u);
        const unsigned gen = old / nloc;
        if (old + 1u == (gen + 1u) * nloc) {
            __builtin_amdgcn_fence(__ATOMIC_RELEASE, "agent");
            asm volatile("s_waitcnt vmcnt(0)" ::: "memory");
            const unsigned og = xb_add(&bar[XB_TOP], 1u);
            const unsigned tg = og / nx;
            if (og + 1u == (tg + 1u) * nx) xb_add(&bar[XB_TOPGEN], 1u);
            else XB_SPIN(xb_ld(&bar[XB_TOPGEN]) == tg, bar);
            __builtin_amdgcn_fence(__ATOMIC_ACQUIRE, "agent");
            xb_add(&bar[XB_XGEN(b.x)], 1u);
            asm volatile("s_waitcnt vmcnt(0)" ::: "memory");
        } else {
            XB_SPIN(xb_ld(&bar[XB_XGEN(b.x)]) == gen, bar);
            __builtin_amdgcn_fence(__ATOMIC_ACQUIRE, "agent");
            asm volatile("s_waitcnt vmcnt(0)" ::: "memory");
        }
    }
    __syncthreads();
}

#define XB_DONE(j)  (3456 + 64 * (j))
__device__ __forceinline__ void xcd_barrier2(const XcdBarrier& b) {
    asm volatile("s_waitcnt vmcnt(0)" ::: "memory");
    __syncthreads();
    if (threadIdx.x == 0) {
        unsigned* bar = b.bar;
        __builtin_amdgcn_s_waitcnt(0);
        unsigned nloc = b.st[0], nx = b.st[1];
        if (nloc == 0u) { xcd_barrier_complete(bar, b.x, nloc, nx); b.st[0] = nloc; b.st[1] = nx; }
        const unsigned old = xb_add(&bar[XB_XSUB(b.x)], 1u);
        const unsigned gen = old / nloc;
        if (old + 1u == (gen + 1u) * nloc) {
            __builtin_amdgcn_fence(__ATOMIC_RELEASE, "agent");
            asm volatile("s_waitcnt vmcnt(0)" ::: "memory");
#pragma unroll
            for (unsigned j = 0; j < 16; ++j) (void)xb_add(&bar[XB_DONE(j)], 1u);
        }
        XB_SPIN(xb_ld(&bar[XB_DONE(b.x)]) < (gen + 1u) * nx, bar);
        __builtin_amdgcn_fence(__ATOMIC_ACQUIRE, "agent");
        asm volatile("s_waitcnt vmcnt(0)" ::: "memory");
    }
    __syncthreads();
}

#define FB_WORD(j) (64 * (j))
#define FB_TMO 640
__device__ __forceinline__ void flat_barrier(unsigned* fb, unsigned epoch) {
    asm volatile("s_waitcnt vmcnt(0)" ::: "memory");
    __syncthreads();
    if (threadIdx.x == 0) {
        __builtin_amdgcn_s_waitcnt(0);
        __builtin_amdgcn_fence(__ATOMIC_RELEASE, "agent");
        asm volatile("s_waitcnt vmcnt(0)" ::: "memory");
        (void)xb_add(&fb[FB_WORD(blockIdx.x & 7u)], 1u);
        const unsigned want = epoch * gridDim.x; unsigned sp = 0u;
        for (;;) {
            unsigned s = 0u;
#pragma unroll
            for (int j = 0; j < 8; ++j) s += xb_ld(&fb[FB_WORD(j)]);
            if (s >= want) break;
            __builtin_amdgcn_s_sleep(1);
            if ((++sp & 255u) == 0u) { if (xb_ld(&fb[FB_TMO])) break; if (sp > XB_SPIN_CAP) { atomicAdd(&fb[FB_TMO], 1u); break; } }
        }
        __builtin_amdgcn_fence(__ATOMIC_ACQUIRE, "agent");
        asm volatile("s_waitcnt vmcnt(0)" ::: "memory");
    }
    __syncthreads();
}

struct Frame {
    LAS unsigned char* lds;
    volatile LAS unsigned* MISC;
    unsigned* ctl;
    int tid, lane, wave, G, gw, NGW;
    float* out;
    unsigned char* ws;
};
enum { I_X = 0, I_C, I_CTX, I_CCTX, I_WADA, I_BADA, I_NPM, I_NQM, I_NPF, I_NQF, I_WIN, I_MU, I_W0, I_WDU, I_A0, I_WIU, I_KK, I_KA, I_RK, I_WGU, I_LNW, I_LNB, I_CONVW,
       I_WOUT, I_WR, I_BR, I_WEI, I_BEI, I_WEO, I_BEO };


typedef const float* fptr_t;
__device__ __forceinline__ fptr_t kin_ptr(int i) { const volatile __attribute__((address_space(4))) fptr_t* ka = (const volatile __attribute__((address_space(4))) fptr_t*)__builtin_amdgcn_kernarg_segment_ptr(); return ka[i]; }
#define KIN(i) kin_ptr(i)
__device__ __forceinline__ void transpose_item(const float* W, int N, int k0, int n0, bf16* WT, int ldk, int rowbase, LAS float* scr, int lane) {
#pragma unroll 8
    for (int i = 0; i < 32; ++i) { const int kk = 2 * i + (lane >> 5); scr[kk * 33 + (lane & 31)] = W[(size_t)(k0 + kk) * N + n0 + (lane & 31)]; }
    LDS_WAIT(); asm volatile("" ::: "memory");
    const int c = lane & 7;
#pragma unroll
    for (int j = 0; j < 4; ++j) { const int n = (lane >> 3) + 8 * j; const LAS float* s = scr + (8 * c) * 33 + n;
        v4u o; o.x = pk2(s[0 * 33], s[1 * 33]); o.y = pk2(s[2 * 33], s[3 * 33]); o.z = pk2(s[4 * 33], s[5 * 33]); o.w = pk2(s[6 * 33], s[7 * 33]);
        *(v4u*)(WT + (size_t)(rowbase + n) * ldk + k0 + 8 * c) = o; }
    LDS_WAIT(); asm volatile("" ::: "memory");
}

__device__ __forceinline__ unsigned pack_q4c(float a, float b, float c, float d) {
    const int qa = __float2int_rn(fminf(fmaxf(a, -127.f), 127.f)), qb = __float2int_rn(fminf(fmaxf(b, -127.f), 127.f)), qc = __float2int_rn(fminf(fmaxf(c, -127.f), 127.f)), qd = __float2int_rn(fminf(fmaxf(d, -127.f), 127.f));
    return (unsigned)(qa & 255) | ((unsigned)(qb & 255) << 8) | ((unsigned)(qc & 255) << 16) | ((unsigned)qd << 24);
}
__device__ __forceinline__ void q8_item(const float* W, int N, int n0, signed char* WT, float* cs, int rowbase, LAS float* scr, int lane, int kb0 = 0, int kb1 = 16) {
    const int r8 = lane >> 3, c4 = lane & 7;
    const float* p0 = W + (size_t)r8 * N + n0 + 4 * c4;
    f32x4 ss = {0.f, 0.f, 0.f, 0.f};
#pragma unroll 8
    for (int i = 0; i < 32; ++i) { const f32x4 v = *(const f32x4*)(p0 + (size_t)(8 * i) * N); ss += v * v; }
#pragma unroll
    for (int o = 8; o < 64; o <<= 1) { ss.x += __shfl_xor(ss.x, o); ss.y += __shfl_xor(ss.y, o); ss.z += __shfl_xor(ss.z, o); ss.w += __shfl_xor(ss.w, o); }
    if (lane < 8) {
#pragma unroll
        for (int q = 0; q < 4; ++q) { const float m = 6.0f * sqrtf(ss[q] * (1.0f / 256.0f)); cs[rowbase + 4 * lane + q] = m * (1.0f / 127.0f); scr[2112 + 4 * lane + q] = m > 0.f ? 127.0f / m : 0.f; } }
    LDS_WAIT(); asm volatile("" ::: "memory");
    f32x4 cur[8];
#pragma unroll
    for (int i = 0; i < 8; ++i) cur[i] = *(const f32x4*)(p0 + (size_t)(64 * kb0 + 8 * i) * N);
    for (int kb = kb0; kb < kb1; ++kb) {
        f32x4 nxt[8];
        const int kn = kb < kb1 - 1 ? kb + 1 : kb;
#pragma unroll
        for (int i = 0; i < 8; ++i) nxt[i] = *(const f32x4*)(p0 + (size_t)(64 * kn + 8 * i) * N);
#pragma unroll
        for (int i = 0; i < 8; ++i) { LAS float* s = scr + (r8 + 8 * i) * 33 + 4 * c4; s[0] = cur[i].x; s[1] = cur[i].y; s[2] = cur[i].z; s[3] = cur[i].w; }
        LDS_WAIT(); asm volatile("" ::: "memory");
        const int c = lane & 3;
#pragma unroll
        for (int j = 0; j < 2; ++j) { const int n = (lane >> 2) + 16 * j; const float iv = scr[2112 + n]; const LAS float* s = scr + (16 * c) * 33 + n;
            v4u o; o.x = pack_q4c(s[0] * iv, s[33] * iv, s[66] * iv, s[99] * iv); o.y = pack_q4c(s[132] * iv, s[165] * iv, s[198] * iv, s[231] * iv);
            o.z = pack_q4c(s[264] * iv, s[297] * iv, s[330] * iv, s[363] * iv); o.w = pack_q4c(s[396] * iv, s[429] * iv, s[462] * iv, s[495] * iv);
            *(v4u*)(WT + (size_t)(rowbase + n) * 1024 + 64 * kb + 16 * c) = o; }
        LDS_WAIT(); asm volatile("" ::: "memory");
#pragma unroll
        for (int i = 0; i < 8; ++i) cur[i] = nxt[i];
    }
}

__device__ __forceinline__ float mod_val(const float* modp, const float* b_ada, int vec, int j) {
    float s = b_ada[j];
#pragma unroll
    for (int ks = 0; ks < KSPLIT; ++ks) s += modp[((size_t)ks * 3 + vec) * 6144 + j];
    return s;
}
__device__ __forceinline__ int nbr_row(int row, int j) {
    if (row < ML) { const int t = row & (T - 1), gc = t & 63, gr = t >> 6;
        if (j == 0) return gc > 0 ? row - 1 : -1; if (j == 1) return gc < 63 ? row + 1 : -1; if (j == 2) return gr > 0 ? row - 64 : -1; return gr < 127 ? row + 64 : -1; }
    const int tc = (row - ML) & (TC - 1);
    if ((j & 1) == 0) return tc > 0 ? row - 1 : -1; return tc < TC - 1 ? row + 1 : -1;
}
__device__ __forceinline__ void load_shift16(const bf16* z, int row, int col0, const LAS float* mu, float (&out)[16]) {
    float s[16]; ld16bf(z + (size_t)row * NZ + col0, s);
    float m[16]; ld16f_lds(mu, m);
#pragma unroll
    for (int j = 0; j < 4; ++j) {
        const int nr = nbr_row(row, j); float t[16];
        if (nr >= 0) ld16bf(z + (size_t)nr * NZ + col0, t); else {
#pragma unroll
            for (int i = 0; i < 16; ++i) t[i] = 0.f; }
#pragma unroll
        for (int i = j; i < 16; i += 4) out[i] = s[i] + m[i] * (t[i] - s[i]);
    }
}

__device__ __forceinline__ void phase_prologue(Frame& F) {
    LAS float* scr = (LAS float*)(F.lds + RING_OFF + F.wave * 16384);
    LAS float* sil = (LAS float*)(F.lds + LDS_X_OFF);
    for (int i = F.tid; i < 3 * D; i += NWAVES * 64) { const int v = i / D, j = i % D; const float c = v < 2 ? KIN(I_C)[v * D + j] : KIN(I_CCTX)[j]; sil[i] = c / (1.0f + __expf(-c)); }
    __syncthreads();
    bf16* WoutT = (bf16*)(F.ws + WS_WOUT);
    constexpr int IT_WIN = (N_IN / 32) * 4, IT_WOUT = (D / 64) * (D / 32), IT_ADA = 24 * KSPLIT;
    constexpr int NITEMS = IT_ADA + IT_WIN + IT_WOUT;
    float* modp = (float*)(F.ws + WS_MODP);
    for (int it = F.gw; it < NITEMS; it += F.NGW) {
        int r = it;
        if (r < IT_ADA) {
            const int cc = r % 24, ks = r / 24, col = cc * 256 + F.lane * 4;
            f32x4 a0 = {0.f, 0.f, 0.f, 0.f}, a1 = a0, a2 = a0;
            const float* wp = KIN(I_WADA) + (size_t)(ks * 64) * 6144 + col;
#pragma unroll 8
            for (int k = 0; k < 64; ++k) { const f32x4 w = *(const f32x4*)(wp + (size_t)k * 6144); const int kk = ks * 64 + k;
                a0 += w * sil[kk]; a1 += w * sil[D + kk]; a2 += w * sil[2 * D + kk]; }
            *(f32x4*)(modp + ((size_t)ks * 3 + 0) * 6144 + col) = a0; *(f32x4*)(modp + ((size_t)ks * 3 + 1) * 6144 + col) = a1; *(f32x4*)(modp + ((size_t)ks * 3 + 2) * 6144 + col) = a2;
            continue; }
        r -= IT_ADA;
        if (r < IT_WIN) { const int st = r >> 2, qq = r & 3; q8_item(KIN(I_WIN), N_IN, 32 * st, (signed char*)(F.ws + WS_WIN), (float*)(F.ws + MI_CSWIN), 32 * st, scr, F.lane, 4 * qq, 4 * qq + 4); continue; }
        r -= IT_WIN;
        { const int nb = D / 32, kb = r / nb, n0 = 32 * (r % nb); transpose_item(KIN(I_WOUT), D, 64 * kb, n0, WoutT, D, n0, scr, F.lane); }
    }
    const int gt = blockIdx.x * (NWAVES * 64) + F.tid, NGT = F.G * NWAVES * 64;
    for (int i = gt; i < (NZ - N_IN) * D / 16; i += NGT) *(v4u*)(F.ws + WS_WIN + (size_t)N_IN * D + (size_t)i * 16) = (v4u){0u, 0u, 0u, 0u};
    for (int i = gt; i < NZ - N_IN; i += NGT) ((float*)(F.ws + MI_CSWIN))[N_IN + i] = 0.f;
    bf16* WL = (bf16*)(F.ws + WS_WLORA);
    for (int i = gt; i < NL * (KL / 8); i += NGT) {
        const int c8 = i / NL, row = i % NL, blk = row >> 10, n = row & 1023, col = c8 * 8, g = col >> 6;
        const float* src = nullptr; int kofs = 0;
        if (blk < 2) { if (g == blk) { src = KIN(I_WDU) + (size_t)blk * 64 * D; kofs = col - 64 * blk; } }
        else if (blk < 4) { if (g == blk) { src = KIN(I_WIU) + (size_t)(blk - 2) * 64 * D; kofs = col - 64 * blk; } }
        else { if (g >= 4) { src = KIN(I_WGU); kofs = col - 256; } }
        v4u o = {0u, 0u, 0u, 0u};
        if (src) { float v[8];
#pragma unroll
            for (int q = 0; q < 8; ++q) v[q] = src[(size_t)(kofs + q) * D + n];
            o.x = pk2(v[0], v[1]); o.y = pk2(v[2], v[3]); o.z = pk2(v[4], v[5]); o.w = pk2(v[6], v[7]); }
        *(v4u*)(WL + (size_t)row * KL + col) = o;
    }
    bf16* WR = (bf16*)(F.ws + WS_WROUT);
    for (int i = gt; i < 256 * (D / 8); i += NGT) {
        const int row = i % 256, c8 = i / 256; v4u o = {0u, 0u, 0u, 0u};
        if (row < NE) { float v[8];
#pragma unroll
            for (int q = 0; q < 8; ++q) v[q] = KIN(I_WR)[(size_t)(c8 * 8 + q) * NE + row];
            o.x = pk2(v[0], v[1]); o.y = pk2(v[2], v[3]); o.z = pk2(v[4], v[5]); o.w = pk2(v[6], v[7]); }
        *(v4u*)(WR + (size_t)row * D + c8 * 8) = o;
    }
}

__device__ __forceinline__ void phase_hrows(Frame& F) {
    LAS float* LA = (LAS float*)(F.lds);
    LAS float* LB = LA + 3 * D;
    const float* modp = (const float*)(F.ws + WS_MODP);
    for (int i = F.tid; i < 3 * D; i += NWAVES * 64) { const int v = i / D, j = i % D;
        LA[i] = KIN(I_NPM)[j] * (1.0f + mod_val(modp, KIN(I_BADA), v, 1024 + j)); LB[i] = mod_val(modp, KIN(I_BADA), v, j); }
    __syncthreads();
    signed char* A0q = (signed char*)(F.ws + WS_A0);
    for (int row = F.gw; row < MT; row += F.NGW) {
        const float* xr; int vec;
        if (row < ML) { xr = KIN(I_X) + (size_t)row * D; vec = row >> 13; } else { xr = KIN(I_CTX) + (size_t)(row - ML) * D; vec = 2; }
        f32x4 v[4]; float s = 0.f;
#pragma unroll
        for (int j = 0; j < 4; ++j) { v[j] = *(const f32x4*)(xr + 4 * F.lane + 256 * j); s += (v[j].x * v[j].x + v[j].y * v[j].y) + (v[j].z * v[j].z + v[j].w * v[j].w); }
        const float rstd = 1.0f / sqrtf(wave_sum(s) * (1.0f / D) + 1e-6f);
        f32x4 hq[4]; float mx = 0.f;
#pragma unroll
        for (int j = 0; j < 4; ++j) { const int c = 4 * F.lane + 256 * j; const f32x4 a = *(const LAS f32x4*)(LA + vec * D + c), b = *(const LAS f32x4*)(LB + vec * D + c);
            hq[j] = v[j] * rstd * a + b; mx = fmaxf(mx, fmaxf(fmaxf(fabsf(hq[j].x), fabsf(hq[j].y)), fmaxf(fabsf(hq[j].z), fabsf(hq[j].w)))); }
        mx = wave_max(mx);
        const float iv = mx > 0.f ? 127.0f / mx : 0.f;
        if (F.lane == 0) ((float*)(F.ws + MI_RSH))[row] = mx * (1.0f / 127.0f);
        unsigned* o4 = (unsigned*)(A0q + (size_t)row * D) + F.lane;
#pragma unroll
        for (int j = 0; j < 4; ++j) o4[64 * j] = pack_q4(hq[j].x * iv, hq[j].y * iv, hq[j].z * iv, hq[j].w * iv);
    }
}

__device__ __forceinline__ void phase_lora_in(Frame& F) {
    const bf16* z = (const bf16*)(F.ws + WS_Z); bf16* AL = (bf16*)(F.ws + WS_AL);
    const int gt = blockIdx.x * (NWAVES * 64) + F.tid, NGT = F.G * NWAVES * 64;
    for (int i = gt; i < MT * (KL / 4); i += NGT) {
        const int row = i / (KL / 4), q = i % (KL / 4), j0 = 4 * q;
        const int zc = j0 < 256 ? DECAY_OFF + j0 : GLORA_OFF + (j0 - 256);
        float o[4];
        if (j0 >= 256 && row >= ML) { o[0] = o[1] = o[2] = o[3] = 0.f; }
        else {
            const uint2 sv = *(const uint2*)(z + (size_t)row * NZ + zc); const float s[4] = {bflo(sv.x), bfhi(sv.x), bflo(sv.y), bfhi(sv.y)};
#pragma unroll
            for (int j = 0; j < 4; ++j) { const int nr = nbr_row(row, j); float t = 0.f;
                if (nr >= 0) t = bf1(z[(size_t)nr * NZ + zc + j]);
                const float v = s[j] + KIN(I_MU)[zc + j] * (t - s[j]);
                o[j] = j0 < 128 ? tanhf(v) : (j0 < 256 ? v : sigmoidf_(v)); }
        }
        *(uint2*)(AL + (size_t)row * KL + j0) = make_uint2(pk2(o[0], o[1]), pk2(o[2], o[3]));
    }
}


namespace ck {
typedef short bf16x8 __attribute__((ext_vector_type(8)));
constexpr int TILE = 8192;
constexpr int NU_L = BATCH * (T / 64) * NH;
constexpr int NU_ALL = NU_L + BATCH * (TC / 64) * NH;
__device__ __forceinline__ int swz(int row) { return (row ^ (row >> 3)) & 7; }
__device__ __forceinline__ int toff(int row, int col) { return row * 128 + ((col * 2) ^ (swz(row) << 4)); }
__device__ __forceinline__ bf16x8 ldfrag(const LAS unsigned char* t, int row, int chunk) { return *(const LAS bf16x8*)(t + row * 128 + ((chunk ^ swz(row)) << 4)); }
typedef __bf16 bf16v2_t __attribute__((ext_vector_type(2)));
__device__ __forceinline__ unsigned cvtpk(float lo, float hi) { const bf16v2_t v = {(__bf16)lo, (__bf16)hi}; return __builtin_bit_cast(unsigned, v); }
#define CK_MFMA(a, b, c) __builtin_amdgcn_mfma_f32_16x16x32_bf16(a, b, c, 0, 0, 0)
template <bool MASKDIAG>
__device__ __forceinline__ void mm64(f32x4 (&acc)[4], const LAS unsigned char* Lt, const LAS unsigned char* Rt, int wq, int lane) {
    const int lr = lane & 15, g = lane >> 4;
    const bf16x8 l0 = ldfrag(Lt, 16 * wq + lr, g), l1 = ldfrag(Lt, 16 * wq + lr, 4 + g);
#pragma unroll
    for (int n = 0; n < 4; ++n) {
        bf16x8 r0 = ldfrag(Rt, 16 * n + lr, g), r1 = ldfrag(Rt, 16 * n + lr, 4 + g);
        if (MASKDIAG) { const bf16x8 zz = {0, 0, 0, 0, 0, 0, 0, 0}; if ((g >> 1) == n) r0 = zz; if (2 + (g >> 1) == n) r1 = zz; }
        acc[n] = CK_MFMA(l0, r0, acc[n]); acc[n] = CK_MFMA(l1, r1, acc[n]);
    }
}
__device__ __forceinline__ void zero4(f32x4 (&a)[4]) {
#pragma unroll
    for (int n = 0; n < 4; ++n) a[n] = (f32x4){0.f, 0.f, 0.f, 0.f};
}
__device__ __forceinline__ void storeT(LAS unsigned char* t, const f32x4 (&v)[4], int wq, int lane) {
    const int lr = lane & 15, g = lane >> 4;
#pragma unroll
    for (int n = 0; n < 4; ++n) *(LAS v2u*)(t + toff(16 * n + lr, 16 * wq + 4 * g)) = (v2u){cvtpk(v[n][0], v[n][1]), cvtpk(v[n][2], v[n][3])};
}
__device__ __forceinline__ void storeN(LAS unsigned char* t, const f32x4 (&v)[4], int wq, int lane) {
    const int lr = lane & 15, g = lane >> 4;
#pragma unroll
    for (int n = 0; n < 4; ++n)
#pragma unroll
        for (int i = 0; i < 4; ++i) *(LAS unsigned short*)(t + toff(16 * wq + 4 * g + i, 16 * n + lr)) = (unsigned short)f2bf(v[n][i]);
}
__device__ __forceinline__ void loadT(f32x4 (&v)[4], const LAS unsigned char* t, int wq, int lane) {
    const int lr = lane & 15, g = lane >> 4;
#pragma unroll
    for (int n = 0; n < 4; ++n) { const v2u w = *(const LAS v2u*)(t + toff(16 * n + lr, 16 * wq + 4 * g)); v[n] = (f32x4){bflo(w.x), bfhi(w.x), bflo(w.y), bfhi(w.y)}; }
}
__device__ __forceinline__ void unit_decode(int unit, int& b, int& h, int& rowbase) {
    if (unit < NU_L) { h = unit & 15; const int blk = (unit >> 4) & 127; b = unit >> 11; rowbase = b * T + blk * 64; }
    else { const int u = unit - NU_L; h = u & 15; const int cb = (u >> 4) & 3; b = u >> 6; rowbase = ML + b * TC + cb * 64; }
}
__device__ __forceinline__ void pack8(LAS unsigned char* t, int row, int chunk, const float (&v)[8], bool rev) {
    v4u o;
    if (!rev) { o.x = cvtpk(v[0], v[1]); o.y = cvtpk(v[2], v[3]); o.z = cvtpk(v[4], v[5]); o.w = cvtpk(v[6], v[7]); }
    else { o.x = cvtpk(v[7], v[6]); o.y = cvtpk(v[5], v[4]); o.z = cvtpk(v[3], v[2]); o.w = cvtpk(v[1], v[0]); }
    *(LAS v4u*)(t + row * 128 + ((chunk ^ swz(row)) << 4)) = o;
}

__device__ __forceinline__ void unpack8(const v4u p, float (&o)[8]) {
    o[0] = bflo(p.x); o[1] = bfhi(p.x); o[2] = bflo(p.y); o[3] = bfhi(p.y); o[4] = bflo(p.z); o[5] = bfhi(p.z); o[6] = bflo(p.w); o[7] = bfhi(p.w);
}
__device__ __forceinline__ void ld8f(const float* p, float (&o)[8]) {
    const f32x4 a = *(const f32x4*)p, b = *(const f32x4*)(p + 4); o[0] = a.x; o[1] = a.y; o[2] = a.z; o[3] = a.w; o[4] = b.x; o[5] = b.y; o[6] = b.z; o[7] = b.w;
}
__device__ __forceinline__ float fsig(float x) { return __builtin_amdgcn_rcpf(1.0f + __expf(-x)); }
template <bool IS_CO> struct EPre { v4u k[5], v[5], r[IS_CO ? 5 : 1], lo[4]; };
template <bool IS_CO>
__device__ __forceinline__ void epre_load(EPre<IS_CO>& P, const bf16* z, const bf16* LO, int unit, int wave, int lane) {
    int b, h, rowbase; unit_decode(unit, b, h, rowbase);
    const int row = rowbase + 8 * wave + (lane >> 3), c0 = h * 64 + 8 * (lane & 7);
    const v4u zz = {0u, 0u, 0u, 0u};
    const bf16* zr = z + (size_t)row * NZ;
    P.k[0] = *(const v4u*)(zr + K_OFF + c0); P.v[0] = *(const v4u*)(zr + V_OFF + c0); if (IS_CO) P.r[0] = *(const v4u*)(zr + R_OFF + c0);
#pragma unroll
    for (int j = 0; j < 4; ++j) { const int nr = nbr_row(row, j); const bf16* zn = z + (size_t)(nr >= 0 ? nr : row) * NZ;
        const v4u a = *(const v4u*)(zn + K_OFF + c0), bq = *(const v4u*)(zn + V_OFF + c0);
        P.k[1 + j] = nr >= 0 ? a : zz; P.v[1 + j] = nr >= 0 ? bq : zz;
        if (IS_CO) { const v4u cq = *(const v4u*)(zn + R_OFF + c0); P.r[1 + j] = nr >= 0 ? cq : zz; } }
    const bf16* lr_ = LO + (size_t)row * NL + c0;
    P.lo[0] = *(const v4u*)(lr_); P.lo[1] = *(const v4u*)(lr_ + 1024); P.lo[2] = *(const v4u*)(lr_ + 2048); P.lo[3] = *(const v4u*)(lr_ + 3072);
}
__device__ __forceinline__ void shift8(const v4u (&q)[5], const float* mu, float (&out)[8]) {
    const v4u s = q[0], n0 = q[1], n1 = q[2], n2 = q[3], n3 = q[4];
    float m[8]; ld8f(mu, m);
    out[0] = bflo(s.x) + m[0] * (bflo(n0.x) - bflo(s.x)); out[1] = bfhi(s.x) + m[1] * (bfhi(n1.x) - bfhi(s.x));
    out[2] = bflo(s.y) + m[2] * (bflo(n2.y) - bflo(s.y)); out[3] = bfhi(s.y) + m[3] * (bfhi(n3.y) - bfhi(s.y));
    out[4] = bflo(s.z) + m[4] * (bflo(n0.z) - bflo(s.z)); out[5] = bfhi(s.z) + m[5] * (bfhi(n1.z) - bfhi(s.z));
    out[6] = bflo(s.w) + m[6] * (bflo(n2.w) - bflo(s.w)); out[7] = bfhi(s.w) + m[7] * (bfhi(n3.w) - bfhi(s.w));
}
__device__ __forceinline__ void putN(LAS unsigned char* t, int tau, int oct, const float (&v)[8]) {
    v4u o; o.x = cvtpk(v[0], v[1]); o.y = cvtpk(v[2], v[3]); o.z = cvtpk(v[4], v[5]); o.w = cvtpk(v[6], v[7]);
    *(LAS v4u*)(t + tau * 128 + ((oct ^ swz(tau)) << 4)) = o;
}
__device__ __forceinline__ void putT(LAS unsigned char* t, int tau, int ch0, const float (&v)[8]) {
#pragma unroll
    for (int i = 0; i < 8; ++i) *(LAS unsigned short*)(t + toff(ch0 + i, tau)) = (unsigned short)f2bf(v[i]);
}

template <bool IS_CO, bool STAGES = true>
__device__ __forceinline__ void phase_chunk(Frame& F) {
    const int wave = F.wave;
    const int dgrp = wave >> 2, wq = wave & 3;
    LAS unsigned char* tl = F.lds + dgrp * 9 * TILE;
#define SL(k) (tl + (k) * TILE)
    LAS float* SEG = (LAS float*)(F.lds + LDS_X_OFF);
    LAS float* GAM = SEG + 1024;
    LAS unsigned char* DIB = (LAS unsigned char*)(GAM + 128) + dgrp * 2048;
    LAS float* LW0 = (LAS float*)(F.lds + 7 * TILE);
    LAS float* LW1 = (LAS float*)(F.lds + 16 * TILE);
    const bf16* z = (const bf16*)(F.ws + WS_Z); const bf16* LO = (const bf16*)(F.ws + WS_LORA);
    unsigned char* PQ = F.ws + WS_PQ; unsigned char* TKN = F.ws + WS_TKN; unsigned char* UPRE = F.ws + WS_UPRE; unsigned char* H0T = F.ws + WS_H0T;
    bf16* MG = (bf16*)(F.ws + WS_A0);
    const float* p_mu = KIN(I_MU); const float* p_kk = KIN(I_KK); const float* p_ka = KIN(I_KA);
    const int NU = IS_CO ? NU_L : NU_ALL;
    EPre<IS_CO> PF;
    if ((int)blockIdx.x < NU) epre_load<IS_CO>(PF, z, LO, (int)blockIdx.x, wave, F.lane);
    for (int unit = blockIdx.x; unit < NU; unit += F.G) {
        int lane = F.lane; asm volatile("" : "+v"(lane));
        const int lr = lane & 15, g = lane >> 4;
        int b, h, rowbase; unit_decode(unit, b, h, rowbase);
        const int tok = 8 * wave + (lane >> 3), oct = lane & 7, ch0 = 8 * oct, c0 = h * 64 + ch0, row = rowbase + tok;
        float ks[8], vs[8], rs[8], kkp[8], lw0[8], lw1[8], kd0[8], kd1[8], a_0[8], a_1[8], ssq;
        {
            shift8(PF.k, p_mu + K_OFF + c0, ks);
            shift8(PF.v, p_mu + V_OFF + c0, vs);
            if (IS_CO) { v4u rr[5];
#pragma unroll
                for (int j = 0; j < 5; ++j) rr[j] = PF.r[IS_CO ? j : 0];
                shift8(rr, p_mu + R_OFF + c0, rs); }
            else {
#pragma unroll
                for (int i = 0; i < 8; ++i) rs[i] = 0.f; }
            float xw0[8], xw1[8], xa0[8], xa1[8];
            unpack8(PF.lo[0], xw0); unpack8(PF.lo[1], xw1); unpack8(PF.lo[2], xa0); unpack8(PF.lo[3], xa1);
            float kkk[8], kaa[8];
            ld8f(p_kk + c0, kkk); ld8f(p_ka + c0, kaa);
            float ss = 0.f;
#pragma unroll
            for (int i = 0; i < 8; ++i) {
                kkp[i] = ks[i] * kkk[i]; ss += kkp[i] * kkp[i];
                lw0[i] = xw0[i]; lw1[i] = xw1[i];
                a_0[i] = xa0[i]; a_1[i] = xa1[i];
                kd0[i] = ks[i] * (1.0f + (a_0[i] - 1.0f) * kaa[i]); kd1[i] = ks[i] * (1.0f + (a_1[i] - 1.0f) * kaa[i]);
                const int ch = ch0 + i, sw = tok ^ (4 * ((ch & 15) ^ (2 * (ch >> 4))));
                LW0[ch * 64 + sw] = lw0[i]; LW1[ch * 64 + sw] = lw1[i];
            }
            ss += __shfl_xor(ss, 1); ss += __shfl_xor(ss, 2); ss += __shfl_xor(ss, 4);
            ssq = ss;
        }
        __syncthreads();
        {
            const int ch2 = lane, seg = wave, sw = 4 * ((ch2 & 15) ^ (2 * (ch2 >> 4)));
            LAS f32x4* p0a = (LAS f32x4*)(LW0 + ch2 * 64 + ((8 * seg) ^ sw)); LAS f32x4* p0b = (LAS f32x4*)(LW0 + ch2 * 64 + ((8 * seg + 4) ^ sw));
            LAS f32x4* p1a = (LAS f32x4*)(LW1 + ch2 * 64 + ((8 * seg) ^ sw)); LAS f32x4* p1b = (LAS f32x4*)(LW1 + ch2 * 64 + ((8 * seg + 4) ^ sw));
            f32x4 a = *p0a, bq = *p0b, c = *p1a, d = *p1b;
            a.y += a.x; a.z += a.y; a.w += a.z; bq.x += a.w; bq.y += bq.x; bq.z += bq.y; bq.w += bq.z;
            d.z += d.w; d.y += d.z; d.x += d.y; c.w += d.x; c.z += c.w; c.y += c.z; c.x += c.y;
            SEG[seg * 64 + ch2] = bq.w; SEG[(8 + seg) * 64 + ch2] = c.x;
            __syncthreads();
            float off0 = 0.f, off1 = 0.f;
#pragma unroll
            for (int s2 = 0; s2 < 8; ++s2) { const float t0 = SEG[s2 * 64 + ch2], t1 = SEG[(8 + s2) * 64 + ch2]; off0 += (s2 < seg) ? t0 : 0.f; off1 += (s2 > seg) ? t1 : 0.f; }
            *p0a = a + off0; *p0b = bq + off0; *p1a = c + off1; *p1b = d + off1;
        }
        __syncthreads();
        {
            const float inv = 1.0f / fmaxf(sqrtf(ssq), 1e-12f);
            float t8[8], u8[8], w8[8];
            {
                LAS unsigned char* t0 = F.lds; const int tau = tok;
                float e1[8], ei[8];
#pragma unroll
                for (int i = 0; i < 8; ++i) { const int ch = ch0 + i; const float cm = LW0[ch * 64 + (tok ^ (4 * ((ch & 15) ^ (2 * (ch >> 4)))))]; e1[i] = __expf(cm); ei[i] = __builtin_amdgcn_rcpf(e1[i]); t8[i] = kkp[i] * inv * __expf(cm - lw0[i]); }
                if (tok == 63) {
#pragma unroll
                    for (int i = 0; i < 8; ++i) GAM[ch0 + i] = e1[i]; }
#pragma unroll
                for (int i = 0; i < 8; ++i) { u8[i] = kkp[i] * inv * a_0[i] * ei[i]; w8[i] = kd0[i] * ei[i]; }
                if (!IS_CO) { putN(t0 + 0 * TILE, tau, oct, t8); putT(t0 + 1 * TILE, tau, ch0, t8); putN(t0 + 2 * TILE, tau, oct, u8); putT(t0 + 3 * TILE, tau, ch0, u8);
                    putN(t0 + 4 * TILE, tau, oct, w8); putT(t0 + 5 * TILE, tau, ch0, w8); putT(t0 + 6 * TILE, tau, ch0, vs); }
                else {
#pragma unroll
                    for (int i = 0; i < 8; ++i) t8[i] = rs[i] * e1[i];
                    putN(t0 + 0 * TILE, tau, oct, w8); putN(t0 + 1 * TILE, tau, oct, u8); putN(t0 + 2 * TILE, tau, oct, t8); putT(t0 + 3 * TILE, tau, ch0, vs); }
            }
            {
                LAS unsigned char* t1 = F.lds + 9 * TILE; const int tau = 63 - tok;
                float e1[8], ei[8];
#pragma unroll
                for (int i = 0; i < 8; ++i) { const int ch = ch0 + i; const float cm = LW1[ch * 64 + (tok ^ (4 * ((ch & 15) ^ (2 * (ch >> 4)))))]; e1[i] = __expf(cm); ei[i] = __builtin_amdgcn_rcpf(e1[i]); t8[i] = kkp[i] * inv * __expf(cm - lw1[i]); }
                if (tok == 0) {
#pragma unroll
                    for (int i = 0; i < 8; ++i) GAM[64 + ch0 + i] = e1[i]; }
#pragma unroll
                for (int i = 0; i < 8; ++i) { u8[i] = kkp[i] * inv * a_1[i] * ei[i]; w8[i] = kd1[i] * ei[i]; }
                if (!IS_CO) { putN(t1 + 0 * TILE, tau, oct, t8); putT(t1 + 1 * TILE, tau, ch0, t8); putN(t1 + 2 * TILE, tau, oct, u8); putT(t1 + 3 * TILE, tau, ch0, u8);
                    putN(t1 + 4 * TILE, tau, oct, w8); putT(t1 + 5 * TILE, tau, ch0, w8); putT(t1 + 6 * TILE, tau, ch0, vs); }
                else {
#pragma unroll
                    for (int i = 0; i < 8; ++i) t8[i] = rs[i] * e1[i];
                    putN(t1 + 0 * TILE, tau, oct, w8); putN(t1 + 1 * TILE, tau, oct, u8); putN(t1 + 2 * TILE, tau, oct, t8); putT(t1 + 3 * TILE, tau, ch0, vs); }
            }
        }
        if (!STAGES) { __syncthreads(); continue; }
        const size_t inst = (size_t)unit * 2 + dgrp;
        const int t2 = (wq << 6) | lane;
        if (IS_CO) {
#pragma unroll
            for (int rep = 0; rep < 2; ++rep) { const int cidx = t2 + 256 * rep, row = cidx >> 3, ch = cidx & 7;
                const v4u a = *(const v4u*)(TKN + inst * 8192 + (size_t)(row * 64 + ch * 8) * 2), hh = *(const v4u*)(H0T + inst * 8192 + (size_t)(row * 64 + ch * 8) * 2);
                *(LAS v4u*)(SL(4) + row * 128 + ((ch ^ swz(row)) << 4)) = a; *(LAS v4u*)(SL(5) + row * 128 + ((ch ^ swz(row)) << 4)) = hh; }
        }
        v4u upre0 = {0u, 0u, 0u, 0u}, upre1 = upre0;
        if (IS_CO) { const unsigned char* up = UPRE + inst * 8192 + (size_t)((wq * 64 + lane) * 32); upre0 = *(const v4u*)up; upre1 = *(const v4u*)(up + 16); }
        if (unit + F.G < NU) epre_load<IS_CO>(PF, z, LO, unit + F.G, wave, lane);
        __syncthreads();
        f32x4 acc[4], acc2[4];
        if (!IS_CO) {
            zero4(acc); mm64<false>(acc, SL(2), SL(0), wq, lane);
            zero4(acc2); mm64<false>(acc2, SL(4), SL(0), wq, lane);
#pragma unroll
            for (int n = 0; n < 4; ++n)
#pragma unroll
                for (int q = 0; q < 4; ++q) { const bool lo = (16 * wq + 4 * g + q < 16 * n + lr); acc[n][q] = lo ? acc[n][q] : 0.f; acc2[n][q] = lo ? acc2[n][q] : 0.f; }
            storeT(SL(7), acc, wq, lane); storeT(SL(8), acc2, wq, lane);
            __syncthreads();
            zero4(acc); mm64<false>(acc, SL(8), SL(6), wq, lane); storeT(SL(0), acc, wq, lane);
            if (wq == 0) {
                const int bb = lane >> 4, jj = lane & 15;
                float X[16];
                X[0] = (jj == 0) ? 1.f : 0.f;
#pragma unroll
                for (int t = 1; t < 16; ++t) {
                    const int row = 16 * bb + t;
                    const v4u p0 = *(const LAS v4u*)(SL(7) + row * 128 + (((2 * bb) ^ swz(row)) << 4)), p1 = *(const LAS v4u*)(SL(7) + row * 128 + (((2 * bb + 1) ^ swz(row)) << 4));
                    float rw[16];
                    rw[0] = bflo(p0.x); rw[1] = bfhi(p0.x); rw[2] = bflo(p0.y); rw[3] = bfhi(p0.y); rw[4] = bflo(p0.z); rw[5] = bfhi(p0.z); rw[6] = bflo(p0.w); rw[7] = bfhi(p0.w);
                    rw[8] = bflo(p1.x); rw[9] = bfhi(p1.x); rw[10] = bflo(p1.y); rw[11] = bfhi(p1.y); rw[12] = bflo(p1.z); rw[13] = bfhi(p1.z); rw[14] = bflo(p1.w); rw[15] = bfhi(p1.w);
                    float xv = (t == jj) ? 1.f : 0.f;
#pragma unroll
                    for (int s = 0; s < t; ++s) xv -= rw[s] * X[s];
                    X[t] = xv;
                }
#pragma unroll
                for (int t = 0; t < 16; ++t) *(LAS unsigned short*)(DIB + (((bb * 16 + t) * 16 + jj) << 1)) = (unsigned short)f2bf(X[t]);
            }
            __syncthreads();
            {
                const bool isU = wq >= 2; const int cbase = 32 * (wq & 1);
                const LAS unsigned char* Rt = isU ? SL(0) : SL(1);
                LAS unsigned char* outT = isU ? SL(4) : SL(2);
#pragma unroll
                for (int ct = 0; ct < 2; ++ct) {
                    const int col = cbase + 16 * ct + lr;
                    f32x4 X[4];
#pragma unroll
                    for (int b = 0; b < 4; ++b) {
                        const v2u rwv = *(const LAS v2u*)(Rt + toff(col, 16 * b + 4 * g));
                        f32x4 Zt = {bflo(rwv.x), bfhi(rwv.x), bflo(rwv.y), bfhi(rwv.y)};
                        if (b >= 1) {
                            f32x4 Y = {0.f, 0.f, 0.f, 0.f};
#pragma unroll
                            for (int s = 0; s < (b + 1) / 2; ++s) {
                                v2u alo = {0u, 0u}, ahi = {0u, 0u};
                                if (2 * s < b) alo = *(const LAS v2u*)(SL(7) + toff(16 * b + lr, 32 * s + 4 * g));
                                if (2 * s + 1 < b) ahi = *(const LAS v2u*)(SL(7) + toff(16 * b + lr, 32 * s + 16 + 4 * g));
                                v4u bw = {cvtpk(X[2 * s][0], X[2 * s][1]), cvtpk(X[2 * s][2], X[2 * s][3]), 0u, 0u};
                                if (2 * s + 1 < b) { bw.z = cvtpk(X[2 * s + 1][0], X[2 * s + 1][1]); bw.w = cvtpk(X[2 * s + 1][2], X[2 * s + 1][3]); }
                                Y = CK_MFMA(__builtin_bit_cast(bf16x8, ((v4u){alo.x, alo.y, ahi.x, ahi.y})), __builtin_bit_cast(bf16x8, bw), Y);
                            }
                            Zt = Zt - Y;
                        }
                        const v2u dv = *(const LAS v2u*)(DIB + (((b * 16 + lr) * 16 + 4 * g) << 1));
                        const v4u bz = {cvtpk(Zt[0], Zt[1]), cvtpk(Zt[2], Zt[3]), 0u, 0u};
                        X[b] = CK_MFMA(__builtin_bit_cast(bf16x8, ((v4u){dv.x, dv.y, 0u, 0u})), __builtin_bit_cast(bf16x8, bz), ((f32x4){0.f, 0.f, 0.f, 0.f}));
                    }
#pragma unroll
                    for (int b = 0; b < 4; ++b) {
                        const v2u pk = {cvtpk(X[b][0], X[b][1]), cvtpk(X[b][2], X[b][3])};
                        *(LAS v2u*)(outT + toff(col, 16 * b + 4 * g)) = pk;
                        if (!isU) {
#pragma unroll
                            for (int q = 0; q < 4; ++q) *(LAS unsigned short*)(SL(8) + toff(16 * b + 4 * g + q, col)) = (unsigned short)f2bf(X[b][q]);
                        } else {
                            *(uint2*)(UPRE + inst * 8192 + (size_t)(((b * 64 + lane) * 4 + 2 * (wq & 1) + ct) * 8)) = make_uint2(pk.x, pk.y);
                        }
                    }
                }
            }
            __syncthreads();
            { zero4(acc); mm64<false>(acc, SL(2), SL(3), wq, lane);
              unsigned char* pb = PQ + inst * 16384;
#pragma unroll
              for (int n = 0; n < 4; ++n) { const int k = 16 * n + lr; const float gm = GAM[dgrp * 64 + k]; float p[4];
#pragma unroll
                  for (int q = 0; q < 4; ++q) p[q] = gm * (((16 * wq + 4 * g + q) == k ? 1.f : 0.f) - acc[n][q]);
                  *(uint2*)(pb + (size_t)(((n * 2 + (wq >> 1)) * 64 + lane) * 16 + (wq & 1) * 8)) = make_uint2(cvtpk(p[0], p[1]), cvtpk(p[2], p[3])); }
              zero4(acc); mm64<false>(acc, SL(5), SL(6), wq, lane); zero4(acc2); mm64<false>(acc2, SL(3), SL(4), wq, lane);
              const f32x4 gm4 = *(const LAS f32x4*)(GAM + dgrp * 64 + 16 * wq + 4 * g);
#pragma unroll
              for (int n = 0; n < 4; ++n) { const f32x4 qv = (acc[n] - acc2[n]) * gm4;
                  *(uint2*)(pb + 8192 + (size_t)(((n * 64 + lane) * 4 + wq) * 8)) = make_uint2(cvtpk(qv[0], qv[1]), cvtpk(qv[2], qv[3])); }
#pragma unroll
              for (int rep = 0; rep < 2; ++rep) { const int cidx = t2 + 256 * rep, row = cidx >> 3, ch = cidx & 7;
                  *(v4u*)(TKN + inst * 8192 + (size_t)(row * 64 + ch * 8) * 2) = *(const LAS v4u*)(SL(8) + row * 128 + ((ch ^ swz(row)) << 4)); }
            }
        } else {
            zero4(acc); mm64<false>(acc, SL(0), SL(2), wq, lane);
#pragma unroll
            for (int n = 0; n < 4; ++n)
#pragma unroll
                for (int q = 0; q < 4; ++q) acc[n][q] = (16 * wq + 4 * g + q <= 16 * n + lr) ? acc[n][q] : 0.f;
            storeT(SL(6), acc, wq, lane);
            zero4(acc); mm64<false>(acc, SL(1), SL(2), wq, lane);
#pragma unroll
            for (int n = 0; n < 4; ++n)
#pragma unroll
                for (int q = 0; q < 4; ++q) acc[n][q] = (16 * wq + 4 * g + q <= 16 * n + lr) ? -acc[n][q] : 0.f;
            storeT(SL(7), acc, wq, lane);
            { const v4u o0 = upre0, o1 = upre1;
              acc[0] = (f32x4){bflo(o0.x), bfhi(o0.x), bflo(o0.y), bfhi(o0.y)}; acc[1] = (f32x4){bflo(o0.z), bfhi(o0.z), bflo(o0.w), bfhi(o0.w)};
              acc[2] = (f32x4){bflo(o1.x), bfhi(o1.x), bflo(o1.y), bfhi(o1.y)}; acc[3] = (f32x4){bflo(o1.z), bfhi(o1.z), bflo(o1.w), bfhi(o1.w)}; }
            mm64<false>(acc, SL(4), SL(5), wq, lane);
            storeT(SL(8), acc, wq, lane);
            __syncthreads();
            zero4(acc); mm64<false>(acc, SL(2), SL(5), wq, lane); mm64<false>(acc, SL(6), SL(3), wq, lane); mm64<false>(acc, SL(7), SL(8), wq, lane);
            __syncthreads();
            { LAS float* Yf = (LAS float*)(tl);
#pragma unroll
              for (int n = 0; n < 4; ++n)
#pragma unroll
                  for (int q = 0; q < 4; ++q) { const int tau = 16 * wq + 4 * g + q; Yf[tau * 64 + ((16 * n + lr) ^ (4 * (tau & 15)))] = acc[n][q]; } }
            __syncthreads();
            { const LAS float* Y0 = (const LAS float*)(F.lds); const LAS float* Y1 = (const LAS float*)(F.lds + 9 * TILE);
              const int t = row & (T - 1);
              const bf16* zr = z + (size_t)row * NZ;
              const v4u zz = {0u, 0u, 0u, 0u};
              const v4u q_g = *(const v4u*)(LO + (size_t)row * NL + 4096 + c0);
              const v4u q_gb = *(const v4u*)(zr + CONV_OFF + c0), q_c0 = *(const v4u*)(zr + CONV_OFF + 1024 + c0), q_x0 = *(const v4u*)(zr + CONV_OFF + 2048 + c0);
              const v4u q_cm = t > 0 ? *(const v4u*)(zr - NZ + CONV_OFF + 1024 + c0) : zz, q_xm = t > 0 ? *(const v4u*)(zr - NZ + CONV_OFF + 2048 + c0) : zz;
              const v4u q_cp = t < T - 1 ? *(const v4u*)(zr + NZ + CONV_OFF + 1024 + c0) : zz, q_xp = t < T - 1 ? *(const v4u*)(zr + NZ + CONV_OFF + 2048 + c0) : zz;
              const v4u q_ga = *(const v4u*)(zr + GATE_OFF + c0), q_gr = *(const v4u*)(zr + GATE_OFF + 1024 + c0);
              float y[8];
              { const int s0 = 4 * (tok & 15), s1 = 4 * ((63 - tok) & 15);
                const f32x4 a0 = *(const LAS f32x4*)(Y0 + tok * 64 + (ch0 ^ s0)), a1 = *(const LAS f32x4*)(Y0 + tok * 64 + ((ch0 + 4) ^ s0));
                const f32x4 b0 = *(const LAS f32x4*)(Y1 + (63 - tok) * 64 + (ch0 ^ s1)), b1 = *(const LAS f32x4*)(Y1 + (63 - tok) * 64 + ((ch0 + 4) ^ s1));
                y[0] = a0.x + b0.x; y[1] = a0.y + b0.y; y[2] = a0.z + b0.z; y[3] = a0.w + b0.w; y[4] = a1.x + b1.x; y[5] = a1.y + b1.y; y[6] = a1.z + b1.z; y[7] = a1.w + b1.w; }
              float rk[8]; ld8f(KIN(I_RK) + c0, rk);
              float s1 = 0.f, s2 = 0.f, s3 = 0.f;
#pragma unroll
              for (int i = 0; i < 8; ++i) { s1 += y[i]; s2 += y[i] * y[i]; s3 += rs[i] * 0.5f * (kd0[i] + kd1[i]) * rk[i]; }
              s1 += __shfl_xor(s1, 1); s2 += __shfl_xor(s2, 1); s3 += __shfl_xor(s3, 1); s1 += __shfl_xor(s1, 2); s2 += __shfl_xor(s2, 2); s3 += __shfl_xor(s3, 2);
              s1 += __shfl_xor(s1, 4); s2 += __shfl_xor(s2, 4); s3 += __shfl_xor(s3, 4);
              const float S1 = s1, S2 = s2, S3 = s3;
              const float mean = S1 * (1.0f / 64.0f), var = fmaxf(S2 * (1.0f / 64.0f) - mean * mean, 0.f), rstd = __builtin_amdgcn_rsqf(var + 64e-5f);
              float lnw[8], lnb[8], cw0[8], cw1[8], cw2[8];
              ld8f(KIN(I_LNW) + c0, lnw); ld8f(KIN(I_LNB) + c0, lnb); ld8f(KIN(I_CONVW) + c0, cw0); ld8f(KIN(I_CONVW) + D + c0, cw1); ld8f(KIN(I_CONVW) + 2 * D + c0, cw2);
              float gg[8], gb[8], cc[8], xx[8], cm[8], xm[8], cp[8], xp[8], ga[8], gr[8];
              unpack8(q_g, gg); unpack8(q_gb, gb); unpack8(q_c0, cc); unpack8(q_x0, xx); unpack8(q_cm, cm); unpack8(q_xm, xm); unpack8(q_cp, cp); unpack8(q_xp, xp); unpack8(q_ga, ga); unpack8(q_gr, gr);
              float o[8];
#pragma unroll
              for (int i = 0; i < 8; ++i) {
                  const float yn = (y[i] - mean) * rstd * lnw[i] + lnb[i];
                  const float yr = (yn + S3 * vs[i]) * gg[i];
                  const float yc = gb[i] * (cw0[i] * (cm[i] * xm[i]) + cw1[i] * (cc[i] * xx[i]) + cw2[i] * (cp[i] * xp[i]));
                  o[i] = fsig(ga[i]) * yr + fsig(gr[i]) * yc;
              }
              v4u ov; ov.x = cvtpk(o[0], o[1]); ov.y = cvtpk(o[2], o[3]); ov.z = cvtpk(o[4], o[5]); ov.w = cvtpk(o[6], o[7]);
              *(v4u*)(MG + (size_t)row * D + c0) = ov;
            }
        }
        __syncthreads();
    }
#undef SL
}

struct SSIn { v4u a[8]; v4u q[2]; };
__device__ __forceinline__ size_t ss_inst(int step, int b, int h, int d) {
    int unit;
    if (step < 4) { const int cb = d ? 3 - step : step; unit = NU_L + (b * 4 + cb) * 16 + h; }
    else { const int blk = d ? 127 - (step - 4) : step - 4; unit = (b * 128 + blk) * 16 + h; }
    return (size_t)unit * 2 + d;
}
__device__ __forceinline__ void ss_load(SSIn& I, const unsigned char* PQ, size_t inst, int wv, int lane) {
    const unsigned char* pb = PQ + inst * 16384;
#pragma unroll
    for (int f = 0; f < 8; ++f) I.a[f] = *(const v4u*)(pb + (size_t)((f * 64 + lane) * 16));
    I.q[0] = *(const v4u*)(pb + 8192 + (size_t)((wv * 64 + lane) * 32)); I.q[1] = *(const v4u*)(pb + 8192 + (size_t)((wv * 64 + lane) * 32 + 16));
}
__device__ __forceinline__ void ss_step(f32x4 (&H)[4], const SSIn& cur, unsigned char* H0T, size_t inst, bool store_h0, int wv, int lr, int g) {
    const unsigned p00 = cvtpk(H[0][0], H[0][1]), p01 = cvtpk(H[0][2], H[0][3]), p10 = cvtpk(H[1][0], H[1][1]), p11 = cvtpk(H[1][2], H[1][3]);
    const unsigned p20 = cvtpk(H[2][0], H[2][1]), p21 = cvtpk(H[2][2], H[2][3]), p30 = cvtpk(H[3][0], H[3][1]), p31 = cvtpk(H[3][2], H[3][3]);
    if (store_h0) { unsigned char* hb = H0T + inst * 8192 + (size_t)((16 * wv + lr) * 64 + 4 * g) * 2;
        *(uint2*)(hb) = make_uint2(p00, p01); *(uint2*)(hb + 32) = make_uint2(p10, p11); *(uint2*)(hb + 64) = make_uint2(p20, p21); *(uint2*)(hb + 96) = make_uint2(p30, p31); }
    const bf16x8 b0 = __builtin_bit_cast(bf16x8, ((v4u){p00, p01, p10, p11})), b1 = __builtin_bit_cast(bf16x8, ((v4u){p20, p21, p30, p31}));
    H[0] = (f32x4){bflo(cur.q[0].x), bfhi(cur.q[0].x), bflo(cur.q[0].y), bfhi(cur.q[0].y)}; H[1] = (f32x4){bflo(cur.q[0].z), bfhi(cur.q[0].z), bflo(cur.q[0].w), bfhi(cur.q[0].w)};
    H[2] = (f32x4){bflo(cur.q[1].x), bfhi(cur.q[1].x), bflo(cur.q[1].y), bfhi(cur.q[1].y)}; H[3] = (f32x4){bflo(cur.q[1].z), bfhi(cur.q[1].z), bflo(cur.q[1].w), bfhi(cur.q[1].w)};
#pragma unroll
    for (int m = 0; m < 4; ++m) { H[m] = CK_MFMA(__builtin_bit_cast(bf16x8, cur.a[2 * m]), b0, H[m]); H[m] = CK_MFMA(__builtin_bit_cast(bf16x8, cur.a[2 * m + 1]), b1, H[m]); }
}
__device__ __forceinline__ void phase_ss(Frame& F) {
    const unsigned char* PQ = F.ws + WS_PQ; unsigned char* H0T = F.ws + WS_H0T;
    const int lane = F.lane, lr = lane & 15, g = lane >> 4;
    for (int task = (int)blockIdx.x; task < 256; task += F.G) {
        const int chain = task >> 2, wv = task & 3, b = chain >> 5, h = (chain >> 1) & 15, d = chain & 1;
        f32x4 H[4]; zero4(H);
        constexpr int NS = 4 + T / 64;
        static_assert(NS % 4 == 0, "unrolled by four");
        SSIn b0, b1, b2, b3;
        ss_load(b0, PQ, ss_inst(0, b, h, d), wv, lane); ss_load(b1, PQ, ss_inst(1, b, h, d), wv, lane); ss_load(b2, PQ, ss_inst(2, b, h, d), wv, lane); ss_load(b3, PQ, ss_inst(3, b, h, d), wv, lane);
        for (int step = 0; step < NS; step += 4) {
            const int n0 = step + 4 < NS ? step + 4 : NS - 1, n1 = step + 5 < NS ? step + 5 : NS - 1, n2 = step + 6 < NS ? step + 6 : NS - 1, n3 = step + 7 < NS ? step + 7 : NS - 1;
            ss_step(H, b0, H0T, ss_inst(step, b, h, d), step >= 4, wv, lr, g);     ss_load(b0, PQ, ss_inst(n0, b, h, d), wv, lane);
            ss_step(H, b1, H0T, ss_inst(step + 1, b, h, d), step >= 4, wv, lr, g); ss_load(b1, PQ, ss_inst(n1, b, h, d), wv, lane);
            ss_step(H, b2, H0T, ss_inst(step + 2, b, h, d), step >= 4, wv, lr, g); ss_load(b2, PQ, ss_inst(n2, b, h, d), wv, lane);
            ss_step(H, b3, H0T, ss_inst(step + 3, b, h, d), step >= 4, wv, lr, g); ss_load(b3, PQ, ss_inst(n3, b, h, d), wv, lane);
        }
    }
}

__device__ __forceinline__ void lora_atile(const bf16* z, const float* p_mu, LAS unsigned char* lds, int r0, int gi, int wave, int lane) {
    const int tok = 8 * wave + (lane >> 3), oct = lane & 7, row = r0 + tok;
    const v4u zz = {0u, 0u, 0u, 0u};
    const int col = (gi < 4 ? DECAY_OFF + 64 * gi : GLORA_OFF + 64 * (gi - 4)) + 8 * oct;
    v4u q[5]; q[0] = *(const v4u*)(z + (size_t)row * NZ + col);
#pragma unroll
    for (int j = 0; j < 4; ++j) { const int nr = nbr_row(row, j); q[1 + j] = nr >= 0 ? *(const v4u*)(z + (size_t)nr * NZ + col) : zz; }
    float v[8]; shift8(q, p_mu + col, v);
#pragma unroll
    for (int i = 0; i < 8; ++i) v[i] = gi < 2 ? 1.0f - 2.0f * __builtin_amdgcn_rcpf(1.0f + __expf(2.0f * v[i])) : (gi < 4 ? v[i] : fsig(v[i]));
    putN(lds + gi * TILE, tok, oct, v);
}
template <int KS> struct LoraB { bf16x8 w[KS][4]; };
template <int KS>
__device__ __forceinline__ void lora_bload(LoraB<KS>& B, const bf16* WL, int q, int lr, int g) {
    const int blkid = q >> 4, h = q & 15;
    const bf16* wrow = WL + (size_t)(blkid * 1024 + h * 64 + 8 * (lr >> 2) + (lr & 3)) * KL + blkid * 64 + 8 * g;
#pragma unroll
    for (int s = 0; s < KS; ++s)
#pragma unroll
        for (int n = 0; n < 4; ++n) B.w[s][n] = *(const bf16x8*)(wrow + (size_t)(32 * (n >> 1) + 4 * (n & 1)) * KL + 32 * s);
}
template <int KS>
__device__ __forceinline__ void lora_product(const LoraB<KS>& B, const LAS unsigned char* At, bf16* LO, int r0, int q, int lr, int g, const float* p_w0, const float* p_a0) {
    const int blkid = q >> 4, h = q & 15;
    f32x4 acc[4][4];
#pragma unroll
    for (int n = 0; n < 4; ++n)
#pragma unroll
        for (int m = 0; m < 4; ++m) acc[n][m] = (f32x4){0.f, 0.f, 0.f, 0.f};
#pragma unroll
    for (int s = 0; s < KS; ++s) {
        bf16x8 af[4];
#pragma unroll
        for (int m = 0; m < 4; ++m) af[m] = ldfrag(At + (s >> 1) * TILE, 16 * m + lr, 4 * (s & 1) + g);
#pragma unroll
        for (int n = 0; n < 4; ++n)
#pragma unroll
            for (int m = 0; m < 4; ++m) acc[n][m] = CK_MFMA(B.w[s][n], af[m], acc[n][m]);
    }
    bf16* ob = LO + (size_t)(r0 + lr) * NL + blkid * 1024 + h * 64 + 8 * g;
#pragma unroll
    for (int m = 0; m < 4; ++m)
#pragma unroll
        for (int p = 0; p < 2; ++p) {
            f32x4 v0 = acc[2 * p][m], v1 = acc[2 * p + 1][m];
            if (KS == 2) {
                const float* bp = (blkid < 2 ? p_w0 + (blkid & 1) * D : p_a0 + (blkid & 1) * D) + h * 64 + 8 * g + 32 * p;
                const f32x4 b0 = *(const f32x4*)bp, b1 = *(const f32x4*)(bp + 4); const float sc = blkid < 2 ? -0.6065306597126334f : 1.0f;
#pragma unroll
                for (int e = 0; e < 4; ++e) { v0[e] = sc * fsig(v0[e] + b0[e]); v1[e] = sc * fsig(v1[e] + b1[e]); }
            }
            v4u o; o.x = cvtpk(v0[0], v0[1]); o.y = cvtpk(v0[2], v0[3]); o.z = cvtpk(v1[0], v1[1]); o.w = cvtpk(v1[2], v1[3]);
            *(v4u*)(ob + (size_t)(16 * m) * NL + 32 * p) = o; }
}
__device__ __forceinline__ void phase_lora(Frame& F) {
    const bf16* z = (const bf16*)(F.ws + WS_Z); bf16* LO = (bf16*)(F.ws + WS_LORA); const bf16* WL = (const bf16*)(F.ws + WS_WLORA);
    const float* p_mu = KIN(I_MU); const float* p_w0 = KIN(I_W0); const float* p_a0 = KIN(I_A0);
    for (int unit = blockIdx.x; unit < ML / 64; unit += F.G) {
        int lane = F.lane; asm volatile("" : "+v"(lane));
        const int lr = lane & 15, g = lane >> 4, r0 = unit * 64;
#pragma unroll
        for (int gi = 0; gi < 6; ++gi) lora_atile(z, p_mu, F.lds, r0, gi, F.wave, lane);
        __syncthreads();
        LoraB<2> b0, b1;
        lora_bload<2>(b0, WL, F.wave, lr, g);
#pragma unroll
        for (int i = 0; i < 8; i += 2) {
            lora_bload<2>(b1, WL, F.wave + 8 * (i + 1), lr, g);
            lora_product<2>(b0, F.lds + ((F.wave + 8 * i) >> 4) * TILE, LO, r0, F.wave + 8 * i, lr, g, p_w0, p_a0);
            if (i + 2 < 8) lora_bload<2>(b0, WL, F.wave + 8 * (i + 2), lr, g);
            lora_product<2>(b1, F.lds + ((F.wave + 8 * (i + 1)) >> 4) * TILE, LO, r0, F.wave + 8 * (i + 1), lr, g, p_w0, p_a0);
        }
        { LoraB<4> c0; lora_bload<4>(c0, WL, 64 + F.wave, lr, g); lora_product<4>(c0, F.lds + 4 * TILE, LO, r0, 64 + F.wave, lr, g, p_w0, p_a0);
          lora_bload<4>(c0, WL, 72 + F.wave, lr, g); lora_product<4>(c0, F.lds + 4 * TILE, LO, r0, 72 + F.wave, lr, g, p_w0, p_a0); }
        __syncthreads();
    }
    for (int t = blockIdx.x; t < (MC / 64) * 32; t += F.G) {
        int lane = F.lane; asm volatile("" : "+v"(lane));
        const int lr = lane & 15, g = lane >> 4, r0 = ML + (t >> 5) * 64, q0 = 2 * (t & 31), gi = q0 >> 4;
        lora_atile(z, p_mu, F.lds, r0, gi, F.wave, lane);
        __syncthreads();
        if (F.wave < 2) { LoraB<2> b0; lora_bload<2>(b0, WL, q0 + F.wave, lr, g); lora_product<2>(b0, F.lds + gi * TILE, LO, r0, q0 + F.wave, lr, g, p_w0, p_a0); }
        __syncthreads();
    }
}
}
template <int PART>
__device__ __forceinline__ void phase_moe_weights(Frame& F) {
    LAS float* scr = (LAS float*)(F.lds + RING_OFF + F.wave * 16384);
    bf16* WEO = (bf16*)(F.ws + WS_WEOUT);
    constexpr int IT_IN = (D / 64) * (2048 / 32), IT_OUT = (D / 64) * (D / 32);
    if (PART == 0) {
        const float* wei = KIN(I_WEI);
        const int nstat = F.G * 7;
        int it = (int)blockIdx.x * 7 + F.wave - 1;
        while (it < NE * 128) {
            const int half = it & 1, r = it >> 1, e = r >> 6, n0 = 32 * (r & 63);
            const int c = n0 & 1023, rowbase = (c >> 7) * 256 + (n0 >= 1024 ? 128 : 0) + (c & 127);
            q8_item(wei + (size_t)e * D * 2048, 2048, n0, (signed char*)(F.ws + WS_WEIN) + (size_t)e * 2048 * D, (float*)(F.ws + MI_CSWEI) + (size_t)e * 2048, rowbase, scr, F.lane, 8 * half, 8 * half + 8);
            int nx = 0; if (F.lane == 0) nx = (int)__hip_atomic_fetch_add(F.ctl + CW_Q6, 1u, __ATOMIC_RELAXED, __HIP_MEMORY_SCOPE_AGENT);
            it = nstat + __builtin_amdgcn_readfirstlane(nx);
        }
    } else {
        const float* weo = KIN(I_WEO);
        for (int r = (int)blockIdx.x * 7 + F.wave - 1; r < NE * IT_OUT; r += F.G * 7) { const int e = r / IT_OUT, q = r % IT_OUT, kb = q / 32, n0 = 32 * (q % 32);
            transpose_item(weo + (size_t)e * D * D, D, 64 * kb, n0, WEO + (size_t)e * D * D, D, n0, scr, F.lane); }
    }
}

__device__ __forceinline__ void phase_x1_h2(Frame& F) {
    LAS float* LG = (LAS float*)(F.lds);
    LAS float* LA = LG + 2 * D; LAS float* LB = LA + 2 * D;
    const float* modp = (const float*)(F.ws + WS_MODP);
    for (int i = F.tid; i < 2 * D; i += NWAVES * 64) { const int v = i / D, j = i % D;
        LG[i] = mod_val(modp, KIN(I_BADA), v, 2048 + j) * KIN(I_NQM)[j];
        LA[i] = KIN(I_NPF)[j] * (1.0f + mod_val(modp, KIN(I_BADA), v, 4096 + j)); LB[i] = mod_val(modp, KIN(I_BADA), v, 3072 + j); }
    __syncthreads();
    const float* mix = (const float*)(F.ws + WS_MIX); float* x1 = (float*)(F.ws + WS_X1); bf16* h2 = (bf16*)(F.ws + WS_H2);
    for (int row = F.gw; row < ML; row += F.NGW) {
        const int vec = row >> 13;
        f32x4 m[4], x[4]; float s = 0.f;
#pragma unroll
        for (int j = 0; j < 4; ++j) { m[j] = *(const f32x4*)(mix + (size_t)row * D + 4 * F.lane + 256 * j); x[j] = *(const f32x4*)(KIN(I_X) + (size_t)row * D + 4 * F.lane + 256 * j);
            s += (m[j].x * m[j].x + m[j].y * m[j].y) + (m[j].z * m[j].z + m[j].w * m[j].w); }
        const float rstd = 1.0f / sqrtf(wave_sum(s) * (1.0f / D) + 1e-6f);
        float s2 = 0.f;
#pragma unroll
        for (int j = 0; j < 4; ++j) { const int c = 4 * F.lane + 256 * j; const f32x4 g = *(const LAS f32x4*)(LG + vec * D + c);
            x[j] = x[j] + g * (m[j] * rstd); *(f32x4*)(x1 + (size_t)row * D + c) = x[j];
            s2 += (x[j].x * x[j].x + x[j].y * x[j].y) + (x[j].z * x[j].z + x[j].w * x[j].w); }
        const float rstd2 = 1.0f / sqrtf(wave_sum(s2) * (1.0f / D) + 1e-6f);
        unsigned long long* o8 = (unsigned long long*)(h2 + (size_t)row * D) + F.lane;
        f32x4 hq[4]; float mx = 0.f;
#pragma unroll
        for (int j = 0; j < 4; ++j) { const int c = 4 * F.lane + 256 * j; const f32x4 a = *(const LAS f32x4*)(LA + vec * D + c), b = *(const LAS f32x4*)(LB + vec * D + c);
            const f32x4 h = x[j] * rstd2 * a + b; hq[j] = h;
            mx = fmaxf(mx, fmaxf(fmaxf(fabsf(h.x), fabsf(h.y)), fmaxf(fabsf(h.z), fabsf(h.w))));
            o8[64 * j] = (unsigned long long)pk2(h.x, h.y) | ((unsigned long long)pk2(h.z, h.w) << 32); }
        mx = wave_max(mx);
        const float iv = mx > 0.f ? 127.0f / mx : 0.f;
        if (F.lane == 0) ((float*)(F.ws + MI_RSH2))[row] = mx * (1.0f / 127.0f);
        unsigned* o4 = (unsigned*)(F.ws + WS_H2Q + (size_t)row * D) + F.lane;
#pragma unroll
        for (int j = 0; j < 4; ++j) o4[64 * j] = pack_q4(hq[j].x * iv, hq[j].y * iv, hq[j].z * iv, hq[j].w * iv);
    }
}

__device__ __forceinline__ void phase_route(Frame& F) {
    const float* LG = (const float*)(F.ws + WS_LOGIT);
    int* selE = (int*)(F.ws + MI_SELE); int* selP = (int*)(F.ws + MI_SELP); float* gate = (float*)(F.ws + MI_GATE);
    for (int task = F.gw; task < ML / 64; task += F.NGW) {
        const int row = task * 64 + F.lane;
        float v[NE];
#pragma unroll
        for (int q = 0; q < NE / 4; ++q) { const f32x4 x = *(const f32x4*)(LG + (size_t)row * 256 + 4 * q); const f32x4 bb = *(const f32x4*)(KIN(I_BR) + 4 * q);
            v[4 * q] = x.x + bb.x; v[4 * q + 1] = x.y + bb.y; v[4 * q + 2] = x.z + bb.z; v[4 * q + 3] = x.w + bb.w; }
        int se[4]; float sv[4];
#pragma unroll
        for (int k = 0; k < 4; ++k) { float best = -3.0e38f; int bi = 0;
#pragma unroll
            for (int e = 0; e < NE; ++e) if (v[e] > best) { best = v[e]; bi = e; }
#pragma unroll
            for (int e = 0; e < NE; ++e) v[e] = (e == bi) ? -3.0e38f : v[e];
            se[k] = bi; sv[k] = best; }
        float ex[4], sum = 0.f;
#pragma unroll
        for (int k = 0; k < 4; ++k) { ex[k] = __expf(sv[k] - sv[0]); sum += ex[k]; }
        const float inv = 1.0f / sum;
        int sp[4] = {0, 0, 0, 0};
        int myn = 0;
#pragma unroll
        for (int e = 0; e < NE; ++e) { const bool p = (se[0] == e) | (se[1] == e) | (se[2] == e) | (se[3] == e); const int n = __popcll(__ballot(p)); myn = (F.lane == e) ? n : myn; }
        int mybase = 0;
        if (F.lane < NE && myn > 0) mybase = (int)__hip_atomic_fetch_add(F.ctl + CW_CNT + 64 * F.lane, (unsigned)myn, __ATOMIC_RELAXED, __HIP_MEMORY_SCOPE_AGENT);
#pragma unroll
        for (int e = 0; e < NE; ++e) {
            const bool p = (se[0] == e) | (se[1] == e) | (se[2] == e) | (se[3] == e);
            const unsigned long long mask = __ballot(p);
            const int base = __shfl(mybase, e);
            const int pos = base + __popcll(mask & ((1ull << F.lane) - 1ull));
#pragma unroll
            for (int k = 0; k < 4; ++k) if (se[k] == e) sp[k] = pos;
        }
        *(int4*)(selE + (size_t)row * 4) = make_int4(se[0], se[1], se[2], se[3]);
        *(int4*)(selP + (size_t)row * 4) = make_int4(sp[0], sp[1], sp[2], sp[3]);
        *(f32x4*)(gate + (size_t)row * 4) = (f32x4){ex[0] * inv, ex[1] * inv, ex[2] * inv, ex[3] * inv};
    }
}

__device__ __forceinline__ void phase_x1h2_route(Frame& F) {
    constexpr int HS_STRIDE = 2064;
    LAS unsigned char* Hs = F.lds;
    LAS float* LG = (LAS float*)(F.lds + 132096);
    LAS float* LA = LG + D; LAS float* LB = LA + D;
    LAS float* LGT = (LAS float*)(F.lds + LDS_X_OFF);
    const float* modp = (const float*)(F.ws + WS_MODP);
    const float* mix = (const float*)(F.ws + WS_MIX); float* x1 = (float*)(F.ws + WS_X1);
    const float* xin = KIN(I_X); const float* b_ada = KIN(I_BADA); const float* nqm = KIN(I_NQM); const float* npf = KIN(I_NPF);
    const bf16* WR = (const bf16*)(F.ws + WS_WROUT);
    int* selE = (int*)(F.ws + MI_SELE); int* selP = (int*)(F.ws + MI_SELP); float* gate = (float*)(F.ws + MI_GATE);
    for (int rb = blockIdx.x; rb < ML / 64; rb += F.G) {
        const int vec = (rb * 64) >> 13;
        __syncthreads();
        for (int i = F.tid; i < D; i += NWAVES * 64) {
            LG[i] = mod_val(modp, b_ada, vec, 2048 + i) * nqm[i];
            LA[i] = npf[i] * (1.0f + mod_val(modp, b_ada, vec, 4096 + i)); LB[i] = mod_val(modp, b_ada, vec, 3072 + i); }
        __syncthreads();
        for (int rr = 0; rr < 8; ++rr) {
            const int lrow = F.wave * 8 + rr, row = rb * 64 + lrow;
            f32x4 m[4], x[4]; float s = 0.f;
#pragma unroll
            for (int j = 0; j < 4; ++j) { m[j] = *(const f32x4*)(mix + (size_t)row * D + 4 * F.lane + 256 * j); x[j] = *(const f32x4*)(xin + (size_t)row * D + 4 * F.lane + 256 * j);
                s += (m[j].x * m[j].x + m[j].y * m[j].y) + (m[j].z * m[j].z + m[j].w * m[j].w); }
            const float rstd = 1.0f / sqrtf(wave_sum(s) * (1.0f / D) + 1e-6f);
            float s2 = 0.f;
#pragma unroll
            for (int j = 0; j < 4; ++j) { const int c = 4 * F.lane + 256 * j; const f32x4 g = *(const LAS f32x4*)(LG + c);
                x[j] = x[j] + g * (m[j] * rstd); *(f32x4*)(x1 + (size_t)row * D + c) = x[j];
                s2 += (x[j].x * x[j].x + x[j].y * x[j].y) + (x[j].z * x[j].z + x[j].w * x[j].w); }
            const float rstd2 = 1.0f / sqrtf(wave_sum(s2) * (1.0f / D) + 1e-6f);
            f32x4 hq[4]; float mx = 0.f;
#pragma unroll
            for (int j = 0; j < 4; ++j) { const int c = 4 * F.lane + 256 * j; const f32x4 a = *(const LAS f32x4*)(LA + c), b = *(const LAS f32x4*)(LB + c);
                const f32x4 h = x[j] * rstd2 * a + b; hq[j] = h;
                mx = fmaxf(mx, fmaxf(fmaxf(fabsf(h.x), fabsf(h.y)), fmaxf(fabsf(h.z), fabsf(h.w))));
                *(LAS v2u*)(Hs + lrow * HS_STRIDE + c * 2) = (v2u){pk2(h.x, h.y), pk2(h.z, h.w)}; }
            mx = wave_max(mx);
            const float iv = mx > 0.f ? 127.0f / mx : 0.f;
            if (F.lane == 0) ((float*)(F.ws + MI_RSH2))[row] = mx * (1.0f / 127.0f);
            unsigned* o4 = (unsigned*)(F.ws + WS_H2Q + (size_t)row * D) + F.lane;
#pragma unroll
            for (int j = 0; j < 4; ++j) o4[64 * j] = pack_q4(hq[j].x * iv, hq[j].y * iv, hq[j].z * iv, hq[j].w * iv);
        }
        __syncthreads();
        {
            const int rt = F.wave & 3, et = F.wave >> 2, lr = F.lane & 15, g = F.lane >> 4;
            typedef short bf16x8_t __attribute__((ext_vector_type(8)));
            f32x4 acc = {0.f, 0.f, 0.f, 0.f};
            const LAS unsigned char* ap = Hs + (16 * rt + lr) * HS_STRIDE + 16 * g; const bf16* bp = WR + (size_t)(16 * et + lr) * D + 8 * g;
#pragma unroll 8
            for (int s = 0; s < 32; ++s) { const bf16x8_t a = *(const LAS bf16x8_t*)(ap + 64 * s); const bf16x8_t b = *(const bf16x8_t*)(bp + 32 * s);
                acc = __builtin_amdgcn_mfma_f32_16x16x32_bf16(a, b, acc, 0, 0, 0); }
#pragma unroll
            for (int i = 0; i < 4; ++i) LGT[(16 * rt + 4 * g + i) * 33 + 16 * et + lr] = acc[i];
        }
        __syncthreads();
        if (F.wave == 0) {
            const int row = rb * 64 + F.lane;
            const float* br = KIN(I_BR);
            float v[NE];
#pragma unroll
            for (int e = 0; e < NE; ++e) v[e] = LGT[F.lane * 33 + e] + br[e];
            int se[4]; float sv[4];
#pragma unroll
            for (int k = 0; k < 4; ++k) { float best = -3.0e38f; int bi = 0;
#pragma unroll
                for (int e = 0; e < NE; ++e) if (v[e] > best) { best = v[e]; bi = e; }
#pragma unroll
                for (int e = 0; e < NE; ++e) v[e] = (e == bi) ? -3.0e38f : v[e];
                se[k] = bi; sv[k] = best; }
            float ex[4], sum = 0.f;
#pragma unroll
            for (int k = 0; k < 4; ++k) { ex[k] = __expf(sv[k] - sv[0]); sum += ex[k]; }
            const float inv = 1.0f / sum;
            int sp[4] = {0, 0, 0, 0};
            int myn = 0;
#pragma unroll
            for (int e = 0; e < NE; ++e) { const bool p = (se[0] == e) | (se[1] == e) | (se[2] == e) | (se[3] == e); const int n = __popcll(__ballot(p)); myn = (F.lane == e) ? n : myn; }
            int mybase = 0;
            if (F.lane < NE && myn > 0) mybase = (int)__hip_atomic_fetch_add(F.ctl + CW_CNT + 64 * F.lane, (unsigned)myn, __ATOMIC_RELAXED, __HIP_MEMORY_SCOPE_AGENT);
#pragma unroll
            for (int e = 0; e < NE; ++e) {
                const bool p = (se[0] == e) | (se[1] == e) | (se[2] == e) | (se[3] == e);
                const unsigned long long mask = __ballot(p);
                const int base = __shfl(mybase, e);
                const int pos = base + __popcll(mask & ((1ull << F.lane) - 1ull));
#pragma unroll
                for (int k = 0; k < 4; ++k) if (se[k] == e) sp[k] = pos;
            }
            *(int4*)(selE + (size_t)row * 4) = make_int4(se[0], se[1], se[2], se[3]);
            *(int4*)(selP + (size_t)row * 4) = make_int4(sp[0], sp[1], sp[2], sp[3]);
            *(f32x4*)(gate + (size_t)row * 4) = (f32x4){ex[0] * inv, ex[1] * inv, ex[2] * inv, ex[3] * inv};
        }
    }
    __syncthreads();
}

__device__ __forceinline__ void phase_scatter(Frame& F) {
    LAS int* PS = (LAS int*)(F.lds);
    if (F.tid == 0) { int acc = 0;
        for (int e = 0; e < NE; ++e) { const int c = (int)__hip_atomic_load(F.ctl + CW_CNT + 64 * e, __ATOMIC_RELAXED, __HIP_MEMORY_SCOPE_AGENT); PS[e] = acc; PS[64 + e] = c; acc += (c + 255) / 256 * 256; }
        PS[NE] = acc; }
    __syncthreads();
    int* blkE = (int*)(F.ws + MI_BLKE);
    if (blockIdx.x == 0) {
        for (int b = F.tid; b < MAXBLK; b += NWAVES * 64) { int e = NE - 1;
            for (int q = 0; q < NE; ++q) if (b * 256 >= PS[q] && b * 256 < PS[q + 1]) e = q;
            blkE[b] = e; }
        if (F.tid == 0) blkE[MAXBLK] = PS[NE] / 256;
    }
    const int* selE = (const int*)(F.ws + MI_SELE); const int* selP = (const int*)(F.ws + MI_SELP); int* dest = (int*)(F.ws + MI_DEST);
    const unsigned char* h2q = F.ws + WS_H2Q; unsigned char* xb = F.ws + WS_XB; const float* rsh2 = (const float*)(F.ws + MI_RSH2); float* rsxb = (float*)(F.ws + MI_RSXB);
    for (int row = F.gw; row < ML; row += F.NGW) {
        const int4 se = *(const int4*)(selE + (size_t)row * 4), sp = *(const int4*)(selP + (size_t)row * 4);
        const int d0 = PS[se.x] + sp.x, d1 = PS[se.y] + sp.y, d2 = PS[se.z] + sp.z, d3 = PS[se.w] + sp.w;
        const float rsc = rsh2[row];
        if (F.lane == 0) { *(int4*)(dest + (size_t)row * 4) = make_int4(d0, d1, d2, d3); rsxb[d0] = rsc; rsxb[d1] = rsc; rsxb[d2] = rsc; rsxb[d3] = rsc; }
        const v4u a = *(const v4u*)(h2q + (size_t)row * D + 16 * F.lane);
        *(v4u*)(xb + (size_t)d0 * D + 16 * F.lane) = a; *(v4u*)(xb + (size_t)d1 * D + 16 * F.lane) = a;
        *(v4u*)(xb + (size_t)d2 * D + 16 * F.lane) = a; *(v4u*)(xb + (size_t)d3 * D + 16 * F.lane) = a;
    }
    for (int p = F.gw; p < NE * 256; p += F.NGW) {
        const int e = p >> 8, r = p & 255, c = PS[64 + e], padded = (c + 255) / 256 * 256;
        if (c + r < padded) { unsigned char* dst = xb + (size_t)(PS[e] + c + r) * D; *(v4u*)(dst + 16 * F.lane) = (v4u){0u, 0u, 0u, 0u}; if (F.lane == 0) rsxb[PS[e] + c + r] = 0.f; }
    }
}

__device__ __forceinline__ void phase_combine(Frame& F) {
    LAS float* LG = (LAS float*)(F.lds);
    const float* modp = (const float*)(F.ws + WS_MODP);
    for (int i = F.tid; i < 2 * D; i += NWAVES * 64) { const int v = i / D, j = i % D; LG[i] = mod_val(modp, KIN(I_BADA), v, 5120 + j) * KIN(I_NQF)[j]; }
    __syncthreads();
    const int* dest = (const int*)(F.ws + MI_DEST); const float* gate = (const float*)(F.ws + MI_GATE);
    const bf16* y2 = (const bf16*)(F.ws + WS_Y2); const float* x1 = (const float*)(F.ws + WS_X1);
    for (int row = F.gw; row < ML; row += F.NGW) {
        const int vec = row >> 13;
        const int4 dd = *(const int4*)(dest + (size_t)row * 4); const f32x4 gg = *(const f32x4*)(gate + (size_t)row * 4);
        const int dk[4] = {dd.x, dd.y, dd.z, dd.w}; const float gk[4] = {gg.x, gg.y, gg.z, gg.w};
        float f[16];
#pragma unroll
        for (int i = 0; i < 16; ++i) f[i] = 0.f;
#pragma unroll
        for (int k = 0; k < 4; ++k) { float t[16]; ld16bf(y2 + (size_t)dk[k] * D + 16 * F.lane, t);
#pragma unroll
            for (int i = 0; i < 16; ++i) f[i] += gk[k] * t[i]; }
        float s = 0.f;
#pragma unroll
        for (int i = 0; i < 16; ++i) s += f[i] * f[i];
        const float rstd = 1.0f / sqrtf(wave_sum(s) * (1.0f / D) + 1e-6f);
        float xv[16], g[16], o[16]; ld16f(x1 + (size_t)row * D + 16 * F.lane, xv); ld16f_lds(LG + vec * D + 16 * F.lane, g);
#pragma unroll
        for (int i = 0; i < 16; ++i) o[i] = xv[i] + g[i] * (f[i] * rstd);
        st16f(F.out + (size_t)row * D + 16 * F.lane, o);
    }
}

constexpr int N_PHASES = 13;
#ifndef PROBE_MASK
#define PROBE_MASK 0
#endif
#ifndef STAGE_REP
#define STAGE_REP 0
#endif
#ifndef USE_FLAT_BAR
#define USE_FLAT_BAR 0
#endif
struct Args { const float* in[30]; float* out; unsigned char* ws; int ph_lo, ph_hi; };
__global__ void __launch_bounds__(NWAVES * 64, 2) fwd(Args args) {
    extern __shared__ __attribute__((aligned(16))) unsigned char lds[];
    Frame F;
    F.lds = (LAS unsigned char*)lds;
    F.MISC = (volatile LAS unsigned*)(F.lds + MISC_OFF);
    F.tid = threadIdx.x; F.lane = F.tid & 63; F.wave = __builtin_amdgcn_readfirstlane(F.tid >> 6);
    F.G = gridDim.x; F.gw = blockIdx.x * NWAVES + F.wave; F.NGW = F.G * NWAVES;
    F.ws = args.ws; F.ctl = (unsigned*)(args.ws + WS_CTL); F.out = args.out;
    for (int u = F.tid; u < (LDS_X_OFF - LDSCTL_OFF) / 4; u += NWAVES * 64) ((LAS unsigned*)(F.lds + LDSCTL_OFF))[u] = 0u;
    __syncthreads();
    const int lo = args.ph_lo, hi = args.ph_hi;
    const bool use_bar = (hi - lo) > 1;
    XcdBarrier bar; bar.bar = F.ctl + CW_BAR; bar.x = 0; bar.st = nullptr;
    if (use_bar && !USE_FLAT_BAR) bar = xcd_barrier_post(F.ctl + CW_BAR, F.MISC + 8);
#define IN(k) (lo <= (k) && (k) < hi)
    unsigned fb_extra = 0u;
#define SEAM(k) do { if (IN(k) && IN((k) + 1)) { if (USE_FLAT_BAR) flat_barrier(F.ctl + CW_FB, (unsigned)((k) - lo + 1) + fb_extra); else xcd_barrier2(bar); } else __syncthreads(); } while (0)

#define DUP(k) ((PROBE_MASK >> (k)) & 1)
    if (IN(0)) { phase_prologue(F); if (DUP(0)) { __syncthreads(); phase_prologue(F); } SEAM(0); }
    if (DUP(20)) { for (int q = 0; q < 10; ++q) { if (USE_FLAT_BAR) { ++fb_extra; flat_barrier(F.ctl + CW_FB, 1u + fb_extra); } else xcd_barrier2(bar); } }
    if (IN(1)) { phase_hrows(F); if (DUP(1)) { __syncthreads(); phase_hrows(F); } SEAM(1); }
    if (IN(2)) {
        {         pg8::Gemm g{(const bf16*)(F.ws + WS_A0), (const bf16*)(F.ws + WS_WIN), MT, NZ, D}; pg8::StaticOrder S; S.init(MT, NZ, F.G, (int)blockIdx.x);
        pg8::EpiBf16I8 E{(bf16*)(F.ws + WS_Z), NZ, (const float*)(F.ws + MI_RSH), (const float*)(F.ws + MI_CSWIN)};
        pg8::gemm_phase_i8<pg8::EpiBf16I8, pg8::StaticOrder, true, true>(F.lds + RING_OFF, g, S, E); __syncthreads(); }
        if (DUP(2)) {         pg8::Gemm g{(const bf16*)(F.ws + WS_A0), (const bf16*)(F.ws + WS_WIN), MT, NZ, D}; pg8::StaticOrder S; S.init(MT, NZ, F.G, (int)blockIdx.x);
        pg8::EpiBf16I8 E{(bf16*)(F.ws + WS_Z), NZ, (const float*)(F.ws + MI_RSH), (const float*)(F.ws + MI_CSWIN)};
        pg8::gemm_phase_i8<pg8::EpiBf16I8, pg8::StaticOrder, true, true>(F.lds + RING_OFF, g, S, E); __syncthreads(); }
        SEAM(2); }
    if (IN(3)) { ck::phase_lora(F); SEAM(3); }
    if (IN(4)) { ck::phase_chunk<false>(F); if (DUP(5)) { __syncthreads(); ck::phase_chunk<false>(F); } if (DUP(21)) { __syncthreads(); ck::phase_chunk<false, false>(F); } if (DUP(22)) { __syncthreads(); ck::phase_lora(F); } SEAM(4); }
    if (IN(5)) { if (F.wave == 0) ck::phase_ss(F); else { phase_moe_weights<0>(F); phase_moe_weights<1>(F); } if (DUP(6)) { __syncthreads(); if (F.wave == 0) ck::phase_ss(F); else phase_moe_weights<0>(F); } if (DUP(17)) { __syncthreads(); if (F.wave == 0) ck::phase_ss(F); } SEAM(5); }
    if (IN(6)) { ck::phase_chunk<true>(F); if (DUP(7)) { __syncthreads(); ck::phase_chunk<true>(F); } SEAM(6); }
    if (IN(7)) {
        {         pg8::Gemm g{(const bf16*)(F.ws + WS_A0), (const bf16*)(F.ws + WS_WOUT), ML, D, D}; pg8::StaticOrder S; S.init(ML, D, F.G, (int)blockIdx.x);
        pg8::EpiF32 E{(float*)(F.ws + WS_MIX), D};
        pg8::gemm_phase<pg8::EpiF32, pg8::StaticOrder, true, true>(F.lds + RING_OFF, g, S, E);
        __syncthreads(); }
        if (DUP(8)) {         pg8::Gemm g{(const bf16*)(F.ws + WS_A0), (const bf16*)(F.ws + WS_WOUT), ML, D, D}; pg8::StaticOrder S; S.init(ML, D, F.G, (int)blockIdx.x);
        pg8::EpiF32 E{(float*)(F.ws + WS_MIX), D};
        pg8::gemm_phase<pg8::EpiF32, pg8::StaticOrder, true, true>(F.lds + RING_OFF, g, S, E);
        __syncthreads(); }
        SEAM(7); }
    if (IN(8)) { phase_x1h2_route(F); SEAM(8); }
    if (IN(9)) { phase_scatter(F); if (DUP(12)) { __syncthreads(); phase_scatter(F); } SEAM(9); }
    if (IN(10)) {
        {         const int* blkE = (const int*)(F.ws + MI_BLKE);
        pg8::Gemm g{(const bf16*)(F.ws + WS_XB), (const bf16*)(F.ws + WS_WEIN), NROWS, 2048, D};
        pg8::MoeOrder<8> S{blkE, __hip_atomic_load(blkE + MAXBLK, __ATOMIC_RELAXED, __HIP_MEMORY_SCOPE_AGENT) * 8, F.G, (int)blockIdx.x};
        pg8::EpiSwigluI8 E{(bf16*)(F.ws + WS_ACT), KIN(I_BEI), (const float*)(F.ws + MI_RSXB), (const float*)(F.ws + MI_CSWEI)};
        pg8::gemm_phase_i8<pg8::EpiSwigluI8, pg8::MoeOrder<8>, true, true>(F.lds + RING_OFF, g, S, E); __syncthreads(); }
        if (DUP(13)) {         const int* blkE = (const int*)(F.ws + MI_BLKE);
        pg8::Gemm g{(const bf16*)(F.ws + WS_XB), (const bf16*)(F.ws + WS_WEIN), NROWS, 2048, D};
        pg8::MoeOrder<8> S{blkE, __hip_atomic_load(blkE + MAXBLK, __ATOMIC_RELAXED, __HIP_MEMORY_SCOPE_AGENT) * 8, F.G, (int)blockIdx.x};
        pg8::EpiSwigluI8 E{(bf16*)(F.ws + WS_ACT), KIN(I_BEI), (const float*)(F.ws + MI_RSXB), (const float*)(F.ws + MI_CSWEI)};
        pg8::gemm_phase_i8<pg8::EpiSwigluI8, pg8::MoeOrder<8>, true, true>(F.lds + RING_OFF, g, S, E); __syncthreads(); }
        SEAM(10); }
    if (IN(11)) {
        {         const int* blkE = (const int*)(F.ws + MI_BLKE);
        pg8::Gemm g{(const bf16*)(F.ws + WS_ACT), (const bf16*)(F.ws + WS_WEOUT), NROWS, D, D};
        pg8::MoeOrder<4> S{blkE, __hip_atomic_load(blkE + MAXBLK, __ATOMIC_RELAXED, __HIP_MEMORY_SCOPE_AGENT) * 4, F.G, (int)blockIdx.x};
        pg8::EpiBf16 E{(bf16*)(F.ws + WS_Y2), D, KIN(I_BEO), D};
        pg8::gemm_phase<pg8::EpiBf16, pg8::MoeOrder<4>, true, true>(F.lds + RING_OFF, g, S, E); __syncthreads(); }
        if (DUP(14)) {         const int* blkE = (const int*)(F.ws + MI_BLKE);
        pg8::Gemm g{(const bf16*)(F.ws + WS_ACT), (const bf16*)(F.ws + WS_WEOUT), NROWS, D, D};
        pg8::MoeOrder<4> S{blkE, __hip_atomic_load(blkE + MAXBLK, __ATOMIC_RELAXED, __HIP_MEMORY_SCOPE_AGENT) * 4, F.G, (int)blockIdx.x};
        pg8::EpiBf16 E{(bf16*)(F.ws + WS_Y2), D, KIN(I_BEO), D};
        pg8::gemm_phase<pg8::EpiBf16, pg8::MoeOrder<4>, true, true>(F.lds + RING_OFF, g, S, E); __syncthreads(); }
        SEAM(11); }
    if (IN(12)) { phase_combine(F); if (DUP(15)) { __syncthreads(); phase_combine(F); } }
#undef IN
#undef SEAM
}

#ifndef MK_N_LAUNCHES
#define MK_N_LAUNCHES 1
#endif
extern "C" void kernel_launch(void* const* d_in, const int* in_sizes, int n_in, void* d_out, int out_size, void* d_ws, size_t ws_size, hipStream_t stream) {
    static int grid = 0;
    if (grid == 0) {
        if (n_in != 30 || out_size != ML * D || ws_size < WS_END) { fprintf(stderr, "kernel_launch: unexpected shapes (n_in %d out %d ws %zu, need %zu); nothing launched\n", n_in, out_size, ws_size, (size_t)WS_END); grid = -1; return; }
        int dev = 0, cus = 0, per_cu = 0;
        if (hipGetDevice(&dev) != hipSuccess || hipDeviceGetAttribute(&cus, hipDeviceAttributeMultiprocessorCount, dev) != hipSuccess) { grid = -1; return; }
        if (hipFuncSetAttribute((const void*)fwd, hipFuncAttributeMaxDynamicSharedMemorySize, LDS_BYTES) != hipSuccess) { fprintf(stderr, "kernel_launch: hipFuncSetAttribute failed\n"); grid = -1; return; }
        if (hipOccupancyMaxActiveBlocksPerMultiprocessor(&per_cu, (const void*)fwd, NWAVES * 64, LDS_BYTES) != hipSuccess || per_cu < 1)
            fprintf(stderr, "kernel_launch: note: occupancy query reports %d workgroups per CU\n", per_cu);
        (void)hipGetLastError();
        grid = cus;
    }
    if (grid < 0) return;
    if (hipMemsetAsync((char*)d_ws + WS_CTL, 0, CTL_ZERO_BYTES, stream) != hipSuccess) return;
    Args a{};
    for (int i = 0; i < 30; ++i) a.in[i] = (const float*)d_in[i];
    a.out = (float*)d_out; a.ws = (unsigned char*)d_ws;
    if (MK_N_LAUNCHES == 1) { a.ph_lo = 0; a.ph_hi = N_PHASES; hipLaunchKernelGGL(fwd, dim3(grid), dim3(NWAVES * 64), LDS_BYTES, stream, a); }
    else for (int p = 0; p < N_PHASES; ++p) { a.ph_lo = p; a.ph_hi = p + 1; hipLaunchKernelGGL(fwd, dim3(grid), dim3(NWAVES * 64), LDS_BYTES, stream, a); }
}
```

```cpp
#include <hip/hip_runtime.h>
#include <cstdio>
#include <cstdint>

namespace pg8 {
#define PG8_LAS __attribute__((address_space(3)))
typedef unsigned short bf16_t;
typedef short bf16x8 __attribute__((ext_vector_type(8)));
typedef float f32x4 __attribute__((ext_vector_type(4)));
typedef unsigned u32x4 __attribute__((ext_vector_type(4)));
constexpr int BM = 256, BK = 64, HALF = 128, HTB = HALF * BK * 2  , STAGE_BYTES = 8 * HTB, NXCD = 8, WGM = 8;

__host__ __device__ __forceinline__ int lds_byte(int r, int c) { const int st = (r >> 4) * 2 + (c >> 5), rr = r & 15, cc = c & 31, ob = rr * 64 + cc * 2; return st * 1024 + (ob ^ (((ob >> 9) & 1) << 5)); }
__host__ __device__ __forceinline__ void stage_rc(int b, int& R, int& C) { const int st = b / 1024, sb = b % 1024, swz = sb ^ (((sb >> 9) & 1) << 5); R = (st >> 1) * 16 + swz / 64; C = (st & 1) * 32 + (swz % 64) / 2; }
__host__ __device__ __forceinline__ int perm32(int rho) { const int n = rho >> 4, i = rho & 15; return 8 * (i >> 2) + 4 * n + (i & 3); }

struct Unit { int pm, pn, pb, e; };
struct Gemm { const bf16_t* A; const bf16_t* Bt; int M, N, K; };

struct StaticOrder {
    int nM, nN, nwg, G, c;
    __host__ __device__ void init(int M, int N, int G_, int c_) { nM = M / BM; nN = N / BM; nwg = nM * nN; G = G_; c = c_; }
    __host__ __device__ bool next(int i, Unit& u) const {
        const long L = (long)i * G + c; if (L >= nwg) return false;
        int wgid = (int)L; { const int q = nwg / NXCD, r = nwg % NXCD, xcd = wgid % NXCD, off = wgid / NXCD; wgid = (xcd < r ? xcd * (q + 1) : r * (q + 1) + (xcd - r) * q) + off; }
        const int nig = WGM * nN, gid = wgid / nig, fm = gid * WGM, gsz = (nM - fm) < WGM ? (nM - fm) : WGM;
        u.pm = fm + ((wgid % nig) % gsz); u.pn = (wgid % nig) / gsz; u.pb = u.pn; u.e = 0; return true;
    }
    __device__ __forceinline__ void a_ready(const Unit&) const {}
    __device__ __forceinline__ void done(const Unit&) const {}
};
template <int NT> struct MoeOrder {
    const int* blk_e; int nunits, G, c;
    __device__ bool next(int i, Unit& u) const {
        const long L = (long)i * G + c; if (L >= nunits) return false;
        const int blk = (int)L / NT, pn = (int)L % NT; const int e = __hip_atomic_load(blk_e + blk, __ATOMIC_RELAXED, __HIP_MEMORY_SCOPE_AGENT);
        u.pm = blk; u.pn = pn; u.pb = e * NT + pn; u.e = e; return true;
    }
    __device__ __forceinline__ void a_ready(const Unit&) const {}
    __device__ __forceinline__ void done(const Unit&) const {}
};

__device__ __forceinline__ unsigned cvt_pk_bf16(float lo, float hi) { unsigned r; asm volatile("v_cvt_pk_bf16_f32 %0, %1, %2" : "=v"(r) : "v"(lo), "v"(hi)); return r; }

struct EpiF32 {
    static constexpr bool PERM = false, AFTER_DRAIN = false;
    float* C; int ldc;
    __device__ __forceinline__ void operator()(const f32x4 (&acc)[2][2][4][2], const Unit& u, int wr, int wc, int fr, int fq) const {
        const int row0 = u.pm * BM + wr * 64 + fr, col0 = u.pn * BM + wc * 32 + 4 * fq;
#pragma unroll
        for (int ai = 0; ai < 2; ++ai)
#pragma unroll
            for (int m = 0; m < 4; ++m) { float* rowp = C + (size_t)(row0 + ai * HALF + m * 16) * ldc + col0;
#pragma unroll
                for (int bj = 0; bj < 2; ++bj)
#pragma unroll
                    for (int n = 0; n < 2; ++n) __builtin_nontemporal_store(acc[ai][bj][m][n], (f32x4*)(rowp + bj * HALF + n * 16)); }
    }
};
struct EpiBf16 {
    static constexpr bool PERM = true, AFTER_DRAIN = false;
    bf16_t* O; int ldc; const float* bias; int bias_estride;
    __device__ __forceinline__ void operator()(const f32x4 (&acc)[2][2][4][2], const Unit& u, int wr, int wc, int fr, int fq) const {
        const int row0 = u.pm * BM + wr * 64 + fr; const int col0 = u.pn * BM + wc * 32 + 8 * fq;
        const float* bp = bias ? bias + (size_t)u.e * bias_estride + col0 : nullptr;
        f32x4 bv[2][2];
#pragma unroll
        for (int bj = 0; bj < 2; ++bj)
#pragma unroll
            for (int n = 0; n < 2; ++n) bv[bj][n] = bp ? *(const f32x4*)(bp + bj * HALF + 4 * n) : (f32x4){0.f, 0.f, 0.f, 0.f};
#pragma unroll
        for (int ai = 0; ai < 2; ++ai)
#pragma unroll
            for (int m = 0; m < 4; ++m) { bf16_t* rowp = O + (size_t)(row0 + ai * HALF + m * 16) * ldc + col0;
#pragma unroll
                for (int bj = 0; bj < 2; ++bj) { const f32x4 v0 = acc[ai][bj][m][0] + bv[bj][0], v1 = acc[ai][bj][m][1] + bv[bj][1];
                    u32x4 w; w.x = cvt_pk_bf16(v0[0], v0[1]); w.y = cvt_pk_bf16(v0[2], v0[3]); w.z = cvt_pk_bf16(v1[0], v1[1]); w.w = cvt_pk_bf16(v1[2], v1[3]);
                    __builtin_nontemporal_store(w, (u32x4*)(rowp + bj * HALF)); } }
    }
};
struct EpiSwiglu {
    static constexpr bool PERM = true, AFTER_DRAIN = false;
    bf16_t* O; const float* bias;
    __device__ __forceinline__ float act1(float g, float up) const {
        g = fminf(g, 7.0f); up = fminf(fmaxf(up, -7.0f), 7.0f);
        const float sg = 1.0f / (1.0f + __expf(-1.702f * g));
        return (up + 1.0f) * g * sg;
    }
    __device__ __forceinline__ void operator()(const f32x4 (&acc)[2][2][4][2], const Unit& u, int wr, int wc, int fr, int fq) const {
        const int row0 = u.pm * BM + wr * 64 + fr; const int col0 = u.pn * HALF + wc * 32 + 8 * fq;
        const float* bp = bias + (size_t)u.e * 2048 + col0;
        f32x4 bg[2], bu[2];
#pragma unroll
        for (int n = 0; n < 2; ++n) { bg[n] = *(const f32x4*)(bp + 4 * n); bu[n] = *(const f32x4*)(bp + 1024 + 4 * n); }
#pragma unroll
        for (int ai = 0; ai < 2; ++ai)
#pragma unroll
            for (int m = 0; m < 4; ++m) { bf16_t* rowp = O + (size_t)(row0 + ai * HALF + m * 16) * 1024 + col0;
                const f32x4 g0 = acc[ai][0][m][0] + bg[0], g1 = acc[ai][0][m][1] + bg[1], u0 = acc[ai][1][m][0] + bu[0], u1 = acc[ai][1][m][1] + bu[1];
                u32x4 w; w.x = cvt_pk_bf16(act1(g0[0], u0[0]), act1(g0[1], u0[1])); w.y = cvt_pk_bf16(act1(g0[2], u0[2]), act1(g0[3], u0[3]));
                w.z = cvt_pk_bf16(act1(g1[0], u1[0]), act1(g1[1], u1[1])); w.w = cvt_pk_bf16(act1(g1[2], u1[2]), act1(g1[3], u1[3]));
                __builtin_nontemporal_store(w, (u32x4*)rowp); }
    }
};


typedef int i32x4 __attribute__((ext_vector_type(4)));
struct EpiBf16I8 {
    static constexpr bool PERM = true, AFTER_DRAIN = false;
    bf16_t* O; int ldc; const float* rs; const float* cs;
    __device__ __forceinline__ void operator()(const i32x4 (&acc)[2][2][4][2], const Unit& u, int wr, int wc, int fr, int fq) const {
        const int row0 = u.pm * BM + wr * 64 + fr; const int col0 = u.pn * BM + wc * 32 + 8 * fq;
        const float* cp = cs + (size_t)u.pb * BM + wc * 32 + 8 * fq;
        f32x4 cv[2][2];
#pragma unroll
        for (int bj = 0; bj < 2; ++bj)
#pragma unroll
            for (int n = 0; n < 2; ++n) cv[bj][n] = *(const f32x4*)(cp + bj * HALF + 4 * n);
#pragma unroll
        for (int ai = 0; ai < 2; ++ai)
#pragma unroll
            for (int m = 0; m < 4; ++m) { const int row = row0 + ai * HALF + m * 16; const float r = rs[row]; bf16_t* rowp = O + (size_t)row * ldc + col0;
#pragma unroll
                for (int bj = 0; bj < 2; ++bj) { const i32x4 a0 = acc[ai][bj][m][0], a1 = acc[ai][bj][m][1];
                    const f32x4 v0 = (f32x4){(float)a0[0], (float)a0[1], (float)a0[2], (float)a0[3]} * cv[bj][0] * r, v1 = (f32x4){(float)a1[0], (float)a1[1], (float)a1[2], (float)a1[3]} * cv[bj][1] * r;
                    u32x4 w; w.x = cvt_pk_bf16(v0[0], v0[1]); w.y = cvt_pk_bf16(v0[2], v0[3]); w.z = cvt_pk_bf16(v1[0], v1[1]); w.w = cvt_pk_bf16(v1[2], v1[3]);
                    __builtin_nontemporal_store(w, (u32x4*)(rowp + bj * HALF)); } }
    }
};
struct EpiSwigluI8 {
    static constexpr bool PERM = true, AFTER_DRAIN = false;
    bf16_t* O; const float* bias; const float* rs; const float* cs;
    __device__ __forceinline__ float act1(float g, float up) const {
        g = fminf(g, 7.0f); up = fminf(fmaxf(up, -7.0f), 7.0f);
        const float sg = __builtin_amdgcn_rcpf(1.0f + __expf(-1.702f * g));
        return (up + 1.0f) * g * sg;
    }
    __device__ __forceinline__ void operator()(const i32x4 (&acc)[2][2][4][2], const Unit& u, int wr, int wc, int fr, int fq) const {
        const int row0 = u.pm * BM + wr * 64 + fr; const int col0 = u.pn * HALF + wc * 32 + 8 * fq;
        const float* bp = bias + (size_t)u.e * 2048 + col0;
        const float* cp = cs + (size_t)u.pb * BM + wc * 32 + 8 * fq;
        f32x4 bg[2], bu[2], cg[2], cu[2];
#pragma unroll
        for (int n = 0; n < 2; ++n) { bg[n] = *(const f32x4*)(bp + 4 * n); bu[n] = *(const f32x4*)(bp + 1024 + 4 * n); cg[n] = *(const f32x4*)(cp + 4 * n); cu[n] = *(const f32x4*)(cp + HALF + 4 * n); }
#pragma unroll
        for (int ai = 0; ai < 2; ++ai)
#pragma unroll
            for (int m = 0; m < 4; ++m) { const int row = row0 + ai * HALF + m * 16; const float r = rs[row]; bf16_t* rowp = O + (size_t)row * 1024 + col0;
                f32x4 g[2], up[2];
#pragma unroll
                for (int n = 0; n < 2; ++n) { const i32x4 ag = acc[ai][0][m][n], au = acc[ai][1][m][n];
                    g[n] = (f32x4){(float)ag[0], (float)ag[1], (float)ag[2], (float)ag[3]} * cg[n] * r + bg[n];
                    up[n] = (f32x4){(float)au[0], (float)au[1], (float)au[2], (float)au[3]} * cu[n] * r + bu[n]; }
                u32x4 w; w.x = cvt_pk_bf16(act1(g[0][0], up[0][0]), act1(g[0][1], up[0][1])); w.y = cvt_pk_bf16(act1(g[0][2], up[0][2]), act1(g[0][3], up[0][3]));
                w.z = cvt_pk_bf16(act1(g[1][0], up[1][0]), act1(g[1][1], up[1][1])); w.w = cvt_pk_bf16(act1(g[1][2], up[1][2]), act1(g[1][3], up[1][3]));
                __builtin_nontemporal_store(w, (u32x4*)rowp); }
    }
};
template <class Epi, class Sched, bool ALIGN_EPI = false, bool SP2 = false>
__device__ __forceinline__ void gemm_phase(PG8_LAS unsigned char* lds, const Gemm g, const Sched& S, const Epi& E) {
    const int tid = threadIdx.x, wid = __builtin_amdgcn_readfirstlane(tid >> 6), lane = tid & 63, wr = wid >> 2, wc = wid & 3, fr = lane & 15, fq = lane >> 4;
    const int K = g.K, nt = K / BK;
    unsigned voffA[2], voffB[2];
#pragma unroll
    for (int i = 0; i < 2; ++i) { int R, C; stage_rc(tid * 16 + i * 8192, R, C); const int Rb = Epi::PERM ? ((R & ~31) + perm32(R & 31)) : R;
        voffA[i] = (unsigned)(R * K + C) * 2u; voffB[i] = (unsigned)(Rb * K + C) * 2u; }
    const size_t kstep = (size_t)(BK * 2);
    const size_t hstep = (size_t)HALF * K * 2;
    const size_t tstep = 2 * hstep;
    const unsigned ldsw = (unsigned)wid * 1024u;
    const int aoff = lds_byte(wr * 64 + fr, fq * 8), boff = lds_byte(wc * 32 + fr, fq * 8);
#define PG8_SA(b, h) (((b) * 2 + (h)) * HTB)
#define PG8_SB(b, h) ((4 + (b) * 2 + (h)) * HTB)
#define PG8_STAGE(bufoff, gbase, voff) do { _Pragma("unroll") for (int _i = 0; _i < 2; ++_i) \
        __builtin_amdgcn_global_load_lds((const unsigned*)((const char*)(gbase) + (voff)[_i]), (PG8_LAS unsigned*)(lds + (bufoff) + ldsw + _i * 8192), 16, 0, 0); } while (0)
#define PG8_LDA(dst, b, h) do { _Pragma("unroll") for (int m = 0; m < 4; ++m) _Pragma("unroll") for (int k = 0; k < 2; ++k) dst[m][k] = *(const PG8_LAS bf16x8*)(lds + PG8_SA(b, h) + aoff + m * 2048 + k * 1024); } while (0)
#define PG8_LDB(dst, b, h) do { _Pragma("unroll") for (int n = 0; n < 2; ++n) _Pragma("unroll") for (int k = 0; k < 2; ++k) dst[n][k] = *(const PG8_LAS bf16x8*)(lds + PG8_SB(b, h) + boff + n * 2048 + k * 1024); } while (0)
#define PG8_MMA(ai, bj, At, Bt) do { __builtin_amdgcn_s_setprio(1); _Pragma("unroll") for (int m = 0; m < 4; ++m) _Pragma("unroll") for (int n = 0; n < 2; ++n) _Pragma("unroll") for (int k = 0; k < 2; ++k) \
        acc[ai][bj][m][n] = __builtin_amdgcn_mfma_f32_16x16x32_bf16(Bt[n][k], At[m][k], acc[ai][bj][m][n], 0, 0, 0); __builtin_amdgcn_s_setprio(0); } while (0)
#define PG8_WAIT_V(n) asm volatile("s_waitcnt vmcnt(" #n ")" ::: "memory")
#define PG8_WAIT_L(n) asm volatile("s_waitcnt lgkmcnt(" #n ")" ::: "memory")
#define PG8_BAR __builtin_amdgcn_s_barrier()
#define PG8_SCHED __builtin_amdgcn_sched_barrier(0)
    Unit cur, nxt; int ui = 0;
    if (!S.next(0, cur)) return;
    f32x4 acc[2][2][4][2];
#pragma unroll
    for (int a = 0; a < 2; ++a)
#pragma unroll
        for (int b = 0; b < 2; ++b)
#pragma unroll
            for (int m = 0; m < 4; ++m)
#pragma unroll
                for (int n = 0; n < 2; ++n) acc[a][b][m][n] = (f32x4){0.f, 0.f, 0.f, 0.f};
    bf16x8 At[4][2], B0[2][2], B1[2][2];
    const char* cA = (const char*)g.A + (size_t)cur.pm * tstep; const char* cB = (const char*)g.Bt + (size_t)cur.pb * tstep;
    S.a_ready(cur);
    if constexpr (SP2) {
        PG8_STAGE(PG8_SB(0, 0), cB, voffB); PG8_STAGE(PG8_SB(0, 1), cB + hstep, voffB); PG8_STAGE(PG8_SA(0, 0), cA, voffA); PG8_STAGE(PG8_SA(0, 1), cA + hstep, voffA);
        if (wr == 1) PG8_BAR;
        PG8_WAIT_V(2); PG8_BAR;
        PG8_STAGE(PG8_SB(1, 0), cB + kstep, voffB); PG8_STAGE(PG8_SA(1, 0), cA + kstep, voffA); PG8_STAGE(PG8_SB(1, 1), cB + hstep + kstep, voffB);
        PG8_WAIT_V(6); PG8_BAR;
    } else {
        PG8_STAGE(PG8_SB(0, 0), cB, voffB); PG8_STAGE(PG8_SA(0, 0), cA, voffA); PG8_STAGE(PG8_SB(0, 1), cB + hstep, voffB); PG8_STAGE(PG8_SA(0, 1), cA + hstep, voffA);
        if (wr == 1) PG8_BAR;
        PG8_WAIT_V(4); PG8_BAR;
        PG8_STAGE(PG8_SB(1, 0), cB + kstep, voffB); PG8_STAGE(PG8_SA(1, 0), cA + kstep, voffA); PG8_STAGE(PG8_SB(1, 1), cB + hstep + kstep, voffB);
        PG8_WAIT_V(6); PG8_BAR;
    }
    for (;;) {
        const bool has_next = S.next(ui + 1, nxt);
        const char* nA = has_next ? (const char*)g.A + (size_t)nxt.pm * tstep : cA; const char* nB = has_next ? (const char*)g.Bt + (size_t)nxt.pb * tstep : cB;
        for (int t = 0; t < nt; t += 2) {
            const bool last = (t == nt - 2);
            const char* a1 = cA + (size_t)(t + 1) * kstep;
            const char* a2 = last ? nA : cA + (size_t)(t + 2) * kstep; const char* b2 = last ? nB : cB + (size_t)(t + 2) * kstep;
            const char* a3 = a2 + kstep; const char* b3 = b2 + kstep;
            if (last && has_next) S.a_ready(nxt);
            if constexpr (SP2) {
            PG8_LDB(B0, 0, 0); PG8_LDB(B1, 0, 1); PG8_SCHED; PG8_LDA(At, 0, 0); PG8_STAGE(PG8_SA(1, 1), a1 + hstep, voffA);
            PG8_WAIT_V(8); PG8_WAIT_L(0); PG8_BAR; PG8_MMA(0, 0, At, B0); PG8_MMA(0, 1, At, B1); PG8_BAR; PG8_SCHED;
            PG8_LDA(At, 0, 1); PG8_STAGE(PG8_SB(0, 0), b2, voffB); PG8_STAGE(PG8_SB(0, 1), b2 + hstep, voffB); PG8_STAGE(PG8_SA(0, 0), a2, voffA);
            PG8_WAIT_V(8); PG8_WAIT_L(0); PG8_BAR; PG8_MMA(1, 0, At, B0); PG8_MMA(1, 1, At, B1); PG8_BAR; PG8_SCHED;
            PG8_LDB(B0, 1, 0); PG8_LDB(B1, 1, 1); PG8_SCHED; PG8_LDA(At, 1, 0); PG8_STAGE(PG8_SA(0, 1), a2 + hstep, voffA);
            PG8_WAIT_V(8); PG8_WAIT_L(0); PG8_BAR; PG8_MMA(0, 0, At, B0); PG8_MMA(0, 1, At, B1); PG8_BAR; PG8_SCHED;
            PG8_LDA(At, 1, 1); PG8_STAGE(PG8_SB(1, 0), b3, voffB); PG8_STAGE(PG8_SB(1, 1), b3 + hstep, voffB); PG8_STAGE(PG8_SA(1, 0), a3, voffA);
            PG8_WAIT_V(8); PG8_WAIT_L(0); PG8_BAR; PG8_MMA(1, 0, At, B0); PG8_MMA(1, 1, At, B1); PG8_BAR; PG8_SCHED;
            } else {
            PG8_LDB(B0, 0, 0); PG8_SCHED; PG8_LDA(At, 0, 0); PG8_STAGE(PG8_SA(1, 1), a1 + hstep, voffA);
            PG8_WAIT_L(8); PG8_BAR; PG8_WAIT_L(0); PG8_MMA(0, 0, At, B0); PG8_BAR; PG8_SCHED;
            PG8_LDB(B1, 0, 1); PG8_STAGE(PG8_SB(0, 0), b2, voffB);
            PG8_BAR; PG8_WAIT_L(0); PG8_MMA(0, 1, At, B1); PG8_BAR;
            PG8_LDA(At, 0, 1); PG8_STAGE(PG8_SA(0, 0), a2, voffA);
            PG8_BAR; PG8_WAIT_L(0); PG8_MMA(1, 0, At, B0); PG8_BAR; PG8_SCHED;
            PG8_STAGE(PG8_SB(0, 1), b2 + hstep, voffB);
            PG8_WAIT_V(6); PG8_BAR; PG8_MMA(1, 1, At, B1); PG8_BAR;
            PG8_LDB(B0, 1, 0); PG8_SCHED; PG8_LDA(At, 1, 0); PG8_STAGE(PG8_SA(0, 1), a2 + hstep, voffA);
            PG8_WAIT_L(8); PG8_BAR; PG8_WAIT_L(0); PG8_MMA(0, 0, At, B0); PG8_BAR; PG8_SCHED;
            PG8_LDB(B1, 1, 1); PG8_STAGE(PG8_SB(1, 0), b3, voffB);
            PG8_BAR; PG8_WAIT_L(0); PG8_MMA(0, 1, At, B1); PG8_BAR;
            PG8_LDA(At, 1, 1); PG8_STAGE(PG8_SA(1, 0), a3, voffA);
            PG8_BAR; PG8_WAIT_L(0); PG8_MMA(1, 0, At, B0); PG8_BAR; PG8_SCHED;
            PG8_STAGE(PG8_SB(1, 1), b3 + hstep, voffB);
            PG8_WAIT_V(6); PG8_BAR; PG8_MMA(1, 1, At, B1); PG8_BAR;
            }
        }
        if constexpr (ALIGN_EPI) { if (wr == 0) PG8_BAR; }
        if constexpr (!Epi::AFTER_DRAIN) { E(acc, cur, wr, wc, fr, fq); S.done(cur); }
        if (!has_next) break;
#pragma unroll
        for (int a = 0; a < 2; ++a)
#pragma unroll
            for (int b = 0; b < 2; ++b)
#pragma unroll
                for (int m = 0; m < 4; ++m)
#pragma unroll
                    for (int n = 0; n < 2; ++n) acc[a][b][m][n] = (f32x4){0.f, 0.f, 0.f, 0.f};
        cur = nxt; cA = nA; cB = nB; ++ui;
        if constexpr (ALIGN_EPI) { if (wr == 1) PG8_BAR; }
    }
    PG8_WAIT_V(0);
    if constexpr (!ALIGN_EPI) { if (wr == 0) PG8_BAR; }
    PG8_BAR;
    if constexpr (Epi::AFTER_DRAIN) { E.fused(acc, cur, wr, wc, fr, fq, lds, wid, lane); S.done(cur); }
#undef PG8_SA
#undef PG8_SB
#undef PG8_STAGE
#undef PG8_LDA
#undef PG8_LDB
#undef PG8_MMA
#undef PG8_WAIT_V
#undef PG8_WAIT_L
#undef PG8_BAR
#undef PG8_SCHED
}
template <class Epi, class Sched, bool ALIGN_EPI = false, bool SP2 = false>
__device__ __forceinline__ void gemm_phase_i8(PG8_LAS unsigned char* lds, const Gemm g, const Sched& S, const Epi& E) {
    const int tid = threadIdx.x, wid = __builtin_amdgcn_readfirstlane(tid >> 6), lane = tid & 63, wr = wid >> 2, wc = wid & 3, fr = lane & 15, fq = lane >> 4;
    const int K = g.K, nt = K / 128;
    unsigned voffA[2], voffB[2];
#pragma unroll
    for (int i = 0; i < 2; ++i) { int R, C; stage_rc(tid * 16 + i * 8192, R, C); const int Rb = Epi::PERM ? ((R & ~31) + perm32(R & 31)) : R;
        voffA[i] = (unsigned)(R * K + C * 2); voffB[i] = (unsigned)(Rb * K + C * 2); }
    const size_t kstep = (size_t)(BK * 2);
    const size_t hstep = (size_t)HALF * K;
    const size_t tstep = 2 * hstep;
    const unsigned ldsw = (unsigned)wid * 1024u;
    const int aoff = lds_byte(wr * 64 + fr, fq * 8), boff = lds_byte(wc * 32 + fr, fq * 8);
#define PG8_SA(b, h) (((b) * 2 + (h)) * HTB)
#define PG8_SB(b, h) ((4 + (b) * 2 + (h)) * HTB)
#define PG8_STAGE(bufoff, gbase, voff) do { _Pragma("unroll") for (int _i = 0; _i < 2; ++_i) \
        __builtin_amdgcn_global_load_lds((const unsigned*)((const char*)(gbase) + (voff)[_i]), (PG8_LAS unsigned*)(lds + (bufoff) + ldsw + _i * 8192), 16, 0, 0); } while (0)
#define PG8_LDA(dst, b, h) do { _Pragma("unroll") for (int m = 0; m < 4; ++m) _Pragma("unroll") for (int k = 0; k < 2; ++k) dst[m][k] = *(const PG8_LAS bf16x8*)(lds + PG8_SA(b, h) + aoff + m * 2048 + k * 1024); } while (0)
#define PG8_LDB(dst, b, h) do { _Pragma("unroll") for (int n = 0; n < 2; ++n) _Pragma("unroll") for (int k = 0; k < 2; ++k) dst[n][k] = *(const PG8_LAS bf16x8*)(lds + PG8_SB(b, h) + boff + n * 2048 + k * 1024); } while (0)
#define PG8_MMA(ai, bj, At, Bt) do { __builtin_amdgcn_s_setprio(1); _Pragma("unroll") for (int m = 0; m < 4; ++m) _Pragma("unroll") for (int n = 0; n < 2; ++n) _Pragma("unroll") for (int k = 0; k < 2; ++k) \
        acc[ai][bj][m][n] = __builtin_amdgcn_mfma_i32_16x16x64_i8(__builtin_bit_cast(i32x4, Bt[n][k]), __builtin_bit_cast(i32x4, At[m][k]), acc[ai][bj][m][n], 0, 0, 0); __builtin_amdgcn_s_setprio(0); } while (0)
#define PG8_WAIT_V(n) asm volatile("s_waitcnt vmcnt(" #n ")" ::: "memory")
#define PG8_WAIT_L(n) asm volatile("s_waitcnt lgkmcnt(" #n ")" ::: "memory")
#define PG8_BAR __builtin_amdgcn_s_barrier()
#define PG8_SCHED __builtin_amdgcn_sched_barrier(0)
    Unit cur, nxt; int ui = 0;
    if (!S.next(0, cur)) return;
    i32x4 acc[2][2][4][2];
#pragma unroll
    for (int a = 0; a < 2; ++a)
#pragma unroll
        for (int b = 0; b < 2; ++b)
#pragma unroll
            for (int m = 0; m < 4; ++m)
#pragma unroll
                for (int n = 0; n < 2; ++n) acc[a][b][m][n] = (i32x4){0, 0, 0, 0};
    bf16x8 At[4][2], B0[2][2], B1[2][2];
    const char* cA = (const char*)g.A + (size_t)cur.pm * tstep; const char* cB = (const char*)g.Bt + (size_t)cur.pb * tstep;
    S.a_ready(cur);
    if constexpr (SP2) {
        PG8_STAGE(PG8_SB(0, 0), cB, voffB); PG8_STAGE(PG8_SB(0, 1), cB + hstep, voffB); PG8_STAGE(PG8_SA(0, 0), cA, voffA); PG8_STAGE(PG8_SA(0, 1), cA + hstep, voffA);
        if (wr == 1) PG8_BAR;
        PG8_WAIT_V(2); PG8_BAR;
        PG8_STAGE(PG8_SB(1, 0), cB + kstep, voffB); PG8_STAGE(PG8_SA(1, 0), cA + kstep, voffA); PG8_STAGE(PG8_SB(1, 1), cB + hstep + kstep, voffB);
        PG8_WAIT_V(6); PG8_BAR;
    } else {
        PG8_STAGE(PG8_SB(0, 0), cB, voffB); PG8_STAGE(PG8_SA(0, 0), cA, voffA); PG8_STAGE(PG8_SB(0, 1), cB + hstep, voffB); PG8_STAGE(PG8_SA(0, 1), cA + hstep, voffA);
        if (wr == 1) PG8_BAR;
        PG8_WAIT_V(4); PG8_BAR;
        PG8_STAGE(PG8_SB(1, 0), cB + kstep, voffB); PG8_STAGE(PG8_SA(1, 0), cA + kstep, voffA); PG8_STAGE(PG8_SB(1, 1), cB + hstep + kstep, voffB);
        PG8_WAIT_V(6); PG8_BAR;
    }
    for (;;) {
        const bool has_next = S.next(ui + 1, nxt);
        const char* nA = has_next ? (const char*)g.A + (size_t)nxt.pm * tstep : cA; const char* nB = has_next ? (const char*)g.Bt + (size_t)nxt.pb * tstep : cB;
        for (int t = 0; t < nt; t += 2) {
            const bool last = (t == nt - 2);
            const char* a1 = cA + (size_t)(t + 1) * kstep;
            const char* a2 = last ? nA : cA + (size_t)(t + 2) * kstep; const char* b2 = last ? nB : cB + (size_t)(t + 2) * kstep;
            const char* a3 = a2 + kstep; const char* b3 = b2 + kstep;
            if (last && has_next) S.a_ready(nxt);
            if constexpr (SP2) {
            PG8_LDB(B0, 0, 0); PG8_LDB(B1, 0, 1); PG8_SCHED; PG8_LDA(At, 0, 0); PG8_STAGE(PG8_SA(1, 1), a1 + hstep, voffA);
            PG8_WAIT_V(8); PG8_WAIT_L(0); PG8_BAR; PG8_MMA(0, 0, At, B0); PG8_MMA(0, 1, At, B1); PG8_BAR; PG8_SCHED;
            PG8_LDA(At, 0, 1); PG8_STAGE(PG8_SB(0, 0), b2, voffB); PG8_STAGE(PG8_SB(0, 1), b2 + hstep, voffB); PG8_STAGE(PG8_SA(0, 0), a2, voffA);
            PG8_WAIT_V(8); PG8_WAIT_L(0); PG8_BAR; PG8_MMA(1, 0, At, B0); PG8_MMA(1, 1, At, B1); PG8_BAR; PG8_SCHED;
            PG8_LDB(B0, 1, 0); PG8_LDB(B1, 1, 1); PG8_SCHED; PG8_LDA(At, 1, 0); PG8_STAGE(PG8_SA(0, 1), a2 + hstep, voffA);
            PG8_WAIT_V(8); PG8_WAIT_L(0); PG8_BAR; PG8_MMA(0, 0, At, B0); PG8_MMA(0, 1, At, B1); PG8_BAR; PG8_SCHED;
            PG8_LDA(At, 1, 1); PG8_STAGE(PG8_SB(1, 0), b3, voffB); PG8_STAGE(PG8_SB(1, 1), b3 + hstep, voffB); PG8_STAGE(PG8_SA(1, 0), a3, voffA);
            PG8_WAIT_V(8); PG8_WAIT_L(0); PG8_BAR; PG8_MMA(1, 0, At, B0); PG8_MMA(1, 1, At, B1); PG8_BAR; PG8_SCHED;
            } else {
            PG8_LDB(B0, 0, 0); PG8_SCHED; PG8_LDA(At, 0, 0); PG8_STAGE(PG8_SA(1, 1), a1 + hstep, voffA);
            PG8_WAIT_L(8); PG8_BAR; PG8_WAIT_L(0); PG8_MMA(0, 0, At, B0); PG8_BAR; PG8_SCHED;
            PG8_LDB(B1, 0, 1); PG8_STAGE(PG8_SB(0, 0), b2, voffB);
            PG8_BAR; PG8_WAIT_L(0); PG8_MMA(0, 1, At, B1); PG8_BAR;
            PG8_LDA(At, 0, 1); PG8_STAGE(PG8_SA(0, 0), a2, voffA);
            PG8_BAR; PG8_WAIT_L(0); PG8_MMA(1, 0, At, B0); PG8_BAR; PG8_SCHED;
            PG8_STAGE(PG8_SB(0, 1), b2 + hstep, voffB);
            PG8_WAIT_V(6); PG8_BAR; PG8_MMA(1, 1, At, B1); PG8_BAR;
            PG8_LDB(B0, 1, 0); PG8_SCHED; PG8_LDA(At, 1, 0); PG8_STAGE(PG8_SA(0, 1), a2 + hstep, voffA);
            PG8_WAIT_L(8); PG8_BAR; PG8_WAIT_L(0); PG8_MMA(0, 0, At, B0); PG8_BAR; PG8_SCHED;
            PG8_LDB(B1, 1, 1); PG8_STAGE(PG8_SB(1, 0), b3, voffB);
            PG8_BAR; PG8_WAIT_L(0); PG8_MMA(0, 1, At, B1); PG8_BAR;
            PG8_LDA(At, 1, 1); PG8_STAGE(PG8_SA(1, 0), a3, voffA);
            PG8_BAR; PG8_WAIT_L(0); PG8_MMA(1, 0, At, B0); PG8_BAR; PG8_SCHED;
            PG8_STAGE(PG8_SB(1, 1), b3 + hstep, voffB);
            PG8_WAIT_V(6); PG8_BAR; PG8_MMA(1, 1, At, B1); PG8_BAR;
            }
        }
        if constexpr (ALIGN_EPI) { if (wr == 0) PG8_BAR; }
        if constexpr (!Epi::AFTER_DRAIN) { E(acc, cur, wr, wc, fr, fq); S.done(cur); }
        if (!has_next) break;
#pragma unroll
        for (int a = 0; a < 2; ++a)
#pragma unroll
            for (int b = 0; b < 2; ++b)
#pragma unroll
                for (int m = 0; m < 4; ++m)
#pragma unroll
                    for (int n = 0; n < 2; ++n) acc[a][b][m][n] = (i32x4){0, 0, 0, 0};
        cur = nxt; cA = nA; cB = nB; ++ui;
        if constexpr (ALIGN_EPI) { if (wr == 1) PG8_BAR; }
    }
    PG8_WAIT_V(0);
    if constexpr (!ALIGN_EPI) { if (wr == 0) PG8_BAR; }
    PG8_BAR;
    if constexpr (Epi::AFTER_DRAIN) { E.fused(acc, cur, wr, wc, fr, fq, lds, wid, lane); S.done(cur); }
#undef PG8_SA
#undef PG8_SB
#undef PG8_STAGE
#undef PG8_LDA
#undef PG8_LDB
#undef PG8_MMA
#undef PG8_WAIT_V
#undef PG8_WAIT_L
#undef PG8_BAR
#undef PG8_SCHED
}

}
#ifndef STAGE_REP
#define STAGE_REP 0
#endif

constexpr int NWAVES = 8;
constexpr int D = 1024, BATCH = 2, T = 8192, TC = 256, NH = 16;
constexpr int ML = BATCH * T;
constexpr int MC = BATCH * TC;
constexpr int MT = ML + MC;
constexpr int N_IN = 8576, NZ = 8704;
constexpr int K_OFF = 0, V_OFF = 1024, DECAY_OFF = 2048, ICLR_OFF = 2176, STATE_COLS = 2304, R_OFF = 2304, GLORA_OFF = 3328, SHIFT_COLS = 3456;
constexpr int CONV_OFF = 3456, GATE_OFF = 6528;
constexpr int NE = 32, TOPK = 4, DFF = 1024;
constexpr int NL = 5120, KL = 384;
constexpr int MAXBLK = 288;
constexpr int NROWS = MAXBLK * 256;
constexpr int KSPLIT = 16;

constexpr size_t MiB = 1u << 20;
constexpr size_t WS_CTL = 0, CTL_ZERO_BYTES = 1 * MiB;
constexpr size_t WS_MODP = 1 * MiB;
constexpr size_t WS_WLORA = 3 * MiB;
constexpr size_t WS_WROUT = 7 * MiB;
constexpr size_t WS_WOUT = 8 * MiB;
constexpr size_t WS_WIN = 10 * MiB;
constexpr size_t WS_A0 = 28 * MiB;
constexpr size_t WS_MISC = 61 * MiB;
constexpr size_t WS_Z = 64 * MiB;
constexpr size_t WS_AL = 345 * MiB;
constexpr size_t WS_LORA = 358 * MiB;
constexpr size_t WS_SCAN = 523 * MiB;
constexpr size_t WS_Y = 886 * MiB;
constexpr size_t WS_END = 1014 * MiB;
constexpr size_t WS_PQ = WS_SCAN;
constexpr size_t WS_TKN = WS_PQ + 132 * MiB;
constexpr size_t WS_UPRE = WS_TKN + 66 * MiB;
constexpr size_t WS_H0T = WS_UPRE + 66 * MiB;
static_assert(WS_H0T + 64 * MiB <= WS_Y, "scan region");
constexpr size_t WS_MIX = WS_LORA, WS_X1 = WS_LORA + 64 * MiB, WS_H2 = WS_LORA + 128 * MiB;
constexpr size_t WS_LOGIT = WS_SCAN, WS_XB = WS_SCAN + 16 * MiB, WS_ACT = WS_XB + 144 * MiB;
constexpr size_t WS_Y2 = WS_Z, WS_WEIN = WS_Y, WS_WEOUT = WS_Y + 64 * MiB;
static_assert(WS_ACT + 144 * MiB <= WS_Y && WS_WEIN + 64 * MiB <= WS_WEOUT && WS_WEOUT + 64 * MiB <= WS_END, "late regions");
constexpr size_t MI_SELE = WS_MISC, MI_SELP = MI_SELE + (size_t)ML * 4 * 4, MI_GATE = MI_SELP + (size_t)ML * 4 * 4, MI_DEST = MI_GATE + (size_t)ML * 4 * 4, MI_BLKE = MI_DEST + (size_t)ML * 4 * 4;
constexpr size_t MI_RSH = MI_BLKE + 4096;
constexpr size_t MI_CSWIN = MI_RSH + (size_t)MT * 4;
constexpr size_t MI_RSH2 = MI_CSWIN + (size_t)NZ * 4;
constexpr size_t MI_RSXB = MI_RSH2 + (size_t)ML * 4;
constexpr size_t MI_CSWEI = MI_RSXB + (size_t)NROWS * 4;
static_assert(MI_CSWEI + (size_t)NE * 2048 * 4 <= WS_Z && MI_RSH % 16 == 0 && MI_CSWIN % 16 == 0 && MI_CSWEI % 16 == 0, "misc");
constexpr size_t WS_H2Q = WS_A0;
constexpr int CW_BAR = 4096;
constexpr int CW_CNT = 16384;
constexpr int CW_FB = 8192;
constexpr int CW_Q6 = CW_CNT + 64 * 40;

constexpr int RING_OFF = 0, RING_BYTES = 131072;
constexpr int LDSCTL_OFF = 147456, MISC_OFF = LDSCTL_OFF + 320;
constexpr int LDS_X_OFF = LDSCTL_OFF + 512;
constexpr int LDS_BYTES = 163840;

#define GAS __attribute__((address_space(1)))
#define LAS __attribute__((address_space(3)))
typedef unsigned short bf16;
typedef unsigned v4u __attribute__((ext_vector_type(4)));
typedef unsigned v2u __attribute__((ext_vector_type(2)));
typedef float f32x4 __attribute__((ext_vector_type(4)));
#define LDS_WAIT() asm volatile("s_waitcnt lgkmcnt(0)" ::: "memory")
#define VM_WAIT() asm volatile("s_waitcnt vmcnt(0)" ::: "memory")
__device__ __forceinline__ unsigned f2bf(float f) { unsigned u = __builtin_bit_cast(unsigned, f); return (u + 0x7fffu + ((u >> 16) & 1u)) >> 16; }
__device__ __forceinline__ unsigned pk2(float lo, float hi) { return f2bf(lo) | (f2bf(hi) << 16); }
__device__ __forceinline__ float bflo(unsigned w) { return __builtin_bit_cast(float, w << 16); }
__device__ __forceinline__ float bfhi(unsigned w) { return __builtin_bit_cast(float, w & 0xffff0000u); }
__device__ __forceinline__ float bf1(bf16 h) { return __builtin_bit_cast(float, (unsigned)h << 16); }
__device__ __forceinline__ void ld16bf(const bf16* p, float (&o)[16]) {
    const v4u a = *(const v4u*)p, b = *(const v4u*)(p + 8);
    o[0] = bflo(a.x); o[1] = bfhi(a.x); o[2] = bflo(a.y); o[3] = bfhi(a.y); o[4] = bflo(a.z); o[5] = bfhi(a.z); o[6] = bflo(a.w); o[7] = bfhi(a.w);
    o[8] = bflo(b.x); o[9] = bfhi(b.x); o[10] = bflo(b.y); o[11] = bfhi(b.y); o[12] = bflo(b.z); o[13] = bfhi(b.z); o[14] = bflo(b.w); o[15] = bfhi(b.w);
}
__device__ __forceinline__ void st16bf(bf16* p, const float (&o)[16]) {
    v4u a, b; a.x = pk2(o[0], o[1]); a.y = pk2(o[2], o[3]); a.z = pk2(o[4], o[5]); a.w = pk2(o[6], o[7]);
    b.x = pk2(o[8], o[9]); b.y = pk2(o[10], o[11]); b.z = pk2(o[12], o[13]); b.w = pk2(o[14], o[15]);
    *(v4u*)p = a; *(v4u*)(p + 8) = b;
}
__device__ __forceinline__ void ld16f(const float* p, float (&o)[16]) {
#pragma unroll
    for (int q = 0; q < 4; ++q) { const f32x4 v = *(const f32x4*)(p + 4 * q); o[4 * q] = v.x; o[4 * q + 1] = v.y; o[4 * q + 2] = v.z; o[4 * q + 3] = v.w; }
}
__device__ __forceinline__ void ld16f_lds(const LAS float* p, float (&o)[16]) {
#pragma unroll
    for (int q = 0; q < 4; ++q) { const f32x4 v = *(const LAS f32x4*)(p + 4 * q); o[4 * q] = v.x; o[4 * q + 1] = v.y; o[4 * q + 2] = v.z; o[4 * q + 3] = v.w; }
}
__device__ __forceinline__ void st16f(float* p, const float (&o)[16]) {
#pragma unroll
    for (int q = 0; q < 4; ++q) *(f32x4*)(p + 4 * q) = (f32x4){o[4 * q], o[4 * q + 1], o[4 * q + 2], o[4 * q + 3]};
}
__device__ __forceinline__ float sigmoidf_(float x) { return 1.0f / (1.0f + __expf(-x)); }
__device__ __forceinline__ float wave_sum(float v) {
#pragma unroll
    for (int o = 1; o < 64; o <<= 1) v += __shfl_xor(v, o);
    return v;
}
__device__ __forceinline__ float wave_max(float v) {
#pragma unroll
    for (int o = 1; o < 64; o <<= 1) v = fmaxf(v, __shfl_xor(v, o));
    return v;
}
__device__ __forceinline__ unsigned pack_q4(float a, float b, float c, float d) {
    const int qa = __float2int_rn(a), qb = __float2int_rn(b), qc = __float2int_rn(c), qd = __float2int_rn(d);
    return (unsigned)(qa & 255) | ((unsigned)(qb & 255) << 8) | ((unsigned)(qc & 255) << 16) | ((unsigned)qd << 24);
}
__device__ __forceinline__ float quad_sum(float v) { v += __shfl_xor(v, 1); v += __shfl_xor(v, 2); return v; }

#define XB_TMO      128
#define XB_XCNT(j)  (256  + 64 * (j))
#define XB_XSUB(j)  (1280 + 64 * (j))
#define XB_XGEN(j)  (2304 + 64 * (j))
#define XB_TOP      3328
#define XB_TOPGEN   3392
#define XCD_BAR_WORDS 3456
#define XB_SPIN_CAP (1u << 18)

__device__ __forceinline__ unsigned xb_ld(unsigned* p)              { return __hip_atomic_load(p, __ATOMIC_RELAXED, __HIP_MEMORY_SCOPE_AGENT); }
__device__ __forceinline__ unsigned xb_add(unsigned* p, unsigned v) { return __hip_atomic_fetch_add(p, v, __ATOMIC_RELAXED, __HIP_MEMORY_SCOPE_AGENT); }
__device__ __forceinline__ unsigned xb_xcc_id() { return (unsigned)__builtin_amdgcn_s_getreg((3 << 11) | 20) & 0xFu; }
#define XB_SPIN(cond, bar) do { unsigned _sp = 0; while (cond) { __builtin_amdgcn_s_sleep(1); \
    if ((++_sp & 255u) == 0u) { if (xb_ld(&(bar)[XB_TMO])) break; if (_sp > XB_SPIN_CAP) { atomicAdd(&(bar)[XB_TMO], 1u); break; } } } } while (0)

struct XcdBarrier { unsigned* bar; unsigned x; volatile LAS unsigned* st; };

__device__ __forceinline__ XcdBarrier xcd_barrier_post(unsigned* bar, volatile LAS unsigned* st) {
    XcdBarrier b; b.bar = bar; b.x = xb_xcc_id(); b.st = st;
    if (threadIdx.x == 0) (void)xb_add(&bar[XB_XCNT(b.x)], 1u);
    return b;
}
__device__ __forceinline__ void xcd_barrier_complete(unsigned* bar, unsigned x, unsigned& nloc, unsigned& nx) {
    const unsigned G = gridDim.x * gridDim.y * gridDim.z;
    unsigned sum, cnt, mine, sp = 0u;
    for (;;) {
        sum = 0u; cnt = 0u; mine = 0u;
#pragma unroll
        for (unsigned j = 0; j < 16; ++j) { const unsigned c = xb_ld(&bar[XB_XCNT(j)]); sum += c; cnt += (c > 0u) ? 1u : 0u; mine = (j == x) ? c : mine; }
        if (sum == G) break;
        __builtin_amdgcn_s_sleep(1);
        if ((++sp & 255u) == 0u) { if (xb_ld(&bar[XB_TMO])) break; if (sp > XB_SPIN_CAP) { atomicAdd(&bar[XB_TMO], 1u); break; } }
    }
    nloc = mine > 0u ? mine : 1u; nx = cnt > 0u ? cnt : 1u;
}
__device__ __forceinline__ void xcd_barrier(const XcdBarrier& b) {
    asm volatile("s_waitcnt vmcnt(0)" ::: "memory");
    __syncthreads();
    if (threadIdx.x == 0) {
        unsigned* bar = b.bar;
        __builtin_amdgcn_s_waitcnt(0);
        unsigned nloc = b.st[0], nx = b.st[1];
        if (nloc == 0u) { xcd_barrier_complete(bar, b.x, nloc, nx); b.st[0] = nloc; b.st[1] = nx; }
        const unsigned old = xb_add(&bar[XB_XSUB(b.x)], 1u);
        const unsigned gen = old / nloc;
        if (old + 1u == (gen + 1u) * nloc) {
            __builtin_amdgcn_fence(__ATOMIC_RELEASE, "agent");
            asm volatile("s_waitcnt vmcnt(0)" ::: "memory");
            const unsigned og = xb_add(&bar[XB_TOP], 1u);
            const unsigned tg = og / nx;
            if (og + 1u == (tg + 1u) * nx) xb_add(&bar[XB_TOPGEN], 1u);
            else XB_SPIN(xb_ld(&bar[XB_TOPGEN]) == tg, bar);
            __builtin_amdgcn_fence(__ATOMIC_ACQUIRE, "agent");
            xb_add(&bar[XB_XGEN(b.x)], 1u);
            asm volatile("s_waitcnt vmcnt(0)" ::: "memory");
        } else {
            XB_SPIN(xb_ld(&bar[XB_XGEN(b.x)]) == gen, bar);
            __builtin_amdgcn_fence(__ATOMIC_ACQUIRE, "agent");
            asm volatile("s_waitcnt vmcnt(0)" ::: "memory");
        }
    }
    __syncthreads();
}

#define XB_DONE(j)  (3456 + 64 * (j))
__device__ __forceinline__ void xcd_barrier2(const XcdBarrier& b) {
    asm volatile("s_waitcnt vmcnt(0)" ::: "memory");
    __syncthreads();
    if (threadIdx.x == 0) {
        unsigned* bar = b.bar;
        __builtin_amdgcn_s_waitcnt(0);
        unsigned nloc = b.st[0], nx = b.st[1];
        if (nloc == 0u) { xcd_barrier_complete(bar, b.x, nloc, nx); b.st[0] = nloc; b.st[1] = nx; }
        const unsigned old = xb_add(&bar[XB_XSUB(b.x)], 1u);
        const unsigned gen = old / nloc;
        if (old + 1u == (gen + 1u) * nloc) {
            __builtin_amdgcn_fence(__ATOMIC_RELEASE, "agent");
            asm volatile("s_waitcnt vmcnt(0)" ::: "memory");
#pragma unroll
            for (unsigned j = 0; j < 16; ++j) (void)xb_add(&bar[XB_DONE(j)], 1u);
        }
        XB_SPIN(xb_ld(&bar[XB_DONE(b.x)]) < (gen + 1u) * nx, bar);
        __builtin_amdgcn_fence(__ATOMIC_ACQUIRE, "agent");
        asm volatile("s_waitcnt vmcnt(0)" ::: "memory");
    }
    __syncthreads();
}

#define FB_WORD(j) (64 * (j))
#define FB_TMO 640
__device__ __forceinline__ void flat_barrier(unsigned* fb, unsigned epoch) {
    asm volatile("s_waitcnt vmcnt(0)" ::: "memory");
    __syncthreads();
    if (threadIdx.x == 0) {
        __builtin_amdgcn_s_waitcnt(0);
        __builtin_amdgcn_fence(__ATOMIC_RELEASE, "agent");
        asm volatile("s_waitcnt vmcnt(0)" ::: "memory");
        (void)xb_add(&fb[FB_WORD(blockIdx.x & 7u)], 1u);
        const unsigned want = epoch * gridDim.x; unsigned sp = 0u;
        for (;;) {
            unsigned s = 0u;
#pragma unroll
            for (int j = 0; j < 8; ++j) s += xb_ld(&fb[FB_WORD(j)]);
            if (s >= want) break;
            __builtin_amdgcn_s_sleep(1);
            if ((++sp & 255u) == 0u) { if (xb_ld(&fb[FB_TMO])) break; if (sp > XB_SPIN_CAP) { atomicAdd(&fb[FB_TMO], 1u); break; } }
        }
        __builtin_amdgcn_fence(__ATOMIC_ACQUIRE, "agent");
        asm volatile("s_waitcnt vmcnt(0)" ::: "memory");
    }
    __syncthreads();
}

struct Frame {
    LAS unsigned char* lds;
    volatile LAS unsigned* MISC;
    unsigned* ctl;
    int tid, lane, wave, G, gw, NGW;
    float* out;
    unsigned char* ws;
};
enum { I_X = 0, I_C, I_CTX, I_CCTX, I_WADA, I_BADA, I_NPM, I_NQM, I_NPF, I_NQF, I_WIN, I_MU, I_W0, I_WDU, I_A0, I_WIU, I_KK, I_KA, I_RK, I_WGU, I_LNW, I_LNB, I_CONVW,
       I_WOUT, I_WR, I_BR, I_WEI, I_BEI, I_WEO, I_BEO };


typedef const float* fptr_t;
__device__ __forceinline__ fptr_t kin_ptr(int i) { const volatile __attribute__((address_space(4))) fptr_t* ka = (const volatile __attribute__((address_space(4))) fptr_t*)__builtin_amdgcn_kernarg_segment_ptr(); return ka[i]; }
#define KIN(i) kin_ptr(i)
__device__ __forceinline__ void transpose_item(const float* W, int N, int k0, int n0, bf16* WT, int ldk, int rowbase, LAS float* scr, int lane) {
#pragma unroll 8
    for (int i = 0; i < 32; ++i) { const int kk = 2 * i + (lane >> 5); scr[kk * 33 + (lane & 31)] = W[(size_t)(k0 + kk) * N + n0 + (lane & 31)]; }
    LDS_WAIT(); asm volatile("" ::: "memory");
    const int c = lane & 7;
#pragma unroll
    for (int j = 0; j < 4; ++j) { const int n = (lane >> 3) + 8 * j; const LAS float* s = scr + (8 * c) * 33 + n;
        v4u o; o.x = pk2(s[0 * 33], s[1 * 33]); o.y = pk2(s[2 * 33], s[3 * 33]); o.z = pk2(s[4 * 33], s[5 * 33]); o.w = pk2(s[6 * 33], s[7 * 33]);
        *(v4u*)(WT + (size_t)(rowbase + n) * ldk + k0 + 8 * c) = o; }
    LDS_WAIT(); asm volatile("" ::: "memory");
}

__device__ __forceinline__ unsigned pack_q4c(float a, float b, float c, float d) {
    const int qa = __float2int_rn(fminf(fmaxf(a, -127.f), 127.f)), qb = __float2int_rn(fminf(fmaxf(b, -127.f), 127.f)), qc = __float2int_rn(fminf(fmaxf(c, -127.f), 127.f)), qd = __float2int_rn(fminf(fmaxf(d, -127.f), 127.f));
    return (unsigned)(qa & 255) | ((unsigned)(qb & 255) << 8) | ((unsigned)(qc & 255) << 16) | ((unsigned)qd << 24);
}
__device__ __forceinline__ void q8_item(const float* W, int N, int n0, signed char* WT, float* cs, int rowbase, LAS float* scr, int lane, int kb0 = 0, int kb1 = 16) {
    const int r8 = lane >> 3, c4 = lane & 7;
    const float* p0 = W + (size_t)r8 * N + n0 + 4 * c4;
    f32x4 ss = {0.f, 0.f, 0.f, 0.f};
#pragma unroll 8
    for (int i = 0; i < 32; ++i) { const f32x4 v = *(const f32x4*)(p0 + (size_t)(8 * i) * N); ss += v * v; }
#pragma unroll
    for (int o = 8; o < 64; o <<= 1) { ss.x += __shfl_xor(ss.x, o); ss.y += __shfl_xor(ss.y, o); ss.z += __shfl_xor(ss.z, o); ss.w += __shfl_xor(ss.w, o); }
    if (lane < 8) {
#pragma unroll
        for (int q = 0; q < 4; ++q) { const float m = 6.0f * sqrtf(ss[q] * (1.0f / 256.0f)); cs[rowbase + 4 * lane + q] = m * (1.0f / 127.0f); scr[2112 + 4 * lane + q] = m > 0.f ? 127.0f / m : 0.f; } }
    LDS_WAIT(); asm volatile("" ::: "memory");
    f32x4 cur[8];
#pragma unroll
    for (int i = 0; i < 8; ++i) cur[i] = *(const f32x4*)(p0 + (size_t)(64 * kb0 + 8 * i) * N);
    for (int kb = kb0; kb < kb1; ++kb) {
        f32x4 nxt[8];
        const int kn = kb < kb1 - 1 ? kb + 1 : kb;
#pragma unroll
        for (int i = 0; i < 8; ++i) nxt[i] = *(const f32x4*)(p0 + (size_t)(64 * kn + 8 * i) * N);
#pragma unroll
        for (int i = 0; i < 8; ++i) { LAS float* s = scr + (r8 + 8 * i) * 33 + 4 * c4; s[0] = cur[i].x; s[1] = cur[i].y; s[2] = cur[i].z; s[3] = cur[i].w; }
        LDS_WAIT(); asm volatile("" ::: "memory");
        const int c = lane & 3;
#pragma unroll
        for (int j = 0; j < 2; ++j) { const int n = (lane >> 2) + 16 * j; const float iv = scr[2112 + n]; const LAS float* s = scr + (16 * c) * 33 + n;
            v4u o; o.x = pack_q4c(s[0] * iv, s[33] * iv, s[66] * iv, s[99] * iv); o.y = pack_q4c(s[132] * iv, s[165] * iv, s[198] * iv, s[231] * iv);
            o.z = pack_q4c(s[264] * iv, s[297] * iv, s[330] * iv, s[363] * iv); o.w = pack_q4c(s[396] * iv, s[429] * iv, s[462] * iv, s[495] * iv);
            *(v4u*)(WT + (size_t)(rowbase + n) * 1024 + 64 * kb + 16 * c) = o; }
        LDS_WAIT(); asm volatile("" ::: "memory");
#pragma unroll
        for (int i = 0; i < 8; ++i) cur[i] = nxt[i];
    }
}

__device__ __forceinline__ float mod_val(const float* modp, const float* b_ada, int vec, int j) {
    float s = b_ada[j];
#pragma unroll
    for (int ks = 0; ks < KSPLIT; ++ks) s += modp[((size_t)ks * 3 + vec) * 6144 + j];
    return s;
}
__device__ __forceinline__ int nbr_row(int row, int j) {
    if (row < ML) { const int t = row & (T - 1), gc = t & 63, gr = t >> 6;
        if (j == 0) return gc > 0 ? row - 1 : -1; if (j == 1) return gc < 63 ? row + 1 : -1; if (j == 2) return gr > 0 ? row - 64 : -1; return gr < 127 ? row + 64 : -1; }
    const int tc = (row - ML) & (TC - 1);
    if ((j & 1) == 0) return tc > 0 ? row - 1 : -1; return tc < TC - 1 ? row + 1 : -1;
}
__device__ __forceinline__ void load_shift16(const bf16* z, int row, int col0, const LAS float* mu, float (&out)[16]) {
    float s[16]; ld16bf(z + (size_t)row * NZ + col0, s);
    float m[16]; ld16f_lds(mu, m);
#pragma unroll
    for (int j = 0; j < 4; ++j) {
        const int nr = nbr_row(row, j); float t[16];
        if (nr >= 0) ld16bf(z + (size_t)nr * NZ + col0, t); else {
#pragma unroll
            for (int i = 0; i < 16; ++i) t[i] = 0.f; }
#pragma unroll
        for (int i = j; i < 16; i += 4) out[i] = s[i] + m[i] * (t[i] - s[i]);
    }
}

__device__ __forceinline__ void phase_prologue(Frame& F) {
    LAS float* scr = (LAS float*)(F.lds + RING_OFF + F.wave * 16384);
    LAS float* sil = (LAS float*)(F.lds + LDS_X_OFF);
    for (int i = F.tid; i < 3 * D; i += NWAVES * 64) { const int v = i / D, j = i % D; const float c = v < 2 ? KIN(I_C)[v * D + j] : KIN(I_CCTX)[j]; sil[i] = c / (1.0f + __expf(-c)); }
    __syncthreads();
    bf16* WoutT = (bf16*)(F.ws + WS_WOUT);
    constexpr int IT_WIN = (N_IN / 32) * 4, IT_WOUT = (D / 64) * (D / 32), IT_ADA = 24 * KSPLIT;
    constexpr int NITEMS = IT_ADA + IT_WIN + IT_WOUT;
    float* modp = (float*)(F.ws + WS_MODP);
    for (int it = F.gw; it < NITEMS; it += F.NGW) {
        int r = it;
        if (r < IT_ADA) {
            const int cc = r % 24, ks = r / 24, col = cc * 256 + F.lane * 4;
            f32x4 a0 = {0.f, 0.f, 0.f, 0.f}, a1 = a0, a2 = a0;
            const float* wp = KIN(I_WADA) + (size_t)(ks * 64) * 6144 + col;
#pragma unroll 8
            for (int k = 0; k < 64; ++k) { const f32x4 w = *(const f32x4*)(wp + (size_t)k * 6144); const int kk = ks * 64 + k;
                a0 += w * sil[kk]; a1 += w * sil[D + kk]; a2 += w * sil[2 * D + kk]; }
            *(f32x4*)(modp + ((size_t)ks * 3 + 0) * 6144 + col) = a0; *(f32x4*)(modp + ((size_t)ks * 3 + 1) * 6144 + col) = a1; *(f32x4*)(modp + ((size_t)ks * 3 + 2) * 6144 + col) = a2;
            continue; }
        r -= IT_ADA;
        if (r < IT_WIN) { const int st = r >> 2, qq = r & 3; q8_item(KIN(I_WIN), N_IN, 32 * st, (signed char*)(F.ws + WS_WIN), (float*)(F.ws + MI_CSWIN), 32 * st, scr, F.lane, 4 * qq, 4 * qq + 4); continue; }
        r -= IT_WIN;
        { const int nb = D / 32, kb = r / nb, n0 = 32 * (r % nb); transpose_item(KIN(I_WOUT), D, 64 * kb, n0, WoutT, D, n0, scr, F.lane); }
    }
    const int gt = blockIdx.x * (NWAVES * 64) + F.tid, NGT = F.G * NWAVES * 64;
    for (int i = gt; i < (NZ - N_IN) * D / 16; i += NGT) *(v4u*)(F.ws + WS_WIN + (size_t)N_IN * D + (size_t)i * 16) = (v4u){0u, 0u, 0u, 0u};
    for (int i = gt; i < NZ - N_IN; i += NGT) ((float*)(F.ws + MI_CSWIN))[N_IN + i] = 0.f;
    bf16* WL = (bf16*)(F.ws + WS_WLORA);
    for (int i = gt; i < NL * (KL / 8); i += NGT) {
        const int c8 = i / NL, row = i % NL, blk = row >> 10, n = row & 1023, col = c8 * 8, g = col >> 6;
        const float* src = nullptr; int kofs = 0;
        if (blk < 2) { if (g == blk) { src = KIN(I_WDU) + (size_t)blk * 64 * D; kofs = col - 64 * blk; } }
        else if (blk < 4) { if (g == blk) { src = KIN(I_WIU) + (size_t)(blk - 2) * 64 * D; kofs = col - 64 * blk; } }
        else { if (g >= 4) { src = KIN(I_WGU); kofs = col - 256; } }
        v4u o = {0u, 0u, 0u, 0u};
        if (src) { float v[8];
#pragma unroll
            for (int q = 0; q < 8; ++q) v[q] = src[(size_t)(kofs + q) * D + n];
            o.x = pk2(v[0], v[1]); o.y = pk2(v[2], v[3]); o.z = pk2(v[4], v[5]); o.w = pk2(v[6], v[7]); }
        *(v4u*)(WL + (size_t)row * KL + col) = o;
    }
    bf16* WR = (bf16*)(F.ws + WS_WROUT);
    for (int i = gt; i < 256 * (D / 8); i += NGT) {
        const int row = i % 256, c8 = i / 256; v4u o = {0u, 0u, 0u, 0u};
        if (row < NE) { float v[8];
#pragma unroll
            for (int q = 0; q < 8; ++q) v[q] = KIN(I_WR)[(size_t)(c8 * 8 + q) * NE + row];
            o.x = pk2(v[0], v[1]); o.y = pk2(v[2], v[3]); o.z = pk2(v[4], v[5]); o.w = pk2(v[6], v[7]); }
        *(v4u*)(WR + (size_t)row * D + c8 * 8) = o;
    }
}

__device__ __forceinline__ void phase_hrows(Frame& F) {
    LAS float* LA = (LAS float*)(F.lds);
    LAS float* LB = LA + 3 * D;
    const float* modp = (const float*)(F.ws + WS_MODP);
    for (int i = F.tid; i < 3 * D; i += NWAVES * 64) { const int v = i / D, j = i % D;
        LA[i] = KIN(I_NPM)[j] * (1.0f + mod_val(modp, KIN(I_BADA), v, 1024 + j)); LB[i] = mod_val(modp, KIN(I_BADA), v, j); }
    __syncthreads();
    signed char* A0q = (signed char*)(F.ws + WS_A0);
    for (int row = F.gw; row < MT; row += F.NGW) {
        const float* xr; int vec;
        if (row < ML) { xr = KIN(I_X) + (size_t)row * D; vec = row >> 13; } else { xr = KIN(I_CTX) + (size_t)(row - ML) * D; vec = 2; }
        f32x4 v[4]; float s = 0.f;
#pragma unroll
        for (int j = 0; j < 4; ++j) { v[j] = *(const f32x4*)(xr + 4 * F.lane + 256 * j); s += (v[j].x * v[j].x + v[j].y * v[j].y) + (v[j].z * v[j].z + v[j].w * v[j].w); }
        const float rstd = 1.0f / sqrtf(wave_sum(s) * (1.0f / D) + 1e-6f);
        f32x4 hq[4]; float mx = 0.f;
#pragma unroll
        for (int j = 0; j < 4; ++j) { const int c = 4 * F.lane + 256 * j; const f32x4 a = *(const LAS f32x4*)(LA + vec * D + c), b = *(const LAS f32x4*)(LB + vec * D + c);
            hq[j] = v[j] * rstd * a + b; mx = fmaxf(mx, fmaxf(fmaxf(fabsf(hq[j].x), fabsf(hq[j].y)), fmaxf(fabsf(hq[j].z), fabsf(hq[j].w)))); }
        mx = wave_max(mx);
        const float iv = mx > 0.f ? 127.0f / mx : 0.f;
        if (F.lane == 0) ((float*)(F.ws + MI_RSH))[row] = mx * (1.0f / 127.0f);
        unsigned* o4 = (unsigned*)(A0q + (size_t)row * D) + F.lane;
#pragma unroll
        for (int j = 0; j < 4; ++j) o4[64 * j] = pack_q4(hq[j].x * iv, hq[j].y * iv, hq[j].z * iv, hq[j].w * iv);
    }
}

__device__ __forceinline__ void phase_lora_in(Frame& F) {
    const bf16* z = (const bf16*)(F.ws + WS_Z); bf16* AL = (bf16*)(F.ws + WS_AL);
    const int gt = blockIdx.x * (NWAVES * 64) + F.tid, NGT = F.G * NWAVES * 64;
    for (int i = gt; i < MT * (KL / 4); i += NGT) {
        const int row = i / (KL / 4), q = i % (KL / 4), j0 = 4 * q;
        const int zc = j0 < 256 ? DECAY_OFF + j0 : GLORA_OFF + (j0 - 256);
        float o[4];
        if (j0 >= 256 && row >= ML) { o[0] = o[1] = o[2] = o[3] = 0.f; }
        else {
            const uint2 sv = *(const uint2*)(z + (size_t)row * NZ + zc); const float s[4] = {bflo(sv.x), bfhi(sv.x), bflo(sv.y), bfhi(sv.y)};
#pragma unroll
            for (int j = 0; j < 4; ++j) { const int nr = nbr_row(row, j); float t = 0.f;
                if (nr >= 0) t = bf1(z[(size_t)nr * NZ + zc + j]);
                const float v = s[j] + KIN(I_MU)[zc + j] * (t - s[j]);
                o[j] = j0 < 128 ? tanhf(v) : (j0 < 256 ? v : sigmoidf_(v)); }
        }
        *(uint2*)(AL + (size_t)row * KL + j0) = make_uint2(pk2(o[0], o[1]), pk2(o[2], o[3]));
    }
}


namespace ck {
typedef short bf16x8 __attribute__((ext_vector_type(8)));
constexpr int TILE = 8192;
constexpr int NU_L = BATCH * (T / 64) * NH;
constexpr int NU_ALL = NU_L + BATCH * (TC / 64) * NH;
__device__ __forceinline__ int swz(int row) { return (row ^ (row >> 3)) & 7; }
__device__ __forceinline__ int toff(int row, int col) { return row * 128 + ((col * 2) ^ (swz(row) << 4)); }
__device__ __forceinline__ bf16x8 ldfrag(const LAS unsigned char* t, int row, int chunk) { return *(const LAS bf16x8*)(t + row * 128 + ((chunk ^ swz(row)) << 4)); }
typedef __bf16 bf16v2_t __attribute__((ext_vector_type(2)));
__device__ __forceinline__ unsigned cvtpk(float lo, float hi) { const bf16v2_t v = {(__bf16)lo, (__bf16)hi}; return __builtin_bit_cast(unsigned, v); }
#define CK_MFMA(a, b, c) __builtin_amdgcn_mfma_f32_16x16x32_bf16(a, b, c, 0, 0, 0)
template <bool MASKDIAG>
__device__ __forceinline__ void mm64(f32x4 (&acc)[4], const LAS unsigned char* Lt, const LAS unsigned char* Rt, int wq, int lane) {
    const int lr = lane & 15, g = lane >> 4;
    const bf16x8 l0 = ldfrag(Lt, 16 * wq + lr, g), l1 = ldfrag(Lt, 16 * wq + lr, 4 + g);
#pragma unroll
    for (int n = 0; n < 4; ++n) {
        bf16x8 r0 = ldfrag(Rt, 16 * n + lr, g), r1 = ldfrag(Rt, 16 * n + lr, 4 + g);
        if (MASKDIAG) { const bf16x8 zz = {0, 0, 0, 0, 0, 0, 0, 0}; if ((g >> 1) == n) r0 = zz; if (2 + (g >> 1) == n) r1 = zz; }
        acc[n] = CK_MFMA(l0, r0, acc[n]); acc[n] = CK_MFMA(l1, r1, acc[n]);
    }
}
__device__ __forceinline__ void zero4(f32x4 (&a)[4]) {
#pragma unroll
    for (int n = 0; n < 4; ++n) a[n] = (f32x4){0.f, 0.f, 0.f, 0.f};
}
__device__ __forceinline__ void storeT(LAS unsigned char* t, const f32x4 (&v)[4], int wq, int lane) {
    const int lr = lane & 15, g = lane >> 4;
#pragma unroll
    for (int n = 0; n < 4; ++n) *(LAS v2u*)(t + toff(16 * n + lr, 16 * wq + 4 * g)) = (v2u){cvtpk(v[n][0], v[n][1]), cvtpk(v[n][2], v[n][3])};
}
__device__ __forceinline__ void storeN(LAS unsigned char* t, const f32x4 (&v)[4], int wq, int lane) {
    const int lr = lane & 15, g = lane >> 4;
#pragma unroll
    for (int n = 0; n < 4; ++n)
#pragma unroll
        for (int i = 0; i < 4; ++i) *(LAS unsigned short*)(t + toff(16 * wq + 4 * g + i, 16 * n + lr)) = (unsigned short)f2bf(v[n][i]);
}
__device__ __forceinline__ void loadT(f32x4 (&v)[4], const LAS unsigned char* t, int wq, int lane) {
    const int lr = lane & 15, g = lane >> 4;
#pragma unroll
    for (int n = 0; n < 4; ++n) { const v2u w = *(const LAS v2u*)(t + toff(16 * n + lr, 16 * wq + 4 * g)); v[n] = (f32x4){bflo(w.x), bfhi(w.x), bflo(w.y), bfhi(w.y)}; }
}
__device__ __forceinline__ void unit_decode(int unit, int& b, int& h, int& rowbase) {
    if (unit < NU_L) { h = unit & 15; const int blk = (unit >> 4) & 127; b = unit >> 11; rowbase = b * T + blk * 64; }
    else { const int u = unit - NU_L; h = u & 15; const int cb = (u >> 4) & 3; b = u >> 6; rowbase = ML + b * TC + cb * 64; }
}
__device__ __forceinline__ void pack8(LAS unsigned char* t, int row, int chunk, const float (&v)[8], bool rev) {
    v4u o;
    if (!rev) { o.x = cvtpk(v[0], v[1]); o.y = cvtpk(v[2], v[3]); o.z = cvtpk(v[4], v[5]); o.w = cvtpk(v[6], v[7]); }
    else { o.x = cvtpk(v[7], v[6]); o.y = cvtpk(v[5], v[4]); o.z = cvtpk(v[3], v[2]); o.w = cvtpk(v[1], v[0]); }
    *(LAS v4u*)(t + row * 128 + ((chunk ^ swz(row)) << 4)) = o;
}

__device__ __forceinline__ void unpack8(const v4u p, float (&o)[8]) {
    o[0] = bflo(p.x); o[1] = bfhi(p.x); o[2] = bflo(p.y); o[3] = bfhi(p.y); o[4] = bflo(p.z); o[5] = bfhi(p.z); o[6] = bflo(p.w); o[7] = bfhi(p.w);
}
__device__ __forceinline__ void ld8f(const float* p, float (&o)[8]) {
    const f32x4 a = *(const f32x4*)p, b = *(const f32x4*)(p + 4); o[0] = a.x; o[1] = a.y; o[2] = a.z; o[3] = a.w; o[4] = b.x; o[5] = b.y; o[6] = b.z; o[7] = b.w;
}
__device__ __forceinline__ float fsig(float x) { return __builtin_amdgcn_rcpf(1.0f + __expf(-x)); }
template <bool IS_CO> struct EPre { v4u k[5], v[5], r[IS_CO ? 5 : 1], lo[4]; };
template <bool IS_CO>
__device__ __forceinline__ void epre_load(EPre<IS_CO>& P, const bf16* z, const bf16* LO, int unit, int wave, int lane) {
    int b, h, rowbase; unit_decode(unit, b, h, rowbase);
    const int row = rowbase + 8 * wave + (lane >> 3), c0 = h * 64 + 8 * (lane & 7);
    const v4u zz = {0u, 0u, 0u, 0u};
    const bf16* zr = z + (size_t)row * NZ;
    P.k[0] = *(const v4u*)(zr + K_OFF + c0); P.v[0] = *(const v4u*)(zr + V_OFF + c0); if (IS_CO) P.r[0] = *(const v4u*)(zr + R_OFF + c0);
#pragma unroll
    for (int j = 0; j < 4; ++j) { const int nr = nbr_row(row, j); const bf16* zn = z + (size_t)(nr >= 0 ? nr : row) * NZ;
        const v4u a = *(const v4u*)(zn + K_OFF + c0), bq = *(const v4u*)(zn + V_OFF + c0);
        P.k[1 + j] = nr >= 0 ? a : zz; P.v[1 + j] = nr >= 0 ? bq : zz;
        if (IS_CO) { const v4u cq = *(const v4u*)(zn + R_OFF + c0); P.r[1 + j] = nr >= 0 ? cq : zz; } }
    const bf16* lr_ = LO + (size_t)row * NL + c0;
    P.lo[0] = *(const v4u*)(lr_); P.lo[1] = *(const v4u*)(lr_ + 1024); P.lo[2] = *(const v4u*)(lr_ + 2048); P.lo[3] = *(const v4u*)(lr_ + 3072);
}
__device__ __forceinline__ void shift8(const v4u (&q)[5], const float* mu, float (&out)[8]) {
    const v4u s = q[0], n0 = q[1], n1 = q[2], n2 = q[3], n3 = q[4];
    float m[8]; ld8f(mu, m);
    out[0] = bflo(s.x) + m[0] * (bflo(n0.x) - bflo(s.x)); out[1] = bfhi(s.x) + m[1] * (bfhi(n1.x) - bfhi(s.x));
    out[2] = bflo(s.y) + m[2] * (bflo(n2.y) - bflo(s.y)); out[3] = bfhi(s.y) + m[3] * (bfhi(n3.y) - bfhi(s.y));
    out[4] = bflo(s.z) + m[4] * (bflo(n0.z) - bflo(s.z)); out[5] = bfhi(s.z) + m[5] * (bfhi(n1.z) - bfhi(s.z));
    out[6] = bflo(s.w) + m[6] * (bflo(n2.w) - bflo(s.w)); out[7] = bfhi(s.w) + m[7] * (bfhi(n3.w) - bfhi(s.w));
}
__device__ __forceinline__ void putN(LAS unsigned char* t, int tau, int oct, const float (&v)[8]) {
    v4u o; o.x = cvtpk(v[0], v[1]); o.y = cvtpk(v[2], v[3]); o.z = cvtpk(v[4], v[5]); o.w = cvtpk(v[6], v[7]);
    *(LAS v4u*)(t + tau * 128 + ((oct ^ swz(tau)) << 4)) = o;
}
__device__ __forceinline__ void putT(LAS unsigned char* t, int tau, int ch0, const float (&v)[8]) {
#pragma unroll
    for (int i = 0; i < 8; ++i) *(LAS unsigned short*)(t + toff(ch0 + i, tau)) = (unsigned short)f2bf(v[i]);
}

template <bool IS_CO, bool STAGES = true>
__device__ __forceinline__ void phase_chunk(Frame& F) {
    const int wave = F.wave;
    const int dgrp = wave >> 2, wq = wave & 3;
    LAS unsigned char* tl = F.lds + dgrp * 9 * TILE;
#define SL(k) (tl + (k) * TILE)
    LAS float* SEG = (LAS float*)(F.lds + LDS_X_OFF);
    LAS float* GAM = SEG + 1024;
    LAS unsigned char* DIB = (LAS unsigned char*)(GAM + 128) + dgrp * 2048;
    LAS float* LW0 = (LAS float*)(F.lds + 7 * TILE);
    LAS float* LW1 = (LAS float*)(F.lds + 16 * TILE);
    const bf16* z = (const bf16*)(F.ws + WS_Z); const bf16* LO = (const bf16*)(F.ws + WS_LORA);
    unsigned char* PQ = F.ws + WS_PQ; unsigned char* TKN = F.ws + WS_TKN; unsigned char* UPRE = F.ws + WS_UPRE; unsigned char* H0T = F.ws + WS_H0T;
    bf16* MG = (bf16*)(F.ws + WS_A0);
    const float* p_mu = KIN(I_MU); const float* p_kk = KIN(I_KK); const float* p_ka = KIN(I_KA);
    const int NU = IS_CO ? NU_L : NU_ALL;
    EPre<IS_CO> PF;
    if ((int)blockIdx.x < NU) epre_load<IS_CO>(PF, z, LO, (int)blockIdx.x, wave, F.lane);
    for (int unit = blockIdx.x; unit < NU; unit += F.G) {
        int lane = F.lane; asm volatile("" : "+v"(lane));
        const int lr = lane & 15, g = lane >> 4;
        int b, h, rowbase; unit_decode(unit, b, h, rowbase);
        const int tok = 8 * wave + (lane >> 3), oct = lane & 7, ch0 = 8 * oct, c0 = h * 64 + ch0, row = rowbase + tok;
        float ks[8], vs[8], rs[8], kkp[8], lw0[8], lw1[8], kd0[8], kd1[8], a_0[8], a_1[8], ssq;
        {
            shift8(PF.k, p_mu + K_OFF + c0, ks);
            shift8(PF.v, p_mu + V_OFF + c0, vs);
            if (IS_CO) { v4u rr[5];
#pragma unroll
                for (int j = 0; j < 5; ++j) rr[j] = PF.r[IS_CO ? j : 0];
                shift8(rr, p_mu + R_OFF + c0, rs); }
            else {
#pragma unroll
                for (int i = 0; i < 8; ++i) rs[i] = 0.f; }
            float xw0[8], xw1[8], xa0[8], xa1[8];
            unpack8(PF.lo[0], xw0); unpack8(PF.lo[1], xw1); unpack8(PF.lo[2], xa0); unpack8(PF.lo[3], xa1);
            float kkk[8], kaa[8];
            ld8f(p_kk + c0, kkk); ld8f(p_ka + c0, kaa);
            float ss = 0.f;
#pragma unroll
            for (int i = 0; i < 8; ++i) {
                kkp[i] = ks[i] * kkk[i]; ss += kkp[i] * kkp[i];
                lw0[i] = xw0[i]; lw1[i] = xw1[i];
                a_0[i] = xa0[i]; a_1[i] = xa1[i];
                kd0[i] = ks[i] * (1.0f + (a_0[i] - 1.0f) * kaa[i]); kd1[i] = ks[i] * (1.0f + (a_1[i] - 1.0f) * kaa[i]);
                const int ch = ch0 + i, sw = tok ^ (4 * ((ch & 15) ^ (2 * (ch >> 4))));
                LW0[ch * 64 + sw] = lw0[i]; LW1[ch * 64 + sw] = lw1[i];
            }
            ss += __shfl_xor(ss, 1); ss += __shfl_xor(ss, 2); ss += __shfl_xor(ss, 4);
            ssq = ss;
        }
        __syncthreads();
        {
            const int ch2 = lane, seg = wave, sw = 4 * ((ch2 & 15) ^ (2 * (ch2 >> 4)));
            LAS f32x4* p0a = (LAS f32x4*)(LW0 + ch2 * 64 + ((8 * seg) ^ sw)); LAS f32x4* p0b = (LAS f32x4*)(LW0 + ch2 * 64 + ((8 * seg + 4) ^ sw));
            LAS f32x4* p1a = (LAS f32x4*)(LW1 + ch2 * 64 + ((8 * seg) ^ sw)); LAS f32x4* p1b = (LAS f32x4*)(LW1 + ch2 * 64 + ((8 * seg + 4) ^ sw));
            f32x4 a = *p0a, bq = *p0b, c = *p1a, d = *p1b;
            a.y += a.x; a.z += a.y; a.w += a.z; bq.x += a.w; bq.y += bq.x; bq.z += bq.y; bq.w += bq.z;
            d.z += d.w; d.y += d.z; d.x += d.y; c.w += d.x; c.z += c.w; c.y += c.z; c.x += c.y;
            SEG[seg * 64 + ch2] = bq.w; SEG[(8 + seg) * 64 + ch2] = c.x;
            __syncthreads();
            float off0 = 0.f, off1 = 0.f;
#pragma unroll
            for (int s2 = 0; s2 < 8; ++s2) { const float t0 = SEG[s2 * 64 + ch2], t1 = SEG[(8 + s2) * 64 + ch2]; off0 += (s2 < seg) ? t0 : 0.f; off1 += (s2 > seg) ? t1 : 0.f; }
            *p0a = a + off0; *p0b = bq + off0; *p1a = c + off1; *p1b = d + off1;
        }
        __syncthreads();
        {
            const float inv = 1.0f / fmaxf(sqrtf(ssq), 1e-12f);
            float t8[8], u8[8], w8[8];
            {
                LAS unsigned char* t0 = F.lds; const int tau = tok;
                float e1[8], ei[8];
#pragma unroll
                for (int i = 0; i < 8; ++i) { const int ch = ch0 + i; const float cm = LW0[ch * 64 + (tok ^ (4 * ((ch & 15) ^ (2 * (ch >> 4)))))]; e1[i] = __expf(cm); ei[i] = __builtin_amdgcn_rcpf(e1[i]); t8[i] = kkp[i] * inv * __expf(cm - lw0[i]); }
                if (tok == 63) {
#pragma unroll
                    for (int i = 0; i < 8; ++i) GAM[ch0 + i] = e1[i]; }
#pragma unroll
                for (int i = 0; i < 8; ++i) { u8[i] = kkp[i] * inv * a_0[i] * ei[i]; w8[i] = kd0[i] * ei[i]; }
                if (!IS_CO) { putN(t0 + 0 * TILE, tau, oct, t8); putT(t0 + 1 * TILE, tau, ch0, t8); putN(t0 + 2 * TILE, tau, oct, u8); putT(t0 + 3 * TILE, tau, ch0, u8);
                    putN(t0 + 4 * TILE, tau, oct, w8); putT(t0 + 5 * TILE, tau, ch0, w8); putT(t0 + 6 * TILE, tau, ch0, vs); }
                else {
#pragma unroll
                    for (int i = 0; i < 8; ++i) t8[i] = rs[i] * e1[i];
                    putN(t0 + 0 * TILE, tau, oct, w8); putN(t0 + 1 * TILE, tau, oct, u8); putN(t0 + 2 * TILE, tau, oct, t8); putT(t0 + 3 * TILE, tau, ch0, vs); }
            }
            {
                LAS unsigned char* t1 = F.lds + 9 * TILE; const int tau = 63 - tok;
                float e1[8], ei[8];
#pragma unroll
                for (int i = 0; i < 8; ++i) { const int ch = ch0 + i; const float cm = LW1[ch * 64 + (tok ^ (4 * ((ch & 15) ^ (2 * (ch >> 4)))))]; e1[i] = __expf(cm); ei[i] = __builtin_amdgcn_rcpf(e1[i]); t8[i] = kkp[i] * inv * __expf(cm - lw1[i]); }
                if (tok == 0) {
#pragma unroll
                    for (int i = 0; i < 8; ++i) GAM[64 + ch0 + i] = e1[i]; }
#pragma unroll
                for (int i = 0; i < 8; ++i) { u8[i] = kkp[i] * inv * a_1[i] * ei[i]; w8[i] = kd1[i] * ei[i]; }
                if (!IS_CO) { putN(t1 + 0 * TILE, tau, oct, t8); putT(t1 + 1 * TILE, tau, ch0, t8); putN(t1 + 2 * TILE, tau, oct, u8); putT(t1 + 3 * TILE, tau, ch0, u8);
                    putN(t1 + 4 * TILE, tau, oct, w8); putT(t1 + 5 * TILE, tau, ch0, w8); putT(t1 + 6 * TILE, tau, ch0, vs); }
                else {
#pragma unroll
                    for (int i = 0; i < 8; ++i) t8[i] = rs[i] * e1[i];
                    putN(t1 + 0 * TILE, tau, oct, w8); putN(t1 + 1 * TILE, tau, oct, u8); putN(t1 + 2 * TILE, tau, oct, t8); putT(t1 + 3 * TILE, tau, ch0, vs); }
            }
        }
        if (!STAGES) { __syncthreads(); continue; }
        const size_t inst = (size_t)unit * 2 + dgrp;
        const int t2 = (wq << 6) | lane;
        if (IS_CO) {
#pragma unroll
            for (int rep = 0; rep < 2; ++rep) { const int cidx = t2 + 256 * rep, row = cidx >> 3, ch = cidx & 7;
                const v4u a = *(const v4u*)(TKN + inst * 8192 + (size_t)(row * 64 + ch * 8) * 2), hh = *(const v4u*)(H0T + inst * 8192 + (size_t)(row * 64 + ch * 8) * 2);
                *(LAS v4u*)(SL(4) + row * 128 + ((ch ^ swz(row)) << 4)) = a; *(LAS v4u*)(SL(5) + row * 128 + ((ch ^ swz(row)) << 4)) = hh; }
        }
        v4u upre0 = {0u, 0u, 0u, 0u}, upre1 = upre0;
        if (IS_CO) { const unsigned char* up = UPRE + inst * 8192 + (size_t)((wq * 64 + lane) * 32); upre0 = *(const v4u*)up; upre1 = *(const v4u*)(up + 16); }
        if (unit + F.G < NU) epre_load<IS_CO>(PF, z, LO, unit + F.G, wave, lane);
        __syncthreads();
        f32x4 acc[4], acc2[4];
        if (!IS_CO) {
            zero4(acc); mm64<false>(acc, SL(2), SL(0), wq, lane);
            zero4(acc2); mm64<false>(acc2, SL(4), SL(0), wq, lane);
#pragma unroll
            for (int n = 0; n < 4; ++n)
#pragma unroll
                for (int q = 0; q < 4; ++q) { const bool lo = (16 * wq + 4 * g + q < 16 * n + lr); acc[n][q] = lo ? acc[n][q] : 0.f; acc2[n][q] = lo ? acc2[n][q] : 0.f; }
            storeT(SL(7), acc, wq, lane); storeT(SL(8), acc2, wq, lane);
            __syncthreads();
            zero4(acc); mm64<false>(acc, SL(8), SL(6), wq, lane); storeT(SL(0), acc, wq, lane);
            if (wq == 0) {
                const int bb = lane >> 4, jj = lane & 15;
                float X[16];
                X[0] = (jj == 0) ? 1.f : 0.f;
#pragma unroll
                for (int t = 1; t < 16; ++t) {
                    const int row = 16 * bb + t;
                    const v4u p0 = *(const LAS v4u*)(SL(7) + row * 128 + (((2 * bb) ^ swz(row)) << 4)), p1 = *(const LAS v4u*)(SL(7) + row * 128 + (((2 * bb + 1) ^ swz(row)) << 4));
                    float rw[16];
                    rw[0] = bflo(p0.x); rw[1] = bfhi(p0.x); rw[2] = bflo(p0.y); rw[3] = bfhi(p0.y); rw[4] = bflo(p0.z); rw[5] = bfhi(p0.z); rw[6] = bflo(p0.w); rw[7] = bfhi(p0.w);
                    rw[8] = bflo(p1.x); rw[9] = bfhi(p1.x); rw[10] = bflo(p1.y); rw[11] = bfhi(p1.y); rw[12] = bflo(p1.z); rw[13] = bfhi(p1.z); rw[14] = bflo(p1.w); rw[15] = bfhi(p1.w);
                    float xv = (t == jj) ? 1.f : 0.f;
#pragma unroll
                    for (int s = 0; s < t; ++s) xv -= rw[s] * X[s];
                    X[t] = xv;
                }
#pragma unroll
                for (int t = 0; t < 16; ++t) *(LAS unsigned short*)(DIB + (((bb * 16 + t) * 16 + jj) << 1)) = (unsigned short)f2bf(X[t]);
            }
            __syncthreads();
            {
                const bool isU = wq >= 2; const int cbase = 32 * (wq & 1);
                const LAS unsigned char* Rt = isU ? SL(0) : SL(1);
                LAS unsigned char* outT = isU ? SL(4) : SL(2);
#pragma unroll
                for (int ct = 0; ct < 2; ++ct) {
                    const int col = cbase + 16 * ct + lr;
                    f32x4 X[4];
#pragma unroll
                    for (int b = 0; b < 4; ++b) {
                        const v2u rwv = *(const LAS v2u*)(Rt + toff(col, 16 * b + 4 * g));
                        f32x4 Zt = {bflo(rwv.x), bfhi(rwv.x), bflo(rwv.y), bfhi(rwv.y)};
                        if (b >= 1) {
                            f32x4 Y = {0.f, 0.f, 0.f, 0.f};
#pragma unroll
                            for (int s = 0; s < (b + 1) / 2; ++s) {
                                v2u alo = {0u, 0u}, ahi = {0u, 0u};
                                if (2 * s < b) alo = *(const LAS v2u*)(SL(7) + toff(16 * b + lr, 32 * s + 4 * g));
                                if (2 * s + 1 < b) ahi = *(const LAS v2u*)(SL(7) + toff(16 * b + lr, 32 * s + 16 + 4 * g));
                                v4u bw = {cvtpk(X[2 * s][0], X[2 * s][1]), cvtpk(X[2 * s][2], X[2 * s][3]), 0u, 0u};
                                if (2 * s + 1 < b) { bw.z = cvtpk(X[2 * s + 1][0], X[2 * s + 1][1]); bw.w = cvtpk(X[2 * s + 1][2], X[2 * s + 1][3]); }
                                Y = CK_MFMA(__builtin_bit_cast(bf16x8, ((v4u){alo.x, alo.y, ahi.x, ahi.y})), __builtin_bit_cast(bf16x8, bw), Y);
                            }
                            Zt = Zt - Y;
                        }
                        const v2u dv = *(const LAS v2u*)(DIB + (((b * 16 + lr) * 16 + 4 * g) << 1));
                        const v4u bz = {cvtpk(Zt[0], Zt[1]), cvtpk(Zt[2], Zt[3]), 0u, 0u};
                        X[b] = CK_MFMA(__builtin_bit_cast(bf16x8, ((v4u){dv.x, dv.y, 0u, 0u})), __builtin_bit_cast(bf16x8, bz), ((f32x4){0.f, 0.f, 0.f, 0.f}));
                    }
#pragma unroll
                    for (int b = 0; b < 4; ++b) {
                        const v2u pk = {cvtpk(X[b][0], X[b][1]), cvtpk(X[b][2], X[b][3])};
                        *(LAS v2u*)(outT + toff(col, 16 * b + 4 * g)) = pk;
                        if (!isU) {
#pragma unroll
                            for (int q = 0; q < 4; ++q) *(LAS unsigned short*)(SL(8) + toff(16 * b + 4 * g + q, col)) = (unsigned short)f2bf(X[b][q]);
                        } else {
                            *(uint2*)(UPRE + inst * 8192 + (size_t)(((b * 64 + lane) * 4 + 2 * (wq & 1) + ct) * 8)) = make_uint2(pk.x, pk.y);
                        }
                    }
                }
            }
            __syncthreads();
            { zero4(acc); mm64<false>(acc, SL(2), SL(3), wq, lane);
              unsigned char* pb = PQ + inst * 16384;
#pragma unroll
              for (int n = 0; n < 4; ++n) { const int k = 16 * n + lr; const float gm = GAM[dgrp * 64 + k]; float p[4];
#pragma unroll
                  for (int q = 0; q < 4; ++q) p[q] = gm * (((16 * wq + 4 * g + q) == k ? 1.f : 0.f) - acc[n][q]);
                  *(uint2*)(pb + (size_t)(((n * 2 + (wq >> 1)) * 64 + lane) * 16 + (wq & 1) * 8)) = make_uint2(cvtpk(p[0], p[1]), cvtpk(p[2], p[3])); }
              zero4(acc); mm64<false>(acc, SL(5), SL(6), wq, lane); zero4(acc2); mm64<false>(acc2, SL(3), SL(4), wq, lane);
              const f32x4 gm4 = *(const LAS f32x4*)(GAM + dgrp * 64 + 16 * wq + 4 * g);
#pragma unroll
              for (int n = 0; n < 4; ++n) { const f32x4 qv = (acc[n] - acc2[n]) * gm4;
                  *(uint2*)(pb + 8192 + (size_t)(((n * 64 + lane) * 4 + wq) * 8)) = make_uint2(cvtpk(qv[0], qv[1]), cvtpk(qv[2], qv[3])); }
#pragma unroll
              for (int rep = 0; rep < 2; ++rep) { const int cidx = t2 + 256 * rep, row = cidx >> 3, ch = cidx & 7;
                  *(v4u*)(TKN + inst * 8192 + (size_t)(row * 64 + ch * 8) * 2) = *(const LAS v4u*)(SL(8) + row * 128 + ((ch ^ swz(row)) << 4)); }
            }
        } else {
            zero4(acc); mm64<false>(acc, SL(0), SL(2), wq, lane);
#pragma unroll
            for (int n = 0; n < 4; ++n)
#pragma unroll
                for (int q = 0; q < 4; ++q) acc[n][q] = (16 * wq + 4 * g + q <= 16 * n + lr) ? acc[n][q] : 0.f;
            storeT(SL(6), acc, wq, lane);
            zero4(acc); mm64<false>(acc, SL(1), SL(2), wq, lane);
#pragma unroll
            for (int n = 0; n < 4; ++n)
#pragma unroll
                for (int q = 0; q < 4; ++q) acc[n][q] = (16 * wq + 4 * g + q <= 16 * n + lr) ? -acc[n][q] : 0.f;
            storeT(SL(7), acc, wq, lane);
            { const v4u o0 = upre0, o1 = upre1;
              acc[0] = (f32x4){bflo(o0.x), bfhi(o0.x), bflo(o0.y), bfhi(o0.y)}; acc[1] = (f32x4){bflo(o0.z), bfhi(o0.z), bflo(o0.w), bfhi(o0.w)};
              acc[2] = (f32x4){bflo(o1.x), bfhi(o1.x), bflo(o1.y), bfhi(o1.y)}; acc[3] = (f32x4){bflo(o1.z), bfhi(o1.z), bflo(o1.w), bfhi(o1.w)}; }
            mm64<false>(acc, SL(4), SL(5), wq, lane);
            storeT(SL(8), acc, wq, lane);
            __syncthreads();
            zero4(acc); mm64<false>(acc, SL(2), SL(5), wq, lane); mm64<false>(acc, SL(6), SL(3), wq, lane); mm64<false>(acc, SL(7), SL(8), wq, lane);
            __syncthreads();
            { LAS float* Yf = (LAS float*)(tl);
#pragma unroll
              for (int n = 0; n < 4; ++n)
#pragma unroll
                  for (int q = 0; q < 4; ++q) { const int tau = 16 * wq + 4 * g + q; Yf[tau * 64 + ((16 * n + lr) ^ (4 * (tau & 15)))] = acc[n][q]; } }
            __syncthreads();
            { const LAS float* Y0 = (const LAS float*)(F.lds); const LAS float* Y1 = (const LAS float*)(F.lds + 9 * TILE);
              const int t = row & (T - 1);
              const bf16* zr = z + (size_t)row * NZ;
              const v4u zz = {0u, 0u, 0u, 0u};
              const v4u q_g = *(const v4u*)(LO + (size_t)row * NL + 4096 + c0);
              const v4u q_gb = *(const v4u*)(zr + CONV_OFF + c0), q_c0 = *(const v4u*)(zr + CONV_OFF + 1024 + c0), q_x0 = *(const v4u*)(zr + CONV_OFF + 2048 + c0);
              const v4u q_cm = t > 0 ? *(const v4u*)(zr - NZ + CONV_OFF + 1024 + c0) : zz, q_xm = t > 0 ? *(const v4u*)(zr - NZ + CONV_OFF + 2048 + c0) : zz;
              const v4u q_cp = t < T - 1 ? *(const v4u*)(zr + NZ + CONV_OFF + 1024 + c0) : zz, q_xp = t < T - 1 ? *(const v4u*)(zr + NZ + CONV_OFF + 2048 + c0) : zz;
              const v4u q_ga = *(const v4u*)(zr + GATE_OFF + c0), q_gr = *(const v4u*)(zr + GATE_OFF + 1024 + c0);
              float y[8];
              { const int s0 = 4 * (tok & 15), s1 = 4 * ((63 - tok) & 15);
                const f32x4 a0 = *(const LAS f32x4*)(Y0 + tok * 64 + (ch0 ^ s0)), a1 = *(const LAS f32x4*)(Y0 + tok * 64 + ((ch0 + 4) ^ s0));
                const f32x4 b0 = *(const LAS f32x4*)(Y1 + (63 - tok) * 64 + (ch0 ^ s1)), b1 = *(const LAS f32x4*)(Y1 + (63 - tok) * 64 + ((ch0 + 4) ^ s1));
                y[0] = a0.x + b0.x; y[1] = a0.y + b0.y; y[2] = a0.z + b0.z; y[3] = a0.w + b0.w; y[4] = a1.x + b1.x; y[5] = a1.y + b1.y; y[6] = a1.z + b1.z; y[7] = a1.w + b1.w; }
              float rk[8]; ld8f(KIN(I_RK) + c0, rk);
              float s1 = 0.f, s2 = 0.f, s3 = 0.f;
#pragma unroll
              for (int i = 0; i < 8; ++i) { s1 += y[i]; s2 += y[i] * y[i]; s3 += rs[i] * 0.5f * (kd0[i] + kd1[i]) * rk[i]; }
              s1 += __shfl_xor(s1, 1); s2 += __shfl_xor(s2, 1); s3 += __shfl_xor(s3, 1); s1 += __shfl_xor(s1, 2); s2 += __shfl_xor(s2, 2); s3 += __shfl_xor(s3, 2);
              s1 += __shfl_xor(s1, 4); s2 += __shfl_xor(s2, 4); s3 += __shfl_xor(s3, 4);
              const float S1 = s1, S2 = s2, S3 = s3;
              const float mean = S1 * (1.0f / 64.0f), var = fmaxf(S2 * (1.0f / 64.0f) - mean * mean, 0.f), rstd = __builtin_amdgcn_rsqf(var + 64e-5f);
              float lnw[8], lnb[8], cw0[8], cw1[8], cw2[8];
              ld8f(KIN(I_LNW) + c0, lnw); ld8f(KIN(I_LNB) + c0, lnb); ld8f(KIN(I_CONVW) + c0, cw0); ld8f(KIN(I_CONVW) + D + c0, cw1); ld8f(KIN(I_CONVW) + 2 * D + c0, cw2);
              float gg[8], gb[8], cc[8], xx[8], cm[8], xm[8], cp[8], xp[8], ga[8], gr[8];
              unpack8(q_g, gg); unpack8(q_gb, gb); unpack8(q_c0, cc); unpack8(q_x0, xx); unpack8(q_cm, cm); unpack8(q_xm, xm); unpack8(q_cp, cp); unpack8(q_xp, xp); unpack8(q_ga, ga); unpack8(q_gr, gr);
              float o[8];
#pragma unroll
              for (int i = 0; i < 8; ++i) {
                  const float yn = (y[i] - mean) * rstd * lnw[i] + lnb[i];
                  const float yr = (yn + S3 * vs[i]) * gg[i];
                  const float yc = gb[i] * (cw0[i] * (cm[i] * xm[i]) + cw1[i] * (cc[i] * xx[i]) + cw2[i] * (cp[i] * xp[i]));
                  o[i] = fsig(ga[i]) * yr + fsig(gr[i]) * yc;
              }
              v4u ov; ov.x = cvtpk(o[0], o[1]); ov.y = cvtpk(o[2], o[3]); ov.z = cvtpk(o[4], o[5]); ov.w = cvtpk(o[6], o[7]);
              *(v4u*)(MG + (size_t)row * D + c0) = ov;
            }
        }
        __syncthreads();
    }
#undef SL
}

struct SSIn { v4u a[8]; v4u q[2]; };
__device__ __forceinline__ size_t ss_inst(int step, int b, int h, int d) {
    int unit;
    if (step < 4) { const int cb = d ? 3 - step : step; unit = NU_L + (b * 4 + cb) * 16 + h; }
    else { const int blk = d ? 127 - (step - 4) : step - 4; unit = (b * 128 + blk) * 16 + h; }
    return (size_t)unit * 2 + d;
}
__device__ __forceinline__ void ss_load(SSIn& I, const unsigned char* PQ, size_t inst, int wv, int lane) {
    const unsigned char* pb = PQ + inst * 16384;
#pragma unroll
    for (int f = 0; f < 8; ++f) I.a[f] = *(const v4u*)(pb + (size_t)((f * 64 + lane) * 16));
    I.q[0] = *(const v4u*)(pb + 8192 + (size_t)((wv * 64 + lane) * 32)); I.q[1] = *(const v4u*)(pb + 8192 + (size_t)((wv * 64 + lane) * 32 + 16));
}
__device__ __forceinline__ void ss_step(f32x4 (&H)[4], const SSIn& cur, unsigned char* H0T, size_t inst, bool store_h0, int wv, int lr, int g) {
    const unsigned p00 = cvtpk(H[0][0], H[0][1]), p01 = cvtpk(H[0][2], H[0][3]), p10 = cvtpk(H[1][0], H[1][1]), p11 = cvtpk(H[1][2], H[1][3]);
    const unsigned p20 = cvtpk(H[2][0], H[2][1]), p21 = cvtpk(H[2][2], H[2][3]), p30 = cvtpk(H[3][0], H[3][1]), p31 = cvtpk(H[3][2], H[3][3]);
    if (store_h0) { unsigned char* hb = H0T + inst * 8192 + (size_t)((16 * wv + lr) * 64 + 4 * g) * 2;
        *(uint2*)(hb) = make_uint2(p00, p01); *(uint2*)(hb + 32) = make_uint2(p10, p11); *(uint2*)(hb + 64) = make_uint2(p20, p21); *(uint2*)(hb + 96) = make_uint2(p30, p31); }
    const bf16x8 b0 = __builtin_bit_cast(bf16x8, ((v4u){p00, p01, p10, p11})), b1 = __builtin_bit_cast(bf16x8, ((v4u){p20, p21, p30, p31}));
    H[0] = (f32x4){bflo(cur.q[0].x), bfhi(cur.q[0].x), bflo(cur.q[0].y), bfhi(cur.q[0].y)}; H[1] = (f32x4){bflo(cur.q[0].z), bfhi(cur.q[0].z), bflo(cur.q[0].w), bfhi(cur.q[0].w)};
    H[2] = (f32x4){bflo(cur.q[1].x), bfhi(cur.q[1].x), bflo(cur.q[1].y), bfhi(cur.q[1].y)}; H[3] = (f32x4){bflo(cur.q[1].z), bfhi(cur.q[1].z), bflo(cur.q[1].w), bfhi(cur.q[1].w)};
#pragma unroll
    for (int m = 0; m < 4; ++m) { H[m] = CK_MFMA(__builtin_bit_cast(bf16x8, cur.a[2 * m]), b0, H[m]); H[m] = CK_MFMA(__builtin_bit_cast(bf16x8, cur.a[2 * m + 1]), b1, H[m]); }
}
__device__ __forceinline__ void phase_ss(Frame& F) {
    const unsigned char* PQ = F.ws + WS_PQ; unsigned char* H0T = F.ws + WS_H0T;
    const int lane = F.lane, lr = lane & 15, g = lane >> 4;
    for (int task = (int)blockIdx.x; task < 256; task += F.G) {
        const int chain = task >> 2, wv = task & 3, b = chain >> 5, h = (chain >> 1) & 15, d = chain & 1;
        f32x4 H[4]; zero4(H);
        constexpr int NS = 4 + T / 64;
        static_assert(NS % 4 == 0, "unrolled by four");
        SSIn b0, b1, b2, b3;
        ss_load(b0, PQ, ss_inst(0, b, h, d), wv, lane); ss_load(b1, PQ, ss_inst(1, b, h, d), wv, lane); ss_load(b2, PQ, ss_inst(2, b, h, d), wv, lane); ss_load(b3, PQ, ss_inst(3, b, h, d), wv, lane);
        for (int step = 0; step < NS; step += 4) {
            const int n0 = step + 4 < NS ? step + 4 : NS - 1, n1 = step + 5 < NS ? step + 5 : NS - 1, n2 = step + 6 < NS ? step + 6 : NS - 1, n3 = step + 7 < NS ? step + 7 : NS - 1;
            ss_step(H, b0, H0T, ss_inst(step, b, h, d), step >= 4, wv, lr, g);     ss_load(b0, PQ, ss_inst(n0, b, h, d), wv, lane);
            ss_step(H, b1, H0T, ss_inst(step + 1, b, h, d), step >= 4, wv, lr, g); ss_load(b1, PQ, ss_inst(n1, b, h, d), wv, lane);
            ss_step(H, b2, H0T, ss_inst(step + 2, b, h, d), step >= 4, wv, lr, g); ss_load(b2, PQ, ss_inst(n2, b, h, d), wv, lane);
            ss_step(H, b3, H0T, ss_inst(step + 3, b, h, d), step >= 4, wv, lr, g); ss_load(b3, PQ, ss_inst(n3, b, h, d), wv, lane);
        }
    }
}

__device__ __forceinline__ void lora_atile(const bf16* z, const float* p_mu, LAS unsigned char* lds, int r0, int gi, int wave, int lane) {
    const int tok = 8 * wave + (lane >> 3), oct = lane & 7, row = r0 + tok;
    const v4u zz = {0u, 0u, 0u, 0u};
    const int col = (gi < 4 ? DECAY_OFF + 64 * gi : GLORA_OFF + 64 * (gi - 4)) + 8 * oct;
    v4u q[5]; q[0] = *(const v4u*)(z + (size_t)row * NZ + col);
#pragma unroll
    for (int j = 0; j < 4; ++j) { const int nr = nbr_row(row, j); q[1 + j] = nr >= 0 ? *(const v4u*)(z + (size_t)nr * NZ + col) : zz; }
    float v[8]; shift8(q, p_mu + col, v);
#pragma unroll
    for (int i = 0; i < 8; ++i) v[i] = gi < 2 ? 1.0f - 2.0f * __builtin_amdgcn_rcpf(1.0f + __expf(2.0f * v[i])) : (gi < 4 ? v[i] : fsig(v[i]));
    putN(lds + gi * TILE, tok, oct, v);
}
template <int KS> struct LoraB { bf16x8 w[KS][4]; };
template <int KS>
__device__ __forceinline__ void lora_bload(LoraB<KS>& B, const bf16* WL, int q, int lr, int g) {
    const int blkid = q >> 4, h = q & 15;
    const bf16* wrow = WL + (size_t)(blkid * 1024 + h * 64 + 8 * (lr >> 2) + (lr & 3)) * KL + blkid * 64 + 8 * g;
#pragma unroll
    for (int s = 0; s < KS; ++s)
#pragma unroll
        for (int n = 0; n < 4; ++n) B.w[s][n] = *(const bf16x8*)(wrow + (size_t)(32 * (n >> 1) + 4 * (n & 1)) * KL + 32 * s);
}
template <int KS>
__device__ __forceinline__ void lora_product(const LoraB<KS>& B, const LAS unsigned char* At, bf16* LO, int r0, int q, int lr, int g, const float* p_w0, const float* p_a0) {
    const int blkid = q >> 4, h = q & 15;
    f32x4 acc[4][4];
#pragma unroll
    for (int n = 0; n < 4; ++n)
#pragma unroll
        for (int m = 0; m < 4; ++m) acc[n][m] = (f32x4){0.f, 0.f, 0.f, 0.f};
#pragma unroll
    for (int s = 0; s < KS; ++s) {
        bf16x8 af[4];
#pragma unroll
        for (int m = 0; m < 4; ++m) af[m] = ldfrag(At + (s >> 1) * TILE, 16 * m + lr, 4 * (s & 1) + g);
#pragma unroll
        for (int n = 0; n < 4; ++n)
#pragma unroll
            for (int m = 0; m < 4; ++m) acc[n][m] = CK_MFMA(B.w[s][n], af[m], acc[n][m]);
    }
    bf16* ob = LO + (size_t)(r0 + lr) * NL + blkid * 1024 + h * 64 + 8 * g;
#pragma unroll
    for (int m = 0; m < 4; ++m)
#pragma unroll
        for (int p = 0; p < 2; ++p) {
            f32x4 v0 = acc[2 * p][m], v1 = acc[2 * p + 1][m];
            if (KS == 2) {
                const float* bp = (blkid < 2 ? p_w0 + (blkid & 1) * D : p_a0 + (blkid & 1) * D) + h * 64 + 8 * g + 32 * p;
                const f32x4 b0 = *(const f32x4*)bp, b1 = *(const f32x4*)(bp + 4); const float sc = blkid < 2 ? -0.6065306597126334f : 1.0f;
#pragma unroll
                for (int e = 0; e < 4; ++e) { v0[e] = sc * fsig(v0[e] + b0[e]); v1[e] = sc * fsig(v1[e] + b1[e]); }
            }
            v4u o; o.x = cvtpk(v0[0], v0[1]); o.y = cvtpk(v0[2], v0[3]); o.z = cvtpk(v1[0], v1[1]); o.w = cvtpk(v1[2], v1[3]);
            *(v4u*)(ob + (size_t)(16 * m) * NL + 32 * p) = o; }
}
__device__ __forceinline__ void phase_lora(Frame& F) {
    const bf16* z = (const bf16*)(F.ws + WS_Z); bf16* LO = (bf16*)(F.ws + WS_LORA); const bf16* WL = (const bf16*)(F.ws + WS_WLORA);
    const float* p_mu = KIN(I_MU); const float* p_w0 = KIN(I_W0); const float* p_a0 = KIN(I_A0);
    for (int unit = blockIdx.x; unit < ML / 64; unit += F.G) {
        int lane = F.lane; asm volatile("" : "+v"(lane));
        const int lr = lane & 15, g = lane >> 4, r0 = unit * 64;
#pragma unroll
        for (int gi = 0; gi < 6; ++gi) lora_atile(z, p_mu, F.lds, r0, gi, F.wave, lane);
        __syncthreads();
        LoraB<2> b0, b1;
        lora_bload<2>(b0, WL, F.wave, lr, g);
#pragma unroll
        for (int i = 0; i < 8; i += 2) {
            lora_bload<2>(b1, WL, F.wave + 8 * (i + 1), lr, g);
            lora_product<2>(b0, F.lds + ((F.wave + 8 * i) >> 4) * TILE, LO, r0, F.wave + 8 * i, lr, g, p_w0, p_a0);
            if (i + 2 < 8) lora_bload<2>(b0, WL, F.wave + 8 * (i + 2), lr, g);
            lora_product<2>(b1, F.lds + ((F.wave + 8 * (i + 1)) >> 4) * TILE, LO, r0, F.wave + 8 * (i + 1), lr, g, p_w0, p_a0);
        }
        { LoraB<4> c0; lora_bload<4>(c0, WL, 64 + F.wave, lr, g); lora_product<4>(c0, F.lds + 4 * TILE, LO, r0, 64 + F.wave, lr, g, p_w0, p_a0);
          lora_bload<4>(c0, WL, 72 + F.wave, lr, g); lora_product<4>(c0, F.lds + 4 * TILE, LO, r0, 72 + F.wave, lr, g, p_w0, p_a0); }
        __syncthreads();
    }
    for (int t = blockIdx.x; t < (MC / 64) * 32; t += F.G) {
        int lane = F.lane; asm volatile("" : "+v"(lane));
        const int lr = lane & 15, g = lane >> 4, r0 = ML + (t >> 5) * 64, q0 = 2 * (t & 31), gi = q0 >> 4;
        lora_atile(z, p_mu, F.lds, r0, gi, F.wave, lane);
        __syncthreads();
        if (F.wave < 2) { LoraB<2> b0; lora_bload<2>(b0, WL, q0 + F.wave, lr, g); lora_product<2>(b0, F.lds + gi * TILE, LO, r0, q0 + F.wave, lr, g, p_w0, p_a0); }
        __syncthreads();
    }
}
}
template <int PART>
__device__ __forceinline__ void phase_moe_weights(Frame& F) {
    LAS float* scr = (LAS float*)(F.lds + RING_OFF + F.wave * 16384);
    bf16* WEO = (bf16*)(F.ws + WS_WEOUT);
    constexpr int IT_IN = (D / 64) * (2048 / 32), IT_OUT = (D / 64) * (D / 32);
    if (PART == 0) {
        const float* wei = KIN(I_WEI);
        const int nstat = F.G * 7;
        int it = (int)blockIdx.x * 7 + F.wave - 1;
        while (it < NE * 128) {
            const int half = it & 1, r = it >> 1, e = r >> 6, n0 = 32 * (r & 63);
            const int c = n0 & 1023, rowbase = (c >> 7) * 256 + (n0 >= 1024 ? 128 : 0) + (c & 127);
            q8_item(wei + (size_t)e * D * 2048, 2048, n0, (signed char*)(F.ws + WS_WEIN) + (size_t)e * 2048 * D, (float*)(F.ws + MI_CSWEI) + (size_t)e * 2048, rowbase, scr, F.lane, 8 * half, 8 * half + 8);
            int nx = 0; if (F.lane == 0) nx = (int)__hip_atomic_fetch_add(F.ctl + CW_Q6, 1u, __ATOMIC_RELAXED, __HIP_MEMORY_SCOPE_AGENT);
            it = nstat + __builtin_amdgcn_readfirstlane(nx);
        }
    } else {
        const float* weo = KIN(I_WEO);
        for (int r = (int)blockIdx.x * 7 + F.wave - 1; r < NE * IT_OUT; r += F.G * 7) { const int e = r / IT_OUT, q = r % IT_OUT, kb = q / 32, n0 = 32 * (q % 32);
            transpose_item(weo + (size_t)e * D * D, D, 64 * kb, n0, WEO + (size_t)e * D * D, D, n0, scr, F.lane); }
    }
}

__device__ __forceinline__ void phase_x1_h2(Frame& F) {
    LAS float* LG = (LAS float*)(F.lds);
    LAS float* LA = LG + 2 * D; LAS float* LB = LA + 2 * D;
    const float* modp = (const float*)(F.ws + WS_MODP);
    for (int i = F.tid; i < 2 * D; i += NWAVES * 64) { const int v = i / D, j = i % D;
        LG[i] = mod_val(modp, KIN(I_BADA), v, 2048 + j) * KIN(I_NQM)[j];
        LA[i] = KIN(I_NPF)[j] * (1.0f + mod_val(modp, KIN(I_BADA), v, 4096 + j)); LB[i] = mod_val(modp, KIN(I_BADA), v, 3072 + j); }
    __syncthreads();
    const float* mix = (const float*)(F.ws + WS_MIX); float* x1 = (float*)(F.ws + WS_X1); bf16* h2 = (bf16*)(F.ws + WS_H2);
    for (int row = F.gw; row < ML; row += F.NGW) {
        const int vec = row >> 13;
        f32x4 m[4], x[4]; float s = 0.f;
#pragma unroll
        for (int j = 0; j < 4; ++j) { m[j] = *(const f32x4*)(mix + (size_t)row * D + 4 * F.lane + 256 * j); x[j] = *(const f32x4*)(KIN(I_X) + (size_t)row * D + 4 * F.lane + 256 * j);
            s += (m[j].x * m[j].x + m[j].y * m[j].y) + (m[j].z * m[j].z + m[j].w * m[j].w); }
        const float rstd = 1.0f / sqrtf(wave_sum(s) * (1.0f / D) + 1e-6f);
        float s2 = 0.f;
#pragma unroll
        for (int j = 0; j < 4; ++j) { const int c = 4 * F.lane + 256 * j; const f32x4 g = *(const LAS f32x4*)(LG + vec * D + c);
            x[j] = x[j] + g * (m[j] * rstd); *(f32x4*)(x1 + (size_t)row * D + c) = x[j];
            s2 += (x[j].x * x[j].x + x[j].y * x[j].y) + (x[j].z * x[j].z + x[j].w * x[j].w); }
        const float rstd2 = 1.0f / sqrtf(wave_sum(s2) * (1.0f / D) + 1e-6f);
        unsigned long long* o8 = (unsigned long long*)(h2 + (size_t)row * D) + F.lane;
        f32x4 hq[4]; float mx = 0.f;
#pragma unroll
        for (int j = 0; j < 4; ++j) { const int c = 4 * F.lane + 256 * j; const f32x4 a = *(const LAS f32x4*)(LA + vec * D + c), b = *(const LAS f32x4*)(LB + vec * D + c);
            const f32x4 h = x[j] * rstd2 * a + b; hq[j] = h;
            mx = fmaxf(mx, fmaxf(fmaxf(fabsf(h.x), fabsf(h.y)), fmaxf(fabsf(h.z), fabsf(h.w))));
            o8[64 * j] = (unsigned long long)pk2(h.x, h.y) | ((unsigned long long)pk2(h.z, h.w) << 32); }
        mx = wave_max(mx);
        const float iv = mx > 0.f ? 127.0f / mx : 0.f;
        if (F.lane == 0) ((float*)(F.ws + MI_RSH2))[row] = mx * (1.0f / 127.0f);
        unsigned* o4 = (unsigned*)(F.ws + WS_H2Q + (size_t)row * D) + F.lane;
#pragma unroll
        for (int j = 0; j < 4; ++j) o4[64 * j] = pack_q4(hq[j].x * iv, hq[j].y * iv, hq[j].z * iv, hq[j].w * iv);
    }
}

__device__ __forceinline__ void phase_route(Frame& F) {
    const float* LG = (const float*)(F.ws + WS_LOGIT);
    int* selE = (int*)(F.ws + MI_SELE); int* selP = (int*)(F.ws + MI_SELP); float* gate = (float*)(F.ws + MI_GATE);
    for (int task = F.gw; task < ML / 64; task += F.NGW) {
        const int row = task * 64 + F.lane;
        float v[NE];
#pragma unroll
        for (int q = 0; q < NE / 4; ++q) { const f32x4 x = *(const f32x4*)(LG + (size_t)row * 256 + 4 * q); const f32x4 bb = *(const f32x4*)(KIN(I_BR) + 4 * q);
            v[4 * q] = x.x + bb.x; v[4 * q + 1] = x.y + bb.y; v[4 * q + 2] = x.z + bb.z; v[4 * q + 3] = x.w + bb.w; }
        int se[4]; float sv[4];
#pragma unroll
        for (int k = 0; k < 4; ++k) { float best = -3.0e38f; int bi = 0;
#pragma unroll
            for (int e = 0; e < NE; ++e) if (v[e] > best) { best = v[e]; bi = e; }
#pragma unroll
            for (int e = 0; e < NE; ++e) v[e] = (e == bi) ? -3.0e38f : v[e];
            se[k] = bi; sv[k] = best; }
        float ex[4], sum = 0.f;
#pragma unroll
        for (int k = 0; k < 4; ++k) { ex[k] = __expf(sv[k] - sv[0]); sum += ex[k]; }
        const float inv = 1.0f / sum;
        int sp[4] = {0, 0, 0, 0};
        int myn = 0;
#pragma unroll
        for (int e = 0; e < NE; ++e) { const bool p = (se[0] == e) | (se[1] == e) | (se[2] == e) | (se[3] == e); const int n = __popcll(__ballot(p)); myn = (F.lane == e) ? n : myn; }
        int mybase = 0;
        if (F.lane < NE && myn > 0) mybase = (int)__hip_atomic_fetch_add(F.ctl + CW_CNT + 64 * F.lane, (unsigned)myn, __ATOMIC_RELAXED, __HIP_MEMORY_SCOPE_AGENT);
#pragma unroll
        for (int e = 0; e < NE; ++e) {
            const bool p = (se[0] == e) | (se[1] == e) | (se[2] == e) | (se[3] == e);
            const unsigned long long mask = __ballot(p);
            const int base = __shfl(mybase, e);
            const int pos = base + __popcll(mask & ((1ull << F.lane) - 1ull));
#pragma unroll
            for (int k = 0; k < 4; ++k) if (se[k] == e) sp[k] = pos;
        }
        *(int4*)(selE + (size_t)row * 4) = make_int4(se[0], se[1], se[2], se[3]);
        *(int4*)(selP + (size_t)row * 4) = make_int4(sp[0], sp[1], sp[2], sp[3]);
        *(f32x4*)(gate + (size_t)row * 4) = (f32x4){ex[0] * inv, ex[1] * inv, ex[2] * inv, ex[3] * inv};
    }
}

__device__ __forceinline__ void phase_x1h2_route(Frame& F) {
    constexpr int HS_STRIDE = 2064;
    LAS unsigned char* Hs = F.lds;
    LAS float* LG = (LAS float*)(F.lds + 132096);
    LAS float* LA = LG + D; LAS float* LB = LA + D;
    LAS float* LGT = (LAS float*)(F.lds + LDS_X_OFF);
    const float* modp = (const float*)(F.ws + WS_MODP);
    const float* mix = (const float*)(F.ws + WS_MIX); float* x1 = (float*)(F.ws + WS_X1);
    const float* xin = KIN(I_X); const float* b_ada = KIN(I_BADA); const float* nqm = KIN(I_NQM); const float* npf = KIN(I_NPF);
    const bf16* WR = (const bf16*)(F.ws + WS_WROUT);
    int* selE = (int*)(F.ws + MI_SELE); int* selP = (int*)(F.ws + MI_SELP); float* gate = (float*)(F.ws + MI_GATE);
    for (int rb = blockIdx.x; rb < ML / 64; rb += F.G) {
        const int vec = (rb * 64) >> 13;
        __syncthreads();
        for (int i = F.tid; i < D; i += NWAVES * 64) {
            LG[i] = mod_val(modp, b_ada, vec, 2048 + i) * nqm[i];
            LA[i] = npf[i] * (1.0f + mod_val(modp, b_ada, vec, 4096 + i)); LB[i] = mod_val(modp, b_ada, vec, 3072 + i); }
        __syncthreads();
        for (int rr = 0; rr < 8; ++rr) {
            const int lrow = F.wave * 8 + rr, row = rb * 64 + lrow;
            f32x4 m[4], x[4]; float s = 0.f;
#pragma unroll
            for (int j = 0; j < 4; ++j) { m[j] = *(const f32x4*)(mix + (size_t)row * D + 4 * F.lane + 256 * j); x[j] = *(const f32x4*)(xin + (size_t)row * D + 4 * F.lane + 256 * j);
                s += (m[j].x * m[j].x + m[j].y * m[j].y) + (m[j].z * m[j].z + m[j].w * m[j].w); }
            const float rstd = 1.0f / sqrtf(wave_sum(s) * (1.0f / D) + 1e-6f);
            float s2 = 0.f;
#pragma unroll
            for (int j = 0; j < 4; ++j) { const int c = 4 * F.lane + 256 * j; const f32x4 g = *(const LAS f32x4*)(LG + c);
                x[j] = x[j] + g * (m[j] * rstd); *(f32x4*)(x1 + (size_t)row * D + c) = x[j];
                s2 += (x[j].x * x[j].x + x[j].y * x[j].y) + (x[j].z * x[j].z + x[j].w * x[j].w); }
            const float rstd2 = 1.0f / sqrtf(wave_sum(s2) * (1.0f / D) + 1e-6f);
            f32x4 hq[4]; float mx = 0.f;
#pragma unroll
            for (int j = 0; j < 4; ++j) { const int c = 4 * F.lane + 256 * j; const f32x4 a = *(const LAS f32x4*)(LA + c), b = *(const LAS f32x4*)(LB + c);
                const f32x4 h = x[j] * rstd2 * a + b; hq[j] = h;
                mx = fmaxf(mx, fmaxf(fmaxf(fabsf(h.x), fabsf(h.y)), fmaxf(fabsf(h.z), fabsf(h.w))));
                *(LAS v2u*)(Hs + lrow * HS_STRIDE + c * 2) = (v2u){pk2(h.x, h.y), pk2(h.z, h.w)}; }
            mx = wave_max(mx);
            const float iv = mx > 0.f ? 127.0f / mx : 0.f;
            if (F.lane == 0) ((float*)(F.ws + MI_RSH2))[row] = mx * (1.0f / 127.0f);
            unsigned* o4 = (unsigned*)(F.ws + WS_H2Q + (size_t)row * D) + F.lane;
#pragma unroll
            for (int j = 0; j < 4; ++j) o4[64 * j] = pack_q4(hq[j].x * iv, hq[j].y * iv, hq[j].z * iv, hq[j].w * iv);
        }
        __syncthreads();
        {
            const int rt = F.wave & 3, et = F.wave >> 2, lr = F.lane & 15, g = F.lane >> 4;
            typedef short bf16x8_t __attribute__((ext_vector_type(8)));
            f32x4 acc = {0.f, 0.f, 0.f, 0.f};
            const LAS unsigned char* ap = Hs + (16 * rt + lr) * HS_STRIDE + 16 * g; const bf16* bp = WR + (size_t)(16 * et + lr) * D + 8 * g;
#pragma unroll 8
            for (int s = 0; s < 32; ++s) { const bf16x8_t a = *(const LAS bf16x8_t*)(ap + 64 * s); const bf16x8_t b = *(const bf16x8_t*)(bp + 32 * s);
                acc = __builtin_amdgcn_mfma_f32_16x16x32_bf16(a, b, acc, 0, 0, 0); }
#pragma unroll
            for (int i = 0; i < 4; ++i) LGT[(16 * rt + 4 * g + i) * 33 + 16 * et + lr] = acc[i];
        }
        __syncthreads();
        if (F.wave == 0) {
            const int row = rb * 64 + F.lane;
            const float* br = KIN(I_BR);
            float v[NE];
#pragma unroll
            for (int e = 0; e < NE; ++e) v[e] = LGT[F.lane * 33 + e] + br[e];
            int se[4]; float sv[4];
#pragma unroll
            for (int k = 0; k < 4; ++k) { float best = -3.0e38f; int bi = 0;
#pragma unroll
                for (int e = 0; e < NE; ++e) if (v[e] > best) { best = v[e]; bi = e; }
#pragma unroll
                for (int e = 0; e < NE; ++e) v[e] = (e == bi) ? -3.0e38f : v[e];
                se[k] = bi; sv[k] = best; }
            float ex[4], sum = 0.f;
#pragma unroll
            for (int k = 0; k < 4; ++k) { ex[k] = __expf(sv[k] - sv[0]); sum += ex[k]; }
            const float inv = 1.0f / sum;
            int sp[4] = {0, 0, 0, 0};
            int myn = 0;
#pragma unroll
            for (int e = 0; e < NE; ++e) { const bool p = (se[0] == e) | (se[1] == e) | (se[2] == e) | (se[3] == e); const int n = __popcll(__ballot(p)); myn = (F.lane == e) ? n : myn; }
            int mybase = 0;
            if (F.lane < NE && myn > 0) mybase = (int)__hip_atomic_fetch_add(F.ctl + CW_CNT + 64 * F.lane, (unsigned)myn, __ATOMIC_RELAXED, __HIP_MEMORY_SCOPE_AGENT);
#pragma unroll
            for (int e = 0; e < NE; ++e) {
                const bool p = (se[0] == e) | (se[1] == e) | (se[2] == e) | (se[3] == e);
                const unsigned long long mask = __ballot(p);
                const int base = __shfl(mybase, e);
                const int pos = base + __popcll(mask & ((1ull << F.lane) - 1ull));
#pragma unroll
                for (int k = 0; k < 4; ++k) if (se[k] == e) sp[k] = pos;
            }
            *(int4*)(selE + (size_t)row * 4) = make_int4(se[0], se[1], se[2], se[3]);
            *(int4*)(selP + (size_t)row * 4) = make_int4(sp[0], sp[1], sp[2], sp[3]);
            *(f32x4*)(gate + (size_t)row * 4) = (f32x4){ex[0] * inv, ex[1] * inv, ex[2] * inv, ex[3] * inv};
        }
    }
    __syncthreads();
}

__device__ __forceinline__ void phase_scatter(Frame& F) {
    LAS int* PS = (LAS int*)(F.lds);
    if (F.tid == 0) { int acc = 0;
        for (int e = 0; e < NE; ++e) { const int c = (int)__hip_atomic_load(F.ctl + CW_CNT + 64 * e, __ATOMIC_RELAXED, __HIP_MEMORY_SCOPE_AGENT); PS[e] = acc; PS[64 + e] = c; acc += (c + 255) / 256 * 256; }
        PS[NE] = acc; }
    __syncthreads();
    int* blkE = (int*)(F.ws + MI_BLKE);
    if (blockIdx.x == 0) {
        for (int b = F.tid; b < MAXBLK; b += NWAVES * 64) { int e = NE - 1;
            for (int q = 0; q < NE; ++q) if (b * 256 >= PS[q] && b * 256 < PS[q + 1]) e = q;
            blkE[b] = e; }
        if (F.tid == 0) blkE[MAXBLK] = PS[NE] / 256;
    }
    const int* selE = (const int*)(F.ws + MI_SELE); const int* selP = (const int*)(F.ws + MI_SELP); int* dest = (int*)(F.ws + MI_DEST);
    const unsigned char* h2q = F.ws + WS_H2Q; unsigned char* xb = F.ws + WS_XB; const float* rsh2 = (const float*)(F.ws + MI_RSH2); float* rsxb = (float*)(F.ws + MI_RSXB);
    for (int row = F.gw; row < ML; row += F.NGW) {
        const int4 se = *(const int4*)(selE + (size_t)row * 4), sp = *(const int4*)(selP + (size_t)row * 4);
        const int d0 = PS[se.x] + sp.x, d1 = PS[se.y] + sp.y, d2 = PS[se.z] + sp.z, d3 = PS[se.w] + sp.w;
        const float rsc = rsh2[row];
        if (F.lane == 0) { *(int4*)(dest + (size_t)row * 4) = make_int4(d0, d1, d2, d3); rsxb[d0] = rsc; rsxb[d1] = rsc; rsxb[d2] = rsc; rsxb[d3] = rsc; }
        const v4u a = *(const v4u*)(h2q + (size_t)row * D + 16 * F.lane);
        *(v4u*)(xb + (size_t)d0 * D + 16 * F.lane) = a; *(v4u*)(xb + (size_t)d1 * D + 16 * F.lane) = a;
        *(v4u*)(xb + (size_t)d2 * D + 16 * F.lane) = a; *(v4u*)(xb + (size_t)d3 * D + 16 * F.lane) = a;
    }
    for (int p = F.gw; p < NE * 256; p += F.NGW) {
        const int e = p >> 8, r = p & 255, c = PS[64 + e], padded = (c + 255) / 256 * 256;
        if (c + r < padded) { unsigned char* dst = xb + (size_t)(PS[e] + c + r) * D; *(v4u*)(dst + 16 * F.lane) = (v4u){0u, 0u, 0u, 0u}; if (F.lane == 0) rsxb[PS[e] + c + r] = 0.f; }
    }
}

__device__ __forceinline__ void phase_combine(Frame& F) {
    LAS float* LG = (LAS float*)(F.lds);
    const float* modp = (const float*)(F.ws + WS_MODP);
    for (int i = F.tid; i < 2 * D; i += NWAVES * 64) { const int v = i / D, j = i % D; LG[i] = mod_val(modp, KIN(I_BADA), v, 5120 + j) * KIN(I_NQF)[j]; }
    __syncthreads();
    const int* dest = (const int*)(F.ws + MI_DEST); const float* gate = (const float*)(F.ws + MI_GATE);
    const bf16* y2 = (const bf16*)(F.ws + WS_Y2); const float* x1 = (const float*)(F.ws + WS_X1);
    for (int row = F.gw; row < ML; row += F.NGW) {
        const int vec = row >> 13;
        const int4 dd = *(const int4*)(dest + (size_t)row * 4); const f32x4 gg = *(const f32x4*)(gate + (size_t)row * 4);
        const int dk[4] = {dd.x, dd.y, dd.z, dd.w}; const float gk[4] = {gg.x, gg.y, gg.z, gg.w};
        float f[16];
#pragma unroll
        for (int i = 0; i < 16; ++i) f[i] = 0.f;
#pragma unroll
        for (int k = 0; k < 4; ++k) { float t[16]; ld16bf(y2 + (size_t)dk[k] * D + 16 * F.lane, t);
#pragma unroll
            for (int i = 0; i < 16; ++i) f[i] += gk[k] * t[i]; }
        float s = 0.f;
#pragma unroll
        for (int i = 0; i < 16; ++i) s += f[i] * f[i];
        const float rstd = 1.0f / sqrtf(wave_sum(s) * (1.0f / D) + 1e-6f);
        float xv[16], g[16], o[16]; ld16f(x1 + (size_t)row * D + 16 * F.lane, xv); ld16f_lds(LG + vec * D + 16 * F.lane, g);
#pragma unroll
        for (int i = 0; i < 16; ++i) o[i] = xv[i] + g[i] * (f[i] * rstd);
        st16f(F.out + (size_t)row * D + 16 * F.lane, o);
    }
}

constexpr int N_PHASES = 13;
#ifndef PROBE_MASK
#define PROBE_MASK 0
#endif
#ifndef STAGE_REP
#define STAGE_REP 0
#endif
#ifndef USE_FLAT_BAR
#define USE_FLAT_BAR 0
#endif
struct Args { const float* in[30]; float* out; unsigned char* ws; int ph_lo, ph_hi; };
__global__ void __launch_bounds__(NWAVES * 64, 2) fwd(Args args) {
    extern __shared__ __attribute__((aligned(16))) unsigned char lds[];
    Frame F;
    F.lds = (LAS unsigned char*)lds;
    F.MISC = (volatile LAS unsigned*)(F.lds + MISC_OFF);
    F.tid = threadIdx.x; F.lane = F.tid & 63; F.wave = __builtin_amdgcn_readfirstlane(F.tid >> 6);
    F.G = gridDim.x; F.gw = blockIdx.x * NWAVES + F.wave; F.NGW = F.G * NWAVES;
    F.ws = args.ws; F.ctl = (unsigned*)(args.ws + WS_CTL); F.out = args.out;
    for (int u = F.tid; u < (LDS_X_OFF - LDSCTL_OFF) / 4; u += NWAVES * 64) ((LAS unsigned*)(F.lds + LDSCTL_OFF))[u] = 0u;
    __syncthreads();
    const int lo = args.ph_lo, hi = args.ph_hi;
    const bool use_bar = (hi - lo) > 1;
    XcdBarrier bar; bar.bar = F.ctl + CW_BAR; bar.x = 0; bar.st = nullptr;
    if (use_bar && !USE_FLAT_BAR) bar = xcd_barrier_post(F.ctl + CW_BAR, F.MISC + 8);
#define IN(k) (lo <= (k) && (k) < hi)
    unsigned fb_extra = 0u;
#define SEAM(k) do { if (IN(k) && IN((k) + 1)) { if (USE_FLAT_BAR) flat_barrier(F.ctl + CW_FB, (unsigned)((k) - lo + 1) + fb_extra); else xcd_barrier2(bar); } else __syncthreads(); } while (0)

#define DUP(k) ((PROBE_MASK >> (k)) & 1)
    if (IN(0)) { phase_prologue(F); if (DUP(0)) { __syncthreads(); phase_prologue(F); } SEAM(0); }
    if (DUP(20)) { for (int q = 0; q < 10; ++q) { if (USE_FLAT_BAR) { ++fb_extra; flat_barrier(F.ctl + CW_FB, 1u + fb_extra); } else xcd_barrier2(bar); } }
    if (IN(1)) { phase_hrows(F); if (DUP(1)) { __syncthreads(); phase_hrows(F); } SEAM(1); }
    if (IN(2)) {
        {         pg8::Gemm g{(const bf16*)(F.ws + WS_A0), (const bf16*)(F.ws + WS_WIN), MT, NZ, D}; pg8::StaticOrder S; S.init(MT, NZ, F.G, (int)blockIdx.x);
        pg8::EpiBf16I8 E{(bf16*)(F.ws + WS_Z), NZ, (const float*)(F.ws + MI_RSH), (const float*)(F.ws + MI_CSWIN)};
        pg8::gemm_phase_i8<pg8::EpiBf16I8, pg8::StaticOrder, true, true>(F.lds + RING_OFF, g, S, E); __syncthreads(); }
        if (DUP(2)) {         pg8::Gemm g{(const bf16*)(F.ws + WS_A0), (const bf16*)(F.ws + WS_WIN), MT, NZ, D}; pg8::StaticOrder S; S.init(MT, NZ, F.G, (int)blockIdx.x);
        pg8::EpiBf16I8 E{(bf16*)(F.ws + WS_Z), NZ, (const float*)(F.ws + MI_RSH), (const float*)(F.ws + MI_CSWIN)};
        pg8::gemm_phase_i8<pg8::EpiBf16I8, pg8::StaticOrder, true, true>(F.lds + RING_OFF, g, S, E); __syncthreads(); }
        SEAM(2); }
    if (IN(3)) { ck::phase_lora(F); SEAM(3); }
    if (IN(4)) { ck::phase_chunk<false>(F); if (DUP(5)) { __syncthreads(); ck::phase_chunk<false>(F); } if (DUP(21)) { __syncthreads(); ck::phase_chunk<false, false>(F); } if (DUP(22)) { __syncthreads(); ck::phase_lora(F); } SEAM(4); }
    if (IN(5)) { if (F.wave == 0) ck::phase_ss(F); else { phase_moe_weights<0>(F); phase_moe_weights<1>(F); } if (DUP(6)) { __syncthreads(); if (F.wave == 0) ck::phase_ss(F); else phase_moe_weights<0>(F); } if (DUP(17)) { __syncthreads(); if (F.wave == 0) ck::phase_ss(F); } SEAM(5); }
    if (IN(6)) { ck::phase_chunk<true>(F); if (DUP(7)) { __syncthreads(); ck::phase_chunk<true>(F); } SEAM(6); }
    if (IN(7)) {
        {         pg8::Gemm g{(const bf16*)(F.ws + WS_A0), (const bf16*)(F.ws + WS_WOUT), ML, D, D}; pg8::StaticOrder S; S.init(ML, D, F.G, (int)blockIdx.x);
        pg8::EpiF32 E{(float*)(F.ws + WS_MIX), D};
        pg8::gemm_phase<pg8::EpiF32, pg8::StaticOrder, true, true>(F.lds + RING_OFF, g, S, E);
        __syncthreads(); }
        if (DUP(8)) {         pg8::Gemm g{(const bf16*)(F.ws + WS_A0), (const bf16*)(F.ws + WS_WOUT), ML, D, D}; pg8::StaticOrder S; S.init(ML, D, F.G, (int)blockIdx.x);
        pg8::EpiF32 E{(float*)(F.ws + WS_MIX), D};
        pg8::gemm_phase<pg8::EpiF32, pg8::StaticOrder, true, true>(F.lds + RING_OFF, g, S, E);
        __syncthreads(); }
        SEAM(7); }
    if (IN(8)) { phase_x1h2_route(F); SEAM(8); }
    if (IN(9)) { phase_scatter(F); if (DUP(12)) { __syncthreads(); phase_scatter(F); } SEAM(9); }
    if (IN(10)) {
        {         const int* blkE = (const int*)(F.ws + MI_BLKE);
        pg8::Gemm g{(const bf16*)(F.ws + WS_XB), (const bf16*)(F.ws + WS_WEIN), NROWS, 2048, D};
        pg8::MoeOrder<8> S{blkE, __hip_atomic_load(blkE + MAXBLK, __ATOMIC_RELAXED, __HIP_MEMORY_SCOPE_AGENT) * 8, F.G, (int)blockIdx.x};
        pg8::EpiSwigluI8 E{(bf16*)(F.ws + WS_ACT), KIN(I_BEI), (const float*)(F.ws + MI_RSXB), (const float*)(F.ws + MI_CSWEI)};
        pg8::gemm_phase_i8<pg8::EpiSwigluI8, pg8::MoeOrder<8>, true, true>(F.lds + RING_OFF, g, S, E); __syncthreads(); }
        if (DUP(13)) {         const int* blkE = (const int*)(F.ws + MI_BLKE);
        pg8::Gemm g{(const bf16*)(F.ws + WS_XB), (const bf16*)(F.ws + WS_WEIN), NROWS, 2048, D};
        pg8::MoeOrder<8> S{blkE, __hip_atomic_load(blkE + MAXBLK, __ATOMIC_RELAXED, __HIP_MEMORY_SCOPE_AGENT) * 8, F.G, (int)blockIdx.x};
        pg8::EpiSwigluI8 E{(bf16*)(F.ws + WS_ACT), KIN(I_BEI), (const float*)(F.ws + MI_RSXB), (const float*)(F.ws + MI_CSWEI)};
        pg8::gemm_phase_i8<pg8::EpiSwigluI8, pg8::MoeOrder<8>, true, true>(F.lds + RING_OFF, g, S, E); __syncthreads(); }
        SEAM(10); }
    if (IN(11)) {
        {         const int* blkE = (const int*)(F.ws + MI_BLKE);
        pg8::Gemm g{(const bf16*)(F.ws + WS_ACT), (const bf16*)(F.ws + WS_WEOUT), NROWS, D, D};
        pg8::MoeOrder<4> S{blkE, __hip_atomic_load(blkE + MAXBLK, __ATOMIC_RELAXED, __HIP_MEMORY_SCOPE_AGENT) * 4, F.G, (int)blockIdx.x};
        pg8::EpiBf16 E{(bf16*)(F.ws + WS_Y2), D, KIN(I_BEO), D};
        pg8::gemm_phase<pg8::EpiBf16, pg8::MoeOrder<4>, true, true>(F.lds + RING_OFF, g, S, E); __syncthreads(); }
        if (DUP(14)) {         const int* blkE = (const int*)(F.ws + MI_BLKE);
        pg8::Gemm g{(const bf16*)(F.ws + WS_ACT), (const bf16*)(F.ws + WS_WEOUT), NROWS, D, D};
        pg8::MoeOrder<4> S{blkE, __hip_atomic_load(blkE + MAXBLK, __ATOMIC_RELAXED, __HIP_MEMORY_SCOPE_AGENT) * 4, F.G, (int)blockIdx.x};
        pg8::EpiBf16 E{(bf16*)(F.ws + WS_Y2), D, KIN(I_BEO), D};
        pg8::gemm_phase<pg8::EpiBf16, pg8::MoeOrder<4>, true, true>(F.lds + RING_OFF, g, S, E); __syncthreads(); }
        SEAM(11); }
    if (IN(12)) { phase_combine(F); if (DUP(15)) { __syncthreads(); phase_combine(F); } }
#undef IN
#undef SEAM
}

#ifndef MK_N_LAUNCHES
#define MK_N_LAUNCHES 1
#endif
extern "C" void kernel_launch(void* const* d_in, const int* in_sizes, int n_in, void* d_out, int out_size, void* d_ws, size_t ws_size, hipStream_t stream) {
    static int grid = 0;
    if (grid == 0) {
        if (n_in != 30 || out_size != ML * D || ws_size < WS_END) { fprintf(stderr, "kernel_launch: unexpected shapes (n_in %d out %d ws %zu, need %zu); nothing launched\n", n_in, out_size, ws_size, (size_t)WS_END); grid = -1; return; }
        int dev = 0, cus = 0, per_cu = 0;
        if (hipGetDevice(&dev) != hipSuccess || hipDeviceGetAttribute(&cus, hipDeviceAttributeMultiprocessorCount, dev) != hipSuccess) { grid = -1; return; }
        if (hipFuncSetAttribute((const void*)fwd, hipFuncAttributeMaxDynamicSharedMemorySize, LDS_BYTES) != hipSuccess) { fprintf(stderr, "kernel_launch: hipFuncSetAttribute failed\n"); grid = -1; return; }
        if (hipOccupancyMaxActiveBlocksPerMultiprocessor(&per_cu, (const void*)fwd, NWAVES * 64, LDS_BYTES) != hipSuccess || per_cu < 1)
            fprintf(stderr, "kernel_launch: note: occupancy query reports %d workgroups per CU\n", per_cu);
        (void)hipGetLastError();
        grid = cus;
    }
    if (grid < 0) return;
    if (hipMemsetAsync((char*)d_ws + WS_CTL, 0, CTL_ZERO_BYTES, stream) != hipSuccess) return;
    Args a{};
    for (int i = 0; i < 30; ++i) a.in[i] = (const float*)d_in[i];
    a.out = (float*)d_out; a.ws = (unsigned char*)d_ws;
    if (MK_N_LAUNCHES == 1) { a.ph_lo = 0; a.ph_hi = N_PHASES; hipLaunchKernelGGL(fwd, dim3(grid), dim3(NWAVES * 64), LDS_BYTES, stream, a); }
    else for (int p = 0; p < N_PHASES; ++p) { a.ph_lo = p; a.ph_hi = p + 1; hipLaunchKernelGGL(fwd, dim3(grid), dim3(NWAVES * 64), LDS_BYTES, stream, a); }
}
```

```cpp
#include <hip/hip_runtime.h>
#include <cstdio>
#include <cstdint>

namespace pg8 {
#define PG8_LAS __attribute__((address_space(3)))
typedef unsigned short bf16_t;
typedef short bf16x8 __attribute__((ext_vector_type(8)));
typedef float f32x4 __attribute__((ext_vector_type(4)));
typedef unsigned u32x4 __attribute__((ext_vector_type(4)));
constexpr int BM = 256, BK = 64, HALF = 128, HTB = HALF * BK * 2  , STAGE_BYTES = 8 * HTB, NXCD = 8, WGM = 8;

__host__ __device__ __forceinline__ int lds_byte(int r, int c) { const int st = (r >> 4) * 2 + (c >> 5), rr = r & 15, cc = c & 31, ob = rr * 64 + cc * 2; return st * 1024 + (ob ^ (((ob >> 9) & 1) << 5)); }
__host__ __device__ __forceinline__ void stage_rc(int b, int& R, int& C) { const int st = b / 1024, sb = b % 1024, swz = sb ^ (((sb >> 9) & 1) << 5); R = (st >> 1) * 16 + swz / 64; C = (st & 1) * 32 + (swz % 64) / 2; }
__host__ __device__ __forceinline__ int perm32(int rho) { const int n = rho >> 4, i = rho & 15; return 8 * (i >> 2) + 4 * n + (i & 3); }

struct Unit { int pm, pn, pb, e; };
struct Gemm { const bf16_t* A; const bf16_t* Bt; int M, N, K; };

struct StaticOrder {
    int nM, nN, nwg, G, c;
    __host__ __device__ void init(int M, int N, int G_, int c_) { nM = M / BM; nN = N / BM; nwg = nM * nN; G = G_; c = c_; }
    __host__ __device__ bool next(int i, Unit& u) const {
        const long L = (long)i * G + c; if (L >= nwg) return false;
        int wgid = (int)L; { const int q = nwg / NXCD, r = nwg % NXCD, xcd = wgid % NXCD, off = wgid / NXCD; wgid = (xcd < r ? xcd * (q + 1) : r * (q + 1) + (xcd - r) * q) + off; }
        const int nig = WGM * nN, gid = wgid / nig, fm = gid * WGM, gsz = (nM - fm) < WGM ? (nM - fm) : WGM;
        u.pm = fm + ((wgid % nig) % gsz); u.pn = (wgid % nig) / gsz; u.pb = u.pn; u.e = 0; return true;
    }
    __device__ __forceinline__ void a_ready(const Unit&) const {}
    __device__ __forceinline__ void done(const Unit&) const {}
};
template <int NT> struct MoeOrder {
    const int* blk_e; int nunits, G, c;
    __device__ bool next(int i, Unit& u) const {
        int L;
        if ((G & 7) == 0 && ((G >> 3) % NT) == 0) { const int per = G >> 3, xcd = c & 7, k = c >> 3, bpx = per / NT;
            L = ((i * 8 + xcd) * bpx + k / NT) * NT + (k % NT); }
        else L = i * G + c;
        if (L >= nunits) return false;
        const int blk = L / NT, pn = L % NT; const int e = __hip_atomic_load(blk_e + blk, __ATOMIC_RELAXED, __HIP_MEMORY_SCOPE_AGENT);
        u.pm = blk; u.pn = pn; u.pb = e * NT + pn; u.e = e; return true;
    }
    __device__ __forceinline__ void a_ready(const Unit&) const {}
    __device__ __forceinline__ void done(const Unit&) const {}
};

__device__ __forceinline__ unsigned cvt_pk_bf16(float lo, float hi) { unsigned r; asm volatile("v_cvt_pk_bf16_f32 %0, %1, %2" : "=v"(r) : "v"(lo), "v"(hi)); return r; }

struct EpiF32 {
    static constexpr bool PERM = false, AFTER_DRAIN = false;
    float* C; int ldc;
    __device__ __forceinline__ void operator()(const f32x4 (&acc)[2][2][4][2], const Unit& u, int wr, int wc, int fr, int fq) const {
        const int row0 = u.pm * BM + wr * 64 + fr, col0 = u.pn * BM + wc * 32 + 4 * fq;
#pragma unroll
        for (int ai = 0; ai < 2; ++ai)
#pragma unroll
            for (int m = 0; m < 4; ++m) { float* rowp = C + (size_t)(row0 + ai * HALF + m * 16) * ldc + col0;
#pragma unroll
                for (int bj = 0; bj < 2; ++bj)
#pragma unroll
                    for (int n = 0; n < 2; ++n) __builtin_nontemporal_store(acc[ai][bj][m][n], (f32x4*)(rowp + bj * HALF + n * 16)); }
    }
};
struct EpiBf16 {
    static constexpr bool PERM = true, AFTER_DRAIN = false;
    bf16_t* O; int ldc; const float* bias; int bias_estride;
    __device__ __forceinline__ void operator()(const f32x4 (&acc)[2][2][4][2], const Unit& u, int wr, int wc, int fr, int fq) const {
        const int row0 = u.pm * BM + wr * 64 + fr; const int col0 = u.pn * BM + wc * 32 + 8 * fq;
        const float* bp = bias ? bias + (size_t)u.e * bias_estride + col0 : nullptr;
        f32x4 bv[2][2];
#pragma unroll
        for (int bj = 0; bj < 2; ++bj)
#pragma unroll
            for (int n = 0; n < 2; ++n) bv[bj][n] = bp ? *(const f32x4*)(bp + bj * HALF + 4 * n) : (f32x4){0.f, 0.f, 0.f, 0.f};
#pragma unroll
        for (int ai = 0; ai < 2; ++ai)
#pragma unroll
            for (int m = 0; m < 4; ++m) { bf16_t* rowp = O + (size_t)(row0 + ai * HALF + m * 16) * ldc + col0;
#pragma unroll
                for (int bj = 0; bj < 2; ++bj) { const f32x4 v0 = acc[ai][bj][m][0] + bv[bj][0], v1 = acc[ai][bj][m][1] + bv[bj][1];
                    u32x4 w; w.x = cvt_pk_bf16(v0[0], v0[1]); w.y = cvt_pk_bf16(v0[2], v0[3]); w.z = cvt_pk_bf16(v1[0], v1[1]); w.w = cvt_pk_bf16(v1[2], v1[3]);
                    __builtin_nontemporal_store(w, (u32x4*)(rowp + bj * HALF)); } }
    }
};
struct EpiSwiglu {
    static constexpr bool PERM = true, AFTER_DRAIN = false;
    bf16_t* O; const float* bias;
    __device__ __forceinline__ float act1(float g, float up) const {
        g = fminf(g, 7.0f); up = fminf(fmaxf(up, -7.0f), 7.0f);
        const float sg = 1.0f / (1.0f + __expf(-1.702f * g));
        return (up + 1.0f) * g * sg;
    }
    __device__ __forceinline__ void operator()(const f32x4 (&acc)[2][2][4][2], const Unit& u, int wr, int wc, int fr, int fq) const {
        const int row0 = u.pm * BM + wr * 64 + fr; const int col0 = u.pn * HALF + wc * 32 + 8 * fq;
        const float* bp = bias + (size_t)u.e * 2048 + col0;
        f32x4 bg[2], bu[2];
#pragma unroll
        for (int n = 0; n < 2; ++n) { bg[n] = *(const f32x4*)(bp + 4 * n); bu[n] = *(const f32x4*)(bp + 1024 + 4 * n); }
#pragma unroll
        for (int ai = 0; ai < 2; ++ai)
#pragma unroll
            for (int m = 0; m < 4; ++m) { bf16_t* rowp = O + (size_t)(row0 + ai * HALF + m * 16) * 1024 + col0;
                const f32x4 g0 = acc[ai][0][m][0] + bg[0], g1 = acc[ai][0][m][1] + bg[1], u0 = acc[ai][1][m][0] + bu[0], u1 = acc[ai][1][m][1] + bu[1];
                u32x4 w; w.x = cvt_pk_bf16(act1(g0[0], u0[0]), act1(g0[1], u0[1])); w.y = cvt_pk_bf16(act1(g0[2], u0[2]), act1(g0[3], u0[3]));
                w.z = cvt_pk_bf16(act1(g1[0], u1[0]), act1(g1[1], u1[1])); w.w = cvt_pk_bf16(act1(g1[2], u1[2]), act1(g1[3], u1[3]));
                __builtin_nontemporal_store(w, (u32x4*)rowp); }
    }
};


typedef int i32x4 __attribute__((ext_vector_type(4)));
struct EpiBf16I8 {
    static constexpr bool PERM = true, AFTER_DRAIN = false;
    bf16_t* O; int ldc; const float* rs; const float* cs;
    __device__ __forceinline__ void operator()(const i32x4 (&acc)[2][2][4][2], const Unit& u, int wr, int wc, int fr, int fq) const {
        const int row0 = u.pm * BM + wr * 64 + fr; const int col0 = u.pn * BM + wc * 32 + 8 * fq;
        const float* cp = cs + (size_t)u.pb * BM + wc * 32 + 8 * fq;
        f32x4 cv[2][2];
#pragma unroll
        for (int bj = 0; bj < 2; ++bj)
#pragma unroll
            for (int n = 0; n < 2; ++n) cv[bj][n] = *(const f32x4*)(cp + bj * HALF + 4 * n);
#pragma unroll
        for (int ai = 0; ai < 2; ++ai)
#pragma unroll
            for (int m = 0; m < 4; ++m) { const int row = row0 + ai * HALF + m * 16; const float r = rs[row]; bf16_t* rowp = O + (size_t)row * ldc + col0;
#pragma unroll
                for (int bj = 0; bj < 2; ++bj) { const i32x4 a0 = acc[ai][bj][m][0], a1 = acc[ai][bj][m][1];
                    const f32x4 v0 = (f32x4){(float)a0[0], (float)a0[1], (float)a0[2], (float)a0[3]} * cv[bj][0] * r, v1 = (f32x4){(float)a1[0], (float)a1[1], (float)a1[2], (float)a1[3]} * cv[bj][1] * r;
                    u32x4 w; w.x = cvt_pk_bf16(v0[0], v0[1]); w.y = cvt_pk_bf16(v0[2], v0[3]); w.z = cvt_pk_bf16(v1[0], v1[1]); w.w = cvt_pk_bf16(v1[2], v1[3]);
                    __builtin_nontemporal_store(w, (u32x4*)(rowp + bj * HALF)); } }
    }
};
struct EpiSwigluI8 {
    static constexpr bool PERM = true, AFTER_DRAIN = false;
    bf16_t* O; const float* bias; const float* rs; const float* cs;
    __device__ __forceinline__ float act1(float g, float up) const {
        g = fminf(g, 7.0f); up = fminf(fmaxf(up, -7.0f), 7.0f);
        const float sg = __builtin_amdgcn_rcpf(1.0f + __expf(-1.702f * g));
        return (up + 1.0f) * g * sg;
    }
    __device__ __forceinline__ void operator()(const i32x4 (&acc)[2][2][4][2], const Unit& u, int wr, int wc, int fr, int fq) const {
        const int row0 = u.pm * BM + wr * 64 + fr; const int col0 = u.pn * HALF + wc * 32 + 8 * fq;
        const float* bp = bias + (size_t)u.e * 2048 + col0;
        const float* cp = cs + (size_t)u.pb * BM + wc * 32 + 8 * fq;
        f32x4 bg[2], bu[2], cg[2], cu[2];
#pragma unroll
        for (int n = 0; n < 2; ++n) { bg[n] = *(const f32x4*)(bp + 4 * n); bu[n] = *(const f32x4*)(bp + 1024 + 4 * n); cg[n] = *(const f32x4*)(cp + 4 * n); cu[n] = *(const f32x4*)(cp + HALF + 4 * n); }
#pragma unroll
        for (int ai = 0; ai < 2; ++ai)
#pragma unroll
            for (int m = 0; m < 4; ++m) { const int row = row0 + ai * HALF + m * 16; const float r = rs[row]; bf16_t* rowp = O + (size_t)row * 1024 + col0;
                f32x4 g[2], up[2];
#pragma unroll
                for (int n = 0; n < 2; ++n) { const i32x4 ag = acc[ai][0][m][n], au = acc[ai][1][m][n];
                    g[n] = (f32x4){(float)ag[0], (float)ag[1], (float)ag[2], (float)ag[3]} * cg[n] * r + bg[n];
                    up[n] = (f32x4){(float)au[0], (float)au[1], (float)au[2], (float)au[3]} * cu[n] * r + bu[n]; }
                u32x4 w; w.x = cvt_pk_bf16(act1(g[0][0], up[0][0]), act1(g[0][1], up[0][1])); w.y = cvt_pk_bf16(act1(g[0][2], up[0][2]), act1(g[0][3], up[0][3]));
                w.z = cvt_pk_bf16(act1(g[1][0], up[1][0]), act1(g[1][1], up[1][1])); w.w = cvt_pk_bf16(act1(g[1][2], up[1][2]), act1(g[1][3], up[1][3]));
                __builtin_nontemporal_store(w, (u32x4*)rowp); }
    }
};
template <class Epi, class Sched, bool ALIGN_EPI = false, bool SP2 = false>
__device__ __forceinline__ void gemm_phase(PG8_LAS unsigned char* lds, const Gemm g, const Sched& S, const Epi& E) {
    const int tid = threadIdx.x, wid = __builtin_amdgcn_readfirstlane(tid >> 6), lane = tid & 63, wr = wid >> 2, wc = wid & 3, fr = lane & 15, fq = lane >> 4;
    const int K = g.K, nt = K / BK;
    unsigned voffA[2], voffB[2];
#pragma unroll
    for (int i = 0; i < 2; ++i) { int R, C; stage_rc(tid * 16 + i * 8192, R, C); const int Rb = Epi::PERM ? ((R & ~31) + perm32(R & 31)) : R;
        voffA[i] = (unsigned)(R * K + C) * 2u; voffB[i] = (unsigned)(Rb * K + C) * 2u; }
    const size_t kstep = (size_t)(BK * 2);
    const size_t hstep = (size_t)HALF * K * 2;
    const size_t tstep = 2 * hstep;
    const unsigned ldsw = (unsigned)wid * 1024u;
    const int aoff = lds_byte(wr * 64 + fr, fq * 8), boff = lds_byte(wc * 32 + fr, fq * 8);
#define PG8_SA(b, h) (((b) * 2 + (h)) * HTB)
#define PG8_SB(b, h) ((4 + (b) * 2 + (h)) * HTB)
#define PG8_STAGE(bufoff, gbase, voff) do { _Pragma("unroll") for (int _i = 0; _i < 2; ++_i) \
        __builtin_amdgcn_global_load_lds((const unsigned*)((const char*)(gbase) + (voff)[_i]), (PG8_LAS unsigned*)(lds + (bufoff) + ldsw + _i * 8192), 16, 0, 0); } while (0)
#define PG8_LDA(dst, b, h) do { _Pragma("unroll") for (int m = 0; m < 4; ++m) _Pragma("unroll") for (int k = 0; k < 2; ++k) dst[m][k] = *(const PG8_LAS bf16x8*)(lds + PG8_SA(b, h) + aoff + m * 2048 + k * 1024); } while (0)
#define PG8_LDB(dst, b, h) do { _Pragma("unroll") for (int n = 0; n < 2; ++n) _Pragma("unroll") for (int k = 0; k < 2; ++k) dst[n][k] = *(const PG8_LAS bf16x8*)(lds + PG8_SB(b, h) + boff + n * 2048 + k * 1024); } while (0)
#define PG8_MMA(ai, bj, At, Bt) do { __builtin_amdgcn_s_setprio(1); _Pragma("unroll") for (int m = 0; m < 4; ++m) _Pragma("unroll") for (int n = 0; n < 2; ++n) _Pragma("unroll") for (int k = 0; k < 2; ++k) \
        acc[ai][bj][m][n] = __builtin_amdgcn_mfma_f32_16x16x32_bf16(Bt[n][k], At[m][k], acc[ai][bj][m][n], 0, 0, 0); __builtin_amdgcn_s_setprio(0); } while (0)
#define PG8_WAIT_V(n) asm volatile("s_waitcnt vmcnt(" #n ")" ::: "memory")
#define PG8_WAIT_L(n) asm volatile("s_waitcnt lgkmcnt(" #n ")" ::: "memory")
#define PG8_BAR __builtin_amdgcn_s_barrier()
#define PG8_SCHED __builtin_amdgcn_sched_barrier(0)
    Unit cur, nxt; int ui = 0;
    if (!S.next(0, cur)) return;
    f32x4 acc[2][2][4][2];
#pragma unroll
    for (int a = 0; a < 2; ++a)
#pragma unroll
        for (int b = 0; b < 2; ++b)
#pragma unroll
            for (int m = 0; m < 4; ++m)
#pragma unroll
                for (int n = 0; n < 2; ++n) acc[a][b][m][n] = (f32x4){0.f, 0.f, 0.f, 0.f};
    bf16x8 At[4][2], B0[2][2], B1[2][2];
    const char* cA = (const char*)g.A + (size_t)cur.pm * tstep; const char* cB = (const char*)g.Bt + (size_t)cur.pb * tstep;
    S.a_ready(cur);
    if constexpr (SP2) {
        PG8_STAGE(PG8_SB(0, 0), cB, voffB); PG8_STAGE(PG8_SB(0, 1), cB + hstep, voffB); PG8_STAGE(PG8_SA(0, 0), cA, voffA); PG8_STAGE(PG8_SA(0, 1), cA + hstep, voffA);
        if (wr == 1) PG8_BAR;
        PG8_WAIT_V(2); PG8_BAR;
        PG8_STAGE(PG8_SB(1, 0), cB + kstep, voffB); PG8_STAGE(PG8_SA(1, 0), cA + kstep, voffA); PG8_STAGE(PG8_SB(1, 1), cB + hstep + kstep, voffB);
        PG8_WAIT_V(6); PG8_BAR;
    } else {
        PG8_STAGE(PG8_SB(0, 0), cB, voffB); PG8_STAGE(PG8_SA(0, 0), cA, voffA); PG8_STAGE(PG8_SB(0, 1), cB + hstep, voffB); PG8_STAGE(PG8_SA(0, 1), cA + hstep, voffA);
        if (wr == 1) PG8_BAR;
        PG8_WAIT_V(4); PG8_BAR;
        PG8_STAGE(PG8_SB(1, 0), cB + kstep, voffB); PG8_STAGE(PG8_SA(1, 0), cA + kstep, voffA); PG8_STAGE(PG8_SB(1, 1), cB + hstep + kstep, voffB);
        PG8_WAIT_V(6); PG8_BAR;
    }
    for (;;) {
        const bool has_next = S.next(ui + 1, nxt);
        const char* nA = has_next ? (const char*)g.A + (size_t)nxt.pm * tstep : cA; const char* nB = has_next ? (const char*)g.Bt + (size_t)nxt.pb * tstep : cB;
        for (int t = 0; t < nt; t += 2) {
            const bool last = (t == nt - 2);
            const char* a1 = cA + (size_t)(t + 1) * kstep;
            const char* a2 = last ? nA : cA + (size_t)(t + 2) * kstep; const char* b2 = last ? nB : cB + (size_t)(t + 2) * kstep;
            const char* a3 = a2 + kstep; const char* b3 = b2 + kstep;
            if (last && has_next) S.a_ready(nxt);
            if constexpr (SP2) {
            PG8_LDB(B0, 0, 0); PG8_LDB(B1, 0, 1); PG8_SCHED; PG8_LDA(At, 0, 0); PG8_STAGE(PG8_SA(1, 1), a1 + hstep, voffA);
            PG8_WAIT_V(8); PG8_WAIT_L(0); PG8_BAR; PG8_MMA(0, 0, At, B0); PG8_MMA(0, 1, At, B1); PG8_BAR; PG8_SCHED;
            PG8_LDA(At, 0, 1); PG8_STAGE(PG8_SB(0, 0), b2, voffB); PG8_STAGE(PG8_SB(0, 1), b2 + hstep, voffB); PG8_STAGE(PG8_SA(0, 0), a2, voffA);
            PG8_WAIT_V(8); PG8_WAIT_L(0); PG8_BAR; PG8_MMA(1, 0, At, B0); PG8_MMA(1, 1, At, B1); PG8_BAR; PG8_SCHED;
            PG8_LDB(B0, 1, 0); PG8_LDB(B1, 1, 1); PG8_SCHED; PG8_LDA(At, 1, 0); PG8_STAGE(PG8_SA(0, 1), a2 + hstep, voffA);
            PG8_WAIT_V(8); PG8_WAIT_L(0); PG8_BAR; PG8_MMA(0, 0, At, B0); PG8_MMA(0, 1, At, B1); PG8_BAR; PG8_SCHED;
            PG8_LDA(At, 1, 1); PG8_STAGE(PG8_SB(1, 0), b3, voffB); PG8_STAGE(PG8_SB(1, 1), b3 + hstep, voffB); PG8_STAGE(PG8_SA(1, 0), a3, voffA);
            PG8_WAIT_V(8); PG8_WAIT_L(0); PG8_BAR; PG8_MMA(1, 0, At, B0); PG8_MMA(1, 1, At, B1); PG8_BAR; PG8_SCHED;
            } else {
            PG8_LDB(B0, 0, 0); PG8_SCHED; PG8_LDA(At, 0, 0); PG8_STAGE(PG8_SA(1, 1), a1 + hstep, voffA);
            PG8_WAIT_L(8); PG8_BAR; PG8_WAIT_L(0); PG8_MMA(0, 0, At, B0); PG8_BAR; PG8_SCHED;
            PG8_LDB(B1, 0, 1); PG8_STAGE(PG8_SB(0, 0), b2, voffB);
            PG8_BAR; PG8_WAIT_L(0); PG8_MMA(0, 1, At, B1); PG8_BAR;
            PG8_LDA(At, 0, 1); PG8_STAGE(PG8_SA(0, 0), a2, voffA);
            PG8_BAR; PG8_WAIT_L(0); PG8_MMA(1, 0, At, B0); PG8_BAR; PG8_SCHED;
            PG8_STAGE(PG8_SB(0, 1), b2 + hstep, voffB);
            PG8_WAIT_V(6); PG8_BAR; PG8_MMA(1, 1, At, B1); PG8_BAR;
            PG8_LDB(B0, 1, 0); PG8_SCHED; PG8_LDA(At, 1, 0); PG8_STAGE(PG8_SA(0, 1), a2 + hstep, voffA);
            PG8_WAIT_L(8); PG8_BAR; PG8_WAIT_L(0); PG8_MMA(0, 0, At, B0); PG8_BAR; PG8_SCHED;
            PG8_LDB(B1, 1, 1); PG8_STAGE(PG8_SB(1, 0), b3, voffB);
            PG8_BAR; PG8_WAIT_L(0); PG8_MMA(0, 1, At, B1); PG8_BAR;
            PG8_LDA(At, 1, 1); PG8_STAGE(PG8_SA(1, 0), a3, voffA);
            PG8_BAR; PG8_WAIT_L(0); PG8_MMA(1, 0, At, B0); PG8_BAR; PG8_SCHED;
            PG8_STAGE(PG8_SB(1, 1), b3 + hstep, voffB);
            PG8_WAIT_V(6); PG8_BAR; PG8_MMA(1, 1, At, B1); PG8_BAR;
            }
        }
        if constexpr (ALIGN_EPI) { if (wr == 0) PG8_BAR; }
        if constexpr (!Epi::AFTER_DRAIN) { E(acc, cur, wr, wc, fr, fq); S.done(cur); }
        if (!has_next) break;
#pragma unroll
        for (int a = 0; a < 2; ++a)
#pragma unroll
            for (int b = 0; b < 2; ++b)
#pragma unroll
                for (int m = 0; m < 4; ++m)
#pragma unroll
                    for (int n = 0; n < 2; ++n) acc[a][b][m][n] = (f32x4){0.f, 0.f, 0.f, 0.f};
        cur = nxt; cA = nA; cB = nB; ++ui;
        if constexpr (ALIGN_EPI) { if (wr == 1) PG8_BAR; }
    }
    PG8_WAIT_V(0);
    if constexpr (!ALIGN_EPI) { if (wr == 0) PG8_BAR; }
    PG8_BAR;
    if constexpr (Epi::AFTER_DRAIN) { E.fused(acc, cur, wr, wc, fr, fq, lds, wid, lane); S.done(cur); }
#undef PG8_SA
#undef PG8_SB
#undef PG8_STAGE
#undef PG8_LDA
#undef PG8_LDB
#undef PG8_MMA
#undef PG8_WAIT_V
#undef PG8_WAIT_L
#undef PG8_BAR
#undef PG8_SCHED
}
template <class Epi, class Sched, bool ALIGN_EPI = false, bool SP2 = false>
__device__ __forceinline__ void gemm_phase_i8(PG8_LAS unsigned char* lds, const Gemm g, const Sched& S, const Epi& E) {
    const int tid = threadIdx.x, wid = __builtin_amdgcn_readfirstlane(tid >> 6), lane = tid & 63, wr = wid >> 2, wc = wid & 3, fr = lane & 15, fq = lane >> 4;
    const int K = g.K, nt = K / 128;
    unsigned voffA[2], voffB[2];
#pragma unroll
    for (int i = 0; i < 2; ++i) { int R, C; stage_rc(tid * 16 + i * 8192, R, C); const int Rb = Epi::PERM ? ((R & ~31) + perm32(R & 31)) : R;
        voffA[i] = (unsigned)(R * K + C * 2); voffB[i] = (unsigned)(Rb * K + C * 2); }
    const size_t kstep = (size_t)(BK * 2);
    const size_t hstep = (size_t)HALF * K;
    const size_t tstep = 2 * hstep;
    const unsigned ldsw = (unsigned)wid * 1024u;
    const int aoff = lds_byte(wr * 64 + fr, fq * 8), boff = lds_byte(wc * 32 + fr, fq * 8);
#define PG8_SA(b, h) (((b) * 2 + (h)) * HTB)
#define PG8_SB(b, h) ((4 + (b) * 2 + (h)) * HTB)
#define PG8_STAGE(bufoff, gbase, voff) do { _Pragma("unroll") for (int _i = 0; _i < 2; ++_i) \
        __builtin_amdgcn_global_load_lds((const unsigned*)((const char*)(gbase) + (voff)[_i]), (PG8_LAS unsigned*)(lds + (bufoff) + ldsw + _i * 8192), 16, 0, 0); } while (0)
#define PG8_LDA(dst, b, h) do { _Pragma("unroll") for (int m = 0; m < 4; ++m) _Pragma("unroll") for (int k = 0; k < 2; ++k) dst[m][k] = *(const PG8_LAS bf16x8*)(lds + PG8_SA(b, h) + aoff + m * 2048 + k * 1024); } while (0)
#define PG8_LDB(dst, b, h) do { _Pragma("unroll") for (int n = 0; n < 2; ++n) _Pragma("unroll") for (int k = 0; k < 2; ++k) dst[n][k] = *(const PG8_LAS bf16x8*)(lds + PG8_SB(b, h) + boff + n * 2048 + k * 1024); } while (0)
#define PG8_MMA(ai, bj, At, Bt) do { __builtin_amdgcn_s_setprio(1); _Pragma("unroll") for (int m = 0; m < 4; ++m) _Pragma("unroll") for (int n = 0; n < 2; ++n) _Pragma("unroll") for (int k = 0; k < 2; ++k) \
        acc[ai][bj][m][n] = __builtin_amdgcn_mfma_i32_16x16x64_i8(__builtin_bit_cast(i32x4, Bt[n][k]), __builtin_bit_cast(i32x4, At[m][k]), acc[ai][bj][m][n], 0, 0, 0); __builtin_amdgcn_s_setprio(0); } while (0)
#define PG8_WAIT_V(n) asm volatile("s_waitcnt vmcnt(" #n ")" ::: "memory")
#define PG8_WAIT_L(n) asm volatile("s_waitcnt lgkmcnt(" #n ")" ::: "memory")
#define PG8_BAR __builtin_amdgcn_s_barrier()
#define PG8_SCHED __builtin_amdgcn_sched_barrier(0)
    Unit cur, nxt; int ui = 0;
    if (!S.next(0, cur)) return;
    i32x4 acc[2][2][4][2];
#pragma unroll
    for (int a = 0; a < 2; ++a)
#pragma unroll
        for (int b = 0; b < 2; ++b)
#pragma unroll
            for (int m = 0; m < 4; ++m)
#pragma unroll
                for (int n = 0; n < 2; ++n) acc[a][b][m][n] = (i32x4){0, 0, 0, 0};
    bf16x8 At[4][2], B0[2][2], B1[2][2];
    const char* cA = (const char*)g.A + (size_t)cur.pm * tstep; const char* cB = (const char*)g.Bt + (size_t)cur.pb * tstep;
    S.a_ready(cur);
    if constexpr (SP2) {
        PG8_STAGE(PG8_SB(0, 0), cB, voffB); PG8_STAGE(PG8_SB(0, 1), cB + hstep, voffB); PG8_STAGE(PG8_SA(0, 0), cA, voffA); PG8_STAGE(PG8_SA(0, 1), cA + hstep, voffA);
        if (wr == 1) PG8_BAR;
        PG8_WAIT_V(2); PG8_BAR;
        PG8_STAGE(PG8_SB(1, 0), cB + kstep, voffB); PG8_STAGE(PG8_SA(1, 0), cA + kstep, voffA); PG8_STAGE(PG8_SB(1, 1), cB + hstep + kstep, voffB);
        PG8_WAIT_V(6); PG8_BAR;
    } else {
        PG8_STAGE(PG8_SB(0, 0), cB, voffB); PG8_STAGE(PG8_SA(0, 0), cA, voffA); PG8_STAGE(PG8_SB(0, 1), cB + hstep, voffB); PG8_STAGE(PG8_SA(0, 1), cA + hstep, voffA);
        if (wr == 1) PG8_BAR;
        PG8_WAIT_V(4); PG8_BAR;
        PG8_STAGE(PG8_SB(1, 0), cB + kstep, voffB); PG8_STAGE(PG8_SA(1, 0), cA + kstep, voffA); PG8_STAGE(PG8_SB(1, 1), cB + hstep + kstep, voffB);
        PG8_WAIT_V(6); PG8_BAR;
    }
    for (;;) {
        const bool has_next = S.next(ui + 1, nxt);
        const char* nA = has_next ? (const char*)g.A + (size_t)nxt.pm * tstep : cA; const char* nB = has_next ? (const char*)g.Bt + (size_t)nxt.pb * tstep : cB;
        for (int t = 0; t < nt; t += 2) {
            const bool last = (t == nt - 2);
            const char* a1 = cA + (size_t)(t + 1) * kstep;
            const char* a2 = last ? nA : cA + (size_t)(t + 2) * kstep; const char* b2 = last ? nB : cB + (size_t)(t + 2) * kstep;
            const char* a3 = a2 + kstep; const char* b3 = b2 + kstep;
            if (last && has_next) S.a_ready(nxt);
            if constexpr (SP2) {
            PG8_LDB(B0, 0, 0); PG8_LDB(B1, 0, 1); PG8_SCHED; PG8_LDA(At, 0, 0); PG8_STAGE(PG8_SA(1, 1), a1 + hstep, voffA);
            PG8_WAIT_V(8); PG8_WAIT_L(0); PG8_BAR; PG8_MMA(0, 0, At, B0); PG8_MMA(0, 1, At, B1); PG8_BAR; PG8_SCHED;
            PG8_LDA(At, 0, 1); PG8_STAGE(PG8_SB(0, 0), b2, voffB); PG8_STAGE(PG8_SB(0, 1), b2 + hstep, voffB); PG8_STAGE(PG8_SA(0, 0), a2, voffA);
            PG8_WAIT_V(8); PG8_WAIT_L(0); PG8_BAR; PG8_MMA(1, 0, At, B0); PG8_MMA(1, 1, At, B1); PG8_BAR; PG8_SCHED;
            PG8_LDB(B0, 1, 0); PG8_LDB(B1, 1, 1); PG8_SCHED; PG8_LDA(At, 1, 0); PG8_STAGE(PG8_SA(0, 1), a2 + hstep, voffA);
            PG8_WAIT_V(8); PG8_WAIT_L(0); PG8_BAR; PG8_MMA(0, 0, At, B0); PG8_MMA(0, 1, At, B1); PG8_BAR; PG8_SCHED;
            PG8_LDA(At, 1, 1); PG8_STAGE(PG8_SB(1, 0), b3, voffB); PG8_STAGE(PG8_SB(1, 1), b3 + hstep, voffB); PG8_STAGE(PG8_SA(1, 0), a3, voffA);
            PG8_WAIT_V(8); PG8_WAIT_L(0); PG8_BAR; PG8_MMA(1, 0, At, B0); PG8_MMA(1, 1, At, B1); PG8_BAR; PG8_SCHED;
            } else {
            PG8_LDB(B0, 0, 0); PG8_SCHED; PG8_LDA(At, 0, 0); PG8_STAGE(PG8_SA(1, 1), a1 + hstep, voffA);
            PG8_WAIT_L(8); PG8_BAR; PG8_WAIT_L(0); PG8_MMA(0, 0, At, B0); PG8_BAR; PG8_SCHED;
            PG8_LDB(B1, 0, 1); PG8_STAGE(PG8_SB(0, 0), b2, voffB);
            PG8_BAR; PG8_WAIT_L(0); PG8_MMA(0, 1, At, B1); PG8_BAR;
            PG8_LDA(At, 0, 1); PG8_STAGE(PG8_SA(0, 0), a2, voffA);
            PG8_BAR; PG8_WAIT_L(0); PG8_MMA(1, 0, At, B0); PG8_BAR; PG8_SCHED;
            PG8_STAGE(PG8_SB(0, 1), b2 + hstep, voffB);
            PG8_WAIT_V(6); PG8_BAR; PG8_MMA(1, 1, At, B1); PG8_BAR;
            PG8_LDB(B0, 1, 0); PG8_SCHED; PG8_LDA(At, 1, 0); PG8_STAGE(PG8_SA(0, 1), a2 + hstep, voffA);
            PG8_WAIT_L(8); PG8_BAR; PG8_WAIT_L(0); PG8_MMA(0, 0, At, B0); PG8_BAR; PG8_SCHED;
            PG8_LDB(B1, 1, 1); PG8_STAGE(PG8_SB(1, 0), b3, voffB);
            PG8_BAR; PG8_WAIT_L(0); PG8_MMA(0, 1, At, B1); PG8_BAR;
            PG8_LDA(At, 1, 1); PG8_STAGE(PG8_SA(1, 0), a3, voffA);
            PG8_BAR; PG8_WAIT_L(0); PG8_MMA(1, 0, At, B0); PG8_BAR; PG8_SCHED;
            PG8_STAGE(PG8_SB(1, 1), b3 + hstep, voffB);
            PG8_WAIT_V(6); PG8_BAR; PG8_MMA(1, 1, At, B1); PG8_BAR;
            }
        }
        if constexpr (ALIGN_EPI) { if (wr == 0) PG8_BAR; }
        if constexpr (!Epi::AFTER_DRAIN) { E(acc, cur, wr, wc, fr, fq); S.done(cur); }
        if (!has_next) break;
#pragma unroll
        for (int a = 0; a < 2; ++a)
#pragma unroll
            for (int b = 0; b < 2; ++b)
#pragma unroll
                for (int m = 0; m < 4; ++m)
#pragma unroll
                    for (int n = 0; n < 2; ++n) acc[a][b][m][n] = (i32x4){0, 0, 0, 0};
        cur = nxt; cA = nA; cB = nB; ++ui;
        if constexpr (ALIGN_EPI) { if (wr == 1) PG8_BAR; }
    }
    PG8_WAIT_V(0);
    if constexpr (!ALIGN_EPI) { if (wr == 0) PG8_BAR; }
    PG8_BAR;
    if constexpr (Epi::AFTER_DRAIN) { E.fused(acc, cur, wr, wc, fr, fq, lds, wid, lane); S.done(cur); }
#undef PG8_SA
#undef PG8_SB
#undef PG8_STAGE
#undef PG8_LDA
#undef PG8_LDB
#undef PG8_MMA
#undef PG8_WAIT_V
#undef PG8_WAIT_L
#undef PG8_BAR
#undef PG8_SCHED
}

}
#ifndef STAGE_REP
#define STAGE_REP 0
#endif

constexpr int NWAVES = 8;
constexpr int D = 1024, BATCH = 2, T = 8192, TC = 256, NH = 16;
constexpr int ML = BATCH * T;
constexpr int MC = BATCH * TC;
constexpr int MT = ML + MC;
constexpr int N_IN = 8576, NZ = 8704;
constexpr int K_OFF = 0, V_OFF = 1024, DECAY_OFF = 2048, ICLR_OFF = 2176, STATE_COLS = 2304, R_OFF = 2304, GLORA_OFF = 3328, SHIFT_COLS = 3456;
constexpr int CONV_OFF = 3456, GATE_OFF = 6528;
constexpr int NE = 32, TOPK = 4, DFF = 1024;
constexpr int NL = 5120, KL = 384;
constexpr int MAXBLK = 288;
constexpr int NROWS = MAXBLK * 256;
constexpr int KSPLIT = 16;

constexpr size_t MiB = 1u << 20;
constexpr size_t WS_CTL = 0, CTL_ZERO_BYTES = 1 * MiB;
constexpr size_t WS_MODP = 1 * MiB;
constexpr size_t WS_WLORA = 3 * MiB;
constexpr size_t WS_WROUT = 7 * MiB;
constexpr size_t WS_WOUT = 8 * MiB;
constexpr size_t WS_WIN = 10 * MiB;
constexpr size_t WS_A0 = 28 * MiB;
constexpr size_t WS_MISC = 61 * MiB;
constexpr size_t WS_Z = 64 * MiB;
constexpr size_t WS_AL = 345 * MiB;
constexpr size_t WS_LORA = 358 * MiB;
constexpr size_t WS_SCAN = 523 * MiB;
constexpr size_t WS_Y = 886 * MiB;
constexpr size_t WS_END = 1014 * MiB;
constexpr size_t WS_PQ = WS_SCAN;
constexpr size_t WS_TKN = WS_PQ + 132 * MiB;
constexpr size_t WS_UPRE = WS_TKN + 66 * MiB;
constexpr size_t WS_H0T = WS_UPRE + 66 * MiB;
static_assert(WS_H0T + 64 * MiB <= WS_Y, "scan region");
constexpr size_t WS_MIX = WS_LORA, WS_X1 = WS_LORA + 64 * MiB, WS_H2 = WS_LORA + 128 * MiB;
constexpr size_t WS_LOGIT = WS_SCAN, WS_XB = WS_SCAN + 16 * MiB, WS_ACT = WS_XB + 144 * MiB;
constexpr size_t WS_Y2 = WS_Z, WS_WEIN = WS_Y, WS_WEOUT = WS_Y + 64 * MiB;
static_assert(WS_ACT + 144 * MiB <= WS_Y && WS_WEIN + 64 * MiB <= WS_WEOUT && WS_WEOUT + 64 * MiB <= WS_END, "late regions");
constexpr size_t MI_SELE = WS_MISC, MI_SELP = MI_SELE + (size_t)ML * 4 * 4, MI_GATE = MI_SELP + (size_t)ML * 4 * 4, MI_DEST = MI_GATE + (size_t)ML * 4 * 4, MI_BLKE = MI_DEST + (size_t)ML * 4 * 4;
constexpr size_t MI_RSH = MI_BLKE + 4096;
constexpr size_t MI_CSWIN = MI_RSH + (size_t)MT * 4;
constexpr size_t MI_RSH2 = MI_CSWIN + (size_t)NZ * 4;
constexpr size_t MI_RSXB = MI_RSH2 + (size_t)ML * 4;
constexpr size_t MI_CSWEI = MI_RSXB + (size_t)NROWS * 4;
constexpr size_t MI_BON = MI_CSWEI + (size_t)NE * 2048 * 4;
static_assert(MI_BON + (size_t)4096 * 64 * 4 <= WS_Z && MI_RSH % 16 == 0 && MI_CSWIN % 16 == 0 && MI_CSWEI % 16 == 0, "misc");
constexpr size_t WS_H2Q = WS_A0;
constexpr int CW_BAR = 4096;
constexpr int CW_CNT = 16384;
constexpr int CW_FB = 8192;
constexpr int CW_Q6 = CW_CNT + 64 * 40;

constexpr int RING_OFF = 0, RING_BYTES = 131072;
constexpr int LDSCTL_OFF = 147456, MISC_OFF = LDSCTL_OFF + 320;
constexpr int LDS_X_OFF = LDSCTL_OFF + 512;
constexpr int LDS_BYTES = 163840;

#define GAS __attribute__((address_space(1)))
#define LAS __attribute__((address_space(3)))
typedef unsigned short bf16;
typedef unsigned v4u __attribute__((ext_vector_type(4)));
typedef unsigned v2u __attribute__((ext_vector_type(2)));
typedef float f32x4 __attribute__((ext_vector_type(4)));
#define LDS_WAIT() asm volatile("s_waitcnt lgkmcnt(0)" ::: "memory")
#define VM_WAIT() asm volatile("s_waitcnt vmcnt(0)" ::: "memory")
__device__ __forceinline__ unsigned f2bf(float f) { unsigned u = __builtin_bit_cast(unsigned, f); return (u + 0x7fffu + ((u >> 16) & 1u)) >> 16; }
__device__ __forceinline__ unsigned pk2(float lo, float hi) { return f2bf(lo) | (f2bf(hi) << 16); }
typedef __bf16 bf16v2h_t __attribute__((ext_vector_type(2)));
__device__ __forceinline__ unsigned pk2h(float lo, float hi) { const bf16v2h_t v = {(__bf16)lo, (__bf16)hi}; return __builtin_bit_cast(unsigned, v); }
__device__ __forceinline__ float bflo(unsigned w) { return __builtin_bit_cast(float, w << 16); }
__device__ __forceinline__ float bfhi(unsigned w) { return __builtin_bit_cast(float, w & 0xffff0000u); }
__device__ __forceinline__ float bf1(bf16 h) { return __builtin_bit_cast(float, (unsigned)h << 16); }
__device__ __forceinline__ void ld16bf(const bf16* p, float (&o)[16]) {
    const v4u a = *(const v4u*)p, b = *(const v4u*)(p + 8);
    o[0] = bflo(a.x); o[1] = bfhi(a.x); o[2] = bflo(a.y); o[3] = bfhi(a.y); o[4] = bflo(a.z); o[5] = bfhi(a.z); o[6] = bflo(a.w); o[7] = bfhi(a.w);
    o[8] = bflo(b.x); o[9] = bfhi(b.x); o[10] = bflo(b.y); o[11] = bfhi(b.y); o[12] = bflo(b.z); o[13] = bfhi(b.z); o[14] = bflo(b.w); o[15] = bfhi(b.w);
}
__device__ __forceinline__ void st16bf(bf16* p, const float (&o)[16]) {
    v4u a, b; a.x = pk2(o[0], o[1]); a.y = pk2(o[2], o[3]); a.z = pk2(o[4], o[5]); a.w = pk2(o[6], o[7]);
    b.x = pk2(o[8], o[9]); b.y = pk2(o[10], o[11]); b.z = pk2(o[12], o[13]); b.w = pk2(o[14], o[15]);
    *(v4u*)p = a; *(v4u*)(p + 8) = b;
}
__device__ __forceinline__ void ld16f(const float* p, float (&o)[16]) {
#pragma unroll
    for (int q = 0; q < 4; ++q) { const f32x4 v = *(const f32x4*)(p + 4 * q); o[4 * q] = v.x; o[4 * q + 1] = v.y; o[4 * q + 2] = v.z; o[4 * q + 3] = v.w; }
}
__device__ __forceinline__ void ld16f_lds(const LAS float* p, float (&o)[16]) {
#pragma unroll
    for (int q = 0; q < 4; ++q) { const f32x4 v = *(const LAS f32x4*)(p + 4 * q); o[4 * q] = v.x; o[4 * q + 1] = v.y; o[4 * q + 2] = v.z; o[4 * q + 3] = v.w; }
}
__device__ __forceinline__ void st16f(float* p, const float (&o)[16]) {
#pragma unroll
    for (int q = 0; q < 4; ++q) *(f32x4*)(p + 4 * q) = (f32x4){o[4 * q], o[4 * q + 1], o[4 * q + 2], o[4 * q + 3]};
}
__device__ __forceinline__ float sigmoidf_(float x) { return 1.0f / (1.0f + __expf(-x)); }
__device__ __forceinline__ float wave_sum(float v) {
#pragma unroll
    for (int o = 1; o < 64; o <<= 1) v += __shfl_xor(v, o);
    return v;
}
__device__ __forceinline__ float wave_max(float v) {
#pragma unroll
    for (int o = 1; o < 64; o <<= 1) v = fmaxf(v, __shfl_xor(v, o));
    return v;
}
__device__ __forceinline__ unsigned pack_q4(float a, float b, float c, float d) {
    const int qa = __float2int_rn(a), qb = __float2int_rn(b), qc = __float2int_rn(c), qd = __float2int_rn(d);
    return (unsigned)(qa & 255) | ((unsigned)(qb & 255) << 8) | ((unsigned)(qc & 255) << 16) | ((unsigned)qd << 24);
}
__device__ __forceinline__ float quad_sum(float v) { v += __shfl_xor(v, 1); v += __shfl_xor(v, 2); return v; }

#define XB_TMO      128
#define XB_XCNT(j)  (256  + 64 * (j))
#define XB_XSUB(j)  (1280 + 64 * (j))
#define XB_XGEN(j)  (2304 + 64 * (j))
#define XB_TOP      3328
#define XB_TOPGEN   3392
#define XCD_BAR_WORDS 3456
#define XB_SPIN_CAP (1u << 18)

__device__ __forceinline__ unsigned xb_ld(unsigned* p)              { return __hip_atomic_load(p, __ATOMIC_RELAXED, __HIP_MEMORY_SCOPE_AGENT); }
__device__ __forceinline__ unsigned xb_add(unsigned* p, unsigned v) { return __hip_atomic_fetch_add(p, v, __ATOMIC_RELAXED, __HIP_MEMORY_SCOPE_AGENT); }
__device__ __forceinline__ unsigned xb_xcc_id() { return (unsigned)__builtin_amdgcn_s_getreg((3 << 11) | 20) & 0xFu; }
#define XB_SPIN(cond, bar) do { unsigned _sp = 0; while (cond) { __builtin_amdgcn_s_sleep(1); \
    if ((++_sp & 255u) == 0u) { if (xb_ld(&(bar)[XB_TMO])) break; if (_sp > XB_SPIN_CAP) { atomicAdd(&(bar)[XB_TMO], 1u); break; } } } } while (0)

struct XcdBarrier { unsigned* bar; unsigned x; volatile LAS unsigned* st; };

__device__ __forceinline__ XcdBarrier xcd_barrier_post(unsigned* bar, volatile LAS unsigned* st) {
    XcdBarrier b; b.bar = bar; b.x = xb_xcc_id(); b.st = st;
    if (threadIdx.x == 0) (void)xb_add(&bar[XB_XCNT(b.x)], 1u);
    return b;
}
__device__ __forceinline__ void xcd_barrier_complete(unsigned* bar, unsigned x, unsigned& nloc, unsigned& nx) {
    const unsigned G = gridDim.x * gridDim.y * gridDim.z;
    unsigned sum, cnt, mine, sp = 0u;
    for (;;) {
        sum = 0u; cnt = 0u; mine = 0u;
#pragma unroll
        for (unsigned j = 0; j < 16; ++j) { const unsigned c = xb_ld(&bar[XB_XCNT(j)]); sum += c; cnt += (c > 0u) ? 1u : 0u; mine = (j == x) ? c : mine; }
        if (sum == G) break;
        __builtin_amdgcn_s_sleep(1);
        if ((++sp & 255u) == 0u) { if (xb_ld(&bar[XB_TMO])) break; if (sp > XB_SPIN_CAP) { atomicAdd(&bar[XB_TMO], 1u); break; } }
    }
    nloc = mine > 0u ? mine : 1u; nx = cnt > 0u ? cnt : 1u;
}
__device__ __forceinline__ void xcd_barrier(const XcdBarrier& b) {
    asm volatile("s_waitcnt vmcnt(0)" ::: "memory");
    __syncthreads();
    if (threadIdx.x == 0) {
        unsigned* bar = b.bar;
        __builtin_amdgcn_s_waitcnt(0);
        unsigned nloc = b.st[0], nx = b.st[1];
        if (nloc == 0u) { xcd_barrier_complete(bar, b.x, nloc, nx); b.st[0] = nloc; b.st[1] = nx; }
        const unsigned old = xb_add(&bar[XB_XSUB(b.x)], 1u);
        const unsigned gen = old / nloc;
        if (old + 1u == (gen + 1u) * nloc) {
            __builtin_amdgcn_fence(__ATOMIC_RELEASE, "agent");
            asm volatile("s_waitcnt vmcnt(0)" ::: "memory");
            const unsigned og = xb_add(&bar[XB_TOP], 1u);
            const unsigned tg = og / nx;
            if (og + 1u == (tg + 1u) * nx) xb_add(&bar[XB_TOPGEN], 1u);
            else XB_SPIN(xb_ld(&bar[XB_TOPGEN]) == tg, bar);
            __builtin_amdgcn_fence(__ATOMIC_ACQUIRE, "agent");
            xb_add(&bar[XB_XGEN(b.x)], 1u);
            asm volatile("s_waitcnt vmcnt(0)" ::: "memory");
        } else {
            XB_SPIN(xb_ld(&bar[XB_XGEN(b.x)]) == gen, bar);
            __builtin_amdgcn_fence(__ATOMIC_ACQUIRE, "agent");
            asm volatile("s_waitcnt vmcnt(0)" ::: "memory");
        }
    }
    __syncthreads();
}

#define XB_DONE(j)  (3456 + 64 * (j))
__device__ __forceinline__ void xcd_barrier2(const XcdBarrier& b) {
    asm volatile("s_waitcnt vmcnt(0)" ::: "memory");
    __syncthreads();
    if (threadIdx.x == 0) {
        unsigned* bar = b.bar;
        __builtin_amdgcn_s_waitcnt(0);
        unsigned nloc = b.st[0], nx = b.st[1];
        if (nloc == 0u) { xcd_barrier_complete(bar, b.x, nloc, nx); b.st[0] = nloc; b.st[1] = nx; }
        const unsigned old = xb_add(&bar[XB_XSUB(b.x)], 1u);
        const unsigned gen = old / nloc;
        if (old + 1u == (gen + 1u) * nloc) {
            __builtin_amdgcn_fence(__ATOMIC_RELEASE, "agent");
            asm volatile("s_waitcnt vmcnt(0)" ::: "memory");
#pragma unroll
            for (unsigned j = 0; j < 16; ++j) (void)xb_add(&bar[XB_DONE(j)], 1u);
        }
        XB_SPIN(xb_ld(&bar[XB_DONE(b.x)]) < (gen + 1u) * nx, bar);
        __builtin_amdgcn_fence(__ATOMIC_ACQUIRE, "agent");
        asm volatile("s_waitcnt vmcnt(0)" ::: "memory");
    }
    __syncthreads();
}

#define FB_WORD(j) (64 * (j))
#define FB_TMO 640
__device__ __forceinline__ void flat_barrier(unsigned* fb, unsigned epoch) {
    asm volatile("s_waitcnt vmcnt(0)" ::: "memory");
    __syncthreads();
    if (threadIdx.x == 0) {
        __builtin_amdgcn_s_waitcnt(0);
        __builtin_amdgcn_fence(__ATOMIC_RELEASE, "agent");
        asm volatile("s_waitcnt vmcnt(0)" ::: "memory");
        (void)xb_add(&fb[FB_WORD(blockIdx.x & 7u)], 1u);
        const unsigned want = epoch * gridDim.x; unsigned sp = 0u;
        for (;;) {
            unsigned s = 0u;
#pragma unroll
            for (int j = 0; j < 8; ++j) s += xb_ld(&fb[FB_WORD(j)]);
            if (s >= want) break;
            __builtin_amdgcn_s_sleep(1);
            if ((++sp & 255u) == 0u) { if (xb_ld(&fb[FB_TMO])) break; if (sp > XB_SPIN_CAP) { atomicAdd(&fb[FB_TMO], 1u); break; } }
        }
        __builtin_amdgcn_fence(__ATOMIC_ACQUIRE, "agent");
        asm volatile("s_waitcnt vmcnt(0)" ::: "memory");
    }
    __syncthreads();
}

struct Frame {
    LAS unsigned char* lds;
    volatile LAS unsigned* MISC;
    unsigned* ctl;
    int tid, lane, wave, G, gw, NGW;
    float* out;
    unsigned char* ws;
};
enum { I_X = 0, I_C, I_CTX, I_CCTX, I_WADA, I_BADA, I_NPM, I_NQM, I_NPF, I_NQF, I_WIN, I_MU, I_W0, I_WDU, I_A0, I_WIU, I_KK, I_KA, I_RK, I_WGU, I_LNW, I_LNB, I_CONVW,
       I_WOUT, I_WR, I_BR, I_WEI, I_BEI, I_WEO, I_BEO };


typedef const float* fptr_t;
__device__ __forceinline__ fptr_t kin_ptr(int i) { const volatile __attribute__((address_space(4))) fptr_t* ka = (const volatile __attribute__((address_space(4))) fptr_t*)__builtin_amdgcn_kernarg_segment_ptr(); return ka[i]; }
#define KIN(i) kin_ptr(i)
__device__ __forceinline__ void transpose_item(const float* W, int N, int k0, int n0, bf16* WT, int ldk, int rowbase, LAS float* scr, int lane) {
#pragma unroll 8
    for (int i = 0; i < 32; ++i) { const int kk = 2 * i + (lane >> 5); scr[kk * 33 + (lane & 31)] = W[(size_t)(k0 + kk) * N + n0 + (lane & 31)]; }
    LDS_WAIT(); asm volatile("" ::: "memory");
    const int c = lane & 7;
#pragma unroll
    for (int j = 0; j < 4; ++j) { const int n = (lane >> 3) + 8 * j; const LAS float* s = scr + (8 * c) * 33 + n;
        v4u o; o.x = pk2(s[0 * 33], s[1 * 33]); o.y = pk2(s[2 * 33], s[3 * 33]); o.z = pk2(s[4 * 33], s[5 * 33]); o.w = pk2(s[6 * 33], s[7 * 33]);
        *(v4u*)(WT + (size_t)(rowbase + n) * ldk + k0 + 8 * c) = o; }
    LDS_WAIT(); asm volatile("" ::: "memory");
}

__device__ __forceinline__ unsigned pack_q4c(float a, float b, float c, float d) {
    const int qa = __float2int_rn(fminf(fmaxf(a, -127.f), 127.f)), qb = __float2int_rn(fminf(fmaxf(b, -127.f), 127.f)), qc = __float2int_rn(fminf(fmaxf(c, -127.f), 127.f)), qd = __float2int_rn(fminf(fmaxf(d, -127.f), 127.f));
    return (unsigned)(qa & 255) | ((unsigned)(qb & 255) << 8) | ((unsigned)(qc & 255) << 16) | ((unsigned)qd << 24);
}
__device__ __forceinline__ void q8_item(const float* W, int N, int n0, signed char* WT, float* cs, int rowbase, LAS float* scr, int lane, int kb0 = 0, int kb1 = 16) {
    const int r8 = lane >> 3, c4 = lane & 7;
    const float* p0 = W + (size_t)r8 * N + n0 + 4 * c4;
    f32x4 ss = {0.f, 0.f, 0.f, 0.f};
#pragma unroll 8
    for (int i = 0; i < 32; ++i) { const f32x4 v = *(const f32x4*)(p0 + (size_t)(8 * i) * N); ss += v * v; }
#pragma unroll
    for (int o = 8; o < 64; o <<= 1) { ss.x += __shfl_xor(ss.x, o); ss.y += __shfl_xor(ss.y, o); ss.z += __shfl_xor(ss.z, o); ss.w += __shfl_xor(ss.w, o); }
    if (lane < 8) {
#pragma unroll
        for (int q = 0; q < 4; ++q) { const float m = 6.0f * sqrtf(ss[q] * (1.0f / 256.0f)); cs[rowbase + 4 * lane + q] = m * (1.0f / 127.0f); scr[2112 + 4 * lane + q] = m > 0.f ? 127.0f / m : 0.f; } }
    LDS_WAIT(); asm volatile("" ::: "memory");
    f32x4 cur[8];
#pragma unroll
    for (int i = 0; i < 8; ++i) cur[i] = *(const f32x4*)(p0 + (size_t)(64 * kb0 + 8 * i) * N);
    for (int kb = kb0; kb < kb1; ++kb) {
        f32x4 nxt[8];
        const int kn = kb < kb1 - 1 ? kb + 1 : kb;
#pragma unroll
        for (int i = 0; i < 8; ++i) nxt[i] = *(const f32x4*)(p0 + (size_t)(64 * kn + 8 * i) * N);
#pragma unroll
        for (int i = 0; i < 8; ++i) { LAS float* s = scr + (r8 + 8 * i) * 33 + 4 * c4; s[0] = cur[i].x; s[1] = cur[i].y; s[2] = cur[i].z; s[3] = cur[i].w; }
        LDS_WAIT(); asm volatile("" ::: "memory");
        const int c = lane & 3;
#pragma unroll
        for (int j = 0; j < 2; ++j) { const int n = (lane >> 2) + 16 * j; const float iv = scr[2112 + n]; const LAS float* s = scr + (16 * c) * 33 + n;
            v4u o; o.x = pack_q4c(s[0] * iv, s[33] * iv, s[66] * iv, s[99] * iv); o.y = pack_q4c(s[132] * iv, s[165] * iv, s[198] * iv, s[231] * iv);
            o.z = pack_q4c(s[264] * iv, s[297] * iv, s[330] * iv, s[363] * iv); o.w = pack_q4c(s[396] * iv, s[429] * iv, s[462] * iv, s[495] * iv);
            *(v4u*)(WT + (size_t)(rowbase + n) * 1024 + 64 * kb + 16 * c) = o; }
        LDS_WAIT(); asm volatile("" ::: "memory");
#pragma unroll
        for (int i = 0; i < 8; ++i) cur[i] = nxt[i];
    }
}

struct CvTile { f32x4 v[8]; };
__device__ __forceinline__ void cv_load(CvTile& t, const float* W, int N, int n0, int kb, int lane) {
    const float* p0 = W + (size_t)(64 * kb + (lane >> 3)) * N + n0 + 4 * (lane & 7);
#pragma unroll
    for (int i = 0; i < 8; ++i) t.v[i] = *(const f32x4*)(p0 + (size_t)(8 * i) * N);
}
__device__ __forceinline__ void cv_to_lds(const CvTile& t, LAS float* scr, int lane) {
    const int r8 = lane >> 3, c4 = lane & 7;
#pragma unroll
    for (int i = 0; i < 8; ++i) { LAS float* s = scr + (r8 + 8 * i) * 33 + 4 * c4; s[0] = t.v[i].x; s[1] = t.v[i].y; s[2] = t.v[i].z; s[3] = t.v[i].w; }
    LDS_WAIT(); asm volatile("" ::: "memory");
}
__device__ __forceinline__ void cv_store_bf16(const LAS float* scr, bf16* WT, int ldk, int rowbase, int k0, int lane) {
    const int c = lane & 7;
#pragma unroll
    for (int j = 0; j < 4; ++j) { const int n = (lane >> 3) + 8 * j; const LAS float* s = scr + (8 * c) * 33 + n;
        v4u o; o.x = pk2h(s[0 * 33], s[1 * 33]); o.y = pk2h(s[2 * 33], s[3 * 33]); o.z = pk2h(s[4 * 33], s[5 * 33]); o.w = pk2h(s[6 * 33], s[7 * 33]);
        *(v4u*)(WT + (size_t)(rowbase + n) * ldk + k0 + 8 * c) = o; }
    LDS_WAIT(); asm volatile("" ::: "memory");
}
__device__ __forceinline__ unsigned q8_pack4(float a, float b, float c, float d) {
    const float M = 12582912.0f;
    const unsigned x0 = __builtin_bit_cast(unsigned, __builtin_amdgcn_fmed3f(a, -127.f, 127.f) + M), x1 = __builtin_bit_cast(unsigned, __builtin_amdgcn_fmed3f(b, -127.f, 127.f) + M);
    const unsigned x2 = __builtin_bit_cast(unsigned, __builtin_amdgcn_fmed3f(c, -127.f, 127.f) + M), x3 = __builtin_bit_cast(unsigned, __builtin_amdgcn_fmed3f(d, -127.f, 127.f) + M);
    return __builtin_amdgcn_perm(x1, x0, 0x0c0c0400u) | __builtin_amdgcn_perm(x3, x2, 0x04000c0cu);
}
__device__ __forceinline__ void cv_store_q8(const CvTile& t, LAS float* scr, signed char* WT, int rowbase, int kb, const float (&iv)[4], int lane) {
    LAS unsigned* img = (LAS unsigned*)scr;
    const int r8 = lane >> 3, c4 = lane & 7;
#pragma unroll
    for (int i = 0; i < 8; ++i) img[(r8 + 8 * i) * 9 + c4] = q8_pack4(t.v[i].x * iv[0], t.v[i].y * iv[1], t.v[i].z * iv[2], t.v[i].w * iv[3]);
    LDS_WAIT(); asm volatile("" ::: "memory");
    const int c = lane & 3;
#pragma unroll
    for (int j = 0; j < 2; ++j) { const int n = (lane >> 2) + 16 * j; const unsigned bs = (unsigned)(n & 3);
        const unsigned s01 = 0x0c0c0000u | bs | ((4u + bs) << 8), s23 = 0x00000c0cu | (bs << 16) | ((4u + bs) << 24);
        const LAS unsigned* s = img + (16 * c) * 9 + (n >> 2);
        v4u o;
        o.x = __builtin_amdgcn_perm(s[9], s[0], s01) | __builtin_amdgcn_perm(s[27], s[18], s23);
        o.y = __builtin_amdgcn_perm(s[45], s[36], s01) | __builtin_amdgcn_perm(s[63], s[54], s23);
        o.z = __builtin_amdgcn_perm(s[81], s[72], s01) | __builtin_amdgcn_perm(s[99], s[90], s23);
        o.w = __builtin_amdgcn_perm(s[117], s[108], s01) | __builtin_amdgcn_perm(s[135], s[126], s23);
        *(v4u*)(WT + (size_t)(rowbase + n) * 1024 + 64 * kb + 16 * c) = o; }
    LDS_WAIT(); asm volatile("" ::: "memory");
}
__device__ __forceinline__ void cv_scale_q8(const float* W, int N, int n0, float* cs, int rowbase, int lane, float (&iv)[4]) {
    const float* p0 = W + (size_t)(lane >> 3) * N + n0 + 4 * (lane & 7);
    f32x4 ss = {0.f, 0.f, 0.f, 0.f};
#pragma unroll 8
    for (int i = 0; i < 32; ++i) { const f32x4 v = *(const f32x4*)(p0 + (size_t)(8 * i) * N); ss += v * v; }
#pragma unroll
    for (int o = 8; o < 64; o <<= 1) { ss.x += __shfl_xor(ss.x, o); ss.y += __shfl_xor(ss.y, o); ss.z += __shfl_xor(ss.z, o); ss.w += __shfl_xor(ss.w, o); }
#pragma unroll
    for (int q = 0; q < 4; ++q) { const float m = 6.0f * sqrtf(ss[q] * (1.0f / 256.0f)); if (lane < 8) cs[rowbase + 4 * lane + q] = m * (1.0f / 127.0f); iv[q] = m > 0.f ? 127.0f / m : 0.f; }
}
__device__ __forceinline__ void wei_strip(int s, int& e, int& n0, int& rowbase) { e = s >> 6; n0 = 32 * (s & 63); const int c = n0 & 1023; rowbase = (c >> 7) * 256 + (n0 >= 1024 ? 128 : 0) + (c & 127); }

__device__ __forceinline__ float mod_val(const float* modp, const float* b_ada, int vec, int j) {
    float s = b_ada[j];
#pragma unroll
    for (int ks = 0; ks < KSPLIT; ++ks) s += modp[((size_t)ks * 3 + vec) * 6144 + j];
    return s;
}
__device__ __forceinline__ int nbr_row(int row, int j) {
    if (row < ML) { const int t = row & (T - 1), gc = t & 63, gr = t >> 6;
        if (j == 0) return gc > 0 ? row - 1 : -1; if (j == 1) return gc < 63 ? row + 1 : -1; if (j == 2) return gr > 0 ? row - 64 : -1; return gr < 127 ? row + 64 : -1; }
    const int tc = (row - ML) & (TC - 1);
    if ((j & 1) == 0) return tc > 0 ? row - 1 : -1; return tc < TC - 1 ? row + 1 : -1;
}
__device__ __forceinline__ void load_shift16(const bf16* z, int row, int col0, const LAS float* mu, float (&out)[16]) {
    float s[16]; ld16bf(z + (size_t)row * NZ + col0, s);
    float m[16]; ld16f_lds(mu, m);
#pragma unroll
    for (int j = 0; j < 4; ++j) {
        const int nr = nbr_row(row, j); float t[16];
        if (nr >= 0) ld16bf(z + (size_t)nr * NZ + col0, t); else {
#pragma unroll
            for (int i = 0; i < 16; ++i) t[i] = 0.f; }
#pragma unroll
        for (int i = j; i < 16; i += 4) out[i] = s[i] + m[i] * (t[i] - s[i]);
    }
}

__device__ __forceinline__ void phase_prologue(Frame& F) {
    LAS float* scr = (LAS float*)(F.lds + RING_OFF + F.wave * 16384);
    LAS float* sil = (LAS float*)(F.lds + LDS_X_OFF);
    for (int i = F.tid; i < 3 * D; i += NWAVES * 64) { const int v = i / D, j = i % D; const float c = v < 2 ? KIN(I_C)[v * D + j] : KIN(I_CCTX)[j]; sil[i] = c / (1.0f + __expf(-c)); }
    __syncthreads();
    bf16* WoutT = (bf16*)(F.ws + WS_WOUT);
    constexpr int IT_WIN = (N_IN / 32) * 4, IT_WOUT = (D / 64) * (D / 32), IT_ADA = 24 * KSPLIT;
    constexpr int NITEMS = IT_ADA + IT_WIN + IT_WOUT;
    float* modp = (float*)(F.ws + WS_MODP);
    for (int it = F.gw; it < NITEMS; it += F.NGW) {
        int r = it;
        if (r < IT_ADA) {
            const int cc = r % 24, ks = r / 24, col = cc * 256 + F.lane * 4;
            f32x4 a0 = {0.f, 0.f, 0.f, 0.f}, a1 = a0, a2 = a0;
            const float* wp = KIN(I_WADA) + (size_t)(ks * 64) * 6144 + col;
#pragma unroll 8
            for (int k = 0; k < 64; ++k) { const f32x4 w = *(const f32x4*)(wp + (size_t)k * 6144); const int kk = ks * 64 + k;
                a0 += w * sil[kk]; a1 += w * sil[D + kk]; a2 += w * sil[2 * D + kk]; }
            *(f32x4*)(modp + ((size_t)ks * 3 + 0) * 6144 + col) = a0; *(f32x4*)(modp + ((size_t)ks * 3 + 1) * 6144 + col) = a1; *(f32x4*)(modp + ((size_t)ks * 3 + 2) * 6144 + col) = a2;
            continue; }
        r -= IT_ADA;
        if (r < IT_WIN) { const int st = r >> 2, qq = r & 3; q8_item(KIN(I_WIN), N_IN, 32 * st, (signed char*)(F.ws + WS_WIN), (float*)(F.ws + MI_CSWIN), 32 * st, scr, F.lane, 4 * qq, 4 * qq + 4); continue; }
        r -= IT_WIN;
        { const int nb = D / 32, kb = r / nb, n0 = 32 * (r % nb); transpose_item(KIN(I_WOUT), D, 64 * kb, n0, WoutT, D, n0, scr, F.lane); }
    }
    const int gt = blockIdx.x * (NWAVES * 64) + F.tid, NGT = F.G * NWAVES * 64;
    for (int i = gt; i < (NZ - N_IN) * D / 16; i += NGT) *(v4u*)(F.ws + WS_WIN + (size_t)N_IN * D + (size_t)i * 16) = (v4u){0u, 0u, 0u, 0u};
    for (int i = gt; i < NZ - N_IN; i += NGT) ((float*)(F.ws + MI_CSWIN))[N_IN + i] = 0.f;
    bf16* WL = (bf16*)(F.ws + WS_WLORA);
    for (int i = gt; i < NL * (KL / 8); i += NGT) {
        const int c8 = i / NL, row = i % NL, blk = row >> 10, n = row & 1023, col = c8 * 8, g = col >> 6;
        const float* src = nullptr; int kofs = 0;
        if (blk < 2) { if (g == blk) { src = KIN(I_WDU) + (size_t)blk * 64 * D; kofs = col - 64 * blk; } }
        else if (blk < 4) { if (g == blk) { src = KIN(I_WIU) + (size_t)(blk - 2) * 64 * D; kofs = col - 64 * blk; } }
        else { if (g >= 4) { src = KIN(I_WGU); kofs = col - 256; } }
        v4u o = {0u, 0u, 0u, 0u};
        if (src) { float v[8];
#pragma unroll
            for (int q = 0; q < 8; ++q) v[q] = src[(size_t)(kofs + q) * D + n];
            o.x = pk2(v[0], v[1]); o.y = pk2(v[2], v[3]); o.z = pk2(v[4], v[5]); o.w = pk2(v[6], v[7]); }
        *(v4u*)(WL + (size_t)row * KL + col) = o;
    }
    bf16* WR = (bf16*)(F.ws + WS_WROUT);
    for (int i = gt; i < 256 * (D / 8); i += NGT) {
        const int row = i % 256, c8 = i / 256; v4u o = {0u, 0u, 0u, 0u};
        if (row < NE) { float v[8];
#pragma unroll
            for (int q = 0; q < 8; ++q) v[q] = KIN(I_WR)[(size_t)(c8 * 8 + q) * NE + row];
            o.x = pk2(v[0], v[1]); o.y = pk2(v[2], v[3]); o.z = pk2(v[4], v[5]); o.w = pk2(v[6], v[7]); }
        *(v4u*)(WR + (size_t)row * D + c8 * 8) = o;
    }
}

__device__ __forceinline__ void phase_hrows(Frame& F) {
    LAS float* LA = (LAS float*)(F.lds);
    LAS float* LB = LA + 3 * D;
    const float* modp = (const float*)(F.ws + WS_MODP);
    for (int i = F.tid; i < 3 * D; i += NWAVES * 64) { const int v = i / D, j = i % D;
        LA[i] = KIN(I_NPM)[j] * (1.0f + mod_val(modp, KIN(I_BADA), v, 1024 + j)); LB[i] = mod_val(modp, KIN(I_BADA), v, j); }
    __syncthreads();
    signed char* A0q = (signed char*)(F.ws + WS_A0);
    for (int row = F.gw; row < MT; row += F.NGW) {
        const float* xr; int vec;
        if (row < ML) { xr = KIN(I_X) + (size_t)row * D; vec = row >> 13; } else { xr = KIN(I_CTX) + (size_t)(row - ML) * D; vec = 2; }
        f32x4 v[4]; float s = 0.f;
#pragma unroll
        for (int j = 0; j < 4; ++j) { v[j] = *(const f32x4*)(xr + 4 * F.lane + 256 * j); s += (v[j].x * v[j].x + v[j].y * v[j].y) + (v[j].z * v[j].z + v[j].w * v[j].w); }
        const float rstd = 1.0f / sqrtf(wave_sum(s) * (1.0f / D) + 1e-6f);
        f32x4 hq[4]; float mx = 0.f;
#pragma unroll
        for (int j = 0; j < 4; ++j) { const int c = 4 * F.lane + 256 * j; const f32x4 a = *(const LAS f32x4*)(LA + vec * D + c), b = *(const LAS f32x4*)(LB + vec * D + c);
            hq[j] = v[j] * rstd * a + b; mx = fmaxf(mx, fmaxf(fmaxf(fabsf(hq[j].x), fabsf(hq[j].y)), fmaxf(fabsf(hq[j].z), fabsf(hq[j].w)))); }
        mx = wave_max(mx);
        const float iv = mx > 0.f ? 127.0f / mx : 0.f;
        if (F.lane == 0) ((float*)(F.ws + MI_RSH))[row] = mx * (1.0f / 127.0f);
        unsigned* o4 = (unsigned*)(A0q + (size_t)row * D) + F.lane;
#pragma unroll
        for (int j = 0; j < 4; ++j) o4[64 * j] = pack_q4(hq[j].x * iv, hq[j].y * iv, hq[j].z * iv, hq[j].w * iv);
    }
}

__device__ __forceinline__ void phase_lora_in(Frame& F) {
    const bf16* z = (const bf16*)(F.ws + WS_Z); bf16* AL = (bf16*)(F.ws + WS_AL);
    const int gt = blockIdx.x * (NWAVES * 64) + F.tid, NGT = F.G * NWAVES * 64;
    for (int i = gt; i < MT * (KL / 4); i += NGT) {
        const int row = i / (KL / 4), q = i % (KL / 4), j0 = 4 * q;
        const int zc = j0 < 256 ? DECAY_OFF + j0 : GLORA_OFF + (j0 - 256);
        float o[4];
        if (j0 >= 256 && row >= ML) { o[0] = o[1] = o[2] = o[3] = 0.f; }
        else {
            const uint2 sv = *(const uint2*)(z + (size_t)row * NZ + zc); const float s[4] = {bflo(sv.x), bfhi(sv.x), bflo(sv.y), bfhi(sv.y)};
#pragma unroll
            for (int j = 0; j < 4; ++j) { const int nr = nbr_row(row, j); float t = 0.f;
                if (nr >= 0) t = bf1(z[(size_t)nr * NZ + zc + j]);
                const float v = s[j] + KIN(I_MU)[zc + j] * (t - s[j]);
                o[j] = j0 < 128 ? tanhf(v) : (j0 < 256 ? v : sigmoidf_(v)); }
        }
        *(uint2*)(AL + (size_t)row * KL + j0) = make_uint2(pk2(o[0], o[1]), pk2(o[2], o[3]));
    }
}


namespace ck {
typedef short bf16x8 __attribute__((ext_vector_type(8)));
constexpr int TILE = 8192;
constexpr int NU_L = BATCH * (T / 64) * NH;
constexpr int NU_ALL = NU_L + BATCH * (TC / 64) * NH;
__device__ __forceinline__ int swz(int row) { return (row ^ (row >> 3)) & 7; }
__device__ __forceinline__ int toff(int row, int col) { return row * 128 + ((col * 2) ^ (swz(row) << 4)); }
__device__ __forceinline__ bf16x8 ldfrag(const LAS unsigned char* t, int row, int chunk) { return *(const LAS bf16x8*)(t + row * 128 + ((chunk ^ swz(row)) << 4)); }
typedef __bf16 bf16v2_t __attribute__((ext_vector_type(2)));
__device__ __forceinline__ unsigned cvtpk(float lo, float hi) { const bf16v2_t v = {(__bf16)lo, (__bf16)hi}; return __builtin_bit_cast(unsigned, v); }
#define CK_MFMA(a, b, c) __builtin_amdgcn_mfma_f32_16x16x32_bf16(a, b, c, 0, 0, 0)
template <bool MASKDIAG>
__device__ __forceinline__ void mm64(f32x4 (&acc)[4], const LAS unsigned char* Lt, const LAS unsigned char* Rt, int wq, int lane) {
    const int lr = lane & 15, g = lane >> 4;
    const bf16x8 l0 = ldfrag(Lt, 16 * wq + lr, g), l1 = ldfrag(Lt, 16 * wq + lr, 4 + g);
#pragma unroll
    for (int n = 0; n < 4; ++n) {
        bf16x8 r0 = ldfrag(Rt, 16 * n + lr, g), r1 = ldfrag(Rt, 16 * n + lr, 4 + g);
        if (MASKDIAG) { const bf16x8 zz = {0, 0, 0, 0, 0, 0, 0, 0}; if ((g >> 1) == n) r0 = zz; if (2 + (g >> 1) == n) r1 = zz; }
        acc[n] = CK_MFMA(l0, r0, acc[n]); acc[n] = CK_MFMA(l1, r1, acc[n]);
    }
}
__device__ __forceinline__ void zero4(f32x4 (&a)[4]) {
#pragma unroll
    for (int n = 0; n < 4; ++n) a[n] = (f32x4){0.f, 0.f, 0.f, 0.f};
}
__device__ __forceinline__ void storeT(LAS unsigned char* t, const f32x4 (&v)[4], int wq, int lane) {
    const int lr = lane & 15, g = lane >> 4;
#pragma unroll
    for (int n = 0; n < 4; ++n) *(LAS v2u*)(t + toff(16 * n + lr, 16 * wq + 4 * g)) = (v2u){cvtpk(v[n][0], v[n][1]), cvtpk(v[n][2], v[n][3])};
}
__device__ __forceinline__ void storeN(LAS unsigned char* t, const f32x4 (&v)[4], int wq, int lane) {
    const int lr = lane & 15, g = lane >> 4;
#pragma unroll
    for (int n = 0; n < 4; ++n)
#pragma unroll
        for (int i = 0; i < 4; ++i) *(LAS unsigned short*)(t + toff(16 * wq + 4 * g + i, 16 * n + lr)) = (unsigned short)f2bf(v[n][i]);
}
__device__ __forceinline__ void loadT(f32x4 (&v)[4], const LAS unsigned char* t, int wq, int lane) {
    const int lr = lane & 15, g = lane >> 4;
#pragma unroll
    for (int n = 0; n < 4; ++n) { const v2u w = *(const LAS v2u*)(t + toff(16 * n + lr, 16 * wq + 4 * g)); v[n] = (f32x4){bflo(w.x), bfhi(w.x), bflo(w.y), bfhi(w.y)}; }
}
__device__ __forceinline__ void unit_decode(int unit, int& b, int& h, int& rowbase) {
    if (unit < NU_L) { h = unit & 15; const int blk = (unit >> 4) & 127; b = unit >> 11; rowbase = b * T + blk * 64; }
    else { const int u = unit - NU_L; h = u & 15; const int cb = (u >> 4) & 3; b = u >> 6; rowbase = ML + b * TC + cb * 64; }
}
__device__ __forceinline__ void pack8(LAS unsigned char* t, int row, int chunk, const float (&v)[8], bool rev) {
    v4u o;
    if (!rev) { o.x = cvtpk(v[0], v[1]); o.y = cvtpk(v[2], v[3]); o.z = cvtpk(v[4], v[5]); o.w = cvtpk(v[6], v[7]); }
    else { o.x = cvtpk(v[7], v[6]); o.y = cvtpk(v[5], v[4]); o.z = cvtpk(v[3], v[2]); o.w = cvtpk(v[1], v[0]); }
    *(LAS v4u*)(t + row * 128 + ((chunk ^ swz(row)) << 4)) = o;
}

__device__ __forceinline__ void unpack8(const v4u p, float (&o)[8]) {
    o[0] = bflo(p.x); o[1] = bfhi(p.x); o[2] = bflo(p.y); o[3] = bfhi(p.y); o[4] = bflo(p.z); o[5] = bfhi(p.z); o[6] = bflo(p.w); o[7] = bfhi(p.w);
}
__device__ __forceinline__ void ld8f(const float* p, float (&o)[8]) {
    const f32x4 a = *(const f32x4*)p, b = *(const f32x4*)(p + 4); o[0] = a.x; o[1] = a.y; o[2] = a.z; o[3] = a.w; o[4] = b.x; o[5] = b.y; o[6] = b.z; o[7] = b.w;
}
__device__ __forceinline__ float fsig(float x) { return __builtin_amdgcn_rcpf(1.0f + __expf(-x)); }
template <bool IS_CO> struct EPre { v4u k[5], v[5], r[IS_CO ? 5 : 1], lo[4]; };
template <bool IS_CO>
__device__ __forceinline__ void epre_load(EPre<IS_CO>& P, const bf16* z, const bf16* LO, int unit, int wave, int lane) {
    int b, h, rowbase; unit_decode(unit, b, h, rowbase);
    const int row = rowbase + 8 * wave + (lane >> 3), c0 = h * 64 + 8 * (lane & 7);
    const v4u zz = {0u, 0u, 0u, 0u};
    const bf16* zr = z + (size_t)row * NZ;
    P.k[0] = *(const v4u*)(zr + K_OFF + c0); P.v[0] = *(const v4u*)(zr + V_OFF + c0); if (IS_CO) P.r[0] = *(const v4u*)(zr + R_OFF + c0);
#pragma unroll
    for (int j = 0; j < 4; ++j) { const int nr = nbr_row(row, j); const bf16* zn = z + (size_t)(nr >= 0 ? nr : row) * NZ;
        const v4u a = *(const v4u*)(zn + K_OFF + c0), bq = *(const v4u*)(zn + V_OFF + c0);
        P.k[1 + j] = nr >= 0 ? a : zz; P.v[1 + j] = nr >= 0 ? bq : zz;
        if (IS_CO) { const v4u cq = *(const v4u*)(zn + R_OFF + c0); P.r[1 + j] = nr >= 0 ? cq : zz; } }
    const bf16* lr_ = LO + (size_t)row * NL + c0;
    P.lo[0] = *(const v4u*)(lr_); P.lo[1] = *(const v4u*)(lr_ + 1024); P.lo[2] = *(const v4u*)(lr_ + 2048); P.lo[3] = *(const v4u*)(lr_ + 3072);
}
__device__ __forceinline__ void shift8(const v4u (&q)[5], const float* mu, float (&out)[8]) {
    const v4u s = q[0], n0 = q[1], n1 = q[2], n2 = q[3], n3 = q[4];
    float m[8]; ld8f(mu, m);
    out[0] = bflo(s.x) + m[0] * (bflo(n0.x) - bflo(s.x)); out[1] = bfhi(s.x) + m[1] * (bfhi(n1.x) - bfhi(s.x));
    out[2] = bflo(s.y) + m[2] * (bflo(n2.y) - bflo(s.y)); out[3] = bfhi(s.y) + m[3] * (bfhi(n3.y) - bfhi(s.y));
    out[4] = bflo(s.z) + m[4] * (bflo(n0.z) - bflo(s.z)); out[5] = bfhi(s.z) + m[5] * (bfhi(n1.z) - bfhi(s.z));
    out[6] = bflo(s.w) + m[6] * (bflo(n2.w) - bflo(s.w)); out[7] = bfhi(s.w) + m[7] * (bfhi(n3.w) - bfhi(s.w));
}
__device__ __forceinline__ void putN(LAS unsigned char* t, int tau, int oct, const float (&v)[8]) {
    v4u o; o.x = cvtpk(v[0], v[1]); o.y = cvtpk(v[2], v[3]); o.z = cvtpk(v[4], v[5]); o.w = cvtpk(v[6], v[7]);
    *(LAS v4u*)(t + tau * 128 + ((oct ^ swz(tau)) << 4)) = o;
}
__device__ __forceinline__ void putT(LAS unsigned char* t, int tau, int ch0, const float (&v)[8]) {
#pragma unroll
    for (int i = 0; i < 8; ++i) *(LAS unsigned short*)(t + toff(ch0 + i, tau)) = (unsigned short)f2bf(v[i]);
}

template <bool IS_CO, bool STAGES = true>
__device__ __forceinline__ void phase_chunk(Frame& F) {
    const int wave = F.wave;
    const int dgrp = wave >> 2, wq = wave & 3;
    LAS unsigned char* tl = F.lds + dgrp * 9 * TILE;
#define SL(k) (tl + (k) * TILE)
    LAS float* SEG = (LAS float*)(F.lds + LDS_X_OFF);
    LAS float* GAM = SEG + 1024;
    LAS unsigned char* DIB = (LAS unsigned char*)(GAM + 128) + dgrp * 2048;
    LAS float* LW0 = (LAS float*)(F.lds + 7 * TILE);
    LAS float* LW1 = (LAS float*)(F.lds + 16 * TILE);
    const bf16* z = (const bf16*)(F.ws + WS_Z); const bf16* LO = (const bf16*)(F.ws + WS_LORA);
    unsigned char* PQ = F.ws + WS_PQ; unsigned char* TKN = F.ws + WS_TKN; unsigned char* UPRE = F.ws + WS_UPRE; unsigned char* H0T = F.ws + WS_H0T;
    bf16* MG = (bf16*)(F.ws + WS_A0);
    const float* p_mu = KIN(I_MU); const float* p_kk = KIN(I_KK); const float* p_ka = KIN(I_KA);
    const int NU = IS_CO ? NU_L : NU_ALL;
    EPre<IS_CO> PF;
    CvTile cvt; float civ[4] = {0.f, 0.f, 0.f, 0.f}; int cv_t = 0;
    const float* cv_w = KIN(I_WEI);
    LAS float* cv_scr = (LAS float*)(F.lds + wave * 16384);
    if ((int)blockIdx.x < NU) epre_load<IS_CO>(PF, z, LO, (int)blockIdx.x, wave, F.lane);
    for (int unit = blockIdx.x; unit < NU; unit += F.G) {
        int lane = F.lane; asm volatile("" : "+v"(lane));
        const int lr = lane & 15, g = lane >> 4;
        int b, h, rowbase; unit_decode(unit, b, h, rowbase);
        const int tok = 8 * wave + (lane >> 3), oct = lane & 7, ch0 = 8 * oct, c0 = h * 64 + ch0, row = rowbase + tok;
        float ks[8], vs[8], rs[8], kkp[8], lw0[8], lw1[8], kd0[8], kd1[8], a_0[8], a_1[8], ssq;
        {
            shift8(PF.k, p_mu + K_OFF + c0, ks);
            shift8(PF.v, p_mu + V_OFF + c0, vs);
            if (IS_CO) { v4u rr[5];
#pragma unroll
                for (int j = 0; j < 5; ++j) rr[j] = PF.r[IS_CO ? j : 0];
                shift8(rr, p_mu + R_OFF + c0, rs); }
            else {
#pragma unroll
                for (int i = 0; i < 8; ++i) rs[i] = 0.f; }
            float xw0[8], xw1[8], xa0[8], xa1[8];
            unpack8(PF.lo[0], xw0); unpack8(PF.lo[1], xw1); unpack8(PF.lo[2], xa0); unpack8(PF.lo[3], xa1);
            float kkk[8], kaa[8];
            ld8f(p_kk + c0, kkk); ld8f(p_ka + c0, kaa);
            float ss = 0.f;
#pragma unroll
            for (int i = 0; i < 8; ++i) {
                kkp[i] = ks[i] * kkk[i]; ss += kkp[i] * kkp[i];
                lw0[i] = xw0[i]; lw1[i] = xw1[i];
                a_0[i] = xa0[i]; a_1[i] = xa1[i];
                kd0[i] = ks[i] * (1.0f + (a_0[i] - 1.0f) * kaa[i]); kd1[i] = ks[i] * (1.0f + (a_1[i] - 1.0f) * kaa[i]);
                const int ch = ch0 + i, sw = tok ^ (4 * ((ch & 15) ^ (2 * (ch >> 4))));
                LW0[ch * 64 + sw] = lw0[i]; LW1[ch * 64 + sw] = lw1[i];
            }
            ss += __shfl_xor(ss, 1); ss += __shfl_xor(ss, 2); ss += __shfl_xor(ss, 4);
            ssq = ss;
        }
        __syncthreads();
        {
            const int ch2 = lane, seg = wave, sw = 4 * ((ch2 & 15) ^ (2 * (ch2 >> 4)));
            LAS f32x4* p0a = (LAS f32x4*)(LW0 + ch2 * 64 + ((8 * seg) ^ sw)); LAS f32x4* p0b = (LAS f32x4*)(LW0 + ch2 * 64 + ((8 * seg + 4) ^ sw));
            LAS f32x4* p1a = (LAS f32x4*)(LW1 + ch2 * 64 + ((8 * seg) ^ sw)); LAS f32x4* p1b = (LAS f32x4*)(LW1 + ch2 * 64 + ((8 * seg + 4) ^ sw));
            f32x4 a = *p0a, bq = *p0b, c = *p1a, d = *p1b;
            a.y += a.x; a.z += a.y; a.w += a.z; bq.x += a.w; bq.y += bq.x; bq.z += bq.y; bq.w += bq.z;
            d.z += d.w; d.y += d.z; d.x += d.y; c.w += d.x; c.z += c.w; c.y += c.z; c.x += c.y;
            SEG[seg * 64 + ch2] = bq.w; SEG[(8 + seg) * 64 + ch2] = c.x;
            __syncthreads();
            float off0 = 0.f, off1 = 0.f;
#pragma unroll
            for (int s2 = 0; s2 < 8; ++s2) { const float t0 = SEG[s2 * 64 + ch2], t1 = SEG[(8 + s2) * 64 + ch2]; off0 += (s2 < seg) ? t0 : 0.f; off1 += (s2 > seg) ? t1 : 0.f; }
            *p0a = a + off0; *p0b = bq + off0; *p1a = c + off1; *p1b = d + off1;
        }
        __syncthreads();
        {
            const float inv = 1.0f / fmaxf(sqrtf(ssq), 1e-12f);
            float t8[8], u8[8], w8[8];
            {
                LAS unsigned char* t0 = F.lds; const int tau = tok;
                float e1[8], ei[8];
#pragma unroll
                for (int i = 0; i < 8; ++i) { const int ch = ch0 + i; const float cm = LW0[ch * 64 + (tok ^ (4 * ((ch & 15) ^ (2 * (ch >> 4)))))]; e1[i] = __expf(cm); ei[i] = __builtin_amdgcn_rcpf(e1[i]); t8[i] = kkp[i] * inv * __expf(cm - lw0[i]); }
                if (tok == 63) {
#pragma unroll
                    for (int i = 0; i < 8; ++i) GAM[ch0 + i] = e1[i]; }
#pragma unroll
                for (int i = 0; i < 8; ++i) { u8[i] = kkp[i] * inv * a_0[i] * ei[i]; w8[i] = kd0[i] * ei[i]; }
                if (!IS_CO) { putN(t0 + 0 * TILE, tau, oct, t8); putT(t0 + 1 * TILE, tau, ch0, t8); putN(t0 + 2 * TILE, tau, oct, u8); putT(t0 + 3 * TILE, tau, ch0, u8);
                    putN(t0 + 4 * TILE, tau, oct, w8); putT(t0 + 5 * TILE, tau, ch0, w8); putT(t0 + 6 * TILE, tau, ch0, vs); }
                else {
#pragma unroll
                    for (int i = 0; i < 8; ++i) t8[i] = rs[i] * e1[i];
                    putN(t0 + 0 * TILE, tau, oct, w8); putN(t0 + 1 * TILE, tau, oct, u8); putN(t0 + 2 * TILE, tau, oct, t8); putT(t0 + 3 * TILE, tau, ch0, vs); }
            }
            {
                LAS unsigned char* t1 = F.lds + 9 * TILE; const int tau = 63 - tok;
                float e1[8], ei[8];
#pragma unroll
                for (int i = 0; i < 8; ++i) { const int ch = ch0 + i; const float cm = LW1[ch * 64 + (tok ^ (4 * ((ch & 15) ^ (2 * (ch >> 4)))))]; e1[i] = __expf(cm); ei[i] = __builtin_amdgcn_rcpf(e1[i]); t8[i] = kkp[i] * inv * __expf(cm - lw1[i]); }
                if (tok == 0) {
#pragma unroll
                    for (int i = 0; i < 8; ++i) GAM[64 + ch0 + i] = e1[i]; }
#pragma unroll
                for (int i = 0; i < 8; ++i) { u8[i] = kkp[i] * inv * a_1[i] * ei[i]; w8[i] = kd1[i] * ei[i]; }
                if (!IS_CO) { putN(t1 + 0 * TILE, tau, oct, t8); putT(t1 + 1 * TILE, tau, ch0, t8); putN(t1 + 2 * TILE, tau, oct, u8); putT(t1 + 3 * TILE, tau, ch0, u8);
                    putN(t1 + 4 * TILE, tau, oct, w8); putT(t1 + 5 * TILE, tau, ch0, w8); putT(t1 + 6 * TILE, tau, ch0, vs); }
                else {
#pragma unroll
                    for (int i = 0; i < 8; ++i) t8[i] = rs[i] * e1[i];
                    putN(t1 + 0 * TILE, tau, oct, w8); putN(t1 + 1 * TILE, tau, oct, u8); putN(t1 + 2 * TILE, tau, oct, t8); putT(t1 + 3 * TILE, tau, ch0, vs); }
            }
        }
        if (!STAGES) { __syncthreads(); continue; }
        const size_t inst = (size_t)unit * 2 + dgrp;
        const int t2 = (wq << 6) | lane;
        if (IS_CO) {
#pragma unroll
            for (int rep = 0; rep < 2; ++rep) { const int cidx = t2 + 256 * rep, row = cidx >> 3, ch = cidx & 7;
                const v4u a = *(const v4u*)(TKN + inst * 8192 + (size_t)(row * 64 + ch * 8) * 2), hh = *(const v4u*)(H0T + inst * 8192 + (size_t)(row * 64 + ch * 8) * 2);
                *(LAS v4u*)(SL(4) + row * 128 + ((ch ^ swz(row)) << 4)) = a; *(LAS v4u*)(SL(5) + row * 128 + ((ch ^ swz(row)) << 4)) = hh; }
        }
        v4u upre0 = {0u, 0u, 0u, 0u}, upre1 = upre0;
        if (IS_CO) { const unsigned char* up = UPRE + inst * 8192 + (size_t)((wq * 64 + lane) * 32); upre0 = *(const v4u*)up; upre1 = *(const v4u*)(up + 16); }
        if (unit + F.G < NU) epre_load<IS_CO>(PF, z, LO, unit + F.G, wave, lane);
        const int cv_strip = F.gw + (cv_t >> 4) * F.NGW, cv_kb = cv_t & 15;
        if (!IS_CO && cv_strip < NE * 64) { int e_, n0_, rb_; wei_strip(cv_strip, e_, n0_, rb_); cv_load(cvt, cv_w + (size_t)e_ * D * 2048, 2048, n0_, cv_kb, lane); }
        __syncthreads();
        f32x4 acc[4], acc2[4];
        if (!IS_CO) {
            zero4(acc); mm64<false>(acc, SL(2), SL(0), wq, lane);
            zero4(acc2); mm64<false>(acc2, SL(4), SL(0), wq, lane);
#pragma unroll
            for (int n = 0; n < 4; ++n)
#pragma unroll
                for (int q = 0; q < 4; ++q) { const bool lo = (16 * wq + 4 * g + q < 16 * n + lr); acc[n][q] = lo ? acc[n][q] : 0.f; acc2[n][q] = lo ? acc2[n][q] : 0.f; }
            storeT(SL(7), acc, wq, lane); storeT(SL(8), acc2, wq, lane);
            __syncthreads();
            zero4(acc); mm64<false>(acc, SL(8), SL(6), wq, lane); storeT(SL(0), acc, wq, lane);
            if (wq == 0) {
                const int bb = lane >> 4, jj = lane & 15;
                float X[16];
                X[0] = (jj == 0) ? 1.f : 0.f;
#pragma unroll
                for (int t = 1; t < 16; ++t) {
                    const int row = 16 * bb + t;
                    const v4u p0 = *(const LAS v4u*)(SL(7) + row * 128 + (((2 * bb) ^ swz(row)) << 4)), p1 = *(const LAS v4u*)(SL(7) + row * 128 + (((2 * bb + 1) ^ swz(row)) << 4));
                    float rw[16];
                    rw[0] = bflo(p0.x); rw[1] = bfhi(p0.x); rw[2] = bflo(p0.y); rw[3] = bfhi(p0.y); rw[4] = bflo(p0.z); rw[5] = bfhi(p0.z); rw[6] = bflo(p0.w); rw[7] = bfhi(p0.w);
                    rw[8] = bflo(p1.x); rw[9] = bfhi(p1.x); rw[10] = bflo(p1.y); rw[11] = bfhi(p1.y); rw[12] = bflo(p1.z); rw[13] = bfhi(p1.z); rw[14] = bflo(p1.w); rw[15] = bfhi(p1.w);
                    float xv = (t == jj) ? 1.f : 0.f;
#pragma unroll
                    for (int s = 0; s < t; ++s) xv -= rw[s] * X[s];
                    X[t] = xv;
                }
#pragma unroll
                for (int t = 0; t < 16; ++t) *(LAS unsigned short*)(DIB + (((bb * 16 + t) * 16 + jj) << 1)) = (unsigned short)f2bf(X[t]);
            }
            __syncthreads();
            {
                const bool isU = wq >= 2; const int cbase = 32 * (wq & 1);
                const LAS unsigned char* Rt = isU ? SL(0) : SL(1);
                LAS unsigned char* outT = isU ? SL(4) : SL(2);
#pragma unroll
                for (int ct = 0; ct < 2; ++ct) {
                    const int col = cbase + 16 * ct + lr;
                    f32x4 X[4];
#pragma unroll
                    for (int b = 0; b < 4; ++b) {
                        const v2u rwv = *(const LAS v2u*)(Rt + toff(col, 16 * b + 4 * g));
                        f32x4 Zt = {bflo(rwv.x), bfhi(rwv.x), bflo(rwv.y), bfhi(rwv.y)};
                        if (b >= 1) {
                            f32x4 Y = {0.f, 0.f, 0.f, 0.f};
#pragma unroll
                            for (int s = 0; s < (b + 1) / 2; ++s) {
                                v2u alo = {0u, 0u}, ahi = {0u, 0u};
                                if (2 * s < b) alo = *(const LAS v2u*)(SL(7) + toff(16 * b + lr, 32 * s + 4 * g));
                                if (2 * s + 1 < b) ahi = *(const LAS v2u*)(SL(7) + toff(16 * b + lr, 32 * s + 16 + 4 * g));
                                v4u bw = {cvtpk(X[2 * s][0], X[2 * s][1]), cvtpk(X[2 * s][2], X[2 * s][3]), 0u, 0u};
                                if (2 * s + 1 < b) { bw.z = cvtpk(X[2 * s + 1][0], X[2 * s + 1][1]); bw.w = cvtpk(X[2 * s + 1][2], X[2 * s + 1][3]); }
                                Y = CK_MFMA(__builtin_bit_cast(bf16x8, ((v4u){alo.x, alo.y, ahi.x, ahi.y})), __builtin_bit_cast(bf16x8, bw), Y);
                            }
                            Zt = Zt - Y;
                        }
                        const v2u dv = *(const LAS v2u*)(DIB + (((b * 16 + lr) * 16 + 4 * g) << 1));
                        const v4u bz = {cvtpk(Zt[0], Zt[1]), cvtpk(Zt[2], Zt[3]), 0u, 0u};
                        X[b] = CK_MFMA(__builtin_bit_cast(bf16x8, ((v4u){dv.x, dv.y, 0u, 0u})), __builtin_bit_cast(bf16x8, bz), ((f32x4){0.f, 0.f, 0.f, 0.f}));
                    }
#pragma unroll
                    for (int b = 0; b < 4; ++b) {
                        const v2u pk = {cvtpk(X[b][0], X[b][1]), cvtpk(X[b][2], X[b][3])};
                        *(LAS v2u*)(outT + toff(col, 16 * b + 4 * g)) = pk;
                        if (!isU) {
#pragma unroll
                            for (int q = 0; q < 4; ++q) *(LAS unsigned short*)(SL(8) + toff(16 * b + 4 * g + q, col)) = (unsigned short)f2bf(X[b][q]);
                        } else {
                            *(uint2*)(UPRE + inst * 8192 + (size_t)(((b * 64 + lane) * 4 + 2 * (wq & 1) + ct) * 8)) = make_uint2(pk.x, pk.y);
                        }
                    }
                }
            }
            __syncthreads();
            { zero4(acc); mm64<false>(acc, SL(2), SL(3), wq, lane);
              const int cstep_ = unit < NU_L ? 4 + (dgrp ? 127 - ((unit >> 4) & 127) : ((unit >> 4) & 127)) : (dgrp ? 3 - (((unit - NU_L) >> 4) & 3) : (((unit - NU_L) >> 4) & 3));
              unsigned char* pb = PQ + (size_t)(((b * 16 + h) * 2 + dgrp) * (4 + T / 64) + cstep_) * 16384;
#pragma unroll
              for (int n = 0; n < 4; ++n) { const int k = 16 * n + lr; const float gm = GAM[dgrp * 64 + k]; float p[4];
#pragma unroll
                  for (int q = 0; q < 4; ++q) p[q] = gm * (((16 * wq + 4 * g + q) == k ? 1.f : 0.f) - acc[n][q]);
                  *(uint2*)(pb + (size_t)(((n * 2 + (wq >> 1)) * 64 + lane) * 16 + (wq & 1) * 8)) = make_uint2(cvtpk(p[0], p[1]), cvtpk(p[2], p[3])); }
              zero4(acc); mm64<false>(acc, SL(5), SL(6), wq, lane); zero4(acc2); mm64<false>(acc2, SL(3), SL(4), wq, lane);
              const f32x4 gm4 = *(const LAS f32x4*)(GAM + dgrp * 64 + 16 * wq + 4 * g);
#pragma unroll
              for (int n = 0; n < 4; ++n) { const f32x4 qv = (acc[n] - acc2[n]) * gm4;
                  *(uint2*)(pb + 8192 + (size_t)(((n * 64 + lane) * 4 + wq) * 8)) = make_uint2(cvtpk(qv[0], qv[1]), cvtpk(qv[2], qv[3])); }
#pragma unroll
              for (int rep = 0; rep < 2; ++rep) { const int cidx = t2 + 256 * rep, row = cidx >> 3, ch = cidx & 7;
                  *(v4u*)(TKN + inst * 8192 + (size_t)(row * 64 + ch * 8) * 2) = *(const LAS v4u*)(SL(8) + row * 128 + ((ch ^ swz(row)) << 4)); }
            }
        } else {
            zero4(acc); mm64<false>(acc, SL(0), SL(2), wq, lane);
#pragma unroll
            for (int n = 0; n < 4; ++n)
#pragma unroll
                for (int q = 0; q < 4; ++q) acc[n][q] = (16 * wq + 4 * g + q <= 16 * n + lr) ? acc[n][q] : 0.f;
            storeT(SL(6), acc, wq, lane);
            zero4(acc); mm64<false>(acc, SL(1), SL(2), wq, lane);
#pragma unroll
            for (int n = 0; n < 4; ++n)
#pragma unroll
                for (int q = 0; q < 4; ++q) acc[n][q] = (16 * wq + 4 * g + q <= 16 * n + lr) ? -acc[n][q] : 0.f;
            storeT(SL(7), acc, wq, lane);
            { const v4u o0 = upre0, o1 = upre1;
              acc[0] = (f32x4){bflo(o0.x), bfhi(o0.x), bflo(o0.y), bfhi(o0.y)}; acc[1] = (f32x4){bflo(o0.z), bfhi(o0.z), bflo(o0.w), bfhi(o0.w)};
              acc[2] = (f32x4){bflo(o1.x), bfhi(o1.x), bflo(o1.y), bfhi(o1.y)}; acc[3] = (f32x4){bflo(o1.z), bfhi(o1.z), bflo(o1.w), bfhi(o1.w)}; }
            mm64<false>(acc, SL(4), SL(5), wq, lane);
            storeT(SL(8), acc, wq, lane);
            __syncthreads();
            zero4(acc); mm64<false>(acc, SL(2), SL(5), wq, lane); mm64<false>(acc, SL(6), SL(3), wq, lane); mm64<false>(acc, SL(7), SL(8), wq, lane);
            __syncthreads();
            { LAS float* Yf = (LAS float*)(tl);
#pragma unroll
              for (int n = 0; n < 4; ++n)
#pragma unroll
                  for (int q = 0; q < 4; ++q) { const int tau = 16 * wq + 4 * g + q; Yf[tau * 64 + ((16 * n + lr) ^ (4 * (tau & 15)))] = acc[n][q]; } }
            __syncthreads();
            { const LAS float* Y0 = (const LAS float*)(F.lds); const LAS float* Y1 = (const LAS float*)(F.lds + 9 * TILE);
              const int t = row & (T - 1);
              const bf16* zr = z + (size_t)row * NZ;
              const v4u zz = {0u, 0u, 0u, 0u};
              const v4u q_g = *(const v4u*)(LO + (size_t)row * NL + 4096 + c0);
              const v4u q_gb = *(const v4u*)(zr + CONV_OFF + c0), q_c0 = *(const v4u*)(zr + CONV_OFF + 1024 + c0), q_x0 = *(const v4u*)(zr + CONV_OFF + 2048 + c0);
              const v4u q_cm = t > 0 ? *(const v4u*)(zr - NZ + CONV_OFF + 1024 + c0) : zz, q_xm = t > 0 ? *(const v4u*)(zr - NZ + CONV_OFF + 2048 + c0) : zz;
              const v4u q_cp = t < T - 1 ? *(const v4u*)(zr + NZ + CONV_OFF + 1024 + c0) : zz, q_xp = t < T - 1 ? *(const v4u*)(zr + NZ + CONV_OFF + 2048 + c0) : zz;
              const v4u q_ga = *(const v4u*)(zr + GATE_OFF + c0), q_gr = *(const v4u*)(zr + GATE_OFF + 1024 + c0);
              float y[8];
              { const int s0 = 4 * (tok & 15), s1 = 4 * ((63 - tok) & 15);
                const f32x4 a0 = *(const LAS f32x4*)(Y0 + tok * 64 + (ch0 ^ s0)), a1 = *(const LAS f32x4*)(Y0 + tok * 64 + ((ch0 + 4) ^ s0));
                const f32x4 b0 = *(const LAS f32x4*)(Y1 + (63 - tok) * 64 + (ch0 ^ s1)), b1 = *(const LAS f32x4*)(Y1 + (63 - tok) * 64 + ((ch0 + 4) ^ s1));
                y[0] = a0.x + b0.x; y[1] = a0.y + b0.y; y[2] = a0.z + b0.z; y[3] = a0.w + b0.w; y[4] = a1.x + b1.x; y[5] = a1.y + b1.y; y[6] = a1.z + b1.z; y[7] = a1.w + b1.w; }
              float rk[8]; ld8f(KIN(I_RK) + c0, rk);
              float s1 = 0.f, s2 = 0.f, s3 = 0.f;
#pragma unroll
              for (int i = 0; i < 8; ++i) { s1 += y[i]; s2 += y[i] * y[i]; s3 += rs[i] * 0.5f * (kd0[i] + kd1[i]) * rk[i]; }
              s1 += __shfl_xor(s1, 1); s2 += __shfl_xor(s2, 1); s3 += __shfl_xor(s3, 1); s1 += __shfl_xor(s1, 2); s2 += __shfl_xor(s2, 2); s3 += __shfl_xor(s3, 2);
              s1 += __shfl_xor(s1, 4); s2 += __shfl_xor(s2, 4); s3 += __shfl_xor(s3, 4);
              const float S1 = s1, S2 = s2, S3 = s3;
              const float mean = S1 * (1.0f / 64.0f), var = fmaxf(S2 * (1.0f / 64.0f) - mean * mean, 0.f), rstd = __builtin_amdgcn_rsqf(var + 64e-5f);
              float lnw[8], lnb[8], cw0[8], cw1[8], cw2[8];
              ld8f(KIN(I_LNW) + c0, lnw); ld8f(KIN(I_LNB) + c0, lnb); ld8f(KIN(I_CONVW) + c0, cw0); ld8f(KIN(I_CONVW) + D + c0, cw1); ld8f(KIN(I_CONVW) + 2 * D + c0, cw2);
              float gg[8], gb[8], cc[8], xx[8], cm[8], xm[8], cp[8], xp[8], ga[8], gr[8];
              unpack8(q_g, gg); unpack8(q_gb, gb); unpack8(q_c0, cc); unpack8(q_x0, xx); unpack8(q_cm, cm); unpack8(q_xm, xm); unpack8(q_cp, cp); unpack8(q_xp, xp); unpack8(q_ga, ga); unpack8(q_gr, gr);
              float o[8];
#pragma unroll
              for (int i = 0; i < 8; ++i) {
                  const float yn = (y[i] - mean) * rstd * lnw[i] + lnb[i];
                  const float yr = (yn + S3 * vs[i]) * gg[i];
                  const float yc = gb[i] * (cw0[i] * (cm[i] * xm[i]) + cw1[i] * (cc[i] * xx[i]) + cw2[i] * (cp[i] * xp[i]));
                  o[i] = fsig(ga[i]) * yr + fsig(gr[i]) * yc;
              }
              v4u ov; ov.x = cvtpk(o[0], o[1]); ov.y = cvtpk(o[2], o[3]); ov.z = cvtpk(o[4], o[5]); ov.w = cvtpk(o[6], o[7]);
              *(v4u*)(MG + (size_t)row * D + c0) = ov;
            }
        }
        __syncthreads();
        if (!IS_CO) {
            if (cv_strip < NE * 64) { int e_, n0_, rb_; wei_strip(cv_strip, e_, n0_, rb_);
                if (cv_kb == 0) cv_scale_q8(cv_w + (size_t)e_ * D * 2048, 2048, n0_, (float*)(F.ws + MI_CSWEI) + (size_t)e_ * 2048, rb_, lane, civ);
                cv_store_q8(cvt, cv_scr, (signed char*)(F.ws + WS_WEIN) + (size_t)e_ * 2048 * D, rb_, cv_kb, civ, lane); }
            ++cv_t;
            __syncthreads();
        }
    }
    if (!IS_CO) {
        for (;;) { const int s_ = F.gw + (cv_t >> 4) * F.NGW, kb_ = cv_t & 15; if (s_ >= NE * 64) break;
            int e_, n0_, rb_; wei_strip(s_, e_, n0_, rb_);
            if (kb_ == 0) cv_scale_q8(cv_w + (size_t)e_ * D * 2048, 2048, n0_, (float*)(F.ws + MI_CSWEI) + (size_t)e_ * 2048, rb_, F.lane, civ);
            cv_load(cvt, cv_w + (size_t)e_ * D * 2048, 2048, n0_, kb_, F.lane);
            cv_store_q8(cvt, cv_scr, (signed char*)(F.ws + WS_WEIN) + (size_t)e_ * 2048 * D, rb_, kb_, civ, F.lane); ++cv_t; }
    }
#undef SL
}

typedef short s16x4 __attribute__((ext_vector_type(4)));
__device__ __forceinline__ bf16x8 ldfragT(const LAS unsigned char* t, int c, int ks, int lane) {
    const int g = lane >> 4, q = (lane & 15) >> 2, p = lane & 3;
    const int r0 = 32 * ks + 8 * g + q, r1 = r0 + 4;
    const s16x4 a = __builtin_amdgcn_ds_read_tr16_b64_v4i16((LAS s16x4*)(t + r0 * 128 + (((2 * c + (p >> 1)) ^ swz(r0)) << 4) + 8 * (p & 1)));
    const s16x4 b = __builtin_amdgcn_ds_read_tr16_b64_v4i16((LAS s16x4*)(t + r1 * 128 + (((2 * c + (p >> 1)) ^ swz(r1)) << 4) + 8 * (p & 1)));
    return (bf16x8){a[0], a[1], a[2], a[3], b[0], b[1], b[2], b[3]};
}
__device__ __forceinline__ f32x4 loadN_acc(const LAS unsigned char* t, int b, int ct, int lane) {
    const int g = lane >> 4, q = (lane & 15) >> 2, p = lane & 3;
    const int r0 = 16 * b + 4 * g + q;
    const s16x4 a = __builtin_amdgcn_ds_read_tr16_b64_v4i16((LAS s16x4*)(t + r0 * 128 + (((2 * ct + (p >> 1)) ^ swz(r0)) << 4) + 8 * (p & 1)));
    return (f32x4){bf1((bf16)a[0]), bf1((bf16)a[1]), bf1((bf16)a[2]), bf1((bf16)a[3])};
}
template <bool LT, bool RT>
__device__ __forceinline__ void mm64x(f32x4 (&acc)[4], const LAS unsigned char* Lt, const LAS unsigned char* Rt, int wq, int lane) {
    const int lr = lane & 15, g = lane >> 4;
    const bf16x8 l0 = LT ? ldfragT(Lt, wq, 0, lane) : ldfrag(Lt, 16 * wq + lr, g), l1 = LT ? ldfragT(Lt, wq, 1, lane) : ldfrag(Lt, 16 * wq + lr, 4 + g);
#pragma unroll
    for (int n = 0; n < 4; ++n) {
        const bf16x8 r0 = RT ? ldfragT(Rt, n, 0, lane) : ldfrag(Rt, 16 * n + lr, g), r1 = RT ? ldfragT(Rt, n, 1, lane) : ldfrag(Rt, 16 * n + lr, 4 + g);
        acc[n] = CK_MFMA(l0, r0, acc[n]); acc[n] = CK_MFMA(l1, r1, acc[n]);
    }
}

__device__ __forceinline__ void phase_cp2(Frame& F) {
    const int wave = F.wave;
    const int dgrp = wave >> 2, wq = wave & 3;
    LAS unsigned char* tl = F.lds + dgrp * 9 * TILE;
#define SL(k) (tl + (k) * TILE)
    LAS float* SEG = (LAS float*)(F.lds + LDS_X_OFF);
    LAS float* GAM = SEG + 1024;
    LAS unsigned char* DIB = (LAS unsigned char*)(GAM + 128) + dgrp * 2048;
    LAS float* LW0 = (LAS float*)(F.lds + 7 * TILE);
    LAS float* LW1 = (LAS float*)(F.lds + 16 * TILE);
    const bf16* z = (const bf16*)(F.ws + WS_Z); const bf16* LO = (const bf16*)(F.ws + WS_LORA);
    unsigned char* PQ = F.ws + WS_PQ; unsigned char* RHAT = F.ws + WS_TKN; unsigned char* YLOC = F.ws + WS_UPRE;
    float* BON = (float*)(F.ws + MI_BON);
    const float* p_mu = KIN(I_MU); const float* p_kk = KIN(I_KK); const float* p_ka = KIN(I_KA); const float* p_rk = KIN(I_RK);
    constexpr int NU = NU_ALL;
    EPre<true> PF;
    CvTile cvt; float civ[4] = {0.f, 0.f, 0.f, 0.f}; int cv_t = 0;
    const float* cv_w = KIN(I_WEI);
    LAS float* cv_scr = (LAS float*)(F.lds + wave * 16384);
    if ((int)blockIdx.x < NU) epre_load<true>(PF, z, LO, (int)blockIdx.x, wave, F.lane);
    for (int unit = blockIdx.x; unit < NU; unit += F.G) {
        int lane = F.lane; asm volatile("" : "+v"(lane));
        const int lr = lane & 15, g = lane >> 4;
        int b, h, rowbase; unit_decode(unit, b, h, rowbase);
        const int tok = 8 * wave + (lane >> 3), oct = lane & 7, ch0 = 8 * oct, c0 = h * 64 + ch0;
        float ks[8], vs[8], rs[8], kkp[8], lw0[8], lw1[8], kd0[8], kd1[8], a_0[8], a_1[8], ssq;
        {
            shift8(PF.k, p_mu + K_OFF + c0, ks); shift8(PF.v, p_mu + V_OFF + c0, vs); shift8(PF.r, p_mu + R_OFF + c0, rs);
            float kkk[8], kaa[8], rkk[8];
            unpack8(PF.lo[0], lw0); unpack8(PF.lo[1], lw1); unpack8(PF.lo[2], a_0); unpack8(PF.lo[3], a_1);
            ld8f(p_kk + c0, kkk); ld8f(p_ka + c0, kaa); ld8f(p_rk + c0, rkk);
            float ss = 0.f, bs = 0.f;
#pragma unroll
            for (int i = 0; i < 8; ++i) {
                kkp[i] = ks[i] * kkk[i]; ss += kkp[i] * kkp[i];
                kd0[i] = ks[i] * (1.0f + (a_0[i] - 1.0f) * kaa[i]); kd1[i] = ks[i] * (1.0f + (a_1[i] - 1.0f) * kaa[i]);
                bs += rs[i] * 0.5f * (kd0[i] + kd1[i]) * rkk[i];
                const int ch = ch0 + i, sw = tok ^ (4 * ((ch & 15) ^ (2 * (ch >> 4))));
                LW0[ch * 64 + sw] = lw0[i]; LW1[ch * 64 + sw] = lw1[i];
            }
            ss += __shfl_xor(ss, 1); bs += __shfl_xor(bs, 1); ss += __shfl_xor(ss, 2); bs += __shfl_xor(bs, 2); ss += __shfl_xor(ss, 4); bs += __shfl_xor(bs, 4);
            ssq = ss;
            if (oct == 0 && unit < NU_L) BON[(size_t)unit * 64 + tok] = bs;
        }
        __syncthreads();
        {
            const int ch2 = lane, seg = wave, sw = 4 * ((ch2 & 15) ^ (2 * (ch2 >> 4)));
            LAS f32x4* p0a = (LAS f32x4*)(LW0 + ch2 * 64 + ((8 * seg) ^ sw)); LAS f32x4* p0b = (LAS f32x4*)(LW0 + ch2 * 64 + ((8 * seg + 4) ^ sw));
            LAS f32x4* p1a = (LAS f32x4*)(LW1 + ch2 * 64 + ((8 * seg) ^ sw)); LAS f32x4* p1b = (LAS f32x4*)(LW1 + ch2 * 64 + ((8 * seg + 4) ^ sw));
            f32x4 a = *p0a, bq = *p0b, c = *p1a, d = *p1b;
            a.y += a.x; a.z += a.y; a.w += a.z; bq.x += a.w; bq.y += bq.x; bq.z += bq.y; bq.w += bq.z;
            d.z += d.w; d.y += d.z; d.x += d.y; c.w += d.x; c.z += c.w; c.y += c.z; c.x += c.y;
            SEG[seg * 64 + ch2] = bq.w; SEG[(8 + seg) * 64 + ch2] = c.x;
            __syncthreads();
            float off0 = 0.f, off1 = 0.f;
#pragma unroll
            for (int s2 = 0; s2 < 8; ++s2) { const float t0 = SEG[s2 * 64 + ch2], t1 = SEG[(8 + s2) * 64 + ch2]; off0 += (s2 < seg) ? t0 : 0.f; off1 += (s2 > seg) ? t1 : 0.f; }
            *p0a = a + off0; *p0b = bq + off0; *p1a = c + off1; *p1b = d + off1;
        }
        __syncthreads();
        {
            const float inv = 1.0f / fmaxf(sqrtf(ssq), 1e-12f);
            float t8[8], u8[8], w8[8], r8v[8];
            {
                LAS unsigned char* t0 = F.lds; const int tau = tok;
                float e1[8], ei[8];
#pragma unroll
                for (int i = 0; i < 8; ++i) { const int ch = ch0 + i; const float cm = LW0[ch * 64 + (tok ^ (4 * ((ch & 15) ^ (2 * (ch >> 4)))))]; e1[i] = __expf(cm); ei[i] = __builtin_amdgcn_rcpf(e1[i]); t8[i] = kkp[i] * inv * __expf(cm - lw0[i]); }
                if (tok == 63) {
#pragma unroll
                    for (int i = 0; i < 8; ++i) GAM[ch0 + i] = e1[i]; }
#pragma unroll
                for (int i = 0; i < 8; ++i) { u8[i] = kkp[i] * inv * a_0[i] * ei[i]; w8[i] = kd0[i] * ei[i]; r8v[i] = rs[i] * e1[i]; }
                putN(t0 + 0 * TILE, tau, oct, t8); putN(t0 + 1 * TILE, tau, oct, u8); putN(t0 + 2 * TILE, tau, oct, w8); putN(t0 + 3 * TILE, tau, oct, vs); putN(t0 + 4 * TILE, tau, oct, r8v);
            }
            {
                LAS unsigned char* t1 = F.lds + 9 * TILE; const int tau = 63 - tok;
                float e1[8], ei[8];
#pragma unroll
                for (int i = 0; i < 8; ++i) { const int ch = ch0 + i; const float cm = LW1[ch * 64 + (tok ^ (4 * ((ch & 15) ^ (2 * (ch >> 4)))))]; e1[i] = __expf(cm); ei[i] = __builtin_amdgcn_rcpf(e1[i]); t8[i] = kkp[i] * inv * __expf(cm - lw1[i]); }
                if (tok == 0) {
#pragma unroll
                    for (int i = 0; i < 8; ++i) GAM[64 + ch0 + i] = e1[i]; }
#pragma unroll
                for (int i = 0; i < 8; ++i) { u8[i] = kkp[i] * inv * a_1[i] * ei[i]; w8[i] = kd1[i] * ei[i]; r8v[i] = rs[i] * e1[i]; }
                putN(t1 + 0 * TILE, tau, oct, t8); putN(t1 + 1 * TILE, tau, oct, u8); putN(t1 + 2 * TILE, tau, oct, w8); putN(t1 + 3 * TILE, tau, oct, vs); putN(t1 + 4 * TILE, tau, oct, r8v);
            }
        }
        const size_t inst = (size_t)unit * 2 + dgrp;
        if (unit + F.G < NU) epre_load<true>(PF, z, LO, unit + F.G, wave, lane);
        const int cv_strip = F.gw + (cv_t >> 4) * F.NGW, cv_kb = cv_t & 15;
        if (cv_strip < NE * 64) { int e_, n0_, rb_; wei_strip(cv_strip, e_, n0_, rb_); cv_load(cvt, cv_w + (size_t)e_ * D * 2048, 2048, n0_, cv_kb, lane); }
        __syncthreads();
        f32x4 acc[4], acc2[4];
        zero4(acc); mm64x<false, false>(acc, SL(1), SL(0), wq, lane);
        zero4(acc2); mm64x<false, false>(acc2, SL(2), SL(0), wq, lane);
#pragma unroll
        for (int n = 0; n < 4; ++n)
#pragma unroll
            for (int q = 0; q < 4; ++q) { const bool lo = (16 * wq + 4 * g + q < 16 * n + lr); acc[n][q] = lo ? acc[n][q] : 0.f; acc2[n][q] = lo ? acc2[n][q] : 0.f; }
        storeT(SL(5), acc, wq, lane); storeT(SL(6), acc2, wq, lane);
        __syncthreads();
        zero4(acc); mm64x<false, true>(acc, SL(6), SL(3), wq, lane); storeT(SL(7), acc, wq, lane);
        if (wq == 0) {
            const int bb = lane >> 4, jj = lane & 15;
            float X[16];
            X[0] = (jj == 0) ? 1.f : 0.f;
#pragma unroll
            for (int t = 1; t < 16; ++t) {
                const int row = 16 * bb + t;
                const v4u p0 = *(const LAS v4u*)(SL(5) + row * 128 + (((2 * bb) ^ swz(row)) << 4)), p1 = *(const LAS v4u*)(SL(5) + row * 128 + (((2 * bb + 1) ^ swz(row)) << 4));
                float rw[16];
                rw[0] = bflo(p0.x); rw[1] = bfhi(p0.x); rw[2] = bflo(p0.y); rw[3] = bfhi(p0.y); rw[4] = bflo(p0.z); rw[5] = bfhi(p0.z); rw[6] = bflo(p0.w); rw[7] = bfhi(p0.w);
                rw[8] = bflo(p1.x); rw[9] = bfhi(p1.x); rw[10] = bflo(p1.y); rw[11] = bfhi(p1.y); rw[12] = bflo(p1.z); rw[13] = bfhi(p1.z); rw[14] = bflo(p1.w); rw[15] = bfhi(p1.w);
                float xv = (t == jj) ? 1.f : 0.f;
#pragma unroll
                for (int s = 0; s < t; ++s) xv -= rw[s] * X[s];
                X[t] = xv;
            }
#pragma unroll
            for (int t = 0; t < 16; ++t) *(LAS unsigned short*)(DIB + (((bb * 16 + t) * 16 + jj) << 1)) = (unsigned short)f2bf(X[t]);
        }
        __syncthreads();
        {
            const bool isU = wq >= 2; const int cbase = 32 * (wq & 1);
            LAS unsigned char* outT = isU ? SL(6) : SL(8);
#pragma unroll
            for (int ct = 0; ct < 2; ++ct) {
                const int ctile = 2 * (wq & 1) + ct, col = cbase + 16 * ct + lr;
                f32x4 X[4];
#pragma unroll
                for (int b2 = 0; b2 < 4; ++b2) {
                    f32x4 Zt;
                    if (isU) { const v2u rwv = *(const LAS v2u*)(SL(7) + toff(col, 16 * b2 + 4 * g)); Zt = (f32x4){bflo(rwv.x), bfhi(rwv.x), bflo(rwv.y), bfhi(rwv.y)}; }
                    else Zt = loadN_acc(SL(0), b2, ctile, lane);
                    if (b2 >= 1) {
                        f32x4 Y = {0.f, 0.f, 0.f, 0.f};
#pragma unroll
                        for (int s = 0; s < (b2 + 1) / 2; ++s) {
                            v2u alo = {0u, 0u}, ahi = {0u, 0u};
                            if (2 * s < b2) alo = *(const LAS v2u*)(SL(5) + toff(16 * b2 + lr, 32 * s + 4 * g));
                            if (2 * s + 1 < b2) ahi = *(const LAS v2u*)(SL(5) + toff(16 * b2 + lr, 32 * s + 16 + 4 * g));
                            v4u bw = {cvtpk(X[2 * s][0], X[2 * s][1]), cvtpk(X[2 * s][2], X[2 * s][3]), 0u, 0u};
                            if (2 * s + 1 < b2) { bw.z = cvtpk(X[2 * s + 1][0], X[2 * s + 1][1]); bw.w = cvtpk(X[2 * s + 1][2], X[2 * s + 1][3]); }
                            Y = CK_MFMA(__builtin_bit_cast(bf16x8, ((v4u){alo.x, alo.y, ahi.x, ahi.y})), __builtin_bit_cast(bf16x8, bw), Y);
                        }
                        Zt = Zt - Y;
                    }
                    const v2u dv = *(const LAS v2u*)(DIB + (((b2 * 16 + lr) * 16 + 4 * g) << 1));
                    const v4u bz = {cvtpk(Zt[0], Zt[1]), cvtpk(Zt[2], Zt[3]), 0u, 0u};
                    X[b2] = CK_MFMA(__builtin_bit_cast(bf16x8, ((v4u){dv.x, dv.y, 0u, 0u})), __builtin_bit_cast(bf16x8, bz), ((f32x4){0.f, 0.f, 0.f, 0.f}));
                }
#pragma unroll
                for (int b2 = 0; b2 < 4; ++b2) *(LAS v2u*)(outT + toff(col, 16 * b2 + 4 * g)) = (v2u){cvtpk(X[b2][0], X[b2][1]), cvtpk(X[b2][2], X[b2][3])};
            }
        }
        __syncthreads();
        {
            zero4(acc); mm64x<false, true>(acc, SL(8), SL(1), wq, lane);
            const int cstep_ = unit < NU_L ? 4 + (dgrp ? 127 - ((unit >> 4) & 127) : ((unit >> 4) & 127)) : (dgrp ? 3 - (((unit - NU_L) >> 4) & 3) : (((unit - NU_L) >> 4) & 3));
            unsigned char* pb = PQ + (size_t)(((b * 16 + h) * 2 + dgrp) * (4 + T / 64) + cstep_) * 16384;
#pragma unroll
            for (int n = 0; n < 4; ++n) { const int k = 16 * n + lr; const float gm = GAM[dgrp * 64 + k]; float p[4];
#pragma unroll
                for (int q = 0; q < 4; ++q) p[q] = gm * (((16 * wq + 4 * g + q) == k ? 1.f : 0.f) - acc[n][q]);
                *(uint2*)(pb + (size_t)(((n * 2 + (wq >> 1)) * 64 + lane) * 16 + (wq & 1) * 8)) = make_uint2(cvtpk(p[0], p[1]), cvtpk(p[2], p[3])); }
            zero4(acc); mm64x<true, true>(acc, SL(2), SL(3), wq, lane); zero4(acc2); mm64x<true, false>(acc2, SL(1), SL(6), wq, lane);
            const f32x4 gm4 = *(const LAS f32x4*)(GAM + dgrp * 64 + 16 * wq + 4 * g);
#pragma unroll
            for (int n = 0; n < 4; ++n) { const f32x4 qv = (acc[n] - acc2[n]) * gm4;
                *(uint2*)(pb + 8192 + (size_t)(((n * 64 + lane) * 4 + wq) * 8)) = make_uint2(cvtpk(qv[0], qv[1]), cvtpk(qv[2], qv[3])); }
            if (unit < NU_L) {
                zero4(acc); mm64x<false, false>(acc, SL(2), SL(4), wq, lane);
                zero4(acc2); mm64x<false, false>(acc2, SL(1), SL(4), wq, lane);
#pragma unroll
                for (int n = 0; n < 4; ++n)
#pragma unroll
                    for (int q = 0; q < 4; ++q) { const bool le = (16 * wq + 4 * g + q <= 16 * n + lr); acc[n][q] = le ? acc[n][q] : 0.f; acc2[n][q] = le ? -acc2[n][q] : 0.f; }
                storeT(SL(5), acc, wq, lane); storeT(SL(7), acc2, wq, lane);
            }
        }
        __syncthreads();
        if (unit < NU_L) {
            loadT(acc, SL(4), wq, lane);
            mm64x<false, false>(acc, SL(8), SL(7), wq, lane);
            unsigned char* rb = RHAT + inst * 8192;
#pragma unroll
            for (int n = 0; n < 4; ++n) *(uint2*)(rb + (size_t)((16 * n + lr) * 64 + 16 * wq + 4 * g) * 2) = make_uint2(cvtpk(acc[n][0], acc[n][1]), cvtpk(acc[n][2], acc[n][3]));
            zero4(acc2); mm64x<false, true>(acc2, SL(5), SL(3), wq, lane); mm64x<false, false>(acc2, SL(7), SL(6), wq, lane);
            unsigned char* yb = YLOC + inst * 8192 + (size_t)((wq * 64 + lane) * 32);
            v4u o0, o1; o0.x = cvtpk(acc2[0][0], acc2[0][1]); o0.y = cvtpk(acc2[0][2], acc2[0][3]); o0.z = cvtpk(acc2[1][0], acc2[1][1]); o0.w = cvtpk(acc2[1][2], acc2[1][3]);
            o1.x = cvtpk(acc2[2][0], acc2[2][1]); o1.y = cvtpk(acc2[2][2], acc2[2][3]); o1.z = cvtpk(acc2[3][0], acc2[3][1]); o1.w = cvtpk(acc2[3][2], acc2[3][3]);
            *(v4u*)yb = o0; *(v4u*)(yb + 16) = o1;
        }
        __syncthreads();
        {
            if (cv_strip < NE * 64) { int e_, n0_, rb_; wei_strip(cv_strip, e_, n0_, rb_);
                if (cv_kb == 0) cv_scale_q8(cv_w + (size_t)e_ * D * 2048, 2048, n0_, (float*)(F.ws + MI_CSWEI) + (size_t)e_ * 2048, rb_, lane, civ);
                cv_store_q8(cvt, cv_scr, (signed char*)(F.ws + WS_WEIN) + (size_t)e_ * 2048 * D, rb_, cv_kb, civ, lane); }
            ++cv_t;
            __syncthreads();
        }
    }
    for (;;) { const int s_ = F.gw + (cv_t >> 4) * F.NGW, kb_ = cv_t & 15; if (s_ >= NE * 64) break;
        int e_, n0_, rb_; wei_strip(s_, e_, n0_, rb_);
        if (kb_ == 0) cv_scale_q8(cv_w + (size_t)e_ * D * 2048, 2048, n0_, (float*)(F.ws + MI_CSWEI) + (size_t)e_ * 2048, rb_, F.lane, civ);
        cv_load(cvt, cv_w + (size_t)e_ * D * 2048, 2048, n0_, kb_, F.lane);
        cv_store_q8(cvt, cv_scr, (signed char*)(F.ws + WS_WEIN) + (size_t)e_ * 2048 * D, rb_, kb_, civ, F.lane); ++cv_t; }
#undef SL
}

__device__ __forceinline__ void phase_co2(Frame& F) {
    const int wave = F.wave;
    const int dgrp = wave >> 2, wq = wave & 3;
    LAS unsigned char* tl = F.lds + dgrp * 9 * TILE;
#define SL(k) (tl + (k) * TILE)
    const bf16* z = (const bf16*)(F.ws + WS_Z); const bf16* LO = (const bf16*)(F.ws + WS_LORA);
    const unsigned char* RHAT = F.ws + WS_TKN; const unsigned char* YLOC = F.ws + WS_UPRE; const unsigned char* H0T = F.ws + WS_H0T;
    const float* BON = (const float*)(F.ws + MI_BON);
    bf16* MG = (bf16*)(F.ws + WS_A0);
    const float* p_mu = KIN(I_MU);
    for (int unit = blockIdx.x; unit < NU_L; unit += F.G) {
        int lane = F.lane; asm volatile("" : "+v"(lane));
        const int lr = lane & 15, g = lane >> 4;
        int b, h, rowbase; unit_decode(unit, b, h, rowbase);
        const int tok = 8 * wave + (lane >> 3), oct = lane & 7, ch0 = 8 * oct, c0 = h * 64 + ch0, row = rowbase + tok;
        const size_t inst = (size_t)unit * 2 + dgrp;
        const int t2 = (wq << 6) | lane;
#pragma unroll
        for (int rep = 0; rep < 2; ++rep) { const int cidx = t2 + 256 * rep, r_ = cidx >> 3, ch = cidx & 7;
            const v4u a = *(const v4u*)(RHAT + inst * 8192 + (size_t)(r_ * 64 + ch * 8) * 2), hh = *(const v4u*)(H0T + inst * 8192 + (size_t)(r_ * 64 + ch * 8) * 2);
            *(LAS v4u*)(SL(0) + r_ * 128 + ((ch ^ swz(r_)) << 4)) = a; *(LAS v4u*)(SL(1) + r_ * 128 + ((ch ^ swz(r_)) << 4)) = hh; }
        f32x4 acc[4];
        { const unsigned char* yb = YLOC + inst * 8192 + (size_t)((wq * 64 + lane) * 32); const v4u o0 = *(const v4u*)yb, o1 = *(const v4u*)(yb + 16);
          acc[0] = (f32x4){bflo(o0.x), bfhi(o0.x), bflo(o0.y), bfhi(o0.y)}; acc[1] = (f32x4){bflo(o0.z), bfhi(o0.z), bflo(o0.w), bfhi(o0.w)};
          acc[2] = (f32x4){bflo(o1.x), bfhi(o1.x), bflo(o1.y), bfhi(o1.y)}; acc[3] = (f32x4){bflo(o1.z), bfhi(o1.z), bflo(o1.w), bfhi(o1.w)}; }
        const int t = row & (T - 1);
        const bf16* zr = z + (size_t)row * NZ;
        const v4u zz = {0u, 0u, 0u, 0u};
        v4u qv[5]; qv[0] = *(const v4u*)(zr + V_OFF + c0);
#pragma unroll
        for (int j = 0; j < 4; ++j) { const int nr = nbr_row(row, j); qv[1 + j] = nr >= 0 ? *(const v4u*)(z + (size_t)nr * NZ + V_OFF + c0) : zz; }
        const v4u q_g = *(const v4u*)(LO + (size_t)row * NL + 4096 + c0);
        const v4u q_gb = *(const v4u*)(zr + CONV_OFF + c0), q_c0 = *(const v4u*)(zr + CONV_OFF + 1024 + c0), q_x0 = *(const v4u*)(zr + CONV_OFF + 2048 + c0);
        const v4u q_cm = t > 0 ? *(const v4u*)(zr - NZ + CONV_OFF + 1024 + c0) : zz, q_xm = t > 0 ? *(const v4u*)(zr - NZ + CONV_OFF + 2048 + c0) : zz;
        const v4u q_cp = t < T - 1 ? *(const v4u*)(zr + NZ + CONV_OFF + 1024 + c0) : zz, q_xp = t < T - 1 ? *(const v4u*)(zr + NZ + CONV_OFF + 2048 + c0) : zz;
        const v4u q_ga = *(const v4u*)(zr + GATE_OFF + c0), q_gr = *(const v4u*)(zr + GATE_OFF + 1024 + c0);
        const float S3 = BON[(size_t)unit * 64 + tok];
        __syncthreads();
        mm64x<false, false>(acc, SL(0), SL(1), wq, lane);
        { LAS float* Yf = (LAS float*)(tl + 2 * TILE);
#pragma unroll
          for (int n = 0; n < 4; ++n)
#pragma unroll
              for (int q = 0; q < 4; ++q) { const int tau = 16 * wq + 4 * g + q; Yf[tau * 64 + ((16 * n + lr) ^ (4 * (tau & 15)))] = acc[n][q]; } }
        __syncthreads();
        { const LAS float* Y0 = (const LAS float*)(F.lds + 2 * TILE); const LAS float* Y1 = (const LAS float*)(F.lds + 11 * TILE);
          float y[8];
          { const int s0 = 4 * (tok & 15), s1 = 4 * ((63 - tok) & 15);
            const f32x4 a0 = *(const LAS f32x4*)(Y0 + tok * 64 + (ch0 ^ s0)), a1 = *(const LAS f32x4*)(Y0 + tok * 64 + ((ch0 + 4) ^ s0));
            const f32x4 b0 = *(const LAS f32x4*)(Y1 + (63 - tok) * 64 + (ch0 ^ s1)), b1 = *(const LAS f32x4*)(Y1 + (63 - tok) * 64 + ((ch0 + 4) ^ s1));
            y[0] = a0.x + b0.x; y[1] = a0.y + b0.y; y[2] = a0.z + b0.z; y[3] = a0.w + b0.w; y[4] = a1.x + b1.x; y[5] = a1.y + b1.y; y[6] = a1.z + b1.z; y[7] = a1.w + b1.w; }
          float s1 = 0.f, s2 = 0.f;
#pragma unroll
          for (int i = 0; i < 8; ++i) { s1 += y[i]; s2 += y[i] * y[i]; }
          s1 += __shfl_xor(s1, 1); s2 += __shfl_xor(s2, 1); s1 += __shfl_xor(s1, 2); s2 += __shfl_xor(s2, 2); s1 += __shfl_xor(s1, 4); s2 += __shfl_xor(s2, 4);
          const float mean = s1 * (1.0f / 64.0f), var = fmaxf(s2 * (1.0f / 64.0f) - mean * mean, 0.f), rstd = __builtin_amdgcn_rsqf(var + 64e-5f);
          float vs[8]; shift8(qv, p_mu + V_OFF + c0, vs);
          float lnw[8], lnb[8], cw0[8], cw1[8], cw2[8];
          ld8f(KIN(I_LNW) + c0, lnw); ld8f(KIN(I_LNB) + c0, lnb); ld8f(KIN(I_CONVW) + c0, cw0); ld8f(KIN(I_CONVW) + D + c0, cw1); ld8f(KIN(I_CONVW) + 2 * D + c0, cw2);
          float gg[8], gb[8], cc[8], xx[8], cm[8], xm[8], cp[8], xp[8], ga[8], gr[8];
          unpack8(q_g, gg); unpack8(q_gb, gb); unpack8(q_c0, cc); unpack8(q_x0, xx); unpack8(q_cm, cm); unpack8(q_xm, xm); unpack8(q_cp, cp); unpack8(q_xp, xp); unpack8(q_ga, ga); unpack8(q_gr, gr);
          float o[8];
#pragma unroll
          for (int i = 0; i < 8; ++i) {
              const float yn = (y[i] - mean) * rstd * lnw[i] + lnb[i];
              const float yr = (yn + S3 * vs[i]) * gg[i];
              const float yc = gb[i] * (cw0[i] * (cm[i] * xm[i]) + cw1[i] * (cc[i] * xx[i]) + cw2[i] * (cp[i] * xp[i]));
              o[i] = fsig(ga[i]) * yr + fsig(gr[i]) * yc;
          }
          v4u ov; ov.x = cvtpk(o[0], o[1]); ov.y = cvtpk(o[2], o[3]); ov.z = cvtpk(o[4], o[5]); ov.w = cvtpk(o[6], o[7]);
          *(v4u*)(MG + (size_t)row * D + c0) = ov;
        }
        __syncthreads();
    }
#undef SL
}

struct SSIn { v4u a[8]; v4u q[2]; };
__device__ __forceinline__ size_t ss_pq(int step, int b, int h, int d) { return (size_t)(((b * 16 + h) * 2 + d) * (4 + T / 64) + step); }
__device__ __forceinline__ size_t ss_inst(int step, int b, int h, int d) {
    int unit;
    if (step < 4) { const int cb = d ? 3 - step : step; unit = NU_L + (b * 4 + cb) * 16 + h; }
    else { const int blk = d ? 127 - (step - 4) : step - 4; unit = (b * 128 + blk) * 16 + h; }
    return (size_t)unit * 2 + d;
}
__device__ __forceinline__ void ss_load(SSIn& I, const unsigned char* PQ, size_t inst, int wv, int lane) {
    const unsigned char* pb = PQ + inst * 16384;
#pragma unroll
    for (int f = 0; f < 8; ++f) I.a[f] = *(const v4u*)(pb + (size_t)((f * 64 + lane) * 16));
    I.q[0] = *(const v4u*)(pb + 8192 + (size_t)((wv * 64 + lane) * 32)); I.q[1] = *(const v4u*)(pb + 8192 + (size_t)((wv * 64 + lane) * 32 + 16));
}
__device__ __forceinline__ void ss_step(f32x4 (&H)[4], const SSIn& cur, unsigned char* H0T, size_t inst, bool store_h0, int wv, int lr, int g) {
    const unsigned p00 = cvtpk(H[0][0], H[0][1]), p01 = cvtpk(H[0][2], H[0][3]), p10 = cvtpk(H[1][0], H[1][1]), p11 = cvtpk(H[1][2], H[1][3]);
    const unsigned p20 = cvtpk(H[2][0], H[2][1]), p21 = cvtpk(H[2][2], H[2][3]), p30 = cvtpk(H[3][0], H[3][1]), p31 = cvtpk(H[3][2], H[3][3]);
    if (store_h0) { unsigned char* hb = H0T + inst * 8192 + (size_t)((16 * wv + lr) * 64 + 4 * g) * 2;
        *(uint2*)(hb) = make_uint2(p00, p01); *(uint2*)(hb + 32) = make_uint2(p10, p11); *(uint2*)(hb + 64) = make_uint2(p20, p21); *(uint2*)(hb + 96) = make_uint2(p30, p31); }
    const bf16x8 b0 = __builtin_bit_cast(bf16x8, ((v4u){p00, p01, p10, p11})), b1 = __builtin_bit_cast(bf16x8, ((v4u){p20, p21, p30, p31}));
    H[0] = (f32x4){bflo(cur.q[0].x), bfhi(cur.q[0].x), bflo(cur.q[0].y), bfhi(cur.q[0].y)}; H[1] = (f32x4){bflo(cur.q[0].z), bfhi(cur.q[0].z), bflo(cur.q[0].w), bfhi(cur.q[0].w)};
    H[2] = (f32x4){bflo(cur.q[1].x), bfhi(cur.q[1].x), bflo(cur.q[1].y), bfhi(cur.q[1].y)}; H[3] = (f32x4){bflo(cur.q[1].z), bfhi(cur.q[1].z), bflo(cur.q[1].w), bfhi(cur.q[1].w)};
#pragma unroll
    for (int m = 0; m < 4; ++m) { H[m] = CK_MFMA(__builtin_bit_cast(bf16x8, cur.a[2 * m]), b0, H[m]); H[m] = CK_MFMA(__builtin_bit_cast(bf16x8, cur.a[2 * m + 1]), b1, H[m]); }
}
__device__ __forceinline__ void phase_ss(Frame& F) {
    const unsigned char* PQ = F.ws + WS_PQ; unsigned char* H0T = F.ws + WS_H0T;
    const int lane = F.lane, lr = lane & 15, g = lane >> 4;
    for (int task = (int)blockIdx.x; task < 256; task += F.G) {
        const int chain = task >> 2, wv = task & 3, b = chain >> 5, h = (chain >> 1) & 15, d = chain & 1;
        f32x4 H[4]; zero4(H);
        constexpr int NS = 4 + T / 64;
        static_assert(NS % 4 == 0, "unrolled by four");
        SSIn b0, b1, b2, b3;
        ss_load(b0, PQ, ss_pq(0, b, h, d), wv, lane); ss_load(b1, PQ, ss_pq(1, b, h, d), wv, lane); ss_load(b2, PQ, ss_pq(2, b, h, d), wv, lane); ss_load(b3, PQ, ss_pq(3, b, h, d), wv, lane);
        for (int step = 0; step < NS; step += 4) {
            const int n0 = step + 4 < NS ? step + 4 : NS - 1, n1 = step + 5 < NS ? step + 5 : NS - 1, n2 = step + 6 < NS ? step + 6 : NS - 1, n3 = step + 7 < NS ? step + 7 : NS - 1;
            ss_step(H, b0, H0T, ss_inst(step, b, h, d), step >= 4, wv, lr, g);     ss_load(b0, PQ, ss_pq(n0, b, h, d), wv, lane);
            ss_step(H, b1, H0T, ss_inst(step + 1, b, h, d), step >= 4, wv, lr, g); ss_load(b1, PQ, ss_pq(n1, b, h, d), wv, lane);
            ss_step(H, b2, H0T, ss_inst(step + 2, b, h, d), step >= 4, wv, lr, g); ss_load(b2, PQ, ss_pq(n2, b, h, d), wv, lane);
            ss_step(H, b3, H0T, ss_inst(step + 3, b, h, d), step >= 4, wv, lr, g); ss_load(b3, PQ, ss_pq(n3, b, h, d), wv, lane);
        }
    }
}

__device__ __forceinline__ void lora_atile(const bf16* z, const float* p_mu, LAS unsigned char* lds, int r0, int gi, int wave, int lane) {
    const int tok = 8 * wave + (lane >> 3), oct = lane & 7, row = r0 + tok;
    const v4u zz = {0u, 0u, 0u, 0u};
    const int col = (gi < 4 ? DECAY_OFF + 64 * gi : GLORA_OFF + 64 * (gi - 4)) + 8 * oct;
    v4u q[5]; q[0] = *(const v4u*)(z + (size_t)row * NZ + col);
#pragma unroll
    for (int j = 0; j < 4; ++j) { const int nr = nbr_row(row, j); q[1 + j] = nr >= 0 ? *(const v4u*)(z + (size_t)nr * NZ + col) : zz; }
    float v[8]; shift8(q, p_mu + col, v);
#pragma unroll
    for (int i = 0; i < 8; ++i) v[i] = gi < 2 ? 1.0f - 2.0f * __builtin_amdgcn_rcpf(1.0f + __expf(2.0f * v[i])) : (gi < 4 ? v[i] : fsig(v[i]));
    putN(lds + gi * TILE, tok, oct, v);
}
template <int KS> struct LoraB { bf16x8 w[KS][4]; };
template <int KS>
__device__ __forceinline__ void lora_bload(LoraB<KS>& B, const bf16* WL, int q, int lr, int g) {
    const int blkid = q >> 4, h = q & 15;
    const bf16* wrow = WL + (size_t)(blkid * 1024 + h * 64 + 8 * (lr >> 2) + (lr & 3)) * KL + blkid * 64 + 8 * g;
#pragma unroll
    for (int s = 0; s < KS; ++s)
#pragma unroll
        for (int n = 0; n < 4; ++n) B.w[s][n] = *(const bf16x8*)(wrow + (size_t)(32 * (n >> 1) + 4 * (n & 1)) * KL + 32 * s);
}
template <int KS>
__device__ __forceinline__ void lora_product(const LoraB<KS>& B, const LAS unsigned char* At, bf16* LO, int r0, int q, int lr, int g, const float* p_w0, const float* p_a0) {
    const int blkid = q >> 4, h = q & 15;
    f32x4 acc[4][4];
#pragma unroll
    for (int n = 0; n < 4; ++n)
#pragma unroll
        for (int m = 0; m < 4; ++m) acc[n][m] = (f32x4){0.f, 0.f, 0.f, 0.f};
#pragma unroll
    for (int s = 0; s < KS; ++s) {
        bf16x8 af[4];
#pragma unroll
        for (int m = 0; m < 4; ++m) af[m] = ldfrag(At + (s >> 1) * TILE, 16 * m + lr, 4 * (s & 1) + g);
#pragma unroll
        for (int n = 0; n < 4; ++n)
#pragma unroll
            for (int m = 0; m < 4; ++m) acc[n][m] = CK_MFMA(B.w[s][n], af[m], acc[n][m]);
    }
    bf16* ob = LO + (size_t)(r0 + lr) * NL + blkid * 1024 + h * 64 + 8 * g;
#pragma unroll
    for (int m = 0; m < 4; ++m)
#pragma unroll
        for (int p = 0; p < 2; ++p) {
            f32x4 v0 = acc[2 * p][m], v1 = acc[2 * p + 1][m];
            if (KS == 2) {
                const float* bp = (blkid < 2 ? p_w0 + (blkid & 1) * D : p_a0 + (blkid & 1) * D) + h * 64 + 8 * g + 32 * p;
                const f32x4 b0 = *(const f32x4*)bp, b1 = *(const f32x4*)(bp + 4); const float sc = blkid < 2 ? -0.6065306597126334f : 1.0f;
#pragma unroll
                for (int e = 0; e < 4; ++e) { v0[e] = sc * fsig(v0[e] + b0[e]); v1[e] = sc * fsig(v1[e] + b1[e]); }
            }
            v4u o; o.x = cvtpk(v0[0], v0[1]); o.y = cvtpk(v0[2], v0[3]); o.z = cvtpk(v1[0], v1[1]); o.w = cvtpk(v1[2], v1[3]);
            *(v4u*)(ob + (size_t)(16 * m) * NL + 32 * p) = o; }
}
__device__ __forceinline__ void phase_lora(Frame& F) {
    const bf16* z = (const bf16*)(F.ws + WS_Z); bf16* LO = (bf16*)(F.ws + WS_LORA); const bf16* WL = (const bf16*)(F.ws + WS_WLORA);
    const float* p_mu = KIN(I_MU); const float* p_w0 = KIN(I_W0); const float* p_a0 = KIN(I_A0);
    for (int unit = blockIdx.x; unit < ML / 64; unit += F.G) {
        int lane = F.lane; asm volatile("" : "+v"(lane));
        const int lr = lane & 15, g = lane >> 4, r0 = unit * 64;
#pragma unroll
        for (int gi = 0; gi < 6; ++gi) lora_atile(z, p_mu, F.lds, r0, gi, F.wave, lane);
        __syncthreads();
        const float* weo = KIN(I_WEO); bf16* WEO = (bf16*)(F.ws + WS_WEOUT);
        LAS float* fscr = (LAS float*)(F.lds + 6 * TILE + F.wave * 8704);
        const int ft0 = (unit * NWAVES + F.wave) * 10;
        CvTile ft;
#define LORA_FILL_LOAD(p) do { const int id_ = ft0 + (p); if (id_ < NE * 512) { const int e_ = id_ >> 9, q_ = id_ & 511; cv_load(ft, weo + (size_t)e_ * D * D, D, 32 * (q_ & 31), q_ >> 5, lane); } } while (0)
#define LORA_FILL_STORE(p) do { const int id_ = ft0 + (p); if (id_ < NE * 512) { const int e_ = id_ >> 9, q_ = id_ & 511; cv_to_lds(ft, fscr, lane); cv_store_bf16(fscr, WEO + (size_t)e_ * D * D, D, 32 * (q_ & 31), 64 * (q_ >> 5), lane); } } while (0)
        LoraB<2> b0, b1;
        lora_bload<2>(b0, WL, F.wave, lr, g);
#pragma unroll
        for (int i = 0; i < 8; i += 2) {
            lora_bload<2>(b1, WL, F.wave + 8 * (i + 1), lr, g); LORA_FILL_LOAD(i);
            lora_product<2>(b0, F.lds + ((F.wave + 8 * i) >> 4) * TILE, LO, r0, F.wave + 8 * i, lr, g, p_w0, p_a0);
            LORA_FILL_STORE(i);
            if (i + 2 < 8) lora_bload<2>(b0, WL, F.wave + 8 * (i + 2), lr, g);
            LORA_FILL_LOAD(i + 1);
            lora_product<2>(b1, F.lds + ((F.wave + 8 * (i + 1)) >> 4) * TILE, LO, r0, F.wave + 8 * (i + 1), lr, g, p_w0, p_a0);
            LORA_FILL_STORE(i + 1);
        }
        { LoraB<4> c0; lora_bload<4>(c0, WL, 64 + F.wave, lr, g); LORA_FILL_LOAD(8); lora_product<4>(c0, F.lds + 4 * TILE, LO, r0, 64 + F.wave, lr, g, p_w0, p_a0); LORA_FILL_STORE(8);
          lora_bload<4>(c0, WL, 72 + F.wave, lr, g); LORA_FILL_LOAD(9); lora_product<4>(c0, F.lds + 4 * TILE, LO, r0, 72 + F.wave, lr, g, p_w0, p_a0); LORA_FILL_STORE(9); }
#undef LORA_FILL_LOAD
#undef LORA_FILL_STORE
        __syncthreads();
    }
    for (int t = blockIdx.x; t < (MC / 64) * 32; t += F.G) {
        int lane = F.lane; asm volatile("" : "+v"(lane));
        const int lr = lane & 15, g = lane >> 4, r0 = ML + (t >> 5) * 64, q0 = 2 * (t & 31), gi = q0 >> 4;
        lora_atile(z, p_mu, F.lds, r0, gi, F.wave, lane);
        __syncthreads();
        if (F.wave < 2) { LoraB<2> b0; lora_bload<2>(b0, WL, q0 + F.wave, lr, g); lora_product<2>(b0, F.lds + gi * TILE, LO, r0, q0 + F.wave, lr, g, p_w0, p_a0); }
        __syncthreads();
    }
}

__device__ __forceinline__ void ss2_load(v4u& ra, v4u& rq, const unsigned char* PQ, size_t inst, int wv, int wave, int lane) {
    const unsigned char* pb = PQ + inst * 16384;
    ra = *(const v4u*)(pb + (size_t)((wave * 64 + lane) * 16));
    if (wave < 2) rq = *(const v4u*)(pb + 8192 + (size_t)((wv * 64 + lane) * 32 + 16 * wave));
}
__device__ __forceinline__ void phase_ss2(Frame& F) {
    const unsigned char* PQ = F.ws + WS_PQ; unsigned char* H0T = F.ws + WS_H0T;
    const int lane = F.lane, wave = F.wave, lr = lane & 15, g = lane >> 4;
    LAS unsigned char* ring = F.lds;
    constexpr int SLOT = 10240, NS = 4 + T / 64, DEPTH = 12;
    static_assert(NS % DEPTH == 0, "unrolled by DEPTH");
    for (int task = (int)blockIdx.x; task < 256; task += F.G) {
        const int chain = task >> 2, wv = task & 3, b = chain >> 5, h = (chain >> 1) & 15, d = chain & 1;
        f32x4 H[4]; zero4(H);
        v4u ra[DEPTH], rq[DEPTH];
#pragma unroll
        for (int k = 0; k < DEPTH; ++k) { rq[k] = (v4u){0u, 0u, 0u, 0u}; ss2_load(ra[k], rq[k], PQ, ss_pq(k, b, h, d), wv, wave, lane); }
        for (int step = 0; step < NS; step += DEPTH) {
#pragma unroll
            for (int k = 0; k < DEPTH; ++k) {
                const int st = step + k; LAS unsigned char* sl = ring + (st & 1) * SLOT;
                *(LAS v4u*)(sl + (wave * 64 + lane) * 16) = ra[k]; if (wave < 2) *(LAS v4u*)(sl + 8192 + (wave * 64 + lane) * 16) = rq[k];
                { const int nx = st + DEPTH < NS ? st + DEPTH : NS - 1; ss2_load(ra[k], rq[k], PQ, ss_pq(nx, b, h, d), wv, wave, lane); }
                __syncthreads();
                if (wave == 0) { SSIn cur;
#pragma unroll
                    for (int f = 0; f < 8; ++f) cur.a[f] = *(const LAS v4u*)(sl + (f * 64 + lane) * 16);
                    cur.q[0] = *(const LAS v4u*)(sl + 8192 + lane * 16); cur.q[1] = *(const LAS v4u*)(sl + 8192 + (64 + lane) * 16);
                    ss_step(H, cur, H0T, ss_inst(st, b, h, d), st >= 4, wv, lr, g); }
            }
        }
        __syncthreads();
    }
}

__device__ __forceinline__ void ss3_load(v4u& a0, v4u& a1, v2u& q, const unsigned char* PQ, size_t pq, int wv, int m, int lane) {
    const unsigned char* pb = PQ + pq * 16384;
    a0 = *(const v4u*)(pb + (size_t)(((2 * m) * 64 + lane) * 16)); a1 = *(const v4u*)(pb + (size_t)(((2 * m + 1) * 64 + lane) * 16));
    q = *(const v2u*)(pb + 8192 + (size_t)((wv * 64 + lane) * 32 + 8 * m));
}
__device__ __forceinline__ void phase_ss3(Frame& F) {
    const unsigned char* PQ = F.ws + WS_PQ; unsigned char* H0T = F.ws + WS_H0T;
    const int lane = F.lane, wave = F.wave, lr = lane & 15, g = lane >> 4, m = wave & 3;
    LAS unsigned char* xch = F.lds;
    constexpr int NS = 4 + T / 64, DEPTH = 12;
    static_assert(NS % DEPTH == 0, "unrolled by DEPTH");
    for (int task = (int)blockIdx.x; task < 256; task += F.G) {
        const int chain = task >> 2, wv = task & 3, b = chain >> 5, h = (chain >> 1) & 15, d = chain & 1;
        f32x4 H = {0.f, 0.f, 0.f, 0.f};
        v4u a0[DEPTH], a1[DEPTH]; v2u qv[DEPTH];
        if (wave < 4) {
#pragma unroll
            for (int k = 0; k < DEPTH; ++k) ss3_load(a0[k], a1[k], qv[k], PQ, ss_pq(k, b, h, d), wv, m, lane);
        }
        for (int step = 0; step < NS; step += DEPTH) {
#pragma unroll
            for (int k = 0; k < DEPTH; ++k) {
                const int st = step + k; LAS unsigned char* xs = xch + (st & 1) * 2048;
                if (wave < 4) {
                    const v2u pk = {cvtpk(H[0], H[1]), cvtpk(H[2], H[3])};
                    *(LAS v2u*)(xs + lane * 32 + 8 * m) = pk;
                    if (st >= 4) *(v2u*)(H0T + ss_inst(st, b, h, d) * 8192 + (size_t)((16 * wv + lr) * 64 + 16 * m + 4 * g) * 2) = pk;
                }
                __syncthreads();
                if (wave < 4) {
                    const v4u b0 = *(const LAS v4u*)(xs + lane * 32), b1 = *(const LAS v4u*)(xs + lane * 32 + 16);
                    f32x4 Hn = {bflo(qv[k].x), bfhi(qv[k].x), bflo(qv[k].y), bfhi(qv[k].y)};
                    Hn = CK_MFMA(__builtin_bit_cast(bf16x8, a0[k]), __builtin_bit_cast(bf16x8, b0), Hn);
                    Hn = CK_MFMA(__builtin_bit_cast(bf16x8, a1[k]), __builtin_bit_cast(bf16x8, b1), Hn);
                    H = Hn;
                    const int nx = st + DEPTH < NS ? st + DEPTH : NS - 1;
                    ss3_load(a0[k], a1[k], qv[k], PQ, ss_pq(nx, b, h, d), wv, m, lane);
                }
            }
        }
        __syncthreads();
    }
}
}
template <int PART>
__device__ __forceinline__ void phase_moe_weights(Frame& F) {
    LAS float* scr = (LAS float*)(F.lds + RING_OFF + F.wave * 16384);
    bf16* WEO = (bf16*)(F.ws + WS_WEOUT);
    constexpr int IT_IN = (D / 64) * (2048 / 32), IT_OUT = (D / 64) * (D / 32);
    if (PART == 0) {
        const float* wei = KIN(I_WEI);
        const int nstat = F.G * 7;
        int it = (int)blockIdx.x * 7 + F.wave - 1;
        while (it < NE * 128) {
            const int half = it & 1, r = it >> 1, e = r >> 6, n0 = 32 * (r & 63);
            const int c = n0 & 1023, rowbase = (c >> 7) * 256 + (n0 >= 1024 ? 128 : 0) + (c & 127);
            q8_item(wei + (size_t)e * D * 2048, 2048, n0, (signed char*)(F.ws + WS_WEIN) + (size_t)e * 2048 * D, (float*)(F.ws + MI_CSWEI) + (size_t)e * 2048, rowbase, scr, F.lane, 8 * half, 8 * half + 8);
            int nx = 0; if (F.lane == 0) nx = (int)__hip_atomic_fetch_add(F.ctl + CW_Q6, 1u, __ATOMIC_RELAXED, __HIP_MEMORY_SCOPE_AGENT);
            it = nstat + __builtin_amdgcn_readfirstlane(nx);
        }
    } else {
        const float* weo = KIN(I_WEO);
        for (int r = (int)blockIdx.x * 7 + F.wave - 1; r < NE * IT_OUT; r += F.G * 7) { const int e = r / IT_OUT, q = r % IT_OUT, kb = q / 32, n0 = 32 * (q % 32);
            transpose_item(weo + (size_t)e * D * D, D, 64 * kb, n0, WEO + (size_t)e * D * D, D, n0, scr, F.lane); }
    }
}

__device__ __forceinline__ void phase_x1_h2(Frame& F) {
    LAS float* LG = (LAS float*)(F.lds);
    LAS float* LA = LG + 2 * D; LAS float* LB = LA + 2 * D;
    const float* modp = (const float*)(F.ws + WS_MODP);
    for (int i = F.tid; i < 2 * D; i += NWAVES * 64) { const int v = i / D, j = i % D;
        LG[i] = mod_val(modp, KIN(I_BADA), v, 2048 + j) * KIN(I_NQM)[j];
        LA[i] = KIN(I_NPF)[j] * (1.0f + mod_val(modp, KIN(I_BADA), v, 4096 + j)); LB[i] = mod_val(modp, KIN(I_BADA), v, 3072 + j); }
    __syncthreads();
    const float* mix = (const float*)(F.ws + WS_MIX); float* x1 = (float*)(F.ws + WS_X1); bf16* h2 = (bf16*)(F.ws + WS_H2);
    for (int row = F.gw; row < ML; row += F.NGW) {
        const int vec = row >> 13;
        f32x4 m[4], x[4]; float s = 0.f;
#pragma unroll
        for (int j = 0; j < 4; ++j) { m[j] = *(const f32x4*)(mix + (size_t)row * D + 4 * F.lane + 256 * j); x[j] = *(const f32x4*)(KIN(I_X) + (size_t)row * D + 4 * F.lane + 256 * j);
            s += (m[j].x * m[j].x + m[j].y * m[j].y) + (m[j].z * m[j].z + m[j].w * m[j].w); }
        const float rstd = 1.0f / sqrtf(wave_sum(s) * (1.0f / D) + 1e-6f);
        float s2 = 0.f;
#pragma unroll
        for (int j = 0; j < 4; ++j) { const int c = 4 * F.lane + 256 * j; const f32x4 g = *(const LAS f32x4*)(LG + vec * D + c);
            x[j] = x[j] + g * (m[j] * rstd); *(f32x4*)(x1 + (size_t)row * D + c) = x[j];
            s2 += (x[j].x * x[j].x + x[j].y * x[j].y) + (x[j].z * x[j].z + x[j].w * x[j].w); }
        const float rstd2 = 1.0f / sqrtf(wave_sum(s2) * (1.0f / D) + 1e-6f);
        unsigned long long* o8 = (unsigned long long*)(h2 + (size_t)row * D) + F.lane;
        f32x4 hq[4]; float mx = 0.f;
#pragma unroll
        for (int j = 0; j < 4; ++j) { const int c = 4 * F.lane + 256 * j; const f32x4 a = *(const LAS f32x4*)(LA + vec * D + c), b = *(const LAS f32x4*)(LB + vec * D + c);
            const f32x4 h = x[j] * rstd2 * a + b; hq[j] = h;
            mx = fmaxf(mx, fmaxf(fmaxf(fabsf(h.x), fabsf(h.y)), fmaxf(fabsf(h.z), fabsf(h.w))));
            o8[64 * j] = (unsigned long long)pk2(h.x, h.y) | ((unsigned long long)pk2(h.z, h.w) << 32); }
        mx = wave_max(mx);
        const float iv = mx > 0.f ? 127.0f / mx : 0.f;
        if (F.lane == 0) ((float*)(F.ws + MI_RSH2))[row] = mx * (1.0f / 127.0f);
        unsigned* o4 = (unsigned*)(F.ws + WS_H2Q + (size_t)row * D) + F.lane;
#pragma unroll
        for (int j = 0; j < 4; ++j) o4[64 * j] = pack_q4(hq[j].x * iv, hq[j].y * iv, hq[j].z * iv, hq[j].w * iv);
    }
}

__device__ __forceinline__ void phase_route(Frame& F) {
    const float* LG = (const float*)(F.ws + WS_LOGIT);
    int* selE = (int*)(F.ws + MI_SELE); int* selP = (int*)(F.ws + MI_SELP); float* gate = (float*)(F.ws + MI_GATE);
    for (int task = F.gw; task < ML / 64; task += F.NGW) {
        const int row = task * 64 + F.lane;
        float v[NE];
#pragma unroll
        for (int q = 0; q < NE / 4; ++q) { const f32x4 x = *(const f32x4*)(LG + (size_t)row * 256 + 4 * q); const f32x4 bb = *(const f32x4*)(KIN(I_BR) + 4 * q);
            v[4 * q] = x.x + bb.x; v[4 * q + 1] = x.y + bb.y; v[4 * q + 2] = x.z + bb.z; v[4 * q + 3] = x.w + bb.w; }
        int se[4]; float sv[4];
#pragma unroll
        for (int k = 0; k < 4; ++k) { float best = -3.0e38f; int bi = 0;
#pragma unroll
            for (int e = 0; e < NE; ++e) if (v[e] > best) { best = v[e]; bi = e; }
#pragma unroll
            for (int e = 0; e < NE; ++e) v[e] = (e == bi) ? -3.0e38f : v[e];
            se[k] = bi; sv[k] = best; }
        float ex[4], sum = 0.f;
#pragma unroll
        for (int k = 0; k < 4; ++k) { ex[k] = __expf(sv[k] - sv[0]); sum += ex[k]; }
        const float inv = 1.0f / sum;
        int sp[4] = {0, 0, 0, 0};
        int myn = 0;
#pragma unroll
        for (int e = 0; e < NE; ++e) { const bool p = (se[0] == e) | (se[1] == e) | (se[2] == e) | (se[3] == e); const int n = __popcll(__ballot(p)); myn = (F.lane == e) ? n : myn; }
        int mybase = 0;
        if (F.lane < NE && myn > 0) mybase = (int)__hip_atomic_fetch_add(F.ctl + CW_CNT + 64 * F.lane, (unsigned)myn, __ATOMIC_RELAXED, __HIP_MEMORY_SCOPE_AGENT);
#pragma unroll
        for (int e = 0; e < NE; ++e) {
            const bool p = (se[0] == e) | (se[1] == e) | (se[2] == e) | (se[3] == e);
            const unsigned long long mask = __ballot(p);
            const int base = __shfl(mybase, e);
            const int pos = base + __popcll(mask & ((1ull << F.lane) - 1ull));
#pragma unroll
            for (int k = 0; k < 4; ++k) if (se[k] == e) sp[k] = pos;
        }
        *(int4*)(selE + (size_t)row * 4) = make_int4(se[0], se[1], se[2], se[3]);
        *(int4*)(selP + (size_t)row * 4) = make_int4(sp[0], sp[1], sp[2], sp[3]);
        *(f32x4*)(gate + (size_t)row * 4) = (f32x4){ex[0] * inv, ex[1] * inv, ex[2] * inv, ex[3] * inv};
    }
}

__device__ __forceinline__ void phase_x1h2_route(Frame& F) {
    constexpr int HS_STRIDE = 2064;
    LAS unsigned char* Hs = F.lds;
    LAS float* LG = (LAS float*)(F.lds + 132096);
    LAS float* LA = LG + D; LAS float* LB = LA + D;
    LAS float* LGT = (LAS float*)(F.lds + LDS_X_OFF);
    const float* modp = (const float*)(F.ws + WS_MODP);
    const float* mix = (const float*)(F.ws + WS_MIX); float* x1 = (float*)(F.ws + WS_X1);
    const float* xin = KIN(I_X); const float* b_ada = KIN(I_BADA); const float* nqm = KIN(I_NQM); const float* npf = KIN(I_NPF);
    const bf16* WR = (const bf16*)(F.ws + WS_WROUT);
    int* selE = (int*)(F.ws + MI_SELE); int* selP = (int*)(F.ws + MI_SELP); float* gate = (float*)(F.ws + MI_GATE);
    for (int rb = blockIdx.x; rb < ML / 64; rb += F.G) {
        const int vec = (rb * 64) >> 13;
        __syncthreads();
        for (int i = F.tid; i < D; i += NWAVES * 64) {
            LG[i] = mod_val(modp, b_ada, vec, 2048 + i) * nqm[i];
            LA[i] = npf[i] * (1.0f + mod_val(modp, b_ada, vec, 4096 + i)); LB[i] = mod_val(modp, b_ada, vec, 3072 + i); }
        __syncthreads();
        for (int rr = 0; rr < 8; ++rr) {
            const int lrow = F.wave * 8 + rr, row = rb * 64 + lrow;
            f32x4 m[4], x[4]; float s = 0.f;
#pragma unroll
            for (int j = 0; j < 4; ++j) { m[j] = *(const f32x4*)(mix + (size_t)row * D + 4 * F.lane + 256 * j); x[j] = *(const f32x4*)(xin + (size_t)row * D + 4 * F.lane + 256 * j);
                s += (m[j].x * m[j].x + m[j].y * m[j].y) + (m[j].z * m[j].z + m[j].w * m[j].w); }
            const float rstd = 1.0f / sqrtf(wave_sum(s) * (1.0f / D) + 1e-6f);
            float s2 = 0.f;
#pragma unroll
            for (int j = 0; j < 4; ++j) { const int c = 4 * F.lane + 256 * j; const f32x4 g = *(const LAS f32x4*)(LG + c);
                x[j] = x[j] + g * (m[j] * rstd); *(f32x4*)(x1 + (size_t)row * D + c) = x[j];
                s2 += (x[j].x * x[j].x + x[j].y * x[j].y) + (x[j].z * x[j].z + x[j].w * x[j].w); }
            const float rstd2 = 1.0f / sqrtf(wave_sum(s2) * (1.0f / D) + 1e-6f);
            f32x4 hq[4]; float mx = 0.f;
#pragma unroll
            for (int j = 0; j < 4; ++j) { const int c = 4 * F.lane + 256 * j; const f32x4 a = *(const LAS f32x4*)(LA + c), b = *(const LAS f32x4*)(LB + c);
                const f32x4 h = x[j] * rstd2 * a + b; hq[j] = h;
                mx = fmaxf(mx, fmaxf(fmaxf(fabsf(h.x), fabsf(h.y)), fmaxf(fabsf(h.z), fabsf(h.w))));
                *(LAS v2u*)(Hs + lrow * HS_STRIDE + c * 2) = (v2u){pk2(h.x, h.y), pk2(h.z, h.w)}; }
            mx = wave_max(mx);
            const float iv = mx > 0.f ? 127.0f / mx : 0.f;
            if (F.lane == 0) ((float*)(F.ws + MI_RSH2))[row] = mx * (1.0f / 127.0f);
            unsigned* o4 = (unsigned*)(F.ws + WS_H2Q + (size_t)row * D) + F.lane;
#pragma unroll
            for (int j = 0; j < 4; ++j) o4[64 * j] = pack_q4(hq[j].x * iv, hq[j].y * iv, hq[j].z * iv, hq[j].w * iv);
        }
        __syncthreads();
        {
            const int rt = F.wave & 3, et = F.wave >> 2, lr = F.lane & 15, g = F.lane >> 4;
            typedef short bf16x8_t __attribute__((ext_vector_type(8)));
            f32x4 acc = {0.f, 0.f, 0.f, 0.f};
            const LAS unsigned char* ap = Hs + (16 * rt + lr) * HS_STRIDE + 16 * g; const bf16* bp = WR + (size_t)(16 * et + lr) * D + 8 * g;
#pragma unroll 8
            for (int s = 0; s < 32; ++s) { const bf16x8_t a = *(const LAS bf16x8_t*)(ap + 64 * s); const bf16x8_t b = *(const bf16x8_t*)(bp + 32 * s);
                acc = __builtin_amdgcn_mfma_f32_16x16x32_bf16(a, b, acc, 0, 0, 0); }
#pragma unroll
            for (int i = 0; i < 4; ++i) LGT[(16 * rt + 4 * g + i) * 33 + 16 * et + lr] = acc[i];
        }
        __syncthreads();
        if (F.wave == 0) {
            const int row = rb * 64 + F.lane;
            const float* br = KIN(I_BR);
            float v[NE];
#pragma unroll
            for (int e = 0; e < NE; ++e) v[e] = LGT[F.lane * 33 + e] + br[e];
            int se[4]; float sv[4];
#pragma unroll
            for (int k = 0; k < 4; ++k) { float best = -3.0e38f; int bi = 0;
#pragma unroll
                for (int e = 0; e < NE; ++e) if (v[e] > best) { best = v[e]; bi = e; }
#pragma unroll
                for (int e = 0; e < NE; ++e) v[e] = (e == bi) ? -3.0e38f : v[e];
                se[k] = bi; sv[k] = best; }
            float ex[4], sum = 0.f;
#pragma unroll
            for (int k = 0; k < 4; ++k) { ex[k] = __expf(sv[k] - sv[0]); sum += ex[k]; }
            const float inv = 1.0f / sum;
            int sp[4] = {0, 0, 0, 0};
            int myn = 0;
#pragma unroll
            for (int e = 0; e < NE; ++e) { const bool p = (se[0] == e) | (se[1] == e) | (se[2] == e) | (se[3] == e); const int n = __popcll(__ballot(p)); myn = (F.lane == e) ? n : myn; }
            int mybase = 0;
            if (F.lane < NE && myn > 0) mybase = (int)__hip_atomic_fetch_add(F.ctl + CW_CNT + 64 * F.lane, (unsigned)myn, __ATOMIC_RELAXED, __HIP_MEMORY_SCOPE_AGENT);
#pragma unroll
            for (int e = 0; e < NE; ++e) {
                const bool p = (se[0] == e) | (se[1] == e) | (se[2] == e) | (se[3] == e);
                const unsigned long long mask = __ballot(p);
                const int base = __shfl(mybase, e);
                const int pos = base + __popcll(mask & ((1ull << F.lane) - 1ull));
#pragma unroll
                for (int k = 0; k < 4; ++k) if (se[k] == e) sp[k] = pos;
            }
            *(int4*)(selE + (size_t)row * 4) = make_int4(se[0], se[1], se[2], se[3]);
            *(int4*)(selP + (size_t)row * 4) = make_int4(sp[0], sp[1], sp[2], sp[3]);
            *(f32x4*)(gate + (size_t)row * 4) = (f32x4){ex[0] * inv, ex[1] * inv, ex[2] * inv, ex[3] * inv};
        }
    }
    __syncthreads();
}

__device__ __forceinline__ void phase_scatter(Frame& F) {
    LAS int* PS = (LAS int*)(F.lds);
    if (F.tid == 0) { int acc = 0;
        for (int e = 0; e < NE; ++e) { const int c = (int)__hip_atomic_load(F.ctl + CW_CNT + 64 * e, __ATOMIC_RELAXED, __HIP_MEMORY_SCOPE_AGENT); PS[e] = acc; PS[64 + e] = c; acc += (c + 255) / 256 * 256; }
        PS[NE] = acc; }
    __syncthreads();
    int* blkE = (int*)(F.ws + MI_BLKE);
    if (blockIdx.x == 0) {
        for (int b = F.tid; b < MAXBLK; b += NWAVES * 64) { int e = NE - 1;
            for (int q = 0; q < NE; ++q) if (b * 256 >= PS[q] && b * 256 < PS[q + 1]) e = q;
            blkE[b] = e; }
        if (F.tid == 0) blkE[MAXBLK] = PS[NE] / 256;
    }
    const int* selE = (const int*)(F.ws + MI_SELE); const int* selP = (const int*)(F.ws + MI_SELP); int* dest = (int*)(F.ws + MI_DEST);
    const unsigned char* h2q = F.ws + WS_H2Q; unsigned char* xb = F.ws + WS_XB; const float* rsh2 = (const float*)(F.ws + MI_RSH2); float* rsxb = (float*)(F.ws + MI_RSXB);
    for (int row = F.gw; row < ML; row += F.NGW) {
        const int4 se = *(const int4*)(selE + (size_t)row * 4), sp = *(const int4*)(selP + (size_t)row * 4);
        const int d0 = PS[se.x] + sp.x, d1 = PS[se.y] + sp.y, d2 = PS[se.z] + sp.z, d3 = PS[se.w] + sp.w;
        const float rsc = rsh2[row];
        if (F.lane == 0) { *(int4*)(dest + (size_t)row * 4) = make_int4(d0, d1, d2, d3); rsxb[d0] = rsc; rsxb[d1] = rsc; rsxb[d2] = rsc; rsxb[d3] = rsc; }
        const v4u a = *(const v4u*)(h2q + (size_t)row * D + 16 * F.lane);
        *(v4u*)(xb + (size_t)d0 * D + 16 * F.lane) = a; *(v4u*)(xb + (size_t)d1 * D + 16 * F.lane) = a;
        *(v4u*)(xb + (size_t)d2 * D + 16 * F.lane) = a; *(v4u*)(xb + (size_t)d3 * D + 16 * F.lane) = a;
    }
    for (int p = F.gw; p < NE * 256; p += F.NGW) {
        const int e = p >> 8, r = p & 255, c = PS[64 + e], padded = (c + 255) / 256 * 256;
        if (c + r < padded) { unsigned char* dst = xb + (size_t)(PS[e] + c + r) * D; *(v4u*)(dst + 16 * F.lane) = (v4u){0u, 0u, 0u, 0u}; if (F.lane == 0) rsxb[PS[e] + c + r] = 0.f; }
    }
}

__device__ __forceinline__ void phase_combine(Frame& F) {
    LAS float* LG = (LAS float*)(F.lds);
    const float* modp = (const float*)(F.ws + WS_MODP);
    for (int i = F.tid; i < 2 * D; i += NWAVES * 64) { const int v = i / D, j = i % D; LG[i] = mod_val(modp, KIN(I_BADA), v, 5120 + j) * KIN(I_NQF)[j]; }
    __syncthreads();
    const int* dest = (const int*)(F.ws + MI_DEST); const float* gate = (const float*)(F.ws + MI_GATE);
    const bf16* y2 = (const bf16*)(F.ws + WS_Y2); const float* x1 = (const float*)(F.ws + WS_X1);
    for (int row = F.gw; row < ML; row += F.NGW) {
        const int vec = row >> 13;
        const int4 dd = *(const int4*)(dest + (size_t)row * 4); const f32x4 gg = *(const f32x4*)(gate + (size_t)row * 4);
        const int dk[4] = {dd.x, dd.y, dd.z, dd.w}; const float gk[4] = {gg.x, gg.y, gg.z, gg.w};
        float f[16];
#pragma unroll
        for (int i = 0; i < 16; ++i) f[i] = 0.f;
#pragma unroll
        for (int k = 0; k < 4; ++k) { float t[16]; ld16bf(y2 + (size_t)dk[k] * D + 16 * F.lane, t);
#pragma unroll
            for (int i = 0; i < 16; ++i) f[i] += gk[k] * t[i]; }
        float s = 0.f;
#pragma unroll
        for (int i = 0; i < 16; ++i) s += f[i] * f[i];
        const float rstd = 1.0f / sqrtf(wave_sum(s) * (1.0f / D) + 1e-6f);
        float xv[16], g[16], o[16]; ld16f(x1 + (size_t)row * D + 16 * F.lane, xv); ld16f_lds(LG + vec * D + 16 * F.lane, g);
#pragma unroll
        for (int i = 0; i < 16; ++i) o[i] = xv[i] + g[i] * (f[i] * rstd);
        st16f(F.out + (size_t)row * D + 16 * F.lane, o);
    }
}

constexpr int N_PHASES = 13;
#ifndef PROBE_MASK
#define PROBE_MASK 0
#endif
#ifndef STAGE_REP
#define STAGE_REP 0
#endif
#ifndef USE_FLAT_BAR
#define USE_FLAT_BAR 0
#endif
struct Args { const float* in[30]; float* out; unsigned char* ws; int ph_lo, ph_hi; };
__global__ void __launch_bounds__(NWAVES * 64, 2) fwd(Args args) {
    extern __shared__ __attribute__((aligned(16))) unsigned char lds[];
    Frame F;
    F.lds = (LAS unsigned char*)lds;
    F.MISC = (volatile LAS unsigned*)(F.lds + MISC_OFF);
    F.tid = threadIdx.x; F.lane = F.tid & 63; F.wave = __builtin_amdgcn_readfirstlane(F.tid >> 6);
    F.G = gridDim.x; F.gw = blockIdx.x * NWAVES + F.wave; F.NGW = F.G * NWAVES;
    F.ws = args.ws; F.ctl = (unsigned*)(args.ws + WS_CTL); F.out = args.out;
    for (int u = F.tid; u < (LDS_X_OFF - LDSCTL_OFF) / 4; u += NWAVES * 64) ((LAS unsigned*)(F.lds + LDSCTL_OFF))[u] = 0u;
    __syncthreads();
    const int lo = args.ph_lo, hi = args.ph_hi;
    const bool use_bar = (hi - lo) > 1;
    XcdBarrier bar; bar.bar = F.ctl + CW_BAR; bar.x = 0; bar.st = nullptr;
    if (use_bar && !USE_FLAT_BAR) bar = xcd_barrier_post(F.ctl + CW_BAR, F.MISC + 8);
#define IN(k) (lo <= (k) && (k) < hi)
    unsigned fb_extra = 0u;
#define SEAM(k) do { if (IN(k) && IN((k) + 1)) { if (USE_FLAT_BAR) flat_barrier(F.ctl + CW_FB, (unsigned)((k) - lo + 1) + fb_extra); else xcd_barrier2(bar); } else __syncthreads(); } while (0)

#define DUP(k) ((PROBE_MASK >> (k)) & 1)
    if (IN(0)) { phase_prologue(F); if (DUP(0)) { __syncthreads(); phase_prologue(F); } SEAM(0); }
    if (DUP(20)) { for (int q = 0; q < 10; ++q) { if (USE_FLAT_BAR) { ++fb_extra; flat_barrier(F.ctl + CW_FB, 1u + fb_extra); } else xcd_barrier2(bar); } }
    if (IN(1)) { phase_hrows(F); if (DUP(1)) { __syncthreads(); phase_hrows(F); } SEAM(1); }
    if (IN(2)) {
        {         pg8::Gemm g{(const bf16*)(F.ws + WS_A0), (const bf16*)(F.ws + WS_WIN), MT, NZ, D}; pg8::StaticOrder S; S.init(MT, NZ, F.G, (int)blockIdx.x);
        pg8::EpiBf16I8 E{(bf16*)(F.ws + WS_Z), NZ, (const float*)(F.ws + MI_RSH), (const float*)(F.ws + MI_CSWIN)};
        pg8::gemm_phase_i8<pg8::EpiBf16I8, pg8::StaticOrder, true, true>(F.lds + RING_OFF, g, S, E); __syncthreads(); }
        if (DUP(2)) {         pg8::Gemm g{(const bf16*)(F.ws + WS_A0), (const bf16*)(F.ws + WS_WIN), MT, NZ, D}; pg8::StaticOrder S; S.init(MT, NZ, F.G, (int)blockIdx.x);
        pg8::EpiBf16I8 E{(bf16*)(F.ws + WS_Z), NZ, (const float*)(F.ws + MI_RSH), (const float*)(F.ws + MI_CSWIN)};
        pg8::gemm_phase_i8<pg8::EpiBf16I8, pg8::StaticOrder, true, true>(F.lds + RING_OFF, g, S, E); __syncthreads(); }
        SEAM(2); }
    if (IN(3)) { ck::phase_lora(F); SEAM(3); }
    if (IN(4)) { ck::phase_cp2(F); if (DUP(5)) { __syncthreads(); ck::phase_cp2(F); } if (DUP(22)) { __syncthreads(); ck::phase_lora(F); } SEAM(4); }
    if (IN(5)) { if (F.wave == 0) ck::phase_ss(F); if (DUP(23)) { __syncthreads(); ck::phase_ss3(F); } if (DUP(6)) { __syncthreads(); if (F.wave == 0) ck::phase_ss(F); else phase_moe_weights<0>(F); } if (DUP(17)) { __syncthreads(); if (F.wave == 0) ck::phase_ss(F); } SEAM(5); }
    if (IN(6)) { ck::phase_co2(F); if (DUP(7)) { __syncthreads(); ck::phase_co2(F); } SEAM(6); }
    if (IN(7)) {
        {         pg8::Gemm g{(const bf16*)(F.ws + WS_A0), (const bf16*)(F.ws + WS_WOUT), ML, D, D}; pg8::StaticOrder S; S.init(ML, D, F.G, (int)blockIdx.x);
        pg8::EpiF32 E{(float*)(F.ws + WS_MIX), D};
        pg8::gemm_phase<pg8::EpiF32, pg8::StaticOrder, true, true>(F.lds + RING_OFF, g, S, E);
        __syncthreads(); }
        if (DUP(8)) {         pg8::Gemm g{(const bf16*)(F.ws + WS_A0), (const bf16*)(F.ws + WS_WOUT), ML, D, D}; pg8::StaticOrder S; S.init(ML, D, F.G, (int)blockIdx.x);
        pg8::EpiF32 E{(float*)(F.ws + WS_MIX), D};
        pg8::gemm_phase<pg8::EpiF32, pg8::StaticOrder, true, true>(F.lds + RING_OFF, g, S, E);
        __syncthreads(); }
        SEAM(7); }
    if (IN(8)) { phase_x1h2_route(F); SEAM(8); }
    if (IN(9)) { phase_scatter(F); if (DUP(12)) { __syncthreads(); phase_scatter(F); } SEAM(9); }
    if (IN(10)) {
        {         const int* blkE = (const int*)(F.ws + MI_BLKE);
        pg8::Gemm g{(const bf16*)(F.ws + WS_XB), (const bf16*)(F.ws + WS_WEIN), NROWS, 2048, D};
        pg8::MoeOrder<8> S{blkE, __hip_atomic_load(blkE + MAXBLK, __ATOMIC_RELAXED, __HIP_MEMORY_SCOPE_AGENT) * 8, F.G, (int)blockIdx.x};
        pg8::EpiSwigluI8 E{(bf16*)(F.ws + WS_ACT), KIN(I_BEI), (const float*)(F.ws + MI_RSXB), (const float*)(F.ws + MI_CSWEI)};
        pg8::gemm_phase_i8<pg8::EpiSwigluI8, pg8::MoeOrder<8>, true, true>(F.lds + RING_OFF, g, S, E); __syncthreads(); }
        if (DUP(13)) {         const int* blkE = (const int*)(F.ws + MI_BLKE);
        pg8::Gemm g{(const bf16*)(F.ws + WS_XB), (const bf16*)(F.ws + WS_WEIN), NROWS, 2048, D};
        pg8::MoeOrder<8> S{blkE, __hip_atomic_load(blkE + MAXBLK, __ATOMIC_RELAXED, __HIP_MEMORY_SCOPE_AGENT) * 8, F.G, (int)blockIdx.x};
        pg8::EpiSwigluI8 E{(bf16*)(F.ws + WS_ACT), KIN(I_BEI), (const float*)(F.ws + MI_RSXB), (const float*)(F.ws + MI_CSWEI)};
        pg8::gemm_phase_i8<pg8::EpiSwigluI8, pg8::MoeOrder<8>, true, true>(F.lds + RING_OFF, g, S, E); __syncthreads(); }
        SEAM(10); }
    if (IN(11)) {
        {         const int* blkE = (const int*)(F.ws + MI_BLKE);
        pg8::Gemm g{(const bf16*)(F.ws + WS_ACT), (const bf16*)(F.ws + WS_WEOUT), NROWS, D, D};
        pg8::MoeOrder<4> S{blkE, __hip_atomic_load(blkE + MAXBLK, __ATOMIC_RELAXED, __HIP_MEMORY_SCOPE_AGENT) * 4, F.G, (int)blockIdx.x};
        pg8::EpiBf16 E{(bf16*)(F.ws + WS_Y2), D, KIN(I_BEO), D};
        pg8::gemm_phase<pg8::EpiBf16, pg8::MoeOrder<4>, true, true>(F.lds + RING_OFF, g, S, E); __syncthreads(); }
        if (DUP(14)) {         const int* blkE = (const int*)(F.ws + MI_BLKE);
        pg8::Gemm g{(const bf16*)(F.ws + WS_ACT), (const bf16*)(F.ws + WS_WEOUT), NROWS, D, D};
        pg8::MoeOrder<4> S{blkE, __hip_atomic_load(blkE + MAXBLK, __ATOMIC_RELAXED, __HIP_MEMORY_SCOPE_AGENT) * 4, F.G, (int)blockIdx.x};
        pg8::EpiBf16 E{(bf16*)(F.ws + WS_Y2), D, KIN(I_BEO), D};
        pg8::gemm_phase<pg8::EpiBf16, pg8::MoeOrder<4>, true, true>(F.lds + RING_OFF, g, S, E); __syncthreads(); }
        SEAM(11); }
    if (IN(12)) { phase_combine(F); if (DUP(15)) { __syncthreads(); phase_combine(F); } }
#undef IN
#undef SEAM
}

#ifndef MK_N_LAUNCHES
#define MK_N_LAUNCHES 1
#endif
extern "C" void kernel_launch(void* const* d_in, const int* in_sizes, int n_in, void* d_out, int out_size, void* d_ws, size_t ws_size, hipStream_t stream) {
    static int grid = 0;
    if (grid == 0) {
        if (n_in != 30 || out_size != ML * D || ws_size < WS_END) { fprintf(stderr, "kernel_launch: unexpected shapes (n_in %d out %d ws %zu, need %zu); nothing launched\n", n_in, out_size, ws_size, (size_t)WS_END); grid = -1; return; }
        int dev = 0, cus = 0, per_cu = 0;
        if (hipGetDevice(&dev) != hipSuccess || hipDeviceGetAttribute(&cus, hipDeviceAttributeMultiprocessorCount, dev) != hipSuccess) { grid = -1; return; }
        if (hipFuncSetAttribute((const void*)fwd, hipFuncAttributeMaxDynamicSharedMemorySize, LDS_BYTES) != hipSuccess) { fprintf(stderr, "kernel_launch: hipFuncSetAttribute failed\n"); grid = -1; return; }
        if (hipOccupancyMaxActiveBlocksPerMultiprocessor(&per_cu, (const void*)fwd, NWAVES * 64, LDS_BYTES) != hipSuccess || per_cu < 1)
            fprintf(stderr, "kernel_launch: note: occupancy query reports %d workgroups per CU\n", per_cu);
        (void)hipGetLastError();
        grid = cus;
    }
    if (grid < 0) return;
    if (hipMemsetAsync((char*)d_ws + WS_CTL, 0, CTL_ZERO_BYTES, stream) != hipSuccess) return;
    Args a{};
    for (int i = 0; i < 30; ++i) a.in[i] = (const float*)d_in[i];
    a.out = (float*)d_out; a.ws = (unsigned char*)d_ws;
    if (MK_N_LAUNCHES == 1) { a.ph_lo = 0; a.ph_hi = N_PHASES; hipLaunchKernelGGL(fwd, dim3(grid), dim3(NWAVES * 64), LDS_BYTES, stream, a); }
    else for (int p = 0; p < N_PHASES; ++p) { a.ph_lo = p; a.ph_hi = p + 1; hipLaunchKernelGGL(fwd, dim3(grid), dim3(NWAVES * 64), LDS_BYTES, stream, a); }
}
```

```cpp
#include <hip/hip_runtime.h>
#include <cstdio>
#include <cstdint>

namespace pg8 {
#define PG8_LAS __attribute__((address_space(3)))
typedef unsigned short bf16_t;
typedef short bf16x8 __attribute__((ext_vector_type(8)));
typedef float f32x4 __attribute__((ext_vector_type(4)));
typedef unsigned u32x4 __attribute__((ext_vector_type(4)));
constexpr int BM = 256, BK = 64, HALF = 128, HTB = HALF * BK * 2  , STAGE_BYTES = 8 * HTB, NXCD = 8, WGM = 8;

__host__ __device__ __forceinline__ int lds_byte(int r, int c) { const int st = (r >> 4) * 2 + (c >> 5), rr = r & 15, cc = c & 31, ob = rr * 64 + cc * 2; return st * 1024 + (ob ^ (((ob >> 9) & 1) << 5)); }
__host__ __device__ __forceinline__ void stage_rc(int b, int& R, int& C) { const int st = b / 1024, sb = b % 1024, swz = sb ^ (((sb >> 9) & 1) << 5); R = (st >> 1) * 16 + swz / 64; C = (st & 1) * 32 + (swz % 64) / 2; }
__host__ __device__ __forceinline__ int perm32(int rho) { const int n = rho >> 4, i = rho & 15; return 8 * (i >> 2) + 4 * n + (i & 3); }

struct Unit { int pm, pn, pb, e; };
struct Gemm { const bf16_t* A; const bf16_t* Bt; int M, N, K; };

struct StaticOrder {
    int nM, nN, nwg, G, c;
    __host__ __device__ void init(int M, int N, int G_, int c_) { nM = M / BM; nN = N / BM; nwg = nM * nN; G = G_; c = c_; }
    __host__ __device__ bool next(int i, Unit& u) const {
        const long L = (long)i * G + c; if (L >= nwg) return false;
        int wgid = (int)L; { const int q = nwg / NXCD, r = nwg % NXCD, xcd = wgid % NXCD, off = wgid / NXCD; wgid = (xcd < r ? xcd * (q + 1) : r * (q + 1) + (xcd - r) * q) + off; }
        const int nig = WGM * nN, gid = wgid / nig, fm = gid * WGM, gsz = (nM - fm) < WGM ? (nM - fm) : WGM;
        u.pm = fm + ((wgid % nig) % gsz); u.pn = (wgid % nig) / gsz; u.pb = u.pn; u.e = 0; return true;
    }
    __device__ __forceinline__ void a_ready(const Unit&) const {}
    __device__ __forceinline__ void done(const Unit&) const {}
};
template <int NT> struct MoeOrder {
    const int* blk_e; int nunits, G, c;
    __device__ bool next(int i, Unit& u) const {
        int L;
        if ((G & 7) == 0 && ((G >> 3) % NT) == 0) { const int per = G >> 3, xcd = c & 7, k = c >> 3, bpx = per / NT;
            L = ((i * 8 + xcd) * bpx + k / NT) * NT + (k % NT); }
        else L = i * G + c;
        if (L >= nunits) return false;
        const int blk = L / NT, pn = L % NT; const int e = __hip_atomic_load(blk_e + blk, __ATOMIC_RELAXED, __HIP_MEMORY_SCOPE_AGENT);
        u.pm = blk; u.pn = pn; u.pb = e * NT + pn; u.e = e; return true;
    }
    __device__ __forceinline__ void a_ready(const Unit&) const {}
    __device__ __forceinline__ void done(const Unit&) const {}
};

__device__ __forceinline__ unsigned cvt_pk_bf16(float lo, float hi) { unsigned r; asm volatile("v_cvt_pk_bf16_f32 %0, %1, %2" : "=v"(r) : "v"(lo), "v"(hi)); return r; }

struct EpiF32 {
    static constexpr bool PERM = false, AFTER_DRAIN = false;
    float* C; int ldc;
    __device__ __forceinline__ void operator()(const f32x4 (&acc)[2][2][4][2], const Unit& u, int wr, int wc, int fr, int fq) const {
        const int row0 = u.pm * BM + wr * 64 + fr, col0 = u.pn * BM + wc * 32 + 4 * fq;
#pragma unroll
        for (int ai = 0; ai < 2; ++ai)
#pragma unroll
            for (int m = 0; m < 4; ++m) { float* rowp = C + (size_t)(row0 + ai * HALF + m * 16) * ldc + col0;
#pragma unroll
                for (int bj = 0; bj < 2; ++bj)
#pragma unroll
                    for (int n = 0; n < 2; ++n) __builtin_nontemporal_store(acc[ai][bj][m][n], (f32x4*)(rowp + bj * HALF + n * 16)); }
    }
};
struct EpiBf16 {
    static constexpr bool PERM = true, AFTER_DRAIN = false;
    bf16_t* O; int ldc; const float* bias; int bias_estride;
    __device__ __forceinline__ void operator()(const f32x4 (&acc)[2][2][4][2], const Unit& u, int wr, int wc, int fr, int fq) const {
        const int row0 = u.pm * BM + wr * 64 + fr; const int col0 = u.pn * BM + wc * 32 + 8 * fq;
        const float* bp = bias ? bias + (size_t)u.e * bias_estride + col0 : nullptr;
        f32x4 bv[2][2];
#pragma unroll
        for (int bj = 0; bj < 2; ++bj)
#pragma unroll
            for (int n = 0; n < 2; ++n) bv[bj][n] = bp ? *(const f32x4*)(bp + bj * HALF + 4 * n) : (f32x4){0.f, 0.f, 0.f, 0.f};
#pragma unroll
        for (int ai = 0; ai < 2; ++ai)
#pragma unroll
            for (int m = 0; m < 4; ++m) { bf16_t* rowp = O + (size_t)(row0 + ai * HALF + m * 16) * ldc + col0;
#pragma unroll
                for (int bj = 0; bj < 2; ++bj) { const f32x4 v0 = acc[ai][bj][m][0] + bv[bj][0], v1 = acc[ai][bj][m][1] + bv[bj][1];
                    u32x4 w; w.x = cvt_pk_bf16(v0[0], v0[1]); w.y = cvt_pk_bf16(v0[2], v0[3]); w.z = cvt_pk_bf16(v1[0], v1[1]); w.w = cvt_pk_bf16(v1[2], v1[3]);
                    __builtin_nontemporal_store(w, (u32x4*)(rowp + bj * HALF)); } }
    }
};
struct EpiSwiglu {
    static constexpr bool PERM = true, AFTER_DRAIN = false;
    bf16_t* O; const float* bias;
    __device__ __forceinline__ float act1(float g, float up) const {
        g = fminf(g, 7.0f); up = fminf(fmaxf(up, -7.0f), 7.0f);
        const float sg = 1.0f / (1.0f + __expf(-1.702f * g));
        return (up + 1.0f) * g * sg;
    }
    __device__ __forceinline__ void operator()(const f32x4 (&acc)[2][2][4][2], const Unit& u, int wr, int wc, int fr, int fq) const {
        const int row0 = u.pm * BM + wr * 64 + fr; const int col0 = u.pn * HALF + wc * 32 + 8 * fq;
        const float* bp = bias + (size_t)u.e * 2048 + col0;
        f32x4 bg[2], bu[2];
#pragma unroll
        for (int n = 0; n < 2; ++n) { bg[n] = *(const f32x4*)(bp + 4 * n); bu[n] = *(const f32x4*)(bp + 1024 + 4 * n); }
#pragma unroll
        for (int ai = 0; ai < 2; ++ai)
#pragma unroll
            for (int m = 0; m < 4; ++m) { bf16_t* rowp = O + (size_t)(row0 + ai * HALF + m * 16) * 1024 + col0;
                const f32x4 g0 = acc[ai][0][m][0] + bg[0], g1 = acc[ai][0][m][1] + bg[1], u0 = acc[ai][1][m][0] + bu[0], u1 = acc[ai][1][m][1] + bu[1];
                u32x4 w; w.x = cvt_pk_bf16(act1(g0[0], u0[0]), act1(g0[1], u0[1])); w.y = cvt_pk_bf16(act1(g0[2], u0[2]), act1(g0[3], u0[3]));
                w.z = cvt_pk_bf16(act1(g1[0], u1[0]), act1(g1[1], u1[1])); w.w = cvt_pk_bf16(act1(g1[2], u1[2]), act1(g1[3], u1[3]));
                __builtin_nontemporal_store(w, (u32x4*)rowp); }
    }
};


typedef int i32x4 __attribute__((ext_vector_type(4)));
struct EpiBf16I8 {
    static constexpr bool PERM = true, AFTER_DRAIN = false;
    bf16_t* O; int ldc; const float* rs; const float* cs;
    __device__ __forceinline__ void operator()(const i32x4 (&acc)[2][2][4][2], const Unit& u, int wr, int wc, int fr, int fq) const {
        const int row0 = u.pm * BM + wr * 64 + fr; const int col0 = u.pn * BM + wc * 32 + 8 * fq;
        const float* cp = cs + (size_t)u.pb * BM + wc * 32 + 8 * fq;
        f32x4 cv[2][2]; float rsv[2][4];
#pragma unroll
        for (int bj = 0; bj < 2; ++bj)
#pragma unroll
            for (int n = 0; n < 2; ++n) cv[bj][n] = *(const f32x4*)(cp + bj * HALF + 4 * n);
#pragma unroll
        for (int ai = 0; ai < 2; ++ai)
#pragma unroll
            for (int m = 0; m < 4; ++m) rsv[ai][m] = rs[row0 + ai * HALF + m * 16];
#pragma unroll
        for (int ai = 0; ai < 2; ++ai)
#pragma unroll
            for (int m = 0; m < 4; ++m) { const int row = row0 + ai * HALF + m * 16; const float r = rsv[ai][m]; bf16_t* rowp = O + (size_t)row * ldc + col0;
#pragma unroll
                for (int bj = 0; bj < 2; ++bj) { const i32x4 a0 = acc[ai][bj][m][0], a1 = acc[ai][bj][m][1];
                    const f32x4 v0 = (f32x4){(float)a0[0], (float)a0[1], (float)a0[2], (float)a0[3]} * cv[bj][0] * r, v1 = (f32x4){(float)a1[0], (float)a1[1], (float)a1[2], (float)a1[3]} * cv[bj][1] * r;
                    u32x4 w; w.x = cvt_pk_bf16(v0[0], v0[1]); w.y = cvt_pk_bf16(v0[2], v0[3]); w.z = cvt_pk_bf16(v1[0], v1[1]); w.w = cvt_pk_bf16(v1[2], v1[3]);
                    __builtin_nontemporal_store(w, (u32x4*)(rowp + bj * HALF)); } }
    }
};
struct EpiSwigluI8 {
    static constexpr bool PERM = true, AFTER_DRAIN = false;
    bf16_t* O; const float* bias; const float* rs; const float* cs;
    __device__ __forceinline__ float act1(float g, float up) const {
        g = fminf(g, 7.0f); up = fminf(fmaxf(up, -7.0f), 7.0f);
        const float sg = __builtin_amdgcn_rcpf(1.0f + __expf(-1.702f * g));
        return (up + 1.0f) * g * sg;
    }
    __device__ __forceinline__ void operator()(const i32x4 (&acc)[2][2][4][2], const Unit& u, int wr, int wc, int fr, int fq) const {
        const int row0 = u.pm * BM + wr * 64 + fr; const int col0 = u.pn * HALF + wc * 32 + 8 * fq;
        const float* bp = bias + (size_t)u.e * 2048 + col0;
        const float* cp = cs + (size_t)u.pb * BM + wc * 32 + 8 * fq;
        f32x4 bg[2], bu[2], cg[2], cu[2]; float rsv[2][4];
#pragma unroll
        for (int n = 0; n < 2; ++n) { bg[n] = *(const f32x4*)(bp + 4 * n); bu[n] = *(const f32x4*)(bp + 1024 + 4 * n); cg[n] = *(const f32x4*)(cp + 4 * n); cu[n] = *(const f32x4*)(cp + HALF + 4 * n); }
#pragma unroll
        for (int ai = 0; ai < 2; ++ai)
#pragma unroll
            for (int m = 0; m < 4; ++m) rsv[ai][m] = rs[row0 + ai * HALF + m * 16];
#pragma unroll
        for (int ai = 0; ai < 2; ++ai)
#pragma unroll
            for (int m = 0; m < 4; ++m) { const int row = row0 + ai * HALF + m * 16; const float r = rsv[ai][m]; bf16_t* rowp = O + (size_t)row * 1024 + col0;
                f32x4 g[2], up[2];
#pragma unroll
                for (int n = 0; n < 2; ++n) { const i32x4 ag = acc[ai][0][m][n], au = acc[ai][1][m][n];
                    g[n] = (f32x4){(float)ag[0], (float)ag[1], (float)ag[2], (float)ag[3]} * cg[n] * r + bg[n];
                    up[n] = (f32x4){(float)au[0], (float)au[1], (float)au[2], (float)au[3]} * cu[n] * r + bu[n]; }
                u32x4 w; w.x = cvt_pk_bf16(act1(g[0][0], up[0][0]), act1(g[0][1], up[0][1])); w.y = cvt_pk_bf16(act1(g[0][2], up[0][2]), act1(g[0][3], up[0][3]));
                w.z = cvt_pk_bf16(act1(g[1][0], up[1][0]), act1(g[1][1], up[1][1])); w.w = cvt_pk_bf16(act1(g[1][2], up[1][2]), act1(g[1][3], up[1][3]));
                __builtin_nontemporal_store(w, (u32x4*)rowp); }
    }
};
template <class Epi, class Sched, bool ALIGN_EPI = false, bool SP2 = false>
__device__ __forceinline__ void gemm_phase(PG8_LAS unsigned char* lds, const Gemm g, const Sched& S, const Epi& E) {
    const int tid = threadIdx.x, wid = __builtin_amdgcn_readfirstlane(tid >> 6), lane = tid & 63, wr = wid >> 2, wc = wid & 3, fr = lane & 15, fq = lane >> 4;
    const int K = g.K, nt = K / BK;
    unsigned voffA[2], voffB[2];
#pragma unroll
    for (int i = 0; i < 2; ++i) { int R, C; stage_rc(tid * 16 + i * 8192, R, C); const int Rb = Epi::PERM ? ((R & ~31) + perm32(R & 31)) : R;
        voffA[i] = (unsigned)(R * K + C) * 2u; voffB[i] = (unsigned)(Rb * K + C) * 2u; }
    const size_t kstep = (size_t)(BK * 2);
    const size_t hstep = (size_t)HALF * K * 2;
    const size_t tstep = 2 * hstep;
    const unsigned ldsw = (unsigned)wid * 1024u;
    const int aoff = lds_byte(wr * 64 + fr, fq * 8), boff = lds_byte(wc * 32 + fr, fq * 8);
#define PG8_SA(b, h) (((b) * 2 + (h)) * HTB)
#define PG8_SB(b, h) ((4 + (b) * 2 + (h)) * HTB)
#define PG8_STAGE(bufoff, gbase, voff) do { _Pragma("unroll") for (int _i = 0; _i < 2; ++_i) \
        __builtin_amdgcn_global_load_lds((const unsigned*)((const char*)(gbase) + (voff)[_i]), (PG8_LAS unsigned*)(lds + (bufoff) + ldsw + _i * 8192), 16, 0, 0); } while (0)
#define PG8_LDA(dst, b, h) do { _Pragma("unroll") for (int m = 0; m < 4; ++m) _Pragma("unroll") for (int k = 0; k < 2; ++k) dst[m][k] = *(const PG8_LAS bf16x8*)(lds + PG8_SA(b, h) + aoff + m * 2048 + k * 1024); } while (0)
#define PG8_LDB(dst, b, h) do { _Pragma("unroll") for (int n = 0; n < 2; ++n) _Pragma("unroll") for (int k = 0; k < 2; ++k) dst[n][k] = *(const PG8_LAS bf16x8*)(lds + PG8_SB(b, h) + boff + n * 2048 + k * 1024); } while (0)
#define PG8_MMA(ai, bj, At, Bt) do { __builtin_amdgcn_s_setprio(1); _Pragma("unroll") for (int m = 0; m < 4; ++m) _Pragma("unroll") for (int n = 0; n < 2; ++n) _Pragma("unroll") for (int k = 0; k < 2; ++k) \
        acc[ai][bj][m][n] = __builtin_amdgcn_mfma_f32_16x16x32_bf16(Bt[n][k], At[m][k], acc[ai][bj][m][n], 0, 0, 0); __builtin_amdgcn_s_setprio(0); } while (0)
#define PG8_WAIT_V(n) asm volatile("s_waitcnt vmcnt(" #n ")" ::: "memory")
#define PG8_WAIT_L(n) asm volatile("s_waitcnt lgkmcnt(" #n ")" ::: "memory")
#define PG8_BAR __builtin_amdgcn_s_barrier()
#define PG8_SCHED __builtin_amdgcn_sched_barrier(0)
    Unit cur, nxt; int ui = 0;
    if (!S.next(0, cur)) return;
    f32x4 acc[2][2][4][2];
#pragma unroll
    for (int a = 0; a < 2; ++a)
#pragma unroll
        for (int b = 0; b < 2; ++b)
#pragma unroll
            for (int m = 0; m < 4; ++m)
#pragma unroll
                for (int n = 0; n < 2; ++n) acc[a][b][m][n] = (f32x4){0.f, 0.f, 0.f, 0.f};
    bf16x8 At[4][2], B0[2][2], B1[2][2];
    const char* cA = (const char*)g.A + (size_t)cur.pm * tstep; const char* cB = (const char*)g.Bt + (size_t)cur.pb * tstep;
    S.a_ready(cur);
    if constexpr (SP2) {
        PG8_STAGE(PG8_SB(0, 0), cB, voffB); PG8_STAGE(PG8_SB(0, 1), cB + hstep, voffB); PG8_STAGE(PG8_SA(0, 0), cA, voffA); PG8_STAGE(PG8_SA(0, 1), cA + hstep, voffA);
        if (wr == 1) PG8_BAR;
        PG8_WAIT_V(2); PG8_BAR;
        PG8_STAGE(PG8_SB(1, 0), cB + kstep, voffB); PG8_STAGE(PG8_SA(1, 0), cA + kstep, voffA); PG8_STAGE(PG8_SB(1, 1), cB + hstep + kstep, voffB);
        PG8_WAIT_V(6); PG8_BAR;
    } else {
        PG8_STAGE(PG8_SB(0, 0), cB, voffB); PG8_STAGE(PG8_SA(0, 0), cA, voffA); PG8_STAGE(PG8_SB(0, 1), cB + hstep, voffB); PG8_STAGE(PG8_SA(0, 1), cA + hstep, voffA);
        if (wr == 1) PG8_BAR;
        PG8_WAIT_V(4); PG8_BAR;
        PG8_STAGE(PG8_SB(1, 0), cB + kstep, voffB); PG8_STAGE(PG8_SA(1, 0), cA + kstep, voffA); PG8_STAGE(PG8_SB(1, 1), cB + hstep + kstep, voffB);
        PG8_WAIT_V(6); PG8_BAR;
    }
    for (;;) {
        const bool has_next = S.next(ui + 1, nxt);
        const char* nA = has_next ? (const char*)g.A + (size_t)nxt.pm * tstep : cA; const char* nB = has_next ? (const char*)g.Bt + (size_t)nxt.pb * tstep : cB;
        for (int t = 0; t < nt; t += 2) {
            const bool last = (t == nt - 2);
            const char* a1 = cA + (size_t)(t + 1) * kstep;
            const char* a2 = last ? nA : cA + (size_t)(t + 2) * kstep; const char* b2 = last ? nB : cB + (size_t)(t + 2) * kstep;
            const char* a3 = a2 + kstep; const char* b3 = b2 + kstep;
            if (last && has_next) S.a_ready(nxt);
            if constexpr (SP2) {
            PG8_LDB(B0, 0, 0); PG8_LDB(B1, 0, 1); PG8_SCHED; PG8_LDA(At, 0, 0); PG8_STAGE(PG8_SA(1, 1), a1 + hstep, voffA);
            PG8_WAIT_V(8); PG8_WAIT_L(0); PG8_BAR; PG8_MMA(0, 0, At, B0); PG8_MMA(0, 1, At, B1); PG8_BAR; PG8_SCHED;
            PG8_LDA(At, 0, 1); PG8_STAGE(PG8_SB(0, 0), b2, voffB); PG8_STAGE(PG8_SB(0, 1), b2 + hstep, voffB); PG8_STAGE(PG8_SA(0, 0), a2, voffA);
            PG8_WAIT_V(8); PG8_WAIT_L(0); PG8_BAR; PG8_MMA(1, 0, At, B0); PG8_MMA(1, 1, At, B1); PG8_BAR; PG8_SCHED;
            PG8_LDB(B0, 1, 0); PG8_LDB(B1, 1, 1); PG8_SCHED; PG8_LDA(At, 1, 0); PG8_STAGE(PG8_SA(0, 1), a2 + hstep, voffA);
            PG8_WAIT_V(8); PG8_WAIT_L(0); PG8_BAR; PG8_MMA(0, 0, At, B0); PG8_MMA(0, 1, At, B1); PG8_BAR; PG8_SCHED;
            PG8_LDA(At, 1, 1); PG8_STAGE(PG8_SB(1, 0), b3, voffB); PG8_STAGE(PG8_SB(1, 1), b3 + hstep, voffB); PG8_STAGE(PG8_SA(1, 0), a3, voffA);
            PG8_WAIT_V(8); PG8_WAIT_L(0); PG8_BAR; PG8_MMA(1, 0, At, B0); PG8_MMA(1, 1, At, B1); PG8_BAR; PG8_SCHED;
            } else {
            PG8_LDB(B0, 0, 0); PG8_SCHED; PG8_LDA(At, 0, 0); PG8_STAGE(PG8_SA(1, 1), a1 + hstep, voffA);
            PG8_WAIT_L(8); PG8_BAR; PG8_WAIT_L(0); PG8_MMA(0, 0, At, B0); PG8_BAR; PG8_SCHED;
            PG8_LDB(B1, 0, 1); PG8_STAGE(PG8_SB(0, 0), b2, voffB);
            PG8_BAR; PG8_WAIT_L(0); PG8_MMA(0, 1, At, B1); PG8_BAR;
            PG8_LDA(At, 0, 1); PG8_STAGE(PG8_SA(0, 0), a2, voffA);
            PG8_BAR; PG8_WAIT_L(0); PG8_MMA(1, 0, At, B0); PG8_BAR; PG8_SCHED;
            PG8_STAGE(PG8_SB(0, 1), b2 + hstep, voffB);
            PG8_WAIT_V(6); PG8_BAR; PG8_MMA(1, 1, At, B1); PG8_BAR;
            PG8_LDB(B0, 1, 0); PG8_SCHED; PG8_LDA(At, 1, 0); PG8_STAGE(PG8_SA(0, 1), a2 + hstep, voffA);
            PG8_WAIT_L(8); PG8_BAR; PG8_WAIT_L(0); PG8_MMA(0, 0, At, B0); PG8_BAR; PG8_SCHED;
            PG8_LDB(B1, 1, 1); PG8_STAGE(PG8_SB(1, 0), b3, voffB);
            PG8_BAR; PG8_WAIT_L(0); PG8_MMA(0, 1, At, B1); PG8_BAR;
            PG8_LDA(At, 1, 1); PG8_STAGE(PG8_SA(1, 0), a3, voffA);
            PG8_BAR; PG8_WAIT_L(0); PG8_MMA(1, 0, At, B0); PG8_BAR; PG8_SCHED;
            PG8_STAGE(PG8_SB(1, 1), b3 + hstep, voffB);
            PG8_WAIT_V(6); PG8_BAR; PG8_MMA(1, 1, At, B1); PG8_BAR;
            }
        }
        if constexpr (ALIGN_EPI) { if (wr == 0) PG8_BAR; }
        if constexpr (!Epi::AFTER_DRAIN) { E(acc, cur, wr, wc, fr, fq); S.done(cur); }
        if (!has_next) break;
#pragma unroll
        for (int a = 0; a < 2; ++a)
#pragma unroll
            for (int b = 0; b < 2; ++b)
#pragma unroll
                for (int m = 0; m < 4; ++m)
#pragma unroll
                    for (int n = 0; n < 2; ++n) acc[a][b][m][n] = (f32x4){0.f, 0.f, 0.f, 0.f};
        cur = nxt; cA = nA; cB = nB; ++ui;
        if constexpr (ALIGN_EPI) { if (wr == 1) PG8_BAR; }
    }
    PG8_WAIT_V(0);
    if constexpr (!ALIGN_EPI) { if (wr == 0) PG8_BAR; }
    PG8_BAR;
    if constexpr (Epi::AFTER_DRAIN) { E.fused(acc, cur, wr, wc, fr, fq, lds, wid, lane); S.done(cur); }
#undef PG8_SA
#undef PG8_SB
#undef PG8_STAGE
#undef PG8_LDA
#undef PG8_LDB
#undef PG8_MMA
#undef PG8_WAIT_V
#undef PG8_WAIT_L
#undef PG8_BAR
#undef PG8_SCHED
}
template <class Epi, class Sched, bool ALIGN_EPI = false, bool SP2 = false>
__device__ __forceinline__ void gemm_phase_i8(PG8_LAS unsigned char* lds, const Gemm g, const Sched& S, const Epi& E) {
    const int tid = threadIdx.x, wid = __builtin_amdgcn_readfirstlane(tid >> 6), lane = tid & 63, wr = wid >> 2, wc = wid & 3, fr = lane & 15, fq = lane >> 4;
    const int K = g.K, nt = K / 128;
    unsigned voffA[2], voffB[2];
#pragma unroll
    for (int i = 0; i < 2; ++i) { int R, C; stage_rc(tid * 16 + i * 8192, R, C); const int Rb = Epi::PERM ? ((R & ~31) + perm32(R & 31)) : R;
        voffA[i] = (unsigned)(R * K + C * 2); voffB[i] = (unsigned)(Rb * K + C * 2); }
    const size_t kstep = (size_t)(BK * 2);
    const size_t hstep = (size_t)HALF * K;
    const size_t tstep = 2 * hstep;
    const unsigned ldsw = (unsigned)wid * 1024u;
    const int aoff = lds_byte(wr * 64 + fr, fq * 8), boff = lds_byte(wc * 32 + fr, fq * 8);
#define PG8_SA(b, h) (((b) * 2 + (h)) * HTB)
#define PG8_SB(b, h) ((4 + (b) * 2 + (h)) * HTB)
#define PG8_STAGE(bufoff, gbase, voff) do { _Pragma("unroll") for (int _i = 0; _i < 2; ++_i) \
        __builtin_amdgcn_global_load_lds((const unsigned*)((const char*)(gbase) + (voff)[_i]), (PG8_LAS unsigned*)(lds + (bufoff) + ldsw + _i * 8192), 16, 0, 0); } while (0)
#define PG8_LDA(dst, b, h) do { _Pragma("unroll") for (int m = 0; m < 4; ++m) _Pragma("unroll") for (int k = 0; k < 2; ++k) dst[m][k] = *(const PG8_LAS bf16x8*)(lds + PG8_SA(b, h) + aoff + m * 2048 + k * 1024); } while (0)
#define PG8_LDB(dst, b, h) do { _Pragma("unroll") for (int n = 0; n < 2; ++n) _Pragma("unroll") for (int k = 0; k < 2; ++k) dst[n][k] = *(const PG8_LAS bf16x8*)(lds + PG8_SB(b, h) + boff + n * 2048 + k * 1024); } while (0)
#define PG8_MMA(ai, bj, At, Bt) do { __builtin_amdgcn_s_setprio(1); _Pragma("unroll") for (int m = 0; m < 4; ++m) _Pragma("unroll") for (int n = 0; n < 2; ++n) _Pragma("unroll") for (int k = 0; k < 2; ++k) \
        acc[ai][bj][m][n] = __builtin_amdgcn_mfma_i32_16x16x64_i8(__builtin_bit_cast(i32x4, Bt[n][k]), __builtin_bit_cast(i32x4, At[m][k]), acc[ai][bj][m][n], 0, 0, 0); __builtin_amdgcn_s_setprio(0); } while (0)
#define PG8_WAIT_V(n) asm volatile("s_waitcnt vmcnt(" #n ")" ::: "memory")
#define PG8_WAIT_L(n) asm volatile("s_waitcnt lgkmcnt(" #n ")" ::: "memory")
#define PG8_BAR __builtin_amdgcn_s_barrier()
#define PG8_SCHED __builtin_amdgcn_sched_barrier(0)
    Unit cur, nxt; int ui = 0;
    if (!S.next(0, cur)) return;
    i32x4 acc[2][2][4][2];
#pragma unroll
    for (int a = 0; a < 2; ++a)
#pragma unroll
        for (int b = 0; b < 2; ++b)
#pragma unroll
            for (int m = 0; m < 4; ++m)
#pragma unroll
                for (int n = 0; n < 2; ++n) acc[a][b][m][n] = (i32x4){0, 0, 0, 0};
    bf16x8 At[4][2], B0[2][2], B1[2][2];
    const char* cA = (const char*)g.A + (size_t)cur.pm * tstep; const char* cB = (const char*)g.Bt + (size_t)cur.pb * tstep;
    S.a_ready(cur);
    if constexpr (SP2) {
        PG8_STAGE(PG8_SB(0, 0), cB, voffB); PG8_STAGE(PG8_SB(0, 1), cB + hstep, voffB); PG8_STAGE(PG8_SA(0, 0), cA, voffA); PG8_STAGE(PG8_SA(0, 1), cA + hstep, voffA);
        if (wr == 1) PG8_BAR;
        PG8_WAIT_V(2); PG8_BAR;
        PG8_STAGE(PG8_SB(1, 0), cB + kstep, voffB); PG8_STAGE(PG8_SA(1, 0), cA + kstep, voffA); PG8_STAGE(PG8_SB(1, 1), cB + hstep + kstep, voffB);
        PG8_WAIT_V(6); PG8_BAR;
    } else {
        PG8_STAGE(PG8_SB(0, 0), cB, voffB); PG8_STAGE(PG8_SA(0, 0), cA, voffA); PG8_STAGE(PG8_SB(0, 1), cB + hstep, voffB); PG8_STAGE(PG8_SA(0, 1), cA + hstep, voffA);
        if (wr == 1) PG8_BAR;
        PG8_WAIT_V(4); PG8_BAR;
        PG8_STAGE(PG8_SB(1, 0), cB + kstep, voffB); PG8_STAGE(PG8_SA(1, 0), cA + kstep, voffA); PG8_STAGE(PG8_SB(1, 1), cB + hstep + kstep, voffB);
        PG8_WAIT_V(6); PG8_BAR;
    }
    for (;;) {
        const bool has_next = S.next(ui + 1, nxt);
        const char* nA = has_next ? (const char*)g.A + (size_t)nxt.pm * tstep : cA; const char* nB = has_next ? (const char*)g.Bt + (size_t)nxt.pb * tstep : cB;
        for (int t = 0; t < nt; t += 2) {
            const bool last = (t == nt - 2);
            const char* a1 = cA + (size_t)(t + 1) * kstep;
            const char* a2 = last ? nA : cA + (size_t)(t + 2) * kstep; const char* b2 = last ? nB : cB + (size_t)(t + 2) * kstep;
            const char* a3 = a2 + kstep; const char* b3 = b2 + kstep;
            if (last && has_next) S.a_ready(nxt);
            if constexpr (SP2) {
            PG8_LDB(B0, 0, 0); PG8_LDB(B1, 0, 1); PG8_SCHED; PG8_LDA(At, 0, 0); PG8_STAGE(PG8_SA(1, 1), a1 + hstep, voffA);
            PG8_WAIT_V(8); PG8_WAIT_L(0); PG8_BAR; PG8_MMA(0, 0, At, B0); PG8_MMA(0, 1, At, B1); PG8_BAR; PG8_SCHED;
            PG8_LDA(At, 0, 1); PG8_STAGE(PG8_SB(0, 0), b2, voffB); PG8_STAGE(PG8_SB(0, 1), b2 + hstep, voffB); PG8_STAGE(PG8_SA(0, 0), a2, voffA);
            PG8_WAIT_V(8); PG8_WAIT_L(0); PG8_BAR; PG8_MMA(1, 0, At, B0); PG8_MMA(1, 1, At, B1); PG8_BAR; PG8_SCHED;
            PG8_LDB(B0, 1, 0); PG8_LDB(B1, 1, 1); PG8_SCHED; PG8_LDA(At, 1, 0); PG8_STAGE(PG8_SA(0, 1), a2 + hstep, voffA);
            PG8_WAIT_V(8); PG8_WAIT_L(0); PG8_BAR; PG8_MMA(0, 0, At, B0); PG8_MMA(0, 1, At, B1); PG8_BAR; PG8_SCHED;
            PG8_LDA(At, 1, 1); PG8_STAGE(PG8_SB(1, 0), b3, voffB); PG8_STAGE(PG8_SB(1, 1), b3 + hstep, voffB); PG8_STAGE(PG8_SA(1, 0), a3, voffA);
            PG8_WAIT_V(8); PG8_WAIT_L(0); PG8_BAR; PG8_MMA(1, 0, At, B0); PG8_MMA(1, 1, At, B1); PG8_BAR; PG8_SCHED;
            } else {
            PG8_LDB(B0, 0, 0); PG8_SCHED; PG8_LDA(At, 0, 0); PG8_STAGE(PG8_SA(1, 1), a1 + hstep, voffA);
            PG8_WAIT_L(8); PG8_BAR; PG8_WAIT_L(0); PG8_MMA(0, 0, At, B0); PG8_BAR; PG8_SCHED;
            PG8_LDB(B1, 0, 1); PG8_STAGE(PG8_SB(0, 0), b2, voffB);
            PG8_BAR; PG8_WAIT_L(0); PG8_MMA(0, 1, At, B1); PG8_BAR;
            PG8_LDA(At, 0, 1); PG8_STAGE(PG8_SA(0, 0), a2, voffA);
            PG8_BAR; PG8_WAIT_L(0); PG8_MMA(1, 0, At, B0); PG8_BAR; PG8_SCHED;
            PG8_STAGE(PG8_SB(0, 1), b2 + hstep, voffB);
            PG8_WAIT_V(6); PG8_BAR; PG8_MMA(1, 1, At, B1); PG8_BAR;
            PG8_LDB(B0, 1, 0); PG8_SCHED; PG8_LDA(At, 1, 0); PG8_STAGE(PG8_SA(0, 1), a2 + hstep, voffA);
            PG8_WAIT_L(8); PG8_BAR; PG8_WAIT_L(0); PG8_MMA(0, 0, At, B0); PG8_BAR; PG8_SCHED;
            PG8_LDB(B1, 1, 1); PG8_STAGE(PG8_SB(1, 0), b3, voffB);
            PG8_BAR; PG8_WAIT_L(0); PG8_MMA(0, 1, At, B1); PG8_BAR;
            PG8_LDA(At, 1, 1); PG8_STAGE(PG8_SA(1, 0), a3, voffA);
            PG8_BAR; PG8_WAIT_L(0); PG8_MMA(1, 0, At, B0); PG8_BAR; PG8_SCHED;
            PG8_STAGE(PG8_SB(1, 1), b3 + hstep, voffB);
            PG8_WAIT_V(6); PG8_BAR; PG8_MMA(1, 1, At, B1); PG8_BAR;
            }
        }
        if constexpr (ALIGN_EPI) { if (wr == 0) PG8_BAR; }
        if constexpr (!Epi::AFTER_DRAIN) { E(acc, cur, wr, wc, fr, fq); S.done(cur); }
        if (!has_next) break;
#pragma unroll
        for (int a = 0; a < 2; ++a)
#pragma unroll
            for (int b = 0; b < 2; ++b)
#pragma unroll
                for (int m = 0; m < 4; ++m)
#pragma unroll
                    for (int n = 0; n < 2; ++n) acc[a][b][m][n] = (i32x4){0, 0, 0, 0};
        cur = nxt; cA = nA; cB = nB; ++ui;
        if constexpr (ALIGN_EPI) { if (wr == 1) PG8_BAR; }
    }
    PG8_WAIT_V(0);
    if constexpr (!ALIGN_EPI) { if (wr == 0) PG8_BAR; }
    PG8_BAR;
    if constexpr (Epi::AFTER_DRAIN) { E.fused(acc, cur, wr, wc, fr, fq, lds, wid, lane); S.done(cur); }
#undef PG8_SA
#undef PG8_SB
#undef PG8_STAGE
#undef PG8_LDA
#undef PG8_LDB
#undef PG8_MMA
#undef PG8_WAIT_V
#undef PG8_WAIT_L
#undef PG8_BAR
#undef PG8_SCHED
}

}
#ifndef STAGE_REP
#define STAGE_REP 0
#endif

constexpr int NWAVES = 8;
constexpr int D = 1024, BATCH = 2, T = 8192, TC = 256, NH = 16;
constexpr int ML = BATCH * T;
constexpr int MC = BATCH * TC;
constexpr int MT = ML + MC;
constexpr int N_IN = 8576, NZ = 8704;
constexpr int K_OFF = 0, V_OFF = 1024, DECAY_OFF = 2048, ICLR_OFF = 2176, STATE_COLS = 2304, R_OFF = 2304, GLORA_OFF = 3328, SHIFT_COLS = 3456;
constexpr int CONV_OFF = 3456, GATE_OFF = 6528;
constexpr int NE = 32, TOPK = 4, DFF = 1024;
constexpr int NL = 5120, KL = 384;
constexpr int MAXBLK = 288;
constexpr int NROWS = MAXBLK * 256;
constexpr int KSPLIT = 16;

constexpr size_t MiB = 1u << 20;
constexpr size_t WS_CTL = 0, CTL_ZERO_BYTES = 1 * MiB;
constexpr size_t WS_MODP = 1 * MiB;
constexpr size_t WS_WLORA = 3 * MiB;
constexpr size_t WS_WROUT = 7 * MiB;
constexpr size_t WS_WOUT = 8 * MiB;
constexpr size_t WS_WIN = 10 * MiB;
constexpr size_t WS_A0 = 28 * MiB;
constexpr size_t WS_MISC = 61 * MiB;
constexpr size_t WS_Z = 64 * MiB;
constexpr size_t WS_AL = 345 * MiB;
constexpr size_t WS_LORA = 358 * MiB;
constexpr size_t WS_SCAN = 523 * MiB;
constexpr size_t WS_Y = 886 * MiB;
constexpr size_t WS_END = 1014 * MiB;
constexpr size_t WS_PQ = WS_SCAN;
constexpr size_t WS_TKN = WS_PQ + 132 * MiB;
constexpr size_t WS_UPRE = WS_TKN + 66 * MiB;
constexpr size_t WS_H0T = WS_UPRE + 66 * MiB;
static_assert(WS_H0T + 64 * MiB <= WS_Y, "scan region");
constexpr size_t WS_MIX = WS_LORA, WS_X1 = WS_LORA + 64 * MiB, WS_H2 = WS_LORA + 128 * MiB;
constexpr size_t WS_LOGIT = WS_SCAN, WS_XB = WS_SCAN + 16 * MiB, WS_ACT = WS_XB + 144 * MiB;
constexpr size_t WS_Y2 = WS_Z, WS_WEIN = WS_Y, WS_WEOUT = WS_Y + 64 * MiB;
static_assert(WS_ACT + 144 * MiB <= WS_Y && WS_WEIN + 64 * MiB <= WS_WEOUT && WS_WEOUT + 64 * MiB <= WS_END, "late regions");
constexpr size_t MI_SELE = WS_MISC, MI_SELP = MI_SELE + (size_t)ML * 4 * 4, MI_GATE = MI_SELP + (size_t)ML * 4 * 4, MI_DEST = MI_GATE + (size_t)ML * 4 * 4, MI_BLKE = MI_DEST + (size_t)ML * 4 * 4;
constexpr size_t MI_RSH = MI_BLKE + 4096;
constexpr size_t MI_CSWIN = MI_RSH + (size_t)MT * 4;
constexpr size_t MI_RSH2 = MI_CSWIN + (size_t)NZ * 4;
constexpr size_t MI_RSXB = MI_RSH2 + (size_t)ML * 4;
constexpr size_t MI_CSWEI = MI_RSXB + (size_t)NROWS * 4;
constexpr size_t MI_BON = MI_CSWEI + (size_t)NE * 2048 * 4;
static_assert(MI_BON + (size_t)4096 * 64 * 4 <= WS_Z && MI_RSH % 16 == 0 && MI_CSWIN % 16 == 0 && MI_CSWEI % 16 == 0, "misc");
constexpr size_t WS_H2Q = WS_A0;
constexpr int CW_BAR = 4096;
constexpr int CW_CNT = 16384;
constexpr int CW_FB = 8192;
constexpr int CW_Q6 = CW_CNT + 64 * 40;

constexpr int RING_OFF = 0, RING_BYTES = 131072;
constexpr int LDSCTL_OFF = 147456, MISC_OFF = LDSCTL_OFF + 320;
constexpr int LDS_X_OFF = LDSCTL_OFF + 512;
constexpr int LDS_BYTES = 163840;

#define GAS __attribute__((address_space(1)))
#define LAS __attribute__((address_space(3)))
typedef unsigned short bf16;
typedef unsigned v4u __attribute__((ext_vector_type(4)));
typedef unsigned v2u __attribute__((ext_vector_type(2)));
typedef float f32x4 __attribute__((ext_vector_type(4)));
#define LDS_WAIT() asm volatile("s_waitcnt lgkmcnt(0)" ::: "memory")
#define VM_WAIT() asm volatile("s_waitcnt vmcnt(0)" ::: "memory")
__device__ __forceinline__ unsigned f2bf(float f) { unsigned u = __builtin_bit_cast(unsigned, f); return (u + 0x7fffu + ((u >> 16) & 1u)) >> 16; }
__device__ __forceinline__ unsigned pk2(float lo, float hi) { return f2bf(lo) | (f2bf(hi) << 16); }
typedef __bf16 bf16v2h_t __attribute__((ext_vector_type(2)));
__device__ __forceinline__ unsigned pk2h(float lo, float hi) { const bf16v2h_t v = {(__bf16)lo, (__bf16)hi}; return __builtin_bit_cast(unsigned, v); }
__device__ __forceinline__ float bflo(unsigned w) { return __builtin_bit_cast(float, w << 16); }
__device__ __forceinline__ float bfhi(unsigned w) { return __builtin_bit_cast(float, w & 0xffff0000u); }
__device__ __forceinline__ float bf1(bf16 h) { return __builtin_bit_cast(float, (unsigned)h << 16); }
__device__ __forceinline__ void ld16bf(const bf16* p, float (&o)[16]) {
    const v4u a = *(const v4u*)p, b = *(const v4u*)(p + 8);
    o[0] = bflo(a.x); o[1] = bfhi(a.x); o[2] = bflo(a.y); o[3] = bfhi(a.y); o[4] = bflo(a.z); o[5] = bfhi(a.z); o[6] = bflo(a.w); o[7] = bfhi(a.w);
    o[8] = bflo(b.x); o[9] = bfhi(b.x); o[10] = bflo(b.y); o[11] = bfhi(b.y); o[12] = bflo(b.z); o[13] = bfhi(b.z); o[14] = bflo(b.w); o[15] = bfhi(b.w);
}
__device__ __forceinline__ void st16bf(bf16* p, const float (&o)[16]) {
    v4u a, b; a.x = pk2(o[0], o[1]); a.y = pk2(o[2], o[3]); a.z = pk2(o[4], o[5]); a.w = pk2(o[6], o[7]);
    b.x = pk2(o[8], o[9]); b.y = pk2(o[10], o[11]); b.z = pk2(o[12], o[13]); b.w = pk2(o[14], o[15]);
    *(v4u*)p = a; *(v4u*)(p + 8) = b;
}
__device__ __forceinline__ void ld16f(const float* p, float (&o)[16]) {
#pragma unroll
    for (int q = 0; q < 4; ++q) { const f32x4 v = *(const f32x4*)(p + 4 * q); o[4 * q] = v.x; o[4 * q + 1] = v.y; o[4 * q + 2] = v.z; o[4 * q + 3] = v.w; }
}
__device__ __forceinline__ void ld16f_lds(const LAS float* p, float (&o)[16]) {
#pragma unroll
    for (int q = 0; q < 4; ++q) { const f32x4 v = *(const LAS f32x4*)(p + 4 * q); o[4 * q] = v.x; o[4 * q + 1] = v.y; o[4 * q + 2] = v.z; o[4 * q + 3] = v.w; }
}
__device__ __forceinline__ void st16f(float* p, const float (&o)[16]) {
#pragma unroll
    for (int q = 0; q < 4; ++q) *(f32x4*)(p + 4 * q) = (f32x4){o[4 * q], o[4 * q + 1], o[4 * q + 2], o[4 * q + 3]};
}
__device__ __forceinline__ float sigmoidf_(float x) { return 1.0f / (1.0f + __expf(-x)); }
__device__ __forceinline__ float wave_sum(float v) {
#pragma unroll
    for (int o = 1; o < 64; o <<= 1) v += __shfl_xor(v, o);
    return v;
}
__device__ __forceinline__ float wave_max(float v) {
#pragma unroll
    for (int o = 1; o < 64; o <<= 1) v = fmaxf(v, __shfl_xor(v, o));
    return v;
}
__device__ __forceinline__ unsigned pack_q4(float a, float b, float c, float d) {
    const int qa = __float2int_rn(a), qb = __float2int_rn(b), qc = __float2int_rn(c), qd = __float2int_rn(d);
    return (unsigned)(qa & 255) | ((unsigned)(qb & 255) << 8) | ((unsigned)(qc & 255) << 16) | ((unsigned)qd << 24);
}
__device__ __forceinline__ float quad_sum(float v) { v += __shfl_xor(v, 1); v += __shfl_xor(v, 2); return v; }

#define XB_TMO      128
#define XB_XCNT(j)  (256  + 64 * (j))
#define XB_XSUB(j)  (1280 + 64 * (j))
#define XB_XGEN(j)  (2304 + 64 * (j))
#define XB_TOP      3328
#define XB_TOPGEN   3392
#define XCD_BAR_WORDS 3456
#define XB_SPIN_CAP (1u << 18)

__device__ __forceinline__ unsigned xb_ld(unsigned* p)              { return __hip_atomic_load(p, __ATOMIC_RELAXED, __HIP_MEMORY_SCOPE_AGENT); }
__device__ __forceinline__ unsigned xb_add(unsigned* p, unsigned v) { return __hip_atomic_fetch_add(p, v, __ATOMIC_RELAXED, __HIP_MEMORY_SCOPE_AGENT); }
__device__ __forceinline__ unsigned xb_xcc_id() { return (unsigned)__builtin_amdgcn_s_getreg((3 << 11) | 20) & 0xFu; }
#define XB_SPIN(cond, bar) do { unsigned _sp = 0; while (cond) { __builtin_amdgcn_s_sleep(1); \
    if ((++_sp & 255u) == 0u) { if (xb_ld(&(bar)[XB_TMO])) break; if (_sp > XB_SPIN_CAP) { atomicAdd(&(bar)[XB_TMO], 1u); break; } } } } while (0)

struct XcdBarrier { unsigned* bar; unsigned x; volatile LAS unsigned* st; };

__device__ __forceinline__ XcdBarrier xcd_barrier_post(unsigned* bar, volatile LAS unsigned* st) {
    XcdBarrier b; b.bar = bar; b.x = xb_xcc_id(); b.st = st;
    if (threadIdx.x == 0) (void)xb_add(&bar[XB_XCNT(b.x)], 1u);
    return b;
}
__device__ __forceinline__ void xcd_barrier_complete(unsigned* bar, unsigned x, unsigned& nloc, unsigned& nx) {
    const unsigned G = gridDim.x * gridDim.y * gridDim.z;
    unsigned sum, cnt, mine, sp = 0u;
    for (;;) {
        sum = 0u; cnt = 0u; mine = 0u;
#pragma unroll
        for (unsigned j = 0; j < 16; ++j) { const unsigned c = xb_ld(&bar[XB_XCNT(j)]); sum += c; cnt += (c > 0u) ? 1u : 0u; mine = (j == x) ? c : mine; }
        if (sum == G) break;
        __builtin_amdgcn_s_sleep(1);
        if ((++sp & 255u) == 0u) { if (xb_ld(&bar[XB_TMO])) break; if (sp > XB_SPIN_CAP) { atomicAdd(&bar[XB_TMO], 1u); break; } }
    }
    nloc = mine > 0u ? mine : 1u; nx = cnt > 0u ? cnt : 1u;
}
__device__ __forceinline__ void xcd_barrier(const XcdBarrier& b) {
    asm volatile("s_waitcnt vmcnt(0)" ::: "memory");
    __syncthreads();
    if (threadIdx.x == 0) {
        unsigned* bar = b.bar;
        __builtin_amdgcn_s_waitcnt(0);
        unsigned nloc = b.st[0], nx = b.st[1];
        if (nloc == 0u) { xcd_barrier_complete(bar, b.x, nloc, nx); b.st[0] = nloc; b.st[1] = nx; }
        const unsigned old = xb_add(&bar[XB_XSUB(b.x)], 1u);
        const unsigned gen = old / nloc;
        if (old + 1u == (gen + 1u) * nloc) {
            __builtin_amdgcn_fence(__ATOMIC_RELEASE, "agent");
            asm volatile("s_waitcnt vmcnt(0)" ::: "memory");
            const unsigned og = xb_add(&bar[XB_TOP], 1u);
            const unsigned tg = og / nx;
            if (og + 1u == (tg + 1u) * nx) xb_add(&bar[XB_TOPGEN], 1u);
            else XB_SPIN(xb_ld(&bar[XB_TOPGEN]) == tg, bar);
            __builtin_amdgcn_fence(__ATOMIC_ACQUIRE, "agent");
            xb_add(&bar[XB_XGEN(b.x)], 1u);
            asm volatile("s_waitcnt vmcnt(0)" ::: "memory");
        } else {
            XB_SPIN(xb_ld(&bar[XB_XGEN(b.x)]) == gen, bar);
            __builtin_amdgcn_fence(__ATOMIC_ACQUIRE, "agent");
            asm volatile("s_waitcnt vmcnt(0)" ::: "memory");
        }
    }
    __syncthreads();
}

#define XB_DONE(j)  (3456 + 64 * (j))
__device__ __forceinline__ void xcd_barrier2(const XcdBarrier& b) {
    asm volatile("s_waitcnt vmcnt(0)" ::: "memory");
    __syncthreads();
    if (threadIdx.x == 0) {
        unsigned* bar = b.bar;
        __builtin_amdgcn_s_waitcnt(0);
        unsigned nloc = b.st[0], nx = b.st[1];
        if (nloc == 0u) { xcd_barrier_complete(bar, b.x, nloc, nx); b.st[0] = nloc; b.st[1] = nx; }
        const unsigned old = xb_add(&bar[XB_XSUB(b.x)], 1u);
        const unsigned gen = old / nloc;
        if (old + 1u == (gen + 1u) * nloc) {
            __builtin_amdgcn_fence(__ATOMIC_RELEASE, "agent");
            asm volatile("s_waitcnt vmcnt(0)" ::: "memory");
#pragma unroll
            for (unsigned j = 0; j < 16; ++j) (void)xb_add(&bar[XB_DONE(j)], 1u);
        }
        XB_SPIN(xb_ld(&bar[XB_DONE(b.x)]) < (gen + 1u) * nx, bar);
        __builtin_amdgcn_fence(__ATOMIC_ACQUIRE, "agent");
        asm volatile("s_waitcnt vmcnt(0)" ::: "memory");
    }
    __syncthreads();
}

#define FB_WORD(j) (64 * (j))
#define FB_TMO 640
__device__ __forceinline__ void flat_barrier(unsigned* fb, unsigned epoch) {
    asm volatile("s_waitcnt vmcnt(0)" ::: "memory");
    __syncthreads();
    if (threadIdx.x == 0) {
        __builtin_amdgcn_s_waitcnt(0);
        __builtin_amdgcn_fence(__ATOMIC_RELEASE, "agent");
        asm volatile("s_waitcnt vmcnt(0)" ::: "memory");
        (void)xb_add(&fb[FB_WORD(blockIdx.x & 7u)], 1u);
        const unsigned want = epoch * gridDim.x; unsigned sp = 0u;
        for (;;) {
            unsigned s = 0u;
#pragma unroll
            for (int j = 0; j < 8; ++j) s += xb_ld(&fb[FB_WORD(j)]);
            if (s >= want) break;
            __builtin_amdgcn_s_sleep(1);
            if ((++sp & 255u) == 0u) { if (xb_ld(&fb[FB_TMO])) break; if (sp > XB_SPIN_CAP) { atomicAdd(&fb[FB_TMO], 1u); break; } }
        }
        __builtin_amdgcn_fence(__ATOMIC_ACQUIRE, "agent");
        asm volatile("s_waitcnt vmcnt(0)" ::: "memory");
    }
    __syncthreads();
}

struct Frame {
    LAS unsigned char* lds;
    volatile LAS unsigned* MISC;
    unsigned* ctl;
    int tid, lane, wave, G, gw, NGW;
    float* out;
    unsigned char* ws;
};
enum { I_X = 0, I_C, I_CTX, I_CCTX, I_WADA, I_BADA, I_NPM, I_NQM, I_NPF, I_NQF, I_WIN, I_MU, I_W0, I_WDU, I_A0, I_WIU, I_KK, I_KA, I_RK, I_WGU, I_LNW, I_LNB, I_CONVW,
       I_WOUT, I_WR, I_BR, I_WEI, I_BEI, I_WEO, I_BEO };


typedef const float* fptr_t;
__device__ __forceinline__ fptr_t kin_ptr(int i) { const volatile __attribute__((address_space(4))) fptr_t* ka = (const volatile __attribute__((address_space(4))) fptr_t*)__builtin_amdgcn_kernarg_segment_ptr(); return ka[i]; }
#define KIN(i) kin_ptr(i)
__device__ __forceinline__ void transpose_item(const float* W, int N, int k0, int n0, bf16* WT, int ldk, int rowbase, LAS float* scr, int lane) {
#pragma unroll 8
    for (int i = 0; i < 32; ++i) { const int kk = 2 * i + (lane >> 5); scr[kk * 33 + (lane & 31)] = W[(size_t)(k0 + kk) * N + n0 + (lane & 31)]; }
    LDS_WAIT(); asm volatile("" ::: "memory");
    const int c = lane & 7;
#pragma unroll
    for (int j = 0; j < 4; ++j) { const int n = (lane >> 3) + 8 * j; const LAS float* s = scr + (8 * c) * 33 + n;
        v4u o; o.x = pk2(s[0 * 33], s[1 * 33]); o.y = pk2(s[2 * 33], s[3 * 33]); o.z = pk2(s[4 * 33], s[5 * 33]); o.w = pk2(s[6 * 33], s[7 * 33]);
        *(v4u*)(WT + (size_t)(rowbase + n) * ldk + k0 + 8 * c) = o; }
    LDS_WAIT(); asm volatile("" ::: "memory");
}

__device__ __forceinline__ unsigned pack_q4c(float a, float b, float c, float d) {
    const int qa = __float2int_rn(fminf(fmaxf(a, -127.f), 127.f)), qb = __float2int_rn(fminf(fmaxf(b, -127.f), 127.f)), qc = __float2int_rn(fminf(fmaxf(c, -127.f), 127.f)), qd = __float2int_rn(fminf(fmaxf(d, -127.f), 127.f));
    return (unsigned)(qa & 255) | ((unsigned)(qb & 255) << 8) | ((unsigned)(qc & 255) << 16) | ((unsigned)qd << 24);
}
__device__ __forceinline__ void q8_item(const float* W, int N, int n0, signed char* WT, float* cs, int rowbase, LAS float* scr, int lane, int kb0 = 0, int kb1 = 16) {
    const int r8 = lane >> 3, c4 = lane & 7;
    const float* p0 = W + (size_t)r8 * N + n0 + 4 * c4;
    f32x4 ss = {0.f, 0.f, 0.f, 0.f};
#pragma unroll
    for (int hb = 0; hb < 2; ++hb) {
        f32x4 v[16];
#pragma unroll
        for (int i = 0; i < 16; ++i) v[i] = *(const f32x4*)(p0 + (size_t)(8 * (16 * hb + i)) * N);
        __builtin_amdgcn_sched_barrier(0);
#pragma unroll
        for (int i = 0; i < 16; ++i) ss += v[i] * v[i];
    }
#pragma unroll
    for (int o = 8; o < 64; o <<= 1) { ss.x += __shfl_xor(ss.x, o); ss.y += __shfl_xor(ss.y, o); ss.z += __shfl_xor(ss.z, o); ss.w += __shfl_xor(ss.w, o); }
    if (lane < 8) {
#pragma unroll
        for (int q = 0; q < 4; ++q) { const float m = 6.0f * sqrtf(ss[q] * (1.0f / 256.0f)); cs[rowbase + 4 * lane + q] = m * (1.0f / 127.0f); scr[2112 + 4 * lane + q] = m > 0.f ? 127.0f / m : 0.f; } }
    LDS_WAIT(); asm volatile("" ::: "memory");
    f32x4 cur[8];
#pragma unroll
    for (int i = 0; i < 8; ++i) cur[i] = *(const f32x4*)(p0 + (size_t)(64 * kb0 + 8 * i) * N);
    for (int kb = kb0; kb < kb1; ++kb) {
        f32x4 nxt[8];
        const int kn = kb < kb1 - 1 ? kb + 1 : kb;
#pragma unroll
        for (int i = 0; i < 8; ++i) nxt[i] = *(const f32x4*)(p0 + (size_t)(64 * kn + 8 * i) * N);
#pragma unroll
        for (int i = 0; i < 8; ++i) { LAS float* s = scr + (r8 + 8 * i) * 33 + 4 * c4; s[0] = cur[i].x; s[1] = cur[i].y; s[2] = cur[i].z; s[3] = cur[i].w; }
        LDS_WAIT(); asm volatile("" ::: "memory");
        const int c = lane & 3;
#pragma unroll
        for (int j = 0; j < 2; ++j) { const int n = (lane >> 2) + 16 * j; const float iv = scr[2112 + n]; const LAS float* s = scr + (16 * c) * 33 + n;
            v4u o; o.x = pack_q4c(s[0] * iv, s[33] * iv, s[66] * iv, s[99] * iv); o.y = pack_q4c(s[132] * iv, s[165] * iv, s[198] * iv, s[231] * iv);
            o.z = pack_q4c(s[264] * iv, s[297] * iv, s[330] * iv, s[363] * iv); o.w = pack_q4c(s[396] * iv, s[429] * iv, s[462] * iv, s[495] * iv);
            *(v4u*)(WT + (size_t)(rowbase + n) * 1024 + 64 * kb + 16 * c) = o; }
        LDS_WAIT(); asm volatile("" ::: "memory");
#pragma unroll
        for (int i = 0; i < 8; ++i) cur[i] = nxt[i];
    }
}

struct CvTile { f32x4 v[8]; };
__device__ __forceinline__ void cv_load(CvTile& t, const float* W, int N, int n0, int kb, int lane) {
    const float* p0 = W + (size_t)(64 * kb + (lane >> 3)) * N + n0 + 4 * (lane & 7);
#pragma unroll
    for (int i = 0; i < 8; ++i) t.v[i] = *(const f32x4*)(p0 + (size_t)(8 * i) * N);
}
__device__ __forceinline__ void cv_to_lds(const CvTile& t, LAS float* scr, int lane) {
    const int r8 = lane >> 3, c4 = lane & 7;
#pragma unroll
    for (int i = 0; i < 8; ++i) { LAS float* s = scr + (r8 + 8 * i) * 33 + 4 * c4; s[0] = t.v[i].x; s[1] = t.v[i].y; s[2] = t.v[i].z; s[3] = t.v[i].w; }
    LDS_WAIT(); asm volatile("" ::: "memory");
}
__device__ __forceinline__ void cv_store_bf16(const LAS float* scr, bf16* WT, int ldk, int rowbase, int k0, int lane) {
    const int c = lane & 7;
#pragma unroll
    for (int j = 0; j < 4; ++j) { const int n = (lane >> 3) + 8 * j; const LAS float* s = scr + (8 * c) * 33 + n;
        v4u o; o.x = pk2h(s[0 * 33], s[1 * 33]); o.y = pk2h(s[2 * 33], s[3 * 33]); o.z = pk2h(s[4 * 33], s[5 * 33]); o.w = pk2h(s[6 * 33], s[7 * 33]);
        *(v4u*)(WT + (size_t)(rowbase + n) * ldk + k0 + 8 * c) = o; }
    LDS_WAIT(); asm volatile("" ::: "memory");
}
__device__ __forceinline__ unsigned q8_pack4(float a, float b, float c, float d) {
    const float M = 12582912.0f;
    const unsigned x0 = __builtin_bit_cast(unsigned, __builtin_amdgcn_fmed3f(a, -127.f, 127.f) + M), x1 = __builtin_bit_cast(unsigned, __builtin_amdgcn_fmed3f(b, -127.f, 127.f) + M);
    const unsigned x2 = __builtin_bit_cast(unsigned, __builtin_amdgcn_fmed3f(c, -127.f, 127.f) + M), x3 = __builtin_bit_cast(unsigned, __builtin_amdgcn_fmed3f(d, -127.f, 127.f) + M);
    return __builtin_amdgcn_perm(x1, x0, 0x0c0c0400u) | __builtin_amdgcn_perm(x3, x2, 0x04000c0cu);
}
__device__ __forceinline__ void cv_store_q8(const CvTile& t, LAS float* scr, signed char* WT, int rowbase, int kb, const float (&iv)[4], int lane) {
    LAS unsigned* img = (LAS unsigned*)scr;
    const int r8 = lane >> 3, c4 = lane & 7;
#pragma unroll
    for (int i = 0; i < 8; ++i) img[(r8 + 8 * i) * 9 + c4] = q8_pack4(t.v[i].x * iv[0], t.v[i].y * iv[1], t.v[i].z * iv[2], t.v[i].w * iv[3]);
    LDS_WAIT(); asm volatile("" ::: "memory");
    const int c = lane & 3;
#pragma unroll
    for (int j = 0; j < 2; ++j) { const int n = (lane >> 2) + 16 * j; const unsigned bs = (unsigned)(n & 3);
        const unsigned s01 = 0x0c0c0000u | bs | ((4u + bs) << 8), s23 = 0x00000c0cu | (bs << 16) | ((4u + bs) << 24);
        const LAS unsigned* s = img + (16 * c) * 9 + (n >> 2);
        v4u o;
        o.x = __builtin_amdgcn_perm(s[9], s[0], s01) | __builtin_amdgcn_perm(s[27], s[18], s23);
        o.y = __builtin_amdgcn_perm(s[45], s[36], s01) | __builtin_amdgcn_perm(s[63], s[54], s23);
        o.z = __builtin_amdgcn_perm(s[81], s[72], s01) | __builtin_amdgcn_perm(s[99], s[90], s23);
        o.w = __builtin_amdgcn_perm(s[117], s[108], s01) | __builtin_amdgcn_perm(s[135], s[126], s23);
        *(v4u*)(WT + (size_t)(rowbase + n) * 1024 + 64 * kb + 16 * c) = o; }
    LDS_WAIT(); asm volatile("" ::: "memory");
}
__device__ __forceinline__ void cv_scale_q8(const float* W, int N, int n0, float* cs, int rowbase, int lane, float (&iv)[4]) {
    const float* p0 = W + (size_t)(lane >> 3) * N + n0 + 4 * (lane & 7);
    f32x4 ss = {0.f, 0.f, 0.f, 0.f};
#pragma unroll
    for (int hb = 0; hb < 2; ++hb) {
        f32x4 v[16];
#pragma unroll
        for (int i = 0; i < 16; ++i) v[i] = *(const f32x4*)(p0 + (size_t)(8 * (16 * hb + i)) * N);
        __builtin_amdgcn_sched_barrier(0);
#pragma unroll
        for (int i = 0; i < 16; ++i) ss += v[i] * v[i];
    }
#pragma unroll
    for (int o = 8; o < 64; o <<= 1) { ss.x += __shfl_xor(ss.x, o); ss.y += __shfl_xor(ss.y, o); ss.z += __shfl_xor(ss.z, o); ss.w += __shfl_xor(ss.w, o); }
#pragma unroll
    for (int q = 0; q < 4; ++q) { const float m = 6.0f * sqrtf(ss[q] * (1.0f / 256.0f)); if (lane < 8) cs[rowbase + 4 * lane + q] = m * (1.0f / 127.0f); iv[q] = m > 0.f ? 127.0f / m : 0.f; }
}
__device__ __forceinline__ void wei_strip(int s, int& e, int& n0, int& rowbase) { e = s >> 6; n0 = 32 * (s & 63); const int c = n0 & 1023; rowbase = (c >> 7) * 256 + (n0 >= 1024 ? 128 : 0) + (c & 127); }

__device__ __forceinline__ float mod_val(const float* modp, const float* b_ada, int vec, int j) {
    float s = b_ada[j];
#pragma unroll
    for (int ks = 0; ks < KSPLIT; ++ks) s += modp[((size_t)ks * 3 + vec) * 6144 + j];
    return s;
}
__device__ __forceinline__ int nbr_row(int row, int j) {
    if (row < ML) { const int t = row & (T - 1), gc = t & 63, gr = t >> 6;
        if (j == 0) return gc > 0 ? row - 1 : -1; if (j == 1) return gc < 63 ? row + 1 : -1; if (j == 2) return gr > 0 ? row - 64 : -1; return gr < 127 ? row + 64 : -1; }
    const int tc = (row - ML) & (TC - 1);
    if ((j & 1) == 0) return tc > 0 ? row - 1 : -1; return tc < TC - 1 ? row + 1 : -1;
}
__device__ __forceinline__ void load_shift16(const bf16* z, int row, int col0, const LAS float* mu, float (&out)[16]) {
    float s[16]; ld16bf(z + (size_t)row * NZ + col0, s);
    float m[16]; ld16f_lds(mu, m);
#pragma unroll
    for (int j = 0; j < 4; ++j) {
        const int nr = nbr_row(row, j); float t[16];
        if (nr >= 0) ld16bf(z + (size_t)nr * NZ + col0, t); else {
#pragma unroll
            for (int i = 0; i < 16; ++i) t[i] = 0.f; }
#pragma unroll
        for (int i = j; i < 16; i += 4) out[i] = s[i] + m[i] * (t[i] - s[i]);
    }
}

__device__ __forceinline__ void phase_prologue(Frame& F) {
    LAS float* scr = (LAS float*)(F.lds + RING_OFF + F.wave * 16384);
    LAS float* sil = (LAS float*)(F.lds + LDS_X_OFF);
    for (int i = F.tid; i < 3 * D; i += NWAVES * 64) { const int v = i / D, j = i % D; const float c = v < 2 ? KIN(I_C)[v * D + j] : KIN(I_CCTX)[j]; sil[i] = c / (1.0f + __expf(-c)); }
    __syncthreads();
    bf16* WoutT = (bf16*)(F.ws + WS_WOUT);
    constexpr int IT_WIN = (N_IN / 32) * 4, IT_WOUT = (D / 64) * (D / 32), IT_ADA = 24 * KSPLIT;
    constexpr int NITEMS = IT_ADA + IT_WIN + IT_WOUT;
    float* modp = (float*)(F.ws + WS_MODP);
    for (int it = F.gw; it < NITEMS; it += F.NGW) {
        int r = it;
        if (r < IT_ADA) {
            const int cc = r % 24, ks = r / 24, col = cc * 256 + F.lane * 4;
            f32x4 a0 = {0.f, 0.f, 0.f, 0.f}, a1 = a0, a2 = a0;
            const float* wp = KIN(I_WADA) + (size_t)(ks * 64) * 6144 + col;
#pragma unroll 8
            for (int k = 0; k < 64; ++k) { const f32x4 w = *(const f32x4*)(wp + (size_t)k * 6144); const int kk = ks * 64 + k;
                a0 += w * sil[kk]; a1 += w * sil[D + kk]; a2 += w * sil[2 * D + kk]; }
            *(f32x4*)(modp + ((size_t)ks * 3 + 0) * 6144 + col) = a0; *(f32x4*)(modp + ((size_t)ks * 3 + 1) * 6144 + col) = a1; *(f32x4*)(modp + ((size_t)ks * 3 + 2) * 6144 + col) = a2;
            continue; }
        r -= IT_ADA;
        if (r < IT_WIN) { const int st = r >> 2, qq = r & 3; q8_item(KIN(I_WIN), N_IN, 32 * st, (signed char*)(F.ws + WS_WIN), (float*)(F.ws + MI_CSWIN), 32 * st, scr, F.lane, 4 * qq, 4 * qq + 4); continue; }
        r -= IT_WIN;
        { const int nb = D / 32, kb = r / nb, n0 = 32 * (r % nb); transpose_item(KIN(I_WOUT), D, 64 * kb, n0, WoutT, D, n0, scr, F.lane); }
    }
    const int gt = blockIdx.x * (NWAVES * 64) + F.tid, NGT = F.G * NWAVES * 64;
    for (int i = gt; i < (NZ - N_IN) * D / 16; i += NGT) *(v4u*)(F.ws + WS_WIN + (size_t)N_IN * D + (size_t)i * 16) = (v4u){0u, 0u, 0u, 0u};
    for (int i = gt; i < NZ - N_IN; i += NGT) ((float*)(F.ws + MI_CSWIN))[N_IN + i] = 0.f;
    bf16* WL = (bf16*)(F.ws + WS_WLORA);
    for (int i = gt; i < NL * (KL / 8); i += NGT) {
        const int c8 = i / NL, row = i % NL, blk = row >> 10, n = row & 1023, col = c8 * 8, g = col >> 6;
        const float* src = nullptr; int kofs = 0;
        if (blk < 2) { if (g == blk) { src = KIN(I_WDU) + (size_t)blk * 64 * D; kofs = col - 64 * blk; } }
        else if (blk < 4) { if (g == blk) { src = KIN(I_WIU) + (size_t)(blk - 2) * 64 * D; kofs = col - 64 * blk; } }
        else { if (g >= 4) { src = KIN(I_WGU); kofs = col - 256; } }
        v4u o = {0u, 0u, 0u, 0u};
        if (src) { float v[8];
#pragma unroll
            for (int q = 0; q < 8; ++q) v[q] = src[(size_t)(kofs + q) * D + n];
            o.x = pk2(v[0], v[1]); o.y = pk2(v[2], v[3]); o.z = pk2(v[4], v[5]); o.w = pk2(v[6], v[7]); }
        *(v4u*)(WL + (size_t)row * KL + col) = o;
    }
    bf16* WR = (bf16*)(F.ws + WS_WROUT);
    for (int i = gt; i < 256 * (D / 8); i += NGT) {
        const int row = i % 256, c8 = i / 256; v4u o = {0u, 0u, 0u, 0u};
        if (row < NE) { float v[8];
#pragma unroll
            for (int q = 0; q < 8; ++q) v[q] = KIN(I_WR)[(size_t)(c8 * 8 + q) * NE + row];
            o.x = pk2(v[0], v[1]); o.y = pk2(v[2], v[3]); o.z = pk2(v[4], v[5]); o.w = pk2(v[6], v[7]); }
        *(v4u*)(WR + (size_t)row * D + c8 * 8) = o;
    }
}

__device__ __forceinline__ void phase_hrows(Frame& F) {
    LAS float* LA = (LAS float*)(F.lds);
    LAS float* LB = LA + 3 * D;
    const float* modp = (const float*)(F.ws + WS_MODP);
    for (int i = F.tid; i < 3 * D; i += NWAVES * 64) { const int v = i / D, j = i % D;
        LA[i] = KIN(I_NPM)[j] * (1.0f + mod_val(modp, KIN(I_BADA), v, 1024 + j)); LB[i] = mod_val(modp, KIN(I_BADA), v, j); }
    __syncthreads();
    signed char* A0q = (signed char*)(F.ws + WS_A0);
    for (int row = F.gw; row < MT; row += F.NGW) {
        const float* xr; int vec;
        if (row < ML) { xr = KIN(I_X) + (size_t)row * D; vec = row >> 13; } else { xr = KIN(I_CTX) + (size_t)(row - ML) * D; vec = 2; }
        f32x4 v[4]; float s = 0.f;
#pragma unroll
        for (int j = 0; j < 4; ++j) { v[j] = *(const f32x4*)(xr + 4 * F.lane + 256 * j); s += (v[j].x * v[j].x + v[j].y * v[j].y) + (v[j].z * v[j].z + v[j].w * v[j].w); }
        const float rstd = 1.0f / sqrtf(wave_sum(s) * (1.0f / D) + 1e-6f);
        f32x4 hq[4]; float mx = 0.f;
#pragma unroll
        for (int j = 0; j < 4; ++j) { const int c = 4 * F.lane + 256 * j; const f32x4 a = *(const LAS f32x4*)(LA + vec * D + c), b = *(const LAS f32x4*)(LB + vec * D + c);
            hq[j] = v[j] * rstd * a + b; mx = fmaxf(mx, fmaxf(fmaxf(fabsf(hq[j].x), fabsf(hq[j].y)), fmaxf(fabsf(hq[j].z), fabsf(hq[j].w)))); }
        mx = wave_max(mx);
        const float iv = mx > 0.f ? 127.0f / mx : 0.f;
        if (F.lane == 0) ((float*)(F.ws + MI_RSH))[row] = mx * (1.0f / 127.0f);
        unsigned* o4 = (unsigned*)(A0q + (size_t)row * D) + F.lane;
#pragma unroll
        for (int j = 0; j < 4; ++j) o4[64 * j] = pack_q4(hq[j].x * iv, hq[j].y * iv, hq[j].z * iv, hq[j].w * iv);
    }
}

__device__ __forceinline__ void phase_lora_in(Frame& F) {
    const bf16* z = (const bf16*)(F.ws + WS_Z); bf16* AL = (bf16*)(F.ws + WS_AL);
    const int gt = blockIdx.x * (NWAVES * 64) + F.tid, NGT = F.G * NWAVES * 64;
    for (int i = gt; i < MT * (KL / 4); i += NGT) {
        const int row = i / (KL / 4), q = i % (KL / 4), j0 = 4 * q;
        const int zc = j0 < 256 ? DECAY_OFF + j0 : GLORA_OFF + (j0 - 256);
        float o[4];
        if (j0 >= 256 && row >= ML) { o[0] = o[1] = o[2] = o[3] = 0.f; }
        else {
            const uint2 sv = *(const uint2*)(z + (size_t)row * NZ + zc); const float s[4] = {bflo(sv.x), bfhi(sv.x), bflo(sv.y), bfhi(sv.y)};
#pragma unroll
            for (int j = 0; j < 4; ++j) { const int nr = nbr_row(row, j); float t = 0.f;
                if (nr >= 0) t = bf1(z[(size_t)nr * NZ + zc + j]);
                const float v = s[j] + KIN(I_MU)[zc + j] * (t - s[j]);
                o[j] = j0 < 128 ? tanhf(v) : (j0 < 256 ? v : sigmoidf_(v)); }
        }
        *(uint2*)(AL + (size_t)row * KL + j0) = make_uint2(pk2(o[0], o[1]), pk2(o[2], o[3]));
    }
}


namespace ck {
typedef short bf16x8 __attribute__((ext_vector_type(8)));
constexpr int TILE = 8192;
constexpr int NU_L = BATCH * (T / 64) * NH;
constexpr int NU_ALL = NU_L + BATCH * (TC / 64) * NH;
__device__ __forceinline__ int swz(int row) { return (row ^ (row >> 3)) & 7; }
__device__ __forceinline__ int toff(int row, int col) { return row * 128 + ((col * 2) ^ (swz(row) << 4)); }
__device__ __forceinline__ bf16x8 ldfrag(const LAS unsigned char* t, int row, int chunk) { return *(const LAS bf16x8*)(t + row * 128 + ((chunk ^ swz(row)) << 4)); }
typedef __bf16 bf16v2_t __attribute__((ext_vector_type(2)));
__device__ __forceinline__ unsigned cvtpk(float lo, float hi) { const bf16v2_t v = {(__bf16)lo, (__bf16)hi}; return __builtin_bit_cast(unsigned, v); }
#define CK_MFMA(a, b, c) __builtin_amdgcn_mfma_f32_16x16x32_bf16(a, b, c, 0, 0, 0)
template <bool MASKDIAG>
__device__ __forceinline__ void mm64(f32x4 (&acc)[4], const LAS unsigned char* Lt, const LAS unsigned char* Rt, int wq, int lane) {
    const int lr = lane & 15, g = lane >> 4;
    const bf16x8 l0 = ldfrag(Lt, 16 * wq + lr, g), l1 = ldfrag(Lt, 16 * wq + lr, 4 + g);
#pragma unroll
    for (int n = 0; n < 4; ++n) {
        bf16x8 r0 = ldfrag(Rt, 16 * n + lr, g), r1 = ldfrag(Rt, 16 * n + lr, 4 + g);
        if (MASKDIAG) { const bf16x8 zz = {0, 0, 0, 0, 0, 0, 0, 0}; if ((g >> 1) == n) r0 = zz; if (2 + (g >> 1) == n) r1 = zz; }
        acc[n] = CK_MFMA(l0, r0, acc[n]); acc[n] = CK_MFMA(l1, r1, acc[n]);
    }
}
__device__ __forceinline__ void zero4(f32x4 (&a)[4]) {
#pragma unroll
    for (int n = 0; n < 4; ++n) a[n] = (f32x4){0.f, 0.f, 0.f, 0.f};
}
__device__ __forceinline__ void storeT(LAS unsigned char* t, const f32x4 (&v)[4], int wq, int lane) {
    const int lr = lane & 15, g = lane >> 4;
#pragma unroll
    for (int n = 0; n < 4; ++n) *(LAS v2u*)(t + toff(16 * n + lr, 16 * wq + 4 * g)) = (v2u){cvtpk(v[n][0], v[n][1]), cvtpk(v[n][2], v[n][3])};
}
__device__ __forceinline__ void storeN(LAS unsigned char* t, const f32x4 (&v)[4], int wq, int lane) {
    const int lr = lane & 15, g = lane >> 4;
#pragma unroll
    for (int n = 0; n < 4; ++n)
#pragma unroll
        for (int i = 0; i < 4; ++i) *(LAS unsigned short*)(t + toff(16 * wq + 4 * g + i, 16 * n + lr)) = (unsigned short)f2bf(v[n][i]);
}
__device__ __forceinline__ void loadT(f32x4 (&v)[4], const LAS unsigned char* t, int wq, int lane) {
    const int lr = lane & 15, g = lane >> 4;
#pragma unroll
    for (int n = 0; n < 4; ++n) { const v2u w = *(const LAS v2u*)(t + toff(16 * n + lr, 16 * wq + 4 * g)); v[n] = (f32x4){bflo(w.x), bfhi(w.x), bflo(w.y), bfhi(w.y)}; }
}
__device__ __forceinline__ void unit_decode(int unit, int& b, int& h, int& rowbase) {
    if (unit < NU_L) { h = unit & 15; const int blk = (unit >> 4) & 127; b = unit >> 11; rowbase = b * T + blk * 64; }
    else { const int u = unit - NU_L; h = u & 15; const int cb = (u >> 4) & 3; b = u >> 6; rowbase = ML + b * TC + cb * 64; }
}
__device__ __forceinline__ void pack8(LAS unsigned char* t, int row, int chunk, const float (&v)[8], bool rev) {
    v4u o;
    if (!rev) { o.x = cvtpk(v[0], v[1]); o.y = cvtpk(v[2], v[3]); o.z = cvtpk(v[4], v[5]); o.w = cvtpk(v[6], v[7]); }
    else { o.x = cvtpk(v[7], v[6]); o.y = cvtpk(v[5], v[4]); o.z = cvtpk(v[3], v[2]); o.w = cvtpk(v[1], v[0]); }
    *(LAS v4u*)(t + row * 128 + ((chunk ^ swz(row)) << 4)) = o;
}

__device__ __forceinline__ void unpack8(const v4u p, float (&o)[8]) {
    o[0] = bflo(p.x); o[1] = bfhi(p.x); o[2] = bflo(p.y); o[3] = bfhi(p.y); o[4] = bflo(p.z); o[5] = bfhi(p.z); o[6] = bflo(p.w); o[7] = bfhi(p.w);
}
__device__ __forceinline__ void ld8f(const float* p, float (&o)[8]) {
    const f32x4 a = *(const f32x4*)p, b = *(const f32x4*)(p + 4); o[0] = a.x; o[1] = a.y; o[2] = a.z; o[3] = a.w; o[4] = b.x; o[5] = b.y; o[6] = b.z; o[7] = b.w;
}
__device__ __forceinline__ float fsig(float x) { return __builtin_amdgcn_rcpf(1.0f + __expf(-x)); }
template <bool IS_CO> struct EPre { v4u k[5], v[5], r[IS_CO ? 5 : 1], lo[4]; unsigned msk; };
template <bool IS_CO>
__device__ __forceinline__ void epre_load(EPre<IS_CO>& P, const bf16* z, const bf16* LO, int unit, int wave, int lane) {
    int b, h, rowbase; unit_decode(unit, b, h, rowbase);
    const int row = rowbase + 8 * wave + (lane >> 3), c0 = h * 64 + 8 * (lane & 7);
    const bf16* zr = z + (size_t)row * NZ;
    P.k[0] = *(const v4u*)(zr + K_OFF + c0); P.v[0] = *(const v4u*)(zr + V_OFF + c0); if (IS_CO) P.r[0] = *(const v4u*)(zr + R_OFF + c0);
    unsigned msk = 0u;
#pragma unroll
    for (int j = 0; j < 4; ++j) { const int nr = nbr_row(row, j); const bf16* zn = z + (size_t)(nr >= 0 ? nr : row) * NZ; msk |= (nr >= 0 ? 1u : 0u) << j;
        P.k[1 + j] = *(const v4u*)(zn + K_OFF + c0); P.v[1 + j] = *(const v4u*)(zn + V_OFF + c0);
        if (IS_CO) P.r[1 + j] = *(const v4u*)(zn + R_OFF + c0); }
    P.msk = msk;
    const bf16* lr_ = LO + (size_t)row * NL + c0;
    P.lo[0] = *(const v4u*)(lr_); P.lo[1] = *(const v4u*)(lr_ + 1024); P.lo[2] = *(const v4u*)(lr_ + 2048); P.lo[3] = *(const v4u*)(lr_ + 3072);
}
__device__ __forceinline__ void shift8(const v4u (&q)[5], const float* mu, float (&out)[8], unsigned msk = 15u) {
    const v4u zz = {0u, 0u, 0u, 0u};
    const v4u s = q[0], n0 = (msk & 1u) ? q[1] : zz, n1 = (msk & 2u) ? q[2] : zz, n2 = (msk & 4u) ? q[3] : zz, n3 = (msk & 8u) ? q[4] : zz;
    float m[8]; ld8f(mu, m);
    out[0] = bflo(s.x) + m[0] * (bflo(n0.x) - bflo(s.x)); out[1] = bfhi(s.x) + m[1] * (bfhi(n1.x) - bfhi(s.x));
    out[2] = bflo(s.y) + m[2] * (bflo(n2.y) - bflo(s.y)); out[3] = bfhi(s.y) + m[3] * (bfhi(n3.y) - bfhi(s.y));
    out[4] = bflo(s.z) + m[4] * (bflo(n0.z) - bflo(s.z)); out[5] = bfhi(s.z) + m[5] * (bfhi(n1.z) - bfhi(s.z));
    out[6] = bflo(s.w) + m[6] * (bflo(n2.w) - bflo(s.w)); out[7] = bfhi(s.w) + m[7] * (bfhi(n3.w) - bfhi(s.w));
}
struct EPre2 { v4u k0, v0, r0; v2u kn[4], vn[4], rn[4]; v4u lo[4]; unsigned msk; };
__device__ __forceinline__ void epre2_load(EPre2& P, const bf16* z, const bf16* LO, int unit, int wave, int lane) {
    int b, h, rowbase; unit_decode(unit, b, h, rowbase);
    const int row = rowbase + 8 * wave + (lane >> 3), c0 = h * 64 + 8 * (lane & 7);
    const bf16* zr = z + (size_t)row * NZ;
    P.k0 = *(const v4u*)(zr + K_OFF + c0); P.v0 = *(const v4u*)(zr + V_OFF + c0); P.r0 = *(const v4u*)(zr + R_OFF + c0);
    unsigned msk = 0u;
#pragma unroll
    for (int j = 0; j < 4; ++j) { const int nr = nbr_row(row, j); const unsigned* zn = (const unsigned*)(z + (size_t)(nr >= 0 ? nr : row) * NZ + c0) + (j >> 1); msk |= (nr >= 0 ? 1u : 0u) << j;
        P.kn[j].x = zn[K_OFF / 2]; P.kn[j].y = zn[K_OFF / 2 + 2]; P.vn[j].x = zn[V_OFF / 2]; P.vn[j].y = zn[V_OFF / 2 + 2]; P.rn[j].x = zn[R_OFF / 2]; P.rn[j].y = zn[R_OFF / 2 + 2]; }
    P.msk = msk;
    const bf16* lr_ = LO + (size_t)row * NL + c0;
    P.lo[0] = *(const v4u*)(lr_); P.lo[1] = *(const v4u*)(lr_ + 1024); P.lo[2] = *(const v4u*)(lr_ + 2048); P.lo[3] = *(const v4u*)(lr_ + 3072);
}
__device__ __forceinline__ void shift8n(const v4u s, const v2u (&nb)[4], const float* mu, float (&out)[8], unsigned msk) {
    float m[8]; ld8f(mu, m);
    const float n0a = (msk & 1u) ? bflo(nb[0].x) : 0.f, n0b = (msk & 1u) ? bflo(nb[0].y) : 0.f, n1a = (msk & 2u) ? bfhi(nb[1].x) : 0.f, n1b = (msk & 2u) ? bfhi(nb[1].y) : 0.f;
    const float n2a = (msk & 4u) ? bflo(nb[2].x) : 0.f, n2b = (msk & 4u) ? bflo(nb[2].y) : 0.f, n3a = (msk & 8u) ? bfhi(nb[3].x) : 0.f, n3b = (msk & 8u) ? bfhi(nb[3].y) : 0.f;
    out[0] = bflo(s.x) + m[0] * (n0a - bflo(s.x)); out[1] = bfhi(s.x) + m[1] * (n1a - bfhi(s.x));
    out[2] = bflo(s.y) + m[2] * (n2a - bflo(s.y)); out[3] = bfhi(s.y) + m[3] * (n3a - bfhi(s.y));
    out[4] = bflo(s.z) + m[4] * (n0b - bflo(s.z)); out[5] = bfhi(s.z) + m[5] * (n1b - bfhi(s.z));
    out[6] = bflo(s.w) + m[6] * (n2b - bflo(s.w)); out[7] = bfhi(s.w) + m[7] * (n3b - bfhi(s.w));
}
__device__ __forceinline__ void putN(LAS unsigned char* t, int tau, int oct, const float (&v)[8]) {
    v4u o; o.x = cvtpk(v[0], v[1]); o.y = cvtpk(v[2], v[3]); o.z = cvtpk(v[4], v[5]); o.w = cvtpk(v[6], v[7]);
    *(LAS v4u*)(t + tau * 128 + ((oct ^ swz(tau)) << 4)) = o;
}
__device__ __forceinline__ void putT(LAS unsigned char* t, int tau, int ch0, const float (&v)[8]) {
#pragma unroll
    for (int i = 0; i < 8; ++i) *(LAS unsigned short*)(t + toff(ch0 + i, tau)) = (unsigned short)f2bf(v[i]);
}

template <bool IS_CO, bool STAGES = true>
__device__ __forceinline__ void phase_chunk(Frame& F) {
    const int wave = F.wave;
    const int dgrp = wave >> 2, wq = wave & 3;
    LAS unsigned char* tl = F.lds + dgrp * 9 * TILE;
#define SL(k) (tl + (k) * TILE)
    LAS float* SEG = (LAS float*)(F.lds + LDS_X_OFF);
    LAS float* GAM = SEG + 1024;
    LAS unsigned char* DIB = (LAS unsigned char*)(GAM + 128) + dgrp * 2048;
    LAS float* LW0 = (LAS float*)(F.lds + 7 * TILE);
    LAS float* LW1 = (LAS float*)(F.lds + 16 * TILE);
    const bf16* z = (const bf16*)(F.ws + WS_Z); const bf16* LO = (const bf16*)(F.ws + WS_LORA);
    unsigned char* PQ = F.ws + WS_PQ; unsigned char* TKN = F.ws + WS_TKN; unsigned char* UPRE = F.ws + WS_UPRE; unsigned char* H0T = F.ws + WS_H0T;
    bf16* MG = (bf16*)(F.ws + WS_A0);
    const float* p_mu = KIN(I_MU); const float* p_kk = KIN(I_KK); const float* p_ka = KIN(I_KA);
    const int NU = IS_CO ? NU_L : NU_ALL;
    EPre<IS_CO> PF;
    CvTile cvt; float civ[4] = {0.f, 0.f, 0.f, 0.f}; int cv_t = 0;
    const float* cv_w = KIN(I_WEI);
    LAS float* cv_scr = (LAS float*)(F.lds + wave * 16384);
    if ((int)blockIdx.x < NU) epre_load<IS_CO>(PF, z, LO, (int)blockIdx.x, wave, F.lane);
    for (int unit = blockIdx.x; unit < NU; unit += F.G) {
        int lane = F.lane; asm volatile("" : "+v"(lane));
        const int lr = lane & 15, g = lane >> 4;
        int b, h, rowbase; unit_decode(unit, b, h, rowbase);
        const int tok = 8 * wave + (lane >> 3), oct = lane & 7, ch0 = 8 * oct, c0 = h * 64 + ch0, row = rowbase + tok;
        float ks[8], vs[8], rs[8], kkp[8], lw0[8], lw1[8], kd0[8], kd1[8], a_0[8], a_1[8], ssq;
        {
            shift8(PF.k, p_mu + K_OFF + c0, ks, PF.msk);
            shift8(PF.v, p_mu + V_OFF + c0, vs, PF.msk);
            if (IS_CO) { v4u rr[5];
#pragma unroll
                for (int j = 0; j < 5; ++j) rr[j] = PF.r[IS_CO ? j : 0];
                shift8(rr, p_mu + R_OFF + c0, rs, PF.msk); }
            else {
#pragma unroll
                for (int i = 0; i < 8; ++i) rs[i] = 0.f; }
            float xw0[8], xw1[8], xa0[8], xa1[8];
            unpack8(PF.lo[0], xw0); unpack8(PF.lo[1], xw1); unpack8(PF.lo[2], xa0); unpack8(PF.lo[3], xa1);
            float kkk[8], kaa[8];
            ld8f(p_kk + c0, kkk); ld8f(p_ka + c0, kaa);
            float ss = 0.f;
#pragma unroll
            for (int i = 0; i < 8; ++i) {
                kkp[i] = ks[i] * kkk[i]; ss += kkp[i] * kkp[i];
                lw0[i] = xw0[i]; lw1[i] = xw1[i];
                a_0[i] = xa0[i]; a_1[i] = xa1[i];
                kd0[i] = ks[i] * (1.0f + (a_0[i] - 1.0f) * kaa[i]); kd1[i] = ks[i] * (1.0f + (a_1[i] - 1.0f) * kaa[i]);
                const int ch = ch0 + i, sw = tok ^ (4 * ((ch & 15) ^ (2 * (ch >> 4))));
                LW0[ch * 64 + sw] = lw0[i]; LW1[ch * 64 + sw] = lw1[i];
            }
            ss += __shfl_xor(ss, 1); ss += __shfl_xor(ss, 2); ss += __shfl_xor(ss, 4);
            ssq = ss;
        }
        __syncthreads();
        {
            const int ch2 = lane, seg = wave, sw = 4 * ((ch2 & 15) ^ (2 * (ch2 >> 4)));
            LAS f32x4* p0a = (LAS f32x4*)(LW0 + ch2 * 64 + ((8 * seg) ^ sw)); LAS f32x4* p0b = (LAS f32x4*)(LW0 + ch2 * 64 + ((8 * seg + 4) ^ sw));
            LAS f32x4* p1a = (LAS f32x4*)(LW1 + ch2 * 64 + ((8 * seg) ^ sw)); LAS f32x4* p1b = (LAS f32x4*)(LW1 + ch2 * 64 + ((8 * seg + 4) ^ sw));
            f32x4 a = *p0a, bq = *p0b, c = *p1a, d = *p1b;
            a.y += a.x; a.z += a.y; a.w += a.z; bq.x += a.w; bq.y += bq.x; bq.z += bq.y; bq.w += bq.z;
            d.z += d.w; d.y += d.z; d.x += d.y; c.w += d.x; c.z += c.w; c.y += c.z; c.x += c.y;
            SEG[seg * 64 + ch2] = bq.w; SEG[(8 + seg) * 64 + ch2] = c.x;
            __syncthreads();
            float off0 = 0.f, off1 = 0.f;
#pragma unroll
            for (int s2 = 0; s2 < 8; ++s2) { const float t0 = SEG[s2 * 64 + ch2], t1 = SEG[(8 + s2) * 64 + ch2]; off0 += (s2 < seg) ? t0 : 0.f; off1 += (s2 > seg) ? t1 : 0.f; }
            *p0a = a + off0; *p0b = bq + off0; *p1a = c + off1; *p1b = d + off1;
        }
        __syncthreads();
        {
            const float inv = 1.0f / fmaxf(sqrtf(ssq), 1e-12f);
            float t8[8], u8[8], w8[8];
            {
                LAS unsigned char* t0 = F.lds; const int tau = tok;
                float e1[8], ei[8];
#pragma unroll
                for (int i = 0; i < 8; ++i) { const int ch = ch0 + i; const float cm = LW0[ch * 64 + (tok ^ (4 * ((ch & 15) ^ (2 * (ch >> 4)))))]; e1[i] = __expf(cm); ei[i] = __builtin_amdgcn_rcpf(e1[i]); t8[i] = kkp[i] * inv * __expf(cm - lw0[i]); }
                if (tok == 63) {
#pragma unroll
                    for (int i = 0; i < 8; ++i) GAM[ch0 + i] = e1[i]; }
#pragma unroll
                for (int i = 0; i < 8; ++i) { u8[i] = kkp[i] * inv * a_0[i] * ei[i]; w8[i] = kd0[i] * ei[i]; }
                if (!IS_CO) { putN(t0 + 0 * TILE, tau, oct, t8); putT(t0 + 1 * TILE, tau, ch0, t8); putN(t0 + 2 * TILE, tau, oct, u8); putT(t0 + 3 * TILE, tau, ch0, u8);
                    putN(t0 + 4 * TILE, tau, oct, w8); putT(t0 + 5 * TILE, tau, ch0, w8); putT(t0 + 6 * TILE, tau, ch0, vs); }
                else {
#pragma unroll
                    for (int i = 0; i < 8; ++i) t8[i] = rs[i] * e1[i];
                    putN(t0 + 0 * TILE, tau, oct, w8); putN(t0 + 1 * TILE, tau, oct, u8); putN(t0 + 2 * TILE, tau, oct, t8); putT(t0 + 3 * TILE, tau, ch0, vs); }
            }
            {
                LAS unsigned char* t1 = F.lds + 9 * TILE; const int tau = 63 - tok;
                float e1[8], ei[8];
#pragma unroll
                for (int i = 0; i < 8; ++i) { const int ch = ch0 + i; const float cm = LW1[ch * 64 + (tok ^ (4 * ((ch & 15) ^ (2 * (ch >> 4)))))]; e1[i] = __expf(cm); ei[i] = __builtin_amdgcn_rcpf(e1[i]); t8[i] = kkp[i] * inv * __expf(cm - lw1[i]); }
                if (tok == 0) {
#pragma unroll
                    for (int i = 0; i < 8; ++i) GAM[64 + ch0 + i] = e1[i]; }
#pragma unroll
                for (int i = 0; i < 8; ++i) { u8[i] = kkp[i] * inv * a_1[i] * ei[i]; w8[i] = kd1[i] * ei[i]; }
                if (!IS_CO) { putN(t1 + 0 * TILE, tau, oct, t8); putT(t1 + 1 * TILE, tau, ch0, t8); putN(t1 + 2 * TILE, tau, oct, u8); putT(t1 + 3 * TILE, tau, ch0, u8);
                    putN(t1 + 4 * TILE, tau, oct, w8); putT(t1 + 5 * TILE, tau, ch0, w8); putT(t1 + 6 * TILE, tau, ch0, vs); }
                else {
#pragma unroll
                    for (int i = 0; i < 8; ++i) t8[i] = rs[i] * e1[i];
                    putN(t1 + 0 * TILE, tau, oct, w8); putN(t1 + 1 * TILE, tau, oct, u8); putN(t1 + 2 * TILE, tau, oct, t8); putT(t1 + 3 * TILE, tau, ch0, vs); }
            }
        }
        if (!STAGES) { __syncthreads(); continue; }
        const size_t inst = (size_t)unit * 2 + dgrp;
        const int t2 = (wq << 6) | lane;
        if (IS_CO) {
#pragma unroll
            for (int rep = 0; rep < 2; ++rep) { const int cidx = t2 + 256 * rep, row = cidx >> 3, ch = cidx & 7;
                const v4u a = *(const v4u*)(TKN + inst * 8192 + (size_t)(row * 64 + ch * 8) * 2), hh = *(const v4u*)(H0T + inst * 8192 + (size_t)(row * 64 + ch * 8) * 2);
                *(LAS v4u*)(SL(4) + row * 128 + ((ch ^ swz(row)) << 4)) = a; *(LAS v4u*)(SL(5) + row * 128 + ((ch ^ swz(row)) << 4)) = hh; }
        }
        v4u upre0 = {0u, 0u, 0u, 0u}, upre1 = upre0;
        if (IS_CO) { const unsigned char* up = UPRE + inst * 8192 + (size_t)((wq * 64 + lane) * 32); upre0 = *(const v4u*)up; upre1 = *(const v4u*)(up + 16); }
        if (unit + F.G < NU) epre_load<IS_CO>(PF, z, LO, unit + F.G, wave, lane);
        const int cv_strip = F.gw + (cv_t >> 4) * F.NGW, cv_kb = cv_t & 15;
        if (!IS_CO && cv_strip < NE * 64) { int e_, n0_, rb_; wei_strip(cv_strip, e_, n0_, rb_); cv_load(cvt, cv_w + (size_t)e_ * D * 2048, 2048, n0_, cv_kb, lane); }
        __syncthreads();
        f32x4 acc[4], acc2[4];
        if (!IS_CO) {
            zero4(acc); mm64<false>(acc, SL(2), SL(0), wq, lane);
            zero4(acc2); mm64<false>(acc2, SL(4), SL(0), wq, lane);
#pragma unroll
            for (int n = 0; n < 4; ++n)
#pragma unroll
                for (int q = 0; q < 4; ++q) { const bool lo = (16 * wq + 4 * g + q < 16 * n + lr); acc[n][q] = lo ? acc[n][q] : 0.f; acc2[n][q] = lo ? acc2[n][q] : 0.f; }
            storeT(SL(7), acc, wq, lane); storeT(SL(8), acc2, wq, lane);
            __syncthreads();
            zero4(acc); mm64<false>(acc, SL(8), SL(6), wq, lane); storeT(SL(0), acc, wq, lane);
            if (wq == 0) {
                const int bb = lane >> 4, jj = lane & 15;
                float X[16];
                X[0] = (jj == 0) ? 1.f : 0.f;
#pragma unroll
                for (int t = 1; t < 16; ++t) {
                    const int row = 16 * bb + t;
                    const v4u p0 = *(const LAS v4u*)(SL(7) + row * 128 + (((2 * bb) ^ swz(row)) << 4)), p1 = *(const LAS v4u*)(SL(7) + row * 128 + (((2 * bb + 1) ^ swz(row)) << 4));
                    float rw[16];
                    rw[0] = bflo(p0.x); rw[1] = bfhi(p0.x); rw[2] = bflo(p0.y); rw[3] = bfhi(p0.y); rw[4] = bflo(p0.z); rw[5] = bfhi(p0.z); rw[6] = bflo(p0.w); rw[7] = bfhi(p0.w);
                    rw[8] = bflo(p1.x); rw[9] = bfhi(p1.x); rw[10] = bflo(p1.y); rw[11] = bfhi(p1.y); rw[12] = bflo(p1.z); rw[13] = bfhi(p1.z); rw[14] = bflo(p1.w); rw[15] = bfhi(p1.w);
                    float xv = (t == jj) ? 1.f : 0.f;
#pragma unroll
                    for (int s = 0; s < t; ++s) xv -= rw[s] * X[s];
                    X[t] = xv;
                }
#pragma unroll
                for (int t = 0; t < 16; ++t) *(LAS unsigned short*)(DIB + (((bb * 16 + t) * 16 + jj) << 1)) = (unsigned short)f2bf(X[t]);
            }
            __syncthreads();
            {
                const bool isU = wq >= 2; const int cbase = 32 * (wq & 1);
                const LAS unsigned char* Rt = isU ? SL(0) : SL(1);
                LAS unsigned char* outT = isU ? SL(4) : SL(2);
#pragma unroll
                for (int ct = 0; ct < 2; ++ct) {
                    const int col = cbase + 16 * ct + lr;
                    f32x4 X[4];
#pragma unroll
                    for (int b = 0; b < 4; ++b) {
                        const v2u rwv = *(const LAS v2u*)(Rt + toff(col, 16 * b + 4 * g));
                        f32x4 Zt = {bflo(rwv.x), bfhi(rwv.x), bflo(rwv.y), bfhi(rwv.y)};
                        if (b >= 1) {
                            f32x4 Y = {0.f, 0.f, 0.f, 0.f};
#pragma unroll
                            for (int s = 0; s < (b + 1) / 2; ++s) {
                                v2u alo = {0u, 0u}, ahi = {0u, 0u};
                                if (2 * s < b) alo = *(const LAS v2u*)(SL(7) + toff(16 * b + lr, 32 * s + 4 * g));
                                if (2 * s + 1 < b) ahi = *(const LAS v2u*)(SL(7) + toff(16 * b + lr, 32 * s + 16 + 4 * g));
                                v4u bw = {cvtpk(X[2 * s][0], X[2 * s][1]), cvtpk(X[2 * s][2], X[2 * s][3]), 0u, 0u};
                                if (2 * s + 1 < b) { bw.z = cvtpk(X[2 * s + 1][0], X[2 * s + 1][1]); bw.w = cvtpk(X[2 * s + 1][2], X[2 * s + 1][3]); }
                                Y = CK_MFMA(__builtin_bit_cast(bf16x8, ((v4u){alo.x, alo.y, ahi.x, ahi.y})), __builtin_bit_cast(bf16x8, bw), Y);
                            }
                            Zt = Zt - Y;
                        }
                        const v2u dv = *(const LAS v2u*)(DIB + (((b * 16 + lr) * 16 + 4 * g) << 1));
                        const v4u bz = {cvtpk(Zt[0], Zt[1]), cvtpk(Zt[2], Zt[3]), 0u, 0u};
                        X[b] = CK_MFMA(__builtin_bit_cast(bf16x8, ((v4u){dv.x, dv.y, 0u, 0u})), __builtin_bit_cast(bf16x8, bz), ((f32x4){0.f, 0.f, 0.f, 0.f}));
                    }
#pragma unroll
                    for (int b = 0; b < 4; ++b) {
                        const v2u pk = {cvtpk(X[b][0], X[b][1]), cvtpk(X[b][2], X[b][3])};
                        *(LAS v2u*)(outT + toff(col, 16 * b + 4 * g)) = pk;
                        if (!isU) {
#pragma unroll
                            for (int q = 0; q < 4; ++q) *(LAS unsigned short*)(SL(8) + toff(16 * b + 4 * g + q, col)) = (unsigned short)f2bf(X[b][q]);
                        } else {
                            *(uint2*)(UPRE + inst * 8192 + (size_t)(((b * 64 + lane) * 4 + 2 * (wq & 1) + ct) * 8)) = make_uint2(pk.x, pk.y);
                        }
                    }
                }
            }
            __syncthreads();
            { zero4(acc); mm64<false>(acc, SL(2), SL(3), wq, lane);
              const int cstep_ = unit < NU_L ? 4 + (dgrp ? 127 - ((unit >> 4) & 127) : ((unit >> 4) & 127)) : (dgrp ? 3 - (((unit - NU_L) >> 4) & 3) : (((unit - NU_L) >> 4) & 3));
              unsigned char* pb = PQ + (size_t)(((b * 16 + h) * 2 + dgrp) * (4 + T / 64) + cstep_) * 16384;
#pragma unroll
              for (int n = 0; n < 4; ++n) { const int k = 16 * n + lr; const float gm = GAM[dgrp * 64 + k]; float p[4];
#pragma unroll
                  for (int q = 0; q < 4; ++q) p[q] = gm * (((16 * wq + 4 * g + q) == k ? 1.f : 0.f) - acc[n][q]);
                  *(uint2*)(pb + (size_t)(((n * 2 + (wq >> 1)) * 64 + lane) * 16 + (wq & 1) * 8)) = make_uint2(cvtpk(p[0], p[1]), cvtpk(p[2], p[3])); }
              zero4(acc); mm64<false>(acc, SL(5), SL(6), wq, lane); zero4(acc2); mm64<false>(acc2, SL(3), SL(4), wq, lane);
              const f32x4 gm4 = *(const LAS f32x4*)(GAM + dgrp * 64 + 16 * wq + 4 * g);
#pragma unroll
              for (int n = 0; n < 4; ++n) { const f32x4 qv = (acc[n] - acc2[n]) * gm4;
                  *(uint2*)(pb + 8192 + (size_t)(((n * 64 + lane) * 4 + wq) * 8)) = make_uint2(cvtpk(qv[0], qv[1]), cvtpk(qv[2], qv[3])); }
#pragma unroll
              for (int rep = 0; rep < 2; ++rep) { const int cidx = t2 + 256 * rep, row = cidx >> 3, ch = cidx & 7;
                  *(v4u*)(TKN + inst * 8192 + (size_t)(row * 64 + ch * 8) * 2) = *(const LAS v4u*)(SL(8) + row * 128 + ((ch ^ swz(row)) << 4)); }
            }
        } else {
            zero4(acc); mm64<false>(acc, SL(0), SL(2), wq, lane);
#pragma unroll
            for (int n = 0; n < 4; ++n)
#pragma unroll
                for (int q = 0; q < 4; ++q) acc[n][q] = (16 * wq + 4 * g + q <= 16 * n + lr) ? acc[n][q] : 0.f;
            storeT(SL(6), acc, wq, lane);
            zero4(acc); mm64<false>(acc, SL(1), SL(2), wq, lane);
#pragma unroll
            for (int n = 0; n < 4; ++n)
#pragma unroll
                for (int q = 0; q < 4; ++q) acc[n][q] = (16 * wq + 4 * g + q <= 16 * n + lr) ? -acc[n][q] : 0.f;
            storeT(SL(7), acc, wq, lane);
            { const v4u o0 = upre0, o1 = upre1;
              acc[0] = (f32x4){bflo(o0.x), bfhi(o0.x), bflo(o0.y), bfhi(o0.y)}; acc[1] = (f32x4){bflo(o0.z), bfhi(o0.z), bflo(o0.w), bfhi(o0.w)};
              acc[2] = (f32x4){bflo(o1.x), bfhi(o1.x), bflo(o1.y), bfhi(o1.y)}; acc[3] = (f32x4){bflo(o1.z), bfhi(o1.z), bflo(o1.w), bfhi(o1.w)}; }
            mm64<false>(acc, SL(4), SL(5), wq, lane);
            storeT(SL(8), acc, wq, lane);
            __syncthreads();
            zero4(acc); mm64<false>(acc, SL(2), SL(5), wq, lane); mm64<false>(acc, SL(6), SL(3), wq, lane); mm64<false>(acc, SL(7), SL(8), wq, lane);
            __syncthreads();
            { LAS float* Yf = (LAS float*)(tl);
#pragma unroll
              for (int n = 0; n < 4; ++n)
#pragma unroll
                  for (int q = 0; q < 4; ++q) { const int tau = 16 * wq + 4 * g + q; Yf[tau * 64 + ((16 * n + lr) ^ (4 * (tau & 15)))] = acc[n][q]; } }
            __syncthreads();
            { const LAS float* Y0 = (const LAS float*)(F.lds); const LAS float* Y1 = (const LAS float*)(F.lds + 9 * TILE);
              const int t = row & (T - 1);
              const bf16* zr = z + (size_t)row * NZ;
              const v4u zz = {0u, 0u, 0u, 0u};
              const v4u q_g = *(const v4u*)(LO + (size_t)row * NL + 4096 + c0);
              const v4u q_gb = *(const v4u*)(zr + CONV_OFF + c0), q_c0 = *(const v4u*)(zr + CONV_OFF + 1024 + c0), q_x0 = *(const v4u*)(zr + CONV_OFF + 2048 + c0);
              const v4u q_cm = t > 0 ? *(const v4u*)(zr - NZ + CONV_OFF + 1024 + c0) : zz, q_xm = t > 0 ? *(const v4u*)(zr - NZ + CONV_OFF + 2048 + c0) : zz;
              const v4u q_cp = t < T - 1 ? *(const v4u*)(zr + NZ + CONV_OFF + 1024 + c0) : zz, q_xp = t < T - 1 ? *(const v4u*)(zr + NZ + CONV_OFF + 2048 + c0) : zz;
              const v4u q_ga = *(const v4u*)(zr + GATE_OFF + c0), q_gr = *(const v4u*)(zr + GATE_OFF + 1024 + c0);
              float y[8];
              { const int s0 = 4 * (tok & 15), s1 = 4 * ((63 - tok) & 15);
                const f32x4 a0 = *(const LAS f32x4*)(Y0 + tok * 64 + (ch0 ^ s0)), a1 = *(const LAS f32x4*)(Y0 + tok * 64 + ((ch0 + 4) ^ s0));
                const f32x4 b0 = *(const LAS f32x4*)(Y1 + (63 - tok) * 64 + (ch0 ^ s1)), b1 = *(const LAS f32x4*)(Y1 + (63 - tok) * 64 + ((ch0 + 4) ^ s1));
                y[0] = a0.x + b0.x; y[1] = a0.y + b0.y; y[2] = a0.z + b0.z; y[3] = a0.w + b0.w; y[4] = a1.x + b1.x; y[5] = a1.y + b1.y; y[6] = a1.z + b1.z; y[7] = a1.w + b1.w; }
              float rk[8]; ld8f(KIN(I_RK) + c0, rk);
              float s1 = 0.f, s2 = 0.f, s3 = 0.f;
#pragma unroll
              for (int i = 0; i < 8; ++i) { s1 += y[i]; s2 += y[i] * y[i]; s3 += rs[i] * 0.5f * (kd0[i] + kd1[i]) * rk[i]; }
              s1 += __shfl_xor(s1, 1); s2 += __shfl_xor(s2, 1); s3 += __shfl_xor(s3, 1); s1 += __shfl_xor(s1, 2); s2 += __shfl_xor(s2, 2); s3 += __shfl_xor(s3, 2);
              s1 += __shfl_xor(s1, 4); s2 += __shfl_xor(s2, 4); s3 += __shfl_xor(s3, 4);
              const float S1 = s1, S2 = s2, S3 = s3;
              const float mean = S1 * (1.0f / 64.0f), var = fmaxf(S2 * (1.0f / 64.0f) - mean * mean, 0.f), rstd = __builtin_amdgcn_rsqf(var + 64e-5f);
              float lnw[8], lnb[8], cw0[8], cw1[8], cw2[8];
              ld8f(KIN(I_LNW) + c0, lnw); ld8f(KIN(I_LNB) + c0, lnb); ld8f(KIN(I_CONVW) + c0, cw0); ld8f(KIN(I_CONVW) + D + c0, cw1); ld8f(KIN(I_CONVW) + 2 * D + c0, cw2);
              float gg[8], gb[8], cc[8], xx[8], cm[8], xm[8], cp[8], xp[8], ga[8], gr[8];
              unpack8(q_g, gg); unpack8(q_gb, gb); unpack8(q_c0, cc); unpack8(q_x0, xx); unpack8(q_cm, cm); unpack8(q_xm, xm); unpack8(q_cp, cp); unpack8(q_xp, xp); unpack8(q_ga, ga); unpack8(q_gr, gr);
              float o[8];
#pragma unroll
              for (int i = 0; i < 8; ++i) {
                  const float yn = (y[i] - mean) * rstd * lnw[i] + lnb[i];
                  const float yr = (yn + S3 * vs[i]) * gg[i];
                  const float yc = gb[i] * (cw0[i] * (cm[i] * xm[i]) + cw1[i] * (cc[i] * xx[i]) + cw2[i] * (cp[i] * xp[i]));
                  o[i] = fsig(ga[i]) * yr + fsig(gr[i]) * yc;
              }
              v4u ov; ov.x = cvtpk(o[0], o[1]); ov.y = cvtpk(o[2], o[3]); ov.z = cvtpk(o[4], o[5]); ov.w = cvtpk(o[6], o[7]);
              *(v4u*)(MG + (size_t)row * D + c0) = ov;
            }
        }
        __syncthreads();
        if (!IS_CO) {
            if (cv_strip < NE * 64) { int e_, n0_, rb_; wei_strip(cv_strip, e_, n0_, rb_);
                if (cv_kb == 0) cv_scale_q8(cv_w + (size_t)e_ * D * 2048, 2048, n0_, (float*)(F.ws + MI_CSWEI) + (size_t)e_ * 2048, rb_, lane, civ);
                cv_store_q8(cvt, cv_scr, (signed char*)(F.ws + WS_WEIN) + (size_t)e_ * 2048 * D, rb_, cv_kb, civ, lane); }
            ++cv_t;
            __syncthreads();
        }
    }
    if (!IS_CO) {
        for (;;) { const int s_ = F.gw + (cv_t >> 4) * F.NGW, kb_ = cv_t & 15; if (s_ >= NE * 64) break;
            int e_, n0_, rb_; wei_strip(s_, e_, n0_, rb_);
            if (kb_ == 0) cv_scale_q8(cv_w + (size_t)e_ * D * 2048, 2048, n0_, (float*)(F.ws + MI_CSWEI) + (size_t)e_ * 2048, rb_, F.lane, civ);
            cv_load(cvt, cv_w + (size_t)e_ * D * 2048, 2048, n0_, kb_, F.lane);
            cv_store_q8(cvt, cv_scr, (signed char*)(F.ws + WS_WEIN) + (size_t)e_ * 2048 * D, rb_, kb_, civ, F.lane); ++cv_t; }
    }
#undef SL
}

typedef short s16x4 __attribute__((ext_vector_type(4)));
__device__ __forceinline__ bf16x8 ldfragT(const LAS unsigned char* t, int c, int ks, int lane) {
    const int g = lane >> 4, q = (lane & 15) >> 2, p = lane & 3;
    const int r0 = 32 * ks + 8 * g + q, r1 = r0 + 4;
    const s16x4 a = __builtin_amdgcn_ds_read_tr16_b64_v4i16((LAS s16x4*)(t + r0 * 128 + (((2 * c + (p >> 1)) ^ swz(r0)) << 4) + 8 * (p & 1)));
    const s16x4 b = __builtin_amdgcn_ds_read_tr16_b64_v4i16((LAS s16x4*)(t + r1 * 128 + (((2 * c + (p >> 1)) ^ swz(r1)) << 4) + 8 * (p & 1)));
    return (bf16x8){a[0], a[1], a[2], a[3], b[0], b[1], b[2], b[3]};
}
__device__ __forceinline__ f32x4 loadN_acc(const LAS unsigned char* t, int b, int ct, int lane) {
    const int g = lane >> 4, q = (lane & 15) >> 2, p = lane & 3;
    const int r0 = 16 * b + 4 * g + q;
    const s16x4 a = __builtin_amdgcn_ds_read_tr16_b64_v4i16((LAS s16x4*)(t + r0 * 128 + (((2 * ct + (p >> 1)) ^ swz(r0)) << 4) + 8 * (p & 1)));
    return (f32x4){bf1((bf16)a[0]), bf1((bf16)a[1]), bf1((bf16)a[2]), bf1((bf16)a[3])};
}
template <bool LT, bool RT>
__device__ __forceinline__ void mm64x(f32x4 (&acc)[4], const LAS unsigned char* Lt, const LAS unsigned char* Rt, int wq, int lane) {
    const int lr = lane & 15, g = lane >> 4;
    const bf16x8 l0 = LT ? ldfragT(Lt, wq, 0, lane) : ldfrag(Lt, 16 * wq + lr, g), l1 = LT ? ldfragT(Lt, wq, 1, lane) : ldfrag(Lt, 16 * wq + lr, 4 + g);
#pragma unroll
    for (int n = 0; n < 4; ++n) {
        const bf16x8 r0 = RT ? ldfragT(Rt, n, 0, lane) : ldfrag(Rt, 16 * n + lr, g), r1 = RT ? ldfragT(Rt, n, 1, lane) : ldfrag(Rt, 16 * n + lr, 4 + g);
        acc[n] = CK_MFMA(l0, r0, acc[n]); acc[n] = CK_MFMA(l1, r1, acc[n]);
    }
}

__device__ __forceinline__ void phase_cp2(Frame& F) {
    const int wave = F.wave;
    const int dgrp = wave >> 2, wq = wave & 3;
    LAS unsigned char* tl = F.lds + dgrp * 9 * TILE;
#define SL(k) (tl + (k) * TILE)
    LAS float* SEG = (LAS float*)(F.lds + LDS_X_OFF);
    LAS float* GAM = SEG + 1024;
    LAS unsigned char* DIB = (LAS unsigned char*)(GAM + 128) + dgrp * 2048;
    LAS float* LW0 = (LAS float*)(F.lds + 7 * TILE);
    LAS float* LW1 = (LAS float*)(F.lds + 16 * TILE);
    const bf16* z = (const bf16*)(F.ws + WS_Z); const bf16* LO = (const bf16*)(F.ws + WS_LORA);
    unsigned char* PQ = F.ws + WS_PQ; unsigned char* RHAT = F.ws + WS_TKN; unsigned char* YLOC = F.ws + WS_UPRE;
    float* BON = (float*)(F.ws + MI_BON);
    const float* p_mu = KIN(I_MU); const float* p_kk = KIN(I_KK); const float* p_ka = KIN(I_KA); const float* p_rk = KIN(I_RK);
    constexpr int NU = NU_ALL;
    EPre<true> PF;
    CvTile cvt; float civ[4] = {0.f, 0.f, 0.f, 0.f}; int cv_t = 0;
    const float* cv_w = KIN(I_WEI);
    LAS float* cv_scr = (LAS float*)(F.lds + wave * 16384);
    if ((int)blockIdx.x < NU) epre_load<true>(PF, z, LO, (int)blockIdx.x, wave, F.lane);
    if (F.gw < NE * 64) { int e_, n0_, rb_; wei_strip(F.gw, e_, n0_, rb_);
        cv_scale_q8(cv_w + (size_t)e_ * D * 2048, 2048, n0_, (float*)(F.ws + MI_CSWEI) + (size_t)e_ * 2048, rb_, F.lane, civ); }
    for (int unit = blockIdx.x; unit < NU; unit += F.G) {
        int lane = F.lane; asm volatile("" : "+v"(lane));
        const int lr = lane & 15, g = lane >> 4;
        int b, h, rowbase; unit_decode(unit, b, h, rowbase);
        const int tok = 8 * wave + (lane >> 3), oct = lane & 7, ch0 = 8 * oct, c0 = h * 64 + ch0;
        float ks[8], vs[8], rs[8], kkp[8], lw0[8], lw1[8], kd0[8], kd1[8], a_0[8], a_1[8], ssq;
        {
            shift8(PF.k, p_mu + K_OFF + c0, ks, PF.msk); shift8(PF.v, p_mu + V_OFF + c0, vs, PF.msk); shift8(PF.r, p_mu + R_OFF + c0, rs, PF.msk);
            float kkk[8], kaa[8], rkk[8];
            unpack8(PF.lo[0], lw0); unpack8(PF.lo[1], lw1); unpack8(PF.lo[2], a_0); unpack8(PF.lo[3], a_1);
            ld8f(p_kk + c0, kkk); ld8f(p_ka + c0, kaa); ld8f(p_rk + c0, rkk);
            float ss = 0.f, bs = 0.f;
#pragma unroll
            for (int i = 0; i < 8; ++i) {
                kkp[i] = ks[i] * kkk[i]; ss += kkp[i] * kkp[i];
                kd0[i] = ks[i] * (1.0f + (a_0[i] - 1.0f) * kaa[i]); kd1[i] = ks[i] * (1.0f + (a_1[i] - 1.0f) * kaa[i]);
                bs += rs[i] * 0.5f * (kd0[i] + kd1[i]) * rkk[i];
                const int ch = ch0 + i, sw = tok ^ (4 * ((ch & 15) ^ (2 * (ch >> 4))));
                LW0[ch * 64 + sw] = lw0[i]; LW1[ch * 64 + sw] = lw1[i];
            }
            ss += __shfl_xor(ss, 1); bs += __shfl_xor(bs, 1); ss += __shfl_xor(ss, 2); bs += __shfl_xor(bs, 2); ss += __shfl_xor(ss, 4); bs += __shfl_xor(bs, 4);
            ssq = ss;
            if (oct == 0 && unit < NU_L) BON[(size_t)unit * 64 + tok] = bs;
        }
        __syncthreads();
        {
            const int ch2 = lane, seg = wave, sw = 4 * ((ch2 & 15) ^ (2 * (ch2 >> 4)));
            LAS f32x4* p0a = (LAS f32x4*)(LW0 + ch2 * 64 + ((8 * seg) ^ sw)); LAS f32x4* p0b = (LAS f32x4*)(LW0 + ch2 * 64 + ((8 * seg + 4) ^ sw));
            LAS f32x4* p1a = (LAS f32x4*)(LW1 + ch2 * 64 + ((8 * seg) ^ sw)); LAS f32x4* p1b = (LAS f32x4*)(LW1 + ch2 * 64 + ((8 * seg + 4) ^ sw));
            f32x4 a = *p0a, bq = *p0b, c = *p1a, d = *p1b;
            a.y += a.x; a.z += a.y; a.w += a.z; bq.x += a.w; bq.y += bq.x; bq.z += bq.y; bq.w += bq.z;
            d.z += d.w; d.y += d.z; d.x += d.y; c.w += d.x; c.z += c.w; c.y += c.z; c.x += c.y;
            SEG[seg * 64 + ch2] = bq.w; SEG[(8 + seg) * 64 + ch2] = c.x;
            __syncthreads();
            float off0 = 0.f, off1 = 0.f;
#pragma unroll
            for (int s2 = 0; s2 < 8; ++s2) { const float t0 = SEG[s2 * 64 + ch2], t1 = SEG[(8 + s2) * 64 + ch2]; off0 += (s2 < seg) ? t0 : 0.f; off1 += (s2 > seg) ? t1 : 0.f; }
            *p0a = a + off0; *p0b = bq + off0; *p1a = c + off1; *p1b = d + off1;
        }
        __syncthreads();
        {
            const float inv = 1.0f / fmaxf(sqrtf(ssq), 1e-12f);
            float t8[8], u8[8], w8[8], r8v[8];
            {
                LAS unsigned char* t0 = F.lds; const int tau = tok;
                float e1[8], ei[8];
#pragma unroll
                for (int i = 0; i < 8; ++i) { const int ch = ch0 + i; const float cm = LW0[ch * 64 + (tok ^ (4 * ((ch & 15) ^ (2 * (ch >> 4)))))]; e1[i] = __expf(cm); ei[i] = __builtin_amdgcn_rcpf(e1[i]); t8[i] = kkp[i] * inv * __expf(cm - lw0[i]); }
                if (tok == 63) {
#pragma unroll
                    for (int i = 0; i < 8; ++i) GAM[ch0 + i] = e1[i]; }
#pragma unroll
                for (int i = 0; i < 8; ++i) { u8[i] = kkp[i] * inv * a_0[i] * ei[i]; w8[i] = kd0[i] * ei[i]; r8v[i] = rs[i] * e1[i]; }
                putN(t0 + 0 * TILE, tau, oct, t8); putN(t0 + 1 * TILE, tau, oct, u8); putN(t0 + 2 * TILE, tau, oct, w8); putN(t0 + 3 * TILE, tau, oct, vs); putN(t0 + 4 * TILE, tau, oct, r8v);
            }
            {
                LAS unsigned char* t1 = F.lds + 9 * TILE; const int tau = 63 - tok;
                float e1[8], ei[8];
#pragma unroll
                for (int i = 0; i < 8; ++i) { const int ch = ch0 + i; const float cm = LW1[ch * 64 + (tok ^ (4 * ((ch & 15) ^ (2 * (ch >> 4)))))]; e1[i] = __expf(cm); ei[i] = __builtin_amdgcn_rcpf(e1[i]); t8[i] = kkp[i] * inv * __expf(cm - lw1[i]); }
                if (tok == 0) {
#pragma unroll
                    for (int i = 0; i < 8; ++i) GAM[64 + ch0 + i] = e1[i]; }
#pragma unroll
                for (int i = 0; i < 8; ++i) { u8[i] = kkp[i] * inv * a_1[i] * ei[i]; w8[i] = kd1[i] * ei[i]; r8v[i] = rs[i] * e1[i]; }
                putN(t1 + 0 * TILE, tau, oct, t8); putN(t1 + 1 * TILE, tau, oct, u8); putN(t1 + 2 * TILE, tau, oct, w8); putN(t1 + 3 * TILE, tau, oct, vs); putN(t1 + 4 * TILE, tau, oct, r8v);
            }
        }
        const size_t inst = (size_t)unit * 2 + dgrp;
        epre_load<true>(PF, z, LO, unit + F.G < NU ? unit + F.G : unit, wave, lane);
        const int cv_strip = F.gw + (cv_t >> 4) * F.NGW, cv_kb = cv_t & 15;
        { int e_, n0_, rb_; wei_strip(cv_strip < NE * 64 ? cv_strip : 0, e_, n0_, rb_); cv_load(cvt, cv_w + (size_t)e_ * D * 2048, 2048, n0_, cv_kb, lane); }
        __syncthreads();
        f32x4 acc[4], acc2[4];
        zero4(acc); mm64x<false, false>(acc, SL(1), SL(0), wq, lane);
        zero4(acc2); mm64x<false, false>(acc2, SL(2), SL(0), wq, lane);
#pragma unroll
        for (int n = 0; n < 4; ++n)
#pragma unroll
            for (int q = 0; q < 4; ++q) { const bool lo = (16 * wq + 4 * g + q < 16 * n + lr); acc[n][q] = lo ? acc[n][q] : 0.f; acc2[n][q] = lo ? acc2[n][q] : 0.f; }
        storeT(SL(5), acc, wq, lane); storeT(SL(6), acc2, wq, lane);
        __syncthreads();
        zero4(acc); mm64x<false, true>(acc, SL(6), SL(3), wq, lane); storeT(SL(7), acc, wq, lane);
        if (wq == 0) {
            const int bb = lane >> 4, jj = lane & 15;
            float X[16];
            X[0] = (jj == 0) ? 1.f : 0.f;
#pragma unroll
            for (int t = 1; t < 16; ++t) {
                const int row = 16 * bb + t;
                const v4u p0 = *(const LAS v4u*)(SL(5) + row * 128 + (((2 * bb) ^ swz(row)) << 4)), p1 = *(const LAS v4u*)(SL(5) + row * 128 + (((2 * bb + 1) ^ swz(row)) << 4));
                float rw[16];
                rw[0] = bflo(p0.x); rw[1] = bfhi(p0.x); rw[2] = bflo(p0.y); rw[3] = bfhi(p0.y); rw[4] = bflo(p0.z); rw[5] = bfhi(p0.z); rw[6] = bflo(p0.w); rw[7] = bfhi(p0.w);
                rw[8] = bflo(p1.x); rw[9] = bfhi(p1.x); rw[10] = bflo(p1.y); rw[11] = bfhi(p1.y); rw[12] = bflo(p1.z); rw[13] = bfhi(p1.z); rw[14] = bflo(p1.w); rw[15] = bfhi(p1.w);
                float xv = (t == jj) ? 1.f : 0.f;
#pragma unroll
                for (int s = 0; s < t; ++s) xv -= rw[s] * X[s];
                X[t] = xv;
            }
#pragma unroll
            for (int t = 0; t < 16; ++t) *(LAS unsigned short*)(DIB + (((bb * 16 + t) * 16 + jj) << 1)) = (unsigned short)f2bf(X[t]);
        }
        __syncthreads();
        {
            const bool isU = wq >= 2; const int cbase = 32 * (wq & 1);
            LAS unsigned char* outT = isU ? SL(6) : SL(8);
#pragma unroll
            for (int ct = 0; ct < 2; ++ct) {
                const int ctile = 2 * (wq & 1) + ct, col = cbase + 16 * ct + lr;
                f32x4 X[4];
#pragma unroll
                for (int b2 = 0; b2 < 4; ++b2) {
                    f32x4 Zt;
                    if (isU) { const v2u rwv = *(const LAS v2u*)(SL(7) + toff(col, 16 * b2 + 4 * g)); Zt = (f32x4){bflo(rwv.x), bfhi(rwv.x), bflo(rwv.y), bfhi(rwv.y)}; }
                    else Zt = loadN_acc(SL(0), b2, ctile, lane);
                    if (b2 >= 1) {
                        f32x4 Y = {0.f, 0.f, 0.f, 0.f};
#pragma unroll
                        for (int s = 0; s < (b2 + 1) / 2; ++s) {
                            v2u alo = {0u, 0u}, ahi = {0u, 0u};
                            if (2 * s < b2) alo = *(const LAS v2u*)(SL(5) + toff(16 * b2 + lr, 32 * s + 4 * g));
                            if (2 * s + 1 < b2) ahi = *(const LAS v2u*)(SL(5) + toff(16 * b2 + lr, 32 * s + 16 + 4 * g));
                            v4u bw = {cvtpk(X[2 * s][0], X[2 * s][1]), cvtpk(X[2 * s][2], X[2 * s][3]), 0u, 0u};
                            if (2 * s + 1 < b2) { bw.z = cvtpk(X[2 * s + 1][0], X[2 * s + 1][1]); bw.w = cvtpk(X[2 * s + 1][2], X[2 * s + 1][3]); }
                            Y = CK_MFMA(__builtin_bit_cast(bf16x8, ((v4u){alo.x, alo.y, ahi.x, ahi.y})), __builtin_bit_cast(bf16x8, bw), Y);
                        }
                        Zt = Zt - Y;
                    }
                    const v2u dv = *(const LAS v2u*)(DIB + (((b2 * 16 + lr) * 16 + 4 * g) << 1));
                    const v4u bz = {cvtpk(Zt[0], Zt[1]), cvtpk(Zt[2], Zt[3]), 0u, 0u};
                    X[b2] = CK_MFMA(__builtin_bit_cast(bf16x8, ((v4u){dv.x, dv.y, 0u, 0u})), __builtin_bit_cast(bf16x8, bz), ((f32x4){0.f, 0.f, 0.f, 0.f}));
                }
#pragma unroll
                for (int b2 = 0; b2 < 4; ++b2) *(LAS v2u*)(outT + toff(col, 16 * b2 + 4 * g)) = (v2u){cvtpk(X[b2][0], X[b2][1]), cvtpk(X[b2][2], X[b2][3])};
            }
        }
        __syncthreads();
        asm volatile("" : "+v"(PF.k[0]), "+v"(PF.k[1]), "+v"(PF.k[2]), "+v"(PF.k[3]), "+v"(PF.k[4]), "+v"(PF.v[0]), "+v"(PF.v[1]), "+v"(PF.v[2]), "+v"(PF.v[3]), "+v"(PF.v[4]));
        asm volatile("" : "+v"(PF.r[0]), "+v"(PF.r[1]), "+v"(PF.r[2]), "+v"(PF.r[3]), "+v"(PF.r[4]), "+v"(PF.lo[0]), "+v"(PF.lo[1]), "+v"(PF.lo[2]), "+v"(PF.lo[3]));
        asm volatile("" : "+v"(cvt.v[0]), "+v"(cvt.v[1]), "+v"(cvt.v[2]), "+v"(cvt.v[3]), "+v"(cvt.v[4]), "+v"(cvt.v[5]), "+v"(cvt.v[6]), "+v"(cvt.v[7]));
        {
            zero4(acc); mm64x<false, true>(acc, SL(8), SL(1), wq, lane);
            const int cstep_ = unit < NU_L ? 4 + (dgrp ? 127 - ((unit >> 4) & 127) : ((unit >> 4) & 127)) : (dgrp ? 3 - (((unit - NU_L) >> 4) & 3) : (((unit - NU_L) >> 4) & 3));
            unsigned char* pb = PQ + (size_t)(((b * 16 + h) * 2 + dgrp) * (4 + T / 64) + cstep_) * 16384;
#pragma unroll
            for (int n = 0; n < 4; ++n) { const int k = 16 * n + lr; const float gm = GAM[dgrp * 64 + k]; float p[4];
#pragma unroll
                for (int q = 0; q < 4; ++q) p[q] = gm * (((16 * wq + 4 * g + q) == k ? 1.f : 0.f) - acc[n][q]);
                *(uint2*)(pb + (size_t)(((n * 2 + (wq >> 1)) * 64 + lane) * 16 + (wq & 1) * 8)) = make_uint2(cvtpk(p[0], p[1]), cvtpk(p[2], p[3])); }
            zero4(acc); mm64x<true, true>(acc, SL(2), SL(3), wq, lane); zero4(acc2); mm64x<true, false>(acc2, SL(1), SL(6), wq, lane);
            const f32x4 gm4 = *(const LAS f32x4*)(GAM + dgrp * 64 + 16 * wq + 4 * g);
#pragma unroll
            for (int n = 0; n < 4; ++n) { const f32x4 qv = (acc[n] - acc2[n]) * gm4;
                *(uint2*)(pb + 8192 + (size_t)(((n * 64 + lane) * 4 + wq) * 8)) = make_uint2(cvtpk(qv[0], qv[1]), cvtpk(qv[2], qv[3])); }
            if (unit < NU_L) {
                zero4(acc); mm64x<false, false>(acc, SL(2), SL(4), wq, lane);
                zero4(acc2); mm64x<false, false>(acc2, SL(1), SL(4), wq, lane);
#pragma unroll
                for (int n = 0; n < 4; ++n)
#pragma unroll
                    for (int q = 0; q < 4; ++q) { const bool le = (16 * wq + 4 * g + q <= 16 * n + lr); acc[n][q] = le ? acc[n][q] : 0.f; acc2[n][q] = le ? -acc2[n][q] : 0.f; }
                storeT(SL(5), acc, wq, lane); storeT(SL(7), acc2, wq, lane);
            }
        }
        __syncthreads();
        if (unit < NU_L) {
            loadT(acc, SL(4), wq, lane);
            mm64x<false, false>(acc, SL(8), SL(7), wq, lane);
            unsigned char* rb = RHAT + inst * 8192;
#pragma unroll
            for (int n = 0; n < 4; ++n) *(uint2*)(rb + (size_t)((16 * n + lr) * 64 + 16 * wq + 4 * g) * 2) = make_uint2(cvtpk(acc[n][0], acc[n][1]), cvtpk(acc[n][2], acc[n][3]));
            zero4(acc2); mm64x<false, true>(acc2, SL(5), SL(3), wq, lane); mm64x<false, false>(acc2, SL(7), SL(6), wq, lane);
            unsigned char* yb = YLOC + inst * 8192 + (size_t)((wq * 64 + lane) * 32);
            v4u o0, o1; o0.x = cvtpk(acc2[0][0], acc2[0][1]); o0.y = cvtpk(acc2[0][2], acc2[0][3]); o0.z = cvtpk(acc2[1][0], acc2[1][1]); o0.w = cvtpk(acc2[1][2], acc2[1][3]);
            o1.x = cvtpk(acc2[2][0], acc2[2][1]); o1.y = cvtpk(acc2[2][2], acc2[2][3]); o1.z = cvtpk(acc2[3][0], acc2[3][1]); o1.w = cvtpk(acc2[3][2], acc2[3][3]);
            *(v4u*)yb = o0; *(v4u*)(yb + 16) = o1;
        }
        __syncthreads();
        {
            if (cv_strip < NE * 64) { int e_, n0_, rb_; wei_strip(cv_strip, e_, n0_, rb_);
                if (cv_kb == 0 && cv_t > 0) cv_scale_q8(cv_w + (size_t)e_ * D * 2048, 2048, n0_, (float*)(F.ws + MI_CSWEI) + (size_t)e_ * 2048, rb_, lane, civ);
                cv_store_q8(cvt, cv_scr, (signed char*)(F.ws + WS_WEIN) + (size_t)e_ * 2048 * D, rb_, cv_kb, civ, lane); }
            ++cv_t;
            __syncthreads();
        }
    }
    for (;;) { const int s_ = F.gw + (cv_t >> 4) * F.NGW, kb_ = cv_t & 15; if (s_ >= NE * 64) break;
        int e_, n0_, rb_; wei_strip(s_, e_, n0_, rb_);
        if (kb_ == 0 && cv_t > 0) cv_scale_q8(cv_w + (size_t)e_ * D * 2048, 2048, n0_, (float*)(F.ws + MI_CSWEI) + (size_t)e_ * 2048, rb_, F.lane, civ);
        cv_load(cvt, cv_w + (size_t)e_ * D * 2048, 2048, n0_, kb_, F.lane);
        cv_store_q8(cvt, cv_scr, (signed char*)(F.ws + WS_WEIN) + (size_t)e_ * 2048 * D, rb_, kb_, civ, F.lane); ++cv_t; }
#undef SL
}

__device__ __forceinline__ void phase_co2(Frame& F) {
    const int wave = F.wave;
    const int dgrp = wave >> 2, wq = wave & 3;
    LAS unsigned char* tl = F.lds + dgrp * 9 * TILE;
#define SL(k) (tl + (k) * TILE)
    const bf16* z = (const bf16*)(F.ws + WS_Z); const bf16* LO = (const bf16*)(F.ws + WS_LORA);
    const unsigned char* RHAT = F.ws + WS_TKN; const unsigned char* YLOC = F.ws + WS_UPRE; const unsigned char* H0T = F.ws + WS_H0T;
    const float* BON = (const float*)(F.ws + MI_BON);
    bf16* MG = (bf16*)(F.ws + WS_A0);
    const float* p_mu = KIN(I_MU);
    for (int unit = blockIdx.x; unit < NU_L; unit += F.G) {
        int lane = F.lane; asm volatile("" : "+v"(lane));
        const int lr = lane & 15, g = lane >> 4;
        int b, h, rowbase; unit_decode(unit, b, h, rowbase);
        const int tok = 8 * wave + (lane >> 3), oct = lane & 7, ch0 = 8 * oct, c0 = h * 64 + ch0, row = rowbase + tok;
        const size_t inst = (size_t)unit * 2 + dgrp;
        const int t2 = (wq << 6) | lane;
#pragma unroll
        for (int rep = 0; rep < 2; ++rep) { const int cidx = t2 + 256 * rep, r_ = cidx >> 3, ch = cidx & 7;
            const v4u a = *(const v4u*)(RHAT + inst * 8192 + (size_t)(r_ * 64 + ch * 8) * 2), hh = *(const v4u*)(H0T + inst * 8192 + (size_t)(r_ * 64 + ch * 8) * 2);
            *(LAS v4u*)(SL(0) + r_ * 128 + ((ch ^ swz(r_)) << 4)) = a; *(LAS v4u*)(SL(1) + r_ * 128 + ((ch ^ swz(r_)) << 4)) = hh; }
        f32x4 acc[4];
        { const unsigned char* yb = YLOC + inst * 8192 + (size_t)((wq * 64 + lane) * 32); const v4u o0 = *(const v4u*)yb, o1 = *(const v4u*)(yb + 16);
          acc[0] = (f32x4){bflo(o0.x), bfhi(o0.x), bflo(o0.y), bfhi(o0.y)}; acc[1] = (f32x4){bflo(o0.z), bfhi(o0.z), bflo(o0.w), bfhi(o0.w)};
          acc[2] = (f32x4){bflo(o1.x), bfhi(o1.x), bflo(o1.y), bfhi(o1.y)}; acc[3] = (f32x4){bflo(o1.z), bfhi(o1.z), bflo(o1.w), bfhi(o1.w)}; }
        const int t = row & (T - 1);
        const bf16* zr = z + (size_t)row * NZ;
        const v4u zz = {0u, 0u, 0u, 0u};
        v4u qv[5]; qv[0] = *(const v4u*)(zr + V_OFF + c0);
#pragma unroll
        for (int j = 0; j < 4; ++j) { const int nr = nbr_row(row, j); qv[1 + j] = nr >= 0 ? *(const v4u*)(z + (size_t)nr * NZ + V_OFF + c0) : zz; }
        const v4u q_g = *(const v4u*)(LO + (size_t)row * NL + 4096 + c0);
        const v4u q_gb = *(const v4u*)(zr + CONV_OFF + c0), q_c0 = *(const v4u*)(zr + CONV_OFF + 1024 + c0), q_x0 = *(const v4u*)(zr + CONV_OFF + 2048 + c0);
        const v4u q_cm = t > 0 ? *(const v4u*)(zr - NZ + CONV_OFF + 1024 + c0) : zz, q_xm = t > 0 ? *(const v4u*)(zr - NZ + CONV_OFF + 2048 + c0) : zz;
        const v4u q_cp = t < T - 1 ? *(const v4u*)(zr + NZ + CONV_OFF + 1024 + c0) : zz, q_xp = t < T - 1 ? *(const v4u*)(zr + NZ + CONV_OFF + 2048 + c0) : zz;
        const v4u q_ga = *(const v4u*)(zr + GATE_OFF + c0), q_gr = *(const v4u*)(zr + GATE_OFF + 1024 + c0);
        const float S3 = BON[(size_t)unit * 64 + tok];
        __syncthreads();
        mm64x<false, false>(acc, SL(0), SL(1), wq, lane);
        { LAS float* Yf = (LAS float*)(tl + 2 * TILE);
#pragma unroll
          for (int n = 0; n < 4; ++n)
#pragma unroll
              for (int q = 0; q < 4; ++q) { const int tau = 16 * wq + 4 * g + q; Yf[tau * 64 + ((16 * n + lr) ^ (4 * (tau & 15)))] = acc[n][q]; } }
        __syncthreads();
        { const LAS float* Y0 = (const LAS float*)(F.lds + 2 * TILE); const LAS float* Y1 = (const LAS float*)(F.lds + 11 * TILE);
          float y[8];
          { const int s0 = 4 * (tok & 15), s1 = 4 * ((63 - tok) & 15);
            const f32x4 a0 = *(const LAS f32x4*)(Y0 + tok * 64 + (ch0 ^ s0)), a1 = *(const LAS f32x4*)(Y0 + tok * 64 + ((ch0 + 4) ^ s0));
            const f32x4 b0 = *(const LAS f32x4*)(Y1 + (63 - tok) * 64 + (ch0 ^ s1)), b1 = *(const LAS f32x4*)(Y1 + (63 - tok) * 64 + ((ch0 + 4) ^ s1));
            y[0] = a0.x + b0.x; y[1] = a0.y + b0.y; y[2] = a0.z + b0.z; y[3] = a0.w + b0.w; y[4] = a1.x + b1.x; y[5] = a1.y + b1.y; y[6] = a1.z + b1.z; y[7] = a1.w + b1.w; }
          float s1 = 0.f, s2 = 0.f;
#pragma unroll
          for (int i = 0; i < 8; ++i) { s1 += y[i]; s2 += y[i] * y[i]; }
          s1 += __shfl_xor(s1, 1); s2 += __shfl_xor(s2, 1); s1 += __shfl_xor(s1, 2); s2 += __shfl_xor(s2, 2); s1 += __shfl_xor(s1, 4); s2 += __shfl_xor(s2, 4);
          const float mean = s1 * (1.0f / 64.0f), var = fmaxf(s2 * (1.0f / 64.0f) - mean * mean, 0.f), rstd = __builtin_amdgcn_rsqf(var + 64e-5f);
          float vs[8]; shift8(qv, p_mu + V_OFF + c0, vs);
          float lnw[8], lnb[8], cw0[8], cw1[8], cw2[8];
          ld8f(KIN(I_LNW) + c0, lnw); ld8f(KIN(I_LNB) + c0, lnb); ld8f(KIN(I_CONVW) + c0, cw0); ld8f(KIN(I_CONVW) + D + c0, cw1); ld8f(KIN(I_CONVW) + 2 * D + c0, cw2);
          float gg[8], gb[8], cc[8], xx[8], cm[8], xm[8], cp[8], xp[8], ga[8], gr[8];
          unpack8(q_g, gg); unpack8(q_gb, gb); unpack8(q_c0, cc); unpack8(q_x0, xx); unpack8(q_cm, cm); unpack8(q_xm, xm); unpack8(q_cp, cp); unpack8(q_xp, xp); unpack8(q_ga, ga); unpack8(q_gr, gr);
          float o[8];
#pragma unroll
          for (int i = 0; i < 8; ++i) {
              const float yn = (y[i] - mean) * rstd * lnw[i] + lnb[i];
              const float yr = (yn + S3 * vs[i]) * gg[i];
              const float yc = gb[i] * (cw0[i] * (cm[i] * xm[i]) + cw1[i] * (cc[i] * xx[i]) + cw2[i] * (cp[i] * xp[i]));
              o[i] = fsig(ga[i]) * yr + fsig(gr[i]) * yc;
          }
          v4u ov; ov.x = cvtpk(o[0], o[1]); ov.y = cvtpk(o[2], o[3]); ov.z = cvtpk(o[4], o[5]); ov.w = cvtpk(o[6], o[7]);
          *(v4u*)(MG + (size_t)row * D + c0) = ov;
        }
        __syncthreads();
    }
#undef SL
}

struct SSIn { v4u a[8]; v4u q[2]; };
__device__ __forceinline__ size_t ss_pq(int step, int b, int h, int d) { return (size_t)(((b * 16 + h) * 2 + d) * (4 + T / 64) + step); }
__device__ __forceinline__ size_t ss_inst(int step, int b, int h, int d) {
    int unit;
    if (step < 4) { const int cb = d ? 3 - step : step; unit = NU_L + (b * 4 + cb) * 16 + h; }
    else { const int blk = d ? 127 - (step - 4) : step - 4; unit = (b * 128 + blk) * 16 + h; }
    return (size_t)unit * 2 + d;
}
__device__ __forceinline__ void ss_load(SSIn& I, const unsigned char* PQ, size_t inst, int wv, int lane) {
    const unsigned char* pb = PQ + inst * 16384;
#pragma unroll
    for (int f = 0; f < 8; ++f) I.a[f] = *(const v4u*)(pb + (size_t)((f * 64 + lane) * 16));
    I.q[0] = *(const v4u*)(pb + 8192 + (size_t)((wv * 64 + lane) * 32)); I.q[1] = *(const v4u*)(pb + 8192 + (size_t)((wv * 64 + lane) * 32 + 16));
}
__device__ __forceinline__ void ss_step(f32x4 (&H)[4], const SSIn& cur, unsigned char* H0T, size_t inst, bool store_h0, int wv, int lr, int g) {
    const unsigned p00 = cvtpk(H[0][0], H[0][1]), p01 = cvtpk(H[0][2], H[0][3]), p10 = cvtpk(H[1][0], H[1][1]), p11 = cvtpk(H[1][2], H[1][3]);
    const unsigned p20 = cvtpk(H[2][0], H[2][1]), p21 = cvtpk(H[2][2], H[2][3]), p30 = cvtpk(H[3][0], H[3][1]), p31 = cvtpk(H[3][2], H[3][3]);
    if (store_h0) { unsigned char* hb = H0T + inst * 8192 + (size_t)((16 * wv + lr) * 64 + 4 * g) * 2;
        *(uint2*)(hb) = make_uint2(p00, p01); *(uint2*)(hb + 32) = make_uint2(p10, p11); *(uint2*)(hb + 64) = make_uint2(p20, p21); *(uint2*)(hb + 96) = make_uint2(p30, p31); }
    const bf16x8 b0 = __builtin_bit_cast(bf16x8, ((v4u){p00, p01, p10, p11})), b1 = __builtin_bit_cast(bf16x8, ((v4u){p20, p21, p30, p31}));
    H[0] = (f32x4){bflo(cur.q[0].x), bfhi(cur.q[0].x), bflo(cur.q[0].y), bfhi(cur.q[0].y)}; H[1] = (f32x4){bflo(cur.q[0].z), bfhi(cur.q[0].z), bflo(cur.q[0].w), bfhi(cur.q[0].w)};
    H[2] = (f32x4){bflo(cur.q[1].x), bfhi(cur.q[1].x), bflo(cur.q[1].y), bfhi(cur.q[1].y)}; H[3] = (f32x4){bflo(cur.q[1].z), bfhi(cur.q[1].z), bflo(cur.q[1].w), bfhi(cur.q[1].w)};
#pragma unroll
    for (int m = 0; m < 4; ++m) { H[m] = CK_MFMA(__builtin_bit_cast(bf16x8, cur.a[2 * m]), b0, H[m]); H[m] = CK_MFMA(__builtin_bit_cast(bf16x8, cur.a[2 * m + 1]), b1, H[m]); }
}
__device__ __forceinline__ void phase_ss(Frame& F) {
    const unsigned char* PQ = F.ws + WS_PQ; unsigned char* H0T = F.ws + WS_H0T;
    const int lane = F.lane, lr = lane & 15, g = lane >> 4;
    for (int task = (int)blockIdx.x; task < 256; task += F.G) {
        const int chain = task >> 2, wv = task & 3, b = chain >> 5, h = (chain >> 1) & 15, d = chain & 1;
        f32x4 H[4]; zero4(H);
        constexpr int NS = 4 + T / 64;
        static_assert(NS % 4 == 0, "unrolled by four");
        SSIn b0, b1, b2, b3;
        ss_load(b0, PQ, ss_pq(0, b, h, d), wv, lane); ss_load(b1, PQ, ss_pq(1, b, h, d), wv, lane); ss_load(b2, PQ, ss_pq(2, b, h, d), wv, lane); ss_load(b3, PQ, ss_pq(3, b, h, d), wv, lane);
        for (int step = 0; step < NS; step += 4) {
            const int n0 = step + 4 < NS ? step + 4 : NS - 1, n1 = step + 5 < NS ? step + 5 : NS - 1, n2 = step + 6 < NS ? step + 6 : NS - 1, n3 = step + 7 < NS ? step + 7 : NS - 1;
            ss_step(H, b0, H0T, ss_inst(step, b, h, d), step >= 4, wv, lr, g);     ss_load(b0, PQ, ss_pq(n0, b, h, d), wv, lane);
            ss_step(H, b1, H0T, ss_inst(step + 1, b, h, d), step >= 4, wv, lr, g); ss_load(b1, PQ, ss_pq(n1, b, h, d), wv, lane);
            ss_step(H, b2, H0T, ss_inst(step + 2, b, h, d), step >= 4, wv, lr, g); ss_load(b2, PQ, ss_pq(n2, b, h, d), wv, lane);
            ss_step(H, b3, H0T, ss_inst(step + 3, b, h, d), step >= 4, wv, lr, g); ss_load(b3, PQ, ss_pq(n3, b, h, d), wv, lane);
        }
    }
}

__device__ __forceinline__ void lora_atile(const bf16* z, const float* p_mu, LAS unsigned char* lds, int r0, int gi, int wave, int lane) {
    const int tok = 8 * wave + (lane >> 3), oct = lane & 7, row = r0 + tok;
    const v4u zz = {0u, 0u, 0u, 0u};
    const int col = (gi < 4 ? DECAY_OFF + 64 * gi : GLORA_OFF + 64 * (gi - 4)) + 8 * oct;
    v4u q[5]; q[0] = *(const v4u*)(z + (size_t)row * NZ + col);
#pragma unroll
    for (int j = 0; j < 4; ++j) { const int nr = nbr_row(row, j); q[1 + j] = nr >= 0 ? *(const v4u*)(z + (size_t)nr * NZ + col) : zz; }
    float v[8]; shift8(q, p_mu + col, v);
#pragma unroll
    for (int i = 0; i < 8; ++i) v[i] = gi < 2 ? 1.0f - 2.0f * __builtin_amdgcn_rcpf(1.0f + __expf(2.0f * v[i])) : (gi < 4 ? v[i] : fsig(v[i]));
    putN(lds + gi * TILE, tok, oct, v);
}
template <int KS> struct LoraB { bf16x8 w[KS][4]; };
template <int KS>
__device__ __forceinline__ void lora_bload(LoraB<KS>& B, const bf16* WL, int q, int lr, int g) {
    const int blkid = q >> 4, h = q & 15;
    const bf16* wrow = WL + (size_t)(blkid * 1024 + h * 64 + 8 * (lr >> 2) + (lr & 3)) * KL + blkid * 64 + 8 * g;
#pragma unroll
    for (int s = 0; s < KS; ++s)
#pragma unroll
        for (int n = 0; n < 4; ++n) B.w[s][n] = *(const bf16x8*)(wrow + (size_t)(32 * (n >> 1) + 4 * (n & 1)) * KL + 32 * s);
}
template <int KS>
__device__ __forceinline__ void lora_product(const LoraB<KS>& B, const LAS unsigned char* At, bf16* LO, int r0, int q, int lr, int g, const float* p_w0, const float* p_a0) {
    const int blkid = q >> 4, h = q & 15;
    f32x4 acc[4][4];
#pragma unroll
    for (int n = 0; n < 4; ++n)
#pragma unroll
        for (int m = 0; m < 4; ++m) acc[n][m] = (f32x4){0.f, 0.f, 0.f, 0.f};
#pragma unroll
    for (int s = 0; s < KS; ++s) {
        bf16x8 af[4];
#pragma unroll
        for (int m = 0; m < 4; ++m) af[m] = ldfrag(At + (s >> 1) * TILE, 16 * m + lr, 4 * (s & 1) + g);
#pragma unroll
        for (int n = 0; n < 4; ++n)
#pragma unroll
            for (int m = 0; m < 4; ++m) acc[n][m] = CK_MFMA(B.w[s][n], af[m], acc[n][m]);
    }
    bf16* ob = LO + (size_t)(r0 + lr) * NL + blkid * 1024 + h * 64 + 8 * g;
#pragma unroll
    for (int m = 0; m < 4; ++m)
#pragma unroll
        for (int p = 0; p < 2; ++p) {
            f32x4 v0 = acc[2 * p][m], v1 = acc[2 * p + 1][m];
            if (KS == 2) {
                const float* bp = (blkid < 2 ? p_w0 + (blkid & 1) * D : p_a0 + (blkid & 1) * D) + h * 64 + 8 * g + 32 * p;
                const f32x4 b0 = *(const f32x4*)bp, b1 = *(const f32x4*)(bp + 4); const float sc = blkid < 2 ? -0.6065306597126334f : 1.0f;
#pragma unroll
                for (int e = 0; e < 4; ++e) { v0[e] = sc * fsig(v0[e] + b0[e]); v1[e] = sc * fsig(v1[e] + b1[e]); }
            }
            v4u o; o.x = cvtpk(v0[0], v0[1]); o.y = cvtpk(v0[2], v0[3]); o.z = cvtpk(v1[0], v1[1]); o.w = cvtpk(v1[2], v1[3]);
            *(v4u*)(ob + (size_t)(16 * m) * NL + 32 * p) = o; }
}
__device__ __forceinline__ void phase_lora(Frame& F) {
    const bf16* z = (const bf16*)(F.ws + WS_Z); bf16* LO = (bf16*)(F.ws + WS_LORA); const bf16* WL = (const bf16*)(F.ws + WS_WLORA);
    const float* p_mu = KIN(I_MU); const float* p_w0 = KIN(I_W0); const float* p_a0 = KIN(I_A0);
    for (int unit = blockIdx.x; unit < ML / 64; unit += F.G) {
        int lane = F.lane; asm volatile("" : "+v"(lane));
        const int lr = lane & 15, g = lane >> 4, r0 = unit * 64;
#pragma unroll
        for (int gi = 0; gi < 6; ++gi) lora_atile(z, p_mu, F.lds, r0, gi, F.wave, lane);
        __syncthreads();
        const float* weo = KIN(I_WEO); bf16* WEO = (bf16*)(F.ws + WS_WEOUT);
        LAS float* fscr = (LAS float*)(F.lds + 6 * TILE + F.wave * 8704);
        const int ft0 = (unit * NWAVES + F.wave) * 10;
        CvTile ft;
#define LORA_FILL_LOAD(p) do { const int id_ = ft0 + (p); if (id_ < NE * 512) { const int e_ = id_ >> 9, q_ = id_ & 511; cv_load(ft, weo + (size_t)e_ * D * D, D, 32 * (q_ & 31), q_ >> 5, lane); } } while (0)
#define LORA_FILL_STORE(p) do { const int id_ = ft0 + (p); if (id_ < NE * 512) { const int e_ = id_ >> 9, q_ = id_ & 511; cv_to_lds(ft, fscr, lane); cv_store_bf16(fscr, WEO + (size_t)e_ * D * D, D, 32 * (q_ & 31), 64 * (q_ >> 5), lane); } } while (0)
        LoraB<2> b0, b1;
        lora_bload<2>(b0, WL, F.wave, lr, g);
#pragma unroll
        for (int i = 0; i < 8; i += 2) {
            lora_bload<2>(b1, WL, F.wave + 8 * (i + 1), lr, g); LORA_FILL_LOAD(i);
            lora_product<2>(b0, F.lds + ((F.wave + 8 * i) >> 4) * TILE, LO, r0, F.wave + 8 * i, lr, g, p_w0, p_a0);
            LORA_FILL_STORE(i);
            if (i + 2 < 8) lora_bload<2>(b0, WL, F.wave + 8 * (i + 2), lr, g);
            LORA_FILL_LOAD(i + 1);
            lora_product<2>(b1, F.lds + ((F.wave + 8 * (i + 1)) >> 4) * TILE, LO, r0, F.wave + 8 * (i + 1), lr, g, p_w0, p_a0);
            LORA_FILL_STORE(i + 1);
        }
        { LoraB<4> c0; lora_bload<4>(c0, WL, 64 + F.wave, lr, g); LORA_FILL_LOAD(8); lora_product<4>(c0, F.lds + 4 * TILE, LO, r0, 64 + F.wave, lr, g, p_w0, p_a0); LORA_FILL_STORE(8);
          lora_bload<4>(c0, WL, 72 + F.wave, lr, g); LORA_FILL_LOAD(9); lora_product<4>(c0, F.lds + 4 * TILE, LO, r0, 72 + F.wave, lr, g, p_w0, p_a0); LORA_FILL_STORE(9); }
#undef LORA_FILL_LOAD
#undef LORA_FILL_STORE
        __syncthreads();
    }
    for (int t = blockIdx.x; t < (MC / 64) * 32; t += F.G) {
        int lane = F.lane; asm volatile("" : "+v"(lane));
        const int lr = lane & 15, g = lane >> 4, r0 = ML + (t >> 5) * 64, q0 = 2 * (t & 31), gi = q0 >> 4;
        lora_atile(z, p_mu, F.lds, r0, gi, F.wave, lane);
        __syncthreads();
        if (F.wave < 2) { LoraB<2> b0; lora_bload<2>(b0, WL, q0 + F.wave, lr, g); lora_product<2>(b0, F.lds + gi * TILE, LO, r0, q0 + F.wave, lr, g, p_w0, p_a0); }
        __syncthreads();
    }
}

__device__ __forceinline__ void ss2_load(v4u& ra, v4u& rq, const unsigned char* PQ, size_t inst, int wv, int wave, int lane) {
    const unsigned char* pb = PQ + inst * 16384;
    ra = *(const v4u*)(pb + (size_t)((wave * 64 + lane) * 16));
    if (wave < 2) rq = *(const v4u*)(pb + 8192 + (size_t)((wv * 64 + lane) * 32 + 16 * wave));
}
__device__ __forceinline__ void phase_ss2(Frame& F) {
    const unsigned char* PQ = F.ws + WS_PQ; unsigned char* H0T = F.ws + WS_H0T;
    const int lane = F.lane, wave = F.wave, lr = lane & 15, g = lane >> 4;
    LAS unsigned char* ring = F.lds;
    constexpr int SLOT = 10240, NS = 4 + T / 64, DEPTH = 12;
    static_assert(NS % DEPTH == 0, "unrolled by DEPTH");
    for (int task = (int)blockIdx.x; task < 256; task += F.G) {
        const int chain = task >> 2, wv = task & 3, b = chain >> 5, h = (chain >> 1) & 15, d = chain & 1;
        f32x4 H[4]; zero4(H);
        v4u ra[DEPTH], rq[DEPTH];
#pragma unroll
        for (int k = 0; k < DEPTH; ++k) { rq[k] = (v4u){0u, 0u, 0u, 0u}; ss2_load(ra[k], rq[k], PQ, ss_pq(k, b, h, d), wv, wave, lane); }
        for (int step = 0; step < NS; step += DEPTH) {
#pragma unroll
            for (int k = 0; k < DEPTH; ++k) {
                const int st = step + k; LAS unsigned char* sl = ring + (st & 1) * SLOT;
                *(LAS v4u*)(sl + (wave * 64 + lane) * 16) = ra[k]; if (wave < 2) *(LAS v4u*)(sl + 8192 + (wave * 64 + lane) * 16) = rq[k];
                { const int nx = st + DEPTH < NS ? st + DEPTH : NS - 1; ss2_load(ra[k], rq[k], PQ, ss_pq(nx, b, h, d), wv, wave, lane); }
                __syncthreads();
                if (wave == 0) { SSIn cur;
#pragma unroll
                    for (int f = 0; f < 8; ++f) cur.a[f] = *(const LAS v4u*)(sl + (f * 64 + lane) * 16);
                    cur.q[0] = *(const LAS v4u*)(sl + 8192 + lane * 16); cur.q[1] = *(const LAS v4u*)(sl + 8192 + (64 + lane) * 16);
                    ss_step(H, cur, H0T, ss_inst(st, b, h, d), st >= 4, wv, lr, g); }
            }
        }
        __syncthreads();
    }
}

__device__ __forceinline__ void ss3_load(v4u& a0, v4u& a1, v2u& q, const unsigned char* PQ, size_t pq, int wv, int m, int lane) {
    const unsigned char* pb = PQ + pq * 16384;
    a0 = *(const v4u*)(pb + (size_t)(((2 * m) * 64 + lane) * 16)); a1 = *(const v4u*)(pb + (size_t)(((2 * m + 1) * 64 + lane) * 16));
    q = *(const v2u*)(pb + 8192 + (size_t)((wv * 64 + lane) * 32 + 8 * m));
}
__device__ __forceinline__ void phase_ss3(Frame& F) {
    const unsigned char* PQ = F.ws + WS_PQ; unsigned char* H0T = F.ws + WS_H0T;
    const int lane = F.lane, wave = F.wave, lr = lane & 15, g = lane >> 4, m = wave & 3;
    LAS unsigned char* xch = F.lds;
    constexpr int NS = 4 + T / 64, DEPTH = 12;
    static_assert(NS % DEPTH == 0, "unrolled by DEPTH");
    for (int task = (int)blockIdx.x; task < 256; task += F.G) {
        const int chain = task >> 2, wv = task & 3, b = chain >> 5, h = (chain >> 1) & 15, d = chain & 1;
        f32x4 H = {0.f, 0.f, 0.f, 0.f};
        v4u a0[DEPTH], a1[DEPTH]; v2u qv[DEPTH];
        if (wave < 4) {
#pragma unroll
            for (int k = 0; k < DEPTH; ++k) ss3_load(a0[k], a1[k], qv[k], PQ, ss_pq(k, b, h, d), wv, m, lane);
        }
        for (int step = 0; step < NS; step += DEPTH) {
#pragma unroll
            for (int k = 0; k < DEPTH; ++k) {
                const int st = step + k; LAS unsigned char* xs = xch + (st & 1) * 2048;
                if (wave < 4) {
                    const v2u pk = {cvtpk(H[0], H[1]), cvtpk(H[2], H[3])};
                    *(LAS v2u*)(xs + lane * 32 + 8 * m) = pk;
                    if (st >= 4) *(v2u*)(H0T + ss_inst(st, b, h, d) * 8192 + (size_t)((16 * wv + lr) * 64 + 16 * m + 4 * g) * 2) = pk;
                }
                __syncthreads();
                if (wave < 4) {
                    const v4u b0 = *(const LAS v4u*)(xs + lane * 32), b1 = *(const LAS v4u*)(xs + lane * 32 + 16);
                    f32x4 Hn = {bflo(qv[k].x), bfhi(qv[k].x), bflo(qv[k].y), bfhi(qv[k].y)};
                    Hn = CK_MFMA(__builtin_bit_cast(bf16x8, a0[k]), __builtin_bit_cast(bf16x8, b0), Hn);
                    Hn = CK_MFMA(__builtin_bit_cast(bf16x8, a1[k]), __builtin_bit_cast(bf16x8, b1), Hn);
                    H = Hn;
                    const int nx = st + DEPTH < NS ? st + DEPTH : NS - 1;
                    ss3_load(a0[k], a1[k], qv[k], PQ, ss_pq(nx, b, h, d), wv, m, lane);
                }
            }
        }
        __syncthreads();
    }
}
}
template <int PART>
__device__ __forceinline__ void phase_moe_weights(Frame& F) {
    LAS float* scr = (LAS float*)(F.lds + RING_OFF + F.wave * 16384);
    bf16* WEO = (bf16*)(F.ws + WS_WEOUT);
    constexpr int IT_IN = (D / 64) * (2048 / 32), IT_OUT = (D / 64) * (D / 32);
    if (PART == 0) {
        const float* wei = KIN(I_WEI);
        const int nstat = F.G * 7;
        int it = (int)blockIdx.x * 7 + F.wave - 1;
        while (it < NE * 128) {
            const int half = it & 1, r = it >> 1, e = r >> 6, n0 = 32 * (r & 63);
            const int c = n0 & 1023, rowbase = (c >> 7) * 256 + (n0 >= 1024 ? 128 : 0) + (c & 127);
            q8_item(wei + (size_t)e * D * 2048, 2048, n0, (signed char*)(F.ws + WS_WEIN) + (size_t)e * 2048 * D, (float*)(F.ws + MI_CSWEI) + (size_t)e * 2048, rowbase, scr, F.lane, 8 * half, 8 * half + 8);
            int nx = 0; if (F.lane == 0) nx = (int)__hip_atomic_fetch_add(F.ctl + CW_Q6, 1u, __ATOMIC_RELAXED, __HIP_MEMORY_SCOPE_AGENT);
            it = nstat + __builtin_amdgcn_readfirstlane(nx);
        }
    } else {
        const float* weo = KIN(I_WEO);
        for (int r = (int)blockIdx.x * 7 + F.wave - 1; r < NE * IT_OUT; r += F.G * 7) { const int e = r / IT_OUT, q = r % IT_OUT, kb = q / 32, n0 = 32 * (q % 32);
            transpose_item(weo + (size_t)e * D * D, D, 64 * kb, n0, WEO + (size_t)e * D * D, D, n0, scr, F.lane); }
    }
}

__device__ __forceinline__ void phase_x1_h2(Frame& F) {
    LAS float* LG = (LAS float*)(F.lds);
    LAS float* LA = LG + 2 * D; LAS float* LB = LA + 2 * D;
    const float* modp = (const float*)(F.ws + WS_MODP);
    for (int i = F.tid; i < 2 * D; i += NWAVES * 64) { const int v = i / D, j = i % D;
        LG[i] = mod_val(modp, KIN(I_BADA), v, 2048 + j) * KIN(I_NQM)[j];
        LA[i] = KIN(I_NPF)[j] * (1.0f + mod_val(modp, KIN(I_BADA), v, 4096 + j)); LB[i] = mod_val(modp, KIN(I_BADA), v, 3072 + j); }
    __syncthreads();
    const float* mix = (const float*)(F.ws + WS_MIX); float* x1 = (float*)(F.ws + WS_X1); bf16* h2 = (bf16*)(F.ws + WS_H2);
    for (int row = F.gw; row < ML; row += F.NGW) {
        const int vec = row >> 13;
        f32x4 m[4], x[4]; float s = 0.f;
#pragma unroll
        for (int j = 0; j < 4; ++j) { m[j] = *(const f32x4*)(mix + (size_t)row * D + 4 * F.lane + 256 * j); x[j] = *(const f32x4*)(KIN(I_X) + (size_t)row * D + 4 * F.lane + 256 * j);
            s += (m[j].x * m[j].x + m[j].y * m[j].y) + (m[j].z * m[j].z + m[j].w * m[j].w); }
        const float rstd = 1.0f / sqrtf(wave_sum(s) * (1.0f / D) + 1e-6f);
        float s2 = 0.f;
#pragma unroll
        for (int j = 0; j < 4; ++j) { const int c = 4 * F.lane + 256 * j; const f32x4 g = *(const LAS f32x4*)(LG + vec * D + c);
            x[j] = x[j] + g * (m[j] * rstd); *(f32x4*)(x1 + (size_t)row * D + c) = x[j];
            s2 += (x[j].x * x[j].x + x[j].y * x[j].y) + (x[j].z * x[j].z + x[j].w * x[j].w); }
        const float rstd2 = 1.0f / sqrtf(wave_sum(s2) * (1.0f / D) + 1e-6f);
        unsigned long long* o8 = (unsigned long long*)(h2 + (size_t)row * D) + F.lane;
        f32x4 hq[4]; float mx = 0.f;
#pragma unroll
        for (int j = 0; j < 4; ++j) { const int c = 4 * F.lane + 256 * j; const f32x4 a = *(const LAS f32x4*)(LA + vec * D + c), b = *(const LAS f32x4*)(LB + vec * D + c);
            const f32x4 h = x[j] * rstd2 * a + b; hq[j] = h;
            mx = fmaxf(mx, fmaxf(fmaxf(fabsf(h.x), fabsf(h.y)), fmaxf(fabsf(h.z), fabsf(h.w))));
            o8[64 * j] = (unsigned long long)pk2(h.x, h.y) | ((unsigned long long)pk2(h.z, h.w) << 32); }
        mx = wave_max(mx);
        const float iv = mx > 0.f ? 127.0f / mx : 0.f;
        if (F.lane == 0) ((float*)(F.ws + MI_RSH2))[row] = mx * (1.0f / 127.0f);
        unsigned* o4 = (unsigned*)(F.ws + WS_H2Q + (size_t)row * D) + F.lane;
#pragma unroll
        for (int j = 0; j < 4; ++j) o4[64 * j] = pack_q4(hq[j].x * iv, hq[j].y * iv, hq[j].z * iv, hq[j].w * iv);
    }
}

__device__ __forceinline__ void phase_route(Frame& F) {
    const float* LG = (const float*)(F.ws + WS_LOGIT);
    int* selE = (int*)(F.ws + MI_SELE); int* selP = (int*)(F.ws + MI_SELP); float* gate = (float*)(F.ws + MI_GATE);
    for (int task = F.gw; task < ML / 64; task += F.NGW) {
        const int row = task * 64 + F.lane;
        float v[NE];
#pragma unroll
        for (int q = 0; q < NE / 4; ++q) { const f32x4 x = *(const f32x4*)(LG + (size_t)row * 256 + 4 * q); const f32x4 bb = *(const f32x4*)(KIN(I_BR) + 4 * q);
            v[4 * q] = x.x + bb.x; v[4 * q + 1] = x.y + bb.y; v[4 * q + 2] = x.z + bb.z; v[4 * q + 3] = x.w + bb.w; }
        int se[4]; float sv[4];
#pragma unroll
        for (int k = 0; k < 4; ++k) { float best = -3.0e38f; int bi = 0;
#pragma unroll
            for (int e = 0; e < NE; ++e) if (v[e] > best) { best = v[e]; bi = e; }
#pragma unroll
            for (int e = 0; e < NE; ++e) v[e] = (e == bi) ? -3.0e38f : v[e];
            se[k] = bi; sv[k] = best; }
        float ex[4], sum = 0.f;
#pragma unroll
        for (int k = 0; k < 4; ++k) { ex[k] = __expf(sv[k] - sv[0]); sum += ex[k]; }
        const float inv = 1.0f / sum;
        int sp[4] = {0, 0, 0, 0};
        int myn = 0;
#pragma unroll
        for (int e = 0; e < NE; ++e) { const bool p = (se[0] == e) | (se[1] == e) | (se[2] == e) | (se[3] == e); const int n = __popcll(__ballot(p)); myn = (F.lane == e) ? n : myn; }
        int mybase = 0;
        if (F.lane < NE && myn > 0) mybase = (int)__hip_atomic_fetch_add(F.ctl + CW_CNT + 64 * F.lane, (unsigned)myn, __ATOMIC_RELAXED, __HIP_MEMORY_SCOPE_AGENT);
#pragma unroll
        for (int e = 0; e < NE; ++e) {
            const bool p = (se[0] == e) | (se[1] == e) | (se[2] == e) | (se[3] == e);
            const unsigned long long mask = __ballot(p);
            const int base = __shfl(mybase, e);
            const int pos = base + __popcll(mask & ((1ull << F.lane) - 1ull));
#pragma unroll
            for (int k = 0; k < 4; ++k) if (se[k] == e) sp[k] = pos;
        }
        *(int4*)(selE + (size_t)row * 4) = make_int4(se[0], se[1], se[2], se[3]);
        *(int4*)(selP + (size_t)row * 4) = make_int4(sp[0], sp[1], sp[2], sp[3]);
        *(f32x4*)(gate + (size_t)row * 4) = (f32x4){ex[0] * inv, ex[1] * inv, ex[2] * inv, ex[3] * inv};
    }
}

__device__ __forceinline__ void phase_x1h2_route(Frame& F) {
    constexpr int HS_STRIDE = 2064;
    LAS unsigned char* Hs = F.lds;
    LAS float* LG = (LAS float*)(F.lds + 132096);
    LAS float* LA = LG + D; LAS float* LB = LA + D;
    LAS float* LGT = (LAS float*)(F.lds + LDS_X_OFF);
    const float* modp = (const float*)(F.ws + WS_MODP);
    const float* mix = (const float*)(F.ws + WS_MIX); float* x1 = (float*)(F.ws + WS_X1);
    const float* xin = KIN(I_X); const float* b_ada = KIN(I_BADA); const float* nqm = KIN(I_NQM); const float* npf = KIN(I_NPF);
    const bf16* WR = (const bf16*)(F.ws + WS_WROUT);
    int* selE = (int*)(F.ws + MI_SELE); int* selP = (int*)(F.ws + MI_SELP); float* gate = (float*)(F.ws + MI_GATE);
    for (int rb = blockIdx.x; rb < ML / 64; rb += F.G) {
        const int vec = (rb * 64) >> 13;
        __syncthreads();
        for (int i = F.tid; i < D; i += NWAVES * 64) {
            LG[i] = mod_val(modp, b_ada, vec, 2048 + i) * nqm[i];
            LA[i] = npf[i] * (1.0f + mod_val(modp, b_ada, vec, 4096 + i)); LB[i] = mod_val(modp, b_ada, vec, 3072 + i); }
        __syncthreads();
        for (int rr = 0; rr < 8; ++rr) {
            const int lrow = F.wave * 8 + rr, row = rb * 64 + lrow;
            f32x4 m[4], x[4]; float s = 0.f;
#pragma unroll
            for (int j = 0; j < 4; ++j) { m[j] = *(const f32x4*)(mix + (size_t)row * D + 4 * F.lane + 256 * j); x[j] = *(const f32x4*)(xin + (size_t)row * D + 4 * F.lane + 256 * j);
                s += (m[j].x * m[j].x + m[j].y * m[j].y) + (m[j].z * m[j].z + m[j].w * m[j].w); }
            const float rstd = 1.0f / sqrtf(wave_sum(s) * (1.0f / D) + 1e-6f);
            float s2 = 0.f;
#pragma unroll
            for (int j = 0; j < 4; ++j) { const int c = 4 * F.lane + 256 * j; const f32x4 g = *(const LAS f32x4*)(LG + c);
                x[j] = x[j] + g * (m[j] * rstd); *(f32x4*)(x1 + (size_t)row * D + c) = x[j];
                s2 += (x[j].x * x[j].x + x[j].y * x[j].y) + (x[j].z * x[j].z + x[j].w * x[j].w); }
            const float rstd2 = 1.0f / sqrtf(wave_sum(s2) * (1.0f / D) + 1e-6f);
            f32x4 hq[4]; float mx = 0.f;
#pragma unroll
            for (int j = 0; j < 4; ++j) { const int c = 4 * F.lane + 256 * j; const f32x4 a = *(const LAS f32x4*)(LA + c), b = *(const LAS f32x4*)(LB + c);
                const f32x4 h = x[j] * rstd2 * a + b; hq[j] = h;
                mx = fmaxf(mx, fmaxf(fmaxf(fabsf(h.x), fabsf(h.y)), fmaxf(fabsf(h.z), fabsf(h.w))));
                *(LAS v2u*)(Hs + lrow * HS_STRIDE + c * 2) = (v2u){pk2(h.x, h.y), pk2(h.z, h.w)}; }
            mx = wave_max(mx);
            const float iv = mx > 0.f ? 127.0f / mx : 0.f;
            if (F.lane == 0) ((float*)(F.ws + MI_RSH2))[row] = mx * (1.0f / 127.0f);
            unsigned* o4 = (unsigned*)(F.ws + WS_H2Q + (size_t)row * D) + F.lane;
#pragma unroll
            for (int j = 0; j < 4; ++j) o4[64 * j] = pack_q4(hq[j].x * iv, hq[j].y * iv, hq[j].z * iv, hq[j].w * iv);
        }
        __syncthreads();
        {
            const int rt = F.wave & 3, et = F.wave >> 2, lr = F.lane & 15, g = F.lane >> 4;
            typedef short bf16x8_t __attribute__((ext_vector_type(8)));
            f32x4 acc = {0.f, 0.f, 0.f, 0.f};
            const LAS unsigned char* ap = Hs + (16 * rt + lr) * HS_STRIDE + 16 * g; const bf16* bp = WR + (size_t)(16 * et + lr) * D + 8 * g;
#pragma unroll 8
            for (int s = 0; s < 32; ++s) { const bf16x8_t a = *(const LAS bf16x8_t*)(ap + 64 * s); const bf16x8_t b = *(const bf16x8_t*)(bp + 32 * s);
                acc = __builtin_amdgcn_mfma_f32_16x16x32_bf16(a, b, acc, 0, 0, 0); }
#pragma unroll
            for (int i = 0; i < 4; ++i) LGT[(16 * rt + 4 * g + i) * 33 + 16 * et + lr] = acc[i];
        }
        __syncthreads();
        if (F.wave == 0) {
            const int row = rb * 64 + F.lane;
            const float* br = KIN(I_BR);
            float v[NE];
#pragma unroll
            for (int e = 0; e < NE; ++e) v[e] = LGT[F.lane * 33 + e] + br[e];
            int se[4]; float sv[4];
#pragma unroll
            for (int k = 0; k < 4; ++k) { float best = -3.0e38f; int bi = 0;
#pragma unroll
                for (int e = 0; e < NE; ++e) if (v[e] > best) { best = v[e]; bi = e; }
#pragma unroll
                for (int e = 0; e < NE; ++e) v[e] = (e == bi) ? -3.0e38f : v[e];
                se[k] = bi; sv[k] = best; }
            float ex[4], sum = 0.f;
#pragma unroll
            for (int k = 0; k < 4; ++k) { ex[k] = __expf(sv[k] - sv[0]); sum += ex[k]; }
            const float inv = 1.0f / sum;
            int sp[4] = {0, 0, 0, 0};
            int myn = 0;
#pragma unroll
            for (int e = 0; e < NE; ++e) { const bool p = (se[0] == e) | (se[1] == e) | (se[2] == e) | (se[3] == e); const int n = __popcll(__ballot(p)); myn = (F.lane == e) ? n : myn; }
            int mybase = 0;
            if (F.lane < NE && myn > 0) mybase = (int)__hip_atomic_fetch_add(F.ctl + CW_CNT + 64 * F.lane, (unsigned)myn, __ATOMIC_RELAXED, __HIP_MEMORY_SCOPE_AGENT);
#pragma unroll
            for (int e = 0; e < NE; ++e) {
                const bool p = (se[0] == e) | (se[1] == e) | (se[2] == e) | (se[3] == e);
                const unsigned long long mask = __ballot(p);
                const int base = __shfl(mybase, e);
                const int pos = base + __popcll(mask & ((1ull << F.lane) - 1ull));
#pragma unroll
                for (int k = 0; k < 4; ++k) if (se[k] == e) sp[k] = pos;
            }
            *(int4*)(selE + (size_t)row * 4) = make_int4(se[0], se[1], se[2], se[3]);
            *(int4*)(selP + (size_t)row * 4) = make_int4(sp[0], sp[1], sp[2], sp[3]);
            *(f32x4*)(gate + (size_t)row * 4) = (f32x4){ex[0] * inv, ex[1] * inv, ex[2] * inv, ex[3] * inv};
        }
    }
    __syncthreads();
}

__device__ __forceinline__ void phase_scatter(Frame& F) {
    LAS int* PS = (LAS int*)(F.lds);
    if (F.tid == 0) { int acc = 0;
        for (int e = 0; e < NE; ++e) { const int c = (int)__hip_atomic_load(F.ctl + CW_CNT + 64 * e, __ATOMIC_RELAXED, __HIP_MEMORY_SCOPE_AGENT); PS[e] = acc; PS[64 + e] = c; acc += (c + 255) / 256 * 256; }
        PS[NE] = acc; }
    __syncthreads();
    int* blkE = (int*)(F.ws + MI_BLKE);
    if (blockIdx.x == 0) {
        for (int b = F.tid; b < MAXBLK; b += NWAVES * 64) { int e = NE - 1;
            for (int q = 0; q < NE; ++q) if (b * 256 >= PS[q] && b * 256 < PS[q + 1]) e = q;
            blkE[b] = e; }
        if (F.tid == 0) blkE[MAXBLK] = PS[NE] / 256;
    }
    const int* selE = (const int*)(F.ws + MI_SELE); const int* selP = (const int*)(F.ws + MI_SELP); int* dest = (int*)(F.ws + MI_DEST);
    const unsigned char* h2q = F.ws + WS_H2Q; unsigned char* xb = F.ws + WS_XB; const float* rsh2 = (const float*)(F.ws + MI_RSH2); float* rsxb = (float*)(F.ws + MI_RSXB);
    for (int row = F.gw; row < ML; row += F.NGW) {
        const int4 se = *(const int4*)(selE + (size_t)row * 4), sp = *(const int4*)(selP + (size_t)row * 4);
        const int d0 = PS[se.x] + sp.x, d1 = PS[se.y] + sp.y, d2 = PS[se.z] + sp.z, d3 = PS[se.w] + sp.w;
        const float rsc = rsh2[row];
        if (F.lane == 0) { *(int4*)(dest + (size_t)row * 4) = make_int4(d0, d1, d2, d3); rsxb[d0] = rsc; rsxb[d1] = rsc; rsxb[d2] = rsc; rsxb[d3] = rsc; }
        const v4u a = *(const v4u*)(h2q + (size_t)row * D + 16 * F.lane);
        *(v4u*)(xb + (size_t)d0 * D + 16 * F.lane) = a; *(v4u*)(xb + (size_t)d1 * D + 16 * F.lane) = a;
        *(v4u*)(xb + (size_t)d2 * D + 16 * F.lane) = a; *(v4u*)(xb + (size_t)d3 * D + 16 * F.lane) = a;
    }
    for (int p = F.gw; p < NE * 256; p += F.NGW) {
        const int e = p >> 8, r = p & 255, c = PS[64 + e], padded = (c + 255) / 256 * 256;
        if (c + r < padded) { unsigned char* dst = xb + (size_t)(PS[e] + c + r) * D; *(v4u*)(dst + 16 * F.lane) = (v4u){0u, 0u, 0u, 0u}; if (F.lane == 0) rsxb[PS[e] + c + r] = 0.f; }
    }
}

__device__ __forceinline__ void phase_combine(Frame& F) {
    LAS float* LG = (LAS float*)(F.lds);
    const float* modp = (const float*)(F.ws + WS_MODP);
    for (int i = F.tid; i < 2 * D; i += NWAVES * 64) { const int v = i / D, j = i % D; LG[i] = mod_val(modp, KIN(I_BADA), v, 5120 + j) * KIN(I_NQF)[j]; }
    __syncthreads();
    const int* dest = (const int*)(F.ws + MI_DEST); const float* gate = (const float*)(F.ws + MI_GATE);
    const bf16* y2 = (const bf16*)(F.ws + WS_Y2); const float* x1 = (const float*)(F.ws + WS_X1);
    for (int row = F.gw; row < ML; row += F.NGW) {
        const int vec = row >> 13;
        const int4 dd = *(const int4*)(dest + (size_t)row * 4); const f32x4 gg = *(const f32x4*)(gate + (size_t)row * 4);
        const int dk[4] = {dd.x, dd.y, dd.z, dd.w}; const float gk[4] = {gg.x, gg.y, gg.z, gg.w};
        float f[16];
#pragma unroll
        for (int i = 0; i < 16; ++i) f[i] = 0.f;
#pragma unroll
        for (int k = 0; k < 4; ++k) { float t[16]; ld16bf(y2 + (size_t)dk[k] * D + 16 * F.lane, t);
#pragma unroll
            for (int i = 0; i < 16; ++i) f[i] += gk[k] * t[i]; }
        float s = 0.f;
#pragma unroll
        for (int i = 0; i < 16; ++i) s += f[i] * f[i];
        const float rstd = 1.0f / sqrtf(wave_sum(s) * (1.0f / D) + 1e-6f);
        float xv[16], g[16], o[16]; ld16f(x1 + (size_t)row * D + 16 * F.lane, xv); ld16f_lds(LG + vec * D + 16 * F.lane, g);
#pragma unroll
        for (int i = 0; i < 16; ++i) o[i] = xv[i] + g[i] * (f[i] * rstd);
        st16f(F.out + (size_t)row * D + 16 * F.lane, o);
    }
}

constexpr int N_PHASES = 13;
#ifndef PROBE_MASK
#define PROBE_MASK 0
#endif
#ifndef STAGE_REP
#define STAGE_REP 0
#endif
#ifndef USE_FLAT_BAR
#define USE_FLAT_BAR 0
#endif
struct Args { const float* in[30]; float* out; unsigned char* ws; int ph_lo, ph_hi; };
__global__ void __launch_bounds__(NWAVES * 64, 2) fwd(Args args) {
    extern __shared__ __attribute__((aligned(16))) unsigned char lds[];
    Frame F;
    F.lds = (LAS unsigned char*)lds;
    F.MISC = (volatile LAS unsigned*)(F.lds + MISC_OFF);
    F.tid = threadIdx.x; F.lane = F.tid & 63; F.wave = __builtin_amdgcn_readfirstlane(F.tid >> 6);
    F.G = gridDim.x; F.gw = blockIdx.x * NWAVES + F.wave; F.NGW = F.G * NWAVES;
    F.ws = args.ws; F.ctl = (unsigned*)(args.ws + WS_CTL); F.out = args.out;
    for (int u = F.tid; u < (LDS_X_OFF - LDSCTL_OFF) / 4; u += NWAVES * 64) ((LAS unsigned*)(F.lds + LDSCTL_OFF))[u] = 0u;
    __syncthreads();
    const int lo = args.ph_lo, hi = args.ph_hi;
    const bool use_bar = (hi - lo) > 1;
    XcdBarrier bar; bar.bar = F.ctl + CW_BAR; bar.x = 0; bar.st = nullptr;
    if (use_bar && !USE_FLAT_BAR) bar = xcd_barrier_post(F.ctl + CW_BAR, F.MISC + 8);
#define IN(k) (lo <= (k) && (k) < hi)
    unsigned fb_extra = 0u;
#define SEAM(k) do { if (IN(k) && IN((k) + 1)) { if (USE_FLAT_BAR) flat_barrier(F.ctl + CW_FB, (unsigned)((k) - lo + 1) + fb_extra); else xcd_barrier2(bar); } else __syncthreads(); } while (0)

#define DUP(k) ((PROBE_MASK >> (k)) & 1)
    if (IN(0)) { phase_prologue(F); if (DUP(0)) { __syncthreads(); phase_prologue(F); } SEAM(0); }
    if (DUP(20)) { for (int q = 0; q < 10; ++q) { if (USE_FLAT_BAR) { ++fb_extra; flat_barrier(F.ctl + CW_FB, 1u + fb_extra); } else xcd_barrier2(bar); } }
    if (IN(1)) { phase_hrows(F); if (DUP(1)) { __syncthreads(); phase_hrows(F); } SEAM(1); }
    if (IN(2)) {
        {         pg8::Gemm g{(const bf16*)(F.ws + WS_A0), (const bf16*)(F.ws + WS_WIN), MT, NZ, D}; pg8::StaticOrder S; S.init(MT, NZ, F.G, (int)blockIdx.x);
        pg8::EpiBf16I8 E{(bf16*)(F.ws + WS_Z), NZ, (const float*)(F.ws + MI_RSH), (const float*)(F.ws + MI_CSWIN)};
        pg8::gemm_phase_i8<pg8::EpiBf16I8, pg8::StaticOrder, true, true>(F.lds + RING_OFF, g, S, E); __syncthreads(); }
        if (DUP(2)) {         pg8::Gemm g{(const bf16*)(F.ws + WS_A0), (const bf16*)(F.ws + WS_WIN), MT, NZ, D}; pg8::StaticOrder S; S.init(MT, NZ, F.G, (int)blockIdx.x);
        pg8::EpiBf16I8 E{(bf16*)(F.ws + WS_Z), NZ, (const float*)(F.ws + MI_RSH), (const float*)(F.ws + MI_CSWIN)};
        pg8::gemm_phase_i8<pg8::EpiBf16I8, pg8::StaticOrder, true, true>(F.lds + RING_OFF, g, S, E); __syncthreads(); }
        SEAM(2); }
    if (IN(3)) { ck::phase_lora(F); SEAM(3); }
    if (IN(4)) { ck::phase_cp2(F); if (DUP(5)) { __syncthreads(); ck::phase_cp2(F); } if (DUP(22)) { __syncthreads(); ck::phase_lora(F); } SEAM(4); }
    if (IN(5)) { if (F.wave == 0) ck::phase_ss(F); if (DUP(23)) { __syncthreads(); ck::phase_ss3(F); } if (DUP(6)) { __syncthreads(); if (F.wave == 0) ck::phase_ss(F); else phase_moe_weights<0>(F); } if (DUP(17)) { __syncthreads(); if (F.wave == 0) ck::phase_ss(F); } SEAM(5); }
    if (IN(6)) { ck::phase_co2(F); if (DUP(7)) { __syncthreads(); ck::phase_co2(F); } SEAM(6); }
    if (IN(7)) {
        {         pg8::Gemm g{(const bf16*)(F.ws + WS_A0), (const bf16*)(F.ws + WS_WOUT), ML, D, D}; pg8::StaticOrder S; S.init(ML, D, F.G, (int)blockIdx.x);
        pg8::EpiF32 E{(float*)(F.ws + WS_MIX), D};
        pg8::gemm_phase<pg8::EpiF32, pg8::StaticOrder, true, true>(F.lds + RING_OFF, g, S, E);
        __syncthreads(); }
        if (DUP(8)) {         pg8::Gemm g{(const bf16*)(F.ws + WS_A0), (const bf16*)(F.ws + WS_WOUT), ML, D, D}; pg8::StaticOrder S; S.init(ML, D, F.G, (int)blockIdx.x);
        pg8::EpiF32 E{(float*)(F.ws + WS_MIX), D};
        pg8::gemm_phase<pg8::EpiF32, pg8::StaticOrder, true, true>(F.lds + RING_OFF, g, S, E);
        __syncthreads(); }
        SEAM(7); }
    if (IN(8)) { phase_x1h2_route(F); SEAM(8); }
    if (IN(9)) { phase_scatter(F); if (DUP(12)) { __syncthreads(); phase_scatter(F); } SEAM(9); }
    if (IN(10)) {
        {         const int* blkE = (const int*)(F.ws + MI_BLKE);
        pg8::Gemm g{(const bf16*)(F.ws + WS_XB), (const bf16*)(F.ws + WS_WEIN), NROWS, 2048, D};
        pg8::MoeOrder<8> S{blkE, __hip_atomic_load(blkE + MAXBLK, __ATOMIC_RELAXED, __HIP_MEMORY_SCOPE_AGENT) * 8, F.G, (int)blockIdx.x};
        pg8::EpiSwigluI8 E{(bf16*)(F.ws + WS_ACT), KIN(I_BEI), (const float*)(F.ws + MI_RSXB), (const float*)(F.ws + MI_CSWEI)};
        pg8::gemm_phase_i8<pg8::EpiSwigluI8, pg8::MoeOrder<8>, true, true>(F.lds + RING_OFF, g, S, E); __syncthreads(); }
        if (DUP(13)) {         const int* blkE = (const int*)(F.ws + MI_BLKE);
        pg8::Gemm g{(const bf16*)(F.ws + WS_XB), (const bf16*)(F.ws + WS_WEIN), NROWS, 2048, D};
        pg8::MoeOrder<8> S{blkE, __hip_atomic_load(blkE + MAXBLK, __ATOMIC_RELAXED, __HIP_MEMORY_SCOPE_AGENT) * 8, F.G, (int)blockIdx.x};
        pg8::EpiSwigluI8 E{(bf16*)(F.ws + WS_ACT), KIN(I_BEI), (const float*)(F.ws + MI_RSXB), (const float*)(F.ws + MI_CSWEI)};
        pg8::gemm_phase_i8<pg8::EpiSwigluI8, pg8::MoeOrder<8>, true, true>(F.lds + RING_OFF, g, S, E); __syncthreads(); }
        SEAM(10); }
    if (IN(11)) {
        {         const int* blkE = (const int*)(F.ws + MI_BLKE);
        pg8::Gemm g{(const bf16*)(F.ws + WS_ACT), (const bf16*)(F.ws + WS_WEOUT), NROWS, D, D};
        pg8::MoeOrder<4> S{blkE, __hip_atomic_load(blkE + MAXBLK, __ATOMIC_RELAXED, __HIP_MEMORY_SCOPE_AGENT) * 4, F.G, (int)blockIdx.x};
        pg8::EpiBf16 E{(bf16*)(F.ws + WS_Y2), D, KIN(I_BEO), D};
        pg8::gemm_phase<pg8::EpiBf16, pg8::MoeOrder<4>, true, true>(F.lds + RING_OFF, g, S, E); __syncthreads(); }
        if (DUP(14)) {         const int* blkE = (const int*)(F.ws + MI_BLKE);
        pg8::Gemm g{(const bf16*)(F.ws + WS_ACT), (const bf16*)(F.ws + WS_WEOUT), NROWS, D, D};
        pg8::MoeOrder<4> S{blkE, __hip_atomic_load(blkE + MAXBLK, __ATOMIC_RELAXED, __HIP_MEMORY_SCOPE_AGENT) * 4, F.G, (int)blockIdx.x};
        pg8::EpiBf16 E{(bf16*)(F.ws + WS_Y2), D, KIN(I_BEO), D};
        pg8::gemm_phase<pg8::EpiBf16, pg8::MoeOrder<4>, true, true>(F.lds + RING_OFF, g, S, E); __syncthreads(); }
        SEAM(11); }
    if (IN(12)) { phase_combine(F); if (DUP(15)) { __syncthreads(); phase_combine(F); } }
#undef IN
#undef SEAM
}

#ifndef MK_N_LAUNCHES
#define MK_N_LAUNCHES 1
#endif
extern "C" void kernel_launch(void* const* d_in, const int* in_sizes, int n_in, void* d_out, int out_size, void* d_ws, size_t ws_size, hipStream_t stream) {
    static int grid = 0;
    if (grid == 0) {
        if (n_in != 30 || out_size != ML * D || ws_size < WS_END) { fprintf(stderr, "kernel_launch: unexpected shapes (n_in %d out %d ws %zu, need %zu); nothing launched\n", n_in, out_size, ws_size, (size_t)WS_END); grid = -1; return; }
        int dev = 0, cus = 0, per_cu = 0;
        if (hipGetDevice(&dev) != hipSuccess || hipDeviceGetAttribute(&cus, hipDeviceAttributeMultiprocessorCount, dev) != hipSuccess) { grid = -1; return; }
        if (hipFuncSetAttribute((const void*)fwd, hipFuncAttributeMaxDynamicSharedMemorySize, LDS_BYTES) != hipSuccess) { fprintf(stderr, "kernel_launch: hipFuncSetAttribute failed\n"); grid = -1; return; }
        if (hipOccupancyMaxActiveBlocksPerMultiprocessor(&per_cu, (const void*)fwd, NWAVES * 64, LDS_BYTES) != hipSuccess || per_cu < 1)
            fprintf(stderr, "kernel_launch: note: occupancy query reports %d workgroups per CU\n", per_cu);
        (void)hipGetLastError();
        grid = cus;
    }
    if (grid < 0) return;
    if (hipMemsetAsync((char*)d_ws + WS_CTL, 0, CTL_ZERO_BYTES, stream) != hipSuccess) return;
    Args a{};
    for (int i = 0; i < 30; ++i) a.in[i] = (const float*)d_in[i];
    a.out = (float*)d_out; a.ws = (unsigned char*)d_ws;
    if (MK_N_LAUNCHES == 1) { a.ph_lo = 0; a.ph_hi = N_PHASES; hipLaunchKernelGGL(fwd, dim3(grid), dim3(NWAVES * 64), LDS_BYTES, stream, a); }
    else for (int p = 0; p < N_PHASES; ++p) { a.ph_lo = p; a.ph_hi = p + 1; hipLaunchKernelGGL(fwd, dim3(grid), dim3(NWAVES * 64), LDS_BYTES, stream, a); }
}
```

```cpp
#include <hip/hip_runtime.h>
#include <cstdio>
#include <cstdint>

namespace pg8 {
#define PG8_LAS __attribute__((address_space(3)))
typedef unsigned short bf16_t;
typedef short bf16x8 __attribute__((ext_vector_type(8)));
typedef float f32x4 __attribute__((ext_vector_type(4)));
typedef unsigned u32x4 __attribute__((ext_vector_type(4)));
constexpr int BM = 256, BK = 64, HALF = 128, HTB = HALF * BK * 2  , STAGE_BYTES = 8 * HTB, NXCD = 8, WGM = 8;

__host__ __device__ __forceinline__ int lds_byte(int r, int c) { const int st = (r >> 4) * 2 + (c >> 5), rr = r & 15, cc = c & 31, ob = rr * 64 + cc * 2; return st * 1024 + (ob ^ (((ob >> 9) & 1) << 5)); }
__host__ __device__ __forceinline__ void stage_rc(int b, int& R, int& C) { const int st = b / 1024, sb = b % 1024, swz = sb ^ (((sb >> 9) & 1) << 5); R = (st >> 1) * 16 + swz / 64; C = (st & 1) * 32 + (swz % 64) / 2; }
__host__ __device__ __forceinline__ int perm32(int rho) { const int n = rho >> 4, i = rho & 15; return 8 * (i >> 2) + 4 * n + (i & 3); }

struct Unit { int pm, pn, pb, e; };
struct Gemm { const bf16_t* A; const bf16_t* Bt; int M, N, K; };

struct StaticOrder {
    int nM, nN, nwg, G, c;
    __host__ __device__ void init(int M, int N, int G_, int c_) { nM = M / BM; nN = N / BM; nwg = nM * nN; G = G_; c = c_; }
    __host__ __device__ bool next(int i, Unit& u) const {
        const long L = (long)i * G + c; if (L >= nwg) return false;
        int wgid = (int)L; { const int q = nwg / NXCD, r = nwg % NXCD, xcd = wgid % NXCD, off = wgid / NXCD; wgid = (xcd < r ? xcd * (q + 1) : r * (q + 1) + (xcd - r) * q) + off; }
        const int nig = WGM * nN, gid = wgid / nig, fm = gid * WGM, gsz = (nM - fm) < WGM ? (nM - fm) : WGM;
        u.pm = fm + ((wgid % nig) % gsz); u.pn = (wgid % nig) / gsz; u.pb = u.pn; u.e = 0; return true;
    }
    __device__ __forceinline__ void a_ready(const Unit&) const {}
    __device__ __forceinline__ void done(const Unit&) const {}
};
template <int NT> struct MoeOrder {
    const int* blk_e; int nunits, G, c;
    __device__ bool next(int i, Unit& u) const {
        int L;
        if ((G & 7) == 0 && ((G >> 3) % NT) == 0) { const int per = G >> 3, xcd = c & 7, k = c >> 3, bpx = per / NT;
            L = ((i * 8 + xcd) * bpx + k / NT) * NT + (k % NT); }
        else L = i * G + c;
        if (L >= nunits) return false;
        const int blk = L / NT, pn = L % NT; const int e = __hip_atomic_load(blk_e + blk, __ATOMIC_RELAXED, __HIP_MEMORY_SCOPE_AGENT);
        u.pm = blk; u.pn = pn; u.pb = e * NT + pn; u.e = e; return true;
    }
    __device__ __forceinline__ void a_ready(const Unit&) const {}
    __device__ __forceinline__ void done(const Unit&) const {}
};

__device__ __forceinline__ unsigned cvt_pk_bf16(float lo, float hi) { unsigned r; asm volatile("v_cvt_pk_bf16_f32 %0, %1, %2" : "=v"(r) : "v"(lo), "v"(hi)); return r; }

struct EpiF32 {
    static constexpr bool PERM = false, AFTER_DRAIN = false;
    float* C; int ldc;
    __device__ __forceinline__ void operator()(const f32x4 (&acc)[2][2][4][2], const Unit& u, int wr, int wc, int fr, int fq) const {
        const int row0 = u.pm * BM + wr * 64 + fr, col0 = u.pn * BM + wc * 32 + 4 * fq;
#pragma unroll
        for (int ai = 0; ai < 2; ++ai)
#pragma unroll
            for (int m = 0; m < 4; ++m) { float* rowp = C + (size_t)(row0 + ai * HALF + m * 16) * ldc + col0;
#pragma unroll
                for (int bj = 0; bj < 2; ++bj)
#pragma unroll
                    for (int n = 0; n < 2; ++n) __builtin_nontemporal_store(acc[ai][bj][m][n], (f32x4*)(rowp + bj * HALF + n * 16)); }
    }
};
struct EpiBf16 {
    static constexpr bool PERM = true, AFTER_DRAIN = false;
    bf16_t* O; int ldc; const float* bias; int bias_estride;
    __device__ __forceinline__ void operator()(const f32x4 (&acc)[2][2][4][2], const Unit& u, int wr, int wc, int fr, int fq) const {
        const int row0 = u.pm * BM + wr * 64 + fr; const int col0 = u.pn * BM + wc * 32 + 8 * fq;
        const float* bp = bias ? bias + (size_t)u.e * bias_estride + col0 : nullptr;
        f32x4 bv[2][2];
#pragma unroll
        for (int bj = 0; bj < 2; ++bj)
#pragma unroll
            for (int n = 0; n < 2; ++n) bv[bj][n] = bp ? *(const f32x4*)(bp + bj * HALF + 4 * n) : (f32x4){0.f, 0.f, 0.f, 0.f};
#pragma unroll
        for (int ai = 0; ai < 2; ++ai)
#pragma unroll
            for (int m = 0; m < 4; ++m) { bf16_t* rowp = O + (size_t)(row0 + ai * HALF + m * 16) * ldc + col0;
#pragma unroll
                for (int bj = 0; bj < 2; ++bj) { const f32x4 v0 = acc[ai][bj][m][0] + bv[bj][0], v1 = acc[ai][bj][m][1] + bv[bj][1];
                    u32x4 w; w.x = cvt_pk_bf16(v0[0], v0[1]); w.y = cvt_pk_bf16(v0[2], v0[3]); w.z = cvt_pk_bf16(v1[0], v1[1]); w.w = cvt_pk_bf16(v1[2], v1[3]);
                    __builtin_nontemporal_store(w, (u32x4*)(rowp + bj * HALF)); } }
    }
};
struct EpiSwiglu {
    static constexpr bool PERM = true, AFTER_DRAIN = false;
    bf16_t* O; const float* bias;
    __device__ __forceinline__ float act1(float g, float up) const {
        g = fminf(g, 7.0f); up = fminf(fmaxf(up, -7.0f), 7.0f);
        const float sg = 1.0f / (1.0f + __expf(-1.702f * g));
        return (up + 1.0f) * g * sg;
    }
    __device__ __forceinline__ void operator()(const f32x4 (&acc)[2][2][4][2], const Unit& u, int wr, int wc, int fr, int fq) const {
        const int row0 = u.pm * BM + wr * 64 + fr; const int col0 = u.pn * HALF + wc * 32 + 8 * fq;
        const float* bp = bias + (size_t)u.e * 2048 + col0;
        f32x4 bg[2], bu[2];
#pragma unroll
        for (int n = 0; n < 2; ++n) { bg[n] = *(const f32x4*)(bp + 4 * n); bu[n] = *(const f32x4*)(bp + 1024 + 4 * n); }
#pragma unroll
        for (int ai = 0; ai < 2; ++ai)
#pragma unroll
            for (int m = 0; m < 4; ++m) { bf16_t* rowp = O + (size_t)(row0 + ai * HALF + m * 16) * 1024 + col0;
                const f32x4 g0 = acc[ai][0][m][0] + bg[0], g1 = acc[ai][0][m][1] + bg[1], u0 = acc[ai][1][m][0] + bu[0], u1 = acc[ai][1][m][1] + bu[1];
                u32x4 w; w.x = cvt_pk_bf16(act1(g0[0], u0[0]), act1(g0[1], u0[1])); w.y = cvt_pk_bf16(act1(g0[2], u0[2]), act1(g0[3], u0[3]));
                w.z = cvt_pk_bf16(act1(g1[0], u1[0]), act1(g1[1], u1[1])); w.w = cvt_pk_bf16(act1(g1[2], u1[2]), act1(g1[3], u1[3]));
                __builtin_nontemporal_store(w, (u32x4*)rowp); }
    }
};


typedef int i32x4 __attribute__((ext_vector_type(4)));
struct EpiBf16I8 {
    static constexpr bool PERM = true, AFTER_DRAIN = false;
    bf16_t* O; int ldc; const float* rs; const float* cs;
    __device__ __forceinline__ void operator()(const i32x4 (&acc)[2][2][4][2], const Unit& u, int wr, int wc, int fr, int fq) const {
        const int row0 = u.pm * BM + wr * 64 + fr; const int col0 = u.pn * BM + wc * 32 + 8 * fq;
        const float* cp = cs + (size_t)u.pb * BM + wc * 32 + 8 * fq;
        f32x4 cv[2][2]; float rsv[2][4];
#pragma unroll
        for (int bj = 0; bj < 2; ++bj)
#pragma unroll
            for (int n = 0; n < 2; ++n) cv[bj][n] = *(const f32x4*)(cp + bj * HALF + 4 * n);
#pragma unroll
        for (int ai = 0; ai < 2; ++ai)
#pragma unroll
            for (int m = 0; m < 4; ++m) rsv[ai][m] = rs[row0 + ai * HALF + m * 16];
#pragma unroll
        for (int ai = 0; ai < 2; ++ai)
#pragma unroll
            for (int m = 0; m < 4; ++m) { const int row = row0 + ai * HALF + m * 16; const float r = rsv[ai][m]; bf16_t* rowp = O + (size_t)row * ldc + col0;
#pragma unroll
                for (int bj = 0; bj < 2; ++bj) { const i32x4 a0 = acc[ai][bj][m][0], a1 = acc[ai][bj][m][1];
                    const f32x4 v0 = (f32x4){(float)a0[0], (float)a0[1], (float)a0[2], (float)a0[3]} * cv[bj][0] * r, v1 = (f32x4){(float)a1[0], (float)a1[1], (float)a1[2], (float)a1[3]} * cv[bj][1] * r;
                    u32x4 w; w.x = cvt_pk_bf16(v0[0], v0[1]); w.y = cvt_pk_bf16(v0[2], v0[3]); w.z = cvt_pk_bf16(v1[0], v1[1]); w.w = cvt_pk_bf16(v1[2], v1[3]);
                    __builtin_nontemporal_store(w, (u32x4*)(rowp + bj * HALF)); } }
    }
};
struct EpiSwigluI8 {
    static constexpr bool PERM = true, AFTER_DRAIN = false;
    bf16_t* O; const float* bias; const float* rs; const float* cs;
    __device__ __forceinline__ float act1(float g, float up) const {
        g = fminf(g, 7.0f); up = fminf(fmaxf(up, -7.0f), 7.0f);
        const float sg = __builtin_amdgcn_rcpf(1.0f + __expf(-1.702f * g));
        return (up + 1.0f) * g * sg;
    }
    __device__ __forceinline__ void operator()(const i32x4 (&acc)[2][2][4][2], const Unit& u, int wr, int wc, int fr, int fq) const {
        const int row0 = u.pm * BM + wr * 64 + fr; const int col0 = u.pn * HALF + wc * 32 + 8 * fq;
        const float* bp = bias + (size_t)u.e * 2048 + col0;
        const float* cp = cs + (size_t)u.pb * BM + wc * 32 + 8 * fq;
        f32x4 bg[2], bu[2], cg[2], cu[2]; float rsv[2][4];
#pragma unroll
        for (int n = 0; n < 2; ++n) { bg[n] = *(const f32x4*)(bp + 4 * n); bu[n] = *(const f32x4*)(bp + 1024 + 4 * n); cg[n] = *(const f32x4*)(cp + 4 * n); cu[n] = *(const f32x4*)(cp + HALF + 4 * n); }
#pragma unroll
        for (int ai = 0; ai < 2; ++ai)
#pragma unroll
            for (int m = 0; m < 4; ++m) rsv[ai][m] = rs[row0 + ai * HALF + m * 16];
#pragma unroll
        for (int ai = 0; ai < 2; ++ai)
#pragma unroll
            for (int m = 0; m < 4; ++m) { const int row = row0 + ai * HALF + m * 16; const float r = rsv[ai][m]; bf16_t* rowp = O + (size_t)row * 1024 + col0;
                f32x4 g[2], up[2];
#pragma unroll
                for (int n = 0; n < 2; ++n) { const i32x4 ag = acc[ai][0][m][n], au = acc[ai][1][m][n];
                    g[n] = (f32x4){(float)ag[0], (float)ag[1], (float)ag[2], (float)ag[3]} * cg[n] * r + bg[n];
                    up[n] = (f32x4){(float)au[0], (float)au[1], (float)au[2], (float)au[3]} * cu[n] * r + bu[n]; }
                u32x4 w; w.x = cvt_pk_bf16(act1(g[0][0], up[0][0]), act1(g[0][1], up[0][1])); w.y = cvt_pk_bf16(act1(g[0][2], up[0][2]), act1(g[0][3], up[0][3]));
                w.z = cvt_pk_bf16(act1(g[1][0], up[1][0]), act1(g[1][1], up[1][1])); w.w = cvt_pk_bf16(act1(g[1][2], up[1][2]), act1(g[1][3], up[1][3]));
                __builtin_nontemporal_store(w, (u32x4*)rowp); }
    }
};
template <class Epi, class Sched, bool ALIGN_EPI = false, bool SP2 = false>
__device__ __forceinline__ void gemm_phase(PG8_LAS unsigned char* lds, const Gemm g, const Sched& S, const Epi& E) {
    const int tid = threadIdx.x, wid = __builtin_amdgcn_readfirstlane(tid >> 6), lane = tid & 63, wr = wid >> 2, wc = wid & 3, fr = lane & 15, fq = lane >> 4;
    const int K = g.K, nt = K / BK;
    unsigned voffA[2], voffB[2];
#pragma unroll
    for (int i = 0; i < 2; ++i) { int R, C; stage_rc(tid * 16 + i * 8192, R, C); const int Rb = Epi::PERM ? ((R & ~31) + perm32(R & 31)) : R;
        voffA[i] = (unsigned)(R * K + C) * 2u; voffB[i] = (unsigned)(Rb * K + C) * 2u; }
    const size_t kstep = (size_t)(BK * 2);
    const size_t hstep = (size_t)HALF * K * 2;
    const size_t tstep = 2 * hstep;
    const unsigned ldsw = (unsigned)wid * 1024u;
    const int aoff = lds_byte(wr * 64 + fr, fq * 8), boff = lds_byte(wc * 32 + fr, fq * 8);
#define PG8_SA(b, h) (((b) * 2 + (h)) * HTB)
#define PG8_SB(b, h) ((4 + (b) * 2 + (h)) * HTB)
#define PG8_STAGE(bufoff, gbase, voff) do { _Pragma("unroll") for (int _i = 0; _i < 2; ++_i) \
        __builtin_amdgcn_global_load_lds((const unsigned*)((const char*)(gbase) + (voff)[_i]), (PG8_LAS unsigned*)(lds + (bufoff) + ldsw + _i * 8192), 16, 0, 0); } while (0)
#define PG8_LDA(dst, b, h) do { _Pragma("unroll") for (int m = 0; m < 4; ++m) _Pragma("unroll") for (int k = 0; k < 2; ++k) dst[m][k] = *(const PG8_LAS bf16x8*)(lds + PG8_SA(b, h) + aoff + m * 2048 + k * 1024); } while (0)
#define PG8_LDB(dst, b, h) do { _Pragma("unroll") for (int n = 0; n < 2; ++n) _Pragma("unroll") for (int k = 0; k < 2; ++k) dst[n][k] = *(const PG8_LAS bf16x8*)(lds + PG8_SB(b, h) + boff + n * 2048 + k * 1024); } while (0)
#define PG8_MMA(ai, bj, At, Bt) do { __builtin_amdgcn_s_setprio(1); _Pragma("unroll") for (int m = 0; m < 4; ++m) _Pragma("unroll") for (int n = 0; n < 2; ++n) _Pragma("unroll") for (int k = 0; k < 2; ++k) \
        acc[ai][bj][m][n] = __builtin_amdgcn_mfma_f32_16x16x32_bf16(Bt[n][k], At[m][k], acc[ai][bj][m][n], 0, 0, 0); __builtin_amdgcn_s_setprio(0); } while (0)
#define PG8_WAIT_V(n) asm volatile("s_waitcnt vmcnt(" #n ")" ::: "memory")
#define PG8_WAIT_L(n) asm volatile("s_waitcnt lgkmcnt(" #n ")" ::: "memory")
#define PG8_BAR __builtin_amdgcn_s_barrier()
#define PG8_SCHED __builtin_amdgcn_sched_barrier(0)
    Unit cur, nxt; int ui = 0;
    if (!S.next(0, cur)) return;
    f32x4 acc[2][2][4][2];
#pragma unroll
    for (int a = 0; a < 2; ++a)
#pragma unroll
        for (int b = 0; b < 2; ++b)
#pragma unroll
            for (int m = 0; m < 4; ++m)
#pragma unroll
                for (int n = 0; n < 2; ++n) acc[a][b][m][n] = (f32x4){0.f, 0.f, 0.f, 0.f};
    bf16x8 At[4][2], B0[2][2], B1[2][2];
    const char* cA = (const char*)g.A + (size_t)cur.pm * tstep; const char* cB = (const char*)g.Bt + (size_t)cur.pb * tstep;
    S.a_ready(cur);
    if constexpr (SP2) {
        PG8_STAGE(PG8_SB(0, 0), cB, voffB); PG8_STAGE(PG8_SB(0, 1), cB + hstep, voffB); PG8_STAGE(PG8_SA(0, 0), cA, voffA); PG8_STAGE(PG8_SA(0, 1), cA + hstep, voffA);
        if (wr == 1) PG8_BAR;
        PG8_WAIT_V(2); PG8_BAR;
        PG8_STAGE(PG8_SB(1, 0), cB + kstep, voffB); PG8_STAGE(PG8_SA(1, 0), cA + kstep, voffA); PG8_STAGE(PG8_SB(1, 1), cB + hstep + kstep, voffB);
        PG8_WAIT_V(6); PG8_BAR;
    } else {
        PG8_STAGE(PG8_SB(0, 0), cB, voffB); PG8_STAGE(PG8_SA(0, 0), cA, voffA); PG8_STAGE(PG8_SB(0, 1), cB + hstep, voffB); PG8_STAGE(PG8_SA(0, 1), cA + hstep, voffA);
        if (wr == 1) PG8_BAR;
        PG8_WAIT_V(4); PG8_BAR;
        PG8_STAGE(PG8_SB(1, 0), cB + kstep, voffB); PG8_STAGE(PG8_SA(1, 0), cA + kstep, voffA); PG8_STAGE(PG8_SB(1, 1), cB + hstep + kstep, voffB);
        PG8_WAIT_V(6); PG8_BAR;
    }
    for (;;) {
        const bool has_next = S.next(ui + 1, nxt);
        const char* nA = has_next ? (const char*)g.A + (size_t)nxt.pm * tstep : cA; const char* nB = has_next ? (const char*)g.Bt + (size_t)nxt.pb * tstep : cB;
        for (int t = 0; t < nt; t += 2) {
            const bool last = (t == nt - 2);
            const char* a1 = cA + (size_t)(t + 1) * kstep;
            const char* a2 = last ? nA : cA + (size_t)(t + 2) * kstep; const char* b2 = last ? nB : cB + (size_t)(t + 2) * kstep;
            const char* a3 = a2 + kstep; const char* b3 = b2 + kstep;
            if (last && has_next) S.a_ready(nxt);
            if constexpr (SP2) {
            PG8_LDB(B0, 0, 0); PG8_LDB(B1, 0, 1); PG8_SCHED; PG8_LDA(At, 0, 0); PG8_STAGE(PG8_SA(1, 1), a1 + hstep, voffA);
            PG8_WAIT_V(8); PG8_WAIT_L(0); PG8_BAR; PG8_MMA(0, 0, At, B0); PG8_MMA(0, 1, At, B1); PG8_BAR; PG8_SCHED;
            PG8_LDA(At, 0, 1); PG8_STAGE(PG8_SB(0, 0), b2, voffB); PG8_STAGE(PG8_SB(0, 1), b2 + hstep, voffB); PG8_STAGE(PG8_SA(0, 0), a2, voffA);
            PG8_WAIT_V(8); PG8_WAIT_L(0); PG8_BAR; PG8_MMA(1, 0, At, B0); PG8_MMA(1, 1, At, B1); PG8_BAR; PG8_SCHED;
            PG8_LDB(B0, 1, 0); PG8_LDB(B1, 1, 1); PG8_SCHED; PG8_LDA(At, 1, 0); PG8_STAGE(PG8_SA(0, 1), a2 + hstep, voffA);
            PG8_WAIT_V(8); PG8_WAIT_L(0); PG8_BAR; PG8_MMA(0, 0, At, B0); PG8_MMA(0, 1, At, B1); PG8_BAR; PG8_SCHED;
            PG8_LDA(At, 1, 1); PG8_STAGE(PG8_SB(1, 0), b3, voffB); PG8_STAGE(PG8_SB(1, 1), b3 + hstep, voffB); PG8_STAGE(PG8_SA(1, 0), a3, voffA);
            PG8_WAIT_V(8); PG8_WAIT_L(0); PG8_BAR; PG8_MMA(1, 0, At, B0); PG8_MMA(1, 1, At, B1); PG8_BAR; PG8_SCHED;
            } else {
            PG8_LDB(B0, 0, 0); PG8_SCHED; PG8_LDA(At, 0, 0); PG8_STAGE(PG8_SA(1, 1), a1 + hstep, voffA);
            PG8_WAIT_L(8); PG8_BAR; PG8_WAIT_L(0); PG8_MMA(0, 0, At, B0); PG8_BAR; PG8_SCHED;
            PG8_LDB(B1, 0, 1); PG8_STAGE(PG8_SB(0, 0), b2, voffB);
            PG8_BAR; PG8_WAIT_L(0); PG8_MMA(0, 1, At, B1); PG8_BAR;
            PG8_LDA(At, 0, 1); PG8_STAGE(PG8_SA(0, 0), a2, voffA);
            PG8_BAR; PG8_WAIT_L(0); PG8_MMA(1, 0, At, B0); PG8_BAR; PG8_SCHED;
            PG8_STAGE(PG8_SB(0, 1), b2 + hstep, voffB);
            PG8_WAIT_V(6); PG8_BAR; PG8_MMA(1, 1, At, B1); PG8_BAR;
            PG8_LDB(B0, 1, 0); PG8_SCHED; PG8_LDA(At, 1, 0); PG8_STAGE(PG8_SA(0, 1), a2 + hstep, voffA);
            PG8_WAIT_L(8); PG8_BAR; PG8_WAIT_L(0); PG8_MMA(0, 0, At, B0); PG8_BAR; PG8_SCHED;
            PG8_LDB(B1, 1, 1); PG8_STAGE(PG8_SB(1, 0), b3, voffB);
            PG8_BAR; PG8_WAIT_L(0); PG8_MMA(0, 1, At, B1); PG8_BAR;
            PG8_LDA(At, 1, 1); PG8_STAGE(PG8_SA(1, 0), a3, voffA);
            PG8_BAR; PG8_WAIT_L(0); PG8_MMA(1, 0, At, B0); PG8_BAR; PG8_SCHED;
            PG8_STAGE(PG8_SB(1, 1), b3 + hstep, voffB);
            PG8_WAIT_V(6); PG8_BAR; PG8_MMA(1, 1, At, B1); PG8_BAR;
            }
        }
        if constexpr (ALIGN_EPI) { if (wr == 0) PG8_BAR; }
        if constexpr (!Epi::AFTER_DRAIN) { E(acc, cur, wr, wc, fr, fq); S.done(cur); }
        if (!has_next) break;
#pragma unroll
        for (int a = 0; a < 2; ++a)
#pragma unroll
            for (int b = 0; b < 2; ++b)
#pragma unroll
                for (int m = 0; m < 4; ++m)
#pragma unroll
                    for (int n = 0; n < 2; ++n) acc[a][b][m][n] = (f32x4){0.f, 0.f, 0.f, 0.f};
        cur = nxt; cA = nA; cB = nB; ++ui;
        if constexpr (ALIGN_EPI) { if (wr == 1) PG8_BAR; }
    }
    PG8_WAIT_V(0);
    if constexpr (!ALIGN_EPI) { if (wr == 0) PG8_BAR; }
    PG8_BAR;
    if constexpr (Epi::AFTER_DRAIN) { E.fused(acc, cur, wr, wc, fr, fq, lds, wid, lane); S.done(cur); }
#undef PG8_SA
#undef PG8_SB
#undef PG8_STAGE
#undef PG8_LDA
#undef PG8_LDB
#undef PG8_MMA
#undef PG8_WAIT_V
#undef PG8_WAIT_L
#undef PG8_BAR
#undef PG8_SCHED
}
template <class Epi, class Sched, bool ALIGN_EPI = false, bool SP2 = false>
__device__ __forceinline__ void gemm_phase_i8(PG8_LAS unsigned char* lds, const Gemm g, const Sched& S, const Epi& E) {
    const int tid = threadIdx.x, wid = __builtin_amdgcn_readfirstlane(tid >> 6), lane = tid & 63, wr = wid >> 2, wc = wid & 3, fr = lane & 15, fq = lane >> 4;
    const int K = g.K, nt = K / 128;
    unsigned voffA[2], voffB[2];
#pragma unroll
    for (int i = 0; i < 2; ++i) { int R, C; stage_rc(tid * 16 + i * 8192, R, C); const int Rb = Epi::PERM ? ((R & ~31) + perm32(R & 31)) : R;
        voffA[i] = (unsigned)(R * K + C * 2); voffB[i] = (unsigned)(Rb * K + C * 2); }
    const size_t kstep = (size_t)(BK * 2);
    const size_t hstep = (size_t)HALF * K;
    const size_t tstep = 2 * hstep;
    const unsigned ldsw = (unsigned)wid * 1024u;
    const int aoff = lds_byte(wr * 64 + fr, fq * 8), boff = lds_byte(wc * 32 + fr, fq * 8);
#define PG8_SA(b, h) (((b) * 2 + (h)) * HTB)
#define PG8_SB(b, h) ((4 + (b) * 2 + (h)) * HTB)
#define PG8_STAGE(bufoff, gbase, voff) do { _Pragma("unroll") for (int _i = 0; _i < 2; ++_i) \
        __builtin_amdgcn_global_load_lds((const unsigned*)((const char*)(gbase) + (voff)[_i]), (PG8_LAS unsigned*)(lds + (bufoff) + ldsw + _i * 8192), 16, 0, 0); } while (0)
#define PG8_LDA(dst, b, h) do { _Pragma("unroll") for (int m = 0; m < 4; ++m) _Pragma("unroll") for (int k = 0; k < 2; ++k) dst[m][k] = *(const PG8_LAS bf16x8*)(lds + PG8_SA(b, h) + aoff + m * 2048 + k * 1024); } while (0)
#define PG8_LDB(dst, b, h) do { _Pragma("unroll") for (int n = 0; n < 2; ++n) _Pragma("unroll") for (int k = 0; k < 2; ++k) dst[n][k] = *(const PG8_LAS bf16x8*)(lds + PG8_SB(b, h) + boff + n * 2048 + k * 1024); } while (0)
#define PG8_MMA(ai, bj, At, Bt) do { __builtin_amdgcn_s_setprio(1); _Pragma("unroll") for (int m = 0; m < 4; ++m) _Pragma("unroll") for (int n = 0; n < 2; ++n) _Pragma("unroll") for (int k = 0; k < 2; ++k) \
        acc[ai][bj][m][n] = __builtin_amdgcn_mfma_i32_16x16x64_i8(__builtin_bit_cast(i32x4, Bt[n][k]), __builtin_bit_cast(i32x4, At[m][k]), acc[ai][bj][m][n], 0, 0, 0); __builtin_amdgcn_s_setprio(0); } while (0)
#define PG8_WAIT_V(n) asm volatile("s_waitcnt vmcnt(" #n ")" ::: "memory")
#define PG8_WAIT_L(n) asm volatile("s_waitcnt lgkmcnt(" #n ")" ::: "memory")
#define PG8_BAR __builtin_amdgcn_s_barrier()
#define PG8_SCHED __builtin_amdgcn_sched_barrier(0)
    Unit cur, nxt; int ui = 0;
    if (!S.next(0, cur)) return;
    i32x4 acc[2][2][4][2];
#pragma unroll
    for (int a = 0; a < 2; ++a)
#pragma unroll
        for (int b = 0; b < 2; ++b)
#pragma unroll
            for (int m = 0; m < 4; ++m)
#pragma unroll
                for (int n = 0; n < 2; ++n) acc[a][b][m][n] = (i32x4){0, 0, 0, 0};
    bf16x8 At[4][2], B0[2][2], B1[2][2];
    const char* cA = (const char*)g.A + (size_t)cur.pm * tstep; const char* cB = (const char*)g.Bt + (size_t)cur.pb * tstep;
    S.a_ready(cur);
    if constexpr (SP2) {
        PG8_STAGE(PG8_SB(0, 0), cB, voffB); PG8_STAGE(PG8_SB(0, 1), cB + hstep, voffB); PG8_STAGE(PG8_SA(0, 0), cA, voffA); PG8_STAGE(PG8_SA(0, 1), cA + hstep, voffA);
        if (wr == 1) PG8_BAR;
        PG8_WAIT_V(2); PG8_BAR;
        PG8_STAGE(PG8_SB(1, 0), cB + kstep, voffB); PG8_STAGE(PG8_SA(1, 0), cA + kstep, voffA); PG8_STAGE(PG8_SB(1, 1), cB + hstep + kstep, voffB);
        PG8_WAIT_V(6); PG8_BAR;
    } else {
        PG8_STAGE(PG8_SB(0, 0), cB, voffB); PG8_STAGE(PG8_SA(0, 0), cA, voffA); PG8_STAGE(PG8_SB(0, 1), cB + hstep, voffB); PG8_STAGE(PG8_SA(0, 1), cA + hstep, voffA);
        if (wr == 1) PG8_BAR;
        PG8_WAIT_V(4); PG8_BAR;
        PG8_STAGE(PG8_SB(1, 0), cB + kstep, voffB); PG8_STAGE(PG8_SA(1, 0), cA + kstep, voffA); PG8_STAGE(PG8_SB(1, 1), cB + hstep + kstep, voffB);
        PG8_WAIT_V(6); PG8_BAR;
    }
    for (;;) {
        const bool has_next = S.next(ui + 1, nxt);
        const char* nA = has_next ? (const char*)g.A + (size_t)nxt.pm * tstep : cA; const char* nB = has_next ? (const char*)g.Bt + (size_t)nxt.pb * tstep : cB;
        for (int t = 0; t < nt; t += 2) {
            const bool last = (t == nt - 2);
            const char* a1 = cA + (size_t)(t + 1) * kstep;
            const char* a2 = last ? nA : cA + (size_t)(t + 2) * kstep; const char* b2 = last ? nB : cB + (size_t)(t + 2) * kstep;
            const char* a3 = a2 + kstep; const char* b3 = b2 + kstep;
            if (last && has_next) S.a_ready(nxt);
            if constexpr (SP2) {
            PG8_LDB(B0, 0, 0); PG8_LDB(B1, 0, 1); PG8_SCHED; PG8_LDA(At, 0, 0); PG8_STAGE(PG8_SA(1, 1), a1 + hstep, voffA);
            PG8_WAIT_V(8); PG8_WAIT_L(0); PG8_BAR; PG8_MMA(0, 0, At, B0); PG8_MMA(0, 1, At, B1); PG8_BAR; PG8_SCHED;
            PG8_LDA(At, 0, 1); PG8_STAGE(PG8_SB(0, 0), b2, voffB); PG8_STAGE(PG8_SB(0, 1), b2 + hstep, voffB); PG8_STAGE(PG8_SA(0, 0), a2, voffA);
            PG8_WAIT_V(8); PG8_WAIT_L(0); PG8_BAR; PG8_MMA(1, 0, At, B0); PG8_MMA(1, 1, At, B1); PG8_BAR; PG8_SCHED;
            PG8_LDB(B0, 1, 0); PG8_LDB(B1, 1, 1); PG8_SCHED; PG8_LDA(At, 1, 0); PG8_STAGE(PG8_SA(0, 1), a2 + hstep, voffA);
            PG8_WAIT_V(8); PG8_WAIT_L(0); PG8_BAR; PG8_MMA(0, 0, At, B0); PG8_MMA(0, 1, At, B1); PG8_BAR; PG8_SCHED;
            PG8_LDA(At, 1, 1); PG8_STAGE(PG8_SB(1, 0), b3, voffB); PG8_STAGE(PG8_SB(1, 1), b3 + hstep, voffB); PG8_STAGE(PG8_SA(1, 0), a3, voffA);
            PG8_WAIT_V(8); PG8_WAIT_L(0); PG8_BAR; PG8_MMA(1, 0, At, B0); PG8_MMA(1, 1, At, B1); PG8_BAR; PG8_SCHED;
            } else {
            PG8_LDB(B0, 0, 0); PG8_SCHED; PG8_LDA(At, 0, 0); PG8_STAGE(PG8_SA(1, 1), a1 + hstep, voffA);
            PG8_WAIT_L(8); PG8_BAR; PG8_WAIT_L(0); PG8_MMA(0, 0, At, B0); PG8_BAR; PG8_SCHED;
            PG8_LDB(B1, 0, 1); PG8_STAGE(PG8_SB(0, 0), b2, voffB);
            PG8_BAR; PG8_WAIT_L(0); PG8_MMA(0, 1, At, B1); PG8_BAR;
            PG8_LDA(At, 0, 1); PG8_STAGE(PG8_SA(0, 0), a2, voffA);
            PG8_BAR; PG8_WAIT_L(0); PG8_MMA(1, 0, At, B0); PG8_BAR; PG8_SCHED;
            PG8_STAGE(PG8_SB(0, 1), b2 + hstep, voffB);
            PG8_WAIT_V(6); PG8_BAR; PG8_MMA(1, 1, At, B1); PG8_BAR;
            PG8_LDB(B0, 1, 0); PG8_SCHED; PG8_LDA(At, 1, 0); PG8_STAGE(PG8_SA(0, 1), a2 + hstep, voffA);
            PG8_WAIT_L(8); PG8_BAR; PG8_WAIT_L(0); PG8_MMA(0, 0, At, B0); PG8_BAR; PG8_SCHED;
            PG8_LDB(B1, 1, 1); PG8_STAGE(PG8_SB(1, 0), b3, voffB);
            PG8_BAR; PG8_WAIT_L(0); PG8_MMA(0, 1, At, B1); PG8_BAR;
            PG8_LDA(At, 1, 1); PG8_STAGE(PG8_SA(1, 0), a3, voffA);
            PG8_BAR; PG8_WAIT_L(0); PG8_MMA(1, 0, At, B0); PG8_BAR; PG8_SCHED;
            PG8_STAGE(PG8_SB(1, 1), b3 + hstep, voffB);
            PG8_WAIT_V(6); PG8_BAR; PG8_MMA(1, 1, At, B1); PG8_BAR;
            }
        }
        if constexpr (ALIGN_EPI) { if (wr == 0) PG8_BAR; }
        if constexpr (!Epi::AFTER_DRAIN) { E(acc, cur, wr, wc, fr, fq); S.done(cur); }
        if (!has_next) break;
#pragma unroll
        for (int a = 0; a < 2; ++a)
#pragma unroll
            for (int b = 0; b < 2; ++b)
#pragma unroll
                for (int m = 0; m < 4; ++m)
#pragma unroll
                    for (int n = 0; n < 2; ++n) acc[a][b][m][n] = (i32x4){0, 0, 0, 0};
        cur = nxt; cA = nA; cB = nB; ++ui;
        if constexpr (ALIGN_EPI) { if (wr == 1) PG8_BAR; }
    }
    PG8_WAIT_V(0);
    if constexpr (!ALIGN_EPI) { if (wr == 0) PG8_BAR; }
    PG8_BAR;
    if constexpr (Epi::AFTER_DRAIN) { E.fused(acc, cur, wr, wc, fr, fq, lds, wid, lane); S.done(cur); }
#undef PG8_SA
#undef PG8_SB
#undef PG8_STAGE
#undef PG8_LDA
#undef PG8_LDB
#undef PG8_MMA
#undef PG8_WAIT_V
#undef PG8_WAIT_L
#undef PG8_BAR
#undef PG8_SCHED
}

}
#ifndef STAGE_REP
#define STAGE_REP 0
#endif

constexpr int NWAVES = 8;
constexpr int D = 1024, BATCH = 2, T = 8192, TC = 256, NH = 16;
constexpr int ML = BATCH * T;
constexpr int MC = BATCH * TC;
constexpr int MT = ML + MC;
constexpr int N_IN = 8576, NZ = 8704;
constexpr int K_OFF = 0, V_OFF = 1024, DECAY_OFF = 2048, ICLR_OFF = 2176, STATE_COLS = 2304, R_OFF = 2304, GLORA_OFF = 3328, SHIFT_COLS = 3456;
constexpr int CONV_OFF = 3456, GATE_OFF = 6528;
constexpr int NE = 32, TOPK = 4, DFF = 1024;
constexpr int NL = 5120, KL = 384;
constexpr int MAXBLK = 288;
constexpr int NROWS = MAXBLK * 256;
constexpr int KSPLIT = 16;

constexpr size_t MiB = 1u << 20;
constexpr size_t WS_CTL = 0, CTL_ZERO_BYTES = 1 * MiB;
constexpr size_t WS_MODP = 1 * MiB;
constexpr size_t WS_WLORA = 3 * MiB;
constexpr size_t WS_WROUT = 7 * MiB;
constexpr size_t WS_WOUT = 8 * MiB;
constexpr size_t WS_WIN = 10 * MiB;
constexpr size_t WS_A0 = 28 * MiB;
constexpr size_t WS_MISC = 61 * MiB;
constexpr size_t WS_Z = 64 * MiB;
constexpr size_t WS_AL = 345 * MiB;
constexpr size_t WS_LORA = 358 * MiB;
constexpr size_t WS_SCAN = 523 * MiB;
constexpr size_t WS_Y = 886 * MiB;
constexpr size_t WS_END = 1014 * MiB;
constexpr size_t WS_PQ = WS_SCAN;
constexpr size_t WS_TKN = WS_PQ + 132 * MiB;
constexpr size_t WS_UPRE = WS_TKN + 66 * MiB;
constexpr size_t WS_H0T = WS_UPRE + 66 * MiB;
static_assert(WS_H0T + 64 * MiB <= WS_Y, "scan region");
constexpr size_t WS_MIX = WS_LORA, WS_X1 = WS_LORA + 64 * MiB, WS_H2 = WS_LORA + 128 * MiB;
constexpr size_t WS_LOGIT = WS_SCAN, WS_XB = WS_SCAN + 16 * MiB, WS_ACT = WS_XB + 144 * MiB;
constexpr size_t WS_Y2 = WS_Z, WS_WEIN = WS_Y, WS_WEOUT = WS_Y + 64 * MiB;
static_assert(WS_ACT + 144 * MiB <= WS_Y && WS_WEIN + 64 * MiB <= WS_WEOUT && WS_WEOUT + 64 * MiB <= WS_END, "late regions");
constexpr size_t MI_SELE = WS_MISC, MI_SELP = MI_SELE + (size_t)ML * 4 * 4, MI_GATE = MI_SELP + (size_t)ML * 4 * 4, MI_DEST = MI_GATE + (size_t)ML * 4 * 4, MI_BLKE = MI_DEST + (size_t)ML * 4 * 4;
constexpr size_t MI_RSH = MI_BLKE + 4096;
constexpr size_t MI_CSWIN = MI_RSH + (size_t)MT * 4;
constexpr size_t MI_RSH2 = MI_CSWIN + (size_t)NZ * 4;
constexpr size_t MI_RSXB = MI_RSH2 + (size_t)ML * 4;
constexpr size_t MI_CSWEI = MI_RSXB + (size_t)NROWS * 4;
constexpr size_t MI_BON = MI_CSWEI + (size_t)NE * 2048 * 4;
static_assert(MI_BON + (size_t)4096 * 64 * 4 <= WS_Z && MI_RSH % 16 == 0 && MI_CSWIN % 16 == 0 && MI_CSWEI % 16 == 0, "misc");
constexpr size_t WS_H2Q = WS_A0;
constexpr int CW_BAR = 4096;
constexpr int CW_CNT = 16384;
constexpr int CW_FB = 8192;
constexpr int CW_Q6 = CW_CNT + 64 * 40;

constexpr int RING_OFF = 0, RING_BYTES = 131072;
constexpr int LDSCTL_OFF = 147456, MISC_OFF = LDSCTL_OFF + 320;
constexpr int LDS_X_OFF = LDSCTL_OFF + 512;
constexpr int LDS_BYTES = 163840;

#define GAS __attribute__((address_space(1)))
#define LAS __attribute__((address_space(3)))
typedef unsigned short bf16;
typedef unsigned v4u __attribute__((ext_vector_type(4)));
typedef unsigned v2u __attribute__((ext_vector_type(2)));
typedef float f32x4 __attribute__((ext_vector_type(4)));
#define LDS_WAIT() asm volatile("s_waitcnt lgkmcnt(0)" ::: "memory")
#define VM_WAIT() asm volatile("s_waitcnt vmcnt(0)" ::: "memory")
__device__ __forceinline__ unsigned f2bf(float f) { unsigned u = __builtin_bit_cast(unsigned, f); return (u + 0x7fffu + ((u >> 16) & 1u)) >> 16; }
__device__ __forceinline__ unsigned pk2(float lo, float hi) { return f2bf(lo) | (f2bf(hi) << 16); }
typedef __bf16 bf16v2h_t __attribute__((ext_vector_type(2)));
__device__ __forceinline__ unsigned pk2h(float lo, float hi) { const bf16v2h_t v = {(__bf16)lo, (__bf16)hi}; return __builtin_bit_cast(unsigned, v); }
__device__ __forceinline__ float bflo(unsigned w) { return __builtin_bit_cast(float, w << 16); }
__device__ __forceinline__ float bfhi(unsigned w) { return __builtin_bit_cast(float, w & 0xffff0000u); }
__device__ __forceinline__ float bf1(bf16 h) { return __builtin_bit_cast(float, (unsigned)h << 16); }
__device__ __forceinline__ void ld16bf(const bf16* p, float (&o)[16]) {
    const v4u a = *(const v4u*)p, b = *(const v4u*)(p + 8);
    o[0] = bflo(a.x); o[1] = bfhi(a.x); o[2] = bflo(a.y); o[3] = bfhi(a.y); o[4] = bflo(a.z); o[5] = bfhi(a.z); o[6] = bflo(a.w); o[7] = bfhi(a.w);
    o[8] = bflo(b.x); o[9] = bfhi(b.x); o[10] = bflo(b.y); o[11] = bfhi(b.y); o[12] = bflo(b.z); o[13] = bfhi(b.z); o[14] = bflo(b.w); o[15] = bfhi(b.w);
}
__device__ __forceinline__ void st16bf(bf16* p, const float (&o)[16]) {
    v4u a, b; a.x = pk2(o[0], o[1]); a.y = pk2(o[2], o[3]); a.z = pk2(o[4], o[5]); a.w = pk2(o[6], o[7]);
    b.x = pk2(o[8], o[9]); b.y = pk2(o[10], o[11]); b.z = pk2(o[12], o[13]); b.w = pk2(o[14], o[15]);
    *(v4u*)p = a; *(v4u*)(p + 8) = b;
}
__device__ __forceinline__ void ld16f(const float* p, float (&o)[16]) {
#pragma unroll
    for (int q = 0; q < 4; ++q) { const f32x4 v = *(const f32x4*)(p + 4 * q); o[4 * q] = v.x; o[4 * q + 1] = v.y; o[4 * q + 2] = v.z; o[4 * q + 3] = v.w; }
}
__device__ __forceinline__ void ld16f_lds(const LAS float* p, float (&o)[16]) {
#pragma unroll
    for (int q = 0; q < 4; ++q) { const f32x4 v = *(const LAS f32x4*)(p + 4 * q); o[4 * q] = v.x; o[4 * q + 1] = v.y; o[4 * q + 2] = v.z; o[4 * q + 3] = v.w; }
}
__device__ __forceinline__ void st16f(float* p, const float (&o)[16]) {
#pragma unroll
    for (int q = 0; q < 4; ++q) *(f32x4*)(p + 4 * q) = (f32x4){o[4 * q], o[4 * q + 1], o[4 * q + 2], o[4 * q + 3]};
}
__device__ __forceinline__ float sigmoidf_(float x) { return 1.0f / (1.0f + __expf(-x)); }
__device__ __forceinline__ float wave_sum(float v) {
#pragma unroll
    for (int o = 1; o < 64; o <<= 1) v += __shfl_xor(v, o);
    return v;
}
__device__ __forceinline__ float wave_max(float v) {
#pragma unroll
    for (int o = 1; o < 64; o <<= 1) v = fmaxf(v, __shfl_xor(v, o));
    return v;
}
__device__ __forceinline__ unsigned pack_q4(float a, float b, float c, float d) {
    const int qa = __float2int_rn(a), qb = __float2int_rn(b), qc = __float2int_rn(c), qd = __float2int_rn(d);
    return (unsigned)(qa & 255) | ((unsigned)(qb & 255) << 8) | ((unsigned)(qc & 255) << 16) | ((unsigned)qd << 24);
}
__device__ __forceinline__ float quad_sum(float v) { v += __shfl_xor(v, 1); v += __shfl_xor(v, 2); return v; }

#define XB_TMO      128
#define XB_XCNT(j)  (256  + 64 * (j))
#define XB_XSUB(j)  (1280 + 64 * (j))
#define XB_XGEN(j)  (2304 + 64 * (j))
#define XB_TOP      3328
#define XB_TOPGEN   3392
#define XCD_BAR_WORDS 3456
#define XB_SPIN_CAP (1u << 18)

__device__ __forceinline__ unsigned xb_ld(unsigned* p)              { return __hip_atomic_load(p, __ATOMIC_RELAXED, __HIP_MEMORY_SCOPE_AGENT); }
__device__ __forceinline__ unsigned xb_add(unsigned* p, unsigned v) { return __hip_atomic_fetch_add(p, v, __ATOMIC_RELAXED, __HIP_MEMORY_SCOPE_AGENT); }
__device__ __forceinline__ unsigned xb_xcc_id() { return (unsigned)__builtin_amdgcn_s_getreg((3 << 11) | 20) & 0xFu; }
#define XB_SPIN(cond, bar) do { unsigned _sp = 0; while (cond) { __builtin_amdgcn_s_sleep(1); \
    if ((++_sp & 255u) == 0u) { if (xb_ld(&(bar)[XB_TMO])) break; if (_sp > XB_SPIN_CAP) { atomicAdd(&(bar)[XB_TMO], 1u); break; } } } } while (0)

struct XcdBarrier { unsigned* bar; unsigned x; volatile LAS unsigned* st; };

__device__ __forceinline__ XcdBarrier xcd_barrier_post(unsigned* bar, volatile LAS unsigned* st) {
    XcdBarrier b; b.bar = bar; b.x = xb_xcc_id(); b.st = st;
    if (threadIdx.x == 0) (void)xb_add(&bar[XB_XCNT(b.x)], 1u);
    return b;
}
__device__ __forceinline__ void xcd_barrier_complete(unsigned* bar, unsigned x, unsigned& nloc, unsigned& nx) {
    const unsigned G = gridDim.x * gridDim.y * gridDim.z;
    unsigned sum, cnt, mine, sp = 0u;
    for (;;) {
        sum = 0u; cnt = 0u; mine = 0u;
#pragma unroll
        for (unsigned j = 0; j < 16; ++j) { const unsigned c = xb_ld(&bar[XB_XCNT(j)]); sum += c; cnt += (c > 0u) ? 1u : 0u; mine = (j == x) ? c : mine; }
        if (sum == G) break;
        __builtin_amdgcn_s_sleep(1);
        if ((++sp & 255u) == 0u) { if (xb_ld(&bar[XB_TMO])) break; if (sp > XB_SPIN_CAP) { atomicAdd(&bar[XB_TMO], 1u); break; } }
    }
    nloc = mine > 0u ? mine : 1u; nx = cnt > 0u ? cnt : 1u;
}
__device__ __forceinline__ void xcd_barrier(const XcdBarrier& b) {
    asm volatile("s_waitcnt vmcnt(0)" ::: "memory");
    __syncthreads();
    if (threadIdx.x == 0) {
        unsigned* bar = b.bar;
        __builtin_amdgcn_s_waitcnt(0);
        unsigned nloc = b.st[0], nx = b.st[1];
        if (nloc == 0u) { xcd_barrier_complete(bar, b.x, nloc, nx); b.st[0] = nloc; b.st[1] = nx; }
        const unsigned old = xb_add(&bar[XB_XSUB(b.x)], 1u);
        const unsigned gen = old / nloc;
        if (old + 1u == (gen + 1u) * nloc) {
            __builtin_amdgcn_fence(__ATOMIC_RELEASE, "agent");
            asm volatile("s_waitcnt vmcnt(0)" ::: "memory");
            const unsigned og = xb_add(&bar[XB_TOP], 1u);
            const unsigned tg = og / nx;
            if (og + 1u == (tg + 1u) * nx) xb_add(&bar[XB_TOPGEN], 1u);
            else XB_SPIN(xb_ld(&bar[XB_TOPGEN]) == tg, bar);
            __builtin_amdgcn_fence(__ATOMIC_ACQUIRE, "agent");
            xb_add(&bar[XB_XGEN(b.x)], 1u);
            asm volatile("s_waitcnt vmcnt(0)" ::: "memory");
        } else {
            XB_SPIN(xb_ld(&bar[XB_XGEN(b.x)]) == gen, bar);
            __builtin_amdgcn_fence(__ATOMIC_ACQUIRE, "agent");
            asm volatile("s_waitcnt vmcnt(0)" ::: "memory");
        }
    }
    __syncthreads();
}

#define XB_DONE(j)  (3456 + 64 * (j))
__device__ __forceinline__ void xcd_barrier2(const XcdBarrier& b) {
    asm volatile("s_waitcnt vmcnt(0)" ::: "memory");
    __syncthreads();
    if (threadIdx.x == 0) {
        unsigned* bar = b.bar;
        __builtin_amdgcn_s_waitcnt(0);
        unsigned nloc = b.st[0], nx = b.st[1];
        if (nloc == 0u) { xcd_barrier_complete(bar, b.x, nloc, nx); b.st[0] = nloc; b.st[1] = nx; }
        const unsigned old = xb_add(&bar[XB_XSUB(b.x)], 1u);
        const unsigned gen = old / nloc;
        if (old + 1u == (gen + 1u) * nloc) {
            __builtin_amdgcn_fence(__ATOMIC_RELEASE, "agent");
            asm volatile("s_waitcnt vmcnt(0)" ::: "memory");
#pragma unroll
            for (unsigned j = 0; j < 16; ++j) (void)xb_add(&bar[XB_DONE(j)], 1u);
        }
        XB_SPIN(xb_ld(&bar[XB_DONE(b.x)]) < (gen + 1u) * nx, bar);
        __builtin_amdgcn_fence(__ATOMIC_ACQUIRE, "agent");
        asm volatile("s_waitcnt vmcnt(0)" ::: "memory");
    }
    __syncthreads();
}

#define FB_WORD(j) (64 * (j))
#define FB_TMO 640
__device__ __forceinline__ void flat_barrier(unsigned* fb, unsigned epoch) {
    asm volatile("s_waitcnt vmcnt(0)" ::: "memory");
    __syncthreads();
    if (threadIdx.x == 0) {
        __builtin_amdgcn_s_waitcnt(0);
        __builtin_amdgcn_fence(__ATOMIC_RELEASE, "agent");
        asm volatile("s_waitcnt vmcnt(0)" ::: "memory");
        (void)xb_add(&fb[FB_WORD(blockIdx.x & 7u)], 1u);
        const unsigned want = epoch * gridDim.x; unsigned sp = 0u;
        for (;;) {
            unsigned s = 0u;
#pragma unroll
            for (int j = 0; j < 8; ++j) s += xb_ld(&fb[FB_WORD(j)]);
            if (s >= want) break;
            __builtin_amdgcn_s_sleep(1);
            if ((++sp & 255u) == 0u) { if (xb_ld(&fb[FB_TMO])) break; if (sp > XB_SPIN_CAP) { atomicAdd(&fb[FB_TMO], 1u); break; } }
        }
        __builtin_amdgcn_fence(__ATOMIC_ACQUIRE, "agent");
        asm volatile("s_waitcnt vmcnt(0)" ::: "memory");
    }
    __syncthreads();
}

struct Frame {
    LAS unsigned char* lds;
    volatile LAS unsigned* MISC;
    unsigned* ctl;
    int tid, lane, wave, G, gw, NGW;
    float* out;
    unsigned char* ws;
};
enum { I_X = 0, I_C, I_CTX, I_CCTX, I_WADA, I_BADA, I_NPM, I_NQM, I_NPF, I_NQF, I_WIN, I_MU, I_W0, I_WDU, I_A0, I_WIU, I_KK, I_KA, I_RK, I_WGU, I_LNW, I_LNB, I_CONVW,
       I_WOUT, I_WR, I_BR, I_WEI, I_BEI, I_WEO, I_BEO };


typedef const float* fptr_t;
__device__ __forceinline__ fptr_t kin_ptr(int i) { const volatile __attribute__((address_space(4))) fptr_t* ka = (const volatile __attribute__((address_space(4))) fptr_t*)__builtin_amdgcn_kernarg_segment_ptr(); return ka[i]; }
#define KIN(i) kin_ptr(i)
__device__ __forceinline__ void transpose_item(const float* W, int N, int k0, int n0, bf16* WT, int ldk, int rowbase, LAS float* scr, int lane) {
#pragma unroll 8
    for (int i = 0; i < 32; ++i) { const int kk = 2 * i + (lane >> 5); scr[kk * 33 + (lane & 31)] = W[(size_t)(k0 + kk) * N + n0 + (lane & 31)]; }
    LDS_WAIT(); asm volatile("" ::: "memory");
    const int c = lane & 7;
#pragma unroll
    for (int j = 0; j < 4; ++j) { const int n = (lane >> 3) + 8 * j; const LAS float* s = scr + (8 * c) * 33 + n;
        v4u o; o.x = pk2(s[0 * 33], s[1 * 33]); o.y = pk2(s[2 * 33], s[3 * 33]); o.z = pk2(s[4 * 33], s[5 * 33]); o.w = pk2(s[6 * 33], s[7 * 33]);
        *(v4u*)(WT + (size_t)(rowbase + n) * ldk + k0 + 8 * c) = o; }
    LDS_WAIT(); asm volatile("" ::: "memory");
}

__device__ __forceinline__ unsigned pack_q4c(float a, float b, float c, float d) {
    const int qa = __float2int_rn(fminf(fmaxf(a, -127.f), 127.f)), qb = __float2int_rn(fminf(fmaxf(b, -127.f), 127.f)), qc = __float2int_rn(fminf(fmaxf(c, -127.f), 127.f)), qd = __float2int_rn(fminf(fmaxf(d, -127.f), 127.f));
    return (unsigned)(qa & 255) | ((unsigned)(qb & 255) << 8) | ((unsigned)(qc & 255) << 16) | ((unsigned)qd << 24);
}
__device__ __forceinline__ void q8_item(const float* W, int N, int n0, signed char* WT, float* cs, int rowbase, LAS float* scr, int lane, int kb0 = 0, int kb1 = 16) {
    const int r8 = lane >> 3, c4 = lane & 7;
    const float* p0 = W + (size_t)r8 * N + n0 + 4 * c4;
    f32x4 ss = {0.f, 0.f, 0.f, 0.f};
#pragma unroll
    for (int hb = 0; hb < 2; ++hb) {
        f32x4 v[16];
#pragma unroll
        for (int i = 0; i < 16; ++i) v[i] = *(const f32x4*)(p0 + (size_t)(8 * (16 * hb + i)) * N);
        __builtin_amdgcn_sched_barrier(0);
#pragma unroll
        for (int i = 0; i < 16; ++i) ss += v[i] * v[i];
    }
#pragma unroll
    for (int o = 8; o < 64; o <<= 1) { ss.x += __shfl_xor(ss.x, o); ss.y += __shfl_xor(ss.y, o); ss.z += __shfl_xor(ss.z, o); ss.w += __shfl_xor(ss.w, o); }
    if (lane < 8) {
#pragma unroll
        for (int q = 0; q < 4; ++q) { const float m = 6.0f * sqrtf(ss[q] * (1.0f / 256.0f)); cs[rowbase + 4 * lane + q] = m * (1.0f / 127.0f); scr[2112 + 4 * lane + q] = m > 0.f ? 127.0f / m : 0.f; } }
    LDS_WAIT(); asm volatile("" ::: "memory");
    f32x4 cur[8];
#pragma unroll
    for (int i = 0; i < 8; ++i) cur[i] = *(const f32x4*)(p0 + (size_t)(64 * kb0 + 8 * i) * N);
    for (int kb = kb0; kb < kb1; ++kb) {
        f32x4 nxt[8];
        const int kn = kb < kb1 - 1 ? kb + 1 : kb;
#pragma unroll
        for (int i = 0; i < 8; ++i) nxt[i] = *(const f32x4*)(p0 + (size_t)(64 * kn + 8 * i) * N);
#pragma unroll
        for (int i = 0; i < 8; ++i) { LAS float* s = scr + (r8 + 8 * i) * 33 + 4 * c4; s[0] = cur[i].x; s[1] = cur[i].y; s[2] = cur[i].z; s[3] = cur[i].w; }
        LDS_WAIT(); asm volatile("" ::: "memory");
        const int c = lane & 3;
#pragma unroll
        for (int j = 0; j < 2; ++j) { const int n = (lane >> 2) + 16 * j; const float iv = scr[2112 + n]; const LAS float* s = scr + (16 * c) * 33 + n;
            v4u o; o.x = pack_q4c(s[0] * iv, s[33] * iv, s[66] * iv, s[99] * iv); o.y = pack_q4c(s[132] * iv, s[165] * iv, s[198] * iv, s[231] * iv);
            o.z = pack_q4c(s[264] * iv, s[297] * iv, s[330] * iv, s[363] * iv); o.w = pack_q4c(s[396] * iv, s[429] * iv, s[462] * iv, s[495] * iv);
            *(v4u*)(WT + (size_t)(rowbase + n) * 1024 + 64 * kb + 16 * c) = o; }
        LDS_WAIT(); asm volatile("" ::: "memory");
#pragma unroll
        for (int i = 0; i < 8; ++i) cur[i] = nxt[i];
    }
}

struct CvTile { f32x4 v[8]; };
__device__ __forceinline__ void cv_load(CvTile& t, const float* W, int N, int n0, int kb, int lane) {
    const float* p0 = W + (size_t)(64 * kb + (lane >> 3)) * N + n0 + 4 * (lane & 7);
#pragma unroll
    for (int i = 0; i < 8; ++i) t.v[i] = *(const f32x4*)(p0 + (size_t)(8 * i) * N);
}
__device__ __forceinline__ void cv_to_lds(const CvTile& t, LAS float* scr, int lane) {
    const int r8 = lane >> 3, c4 = lane & 7;
#pragma unroll
    for (int i = 0; i < 8; ++i) { LAS float* s = scr + (r8 + 8 * i) * 33 + 4 * c4; s[0] = t.v[i].x; s[1] = t.v[i].y; s[2] = t.v[i].z; s[3] = t.v[i].w; }
    LDS_WAIT(); asm volatile("" ::: "memory");
}
__device__ __forceinline__ void cv_store_bf16(const LAS float* scr, bf16* WT, int ldk, int rowbase, int k0, int lane) {
    const int c = lane & 7;
#pragma unroll
    for (int j = 0; j < 4; ++j) { const int n = (lane >> 3) + 8 * j; const LAS float* s = scr + (8 * c) * 33 + n;
        v4u o; o.x = pk2h(s[0 * 33], s[1 * 33]); o.y = pk2h(s[2 * 33], s[3 * 33]); o.z = pk2h(s[4 * 33], s[5 * 33]); o.w = pk2h(s[6 * 33], s[7 * 33]);
        *(v4u*)(WT + (size_t)(rowbase + n) * ldk + k0 + 8 * c) = o; }
    LDS_WAIT(); asm volatile("" ::: "memory");
}
__device__ __forceinline__ unsigned q8_pack4(float a, float b, float c, float d) {
    const float M = 12582912.0f;
    const unsigned x0 = __builtin_bit_cast(unsigned, __builtin_amdgcn_fmed3f(a, -127.f, 127.f) + M), x1 = __builtin_bit_cast(unsigned, __builtin_amdgcn_fmed3f(b, -127.f, 127.f) + M);
    const unsigned x2 = __builtin_bit_cast(unsigned, __builtin_amdgcn_fmed3f(c, -127.f, 127.f) + M), x3 = __builtin_bit_cast(unsigned, __builtin_amdgcn_fmed3f(d, -127.f, 127.f) + M);
    return __builtin_amdgcn_perm(x1, x0, 0x0c0c0400u) | __builtin_amdgcn_perm(x3, x2, 0x04000c0cu);
}
__device__ __forceinline__ void cv_store_q8(const CvTile& t, LAS float* scr, signed char* WT, int rowbase, int kb, const float (&iv)[4], int lane) {
    LAS unsigned* img = (LAS unsigned*)scr;
    const int r8 = lane >> 3, c4 = lane & 7;
#pragma unroll
    for (int i = 0; i < 8; ++i) img[(r8 + 8 * i) * 9 + c4] = q8_pack4(t.v[i].x * iv[0], t.v[i].y * iv[1], t.v[i].z * iv[2], t.v[i].w * iv[3]);
    LDS_WAIT(); asm volatile("" ::: "memory");
    const int c = lane & 3;
#pragma unroll
    for (int j = 0; j < 2; ++j) { const int n = (lane >> 2) + 16 * j; const unsigned bs = (unsigned)(n & 3);
        const unsigned s01 = 0x0c0c0000u | bs | ((4u + bs) << 8), s23 = 0x00000c0cu | (bs << 16) | ((4u + bs) << 24);
        const LAS unsigned* s = img + (16 * c) * 9 + (n >> 2);
        v4u o;
        o.x = __builtin_amdgcn_perm(s[9], s[0], s01) | __builtin_amdgcn_perm(s[27], s[18], s23);
        o.y = __builtin_amdgcn_perm(s[45], s[36], s01) | __builtin_amdgcn_perm(s[63], s[54], s23);
        o.z = __builtin_amdgcn_perm(s[81], s[72], s01) | __builtin_amdgcn_perm(s[99], s[90], s23);
        o.w = __builtin_amdgcn_perm(s[117], s[108], s01) | __builtin_amdgcn_perm(s[135], s[126], s23);
        *(v4u*)(WT + (size_t)(rowbase + n) * 1024 + 64 * kb + 16 * c) = o; }
    LDS_WAIT(); asm volatile("" ::: "memory");
}
__device__ __forceinline__ void cv_scale_q8(const float* W, int N, int n0, float* cs, int rowbase, int lane, float (&iv)[4]) {
    const float* p0 = W + (size_t)(lane >> 3) * N + n0 + 4 * (lane & 7);
    f32x4 ss = {0.f, 0.f, 0.f, 0.f};
#pragma unroll
    for (int hb = 0; hb < 2; ++hb) {
        f32x4 v[16];
#pragma unroll
        for (int i = 0; i < 16; ++i) v[i] = *(const f32x4*)(p0 + (size_t)(8 * (16 * hb + i)) * N);
        __builtin_amdgcn_sched_barrier(0);
#pragma unroll
        for (int i = 0; i < 16; ++i) ss += v[i] * v[i];
    }
#pragma unroll
    for (int o = 8; o < 64; o <<= 1) { ss.x += __shfl_xor(ss.x, o); ss.y += __shfl_xor(ss.y, o); ss.z += __shfl_xor(ss.z, o); ss.w += __shfl_xor(ss.w, o); }
#pragma unroll
    for (int q = 0; q < 4; ++q) { const float m = 6.0f * sqrtf(ss[q] * (1.0f / 256.0f)); if (lane < 8) cs[rowbase + 4 * lane + q] = m * (1.0f / 127.0f); iv[q] = m > 0.f ? 127.0f / m : 0.f; }
}
__device__ __forceinline__ void wei_strip(int s, int& e, int& n0, int& rowbase) { e = s >> 6; n0 = 32 * (s & 63); const int c = n0 & 1023; rowbase = (c >> 7) * 256 + (n0 >= 1024 ? 128 : 0) + (c & 127); }

template <int N>
__device__ __forceinline__ void mod_vals(const float* modp, const float* b_ada, int vec, const int (&j)[N], float (&out)[N]) {
    float p[N][KSPLIT], s[N];
#pragma unroll
    for (int n = 0; n < N; ++n) { s[n] = b_ada[j[n]];
#pragma unroll
        for (int ks = 0; ks < KSPLIT; ++ks) p[n][ks] = modp[((size_t)ks * 3 + vec) * 6144 + j[n]]; }
    __builtin_amdgcn_sched_barrier(0);
#pragma unroll
    for (int n = 0; n < N; ++n) {
#pragma unroll
        for (int ks = 0; ks < KSPLIT; ++ks) s[n] += p[n][ks];
        out[n] = s[n]; }
}
__device__ __forceinline__ float mod_val(const float* modp, const float* b_ada, int vec, int j) { const int jj[1] = {j}; float o[1]; mod_vals<1>(modp, b_ada, vec, jj, o); return o[0]; }
__device__ __forceinline__ int nbr_row(int row, int j) {
    if (row < ML) { const int t = row & (T - 1), gc = t & 63, gr = t >> 6;
        if (j == 0) return gc > 0 ? row - 1 : -1; if (j == 1) return gc < 63 ? row + 1 : -1; if (j == 2) return gr > 0 ? row - 64 : -1; return gr < 127 ? row + 64 : -1; }
    const int tc = (row - ML) & (TC - 1);
    if ((j & 1) == 0) return tc > 0 ? row - 1 : -1; return tc < TC - 1 ? row + 1 : -1;
}
__device__ __forceinline__ void load_shift16(const bf16* z, int row, int col0, const LAS float* mu, float (&out)[16]) {
    float s[16]; ld16bf(z + (size_t)row * NZ + col0, s);
    float m[16]; ld16f_lds(mu, m);
#pragma unroll
    for (int j = 0; j < 4; ++j) {
        const int nr = nbr_row(row, j); float t[16];
        if (nr >= 0) ld16bf(z + (size_t)nr * NZ + col0, t); else {
#pragma unroll
            for (int i = 0; i < 16; ++i) t[i] = 0.f; }
#pragma unroll
        for (int i = j; i < 16; i += 4) out[i] = s[i] + m[i] * (t[i] - s[i]);
    }
}

__device__ __forceinline__ void phase_prologue(Frame& F) {
    LAS float* scr = (LAS float*)(F.lds + RING_OFF + F.wave * 16384);
    LAS float* sil = (LAS float*)(F.lds + LDS_X_OFF);
    for (int i = F.tid; i < 3 * D; i += NWAVES * 64) { const int v = i / D, j = i % D; const float c = v < 2 ? KIN(I_C)[v * D + j] : KIN(I_CCTX)[j]; sil[i] = c / (1.0f + __expf(-c)); }
    __syncthreads();
    bf16* WoutT = (bf16*)(F.ws + WS_WOUT);
    constexpr int IT_WIN = (N_IN / 32) * 4, IT_WOUT = (D / 64) * (D / 32), IT_ADA = 24 * KSPLIT;
    constexpr int NITEMS = IT_ADA + IT_WIN + IT_WOUT;
    float* modp = (float*)(F.ws + WS_MODP);
    for (int it = F.gw; it < NITEMS; it += F.NGW) {
        int r = it;
        if (r < IT_ADA) {
            const int cc = r % 24, ks = r / 24, col = cc * 256 + F.lane * 4;
            f32x4 a0 = {0.f, 0.f, 0.f, 0.f}, a1 = a0, a2 = a0;
            const float* wp = KIN(I_WADA) + (size_t)(ks * 64) * 6144 + col;
#pragma unroll 8
            for (int k = 0; k < 64; ++k) { const f32x4 w = *(const f32x4*)(wp + (size_t)k * 6144); const int kk = ks * 64 + k;
                a0 += w * sil[kk]; a1 += w * sil[D + kk]; a2 += w * sil[2 * D + kk]; }
            *(f32x4*)(modp + ((size_t)ks * 3 + 0) * 6144 + col) = a0; *(f32x4*)(modp + ((size_t)ks * 3 + 1) * 6144 + col) = a1; *(f32x4*)(modp + ((size_t)ks * 3 + 2) * 6144 + col) = a2;
            continue; }
        r -= IT_ADA;
        if (r < IT_WIN) { const int st = r >> 2, qq = r & 3; q8_item(KIN(I_WIN), N_IN, 32 * st, (signed char*)(F.ws + WS_WIN), (float*)(F.ws + MI_CSWIN), 32 * st, scr, F.lane, 4 * qq, 4 * qq + 4); continue; }
        r -= IT_WIN;
        { const int nb = D / 32, kb = r / nb, n0 = 32 * (r % nb); transpose_item(KIN(I_WOUT), D, 64 * kb, n0, WoutT, D, n0, scr, F.lane); }
    }
    const int gt = blockIdx.x * (NWAVES * 64) + F.tid, NGT = F.G * NWAVES * 64;
    for (int i = gt; i < (NZ - N_IN) * D / 16; i += NGT) *(v4u*)(F.ws + WS_WIN + (size_t)N_IN * D + (size_t)i * 16) = (v4u){0u, 0u, 0u, 0u};
    for (int i = gt; i < NZ - N_IN; i += NGT) ((float*)(F.ws + MI_CSWIN))[N_IN + i] = 0.f;
    bf16* WL = (bf16*)(F.ws + WS_WLORA);
    for (int i = gt; i < NL * (KL / 8); i += NGT) {
        const int c8 = i / NL, row = i % NL, blk = row >> 10, n = row & 1023, col = c8 * 8, g = col >> 6;
        const float* src = nullptr; int kofs = 0;
        if (blk < 2) { if (g == blk) { src = KIN(I_WDU) + (size_t)blk * 64 * D; kofs = col - 64 * blk; } }
        else if (blk < 4) { if (g == blk) { src = KIN(I_WIU) + (size_t)(blk - 2) * 64 * D; kofs = col - 64 * blk; } }
        else { if (g >= 4) { src = KIN(I_WGU); kofs = col - 256; } }
        v4u o = {0u, 0u, 0u, 0u};
        if (src) { float v[8];
#pragma unroll
            for (int q = 0; q < 8; ++q) v[q] = src[(size_t)(kofs + q) * D + n];
            o.x = pk2(v[0], v[1]); o.y = pk2(v[2], v[3]); o.z = pk2(v[4], v[5]); o.w = pk2(v[6], v[7]); }
        *(v4u*)(WL + (size_t)row * KL + col) = o;
    }
    bf16* WR = (bf16*)(F.ws + WS_WROUT);
    for (int i = gt; i < 256 * (D / 8); i += NGT) {
        const int row = i % 256, c8 = i / 256; v4u o = {0u, 0u, 0u, 0u};
        if (row < NE) { float v[8];
#pragma unroll
            for (int q = 0; q < 8; ++q) v[q] = KIN(I_WR)[(size_t)(c8 * 8 + q) * NE + row];
            o.x = pk2(v[0], v[1]); o.y = pk2(v[2], v[3]); o.z = pk2(v[4], v[5]); o.w = pk2(v[6], v[7]); }
        *(v4u*)(WR + (size_t)row * D + c8 * 8) = o;
    }
}

__device__ __forceinline__ void phase_hrows(Frame& F) {
    LAS float* LA = (LAS float*)(F.lds);
    LAS float* LB = LA + 3 * D;
    const float* modp = (const float*)(F.ws + WS_MODP);
    for (int i = F.tid; i < 3 * D; i += NWAVES * 64) { const int v = i / D, j = i % D;
        LA[i] = KIN(I_NPM)[j] * (1.0f + mod_val(modp, KIN(I_BADA), v, 1024 + j)); LB[i] = mod_val(modp, KIN(I_BADA), v, j); }
    __syncthreads();
    signed char* A0q = (signed char*)(F.ws + WS_A0);
    for (int row = F.gw; row < MT; row += F.NGW) {
        const float* xr; int vec;
        if (row < ML) { xr = KIN(I_X) + (size_t)row * D; vec = row >> 13; } else { xr = KIN(I_CTX) + (size_t)(row - ML) * D; vec = 2; }
        f32x4 v[4]; float s = 0.f;
#pragma unroll
        for (int j = 0; j < 4; ++j) { v[j] = *(const f32x4*)(xr + 4 * F.lane + 256 * j); s += (v[j].x * v[j].x + v[j].y * v[j].y) + (v[j].z * v[j].z + v[j].w * v[j].w); }
        const float rstd = 1.0f / sqrtf(wave_sum(s) * (1.0f / D) + 1e-6f);
        f32x4 hq[4]; float mx = 0.f;
#pragma unroll
        for (int j = 0; j < 4; ++j) { const int c = 4 * F.lane + 256 * j; const f32x4 a = *(const LAS f32x4*)(LA + vec * D + c), b = *(const LAS f32x4*)(LB + vec * D + c);
            hq[j] = v[j] * rstd * a + b; mx = fmaxf(mx, fmaxf(fmaxf(fabsf(hq[j].x), fabsf(hq[j].y)), fmaxf(fabsf(hq[j].z), fabsf(hq[j].w)))); }
        mx = wave_max(mx);
        const float iv = mx > 0.f ? 127.0f / mx : 0.f;
        if (F.lane == 0) ((float*)(F.ws + MI_RSH))[row] = mx * (1.0f / 127.0f);
        unsigned* o4 = (unsigned*)(A0q + (size_t)row * D) + F.lane;
#pragma unroll
        for (int j = 0; j < 4; ++j) o4[64 * j] = pack_q4(hq[j].x * iv, hq[j].y * iv, hq[j].z * iv, hq[j].w * iv);
    }
}

__device__ __forceinline__ void phase_lora_in(Frame& F) {
    const bf16* z = (const bf16*)(F.ws + WS_Z); bf16* AL = (bf16*)(F.ws + WS_AL);
    const int gt = blockIdx.x * (NWAVES * 64) + F.tid, NGT = F.G * NWAVES * 64;
    for (int i = gt; i < MT * (KL / 4); i += NGT) {
        const int row = i / (KL / 4), q = i % (KL / 4), j0 = 4 * q;
        const int zc = j0 < 256 ? DECAY_OFF + j0 : GLORA_OFF + (j0 - 256);
        float o[4];
        if (j0 >= 256 && row >= ML) { o[0] = o[1] = o[2] = o[3] = 0.f; }
        else {
            const uint2 sv = *(const uint2*)(z + (size_t)row * NZ + zc); const float s[4] = {bflo(sv.x), bfhi(sv.x), bflo(sv.y), bfhi(sv.y)};
#pragma unroll
            for (int j = 0; j < 4; ++j) { const int nr = nbr_row(row, j); float t = 0.f;
                if (nr >= 0) t = bf1(z[(size_t)nr * NZ + zc + j]);
                const float v = s[j] + KIN(I_MU)[zc + j] * (t - s[j]);
                o[j] = j0 < 128 ? tanhf(v) : (j0 < 256 ? v : sigmoidf_(v)); }
        }
        *(uint2*)(AL + (size_t)row * KL + j0) = make_uint2(pk2(o[0], o[1]), pk2(o[2], o[3]));
    }
}


namespace ck {
typedef short bf16x8 __attribute__((ext_vector_type(8)));
constexpr int TILE = 8192;
constexpr int NU_L = BATCH * (T / 64) * NH;
constexpr int NU_ALL = NU_L + BATCH * (TC / 64) * NH;
__device__ __forceinline__ int swz(int row) { return (row ^ (row >> 3)) & 7; }
__device__ __forceinline__ int toff(int row, int col) { return row * 128 + ((col * 2) ^ (swz(row) << 4)); }
__device__ __forceinline__ bf16x8 ldfrag(const LAS unsigned char* t, int row, int chunk) { return *(const LAS bf16x8*)(t + row * 128 + ((chunk ^ swz(row)) << 4)); }
typedef __bf16 bf16v2_t __attribute__((ext_vector_type(2)));
__device__ __forceinline__ unsigned cvtpk(float lo, float hi) { const bf16v2_t v = {(__bf16)lo, (__bf16)hi}; return __builtin_bit_cast(unsigned, v); }
#define CK_MFMA(a, b, c) __builtin_amdgcn_mfma_f32_16x16x32_bf16(a, b, c, 0, 0, 0)
template <bool MASKDIAG>
__device__ __forceinline__ void mm64(f32x4 (&acc)[4], const LAS unsigned char* Lt, const LAS unsigned char* Rt, int wq, int lane) {
    const int lr = lane & 15, g = lane >> 4;
    const bf16x8 l0 = ldfrag(Lt, 16 * wq + lr, g), l1 = ldfrag(Lt, 16 * wq + lr, 4 + g);
#pragma unroll
    for (int n = 0; n < 4; ++n) {
        bf16x8 r0 = ldfrag(Rt, 16 * n + lr, g), r1 = ldfrag(Rt, 16 * n + lr, 4 + g);
        if (MASKDIAG) { const bf16x8 zz = {0, 0, 0, 0, 0, 0, 0, 0}; if ((g >> 1) == n) r0 = zz; if (2 + (g >> 1) == n) r1 = zz; }
        acc[n] = CK_MFMA(l0, r0, acc[n]); acc[n] = CK_MFMA(l1, r1, acc[n]);
    }
}
__device__ __forceinline__ void zero4(f32x4 (&a)[4]) {
#pragma unroll
    for (int n = 0; n < 4; ++n) a[n] = (f32x4){0.f, 0.f, 0.f, 0.f};
}
__device__ __forceinline__ void storeT(LAS unsigned char* t, const f32x4 (&v)[4], int wq, int lane) {
    const int lr = lane & 15, g = lane >> 4;
#pragma unroll
    for (int n = 0; n < 4; ++n) *(LAS v2u*)(t + toff(16 * n + lr, 16 * wq + 4 * g)) = (v2u){cvtpk(v[n][0], v[n][1]), cvtpk(v[n][2], v[n][3])};
}
__device__ __forceinline__ void storeN(LAS unsigned char* t, const f32x4 (&v)[4], int wq, int lane) {
    const int lr = lane & 15, g = lane >> 4;
#pragma unroll
    for (int n = 0; n < 4; ++n)
#pragma unroll
        for (int i = 0; i < 4; ++i) *(LAS unsigned short*)(t + toff(16 * wq + 4 * g + i, 16 * n + lr)) = (unsigned short)f2bf(v[n][i]);
}
__device__ __forceinline__ void loadT(f32x4 (&v)[4], const LAS unsigned char* t, int wq, int lane) {
    const int lr = lane & 15, g = lane >> 4;
#pragma unroll
    for (int n = 0; n < 4; ++n) { const v2u w = *(const LAS v2u*)(t + toff(16 * n + lr, 16 * wq + 4 * g)); v[n] = (f32x4){bflo(w.x), bfhi(w.x), bflo(w.y), bfhi(w.y)}; }
}
__device__ __forceinline__ void unit_decode(int unit, int& b, int& h, int& rowbase) {
    if (unit < NU_L) { h = unit & 15; const int blk = (unit >> 4) & 127; b = unit >> 11; rowbase = b * T + blk * 64; }
    else { const int u = unit - NU_L; h = u & 15; const int cb = (u >> 4) & 3; b = u >> 6; rowbase = ML + b * TC + cb * 64; }
}
__device__ __forceinline__ void pack8(LAS unsigned char* t, int row, int chunk, const float (&v)[8], bool rev) {
    v4u o;
    if (!rev) { o.x = cvtpk(v[0], v[1]); o.y = cvtpk(v[2], v[3]); o.z = cvtpk(v[4], v[5]); o.w = cvtpk(v[6], v[7]); }
    else { o.x = cvtpk(v[7], v[6]); o.y = cvtpk(v[5], v[4]); o.z = cvtpk(v[3], v[2]); o.w = cvtpk(v[1], v[0]); }
    *(LAS v4u*)(t + row * 128 + ((chunk ^ swz(row)) << 4)) = o;
}

__device__ __forceinline__ void unpack8(const v4u p, float (&o)[8]) {
    o[0] = bflo(p.x); o[1] = bfhi(p.x); o[2] = bflo(p.y); o[3] = bfhi(p.y); o[4] = bflo(p.z); o[5] = bfhi(p.z); o[6] = bflo(p.w); o[7] = bfhi(p.w);
}
__device__ __forceinline__ void ld8f(const float* p, float (&o)[8]) {
    const f32x4 a = *(const f32x4*)p, b = *(const f32x4*)(p + 4); o[0] = a.x; o[1] = a.y; o[2] = a.z; o[3] = a.w; o[4] = b.x; o[5] = b.y; o[6] = b.z; o[7] = b.w;
}
__device__ __forceinline__ float fsig(float x) { return __builtin_amdgcn_rcpf(1.0f + __expf(-x)); }
template <bool IS_CO> struct EPre { v4u k[5], v[5], r[IS_CO ? 5 : 1], lo[4]; unsigned msk; };
template <bool IS_CO>
__device__ __forceinline__ void epre_load(EPre<IS_CO>& P, const bf16* z, const bf16* LO, int unit, int wave, int lane) {
    int b, h, rowbase; unit_decode(unit, b, h, rowbase);
    const int row = rowbase + 8 * wave + (lane >> 3), c0 = h * 64 + 8 * (lane & 7);
    const bf16* zr = z + (size_t)row * NZ;
    P.k[0] = *(const v4u*)(zr + K_OFF + c0); P.v[0] = *(const v4u*)(zr + V_OFF + c0); if (IS_CO) P.r[0] = *(const v4u*)(zr + R_OFF + c0);
    unsigned msk = 0u;
#pragma unroll
    for (int j = 0; j < 4; ++j) { const int nr = nbr_row(row, j); const bf16* zn = z + (size_t)(nr >= 0 ? nr : row) * NZ; msk |= (nr >= 0 ? 1u : 0u) << j;
        P.k[1 + j] = *(const v4u*)(zn + K_OFF + c0); P.v[1 + j] = *(const v4u*)(zn + V_OFF + c0);
        if (IS_CO) P.r[1 + j] = *(const v4u*)(zn + R_OFF + c0); }
    P.msk = msk;
    const bf16* lr_ = LO + (size_t)row * NL + c0;
    P.lo[0] = *(const v4u*)(lr_); P.lo[1] = *(const v4u*)(lr_ + 1024); P.lo[2] = *(const v4u*)(lr_ + 2048); P.lo[3] = *(const v4u*)(lr_ + 3072);
}
__device__ __forceinline__ void shift8(const v4u (&q)[5], const float* mu, float (&out)[8], unsigned msk = 15u) {
    const v4u zz = {0u, 0u, 0u, 0u};
    const v4u s = q[0], n0 = (msk & 1u) ? q[1] : zz, n1 = (msk & 2u) ? q[2] : zz, n2 = (msk & 4u) ? q[3] : zz, n3 = (msk & 8u) ? q[4] : zz;
    float m[8]; ld8f(mu, m);
    out[0] = bflo(s.x) + m[0] * (bflo(n0.x) - bflo(s.x)); out[1] = bfhi(s.x) + m[1] * (bfhi(n1.x) - bfhi(s.x));
    out[2] = bflo(s.y) + m[2] * (bflo(n2.y) - bflo(s.y)); out[3] = bfhi(s.y) + m[3] * (bfhi(n3.y) - bfhi(s.y));
    out[4] = bflo(s.z) + m[4] * (bflo(n0.z) - bflo(s.z)); out[5] = bfhi(s.z) + m[5] * (bfhi(n1.z) - bfhi(s.z));
    out[6] = bflo(s.w) + m[6] * (bflo(n2.w) - bflo(s.w)); out[7] = bfhi(s.w) + m[7] * (bfhi(n3.w) - bfhi(s.w));
}
struct EPre2 { v4u k0, v0, r0; v2u kn[4], vn[4], rn[4]; v4u lo[4]; unsigned msk; };
__device__ __forceinline__ void epre2_load(EPre2& P, const bf16* z, const bf16* LO, int unit, int wave, int lane) {
    int b, h, rowbase; unit_decode(unit, b, h, rowbase);
    const int row = rowbase + 8 * wave + (lane >> 3), c0 = h * 64 + 8 * (lane & 7);
    const bf16* zr = z + (size_t)row * NZ;
    P.k0 = *(const v4u*)(zr + K_OFF + c0); P.v0 = *(const v4u*)(zr + V_OFF + c0); P.r0 = *(const v4u*)(zr + R_OFF + c0);
    unsigned msk = 0u;
#pragma unroll
    for (int j = 0; j < 4; ++j) { const int nr = nbr_row(row, j); const unsigned* zn = (const unsigned*)(z + (size_t)(nr >= 0 ? nr : row) * NZ + c0) + (j >> 1); msk |= (nr >= 0 ? 1u : 0u) << j;
        P.kn[j].x = zn[K_OFF / 2]; P.kn[j].y = zn[K_OFF / 2 + 2]; P.vn[j].x = zn[V_OFF / 2]; P.vn[j].y = zn[V_OFF / 2 + 2]; P.rn[j].x = zn[R_OFF / 2]; P.rn[j].y = zn[R_OFF / 2 + 2]; }
    P.msk = msk;
    const bf16* lr_ = LO + (size_t)row * NL + c0;
    P.lo[0] = *(const v4u*)(lr_); P.lo[1] = *(const v4u*)(lr_ + 1024); P.lo[2] = *(const v4u*)(lr_ + 2048); P.lo[3] = *(const v4u*)(lr_ + 3072);
}
__device__ __forceinline__ void shift8n(const v4u s, const v2u (&nb)[4], const float* mu, float (&out)[8], unsigned msk) {
    float m[8]; ld8f(mu, m);
    const float n0a = (msk & 1u) ? bflo(nb[0].x) : 0.f, n0b = (msk & 1u) ? bflo(nb[0].y) : 0.f, n1a = (msk & 2u) ? bfhi(nb[1].x) : 0.f, n1b = (msk & 2u) ? bfhi(nb[1].y) : 0.f;
    const float n2a = (msk & 4u) ? bflo(nb[2].x) : 0.f, n2b = (msk & 4u) ? bflo(nb[2].y) : 0.f, n3a = (msk & 8u) ? bfhi(nb[3].x) : 0.f, n3b = (msk & 8u) ? bfhi(nb[3].y) : 0.f;
    out[0] = bflo(s.x) + m[0] * (n0a - bflo(s.x)); out[1] = bfhi(s.x) + m[1] * (n1a - bfhi(s.x));
    out[2] = bflo(s.y) + m[2] * (n2a - bflo(s.y)); out[3] = bfhi(s.y) + m[3] * (n3a - bfhi(s.y));
    out[4] = bflo(s.z) + m[4] * (n0b - bflo(s.z)); out[5] = bfhi(s.z) + m[5] * (n1b - bfhi(s.z));
    out[6] = bflo(s.w) + m[6] * (n2b - bflo(s.w)); out[7] = bfhi(s.w) + m[7] * (n3b - bfhi(s.w));
}
__device__ __forceinline__ void putN(LAS unsigned char* t, int tau, int oct, const float (&v)[8]) {
    v4u o; o.x = cvtpk(v[0], v[1]); o.y = cvtpk(v[2], v[3]); o.z = cvtpk(v[4], v[5]); o.w = cvtpk(v[6], v[7]);
    *(LAS v4u*)(t + tau * 128 + ((oct ^ swz(tau)) << 4)) = o;
}
__device__ __forceinline__ void putT(LAS unsigned char* t, int tau, int ch0, const float (&v)[8]) {
#pragma unroll
    for (int i = 0; i < 8; ++i) *(LAS unsigned short*)(t + toff(ch0 + i, tau)) = (unsigned short)f2bf(v[i]);
}

template <bool IS_CO, bool STAGES = true>
__device__ __forceinline__ void phase_chunk(Frame& F) {
    const int wave = F.wave;
    const int dgrp = wave >> 2, wq = wave & 3;
    LAS unsigned char* tl = F.lds + dgrp * 9 * TILE;
#define SL(k) (tl + (k) * TILE)
    LAS float* SEG = (LAS float*)(F.lds + LDS_X_OFF);
    LAS float* GAM = SEG + 1024;
    LAS unsigned char* DIB = (LAS unsigned char*)(GAM + 128) + dgrp * 2048;
    LAS float* LW0 = (LAS float*)(F.lds + 7 * TILE);
    LAS float* LW1 = (LAS float*)(F.lds + 16 * TILE);
    const bf16* z = (const bf16*)(F.ws + WS_Z); const bf16* LO = (const bf16*)(F.ws + WS_LORA);
    unsigned char* PQ = F.ws + WS_PQ; unsigned char* TKN = F.ws + WS_TKN; unsigned char* UPRE = F.ws + WS_UPRE; unsigned char* H0T = F.ws + WS_H0T;
    bf16* MG = (bf16*)(F.ws + WS_A0);
    const float* p_mu = KIN(I_MU); const float* p_kk = KIN(I_KK); const float* p_ka = KIN(I_KA);
    const int NU = IS_CO ? NU_L : NU_ALL;
    EPre<IS_CO> PF;
    CvTile cvt; float civ[4] = {0.f, 0.f, 0.f, 0.f}; int cv_t = 0;
    const float* cv_w = KIN(I_WEI);
    LAS float* cv_scr = (LAS float*)(F.lds + wave * 16384);
    if ((int)blockIdx.x < NU) epre_load<IS_CO>(PF, z, LO, (int)blockIdx.x, wave, F.lane);
    for (int unit = blockIdx.x; unit < NU; unit += F.G) {
        int lane = F.lane; asm volatile("" : "+v"(lane));
        const int lr = lane & 15, g = lane >> 4;
        int b, h, rowbase; unit_decode(unit, b, h, rowbase);
        const int tok = 8 * wave + (lane >> 3), oct = lane & 7, ch0 = 8 * oct, c0 = h * 64 + ch0, row = rowbase + tok;
        float ks[8], vs[8], rs[8], kkp[8], lw0[8], lw1[8], kd0[8], kd1[8], a_0[8], a_1[8], ssq;
        {
            shift8(PF.k, p_mu + K_OFF + c0, ks, PF.msk);
            shift8(PF.v, p_mu + V_OFF + c0, vs, PF.msk);
            if (IS_CO) { v4u rr[5];
#pragma unroll
                for (int j = 0; j < 5; ++j) rr[j] = PF.r[IS_CO ? j : 0];
                shift8(rr, p_mu + R_OFF + c0, rs, PF.msk); }
            else {
#pragma unroll
                for (int i = 0; i < 8; ++i) rs[i] = 0.f; }
            float xw0[8], xw1[8], xa0[8], xa1[8];
            unpack8(PF.lo[0], xw0); unpack8(PF.lo[1], xw1); unpack8(PF.lo[2], xa0); unpack8(PF.lo[3], xa1);
            float kkk[8], kaa[8];
            ld8f(p_kk + c0, kkk); ld8f(p_ka + c0, kaa);
            float ss = 0.f;
#pragma unroll
            for (int i = 0; i < 8; ++i) {
                kkp[i] = ks[i] * kkk[i]; ss += kkp[i] * kkp[i];
                lw0[i] = xw0[i]; lw1[i] = xw1[i];
                a_0[i] = xa0[i]; a_1[i] = xa1[i];
                kd0[i] = ks[i] * (1.0f + (a_0[i] - 1.0f) * kaa[i]); kd1[i] = ks[i] * (1.0f + (a_1[i] - 1.0f) * kaa[i]);
                const int ch = ch0 + i, sw = tok ^ (4 * ((ch & 15) ^ (2 * (ch >> 4))));
                LW0[ch * 64 + sw] = lw0[i]; LW1[ch * 64 + sw] = lw1[i];
            }
            ss += __shfl_xor(ss, 1); ss += __shfl_xor(ss, 2); ss += __shfl_xor(ss, 4);
            ssq = ss;
        }
        __syncthreads();
        {
            const int ch2 = lane, seg = wave, sw = 4 * ((ch2 & 15) ^ (2 * (ch2 >> 4)));
            LAS f32x4* p0a = (LAS f32x4*)(LW0 + ch2 * 64 + ((8 * seg) ^ sw)); LAS f32x4* p0b = (LAS f32x4*)(LW0 + ch2 * 64 + ((8 * seg + 4) ^ sw));
            LAS f32x4* p1a = (LAS f32x4*)(LW1 + ch2 * 64 + ((8 * seg) ^ sw)); LAS f32x4* p1b = (LAS f32x4*)(LW1 + ch2 * 64 + ((8 * seg + 4) ^ sw));
            f32x4 a = *p0a, bq = *p0b, c = *p1a, d = *p1b;
            a.y += a.x; a.z += a.y; a.w += a.z; bq.x += a.w; bq.y += bq.x; bq.z += bq.y; bq.w += bq.z;
            d.z += d.w; d.y += d.z; d.x += d.y; c.w += d.x; c.z += c.w; c.y += c.z; c.x += c.y;
            SEG[seg * 64 + ch2] = bq.w; SEG[(8 + seg) * 64 + ch2] = c.x;
            __syncthreads();
            float off0 = 0.f, off1 = 0.f;
#pragma unroll
            for (int s2 = 0; s2 < 8; ++s2) { const float t0 = SEG[s2 * 64 + ch2], t1 = SEG[(8 + s2) * 64 + ch2]; off0 += (s2 < seg) ? t0 : 0.f; off1 += (s2 > seg) ? t1 : 0.f; }
            *p0a = a + off0; *p0b = bq + off0; *p1a = c + off1; *p1b = d + off1;
        }
        __syncthreads();
        {
            const float inv = 1.0f / fmaxf(sqrtf(ssq), 1e-12f);
            float t8[8], u8[8], w8[8];
            {
                LAS unsigned char* t0 = F.lds; const int tau = tok;
                float e1[8], ei[8];
#pragma unroll
                for (int i = 0; i < 8; ++i) { const int ch = ch0 + i; const float cm = LW0[ch * 64 + (tok ^ (4 * ((ch & 15) ^ (2 * (ch >> 4)))))]; e1[i] = __expf(cm); ei[i] = __builtin_amdgcn_rcpf(e1[i]); t8[i] = kkp[i] * inv * __expf(cm - lw0[i]); }
                if (tok == 63) {
#pragma unroll
                    for (int i = 0; i < 8; ++i) GAM[ch0 + i] = e1[i]; }
#pragma unroll
                for (int i = 0; i < 8; ++i) { u8[i] = kkp[i] * inv * a_0[i] * ei[i]; w8[i] = kd0[i] * ei[i]; }
                if (!IS_CO) { putN(t0 + 0 * TILE, tau, oct, t8); putT(t0 + 1 * TILE, tau, ch0, t8); putN(t0 + 2 * TILE, tau, oct, u8); putT(t0 + 3 * TILE, tau, ch0, u8);
                    putN(t0 + 4 * TILE, tau, oct, w8); putT(t0 + 5 * TILE, tau, ch0, w8); putT(t0 + 6 * TILE, tau, ch0, vs); }
                else {
#pragma unroll
                    for (int i = 0; i < 8; ++i) t8[i] = rs[i] * e1[i];
                    putN(t0 + 0 * TILE, tau, oct, w8); putN(t0 + 1 * TILE, tau, oct, u8); putN(t0 + 2 * TILE, tau, oct, t8); putT(t0 + 3 * TILE, tau, ch0, vs); }
            }
            {
                LAS unsigned char* t1 = F.lds + 9 * TILE; const int tau = 63 - tok;
                float e1[8], ei[8];
#pragma unroll
                for (int i = 0; i < 8; ++i) { const int ch = ch0 + i; const float cm = LW1[ch * 64 + (tok ^ (4 * ((ch & 15) ^ (2 * (ch >> 4)))))]; e1[i] = __expf(cm); ei[i] = __builtin_amdgcn_rcpf(e1[i]); t8[i] = kkp[i] * inv * __expf(cm - lw1[i]); }
                if (tok == 0) {
#pragma unroll
                    for (int i = 0; i < 8; ++i) GAM[64 + ch0 + i] = e1[i]; }
#pragma unroll
                for (int i = 0; i < 8; ++i) { u8[i] = kkp[i] * inv * a_1[i] * ei[i]; w8[i] = kd1[i] * ei[i]; }
                if (!IS_CO) { putN(t1 + 0 * TILE, tau, oct, t8); putT(t1 + 1 * TILE, tau, ch0, t8); putN(t1 + 2 * TILE, tau, oct, u8); putT(t1 + 3 * TILE, tau, ch0, u8);
                    putN(t1 + 4 * TILE, tau, oct, w8); putT(t1 + 5 * TILE, tau, ch0, w8); putT(t1 + 6 * TILE, tau, ch0, vs); }
                else {
#pragma unroll
                    for (int i = 0; i < 8; ++i) t8[i] = rs[i] * e1[i];
                    putN(t1 + 0 * TILE, tau, oct, w8); putN(t1 + 1 * TILE, tau, oct, u8); putN(t1 + 2 * TILE, tau, oct, t8); putT(t1 + 3 * TILE, tau, ch0, vs); }
            }
        }
        if (!STAGES) { __syncthreads(); continue; }
        const size_t inst = (size_t)unit * 2 + dgrp;
        const int t2 = (wq << 6) | lane;
        if (IS_CO) {
#pragma unroll
            for (int rep = 0; rep < 2; ++rep) { const int cidx = t2 + 256 * rep, row = cidx >> 3, ch = cidx & 7;
                const v4u a = *(const v4u*)(TKN + inst * 8192 + (size_t)(row * 64 + ch * 8) * 2), hh = *(const v4u*)(H0T + inst * 8192 + (size_t)(row * 64 + ch * 8) * 2);
                *(LAS v4u*)(SL(4) + row * 128 + ((ch ^ swz(row)) << 4)) = a; *(LAS v4u*)(SL(5) + row * 128 + ((ch ^ swz(row)) << 4)) = hh; }
        }
        v4u upre0 = {0u, 0u, 0u, 0u}, upre1 = upre0;
        if (IS_CO) { const unsigned char* up = UPRE + inst * 8192 + (size_t)((wq * 64 + lane) * 32); upre0 = *(const v4u*)up; upre1 = *(const v4u*)(up + 16); }
        if (unit + F.G < NU) epre_load<IS_CO>(PF, z, LO, unit + F.G, wave, lane);
        const int cv_strip = F.gw + (cv_t >> 4) * F.NGW, cv_kb = cv_t & 15;
        if (!IS_CO && cv_strip < NE * 64) { int e_, n0_, rb_; wei_strip(cv_strip, e_, n0_, rb_); cv_load(cvt, cv_w + (size_t)e_ * D * 2048, 2048, n0_, cv_kb, lane); }
        __syncthreads();
        f32x4 acc[4], acc2[4];
        if (!IS_CO) {
            zero4(acc); mm64<false>(acc, SL(2), SL(0), wq, lane);
            zero4(acc2); mm64<false>(acc2, SL(4), SL(0), wq, lane);
#pragma unroll
            for (int n = 0; n < 4; ++n)
#pragma unroll
                for (int q = 0; q < 4; ++q) { const bool lo = (16 * wq + 4 * g + q < 16 * n + lr); acc[n][q] = lo ? acc[n][q] : 0.f; acc2[n][q] = lo ? acc2[n][q] : 0.f; }
            storeT(SL(7), acc, wq, lane); storeT(SL(8), acc2, wq, lane);
            __syncthreads();
            zero4(acc); mm64<false>(acc, SL(8), SL(6), wq, lane); storeT(SL(0), acc, wq, lane);
            if (wq == 0) {
                const int bb = lane >> 4, jj = lane & 15;
                float X[16];
                X[0] = (jj == 0) ? 1.f : 0.f;
#pragma unroll
                for (int t = 1; t < 16; ++t) {
                    const int row = 16 * bb + t;
                    const v4u p0 = *(const LAS v4u*)(SL(7) + row * 128 + (((2 * bb) ^ swz(row)) << 4)), p1 = *(const LAS v4u*)(SL(7) + row * 128 + (((2 * bb + 1) ^ swz(row)) << 4));
                    float rw[16];
                    rw[0] = bflo(p0.x); rw[1] = bfhi(p0.x); rw[2] = bflo(p0.y); rw[3] = bfhi(p0.y); rw[4] = bflo(p0.z); rw[5] = bfhi(p0.z); rw[6] = bflo(p0.w); rw[7] = bfhi(p0.w);
                    rw[8] = bflo(p1.x); rw[9] = bfhi(p1.x); rw[10] = bflo(p1.y); rw[11] = bfhi(p1.y); rw[12] = bflo(p1.z); rw[13] = bfhi(p1.z); rw[14] = bflo(p1.w); rw[15] = bfhi(p1.w);
                    float xv = (t == jj) ? 1.f : 0.f;
#pragma unroll
                    for (int s = 0; s < t; ++s) xv -= rw[s] * X[s];
                    X[t] = xv;
                }
#pragma unroll
                for (int t = 0; t < 16; ++t) *(LAS unsigned short*)(DIB + (((bb * 16 + t) * 16 + jj) << 1)) = (unsigned short)f2bf(X[t]);
            }
            __syncthreads();
            {
                const bool isU = wq >= 2; const int cbase = 32 * (wq & 1);
                const LAS unsigned char* Rt = isU ? SL(0) : SL(1);
                LAS unsigned char* outT = isU ? SL(4) : SL(2);
#pragma unroll
                for (int ct = 0; ct < 2; ++ct) {
                    const int col = cbase + 16 * ct + lr;
                    f32x4 X[4];
#pragma unroll
                    for (int b = 0; b < 4; ++b) {
                        const v2u rwv = *(const LAS v2u*)(Rt + toff(col, 16 * b + 4 * g));
                        f32x4 Zt = {bflo(rwv.x), bfhi(rwv.x), bflo(rwv.y), bfhi(rwv.y)};
                        if (b >= 1) {
                            f32x4 Y = {0.f, 0.f, 0.f, 0.f};
#pragma unroll
                            for (int s = 0; s < (b + 1) / 2; ++s) {
                                v2u alo = {0u, 0u}, ahi = {0u, 0u};
                                if (2 * s < b) alo = *(const LAS v2u*)(SL(7) + toff(16 * b + lr, 32 * s + 4 * g));
                                if (2 * s + 1 < b) ahi = *(const LAS v2u*)(SL(7) + toff(16 * b + lr, 32 * s + 16 + 4 * g));
                                v4u bw = {cvtpk(X[2 * s][0], X[2 * s][1]), cvtpk(X[2 * s][2], X[2 * s][3]), 0u, 0u};
                                if (2 * s + 1 < b) { bw.z = cvtpk(X[2 * s + 1][0], X[2 * s + 1][1]); bw.w = cvtpk(X[2 * s + 1][2], X[2 * s + 1][3]); }
                                Y = CK_MFMA(__builtin_bit_cast(bf16x8, ((v4u){alo.x, alo.y, ahi.x, ahi.y})), __builtin_bit_cast(bf16x8, bw), Y);
                            }
                            Zt = Zt - Y;
                        }
                        const v2u dv = *(const LAS v2u*)(DIB + (((b * 16 + lr) * 16 + 4 * g) << 1));
                        const v4u bz = {cvtpk(Zt[0], Zt[1]), cvtpk(Zt[2], Zt[3]), 0u, 0u};
                        X[b] = CK_MFMA(__builtin_bit_cast(bf16x8, ((v4u){dv.x, dv.y, 0u, 0u})), __builtin_bit_cast(bf16x8, bz), ((f32x4){0.f, 0.f, 0.f, 0.f}));
                    }
#pragma unroll
                    for (int b = 0; b < 4; ++b) {
                        const v2u pk = {cvtpk(X[b][0], X[b][1]), cvtpk(X[b][2], X[b][3])};
                        *(LAS v2u*)(outT + toff(col, 16 * b + 4 * g)) = pk;
                        if (!isU) {
#pragma unroll
                            for (int q = 0; q < 4; ++q) *(LAS unsigned short*)(SL(8) + toff(16 * b + 4 * g + q, col)) = (unsigned short)f2bf(X[b][q]);
                        } else {
                            *(uint2*)(UPRE + inst * 8192 + (size_t)(((b * 64 + lane) * 4 + 2 * (wq & 1) + ct) * 8)) = make_uint2(pk.x, pk.y);
                        }
                    }
                }
            }
            __syncthreads();
            { zero4(acc); mm64<false>(acc, SL(2), SL(3), wq, lane);
              const int cstep_ = unit < NU_L ? 4 + (dgrp ? 127 - ((unit >> 4) & 127) : ((unit >> 4) & 127)) : (dgrp ? 3 - (((unit - NU_L) >> 4) & 3) : (((unit - NU_L) >> 4) & 3));
              unsigned char* pb = PQ + (size_t)(((b * 16 + h) * 2 + dgrp) * (4 + T / 64) + cstep_) * 16384;
#pragma unroll
              for (int n = 0; n < 4; ++n) { const int k = 16 * n + lr; const float gm = GAM[dgrp * 64 + k]; float p[4];
#pragma unroll
                  for (int q = 0; q < 4; ++q) p[q] = gm * (((16 * wq + 4 * g + q) == k ? 1.f : 0.f) - acc[n][q]);
                  *(uint2*)(pb + (size_t)(((n * 2 + (wq >> 1)) * 64 + lane) * 16 + (wq & 1) * 8)) = make_uint2(cvtpk(p[0], p[1]), cvtpk(p[2], p[3])); }
              zero4(acc); mm64<false>(acc, SL(5), SL(6), wq, lane); zero4(acc2); mm64<false>(acc2, SL(3), SL(4), wq, lane);
              const f32x4 gm4 = *(const LAS f32x4*)(GAM + dgrp * 64 + 16 * wq + 4 * g);
#pragma unroll
              for (int n = 0; n < 4; ++n) { const f32x4 qv = (acc[n] - acc2[n]) * gm4;
                  *(uint2*)(pb + 8192 + (size_t)(((n * 64 + lane) * 4 + wq) * 8)) = make_uint2(cvtpk(qv[0], qv[1]), cvtpk(qv[2], qv[3])); }
#pragma unroll
              for (int rep = 0; rep < 2; ++rep) { const int cidx = t2 + 256 * rep, row = cidx >> 3, ch = cidx & 7;
                  *(v4u*)(TKN + inst * 8192 + (size_t)(row * 64 + ch * 8) * 2) = *(const LAS v4u*)(SL(8) + row * 128 + ((ch ^ swz(row)) << 4)); }
            }
        } else {
            zero4(acc); mm64<false>(acc, SL(0), SL(2), wq, lane);
#pragma unroll
            for (int n = 0; n < 4; ++n)
#pragma unroll
                for (int q = 0; q < 4; ++q) acc[n][q] = (16 * wq + 4 * g + q <= 16 * n + lr) ? acc[n][q] : 0.f;
            storeT(SL(6), acc, wq, lane);
            zero4(acc); mm64<false>(acc, SL(1), SL(2), wq, lane);
#pragma unroll
            for (int n = 0; n < 4; ++n)
#pragma unroll
                for (int q = 0; q < 4; ++q) acc[n][q] = (16 * wq + 4 * g + q <= 16 * n + lr) ? -acc[n][q] : 0.f;
            storeT(SL(7), acc, wq, lane);
            { const v4u o0 = upre0, o1 = upre1;
              acc[0] = (f32x4){bflo(o0.x), bfhi(o0.x), bflo(o0.y), bfhi(o0.y)}; acc[1] = (f32x4){bflo(o0.z), bfhi(o0.z), bflo(o0.w), bfhi(o0.w)};
              acc[2] = (f32x4){bflo(o1.x), bfhi(o1.x), bflo(o1.y), bfhi(o1.y)}; acc[3] = (f32x4){bflo(o1.z), bfhi(o1.z), bflo(o1.w), bfhi(o1.w)}; }
            mm64<false>(acc, SL(4), SL(5), wq, lane);
            storeT(SL(8), acc, wq, lane);
            __syncthreads();
            zero4(acc); mm64<false>(acc, SL(2), SL(5), wq, lane); mm64<false>(acc, SL(6), SL(3), wq, lane); mm64<false>(acc, SL(7), SL(8), wq, lane);
            __syncthreads();
            { LAS float* Yf = (LAS float*)(tl);
#pragma unroll
              for (int n = 0; n < 4; ++n)
#pragma unroll
                  for (int q = 0; q < 4; ++q) { const int tau = 16 * wq + 4 * g + q; Yf[tau * 64 + ((16 * n + lr) ^ (4 * (tau & 15)))] = acc[n][q]; } }
            __syncthreads();
            { const LAS float* Y0 = (const LAS float*)(F.lds); const LAS float* Y1 = (const LAS float*)(F.lds + 9 * TILE);
              const int t = row & (T - 1);
              const bf16* zr = z + (size_t)row * NZ;
              const v4u zz = {0u, 0u, 0u, 0u};
              const v4u q_g = *(const v4u*)(LO + (size_t)row * NL + 4096 + c0);
              const v4u q_gb = *(const v4u*)(zr + CONV_OFF + c0), q_c0 = *(const v4u*)(zr + CONV_OFF + 1024 + c0), q_x0 = *(const v4u*)(zr + CONV_OFF + 2048 + c0);
              const v4u q_cm = t > 0 ? *(const v4u*)(zr - NZ + CONV_OFF + 1024 + c0) : zz, q_xm = t > 0 ? *(const v4u*)(zr - NZ + CONV_OFF + 2048 + c0) : zz;
              const v4u q_cp = t < T - 1 ? *(const v4u*)(zr + NZ + CONV_OFF + 1024 + c0) : zz, q_xp = t < T - 1 ? *(const v4u*)(zr + NZ + CONV_OFF + 2048 + c0) : zz;
              const v4u q_ga = *(const v4u*)(zr + GATE_OFF + c0), q_gr = *(const v4u*)(zr + GATE_OFF + 1024 + c0);
              float y[8];
              { const int s0 = 4 * (tok & 15), s1 = 4 * ((63 - tok) & 15);
                const f32x4 a0 = *(const LAS f32x4*)(Y0 + tok * 64 + (ch0 ^ s0)), a1 = *(const LAS f32x4*)(Y0 + tok * 64 + ((ch0 + 4) ^ s0));
                const f32x4 b0 = *(const LAS f32x4*)(Y1 + (63 - tok) * 64 + (ch0 ^ s1)), b1 = *(const LAS f32x4*)(Y1 + (63 - tok) * 64 + ((ch0 + 4) ^ s1));
                y[0] = a0.x + b0.x; y[1] = a0.y + b0.y; y[2] = a0.z + b0.z; y[3] = a0.w + b0.w; y[4] = a1.x + b1.x; y[5] = a1.y + b1.y; y[6] = a1.z + b1.z; y[7] = a1.w + b1.w; }
              float rk[8]; ld8f(KIN(I_RK) + c0, rk);
              float s1 = 0.f, s2 = 0.f, s3 = 0.f;
#pragma unroll
              for (int i = 0; i < 8; ++i) { s1 += y[i]; s2 += y[i] * y[i]; s3 += rs[i] * 0.5f * (kd0[i] + kd1[i]) * rk[i]; }
              s1 += __shfl_xor(s1, 1); s2 += __shfl_xor(s2, 1); s3 += __shfl_xor(s3, 1); s1 += __shfl_xor(s1, 2); s2 += __shfl_xor(s2, 2); s3 += __shfl_xor(s3, 2);
              s1 += __shfl_xor(s1, 4); s2 += __shfl_xor(s2, 4); s3 += __shfl_xor(s3, 4);
              const float S1 = s1, S2 = s2, S3 = s3;
              const float mean = S1 * (1.0f / 64.0f), var = fmaxf(S2 * (1.0f / 64.0f) - mean * mean, 0.f), rstd = __builtin_amdgcn_rsqf(var + 64e-5f);
              float lnw[8], lnb[8], cw0[8], cw1[8], cw2[8];
              ld8f(KIN(I_LNW) + c0, lnw); ld8f(KIN(I_LNB) + c0, lnb); ld8f(KIN(I_CONVW) + c0, cw0); ld8f(KIN(I_CONVW) + D + c0, cw1); ld8f(KIN(I_CONVW) + 2 * D + c0, cw2);
              float gg[8], gb[8], cc[8], xx[8], cm[8], xm[8], cp[8], xp[8], ga[8], gr[8];
              unpack8(q_g, gg); unpack8(q_gb, gb); unpack8(q_c0, cc); unpack8(q_x0, xx); unpack8(q_cm, cm); unpack8(q_xm, xm); unpack8(q_cp, cp); unpack8(q_xp, xp); unpack8(q_ga, ga); unpack8(q_gr, gr);
              float o[8];
#pragma unroll
              for (int i = 0; i < 8; ++i) {
                  const float yn = (y[i] - mean) * rstd * lnw[i] + lnb[i];
                  const float yr = (yn + S3 * vs[i]) * gg[i];
                  const float yc = gb[i] * (cw0[i] * (cm[i] * xm[i]) + cw1[i] * (cc[i] * xx[i]) + cw2[i] * (cp[i] * xp[i]));
                  o[i] = fsig(ga[i]) * yr + fsig(gr[i]) * yc;
              }
              v4u ov; ov.x = cvtpk(o[0], o[1]); ov.y = cvtpk(o[2], o[3]); ov.z = cvtpk(o[4], o[5]); ov.w = cvtpk(o[6], o[7]);
              *(v4u*)(MG + (size_t)row * D + c0) = ov;
            }
        }
        __syncthreads();
        if (!IS_CO) {
            if (cv_strip < NE * 64) { int e_, n0_, rb_; wei_strip(cv_strip, e_, n0_, rb_);
                if (cv_kb == 0) cv_scale_q8(cv_w + (size_t)e_ * D * 2048, 2048, n0_, (float*)(F.ws + MI_CSWEI) + (size_t)e_ * 2048, rb_, lane, civ);
                cv_store_q8(cvt, cv_scr, (signed char*)(F.ws + WS_WEIN) + (size_t)e_ * 2048 * D, rb_, cv_kb, civ, lane); }
            ++cv_t;
            __syncthreads();
        }
    }
    if (!IS_CO) {
        for (;;) { const int s_ = F.gw + (cv_t >> 4) * F.NGW, kb_ = cv_t & 15; if (s_ >= NE * 64) break;
            int e_, n0_, rb_; wei_strip(s_, e_, n0_, rb_);
            if (kb_ == 0) cv_scale_q8(cv_w + (size_t)e_ * D * 2048, 2048, n0_, (float*)(F.ws + MI_CSWEI) + (size_t)e_ * 2048, rb_, F.lane, civ);
            cv_load(cvt, cv_w + (size_t)e_ * D * 2048, 2048, n0_, kb_, F.lane);
            cv_store_q8(cvt, cv_scr, (signed char*)(F.ws + WS_WEIN) + (size_t)e_ * 2048 * D, rb_, kb_, civ, F.lane); ++cv_t; }
    }
#undef SL
}

typedef short s16x4 __attribute__((ext_vector_type(4)));
__device__ __forceinline__ bf16x8 ldfragT(const LAS unsigned char* t, int c, int ks, int lane) {
    const int g = lane >> 4, q = (lane & 15) >> 2, p = lane & 3;
    const int r0 = 32 * ks + 8 * g + q, r1 = r0 + 4;
    const s16x4 a = __builtin_amdgcn_ds_read_tr16_b64_v4i16((LAS s16x4*)(t + r0 * 128 + (((2 * c + (p >> 1)) ^ swz(r0)) << 4) + 8 * (p & 1)));
    const s16x4 b = __builtin_amdgcn_ds_read_tr16_b64_v4i16((LAS s16x4*)(t + r1 * 128 + (((2 * c + (p >> 1)) ^ swz(r1)) << 4) + 8 * (p & 1)));
    return (bf16x8){a[0], a[1], a[2], a[3], b[0], b[1], b[2], b[3]};
}
__device__ __forceinline__ f32x4 loadN_acc(const LAS unsigned char* t, int b, int ct, int lane) {
    const int g = lane >> 4, q = (lane & 15) >> 2, p = lane & 3;
    const int r0 = 16 * b + 4 * g + q;
    const s16x4 a = __builtin_amdgcn_ds_read_tr16_b64_v4i16((LAS s16x4*)(t + r0 * 128 + (((2 * ct + (p >> 1)) ^ swz(r0)) << 4) + 8 * (p & 1)));
    return (f32x4){bf1((bf16)a[0]), bf1((bf16)a[1]), bf1((bf16)a[2]), bf1((bf16)a[3])};
}
template <bool LT, bool RT>
__device__ __forceinline__ void mm64x(f32x4 (&acc)[4], const LAS unsigned char* Lt, const LAS unsigned char* Rt, int wq, int lane) {
    const int lr = lane & 15, g = lane >> 4;
    const bf16x8 l0 = LT ? ldfragT(Lt, wq, 0, lane) : ldfrag(Lt, 16 * wq + lr, g), l1 = LT ? ldfragT(Lt, wq, 1, lane) : ldfrag(Lt, 16 * wq + lr, 4 + g);
#pragma unroll
    for (int n = 0; n < 4; ++n) {
        const bf16x8 r0 = RT ? ldfragT(Rt, n, 0, lane) : ldfrag(Rt, 16 * n + lr, g), r1 = RT ? ldfragT(Rt, n, 1, lane) : ldfrag(Rt, 16 * n + lr, 4 + g);
        acc[n] = CK_MFMA(l0, r0, acc[n]); acc[n] = CK_MFMA(l1, r1, acc[n]);
    }
}

__device__ __forceinline__ void phase_cp2(Frame& F) {
    const int wave = F.wave;
    const int dgrp = wave >> 2, wq = wave & 3;
    LAS unsigned char* tl = F.lds + dgrp * 9 * TILE;
#define SL(k) (tl + (k) * TILE)
    LAS float* SEG = (LAS float*)(F.lds + LDS_X_OFF);
    LAS float* GAM = SEG + 1024;
    LAS unsigned char* DIB = (LAS unsigned char*)(GAM + 128) + dgrp * 2048;
    LAS float* LW0 = (LAS float*)(F.lds + 7 * TILE);
    LAS float* LW1 = (LAS float*)(F.lds + 16 * TILE);
    const bf16* z = (const bf16*)(F.ws + WS_Z); const bf16* LO = (const bf16*)(F.ws + WS_LORA);
    unsigned char* PQ = F.ws + WS_PQ; unsigned char* RHAT = F.ws + WS_TKN; unsigned char* YLOC = F.ws + WS_UPRE;
    float* BON = (float*)(F.ws + MI_BON);
    const float* p_mu = KIN(I_MU); const float* p_kk = KIN(I_KK); const float* p_ka = KIN(I_KA); const float* p_rk = KIN(I_RK);
    constexpr int NU = NU_ALL;
    EPre<true> PF;
    CvTile cvt; float civ[4] = {0.f, 0.f, 0.f, 0.f}; int cv_t = 0;
    const float* cv_w = KIN(I_WEI);
    LAS float* cv_scr = (LAS float*)(F.lds + wave * 16384);
    if ((int)blockIdx.x < NU) epre_load<true>(PF, z, LO, (int)blockIdx.x, wave, F.lane);
    if (F.gw < NE * 64) { int e_, n0_, rb_; wei_strip(F.gw, e_, n0_, rb_);
        cv_scale_q8(cv_w + (size_t)e_ * D * 2048, 2048, n0_, (float*)(F.ws + MI_CSWEI) + (size_t)e_ * 2048, rb_, F.lane, civ); }
    for (int unit = blockIdx.x; unit < NU; unit += F.G) {
        int lane = F.lane; asm volatile("" : "+v"(lane));
        const int lr = lane & 15, g = lane >> 4;
        int b, h, rowbase; unit_decode(unit, b, h, rowbase);
        const int tok = 8 * wave + (lane >> 3), oct = lane & 7, ch0 = 8 * oct, c0 = h * 64 + ch0;
        float ks[8], vs[8], rs[8], kkp[8], lw0[8], lw1[8], kd0[8], kd1[8], a_0[8], a_1[8], ssq;
        {
            shift8(PF.k, p_mu + K_OFF + c0, ks, PF.msk); shift8(PF.v, p_mu + V_OFF + c0, vs, PF.msk); shift8(PF.r, p_mu + R_OFF + c0, rs, PF.msk);
            float kkk[8], kaa[8], rkk[8];
            unpack8(PF.lo[0], lw0); unpack8(PF.lo[1], lw1); unpack8(PF.lo[2], a_0); unpack8(PF.lo[3], a_1);
            ld8f(p_kk + c0, kkk); ld8f(p_ka + c0, kaa); ld8f(p_rk + c0, rkk);
            float ss = 0.f, bs = 0.f;
#pragma unroll
            for (int i = 0; i < 8; ++i) {
                kkp[i] = ks[i] * kkk[i]; ss += kkp[i] * kkp[i];
                kd0[i] = ks[i] * (1.0f + (a_0[i] - 1.0f) * kaa[i]); kd1[i] = ks[i] * (1.0f + (a_1[i] - 1.0f) * kaa[i]);
                bs += rs[i] * 0.5f * (kd0[i] + kd1[i]) * rkk[i];
                const int ch = ch0 + i, sw = tok ^ (4 * ((ch & 15) ^ (2 * (ch >> 4))));
                LW0[ch * 64 + sw] = lw0[i]; LW1[ch * 64 + sw] = lw1[i];
            }
            ss += __shfl_xor(ss, 1); bs += __shfl_xor(bs, 1); ss += __shfl_xor(ss, 2); bs += __shfl_xor(bs, 2); ss += __shfl_xor(ss, 4); bs += __shfl_xor(bs, 4);
            ssq = ss;
            if (oct == 0 && unit < NU_L) BON[(size_t)unit * 64 + tok] = bs;
        }
        __syncthreads();
        {
            const int ch2 = lane, seg = wave, sw = 4 * ((ch2 & 15) ^ (2 * (ch2 >> 4)));
            LAS f32x4* p0a = (LAS f32x4*)(LW0 + ch2 * 64 + ((8 * seg) ^ sw)); LAS f32x4* p0b = (LAS f32x4*)(LW0 + ch2 * 64 + ((8 * seg + 4) ^ sw));
            LAS f32x4* p1a = (LAS f32x4*)(LW1 + ch2 * 64 + ((8 * seg) ^ sw)); LAS f32x4* p1b = (LAS f32x4*)(LW1 + ch2 * 64 + ((8 * seg + 4) ^ sw));
            f32x4 a = *p0a, bq = *p0b, c = *p1a, d = *p1b;
            a.y += a.x; a.z += a.y; a.w += a.z; bq.x += a.w; bq.y += bq.x; bq.z += bq.y; bq.w += bq.z;
            d.z += d.w; d.y += d.z; d.x += d.y; c.w += d.x; c.z += c.w; c.y += c.z; c.x += c.y;
            SEG[seg * 64 + ch2] = bq.w; SEG[(8 + seg) * 64 + ch2] = c.x;
            __syncthreads();
            float off0 = 0.f, off1 = 0.f;
#pragma unroll
            for (int s2 = 0; s2 < 8; ++s2) { const float t0 = SEG[s2 * 64 + ch2], t1 = SEG[(8 + s2) * 64 + ch2]; off0 += (s2 < seg) ? t0 : 0.f; off1 += (s2 > seg) ? t1 : 0.f; }
            *p0a = a + off0; *p0b = bq + off0; *p1a = c + off1; *p1b = d + off1;
        }
        __syncthreads();
        {
            const float inv = 1.0f / fmaxf(sqrtf(ssq), 1e-12f);
            float t8[8], u8[8], w8[8], r8v[8];
            {
                LAS unsigned char* t0 = F.lds; const int tau = tok;
                float e1[8], ei[8];
#pragma unroll
                for (int i = 0; i < 8; ++i) { const int ch = ch0 + i; const float cm = LW0[ch * 64 + (tok ^ (4 * ((ch & 15) ^ (2 * (ch >> 4)))))]; e1[i] = __expf(cm); ei[i] = __builtin_amdgcn_rcpf(e1[i]); t8[i] = kkp[i] * inv * __expf(cm - lw0[i]); }
                if (tok == 63) {
#pragma unroll
                    for (int i = 0; i < 8; ++i) GAM[ch0 + i] = e1[i]; }
#pragma unroll
                for (int i = 0; i < 8; ++i) { u8[i] = kkp[i] * inv * a_0[i] * ei[i]; w8[i] = kd0[i] * ei[i]; r8v[i] = rs[i] * e1[i]; }
                putN(t0 + 0 * TILE, tau, oct, t8); putN(t0 + 1 * TILE, tau, oct, u8); putN(t0 + 2 * TILE, tau, oct, w8); putN(t0 + 3 * TILE, tau, oct, vs); putN(t0 + 4 * TILE, tau, oct, r8v);
            }
            {
                LAS unsigned char* t1 = F.lds + 9 * TILE; const int tau = 63 - tok;
                float e1[8], ei[8];
#pragma unroll
                for (int i = 0; i < 8; ++i) { const int ch = ch0 + i; const float cm = LW1[ch * 64 + (tok ^ (4 * ((ch & 15) ^ (2 * (ch >> 4)))))]; e1[i] = __expf(cm); ei[i] = __builtin_amdgcn_rcpf(e1[i]); t8[i] = kkp[i] * inv * __expf(cm - lw1[i]); }
                if (tok == 0) {
#pragma unroll
                    for (int i = 0; i < 8; ++i) GAM[64 + ch0 + i] = e1[i]; }
#pragma unroll
                for (int i = 0; i < 8; ++i) { u8[i] = kkp[i] * inv * a_1[i] * ei[i]; w8[i] = kd1[i] * ei[i]; r8v[i] = rs[i] * e1[i]; }
                putN(t1 + 0 * TILE, tau, oct, t8); putN(t1 + 1 * TILE, tau, oct, u8); putN(t1 + 2 * TILE, tau, oct, w8); putN(t1 + 3 * TILE, tau, oct, vs); putN(t1 + 4 * TILE, tau, oct, r8v);
            }
        }
        const size_t inst = (size_t)unit * 2 + dgrp;
        epre_load<true>(PF, z, LO, unit + F.G < NU ? unit + F.G : unit, wave, lane);
        const int cv_strip = F.gw + (cv_t >> 4) * F.NGW, cv_kb = cv_t & 15;
        { int e_, n0_, rb_; wei_strip(cv_strip < NE * 64 ? cv_strip : 0, e_, n0_, rb_); cv_load(cvt, cv_w + (size_t)e_ * D * 2048, 2048, n0_, cv_kb, lane); }
        __syncthreads();
        f32x4 acc[4], acc2[4];
        zero4(acc); mm64x<false, false>(acc, SL(1), SL(0), wq, lane);
        zero4(acc2); mm64x<false, false>(acc2, SL(2), SL(0), wq, lane);
#pragma unroll
        for (int n = 0; n < 4; ++n)
#pragma unroll
            for (int q = 0; q < 4; ++q) { const bool lo = (16 * wq + 4 * g + q < 16 * n + lr); acc[n][q] = lo ? acc[n][q] : 0.f; acc2[n][q] = lo ? acc2[n][q] : 0.f; }
        storeT(SL(5), acc, wq, lane); storeT(SL(6), acc2, wq, lane);
        __syncthreads();
        zero4(acc); mm64x<false, true>(acc, SL(6), SL(3), wq, lane); storeT(SL(7), acc, wq, lane);
        if (wq == 0) {
            const int bb = lane >> 4, jj = lane & 15;
            float X[16];
            X[0] = (jj == 0) ? 1.f : 0.f;
#pragma unroll
            for (int t = 1; t < 16; ++t) {
                const int row = 16 * bb + t;
                const v4u p0 = *(const LAS v4u*)(SL(5) + row * 128 + (((2 * bb) ^ swz(row)) << 4)), p1 = *(const LAS v4u*)(SL(5) + row * 128 + (((2 * bb + 1) ^ swz(row)) << 4));
                float rw[16];
                rw[0] = bflo(p0.x); rw[1] = bfhi(p0.x); rw[2] = bflo(p0.y); rw[3] = bfhi(p0.y); rw[4] = bflo(p0.z); rw[5] = bfhi(p0.z); rw[6] = bflo(p0.w); rw[7] = bfhi(p0.w);
                rw[8] = bflo(p1.x); rw[9] = bfhi(p1.x); rw[10] = bflo(p1.y); rw[11] = bfhi(p1.y); rw[12] = bflo(p1.z); rw[13] = bfhi(p1.z); rw[14] = bflo(p1.w); rw[15] = bfhi(p1.w);
                float xv = (t == jj) ? 1.f : 0.f;
#pragma unroll
                for (int s = 0; s < t; ++s) xv -= rw[s] * X[s];
                X[t] = xv;
            }
#pragma unroll
            for (int t = 0; t < 16; ++t) *(LAS unsigned short*)(DIB + (((bb * 16 + t) * 16 + jj) << 1)) = (unsigned short)f2bf(X[t]);
        }
        __syncthreads();
        {
            const bool isU = wq >= 2; const int cbase = 32 * (wq & 1);
            LAS unsigned char* outT = isU ? SL(6) : SL(8);
#pragma unroll
            for (int ct = 0; ct < 2; ++ct) {
                const int ctile = 2 * (wq & 1) + ct, col = cbase + 16 * ct + lr;
                f32x4 X[4];
#pragma unroll
                for (int b2 = 0; b2 < 4; ++b2) {
                    f32x4 Zt;
                    if (isU) { const v2u rwv = *(const LAS v2u*)(SL(7) + toff(col, 16 * b2 + 4 * g)); Zt = (f32x4){bflo(rwv.x), bfhi(rwv.x), bflo(rwv.y), bfhi(rwv.y)}; }
                    else Zt = loadN_acc(SL(0), b2, ctile, lane);
                    if (b2 >= 1) {
                        f32x4 Y = {0.f, 0.f, 0.f, 0.f};
#pragma unroll
                        for (int s = 0; s < (b2 + 1) / 2; ++s) {
                            v2u alo = {0u, 0u}, ahi = {0u, 0u};
                            if (2 * s < b2) alo = *(const LAS v2u*)(SL(5) + toff(16 * b2 + lr, 32 * s + 4 * g));
                            if (2 * s + 1 < b2) ahi = *(const LAS v2u*)(SL(5) + toff(16 * b2 + lr, 32 * s + 16 + 4 * g));
                            v4u bw = {cvtpk(X[2 * s][0], X[2 * s][1]), cvtpk(X[2 * s][2], X[2 * s][3]), 0u, 0u};
                            if (2 * s + 1 < b2) { bw.z = cvtpk(X[2 * s + 1][0], X[2 * s + 1][1]); bw.w = cvtpk(X[2 * s + 1][2], X[2 * s + 1][3]); }
                            Y = CK_MFMA(__builtin_bit_cast(bf16x8, ((v4u){alo.x, alo.y, ahi.x, ahi.y})), __builtin_bit_cast(bf16x8, bw), Y);
                        }
                        Zt = Zt - Y;
                    }
                    const v2u dv = *(const LAS v2u*)(DIB + (((b2 * 16 + lr) * 16 + 4 * g) << 1));
                    const v4u bz = {cvtpk(Zt[0], Zt[1]), cvtpk(Zt[2], Zt[3]), 0u, 0u};
                    X[b2] = CK_MFMA(__builtin_bit_cast(bf16x8, ((v4u){dv.x, dv.y, 0u, 0u})), __builtin_bit_cast(bf16x8, bz), ((f32x4){0.f, 0.f, 0.f, 0.f}));
                }
#pragma unroll
                for (int b2 = 0; b2 < 4; ++b2) *(LAS v2u*)(outT + toff(col, 16 * b2 + 4 * g)) = (v2u){cvtpk(X[b2][0], X[b2][1]), cvtpk(X[b2][2], X[b2][3])};
            }
        }
        __syncthreads();
        asm volatile("" : "+v"(PF.k[0]), "+v"(PF.k[1]), "+v"(PF.k[2]), "+v"(PF.k[3]), "+v"(PF.k[4]), "+v"(PF.v[0]), "+v"(PF.v[1]), "+v"(PF.v[2]), "+v"(PF.v[3]), "+v"(PF.v[4]));
        asm volatile("" : "+v"(PF.r[0]), "+v"(PF.r[1]), "+v"(PF.r[2]), "+v"(PF.r[3]), "+v"(PF.r[4]), "+v"(PF.lo[0]), "+v"(PF.lo[1]), "+v"(PF.lo[2]), "+v"(PF.lo[3]));
        asm volatile("" : "+v"(cvt.v[0]), "+v"(cvt.v[1]), "+v"(cvt.v[2]), "+v"(cvt.v[3]), "+v"(cvt.v[4]), "+v"(cvt.v[5]), "+v"(cvt.v[6]), "+v"(cvt.v[7]));
        {
            zero4(acc); mm64x<false, true>(acc, SL(8), SL(1), wq, lane);
            const int cstep_ = unit < NU_L ? 4 + (dgrp ? 127 - ((unit >> 4) & 127) : ((unit >> 4) & 127)) : (dgrp ? 3 - (((unit - NU_L) >> 4) & 3) : (((unit - NU_L) >> 4) & 3));
            unsigned char* pb = PQ + (size_t)(((b * 16 + h) * 2 + dgrp) * (4 + T / 64) + cstep_) * 16384;
#pragma unroll
            for (int n = 0; n < 4; ++n) { const int k = 16 * n + lr; const float gm = GAM[dgrp * 64 + k]; float p[4];
#pragma unroll
                for (int q = 0; q < 4; ++q) p[q] = gm * (((16 * wq + 4 * g + q) == k ? 1.f : 0.f) - acc[n][q]);
                *(uint2*)(pb + (size_t)(((n * 2 + (wq >> 1)) * 64 + lane) * 16 + (wq & 1) * 8)) = make_uint2(cvtpk(p[0], p[1]), cvtpk(p[2], p[3])); }
            zero4(acc); mm64x<true, true>(acc, SL(2), SL(3), wq, lane); zero4(acc2); mm64x<true, false>(acc2, SL(1), SL(6), wq, lane);
            const f32x4 gm4 = *(const LAS f32x4*)(GAM + dgrp * 64 + 16 * wq + 4 * g);
#pragma unroll
            for (int n = 0; n < 4; ++n) { const f32x4 qv = (acc[n] - acc2[n]) * gm4;
                *(uint2*)(pb + 8192 + (size_t)(((n * 64 + lane) * 4 + wq) * 8)) = make_uint2(cvtpk(qv[0], qv[1]), cvtpk(qv[2], qv[3])); }
            if (unit < NU_L) {
                zero4(acc); mm64x<false, false>(acc, SL(2), SL(4), wq, lane);
                zero4(acc2); mm64x<false, false>(acc2, SL(1), SL(4), wq, lane);
#pragma unroll
                for (int n = 0; n < 4; ++n)
#pragma unroll
                    for (int q = 0; q < 4; ++q) { const bool le = (16 * wq + 4 * g + q <= 16 * n + lr); acc[n][q] = le ? acc[n][q] : 0.f; acc2[n][q] = le ? -acc2[n][q] : 0.f; }
                storeT(SL(5), acc, wq, lane); storeT(SL(7), acc2, wq, lane);
            }
        }
        __syncthreads();
        if (unit < NU_L) {
            loadT(acc, SL(4), wq, lane);
            mm64x<false, false>(acc, SL(8), SL(7), wq, lane);
            unsigned char* rb = RHAT + inst * 8192;
#pragma unroll
            for (int n = 0; n < 4; ++n) *(uint2*)(rb + (size_t)((16 * n + lr) * 64 + 16 * wq + 4 * g) * 2) = make_uint2(cvtpk(acc[n][0], acc[n][1]), cvtpk(acc[n][2], acc[n][3]));
            zero4(acc2); mm64x<false, true>(acc2, SL(5), SL(3), wq, lane); mm64x<false, false>(acc2, SL(7), SL(6), wq, lane);
            unsigned char* yb = YLOC + inst * 8192 + (size_t)((wq * 64 + lane) * 32);
            v4u o0, o1; o0.x = cvtpk(acc2[0][0], acc2[0][1]); o0.y = cvtpk(acc2[0][2], acc2[0][3]); o0.z = cvtpk(acc2[1][0], acc2[1][1]); o0.w = cvtpk(acc2[1][2], acc2[1][3]);
            o1.x = cvtpk(acc2[2][0], acc2[2][1]); o1.y = cvtpk(acc2[2][2], acc2[2][3]); o1.z = cvtpk(acc2[3][0], acc2[3][1]); o1.w = cvtpk(acc2[3][2], acc2[3][3]);
            *(v4u*)yb = o0; *(v4u*)(yb + 16) = o1;
        }
        __syncthreads();
        {
            if (cv_strip < NE * 64) { int e_, n0_, rb_; wei_strip(cv_strip, e_, n0_, rb_);
                if (cv_kb == 0 && cv_t > 0) cv_scale_q8(cv_w + (size_t)e_ * D * 2048, 2048, n0_, (float*)(F.ws + MI_CSWEI) + (size_t)e_ * 2048, rb_, lane, civ);
                cv_store_q8(cvt, cv_scr, (signed char*)(F.ws + WS_WEIN) + (size_t)e_ * 2048 * D, rb_, cv_kb, civ, lane); }
            ++cv_t;
            __syncthreads();
        }
    }
    for (;;) { const int s_ = F.gw + (cv_t >> 4) * F.NGW, kb_ = cv_t & 15; if (s_ >= NE * 64) break;
        int e_, n0_, rb_; wei_strip(s_, e_, n0_, rb_);
        if (kb_ == 0 && cv_t > 0) cv_scale_q8(cv_w + (size_t)e_ * D * 2048, 2048, n0_, (float*)(F.ws + MI_CSWEI) + (size_t)e_ * 2048, rb_, F.lane, civ);
        cv_load(cvt, cv_w + (size_t)e_ * D * 2048, 2048, n0_, kb_, F.lane);
        cv_store_q8(cvt, cv_scr, (signed char*)(F.ws + WS_WEIN) + (size_t)e_ * 2048 * D, rb_, kb_, civ, F.lane); ++cv_t; }
#undef SL
}

__device__ __forceinline__ void phase_co2(Frame& F) {
    const int wave = F.wave;
    const int dgrp = wave >> 2, wq = wave & 3;
    LAS unsigned char* tl = F.lds + dgrp * 9 * TILE;
#define SL(k) (tl + (k) * TILE)
    const bf16* z = (const bf16*)(F.ws + WS_Z); const bf16* LO = (const bf16*)(F.ws + WS_LORA);
    const unsigned char* RHAT = F.ws + WS_TKN; const unsigned char* YLOC = F.ws + WS_UPRE; const unsigned char* H0T = F.ws + WS_H0T;
    const float* BON = (const float*)(F.ws + MI_BON);
    bf16* MG = (bf16*)(F.ws + WS_A0);
    const float* p_mu = KIN(I_MU);
    for (int unit = blockIdx.x; unit < NU_L; unit += F.G) {
        int lane = F.lane; asm volatile("" : "+v"(lane));
        const int lr = lane & 15, g = lane >> 4;
        int b, h, rowbase; unit_decode(unit, b, h, rowbase);
        const int tok = 8 * wave + (lane >> 3), oct = lane & 7, ch0 = 8 * oct, c0 = h * 64 + ch0, row = rowbase + tok;
        const size_t inst = (size_t)unit * 2 + dgrp;
        const int t2 = (wq << 6) | lane;
#pragma unroll
        for (int rep = 0; rep < 2; ++rep) { const int cidx = t2 + 256 * rep, r_ = cidx >> 3, ch = cidx & 7;
            const v4u a = *(const v4u*)(RHAT + inst * 8192 + (size_t)(r_ * 64 + ch * 8) * 2), hh = *(const v4u*)(H0T + inst * 8192 + (size_t)(r_ * 64 + ch * 8) * 2);
            *(LAS v4u*)(SL(0) + r_ * 128 + ((ch ^ swz(r_)) << 4)) = a; *(LAS v4u*)(SL(1) + r_ * 128 + ((ch ^ swz(r_)) << 4)) = hh; }
        f32x4 acc[4];
        { const unsigned char* yb = YLOC + inst * 8192 + (size_t)((wq * 64 + lane) * 32); const v4u o0 = *(const v4u*)yb, o1 = *(const v4u*)(yb + 16);
          acc[0] = (f32x4){bflo(o0.x), bfhi(o0.x), bflo(o0.y), bfhi(o0.y)}; acc[1] = (f32x4){bflo(o0.z), bfhi(o0.z), bflo(o0.w), bfhi(o0.w)};
          acc[2] = (f32x4){bflo(o1.x), bfhi(o1.x), bflo(o1.y), bfhi(o1.y)}; acc[3] = (f32x4){bflo(o1.z), bfhi(o1.z), bflo(o1.w), bfhi(o1.w)}; }
        const int t = row & (T - 1);
        const bf16* zr = z + (size_t)row * NZ;
        const v4u zz = {0u, 0u, 0u, 0u};
        v4u qv[5]; qv[0] = *(const v4u*)(zr + V_OFF + c0);
#pragma unroll
        for (int j = 0; j < 4; ++j) { const int nr = nbr_row(row, j); qv[1 + j] = nr >= 0 ? *(const v4u*)(z + (size_t)nr * NZ + V_OFF + c0) : zz; }
        const v4u q_g = *(const v4u*)(LO + (size_t)row * NL + 4096 + c0);
        const v4u q_gb = *(const v4u*)(zr + CONV_OFF + c0), q_c0 = *(const v4u*)(zr + CONV_OFF + 1024 + c0), q_x0 = *(const v4u*)(zr + CONV_OFF + 2048 + c0);
        const v4u q_cm = t > 0 ? *(const v4u*)(zr - NZ + CONV_OFF + 1024 + c0) : zz, q_xm = t > 0 ? *(const v4u*)(zr - NZ + CONV_OFF + 2048 + c0) : zz;
        const v4u q_cp = t < T - 1 ? *(const v4u*)(zr + NZ + CONV_OFF + 1024 + c0) : zz, q_xp = t < T - 1 ? *(const v4u*)(zr + NZ + CONV_OFF + 2048 + c0) : zz;
        const v4u q_ga = *(const v4u*)(zr + GATE_OFF + c0), q_gr = *(const v4u*)(zr + GATE_OFF + 1024 + c0);
        const float S3 = BON[(size_t)unit * 64 + tok];
        __syncthreads();
        mm64x<false, false>(acc, SL(0), SL(1), wq, lane);
        { LAS float* Yf = (LAS float*)(tl + 2 * TILE);
#pragma unroll
          for (int n = 0; n < 4; ++n)
#pragma unroll
              for (int q = 0; q < 4; ++q) { const int tau = 16 * wq + 4 * g + q; Yf[tau * 64 + ((16 * n + lr) ^ (4 * (tau & 15)))] = acc[n][q]; } }
        __syncthreads();
        { const LAS float* Y0 = (const LAS float*)(F.lds + 2 * TILE); const LAS float* Y1 = (const LAS float*)(F.lds + 11 * TILE);
          float y[8];
          { const int s0 = 4 * (tok & 15), s1 = 4 * ((63 - tok) & 15);
            const f32x4 a0 = *(const LAS f32x4*)(Y0 + tok * 64 + (ch0 ^ s0)), a1 = *(const LAS f32x4*)(Y0 + tok * 64 + ((ch0 + 4) ^ s0));
            const f32x4 b0 = *(const LAS f32x4*)(Y1 + (63 - tok) * 64 + (ch0 ^ s1)), b1 = *(const LAS f32x4*)(Y1 + (63 - tok) * 64 + ((ch0 + 4) ^ s1));
            y[0] = a0.x + b0.x; y[1] = a0.y + b0.y; y[2] = a0.z + b0.z; y[3] = a0.w + b0.w; y[4] = a1.x + b1.x; y[5] = a1.y + b1.y; y[6] = a1.z + b1.z; y[7] = a1.w + b1.w; }
          float s1 = 0.f, s2 = 0.f;
#pragma unroll
          for (int i = 0; i < 8; ++i) { s1 += y[i]; s2 += y[i] * y[i]; }
          s1 += __shfl_xor(s1, 1); s2 += __shfl_xor(s2, 1); s1 += __shfl_xor(s1, 2); s2 += __shfl_xor(s2, 2); s1 += __shfl_xor(s1, 4); s2 += __shfl_xor(s2, 4);
          const float mean = s1 * (1.0f / 64.0f), var = fmaxf(s2 * (1.0f / 64.0f) - mean * mean, 0.f), rstd = __builtin_amdgcn_rsqf(var + 64e-5f);
          float vs[8]; shift8(qv, p_mu + V_OFF + c0, vs);
          float lnw[8], lnb[8], cw0[8], cw1[8], cw2[8];
          ld8f(KIN(I_LNW) + c0, lnw); ld8f(KIN(I_LNB) + c0, lnb); ld8f(KIN(I_CONVW) + c0, cw0); ld8f(KIN(I_CONVW) + D + c0, cw1); ld8f(KIN(I_CONVW) + 2 * D + c0, cw2);
          float gg[8], gb[8], cc[8], xx[8], cm[8], xm[8], cp[8], xp[8], ga[8], gr[8];
          unpack8(q_g, gg); unpack8(q_gb, gb); unpack8(q_c0, cc); unpack8(q_x0, xx); unpack8(q_cm, cm); unpack8(q_xm, xm); unpack8(q_cp, cp); unpack8(q_xp, xp); unpack8(q_ga, ga); unpack8(q_gr, gr);
          float o[8];
#pragma unroll
          for (int i = 0; i < 8; ++i) {
              const float yn = (y[i] - mean) * rstd * lnw[i] + lnb[i];
              const float yr = (yn + S3 * vs[i]) * gg[i];
              const float yc = gb[i] * (cw0[i] * (cm[i] * xm[i]) + cw1[i] * (cc[i] * xx[i]) + cw2[i] * (cp[i] * xp[i]));
              o[i] = fsig(ga[i]) * yr + fsig(gr[i]) * yc;
          }
          v4u ov; ov.x = cvtpk(o[0], o[1]); ov.y = cvtpk(o[2], o[3]); ov.z = cvtpk(o[4], o[5]); ov.w = cvtpk(o[6], o[7]);
          *(v4u*)(MG + (size_t)row * D + c0) = ov;
        }
        __syncthreads();
    }
#undef SL
}

struct SSIn { v4u a[8]; v4u q[2]; };
__device__ __forceinline__ size_t ss_pq(int step, int b, int h, int d) { return (size_t)(((b * 16 + h) * 2 + d) * (4 + T / 64) + step); }
__device__ __forceinline__ size_t ss_inst(int step, int b, int h, int d) {
    int unit;
    if (step < 4) { const int cb = d ? 3 - step : step; unit = NU_L + (b * 4 + cb) * 16 + h; }
    else { const int blk = d ? 127 - (step - 4) : step - 4; unit = (b * 128 + blk) * 16 + h; }
    return (size_t)unit * 2 + d;
}
__device__ __forceinline__ void ss_load(SSIn& I, const unsigned char* PQ, size_t inst, int wv, int lane) {
    const unsigned char* pb = PQ + inst * 16384;
#pragma unroll
    for (int f = 0; f < 8; ++f) I.a[f] = *(const v4u*)(pb + (size_t)((f * 64 + lane) * 16));
    I.q[0] = *(const v4u*)(pb + 8192 + (size_t)((wv * 64 + lane) * 32)); I.q[1] = *(const v4u*)(pb + 8192 + (size_t)((wv * 64 + lane) * 32 + 16));
}
__device__ __forceinline__ void ss_step(f32x4 (&H)[4], const SSIn& cur, unsigned char* H0T, size_t inst, bool store_h0, int wv, int lr, int g) {
    const unsigned p00 = cvtpk(H[0][0], H[0][1]), p01 = cvtpk(H[0][2], H[0][3]), p10 = cvtpk(H[1][0], H[1][1]), p11 = cvtpk(H[1][2], H[1][3]);
    const unsigned p20 = cvtpk(H[2][0], H[2][1]), p21 = cvtpk(H[2][2], H[2][3]), p30 = cvtpk(H[3][0], H[3][1]), p31 = cvtpk(H[3][2], H[3][3]);
    if (store_h0) { unsigned char* hb = H0T + inst * 8192 + (size_t)((16 * wv + lr) * 64 + 4 * g) * 2;
        *(uint2*)(hb) = make_uint2(p00, p01); *(uint2*)(hb + 32) = make_uint2(p10, p11); *(uint2*)(hb + 64) = make_uint2(p20, p21); *(uint2*)(hb + 96) = make_uint2(p30, p31); }
    const bf16x8 b0 = __builtin_bit_cast(bf16x8, ((v4u){p00, p01, p10, p11})), b1 = __builtin_bit_cast(bf16x8, ((v4u){p20, p21, p30, p31}));
    H[0] = (f32x4){bflo(cur.q[0].x), bfhi(cur.q[0].x), bflo(cur.q[0].y), bfhi(cur.q[0].y)}; H[1] = (f32x4){bflo(cur.q[0].z), bfhi(cur.q[0].z), bflo(cur.q[0].w), bfhi(cur.q[0].w)};
    H[2] = (f32x4){bflo(cur.q[1].x), bfhi(cur.q[1].x), bflo(cur.q[1].y), bfhi(cur.q[1].y)}; H[3] = (f32x4){bflo(cur.q[1].z), bfhi(cur.q[1].z), bflo(cur.q[1].w), bfhi(cur.q[1].w)};
#pragma unroll
    for (int m = 0; m < 4; ++m) { H[m] = CK_MFMA(__builtin_bit_cast(bf16x8, cur.a[2 * m]), b0, H[m]); H[m] = CK_MFMA(__builtin_bit_cast(bf16x8, cur.a[2 * m + 1]), b1, H[m]); }
}
__device__ __forceinline__ void phase_ss(Frame& F) {
    const unsigned char* PQ = F.ws + WS_PQ; unsigned char* H0T = F.ws + WS_H0T;
    const int lane = F.lane, lr = lane & 15, g = lane >> 4;
    for (int task = (int)blockIdx.x; task < 256; task += F.G) {
        const int chain = (task & 7) + 8 * (task >> 5), wv = (task >> 3) & 3, b = chain >> 5, h = (chain >> 1) & 15, d = chain & 1;
        f32x4 H[4]; zero4(H);
        constexpr int NS = 4 + T / 64;
        static_assert(NS % 4 == 0, "unrolled by four");
        SSIn b0, b1, b2, b3;
        ss_load(b0, PQ, ss_pq(0, b, h, d), wv, lane); ss_load(b1, PQ, ss_pq(1, b, h, d), wv, lane); ss_load(b2, PQ, ss_pq(2, b, h, d), wv, lane); ss_load(b3, PQ, ss_pq(3, b, h, d), wv, lane);
        for (int step = 0; step < NS; step += 4) {
            const int n0 = step + 4 < NS ? step + 4 : NS - 1, n1 = step + 5 < NS ? step + 5 : NS - 1, n2 = step + 6 < NS ? step + 6 : NS - 1, n3 = step + 7 < NS ? step + 7 : NS - 1;
            ss_step(H, b0, H0T, ss_inst(step, b, h, d), step >= 4, wv, lr, g);     ss_load(b0, PQ, ss_pq(n0, b, h, d), wv, lane);
            ss_step(H, b1, H0T, ss_inst(step + 1, b, h, d), step >= 4, wv, lr, g); ss_load(b1, PQ, ss_pq(n1, b, h, d), wv, lane);
            ss_step(H, b2, H0T, ss_inst(step + 2, b, h, d), step >= 4, wv, lr, g); ss_load(b2, PQ, ss_pq(n2, b, h, d), wv, lane);
            ss_step(H, b3, H0T, ss_inst(step + 3, b, h, d), step >= 4, wv, lr, g); ss_load(b3, PQ, ss_pq(n3, b, h, d), wv, lane);
        }
    }
}

struct LoraARaw { v4u q[5]; f32x4 m0, m1; };
__device__ __forceinline__ int lora_acol(int gi, int oct) { return (gi < 4 ? DECAY_OFF + 64 * gi : GLORA_OFF + 64 * (gi - 4)) + 8 * oct; }
__device__ __forceinline__ unsigned lora_aload(LoraARaw& R, const bf16* z, const float* p_mu, int r0, int gi, int wave, int lane) {
    const int tok = 8 * wave + (lane >> 3), oct = lane & 7, row = r0 + tok, col = lora_acol(gi, oct);
    R.q[0] = *(const v4u*)(z + (size_t)row * NZ + col);
    unsigned msk = 0u;
#pragma unroll
    for (int j = 0; j < 4; ++j) { const int nr = nbr_row(row, j); msk |= (nr >= 0 ? 1u : 0u) << j; R.q[1 + j] = *(const v4u*)(z + (size_t)(nr >= 0 ? nr : row) * NZ + col); }
    R.m0 = *(const f32x4*)(p_mu + col); R.m1 = *(const f32x4*)(p_mu + col + 4);
    return msk;
}
__device__ __forceinline__ void lora_astore(const LoraARaw& R, unsigned msk, LAS unsigned char* lds, int gi, int wave, int lane) {
    const int tok = 8 * wave + (lane >> 3), oct = lane & 7;
    const v4u zz = {0u, 0u, 0u, 0u};
    const v4u s = R.q[0], n0 = (msk & 1u) ? R.q[1] : zz, n1 = (msk & 2u) ? R.q[2] : zz, n2 = (msk & 4u) ? R.q[3] : zz, n3 = (msk & 8u) ? R.q[4] : zz;
    float v[8];
    v[0] = bflo(s.x) + R.m0.x * (bflo(n0.x) - bflo(s.x)); v[1] = bfhi(s.x) + R.m0.y * (bfhi(n1.x) - bfhi(s.x));
    v[2] = bflo(s.y) + R.m0.z * (bflo(n2.y) - bflo(s.y)); v[3] = bfhi(s.y) + R.m0.w * (bfhi(n3.y) - bfhi(s.y));
    v[4] = bflo(s.z) + R.m1.x * (bflo(n0.z) - bflo(s.z)); v[5] = bfhi(s.z) + R.m1.y * (bfhi(n1.z) - bfhi(s.z));
    v[6] = bflo(s.w) + R.m1.z * (bflo(n2.w) - bflo(s.w)); v[7] = bfhi(s.w) + R.m1.w * (bfhi(n3.w) - bfhi(s.w));
#pragma unroll
    for (int i = 0; i < 8; ++i) v[i] = gi < 2 ? 1.0f - 2.0f * __builtin_amdgcn_rcpf(1.0f + __expf(2.0f * v[i])) : (gi < 4 ? v[i] : fsig(v[i]));
    putN(lds + gi * TILE, tok, oct, v);
}
__device__ __forceinline__ void lora_atile(const bf16* z, const float* p_mu, LAS unsigned char* lds, int r0, int gi, int wave, int lane) {
    LoraARaw R; const unsigned msk = lora_aload(R, z, p_mu, r0, gi, wave, lane); lora_astore(R, msk, lds, gi, wave, lane);
}
template <int KS> struct LoraB { bf16x8 w[KS][4]; };
template <int KS>
__device__ __forceinline__ void lora_bload(LoraB<KS>& B, const bf16* WL, int q, int lr, int g) {
    const int blkid = q >> 4, h = q & 15;
    const bf16* wrow = WL + (size_t)(blkid * 1024 + h * 64 + 8 * (lr >> 2) + (lr & 3)) * KL + blkid * 64 + 8 * g;
#pragma unroll
    for (int s = 0; s < KS; ++s)
#pragma unroll
        for (int n = 0; n < 4; ++n) B.w[s][n] = *(const bf16x8*)(wrow + (size_t)(32 * (n >> 1) + 4 * (n & 1)) * KL + 32 * s);
}
template <int KS>
__device__ __forceinline__ void lora_product(const LoraB<KS>& B, const LAS unsigned char* At, bf16* LO, int r0, int q, int lr, int g, const LAS float* LBI) {
    const int blkid = q >> 4, h = q & 15;
    f32x4 acc[4][4];
#pragma unroll
    for (int n = 0; n < 4; ++n)
#pragma unroll
        for (int m = 0; m < 4; ++m) acc[n][m] = (f32x4){0.f, 0.f, 0.f, 0.f};
#pragma unroll
    for (int s = 0; s < KS; ++s) {
        bf16x8 af[4];
#pragma unroll
        for (int m = 0; m < 4; ++m) af[m] = ldfrag(At + (s >> 1) * TILE, 16 * m + lr, 4 * (s & 1) + g);
#pragma unroll
        for (int n = 0; n < 4; ++n)
#pragma unroll
            for (int m = 0; m < 4; ++m) acc[n][m] = CK_MFMA(B.w[s][n], af[m], acc[n][m]);
    }
    bf16* ob = LO + (size_t)(r0 + lr) * NL + blkid * 1024 + h * 64 + 8 * g;
#pragma unroll
    for (int m = 0; m < 4; ++m)
#pragma unroll
        for (int p = 0; p < 2; ++p) {
            f32x4 v0 = acc[2 * p][m], v1 = acc[2 * p + 1][m];
            if (KS == 2) {
                const LAS float* bp = LBI + blkid * 1024 + h * 64 + 8 * g + 32 * p; const f32x4 b0 = *(const LAS f32x4*)bp, b1 = *(const LAS f32x4*)(bp + 4); const float sc = blkid < 2 ? -0.6065306597126334f : 1.0f;
#pragma unroll
                for (int e = 0; e < 4; ++e) { v0[e] = sc * fsig(v0[e] + b0[e]); v1[e] = sc * fsig(v1[e] + b1[e]); }
            }
            v4u o; o.x = cvtpk(v0[0], v0[1]); o.y = cvtpk(v0[2], v0[3]); o.z = cvtpk(v1[0], v1[1]); o.w = cvtpk(v1[2], v1[3]);
            *(v4u*)(ob + (size_t)(16 * m) * NL + 32 * p) = o; }
}
__device__ __forceinline__ void phase_lora(Frame& F) {
    const bf16* z = (const bf16*)(F.ws + WS_Z); bf16* LO = (bf16*)(F.ws + WS_LORA); const bf16* WL = (const bf16*)(F.ws + WS_WLORA);
    const float* p_mu = KIN(I_MU); const float* p_w0 = KIN(I_W0); const float* p_a0 = KIN(I_A0);
    LAS float* LBI = (LAS float*)(F.lds + 15 * TILE);
    { const int i4 = F.tid * 4; *(LAS f32x4*)(LBI + i4) = *(const f32x4*)(p_w0 + i4); *(LAS f32x4*)(LBI + 2048 + i4) = *(const f32x4*)(p_a0 + i4); }
    __syncthreads();
    for (int unit = blockIdx.x; unit < ML / 64; unit += F.G) {
        int lane = F.lane; asm volatile("" : "+v"(lane));
        const int lr = lane & 15, g = lane >> 4, r0 = unit * 64;
#pragma unroll
        for (int gb = 0; gb < 6; gb += 3) {
            LoraARaw R0, R1, R2;
            const unsigned k0 = lora_aload(R0, z, p_mu, r0, gb, F.wave, lane), k1 = lora_aload(R1, z, p_mu, r0, gb + 1, F.wave, lane), k2 = lora_aload(R2, z, p_mu, r0, gb + 2, F.wave, lane);
            __builtin_amdgcn_sched_barrier(0);
            lora_astore(R0, k0, F.lds, gb, F.wave, lane); lora_astore(R1, k1, F.lds, gb + 1, F.wave, lane); lora_astore(R2, k2, F.lds, gb + 2, F.wave, lane);
        }
        __syncthreads();
        const float* weo = KIN(I_WEO); bf16* WEO = (bf16*)(F.ws + WS_WEOUT);
        LAS float* fscr = (LAS float*)(F.lds + 6 * TILE + F.wave * 8704);
        const int ft0 = (unit * NWAVES + F.wave) * 10;
        CvTile ft;
#define LORA_FILL_LOAD(p) do { const int id0_ = ft0 + (p), id_ = id0_ < NE * 512 ? id0_ : 0; const int e_ = id_ >> 9, q_ = id_ & 511; cv_load(ft, weo + (size_t)e_ * D * D, D, 32 * (q_ & 31), q_ >> 5, lane); } while (0)
#define LORA_FILL_STORE(p) do { const int id_ = ft0 + (p); if (id_ < NE * 512) { const int e_ = id_ >> 9, q_ = id_ & 511; cv_to_lds(ft, fscr, lane); cv_store_bf16(fscr, WEO + (size_t)e_ * D * D, D, 32 * (q_ & 31), 64 * (q_ >> 5), lane); } } while (0)
        LoraB<2> b0, b1;
        lora_bload<2>(b0, WL, F.wave, lr, g);
#pragma unroll
        for (int i = 0; i < 8; i += 2) {
            lora_bload<2>(b1, WL, F.wave + 8 * (i + 1), lr, g); LORA_FILL_LOAD(i);
            lora_product<2>(b0, F.lds + ((F.wave + 8 * i) >> 4) * TILE, LO, r0, F.wave + 8 * i, lr, g, LBI);
            LORA_FILL_STORE(i);
            if (i + 2 < 8) lora_bload<2>(b0, WL, F.wave + 8 * (i + 2), lr, g);
            LORA_FILL_LOAD(i + 1);
            lora_product<2>(b1, F.lds + ((F.wave + 8 * (i + 1)) >> 4) * TILE, LO, r0, F.wave + 8 * (i + 1), lr, g, LBI);
            LORA_FILL_STORE(i + 1);
        }
        { LoraB<4> c0; lora_bload<4>(c0, WL, 64 + F.wave, lr, g); LORA_FILL_LOAD(8); lora_product<4>(c0, F.lds + 4 * TILE, LO, r0, 64 + F.wave, lr, g, LBI); LORA_FILL_STORE(8);
          lora_bload<4>(c0, WL, 72 + F.wave, lr, g); LORA_FILL_LOAD(9); lora_product<4>(c0, F.lds + 4 * TILE, LO, r0, 72 + F.wave, lr, g, LBI); LORA_FILL_STORE(9); }
#undef LORA_FILL_LOAD
#undef LORA_FILL_STORE
        __syncthreads();
    }
    for (int t = blockIdx.x; t < (MC / 64) * 32; t += F.G) {
        int lane = F.lane; asm volatile("" : "+v"(lane));
        const int lr = lane & 15, g = lane >> 4, r0 = ML + (t >> 5) * 64, q0 = 2 * (t & 31), gi = q0 >> 4;
        lora_atile(z, p_mu, F.lds, r0, gi, F.wave, lane);
        __syncthreads();
        if (F.wave < 2) { LoraB<2> b0; lora_bload<2>(b0, WL, q0 + F.wave, lr, g); lora_product<2>(b0, F.lds + gi * TILE, LO, r0, q0 + F.wave, lr, g, LBI); }
        __syncthreads();
    }
}

__device__ __forceinline__ void ss2_load(v4u& ra, v4u& rq, const unsigned char* PQ, size_t inst, int wv, int wave, int lane) {
    const unsigned char* pb = PQ + inst * 16384;
    ra = *(const v4u*)(pb + (size_t)((wave * 64 + lane) * 16));
    if (wave < 2) rq = *(const v4u*)(pb + 8192 + (size_t)((wv * 64 + lane) * 32 + 16 * wave));
}
__device__ __forceinline__ void phase_ss2(Frame& F) {
    const unsigned char* PQ = F.ws + WS_PQ; unsigned char* H0T = F.ws + WS_H0T;
    const int lane = F.lane, wave = F.wave, lr = lane & 15, g = lane >> 4;
    LAS unsigned char* ring = F.lds;
    constexpr int SLOT = 10240, NS = 4 + T / 64, DEPTH = 12;
    static_assert(NS % DEPTH == 0, "unrolled by DEPTH");
    for (int task = (int)blockIdx.x; task < 256; task += F.G) {
        const int chain = task >> 2, wv = task & 3, b = chain >> 5, h = (chain >> 1) & 15, d = chain & 1;
        f32x4 H[4]; zero4(H);
        v4u ra[DEPTH], rq[DEPTH];
#pragma unroll
        for (int k = 0; k < DEPTH; ++k) { rq[k] = (v4u){0u, 0u, 0u, 0u}; ss2_load(ra[k], rq[k], PQ, ss_pq(k, b, h, d), wv, wave, lane); }
        for (int step = 0; step < NS; step += DEPTH) {
#pragma unroll
            for (int k = 0; k < DEPTH; ++k) {
                const int st = step + k; LAS unsigned char* sl = ring + (st & 1) * SLOT;
                *(LAS v4u*)(sl + (wave * 64 + lane) * 16) = ra[k]; if (wave < 2) *(LAS v4u*)(sl + 8192 + (wave * 64 + lane) * 16) = rq[k];
                { const int nx = st + DEPTH < NS ? st + DEPTH : NS - 1; ss2_load(ra[k], rq[k], PQ, ss_pq(nx, b, h, d), wv, wave, lane); }
                __syncthreads();
                if (wave == 0) { SSIn cur;
#pragma unroll
                    for (int f = 0; f < 8; ++f) cur.a[f] = *(const LAS v4u*)(sl + (f * 64 + lane) * 16);
                    cur.q[0] = *(const LAS v4u*)(sl + 8192 + lane * 16); cur.q[1] = *(const LAS v4u*)(sl + 8192 + (64 + lane) * 16);
                    ss_step(H, cur, H0T, ss_inst(st, b, h, d), st >= 4, wv, lr, g); }
            }
        }
        __syncthreads();
    }
}

__device__ __forceinline__ void ss3_load(v4u& a0, v4u& a1, v2u& q, const unsigned char* PQ, size_t pq, int wv, int m, int lane) {
    const unsigned char* pb = PQ + pq * 16384;
    a0 = *(const v4u*)(pb + (size_t)(((2 * m) * 64 + lane) * 16)); a1 = *(const v4u*)(pb + (size_t)(((2 * m + 1) * 64 + lane) * 16));
    q = *(const v2u*)(pb + 8192 + (size_t)((wv * 64 + lane) * 32 + 8 * m));
}
__device__ __forceinline__ void phase_ss3(Frame& F) {
    const unsigned char* PQ = F.ws + WS_PQ; unsigned char* H0T = F.ws + WS_H0T;
    const int lane = F.lane, wave = F.wave, lr = lane & 15, g = lane >> 4, m = wave & 3;
    LAS unsigned char* xch = F.lds;
    constexpr int NS = 4 + T / 64, DEPTH = 12;
    static_assert(NS % DEPTH == 0, "unrolled by DEPTH");
    for (int task = (int)blockIdx.x; task < 256; task += F.G) {
        const int chain = task >> 2, wv = task & 3, b = chain >> 5, h = (chain >> 1) & 15, d = chain & 1;
        f32x4 H = {0.f, 0.f, 0.f, 0.f};
        v4u a0[DEPTH], a1[DEPTH]; v2u qv[DEPTH];
        if (wave < 4) {
#pragma unroll
            for (int k = 0; k < DEPTH; ++k) ss3_load(a0[k], a1[k], qv[k], PQ, ss_pq(k, b, h, d), wv, m, lane);
        }
        for (int step = 0; step < NS; step += DEPTH) {
#pragma unroll
            for (int k = 0; k < DEPTH; ++k) {
                const int st = step + k; LAS unsigned char* xs = xch + (st & 1) * 2048;
                if (wave < 4) {
                    const v2u pk = {cvtpk(H[0], H[1]), cvtpk(H[2], H[3])};
                    *(LAS v2u*)(xs + lane * 32 + 8 * m) = pk;
                    if (st >= 4) *(v2u*)(H0T + ss_inst(st, b, h, d) * 8192 + (size_t)((16 * wv + lr) * 64 + 16 * m + 4 * g) * 2) = pk;
                }
                __syncthreads();
                if (wave < 4) {
                    const v4u b0 = *(const LAS v4u*)(xs + lane * 32), b1 = *(const LAS v4u*)(xs + lane * 32 + 16);
                    f32x4 Hn = {bflo(qv[k].x), bfhi(qv[k].x), bflo(qv[k].y), bfhi(qv[k].y)};
                    Hn = CK_MFMA(__builtin_bit_cast(bf16x8, a0[k]), __builtin_bit_cast(bf16x8, b0), Hn);
                    Hn = CK_MFMA(__builtin_bit_cast(bf16x8, a1[k]), __builtin_bit_cast(bf16x8, b1), Hn);
                    H = Hn;
                    const int nx = st + DEPTH < NS ? st + DEPTH : NS - 1;
                    ss3_load(a0[k], a1[k], qv[k], PQ, ss_pq(nx, b, h, d), wv, m, lane);
                }
            }
        }
        __syncthreads();
    }
}
}
template <int PART>
__device__ __forceinline__ void phase_moe_weights(Frame& F) {
    LAS float* scr = (LAS float*)(F.lds + RING_OFF + F.wave * 16384);
    bf16* WEO = (bf16*)(F.ws + WS_WEOUT);
    constexpr int IT_IN = (D / 64) * (2048 / 32), IT_OUT = (D / 64) * (D / 32);
    if (PART == 0) {
        const float* wei = KIN(I_WEI);
        const int nstat = F.G * 7;
        int it = (int)blockIdx.x * 7 + F.wave - 1;
        while (it < NE * 128) {
            const int half = it & 1, r = it >> 1, e = r >> 6, n0 = 32 * (r & 63);
            const int c = n0 & 1023, rowbase = (c >> 7) * 256 + (n0 >= 1024 ? 128 : 0) + (c & 127);
            q8_item(wei + (size_t)e * D * 2048, 2048, n0, (signed char*)(F.ws + WS_WEIN) + (size_t)e * 2048 * D, (float*)(F.ws + MI_CSWEI) + (size_t)e * 2048, rowbase, scr, F.lane, 8 * half, 8 * half + 8);
            int nx = 0; if (F.lane == 0) nx = (int)__hip_atomic_fetch_add(F.ctl + CW_Q6, 1u, __ATOMIC_RELAXED, __HIP_MEMORY_SCOPE_AGENT);
            it = nstat + __builtin_amdgcn_readfirstlane(nx);
        }
    } else {
        const float* weo = KIN(I_WEO);
        for (int r = (int)blockIdx.x * 7 + F.wave - 1; r < NE * IT_OUT; r += F.G * 7) { const int e = r / IT_OUT, q = r % IT_OUT, kb = q / 32, n0 = 32 * (q % 32);
            transpose_item(weo + (size_t)e * D * D, D, 64 * kb, n0, WEO + (size_t)e * D * D, D, n0, scr, F.lane); }
    }
}

__device__ __forceinline__ void phase_x1_h2(Frame& F) {
    LAS float* LG = (LAS float*)(F.lds);
    LAS float* LA = LG + 2 * D; LAS float* LB = LA + 2 * D;
    const float* modp = (const float*)(F.ws + WS_MODP);
    for (int i = F.tid; i < 2 * D; i += NWAVES * 64) { const int v = i / D, j = i % D;
        LG[i] = mod_val(modp, KIN(I_BADA), v, 2048 + j) * KIN(I_NQM)[j];
        LA[i] = KIN(I_NPF)[j] * (1.0f + mod_val(modp, KIN(I_BADA), v, 4096 + j)); LB[i] = mod_val(modp, KIN(I_BADA), v, 3072 + j); }
    __syncthreads();
    const float* mix = (const float*)(F.ws + WS_MIX); float* x1 = (float*)(F.ws + WS_X1); bf16* h2 = (bf16*)(F.ws + WS_H2);
    for (int row = F.gw; row < ML; row += F.NGW) {
        const int vec = row >> 13;
        f32x4 m[4], x[4]; float s = 0.f;
#pragma unroll
        for (int j = 0; j < 4; ++j) { m[j] = *(const f32x4*)(mix + (size_t)row * D + 4 * F.lane + 256 * j); x[j] = *(const f32x4*)(KIN(I_X) + (size_t)row * D + 4 * F.lane + 256 * j);
            s += (m[j].x * m[j].x + m[j].y * m[j].y) + (m[j].z * m[j].z + m[j].w * m[j].w); }
        const float rstd = 1.0f / sqrtf(wave_sum(s) * (1.0f / D) + 1e-6f);
        float s2 = 0.f;
#pragma unroll
        for (int j = 0; j < 4; ++j) { const int c = 4 * F.lane + 256 * j; const f32x4 g = *(const LAS f32x4*)(LG + vec * D + c);
            x[j] = x[j] + g * (m[j] * rstd); *(f32x4*)(x1 + (size_t)row * D + c) = x[j];
            s2 += (x[j].x * x[j].x + x[j].y * x[j].y) + (x[j].z * x[j].z + x[j].w * x[j].w); }
        const float rstd2 = 1.0f / sqrtf(wave_sum(s2) * (1.0f / D) + 1e-6f);
        unsigned long long* o8 = (unsigned long long*)(h2 + (size_t)row * D) + F.lane;
        f32x4 hq[4]; float mx = 0.f;
#pragma unroll
        for (int j = 0; j < 4; ++j) { const int c = 4 * F.lane + 256 * j; const f32x4 a = *(const LAS f32x4*)(LA + vec * D + c), b = *(const LAS f32x4*)(LB + vec * D + c);
            const f32x4 h = x[j] * rstd2 * a + b; hq[j] = h;
            mx = fmaxf(mx, fmaxf(fmaxf(fabsf(h.x), fabsf(h.y)), fmaxf(fabsf(h.z), fabsf(h.w))));
            o8[64 * j] = (unsigned long long)pk2(h.x, h.y) | ((unsigned long long)pk2(h.z, h.w) << 32); }
        mx = wave_max(mx);
        const float iv = mx > 0.f ? 127.0f / mx : 0.f;
        if (F.lane == 0) ((float*)(F.ws + MI_RSH2))[row] = mx * (1.0f / 127.0f);
        unsigned* o4 = (unsigned*)(F.ws + WS_H2Q + (size_t)row * D) + F.lane;
#pragma unroll
        for (int j = 0; j < 4; ++j) o4[64 * j] = pack_q4(hq[j].x * iv, hq[j].y * iv, hq[j].z * iv, hq[j].w * iv);
    }
}

__device__ __forceinline__ void phase_route(Frame& F) {
    const float* LG = (const float*)(F.ws + WS_LOGIT);
    int* selE = (int*)(F.ws + MI_SELE); int* selP = (int*)(F.ws + MI_SELP); float* gate = (float*)(F.ws + MI_GATE);
    for (int task = F.gw; task < ML / 64; task += F.NGW) {
        const int row = task * 64 + F.lane;
        float v[NE];
#pragma unroll
        for (int q = 0; q < NE / 4; ++q) { const f32x4 x = *(const f32x4*)(LG + (size_t)row * 256 + 4 * q); const f32x4 bb = *(const f32x4*)(KIN(I_BR) + 4 * q);
            v[4 * q] = x.x + bb.x; v[4 * q + 1] = x.y + bb.y; v[4 * q + 2] = x.z + bb.z; v[4 * q + 3] = x.w + bb.w; }
        int se[4]; float sv[4];
#pragma unroll
        for (int k = 0; k < 4; ++k) { float best = -3.0e38f; int bi = 0;
#pragma unroll
            for (int e = 0; e < NE; ++e) if (v[e] > best) { best = v[e]; bi = e; }
#pragma unroll
            for (int e = 0; e < NE; ++e) v[e] = (e == bi) ? -3.0e38f : v[e];
            se[k] = bi; sv[k] = best; }
        float ex[4], sum = 0.f;
#pragma unroll
        for (int k = 0; k < 4; ++k) { ex[k] = __expf(sv[k] - sv[0]); sum += ex[k]; }
        const float inv = 1.0f / sum;
        int sp[4] = {0, 0, 0, 0};
        int myn = 0;
#pragma unroll
        for (int e = 0; e < NE; ++e) { const bool p = (se[0] == e) | (se[1] == e) | (se[2] == e) | (se[3] == e); const int n = __popcll(__ballot(p)); myn = (F.lane == e) ? n : myn; }
        int mybase = 0;
        if (F.lane < NE && myn > 0) mybase = (int)__hip_atomic_fetch_add(F.ctl + CW_CNT + 64 * F.lane, (unsigned)myn, __ATOMIC_RELAXED, __HIP_MEMORY_SCOPE_AGENT);
#pragma unroll
        for (int e = 0; e < NE; ++e) {
            const bool p = (se[0] == e) | (se[1] == e) | (se[2] == e) | (se[3] == e);
            const unsigned long long mask = __ballot(p);
            const int base = __shfl(mybase, e);
            const int pos = base + __popcll(mask & ((1ull << F.lane) - 1ull));
#pragma unroll
            for (int k = 0; k < 4; ++k) if (se[k] == e) sp[k] = pos;
        }
        *(int4*)(selE + (size_t)row * 4) = make_int4(se[0], se[1], se[2], se[3]);
        *(int4*)(selP + (size_t)row * 4) = make_int4(sp[0], sp[1], sp[2], sp[3]);
        *(f32x4*)(gate + (size_t)row * 4) = (f32x4){ex[0] * inv, ex[1] * inv, ex[2] * inv, ex[3] * inv};
    }
}

__device__ __forceinline__ void phase_x1h2_route(Frame& F) {
    constexpr int HS_STRIDE = 2064;
    LAS unsigned char* Hs = F.lds;
    LAS float* LG = (LAS float*)(F.lds + 132096);
    LAS float* LA = LG + D; LAS float* LB = LA + D;
    LAS float* LGT = (LAS float*)(F.lds + LDS_X_OFF);
    const float* modp = (const float*)(F.ws + WS_MODP);
    const float* mix = (const float*)(F.ws + WS_MIX); float* x1 = (float*)(F.ws + WS_X1);
    const float* xin = KIN(I_X); const float* b_ada = KIN(I_BADA); const float* nqm = KIN(I_NQM); const float* npf = KIN(I_NPF);
    const bf16* WR = (const bf16*)(F.ws + WS_WROUT);
    int* selE = (int*)(F.ws + MI_SELE); int* selP = (int*)(F.ws + MI_SELP); float* gate = (float*)(F.ws + MI_GATE);
    for (int rb = blockIdx.x; rb < ML / 64; rb += F.G) {
        const int vec = (rb * 64) >> 13;
        __syncthreads();
        for (int i = F.tid; i < D; i += NWAVES * 64) {
            LG[i] = mod_val(modp, b_ada, vec, 2048 + i) * nqm[i];
            LA[i] = npf[i] * (1.0f + mod_val(modp, b_ada, vec, 4096 + i)); LB[i] = mod_val(modp, b_ada, vec, 3072 + i); }
        __syncthreads();
        for (int rr = 0; rr < 8; ++rr) {
            const int lrow = F.wave * 8 + rr, row = rb * 64 + lrow;
            f32x4 m[4], x[4]; float s = 0.f;
#pragma unroll
            for (int j = 0; j < 4; ++j) { m[j] = *(const f32x4*)(mix + (size_t)row * D + 4 * F.lane + 256 * j); x[j] = *(const f32x4*)(xin + (size_t)row * D + 4 * F.lane + 256 * j);
                s += (m[j].x * m[j].x + m[j].y * m[j].y) + (m[j].z * m[j].z + m[j].w * m[j].w); }
            const float rstd = 1.0f / sqrtf(wave_sum(s) * (1.0f / D) + 1e-6f);
            float s2 = 0.f;
#pragma unroll
            for (int j = 0; j < 4; ++j) { const int c = 4 * F.lane + 256 * j; const f32x4 g = *(const LAS f32x4*)(LG + c);
                x[j] = x[j] + g * (m[j] * rstd); *(f32x4*)(x1 + (size_t)row * D + c) = x[j];
                s2 += (x[j].x * x[j].x + x[j].y * x[j].y) + (x[j].z * x[j].z + x[j].w * x[j].w); }
            const float rstd2 = 1.0f / sqrtf(wave_sum(s2) * (1.0f / D) + 1e-6f);
            f32x4 hq[4]; float mx = 0.f;
#pragma unroll
            for (int j = 0; j < 4; ++j) { const int c = 4 * F.lane + 256 * j; const f32x4 a = *(const LAS f32x4*)(LA + c), b = *(const LAS f32x4*)(LB + c);
                const f32x4 h = x[j] * rstd2 * a + b; hq[j] = h;
                mx = fmaxf(mx, fmaxf(fmaxf(fabsf(h.x), fabsf(h.y)), fmaxf(fabsf(h.z), fabsf(h.w))));
                *(LAS v2u*)(Hs + lrow * HS_STRIDE + c * 2) = (v2u){pk2(h.x, h.y), pk2(h.z, h.w)}; }
            mx = wave_max(mx);
            const float iv = mx > 0.f ? 127.0f / mx : 0.f;
            if (F.lane == 0) ((float*)(F.ws + MI_RSH2))[row] = mx * (1.0f / 127.0f);
            unsigned* o4 = (unsigned*)(F.ws + WS_H2Q + (size_t)row * D) + F.lane;
#pragma unroll
            for (int j = 0; j < 4; ++j) o4[64 * j] = pack_q4(hq[j].x * iv, hq[j].y * iv, hq[j].z * iv, hq[j].w * iv);
        }
        __syncthreads();
        {
            const int rt = F.wave & 3, et = F.wave >> 2, lr = F.lane & 15, g = F.lane >> 4;
            typedef short bf16x8_t __attribute__((ext_vector_type(8)));
            f32x4 acc = {0.f, 0.f, 0.f, 0.f};
            const LAS unsigned char* ap = Hs + (16 * rt + lr) * HS_STRIDE + 16 * g; const bf16* bp = WR + (size_t)(16 * et + lr) * D + 8 * g;
#pragma unroll 8
            for (int s = 0; s < 32; ++s) { const bf16x8_t a = *(const LAS bf16x8_t*)(ap + 64 * s); const bf16x8_t b = *(const bf16x8_t*)(bp + 32 * s);
                acc = __builtin_amdgcn_mfma_f32_16x16x32_bf16(a, b, acc, 0, 0, 0); }
#pragma unroll
            for (int i = 0; i < 4; ++i) LGT[(16 * rt + 4 * g + i) * 33 + 16 * et + lr] = acc[i];
        }
        __syncthreads();
        if (F.wave == 0) {
            const int row = rb * 64 + F.lane;
            const float* br = KIN(I_BR);
            float v[NE];
#pragma unroll
            for (int e = 0; e < NE; ++e) v[e] = LGT[F.lane * 33 + e] + br[e];
            int se[4]; float sv[4];
#pragma unroll
            for (int k = 0; k < 4; ++k) { float best = -3.0e38f; int bi = 0;
#pragma unroll
                for (int e = 0; e < NE; ++e) if (v[e] > best) { best = v[e]; bi = e; }
#pragma unroll
                for (int e = 0; e < NE; ++e) v[e] = (e == bi) ? -3.0e38f : v[e];
                se[k] = bi; sv[k] = best; }
            float ex[4], sum = 0.f;
#pragma unroll
            for (int k = 0; k < 4; ++k) { ex[k] = __expf(sv[k] - sv[0]); sum += ex[k]; }
            const float inv = 1.0f / sum;
            int sp[4] = {0, 0, 0, 0};
            int myn = 0;
#pragma unroll
            for (int e = 0; e < NE; ++e) { const bool p = (se[0] == e) | (se[1] == e) | (se[2] == e) | (se[3] == e); const int n = __popcll(__ballot(p)); myn = (F.lane == e) ? n : myn; }
            int mybase = 0;
            if (F.lane < NE && myn > 0) mybase = (int)__hip_atomic_fetch_add(F.ctl + CW_CNT + 64 * F.lane, (unsigned)myn, __ATOMIC_RELAXED, __HIP_MEMORY_SCOPE_AGENT);
#pragma unroll
            for (int e = 0; e < NE; ++e) {
                const bool p = (se[0] == e) | (se[1] == e) | (se[2] == e) | (se[3] == e);
                const unsigned long long mask = __ballot(p);
                const int base = __shfl(mybase, e);
                const int pos = base + __popcll(mask & ((1ull << F.lane) - 1ull));
#pragma unroll
                for (int k = 0; k < 4; ++k) if (se[k] == e) sp[k] = pos;
            }
            *(int4*)(selE + (size_t)row * 4) = make_int4(se[0], se[1], se[2], se[3]);
            *(int4*)(selP + (size_t)row * 4) = make_int4(sp[0], sp[1], sp[2], sp[3]);
            *(f32x4*)(gate + (size_t)row * 4) = (f32x4){ex[0] * inv, ex[1] * inv, ex[2] * inv, ex[3] * inv};
        }
    }
    __syncthreads();
}

__device__ __forceinline__ void phase_scatter(Frame& F) {
    LAS int* PS = (LAS int*)(F.lds);
    if (F.tid == 0) { int acc = 0;
        for (int e = 0; e < NE; ++e) { const int c = (int)__hip_atomic_load(F.ctl + CW_CNT + 64 * e, __ATOMIC_RELAXED, __HIP_MEMORY_SCOPE_AGENT); PS[e] = acc; PS[64 + e] = c; acc += (c + 255) / 256 * 256; }
        PS[NE] = acc; }
    __syncthreads();
    int* blkE = (int*)(F.ws + MI_BLKE);
    if (blockIdx.x == 0) {
        for (int b = F.tid; b < MAXBLK; b += NWAVES * 64) { int e = NE - 1;
            for (int q = 0; q < NE; ++q) if (b * 256 >= PS[q] && b * 256 < PS[q + 1]) e = q;
            blkE[b] = e; }
        if (F.tid == 0) blkE[MAXBLK] = PS[NE] / 256;
    }
    const int* selE = (const int*)(F.ws + MI_SELE); const int* selP = (const int*)(F.ws + MI_SELP); int* dest = (int*)(F.ws + MI_DEST);
    const unsigned char* h2q = F.ws + WS_H2Q; unsigned char* xb = F.ws + WS_XB; const float* rsh2 = (const float*)(F.ws + MI_RSH2); float* rsxb = (float*)(F.ws + MI_RSXB);
    for (int row = F.gw; row < ML; row += F.NGW) {
        const int4 se = *(const int4*)(selE + (size_t)row * 4), sp = *(const int4*)(selP + (size_t)row * 4);
        const int d0 = PS[se.x] + sp.x, d1 = PS[se.y] + sp.y, d2 = PS[se.z] + sp.z, d3 = PS[se.w] + sp.w;
        const float rsc = rsh2[row];
        if (F.lane == 0) { *(int4*)(dest + (size_t)row * 4) = make_int4(d0, d1, d2, d3); rsxb[d0] = rsc; rsxb[d1] = rsc; rsxb[d2] = rsc; rsxb[d3] = rsc; }
        const v4u a = *(const v4u*)(h2q + (size_t)row * D + 16 * F.lane);
        *(v4u*)(xb + (size_t)d0 * D + 16 * F.lane) = a; *(v4u*)(xb + (size_t)d1 * D + 16 * F.lane) = a;
        *(v4u*)(xb + (size_t)d2 * D + 16 * F.lane) = a; *(v4u*)(xb + (size_t)d3 * D + 16 * F.lane) = a;
    }
    for (int p = F.gw; p < NE * 256; p += F.NGW) {
        const int e = p >> 8, r = p & 255, c = PS[64 + e], padded = (c + 255) / 256 * 256;
        if (c + r < padded) { unsigned char* dst = xb + (size_t)(PS[e] + c + r) * D; *(v4u*)(dst + 16 * F.lane) = (v4u){0u, 0u, 0u, 0u}; if (F.lane == 0) rsxb[PS[e] + c + r] = 0.f; }
    }
}

__device__ __forceinline__ void phase_combine(Frame& F) {
    LAS float* LG = (LAS float*)(F.lds);
    const float* modp = (const float*)(F.ws + WS_MODP);
    for (int i = F.tid; i < 2 * D; i += NWAVES * 64) { const int v = i / D, j = i % D; LG[i] = mod_val(modp, KIN(I_BADA), v, 5120 + j) * KIN(I_NQF)[j]; }
    __syncthreads();
    const int* dest = (const int*)(F.ws + MI_DEST); const float* gate = (const float*)(F.ws + MI_GATE);
    const bf16* y2 = (const bf16*)(F.ws + WS_Y2); const float* x1 = (const float*)(F.ws + WS_X1);
    for (int row = F.gw; row < ML; row += F.NGW) {
        const int vec = row >> 13;
        const int4 dd = *(const int4*)(dest + (size_t)row * 4); const f32x4 gg = *(const f32x4*)(gate + (size_t)row * 4);
        const int dk[4] = {dd.x, dd.y, dd.z, dd.w}; const float gk[4] = {gg.x, gg.y, gg.z, gg.w};
        float f[16];
#pragma unroll
        for (int i = 0; i < 16; ++i) f[i] = 0.f;
#pragma unroll
        for (int k = 0; k < 4; ++k) { float t[16]; ld16bf(y2 + (size_t)dk[k] * D + 16 * F.lane, t);
#pragma unroll
            for (int i = 0; i < 16; ++i) f[i] += gk[k] * t[i]; }
        float s = 0.f;
#pragma unroll
        for (int i = 0; i < 16; ++i) s += f[i] * f[i];
        const float rstd = 1.0f / sqrtf(wave_sum(s) * (1.0f / D) + 1e-6f);
        float xv[16], g[16], o[16]; ld16f(x1 + (size_t)row * D + 16 * F.lane, xv); ld16f_lds(LG + vec * D + 16 * F.lane, g);
#pragma unroll
        for (int i = 0; i < 16; ++i) o[i] = xv[i] + g[i] * (f[i] * rstd);
        st16f(F.out + (size_t)row * D + 16 * F.lane, o);
    }
}

constexpr int N_PHASES = 13;
#ifndef PROBE_MASK
#define PROBE_MASK 0
#endif
#ifndef STAGE_REP
#define STAGE_REP 0
#endif
#ifndef USE_FLAT_BAR
#define USE_FLAT_BAR 0
#endif
struct Args { const float* in[30]; float* out; unsigned char* ws; int ph_lo, ph_hi; };
__global__ void __launch_bounds__(NWAVES * 64, 2) fwd(Args args) {
    extern __shared__ __attribute__((aligned(16))) unsigned char lds[];
    Frame F;
    F.lds = (LAS unsigned char*)lds;
    F.MISC = (volatile LAS unsigned*)(F.lds + MISC_OFF);
    F.tid = threadIdx.x; F.lane = F.tid & 63; F.wave = __builtin_amdgcn_readfirstlane(F.tid >> 6);
    F.G = gridDim.x; F.gw = blockIdx.x * NWAVES + F.wave; F.NGW = F.G * NWAVES;
    F.ws = args.ws; F.ctl = (unsigned*)(args.ws + WS_CTL); F.out = args.out;
    for (int u = F.tid; u < (LDS_X_OFF - LDSCTL_OFF) / 4; u += NWAVES * 64) ((LAS unsigned*)(F.lds + LDSCTL_OFF))[u] = 0u;
    __syncthreads();
    const int lo = args.ph_lo, hi = args.ph_hi;
    const bool use_bar = (hi - lo) > 1;
    XcdBarrier bar; bar.bar = F.ctl + CW_BAR; bar.x = 0; bar.st = nullptr;
    if (use_bar && !USE_FLAT_BAR) bar = xcd_barrier_post(F.ctl + CW_BAR, F.MISC + 8);
#define IN(k) (lo <= (k) && (k) < hi)
    unsigned fb_extra = 0u;
#define SEAM(k) do { if (IN(k) && IN((k) + 1)) { if (USE_FLAT_BAR) flat_barrier(F.ctl + CW_FB, (unsigned)((k) - lo + 1) + fb_extra); else xcd_barrier2(bar); } else __syncthreads(); } while (0)

#define DUP(k) ((PROBE_MASK >> (k)) & 1)
    if (IN(0)) { phase_prologue(F); if (DUP(0)) { __syncthreads(); phase_prologue(F); } SEAM(0); }
    if (DUP(20)) { for (int q = 0; q < 10; ++q) { if (USE_FLAT_BAR) { ++fb_extra; flat_barrier(F.ctl + CW_FB, 1u + fb_extra); } else xcd_barrier2(bar); } }
    if (IN(1)) { phase_hrows(F); if (DUP(1)) { __syncthreads(); phase_hrows(F); } SEAM(1); }
    if (IN(2)) {
        {         pg8::Gemm g{(const bf16*)(F.ws + WS_A0), (const bf16*)(F.ws + WS_WIN), MT, NZ, D}; pg8::StaticOrder S; S.init(MT, NZ, F.G, (int)blockIdx.x);
        pg8::EpiBf16I8 E{(bf16*)(F.ws + WS_Z), NZ, (const float*)(F.ws + MI_RSH), (const float*)(F.ws + MI_CSWIN)};
        pg8::gemm_phase_i8<pg8::EpiBf16I8, pg8::StaticOrder, true, true>(F.lds + RING_OFF, g, S, E); __syncthreads(); }
        if (DUP(2)) {         pg8::Gemm g{(const bf16*)(F.ws + WS_A0), (const bf16*)(F.ws + WS_WIN), MT, NZ, D}; pg8::StaticOrder S; S.init(MT, NZ, F.G, (int)blockIdx.x);
        pg8::EpiBf16I8 E{(bf16*)(F.ws + WS_Z), NZ, (const float*)(F.ws + MI_RSH), (const float*)(F.ws + MI_CSWIN)};
        pg8::gemm_phase_i8<pg8::EpiBf16I8, pg8::StaticOrder, true, true>(F.lds + RING_OFF, g, S, E); __syncthreads(); }
        SEAM(2); }
    if (IN(3)) { ck::phase_lora(F); SEAM(3); }
    if (IN(4)) { ck::phase_cp2(F); if (DUP(5)) { __syncthreads(); ck::phase_cp2(F); } if (DUP(22)) { __syncthreads(); ck::phase_lora(F); } SEAM(4); }
    if (IN(5)) { if (F.wave == 0) ck::phase_ss(F); if (DUP(23)) { __syncthreads(); ck::phase_ss3(F); } if (DUP(6)) { __syncthreads(); if (F.wave == 0) ck::phase_ss(F); else phase_moe_weights<0>(F); } if (DUP(17)) { __syncthreads(); if (F.wave == 0) ck::phase_ss(F); } SEAM(5); }
    if (IN(6)) { ck::phase_co2(F); if (DUP(7)) { __syncthreads(); ck::phase_co2(F); } SEAM(6); }
    if (IN(7)) {
        {         pg8::Gemm g{(const bf16*)(F.ws + WS_A0), (const bf16*)(F.ws + WS_WOUT), ML, D, D}; pg8::StaticOrder S; S.init(ML, D, F.G, (int)blockIdx.x);
        pg8::EpiF32 E{(float*)(F.ws + WS_MIX), D};
        pg8::gemm_phase<pg8::EpiF32, pg8::StaticOrder, true, true>(F.lds + RING_OFF, g, S, E);
        __syncthreads(); }
        if (DUP(8)) {         pg8::Gemm g{(const bf16*)(F.ws + WS_A0), (const bf16*)(F.ws + WS_WOUT), ML, D, D}; pg8::StaticOrder S; S.init(ML, D, F.G, (int)blockIdx.x);
        pg8::EpiF32 E{(float*)(F.ws + WS_MIX), D};
        pg8::gemm_phase<pg8::EpiF32, pg8::StaticOrder, true, true>(F.lds + RING_OFF, g, S, E);
        __syncthreads(); }
        SEAM(7); }
    if (IN(8)) { phase_x1h2_route(F); SEAM(8); }
    if (IN(9)) { phase_scatter(F); if (DUP(12)) { __syncthreads(); phase_scatter(F); } SEAM(9); }
    if (IN(10)) {
        {         const int* blkE = (const int*)(F.ws + MI_BLKE);
        pg8::Gemm g{(const bf16*)(F.ws + WS_XB), (const bf16*)(F.ws + WS_WEIN), NROWS, 2048, D};
        pg8::MoeOrder<8> S{blkE, __hip_atomic_load(blkE + MAXBLK, __ATOMIC_RELAXED, __HIP_MEMORY_SCOPE_AGENT) * 8, F.G, (int)blockIdx.x};
        pg8::EpiSwigluI8 E{(bf16*)(F.ws + WS_ACT), KIN(I_BEI), (const float*)(F.ws + MI_RSXB), (const float*)(F.ws + MI_CSWEI)};
        pg8::gemm_phase_i8<pg8::EpiSwigluI8, pg8::MoeOrder<8>, true, true>(F.lds + RING_OFF, g, S, E); __syncthreads(); }
        if (DUP(13)) {         const int* blkE = (const int*)(F.ws + MI_BLKE);
        pg8::Gemm g{(const bf16*)(F.ws + WS_XB), (const bf16*)(F.ws + WS_WEIN), NROWS, 2048, D};
        pg8::MoeOrder<8> S{blkE, __hip_atomic_load(blkE + MAXBLK, __ATOMIC_RELAXED, __HIP_MEMORY_SCOPE_AGENT) * 8, F.G, (int)blockIdx.x};
        pg8::EpiSwigluI8 E{(bf16*)(F.ws + WS_ACT), KIN(I_BEI), (const float*)(F.ws + MI_RSXB), (const float*)(F.ws + MI_CSWEI)};
        pg8::gemm_phase_i8<pg8::EpiSwigluI8, pg8::MoeOrder<8>, true, true>(F.lds + RING_OFF, g, S, E); __syncthreads(); }
        SEAM(10); }
    if (IN(11)) {
        {         const int* blkE = (const int*)(F.ws + MI_BLKE);
        pg8::Gemm g{(const bf16*)(F.ws + WS_ACT), (const bf16*)(F.ws + WS_WEOUT), NROWS, D, D};
        pg8::MoeOrder<4> S{blkE, __hip_atomic_load(blkE + MAXBLK, __ATOMIC_RELAXED, __HIP_MEMORY_SCOPE_AGENT) * 4, F.G, (int)blockIdx.x};
        pg8::EpiBf16 E{(bf16*)(F.ws + WS_Y2), D, KIN(I_BEO), D};
        pg8::gemm_phase<pg8::EpiBf16, pg8::MoeOrder<4>, true, true>(F.lds + RING_OFF, g, S, E); __syncthreads(); }
        if (DUP(14)) {         const int* blkE = (const int*)(F.ws + MI_BLKE);
        pg8::Gemm g{(const bf16*)(F.ws + WS_ACT), (const bf16*)(F.ws + WS_WEOUT), NROWS, D, D};
        pg8::MoeOrder<4> S{blkE, __hip_atomic_load(blkE + MAXBLK, __ATOMIC_RELAXED, __HIP_MEMORY_SCOPE_AGENT) * 4, F.G, (int)blockIdx.x};
        pg8::EpiBf16 E{(bf16*)(F.ws + WS_Y2), D, KIN(I_BEO), D};
        pg8::gemm_phase<pg8::EpiBf16, pg8::MoeOrder<4>, true, true>(F.lds + RING_OFF, g, S, E); __syncthreads(); }
        SEAM(11); }
    if (IN(12)) { phase_combine(F); if (DUP(15)) { __syncthreads(); phase_combine(F); } }
#undef IN
#undef SEAM
}

#ifndef MK_N_LAUNCHES
#define MK_N_LAUNCHES 1
#endif
extern "C" void kernel_launch(void* const* d_in, const int* in_sizes, int n_in, void* d_out, int out_size, void* d_ws, size_t ws_size, hipStream_t stream) {
    static int grid = 0;
    if (grid == 0) {
        if (n_in != 30 || out_size != ML * D || ws_size < WS_END) { fprintf(stderr, "kernel_launch: unexpected shapes (n_in %d out %d ws %zu, need %zu); nothing launched\n", n_in, out_size, ws_size, (size_t)WS_END); grid = -1; return; }
        int dev = 0, cus = 0, per_cu = 0;
        if (hipGetDevice(&dev) != hipSuccess || hipDeviceGetAttribute(&cus, hipDeviceAttributeMultiprocessorCount, dev) != hipSuccess) { grid = -1; return; }
        if (hipFuncSetAttribute((const void*)fwd, hipFuncAttributeMaxDynamicSharedMemorySize, LDS_BYTES) != hipSuccess) { fprintf(stderr, "kernel_launch: hipFuncSetAttribute failed\n"); grid = -1; return; }
        if (hipOccupancyMaxActiveBlocksPerMultiprocessor(&per_cu, (const void*)fwd, NWAVES * 64, LDS_BYTES) != hipSuccess || per_cu < 1)
            fprintf(stderr, "kernel_launch: note: occupancy query reports %d workgroups per CU\n", per_cu);
        (void)hipGetLastError();
        grid = cus;
    }
    if (grid < 0) return;
    if (hipMemsetAsync((char*)d_ws + WS_CTL, 0, CTL_ZERO_BYTES, stream) != hipSuccess) return;
    Args a{};
    for (int i = 0; i < 30; ++i) a.in[i] = (const float*)d_in[i];
    a.out = (float*)d_out; a.ws = (unsigned char*)d_ws;
    if (MK_N_LAUNCHES == 1) { a.ph_lo = 0; a.ph_hi = N_PHASES; hipLaunchKernelGGL(fwd, dim3(grid), dim3(NWAVES * 64), LDS_BYTES, stream, a); }
    else for (int p = 0; p < N_PHASES; ++p) { a.ph_lo = p; a.ph_hi = p + 1; hipLaunchKernelGGL(fwd, dim3(grid), dim3(NWAVES * 64), LDS_BYTES, stream, a); }
}
```

```cpp
#include <hip/hip_runtime.h>
#include <cstdio>
#include <cstdint>

namespace pg8 {
#define PG8_LAS __attribute__((address_space(3)))
typedef unsigned short bf16_t;
typedef short bf16x8 __attribute__((ext_vector_type(8)));
typedef float f32x4 __attribute__((ext_vector_type(4)));
typedef unsigned u32x4 __attribute__((ext_vector_type(4)));
constexpr int BM = 256, BK = 64, HALF = 128, HTB = HALF * BK * 2  , STAGE_BYTES = 8 * HTB, NXCD = 8, WGM = 8;

__host__ __device__ __forceinline__ int lds_byte(int r, int c) { const int st = (r >> 4) * 2 + (c >> 5), rr = r & 15, cc = c & 31, ob = rr * 64 + cc * 2; return st * 1024 + (ob ^ (((ob >> 9) & 1) << 5)); }
__host__ __device__ __forceinline__ void stage_rc(int b, int& R, int& C) { const int st = b / 1024, sb = b % 1024, swz = sb ^ (((sb >> 9) & 1) << 5); R = (st >> 1) * 16 + swz / 64; C = (st & 1) * 32 + (swz % 64) / 2; }
__host__ __device__ __forceinline__ int perm32(int rho) { const int n = rho >> 4, i = rho & 15; return 8 * (i >> 2) + 4 * n + (i & 3); }

struct Unit { int pm, pn, pb, e; };
struct Gemm { const bf16_t* A; const bf16_t* Bt; int M, N, K; };

struct StaticOrder {
    int nM, nN, nwg, G, c;
    __host__ __device__ void init(int M, int N, int G_, int c_) { nM = M / BM; nN = N / BM; nwg = nM * nN; G = G_; c = c_; }
    __host__ __device__ bool next(int i, Unit& u) const {
        const long L = (long)i * G + c; if (L >= nwg) return false;
        int wgid = (int)L; { const int q = nwg / NXCD, r = nwg % NXCD, xcd = wgid % NXCD, off = wgid / NXCD; wgid = (xcd < r ? xcd * (q + 1) : r * (q + 1) + (xcd - r) * q) + off; }
        const int nig = WGM * nN, gid = wgid / nig, fm = gid * WGM, gsz = (nM - fm) < WGM ? (nM - fm) : WGM;
        u.pm = fm + ((wgid % nig) % gsz); u.pn = (wgid % nig) / gsz; u.pb = u.pn; u.e = 0; return true;
    }
    __device__ __forceinline__ void a_ready(const Unit&) const {}
    __device__ __forceinline__ void done(const Unit&) const {}
};
template <int NT> struct MoeOrder {
    const int* blk_e; int nunits, G, c;
    __device__ bool next(int i, Unit& u) const {
        int L;
        if ((G & 7) == 0 && ((G >> 3) % NT) == 0) { const int per = G >> 3, xcd = c & 7, k = c >> 3, bpx = per / NT;
            L = ((i * 8 + xcd) * bpx + k / NT) * NT + (k % NT); }
        else L = i * G + c;
        if (L >= nunits) return false;
        const int blk = L / NT, pn = L % NT; const int e = __hip_atomic_load(blk_e + blk, __ATOMIC_RELAXED, __HIP_MEMORY_SCOPE_AGENT);
        u.pm = blk; u.pn = pn; u.pb = e * NT + pn; u.e = e; return true;
    }
    __device__ __forceinline__ void a_ready(const Unit&) const {}
    __device__ __forceinline__ void done(const Unit&) const {}
};

__device__ __forceinline__ unsigned cvt_pk_bf16(float lo, float hi) { unsigned r; asm volatile("v_cvt_pk_bf16_f32 %0, %1, %2" : "=v"(r) : "v"(lo), "v"(hi)); return r; }

struct EpiF32 {
    static constexpr bool PERM = false, AFTER_DRAIN = false;
    float* C; int ldc;
    __device__ __forceinline__ void operator()(const f32x4 (&acc)[2][2][4][2], const Unit& u, int wr, int wc, int fr, int fq) const {
        const int row0 = u.pm * BM + wr * 64 + fr, col0 = u.pn * BM + wc * 32 + 4 * fq;
#pragma unroll
        for (int ai = 0; ai < 2; ++ai)
#pragma unroll
            for (int m = 0; m < 4; ++m) { float* rowp = C + (size_t)(row0 + ai * HALF + m * 16) * ldc + col0;
#pragma unroll
                for (int bj = 0; bj < 2; ++bj)
#pragma unroll
                    for (int n = 0; n < 2; ++n) __builtin_nontemporal_store(acc[ai][bj][m][n], (f32x4*)(rowp + bj * HALF + n * 16)); }
    }
};
struct EpiBf16 {
    static constexpr bool PERM = true, AFTER_DRAIN = false;
    bf16_t* O; int ldc; const float* bias; int bias_estride;
    __device__ __forceinline__ void operator()(const f32x4 (&acc)[2][2][4][2], const Unit& u, int wr, int wc, int fr, int fq) const {
        const int row0 = u.pm * BM + wr * 64 + fr; const int col0 = u.pn * BM + wc * 32 + 8 * fq;
        const float* bp = bias ? bias + (size_t)u.e * bias_estride + col0 : nullptr;
        f32x4 bv[2][2];
#pragma unroll
        for (int bj = 0; bj < 2; ++bj)
#pragma unroll
            for (int n = 0; n < 2; ++n) bv[bj][n] = bp ? *(const f32x4*)(bp + bj * HALF + 4 * n) : (f32x4){0.f, 0.f, 0.f, 0.f};
#pragma unroll
        for (int ai = 0; ai < 2; ++ai)
#pragma unroll
            for (int m = 0; m < 4; ++m) { bf16_t* rowp = O + (size_t)(row0 + ai * HALF + m * 16) * ldc + col0;
#pragma unroll
                for (int bj = 0; bj < 2; ++bj) { const f32x4 v0 = acc[ai][bj][m][0] + bv[bj][0], v1 = acc[ai][bj][m][1] + bv[bj][1];
                    u32x4 w; w.x = cvt_pk_bf16(v0[0], v0[1]); w.y = cvt_pk_bf16(v0[2], v0[3]); w.z = cvt_pk_bf16(v1[0], v1[1]); w.w = cvt_pk_bf16(v1[2], v1[3]);
                    __builtin_nontemporal_store(w, (u32x4*)(rowp + bj * HALF)); } }
    }
};
struct EpiSwiglu {
    static constexpr bool PERM = true, AFTER_DRAIN = false;
    bf16_t* O; const float* bias;
    __device__ __forceinline__ float act1(float g, float up) const {
        g = fminf(g, 7.0f); up = fminf(fmaxf(up, -7.0f), 7.0f);
        const float sg = 1.0f / (1.0f + __expf(-1.702f * g));
        return (up + 1.0f) * g * sg;
    }
    __device__ __forceinline__ void operator()(const f32x4 (&acc)[2][2][4][2], const Unit& u, int wr, int wc, int fr, int fq) const {
        const int row0 = u.pm * BM + wr * 64 + fr; const int col0 = u.pn * HALF + wc * 32 + 8 * fq;
        const float* bp = bias + (size_t)u.e * 2048 + col0;
        f32x4 bg[2], bu[2];
#pragma unroll
        for (int n = 0; n < 2; ++n) { bg[n] = *(const f32x4*)(bp + 4 * n); bu[n] = *(const f32x4*)(bp + 1024 + 4 * n); }
#pragma unroll
        for (int ai = 0; ai < 2; ++ai)
#pragma unroll
            for (int m = 0; m < 4; ++m) { bf16_t* rowp = O + (size_t)(row0 + ai * HALF + m * 16) * 1024 + col0;
                const f32x4 g0 = acc[ai][0][m][0] + bg[0], g1 = acc[ai][0][m][1] + bg[1], u0 = acc[ai][1][m][0] + bu[0], u1 = acc[ai][1][m][1] + bu[1];
                u32x4 w; w.x = cvt_pk_bf16(act1(g0[0], u0[0]), act1(g0[1], u0[1])); w.y = cvt_pk_bf16(act1(g0[2], u0[2]), act1(g0[3], u0[3]));
                w.z = cvt_pk_bf16(act1(g1[0], u1[0]), act1(g1[1], u1[1])); w.w = cvt_pk_bf16(act1(g1[2], u1[2]), act1(g1[3], u1[3]));
                __builtin_nontemporal_store(w, (u32x4*)rowp); }
    }
};


typedef int i32x4 __attribute__((ext_vector_type(4)));
struct EpiBf16I8 {
    static constexpr bool PERM = true, AFTER_DRAIN = false;
    bf16_t* O; int ldc; const float* rs; const float* cs;
    __device__ __forceinline__ void operator()(const i32x4 (&acc)[2][2][4][2], const Unit& u, int wr, int wc, int fr, int fq) const {
        const int row0 = u.pm * BM + wr * 64 + fr; const int col0 = u.pn * BM + wc * 32 + 8 * fq;
        const float* cp = cs + (size_t)u.pb * BM + wc * 32 + 8 * fq;
        f32x4 cv[2][2]; float rsv[2][4];
#pragma unroll
        for (int bj = 0; bj < 2; ++bj)
#pragma unroll
            for (int n = 0; n < 2; ++n) cv[bj][n] = *(const f32x4*)(cp + bj * HALF + 4 * n);
#pragma unroll
        for (int ai = 0; ai < 2; ++ai)
#pragma unroll
            for (int m = 0; m < 4; ++m) rsv[ai][m] = rs[row0 + ai * HALF + m * 16];
#pragma unroll
        for (int ai = 0; ai < 2; ++ai)
#pragma unroll
            for (int m = 0; m < 4; ++m) { const int row = row0 + ai * HALF + m * 16; const float r = rsv[ai][m]; bf16_t* rowp = O + (size_t)row * ldc + col0;
#pragma unroll
                for (int bj = 0; bj < 2; ++bj) { const i32x4 a0 = acc[ai][bj][m][0], a1 = acc[ai][bj][m][1];
                    const f32x4 v0 = (f32x4){(float)a0[0], (float)a0[1], (float)a0[2], (float)a0[3]} * cv[bj][0] * r, v1 = (f32x4){(float)a1[0], (float)a1[1], (float)a1[2], (float)a1[3]} * cv[bj][1] * r;
                    u32x4 w; w.x = cvt_pk_bf16(v0[0], v0[1]); w.y = cvt_pk_bf16(v0[2], v0[3]); w.z = cvt_pk_bf16(v1[0], v1[1]); w.w = cvt_pk_bf16(v1[2], v1[3]);
                    __builtin_nontemporal_store(w, (u32x4*)(rowp + bj * HALF)); } }
    }
};
struct EpiSwigluI8 {
    static constexpr bool PERM = true, AFTER_DRAIN = false;
    bf16_t* O; const float* bias; const float* rs; const float* cs;
    __device__ __forceinline__ float act1(float g, float up) const {
        g = fminf(g, 7.0f); up = fminf(fmaxf(up, -7.0f), 7.0f);
        const float sg = __builtin_amdgcn_rcpf(1.0f + __expf(-1.702f * g));
        return (up + 1.0f) * g * sg;
    }
    __device__ __forceinline__ void operator()(const i32x4 (&acc)[2][2][4][2], const Unit& u, int wr, int wc, int fr, int fq) const {
        const int row0 = u.pm * BM + wr * 64 + fr; const int col0 = u.pn * HALF + wc * 32 + 8 * fq;
        const float* bp = bias + (size_t)u.e * 2048 + col0;
        const float* cp = cs + (size_t)u.pb * BM + wc * 32 + 8 * fq;
        f32x4 bg[2], bu[2], cg[2], cu[2]; float rsv[2][4];
#pragma unroll
        for (int n = 0; n < 2; ++n) { bg[n] = *(const f32x4*)(bp + 4 * n); bu[n] = *(const f32x4*)(bp + 1024 + 4 * n); cg[n] = *(const f32x4*)(cp + 4 * n); cu[n] = *(const f32x4*)(cp + HALF + 4 * n); }
#pragma unroll
        for (int ai = 0; ai < 2; ++ai)
#pragma unroll
            for (int m = 0; m < 4; ++m) rsv[ai][m] = rs[row0 + ai * HALF + m * 16];
#pragma unroll
        for (int ai = 0; ai < 2; ++ai)
#pragma unroll
            for (int m = 0; m < 4; ++m) { const int row = row0 + ai * HALF + m * 16; const float r = rsv[ai][m]; bf16_t* rowp = O + (size_t)row * 1024 + col0;
                f32x4 g[2], up[2];
#pragma unroll
                for (int n = 0; n < 2; ++n) { const i32x4 ag = acc[ai][0][m][n], au = acc[ai][1][m][n];
                    g[n] = (f32x4){(float)ag[0], (float)ag[1], (float)ag[2], (float)ag[3]} * cg[n] * r + bg[n];
                    up[n] = (f32x4){(float)au[0], (float)au[1], (float)au[2], (float)au[3]} * cu[n] * r + bu[n]; }
                u32x4 w; w.x = cvt_pk_bf16(act1(g[0][0], up[0][0]), act1(g[0][1], up[0][1])); w.y = cvt_pk_bf16(act1(g[0][2], up[0][2]), act1(g[0][3], up[0][3]));
                w.z = cvt_pk_bf16(act1(g[1][0], up[1][0]), act1(g[1][1], up[1][1])); w.w = cvt_pk_bf16(act1(g[1][2], up[1][2]), act1(g[1][3], up[1][3]));
                __builtin_nontemporal_store(w, (u32x4*)rowp); }
    }
};
template <class Epi, class Sched, bool ALIGN_EPI = false, bool SP2 = false>
__device__ __forceinline__ void gemm_phase(PG8_LAS unsigned char* lds, const Gemm g, const Sched& S, const Epi& E) {
    const int tid = threadIdx.x, wid = __builtin_amdgcn_readfirstlane(tid >> 6), lane = tid & 63, wr = wid >> 2, wc = wid & 3, fr = lane & 15, fq = lane >> 4;
    const int K = g.K, nt = K / BK;
    unsigned voffA[2], voffB[2];
#pragma unroll
    for (int i = 0; i < 2; ++i) { int R, C; stage_rc(tid * 16 + i * 8192, R, C); const int Rb = Epi::PERM ? ((R & ~31) + perm32(R & 31)) : R;
        voffA[i] = (unsigned)(R * K + C) * 2u; voffB[i] = (unsigned)(Rb * K + C) * 2u; }
    const size_t kstep = (size_t)(BK * 2);
    const size_t hstep = (size_t)HALF * K * 2;
    const size_t tstep = 2 * hstep;
    const unsigned ldsw = (unsigned)wid * 1024u;
    const int aoff = lds_byte(wr * 64 + fr, fq * 8), boff = lds_byte(wc * 32 + fr, fq * 8);
#define PG8_SA(b, h) (((b) * 2 + (h)) * HTB)
#define PG8_SB(b, h) ((4 + (b) * 2 + (h)) * HTB)
#define PG8_STAGE(bufoff, gbase, voff) do { _Pragma("unroll") for (int _i = 0; _i < 2; ++_i) \
        __builtin_amdgcn_global_load_lds((const unsigned*)((const char*)(gbase) + (voff)[_i]), (PG8_LAS unsigned*)(lds + (bufoff) + ldsw + _i * 8192), 16, 0, 0); } while (0)
#define PG8_LDA(dst, b, h) do { _Pragma("unroll") for (int m = 0; m < 4; ++m) _Pragma("unroll") for (int k = 0; k < 2; ++k) dst[m][k] = *(const PG8_LAS bf16x8*)(lds + PG8_SA(b, h) + aoff + m * 2048 + k * 1024); } while (0)
#define PG8_LDB(dst, b, h) do { _Pragma("unroll") for (int n = 0; n < 2; ++n) _Pragma("unroll") for (int k = 0; k < 2; ++k) dst[n][k] = *(const PG8_LAS bf16x8*)(lds + PG8_SB(b, h) + boff + n * 2048 + k * 1024); } while (0)
#define PG8_MMA(ai, bj, At, Bt) do { __builtin_amdgcn_s_setprio(1); _Pragma("unroll") for (int m = 0; m < 4; ++m) _Pragma("unroll") for (int n = 0; n < 2; ++n) _Pragma("unroll") for (int k = 0; k < 2; ++k) \
        acc[ai][bj][m][n] = __builtin_amdgcn_mfma_f32_16x16x32_bf16(Bt[n][k], At[m][k], acc[ai][bj][m][n], 0, 0, 0); __builtin_amdgcn_s_setprio(0); } while (0)
#define PG8_WAIT_V(n) asm volatile("s_waitcnt vmcnt(" #n ")" ::: "memory")
#define PG8_WAIT_L(n) asm volatile("s_waitcnt lgkmcnt(" #n ")" ::: "memory")
#define PG8_BAR __builtin_amdgcn_s_barrier()
#define PG8_SCHED __builtin_amdgcn_sched_barrier(0)
    Unit cur, nxt; int ui = 0;
    if (!S.next(0, cur)) return;
    f32x4 acc[2][2][4][2];
#pragma unroll
    for (int a = 0; a < 2; ++a)
#pragma unroll
        for (int b = 0; b < 2; ++b)
#pragma unroll
            for (int m = 0; m < 4; ++m)
#pragma unroll
                for (int n = 0; n < 2; ++n) acc[a][b][m][n] = (f32x4){0.f, 0.f, 0.f, 0.f};
    bf16x8 At[4][2], B0[2][2], B1[2][2];
    const char* cA = (const char*)g.A + (size_t)cur.pm * tstep; const char* cB = (const char*)g.Bt + (size_t)cur.pb * tstep;
    S.a_ready(cur);
    if constexpr (SP2) {
        PG8_STAGE(PG8_SB(0, 0), cB, voffB); PG8_STAGE(PG8_SB(0, 1), cB + hstep, voffB); PG8_STAGE(PG8_SA(0, 0), cA, voffA); PG8_STAGE(PG8_SA(0, 1), cA + hstep, voffA);
        if (wr == 1) PG8_BAR;
        PG8_WAIT_V(2); PG8_BAR;
        PG8_STAGE(PG8_SB(1, 0), cB + kstep, voffB); PG8_STAGE(PG8_SA(1, 0), cA + kstep, voffA); PG8_STAGE(PG8_SB(1, 1), cB + hstep + kstep, voffB);
        PG8_WAIT_V(6); PG8_BAR;
    } else {
        PG8_STAGE(PG8_SB(0, 0), cB, voffB); PG8_STAGE(PG8_SA(0, 0), cA, voffA); PG8_STAGE(PG8_SB(0, 1), cB + hstep, voffB); PG8_STAGE(PG8_SA(0, 1), cA + hstep, voffA);
        if (wr == 1) PG8_BAR;
        PG8_WAIT_V(4); PG8_BAR;
        PG8_STAGE(PG8_SB(1, 0), cB + kstep, voffB); PG8_STAGE(PG8_SA(1, 0), cA + kstep, voffA); PG8_STAGE(PG8_SB(1, 1), cB + hstep + kstep, voffB);
        PG8_WAIT_V(6); PG8_BAR;
    }
    for (;;) {
        const bool has_next = S.next(ui + 1, nxt);
        const char* nA = has_next ? (const char*)g.A + (size_t)nxt.pm * tstep : cA; const char* nB = has_next ? (const char*)g.Bt + (size_t)nxt.pb * tstep : cB;
        for (int t = 0; t < nt; t += 2) {
            const bool last = (t == nt - 2);
            const char* a1 = cA + (size_t)(t + 1) * kstep;
            const char* a2 = last ? nA : cA + (size_t)(t + 2) * kstep; const char* b2 = last ? nB : cB + (size_t)(t + 2) * kstep;
            const char* a3 = a2 + kstep; const char* b3 = b2 + kstep;
            if (last && has_next) S.a_ready(nxt);
            if constexpr (SP2) {
            PG8_LDB(B0, 0, 0); PG8_LDB(B1, 0, 1); PG8_SCHED; PG8_LDA(At, 0, 0); PG8_STAGE(PG8_SA(1, 1), a1 + hstep, voffA);
            PG8_WAIT_V(8); PG8_WAIT_L(0); PG8_BAR; PG8_MMA(0, 0, At, B0); PG8_MMA(0, 1, At, B1); PG8_BAR; PG8_SCHED;
            PG8_LDA(At, 0, 1); PG8_STAGE(PG8_SB(0, 0), b2, voffB); PG8_STAGE(PG8_SB(0, 1), b2 + hstep, voffB); PG8_STAGE(PG8_SA(0, 0), a2, voffA);
            PG8_WAIT_V(8); PG8_WAIT_L(0); PG8_BAR; PG8_MMA(1, 0, At, B0); PG8_MMA(1, 1, At, B1); PG8_BAR; PG8_SCHED;
            PG8_LDB(B0, 1, 0); PG8_LDB(B1, 1, 1); PG8_SCHED; PG8_LDA(At, 1, 0); PG8_STAGE(PG8_SA(0, 1), a2 + hstep, voffA);
            PG8_WAIT_V(8); PG8_WAIT_L(0); PG8_BAR; PG8_MMA(0, 0, At, B0); PG8_MMA(0, 1, At, B1); PG8_BAR; PG8_SCHED;
            PG8_LDA(At, 1, 1); PG8_STAGE(PG8_SB(1, 0), b3, voffB); PG8_STAGE(PG8_SB(1, 1), b3 + hstep, voffB); PG8_STAGE(PG8_SA(1, 0), a3, voffA);
            PG8_WAIT_V(8); PG8_WAIT_L(0); PG8_BAR; PG8_MMA(1, 0, At, B0); PG8_MMA(1, 1, At, B1); PG8_BAR; PG8_SCHED;
            } else {
            PG8_LDB(B0, 0, 0); PG8_SCHED; PG8_LDA(At, 0, 0); PG8_STAGE(PG8_SA(1, 1), a1 + hstep, voffA);
            PG8_WAIT_L(8); PG8_BAR; PG8_WAIT_L(0); PG8_MMA(0, 0, At, B0); PG8_BAR; PG8_SCHED;
            PG8_LDB(B1, 0, 1); PG8_STAGE(PG8_SB(0, 0), b2, voffB);
            PG8_BAR; PG8_WAIT_L(0); PG8_MMA(0, 1, At, B1); PG8_BAR;
            PG8_LDA(At, 0, 1); PG8_STAGE(PG8_SA(0, 0), a2, voffA);
            PG8_BAR; PG8_WAIT_L(0); PG8_MMA(1, 0, At, B0); PG8_BAR; PG8_SCHED;
            PG8_STAGE(PG8_SB(0, 1), b2 + hstep, voffB);
            PG8_WAIT_V(6); PG8_BAR; PG8_MMA(1, 1, At, B1); PG8_BAR;
            PG8_LDB(B0, 1, 0); PG8_SCHED; PG8_LDA(At, 1, 0); PG8_STAGE(PG8_SA(0, 1), a2 + hstep, voffA);
            PG8_WAIT_L(8); PG8_BAR; PG8_WAIT_L(0); PG8_MMA(0, 0, At, B0); PG8_BAR; PG8_SCHED;
            PG8_LDB(B1, 1, 1); PG8_STAGE(PG8_SB(1, 0), b3, voffB);
            PG8_BAR; PG8_WAIT_L(0); PG8_MMA(0, 1, At, B1); PG8_BAR;
            PG8_LDA(At, 1, 1); PG8_STAGE(PG8_SA(1, 0), a3, voffA);
            PG8_BAR; PG8_WAIT_L(0); PG8_MMA(1, 0, At, B0); PG8_BAR; PG8_SCHED;
            PG8_STAGE(PG8_SB(1, 1), b3 + hstep, voffB);
            PG8_WAIT_V(6); PG8_BAR; PG8_MMA(1, 1, At, B1); PG8_BAR;
            }
        }
        if constexpr (ALIGN_EPI) { if (wr == 0) PG8_BAR; }
        if constexpr (!Epi::AFTER_DRAIN) { E(acc, cur, wr, wc, fr, fq); S.done(cur); }
        if (!has_next) break;
#pragma unroll
        for (int a = 0; a < 2; ++a)
#pragma unroll
            for (int b = 0; b < 2; ++b)
#pragma unroll
                for (int m = 0; m < 4; ++m)
#pragma unroll
                    for (int n = 0; n < 2; ++n) acc[a][b][m][n] = (f32x4){0.f, 0.f, 0.f, 0.f};
        cur = nxt; cA = nA; cB = nB; ++ui;
        if constexpr (ALIGN_EPI) { if (wr == 1) PG8_BAR; }
    }
    PG8_WAIT_V(0);
    if constexpr (!ALIGN_EPI) { if (wr == 0) PG8_BAR; }
    PG8_BAR;
    if constexpr (Epi::AFTER_DRAIN) { E.fused(acc, cur, wr, wc, fr, fq, lds, wid, lane); S.done(cur); }
#undef PG8_SA
#undef PG8_SB
#undef PG8_STAGE
#undef PG8_LDA
#undef PG8_LDB
#undef PG8_MMA
#undef PG8_WAIT_V
#undef PG8_WAIT_L
#undef PG8_BAR
#undef PG8_SCHED
}
template <class Epi, class Sched, bool ALIGN_EPI = false, bool SP2 = false>
__device__ __forceinline__ void gemm_phase_i8(PG8_LAS unsigned char* lds, const Gemm g, const Sched& S, const Epi& E) {
    const int tid = threadIdx.x, wid = __builtin_amdgcn_readfirstlane(tid >> 6), lane = tid & 63, wr = wid >> 2, wc = wid & 3, fr = lane & 15, fq = lane >> 4;
    const int K = g.K, nt = K / 128;
    unsigned voffA[2], voffB[2];
#pragma unroll
    for (int i = 0; i < 2; ++i) { int R, C; stage_rc(tid * 16 + i * 8192, R, C); const int Rb = Epi::PERM ? ((R & ~31) + perm32(R & 31)) : R;
        voffA[i] = (unsigned)(R * K + C * 2); voffB[i] = (unsigned)(Rb * K + C * 2); }
    const size_t kstep = (size_t)(BK * 2);
    const size_t hstep = (size_t)HALF * K;
    const size_t tstep = 2 * hstep;
    const unsigned ldsw = (unsigned)wid * 1024u;
    const int aoff = lds_byte(wr * 64 + fr, fq * 8), boff = lds_byte(wc * 32 + fr, fq * 8);
#define PG8_SA(b, h) (((b) * 2 + (h)) * HTB)
#define PG8_SB(b, h) ((4 + (b) * 2 + (h)) * HTB)
#define PG8_STAGE(bufoff, gbase, voff) do { _Pragma("unroll") for (int _i = 0; _i < 2; ++_i) \
        __builtin_amdgcn_global_load_lds((const unsigned*)((const char*)(gbase) + (voff)[_i]), (PG8_LAS unsigned*)(lds + (bufoff) + ldsw + _i * 8192), 16, 0, 0); } while (0)
#define PG8_LDA(dst, b, h) do { _Pragma("unroll") for (int m = 0; m < 4; ++m) _Pragma("unroll") for (int k = 0; k < 2; ++k) dst[m][k] = *(const PG8_LAS bf16x8*)(lds + PG8_SA(b, h) + aoff + m * 2048 + k * 1024); } while (0)
#define PG8_LDB(dst, b, h) do { _Pragma("unroll") for (int n = 0; n < 2; ++n) _Pragma("unroll") for (int k = 0; k < 2; ++k) dst[n][k] = *(const PG8_LAS bf16x8*)(lds + PG8_SB(b, h) + boff + n * 2048 + k * 1024); } while (0)
#define PG8_MMA(ai, bj, At, Bt) do { __builtin_amdgcn_s_setprio(1); _Pragma("unroll") for (int m = 0; m < 4; ++m) _Pragma("unroll") for (int n = 0; n < 2; ++n) _Pragma("unroll") for (int k = 0; k < 2; ++k) \
        acc[ai][bj][m][n] = __builtin_amdgcn_mfma_i32_16x16x64_i8(__builtin_bit_cast(i32x4, Bt[n][k]), __builtin_bit_cast(i32x4, At[m][k]), acc[ai][bj][m][n], 0, 0, 0); __builtin_amdgcn_s_setprio(0); } while (0)
#define PG8_WAIT_V(n) asm volatile("s_waitcnt vmcnt(" #n ")" ::: "memory")
#define PG8_WAIT_L(n) asm volatile("s_waitcnt lgkmcnt(" #n ")" ::: "memory")
#define PG8_BAR __builtin_amdgcn_s_barrier()
#define PG8_SCHED __builtin_amdgcn_sched_barrier(0)
    Unit cur, nxt; int ui = 0;
    if (!S.next(0, cur)) return;
    i32x4 acc[2][2][4][2];
#pragma unroll
    for (int a = 0; a < 2; ++a)
#pragma unroll
        for (int b = 0; b < 2; ++b)
#pragma unroll
            for (int m = 0; m < 4; ++m)
#pragma unroll
                for (int n = 0; n < 2; ++n) acc[a][b][m][n] = (i32x4){0, 0, 0, 0};
    bf16x8 At[4][2], B0[2][2], B1[2][2];
    const char* cA = (const char*)g.A + (size_t)cur.pm * tstep; const char* cB = (const char*)g.Bt + (size_t)cur.pb * tstep;
    S.a_ready(cur);
    if constexpr (SP2) {
        PG8_STAGE(PG8_SB(0, 0), cB, voffB); PG8_STAGE(PG8_SB(0, 1), cB + hstep, voffB); PG8_STAGE(PG8_SA(0, 0), cA, voffA); PG8_STAGE(PG8_SA(0, 1), cA + hstep, voffA);
        if (wr == 1) PG8_BAR;
        PG8_WAIT_V(2); PG8_BAR;
        PG8_STAGE(PG8_SB(1, 0), cB + kstep, voffB); PG8_STAGE(PG8_SA(1, 0), cA + kstep, voffA); PG8_STAGE(PG8_SB(1, 1), cB + hstep + kstep, voffB);
        PG8_WAIT_V(6); PG8_BAR;
    } else {
        PG8_STAGE(PG8_SB(0, 0), cB, voffB); PG8_STAGE(PG8_SA(0, 0), cA, voffA); PG8_STAGE(PG8_SB(0, 1), cB + hstep, voffB); PG8_STAGE(PG8_SA(0, 1), cA + hstep, voffA);
        if (wr == 1) PG8_BAR;
        PG8_WAIT_V(4); PG8_BAR;
        PG8_STAGE(PG8_SB(1, 0), cB + kstep, voffB); PG8_STAGE(PG8_SA(1, 0), cA + kstep, voffA); PG8_STAGE(PG8_SB(1, 1), cB + hstep + kstep, voffB);
        PG8_WAIT_V(6); PG8_BAR;
    }
    for (;;) {
        const bool has_next = S.next(ui + 1, nxt);
        const char* nA = has_next ? (const char*)g.A + (size_t)nxt.pm * tstep : cA; const char* nB = has_next ? (const char*)g.Bt + (size_t)nxt.pb * tstep : cB;
        for (int t = 0; t < nt; t += 2) {
            const bool last = (t == nt - 2);
            const char* a1 = cA + (size_t)(t + 1) * kstep;
            const char* a2 = last ? nA : cA + (size_t)(t + 2) * kstep; const char* b2 = last ? nB : cB + (size_t)(t + 2) * kstep;
            const char* a3 = a2 + kstep; const char* b3 = b2 + kstep;
            if (last && has_next) S.a_ready(nxt);
            if constexpr (SP2) {
            PG8_LDB(B0, 0, 0); PG8_LDB(B1, 0, 1); PG8_SCHED; PG8_LDA(At, 0, 0); PG8_STAGE(PG8_SA(1, 1), a1 + hstep, voffA);
            PG8_WAIT_V(8); PG8_WAIT_L(0); PG8_BAR; PG8_MMA(0, 0, At, B0); PG8_MMA(0, 1, At, B1); PG8_BAR; PG8_SCHED;
            PG8_LDA(At, 0, 1); PG8_STAGE(PG8_SB(0, 0), b2, voffB); PG8_STAGE(PG8_SB(0, 1), b2 + hstep, voffB); PG8_STAGE(PG8_SA(0, 0), a2, voffA);
            PG8_WAIT_V(8); PG8_WAIT_L(0); PG8_BAR; PG8_MMA(1, 0, At, B0); PG8_MMA(1, 1, At, B1); PG8_BAR; PG8_SCHED;
            PG8_LDB(B0, 1, 0); PG8_LDB(B1, 1, 1); PG8_SCHED; PG8_LDA(At, 1, 0); PG8_STAGE(PG8_SA(0, 1), a2 + hstep, voffA);
            PG8_WAIT_V(8); PG8_WAIT_L(0); PG8_BAR; PG8_MMA(0, 0, At, B0); PG8_MMA(0, 1, At, B1); PG8_BAR; PG8_SCHED;
            PG8_LDA(At, 1, 1); PG8_STAGE(PG8_SB(1, 0), b3, voffB); PG8_STAGE(PG8_SB(1, 1), b3 + hstep, voffB); PG8_STAGE(PG8_SA(1, 0), a3, voffA);
            PG8_WAIT_V(8); PG8_WAIT_L(0); PG8_BAR; PG8_MMA(1, 0, At, B0); PG8_MMA(1, 1, At, B1); PG8_BAR; PG8_SCHED;
            } else {
            PG8_LDB(B0, 0, 0); PG8_SCHED; PG8_LDA(At, 0, 0); PG8_STAGE(PG8_SA(1, 1), a1 + hstep, voffA);
            PG8_WAIT_L(8); PG8_BAR; PG8_WAIT_L(0); PG8_MMA(0, 0, At, B0); PG8_BAR; PG8_SCHED;
            PG8_LDB(B1, 0, 1); PG8_STAGE(PG8_SB(0, 0), b2, voffB);
            PG8_BAR; PG8_WAIT_L(0); PG8_MMA(0, 1, At, B1); PG8_BAR;
            PG8_LDA(At, 0, 1); PG8_STAGE(PG8_SA(0, 0), a2, voffA);
            PG8_BAR; PG8_WAIT_L(0); PG8_MMA(1, 0, At, B0); PG8_BAR; PG8_SCHED;
            PG8_STAGE(PG8_SB(0, 1), b2 + hstep, voffB);
            PG8_WAIT_V(6); PG8_BAR; PG8_MMA(1, 1, At, B1); PG8_BAR;
            PG8_LDB(B0, 1, 0); PG8_SCHED; PG8_LDA(At, 1, 0); PG8_STAGE(PG8_SA(0, 1), a2 + hstep, voffA);
            PG8_WAIT_L(8); PG8_BAR; PG8_WAIT_L(0); PG8_MMA(0, 0, At, B0); PG8_BAR; PG8_SCHED;
            PG8_LDB(B1, 1, 1); PG8_STAGE(PG8_SB(1, 0), b3, voffB);
            PG8_BAR; PG8_WAIT_L(0); PG8_MMA(0, 1, At, B1); PG8_BAR;
            PG8_LDA(At, 1, 1); PG8_STAGE(PG8_SA(1, 0), a3, voffA);
            PG8_BAR; PG8_WAIT_L(0); PG8_MMA(1, 0, At, B0); PG8_BAR; PG8_SCHED;
            PG8_STAGE(PG8_SB(1, 1), b3 + hstep, voffB);
            PG8_WAIT_V(6); PG8_BAR; PG8_MMA(1, 1, At, B1); PG8_BAR;
            }
        }
        if constexpr (ALIGN_EPI) { if (wr == 0) PG8_BAR; }
        if constexpr (!Epi::AFTER_DRAIN) { E(acc, cur, wr, wc, fr, fq); S.done(cur); }
        if (!has_next) break;
#pragma unroll
        for (int a = 0; a < 2; ++a)
#pragma unroll
            for (int b = 0; b < 2; ++b)
#pragma unroll
                for (int m = 0; m < 4; ++m)
#pragma unroll
                    for (int n = 0; n < 2; ++n) acc[a][b][m][n] = (i32x4){0, 0, 0, 0};
        cur = nxt; cA = nA; cB = nB; ++ui;
        if constexpr (ALIGN_EPI) { if (wr == 1) PG8_BAR; }
    }
    PG8_WAIT_V(0);
    if constexpr (!ALIGN_EPI) { if (wr == 0) PG8_BAR; }
    PG8_BAR;
    if constexpr (Epi::AFTER_DRAIN) { E.fused(acc, cur, wr, wc, fr, fq, lds, wid, lane); S.done(cur); }
#undef PG8_SA
#undef PG8_SB
#undef PG8_STAGE
#undef PG8_LDA
#undef PG8_LDB
#undef PG8_MMA
#undef PG8_WAIT_V
#undef PG8_WAIT_L
#undef PG8_BAR
#undef PG8_SCHED
}

}
#ifndef STAGE_REP
#define STAGE_REP 0
#endif

constexpr int NWAVES = 8;
constexpr int D = 1024, BATCH = 2, T = 8192, TC = 256, NH = 16;
constexpr int ML = BATCH * T;
constexpr int MC = BATCH * TC;
constexpr int MT = ML + MC;
constexpr int N_IN = 8576, NZ = 8704;
constexpr int K_OFF = 0, V_OFF = 1024, DECAY_OFF = 2048, ICLR_OFF = 2176, STATE_COLS = 2304, R_OFF = 2304, GLORA_OFF = 3328, SHIFT_COLS = 3456;
constexpr int CONV_OFF = 3456, GATE_OFF = 6528;
constexpr int NE = 32, TOPK = 4, DFF = 1024;
constexpr int NL = 5120, KL = 384;
constexpr int MAXBLK = 288;
constexpr int NROWS = MAXBLK * 256;
constexpr int KSPLIT = 16;

constexpr size_t MiB = 1u << 20;
constexpr size_t WS_CTL = 0, CTL_ZERO_BYTES = 1 * MiB;
constexpr size_t WS_MODP = 1 * MiB;
constexpr size_t WS_WLORA = 3 * MiB;
constexpr size_t WS_WROUT = 7 * MiB;
constexpr size_t WS_WOUT = 8 * MiB;
constexpr size_t WS_WIN = 10 * MiB;
constexpr size_t WS_A0 = 28 * MiB;
constexpr size_t WS_MISC = 61 * MiB;
constexpr size_t WS_Z = 64 * MiB;
constexpr size_t WS_AL = 345 * MiB;
constexpr size_t WS_LORA = 358 * MiB;
constexpr size_t WS_SCAN = 523 * MiB;
constexpr size_t WS_Y = 886 * MiB;
constexpr size_t WS_END = 1014 * MiB;
constexpr size_t WS_PQ = WS_SCAN;
constexpr size_t WS_TKN = WS_PQ + 132 * MiB;
constexpr size_t WS_UPRE = WS_TKN + 66 * MiB;
constexpr size_t WS_H0T = WS_UPRE + 66 * MiB;
static_assert(WS_H0T + 64 * MiB <= WS_Y, "scan region");
constexpr size_t WS_MIX = WS_LORA, WS_X1 = WS_LORA + 64 * MiB, WS_H2 = WS_LORA + 128 * MiB;
constexpr size_t WS_LOGIT = WS_SCAN, WS_XB = WS_SCAN + 16 * MiB, WS_ACT = WS_XB + 144 * MiB;
constexpr size_t WS_Y2 = WS_Z, WS_WEIN = WS_Y, WS_WEOUT = WS_Y + 64 * MiB;
static_assert(WS_ACT + 144 * MiB <= WS_Y && WS_WEIN + 64 * MiB <= WS_WEOUT && WS_WEOUT + 64 * MiB <= WS_END, "late regions");
constexpr size_t MI_SELE = WS_MISC, MI_SELP = MI_SELE + (size_t)ML * 4 * 4, MI_GATE = MI_SELP + (size_t)ML * 4 * 4, MI_DEST = MI_GATE + (size_t)ML * 4 * 4, MI_BLKE = MI_DEST + (size_t)ML * 4 * 4;
constexpr size_t MI_RSH = MI_BLKE + 4096;
constexpr size_t MI_CSWIN = MI_RSH + (size_t)MT * 4;
constexpr size_t MI_RSH2 = MI_CSWIN + (size_t)NZ * 4;
constexpr size_t MI_RSXB = MI_RSH2 + (size_t)ML * 4;
constexpr size_t MI_CSWEI = MI_RSXB + (size_t)NROWS * 4;
constexpr size_t MI_BON = MI_CSWEI + (size_t)NE * 2048 * 4;
static_assert(MI_BON + (size_t)4096 * 64 * 4 <= WS_Z && MI_RSH % 16 == 0 && MI_CSWIN % 16 == 0 && MI_CSWEI % 16 == 0, "misc");
constexpr size_t WS_H2Q = WS_A0;
constexpr int CW_BAR = 4096;
constexpr int CW_CNT = 16384;
constexpr int CW_FB = 8192;
constexpr int CW_Q6 = CW_CNT + 64 * 40;

constexpr int RING_OFF = 0, RING_BYTES = 131072;
constexpr int LDSCTL_OFF = 147456, MISC_OFF = LDSCTL_OFF + 320;
constexpr int LDS_X_OFF = LDSCTL_OFF + 512;
constexpr int LDS_BYTES = 163840;

#define GAS __attribute__((address_space(1)))
#define LAS __attribute__((address_space(3)))
typedef unsigned short bf16;
typedef unsigned v4u __attribute__((ext_vector_type(4)));
typedef unsigned v2u __attribute__((ext_vector_type(2)));
typedef float f32x4 __attribute__((ext_vector_type(4)));
#define LDS_WAIT() asm volatile("s_waitcnt lgkmcnt(0)" ::: "memory")
#define VM_WAIT() asm volatile("s_waitcnt vmcnt(0)" ::: "memory")
__device__ __forceinline__ unsigned f2bf(float f) { unsigned u = __builtin_bit_cast(unsigned, f); return (u + 0x7fffu + ((u >> 16) & 1u)) >> 16; }
__device__ __forceinline__ unsigned pk2(float lo, float hi) { return f2bf(lo) | (f2bf(hi) << 16); }
typedef __bf16 bf16v2h_t __attribute__((ext_vector_type(2)));
__device__ __forceinline__ unsigned pk2h(float lo, float hi) { const bf16v2h_t v = {(__bf16)lo, (__bf16)hi}; return __builtin_bit_cast(unsigned, v); }
__device__ __forceinline__ float bflo(unsigned w) { return __builtin_bit_cast(float, w << 16); }
__device__ __forceinline__ float bfhi(unsigned w) { return __builtin_bit_cast(float, w & 0xffff0000u); }
__device__ __forceinline__ float bf1(bf16 h) { return __builtin_bit_cast(float, (unsigned)h << 16); }
__device__ __forceinline__ void ld16bf(const bf16* p, float (&o)[16]) {
    const v4u a = *(const v4u*)p, b = *(const v4u*)(p + 8);
    o[0] = bflo(a.x); o[1] = bfhi(a.x); o[2] = bflo(a.y); o[3] = bfhi(a.y); o[4] = bflo(a.z); o[5] = bfhi(a.z); o[6] = bflo(a.w); o[7] = bfhi(a.w);
    o[8] = bflo(b.x); o[9] = bfhi(b.x); o[10] = bflo(b.y); o[11] = bfhi(b.y); o[12] = bflo(b.z); o[13] = bfhi(b.z); o[14] = bflo(b.w); o[15] = bfhi(b.w);
}
__device__ __forceinline__ void st16bf(bf16* p, const float (&o)[16]) {
    v4u a, b; a.x = pk2(o[0], o[1]); a.y = pk2(o[2], o[3]); a.z = pk2(o[4], o[5]); a.w = pk2(o[6], o[7]);
    b.x = pk2(o[8], o[9]); b.y = pk2(o[10], o[11]); b.z = pk2(o[12], o[13]); b.w = pk2(o[14], o[15]);
    *(v4u*)p = a; *(v4u*)(p + 8) = b;
}
__device__ __forceinline__ void ld16f(const float* p, float (&o)[16]) {
#pragma unroll
    for (int q = 0; q < 4; ++q) { const f32x4 v = *(const f32x4*)(p + 4 * q); o[4 * q] = v.x; o[4 * q + 1] = v.y; o[4 * q + 2] = v.z; o[4 * q + 3] = v.w; }
}
__device__ __forceinline__ void ld16f_lds(const LAS float* p, float (&o)[16]) {
#pragma unroll
    for (int q = 0; q < 4; ++q) { const f32x4 v = *(const LAS f32x4*)(p + 4 * q); o[4 * q] = v.x; o[4 * q + 1] = v.y; o[4 * q + 2] = v.z; o[4 * q + 3] = v.w; }
}
__device__ __forceinline__ void st16f(float* p, const float (&o)[16]) {
#pragma unroll
    for (int q = 0; q < 4; ++q) *(f32x4*)(p + 4 * q) = (f32x4){o[4 * q], o[4 * q + 1], o[4 * q + 2], o[4 * q + 3]};
}
__device__ __forceinline__ float sigmoidf_(float x) { return 1.0f / (1.0f + __expf(-x)); }
__device__ __forceinline__ float wave_sum(float v) {
#pragma unroll
    for (int o = 1; o < 64; o <<= 1) v += __shfl_xor(v, o);
    return v;
}
__device__ __forceinline__ float wave_max(float v) {
#pragma unroll
    for (int o = 1; o < 64; o <<= 1) v = fmaxf(v, __shfl_xor(v, o));
    return v;
}
__device__ __forceinline__ unsigned pack_q4(float a, float b, float c, float d) {
    const int qa = __float2int_rn(a), qb = __float2int_rn(b), qc = __float2int_rn(c), qd = __float2int_rn(d);
    return (unsigned)(qa & 255) | ((unsigned)(qb & 255) << 8) | ((unsigned)(qc & 255) << 16) | ((unsigned)qd << 24);
}
__device__ __forceinline__ float quad_sum(float v) { v += __shfl_xor(v, 1); v += __shfl_xor(v, 2); return v; }

#define XB_TMO      128
#define XB_XCNT(j)  (256  + 64 * (j))
#define XB_XSUB(j)  (1280 + 64 * (j))
#define XB_XGEN(j)  (2304 + 64 * (j))
#define XB_TOP      3328
#define XB_TOPGEN   3392
#define XCD_BAR_WORDS 3456
#define XB_SPIN_CAP (1u << 18)

__device__ __forceinline__ unsigned xb_ld(unsigned* p)              { return __hip_atomic_load(p, __ATOMIC_RELAXED, __HIP_MEMORY_SCOPE_AGENT); }
__device__ __forceinline__ unsigned xb_add(unsigned* p, unsigned v) { return __hip_atomic_fetch_add(p, v, __ATOMIC_RELAXED, __HIP_MEMORY_SCOPE_AGENT); }
__device__ __forceinline__ unsigned xb_xcc_id() { return (unsigned)__builtin_amdgcn_s_getreg((3 << 11) | 20) & 0xFu; }
#define XB_SPIN(cond, bar) do { unsigned _sp = 0; while (cond) { __builtin_amdgcn_s_sleep(1); \
    if ((++_sp & 255u) == 0u) { if (xb_ld(&(bar)[XB_TMO])) break; if (_sp > XB_SPIN_CAP) { atomicAdd(&(bar)[XB_TMO], 1u); break; } } } } while (0)

struct XcdBarrier { unsigned* bar; unsigned x; volatile LAS unsigned* st; };

__device__ __forceinline__ XcdBarrier xcd_barrier_post(unsigned* bar, volatile LAS unsigned* st) {
    XcdBarrier b; b.bar = bar; b.x = xb_xcc_id(); b.st = st;
    if (threadIdx.x == 0) (void)xb_add(&bar[XB_XCNT(b.x)], 1u);
    return b;
}
__device__ __forceinline__ void xcd_barrier_complete(unsigned* bar, unsigned x, unsigned& nloc, unsigned& nx) {
    const unsigned G = gridDim.x * gridDim.y * gridDim.z;
    unsigned sum, cnt, mine, sp = 0u;
    for (;;) {
        sum = 0u; cnt = 0u; mine = 0u;
#pragma unroll
        for (unsigned j = 0; j < 16; ++j) { const unsigned c = xb_ld(&bar[XB_XCNT(j)]); sum += c; cnt += (c > 0u) ? 1u : 0u; mine = (j == x) ? c : mine; }
        if (sum == G) break;
        __builtin_amdgcn_s_sleep(1);
        if ((++sp & 255u) == 0u) { if (xb_ld(&bar[XB_TMO])) break; if (sp > XB_SPIN_CAP) { atomicAdd(&bar[XB_TMO], 1u); break; } }
    }
    nloc = mine > 0u ? mine : 1u; nx = cnt > 0u ? cnt : 1u;
}
__device__ __forceinline__ void xcd_barrier(const XcdBarrier& b) {
    asm volatile("s_waitcnt vmcnt(0)" ::: "memory");
    __syncthreads();
    if (threadIdx.x == 0) {
        unsigned* bar = b.bar;
        __builtin_amdgcn_s_waitcnt(0);
        unsigned nloc = b.st[0], nx = b.st[1];
        if (nloc == 0u) { xcd_barrier_complete(bar, b.x, nloc, nx); b.st[0] = nloc; b.st[1] = nx; }
        const unsigned old = xb_add(&bar[XB_XSUB(b.x)], 1u);
        const unsigned gen = old / nloc;
        if (old + 1u == (gen + 1u) * nloc) {
            __builtin_amdgcn_fence(__ATOMIC_RELEASE, "agent");
            asm volatile("s_waitcnt vmcnt(0)" ::: "memory");
            const unsigned og = xb_add(&bar[XB_TOP], 1u);
            const unsigned tg = og / nx;
            if (og + 1u == (tg + 1u) * nx) xb_add(&bar[XB_TOPGEN], 1u);
            else XB_SPIN(xb_ld(&bar[XB_TOPGEN]) == tg, bar);
            __builtin_amdgcn_fence(__ATOMIC_ACQUIRE, "agent");
            xb_add(&bar[XB_XGEN(b.x)], 1u);
            asm volatile("s_waitcnt vmcnt(0)" ::: "memory");
        } else {
            XB_SPIN(xb_ld(&bar[XB_XGEN(b.x)]) == gen, bar);
            __builtin_amdgcn_fence(__ATOMIC_ACQUIRE, "agent");
            asm volatile("s_waitcnt vmcnt(0)" ::: "memory");
        }
    }
    __syncthreads();
}

#define XB_DONE(j)  (3456 + 64 * (j))
__device__ __forceinline__ void xcd_barrier2(const XcdBarrier& b) {
    asm volatile("s_waitcnt vmcnt(0)" ::: "memory");
    __syncthreads();
    if (threadIdx.x == 0) {
        unsigned* bar = b.bar;
        __builtin_amdgcn_s_waitcnt(0);
        unsigned nloc = b.st[0], nx = b.st[1];
        if (nloc == 0u) { xcd_barrier_complete(bar, b.x, nloc, nx); b.st[0] = nloc; b.st[1] = nx; }
        const unsigned old = xb_add(&bar[XB_XSUB(b.x)], 1u);
        const unsigned gen = old / nloc;
        if (old + 1u == (gen + 1u) * nloc) {
            __builtin_amdgcn_fence(__ATOMIC_RELEASE, "agent");
            asm volatile("s_waitcnt vmcnt(0)" ::: "memory");
#pragma unroll
            for (unsigned j = 0; j < 16; ++j) (void)xb_add(&bar[XB_DONE(j)], 1u);
        }
        XB_SPIN(xb_ld(&bar[XB_DONE(b.x)]) < (gen + 1u) * nx, bar);
        __builtin_amdgcn_fence(__ATOMIC_ACQUIRE, "agent");
        asm volatile("s_waitcnt vmcnt(0)" ::: "memory");
    }
    __syncthreads();
}

#define FB_WORD(j) (64 * (j))
#define FB_TMO 640
__device__ __forceinline__ void flat_barrier(unsigned* fb, unsigned epoch) {
    asm volatile("s_waitcnt vmcnt(0)" ::: "memory");
    __syncthreads();
    if (threadIdx.x == 0) {
        __builtin_amdgcn_s_waitcnt(0);
        __builtin_amdgcn_fence(__ATOMIC_RELEASE, "agent");
        asm volatile("s_waitcnt vmcnt(0)" ::: "memory");
        (void)xb_add(&fb[FB_WORD(blockIdx.x & 7u)], 1u);
        const unsigned want = epoch * gridDim.x; unsigned sp = 0u;
        for (;;) {
            unsigned s = 0u;
#pragma unroll
            for (int j = 0; j < 8; ++j) s += xb_ld(&fb[FB_WORD(j)]);
            if (s >= want) break;
            __builtin_amdgcn_s_sleep(1);
            if ((++sp & 255u) == 0u) { if (xb_ld(&fb[FB_TMO])) break; if (sp > XB_SPIN_CAP) { atomicAdd(&fb[FB_TMO], 1u); break; } }
        }
        __builtin_amdgcn_fence(__ATOMIC_ACQUIRE, "agent");
        asm volatile("s_waitcnt vmcnt(0)" ::: "memory");
    }
    __syncthreads();
}

struct Frame {
    LAS unsigned char* lds;
    volatile LAS unsigned* MISC;
    unsigned* ctl;
    int tid, lane, wave, G, gw, NGW;
    float* out;
    unsigned char* ws;
};
enum { I_X = 0, I_C, I_CTX, I_CCTX, I_WADA, I_BADA, I_NPM, I_NQM, I_NPF, I_NQF, I_WIN, I_MU, I_W0, I_WDU, I_A0, I_WIU, I_KK, I_KA, I_RK, I_WGU, I_LNW, I_LNB, I_CONVW,
       I_WOUT, I_WR, I_BR, I_WEI, I_BEI, I_WEO, I_BEO };


typedef const float* fptr_t;
__device__ __forceinline__ fptr_t kin_ptr(int i) { const volatile __attribute__((address_space(4))) fptr_t* ka = (const volatile __attribute__((address_space(4))) fptr_t*)__builtin_amdgcn_kernarg_segment_ptr(); return ka[i]; }
#define KIN(i) kin_ptr(i)
__device__ __forceinline__ void transpose_item(const float* W, int N, int k0, int n0, bf16* WT, int ldk, int rowbase, LAS float* scr, int lane) {
#pragma unroll 8
    for (int i = 0; i < 32; ++i) { const int kk = 2 * i + (lane >> 5); scr[kk * 33 + (lane & 31)] = W[(size_t)(k0 + kk) * N + n0 + (lane & 31)]; }
    LDS_WAIT(); asm volatile("" ::: "memory");
    const int c = lane & 7;
#pragma unroll
    for (int j = 0; j < 4; ++j) { const int n = (lane >> 3) + 8 * j; const LAS float* s = scr + (8 * c) * 33 + n;
        v4u o; o.x = pk2(s[0 * 33], s[1 * 33]); o.y = pk2(s[2 * 33], s[3 * 33]); o.z = pk2(s[4 * 33], s[5 * 33]); o.w = pk2(s[6 * 33], s[7 * 33]);
        *(v4u*)(WT + (size_t)(rowbase + n) * ldk + k0 + 8 * c) = o; }
    LDS_WAIT(); asm volatile("" ::: "memory");
}

__device__ __forceinline__ unsigned pack_q4c(float a, float b, float c, float d) {
    const int qa = __float2int_rn(fminf(fmaxf(a, -127.f), 127.f)), qb = __float2int_rn(fminf(fmaxf(b, -127.f), 127.f)), qc = __float2int_rn(fminf(fmaxf(c, -127.f), 127.f)), qd = __float2int_rn(fminf(fmaxf(d, -127.f), 127.f));
    return (unsigned)(qa & 255) | ((unsigned)(qb & 255) << 8) | ((unsigned)(qc & 255) << 16) | ((unsigned)qd << 24);
}
__device__ __forceinline__ void q8_item(const float* W, int N, int n0, signed char* WT, float* cs, int rowbase, LAS float* scr, int lane, int kb0 = 0, int kb1 = 16) {
    const int r8 = lane >> 3, c4 = lane & 7;
    const float* p0 = W + (size_t)r8 * N + n0 + 4 * c4;
    f32x4 ss = {0.f, 0.f, 0.f, 0.f};
#pragma unroll
    for (int hb = 0; hb < 2; ++hb) {
        f32x4 v[16];
#pragma unroll
        for (int i = 0; i < 16; ++i) v[i] = *(const f32x4*)(p0 + (size_t)(8 * (16 * hb + i)) * N);
        __builtin_amdgcn_sched_barrier(0);
#pragma unroll
        for (int i = 0; i < 16; ++i) ss += v[i] * v[i];
    }
#pragma unroll
    for (int o = 8; o < 64; o <<= 1) { ss.x += __shfl_xor(ss.x, o); ss.y += __shfl_xor(ss.y, o); ss.z += __shfl_xor(ss.z, o); ss.w += __shfl_xor(ss.w, o); }
    if (lane < 8) {
#pragma unroll
        for (int q = 0; q < 4; ++q) { const float m = 6.0f * sqrtf(ss[q] * (1.0f / 256.0f)); cs[rowbase + 4 * lane + q] = m * (1.0f / 127.0f); scr[2112 + 4 * lane + q] = m > 0.f ? 127.0f / m : 0.f; } }
    LDS_WAIT(); asm volatile("" ::: "memory");
    f32x4 cur[8];
#pragma unroll
    for (int i = 0; i < 8; ++i) cur[i] = *(const f32x4*)(p0 + (size_t)(64 * kb0 + 8 * i) * N);
    for (int kb = kb0; kb < kb1; ++kb) {
        f32x4 nxt[8];
        const int kn = kb < kb1 - 1 ? kb + 1 : kb;
#pragma unroll
        for (int i = 0; i < 8; ++i) nxt[i] = *(const f32x4*)(p0 + (size_t)(64 * kn + 8 * i) * N);
#pragma unroll
        for (int i = 0; i < 8; ++i) { LAS float* s = scr + (r8 + 8 * i) * 33 + 4 * c4; s[0] = cur[i].x; s[1] = cur[i].y; s[2] = cur[i].z; s[3] = cur[i].w; }
        LDS_WAIT(); asm volatile("" ::: "memory");
        const int c = lane & 3;
#pragma unroll
        for (int j = 0; j < 2; ++j) { const int n = (lane >> 2) + 16 * j; const float iv = scr[2112 + n]; const LAS float* s = scr + (16 * c) * 33 + n;
            v4u o; o.x = pack_q4c(s[0] * iv, s[33] * iv, s[66] * iv, s[99] * iv); o.y = pack_q4c(s[132] * iv, s[165] * iv, s[198] * iv, s[231] * iv);
            o.z = pack_q4c(s[264] * iv, s[297] * iv, s[330] * iv, s[363] * iv); o.w = pack_q4c(s[396] * iv, s[429] * iv, s[462] * iv, s[495] * iv);
            *(v4u*)(WT + (size_t)(rowbase + n) * 1024 + 64 * kb + 16 * c) = o; }
        LDS_WAIT(); asm volatile("" ::: "memory");
#pragma unroll
        for (int i = 0; i < 8; ++i) cur[i] = nxt[i];
    }
}

struct CvTile { f32x4 v[8]; };
__device__ __forceinline__ void cv_load(CvTile& t, const float* W, int N, int n0, int kb, int lane) {
    const float* p0 = W + (size_t)(64 * kb + (lane >> 3)) * N + n0 + 4 * (lane & 7);
#pragma unroll
    for (int i = 0; i < 8; ++i) t.v[i] = *(const f32x4*)(p0 + (size_t)(8 * i) * N);
}
__device__ __forceinline__ void cv_to_lds(const CvTile& t, LAS float* scr, int lane) {
    const int r8 = lane >> 3, c4 = lane & 7;
#pragma unroll
    for (int i = 0; i < 8; ++i) { LAS float* s = scr + (r8 + 8 * i) * 33 + 4 * c4; s[0] = t.v[i].x; s[1] = t.v[i].y; s[2] = t.v[i].z; s[3] = t.v[i].w; }
    LDS_WAIT(); asm volatile("" ::: "memory");
}
__device__ __forceinline__ void cv_store_bf16(const LAS float* scr, bf16* WT, int ldk, int rowbase, int k0, int lane) {
    const int c = lane & 7;
#pragma unroll
    for (int j = 0; j < 4; ++j) { const int n = (lane >> 3) + 8 * j; const LAS float* s = scr + (8 * c) * 33 + n;
        v4u o; o.x = pk2h(s[0 * 33], s[1 * 33]); o.y = pk2h(s[2 * 33], s[3 * 33]); o.z = pk2h(s[4 * 33], s[5 * 33]); o.w = pk2h(s[6 * 33], s[7 * 33]);
        *(v4u*)(WT + (size_t)(rowbase + n) * ldk + k0 + 8 * c) = o; }
    LDS_WAIT(); asm volatile("" ::: "memory");
}
__device__ __forceinline__ unsigned q8_pack4(float a, float b, float c, float d) {
    const float M = 12582912.0f;
    const unsigned x0 = __builtin_bit_cast(unsigned, __builtin_amdgcn_fmed3f(a, -127.f, 127.f) + M), x1 = __builtin_bit_cast(unsigned, __builtin_amdgcn_fmed3f(b, -127.f, 127.f) + M);
    const unsigned x2 = __builtin_bit_cast(unsigned, __builtin_amdgcn_fmed3f(c, -127.f, 127.f) + M), x3 = __builtin_bit_cast(unsigned, __builtin_amdgcn_fmed3f(d, -127.f, 127.f) + M);
    return __builtin_amdgcn_perm(x1, x0, 0x0c0c0400u) | __builtin_amdgcn_perm(x3, x2, 0x04000c0cu);
}
__device__ __forceinline__ void cv_store_q8(const CvTile& t, LAS float* scr, signed char* WT, int rowbase, int kb, const float (&iv)[4], int lane) {
    LAS unsigned* img = (LAS unsigned*)scr;
    const int r8 = lane >> 3, c4 = lane & 7;
#pragma unroll
    for (int i = 0; i < 8; ++i) img[(r8 + 8 * i) * 9 + c4] = q8_pack4(t.v[i].x * iv[0], t.v[i].y * iv[1], t.v[i].z * iv[2], t.v[i].w * iv[3]);
    LDS_WAIT(); asm volatile("" ::: "memory");
    const int c = lane & 3;
#pragma unroll
    for (int j = 0; j < 2; ++j) { const int n = (lane >> 2) + 16 * j; const unsigned bs = (unsigned)(n & 3);
        const unsigned s01 = 0x0c0c0000u | bs | ((4u + bs) << 8), s23 = 0x00000c0cu | (bs << 16) | ((4u + bs) << 24);
        const LAS unsigned* s = img + (16 * c) * 9 + (n >> 2);
        v4u o;
        o.x = __builtin_amdgcn_perm(s[9], s[0], s01) | __builtin_amdgcn_perm(s[27], s[18], s23);
        o.y = __builtin_amdgcn_perm(s[45], s[36], s01) | __builtin_amdgcn_perm(s[63], s[54], s23);
        o.z = __builtin_amdgcn_perm(s[81], s[72], s01) | __builtin_amdgcn_perm(s[99], s[90], s23);
        o.w = __builtin_amdgcn_perm(s[117], s[108], s01) | __builtin_amdgcn_perm(s[135], s[126], s23);
        *(v4u*)(WT + (size_t)(rowbase + n) * 1024 + 64 * kb + 16 * c) = o; }
    LDS_WAIT(); asm volatile("" ::: "memory");
}
__device__ __forceinline__ void cv_scale_q8(const float* W, int N, int n0, float* cs, int rowbase, int lane, float (&iv)[4]) {
    const float* p0 = W + (size_t)(lane >> 3) * N + n0 + 4 * (lane & 7);
    f32x4 ss = {0.f, 0.f, 0.f, 0.f};
#pragma unroll
    for (int hb = 0; hb < 2; ++hb) {
        f32x4 v[16];
#pragma unroll
        for (int i = 0; i < 16; ++i) v[i] = *(const f32x4*)(p0 + (size_t)(8 * (16 * hb + i)) * N);
        __builtin_amdgcn_sched_barrier(0);
#pragma unroll
        for (int i = 0; i < 16; ++i) ss += v[i] * v[i];
    }
#pragma unroll
    for (int o = 8; o < 64; o <<= 1) { ss.x += __shfl_xor(ss.x, o); ss.y += __shfl_xor(ss.y, o); ss.z += __shfl_xor(ss.z, o); ss.w += __shfl_xor(ss.w, o); }
#pragma unroll
    for (int q = 0; q < 4; ++q) { const float m = 6.0f * sqrtf(ss[q] * (1.0f / 256.0f)); if (lane < 8) cs[rowbase + 4 * lane + q] = m * (1.0f / 127.0f); iv[q] = m > 0.f ? 127.0f / m : 0.f; }
}
__device__ __forceinline__ void wei_strip(int s, int& e, int& n0, int& rowbase) { e = s >> 6; n0 = 32 * (s & 63); const int c = n0 & 1023; rowbase = (c >> 7) * 256 + (n0 >= 1024 ? 128 : 0) + (c & 127); }

template <int N>
__device__ __forceinline__ void mod_vals(const float* modp, const float* b_ada, int vec, const int (&j)[N], float (&out)[N]) {
    float p[N][KSPLIT], s[N];
#pragma unroll
    for (int n = 0; n < N; ++n) { s[n] = b_ada[j[n]];
#pragma unroll
        for (int ks = 0; ks < KSPLIT; ++ks) p[n][ks] = modp[((size_t)ks * 3 + vec) * 6144 + j[n]]; }
    __builtin_amdgcn_sched_barrier(0);
#pragma unroll
    for (int n = 0; n < N; ++n) {
#pragma unroll
        for (int ks = 0; ks < KSPLIT; ++ks) s[n] += p[n][ks];
        out[n] = s[n]; }
}
__device__ __forceinline__ float mod_val(const float* modp, const float* b_ada, int vec, int j) { const int jj[1] = {j}; float o[1]; mod_vals<1>(modp, b_ada, vec, jj, o); return o[0]; }
__device__ __forceinline__ int nbr_row(int row, int j) {
    if (row < ML) { const int t = row & (T - 1), gc = t & 63, gr = t >> 6;
        if (j == 0) return gc > 0 ? row - 1 : -1; if (j == 1) return gc < 63 ? row + 1 : -1; if (j == 2) return gr > 0 ? row - 64 : -1; return gr < 127 ? row + 64 : -1; }
    const int tc = (row - ML) & (TC - 1);
    if ((j & 1) == 0) return tc > 0 ? row - 1 : -1; return tc < TC - 1 ? row + 1 : -1;
}
__device__ __forceinline__ void load_shift16(const bf16* z, int row, int col0, const LAS float* mu, float (&out)[16]) {
    float s[16]; ld16bf(z + (size_t)row * NZ + col0, s);
    float m[16]; ld16f_lds(mu, m);
#pragma unroll
    for (int j = 0; j < 4; ++j) {
        const int nr = nbr_row(row, j); float t[16];
        if (nr >= 0) ld16bf(z + (size_t)nr * NZ + col0, t); else {
#pragma unroll
            for (int i = 0; i < 16; ++i) t[i] = 0.f; }
#pragma unroll
        for (int i = j; i < 16; i += 4) out[i] = s[i] + m[i] * (t[i] - s[i]);
    }
}

__device__ __forceinline__ void phase_prologue(Frame& F) {
    LAS float* scr = (LAS float*)(F.lds + RING_OFF + F.wave * 16384);
    LAS float* sil = (LAS float*)(F.lds + LDS_X_OFF);
    for (int i = F.tid; i < 3 * D; i += NWAVES * 64) { const int v = i / D, j = i % D; const float c = v < 2 ? KIN(I_C)[v * D + j] : KIN(I_CCTX)[j]; sil[i] = c / (1.0f + __expf(-c)); }
    __syncthreads();
    bf16* WoutT = (bf16*)(F.ws + WS_WOUT);
    constexpr int IT_WIN = (N_IN / 32) * 4, IT_WOUT = (D / 64) * (D / 32), IT_ADA = 24 * KSPLIT;
    constexpr int NITEMS = IT_ADA + IT_WIN + IT_WOUT;
    float* modp = (float*)(F.ws + WS_MODP);
    for (int it = F.gw; it < NITEMS; it += F.NGW) {
        int r = it;
        if (r < IT_ADA) {
            const int cc = r % 24, ks = r / 24, col = cc * 256 + F.lane * 4;
            f32x4 a0 = {0.f, 0.f, 0.f, 0.f}, a1 = a0, a2 = a0;
            const float* wp = KIN(I_WADA) + (size_t)(ks * 64) * 6144 + col;
#pragma unroll 8
            for (int k = 0; k < 64; ++k) { const f32x4 w = *(const f32x4*)(wp + (size_t)k * 6144); const int kk = ks * 64 + k;
                a0 += w * sil[kk]; a1 += w * sil[D + kk]; a2 += w * sil[2 * D + kk]; }
            *(f32x4*)(modp + ((size_t)ks * 3 + 0) * 6144 + col) = a0; *(f32x4*)(modp + ((size_t)ks * 3 + 1) * 6144 + col) = a1; *(f32x4*)(modp + ((size_t)ks * 3 + 2) * 6144 + col) = a2;
            continue; }
        r -= IT_ADA;
        if (r < IT_WIN) { const int st = r >> 2, qq = r & 3; q8_item(KIN(I_WIN), N_IN, 32 * st, (signed char*)(F.ws + WS_WIN), (float*)(F.ws + MI_CSWIN), 32 * st, scr, F.lane, 4 * qq, 4 * qq + 4); continue; }
        r -= IT_WIN;
        { const int nb = D / 32, kb = r / nb, n0 = 32 * (r % nb); transpose_item(KIN(I_WOUT), D, 64 * kb, n0, WoutT, D, n0, scr, F.lane); }
    }
    const int gt = blockIdx.x * (NWAVES * 64) + F.tid, NGT = F.G * NWAVES * 64;
    for (int i = gt; i < (NZ - N_IN) * D / 16; i += NGT) *(v4u*)(F.ws + WS_WIN + (size_t)N_IN * D + (size_t)i * 16) = (v4u){0u, 0u, 0u, 0u};
    for (int i = gt; i < NZ - N_IN; i += NGT) ((float*)(F.ws + MI_CSWIN))[N_IN + i] = 0.f;
    bf16* WL = (bf16*)(F.ws + WS_WLORA);
    for (int i = gt; i < NL * (KL / 8); i += NGT) {
        const int c8 = i / NL, row = i % NL, blk = row >> 10, n = row & 1023, col = c8 * 8, g = col >> 6;
        const float* src = nullptr; int kofs = 0;
        if (blk < 2) { if (g == blk) { src = KIN(I_WDU) + (size_t)blk * 64 * D; kofs = col - 64 * blk; } }
        else if (blk < 4) { if (g == blk) { src = KIN(I_WIU) + (size_t)(blk - 2) * 64 * D; kofs = col - 64 * blk; } }
        else { if (g >= 4) { src = KIN(I_WGU); kofs = col - 256; } }
        v4u o = {0u, 0u, 0u, 0u};
        if (src) { float v[8];
#pragma unroll
            for (int q = 0; q < 8; ++q) v[q] = src[(size_t)(kofs + q) * D + n];
            o.x = pk2(v[0], v[1]); o.y = pk2(v[2], v[3]); o.z = pk2(v[4], v[5]); o.w = pk2(v[6], v[7]); }
        *(v4u*)(WL + (size_t)row * KL + col) = o;
    }
    bf16* WR = (bf16*)(F.ws + WS_WROUT);
    for (int i = gt; i < 256 * (D / 8); i += NGT) {
        const int row = i % 256, c8 = i / 256; v4u o = {0u, 0u, 0u, 0u};
        if (row < NE) { float v[8];
#pragma unroll
            for (int q = 0; q < 8; ++q) v[q] = KIN(I_WR)[(size_t)(c8 * 8 + q) * NE + row];
            o.x = pk2(v[0], v[1]); o.y = pk2(v[2], v[3]); o.z = pk2(v[4], v[5]); o.w = pk2(v[6], v[7]); }
        *(v4u*)(WR + (size_t)row * D + c8 * 8) = o;
    }
}

__device__ __forceinline__ void phase_hrows(Frame& F) {
    LAS float* LA = (LAS float*)(F.lds);
    LAS float* LB = LA + 3 * D;
    const float* modp = (const float*)(F.ws + WS_MODP);
    for (int i = F.tid; i < 3 * D; i += NWAVES * 64) { const int v = i / D, j = i % D;
        const int jj[2] = {1024 + j, j}; float mv[2]; mod_vals<2>(modp, KIN(I_BADA), v, jj, mv);
        LA[i] = KIN(I_NPM)[j] * (1.0f + mv[0]); LB[i] = mv[1]; }
    __syncthreads();
    signed char* A0q = (signed char*)(F.ws + WS_A0);
    for (int row0 = F.gw; row0 < MT; row0 += 4 * F.NGW) {
        f32x4 v[4][4];
#pragma unroll
        for (int k = 0; k < 4; ++k) { const int row = row0 + k * F.NGW, rc = row < MT ? row : row0;
            const float* xr = rc < ML ? KIN(I_X) + (size_t)rc * D : KIN(I_CTX) + (size_t)(rc - ML) * D;
#pragma unroll
            for (int j = 0; j < 4; ++j) v[k][j] = *(const f32x4*)(xr + 4 * F.lane + 256 * j); }
        __builtin_amdgcn_sched_barrier(0);
#pragma unroll
        for (int k = 0; k < 4; ++k) { const int row = row0 + k * F.NGW;
            if (row < MT) {
                const int vec = row < ML ? row >> 13 : 2;
                float s = 0.f;
#pragma unroll
                for (int j = 0; j < 4; ++j) s += (v[k][j].x * v[k][j].x + v[k][j].y * v[k][j].y) + (v[k][j].z * v[k][j].z + v[k][j].w * v[k][j].w);
                const float rstd = 1.0f / sqrtf(wave_sum(s) * (1.0f / D) + 1e-6f);
                f32x4 hq[4]; float mx = 0.f;
#pragma unroll
                for (int j = 0; j < 4; ++j) { const int c = 4 * F.lane + 256 * j; const f32x4 a = *(const LAS f32x4*)(LA + vec * D + c), b = *(const LAS f32x4*)(LB + vec * D + c);
                    hq[j] = v[k][j] * rstd * a + b; mx = fmaxf(mx, fmaxf(fmaxf(fabsf(hq[j].x), fabsf(hq[j].y)), fmaxf(fabsf(hq[j].z), fabsf(hq[j].w)))); }
                mx = wave_max(mx);
                const float iv = mx > 0.f ? 127.0f / mx : 0.f;
                if (F.lane == 0) ((float*)(F.ws + MI_RSH))[row] = mx * (1.0f / 127.0f);
                unsigned* o4 = (unsigned*)(A0q + (size_t)row * D) + F.lane;
#pragma unroll
                for (int j = 0; j < 4; ++j) o4[64 * j] = pack_q4(hq[j].x * iv, hq[j].y * iv, hq[j].z * iv, hq[j].w * iv);
            } }
    }
}

__device__ __forceinline__ void phase_lora_in(Frame& F) {
    const bf16* z = (const bf16*)(F.ws + WS_Z); bf16* AL = (bf16*)(F.ws + WS_AL);
    const int gt = blockIdx.x * (NWAVES * 64) + F.tid, NGT = F.G * NWAVES * 64;
    for (int i = gt; i < MT * (KL / 4); i += NGT) {
        const int row = i / (KL / 4), q = i % (KL / 4), j0 = 4 * q;
        const int zc = j0 < 256 ? DECAY_OFF + j0 : GLORA_OFF + (j0 - 256);
        float o[4];
        if (j0 >= 256 && row >= ML) { o[0] = o[1] = o[2] = o[3] = 0.f; }
        else {
            const uint2 sv = *(const uint2*)(z + (size_t)row * NZ + zc); const float s[4] = {bflo(sv.x), bfhi(sv.x), bflo(sv.y), bfhi(sv.y)};
#pragma unroll
            for (int j = 0; j < 4; ++j) { const int nr = nbr_row(row, j); float t = 0.f;
                if (nr >= 0) t = bf1(z[(size_t)nr * NZ + zc + j]);
                const float v = s[j] + KIN(I_MU)[zc + j] * (t - s[j]);
                o[j] = j0 < 128 ? tanhf(v) : (j0 < 256 ? v : sigmoidf_(v)); }
        }
        *(uint2*)(AL + (size_t)row * KL + j0) = make_uint2(pk2(o[0], o[1]), pk2(o[2], o[3]));
    }
}


namespace ck {
typedef short bf16x8 __attribute__((ext_vector_type(8)));
constexpr int TILE = 8192;
constexpr int NU_L = BATCH * (T / 64) * NH;
constexpr int NU_ALL = NU_L + BATCH * (TC / 64) * NH;
__device__ __forceinline__ int swz(int row) { return (row ^ (row >> 3)) & 7; }
__device__ __forceinline__ int toff(int row, int col) { return row * 128 + ((col * 2) ^ (swz(row) << 4)); }
__device__ __forceinline__ bf16x8 ldfrag(const LAS unsigned char* t, int row, int chunk) { return *(const LAS bf16x8*)(t + row * 128 + ((chunk ^ swz(row)) << 4)); }
typedef __bf16 bf16v2_t __attribute__((ext_vector_type(2)));
__device__ __forceinline__ unsigned cvtpk(float lo, float hi) { const bf16v2_t v = {(__bf16)lo, (__bf16)hi}; return __builtin_bit_cast(unsigned, v); }
#define CK_MFMA(a, b, c) __builtin_amdgcn_mfma_f32_16x16x32_bf16(a, b, c, 0, 0, 0)
template <bool MASKDIAG>
__device__ __forceinline__ void mm64(f32x4 (&acc)[4], const LAS unsigned char* Lt, const LAS unsigned char* Rt, int wq, int lane) {
    const int lr = lane & 15, g = lane >> 4;
    const bf16x8 l0 = ldfrag(Lt, 16 * wq + lr, g), l1 = ldfrag(Lt, 16 * wq + lr, 4 + g);
#pragma unroll
    for (int n = 0; n < 4; ++n) {
        bf16x8 r0 = ldfrag(Rt, 16 * n + lr, g), r1 = ldfrag(Rt, 16 * n + lr, 4 + g);
        if (MASKDIAG) { const bf16x8 zz = {0, 0, 0, 0, 0, 0, 0, 0}; if ((g >> 1) == n) r0 = zz; if (2 + (g >> 1) == n) r1 = zz; }
        acc[n] = CK_MFMA(l0, r0, acc[n]); acc[n] = CK_MFMA(l1, r1, acc[n]);
    }
}
__device__ __forceinline__ void zero4(f32x4 (&a)[4]) {
#pragma unroll
    for (int n = 0; n < 4; ++n) a[n] = (f32x4){0.f, 0.f, 0.f, 0.f};
}
__device__ __forceinline__ void storeT(LAS unsigned char* t, const f32x4 (&v)[4], int wq, int lane) {
    const int lr = lane & 15, g = lane >> 4;
#pragma unroll
    for (int n = 0; n < 4; ++n) *(LAS v2u*)(t + toff(16 * n + lr, 16 * wq + 4 * g)) = (v2u){cvtpk(v[n][0], v[n][1]), cvtpk(v[n][2], v[n][3])};
}
__device__ __forceinline__ void storeN(LAS unsigned char* t, const f32x4 (&v)[4], int wq, int lane) {
    const int lr = lane & 15, g = lane >> 4;
#pragma unroll
    for (int n = 0; n < 4; ++n)
#pragma unroll
        for (int i = 0; i < 4; ++i) *(LAS unsigned short*)(t + toff(16 * wq + 4 * g + i, 16 * n + lr)) = (unsigned short)f2bf(v[n][i]);
}
__device__ __forceinline__ void loadT(f32x4 (&v)[4], const LAS unsigned char* t, int wq, int lane) {
    const int lr = lane & 15, g = lane >> 4;
#pragma unroll
    for (int n = 0; n < 4; ++n) { const v2u w = *(const LAS v2u*)(t + toff(16 * n + lr, 16 * wq + 4 * g)); v[n] = (f32x4){bflo(w.x), bfhi(w.x), bflo(w.y), bfhi(w.y)}; }
}
__device__ __forceinline__ void unit_decode(int unit, int& b, int& h, int& rowbase) {
    if (unit < NU_L) { h = unit & 15; const int blk = (unit >> 4) & 127; b = unit >> 11; rowbase = b * T + blk * 64; }
    else { const int u = unit - NU_L; h = u & 15; const int cb = (u >> 4) & 3; b = u >> 6; rowbase = ML + b * TC + cb * 64; }
}
__device__ __forceinline__ void pack8(LAS unsigned char* t, int row, int chunk, const float (&v)[8], bool rev) {
    v4u o;
    if (!rev) { o.x = cvtpk(v[0], v[1]); o.y = cvtpk(v[2], v[3]); o.z = cvtpk(v[4], v[5]); o.w = cvtpk(v[6], v[7]); }
    else { o.x = cvtpk(v[7], v[6]); o.y = cvtpk(v[5], v[4]); o.z = cvtpk(v[3], v[2]); o.w = cvtpk(v[1], v[0]); }
    *(LAS v4u*)(t + row * 128 + ((chunk ^ swz(row)) << 4)) = o;
}

__device__ __forceinline__ void unpack8(const v4u p, float (&o)[8]) {
    o[0] = bflo(p.x); o[1] = bfhi(p.x); o[2] = bflo(p.y); o[3] = bfhi(p.y); o[4] = bflo(p.z); o[5] = bfhi(p.z); o[6] = bflo(p.w); o[7] = bfhi(p.w);
}
__device__ __forceinline__ void ld8f(const float* p, float (&o)[8]) {
    const f32x4 a = *(const f32x4*)p, b = *(const f32x4*)(p + 4); o[0] = a.x; o[1] = a.y; o[2] = a.z; o[3] = a.w; o[4] = b.x; o[5] = b.y; o[6] = b.z; o[7] = b.w;
}
__device__ __forceinline__ float fsig(float x) { return __builtin_amdgcn_rcpf(1.0f + __expf(-x)); }
template <bool IS_CO> struct EPre { v4u k[5], v[5], r[IS_CO ? 5 : 1], lo[4]; unsigned msk; };
template <bool IS_CO>
__device__ __forceinline__ void epre_load(EPre<IS_CO>& P, const bf16* z, const bf16* LO, int unit, int wave, int lane) {
    int b, h, rowbase; unit_decode(unit, b, h, rowbase);
    const int row = rowbase + 8 * wave + (lane >> 3), c0 = h * 64 + 8 * (lane & 7);
    const bf16* zr = z + (size_t)row * NZ;
    P.k[0] = *(const v4u*)(zr + K_OFF + c0); P.v[0] = *(const v4u*)(zr + V_OFF + c0); if (IS_CO) P.r[0] = *(const v4u*)(zr + R_OFF + c0);
    unsigned msk = 0u;
#pragma unroll
    for (int j = 0; j < 4; ++j) { const int nr = nbr_row(row, j); const bf16* zn = z + (size_t)(nr >= 0 ? nr : row) * NZ; msk |= (nr >= 0 ? 1u : 0u) << j;
        P.k[1 + j] = *(const v4u*)(zn + K_OFF + c0); P.v[1 + j] = *(const v4u*)(zn + V_OFF + c0);
        if (IS_CO) P.r[1 + j] = *(const v4u*)(zn + R_OFF + c0); }
    P.msk = msk;
    const bf16* lr_ = LO + (size_t)row * NL + c0;
    P.lo[0] = *(const v4u*)(lr_); P.lo[1] = *(const v4u*)(lr_ + 1024); P.lo[2] = *(const v4u*)(lr_ + 2048); P.lo[3] = *(const v4u*)(lr_ + 3072);
}
__device__ __forceinline__ void shift8(const v4u (&q)[5], const float* mu, float (&out)[8], unsigned msk = 15u) {
    const v4u zz = {0u, 0u, 0u, 0u};
    const v4u s = q[0], n0 = (msk & 1u) ? q[1] : zz, n1 = (msk & 2u) ? q[2] : zz, n2 = (msk & 4u) ? q[3] : zz, n3 = (msk & 8u) ? q[4] : zz;
    float m[8]; ld8f(mu, m);
    out[0] = bflo(s.x) + m[0] * (bflo(n0.x) - bflo(s.x)); out[1] = bfhi(s.x) + m[1] * (bfhi(n1.x) - bfhi(s.x));
    out[2] = bflo(s.y) + m[2] * (bflo(n2.y) - bflo(s.y)); out[3] = bfhi(s.y) + m[3] * (bfhi(n3.y) - bfhi(s.y));
    out[4] = bflo(s.z) + m[4] * (bflo(n0.z) - bflo(s.z)); out[5] = bfhi(s.z) + m[5] * (bfhi(n1.z) - bfhi(s.z));
    out[6] = bflo(s.w) + m[6] * (bflo(n2.w) - bflo(s.w)); out[7] = bfhi(s.w) + m[7] * (bfhi(n3.w) - bfhi(s.w));
}
struct EPre2 { v4u k0, v0, r0; v2u kn[4], vn[4], rn[4]; v4u lo[4]; unsigned msk; };
__device__ __forceinline__ void epre2_load(EPre2& P, const bf16* z, const bf16* LO, int unit, int wave, int lane) {
    int b, h, rowbase; unit_decode(unit, b, h, rowbase);
    const int row = rowbase + 8 * wave + (lane >> 3), c0 = h * 64 + 8 * (lane & 7);
    const bf16* zr = z + (size_t)row * NZ;
    P.k0 = *(const v4u*)(zr + K_OFF + c0); P.v0 = *(const v4u*)(zr + V_OFF + c0); P.r0 = *(const v4u*)(zr + R_OFF + c0);
    unsigned msk = 0u;
#pragma unroll
    for (int j = 0; j < 4; ++j) { const int nr = nbr_row(row, j); const unsigned* zn = (const unsigned*)(z + (size_t)(nr >= 0 ? nr : row) * NZ + c0) + (j >> 1); msk |= (nr >= 0 ? 1u : 0u) << j;
        P.kn[j].x = zn[K_OFF / 2]; P.kn[j].y = zn[K_OFF / 2 + 2]; P.vn[j].x = zn[V_OFF / 2]; P.vn[j].y = zn[V_OFF / 2 + 2]; P.rn[j].x = zn[R_OFF / 2]; P.rn[j].y = zn[R_OFF / 2 + 2]; }
    P.msk = msk;
    const bf16* lr_ = LO + (size_t)row * NL + c0;
    P.lo[0] = *(const v4u*)(lr_); P.lo[1] = *(const v4u*)(lr_ + 1024); P.lo[2] = *(const v4u*)(lr_ + 2048); P.lo[3] = *(const v4u*)(lr_ + 3072);
}
__device__ __forceinline__ void shift8n(const v4u s, const v2u (&nb)[4], const float* mu, float (&out)[8], unsigned msk) {
    float m[8]; ld8f(mu, m);
    const float n0a = (msk & 1u) ? bflo(nb[0].x) : 0.f, n0b = (msk & 1u) ? bflo(nb[0].y) : 0.f, n1a = (msk & 2u) ? bfhi(nb[1].x) : 0.f, n1b = (msk & 2u) ? bfhi(nb[1].y) : 0.f;
    const float n2a = (msk & 4u) ? bflo(nb[2].x) : 0.f, n2b = (msk & 4u) ? bflo(nb[2].y) : 0.f, n3a = (msk & 8u) ? bfhi(nb[3].x) : 0.f, n3b = (msk & 8u) ? bfhi(nb[3].y) : 0.f;
    out[0] = bflo(s.x) + m[0] * (n0a - bflo(s.x)); out[1] = bfhi(s.x) + m[1] * (n1a - bfhi(s.x));
    out[2] = bflo(s.y) + m[2] * (n2a - bflo(s.y)); out[3] = bfhi(s.y) + m[3] * (n3a - bfhi(s.y));
    out[4] = bflo(s.z) + m[4] * (n0b - bflo(s.z)); out[5] = bfhi(s.z) + m[5] * (n1b - bfhi(s.z));
    out[6] = bflo(s.w) + m[6] * (n2b - bflo(s.w)); out[7] = bfhi(s.w) + m[7] * (n3b - bfhi(s.w));
}
__device__ __forceinline__ void putN(LAS unsigned char* t, int tau, int oct, const float (&v)[8]) {
    v4u o; o.x = cvtpk(v[0], v[1]); o.y = cvtpk(v[2], v[3]); o.z = cvtpk(v[4], v[5]); o.w = cvtpk(v[6], v[7]);
    *(LAS v4u*)(t + tau * 128 + ((oct ^ swz(tau)) << 4)) = o;
}
__device__ __forceinline__ void putT(LAS unsigned char* t, int tau, int ch0, const float (&v)[8]) {
#pragma unroll
    for (int i = 0; i < 8; ++i) *(LAS unsigned short*)(t + toff(ch0 + i, tau)) = (unsigned short)f2bf(v[i]);
}

template <bool IS_CO, bool STAGES = true>
__device__ __forceinline__ void phase_chunk(Frame& F) {
    const int wave = F.wave;
    const int dgrp = wave >> 2, wq = wave & 3;
    LAS unsigned char* tl = F.lds + dgrp * 9 * TILE;
#define SL(k) (tl + (k) * TILE)
    LAS float* SEG = (LAS float*)(F.lds + LDS_X_OFF);
    LAS float* GAM = SEG + 1024;
    LAS unsigned char* DIB = (LAS unsigned char*)(GAM + 128) + dgrp * 2048;
    LAS float* LW0 = (LAS float*)(F.lds + 7 * TILE);
    LAS float* LW1 = (LAS float*)(F.lds + 16 * TILE);
    const bf16* z = (const bf16*)(F.ws + WS_Z); const bf16* LO = (const bf16*)(F.ws + WS_LORA);
    unsigned char* PQ = F.ws + WS_PQ; unsigned char* TKN = F.ws + WS_TKN; unsigned char* UPRE = F.ws + WS_UPRE; unsigned char* H0T = F.ws + WS_H0T;
    bf16* MG = (bf16*)(F.ws + WS_A0);
    const float* p_mu = KIN(I_MU); const float* p_kk = KIN(I_KK); const float* p_ka = KIN(I_KA);
    const int NU = IS_CO ? NU_L : NU_ALL;
    EPre<IS_CO> PF;
    CvTile cvt; float civ[4] = {0.f, 0.f, 0.f, 0.f}; int cv_t = 0;
    const float* cv_w = KIN(I_WEI);
    LAS float* cv_scr = (LAS float*)(F.lds + wave * 16384);
    if ((int)blockIdx.x < NU) epre_load<IS_CO>(PF, z, LO, (int)blockIdx.x, wave, F.lane);
    for (int unit = blockIdx.x; unit < NU; unit += F.G) {
        int lane = F.lane; asm volatile("" : "+v"(lane));
        const int lr = lane & 15, g = lane >> 4;
        int b, h, rowbase; unit_decode(unit, b, h, rowbase);
        const int tok = 8 * wave + (lane >> 3), oct = lane & 7, ch0 = 8 * oct, c0 = h * 64 + ch0, row = rowbase + tok;
        float ks[8], vs[8], rs[8], kkp[8], lw0[8], lw1[8], kd0[8], kd1[8], a_0[8], a_1[8], ssq;
        {
            shift8(PF.k, p_mu + K_OFF + c0, ks, PF.msk);
            shift8(PF.v, p_mu + V_OFF + c0, vs, PF.msk);
            if (IS_CO) { v4u rr[5];
#pragma unroll
                for (int j = 0; j < 5; ++j) rr[j] = PF.r[IS_CO ? j : 0];
                shift8(rr, p_mu + R_OFF + c0, rs, PF.msk); }
            else {
#pragma unroll
                for (int i = 0; i < 8; ++i) rs[i] = 0.f; }
            float xw0[8], xw1[8], xa0[8], xa1[8];
            unpack8(PF.lo[0], xw0); unpack8(PF.lo[1], xw1); unpack8(PF.lo[2], xa0); unpack8(PF.lo[3], xa1);
            float kkk[8], kaa[8];
            ld8f(p_kk + c0, kkk); ld8f(p_ka + c0, kaa);
            float ss = 0.f;
#pragma unroll
            for (int i = 0; i < 8; ++i) {
                kkp[i] = ks[i] * kkk[i]; ss += kkp[i] * kkp[i];
                lw0[i] = xw0[i]; lw1[i] = xw1[i];
                a_0[i] = xa0[i]; a_1[i] = xa1[i];
                kd0[i] = ks[i] * (1.0f + (a_0[i] - 1.0f) * kaa[i]); kd1[i] = ks[i] * (1.0f + (a_1[i] - 1.0f) * kaa[i]);
                const int ch = ch0 + i, sw = tok ^ (4 * ((ch & 15) ^ (2 * (ch >> 4))));
                LW0[ch * 64 + sw] = lw0[i]; LW1[ch * 64 + sw] = lw1[i];
            }
            ss += __shfl_xor(ss, 1); ss += __shfl_xor(ss, 2); ss += __shfl_xor(ss, 4);
            ssq = ss;
        }
        __syncthreads();
        {
            const int ch2 = lane, seg = wave, sw = 4 * ((ch2 & 15) ^ (2 * (ch2 >> 4)));
            LAS f32x4* p0a = (LAS f32x4*)(LW0 + ch2 * 64 + ((8 * seg) ^ sw)); LAS f32x4* p0b = (LAS f32x4*)(LW0 + ch2 * 64 + ((8 * seg + 4) ^ sw));
            LAS f32x4* p1a = (LAS f32x4*)(LW1 + ch2 * 64 + ((8 * seg) ^ sw)); LAS f32x4* p1b = (LAS f32x4*)(LW1 + ch2 * 64 + ((8 * seg + 4) ^ sw));
            f32x4 a = *p0a, bq = *p0b, c = *p1a, d = *p1b;
            a.y += a.x; a.z += a.y; a.w += a.z; bq.x += a.w; bq.y += bq.x; bq.z += bq.y; bq.w += bq.z;
            d.z += d.w; d.y += d.z; d.x += d.y; c.w += d.x; c.z += c.w; c.y += c.z; c.x += c.y;
            SEG[seg * 64 + ch2] = bq.w; SEG[(8 + seg) * 64 + ch2] = c.x;
            __syncthreads();
            float off0 = 0.f, off1 = 0.f;
#pragma unroll
            for (int s2 = 0; s2 < 8; ++s2) { const float t0 = SEG[s2 * 64 + ch2], t1 = SEG[(8 + s2) * 64 + ch2]; off0 += (s2 < seg) ? t0 : 0.f; off1 += (s2 > seg) ? t1 : 0.f; }
            *p0a = a + off0; *p0b = bq + off0; *p1a = c + off1; *p1b = d + off1;
        }
        __syncthreads();
        {
            const float inv = 1.0f / fmaxf(sqrtf(ssq), 1e-12f);
            float t8[8], u8[8], w8[8];
            {
                LAS unsigned char* t0 = F.lds; const int tau = tok;
                float e1[8], ei[8];
#pragma unroll
                for (int i = 0; i < 8; ++i) { const int ch = ch0 + i; const float cm = LW0[ch * 64 + (tok ^ (4 * ((ch & 15) ^ (2 * (ch >> 4)))))]; e1[i] = __expf(cm); ei[i] = __builtin_amdgcn_rcpf(e1[i]); t8[i] = kkp[i] * inv * __expf(cm - lw0[i]); }
                if (tok == 63) {
#pragma unroll
                    for (int i = 0; i < 8; ++i) GAM[ch0 + i] = e1[i]; }
#pragma unroll
                for (int i = 0; i < 8; ++i) { u8[i] = kkp[i] * inv * a_0[i] * ei[i]; w8[i] = kd0[i] * ei[i]; }
                if (!IS_CO) { putN(t0 + 0 * TILE, tau, oct, t8); putT(t0 + 1 * TILE, tau, ch0, t8); putN(t0 + 2 * TILE, tau, oct, u8); putT(t0 + 3 * TILE, tau, ch0, u8);
                    putN(t0 + 4 * TILE, tau, oct, w8); putT(t0 + 5 * TILE, tau, ch0, w8); putT(t0 + 6 * TILE, tau, ch0, vs); }
                else {
#pragma unroll
                    for (int i = 0; i < 8; ++i) t8[i] = rs[i] * e1[i];
                    putN(t0 + 0 * TILE, tau, oct, w8); putN(t0 + 1 * TILE, tau, oct, u8); putN(t0 + 2 * TILE, tau, oct, t8); putT(t0 + 3 * TILE, tau, ch0, vs); }
            }
            {
                LAS unsigned char* t1 = F.lds + 9 * TILE; const int tau = 63 - tok;
                float e1[8], ei[8];
#pragma unroll
                for (int i = 0; i < 8; ++i) { const int ch = ch0 + i; const float cm = LW1[ch * 64 + (tok ^ (4 * ((ch & 15) ^ (2 * (ch >> 4)))))]; e1[i] = __expf(cm); ei[i] = __builtin_amdgcn_rcpf(e1[i]); t8[i] = kkp[i] * inv * __expf(cm - lw1[i]); }
                if (tok == 0) {
#pragma unroll
                    for (int i = 0; i < 8; ++i) GAM[64 + ch0 + i] = e1[i]; }
#pragma unroll
                for (int i = 0; i < 8; ++i) { u8[i] = kkp[i] * inv * a_1[i] * ei[i]; w8[i] = kd1[i] * ei[i]; }
                if (!IS_CO) { putN(t1 + 0 * TILE, tau, oct, t8); putT(t1 + 1 * TILE, tau, ch0, t8); putN(t1 + 2 * TILE, tau, oct, u8); putT(t1 + 3 * TILE, tau, ch0, u8);
                    putN(t1 + 4 * TILE, tau, oct, w8); putT(t1 + 5 * TILE, tau, ch0, w8); putT(t1 + 6 * TILE, tau, ch0, vs); }
                else {
#pragma unroll
                    for (int i = 0; i < 8; ++i) t8[i] = rs[i] * e1[i];
                    putN(t1 + 0 * TILE, tau, oct, w8); putN(t1 + 1 * TILE, tau, oct, u8); putN(t1 + 2 * TILE, tau, oct, t8); putT(t1 + 3 * TILE, tau, ch0, vs); }
            }
        }
        if (!STAGES) { __syncthreads(); continue; }
        const size_t inst = (size_t)unit * 2 + dgrp;
        const int t2 = (wq << 6) | lane;
        if (IS_CO) {
#pragma unroll
            for (int rep = 0; rep < 2; ++rep) { const int cidx = t2 + 256 * rep, row = cidx >> 3, ch = cidx & 7;
                const v4u a = *(const v4u*)(TKN + inst * 8192 + (size_t)(row * 64 + ch * 8) * 2), hh = *(const v4u*)(H0T + inst * 8192 + (size_t)(row * 64 + ch * 8) * 2);
                *(LAS v4u*)(SL(4) + row * 128 + ((ch ^ swz(row)) << 4)) = a; *(LAS v4u*)(SL(5) + row * 128 + ((ch ^ swz(row)) << 4)) = hh; }
        }
        v4u upre0 = {0u, 0u, 0u, 0u}, upre1 = upre0;
        if (IS_CO) { const unsigned char* up = UPRE + inst * 8192 + (size_t)((wq * 64 + lane) * 32); upre0 = *(const v4u*)up; upre1 = *(const v4u*)(up + 16); }
        if (unit + F.G < NU) epre_load<IS_CO>(PF, z, LO, unit + F.G, wave, lane);
        const int cv_strip = F.gw + (cv_t >> 4) * F.NGW, cv_kb = cv_t & 15;
        if (!IS_CO && cv_strip < NE * 64) { int e_, n0_, rb_; wei_strip(cv_strip, e_, n0_, rb_); cv_load(cvt, cv_w + (size_t)e_ * D * 2048, 2048, n0_, cv_kb, lane); }
        __syncthreads();
        f32x4 acc[4], acc2[4];
        if (!IS_CO) {
            zero4(acc); mm64<false>(acc, SL(2), SL(0), wq, lane);
            zero4(acc2); mm64<false>(acc2, SL(4), SL(0), wq, lane);
#pragma unroll
            for (int n = 0; n < 4; ++n)
#pragma unroll
                for (int q = 0; q < 4; ++q) { const bool lo = (16 * wq + 4 * g + q < 16 * n + lr); acc[n][q] = lo ? acc[n][q] : 0.f; acc2[n][q] = lo ? acc2[n][q] : 0.f; }
            storeT(SL(7), acc, wq, lane); storeT(SL(8), acc2, wq, lane);
            __syncthreads();
            zero4(acc); mm64<false>(acc, SL(8), SL(6), wq, lane); storeT(SL(0), acc, wq, lane);
            if (wq == 0) {
                const int bb = lane >> 4, jj = lane & 15;
                float X[16];
                X[0] = (jj == 0) ? 1.f : 0.f;
#pragma unroll
                for (int t = 1; t < 16; ++t) {
                    const int row = 16 * bb + t;
                    const v4u p0 = *(const LAS v4u*)(SL(7) + row * 128 + (((2 * bb) ^ swz(row)) << 4)), p1 = *(const LAS v4u*)(SL(7) + row * 128 + (((2 * bb + 1) ^ swz(row)) << 4));
                    float rw[16];
                    rw[0] = bflo(p0.x); rw[1] = bfhi(p0.x); rw[2] = bflo(p0.y); rw[3] = bfhi(p0.y); rw[4] = bflo(p0.z); rw[5] = bfhi(p0.z); rw[6] = bflo(p0.w); rw[7] = bfhi(p0.w);
                    rw[8] = bflo(p1.x); rw[9] = bfhi(p1.x); rw[10] = bflo(p1.y); rw[11] = bfhi(p1.y); rw[12] = bflo(p1.z); rw[13] = bfhi(p1.z); rw[14] = bflo(p1.w); rw[15] = bfhi(p1.w);
                    float xv = (t == jj) ? 1.f : 0.f;
#pragma unroll
                    for (int s = 0; s < t; ++s) xv -= rw[s] * X[s];
                    X[t] = xv;
                }
#pragma unroll
                for (int t = 0; t < 16; ++t) *(LAS unsigned short*)(DIB + (((bb * 16 + t) * 16 + jj) << 1)) = (unsigned short)f2bf(X[t]);
            }
            __syncthreads();
            {
                const bool isU = wq >= 2; const int cbase = 32 * (wq & 1);
                const LAS unsigned char* Rt = isU ? SL(0) : SL(1);
                LAS unsigned char* outT = isU ? SL(4) : SL(2);
#pragma unroll
                for (int ct = 0; ct < 2; ++ct) {
                    const int col = cbase + 16 * ct + lr;
                    f32x4 X[4];
#pragma unroll
                    for (int b = 0; b < 4; ++b) {
                        const v2u rwv = *(const LAS v2u*)(Rt + toff(col, 16 * b + 4 * g));
                        f32x4 Zt = {bflo(rwv.x), bfhi(rwv.x), bflo(rwv.y), bfhi(rwv.y)};
                        if (b >= 1) {
                            f32x4 Y = {0.f, 0.f, 0.f, 0.f};
#pragma unroll
                            for (int s = 0; s < (b + 1) / 2; ++s) {
                                v2u alo = {0u, 0u}, ahi = {0u, 0u};
                                if (2 * s < b) alo = *(const LAS v2u*)(SL(7) + toff(16 * b + lr, 32 * s + 4 * g));
                                if (2 * s + 1 < b) ahi = *(const LAS v2u*)(SL(7) + toff(16 * b + lr, 32 * s + 16 + 4 * g));
                                v4u bw = {cvtpk(X[2 * s][0], X[2 * s][1]), cvtpk(X[2 * s][2], X[2 * s][3]), 0u, 0u};
                                if (2 * s + 1 < b) { bw.z = cvtpk(X[2 * s + 1][0], X[2 * s + 1][1]); bw.w = cvtpk(X[2 * s + 1][2], X[2 * s + 1][3]); }
                                Y = CK_MFMA(__builtin_bit_cast(bf16x8, ((v4u){alo.x, alo.y, ahi.x, ahi.y})), __builtin_bit_cast(bf16x8, bw), Y);
                            }
                            Zt = Zt - Y;
                        }
                        const v2u dv = *(const LAS v2u*)(DIB + (((b * 16 + lr) * 16 + 4 * g) << 1));
                        const v4u bz = {cvtpk(Zt[0], Zt[1]), cvtpk(Zt[2], Zt[3]), 0u, 0u};
                        X[b] = CK_MFMA(__builtin_bit_cast(bf16x8, ((v4u){dv.x, dv.y, 0u, 0u})), __builtin_bit_cast(bf16x8, bz), ((f32x4){0.f, 0.f, 0.f, 0.f}));
                    }
#pragma unroll
                    for (int b = 0; b < 4; ++b) {
                        const v2u pk = {cvtpk(X[b][0], X[b][1]), cvtpk(X[b][2], X[b][3])};
                        *(LAS v2u*)(outT + toff(col, 16 * b + 4 * g)) = pk;
                        if (!isU) {
#pragma unroll
                            for (int q = 0; q < 4; ++q) *(LAS unsigned short*)(SL(8) + toff(16 * b + 4 * g + q, col)) = (unsigned short)f2bf(X[b][q]);
                        } else {
                            *(uint2*)(UPRE + inst * 8192 + (size_t)(((b * 64 + lane) * 4 + 2 * (wq & 1) + ct) * 8)) = make_uint2(pk.x, pk.y);
                        }
                    }
                }
            }
            __syncthreads();
            { zero4(acc); mm64<false>(acc, SL(2), SL(3), wq, lane);
              const int cstep_ = unit < NU_L ? 4 + (dgrp ? 127 - ((unit >> 4) & 127) : ((unit >> 4) & 127)) : (dgrp ? 3 - (((unit - NU_L) >> 4) & 3) : (((unit - NU_L) >> 4) & 3));
              unsigned char* pb = PQ + (size_t)(((b * 16 + h) * 2 + dgrp) * (4 + T / 64) + cstep_) * 16384;
#pragma unroll
              for (int n = 0; n < 4; ++n) { const int k = 16 * n + lr; const float gm = GAM[dgrp * 64 + k]; float p[4];
#pragma unroll
                  for (int q = 0; q < 4; ++q) p[q] = gm * (((16 * wq + 4 * g + q) == k ? 1.f : 0.f) - acc[n][q]);
                  *(uint2*)(pb + (size_t)(((n * 2 + (wq >> 1)) * 64 + lane) * 16 + (wq & 1) * 8)) = make_uint2(cvtpk(p[0], p[1]), cvtpk(p[2], p[3])); }
              zero4(acc); mm64<false>(acc, SL(5), SL(6), wq, lane); zero4(acc2); mm64<false>(acc2, SL(3), SL(4), wq, lane);
              const f32x4 gm4 = *(const LAS f32x4*)(GAM + dgrp * 64 + 16 * wq + 4 * g);
#pragma unroll
              for (int n = 0; n < 4; ++n) { const f32x4 qv = (acc[n] - acc2[n]) * gm4;
                  *(uint2*)(pb + 8192 + (size_t)(((n * 64 + lane) * 4 + wq) * 8)) = make_uint2(cvtpk(qv[0], qv[1]), cvtpk(qv[2], qv[3])); }
#pragma unroll
              for (int rep = 0; rep < 2; ++rep) { const int cidx = t2 + 256 * rep, row = cidx >> 3, ch = cidx & 7;
                  *(v4u*)(TKN + inst * 8192 + (size_t)(row * 64 + ch * 8) * 2) = *(const LAS v4u*)(SL(8) + row * 128 + ((ch ^ swz(row)) << 4)); }
            }
        } else {
            zero4(acc); mm64<false>(acc, SL(0), SL(2), wq, lane);
#pragma unroll
            for (int n = 0; n < 4; ++n)
#pragma unroll
                for (int q = 0; q < 4; ++q) acc[n][q] = (16 * wq + 4 * g + q <= 16 * n + lr) ? acc[n][q] : 0.f;
            storeT(SL(6), acc, wq, lane);
            zero4(acc); mm64<false>(acc, SL(1), SL(2), wq, lane);
#pragma unroll
            for (int n = 0; n < 4; ++n)
#pragma unroll
                for (int q = 0; q < 4; ++q) acc[n][q] = (16 * wq + 4 * g + q <= 16 * n + lr) ? -acc[n][q] : 0.f;
            storeT(SL(7), acc, wq, lane);
            { const v4u o0 = upre0, o1 = upre1;
              acc[0] = (f32x4){bflo(o0.x), bfhi(o0.x), bflo(o0.y), bfhi(o0.y)}; acc[1] = (f32x4){bflo(o0.z), bfhi(o0.z), bflo(o0.w), bfhi(o0.w)};
              acc[2] = (f32x4){bflo(o1.x), bfhi(o1.x), bflo(o1.y), bfhi(o1.y)}; acc[3] = (f32x4){bflo(o1.z), bfhi(o1.z), bflo(o1.w), bfhi(o1.w)}; }
            mm64<false>(acc, SL(4), SL(5), wq, lane);
            storeT(SL(8), acc, wq, lane);
            __syncthreads();
            zero4(acc); mm64<false>(acc, SL(2), SL(5), wq, lane); mm64<false>(acc, SL(6), SL(3), wq, lane); mm64<false>(acc, SL(7), SL(8), wq, lane);
            __syncthreads();
            { LAS float* Yf = (LAS float*)(tl);
#pragma unroll
              for (int n = 0; n < 4; ++n)
#pragma unroll
                  for (int q = 0; q < 4; ++q) { const int tau = 16 * wq + 4 * g + q; Yf[tau * 64 + ((16 * n + lr) ^ (4 * (tau & 15)))] = acc[n][q]; } }
            __syncthreads();
            { const LAS float* Y0 = (const LAS float*)(F.lds); const LAS float* Y1 = (const LAS float*)(F.lds + 9 * TILE);
              const int t = row & (T - 1);
              const bf16* zr = z + (size_t)row * NZ;
              const v4u zz = {0u, 0u, 0u, 0u};
              const v4u q_g = *(const v4u*)(LO + (size_t)row * NL + 4096 + c0);
              const v4u q_gb = *(const v4u*)(zr + CONV_OFF + c0), q_c0 = *(const v4u*)(zr + CONV_OFF + 1024 + c0), q_x0 = *(const v4u*)(zr + CONV_OFF + 2048 + c0);
              const v4u q_cm = t > 0 ? *(const v4u*)(zr - NZ + CONV_OFF + 1024 + c0) : zz, q_xm = t > 0 ? *(const v4u*)(zr - NZ + CONV_OFF + 2048 + c0) : zz;
              const v4u q_cp = t < T - 1 ? *(const v4u*)(zr + NZ + CONV_OFF + 1024 + c0) : zz, q_xp = t < T - 1 ? *(const v4u*)(zr + NZ + CONV_OFF + 2048 + c0) : zz;
              const v4u q_ga = *(const v4u*)(zr + GATE_OFF + c0), q_gr = *(const v4u*)(zr + GATE_OFF + 1024 + c0);
              float y[8];
              { const int s0 = 4 * (tok & 15), s1 = 4 * ((63 - tok) & 15);
                const f32x4 a0 = *(const LAS f32x4*)(Y0 + tok * 64 + (ch0 ^ s0)), a1 = *(const LAS f32x4*)(Y0 + tok * 64 + ((ch0 + 4) ^ s0));
                const f32x4 b0 = *(const LAS f32x4*)(Y1 + (63 - tok) * 64 + (ch0 ^ s1)), b1 = *(const LAS f32x4*)(Y1 + (63 - tok) * 64 + ((ch0 + 4) ^ s1));
                y[0] = a0.x + b0.x; y[1] = a0.y + b0.y; y[2] = a0.z + b0.z; y[3] = a0.w + b0.w; y[4] = a1.x + b1.x; y[5] = a1.y + b1.y; y[6] = a1.z + b1.z; y[7] = a1.w + b1.w; }
              float rk[8]; ld8f(KIN(I_RK) + c0, rk);
              float s1 = 0.f, s2 = 0.f, s3 = 0.f;
#pragma unroll
              for (int i = 0; i < 8; ++i) { s1 += y[i]; s2 += y[i] * y[i]; s3 += rs[i] * 0.5f * (kd0[i] + kd1[i]) * rk[i]; }
              s1 += __shfl_xor(s1, 1); s2 += __shfl_xor(s2, 1); s3 += __shfl_xor(s3, 1); s1 += __shfl_xor(s1, 2); s2 += __shfl_xor(s2, 2); s3 += __shfl_xor(s3, 2);
              s1 += __shfl_xor(s1, 4); s2 += __shfl_xor(s2, 4); s3 += __shfl_xor(s3, 4);
              const float S1 = s1, S2 = s2, S3 = s3;
              const float mean = S1 * (1.0f / 64.0f), var = fmaxf(S2 * (1.0f / 64.0f) - mean * mean, 0.f), rstd = __builtin_amdgcn_rsqf(var + 64e-5f);
              float lnw[8], lnb[8], cw0[8], cw1[8], cw2[8];
              ld8f(KIN(I_LNW) + c0, lnw); ld8f(KIN(I_LNB) + c0, lnb); ld8f(KIN(I_CONVW) + c0, cw0); ld8f(KIN(I_CONVW) + D + c0, cw1); ld8f(KIN(I_CONVW) + 2 * D + c0, cw2);
              float gg[8], gb[8], cc[8], xx[8], cm[8], xm[8], cp[8], xp[8], ga[8], gr[8];
              unpack8(q_g, gg); unpack8(q_gb, gb); unpack8(q_c0, cc); unpack8(q_x0, xx); unpack8(q_cm, cm); unpack8(q_xm, xm); unpack8(q_cp, cp); unpack8(q_xp, xp); unpack8(q_ga, ga); unpack8(q_gr, gr);
              float o[8];
#pragma unroll
              for (int i = 0; i < 8; ++i) {
                  const float yn = (y[i] - mean) * rstd * lnw[i] + lnb[i];
                  const float yr = (yn + S3 * vs[i]) * gg[i];
                  const float yc = gb[i] * (cw0[i] * (cm[i] * xm[i]) + cw1[i] * (cc[i] * xx[i]) + cw2[i] * (cp[i] * xp[i]));
                  o[i] = fsig(ga[i]) * yr + fsig(gr[i]) * yc;
              }
              v4u ov; ov.x = cvtpk(o[0], o[1]); ov.y = cvtpk(o[2], o[3]); ov.z = cvtpk(o[4], o[5]); ov.w = cvtpk(o[6], o[7]);
              *(v4u*)(MG + (size_t)row * D + c0) = ov;
            }
        }
        __syncthreads();
        if (!IS_CO) {
            if (cv_strip < NE * 64) { int e_, n0_, rb_; wei_strip(cv_strip, e_, n0_, rb_);
                if (cv_kb == 0) cv_scale_q8(cv_w + (size_t)e_ * D * 2048, 2048, n0_, (float*)(F.ws + MI_CSWEI) + (size_t)e_ * 2048, rb_, lane, civ);
                cv_store_q8(cvt, cv_scr, (signed char*)(F.ws + WS_WEIN) + (size_t)e_ * 2048 * D, rb_, cv_kb, civ, lane); }
            ++cv_t;
            __syncthreads();
        }
    }
    if (!IS_CO) {
        for (;;) { const int s_ = F.gw + (cv_t >> 4) * F.NGW, kb_ = cv_t & 15; if (s_ >= NE * 64) break;
            int e_, n0_, rb_; wei_strip(s_, e_, n0_, rb_);
            if (kb_ == 0) cv_scale_q8(cv_w + (size_t)e_ * D * 2048, 2048, n0_, (float*)(F.ws + MI_CSWEI) + (size_t)e_ * 2048, rb_, F.lane, civ);
            cv_load(cvt, cv_w + (size_t)e_ * D * 2048, 2048, n0_, kb_, F.lane);
            cv_store_q8(cvt, cv_scr, (signed char*)(F.ws + WS_WEIN) + (size_t)e_ * 2048 * D, rb_, kb_, civ, F.lane); ++cv_t; }
    }
#undef SL
}

typedef short s16x4 __attribute__((ext_vector_type(4)));
__device__ __forceinline__ bf16x8 ldfragT(const LAS unsigned char* t, int c, int ks, int lane) {
    const int g = lane >> 4, q = (lane & 15) >> 2, p = lane & 3;
    const int r0 = 32 * ks + 8 * g + q, r1 = r0 + 4;
    const s16x4 a = __builtin_amdgcn_ds_read_tr16_b64_v4i16((LAS s16x4*)(t + r0 * 128 + (((2 * c + (p >> 1)) ^ swz(r0)) << 4) + 8 * (p & 1)));
    const s16x4 b = __builtin_amdgcn_ds_read_tr16_b64_v4i16((LAS s16x4*)(t + r1 * 128 + (((2 * c + (p >> 1)) ^ swz(r1)) << 4) + 8 * (p & 1)));
    return (bf16x8){a[0], a[1], a[2], a[3], b[0], b[1], b[2], b[3]};
}
__device__ __forceinline__ f32x4 loadN_acc(const LAS unsigned char* t, int b, int ct, int lane) {
    const int g = lane >> 4, q = (lane & 15) >> 2, p = lane & 3;
    const int r0 = 16 * b + 4 * g + q;
    const s16x4 a = __builtin_amdgcn_ds_read_tr16_b64_v4i16((LAS s16x4*)(t + r0 * 128 + (((2 * ct + (p >> 1)) ^ swz(r0)) << 4) + 8 * (p & 1)));
    return (f32x4){bf1((bf16)a[0]), bf1((bf16)a[1]), bf1((bf16)a[2]), bf1((bf16)a[3])};
}
template <bool LT, bool RT>
__device__ __forceinline__ void mm64x(f32x4 (&acc)[4], const LAS unsigned char* Lt, const LAS unsigned char* Rt, int wq, int lane) {
    const int lr = lane & 15, g = lane >> 4;
    const bf16x8 l0 = LT ? ldfragT(Lt, wq, 0, lane) : ldfrag(Lt, 16 * wq + lr, g), l1 = LT ? ldfragT(Lt, wq, 1, lane) : ldfrag(Lt, 16 * wq + lr, 4 + g);
#pragma unroll
    for (int n = 0; n < 4; ++n) {
        const bf16x8 r0 = RT ? ldfragT(Rt, n, 0, lane) : ldfrag(Rt, 16 * n + lr, g), r1 = RT ? ldfragT(Rt, n, 1, lane) : ldfrag(Rt, 16 * n + lr, 4 + g);
        acc[n] = CK_MFMA(l0, r0, acc[n]); acc[n] = CK_MFMA(l1, r1, acc[n]);
    }
}

__device__ __forceinline__ void phase_cp2(Frame& F) {
    const int wave = F.wave;
    const int dgrp = wave >> 2, wq = wave & 3;
    LAS unsigned char* tl = F.lds + dgrp * 9 * TILE;
#define SL(k) (tl + (k) * TILE)
    LAS float* SEG = (LAS float*)(F.lds + LDS_X_OFF);
    LAS float* GAM = SEG + 1024;
    LAS unsigned char* DIB = (LAS unsigned char*)(GAM + 128) + dgrp * 2048;
    LAS float* LW0 = (LAS float*)(F.lds + 7 * TILE);
    LAS float* LW1 = (LAS float*)(F.lds + 16 * TILE);
    const bf16* z = (const bf16*)(F.ws + WS_Z); const bf16* LO = (const bf16*)(F.ws + WS_LORA);
    unsigned char* PQ = F.ws + WS_PQ; unsigned char* RHAT = F.ws + WS_TKN; unsigned char* YLOC = F.ws + WS_UPRE;
    float* BON = (float*)(F.ws + MI_BON);
    const float* p_mu = KIN(I_MU); const float* p_kk = KIN(I_KK); const float* p_ka = KIN(I_KA); const float* p_rk = KIN(I_RK);
    constexpr int NU = NU_ALL;
    EPre<true> PF;
    CvTile cvt; float civ[4] = {0.f, 0.f, 0.f, 0.f}; int cv_t = 0;
    const float* cv_w = KIN(I_WEI);
    LAS float* cv_scr = (LAS float*)(F.lds + wave * 16384);
    if ((int)blockIdx.x < NU) epre_load<true>(PF, z, LO, (int)blockIdx.x, wave, F.lane);
    if (F.gw < NE * 64) { int e_, n0_, rb_; wei_strip(F.gw, e_, n0_, rb_);
        cv_scale_q8(cv_w + (size_t)e_ * D * 2048, 2048, n0_, (float*)(F.ws + MI_CSWEI) + (size_t)e_ * 2048, rb_, F.lane, civ); }
    for (int unit = blockIdx.x; unit < NU; unit += F.G) {
        int lane = F.lane; asm volatile("" : "+v"(lane));
        const int lr = lane & 15, g = lane >> 4;
        int b, h, rowbase; unit_decode(unit, b, h, rowbase);
        const int tok = 8 * wave + (lane >> 3), oct = lane & 7, ch0 = 8 * oct, c0 = h * 64 + ch0;
        float ks[8], vs[8], rs[8], kkp[8], lw0[8], lw1[8], kd0[8], kd1[8], a_0[8], a_1[8], ssq;
        {
            shift8(PF.k, p_mu + K_OFF + c0, ks, PF.msk); shift8(PF.v, p_mu + V_OFF + c0, vs, PF.msk); shift8(PF.r, p_mu + R_OFF + c0, rs, PF.msk);
            float kkk[8], kaa[8], rkk[8];
            unpack8(PF.lo[0], lw0); unpack8(PF.lo[1], lw1); unpack8(PF.lo[2], a_0); unpack8(PF.lo[3], a_1);
            ld8f(p_kk + c0, kkk); ld8f(p_ka + c0, kaa); ld8f(p_rk + c0, rkk);
            float ss = 0.f, bs = 0.f;
#pragma unroll
            for (int i = 0; i < 8; ++i) {
                kkp[i] = ks[i] * kkk[i]; ss += kkp[i] * kkp[i];
                kd0[i] = ks[i] * (1.0f + (a_0[i] - 1.0f) * kaa[i]); kd1[i] = ks[i] * (1.0f + (a_1[i] - 1.0f) * kaa[i]);
                bs += rs[i] * 0.5f * (kd0[i] + kd1[i]) * rkk[i];
                const int ch = ch0 + i, sw = tok ^ (4 * ((ch & 15) ^ (2 * (ch >> 4))));
                LW0[ch * 64 + sw] = lw0[i]; LW1[ch * 64 + sw] = lw1[i];
            }
            ss += __shfl_xor(ss, 1); bs += __shfl_xor(bs, 1); ss += __shfl_xor(ss, 2); bs += __shfl_xor(bs, 2); ss += __shfl_xor(ss, 4); bs += __shfl_xor(bs, 4);
            ssq = ss;
            if (oct == 0 && unit < NU_L) BON[(size_t)unit * 64 + tok] = bs;
        }
        __syncthreads();
        {
            const int ch2 = lane, seg = wave, sw = 4 * ((ch2 & 15) ^ (2 * (ch2 >> 4)));
            LAS f32x4* p0a = (LAS f32x4*)(LW0 + ch2 * 64 + ((8 * seg) ^ sw)); LAS f32x4* p0b = (LAS f32x4*)(LW0 + ch2 * 64 + ((8 * seg + 4) ^ sw));
            LAS f32x4* p1a = (LAS f32x4*)(LW1 + ch2 * 64 + ((8 * seg) ^ sw)); LAS f32x4* p1b = (LAS f32x4*)(LW1 + ch2 * 64 + ((8 * seg + 4) ^ sw));
            f32x4 a = *p0a, bq = *p0b, c = *p1a, d = *p1b;
            a.y += a.x; a.z += a.y; a.w += a.z; bq.x += a.w; bq.y += bq.x; bq.z += bq.y; bq.w += bq.z;
            d.z += d.w; d.y += d.z; d.x += d.y; c.w += d.x; c.z += c.w; c.y += c.z; c.x += c.y;
            SEG[seg * 64 + ch2] = bq.w; SEG[(8 + seg) * 64 + ch2] = c.x;
            __syncthreads();
            float off0 = 0.f, off1 = 0.f;
#pragma unroll
            for (int s2 = 0; s2 < 8; ++s2) { const float t0 = SEG[s2 * 64 + ch2], t1 = SEG[(8 + s2) * 64 + ch2]; off0 += (s2 < seg) ? t0 : 0.f; off1 += (s2 > seg) ? t1 : 0.f; }
            *p0a = a + off0; *p0b = bq + off0; *p1a = c + off1; *p1b = d + off1;
        }
        __syncthreads();
        {
            const float inv = 1.0f / fmaxf(sqrtf(ssq), 1e-12f);
            float t8[8], u8[8], w8[8], r8v[8];
            {
                LAS unsigned char* t0 = F.lds; const int tau = tok;
                float e1[8], ei[8];
#pragma unroll
                for (int i = 0; i < 8; ++i) { const int ch = ch0 + i; const float cm = LW0[ch * 64 + (tok ^ (4 * ((ch & 15) ^ (2 * (ch >> 4)))))]; e1[i] = __expf(cm); ei[i] = __builtin_amdgcn_rcpf(e1[i]); t8[i] = kkp[i] * inv * __expf(cm - lw0[i]); }
                if (tok == 63) {
#pragma unroll
                    for (int i = 0; i < 8; ++i) GAM[ch0 + i] = e1[i]; }
#pragma unroll
                for (int i = 0; i < 8; ++i) { u8[i] = kkp[i] * inv * a_0[i] * ei[i]; w8[i] = kd0[i] * ei[i]; r8v[i] = rs[i] * e1[i]; }
                putN(t0 + 0 * TILE, tau, oct, t8); putN(t0 + 1 * TILE, tau, oct, u8); putN(t0 + 2 * TILE, tau, oct, w8); putN(t0 + 3 * TILE, tau, oct, vs); putN(t0 + 4 * TILE, tau, oct, r8v);
            }
            {
                LAS unsigned char* t1 = F.lds + 9 * TILE; const int tau = 63 - tok;
                float e1[8], ei[8];
#pragma unroll
                for (int i = 0; i < 8; ++i) { const int ch = ch0 + i; const float cm = LW1[ch * 64 + (tok ^ (4 * ((ch & 15) ^ (2 * (ch >> 4)))))]; e1[i] = __expf(cm); ei[i] = __builtin_amdgcn_rcpf(e1[i]); t8[i] = kkp[i] * inv * __expf(cm - lw1[i]); }
                if (tok == 0) {
#pragma unroll
                    for (int i = 0; i < 8; ++i) GAM[64 + ch0 + i] = e1[i]; }
#pragma unroll
                for (int i = 0; i < 8; ++i) { u8[i] = kkp[i] * inv * a_1[i] * ei[i]; w8[i] = kd1[i] * ei[i]; r8v[i] = rs[i] * e1[i]; }
                putN(t1 + 0 * TILE, tau, oct, t8); putN(t1 + 1 * TILE, tau, oct, u8); putN(t1 + 2 * TILE, tau, oct, w8); putN(t1 + 3 * TILE, tau, oct, vs); putN(t1 + 4 * TILE, tau, oct, r8v);
            }
        }
        const size_t inst = (size_t)unit * 2 + dgrp;
        epre_load<true>(PF, z, LO, unit + F.G < NU ? unit + F.G : unit, wave, lane);
        const int cv_strip = F.gw + (cv_t >> 4) * F.NGW, cv_kb = cv_t & 15;
        { int e_, n0_, rb_; wei_strip(cv_strip < NE * 64 ? cv_strip : 0, e_, n0_, rb_); cv_load(cvt, cv_w + (size_t)e_ * D * 2048, 2048, n0_, cv_kb, lane); }
        __syncthreads();
        f32x4 acc[4], acc2[4];
        zero4(acc); mm64x<false, false>(acc, SL(1), SL(0), wq, lane);
        zero4(acc2); mm64x<false, false>(acc2, SL(2), SL(0), wq, lane);
#pragma unroll
        for (int n = 0; n < 4; ++n)
#pragma unroll
            for (int q = 0; q < 4; ++q) { const bool lo = (16 * wq + 4 * g + q < 16 * n + lr); acc[n][q] = lo ? acc[n][q] : 0.f; acc2[n][q] = lo ? acc2[n][q] : 0.f; }
        storeT(SL(5), acc, wq, lane); storeT(SL(6), acc2, wq, lane);
        __syncthreads();
        zero4(acc); mm64x<false, true>(acc, SL(6), SL(3), wq, lane); storeT(SL(7), acc, wq, lane);
        if (wq == 0) {
            const int bb = lane >> 4, jj = lane & 15;
            float X[16];
            X[0] = (jj == 0) ? 1.f : 0.f;
#pragma unroll
            for (int t = 1; t < 16; ++t) {
                const int row = 16 * bb + t;
                const v4u p0 = *(const LAS v4u*)(SL(5) + row * 128 + (((2 * bb) ^ swz(row)) << 4)), p1 = *(const LAS v4u*)(SL(5) + row * 128 + (((2 * bb + 1) ^ swz(row)) << 4));
                float rw[16];
                rw[0] = bflo(p0.x); rw[1] = bfhi(p0.x); rw[2] = bflo(p0.y); rw[3] = bfhi(p0.y); rw[4] = bflo(p0.z); rw[5] = bfhi(p0.z); rw[6] = bflo(p0.w); rw[7] = bfhi(p0.w);
                rw[8] = bflo(p1.x); rw[9] = bfhi(p1.x); rw[10] = bflo(p1.y); rw[11] = bfhi(p1.y); rw[12] = bflo(p1.z); rw[13] = bfhi(p1.z); rw[14] = bflo(p1.w); rw[15] = bfhi(p1.w);
                float xv = (t == jj) ? 1.f : 0.f;
#pragma unroll
                for (int s = 0; s < t; ++s) xv -= rw[s] * X[s];
                X[t] = xv;
            }
#pragma unroll
            for (int t = 0; t < 16; ++t) *(LAS unsigned short*)(DIB + (((bb * 16 + t) * 16 + jj) << 1)) = (unsigned short)f2bf(X[t]);
        }
        __syncthreads();
        {
            const bool isU = wq >= 2; const int cbase = 32 * (wq & 1);
            LAS unsigned char* outT = isU ? SL(6) : SL(8);
#pragma unroll
            for (int ct = 0; ct < 2; ++ct) {
                const int ctile = 2 * (wq & 1) + ct, col = cbase + 16 * ct + lr;
                f32x4 X[4];
#pragma unroll
                for (int b2 = 0; b2 < 4; ++b2) {
                    f32x4 Zt;
                    if (isU) { const v2u rwv = *(const LAS v2u*)(SL(7) + toff(col, 16 * b2 + 4 * g)); Zt = (f32x4){bflo(rwv.x), bfhi(rwv.x), bflo(rwv.y), bfhi(rwv.y)}; }
                    else Zt = loadN_acc(SL(0), b2, ctile, lane);
                    if (b2 >= 1) {
                        f32x4 Y = {0.f, 0.f, 0.f, 0.f};
#pragma unroll
                        for (int s = 0; s < (b2 + 1) / 2; ++s) {
                            v2u alo = {0u, 0u}, ahi = {0u, 0u};
                            if (2 * s < b2) alo = *(const LAS v2u*)(SL(5) + toff(16 * b2 + lr, 32 * s + 4 * g));
                            if (2 * s + 1 < b2) ahi = *(const LAS v2u*)(SL(5) + toff(16 * b2 + lr, 32 * s + 16 + 4 * g));
                            v4u bw = {cvtpk(X[2 * s][0], X[2 * s][1]), cvtpk(X[2 * s][2], X[2 * s][3]), 0u, 0u};
                            if (2 * s + 1 < b2) { bw.z = cvtpk(X[2 * s + 1][0], X[2 * s + 1][1]); bw.w = cvtpk(X[2 * s + 1][2], X[2 * s + 1][3]); }
                            Y = CK_MFMA(__builtin_bit_cast(bf16x8, ((v4u){alo.x, alo.y, ahi.x, ahi.y})), __builtin_bit_cast(bf16x8, bw), Y);
                        }
                        Zt = Zt - Y;
                    }
                    const v2u dv = *(const LAS v2u*)(DIB + (((b2 * 16 + lr) * 16 + 4 * g) << 1));
                    const v4u bz = {cvtpk(Zt[0], Zt[1]), cvtpk(Zt[2], Zt[3]), 0u, 0u};
                    X[b2] = CK_MFMA(__builtin_bit_cast(bf16x8, ((v4u){dv.x, dv.y, 0u, 0u})), __builtin_bit_cast(bf16x8, bz), ((f32x4){0.f, 0.f, 0.f, 0.f}));
                }
#pragma unroll
                for (int b2 = 0; b2 < 4; ++b2) *(LAS v2u*)(outT + toff(col, 16 * b2 + 4 * g)) = (v2u){cvtpk(X[b2][0], X[b2][1]), cvtpk(X[b2][2], X[b2][3])};
            }
        }
        __syncthreads();
        asm volatile("" : "+v"(PF.k[0]), "+v"(PF.k[1]), "+v"(PF.k[2]), "+v"(PF.k[3]), "+v"(PF.k[4]), "+v"(PF.v[0]), "+v"(PF.v[1]), "+v"(PF.v[2]), "+v"(PF.v[3]), "+v"(PF.v[4]));
        asm volatile("" : "+v"(PF.r[0]), "+v"(PF.r[1]), "+v"(PF.r[2]), "+v"(PF.r[3]), "+v"(PF.r[4]), "+v"(PF.lo[0]), "+v"(PF.lo[1]), "+v"(PF.lo[2]), "+v"(PF.lo[3]));
        asm volatile("" : "+v"(cvt.v[0]), "+v"(cvt.v[1]), "+v"(cvt.v[2]), "+v"(cvt.v[3]), "+v"(cvt.v[4]), "+v"(cvt.v[5]), "+v"(cvt.v[6]), "+v"(cvt.v[7]));
        {
            zero4(acc); mm64x<false, true>(acc, SL(8), SL(1), wq, lane);
            const int cstep_ = unit < NU_L ? 4 + (dgrp ? 127 - ((unit >> 4) & 127) : ((unit >> 4) & 127)) : (dgrp ? 3 - (((unit - NU_L) >> 4) & 3) : (((unit - NU_L) >> 4) & 3));
            unsigned char* pb = PQ + (size_t)(((b * 16 + h) * 2 + dgrp) * (4 + T / 64) + cstep_) * 16384;
#pragma unroll
            for (int n = 0; n < 4; ++n) { const int k = 16 * n + lr; const float gm = GAM[dgrp * 64 + k]; float p[4];
#pragma unroll
                for (int q = 0; q < 4; ++q) p[q] = gm * (((16 * wq + 4 * g + q) == k ? 1.f : 0.f) - acc[n][q]);
                *(uint2*)(pb + (size_t)(((n * 2 + (wq >> 1)) * 64 + lane) * 16 + (wq & 1) * 8)) = make_uint2(cvtpk(p[0], p[1]), cvtpk(p[2], p[3])); }
            zero4(acc); mm64x<true, true>(acc, SL(2), SL(3), wq, lane); zero4(acc2); mm64x<true, false>(acc2, SL(1), SL(6), wq, lane);
            const f32x4 gm4 = *(const LAS f32x4*)(GAM + dgrp * 64 + 16 * wq + 4 * g);
#pragma unroll
            for (int n = 0; n < 4; ++n) { const f32x4 qv = (acc[n] - acc2[n]) * gm4;
                *(uint2*)(pb + 8192 + (size_t)(((n * 64 + lane) * 4 + wq) * 8)) = make_uint2(cvtpk(qv[0], qv[1]), cvtpk(qv[2], qv[3])); }
            if (unit < NU_L) {
                zero4(acc); mm64x<false, false>(acc, SL(2), SL(4), wq, lane);
                zero4(acc2); mm64x<false, false>(acc2, SL(1), SL(4), wq, lane);
#pragma unroll
                for (int n = 0; n < 4; ++n)
#pragma unroll
                    for (int q = 0; q < 4; ++q) { const bool le = (16 * wq + 4 * g + q <= 16 * n + lr); acc[n][q] = le ? acc[n][q] : 0.f; acc2[n][q] = le ? -acc2[n][q] : 0.f; }
                storeT(SL(5), acc, wq, lane); storeT(SL(7), acc2, wq, lane);
            }
        }
        __syncthreads();
        if (unit < NU_L) {
            loadT(acc, SL(4), wq, lane);
            mm64x<false, false>(acc, SL(8), SL(7), wq, lane);
            unsigned char* rb = RHAT + inst * 8192;
#pragma unroll
            for (int n = 0; n < 4; ++n) *(uint2*)(rb + (size_t)((16 * n + lr) * 64 + 16 * wq + 4 * g) * 2) = make_uint2(cvtpk(acc[n][0], acc[n][1]), cvtpk(acc[n][2], acc[n][3]));
            zero4(acc2); mm64x<false, true>(acc2, SL(5), SL(3), wq, lane); mm64x<false, false>(acc2, SL(7), SL(6), wq, lane);
            unsigned char* yb = YLOC + inst * 8192 + (size_t)((wq * 64 + lane) * 32);
            v4u o0, o1; o0.x = cvtpk(acc2[0][0], acc2[0][1]); o0.y = cvtpk(acc2[0][2], acc2[0][3]); o0.z = cvtpk(acc2[1][0], acc2[1][1]); o0.w = cvtpk(acc2[1][2], acc2[1][3]);
            o1.x = cvtpk(acc2[2][0], acc2[2][1]); o1.y = cvtpk(acc2[2][2], acc2[2][3]); o1.z = cvtpk(acc2[3][0], acc2[3][1]); o1.w = cvtpk(acc2[3][2], acc2[3][3]);
            *(v4u*)yb = o0; *(v4u*)(yb + 16) = o1;
        }
        __syncthreads();
        {
            if (cv_strip < NE * 64) { int e_, n0_, rb_; wei_strip(cv_strip, e_, n0_, rb_);
                if (cv_kb == 0 && cv_t > 0) cv_scale_q8(cv_w + (size_t)e_ * D * 2048, 2048, n0_, (float*)(F.ws + MI_CSWEI) + (size_t)e_ * 2048, rb_, lane, civ);
                cv_store_q8(cvt, cv_scr, (signed char*)(F.ws + WS_WEIN) + (size_t)e_ * 2048 * D, rb_, cv_kb, civ, lane); }
            ++cv_t;
            __syncthreads();
        }
    }
    for (;;) { const int s_ = F.gw + (cv_t >> 4) * F.NGW, kb_ = cv_t & 15; if (s_ >= NE * 64) break;
        int e_, n0_, rb_; wei_strip(s_, e_, n0_, rb_);
        if (kb_ == 0 && cv_t > 0) cv_scale_q8(cv_w + (size_t)e_ * D * 2048, 2048, n0_, (float*)(F.ws + MI_CSWEI) + (size_t)e_ * 2048, rb_, F.lane, civ);
        cv_load(cvt, cv_w + (size_t)e_ * D * 2048, 2048, n0_, kb_, F.lane);
        cv_store_q8(cvt, cv_scr, (signed char*)(F.ws + WS_WEIN) + (size_t)e_ * 2048 * D, rb_, kb_, civ, F.lane); ++cv_t; }
#undef SL
}

__device__ __forceinline__ void phase_co2(Frame& F) {
    const int wave = F.wave;
    const int dgrp = wave >> 2, wq = wave & 3;
    LAS unsigned char* tl = F.lds + dgrp * 9 * TILE;
#define SL(k) (tl + (k) * TILE)
    const bf16* z = (const bf16*)(F.ws + WS_Z); const bf16* LO = (const bf16*)(F.ws + WS_LORA);
    const unsigned char* RHAT = F.ws + WS_TKN; const unsigned char* YLOC = F.ws + WS_UPRE; const unsigned char* H0T = F.ws + WS_H0T;
    const float* BON = (const float*)(F.ws + MI_BON);
    bf16* MG = (bf16*)(F.ws + WS_A0);
    const float* p_mu = KIN(I_MU);
    for (int unit = blockIdx.x; unit < NU_L; unit += F.G) {
        int lane = F.lane; asm volatile("" : "+v"(lane));
        const int lr = lane & 15, g = lane >> 4;
        int b, h, rowbase; unit_decode(unit, b, h, rowbase);
        const int tok = 8 * wave + (lane >> 3), oct = lane & 7, ch0 = 8 * oct, c0 = h * 64 + ch0, row = rowbase + tok;
        const size_t inst = (size_t)unit * 2 + dgrp;
        const int t2 = (wq << 6) | lane;
#pragma unroll
        for (int rep = 0; rep < 2; ++rep) { const int cidx = t2 + 256 * rep, r_ = cidx >> 3, ch = cidx & 7;
            const v4u a = *(const v4u*)(RHAT + inst * 8192 + (size_t)(r_ * 64 + ch * 8) * 2), hh = *(const v4u*)(H0T + inst * 8192 + (size_t)(r_ * 64 + ch * 8) * 2);
            *(LAS v4u*)(SL(0) + r_ * 128 + ((ch ^ swz(r_)) << 4)) = a; *(LAS v4u*)(SL(1) + r_ * 128 + ((ch ^ swz(r_)) << 4)) = hh; }
        f32x4 acc[4];
        { const unsigned char* yb = YLOC + inst * 8192 + (size_t)((wq * 64 + lane) * 32); const v4u o0 = *(const v4u*)yb, o1 = *(const v4u*)(yb + 16);
          acc[0] = (f32x4){bflo(o0.x), bfhi(o0.x), bflo(o0.y), bfhi(o0.y)}; acc[1] = (f32x4){bflo(o0.z), bfhi(o0.z), bflo(o0.w), bfhi(o0.w)};
          acc[2] = (f32x4){bflo(o1.x), bfhi(o1.x), bflo(o1.y), bfhi(o1.y)}; acc[3] = (f32x4){bflo(o1.z), bfhi(o1.z), bflo(o1.w), bfhi(o1.w)}; }
        const int t = row & (T - 1);
        const bf16* zr = z + (size_t)row * NZ;
        const v4u zz = {0u, 0u, 0u, 0u};
        v4u qv[5]; qv[0] = *(const v4u*)(zr + V_OFF + c0);
#pragma unroll
        for (int j = 0; j < 4; ++j) { const int nr = nbr_row(row, j); qv[1 + j] = nr >= 0 ? *(const v4u*)(z + (size_t)nr * NZ + V_OFF + c0) : zz; }
        const v4u q_g = *(const v4u*)(LO + (size_t)row * NL + 4096 + c0);
        const v4u q_gb = *(const v4u*)(zr + CONV_OFF + c0), q_c0 = *(const v4u*)(zr + CONV_OFF + 1024 + c0), q_x0 = *(const v4u*)(zr + CONV_OFF + 2048 + c0);
        const v4u q_cm = t > 0 ? *(const v4u*)(zr - NZ + CONV_OFF + 1024 + c0) : zz, q_xm = t > 0 ? *(const v4u*)(zr - NZ + CONV_OFF + 2048 + c0) : zz;
        const v4u q_cp = t < T - 1 ? *(const v4u*)(zr + NZ + CONV_OFF + 1024 + c0) : zz, q_xp = t < T - 1 ? *(const v4u*)(zr + NZ + CONV_OFF + 2048 + c0) : zz;
        const v4u q_ga = *(const v4u*)(zr + GATE_OFF + c0), q_gr = *(const v4u*)(zr + GATE_OFF + 1024 + c0);
        const float S3 = BON[(size_t)unit * 64 + tok];
        __syncthreads();
        mm64x<false, false>(acc, SL(0), SL(1), wq, lane);
        { LAS float* Yf = (LAS float*)(tl + 2 * TILE);
#pragma unroll
          for (int n = 0; n < 4; ++n)
#pragma unroll
              for (int q = 0; q < 4; ++q) { const int tau = 16 * wq + 4 * g + q; Yf[tau * 64 + ((16 * n + lr) ^ (4 * (tau & 15)))] = acc[n][q]; } }
        __syncthreads();
        { const LAS float* Y0 = (const LAS float*)(F.lds + 2 * TILE); const LAS float* Y1 = (const LAS float*)(F.lds + 11 * TILE);
          float y[8];
          { const int s0 = 4 * (tok & 15), s1 = 4 * ((63 - tok) & 15);
            const f32x4 a0 = *(const LAS f32x4*)(Y0 + tok * 64 + (ch0 ^ s0)), a1 = *(const LAS f32x4*)(Y0 + tok * 64 + ((ch0 + 4) ^ s0));
            const f32x4 b0 = *(const LAS f32x4*)(Y1 + (63 - tok) * 64 + (ch0 ^ s1)), b1 = *(const LAS f32x4*)(Y1 + (63 - tok) * 64 + ((ch0 + 4) ^ s1));
            y[0] = a0.x + b0.x; y[1] = a0.y + b0.y; y[2] = a0.z + b0.z; y[3] = a0.w + b0.w; y[4] = a1.x + b1.x; y[5] = a1.y + b1.y; y[6] = a1.z + b1.z; y[7] = a1.w + b1.w; }
          float s1 = 0.f, s2 = 0.f;
#pragma unroll
          for (int i = 0; i < 8; ++i) { s1 += y[i]; s2 += y[i] * y[i]; }
          s1 += __shfl_xor(s1, 1); s2 += __shfl_xor(s2, 1); s1 += __shfl_xor(s1, 2); s2 += __shfl_xor(s2, 2); s1 += __shfl_xor(s1, 4); s2 += __shfl_xor(s2, 4);
          const float mean = s1 * (1.0f / 64.0f), var = fmaxf(s2 * (1.0f / 64.0f) - mean * mean, 0.f), rstd = __builtin_amdgcn_rsqf(var + 64e-5f);
          float vs[8]; shift8(qv, p_mu + V_OFF + c0, vs);
          float lnw[8], lnb[8], cw0[8], cw1[8], cw2[8];
          ld8f(KIN(I_LNW) + c0, lnw); ld8f(KIN(I_LNB) + c0, lnb); ld8f(KIN(I_CONVW) + c0, cw0); ld8f(KIN(I_CONVW) + D + c0, cw1); ld8f(KIN(I_CONVW) + 2 * D + c0, cw2);
          float gg[8], gb[8], cc[8], xx[8], cm[8], xm[8], cp[8], xp[8], ga[8], gr[8];
          unpack8(q_g, gg); unpack8(q_gb, gb); unpack8(q_c0, cc); unpack8(q_x0, xx); unpack8(q_cm, cm); unpack8(q_xm, xm); unpack8(q_cp, cp); unpack8(q_xp, xp); unpack8(q_ga, ga); unpack8(q_gr, gr);
          float o[8];
#pragma unroll
          for (int i = 0; i < 8; ++i) {
              const float yn = (y[i] - mean) * rstd * lnw[i] + lnb[i];
              const float yr = (yn + S3 * vs[i]) * gg[i];
              const float yc = gb[i] * (cw0[i] * (cm[i] * xm[i]) + cw1[i] * (cc[i] * xx[i]) + cw2[i] * (cp[i] * xp[i]));
              o[i] = fsig(ga[i]) * yr + fsig(gr[i]) * yc;
          }
          v4u ov; ov.x = cvtpk(o[0], o[1]); ov.y = cvtpk(o[2], o[3]); ov.z = cvtpk(o[4], o[5]); ov.w = cvtpk(o[6], o[7]);
          *(v4u*)(MG + (size_t)row * D + c0) = ov;
        }
        __syncthreads();
    }
#undef SL
}

struct SSIn { v4u a[8]; v4u q[2]; };
__device__ __forceinline__ size_t ss_pq(int step, int b, int h, int d) { return (size_t)(((b * 16 + h) * 2 + d) * (4 + T / 64) + step); }
__device__ __forceinline__ size_t ss_inst(int step, int b, int h, int d) {
    int unit;
    if (step < 4) { const int cb = d ? 3 - step : step; unit = NU_L + (b * 4 + cb) * 16 + h; }
    else { const int blk = d ? 127 - (step - 4) : step - 4; unit = (b * 128 + blk) * 16 + h; }
    return (size_t)unit * 2 + d;
}
__device__ __forceinline__ void ss_load(SSIn& I, const unsigned char* PQ, size_t inst, int wv, int lane) {
    const unsigned char* pb = PQ + inst * 16384;
#pragma unroll
    for (int f = 0; f < 8; ++f) I.a[f] = *(const v4u*)(pb + (size_t)((f * 64 + lane) * 16));
    I.q[0] = *(const v4u*)(pb + 8192 + (size_t)((wv * 64 + lane) * 32)); I.q[1] = *(const v4u*)(pb + 8192 + (size_t)((wv * 64 + lane) * 32 + 16));
}
__device__ __forceinline__ void ss_step(f32x4 (&H)[4], const SSIn& cur, unsigned char* H0T, size_t inst, bool store_h0, int wv, int lr, int g) {
    const unsigned p00 = cvtpk(H[0][0], H[0][1]), p01 = cvtpk(H[0][2], H[0][3]), p10 = cvtpk(H[1][0], H[1][1]), p11 = cvtpk(H[1][2], H[1][3]);
    const unsigned p20 = cvtpk(H[2][0], H[2][1]), p21 = cvtpk(H[2][2], H[2][3]), p30 = cvtpk(H[3][0], H[3][1]), p31 = cvtpk(H[3][2], H[3][3]);
    if (store_h0) { unsigned char* hb = H0T + inst * 8192 + (size_t)((16 * wv + lr) * 64 + 4 * g) * 2;
        *(uint2*)(hb) = make_uint2(p00, p01); *(uint2*)(hb + 32) = make_uint2(p10, p11); *(uint2*)(hb + 64) = make_uint2(p20, p21); *(uint2*)(hb + 96) = make_uint2(p30, p31); }
    const bf16x8 b0 = __builtin_bit_cast(bf16x8, ((v4u){p00, p01, p10, p11})), b1 = __builtin_bit_cast(bf16x8, ((v4u){p20, p21, p30, p31}));
    H[0] = (f32x4){bflo(cur.q[0].x), bfhi(cur.q[0].x), bflo(cur.q[0].y), bfhi(cur.q[0].y)}; H[1] = (f32x4){bflo(cur.q[0].z), bfhi(cur.q[0].z), bflo(cur.q[0].w), bfhi(cur.q[0].w)};
    H[2] = (f32x4){bflo(cur.q[1].x), bfhi(cur.q[1].x), bflo(cur.q[1].y), bfhi(cur.q[1].y)}; H[3] = (f32x4){bflo(cur.q[1].z), bfhi(cur.q[1].z), bflo(cur.q[1].w), bfhi(cur.q[1].w)};
#pragma unroll
    for (int m = 0; m < 4; ++m) { H[m] = CK_MFMA(__builtin_bit_cast(bf16x8, cur.a[2 * m]), b0, H[m]); H[m] = CK_MFMA(__builtin_bit_cast(bf16x8, cur.a[2 * m + 1]), b1, H[m]); }
}
__device__ __forceinline__ void phase_ss(Frame& F) {
    const unsigned char* PQ = F.ws + WS_PQ; unsigned char* H0T = F.ws + WS_H0T;
    const int lane = F.lane, lr = lane & 15, g = lane >> 4;
    for (int task = (int)blockIdx.x; task < 256; task += F.G) {
        const int chain = (task & 7) + 8 * (task >> 5), wv = (task >> 3) & 3, b = chain >> 5, h = (chain >> 1) & 15, d = chain & 1;
        f32x4 H[4]; zero4(H);
        constexpr int NS = 4 + T / 64;
        static_assert(NS % 4 == 0, "unrolled by four");
        SSIn b0, b1, b2, b3;
        ss_load(b0, PQ, ss_pq(0, b, h, d), wv, lane); ss_load(b1, PQ, ss_pq(1, b, h, d), wv, lane); ss_load(b2, PQ, ss_pq(2, b, h, d), wv, lane); ss_load(b3, PQ, ss_pq(3, b, h, d), wv, lane);
        for (int step = 0; step < NS; step += 4) {
            const int n0 = step + 4 < NS ? step + 4 : NS - 1, n1 = step + 5 < NS ? step + 5 : NS - 1, n2 = step + 6 < NS ? step + 6 : NS - 1, n3 = step + 7 < NS ? step + 7 : NS - 1;
            ss_step(H, b0, H0T, ss_inst(step, b, h, d), step >= 4, wv, lr, g);     ss_load(b0, PQ, ss_pq(n0, b, h, d), wv, lane);
            ss_step(H, b1, H0T, ss_inst(step + 1, b, h, d), step >= 4, wv, lr, g); ss_load(b1, PQ, ss_pq(n1, b, h, d), wv, lane);
            ss_step(H, b2, H0T, ss_inst(step + 2, b, h, d), step >= 4, wv, lr, g); ss_load(b2, PQ, ss_pq(n2, b, h, d), wv, lane);
            ss_step(H, b3, H0T, ss_inst(step + 3, b, h, d), step >= 4, wv, lr, g); ss_load(b3, PQ, ss_pq(n3, b, h, d), wv, lane);
        }
    }
}

struct LoraARaw { v4u q[5]; f32x4 m0, m1; };
__device__ __forceinline__ int lora_acol(int gi, int oct) { return (gi < 4 ? DECAY_OFF + 64 * gi : GLORA_OFF + 64 * (gi - 4)) + 8 * oct; }
__device__ __forceinline__ unsigned lora_aload(LoraARaw& R, const bf16* z, const float* p_mu, int r0, int gi, int wave, int lane) {
    const int tok = 8 * wave + (lane >> 3), oct = lane & 7, row = r0 + tok, col = lora_acol(gi, oct);
    R.q[0] = *(const v4u*)(z + (size_t)row * NZ + col);
    unsigned msk = 0u;
#pragma unroll
    for (int j = 0; j < 4; ++j) { const int nr = nbr_row(row, j); msk |= (nr >= 0 ? 1u : 0u) << j; R.q[1 + j] = *(const v4u*)(z + (size_t)(nr >= 0 ? nr : row) * NZ + col); }
    R.m0 = *(const f32x4*)(p_mu + col); R.m1 = *(const f32x4*)(p_mu + col + 4);
    return msk;
}
__device__ __forceinline__ void lora_astore(const LoraARaw& R, unsigned msk, LAS unsigned char* lds, int gi, int wave, int lane) {
    const int tok = 8 * wave + (lane >> 3), oct = lane & 7;
    const v4u zz = {0u, 0u, 0u, 0u};
    const v4u s = R.q[0], n0 = (msk & 1u) ? R.q[1] : zz, n1 = (msk & 2u) ? R.q[2] : zz, n2 = (msk & 4u) ? R.q[3] : zz, n3 = (msk & 8u) ? R.q[4] : zz;
    float v[8];
    v[0] = bflo(s.x) + R.m0.x * (bflo(n0.x) - bflo(s.x)); v[1] = bfhi(s.x) + R.m0.y * (bfhi(n1.x) - bfhi(s.x));
    v[2] = bflo(s.y) + R.m0.z * (bflo(n2.y) - bflo(s.y)); v[3] = bfhi(s.y) + R.m0.w * (bfhi(n3.y) - bfhi(s.y));
    v[4] = bflo(s.z) + R.m1.x * (bflo(n0.z) - bflo(s.z)); v[5] = bfhi(s.z) + R.m1.y * (bfhi(n1.z) - bfhi(s.z));
    v[6] = bflo(s.w) + R.m1.z * (bflo(n2.w) - bflo(s.w)); v[7] = bfhi(s.w) + R.m1.w * (bfhi(n3.w) - bfhi(s.w));
#pragma unroll
    for (int i = 0; i < 8; ++i) v[i] = gi < 2 ? 1.0f - 2.0f * __builtin_amdgcn_rcpf(1.0f + __expf(2.0f * v[i])) : (gi < 4 ? v[i] : fsig(v[i]));
    putN(lds + gi * TILE, tok, oct, v);
}
__device__ __forceinline__ void lora_atile(const bf16* z, const float* p_mu, LAS unsigned char* lds, int r0, int gi, int wave, int lane) {
    LoraARaw R; const unsigned msk = lora_aload(R, z, p_mu, r0, gi, wave, lane); lora_astore(R, msk, lds, gi, wave, lane);
}
template <int KS> struct LoraB { bf16x8 w[KS][4]; };
template <int KS>
__device__ __forceinline__ void lora_bload(LoraB<KS>& B, const bf16* WL, int q, int lr, int g) {
    const int blkid = q >> 4, h = q & 15;
    const bf16* wrow = WL + (size_t)(blkid * 1024 + h * 64 + 8 * (lr >> 2) + (lr & 3)) * KL + blkid * 64 + 8 * g;
#pragma unroll
    for (int s = 0; s < KS; ++s)
#pragma unroll
        for (int n = 0; n < 4; ++n) B.w[s][n] = *(const bf16x8*)(wrow + (size_t)(32 * (n >> 1) + 4 * (n & 1)) * KL + 32 * s);
}
template <int KS>
__device__ __forceinline__ void lora_product(const LoraB<KS>& B, const LAS unsigned char* At, bf16* LO, int r0, int q, int lr, int g, const LAS float* LBI) {
    const int blkid = q >> 4, h = q & 15;
    f32x4 acc[4][4];
#pragma unroll
    for (int n = 0; n < 4; ++n)
#pragma unroll
        for (int m = 0; m < 4; ++m) acc[n][m] = (f32x4){0.f, 0.f, 0.f, 0.f};
#pragma unroll
    for (int s = 0; s < KS; ++s) {
        bf16x8 af[4];
#pragma unroll
        for (int m = 0; m < 4; ++m) af[m] = ldfrag(At + (s >> 1) * TILE, 16 * m + lr, 4 * (s & 1) + g);
#pragma unroll
        for (int n = 0; n < 4; ++n)
#pragma unroll
            for (int m = 0; m < 4; ++m) acc[n][m] = CK_MFMA(B.w[s][n], af[m], acc[n][m]);
    }
    bf16* ob = LO + (size_t)(r0 + lr) * NL + blkid * 1024 + h * 64 + 8 * g;
#pragma unroll
    for (int m = 0; m < 4; ++m)
#pragma unroll
        for (int p = 0; p < 2; ++p) {
            f32x4 v0 = acc[2 * p][m], v1 = acc[2 * p + 1][m];
            if (KS == 2) {
                const LAS float* bp = LBI + blkid * 1024 + h * 64 + 8 * g + 32 * p; const f32x4 b0 = *(const LAS f32x4*)bp, b1 = *(const LAS f32x4*)(bp + 4); const float sc = blkid < 2 ? -0.6065306597126334f : 1.0f;
#pragma unroll
                for (int e = 0; e < 4; ++e) { v0[e] = sc * fsig(v0[e] + b0[e]); v1[e] = sc * fsig(v1[e] + b1[e]); }
            }
            v4u o; o.x = cvtpk(v0[0], v0[1]); o.y = cvtpk(v0[2], v0[3]); o.z = cvtpk(v1[0], v1[1]); o.w = cvtpk(v1[2], v1[3]);
            *(v4u*)(ob + (size_t)(16 * m) * NL + 32 * p) = o; }
}
__device__ __forceinline__ void phase_lora(Frame& F) {
    const bf16* z = (const bf16*)(F.ws + WS_Z); bf16* LO = (bf16*)(F.ws + WS_LORA); const bf16* WL = (const bf16*)(F.ws + WS_WLORA);
    const float* p_mu = KIN(I_MU); const float* p_w0 = KIN(I_W0); const float* p_a0 = KIN(I_A0);
    LAS float* LBI = (LAS float*)(F.lds + 15 * TILE);
    { const int i4 = F.tid * 4; *(LAS f32x4*)(LBI + i4) = *(const f32x4*)(p_w0 + i4); *(LAS f32x4*)(LBI + 2048 + i4) = *(const f32x4*)(p_a0 + i4); }
    __syncthreads();
    for (int unit = blockIdx.x; unit < ML / 64; unit += F.G) {
        int lane = F.lane; asm volatile("" : "+v"(lane));
        const int lr = lane & 15, g = lane >> 4, r0 = unit * 64;
#pragma unroll
        for (int gb = 0; gb < 6; gb += 3) {
            LoraARaw R0, R1, R2;
            const unsigned k0 = lora_aload(R0, z, p_mu, r0, gb, F.wave, lane), k1 = lora_aload(R1, z, p_mu, r0, gb + 1, F.wave, lane), k2 = lora_aload(R2, z, p_mu, r0, gb + 2, F.wave, lane);
            __builtin_amdgcn_sched_barrier(0);
            lora_astore(R0, k0, F.lds, gb, F.wave, lane); lora_astore(R1, k1, F.lds, gb + 1, F.wave, lane); lora_astore(R2, k2, F.lds, gb + 2, F.wave, lane);
        }
        __syncthreads();
        const float* weo = KIN(I_WEO); bf16* WEO = (bf16*)(F.ws + WS_WEOUT);
        LAS float* fscr = (LAS float*)(F.lds + 6 * TILE + F.wave * 8704);
        const int ft0 = (unit * NWAVES + F.wave) * 10;
        CvTile ft;
#define LORA_FILL_LOAD(p) do { const int id0_ = ft0 + (p), id_ = id0_ < NE * 512 ? id0_ : 0; const int e_ = id_ >> 9, q_ = id_ & 511; cv_load(ft, weo + (size_t)e_ * D * D, D, 32 * (q_ & 31), q_ >> 5, lane); } while (0)
#define LORA_FILL_STORE(p) do { const int id_ = ft0 + (p); if (id_ < NE * 512) { const int e_ = id_ >> 9, q_ = id_ & 511; cv_to_lds(ft, fscr, lane); cv_store_bf16(fscr, WEO + (size_t)e_ * D * D, D, 32 * (q_ & 31), 64 * (q_ >> 5), lane); } } while (0)
        LoraB<2> b0, b1;
        lora_bload<2>(b0, WL, F.wave, lr, g);
#pragma unroll
        for (int i = 0; i < 8; i += 2) {
            lora_bload<2>(b1, WL, F.wave + 8 * (i + 1), lr, g); LORA_FILL_LOAD(i);
            lora_product<2>(b0, F.lds + ((F.wave + 8 * i) >> 4) * TILE, LO, r0, F.wave + 8 * i, lr, g, LBI);
            LORA_FILL_STORE(i);
            if (i + 2 < 8) lora_bload<2>(b0, WL, F.wave + 8 * (i + 2), lr, g);
            LORA_FILL_LOAD(i + 1);
            lora_product<2>(b1, F.lds + ((F.wave + 8 * (i + 1)) >> 4) * TILE, LO, r0, F.wave + 8 * (i + 1), lr, g, LBI);
            LORA_FILL_STORE(i + 1);
        }
        { LoraB<4> c0; lora_bload<4>(c0, WL, 64 + F.wave, lr, g); LORA_FILL_LOAD(8); lora_product<4>(c0, F.lds + 4 * TILE, LO, r0, 64 + F.wave, lr, g, LBI); LORA_FILL_STORE(8);
          lora_bload<4>(c0, WL, 72 + F.wave, lr, g); LORA_FILL_LOAD(9); lora_product<4>(c0, F.lds + 4 * TILE, LO, r0, 72 + F.wave, lr, g, LBI); LORA_FILL_STORE(9); }
#undef LORA_FILL_LOAD
#undef LORA_FILL_STORE
        __syncthreads();
    }
    for (int t = blockIdx.x; t < (MC / 64) * 32; t += F.G) {
        int lane = F.lane; asm volatile("" : "+v"(lane));
        const int lr = lane & 15, g = lane >> 4, r0 = ML + (t >> 5) * 64, q0 = 2 * (t & 31), gi = q0 >> 4;
        lora_atile(z, p_mu, F.lds, r0, gi, F.wave, lane);
        __syncthreads();
        if (F.wave < 2) { LoraB<2> b0; lora_bload<2>(b0, WL, q0 + F.wave, lr, g); lora_product<2>(b0, F.lds + gi * TILE, LO, r0, q0 + F.wave, lr, g, LBI); }
        __syncthreads();
    }
}

__device__ __forceinline__ void ss2_load(v4u& ra, v4u& rq, const unsigned char* PQ, size_t inst, int wv, int wave, int lane) {
    const unsigned char* pb = PQ + inst * 16384;
    ra = *(const v4u*)(pb + (size_t)((wave * 64 + lane) * 16));
    if (wave < 2) rq = *(const v4u*)(pb + 8192 + (size_t)((wv * 64 + lane) * 32 + 16 * wave));
}
__device__ __forceinline__ void phase_ss2(Frame& F) {
    const unsigned char* PQ = F.ws + WS_PQ; unsigned char* H0T = F.ws + WS_H0T;
    const int lane = F.lane, wave = F.wave, lr = lane & 15, g = lane >> 4;
    LAS unsigned char* ring = F.lds;
    constexpr int SLOT = 10240, NS = 4 + T / 64, DEPTH = 12;
    static_assert(NS % DEPTH == 0, "unrolled by DEPTH");
    for (int task = (int)blockIdx.x; task < 256; task += F.G) {
        const int chain = task >> 2, wv = task & 3, b = chain >> 5, h = (chain >> 1) & 15, d = chain & 1;
        f32x4 H[4]; zero4(H);
        v4u ra[DEPTH], rq[DEPTH];
#pragma unroll
        for (int k = 0; k < DEPTH; ++k) { rq[k] = (v4u){0u, 0u, 0u, 0u}; ss2_load(ra[k], rq[k], PQ, ss_pq(k, b, h, d), wv, wave, lane); }
        for (int step = 0; step < NS; step += DEPTH) {
#pragma unroll
            for (int k = 0; k < DEPTH; ++k) {
                const int st = step + k; LAS unsigned char* sl = ring + (st & 1) * SLOT;
                *(LAS v4u*)(sl + (wave * 64 + lane) * 16) = ra[k]; if (wave < 2) *(LAS v4u*)(sl + 8192 + (wave * 64 + lane) * 16) = rq[k];
                { const int nx = st + DEPTH < NS ? st + DEPTH : NS - 1; ss2_load(ra[k], rq[k], PQ, ss_pq(nx, b, h, d), wv, wave, lane); }
                __syncthreads();
                if (wave == 0) { SSIn cur;
#pragma unroll
                    for (int f = 0; f < 8; ++f) cur.a[f] = *(const LAS v4u*)(sl + (f * 64 + lane) * 16);
                    cur.q[0] = *(const LAS v4u*)(sl + 8192 + lane * 16); cur.q[1] = *(const LAS v4u*)(sl + 8192 + (64 + lane) * 16);
                    ss_step(H, cur, H0T, ss_inst(st, b, h, d), st >= 4, wv, lr, g); }
            }
        }
        __syncthreads();
    }
}

__device__ __forceinline__ void ss3_load(v4u& a0, v4u& a1, v2u& q, const unsigned char* PQ, size_t pq, int wv, int m, int lane) {
    const unsigned char* pb = PQ + pq * 16384;
    a0 = *(const v4u*)(pb + (size_t)(((2 * m) * 64 + lane) * 16)); a1 = *(const v4u*)(pb + (size_t)(((2 * m + 1) * 64 + lane) * 16));
    q = *(const v2u*)(pb + 8192 + (size_t)((wv * 64 + lane) * 32 + 8 * m));
}
__device__ __forceinline__ void phase_ss3(Frame& F) {
    const unsigned char* PQ = F.ws + WS_PQ; unsigned char* H0T = F.ws + WS_H0T;
    const int lane = F.lane, wave = F.wave, lr = lane & 15, g = lane >> 4, m = wave & 3;
    LAS unsigned char* xch = F.lds;
    constexpr int NS = 4 + T / 64, DEPTH = 12;
    static_assert(NS % DEPTH == 0, "unrolled by DEPTH");
    for (int task = (int)blockIdx.x; task < 256; task += F.G) {
        const int chain = task >> 2, wv = task & 3, b = chain >> 5, h = (chain >> 1) & 15, d = chain & 1;
        f32x4 H = {0.f, 0.f, 0.f, 0.f};
        v4u a0[DEPTH], a1[DEPTH]; v2u qv[DEPTH];
        if (wave < 4) {
#pragma unroll
            for (int k = 0; k < DEPTH; ++k) ss3_load(a0[k], a1[k], qv[k], PQ, ss_pq(k, b, h, d), wv, m, lane);
        }
        for (int step = 0; step < NS; step += DEPTH) {
#pragma unroll
            for (int k = 0; k < DEPTH; ++k) {
                const int st = step + k; LAS unsigned char* xs = xch + (st & 1) * 2048;
                if (wave < 4) {
                    const v2u pk = {cvtpk(H[0], H[1]), cvtpk(H[2], H[3])};
                    *(LAS v2u*)(xs + lane * 32 + 8 * m) = pk;
                    if (st >= 4) *(v2u*)(H0T + ss_inst(st, b, h, d) * 8192 + (size_t)((16 * wv + lr) * 64 + 16 * m + 4 * g) * 2) = pk;
                }
                __syncthreads();
                if (wave < 4) {
                    const v4u b0 = *(const LAS v4u*)(xs + lane * 32), b1 = *(const LAS v4u*)(xs + lane * 32 + 16);
                    f32x4 Hn = {bflo(qv[k].x), bfhi(qv[k].x), bflo(qv[k].y), bfhi(qv[k].y)};
                    Hn = CK_MFMA(__builtin_bit_cast(bf16x8, a0[k]), __builtin_bit_cast(bf16x8, b0), Hn);
                    Hn = CK_MFMA(__builtin_bit_cast(bf16x8, a1[k]), __builtin_bit_cast(bf16x8, b1), Hn);
                    H = Hn;
                    const int nx = st + DEPTH < NS ? st + DEPTH : NS - 1;
                    ss3_load(a0[k], a1[k], qv[k], PQ, ss_pq(nx, b, h, d), wv, m, lane);
                }
            }
        }
        __syncthreads();
    }
}
}
template <int PART>
__device__ __forceinline__ void phase_moe_weights(Frame& F) {
    LAS float* scr = (LAS float*)(F.lds + RING_OFF + F.wave * 16384);
    bf16* WEO = (bf16*)(F.ws + WS_WEOUT);
    constexpr int IT_IN = (D / 64) * (2048 / 32), IT_OUT = (D / 64) * (D / 32);
    if (PART == 0) {
        const float* wei = KIN(I_WEI);
        const int nstat = F.G * 7;
        int it = (int)blockIdx.x * 7 + F.wave - 1;
        while (it < NE * 128) {
            const int half = it & 1, r = it >> 1, e = r >> 6, n0 = 32 * (r & 63);
            const int c = n0 & 1023, rowbase = (c >> 7) * 256 + (n0 >= 1024 ? 128 : 0) + (c & 127);
            q8_item(wei + (size_t)e * D * 2048, 2048, n0, (signed char*)(F.ws + WS_WEIN) + (size_t)e * 2048 * D, (float*)(F.ws + MI_CSWEI) + (size_t)e * 2048, rowbase, scr, F.lane, 8 * half, 8 * half + 8);
            int nx = 0; if (F.lane == 0) nx = (int)__hip_atomic_fetch_add(F.ctl + CW_Q6, 1u, __ATOMIC_RELAXED, __HIP_MEMORY_SCOPE_AGENT);
            it = nstat + __builtin_amdgcn_readfirstlane(nx);
        }
    } else {
        const float* weo = KIN(I_WEO);
        for (int r = (int)blockIdx.x * 7 + F.wave - 1; r < NE * IT_OUT; r += F.G * 7) { const int e = r / IT_OUT, q = r % IT_OUT, kb = q / 32, n0 = 32 * (q % 32);
            transpose_item(weo + (size_t)e * D * D, D, 64 * kb, n0, WEO + (size_t)e * D * D, D, n0, scr, F.lane); }
    }
}

__device__ __forceinline__ void phase_x1_h2(Frame& F) {
    LAS float* LG = (LAS float*)(F.lds);
    LAS float* LA = LG + 2 * D; LAS float* LB = LA + 2 * D;
    const float* modp = (const float*)(F.ws + WS_MODP);
    for (int i = F.tid; i < 2 * D; i += NWAVES * 64) { const int v = i / D, j = i % D;
        LG[i] = mod_val(modp, KIN(I_BADA), v, 2048 + j) * KIN(I_NQM)[j];
        LA[i] = KIN(I_NPF)[j] * (1.0f + mod_val(modp, KIN(I_BADA), v, 4096 + j)); LB[i] = mod_val(modp, KIN(I_BADA), v, 3072 + j); }
    __syncthreads();
    const float* mix = (const float*)(F.ws + WS_MIX); float* x1 = (float*)(F.ws + WS_X1); bf16* h2 = (bf16*)(F.ws + WS_H2);
    for (int row = F.gw; row < ML; row += F.NGW) {
        const int vec = row >> 13;
        f32x4 m[4], x[4]; float s = 0.f;
#pragma unroll
        for (int j = 0; j < 4; ++j) { m[j] = *(const f32x4*)(mix + (size_t)row * D + 4 * F.lane + 256 * j); x[j] = *(const f32x4*)(KIN(I_X) + (size_t)row * D + 4 * F.lane + 256 * j);
            s += (m[j].x * m[j].x + m[j].y * m[j].y) + (m[j].z * m[j].z + m[j].w * m[j].w); }
        const float rstd = 1.0f / sqrtf(wave_sum(s) * (1.0f / D) + 1e-6f);
        float s2 = 0.f;
#pragma unroll
        for (int j = 0; j < 4; ++j) { const int c = 4 * F.lane + 256 * j; const f32x4 g = *(const LAS f32x4*)(LG + vec * D + c);
            x[j] = x[j] + g * (m[j] * rstd); *(f32x4*)(x1 + (size_t)row * D + c) = x[j];
            s2 += (x[j].x * x[j].x + x[j].y * x[j].y) + (x[j].z * x[j].z + x[j].w * x[j].w); }
        const float rstd2 = 1.0f / sqrtf(wave_sum(s2) * (1.0f / D) + 1e-6f);
        unsigned long long* o8 = (unsigned long long*)(h2 + (size_t)row * D) + F.lane;
        f32x4 hq[4]; float mx = 0.f;
#pragma unroll
        for (int j = 0; j < 4; ++j) { const int c = 4 * F.lane + 256 * j; const f32x4 a = *(const LAS f32x4*)(LA + vec * D + c), b = *(const LAS f32x4*)(LB + vec * D + c);
            const f32x4 h = x[j] * rstd2 * a + b; hq[j] = h;
            mx = fmaxf(mx, fmaxf(fmaxf(fabsf(h.x), fabsf(h.y)), fmaxf(fabsf(h.z), fabsf(h.w))));
            o8[64 * j] = (unsigned long long)pk2(h.x, h.y) | ((unsigned long long)pk2(h.z, h.w) << 32); }
        mx = wave_max(mx);
        const float iv = mx > 0.f ? 127.0f / mx : 0.f;
        if (F.lane == 0) ((float*)(F.ws + MI_RSH2))[row] = mx * (1.0f / 127.0f);
        unsigned* o4 = (unsigned*)(F.ws + WS_H2Q + (size_t)row * D) + F.lane;
#pragma unroll
        for (int j = 0; j < 4; ++j) o4[64 * j] = pack_q4(hq[j].x * iv, hq[j].y * iv, hq[j].z * iv, hq[j].w * iv);
    }
}

__device__ __forceinline__ void phase_route(Frame& F) {
    const float* LG = (const float*)(F.ws + WS_LOGIT);
    int* selE = (int*)(F.ws + MI_SELE); int* selP = (int*)(F.ws + MI_SELP); float* gate = (float*)(F.ws + MI_GATE);
    for (int task = F.gw; task < ML / 64; task += F.NGW) {
        const int row = task * 64 + F.lane;
        float v[NE];
#pragma unroll
        for (int q = 0; q < NE / 4; ++q) { const f32x4 x = *(const f32x4*)(LG + (size_t)row * 256 + 4 * q); const f32x4 bb = *(const f32x4*)(KIN(I_BR) + 4 * q);
            v[4 * q] = x.x + bb.x; v[4 * q + 1] = x.y + bb.y; v[4 * q + 2] = x.z + bb.z; v[4 * q + 3] = x.w + bb.w; }
        int se[4]; float sv[4];
#pragma unroll
        for (int k = 0; k < 4; ++k) { float best = -3.0e38f; int bi = 0;
#pragma unroll
            for (int e = 0; e < NE; ++e) if (v[e] > best) { best = v[e]; bi = e; }
#pragma unroll
            for (int e = 0; e < NE; ++e) v[e] = (e == bi) ? -3.0e38f : v[e];
            se[k] = bi; sv[k] = best; }
        float ex[4], sum = 0.f;
#pragma unroll
        for (int k = 0; k < 4; ++k) { ex[k] = __expf(sv[k] - sv[0]); sum += ex[k]; }
        const float inv = 1.0f / sum;
        int sp[4] = {0, 0, 0, 0};
        int myn = 0;
#pragma unroll
        for (int e = 0; e < NE; ++e) { const bool p = (se[0] == e) | (se[1] == e) | (se[2] == e) | (se[3] == e); const int n = __popcll(__ballot(p)); myn = (F.lane == e) ? n : myn; }
        int mybase = 0;
        if (F.lane < NE && myn > 0) mybase = (int)__hip_atomic_fetch_add(F.ctl + CW_CNT + 64 * F.lane, (unsigned)myn, __ATOMIC_RELAXED, __HIP_MEMORY_SCOPE_AGENT);
#pragma unroll
        for (int e = 0; e < NE; ++e) {
            const bool p = (se[0] == e) | (se[1] == e) | (se[2] == e) | (se[3] == e);
            const unsigned long long mask = __ballot(p);
            const int base = __shfl(mybase, e);
            const int pos = base + __popcll(mask & ((1ull << F.lane) - 1ull));
#pragma unroll
            for (int k = 0; k < 4; ++k) if (se[k] == e) sp[k] = pos;
        }
        *(int4*)(selE + (size_t)row * 4) = make_int4(se[0], se[1], se[2], se[3]);
        *(int4*)(selP + (size_t)row * 4) = make_int4(sp[0], sp[1], sp[2], sp[3]);
        *(f32x4*)(gate + (size_t)row * 4) = (f32x4){ex[0] * inv, ex[1] * inv, ex[2] * inv, ex[3] * inv};
    }
}

__device__ __forceinline__ void phase_x1h2_route(Frame& F) {
    constexpr int HS_STRIDE = 2064;
    LAS unsigned char* Hs = F.lds;
    LAS float* LG = (LAS float*)(F.lds + 132096);
    LAS float* LA = LG + D; LAS float* LB = LA + D;
    LAS float* LGT = (LAS float*)(F.lds + LDS_X_OFF);
    const float* modp = (const float*)(F.ws + WS_MODP);
    const float* mix = (const float*)(F.ws + WS_MIX); float* x1 = (float*)(F.ws + WS_X1);
    const float* xin = KIN(I_X); const float* b_ada = KIN(I_BADA); const float* nqm = KIN(I_NQM); const float* npf = KIN(I_NPF);
    const bf16* WR = (const bf16*)(F.ws + WS_WROUT);
    int* selE = (int*)(F.ws + MI_SELE); int* selP = (int*)(F.ws + MI_SELP); float* gate = (float*)(F.ws + MI_GATE);
    for (int rb = blockIdx.x; rb < ML / 64; rb += F.G) {
        const int vec = (rb * 64) >> 13;
        __syncthreads();
        for (int i = F.tid; i < D; i += NWAVES * 64) {
            const int jj[3] = {2048 + i, 4096 + i, 3072 + i}; float mv[3]; mod_vals<3>(modp, b_ada, vec, jj, mv);
            LG[i] = mv[0] * nqm[i]; LA[i] = npf[i] * (1.0f + mv[1]); LB[i] = mv[2]; }
        __syncthreads();
#pragma unroll
        for (int r4 = 0; r4 < 8; r4 += 4) {
            f32x4 mq[4][4], xq[4][4];
#pragma unroll
            for (int k = 0; k < 4; ++k) { const int row = rb * 64 + F.wave * 8 + r4 + k;
#pragma unroll
                for (int j = 0; j < 4; ++j) { mq[k][j] = *(const f32x4*)(mix + (size_t)row * D + 4 * F.lane + 256 * j); xq[k][j] = *(const f32x4*)(xin + (size_t)row * D + 4 * F.lane + 256 * j); } }
            __builtin_amdgcn_sched_barrier(0);
#pragma unroll
            for (int k = 0; k < 4; ++k) {
                const int lrow = F.wave * 8 + r4 + k, row = rb * 64 + lrow;
                f32x4 m[4], x[4]; float s = 0.f;
#pragma unroll
                for (int j = 0; j < 4; ++j) { m[j] = mq[k][j]; x[j] = xq[k][j];
                    s += (m[j].x * m[j].x + m[j].y * m[j].y) + (m[j].z * m[j].z + m[j].w * m[j].w); }
                const float rstd = 1.0f / sqrtf(wave_sum(s) * (1.0f / D) + 1e-6f);
                float s2 = 0.f;
#pragma unroll
                for (int j = 0; j < 4; ++j) { const int c = 4 * F.lane + 256 * j; const f32x4 g = *(const LAS f32x4*)(LG + c);
                    x[j] = x[j] + g * (m[j] * rstd); *(f32x4*)(x1 + (size_t)row * D + c) = x[j];
                    s2 += (x[j].x * x[j].x + x[j].y * x[j].y) + (x[j].z * x[j].z + x[j].w * x[j].w); }
                const float rstd2 = 1.0f / sqrtf(wave_sum(s2) * (1.0f / D) + 1e-6f);
                f32x4 hq[4]; float mx = 0.f;
#pragma unroll
                for (int j = 0; j < 4; ++j) { const int c = 4 * F.lane + 256 * j; const f32x4 a = *(const LAS f32x4*)(LA + c), b = *(const LAS f32x4*)(LB + c);
                    const f32x4 h = x[j] * rstd2 * a + b; hq[j] = h;
                    mx = fmaxf(mx, fmaxf(fmaxf(fabsf(h.x), fabsf(h.y)), fmaxf(fabsf(h.z), fabsf(h.w))));
                    *(LAS v2u*)(Hs + lrow * HS_STRIDE + c * 2) = (v2u){pk2(h.x, h.y), pk2(h.z, h.w)}; }
                mx = wave_max(mx);
                const float iv = mx > 0.f ? 127.0f / mx : 0.f;
                if (F.lane == 0) ((float*)(F.ws + MI_RSH2))[row] = mx * (1.0f / 127.0f);
                unsigned* o4 = (unsigned*)(F.ws + WS_H2Q + (size_t)row * D) + F.lane;
#pragma unroll
                for (int j = 0; j < 4; ++j) o4[64 * j] = pack_q4(hq[j].x * iv, hq[j].y * iv, hq[j].z * iv, hq[j].w * iv);
            }
        }
        __syncthreads();
        {
            const int rt = F.wave & 3, et = F.wave >> 2, lr = F.lane & 15, g = F.lane >> 4;
            typedef short bf16x8_t __attribute__((ext_vector_type(8)));
            f32x4 acc = {0.f, 0.f, 0.f, 0.f};
            const LAS unsigned char* ap = Hs + (16 * rt + lr) * HS_STRIDE + 16 * g; const bf16* bp = WR + (size_t)(16 * et + lr) * D + 8 * g;
#pragma unroll
            for (int sb = 0; sb < 32; sb += 16) {
                bf16x8_t bq[16];
#pragma unroll
                for (int s = 0; s < 16; ++s) bq[s] = *(const bf16x8_t*)(bp + 32 * (sb + s));
                __builtin_amdgcn_sched_barrier(0);
#pragma unroll
                for (int s = 0; s < 16; ++s) { const bf16x8_t a = *(const LAS bf16x8_t*)(ap + 64 * (sb + s)); acc = __builtin_amdgcn_mfma_f32_16x16x32_bf16(a, bq[s], acc, 0, 0, 0); }
            }
#pragma unroll
            for (int i = 0; i < 4; ++i) LGT[(16 * rt + 4 * g + i) * 33 + 16 * et + lr] = acc[i];
        }
        __syncthreads();
        if (F.wave == 0) {
            const int row = rb * 64 + F.lane;
            const float* br = KIN(I_BR);
            float v[NE];
#pragma unroll
            for (int e = 0; e < NE; ++e) v[e] = LGT[F.lane * 33 + e] + br[e];
            int se[4]; float sv[4];
#pragma unroll
            for (int k = 0; k < 4; ++k) { float best = -3.0e38f; int bi = 0;
#pragma unroll
                for (int e = 0; e < NE; ++e) if (v[e] > best) { best = v[e]; bi = e; }
#pragma unroll
                for (int e = 0; e < NE; ++e) v[e] = (e == bi) ? -3.0e38f : v[e];
                se[k] = bi; sv[k] = best; }
            float ex[4], sum = 0.f;
#pragma unroll
            for (int k = 0; k < 4; ++k) { ex[k] = __expf(sv[k] - sv[0]); sum += ex[k]; }
            const float inv = 1.0f / sum;
            int sp[4] = {0, 0, 0, 0};
            int myn = 0;
#pragma unroll
            for (int e = 0; e < NE; ++e) { const bool p = (se[0] == e) | (se[1] == e) | (se[2] == e) | (se[3] == e); const int n = __popcll(__ballot(p)); myn = (F.lane == e) ? n : myn; }
            int mybase = 0;
            if (F.lane < NE && myn > 0) mybase = (int)__hip_atomic_fetch_add(F.ctl + CW_CNT + 64 * F.lane, (unsigned)myn, __ATOMIC_RELAXED, __HIP_MEMORY_SCOPE_AGENT);
#pragma unroll
            for (int e = 0; e < NE; ++e) {
                const bool p = (se[0] == e) | (se[1] == e) | (se[2] == e) | (se[3] == e);
                const unsigned long long mask = __ballot(p);
                const int base = __shfl(mybase, e);
                const int pos = base + __popcll(mask & ((1ull << F.lane) - 1ull));
#pragma unroll
                for (int k = 0; k < 4; ++k) if (se[k] == e) sp[k] = pos;
            }
            *(int4*)(selE + (size_t)row * 4) = make_int4(se[0], se[1], se[2], se[3]);
            *(int4*)(selP + (size_t)row * 4) = make_int4(sp[0], sp[1], sp[2], sp[3]);
            *(f32x4*)(gate + (size_t)row * 4) = (f32x4){ex[0] * inv, ex[1] * inv, ex[2] * inv, ex[3] * inv};
        }
    }
    __syncthreads();
}

__device__ __forceinline__ void phase_scatter(Frame& F) {
    LAS int* PS = (LAS int*)(F.lds);
    if (F.wave == 0) {
        const int c = F.lane < NE ? (int)__hip_atomic_load(F.ctl + CW_CNT + 64 * F.lane, __ATOMIC_RELAXED, __HIP_MEMORY_SCOPE_AGENT) : 0;
        const int pc = (c + 255) / 256 * 256; int s = pc;
#pragma unroll
        for (int o = 1; o < 32; o <<= 1) { const int t = __shfl_up(s, o); s += (F.lane >= o) ? t : 0; }
        if (F.lane < NE) { PS[F.lane] = s - pc; PS[64 + F.lane] = c; }
        if (F.lane == NE - 1) PS[NE] = s; }
    __syncthreads();
    int* blkE = (int*)(F.ws + MI_BLKE);
    if (blockIdx.x == 0) {
        for (int b = F.tid; b < MAXBLK; b += NWAVES * 64) { int e = NE - 1;
            for (int q = 0; q < NE; ++q) if (b * 256 >= PS[q] && b * 256 < PS[q + 1]) e = q;
            blkE[b] = e; }
        if (F.tid == 0) blkE[MAXBLK] = PS[NE] / 256;
    }
    const int* selE = (const int*)(F.ws + MI_SELE); const int* selP = (const int*)(F.ws + MI_SELP); int* dest = (int*)(F.ws + MI_DEST);
    const unsigned char* h2q = F.ws + WS_H2Q; unsigned char* xb = F.ws + WS_XB; const float* rsh2 = (const float*)(F.ws + MI_RSH2); float* rsxb = (float*)(F.ws + MI_RSXB);
    for (int row0 = F.gw; row0 < ML; row0 += 8 * F.NGW) {
        int4 se[8], sp[8]; float rsc[8]; v4u av[8];
#pragma unroll
        for (int k = 0; k < 8; ++k) { const int row = row0 + k * F.NGW, rc = row < ML ? row : row0;
            se[k] = *(const int4*)(selE + (size_t)rc * 4); sp[k] = *(const int4*)(selP + (size_t)rc * 4); rsc[k] = rsh2[rc]; av[k] = *(const v4u*)(h2q + (size_t)rc * D + 16 * F.lane); }
        __builtin_amdgcn_sched_barrier(0);
#pragma unroll
        for (int k = 0; k < 8; ++k) { const int row = row0 + k * F.NGW;
            if (row < ML) {
                const int d0 = PS[se[k].x] + sp[k].x, d1 = PS[se[k].y] + sp[k].y, d2 = PS[se[k].z] + sp[k].z, d3 = PS[se[k].w] + sp[k].w;
                if (F.lane == 0) { *(int4*)(dest + (size_t)row * 4) = make_int4(d0, d1, d2, d3); rsxb[d0] = rsc[k]; rsxb[d1] = rsc[k]; rsxb[d2] = rsc[k]; rsxb[d3] = rsc[k]; }
                *(v4u*)(xb + (size_t)d0 * D + 16 * F.lane) = av[k]; *(v4u*)(xb + (size_t)d1 * D + 16 * F.lane) = av[k];
                *(v4u*)(xb + (size_t)d2 * D + 16 * F.lane) = av[k]; *(v4u*)(xb + (size_t)d3 * D + 16 * F.lane) = av[k]; } }
    }
    for (int p = F.gw; p < NE * 256; p += F.NGW) {
        const int e = p >> 8, r = p & 255, c = PS[64 + e], padded = (c + 255) / 256 * 256;
        if (c + r < padded) { unsigned char* dst = xb + (size_t)(PS[e] + c + r) * D; *(v4u*)(dst + 16 * F.lane) = (v4u){0u, 0u, 0u, 0u}; if (F.lane == 0) rsxb[PS[e] + c + r] = 0.f; }
    }
}

__device__ __forceinline__ void phase_combine(Frame& F) {
    LAS float* LG = (LAS float*)(F.lds);
    const float* modp = (const float*)(F.ws + WS_MODP);
    for (int i = F.tid; i < 2 * D; i += NWAVES * 64) { const int v = i / D, j = i % D; LG[i] = mod_val(modp, KIN(I_BADA), v, 5120 + j) * KIN(I_NQF)[j]; }
    __syncthreads();
    const int* dest = (const int*)(F.ws + MI_DEST); const float* gate = (const float*)(F.ws + MI_GATE);
    const bf16* y2 = (const bf16*)(F.ws + WS_Y2); const float* x1 = (const float*)(F.ws + WS_X1);
    for (int row0 = F.gw; row0 < ML; row0 += 8 * F.NGW) {
        const int rl = row0 + (F.lane & 7) * F.NGW, rlc = rl < ML ? rl : row0;
        const int4 ddl = *(const int4*)(dest + (size_t)rlc * 4); const f32x4 ggl = *(const f32x4*)(gate + (size_t)rlc * 4);
#pragma unroll
        for (int k2 = 0; k2 < 8; k2 += 2) {
            if (row0 + k2 * F.NGW >= ML) break;
            v4u t[2][4][2]; f32x4 xq[2][4];
#pragma unroll
            for (int u = 0; u < 2; ++u) { const int kk = k2 + u, row = row0 + kk * F.NGW, rc = row < ML ? row : row0;
                const int dk[4] = {__builtin_amdgcn_readlane(ddl.x, kk), __builtin_amdgcn_readlane(ddl.y, kk), __builtin_amdgcn_readlane(ddl.z, kk), __builtin_amdgcn_readlane(ddl.w, kk)};
#pragma unroll
                for (int k = 0; k < 4; ++k) { const bf16* yp = y2 + (size_t)dk[k] * D + 16 * F.lane; t[u][k][0] = *(const v4u*)yp; t[u][k][1] = *(const v4u*)(yp + 8); }
#pragma unroll
                for (int j = 0; j < 4; ++j) xq[u][j] = *(const f32x4*)(x1 + (size_t)rc * D + 16 * F.lane + 4 * j); }
            __builtin_amdgcn_sched_barrier(0);
#pragma unroll
            for (int u = 0; u < 2; ++u) { const int kk = k2 + u, row = row0 + kk * F.NGW;
                if (row < ML) {
                    const int vec = row >> 13;
                    const float g0_ = ggl.x, g1_ = ggl.y, g2_ = ggl.z, g3_ = ggl.w;
                    const float gk[4] = {__int_as_float(__builtin_amdgcn_readlane(__float_as_int(g0_), kk)), __int_as_float(__builtin_amdgcn_readlane(__float_as_int(g1_), kk)),
                                         __int_as_float(__builtin_amdgcn_readlane(__float_as_int(g2_), kk)), __int_as_float(__builtin_amdgcn_readlane(__float_as_int(g3_), kk))};
                    float f[16];
#pragma unroll
                    for (int i = 0; i < 16; ++i) f[i] = 0.f;
#pragma unroll
                    for (int k = 0; k < 4; ++k) { const v4u a_ = t[u][k][0], b_ = t[u][k][1];
                        const float tt[16] = {bflo(a_.x), bfhi(a_.x), bflo(a_.y), bfhi(a_.y), bflo(a_.z), bfhi(a_.z), bflo(a_.w), bfhi(a_.w), bflo(b_.x), bfhi(b_.x), bflo(b_.y), bfhi(b_.y), bflo(b_.z), bfhi(b_.z), bflo(b_.w), bfhi(b_.w)};
#pragma unroll
                        for (int i = 0; i < 16; ++i) f[i] += gk[k] * tt[i]; }
                    float s = 0.f;
#pragma unroll
                    for (int i = 0; i < 16; ++i) s += f[i] * f[i];
                    const float rstd = 1.0f / sqrtf(wave_sum(s) * (1.0f / D) + 1e-6f);
                    float g[16], o[16]; ld16f_lds(LG + vec * D + 16 * F.lane, g);
#pragma unroll
                    for (int i = 0; i < 16; ++i) o[i] = xq[u][i >> 2][i & 3] + g[i] * (f[i] * rstd);
                    st16f(F.out + (size_t)row * D + 16 * F.lane, o);
                }
            }
        }
    }
}

constexpr int N_PHASES = 13;
#ifndef PROBE_MASK
#define PROBE_MASK 0
#endif
#ifndef STAGE_REP
#define STAGE_REP 0
#endif
#ifndef USE_FLAT_BAR
#define USE_FLAT_BAR 0
#endif
struct Args { const float* in[30]; float* out; unsigned char* ws; int ph_lo, ph_hi; };
__global__ void __launch_bounds__(NWAVES * 64, 2) fwd(Args args) {
    extern __shared__ __attribute__((aligned(16))) unsigned char lds[];
    Frame F;
    F.lds = (LAS unsigned char*)lds;
    F.MISC = (volatile LAS unsigned*)(F.lds + MISC_OFF);
    F.tid = threadIdx.x; F.lane = F.tid & 63; F.wave = __builtin_amdgcn_readfirstlane(F.tid >> 6);
    F.G = gridDim.x; F.gw = blockIdx.x * NWAVES + F.wave; F.NGW = F.G * NWAVES;
    F.ws = args.ws; F.ctl = (unsigned*)(args.ws + WS_CTL); F.out = args.out;
    for (int u = F.tid; u < (LDS_X_OFF - LDSCTL_OFF) / 4; u += NWAVES * 64) ((LAS unsigned*)(F.lds + LDSCTL_OFF))[u] = 0u;
    __syncthreads();
    const int lo = args.ph_lo, hi = args.ph_hi;
    const bool use_bar = (hi - lo) > 1;
    XcdBarrier bar; bar.bar = F.ctl + CW_BAR; bar.x = 0; bar.st = nullptr;
    if (use_bar && !USE_FLAT_BAR) bar = xcd_barrier_post(F.ctl + CW_BAR, F.MISC + 8);
#define IN(k) (lo <= (k) && (k) < hi)
    unsigned fb_extra = 0u;
#define SEAM(k) do { if (IN(k) && IN((k) + 1)) { if (USE_FLAT_BAR) flat_barrier(F.ctl + CW_FB, (unsigned)((k) - lo + 1) + fb_extra); else xcd_barrier2(bar); } else __syncthreads(); } while (0)

#define DUP(k) ((PROBE_MASK >> (k)) & 1)
    if (IN(0)) { phase_prologue(F); if (DUP(0)) { __syncthreads(); phase_prologue(F); } SEAM(0); }
    if (DUP(20)) { for (int q = 0; q < 10; ++q) { if (USE_FLAT_BAR) { ++fb_extra; flat_barrier(F.ctl + CW_FB, 1u + fb_extra); } else xcd_barrier2(bar); } }
    if (IN(1)) { phase_hrows(F); if (DUP(1)) { __syncthreads(); phase_hrows(F); } SEAM(1); }
    if (IN(2)) {
        {         pg8::Gemm g{(const bf16*)(F.ws + WS_A0), (const bf16*)(F.ws + WS_WIN), MT, NZ, D}; pg8::StaticOrder S; S.init(MT, NZ, F.G, (int)blockIdx.x);
        pg8::EpiBf16I8 E{(bf16*)(F.ws + WS_Z), NZ, (const float*)(F.ws + MI_RSH), (const float*)(F.ws + MI_CSWIN)};
        pg8::gemm_phase_i8<pg8::EpiBf16I8, pg8::StaticOrder, true, true>(F.lds + RING_OFF, g, S, E); __syncthreads(); }
        if (DUP(2)) {         pg8::Gemm g{(const bf16*)(F.ws + WS_A0), (const bf16*)(F.ws + WS_WIN), MT, NZ, D}; pg8::StaticOrder S; S.init(MT, NZ, F.G, (int)blockIdx.x);
        pg8::EpiBf16I8 E{(bf16*)(F.ws + WS_Z), NZ, (const float*)(F.ws + MI_RSH), (const float*)(F.ws + MI_CSWIN)};
        pg8::gemm_phase_i8<pg8::EpiBf16I8, pg8::StaticOrder, true, true>(F.lds + RING_OFF, g, S, E); __syncthreads(); }
        SEAM(2); }
    if (IN(3)) { ck::phase_lora(F); SEAM(3); }
    if (IN(4)) { ck::phase_cp2(F); if (DUP(5)) { __syncthreads(); ck::phase_cp2(F); } if (DUP(22)) { __syncthreads(); ck::phase_lora(F); } SEAM(4); }
    if (IN(5)) { if (F.wave == 0) ck::phase_ss(F); if (DUP(23)) { __syncthreads(); ck::phase_ss3(F); } if (DUP(6)) { __syncthreads(); if (F.wave == 0) ck::phase_ss(F); else phase_moe_weights<0>(F); } if (DUP(17)) { __syncthreads(); if (F.wave == 0) ck::phase_ss(F); } SEAM(5); }
    if (IN(6)) { ck::phase_co2(F); if (DUP(7)) { __syncthreads(); ck::phase_co2(F); } SEAM(6); }
    if (IN(7)) {
        {         pg8::Gemm g{(const bf16*)(F.ws + WS_A0), (const bf16*)(F.ws + WS_WOUT), ML, D, D}; pg8::StaticOrder S; S.init(ML, D, F.G, (int)blockIdx.x);
        pg8::EpiF32 E{(float*)(F.ws + WS_MIX), D};
        pg8::gemm_phase<pg8::EpiF32, pg8::StaticOrder, true, true>(F.lds + RING_OFF, g, S, E);
        __syncthreads(); }
        if (DUP(8)) {         pg8::Gemm g{(const bf16*)(F.ws + WS_A0), (const bf16*)(F.ws + WS_WOUT), ML, D, D}; pg8::StaticOrder S; S.init(ML, D, F.G, (int)blockIdx.x);
        pg8::EpiF32 E{(float*)(F.ws + WS_MIX), D};
        pg8::gemm_phase<pg8::EpiF32, pg8::StaticOrder, true, true>(F.lds + RING_OFF, g, S, E);
        __syncthreads(); }
        SEAM(7); }
    if (IN(8)) { phase_x1h2_route(F); SEAM(8); }
    if (IN(9)) { phase_scatter(F); if (DUP(12)) { __syncthreads(); phase_scatter(F); } SEAM(9); }
    if (IN(10)) {
        {         const int* blkE = (const int*)(F.ws + MI_BLKE);
        pg8::Gemm g{(const bf16*)(F.ws + WS_XB), (const bf16*)(F.ws + WS_WEIN), NROWS, 2048, D};
        pg8::MoeOrder<8> S{blkE, __hip_atomic_load(blkE + MAXBLK, __ATOMIC_RELAXED, __HIP_MEMORY_SCOPE_AGENT) * 8, F.G, (int)blockIdx.x};
        pg8::EpiSwigluI8 E{(bf16*)(F.ws + WS_ACT), KIN(I_BEI), (const float*)(F.ws + MI_RSXB), (const float*)(F.ws + MI_CSWEI)};
        pg8::gemm_phase_i8<pg8::EpiSwigluI8, pg8::MoeOrder<8>, true, true>(F.lds + RING_OFF, g, S, E); __syncthreads(); }
        if (DUP(13)) {         const int* blkE = (const int*)(F.ws + MI_BLKE);
        pg8::Gemm g{(const bf16*)(F.ws + WS_XB), (const bf16*)(F.ws + WS_WEIN), NROWS, 2048, D};
        pg8::MoeOrder<8> S{blkE, __hip_atomic_load(blkE + MAXBLK, __ATOMIC_RELAXED, __HIP_MEMORY_SCOPE_AGENT) * 8, F.G, (int)blockIdx.x};
        pg8::EpiSwigluI8 E{(bf16*)(F.ws + WS_ACT), KIN(I_BEI), (const float*)(F.ws + MI_RSXB), (const float*)(F.ws + MI_CSWEI)};
        pg8::gemm_phase_i8<pg8::EpiSwigluI8, pg8::MoeOrder<8>, true, true>(F.lds + RING_OFF, g, S, E); __syncthreads(); }
        SEAM(10); }
    if (IN(11)) {
        {         const int* blkE = (const int*)(F.ws + MI_BLKE);
        pg8::Gemm g{(const bf16*)(F.ws + WS_ACT), (const bf16*)(F.ws + WS_WEOUT), NROWS, D, D};
        pg8::MoeOrder<4> S{blkE, __hip_atomic_load(blkE + MAXBLK, __ATOMIC_RELAXED, __HIP_MEMORY_SCOPE_AGENT) * 4, F.G, (int)blockIdx.x};
        pg8::EpiBf16 E{(bf16*)(F.ws + WS_Y2), D, KIN(I_BEO), D};
        pg8::gemm_phase<pg8::EpiBf16, pg8::MoeOrder<4>, true, true>(F.lds + RING_OFF, g, S, E); __syncthreads(); }
        if (DUP(14)) {         const int* blkE = (const int*)(F.ws + MI_BLKE);
        pg8::Gemm g{(const bf16*)(F.ws + WS_ACT), (const bf16*)(F.ws + WS_WEOUT), NROWS, D, D};
        pg8::MoeOrder<4> S{blkE, __hip_atomic_load(blkE + MAXBLK, __ATOMIC_RELAXED, __HIP_MEMORY_SCOPE_AGENT) * 4, F.G, (int)blockIdx.x};
        pg8::EpiBf16 E{(bf16*)(F.ws + WS_Y2), D, KIN(I_BEO), D};
        pg8::gemm_phase<pg8::EpiBf16, pg8::MoeOrder<4>, true, true>(F.lds + RING_OFF, g, S, E); __syncthreads(); }
        SEAM(11); }
    if (IN(12)) { phase_combine(F); if (DUP(15)) { __syncthreads(); phase_combine(F); } }
#undef IN
#undef SEAM
}

#ifndef MK_N_LAUNCHES
#define MK_N_LAUNCHES 1
#endif
extern "C" void kernel_launch(void* const* d_in, const int* in_sizes, int n_in, void* d_out, int out_size, void* d_ws, size_t ws_size, hipStream_t stream) {
    static int grid = 0;
    if (grid == 0) {
        if (n_in != 30 || out_size != ML * D || ws_size < WS_END) { fprintf(stderr, "kernel_launch: unexpected shapes (n_in %d out %d ws %zu, need %zu); nothing launched\n", n_in, out_size, ws_size, (size_t)WS_END); grid = -1; return; }
        int dev = 0, cus = 0, per_cu = 0;
        if (hipGetDevice(&dev) != hipSuccess || hipDeviceGetAttribute(&cus, hipDeviceAttributeMultiprocessorCount, dev) != hipSuccess) { grid = -1; return; }
        if (hipFuncSetAttribute((const void*)fwd, hipFuncAttributeMaxDynamicSharedMemorySize, LDS_BYTES) != hipSuccess) { fprintf(stderr, "kernel_launch: hipFuncSetAttribute failed\n"); grid = -1; return; }
        if (hipOccupancyMaxActiveBlocksPerMultiprocessor(&per_cu, (const void*)fwd, NWAVES * 64, LDS_BYTES) != hipSuccess || per_cu < 1)
            fprintf(stderr, "kernel_launch: note: occupancy query reports %d workgroups per CU\n", per_cu);
        (void)hipGetLastError();
        grid = cus;
    }
    if (grid < 0) return;
    if (hipMemsetAsync((char*)d_ws + WS_CTL, 0, CTL_ZERO_BYTES, stream) != hipSuccess) return;
    Args a{};
    for (int i = 0; i < 30; ++i) a.in[i] = (const float*)d_in[i];
    a.out = (float*)d_out; a.ws = (unsigned char*)d_ws;
    if (MK_N_LAUNCHES == 1) { a.ph_lo = 0; a.ph_hi = N_PHASES; hipLaunchKernelGGL(fwd, dim3(grid), dim3(NWAVES * 64), LDS_BYTES, stream, a); }
    else for (int p = 0; p < N_PHASES; ++p) { a.ph_lo = p; a.ph_hi = p + 1; hipLaunchKernelGGL(fwd, dim3(grid), dim3(NWAVES * 64), LDS_BYTES, stream, a); }
}
```

```cpp
#include <hip/hip_runtime.h>
#include <cstdio>
#include <cstdint>

namespace pg8 {
#define PG8_LAS __attribute__((address_space(3)))
typedef unsigned short bf16_t;
typedef short bf16x8 __attribute__((ext_vector_type(8)));
typedef float f32x4 __attribute__((ext_vector_type(4)));
typedef unsigned u32x4 __attribute__((ext_vector_type(4)));
constexpr int BM = 256, BK = 64, HALF = 128, HTB = HALF * BK * 2  , STAGE_BYTES = 8 * HTB, NXCD = 8, WGM = 8;

__host__ __device__ __forceinline__ int lds_byte(int r, int c) { const int st = (r >> 4) * 2 + (c >> 5), rr = r & 15, cc = c & 31, ob = rr * 64 + cc * 2; return st * 1024 + (ob ^ (((ob >> 9) & 1) << 5)); }
__host__ __device__ __forceinline__ void stage_rc(int b, int& R, int& C) { const int st = b / 1024, sb = b % 1024, swz = sb ^ (((sb >> 9) & 1) << 5); R = (st >> 1) * 16 + swz / 64; C = (st & 1) * 32 + (swz % 64) / 2; }
__host__ __device__ __forceinline__ int perm32(int rho) { const int n = rho >> 4, i = rho & 15; return 8 * (i >> 2) + 4 * n + (i & 3); }

struct Unit { int pm, pn, pb, e; };
struct Gemm { const bf16_t* A; const bf16_t* Bt; int M, N, K; };

struct StaticOrder {
    int nM, nN, nwg, G, c;
    __host__ __device__ void init(int M, int N, int G_, int c_) { nM = M / BM; nN = N / BM; nwg = nM * nN; G = G_; c = c_; }
    __host__ __device__ bool next(int i, Unit& u) const {
        const long L = (long)i * G + c; if (L >= nwg) return false;
        int wgid = (int)L; { const int q = nwg / NXCD, r = nwg % NXCD, xcd = wgid % NXCD, off = wgid / NXCD; wgid = (xcd < r ? xcd * (q + 1) : r * (q + 1) + (xcd - r) * q) + off; }
        const int nig = WGM * nN, gid = wgid / nig, fm = gid * WGM, gsz = (nM - fm) < WGM ? (nM - fm) : WGM;
        u.pm = fm + ((wgid % nig) % gsz); u.pn = (wgid % nig) / gsz; u.pb = u.pn; u.e = 0; return true;
    }
    __device__ __forceinline__ void a_ready(const Unit&) const {}
    __device__ __forceinline__ void done(const Unit&) const {}
};
template <int NT> struct MoeOrder {
    const PG8_LAS int* blk_e; int nunits, G, c;
    __device__ bool next(int i, Unit& u) const {
        int L;
        if ((G & 7) == 0 && ((G >> 3) % NT) == 0) { const int per = G >> 3, xcd = c & 7, k = c >> 3, bpx = per / NT;
            const int base = i * G, R = nunits - base;
            if (R > 0 && R < G && (R & 7) == 0) { const int rpx = R >> 3; if (k >= rpx) return false; L = base + xcd * rpx + k; }
            else L = ((i * 8 + xcd) * bpx + k / NT) * NT + (k % NT); }
        else L = i * G + c;
        if (L >= nunits) return false;
        const int blk = L / NT, pn = L % NT; const int e = blk_e[blk];
        u.pm = blk; u.pn = pn; u.pb = e * NT + pn; u.e = e; return true;
    }
    __device__ __forceinline__ void a_ready(const Unit&) const {}
    __device__ __forceinline__ void done(const Unit&) const {}
};

__device__ __forceinline__ unsigned cvt_pk_bf16(float lo, float hi) { unsigned r; asm volatile("v_cvt_pk_bf16_f32 %0, %1, %2" : "=v"(r) : "v"(lo), "v"(hi)); return r; }

struct EpiF32 {
    static constexpr bool PERM = false, AFTER_DRAIN = false; static constexpr int NSTORE = 32;
    float* C; int ldc;
    __device__ __forceinline__ void operator()(const f32x4 (&acc)[2][2][4][2], const Unit& u, int wr, int wc, int fr, int fq) const {
        const int row0 = u.pm * BM + wr * 64 + fr, col0 = u.pn * BM + wc * 32 + 4 * fq;
#pragma unroll
        for (int ai = 0; ai < 2; ++ai)
#pragma unroll
            for (int m = 0; m < 4; ++m) { float* rowp = C + (size_t)(row0 + ai * HALF + m * 16) * ldc + col0;
#pragma unroll
                for (int bj = 0; bj < 2; ++bj)
#pragma unroll
                    for (int n = 0; n < 2; ++n) __builtin_nontemporal_store(acc[ai][bj][m][n], (f32x4*)(rowp + bj * HALF + n * 16)); }
    }
};
struct EpiBf16 {
    static constexpr bool PERM = true, AFTER_DRAIN = false; static constexpr int NSTORE = 16;
    bf16_t* O; int ldc; const float* bias; int bias_estride;
    __device__ __forceinline__ void operator()(const f32x4 (&acc)[2][2][4][2], const Unit& u, int wr, int wc, int fr, int fq) const {
        const int row0 = u.pm * BM + wr * 64 + fr; const int col0 = u.pn * BM + wc * 32 + 8 * fq;
        const float* bp = bias ? bias + (size_t)u.e * bias_estride + col0 : nullptr;
        f32x4 bv[2][2];
#pragma unroll
        for (int bj = 0; bj < 2; ++bj)
#pragma unroll
            for (int n = 0; n < 2; ++n) bv[bj][n] = bp ? *(const f32x4*)(bp + bj * HALF + 4 * n) : (f32x4){0.f, 0.f, 0.f, 0.f};
#pragma unroll
        for (int ai = 0; ai < 2; ++ai)
#pragma unroll
            for (int m = 0; m < 4; ++m) { bf16_t* rowp = O + (size_t)(row0 + ai * HALF + m * 16) * ldc + col0;
#pragma unroll
                for (int bj = 0; bj < 2; ++bj) { const f32x4 v0 = acc[ai][bj][m][0] + bv[bj][0], v1 = acc[ai][bj][m][1] + bv[bj][1];
                    u32x4 w; w.x = cvt_pk_bf16(v0[0], v0[1]); w.y = cvt_pk_bf16(v0[2], v0[3]); w.z = cvt_pk_bf16(v1[0], v1[1]); w.w = cvt_pk_bf16(v1[2], v1[3]);
                    __builtin_nontemporal_store(w, (u32x4*)(rowp + bj * HALF)); } }
    }
};
struct EpiSwiglu {
    static constexpr bool PERM = true, AFTER_DRAIN = false; static constexpr int NSTORE = 8;
    bf16_t* O; const float* bias;
    __device__ __forceinline__ float act1(float g, float up) const {
        g = fminf(g, 7.0f); up = fminf(fmaxf(up, -7.0f), 7.0f);
        const float sg = 1.0f / (1.0f + __expf(-1.702f * g));
        return (up + 1.0f) * g * sg;
    }
    __device__ __forceinline__ void operator()(const f32x4 (&acc)[2][2][4][2], const Unit& u, int wr, int wc, int fr, int fq) const {
        const int row0 = u.pm * BM + wr * 64 + fr; const int col0 = u.pn * HALF + wc * 32 + 8 * fq;
        const float* bp = bias + (size_t)u.e * 2048 + col0;
        f32x4 bg[2], bu[2];
#pragma unroll
        for (int n = 0; n < 2; ++n) { bg[n] = *(const f32x4*)(bp + 4 * n); bu[n] = *(const f32x4*)(bp + 1024 + 4 * n); }
#pragma unroll
        for (int ai = 0; ai < 2; ++ai)
#pragma unroll
            for (int m = 0; m < 4; ++m) { bf16_t* rowp = O + (size_t)(row0 + ai * HALF + m * 16) * 1024 + col0;
                const f32x4 g0 = acc[ai][0][m][0] + bg[0], g1 = acc[ai][0][m][1] + bg[1], u0 = acc[ai][1][m][0] + bu[0], u1 = acc[ai][1][m][1] + bu[1];
                u32x4 w; w.x = cvt_pk_bf16(act1(g0[0], u0[0]), act1(g0[1], u0[1])); w.y = cvt_pk_bf16(act1(g0[2], u0[2]), act1(g0[3], u0[3]));
                w.z = cvt_pk_bf16(act1(g1[0], u1[0]), act1(g1[1], u1[1])); w.w = cvt_pk_bf16(act1(g1[2], u1[2]), act1(g1[3], u1[3]));
                __builtin_nontemporal_store(w, (u32x4*)rowp); }
    }
};


typedef int i32x4 __attribute__((ext_vector_type(4)));
struct EpiBf16I8 {
    static constexpr bool PERM = true, AFTER_DRAIN = false; static constexpr int NSTORE = 16;
    bf16_t* O; int ldc; const float* rs; const float* cs;
    __device__ __forceinline__ void operator()(const i32x4 (&acc)[2][2][4][2], const Unit& u, int wr, int wc, int fr, int fq) const {
        const int row0 = u.pm * BM + wr * 64 + fr; const int col0 = u.pn * BM + wc * 32 + 8 * fq;
        const float* cp = cs + (size_t)u.pb * BM + wc * 32 + 8 * fq;
        f32x4 cv[2][2]; float rsv[2][4];
#pragma unroll
        for (int bj = 0; bj < 2; ++bj)
#pragma unroll
            for (int n = 0; n < 2; ++n) cv[bj][n] = *(const f32x4*)(cp + bj * HALF + 4 * n);
#pragma unroll
        for (int ai = 0; ai < 2; ++ai)
#pragma unroll
            for (int m = 0; m < 4; ++m) rsv[ai][m] = rs[row0 + ai * HALF + m * 16];
#pragma unroll
        for (int ai = 0; ai < 2; ++ai)
#pragma unroll
            for (int m = 0; m < 4; ++m) { const int row = row0 + ai * HALF + m * 16; const float r = rsv[ai][m]; bf16_t* rowp = O + (size_t)row * ldc + col0;
#pragma unroll
                for (int bj = 0; bj < 2; ++bj) { const i32x4 a0 = acc[ai][bj][m][0], a1 = acc[ai][bj][m][1];
                    const f32x4 v0 = (f32x4){(float)a0[0], (float)a0[1], (float)a0[2], (float)a0[3]} * cv[bj][0] * r, v1 = (f32x4){(float)a1[0], (float)a1[1], (float)a1[2], (float)a1[3]} * cv[bj][1] * r;
                    u32x4 w; w.x = cvt_pk_bf16(v0[0], v0[1]); w.y = cvt_pk_bf16(v0[2], v0[3]); w.z = cvt_pk_bf16(v1[0], v1[1]); w.w = cvt_pk_bf16(v1[2], v1[3]);
                    __builtin_nontemporal_store(w, (u32x4*)(rowp + bj * HALF)); } }
    }
};
struct EpiSwigluI8 {
    static constexpr bool PERM = true, AFTER_DRAIN = false; static constexpr int NSTORE = 8;
    bf16_t* O; const float* bias; const float* rs; const float* cs;
    __device__ __forceinline__ float act1(float g, float up) const {
        g = fminf(g, 7.0f); up = fminf(fmaxf(up, -7.0f), 7.0f);
        const float sg = __builtin_amdgcn_rcpf(1.0f + __expf(-1.702f * g));
        return (up + 1.0f) * g * sg;
    }
    __device__ __forceinline__ void operator()(const i32x4 (&acc)[2][2][4][2], const Unit& u, int wr, int wc, int fr, int fq) const {
        const int row0 = u.pm * BM + wr * 64 + fr; const int col0 = u.pn * HALF + wc * 32 + 8 * fq;
        const float* bp = bias + (size_t)u.e * 2048 + col0;
        const float* cp = cs + (size_t)u.pb * BM + wc * 32 + 8 * fq;
        f32x4 bg[2], bu[2], cg[2], cu[2]; float rsv[2][4];
#pragma unroll
        for (int n = 0; n < 2; ++n) { bg[n] = *(const f32x4*)(bp + 4 * n); bu[n] = *(const f32x4*)(bp + 1024 + 4 * n); cg[n] = *(const f32x4*)(cp + 4 * n); cu[n] = *(const f32x4*)(cp + HALF + 4 * n); }
#pragma unroll
        for (int ai = 0; ai < 2; ++ai)
#pragma unroll
            for (int m = 0; m < 4; ++m) rsv[ai][m] = rs[row0 + ai * HALF + m * 16];
#pragma unroll
        for (int ai = 0; ai < 2; ++ai)
#pragma unroll
            for (int m = 0; m < 4; ++m) { const int row = row0 + ai * HALF + m * 16; const float r = rsv[ai][m]; bf16_t* rowp = O + (size_t)row * 1024 + col0;
                f32x4 g[2], up[2];
#pragma unroll
                for (int n = 0; n < 2; ++n) { const i32x4 ag = acc[ai][0][m][n], au = acc[ai][1][m][n];
                    g[n] = (f32x4){(float)ag[0], (float)ag[1], (float)ag[2], (float)ag[3]} * cg[n] * r + bg[n];
                    up[n] = (f32x4){(float)au[0], (float)au[1], (float)au[2], (float)au[3]} * cu[n] * r + bu[n]; }
                u32x4 w; w.x = cvt_pk_bf16(act1(g[0][0], up[0][0]), act1(g[0][1], up[0][1])); w.y = cvt_pk_bf16(act1(g[0][2], up[0][2]), act1(g[0][3], up[0][3]));
                w.z = cvt_pk_bf16(act1(g[1][0], up[1][0]), act1(g[1][1], up[1][1])); w.w = cvt_pk_bf16(act1(g[1][2], up[1][2]), act1(g[1][3], up[1][3]));
                __builtin_nontemporal_store(w, (u32x4*)rowp); }
    }
};
template <class Epi, class Sched, bool ALIGN_EPI = false, bool SP2 = false>
__device__ __forceinline__ void gemm_phase(PG8_LAS unsigned char* lds, const Gemm g, const Sched& S, const Epi& E) {
    const int tid = threadIdx.x, wid = __builtin_amdgcn_readfirstlane(tid >> 6), lane = tid & 63, wr = wid >> 2, wc = wid & 3, fr = lane & 15, fq = lane >> 4;
    const int K = g.K, nt = K / BK;
    unsigned voffA[2], voffB[2];
#pragma unroll
    for (int i = 0; i < 2; ++i) { int R, C; stage_rc(tid * 16 + i * 8192, R, C); const int Rb = Epi::PERM ? ((R & ~31) + perm32(R & 31)) : R;
        voffA[i] = (unsigned)(R * K + C) * 2u; voffB[i] = (unsigned)(Rb * K + C) * 2u; }
    const size_t kstep = (size_t)(BK * 2);
    const size_t hstep = (size_t)HALF * K * 2;
    const size_t tstep = 2 * hstep;
    const unsigned ldsw = (unsigned)wid * 1024u;
    const int aoff = lds_byte(wr * 64 + fr, fq * 8), boff = lds_byte(wc * 32 + fr, fq * 8);
#define PG8_SA(b, h) (((b) * 2 + (h)) * HTB)
#define PG8_SB(b, h) ((4 + (b) * 2 + (h)) * HTB)
#define PG8_STAGE(bufoff, gbase, voff) do { _Pragma("unroll") for (int _i = 0; _i < 2; ++_i) \
        __builtin_amdgcn_global_load_lds((const unsigned*)((const char*)(gbase) + (voff)[_i]), (PG8_LAS unsigned*)(lds + (bufoff) + ldsw + _i * 8192), 16, 0, 0); } while (0)
#define PG8_LDA(dst, b, h) do { _Pragma("unroll") for (int m = 0; m < 4; ++m) _Pragma("unroll") for (int k = 0; k < 2; ++k) dst[m][k] = *(const PG8_LAS bf16x8*)(lds + PG8_SA(b, h) + aoff + m * 2048 + k * 1024); } while (0)
#define PG8_LDB(dst, b, h) do { _Pragma("unroll") for (int n = 0; n < 2; ++n) _Pragma("unroll") for (int k = 0; k < 2; ++k) dst[n][k] = *(const PG8_LAS bf16x8*)(lds + PG8_SB(b, h) + boff + n * 2048 + k * 1024); } while (0)
#define PG8_MMA(ai, bj, At, Bt) do { __builtin_amdgcn_s_setprio(1); _Pragma("unroll") for (int m = 0; m < 4; ++m) _Pragma("unroll") for (int n = 0; n < 2; ++n) _Pragma("unroll") for (int k = 0; k < 2; ++k) \
        acc[ai][bj][m][n] = __builtin_amdgcn_mfma_f32_16x16x32_bf16(Bt[n][k], At[m][k], acc[ai][bj][m][n], 0, 0, 0); __builtin_amdgcn_s_setprio(0); } while (0)
#define PG8_WAIT_V(n) asm volatile("s_waitcnt vmcnt(" #n ")" ::: "memory")
#define PG8_WAIT_L(n) asm volatile("s_waitcnt lgkmcnt(" #n ")" ::: "memory")
#define PG8_WAIT_V8R(rx) asm volatile("s_waitcnt vmcnt(%1)\n\ts_cmp_lg_u32 %0, 0\n\ts_cbranch_scc1 .Lpg8w_%=\n\ts_waitcnt vmcnt(8)\n.Lpg8w_%=:" :: "s"(rx), "n"(8 + Epi::NSTORE) : "scc", "memory")
#define PG8_BAR __builtin_amdgcn_s_barrier()
#define PG8_SCHED __builtin_amdgcn_sched_barrier(0)
    Unit cur, nxt; int ui = 0;
    if (!S.next(0, cur)) return;
    f32x4 acc[2][2][4][2];
#pragma unroll
    for (int a = 0; a < 2; ++a)
#pragma unroll
        for (int b = 0; b < 2; ++b)
#pragma unroll
            for (int m = 0; m < 4; ++m)
#pragma unroll
                for (int n = 0; n < 2; ++n) acc[a][b][m][n] = (f32x4){0.f, 0.f, 0.f, 0.f};
    bf16x8 At[4][2], B0[2][2], B1[2][2];
    const char* cA = (const char*)g.A + (size_t)cur.pm * tstep; const char* cB = (const char*)g.Bt + (size_t)cur.pb * tstep;
    S.a_ready(cur);
    if constexpr (SP2) {
        PG8_STAGE(PG8_SB(0, 0), cB, voffB); PG8_STAGE(PG8_SB(0, 1), cB + hstep, voffB); PG8_STAGE(PG8_SA(0, 0), cA, voffA); PG8_STAGE(PG8_SA(0, 1), cA + hstep, voffA);
        if (wr == 1) PG8_BAR;
        PG8_WAIT_V(2); PG8_BAR;
        PG8_STAGE(PG8_SB(1, 0), cB + kstep, voffB); PG8_STAGE(PG8_SA(1, 0), cA + kstep, voffA); PG8_STAGE(PG8_SB(1, 1), cB + hstep + kstep, voffB);
        PG8_WAIT_V(6); PG8_BAR;
    } else {
        PG8_STAGE(PG8_SB(0, 0), cB, voffB); PG8_STAGE(PG8_SA(0, 0), cA, voffA); PG8_STAGE(PG8_SB(0, 1), cB + hstep, voffB); PG8_STAGE(PG8_SA(0, 1), cA + hstep, voffA);
        if (wr == 1) PG8_BAR;
        PG8_WAIT_V(4); PG8_BAR;
        PG8_STAGE(PG8_SB(1, 0), cB + kstep, voffB); PG8_STAGE(PG8_SA(1, 0), cA + kstep, voffA); PG8_STAGE(PG8_SB(1, 1), cB + hstep + kstep, voffB);
        PG8_WAIT_V(6); PG8_BAR;
    }
    for (;;) {
        const bool has_next = S.next(ui + 1, nxt);
        const char* nA = has_next ? (const char*)g.A + (size_t)nxt.pm * tstep : cA; const char* nB = has_next ? (const char*)g.Bt + (size_t)nxt.pb * tstep : cB;
        for (int t = 0; t < nt; t += 2) {
            const bool last = (t == nt - 2);
            const char* a1 = cA + (size_t)(t + 1) * kstep;
            const char* a2 = last ? nA : cA + (size_t)(t + 2) * kstep; const char* b2 = last ? nB : cB + (size_t)(t + 2) * kstep;
            const char* a3 = a2 + kstep; const char* b3 = b2 + kstep;
            if (last && has_next) S.a_ready(nxt);
            const int relax = __builtin_amdgcn_readfirstlane(((t == 0) && (ui > 0)) ? 1 : 0);
            if constexpr (SP2) {
            PG8_LDB(B0, 0, 0); PG8_LDB(B1, 0, 1); PG8_SCHED; PG8_LDA(At, 0, 0); PG8_STAGE(PG8_SA(1, 1), a1 + hstep, voffA);
            PG8_WAIT_V8R(relax); PG8_WAIT_L(0); PG8_BAR; PG8_MMA(0, 0, At, B0); PG8_MMA(0, 1, At, B1); PG8_BAR; PG8_SCHED;
            PG8_LDA(At, 0, 1); PG8_STAGE(PG8_SB(0, 0), b2, voffB); PG8_STAGE(PG8_SB(0, 1), b2 + hstep, voffB); PG8_STAGE(PG8_SA(0, 0), a2, voffA);
            PG8_WAIT_V8R(relax); PG8_WAIT_L(0); PG8_BAR; PG8_MMA(1, 0, At, B0); PG8_MMA(1, 1, At, B1); PG8_BAR; PG8_SCHED;
            PG8_LDB(B0, 1, 0); PG8_LDB(B1, 1, 1); PG8_SCHED; PG8_LDA(At, 1, 0); PG8_STAGE(PG8_SA(0, 1), a2 + hstep, voffA);
            PG8_WAIT_V(8); PG8_WAIT_L(0); PG8_BAR; PG8_MMA(0, 0, At, B0); PG8_MMA(0, 1, At, B1); PG8_BAR; PG8_SCHED;
            PG8_LDA(At, 1, 1); PG8_STAGE(PG8_SB(1, 0), b3, voffB); PG8_STAGE(PG8_SB(1, 1), b3 + hstep, voffB); PG8_STAGE(PG8_SA(1, 0), a3, voffA);
            PG8_WAIT_V(8); PG8_WAIT_L(0); PG8_BAR; PG8_MMA(1, 0, At, B0); PG8_MMA(1, 1, At, B1); PG8_BAR; PG8_SCHED;
            } else {
            PG8_LDB(B0, 0, 0); PG8_SCHED; PG8_LDA(At, 0, 0); PG8_STAGE(PG8_SA(1, 1), a1 + hstep, voffA);
            PG8_WAIT_L(8); PG8_BAR; PG8_WAIT_L(0); PG8_MMA(0, 0, At, B0); PG8_BAR; PG8_SCHED;
            PG8_LDB(B1, 0, 1); PG8_STAGE(PG8_SB(0, 0), b2, voffB);
            PG8_BAR; PG8_WAIT_L(0); PG8_MMA(0, 1, At, B1); PG8_BAR;
            PG8_LDA(At, 0, 1); PG8_STAGE(PG8_SA(0, 0), a2, voffA);
            PG8_BAR; PG8_WAIT_L(0); PG8_MMA(1, 0, At, B0); PG8_BAR; PG8_SCHED;
            PG8_STAGE(PG8_SB(0, 1), b2 + hstep, voffB);
            PG8_WAIT_V(6); PG8_BAR; PG8_MMA(1, 1, At, B1); PG8_BAR;
            PG8_LDB(B0, 1, 0); PG8_SCHED; PG8_LDA(At, 1, 0); PG8_STAGE(PG8_SA(0, 1), a2 + hstep, voffA);
            PG8_WAIT_L(8); PG8_BAR; PG8_WAIT_L(0); PG8_MMA(0, 0, At, B0); PG8_BAR; PG8_SCHED;
            PG8_LDB(B1, 1, 1); PG8_STAGE(PG8_SB(1, 0), b3, voffB);
            PG8_BAR; PG8_WAIT_L(0); PG8_MMA(0, 1, At, B1); PG8_BAR;
            PG8_LDA(At, 1, 1); PG8_STAGE(PG8_SA(1, 0), a3, voffA);
            PG8_BAR; PG8_WAIT_L(0); PG8_MMA(1, 0, At, B0); PG8_BAR; PG8_SCHED;
            PG8_STAGE(PG8_SB(1, 1), b3 + hstep, voffB);
            PG8_WAIT_V(6); PG8_BAR; PG8_MMA(1, 1, At, B1); PG8_BAR;
            }
        }
        if constexpr (ALIGN_EPI) { if (wr == 0) PG8_BAR; }
        if constexpr (!Epi::AFTER_DRAIN) { E(acc, cur, wr, wc, fr, fq); S.done(cur); }
        if (!has_next) break;
#pragma unroll
        for (int a = 0; a < 2; ++a)
#pragma unroll
            for (int b = 0; b < 2; ++b)
#pragma unroll
                for (int m = 0; m < 4; ++m)
#pragma unroll
                    for (int n = 0; n < 2; ++n) acc[a][b][m][n] = (f32x4){0.f, 0.f, 0.f, 0.f};
        cur = nxt; cA = nA; cB = nB; ++ui;
        if constexpr (ALIGN_EPI) { if (wr == 1) PG8_BAR; }
    }
    PG8_WAIT_V(0);
    if constexpr (!ALIGN_EPI) { if (wr == 0) PG8_BAR; }
    PG8_BAR;
    if constexpr (Epi::AFTER_DRAIN) { E.fused(acc, cur, wr, wc, fr, fq, lds, wid, lane); S.done(cur); }
#undef PG8_SA
#undef PG8_SB
#undef PG8_STAGE
#undef PG8_LDA
#undef PG8_LDB
#undef PG8_MMA
#undef PG8_WAIT_V
#undef PG8_WAIT_L
#undef PG8_WAIT_V8R
#undef PG8_BAR
#undef PG8_SCHED
}
template <class Epi, class Sched, bool ALIGN_EPI = false, bool SP2 = false>
__device__ __forceinline__ void gemm_phase_i8(PG8_LAS unsigned char* lds, const Gemm g, const Sched& S, const Epi& E) {
    const int tid = threadIdx.x, wid = __builtin_amdgcn_readfirstlane(tid >> 6), lane = tid & 63, wr = wid >> 2, wc = wid & 3, fr = lane & 15, fq = lane >> 4;
    const int K = g.K, nt = K / 128;
    unsigned voffA[2], voffB[2];
#pragma unroll
    for (int i = 0; i < 2; ++i) { int R, C; stage_rc(tid * 16 + i * 8192, R, C); const int Rb = Epi::PERM ? ((R & ~31) + perm32(R & 31)) : R;
        voffA[i] = (unsigned)(R * K + C * 2); voffB[i] = (unsigned)(Rb * K + C * 2); }
    const size_t kstep = (size_t)(BK * 2);
    const size_t hstep = (size_t)HALF * K;
    const size_t tstep = 2 * hstep;
    const unsigned ldsw = (unsigned)wid * 1024u;
    const int aoff = lds_byte(wr * 64 + fr, fq * 8), boff = lds_byte(wc * 32 + fr, fq * 8);
#define PG8_SA(b, h) (((b) * 2 + (h)) * HTB)
#define PG8_SB(b, h) ((4 + (b) * 2 + (h)) * HTB)
#define PG8_STAGE(bufoff, gbase, voff) do { _Pragma("unroll") for (int _i = 0; _i < 2; ++_i) \
        __builtin_amdgcn_global_load_lds((const unsigned*)((const char*)(gbase) + (voff)[_i]), (PG8_LAS unsigned*)(lds + (bufoff) + ldsw + _i * 8192), 16, 0, 0); } while (0)
#define PG8_LDA(dst, b, h) do { _Pragma("unroll") for (int m = 0; m < 4; ++m) _Pragma("unroll") for (int k = 0; k < 2; ++k) dst[m][k] = *(const PG8_LAS bf16x8*)(lds + PG8_SA(b, h) + aoff + m * 2048 + k * 1024); } while (0)
#define PG8_LDB(dst, b, h) do { _Pragma("unroll") for (int n = 0; n < 2; ++n) _Pragma("unroll") for (int k = 0; k < 2; ++k) dst[n][k] = *(const PG8_LAS bf16x8*)(lds + PG8_SB(b, h) + boff + n * 2048 + k * 1024); } while (0)
#define PG8_MMA(ai, bj, At, Bt) do { __builtin_amdgcn_s_setprio(1); _Pragma("unroll") for (int m = 0; m < 4; ++m) _Pragma("unroll") for (int n = 0; n < 2; ++n) _Pragma("unroll") for (int k = 0; k < 2; ++k) \
        acc[ai][bj][m][n] = __builtin_amdgcn_mfma_i32_16x16x64_i8(__builtin_bit_cast(i32x4, Bt[n][k]), __builtin_bit_cast(i32x4, At[m][k]), acc[ai][bj][m][n], 0, 0, 0); __builtin_amdgcn_s_setprio(0); } while (0)
#define PG8_WAIT_V(n) asm volatile("s_waitcnt vmcnt(" #n ")" ::: "memory")
#define PG8_WAIT_L(n) asm volatile("s_waitcnt lgkmcnt(" #n ")" ::: "memory")
#define PG8_WAIT_V8R(rx) asm volatile("s_waitcnt vmcnt(%1)\n\ts_cmp_lg_u32 %0, 0\n\ts_cbranch_scc1 .Lpg8w_%=\n\ts_waitcnt vmcnt(8)\n.Lpg8w_%=:" :: "s"(rx), "n"(8 + Epi::NSTORE) : "scc", "memory")
#define PG8_BAR __builtin_amdgcn_s_barrier()
#define PG8_SCHED __builtin_amdgcn_sched_barrier(0)
    Unit cur, nxt; int ui = 0;
    if (!S.next(0, cur)) return;
    i32x4 acc[2][2][4][2];
#pragma unroll
    for (int a = 0; a < 2; ++a)
#pragma unroll
        for (int b = 0; b < 2; ++b)
#pragma unroll
            for (int m = 0; m < 4; ++m)
#pragma unroll
                for (int n = 0; n < 2; ++n) acc[a][b][m][n] = (i32x4){0, 0, 0, 0};
    bf16x8 At[4][2], B0[2][2], B1[2][2];
    const char* cA = (const char*)g.A + (size_t)cur.pm * tstep; const char* cB = (const char*)g.Bt + (size_t)cur.pb * tstep;
    S.a_ready(cur);
    if constexpr (SP2) {
        PG8_STAGE(PG8_SB(0, 0), cB, voffB); PG8_STAGE(PG8_SB(0, 1), cB + hstep, voffB); PG8_STAGE(PG8_SA(0, 0), cA, voffA); PG8_STAGE(PG8_SA(0, 1), cA + hstep, voffA);
        if (wr == 1) PG8_BAR;
        PG8_WAIT_V(2); PG8_BAR;
        PG8_STAGE(PG8_SB(1, 0), cB + kstep, voffB); PG8_STAGE(PG8_SA(1, 0), cA + kstep, voffA); PG8_STAGE(PG8_SB(1, 1), cB + hstep + kstep, voffB);
        PG8_WAIT_V(6); PG8_BAR;
    } else {
        PG8_STAGE(PG8_SB(0, 0), cB, voffB); PG8_STAGE(PG8_SA(0, 0), cA, voffA); PG8_STAGE(PG8_SB(0, 1), cB + hstep, voffB); PG8_STAGE(PG8_SA(0, 1), cA + hstep, voffA);
        if (wr == 1) PG8_BAR;
        PG8_WAIT_V(4); PG8_BAR;
        PG8_STAGE(PG8_SB(1, 0), cB + kstep, voffB); PG8_STAGE(PG8_SA(1, 0), cA + kstep, voffA); PG8_STAGE(PG8_SB(1, 1), cB + hstep + kstep, voffB);
        PG8_WAIT_V(6); PG8_BAR;
    }
    for (;;) {
        const bool has_next = S.next(ui + 1, nxt);
        const char* nA = has_next ? (const char*)g.A + (size_t)nxt.pm * tstep : cA; const char* nB = has_next ? (const char*)g.Bt + (size_t)nxt.pb * tstep : cB;
        for (int t = 0; t < nt; t += 2) {
            const bool last = (t == nt - 2);
            const char* a1 = cA + (size_t)(t + 1) * kstep;
            const char* a2 = last ? nA : cA + (size_t)(t + 2) * kstep; const char* b2 = last ? nB : cB + (size_t)(t + 2) * kstep;
            const char* a3 = a2 + kstep; const char* b3 = b2 + kstep;
            if (last && has_next) S.a_ready(nxt);
            const int relax = __builtin_amdgcn_readfirstlane(((t == 0) && (ui > 0)) ? 1 : 0);
            if constexpr (SP2) {
            PG8_LDB(B0, 0, 0); PG8_LDB(B1, 0, 1); PG8_SCHED; PG8_LDA(At, 0, 0); PG8_STAGE(PG8_SA(1, 1), a1 + hstep, voffA);
            PG8_WAIT_V8R(relax); PG8_WAIT_L(0); PG8_BAR; PG8_MMA(0, 0, At, B0); PG8_MMA(0, 1, At, B1); PG8_BAR; PG8_SCHED;
            PG8_LDA(At, 0, 1); PG8_STAGE(PG8_SB(0, 0), b2, voffB); PG8_STAGE(PG8_SB(0, 1), b2 + hstep, voffB); PG8_STAGE(PG8_SA(0, 0), a2, voffA);
            PG8_WAIT_V8R(relax); PG8_WAIT_L(0); PG8_BAR; PG8_MMA(1, 0, At, B0); PG8_MMA(1, 1, At, B1); PG8_BAR; PG8_SCHED;
            PG8_LDB(B0, 1, 0); PG8_LDB(B1, 1, 1); PG8_SCHED; PG8_LDA(At, 1, 0); PG8_STAGE(PG8_SA(0, 1), a2 + hstep, voffA);
            PG8_WAIT_V(8); PG8_WAIT_L(0); PG8_BAR; PG8_MMA(0, 0, At, B0); PG8_MMA(0, 1, At, B1); PG8_BAR; PG8_SCHED;
            PG8_LDA(At, 1, 1); PG8_STAGE(PG8_SB(1, 0), b3, voffB); PG8_STAGE(PG8_SB(1, 1), b3 + hstep, voffB); PG8_STAGE(PG8_SA(1, 0), a3, voffA);
            PG8_WAIT_V(8); PG8_WAIT_L(0); PG8_BAR; PG8_MMA(1, 0, At, B0); PG8_MMA(1, 1, At, B1); PG8_BAR; PG8_SCHED;
            } else {
            PG8_LDB(B0, 0, 0); PG8_SCHED; PG8_LDA(At, 0, 0); PG8_STAGE(PG8_SA(1, 1), a1 + hstep, voffA);
            PG8_WAIT_L(8); PG8_BAR; PG8_WAIT_L(0); PG8_MMA(0, 0, At, B0); PG8_BAR; PG8_SCHED;
            PG8_LDB(B1, 0, 1); PG8_STAGE(PG8_SB(0, 0), b2, voffB);
            PG8_BAR; PG8_WAIT_L(0); PG8_MMA(0, 1, At, B1); PG8_BAR;
            PG8_LDA(At, 0, 1); PG8_STAGE(PG8_SA(0, 0), a2, voffA);
            PG8_BAR; PG8_WAIT_L(0); PG8_MMA(1, 0, At, B0); PG8_BAR; PG8_SCHED;
            PG8_STAGE(PG8_SB(0, 1), b2 + hstep, voffB);
            PG8_WAIT_V(6); PG8_BAR; PG8_MMA(1, 1, At, B1); PG8_BAR;
            PG8_LDB(B0, 1, 0); PG8_SCHED; PG8_LDA(At, 1, 0); PG8_STAGE(PG8_SA(0, 1), a2 + hstep, voffA);
            PG8_WAIT_L(8); PG8_BAR; PG8_WAIT_L(0); PG8_MMA(0, 0, At, B0); PG8_BAR; PG8_SCHED;
            PG8_LDB(B1, 1, 1); PG8_STAGE(PG8_SB(1, 0), b3, voffB);
            PG8_BAR; PG8_WAIT_L(0); PG8_MMA(0, 1, At, B1); PG8_BAR;
            PG8_LDA(At, 1, 1); PG8_STAGE(PG8_SA(1, 0), a3, voffA);
            PG8_BAR; PG8_WAIT_L(0); PG8_MMA(1, 0, At, B0); PG8_BAR; PG8_SCHED;
            PG8_STAGE(PG8_SB(1, 1), b3 + hstep, voffB);
            PG8_WAIT_V(6); PG8_BAR; PG8_MMA(1, 1, At, B1); PG8_BAR;
            }
        }
        if constexpr (ALIGN_EPI) { if (wr == 0) PG8_BAR; }
        if constexpr (!Epi::AFTER_DRAIN) { E(acc, cur, wr, wc, fr, fq); S.done(cur); }
        if (!has_next) break;
#pragma unroll
        for (int a = 0; a < 2; ++a)
#pragma unroll
            for (int b = 0; b < 2; ++b)
#pragma unroll
                for (int m = 0; m < 4; ++m)
#pragma unroll
                    for (int n = 0; n < 2; ++n) acc[a][b][m][n] = (i32x4){0, 0, 0, 0};
        cur = nxt; cA = nA; cB = nB; ++ui;
        if constexpr (ALIGN_EPI) { if (wr == 1) PG8_BAR; }
    }
    PG8_WAIT_V(0);
    if constexpr (!ALIGN_EPI) { if (wr == 0) PG8_BAR; }
    PG8_BAR;
    if constexpr (Epi::AFTER_DRAIN) { E.fused(acc, cur, wr, wc, fr, fq, lds, wid, lane); S.done(cur); }
#undef PG8_SA
#undef PG8_SB
#undef PG8_STAGE
#undef PG8_LDA
#undef PG8_LDB
#undef PG8_MMA
#undef PG8_WAIT_V
#undef PG8_WAIT_L
#undef PG8_WAIT_V8R
#undef PG8_BAR
#undef PG8_SCHED
}

}
#ifndef STAGE_REP
#define STAGE_REP 0
#endif

constexpr int NWAVES = 8;
#ifndef SEAM_FILL
#define SEAM_FILL 1
#endif
constexpr int D = 1024, BATCH = 2, T = 8192, TC = 256, NH = 16;
constexpr int ML = BATCH * T;
constexpr int MC = BATCH * TC;
constexpr int MT = ML + MC;
constexpr int N_IN = 8576, NZ = 8704;
constexpr int K_OFF = 0, V_OFF = 1024, DECAY_OFF = 2048, ICLR_OFF = 2176, STATE_COLS = 2304, R_OFF = 2304, GLORA_OFF = 3328, SHIFT_COLS = 3456;
constexpr int CONV_OFF = 3456, GATE_OFF = 6528;
constexpr int NE = 32, TOPK = 4, DFF = 1024;
constexpr int NL = 5120, KL = 384;
constexpr int MAXBLK = 288;
constexpr int NROWS = MAXBLK * 256;
constexpr int KSPLIT = 16;

constexpr size_t MiB = 1u << 20;
constexpr size_t WS_CTL = 0, CTL_ZERO_BYTES = 1 * MiB;
constexpr size_t WS_MODP = 1 * MiB;
constexpr size_t WS_WLORA = 3 * MiB;
constexpr size_t WS_WROUT = 7 * MiB;
constexpr size_t WS_WOUT = 8 * MiB;
constexpr size_t WS_WIN = 10 * MiB;
constexpr size_t WS_A0 = 28 * MiB;
constexpr size_t WS_MISC = 61 * MiB;
constexpr size_t WS_Z = 64 * MiB;
constexpr size_t WS_AL = 345 * MiB;
constexpr size_t WS_LORA = 358 * MiB;
constexpr size_t WS_SCAN = 523 * MiB;
constexpr size_t WS_Y = 886 * MiB;
constexpr size_t WS_END = 1014 * MiB;
constexpr size_t WS_PQ = WS_SCAN;
constexpr size_t WS_TKN = WS_PQ + 132 * MiB;
constexpr size_t WS_UPRE = WS_TKN + 66 * MiB;
constexpr size_t WS_H0T = WS_UPRE + 66 * MiB;
static_assert(WS_H0T + 64 * MiB <= WS_Y, "scan region");
constexpr size_t WS_MIX = WS_LORA, WS_X1 = WS_LORA + 64 * MiB, WS_H2 = WS_LORA + 128 * MiB;
constexpr size_t WS_LOGIT = WS_SCAN, WS_XB = WS_SCAN + 16 * MiB, WS_ACT = WS_XB + 144 * MiB;
constexpr size_t WS_Y2 = WS_Z, WS_WEIN = WS_Y, WS_WEOUT = WS_Y + 64 * MiB;
static_assert(WS_ACT + 144 * MiB <= WS_Y && WS_WEIN + 64 * MiB <= WS_WEOUT && WS_WEOUT + 64 * MiB <= WS_END, "late regions");
constexpr size_t MI_SELE = WS_MISC, MI_SELP = MI_SELE + (size_t)ML * 4 * 4, MI_GATE = MI_SELP + (size_t)ML * 4 * 4, MI_DEST = MI_GATE + (size_t)ML * 4 * 4, MI_BLKE = MI_DEST + (size_t)ML * 4 * 4;
constexpr size_t MI_RSH = MI_BLKE + 4096;
constexpr size_t MI_CSWIN = MI_RSH + (size_t)MT * 4;
constexpr size_t MI_RSH2 = MI_CSWIN + (size_t)NZ * 4;
constexpr size_t MI_RSXB = MI_RSH2 + (size_t)ML * 4;
constexpr size_t MI_CSWEI = MI_RSXB + (size_t)NROWS * 4;
constexpr size_t MI_BON = MI_CSWEI + (size_t)NE * 2048 * 4;
static_assert(MI_BON + (size_t)4096 * 64 * 4 <= WS_Z && MI_RSH % 16 == 0 && MI_CSWIN % 16 == 0 && MI_CSWEI % 16 == 0, "misc");
constexpr size_t WS_H2Q = WS_A0;
constexpr int CW_BAR = 4096;
constexpr int CW_CNT = 16384;
constexpr int CW_FB = 8192;
constexpr int CW_Q6 = CW_CNT + 64 * 40;

constexpr int RING_OFF = 0, RING_BYTES = 131072;
constexpr int LDSCTL_OFF = 147456, MISC_OFF = LDSCTL_OFF + 320;
constexpr int LDS_X_OFF = LDSCTL_OFF + 512;
constexpr int LDS_BYTES = 163840;

#define GAS __attribute__((address_space(1)))
#define LAS __attribute__((address_space(3)))
typedef unsigned short bf16;
typedef unsigned v4u __attribute__((ext_vector_type(4)));
typedef unsigned v2u __attribute__((ext_vector_type(2)));
typedef float f32x4 __attribute__((ext_vector_type(4)));
#define LDS_WAIT() asm volatile("s_waitcnt lgkmcnt(0)" ::: "memory")
#define VM_WAIT() asm volatile("s_waitcnt vmcnt(0)" ::: "memory")
__device__ __forceinline__ unsigned f2bf(float f) { unsigned u = __builtin_bit_cast(unsigned, f); return (u + 0x7fffu + ((u >> 16) & 1u)) >> 16; }
__device__ __forceinline__ unsigned pk2(float lo, float hi) { return f2bf(lo) | (f2bf(hi) << 16); }
typedef __bf16 bf16v2h_t __attribute__((ext_vector_type(2)));
__device__ __forceinline__ unsigned pk2h(float lo, float hi) { const bf16v2h_t v = {(__bf16)lo, (__bf16)hi}; return __builtin_bit_cast(unsigned, v); }
__device__ __forceinline__ float bflo(unsigned w) { return __builtin_bit_cast(float, w << 16); }
__device__ __forceinline__ float bfhi(unsigned w) { return __builtin_bit_cast(float, w & 0xffff0000u); }
__device__ __forceinline__ float bf1(bf16 h) { return __builtin_bit_cast(float, (unsigned)h << 16); }
__device__ __forceinline__ void ld16bf(const bf16* p, float (&o)[16]) {
    const v4u a = *(const v4u*)p, b = *(const v4u*)(p + 8);
    o[0] = bflo(a.x); o[1] = bfhi(a.x); o[2] = bflo(a.y); o[3] = bfhi(a.y); o[4] = bflo(a.z); o[5] = bfhi(a.z); o[6] = bflo(a.w); o[7] = bfhi(a.w);
    o[8] = bflo(b.x); o[9] = bfhi(b.x); o[10] = bflo(b.y); o[11] = bfhi(b.y); o[12] = bflo(b.z); o[13] = bfhi(b.z); o[14] = bflo(b.w); o[15] = bfhi(b.w);
}
__device__ __forceinline__ void st16bf(bf16* p, const float (&o)[16]) {
    v4u a, b; a.x = pk2(o[0], o[1]); a.y = pk2(o[2], o[3]); a.z = pk2(o[4], o[5]); a.w = pk2(o[6], o[7]);
    b.x = pk2(o[8], o[9]); b.y = pk2(o[10], o[11]); b.z = pk2(o[12], o[13]); b.w = pk2(o[14], o[15]);
    *(v4u*)p = a; *(v4u*)(p + 8) = b;
}
__device__ __forceinline__ void ld16f(const float* p, float (&o)[16]) {
#pragma unroll
    for (int q = 0; q < 4; ++q) { const f32x4 v = *(const f32x4*)(p + 4 * q); o[4 * q] = v.x; o[4 * q + 1] = v.y; o[4 * q + 2] = v.z; o[4 * q + 3] = v.w; }
}
__device__ __forceinline__ void ld16f_lds(const LAS float* p, float (&o)[16]) {
#pragma unroll
    for (int q = 0; q < 4; ++q) { const f32x4 v = *(const LAS f32x4*)(p + 4 * q); o[4 * q] = v.x; o[4 * q + 1] = v.y; o[4 * q + 2] = v.z; o[4 * q + 3] = v.w; }
}
__device__ __forceinline__ void st16f(float* p, const float (&o)[16]) {
#pragma unroll
    for (int q = 0; q < 4; ++q) *(f32x4*)(p + 4 * q) = (f32x4){o[4 * q], o[4 * q + 1], o[4 * q + 2], o[4 * q + 3]};
}
__device__ __forceinline__ float sigmoidf_(float x) { return 1.0f / (1.0f + __expf(-x)); }
__device__ __forceinline__ float wave_sum(float v) {
#pragma unroll
    for (int o = 1; o < 64; o <<= 1) v += __shfl_xor(v, o);
    return v;
}
__device__ __forceinline__ float wave_max(float v) {
#pragma unroll
    for (int o = 1; o < 64; o <<= 1) v = fmaxf(v, __shfl_xor(v, o));
    return v;
}
__device__ __forceinline__ unsigned pack_q4(float a, float b, float c, float d) {
    const int qa = __float2int_rn(a), qb = __float2int_rn(b), qc = __float2int_rn(c), qd = __float2int_rn(d);
    return (unsigned)(qa & 255) | ((unsigned)(qb & 255) << 8) | ((unsigned)(qc & 255) << 16) | ((unsigned)qd << 24);
}
__device__ __forceinline__ float quad_sum(float v) { v += __shfl_xor(v, 1); v += __shfl_xor(v, 2); return v; }

#define XB_TMO      128
#define XB_XCNT(j)  (256  + 64 * (j))
#define XB_XSUB(j)  (1280 + 64 * (j))
#define XB_XGEN(j)  (2304 + 64 * (j))
#define XB_TOP      3328
#define XB_TOPGEN   3392
#define XCD_BAR_WORDS 3456
#define XB_SPIN_CAP (1u << 18)

__device__ __forceinline__ unsigned xb_ld(unsigned* p)              { return __hip_atomic_load(p, __ATOMIC_RELAXED, __HIP_MEMORY_SCOPE_AGENT); }
__device__ __forceinline__ unsigned xb_add(unsigned* p, unsigned v) { return __hip_atomic_fetch_add(p, v, __ATOMIC_RELAXED, __HIP_MEMORY_SCOPE_AGENT); }
__device__ __forceinline__ unsigned xb_xcc_id() { return (unsigned)__builtin_amdgcn_s_getreg((3 << 11) | 20) & 0xFu; }
#define XB_SPIN(cond, bar) do { unsigned _sp = 0; while (cond) { __builtin_amdgcn_s_sleep(1); \
    if ((++_sp & 255u) == 0u) { if (xb_ld(&(bar)[XB_TMO])) break; if (_sp > XB_SPIN_CAP) { atomicAdd(&(bar)[XB_TMO], 1u); break; } } } } while (0)

struct XcdBarrier { unsigned* bar; unsigned x; volatile LAS unsigned* st; };

__device__ __forceinline__ XcdBarrier xcd_barrier_post(unsigned* bar, volatile LAS unsigned* st) {
    XcdBarrier b; b.bar = bar; b.x = xb_xcc_id(); b.st = st;
    if (threadIdx.x == 0) (void)xb_add(&bar[XB_XCNT(b.x)], 1u);
    return b;
}
__device__ __forceinline__ void xcd_barrier_complete(unsigned* bar, unsigned x, unsigned& nloc, unsigned& nx) {
    const unsigned G = gridDim.x * gridDim.y * gridDim.z;
    unsigned sum, cnt, mine, sp = 0u;
    for (;;) {
        sum = 0u; cnt = 0u; mine = 0u;
#pragma unroll
        for (unsigned j = 0; j < 16; ++j) { const unsigned c = xb_ld(&bar[XB_XCNT(j)]); sum += c; cnt += (c > 0u) ? 1u : 0u; mine = (j == x) ? c : mine; }
        if (sum == G) break;
        __builtin_amdgcn_s_sleep(1);
        if ((++sp & 255u) == 0u) { if (xb_ld(&bar[XB_TMO])) break; if (sp > XB_SPIN_CAP) { atomicAdd(&bar[XB_TMO], 1u); break; } }
    }
    nloc = mine > 0u ? mine : 1u; nx = cnt > 0u ? cnt : 1u;
}
__device__ __forceinline__ void xcd_barrier(const XcdBarrier& b) {
    asm volatile("s_waitcnt vmcnt(0)" ::: "memory");
    __syncthreads();
    if (threadIdx.x == 0) {
        unsigned* bar = b.bar;
        __builtin_amdgcn_s_waitcnt(0);
        unsigned nloc = b.st[0], nx = b.st[1];
        if (nloc == 0u) { xcd_barrier_complete(bar, b.x, nloc, nx); b.st[0] = nloc; b.st[1] = nx; }
        const unsigned old = xb_add(&bar[XB_XSUB(b.x)], 1u);
        const unsigned gen = old / nloc;
        if (old + 1u == (gen + 1u) * nloc) {
            __builtin_amdgcn_fence(__ATOMIC_RELEASE, "agent");
            asm volatile("s_waitcnt vmcnt(0)" ::: "memory");
            const unsigned og = xb_add(&bar[XB_TOP], 1u);
            const unsigned tg = og / nx;
            if (og + 1u == (tg + 1u) * nx) xb_add(&bar[XB_TOPGEN], 1u);
            else XB_SPIN(xb_ld(&bar[XB_TOPGEN]) == tg, bar);
            __builtin_amdgcn_fence(__ATOMIC_ACQUIRE, "agent");
            xb_add(&bar[XB_XGEN(b.x)], 1u);
            asm volatile("s_waitcnt vmcnt(0)" ::: "memory");
        } else {
            XB_SPIN(xb_ld(&bar[XB_XGEN(b.x)]) == gen, bar);
            __builtin_amdgcn_fence(__ATOMIC_ACQUIRE, "agent");
            asm volatile("s_waitcnt vmcnt(0)" ::: "memory");
        }
    }
    __syncthreads();
}

#define XB_DONE(j)  (3456 + 64 * (j))
__device__ __forceinline__ void xcd_barrier2(const XcdBarrier& b) {
    asm volatile("s_waitcnt vmcnt(0)" ::: "memory");
    __syncthreads();
    if (threadIdx.x == 0) {
        unsigned* bar = b.bar;
        __builtin_amdgcn_s_waitcnt(0);
        unsigned nloc = b.st[0], nx = b.st[1];
        if (nloc == 0u) { xcd_barrier_complete(bar, b.x, nloc, nx); b.st[0] = nloc; b.st[1] = nx; }
        const unsigned old = xb_add(&bar[XB_XSUB(b.x)], 1u);
        const unsigned gen = old / nloc;
        if (old + 1u == (gen + 1u) * nloc) {
            __builtin_amdgcn_fence(__ATOMIC_RELEASE, "agent");
            asm volatile("s_waitcnt vmcnt(0)" ::: "memory");
#pragma unroll
            for (unsigned j = 0; j < 16; ++j) (void)xb_add(&bar[XB_DONE(j)], 1u);
        }
        XB_SPIN(xb_ld(&bar[XB_DONE(b.x)]) < (gen + 1u) * nx, bar);
        __builtin_amdgcn_fence(__ATOMIC_ACQUIRE, "agent");
        asm volatile("s_waitcnt vmcnt(0)" ::: "memory");
    }
    __syncthreads();
}

__device__ __forceinline__ void xcd_barrier2_arrive(const XcdBarrier& b) {
    asm volatile("s_waitcnt vmcnt(0)" ::: "memory");
    __syncthreads();
    if (threadIdx.x == 0) {
        unsigned* bar = b.bar;
        __builtin_amdgcn_s_waitcnt(0);
        unsigned nloc = b.st[0], nx = b.st[1];
        if (nloc == 0u) { xcd_barrier_complete(bar, b.x, nloc, nx); b.st[0] = nloc; b.st[1] = nx; }
        const unsigned old = xb_add(&bar[XB_XSUB(b.x)], 1u);
        const unsigned gen = old / nloc;
        if (old + 1u == (gen + 1u) * nloc) {
            __builtin_amdgcn_fence(__ATOMIC_RELEASE, "agent");
            asm volatile("s_waitcnt vmcnt(0)" ::: "memory");
#pragma unroll
            for (unsigned j = 0; j < 16; ++j) (void)xb_add(&bar[XB_DONE(j)], 1u);
        }
        b.st[2] = gen;
    }
}
__device__ __forceinline__ void xcd_barrier2_wait(const XcdBarrier& b) {
    asm volatile("s_waitcnt vmcnt(0)" ::: "memory");
    if (threadIdx.x == 0) {
        unsigned* bar = b.bar;
        const unsigned gen = b.st[2], nx = b.st[1];
        XB_SPIN(xb_ld(&bar[XB_DONE(b.x)]) < (gen + 1u) * nx, bar);
        __builtin_amdgcn_fence(__ATOMIC_ACQUIRE, "agent");
        asm volatile("s_waitcnt vmcnt(0)" ::: "memory");
    }
    __syncthreads();
}

#define FB_WORD(j) (64 * (j))
#define FB_TMO 640
__device__ __forceinline__ void flat_barrier(unsigned* fb, unsigned epoch) {
    asm volatile("s_waitcnt vmcnt(0)" ::: "memory");
    __syncthreads();
    if (threadIdx.x == 0) {
        __builtin_amdgcn_s_waitcnt(0);
        __builtin_amdgcn_fence(__ATOMIC_RELEASE, "agent");
        asm volatile("s_waitcnt vmcnt(0)" ::: "memory");
        (void)xb_add(&fb[FB_WORD(blockIdx.x & 7u)], 1u);
        const unsigned want = epoch * gridDim.x; unsigned sp = 0u;
        for (;;) {
            unsigned s = 0u;
#pragma unroll
            for (int j = 0; j < 8; ++j) s += xb_ld(&fb[FB_WORD(j)]);
            if (s >= want) break;
            __builtin_amdgcn_s_sleep(1);
            if ((++sp & 255u) == 0u) { if (xb_ld(&fb[FB_TMO])) break; if (sp > XB_SPIN_CAP) { atomicAdd(&fb[FB_TMO], 1u); break; } }
        }
        __builtin_amdgcn_fence(__ATOMIC_ACQUIRE, "agent");
        asm volatile("s_waitcnt vmcnt(0)" ::: "memory");
    }
    __syncthreads();
}

struct Frame {
    LAS unsigned char* lds;
    volatile LAS unsigned* MISC;
    unsigned* ctl;
    int tid, lane, wave, G, gw, NGW, vb;
    float* out;
    unsigned char* ws;
};
enum { I_X = 0, I_C, I_CTX, I_CCTX, I_WADA, I_BADA, I_NPM, I_NQM, I_NPF, I_NQF, I_WIN, I_MU, I_W0, I_WDU, I_A0, I_WIU, I_KK, I_KA, I_RK, I_WGU, I_LNW, I_LNB, I_CONVW,
       I_WOUT, I_WR, I_BR, I_WEI, I_BEI, I_WEO, I_BEO };


typedef const float* fptr_t;
__device__ __forceinline__ fptr_t kin_ptr(int i) { const volatile __attribute__((address_space(4))) fptr_t* ka = (const volatile __attribute__((address_space(4))) fptr_t*)__builtin_amdgcn_kernarg_segment_ptr(); return ka[i]; }
#define KIN(i) kin_ptr(i)
__device__ __forceinline__ void transpose_item(const float* W, int N, int k0, int n0, bf16* WT, int ldk, int rowbase, LAS float* scr, int lane) {
#pragma unroll 8
    for (int i = 0; i < 32; ++i) { const int kk = 2 * i + (lane >> 5); scr[kk * 33 + (lane & 31)] = W[(size_t)(k0 + kk) * N + n0 + (lane & 31)]; }
    LDS_WAIT(); asm volatile("" ::: "memory");
    const int c = lane & 7;
#pragma unroll
    for (int j = 0; j < 4; ++j) { const int n = (lane >> 3) + 8 * j; const LAS float* s = scr + (8 * c) * 33 + n;
        v4u o; o.x = pk2(s[0 * 33], s[1 * 33]); o.y = pk2(s[2 * 33], s[3 * 33]); o.z = pk2(s[4 * 33], s[5 * 33]); o.w = pk2(s[6 * 33], s[7 * 33]);
        *(v4u*)(WT + (size_t)(rowbase + n) * ldk + k0 + 8 * c) = o; }
    LDS_WAIT(); asm volatile("" ::: "memory");
}

__device__ __forceinline__ unsigned pack_q4c(float a, float b, float c, float d) {
    const int qa = __float2int_rn(fminf(fmaxf(a, -127.f), 127.f)), qb = __float2int_rn(fminf(fmaxf(b, -127.f), 127.f)), qc = __float2int_rn(fminf(fmaxf(c, -127.f), 127.f)), qd = __float2int_rn(fminf(fmaxf(d, -127.f), 127.f));
    return (unsigned)(qa & 255) | ((unsigned)(qb & 255) << 8) | ((unsigned)(qc & 255) << 16) | ((unsigned)qd << 24);
}
__device__ __forceinline__ void q8_item(const float* W, int N, int n0, signed char* WT, float* cs, int rowbase, LAS float* scr, int lane, int kb0 = 0, int kb1 = 16) {
    const int r8 = lane >> 3, c4 = lane & 7;
    const float* p0 = W + (size_t)r8 * N + n0 + 4 * c4;
    f32x4 ss = {0.f, 0.f, 0.f, 0.f};
#pragma unroll
    for (int hb = 0; hb < 2; ++hb) {
        f32x4 v[16];
#pragma unroll
        for (int i = 0; i < 16; ++i) v[i] = *(const f32x4*)(p0 + (size_t)(8 * (16 * hb + i)) * N);
        __builtin_amdgcn_sched_barrier(0);
#pragma unroll
        for (int i = 0; i < 16; ++i) ss += v[i] * v[i];
    }
#pragma unroll
    for (int o = 8; o < 64; o <<= 1) { ss.x += __shfl_xor(ss.x, o); ss.y += __shfl_xor(ss.y, o); ss.z += __shfl_xor(ss.z, o); ss.w += __shfl_xor(ss.w, o); }
    if (lane < 8) {
#pragma unroll
        for (int q = 0; q < 4; ++q) { const float m = 6.0f * sqrtf(ss[q] * (1.0f / 256.0f)); cs[rowbase + 4 * lane + q] = m * (1.0f / 127.0f); scr[2112 + 4 * lane + q] = m > 0.f ? 127.0f / m : 0.f; } }
    LDS_WAIT(); asm volatile("" ::: "memory");
    f32x4 cur[8];
#pragma unroll
    for (int i = 0; i < 8; ++i) cur[i] = *(const f32x4*)(p0 + (size_t)(64 * kb0 + 8 * i) * N);
    for (int kb = kb0; kb < kb1; ++kb) {
        f32x4 nxt[8];
        const int kn = kb < kb1 - 1 ? kb + 1 : kb;
#pragma unroll
        for (int i = 0; i < 8; ++i) nxt[i] = *(const f32x4*)(p0 + (size_t)(64 * kn + 8 * i) * N);
#pragma unroll
        for (int i = 0; i < 8; ++i) { LAS float* s = scr + (r8 + 8 * i) * 33 + 4 * c4; s[0] = cur[i].x; s[1] = cur[i].y; s[2] = cur[i].z; s[3] = cur[i].w; }
        LDS_WAIT(); asm volatile("" ::: "memory");
        const int c = lane & 3;
#pragma unroll
        for (int j = 0; j < 2; ++j) { const int n = (lane >> 2) + 16 * j; const float iv = scr[2112 + n]; const LAS float* s = scr + (16 * c) * 33 + n;
            v4u o; o.x = pack_q4c(s[0] * iv, s[33] * iv, s[66] * iv, s[99] * iv); o.y = pack_q4c(s[132] * iv, s[165] * iv, s[198] * iv, s[231] * iv);
            o.z = pack_q4c(s[264] * iv, s[297] * iv, s[330] * iv, s[363] * iv); o.w = pack_q4c(s[396] * iv, s[429] * iv, s[462] * iv, s[495] * iv);
            *(v4u*)(WT + (size_t)(rowbase + n) * 1024 + 64 * kb + 16 * c) = o; }
        LDS_WAIT(); asm volatile("" ::: "memory");
#pragma unroll
        for (int i = 0; i < 8; ++i) cur[i] = nxt[i];
    }
}

struct CvTile { f32x4 v[8]; };
__device__ __forceinline__ void cv_load(CvTile& t, const float* W, int N, int n0, int kb, int lane) {
    const float* p0 = W + (size_t)(64 * kb + (lane >> 3)) * N + n0 + 4 * (lane & 7);
#pragma unroll
    for (int i = 0; i < 8; ++i) t.v[i] = *(const f32x4*)(p0 + (size_t)(8 * i) * N);
}
__device__ __forceinline__ void cv_to_lds(const CvTile& t, LAS float* scr, int lane) {
    const int r8 = lane >> 3, c4 = lane & 7;
#pragma unroll
    for (int i = 0; i < 8; ++i) { LAS float* s = scr + (r8 + 8 * i) * 33 + 4 * c4; s[0] = t.v[i].x; s[1] = t.v[i].y; s[2] = t.v[i].z; s[3] = t.v[i].w; }
    LDS_WAIT(); asm volatile("" ::: "memory");
}
__device__ __forceinline__ void cv_store_bf16(const LAS float* scr, bf16* WT, int ldk, int rowbase, int k0, int lane) {
    const int c = lane & 7;
#pragma unroll
    for (int j = 0; j < 4; ++j) { const int n = (lane >> 3) + 8 * j; const LAS float* s = scr + (8 * c) * 33 + n;
        v4u o; o.x = pk2h(s[0 * 33], s[1 * 33]); o.y = pk2h(s[2 * 33], s[3 * 33]); o.z = pk2h(s[4 * 33], s[5 * 33]); o.w = pk2h(s[6 * 33], s[7 * 33]);
        *(v4u*)(WT + (size_t)(rowbase + n) * ldk + k0 + 8 * c) = o; }
    LDS_WAIT(); asm volatile("" ::: "memory");
}
__device__ __forceinline__ unsigned q8_pack4(float a, float b, float c, float d) {
    const float M = 12582912.0f;
    const unsigned x0 = __builtin_bit_cast(unsigned, __builtin_amdgcn_fmed3f(a, -127.f, 127.f) + M), x1 = __builtin_bit_cast(unsigned, __builtin_amdgcn_fmed3f(b, -127.f, 127.f) + M);
    const unsigned x2 = __builtin_bit_cast(unsigned, __builtin_amdgcn_fmed3f(c, -127.f, 127.f) + M), x3 = __builtin_bit_cast(unsigned, __builtin_amdgcn_fmed3f(d, -127.f, 127.f) + M);
    return __builtin_amdgcn_perm(x1, x0, 0x0c0c0400u) | __builtin_amdgcn_perm(x3, x2, 0x04000c0cu);
}
__device__ __forceinline__ void cv_store_q8(const CvTile& t, LAS float* scr, signed char* WT, int rowbase, int kb, const float (&iv)[4], int lane) {
    LAS unsigned* img = (LAS unsigned*)scr;
    const int r8 = lane >> 3, c4 = lane & 7;
#pragma unroll
    for (int i = 0; i < 8; ++i) img[(r8 + 8 * i) * 9 + c4] = q8_pack4(t.v[i].x * iv[0], t.v[i].y * iv[1], t.v[i].z * iv[2], t.v[i].w * iv[3]);
    LDS_WAIT(); asm volatile("" ::: "memory");
    const int c = lane & 3;
#pragma unroll
    for (int j = 0; j < 2; ++j) { const int n = (lane >> 2) + 16 * j; const unsigned bs = (unsigned)(n & 3);
        const unsigned s01 = 0x0c0c0000u | bs | ((4u + bs) << 8), s23 = 0x00000c0cu | (bs << 16) | ((4u + bs) << 24);
        const LAS unsigned* s = img + (16 * c) * 9 + (n >> 2);
        v4u o;
        o.x = __builtin_amdgcn_perm(s[9], s[0], s01) | __builtin_amdgcn_perm(s[27], s[18], s23);
        o.y = __builtin_amdgcn_perm(s[45], s[36], s01) | __builtin_amdgcn_perm(s[63], s[54], s23);
        o.z = __builtin_amdgcn_perm(s[81], s[72], s01) | __builtin_amdgcn_perm(s[99], s[90], s23);
        o.w = __builtin_amdgcn_perm(s[117], s[108], s01) | __builtin_amdgcn_perm(s[135], s[126], s23);
        *(v4u*)(WT + (size_t)(rowbase + n) * 1024 + 64 * kb + 16 * c) = o; }
    LDS_WAIT(); asm volatile("" ::: "memory");
}
__device__ __forceinline__ void cv_scale_q8(const float* W, int N, int n0, float* cs, int rowbase, int lane, float (&iv)[4]) {
    const float* p0 = W + (size_t)(lane >> 3) * N + n0 + 4 * (lane & 7);
    f32x4 ss = {0.f, 0.f, 0.f, 0.f};
#pragma unroll
    for (int hb = 0; hb < 2; ++hb) {
        f32x4 v[16];
#pragma unroll
        for (int i = 0; i < 16; ++i) v[i] = *(const f32x4*)(p0 + (size_t)(8 * (16 * hb + i)) * N);
        __builtin_amdgcn_sched_barrier(0);
#pragma unroll
        for (int i = 0; i < 16; ++i) ss += v[i] * v[i];
    }
#pragma unroll
    for (int o = 8; o < 64; o <<= 1) { ss.x += __shfl_xor(ss.x, o); ss.y += __shfl_xor(ss.y, o); ss.z += __shfl_xor(ss.z, o); ss.w += __shfl_xor(ss.w, o); }
#pragma unroll
    for (int q = 0; q < 4; ++q) { const float m = 6.0f * sqrtf(ss[q] * (1.0f / 256.0f)); if (lane < 8) cs[rowbase + 4 * lane + q] = m * (1.0f / 127.0f); iv[q] = m > 0.f ? 127.0f / m : 0.f; }
}
__device__ __forceinline__ void wei_strip(int s, int& e, int& n0, int& rowbase) { e = s >> 6; n0 = 32 * (s & 63); const int c = n0 & 1023; rowbase = (c >> 7) * 256 + (n0 >= 1024 ? 128 : 0) + (c & 127); }

__device__ __forceinline__ void seam_filler(Frame& F, int s) {
    const int lane = F.lane;
    LAS float* scr = (LAS float*)(F.lds + F.wave * 16384);
    const float* wei = KIN(I_WEI); const float* weo = KIN(I_WEO);
    float* IV = (float*)(F.ws + WS_CTL) + 131072;
    for (int st = F.gw; st < NE * 64; st += F.NGW) {
        int e_, n0_, rb_; wei_strip(st, e_, n0_, rb_);
        const float* W = wei + (size_t)e_ * D * 2048;
        CvTile t0, t1; cv_load(t0, W, 2048, n0_, 2 * s, lane); cv_load(t1, W, 2048, n0_, 2 * s + 1, lane);
        float civ[4];
        if (s == 0) { cv_scale_q8(W, 2048, n0_, (float*)(F.ws + MI_CSWEI) + (size_t)e_ * 2048, rb_, lane, civ);
            if (lane < 8) *(f32x4*)(IV + (size_t)st * 32 + 4 * lane) = (f32x4){civ[0], civ[1], civ[2], civ[3]}; }
        else { const f32x4 v = *(const f32x4*)(IV + (size_t)st * 32 + 4 * (lane & 7)); civ[0] = v.x; civ[1] = v.y; civ[2] = v.z; civ[3] = v.w; }
        cv_store_q8(t0, scr, (signed char*)(F.ws + WS_WEIN) + (size_t)e_ * 2048 * D, rb_, 2 * s, civ, lane);
        cv_store_q8(t1, scr, (signed char*)(F.ws + WS_WEIN) + (size_t)e_ * 2048 * D, rb_, 2 * s + 1, civ, lane);
    }
    bf16* WEO = (bf16*)(F.ws + WS_WEOUT);
    for (int id = F.gw * 8 + s; id < NE * 512; id += F.NGW * 8) {
        const int e_ = id >> 9, q_ = id & 511;
        CvTile ft; cv_load(ft, weo + (size_t)e_ * D * D, D, 32 * (q_ & 31), q_ >> 5, lane);
        cv_to_lds(ft, scr, lane); cv_store_bf16(scr, WEO + (size_t)e_ * D * D, D, 32 * (q_ & 31), 64 * (q_ >> 5), lane);
    }
}

template <int N>
__device__ __forceinline__ void mod_vals(const float* modp, const float* b_ada, int vec, const int (&j)[N], float (&out)[N]) {
    float p[N][KSPLIT], s[N];
#pragma unroll
    for (int n = 0; n < N; ++n) { s[n] = b_ada[j[n]];
#pragma unroll
        for (int ks = 0; ks < KSPLIT; ++ks) p[n][ks] = modp[((size_t)ks * 3 + vec) * 6144 + j[n]]; }
    __builtin_amdgcn_sched_barrier(0);
#pragma unroll
    for (int n = 0; n < N; ++n) {
#pragma unroll
        for (int ks = 0; ks < KSPLIT; ++ks) s[n] += p[n][ks];
        out[n] = s[n]; }
}
__device__ __forceinline__ float mod_val(const float* modp, const float* b_ada, int vec, int j) { const int jj[1] = {j}; float o[1]; mod_vals<1>(modp, b_ada, vec, jj, o); return o[0]; }
__device__ __forceinline__ int nbr_row(int row, int j) {
    if (row < ML) { const int t = row & (T - 1), gc = t & 63, gr = t >> 6;
        if (j == 0) return gc > 0 ? row - 1 : -1; if (j == 1) return gc < 63 ? row + 1 : -1; if (j == 2) return gr > 0 ? row - 64 : -1; return gr < 127 ? row + 64 : -1; }
    const int tc = (row - ML) & (TC - 1);
    if ((j & 1) == 0) return tc > 0 ? row - 1 : -1; return tc < TC - 1 ? row + 1 : -1;
}
__device__ __forceinline__ void load_shift16(const bf16* z, int row, int col0, const LAS float* mu, float (&out)[16]) {
    float s[16]; ld16bf(z + (size_t)row * NZ + col0, s);
    float m[16]; ld16f_lds(mu, m);
#pragma unroll
    for (int j = 0; j < 4; ++j) {
        const int nr = nbr_row(row, j); float t[16];
        if (nr >= 0) ld16bf(z + (size_t)nr * NZ + col0, t); else {
#pragma unroll
            for (int i = 0; i < 16; ++i) t[i] = 0.f; }
#pragma unroll
        for (int i = j; i < 16; i += 4) out[i] = s[i] + m[i] * (t[i] - s[i]);
    }
}

__device__ __forceinline__ void phase_prologue(Frame& F) {
    LAS float* scr = (LAS float*)(F.lds + RING_OFF + F.wave * 16384);
    LAS float* sil = (LAS float*)(F.lds + LDS_X_OFF);
    for (int i = F.tid; i < 3 * D; i += NWAVES * 64) { const int v = i / D, j = i % D; const float c = v < 2 ? KIN(I_C)[v * D + j] : KIN(I_CCTX)[j]; sil[i] = c / (1.0f + __expf(-c)); }
    __syncthreads();
    bf16* WoutT = (bf16*)(F.ws + WS_WOUT);
    constexpr int IT_WIN = (N_IN / 32) * 4, IT_WOUT = (D / 64) * (D / 32), IT_ADA = 24 * KSPLIT;
    constexpr int NITEMS = IT_ADA + IT_WIN + IT_WOUT;
    float* modp = (float*)(F.ws + WS_MODP);
    for (int it = F.gw; it < NITEMS; it += F.NGW) {
        int r = it;
        if (r < IT_ADA) {
            const int cc = r % 24, ks = r / 24, col = cc * 256 + F.lane * 4;
            f32x4 a0 = {0.f, 0.f, 0.f, 0.f}, a1 = a0, a2 = a0;
            const float* wp = KIN(I_WADA) + (size_t)(ks * 64) * 6144 + col;
#pragma unroll 8
            for (int k = 0; k < 64; ++k) { const f32x4 w = *(const f32x4*)(wp + (size_t)k * 6144); const int kk = ks * 64 + k;
                a0 += w * sil[kk]; a1 += w * sil[D + kk]; a2 += w * sil[2 * D + kk]; }
            *(f32x4*)(modp + ((size_t)ks * 3 + 0) * 6144 + col) = a0; *(f32x4*)(modp + ((size_t)ks * 3 + 1) * 6144 + col) = a1; *(f32x4*)(modp + ((size_t)ks * 3 + 2) * 6144 + col) = a2;
            continue; }
        r -= IT_ADA;
        if (r < IT_WIN) { const int st = r >> 2, qq = r & 3; q8_item(KIN(I_WIN), N_IN, 32 * st, (signed char*)(F.ws + WS_WIN), (float*)(F.ws + MI_CSWIN), 32 * st, scr, F.lane, 4 * qq, 4 * qq + 4); continue; }
        r -= IT_WIN;
        { const int nb = D / 32, kb = r / nb, n0 = 32 * (r % nb); transpose_item(KIN(I_WOUT), D, 64 * kb, n0, WoutT, D, n0, scr, F.lane); }
    }
    const int gt = blockIdx.x * (NWAVES * 64) + F.tid, NGT = F.G * NWAVES * 64;
    for (int i = gt; i < (NZ - N_IN) * D / 16; i += NGT) *(v4u*)(F.ws + WS_WIN + (size_t)N_IN * D + (size_t)i * 16) = (v4u){0u, 0u, 0u, 0u};
    for (int i = gt; i < NZ - N_IN; i += NGT) ((float*)(F.ws + MI_CSWIN))[N_IN + i] = 0.f;
    bf16* WL = (bf16*)(F.ws + WS_WLORA);
    for (int i = gt; i < NL * (KL / 8); i += NGT) {
        const int c8 = i / NL, row = i % NL, blk = row >> 10, n = row & 1023, col = c8 * 8, g = col >> 6;
        const float* src = nullptr; int kofs = 0;
        if (blk < 2) { if (g == blk) { src = KIN(I_WDU) + (size_t)blk * 64 * D; kofs = col - 64 * blk; } }
        else if (blk < 4) { if (g == blk) { src = KIN(I_WIU) + (size_t)(blk - 2) * 64 * D; kofs = col - 64 * blk; } }
        else { if (g >= 4) { src = KIN(I_WGU); kofs = col - 256; } }
        v4u o = {0u, 0u, 0u, 0u};
        if (src) { float v[8];
#pragma unroll
            for (int q = 0; q < 8; ++q) v[q] = src[(size_t)(kofs + q) * D + n];
            o.x = pk2(v[0], v[1]); o.y = pk2(v[2], v[3]); o.z = pk2(v[4], v[5]); o.w = pk2(v[6], v[7]); }
        *(v4u*)(WL + (size_t)row * KL + col) = o;
    }
    bf16* WR = (bf16*)(F.ws + WS_WROUT);
    for (int i = gt; i < 256 * (D / 8); i += NGT) {
        const int row = i % 256, c8 = i / 256; v4u o = {0u, 0u, 0u, 0u};
        if (row < NE) { float v[8];
#pragma unroll
            for (int q = 0; q < 8; ++q) v[q] = KIN(I_WR)[(size_t)(c8 * 8 + q) * NE + row];
            o.x = pk2(v[0], v[1]); o.y = pk2(v[2], v[3]); o.z = pk2(v[4], v[5]); o.w = pk2(v[6], v[7]); }
        *(v4u*)(WR + (size_t)row * D + c8 * 8) = o;
    }
}

__device__ __forceinline__ void phase_hrows(Frame& F) {
    LAS float* LA = (LAS float*)(F.lds);
    LAS float* LB = LA + 3 * D;
    const float* modp = (const float*)(F.ws + WS_MODP);
    for (int i = F.tid; i < 3 * D; i += NWAVES * 64) { const int v = i / D, j = i % D;
        const int jj[2] = {1024 + j, j}; float mv[2]; mod_vals<2>(modp, KIN(I_BADA), v, jj, mv);
        LA[i] = KIN(I_NPM)[j] * (1.0f + mv[0]); LB[i] = mv[1]; }
    __syncthreads();
    signed char* A0q = (signed char*)(F.ws + WS_A0);
    for (int row0 = F.gw; row0 < MT; row0 += 4 * F.NGW) {
        f32x4 v[4][4];
#pragma unroll
        for (int k = 0; k < 4; ++k) { const int row = row0 + k * F.NGW, rc = row < MT ? row : row0;
            const float* xr = rc < ML ? KIN(I_X) + (size_t)rc * D : KIN(I_CTX) + (size_t)(rc - ML) * D;
#pragma unroll
            for (int j = 0; j < 4; ++j) v[k][j] = *(const f32x4*)(xr + 4 * F.lane + 256 * j); }
        __builtin_amdgcn_sched_barrier(0);
#pragma unroll
        for (int k = 0; k < 4; ++k) { const int row = row0 + k * F.NGW;
            if (row < MT) {
                const int vec = row < ML ? row >> 13 : 2;
                float s = 0.f;
#pragma unroll
                for (int j = 0; j < 4; ++j) s += (v[k][j].x * v[k][j].x + v[k][j].y * v[k][j].y) + (v[k][j].z * v[k][j].z + v[k][j].w * v[k][j].w);
                const float rstd = 1.0f / sqrtf(wave_sum(s) * (1.0f / D) + 1e-6f);
                f32x4 hq[4]; float mx = 0.f;
#pragma unroll
                for (int j = 0; j < 4; ++j) { const int c = 4 * F.lane + 256 * j; const f32x4 a = *(const LAS f32x4*)(LA + vec * D + c), b = *(const LAS f32x4*)(LB + vec * D + c);
                    hq[j] = v[k][j] * rstd * a + b; mx = fmaxf(mx, fmaxf(fmaxf(fabsf(hq[j].x), fabsf(hq[j].y)), fmaxf(fabsf(hq[j].z), fabsf(hq[j].w)))); }
                mx = wave_max(mx);
                const float iv = mx > 0.f ? 127.0f / mx : 0.f;
                if (F.lane == 0) ((float*)(F.ws + MI_RSH))[row] = mx * (1.0f / 127.0f);
                unsigned* o4 = (unsigned*)(A0q + (size_t)row * D) + F.lane;
#pragma unroll
                for (int j = 0; j < 4; ++j) o4[64 * j] = pack_q4(hq[j].x * iv, hq[j].y * iv, hq[j].z * iv, hq[j].w * iv);
            } }
    }
}

__device__ __forceinline__ void phase_lora_in(Frame& F) {
    const bf16* z = (const bf16*)(F.ws + WS_Z); bf16* AL = (bf16*)(F.ws + WS_AL);
    const int gt = blockIdx.x * (NWAVES * 64) + F.tid, NGT = F.G * NWAVES * 64;
    for (int i = gt; i < MT * (KL / 4); i += NGT) {
        const int row = i / (KL / 4), q = i % (KL / 4), j0 = 4 * q;
        const int zc = j0 < 256 ? DECAY_OFF + j0 : GLORA_OFF + (j0 - 256);
        float o[4];
        if (j0 >= 256 && row >= ML) { o[0] = o[1] = o[2] = o[3] = 0.f; }
        else {
            const uint2 sv = *(const uint2*)(z + (size_t)row * NZ + zc); const float s[4] = {bflo(sv.x), bfhi(sv.x), bflo(sv.y), bfhi(sv.y)};
#pragma unroll
            for (int j = 0; j < 4; ++j) { const int nr = nbr_row(row, j); float t = 0.f;
                if (nr >= 0) t = bf1(z[(size_t)nr * NZ + zc + j]);
                const float v = s[j] + KIN(I_MU)[zc + j] * (t - s[j]);
                o[j] = j0 < 128 ? tanhf(v) : (j0 < 256 ? v : sigmoidf_(v)); }
        }
        *(uint2*)(AL + (size_t)row * KL + j0) = make_uint2(pk2(o[0], o[1]), pk2(o[2], o[3]));
    }
}


namespace ck {
typedef short bf16x8 __attribute__((ext_vector_type(8)));
constexpr int TILE = 8192;
constexpr int NU_L = BATCH * (T / 64) * NH;
constexpr int NU_ALL = NU_L + BATCH * (TC / 64) * NH;
__device__ __forceinline__ int swz(int row) { return (row ^ (row >> 3)) & 7; }
__device__ __forceinline__ int toff(int row, int col) { return row * 128 + ((col * 2) ^ (swz(row) << 4)); }
__device__ __forceinline__ bf16x8 ldfrag(const LAS unsigned char* t, int row, int chunk) { return *(const LAS bf16x8*)(t + row * 128 + ((chunk ^ swz(row)) << 4)); }
typedef __bf16 bf16v2_t __attribute__((ext_vector_type(2)));
__device__ __forceinline__ unsigned cvtpk(float lo, float hi) { const bf16v2_t v = {(__bf16)lo, (__bf16)hi}; return __builtin_bit_cast(unsigned, v); }
#define CK_MFMA(a, b, c) __builtin_amdgcn_mfma_f32_16x16x32_bf16(a, b, c, 0, 0, 0)
template <bool MASKDIAG>
__device__ __forceinline__ void mm64(f32x4 (&acc)[4], const LAS unsigned char* Lt, const LAS unsigned char* Rt, int wq, int lane) {
    const int lr = lane & 15, g = lane >> 4;
    const bf16x8 l0 = ldfrag(Lt, 16 * wq + lr, g), l1 = ldfrag(Lt, 16 * wq + lr, 4 + g);
#pragma unroll
    for (int n = 0; n < 4; ++n) {
        bf16x8 r0 = ldfrag(Rt, 16 * n + lr, g), r1 = ldfrag(Rt, 16 * n + lr, 4 + g);
        if (MASKDIAG) { const bf16x8 zz = {0, 0, 0, 0, 0, 0, 0, 0}; if ((g >> 1) == n) r0 = zz; if (2 + (g >> 1) == n) r1 = zz; }
        acc[n] = CK_MFMA(l0, r0, acc[n]); acc[n] = CK_MFMA(l1, r1, acc[n]);
    }
}
__device__ __forceinline__ void zero4(f32x4 (&a)[4]) {
#pragma unroll
    for (int n = 0; n < 4; ++n) a[n] = (f32x4){0.f, 0.f, 0.f, 0.f};
}
__device__ __forceinline__ void storeT(LAS unsigned char* t, const f32x4 (&v)[4], int wq, int lane) {
    const int lr = lane & 15, g = lane >> 4;
#pragma unroll
    for (int n = 0; n < 4; ++n) *(LAS v2u*)(t + toff(16 * n + lr, 16 * wq + 4 * g)) = (v2u){cvtpk(v[n][0], v[n][1]), cvtpk(v[n][2], v[n][3])};
}
__device__ __forceinline__ void storeN(LAS unsigned char* t, const f32x4 (&v)[4], int wq, int lane) {
    const int lr = lane & 15, g = lane >> 4;
#pragma unroll
    for (int n = 0; n < 4; ++n)
#pragma unroll
        for (int i = 0; i < 4; ++i) *(LAS unsigned short*)(t + toff(16 * wq + 4 * g + i, 16 * n + lr)) = (unsigned short)f2bf(v[n][i]);
}
__device__ __forceinline__ void loadT(f32x4 (&v)[4], const LAS unsigned char* t, int wq, int lane) {
    const int lr = lane & 15, g = lane >> 4;
#pragma unroll
    for (int n = 0; n < 4; ++n) { const v2u w = *(const LAS v2u*)(t + toff(16 * n + lr, 16 * wq + 4 * g)); v[n] = (f32x4){bflo(w.x), bfhi(w.x), bflo(w.y), bfhi(w.y)}; }
}
__device__ __forceinline__ void unit_decode(int unit, int& b, int& h, int& rowbase) {
    if (unit < NU_L) { h = unit & 15; const int blk = (unit >> 4) & 127; b = unit >> 11; rowbase = b * T + blk * 64; }
    else { const int u = unit - NU_L; h = u & 15; const int cb = (u >> 4) & 3; b = u >> 6; rowbase = ML + b * TC + cb * 64; }
}
__device__ __forceinline__ void pack8(LAS unsigned char* t, int row, int chunk, const float (&v)[8], bool rev) {
    v4u o;
    if (!rev) { o.x = cvtpk(v[0], v[1]); o.y = cvtpk(v[2], v[3]); o.z = cvtpk(v[4], v[5]); o.w = cvtpk(v[6], v[7]); }
    else { o.x = cvtpk(v[7], v[6]); o.y = cvtpk(v[5], v[4]); o.z = cvtpk(v[3], v[2]); o.w = cvtpk(v[1], v[0]); }
    *(LAS v4u*)(t + row * 128 + ((chunk ^ swz(row)) << 4)) = o;
}

__device__ __forceinline__ void unpack8(const v4u p, float (&o)[8]) {
    o[0] = bflo(p.x); o[1] = bfhi(p.x); o[2] = bflo(p.y); o[3] = bfhi(p.y); o[4] = bflo(p.z); o[5] = bfhi(p.z); o[6] = bflo(p.w); o[7] = bfhi(p.w);
}
__device__ __forceinline__ void ld8f(const float* p, float (&o)[8]) {
    const f32x4 a = *(const f32x4*)p, b = *(const f32x4*)(p + 4); o[0] = a.x; o[1] = a.y; o[2] = a.z; o[3] = a.w; o[4] = b.x; o[5] = b.y; o[6] = b.z; o[7] = b.w;
}
__device__ __forceinline__ float fsig(float x) { return __builtin_amdgcn_rcpf(1.0f + __expf(-x)); }
template <bool IS_CO> struct EPre { v4u k[5], v[5], r[IS_CO ? 5 : 1], lo[4]; unsigned msk; };
template <bool IS_CO>
__device__ __forceinline__ void epre_load(EPre<IS_CO>& P, const bf16* z, const bf16* LO, int unit, int wave, int lane) {
    int b, h, rowbase; unit_decode(unit, b, h, rowbase);
    const int row = rowbase + 8 * wave + (lane >> 3), c0 = h * 64 + 8 * (lane & 7);
    const bf16* zr = z + (size_t)row * NZ;
    P.k[0] = *(const v4u*)(zr + K_OFF + c0); P.v[0] = *(const v4u*)(zr + V_OFF + c0); if (IS_CO) P.r[0] = *(const v4u*)(zr + R_OFF + c0);
    unsigned msk = 0u;
#pragma unroll
    for (int j = 0; j < 4; ++j) { const int nr = nbr_row(row, j); const bf16* zn = z + (size_t)(nr >= 0 ? nr : row) * NZ; msk |= (nr >= 0 ? 1u : 0u) << j;
        P.k[1 + j] = *(const v4u*)(zn + K_OFF + c0); P.v[1 + j] = *(const v4u*)(zn + V_OFF + c0);
        if (IS_CO) P.r[1 + j] = *(const v4u*)(zn + R_OFF + c0); }
    P.msk = msk;
    const bf16* lr_ = LO + (size_t)row * NL + c0;
    P.lo[0] = *(const v4u*)(lr_); P.lo[1] = *(const v4u*)(lr_ + 1024); P.lo[2] = *(const v4u*)(lr_ + 2048); P.lo[3] = *(const v4u*)(lr_ + 3072);
}
__device__ __forceinline__ void shift8(const v4u (&q)[5], const float* mu, float (&out)[8], unsigned msk = 15u) {
    const v4u zz = {0u, 0u, 0u, 0u};
    const v4u s = q[0], n0 = (msk & 1u) ? q[1] : zz, n1 = (msk & 2u) ? q[2] : zz, n2 = (msk & 4u) ? q[3] : zz, n3 = (msk & 8u) ? q[4] : zz;
    float m[8]; ld8f(mu, m);
    out[0] = bflo(s.x) + m[0] * (bflo(n0.x) - bflo(s.x)); out[1] = bfhi(s.x) + m[1] * (bfhi(n1.x) - bfhi(s.x));
    out[2] = bflo(s.y) + m[2] * (bflo(n2.y) - bflo(s.y)); out[3] = bfhi(s.y) + m[3] * (bfhi(n3.y) - bfhi(s.y));
    out[4] = bflo(s.z) + m[4] * (bflo(n0.z) - bflo(s.z)); out[5] = bfhi(s.z) + m[5] * (bfhi(n1.z) - bfhi(s.z));
    out[6] = bflo(s.w) + m[6] * (bflo(n2.w) - bflo(s.w)); out[7] = bfhi(s.w) + m[7] * (bfhi(n3.w) - bfhi(s.w));
}
__device__ __forceinline__ void ld8l(const LAS float* p, float (&o)[8]) {
    const f32x4 a = *(const LAS f32x4*)p, b = *(const LAS f32x4*)(p + 4); o[0] = a.x; o[1] = a.y; o[2] = a.z; o[3] = a.w; o[4] = b.x; o[5] = b.y; o[6] = b.z; o[7] = b.w;
}
__device__ __forceinline__ void shift8m(const v4u (&q)[5], const float (&m)[8], float (&out)[8], unsigned msk) {
    const v4u zz = {0u, 0u, 0u, 0u};
    const v4u s = q[0], n0 = (msk & 1u) ? q[1] : zz, n1 = (msk & 2u) ? q[2] : zz, n2 = (msk & 4u) ? q[3] : zz, n3 = (msk & 8u) ? q[4] : zz;
    out[0] = bflo(s.x) + m[0] * (bflo(n0.x) - bflo(s.x)); out[1] = bfhi(s.x) + m[1] * (bfhi(n1.x) - bfhi(s.x));
    out[2] = bflo(s.y) + m[2] * (bflo(n2.y) - bflo(s.y)); out[3] = bfhi(s.y) + m[3] * (bfhi(n3.y) - bfhi(s.y));
    out[4] = bflo(s.z) + m[4] * (bflo(n0.z) - bflo(s.z)); out[5] = bfhi(s.z) + m[5] * (bfhi(n1.z) - bfhi(s.z));
    out[6] = bflo(s.w) + m[6] * (bflo(n2.w) - bflo(s.w)); out[7] = bfhi(s.w) + m[7] * (bfhi(n3.w) - bfhi(s.w));
}
struct EPre2 { v4u k0, v0, r0; v2u kn[4], vn[4], rn[4]; v4u lo[4]; unsigned msk; };
__device__ __forceinline__ void epre2_load(EPre2& P, const bf16* z, const bf16* LO, int unit, int wave, int lane) {
    int b, h, rowbase; unit_decode(unit, b, h, rowbase);
    const int row = rowbase + 8 * wave + (lane >> 3), c0 = h * 64 + 8 * (lane & 7);
    const bf16* zr = z + (size_t)row * NZ;
    P.k0 = *(const v4u*)(zr + K_OFF + c0); P.v0 = *(const v4u*)(zr + V_OFF + c0); P.r0 = *(const v4u*)(zr + R_OFF + c0);
    unsigned msk = 0u;
#pragma unroll
    for (int j = 0; j < 4; ++j) { const int nr = nbr_row(row, j); const unsigned* zn = (const unsigned*)(z + (size_t)(nr >= 0 ? nr : row) * NZ + c0) + (j >> 1); msk |= (nr >= 0 ? 1u : 0u) << j;
        P.kn[j].x = zn[K_OFF / 2]; P.kn[j].y = zn[K_OFF / 2 + 2]; P.vn[j].x = zn[V_OFF / 2]; P.vn[j].y = zn[V_OFF / 2 + 2]; P.rn[j].x = zn[R_OFF / 2]; P.rn[j].y = zn[R_OFF / 2 + 2]; }
    P.msk = msk;
    const bf16* lr_ = LO + (size_t)row * NL + c0;
    P.lo[0] = *(const v4u*)(lr_); P.lo[1] = *(const v4u*)(lr_ + 1024); P.lo[2] = *(const v4u*)(lr_ + 2048); P.lo[3] = *(const v4u*)(lr_ + 3072);
}
__device__ __forceinline__ void shift8n(const v4u s, const v2u (&nb)[4], const float* mu, float (&out)[8], unsigned msk) {
    float m[8]; ld8f(mu, m);
    const float n0a = (msk & 1u) ? bflo(nb[0].x) : 0.f, n0b = (msk & 1u) ? bflo(nb[0].y) : 0.f, n1a = (msk & 2u) ? bfhi(nb[1].x) : 0.f, n1b = (msk & 2u) ? bfhi(nb[1].y) : 0.f;
    const float n2a = (msk & 4u) ? bflo(nb[2].x) : 0.f, n2b = (msk & 4u) ? bflo(nb[2].y) : 0.f, n3a = (msk & 8u) ? bfhi(nb[3].x) : 0.f, n3b = (msk & 8u) ? bfhi(nb[3].y) : 0.f;
    out[0] = bflo(s.x) + m[0] * (n0a - bflo(s.x)); out[1] = bfhi(s.x) + m[1] * (n1a - bfhi(s.x));
    out[2] = bflo(s.y) + m[2] * (n2a - bflo(s.y)); out[3] = bfhi(s.y) + m[3] * (n3a - bfhi(s.y));
    out[4] = bflo(s.z) + m[4] * (n0b - bflo(s.z)); out[5] = bfhi(s.z) + m[5] * (n1b - bfhi(s.z));
    out[6] = bflo(s.w) + m[6] * (n2b - bflo(s.w)); out[7] = bfhi(s.w) + m[7] * (n3b - bfhi(s.w));
}
__device__ __forceinline__ void putN(LAS unsigned char* t, int tau, int oct, const float (&v)[8]) {
    v4u o; o.x = cvtpk(v[0], v[1]); o.y = cvtpk(v[2], v[3]); o.z = cvtpk(v[4], v[5]); o.w = cvtpk(v[6], v[7]);
    *(LAS v4u*)(t + tau * 128 + ((oct ^ swz(tau)) << 4)) = o;
}
__device__ __forceinline__ void putT(LAS unsigned char* t, int tau, int ch0, const float (&v)[8]) {
#pragma unroll
    for (int i = 0; i < 8; ++i) *(LAS unsigned short*)(t + toff(ch0 + i, tau)) = (unsigned short)f2bf(v[i]);
}

template <bool IS_CO, bool STAGES = true>
__device__ __forceinline__ void phase_chunk(Frame& F) {
    const int wave = F.wave;
    const int dgrp = wave >> 2, wq = wave & 3;
    LAS unsigned char* tl = F.lds + dgrp * 9 * TILE;
#define SL(k) (tl + (k) * TILE)
    LAS float* SEG = (LAS float*)(F.lds + LDS_X_OFF);
    LAS float* GAM = SEG + 1024;
    LAS unsigned char* DIB = (LAS unsigned char*)(GAM + 128) + dgrp * 2048;
    LAS float* LW0 = (LAS float*)(F.lds + 7 * TILE);
    LAS float* LW1 = (LAS float*)(F.lds + 16 * TILE);
    const bf16* z = (const bf16*)(F.ws + WS_Z); const bf16* LO = (const bf16*)(F.ws + WS_LORA);
    unsigned char* PQ = F.ws + WS_PQ; unsigned char* TKN = F.ws + WS_TKN; unsigned char* UPRE = F.ws + WS_UPRE; unsigned char* H0T = F.ws + WS_H0T;
    bf16* MG = (bf16*)(F.ws + WS_A0);
    const float* p_mu = KIN(I_MU); const float* p_kk = KIN(I_KK); const float* p_ka = KIN(I_KA);
    const int NU = IS_CO ? NU_L : NU_ALL;
    EPre<IS_CO> PF;
    CvTile cvt; float civ[4] = {0.f, 0.f, 0.f, 0.f}; int cv_t = 0;
    const float* cv_w = KIN(I_WEI);
    LAS float* cv_scr = (LAS float*)(F.lds + wave * 16384);
    if ((int)blockIdx.x < NU) epre_load<IS_CO>(PF, z, LO, (int)blockIdx.x, wave, F.lane);
    for (int unit = blockIdx.x; unit < NU; unit += F.G) {
        int lane = F.lane; asm volatile("" : "+v"(lane));
        const int lr = lane & 15, g = lane >> 4;
        int b, h, rowbase; unit_decode(unit, b, h, rowbase);
        const int tok = 8 * wave + (lane >> 3), oct = lane & 7, ch0 = 8 * oct, c0 = h * 64 + ch0, row = rowbase + tok;
        float ks[8], vs[8], rs[8], kkp[8], lw0[8], lw1[8], kd0[8], kd1[8], a_0[8], a_1[8], ssq;
        {
            shift8(PF.k, p_mu + K_OFF + c0, ks, PF.msk);
            shift8(PF.v, p_mu + V_OFF + c0, vs, PF.msk);
            if (IS_CO) { v4u rr[5];
#pragma unroll
                for (int j = 0; j < 5; ++j) rr[j] = PF.r[IS_CO ? j : 0];
                shift8(rr, p_mu + R_OFF + c0, rs, PF.msk); }
            else {
#pragma unroll
                for (int i = 0; i < 8; ++i) rs[i] = 0.f; }
            float xw0[8], xw1[8], xa0[8], xa1[8];
            unpack8(PF.lo[0], xw0); unpack8(PF.lo[1], xw1); unpack8(PF.lo[2], xa0); unpack8(PF.lo[3], xa1);
            float kkk[8], kaa[8];
            ld8f(p_kk + c0, kkk); ld8f(p_ka + c0, kaa);
            float ss = 0.f;
#pragma unroll
            for (int i = 0; i < 8; ++i) {
                kkp[i] = ks[i] * kkk[i]; ss += kkp[i] * kkp[i];
                lw0[i] = xw0[i]; lw1[i] = xw1[i];
                a_0[i] = xa0[i]; a_1[i] = xa1[i];
                kd0[i] = ks[i] * (1.0f + (a_0[i] - 1.0f) * kaa[i]); kd1[i] = ks[i] * (1.0f + (a_1[i] - 1.0f) * kaa[i]);
                const int ch = ch0 + i, sw = tok ^ (4 * ((ch & 15) ^ (2 * (ch >> 4))));
                LW0[ch * 64 + sw] = lw0[i]; LW1[ch * 64 + sw] = lw1[i];
            }
            ss += __shfl_xor(ss, 1); ss += __shfl_xor(ss, 2); ss += __shfl_xor(ss, 4);
            ssq = ss;
        }
        __syncthreads();
        {
            const int ch2 = lane, seg = wave, sw = 4 * ((ch2 & 15) ^ (2 * (ch2 >> 4)));
            LAS f32x4* p0a = (LAS f32x4*)(LW0 + ch2 * 64 + ((8 * seg) ^ sw)); LAS f32x4* p0b = (LAS f32x4*)(LW0 + ch2 * 64 + ((8 * seg + 4) ^ sw));
            LAS f32x4* p1a = (LAS f32x4*)(LW1 + ch2 * 64 + ((8 * seg) ^ sw)); LAS f32x4* p1b = (LAS f32x4*)(LW1 + ch2 * 64 + ((8 * seg + 4) ^ sw));
            f32x4 a = *p0a, bq = *p0b, c = *p1a, d = *p1b;
            a.y += a.x; a.z += a.y; a.w += a.z; bq.x += a.w; bq.y += bq.x; bq.z += bq.y; bq.w += bq.z;
            d.z += d.w; d.y += d.z; d.x += d.y; c.w += d.x; c.z += c.w; c.y += c.z; c.x += c.y;
            SEG[seg * 64 + ch2] = bq.w; SEG[(8 + seg) * 64 + ch2] = c.x;
            __syncthreads();
            float off0 = 0.f, off1 = 0.f;
#pragma unroll
            for (int s2 = 0; s2 < 8; ++s2) { const float t0 = SEG[s2 * 64 + ch2], t1 = SEG[(8 + s2) * 64 + ch2]; off0 += (s2 < seg) ? t0 : 0.f; off1 += (s2 > seg) ? t1 : 0.f; }
            *p0a = a + off0; *p0b = bq + off0; *p1a = c + off1; *p1b = d + off1;
        }
        __syncthreads();
        {
            const float inv = 1.0f / fmaxf(sqrtf(ssq), 1e-12f);
            float t8[8], u8[8], w8[8];
            {
                LAS unsigned char* t0 = F.lds; const int tau = tok;
                float e1[8], ei[8];
#pragma unroll
                for (int i = 0; i < 8; ++i) { const int ch = ch0 + i; const float cm = LW0[ch * 64 + (tok ^ (4 * ((ch & 15) ^ (2 * (ch >> 4)))))]; e1[i] = __expf(cm); ei[i] = __builtin_amdgcn_rcpf(e1[i]); t8[i] = kkp[i] * inv * __expf(cm - lw0[i]); }
                if (tok == 63) {
#pragma unroll
                    for (int i = 0; i < 8; ++i) GAM[ch0 + i] = e1[i]; }
#pragma unroll
                for (int i = 0; i < 8; ++i) { u8[i] = kkp[i] * inv * a_0[i] * ei[i]; w8[i] = kd0[i] * ei[i]; }
                if (!IS_CO) { putN(t0 + 0 * TILE, tau, oct, t8); putT(t0 + 1 * TILE, tau, ch0, t8); putN(t0 + 2 * TILE, tau, oct, u8); putT(t0 + 3 * TILE, tau, ch0, u8);
                    putN(t0 + 4 * TILE, tau, oct, w8); putT(t0 + 5 * TILE, tau, ch0, w8); putT(t0 + 6 * TILE, tau, ch0, vs); }
                else {
#pragma unroll
                    for (int i = 0; i < 8; ++i) t8[i] = rs[i] * e1[i];
                    putN(t0 + 0 * TILE, tau, oct, w8); putN(t0 + 1 * TILE, tau, oct, u8); putN(t0 + 2 * TILE, tau, oct, t8); putT(t0 + 3 * TILE, tau, ch0, vs); }
            }
            {
                LAS unsigned char* t1 = F.lds + 9 * TILE; const int tau = 63 - tok;
                float e1[8], ei[8];
#pragma unroll
                for (int i = 0; i < 8; ++i) { const int ch = ch0 + i; const float cm = LW1[ch * 64 + (tok ^ (4 * ((ch & 15) ^ (2 * (ch >> 4)))))]; e1[i] = __expf(cm); ei[i] = __builtin_amdgcn_rcpf(e1[i]); t8[i] = kkp[i] * inv * __expf(cm - lw1[i]); }
                if (tok == 0) {
#pragma unroll
                    for (int i = 0; i < 8; ++i) GAM[64 + ch0 + i] = e1[i]; }
#pragma unroll
                for (int i = 0; i < 8; ++i) { u8[i] = kkp[i] * inv * a_1[i] * ei[i]; w8[i] = kd1[i] * ei[i]; }
                if (!IS_CO) { putN(t1 + 0 * TILE, tau, oct, t8); putT(t1 + 1 * TILE, tau, ch0, t8); putN(t1 + 2 * TILE, tau, oct, u8); putT(t1 + 3 * TILE, tau, ch0, u8);
                    putN(t1 + 4 * TILE, tau, oct, w8); putT(t1 + 5 * TILE, tau, ch0, w8); putT(t1 + 6 * TILE, tau, ch0, vs); }
                else {
#pragma unroll
                    for (int i = 0; i < 8; ++i) t8[i] = rs[i] * e1[i];
                    putN(t1 + 0 * TILE, tau, oct, w8); putN(t1 + 1 * TILE, tau, oct, u8); putN(t1 + 2 * TILE, tau, oct, t8); putT(t1 + 3 * TILE, tau, ch0, vs); }
            }
        }
        if (!STAGES) { __syncthreads(); continue; }
        const size_t inst = (size_t)unit * 2 + dgrp;
        const int t2 = (wq << 6) | lane;
        if (IS_CO) {
#pragma unroll
            for (int rep = 0; rep < 2; ++rep) { const int cidx = t2 + 256 * rep, row = cidx >> 3, ch = cidx & 7;
                const v4u a = *(const v4u*)(TKN + inst * 8192 + (size_t)(row * 64 + ch * 8) * 2), hh = *(const v4u*)(H0T + inst * 8192 + (size_t)(row * 64 + ch * 8) * 2);
                *(LAS v4u*)(SL(4) + row * 128 + ((ch ^ swz(row)) << 4)) = a; *(LAS v4u*)(SL(5) + row * 128 + ((ch ^ swz(row)) << 4)) = hh; }
        }
        v4u upre0 = {0u, 0u, 0u, 0u}, upre1 = upre0;
        if (IS_CO) { const unsigned char* up = UPRE + inst * 8192 + (size_t)((wq * 64 + lane) * 32); upre0 = *(const v4u*)up; upre1 = *(const v4u*)(up + 16); }
        if (unit + F.G < NU) epre_load<IS_CO>(PF, z, LO, unit + F.G, wave, lane);
        const int cv_strip = F.gw + (cv_t >> 4) * F.NGW, cv_kb = cv_t & 15;
        if (!IS_CO && cv_strip < NE * 64) { int e_, n0_, rb_; wei_strip(cv_strip, e_, n0_, rb_); cv_load(cvt, cv_w + (size_t)e_ * D * 2048, 2048, n0_, cv_kb, lane); }
        __syncthreads();
        f32x4 acc[4], acc2[4];
        if (!IS_CO) {
            zero4(acc); mm64<false>(acc, SL(2), SL(0), wq, lane);
            zero4(acc2); mm64<false>(acc2, SL(4), SL(0), wq, lane);
#pragma unroll
            for (int n = 0; n < 4; ++n)
#pragma unroll
                for (int q = 0; q < 4; ++q) { const bool lo = (16 * wq + 4 * g + q < 16 * n + lr); acc[n][q] = lo ? acc[n][q] : 0.f; acc2[n][q] = lo ? acc2[n][q] : 0.f; }
            storeT(SL(7), acc, wq, lane); storeT(SL(8), acc2, wq, lane);
            __syncthreads();
            zero4(acc); mm64<false>(acc, SL(8), SL(6), wq, lane); storeT(SL(0), acc, wq, lane);
            if (wq == 0) {
                const int bb = lane >> 4, jj = lane & 15;
                float X[16];
                X[0] = (jj == 0) ? 1.f : 0.f;
#pragma unroll
                for (int t = 1; t < 16; ++t) {
                    const int row = 16 * bb + t;
                    const v4u p0 = *(const LAS v4u*)(SL(7) + row * 128 + (((2 * bb) ^ swz(row)) << 4)), p1 = *(const LAS v4u*)(SL(7) + row * 128 + (((2 * bb + 1) ^ swz(row)) << 4));
                    float rw[16];
                    rw[0] = bflo(p0.x); rw[1] = bfhi(p0.x); rw[2] = bflo(p0.y); rw[3] = bfhi(p0.y); rw[4] = bflo(p0.z); rw[5] = bfhi(p0.z); rw[6] = bflo(p0.w); rw[7] = bfhi(p0.w);
                    rw[8] = bflo(p1.x); rw[9] = bfhi(p1.x); rw[10] = bflo(p1.y); rw[11] = bfhi(p1.y); rw[12] = bflo(p1.z); rw[13] = bfhi(p1.z); rw[14] = bflo(p1.w); rw[15] = bfhi(p1.w);
                    float xv = (t == jj) ? 1.f : 0.f;
#pragma unroll
                    for (int s = 0; s < t; ++s) xv -= rw[s] * X[s];
                    X[t] = xv;
                }
#pragma unroll
                for (int t = 0; t < 16; ++t) *(LAS unsigned short*)(DIB + (((bb * 16 + t) * 16 + jj) << 1)) = (unsigned short)f2bf(X[t]);
            }
            __syncthreads();
            {
                const bool isU = wq >= 2; const int cbase = 32 * (wq & 1);
                const LAS unsigned char* Rt = isU ? SL(0) : SL(1);
                LAS unsigned char* outT = isU ? SL(4) : SL(2);
#pragma unroll
                for (int ct = 0; ct < 2; ++ct) {
                    const int col = cbase + 16 * ct + lr;
                    f32x4 X[4];
#pragma unroll
                    for (int b = 0; b < 4; ++b) {
                        const v2u rwv = *(const LAS v2u*)(Rt + toff(col, 16 * b + 4 * g));
                        f32x4 Zt = {bflo(rwv.x), bfhi(rwv.x), bflo(rwv.y), bfhi(rwv.y)};
                        if (b >= 1) {
                            f32x4 Y = {0.f, 0.f, 0.f, 0.f};
#pragma unroll
                            for (int s = 0; s < (b + 1) / 2; ++s) {
                                v2u alo = {0u, 0u}, ahi = {0u, 0u};
                                if (2 * s < b) alo = *(const LAS v2u*)(SL(7) + toff(16 * b + lr, 32 * s + 4 * g));
                                if (2 * s + 1 < b) ahi = *(const LAS v2u*)(SL(7) + toff(16 * b + lr, 32 * s + 16 + 4 * g));
                                v4u bw = {cvtpk(X[2 * s][0], X[2 * s][1]), cvtpk(X[2 * s][2], X[2 * s][3]), 0u, 0u};
                                if (2 * s + 1 < b) { bw.z = cvtpk(X[2 * s + 1][0], X[2 * s + 1][1]); bw.w = cvtpk(X[2 * s + 1][2], X[2 * s + 1][3]); }
                                Y = CK_MFMA(__builtin_bit_cast(bf16x8, ((v4u){alo.x, alo.y, ahi.x, ahi.y})), __builtin_bit_cast(bf16x8, bw), Y);
                            }
                            Zt = Zt - Y;
                        }
                        const v2u dv = *(const LAS v2u*)(DIB + (((b * 16 + lr) * 16 + 4 * g) << 1));
                        const v4u bz = {cvtpk(Zt[0], Zt[1]), cvtpk(Zt[2], Zt[3]), 0u, 0u};
                        X[b] = CK_MFMA(__builtin_bit_cast(bf16x8, ((v4u){dv.x, dv.y, 0u, 0u})), __builtin_bit_cast(bf16x8, bz), ((f32x4){0.f, 0.f, 0.f, 0.f}));
                    }
#pragma unroll
                    for (int b = 0; b < 4; ++b) {
                        const v2u pk = {cvtpk(X[b][0], X[b][1]), cvtpk(X[b][2], X[b][3])};
                        *(LAS v2u*)(outT + toff(col, 16 * b + 4 * g)) = pk;
                        if (!isU) {
#pragma unroll
                            for (int q = 0; q < 4; ++q) *(LAS unsigned short*)(SL(8) + toff(16 * b + 4 * g + q, col)) = (unsigned short)f2bf(X[b][q]);
                        } else {
                            *(uint2*)(UPRE + inst * 8192 + (size_t)(((b * 64 + lane) * 4 + 2 * (wq & 1) + ct) * 8)) = make_uint2(pk.x, pk.y);
                        }
                    }
                }
            }
            __syncthreads();
            { zero4(acc); mm64<false>(acc, SL(2), SL(3), wq, lane);
              const int cstep_ = unit < NU_L ? 4 + (dgrp ? 127 - ((unit >> 4) & 127) : ((unit >> 4) & 127)) : (dgrp ? 3 - (((unit - NU_L) >> 4) & 3) : (((unit - NU_L) >> 4) & 3));
              unsigned char* pb = PQ + (size_t)(((b * 16 + h) * 2 + dgrp) * (4 + T / 64) + cstep_) * 16384;
#pragma unroll
              for (int n = 0; n < 4; ++n) { const int k = 16 * n + lr; const float gm = GAM[dgrp * 64 + k]; float p[4];
#pragma unroll
                  for (int q = 0; q < 4; ++q) p[q] = gm * (((16 * wq + 4 * g + q) == k ? 1.f : 0.f) - acc[n][q]);
                  *(uint2*)(pb + (size_t)(((n * 2 + (wq >> 1)) * 64 + lane) * 16 + (wq & 1) * 8)) = make_uint2(cvtpk(p[0], p[1]), cvtpk(p[2], p[3])); }
              zero4(acc); mm64<false>(acc, SL(5), SL(6), wq, lane); zero4(acc2); mm64<false>(acc2, SL(3), SL(4), wq, lane);
              const f32x4 gm4 = *(const LAS f32x4*)(GAM + dgrp * 64 + 16 * wq + 4 * g);
#pragma unroll
              for (int n = 0; n < 4; ++n) { const f32x4 qv = (acc[n] - acc2[n]) * gm4;
                  *(uint2*)(pb + 8192 + (size_t)(((n * 64 + lane) * 4 + wq) * 8)) = make_uint2(cvtpk(qv[0], qv[1]), cvtpk(qv[2], qv[3])); }
#pragma unroll
              for (int rep = 0; rep < 2; ++rep) { const int cidx = t2 + 256 * rep, row = cidx >> 3, ch = cidx & 7;
                  *(v4u*)(TKN + inst * 8192 + (size_t)(row * 64 + ch * 8) * 2) = *(const LAS v4u*)(SL(8) + row * 128 + ((ch ^ swz(row)) << 4)); }
            }
        } else {
            zero4(acc); mm64<false>(acc, SL(0), SL(2), wq, lane);
#pragma unroll
            for (int n = 0; n < 4; ++n)
#pragma unroll
                for (int q = 0; q < 4; ++q) acc[n][q] = (16 * wq + 4 * g + q <= 16 * n + lr) ? acc[n][q] : 0.f;
            storeT(SL(6), acc, wq, lane);
            zero4(acc); mm64<false>(acc, SL(1), SL(2), wq, lane);
#pragma unroll
            for (int n = 0; n < 4; ++n)
#pragma unroll
                for (int q = 0; q < 4; ++q) acc[n][q] = (16 * wq + 4 * g + q <= 16 * n + lr) ? -acc[n][q] : 0.f;
            storeT(SL(7), acc, wq, lane);
            { const v4u o0 = upre0, o1 = upre1;
              acc[0] = (f32x4){bflo(o0.x), bfhi(o0.x), bflo(o0.y), bfhi(o0.y)}; acc[1] = (f32x4){bflo(o0.z), bfhi(o0.z), bflo(o0.w), bfhi(o0.w)};
              acc[2] = (f32x4){bflo(o1.x), bfhi(o1.x), bflo(o1.y), bfhi(o1.y)}; acc[3] = (f32x4){bflo(o1.z), bfhi(o1.z), bflo(o1.w), bfhi(o1.w)}; }
            mm64<false>(acc, SL(4), SL(5), wq, lane);
            storeT(SL(8), acc, wq, lane);
            __syncthreads();
            zero4(acc); mm64<false>(acc, SL(2), SL(5), wq, lane); mm64<false>(acc, SL(6), SL(3), wq, lane); mm64<false>(acc, SL(7), SL(8), wq, lane);
            __syncthreads();
            { LAS float* Yf = (LAS float*)(tl);
#pragma unroll
              for (int n = 0; n < 4; ++n)
#pragma unroll
                  for (int q = 0; q < 4; ++q) { const int tau = 16 * wq + 4 * g + q; Yf[tau * 64 + ((16 * n + lr) ^ (4 * (tau & 15)))] = acc[n][q]; } }
            __syncthreads();
            { const LAS float* Y0 = (const LAS float*)(F.lds); const LAS float* Y1 = (const LAS float*)(F.lds + 9 * TILE);
              const int t = row & (T - 1);
              const bf16* zr = z + (size_t)row * NZ;
              const v4u zz = {0u, 0u, 0u, 0u};
              const v4u q_g = *(const v4u*)(LO + (size_t)row * NL + 4096 + c0);
              const v4u q_gb = *(const v4u*)(zr + CONV_OFF + c0), q_c0 = *(const v4u*)(zr + CONV_OFF + 1024 + c0), q_x0 = *(const v4u*)(zr + CONV_OFF + 2048 + c0);
              const v4u q_cm = t > 0 ? *(const v4u*)(zr - NZ + CONV_OFF + 1024 + c0) : zz, q_xm = t > 0 ? *(const v4u*)(zr - NZ + CONV_OFF + 2048 + c0) : zz;
              const v4u q_cp = t < T - 1 ? *(const v4u*)(zr + NZ + CONV_OFF + 1024 + c0) : zz, q_xp = t < T - 1 ? *(const v4u*)(zr + NZ + CONV_OFF + 2048 + c0) : zz;
              const v4u q_ga = *(const v4u*)(zr + GATE_OFF + c0), q_gr = *(const v4u*)(zr + GATE_OFF + 1024 + c0);
              float y[8];
              { const int s0 = 4 * (tok & 15), s1 = 4 * ((63 - tok) & 15);
                const f32x4 a0 = *(const LAS f32x4*)(Y0 + tok * 64 + (ch0 ^ s0)), a1 = *(const LAS f32x4*)(Y0 + tok * 64 + ((ch0 + 4) ^ s0));
                const f32x4 b0 = *(const LAS f32x4*)(Y1 + (63 - tok) * 64 + (ch0 ^ s1)), b1 = *(const LAS f32x4*)(Y1 + (63 - tok) * 64 + ((ch0 + 4) ^ s1));
                y[0] = a0.x + b0.x; y[1] = a0.y + b0.y; y[2] = a0.z + b0.z; y[3] = a0.w + b0.w; y[4] = a1.x + b1.x; y[5] = a1.y + b1.y; y[6] = a1.z + b1.z; y[7] = a1.w + b1.w; }
              float rk[8]; ld8f(KIN(I_RK) + c0, rk);
              float s1 = 0.f, s2 = 0.f, s3 = 0.f;
#pragma unroll
              for (int i = 0; i < 8; ++i) { s1 += y[i]; s2 += y[i] * y[i]; s3 += rs[i] * 0.5f * (kd0[i] + kd1[i]) * rk[i]; }
              s1 += __shfl_xor(s1, 1); s2 += __shfl_xor(s2, 1); s3 += __shfl_xor(s3, 1); s1 += __shfl_xor(s1, 2); s2 += __shfl_xor(s2, 2); s3 += __shfl_xor(s3, 2);
              s1 += __shfl_xor(s1, 4); s2 += __shfl_xor(s2, 4); s3 += __shfl_xor(s3, 4);
              const float S1 = s1, S2 = s2, S3 = s3;
              const float mean = S1 * (1.0f / 64.0f), var = fmaxf(S2 * (1.0f / 64.0f) - mean * mean, 0.f), rstd = __builtin_amdgcn_rsqf(var + 64e-5f);
              float lnw[8], lnb[8], cw0[8], cw1[8], cw2[8];
              ld8f(KIN(I_LNW) + c0, lnw); ld8f(KIN(I_LNB) + c0, lnb); ld8f(KIN(I_CONVW) + c0, cw0); ld8f(KIN(I_CONVW) + D + c0, cw1); ld8f(KIN(I_CONVW) + 2 * D + c0, cw2);
              float gg[8], gb[8], cc[8], xx[8], cm[8], xm[8], cp[8], xp[8], ga[8], gr[8];
              unpack8(q_g, gg); unpack8(q_gb, gb); unpack8(q_c0, cc); unpack8(q_x0, xx); unpack8(q_cm, cm); unpack8(q_xm, xm); unpack8(q_cp, cp); unpack8(q_xp, xp); unpack8(q_ga, ga); unpack8(q_gr, gr);
              float o[8];
#pragma unroll
              for (int i = 0; i < 8; ++i) {
                  const float yn = (y[i] - mean) * rstd * lnw[i] + lnb[i];
                  const float yr = (yn + S3 * vs[i]) * gg[i];
                  const float yc = gb[i] * (cw0[i] * (cm[i] * xm[i]) + cw1[i] * (cc[i] * xx[i]) + cw2[i] * (cp[i] * xp[i]));
                  o[i] = fsig(ga[i]) * yr + fsig(gr[i]) * yc;
              }
              v4u ov; ov.x = cvtpk(o[0], o[1]); ov.y = cvtpk(o[2], o[3]); ov.z = cvtpk(o[4], o[5]); ov.w = cvtpk(o[6], o[7]);
              *(v4u*)(MG + (size_t)row * D + c0) = ov;
            }
        }
        __syncthreads();
        if (!IS_CO) {
            if (cv_strip < NE * 64) { int e_, n0_, rb_; wei_strip(cv_strip, e_, n0_, rb_);
                if (cv_kb == 0) cv_scale_q8(cv_w + (size_t)e_ * D * 2048, 2048, n0_, (float*)(F.ws + MI_CSWEI) + (size_t)e_ * 2048, rb_, lane, civ);
                cv_store_q8(cvt, cv_scr, (signed char*)(F.ws + WS_WEIN) + (size_t)e_ * 2048 * D, rb_, cv_kb, civ, lane); }
            ++cv_t;
            __syncthreads();
        }
    }
    if (!IS_CO) {
        for (;;) { const int s_ = F.gw + (cv_t >> 4) * F.NGW, kb_ = cv_t & 15; if (s_ >= NE * 64) break;
            int e_, n0_, rb_; wei_strip(s_, e_, n0_, rb_);
            if (kb_ == 0) cv_scale_q8(cv_w + (size_t)e_ * D * 2048, 2048, n0_, (float*)(F.ws + MI_CSWEI) + (size_t)e_ * 2048, rb_, F.lane, civ);
            cv_load(cvt, cv_w + (size_t)e_ * D * 2048, 2048, n0_, kb_, F.lane);
            cv_store_q8(cvt, cv_scr, (signed char*)(F.ws + WS_WEIN) + (size_t)e_ * 2048 * D, rb_, kb_, civ, F.lane); ++cv_t; }
    }
#undef SL
}

typedef short s16x4 __attribute__((ext_vector_type(4)));
__device__ __forceinline__ bf16x8 ldfragT(const LAS unsigned char* t, int c, int ks, int lane) {
    const int g = lane >> 4, q = (lane & 15) >> 2, p = lane & 3;
    const int r0 = 32 * ks + 8 * g + q, r1 = r0 + 4;
    const s16x4 a = __builtin_amdgcn_ds_read_tr16_b64_v4i16((LAS s16x4*)(t + r0 * 128 + (((2 * c + (p >> 1)) ^ swz(r0)) << 4) + 8 * (p & 1)));
    const s16x4 b = __builtin_amdgcn_ds_read_tr16_b64_v4i16((LAS s16x4*)(t + r1 * 128 + (((2 * c + (p >> 1)) ^ swz(r1)) << 4) + 8 * (p & 1)));
    return (bf16x8){a[0], a[1], a[2], a[3], b[0], b[1], b[2], b[3]};
}
__device__ __forceinline__ f32x4 loadN_acc(const LAS unsigned char* t, int b, int ct, int lane) {
    const int g = lane >> 4, q = (lane & 15) >> 2, p = lane & 3;
    const int r0 = 16 * b + 4 * g + q;
    const s16x4 a = __builtin_amdgcn_ds_read_tr16_b64_v4i16((LAS s16x4*)(t + r0 * 128 + (((2 * ct + (p >> 1)) ^ swz(r0)) << 4) + 8 * (p & 1)));
    return (f32x4){bf1((bf16)a[0]), bf1((bf16)a[1]), bf1((bf16)a[2]), bf1((bf16)a[3])};
}
template <bool LT, bool RT>
__device__ __forceinline__ void mm64x(f32x4 (&acc)[4], const LAS unsigned char* Lt, const LAS unsigned char* Rt, int wq, int lane) {
    const int lr = lane & 15, g = lane >> 4;
    const bf16x8 l0 = LT ? ldfragT(Lt, wq, 0, lane) : ldfrag(Lt, 16 * wq + lr, g), l1 = LT ? ldfragT(Lt, wq, 1, lane) : ldfrag(Lt, 16 * wq + lr, 4 + g);
#pragma unroll
    for (int n = 0; n < 4; ++n) {
        const bf16x8 r0 = RT ? ldfragT(Rt, n, 0, lane) : ldfrag(Rt, 16 * n + lr, g), r1 = RT ? ldfragT(Rt, n, 1, lane) : ldfrag(Rt, 16 * n + lr, 4 + g);
        acc[n] = CK_MFMA(l0, r0, acc[n]); acc[n] = CK_MFMA(l1, r1, acc[n]);
    }
}

__device__ __forceinline__ void phase_cp2(Frame& F) {
    const int wave = F.wave;
    const int dgrp = wave >> 2, wq = wave & 3;
    LAS unsigned char* tl = F.lds + dgrp * 9 * TILE;
#define SL(k) (tl + (k) * TILE)
    LAS float* SEG = (LAS float*)(F.lds + LDS_X_OFF);
    LAS float* GAM = SEG + 1024;
    LAS unsigned char* DIB = (LAS unsigned char*)(GAM + 128) + dgrp * 2048;
    LAS float* LW0 = (LAS float*)(F.lds + 7 * TILE);
    LAS float* LW1 = (LAS float*)(F.lds + 16 * TILE);
    const bf16* z = (const bf16*)(F.ws + WS_Z); const bf16* LO = (const bf16*)(F.ws + WS_LORA);
    unsigned char* PQ = F.ws + WS_PQ; unsigned char* RHAT = F.ws + WS_TKN; unsigned char* YLOC = F.ws + WS_UPRE;
    float* BON = (float*)(F.ws + MI_BON);
    const float* p_mu = KIN(I_MU); const float* p_kk = KIN(I_KK); const float* p_ka = KIN(I_KA); const float* p_rk = KIN(I_RK);
    constexpr int NU = NU_ALL;
    LAS float* PRM = (LAS float*)(F.lds + LDS_X_OFF + 8704);
    int h_prm = -1;
    EPre<true> PF;
    CvTile cvt; float civ[4] = {0.f, 0.f, 0.f, 0.f}; int cv_t = 0;
    const float* cv_w = KIN(I_WEI);
    LAS float* cv_scr = (LAS float*)(F.lds + wave * 16384);
    if ((int)blockIdx.x < NU) epre_load<true>(PF, z, LO, (int)blockIdx.x, wave, F.lane);
    if (!SEAM_FILL && F.gw < NE * 64) { int e_, n0_, rb_; wei_strip(F.gw, e_, n0_, rb_);
        cv_scale_q8(cv_w + (size_t)e_ * D * 2048, 2048, n0_, (float*)(F.ws + MI_CSWEI) + (size_t)e_ * 2048, rb_, F.lane, civ); }
    asm volatile("" : "+v"(PF.k[0]), "+v"(PF.k[1]), "+v"(PF.k[2]), "+v"(PF.k[3]), "+v"(PF.k[4]), "+v"(PF.v[0]), "+v"(PF.v[1]), "+v"(PF.v[2]), "+v"(PF.v[3]), "+v"(PF.v[4]));
    asm volatile("" : "+v"(PF.r[0]), "+v"(PF.r[1]), "+v"(PF.r[2]), "+v"(PF.r[3]), "+v"(PF.r[4]), "+v"(PF.lo[0]), "+v"(PF.lo[1]), "+v"(PF.lo[2]), "+v"(PF.lo[3]));
    asm volatile("s_waitcnt vmcnt(0)" ::: "memory");
    for (int unit = blockIdx.x; unit < NU; unit += F.G) {
        int lane = F.lane; asm volatile("" : "+v"(lane));
        const int lr = lane & 15, g = lane >> 4;
        int b, h, rowbase; unit_decode(unit, b, h, rowbase);
        if (h != h_prm) {
            __syncthreads();
            if (F.tid < 96) { const int arr = F.tid >> 4, off = (F.tid & 15) * 4;
                const float* src = arr == 0 ? p_mu + K_OFF : arr == 1 ? p_mu + V_OFF : arr == 2 ? p_mu + R_OFF : arr == 3 ? p_kk : arr == 4 ? p_ka : p_rk;
                *(LAS f32x4*)(PRM + arr * 64 + off) = *(const f32x4*)(src + h * 64 + off); }
            __syncthreads(); h_prm = h; }
        const int tok = 8 * wave + (lane >> 3), oct = lane & 7, ch0 = 8 * oct, c0 = h * 64 + ch0;
        float ks[8], vs[8], rs[8], kkp[8], lw0[8], lw1[8], kd0[8], kd1[8], a_0[8], a_1[8], ssq;
        {
            { float m_[8]; ld8l(PRM + ch0, m_); shift8m(PF.k, m_, ks, PF.msk); ld8l(PRM + 64 + ch0, m_); shift8m(PF.v, m_, vs, PF.msk); ld8l(PRM + 128 + ch0, m_); shift8m(PF.r, m_, rs, PF.msk); }
            float kkk[8], kaa[8], rkk[8];
            unpack8(PF.lo[0], lw0); unpack8(PF.lo[1], lw1); unpack8(PF.lo[2], a_0); unpack8(PF.lo[3], a_1);
            ld8l(PRM + 192 + ch0, kkk); ld8l(PRM + 256 + ch0, kaa); ld8l(PRM + 320 + ch0, rkk);
            float ss = 0.f, bs = 0.f;
#pragma unroll
            for (int i = 0; i < 8; ++i) {
                kkp[i] = ks[i] * kkk[i]; ss += kkp[i] * kkp[i];
                kd0[i] = ks[i] * (1.0f + (a_0[i] - 1.0f) * kaa[i]); kd1[i] = ks[i] * (1.0f + (a_1[i] - 1.0f) * kaa[i]);
                bs += rs[i] * 0.5f * (kd0[i] + kd1[i]) * rkk[i];
                const int ch = ch0 + i, sw = tok ^ (4 * ((ch & 15) ^ (2 * (ch >> 4))));
                LW0[ch * 64 + sw] = lw0[i]; LW1[ch * 64 + sw] = lw1[i];
            }
            ss += __shfl_xor(ss, 1); bs += __shfl_xor(bs, 1); ss += __shfl_xor(ss, 2); bs += __shfl_xor(bs, 2); ss += __shfl_xor(ss, 4); bs += __shfl_xor(bs, 4);
            ssq = ss;
            if (oct == 0 && unit < NU_L) BON[(size_t)unit * 64 + tok] = bs;
        }
        __syncthreads();
        {
            const int ch2 = lane, seg = wave, sw = 4 * ((ch2 & 15) ^ (2 * (ch2 >> 4)));
            LAS f32x4* p0a = (LAS f32x4*)(LW0 + ch2 * 64 + ((8 * seg) ^ sw)); LAS f32x4* p0b = (LAS f32x4*)(LW0 + ch2 * 64 + ((8 * seg + 4) ^ sw));
            LAS f32x4* p1a = (LAS f32x4*)(LW1 + ch2 * 64 + ((8 * seg) ^ sw)); LAS f32x4* p1b = (LAS f32x4*)(LW1 + ch2 * 64 + ((8 * seg + 4) ^ sw));
            f32x4 a = *p0a, bq = *p0b, c = *p1a, d = *p1b;
            a.y += a.x; a.z += a.y; a.w += a.z; bq.x += a.w; bq.y += bq.x; bq.z += bq.y; bq.w += bq.z;
            d.z += d.w; d.y += d.z; d.x += d.y; c.w += d.x; c.z += c.w; c.y += c.z; c.x += c.y;
            SEG[seg * 64 + ch2] = bq.w; SEG[(8 + seg) * 64 + ch2] = c.x;
            __syncthreads();
            float off0 = 0.f, off1 = 0.f;
#pragma unroll
            for (int s2 = 0; s2 < 8; ++s2) { const float t0 = SEG[s2 * 64 + ch2], t1 = SEG[(8 + s2) * 64 + ch2]; off0 += (s2 < seg) ? t0 : 0.f; off1 += (s2 > seg) ? t1 : 0.f; }
            *p0a = a + off0; *p0b = bq + off0; *p1a = c + off1; *p1b = d + off1;
        }
        __syncthreads();
        {
            const float inv = 1.0f / fmaxf(sqrtf(ssq), 1e-12f);
            float t8[8], u8[8], w8[8], r8v[8];
            {
                LAS unsigned char* t0 = F.lds; const int tau = tok;
                float e1[8], ei[8];
#pragma unroll
                for (int i = 0; i < 8; ++i) { const int ch = ch0 + i; const float cm = LW0[ch * 64 + (tok ^ (4 * ((ch & 15) ^ (2 * (ch >> 4)))))]; e1[i] = __expf(cm); ei[i] = __builtin_amdgcn_rcpf(e1[i]); t8[i] = kkp[i] * inv * __expf(cm - lw0[i]); }
                if (tok == 63) {
#pragma unroll
                    for (int i = 0; i < 8; ++i) GAM[ch0 + i] = e1[i]; }
#pragma unroll
                for (int i = 0; i < 8; ++i) { u8[i] = kkp[i] * inv * a_0[i] * ei[i]; w8[i] = kd0[i] * ei[i]; r8v[i] = rs[i] * e1[i]; }
                putN(t0 + 0 * TILE, tau, oct, t8); putN(t0 + 1 * TILE, tau, oct, u8); putN(t0 + 2 * TILE, tau, oct, w8); putN(t0 + 3 * TILE, tau, oct, vs); putN(t0 + 4 * TILE, tau, oct, r8v);
            }
            {
                LAS unsigned char* t1 = F.lds + 9 * TILE; const int tau = 63 - tok;
                float e1[8], ei[8];
#pragma unroll
                for (int i = 0; i < 8; ++i) { const int ch = ch0 + i; const float cm = LW1[ch * 64 + (tok ^ (4 * ((ch & 15) ^ (2 * (ch >> 4)))))]; e1[i] = __expf(cm); ei[i] = __builtin_amdgcn_rcpf(e1[i]); t8[i] = kkp[i] * inv * __expf(cm - lw1[i]); }
                if (tok == 0) {
#pragma unroll
                    for (int i = 0; i < 8; ++i) GAM[64 + ch0 + i] = e1[i]; }
#pragma unroll
                for (int i = 0; i < 8; ++i) { u8[i] = kkp[i] * inv * a_1[i] * ei[i]; w8[i] = kd1[i] * ei[i]; r8v[i] = rs[i] * e1[i]; }
                putN(t1 + 0 * TILE, tau, oct, t8); putN(t1 + 1 * TILE, tau, oct, u8); putN(t1 + 2 * TILE, tau, oct, w8); putN(t1 + 3 * TILE, tau, oct, vs); putN(t1 + 4 * TILE, tau, oct, r8v);
            }
        }
        const size_t inst = (size_t)unit * 2 + dgrp;
        epre_load<true>(PF, z, LO, unit + F.G < NU ? unit + F.G : unit, wave, lane);
        const int cv_strip = F.gw + (cv_t >> 4) * F.NGW, cv_kb = cv_t & 15;
        if (!SEAM_FILL) { int e_, n0_, rb_; wei_strip(cv_strip < NE * 64 ? cv_strip : 0, e_, n0_, rb_); cv_load(cvt, cv_w + (size_t)e_ * D * 2048, 2048, n0_, cv_kb, lane); }
        __syncthreads();
        f32x4 acc[4], acc2[4];
        zero4(acc); mm64x<false, false>(acc, SL(1), SL(0), wq, lane);
        zero4(acc2); mm64x<false, false>(acc2, SL(2), SL(0), wq, lane);
#pragma unroll
        for (int n = 0; n < 4; ++n)
#pragma unroll
            for (int q = 0; q < 4; ++q) { const bool lo = (16 * wq + 4 * g + q < 16 * n + lr); acc[n][q] = lo ? acc[n][q] : 0.f; acc2[n][q] = lo ? acc2[n][q] : 0.f; }
        storeT(SL(5), acc, wq, lane); storeT(SL(6), acc2, wq, lane);
        __syncthreads();
        zero4(acc); mm64x<false, true>(acc, SL(6), SL(3), wq, lane); storeT(SL(7), acc, wq, lane);
        if (wq == 0) {
            const int bb = lane >> 4, jj = lane & 15;
            float X[16];
            X[0] = (jj == 0) ? 1.f : 0.f;
#pragma unroll
            for (int t = 1; t < 16; ++t) {
                const int row = 16 * bb + t;
                const v4u p0 = *(const LAS v4u*)(SL(5) + row * 128 + (((2 * bb) ^ swz(row)) << 4)), p1 = *(const LAS v4u*)(SL(5) + row * 128 + (((2 * bb + 1) ^ swz(row)) << 4));
                float rw[16];
                rw[0] = bflo(p0.x); rw[1] = bfhi(p0.x); rw[2] = bflo(p0.y); rw[3] = bfhi(p0.y); rw[4] = bflo(p0.z); rw[5] = bfhi(p0.z); rw[6] = bflo(p0.w); rw[7] = bfhi(p0.w);
                rw[8] = bflo(p1.x); rw[9] = bfhi(p1.x); rw[10] = bflo(p1.y); rw[11] = bfhi(p1.y); rw[12] = bflo(p1.z); rw[13] = bfhi(p1.z); rw[14] = bflo(p1.w); rw[15] = bfhi(p1.w);
                float xv = (t == jj) ? 1.f : 0.f;
#pragma unroll
                for (int s = 0; s < t; ++s) xv -= rw[s] * X[s];
                X[t] = xv;
            }
#pragma unroll
            for (int t = 0; t < 16; ++t) *(LAS unsigned short*)(DIB + (((bb * 16 + t) * 16 + jj) << 1)) = (unsigned short)f2bf(X[t]);
        }
        __syncthreads();
        {
            const bool isU = wq >= 2; const int cbase = 32 * (wq & 1);
            LAS unsigned char* outT = isU ? SL(6) : SL(8);
#pragma unroll
            for (int ct = 0; ct < 2; ++ct) {
                const int ctile = 2 * (wq & 1) + ct, col = cbase + 16 * ct + lr;
                f32x4 X[4];
#pragma unroll
                for (int b2 = 0; b2 < 4; ++b2) {
                    f32x4 Zt;
                    if (isU) { const v2u rwv = *(const LAS v2u*)(SL(7) + toff(col, 16 * b2 + 4 * g)); Zt = (f32x4){bflo(rwv.x), bfhi(rwv.x), bflo(rwv.y), bfhi(rwv.y)}; }
                    else Zt = loadN_acc(SL(0), b2, ctile, lane);
                    if (b2 >= 1) {
                        f32x4 Y = {0.f, 0.f, 0.f, 0.f};
#pragma unroll
                        for (int s = 0; s < (b2 + 1) / 2; ++s) {
                            v2u alo = {0u, 0u}, ahi = {0u, 0u};
                            if (2 * s < b2) alo = *(const LAS v2u*)(SL(5) + toff(16 * b2 + lr, 32 * s + 4 * g));
                            if (2 * s + 1 < b2) ahi = *(const LAS v2u*)(SL(5) + toff(16 * b2 + lr, 32 * s + 16 + 4 * g));
                            v4u bw = {cvtpk(X[2 * s][0], X[2 * s][1]), cvtpk(X[2 * s][2], X[2 * s][3]), 0u, 0u};
                            if (2 * s + 1 < b2) { bw.z = cvtpk(X[2 * s + 1][0], X[2 * s + 1][1]); bw.w = cvtpk(X[2 * s + 1][2], X[2 * s + 1][3]); }
                            Y = CK_MFMA(__builtin_bit_cast(bf16x8, ((v4u){alo.x, alo.y, ahi.x, ahi.y})), __builtin_bit_cast(bf16x8, bw), Y);
                        }
                        Zt = Zt - Y;
                    }
                    const v2u dv = *(const LAS v2u*)(DIB + (((b2 * 16 + lr) * 16 + 4 * g) << 1));
                    const v4u bz = {cvtpk(Zt[0], Zt[1]), cvtpk(Zt[2], Zt[3]), 0u, 0u};
                    X[b2] = CK_MFMA(__builtin_bit_cast(bf16x8, ((v4u){dv.x, dv.y, 0u, 0u})), __builtin_bit_cast(bf16x8, bz), ((f32x4){0.f, 0.f, 0.f, 0.f}));
                }
#pragma unroll
                for (int b2 = 0; b2 < 4; ++b2) *(LAS v2u*)(outT + toff(col, 16 * b2 + 4 * g)) = (v2u){cvtpk(X[b2][0], X[b2][1]), cvtpk(X[b2][2], X[b2][3])};
            }
        }
        __syncthreads();
        asm volatile("" : "+v"(PF.k[0]), "+v"(PF.k[1]), "+v"(PF.k[2]), "+v"(PF.k[3]), "+v"(PF.k[4]), "+v"(PF.v[0]), "+v"(PF.v[1]), "+v"(PF.v[2]), "+v"(PF.v[3]), "+v"(PF.v[4]));
        asm volatile("" : "+v"(PF.r[0]), "+v"(PF.r[1]), "+v"(PF.r[2]), "+v"(PF.r[3]), "+v"(PF.r[4]), "+v"(PF.lo[0]), "+v"(PF.lo[1]), "+v"(PF.lo[2]), "+v"(PF.lo[3]));
        if (!SEAM_FILL) asm volatile("" : "+v"(cvt.v[0]), "+v"(cvt.v[1]), "+v"(cvt.v[2]), "+v"(cvt.v[3]), "+v"(cvt.v[4]), "+v"(cvt.v[5]), "+v"(cvt.v[6]), "+v"(cvt.v[7]));
        {
            zero4(acc); mm64x<false, true>(acc, SL(8), SL(1), wq, lane);
            const int cstep_ = unit < NU_L ? 4 + (dgrp ? 127 - ((unit >> 4) & 127) : ((unit >> 4) & 127)) : (dgrp ? 3 - (((unit - NU_L) >> 4) & 3) : (((unit - NU_L) >> 4) & 3));
            unsigned char* pb = PQ + (size_t)(((b * 16 + h) * 2 + dgrp) * (4 + T / 64) + cstep_) * 16384;
#pragma unroll
            for (int n = 0; n < 4; ++n) { const int k = 16 * n + lr; const float gm = GAM[dgrp * 64 + k]; float p[4];
#pragma unroll
                for (int q = 0; q < 4; ++q) p[q] = gm * (((16 * wq + 4 * g + q) == k ? 1.f : 0.f) - acc[n][q]);
                *(uint2*)(pb + (size_t)(((n * 2 + (wq >> 1)) * 64 + lane) * 16 + (wq & 1) * 8)) = make_uint2(cvtpk(p[0], p[1]), cvtpk(p[2], p[3])); }
            zero4(acc); mm64x<true, true>(acc, SL(2), SL(3), wq, lane); zero4(acc2); mm64x<true, false>(acc2, SL(1), SL(6), wq, lane);
            const f32x4 gm4 = *(const LAS f32x4*)(GAM + dgrp * 64 + 16 * wq + 4 * g);
#pragma unroll
            for (int n = 0; n < 4; ++n) { const f32x4 qv = (acc[n] - acc2[n]) * gm4;
                *(uint2*)(pb + 8192 + (size_t)(((n * 64 + lane) * 4 + wq) * 8)) = make_uint2(cvtpk(qv[0], qv[1]), cvtpk(qv[2], qv[3])); }
            if (unit < NU_L) {
                zero4(acc); mm64x<false, false>(acc, SL(2), SL(4), wq, lane);
                zero4(acc2); mm64x<false, false>(acc2, SL(1), SL(4), wq, lane);
#pragma unroll
                for (int n = 0; n < 4; ++n)
#pragma unroll
                    for (int q = 0; q < 4; ++q) { const bool le = (16 * wq + 4 * g + q <= 16 * n + lr); acc[n][q] = le ? acc[n][q] : 0.f; acc2[n][q] = le ? -acc2[n][q] : 0.f; }
                storeT(SL(5), acc, wq, lane); storeT(SL(7), acc2, wq, lane);
            }
        }
        __syncthreads();
        if (unit < NU_L) {
            loadT(acc, SL(4), wq, lane);
            mm64x<false, false>(acc, SL(8), SL(7), wq, lane);
            unsigned char* rb = RHAT + inst * 8192;
#pragma unroll
            for (int n = 0; n < 4; ++n) *(uint2*)(rb + (size_t)((16 * n + lr) * 64 + 16 * wq + 4 * g) * 2) = make_uint2(cvtpk(acc[n][0], acc[n][1]), cvtpk(acc[n][2], acc[n][3]));
            zero4(acc2); mm64x<false, true>(acc2, SL(5), SL(3), wq, lane); mm64x<false, false>(acc2, SL(7), SL(6), wq, lane);
            unsigned char* yb = YLOC + inst * 8192 + (size_t)((wq * 64 + lane) * 32);
            v4u o0, o1; o0.x = cvtpk(acc2[0][0], acc2[0][1]); o0.y = cvtpk(acc2[0][2], acc2[0][3]); o0.z = cvtpk(acc2[1][0], acc2[1][1]); o0.w = cvtpk(acc2[1][2], acc2[1][3]);
            o1.x = cvtpk(acc2[2][0], acc2[2][1]); o1.y = cvtpk(acc2[2][2], acc2[2][3]); o1.z = cvtpk(acc2[3][0], acc2[3][1]); o1.w = cvtpk(acc2[3][2], acc2[3][3]);
            *(v4u*)yb = o0; *(v4u*)(yb + 16) = o1;
        }
        __syncthreads();
        if (!SEAM_FILL) {
            if (cv_strip < NE * 64) { int e_, n0_, rb_; wei_strip(cv_strip, e_, n0_, rb_);
                if (cv_kb == 0 && cv_t > 0) cv_scale_q8(cv_w + (size_t)e_ * D * 2048, 2048, n0_, (float*)(F.ws + MI_CSWEI) + (size_t)e_ * 2048, rb_, lane, civ);
                cv_store_q8(cvt, cv_scr, (signed char*)(F.ws + WS_WEIN) + (size_t)e_ * 2048 * D, rb_, cv_kb, civ, lane); }
            ++cv_t;
            __syncthreads();
        }
    }
    for (; !SEAM_FILL;) { const int s_ = F.gw + (cv_t >> 4) * F.NGW, kb_ = cv_t & 15; if (s_ >= NE * 64) break;
        int e_, n0_, rb_; wei_strip(s_, e_, n0_, rb_);
        if (kb_ == 0 && cv_t > 0) cv_scale_q8(cv_w + (size_t)e_ * D * 2048, 2048, n0_, (float*)(F.ws + MI_CSWEI) + (size_t)e_ * 2048, rb_, F.lane, civ);
        cv_load(cvt, cv_w + (size_t)e_ * D * 2048, 2048, n0_, kb_, F.lane);
        cv_store_q8(cvt, cv_scr, (signed char*)(F.ws + WS_WEIN) + (size_t)e_ * 2048 * D, rb_, kb_, civ, F.lane); ++cv_t; }
#undef SL
}

__device__ __forceinline__ void phase_co2(Frame& F) {
    const int wave = F.wave;
    const int dgrp = wave >> 2, wq = wave & 3;
    LAS unsigned char* tl = F.lds + dgrp * 9 * TILE;
#define SL(k) (tl + (k) * TILE)
    const bf16* z = (const bf16*)(F.ws + WS_Z); const bf16* LO = (const bf16*)(F.ws + WS_LORA);
    const unsigned char* RHAT = F.ws + WS_TKN; const unsigned char* YLOC = F.ws + WS_UPRE; const unsigned char* H0T = F.ws + WS_H0T;
    const float* BON = (const float*)(F.ws + MI_BON);
    bf16* MG = (bf16*)(F.ws + WS_A0);
    const float* p_mu = KIN(I_MU);
    LAS float* PRM = (LAS float*)(F.lds + LDS_X_OFF + 8704);
    LAS unsigned char* VR = F.lds + 4 * TILE;
    LAS float* PX = (LAS float*)(F.lds + 5 * TILE);
    int h_prm = -1;
    for (int unit = blockIdx.x; unit < NU_L; unit += F.G) {
        int lane = F.lane; asm volatile("" : "+v"(lane));
        const int lr = lane & 15, g = lane >> 4;
        int b, h, rowbase; unit_decode(unit, b, h, rowbase);
        if (h != h_prm) {
            __syncthreads();
            if (F.tid < 96) { const int arr = F.tid >> 4, off = (F.tid & 15) * 4;
                const float* src = arr == 0 ? p_mu + V_OFF : arr == 1 ? KIN(I_LNW) : arr == 2 ? KIN(I_LNB) : KIN(I_CONVW) + (arr - 3) * D;
                *(LAS f32x4*)(PRM + arr * 64 + off) = *(const f32x4*)(src + h * 64 + off); }
            __syncthreads(); h_prm = h; }
        const int tok = 8 * wave + (lane >> 3), oct = lane & 7, ch0 = 8 * oct, c0 = h * 64 + ch0, row = rowbase + tok;
        const size_t inst = (size_t)unit * 2 + dgrp;
        const int t2 = (wq << 6) | lane;
#pragma unroll
        for (int rep = 0; rep < 2; ++rep) { const int cidx = t2 + 256 * rep, r_ = cidx >> 3, ch = cidx & 7;
            const v4u a = *(const v4u*)(RHAT + inst * 8192 + (size_t)(r_ * 64 + ch * 8) * 2), hh = *(const v4u*)(H0T + inst * 8192 + (size_t)(r_ * 64 + ch * 8) * 2);
            *(LAS v4u*)(SL(0) + r_ * 128 + ((ch ^ swz(r_)) << 4)) = a; *(LAS v4u*)(SL(1) + r_ * 128 + ((ch ^ swz(r_)) << 4)) = hh; }
        f32x4 acc[4];
        { const unsigned char* yb = YLOC + inst * 8192 + (size_t)((wq * 64 + lane) * 32); const v4u o0 = *(const v4u*)yb, o1 = *(const v4u*)(yb + 16);
          acc[0] = (f32x4){bflo(o0.x), bfhi(o0.x), bflo(o0.y), bfhi(o0.y)}; acc[1] = (f32x4){bflo(o0.z), bfhi(o0.z), bflo(o0.w), bfhi(o0.w)};
          acc[2] = (f32x4){bflo(o1.x), bfhi(o1.x), bflo(o1.y), bfhi(o1.y)}; acc[3] = (f32x4){bflo(o1.z), bfhi(o1.z), bflo(o1.w), bfhi(o1.w)}; }
        const int t = row & (T - 1);
        const bf16* zr = z + (size_t)row * NZ;
        const v4u zz = {0u, 0u, 0u, 0u};
        const v4u qv0 = *(const v4u*)(zr + V_OFF + c0);
        unsigned vmsk = (tok > 0 ? 1u : 0u) | (tok < 63 ? 2u : 0u);
        v4u qvu, qvd;
        { const int nu = nbr_row(row, 2), nd = nbr_row(row, 3); vmsk |= (nu >= 0 ? 4u : 0u) | (nd >= 0 ? 8u : 0u);
          qvu = *(const v4u*)(z + (size_t)(nu >= 0 ? nu : row) * NZ + V_OFF + c0); qvd = *(const v4u*)(z + (size_t)(nd >= 0 ? nd : row) * NZ + V_OFF + c0); }
        const v4u q_g = *(const v4u*)(LO + (size_t)row * NL + 4096 + c0);
        const v4u q_gb = *(const v4u*)(zr + CONV_OFF + c0), q_c0 = *(const v4u*)(zr + CONV_OFF + 1024 + c0), q_x0 = *(const v4u*)(zr + CONV_OFF + 2048 + c0);
        const v4u q_ga = *(const v4u*)(zr + GATE_OFF + c0), q_gr = *(const v4u*)(zr + GATE_OFF + 1024 + c0);
        v4u q_cm = zz, q_xm = zz, q_cp = zz, q_xp = zz;
        if (tok == 0 && t > 0) { q_cm = *(const v4u*)(zr - NZ + CONV_OFF + 1024 + c0); q_xm = *(const v4u*)(zr - NZ + CONV_OFF + 2048 + c0); }
        if (tok == 63 && t < T - 1) { q_cp = *(const v4u*)(zr + NZ + CONV_OFF + 1024 + c0); q_xp = *(const v4u*)(zr + NZ + CONV_OFF + 2048 + c0); }
        const float S3 = BON[(size_t)unit * 64 + tok];
        float cc[8], xx[8];
        unpack8(q_c0, cc); unpack8(q_x0, xx);
#pragma unroll
        for (int i = 0; i < 8; ++i) cc[i] *= xx[i];
        *(LAS v4u*)(VR + tok * 128 + oct * 16) = qv0;
        *(LAS f32x4*)(PX + tok * 64 + ch0) = (f32x4){cc[0], cc[1], cc[2], cc[3]}; *(LAS f32x4*)(PX + tok * 64 + ch0 + 4) = (f32x4){cc[4], cc[5], cc[6], cc[7]};
        __syncthreads();
        mm64x<false, false>(acc, SL(0), SL(1), wq, lane);
        { LAS float* Yf = (LAS float*)(tl + 2 * TILE);
#pragma unroll
          for (int n = 0; n < 4; ++n)
#pragma unroll
              for (int q = 0; q < 4; ++q) { const int tau = 16 * wq + 4 * g + q; Yf[tau * 64 + ((16 * n + lr) ^ (4 * (tau & 15)))] = acc[n][q]; } }
        __syncthreads();
        { const LAS float* Y0 = (const LAS float*)(F.lds + 2 * TILE); const LAS float* Y1 = (const LAS float*)(F.lds + 11 * TILE);
          float y[8];
          { const int s0 = 4 * (tok & 15), s1 = 4 * ((63 - tok) & 15);
            const f32x4 a0 = *(const LAS f32x4*)(Y0 + tok * 64 + (ch0 ^ s0)), a1 = *(const LAS f32x4*)(Y0 + tok * 64 + ((ch0 + 4) ^ s0));
            const f32x4 b0 = *(const LAS f32x4*)(Y1 + (63 - tok) * 64 + (ch0 ^ s1)), b1 = *(const LAS f32x4*)(Y1 + (63 - tok) * 64 + ((ch0 + 4) ^ s1));
            y[0] = a0.x + b0.x; y[1] = a0.y + b0.y; y[2] = a0.z + b0.z; y[3] = a0.w + b0.w; y[4] = a1.x + b1.x; y[5] = a1.y + b1.y; y[6] = a1.z + b1.z; y[7] = a1.w + b1.w; }
          float s1 = 0.f, s2 = 0.f;
#pragma unroll
          for (int i = 0; i < 8; ++i) { s1 += y[i]; s2 += y[i] * y[i]; }
          s1 += __shfl_xor(s1, 1); s2 += __shfl_xor(s2, 1); s1 += __shfl_xor(s1, 2); s2 += __shfl_xor(s2, 2); s1 += __shfl_xor(s1, 4); s2 += __shfl_xor(s2, 4);
          const float mean = s1 * (1.0f / 64.0f), var = fmaxf(s2 * (1.0f / 64.0f) - mean * mean, 0.f), rstd = __builtin_amdgcn_rsqf(var + 64e-5f);
          float vs[8];
          { v4u q[5]; q[0] = qv0; q[1] = *(const LAS v4u*)(VR + (tok > 0 ? tok - 1 : tok) * 128 + oct * 16); q[2] = *(const LAS v4u*)(VR + (tok < 63 ? tok + 1 : tok) * 128 + oct * 16); q[3] = qvu; q[4] = qvd;
            float m_[8]; ld8l(PRM + ch0, m_); shift8m(q, m_, vs, vmsk); }
          float lnw[8], lnb[8], cw0[8], cw1[8], cw2[8];
          ld8l(PRM + 64 + ch0, lnw); ld8l(PRM + 128 + ch0, lnb); ld8l(PRM + 192 + ch0, cw0); ld8l(PRM + 256 + ch0, cw1); ld8l(PRM + 320 + ch0, cw2);
          float gg[8], gb[8], pm[8], pp[8], ga[8], gr[8];
          unpack8(q_g, gg); unpack8(q_gb, gb); unpack8(q_ga, ga); unpack8(q_gr, gr);
          if (tok > 0) ld8l(PX + (tok - 1) * 64 + ch0, pm); else { float c_[8], x_[8]; unpack8(q_cm, c_); unpack8(q_xm, x_);
#pragma unroll
              for (int i = 0; i < 8; ++i) pm[i] = c_[i] * x_[i]; }
          if (tok < 63) ld8l(PX + (tok + 1) * 64 + ch0, pp); else { float c_[8], x_[8]; unpack8(q_cp, c_); unpack8(q_xp, x_);
#pragma unroll
              for (int i = 0; i < 8; ++i) pp[i] = c_[i] * x_[i]; }
          float o[8];
#pragma unroll
          for (int i = 0; i < 8; ++i) {
              const float yn = (y[i] - mean) * rstd * lnw[i] + lnb[i];
              const float yr = (yn + S3 * vs[i]) * gg[i];
              const float yc = gb[i] * (cw0[i] * pm[i] + cw1[i] * cc[i] + cw2[i] * pp[i]);
              o[i] = fsig(ga[i]) * yr + fsig(gr[i]) * yc;
          }
          v4u ov; ov.x = cvtpk(o[0], o[1]); ov.y = cvtpk(o[2], o[3]); ov.z = cvtpk(o[4], o[5]); ov.w = cvtpk(o[6], o[7]);
          *(v4u*)(MG + (size_t)row * D + c0) = ov;
        }
        __syncthreads();
    }
#undef SL
}

struct SSIn { v4u a[8]; v4u q[2]; };
__device__ __forceinline__ size_t ss_pq(int step, int b, int h, int d) { return (size_t)(((b * 16 + h) * 2 + d) * (4 + T / 64) + step); }
__device__ __forceinline__ size_t ss_inst(int step, int b, int h, int d) {
    int unit;
    if (step < 4) { const int cb = d ? 3 - step : step; unit = NU_L + (b * 4 + cb) * 16 + h; }
    else { const int blk = d ? 127 - (step - 4) : step - 4; unit = (b * 128 + blk) * 16 + h; }
    return (size_t)unit * 2 + d;
}
__device__ __forceinline__ void ss_load(SSIn& I, const unsigned char* PQ, size_t inst, int wv, int lane) {
    const unsigned char* pb = PQ + inst * 16384;
#pragma unroll
    for (int f = 0; f < 8; ++f) I.a[f] = *(const v4u*)(pb + (size_t)((f * 64 + lane) * 16));
    I.q[0] = *(const v4u*)(pb + 8192 + (size_t)((wv * 64 + lane) * 32)); I.q[1] = *(const v4u*)(pb + 8192 + (size_t)((wv * 64 + lane) * 32 + 16));
}
__device__ __forceinline__ void ss_step(f32x4 (&H)[4], const SSIn& cur, unsigned char* H0T, size_t inst, bool store_h0, int wv, int lr, int g) {
    const unsigned p00 = cvtpk(H[0][0], H[0][1]), p01 = cvtpk(H[0][2], H[0][3]), p10 = cvtpk(H[1][0], H[1][1]), p11 = cvtpk(H[1][2], H[1][3]);
    const unsigned p20 = cvtpk(H[2][0], H[2][1]), p21 = cvtpk(H[2][2], H[2][3]), p30 = cvtpk(H[3][0], H[3][1]), p31 = cvtpk(H[3][2], H[3][3]);
    if (store_h0) { unsigned char* hb = H0T + inst * 8192 + (size_t)((16 * wv + lr) * 64 + 4 * g) * 2;
        *(uint2*)(hb) = make_uint2(p00, p01); *(uint2*)(hb + 32) = make_uint2(p10, p11); *(uint2*)(hb + 64) = make_uint2(p20, p21); *(uint2*)(hb + 96) = make_uint2(p30, p31); }
    const bf16x8 b0 = __builtin_bit_cast(bf16x8, ((v4u){p00, p01, p10, p11})), b1 = __builtin_bit_cast(bf16x8, ((v4u){p20, p21, p30, p31}));
    H[0] = (f32x4){bflo(cur.q[0].x), bfhi(cur.q[0].x), bflo(cur.q[0].y), bfhi(cur.q[0].y)}; H[1] = (f32x4){bflo(cur.q[0].z), bfhi(cur.q[0].z), bflo(cur.q[0].w), bfhi(cur.q[0].w)};
    H[2] = (f32x4){bflo(cur.q[1].x), bfhi(cur.q[1].x), bflo(cur.q[1].y), bfhi(cur.q[1].y)}; H[3] = (f32x4){bflo(cur.q[1].z), bfhi(cur.q[1].z), bflo(cur.q[1].w), bfhi(cur.q[1].w)};
#pragma unroll
    for (int m = 0; m < 4; ++m) { H[m] = CK_MFMA(__builtin_bit_cast(bf16x8, cur.a[2 * m]), b0, H[m]); H[m] = CK_MFMA(__builtin_bit_cast(bf16x8, cur.a[2 * m + 1]), b1, H[m]); }
}
__device__ __forceinline__ void phase_ss(Frame& F) {
    const unsigned char* PQ = F.ws + WS_PQ; unsigned char* H0T = F.ws + WS_H0T;
    const int lane = F.lane, lr = lane & 15, g = lane >> 4;
    for (int task = F.vb; task < 256; task += F.G) {
        const int chain = (task & 7) + 8 * (task >> 5), wv = (task >> 3) & 3, b = chain >> 5, h = (chain >> 1) & 15, d = chain & 1;
        f32x4 H[4]; zero4(H);
        constexpr int NS = 4 + T / 64;
        static_assert(NS % 4 == 0, "unrolled by four");
        SSIn b0, b1, b2, b3;
        ss_load(b0, PQ, ss_pq(0, b, h, d), wv, lane); ss_load(b1, PQ, ss_pq(1, b, h, d), wv, lane); ss_load(b2, PQ, ss_pq(2, b, h, d), wv, lane); ss_load(b3, PQ, ss_pq(3, b, h, d), wv, lane);
        for (int step = 0; step < NS; step += 4) {
            const int n0 = step + 4 < NS ? step + 4 : NS - 1, n1 = step + 5 < NS ? step + 5 : NS - 1, n2 = step + 6 < NS ? step + 6 : NS - 1, n3 = step + 7 < NS ? step + 7 : NS - 1;
            ss_step(H, b0, H0T, ss_inst(step, b, h, d), step >= 4, wv, lr, g);     ss_load(b0, PQ, ss_pq(n0, b, h, d), wv, lane);
            ss_step(H, b1, H0T, ss_inst(step + 1, b, h, d), step >= 4, wv, lr, g); ss_load(b1, PQ, ss_pq(n1, b, h, d), wv, lane);
            ss_step(H, b2, H0T, ss_inst(step + 2, b, h, d), step >= 4, wv, lr, g); ss_load(b2, PQ, ss_pq(n2, b, h, d), wv, lane);
            ss_step(H, b3, H0T, ss_inst(step + 3, b, h, d), step >= 4, wv, lr, g); ss_load(b3, PQ, ss_pq(n3, b, h, d), wv, lane);
        }
    }
}

struct LoraARaw { v4u q[5]; f32x4 m0, m1; };
__device__ __forceinline__ int lora_acol(int gi, int oct) { return (gi < 4 ? DECAY_OFF + 64 * gi : GLORA_OFF + 64 * (gi - 4)) + 8 * oct; }
__device__ __forceinline__ unsigned lora_aload(LoraARaw& R, const bf16* z, const float* p_mu, int r0, int gi, int wave, int lane) {
    const int tok = 8 * wave + (lane >> 3), oct = lane & 7, row = r0 + tok, col = lora_acol(gi, oct);
    R.q[0] = *(const v4u*)(z + (size_t)row * NZ + col);
    unsigned msk = 0u;
#pragma unroll
    for (int j = 0; j < 4; ++j) { const int nr = nbr_row(row, j); msk |= (nr >= 0 ? 1u : 0u) << j; R.q[1 + j] = *(const v4u*)(z + (size_t)(nr >= 0 ? nr : row) * NZ + col); }
    R.m0 = *(const f32x4*)(p_mu + col); R.m1 = *(const f32x4*)(p_mu + col + 4);
    return msk;
}
__device__ __forceinline__ void lora_astore(const LoraARaw& R, unsigned msk, LAS unsigned char* lds, int gi, int wave, int lane) {
    const int tok = 8 * wave + (lane >> 3), oct = lane & 7;
    const v4u zz = {0u, 0u, 0u, 0u};
    const v4u s = R.q[0], n0 = (msk & 1u) ? R.q[1] : zz, n1 = (msk & 2u) ? R.q[2] : zz, n2 = (msk & 4u) ? R.q[3] : zz, n3 = (msk & 8u) ? R.q[4] : zz;
    float v[8];
    v[0] = bflo(s.x) + R.m0.x * (bflo(n0.x) - bflo(s.x)); v[1] = bfhi(s.x) + R.m0.y * (bfhi(n1.x) - bfhi(s.x));
    v[2] = bflo(s.y) + R.m0.z * (bflo(n2.y) - bflo(s.y)); v[3] = bfhi(s.y) + R.m0.w * (bfhi(n3.y) - bfhi(s.y));
    v[4] = bflo(s.z) + R.m1.x * (bflo(n0.z) - bflo(s.z)); v[5] = bfhi(s.z) + R.m1.y * (bfhi(n1.z) - bfhi(s.z));
    v[6] = bflo(s.w) + R.m1.z * (bflo(n2.w) - bflo(s.w)); v[7] = bfhi(s.w) + R.m1.w * (bfhi(n3.w) - bfhi(s.w));
#pragma unroll
    for (int i = 0; i < 8; ++i) v[i] = gi < 2 ? 1.0f - 2.0f * __builtin_amdgcn_rcpf(1.0f + __expf(2.0f * v[i])) : (gi < 4 ? v[i] : fsig(v[i]));
    putN(lds + gi * TILE, tok, oct, v);
}
__device__ __forceinline__ void lora_atile(const bf16* z, const float* p_mu, LAS unsigned char* lds, int r0, int gi, int wave, int lane) {
    LoraARaw R; const unsigned msk = lora_aload(R, z, p_mu, r0, gi, wave, lane); lora_astore(R, msk, lds, gi, wave, lane);
}
template <int KS> struct LoraB { bf16x8 w[KS][4]; };
template <int KS>
__device__ __forceinline__ void lora_bload(LoraB<KS>& B, const bf16* WL, int q, int lr, int g) {
    const int blkid = q >> 4, h = q & 15;
    const bf16* wrow = WL + (size_t)(blkid * 1024 + h * 64 + 8 * (lr >> 2) + (lr & 3)) * KL + blkid * 64 + 8 * g;
#pragma unroll
    for (int s = 0; s < KS; ++s)
#pragma unroll
        for (int n = 0; n < 4; ++n) B.w[s][n] = *(const bf16x8*)(wrow + (size_t)(32 * (n >> 1) + 4 * (n & 1)) * KL + 32 * s);
}
template <int KS>
__device__ __forceinline__ void lora_product(const LoraB<KS>& B, const LAS unsigned char* At, bf16* LO, int r0, int q, int lr, int g, const LAS float* LBI) {
    const int blkid = q >> 4, h = q & 15;
    f32x4 acc[4][4];
#pragma unroll
    for (int n = 0; n < 4; ++n)
#pragma unroll
        for (int m = 0; m < 4; ++m) acc[n][m] = (f32x4){0.f, 0.f, 0.f, 0.f};
#pragma unroll
    for (int s = 0; s < KS; ++s) {
        bf16x8 af[4];
#pragma unroll
        for (int m = 0; m < 4; ++m) af[m] = ldfrag(At + (s >> 1) * TILE, 16 * m + lr, 4 * (s & 1) + g);
#pragma unroll
        for (int n = 0; n < 4; ++n)
#pragma unroll
            for (int m = 0; m < 4; ++m) acc[n][m] = CK_MFMA(B.w[s][n], af[m], acc[n][m]);
    }
    bf16* ob = LO + (size_t)(r0 + lr) * NL + blkid * 1024 + h * 64 + 8 * g;
#pragma unroll
    for (int m = 0; m < 4; ++m)
#pragma unroll
        for (int p = 0; p < 2; ++p) {
            f32x4 v0 = acc[2 * p][m], v1 = acc[2 * p + 1][m];
            if (KS == 2) {
                const LAS float* bp = LBI + blkid * 1024 + h * 64 + 8 * g + 32 * p; const f32x4 b0 = *(const LAS f32x4*)bp, b1 = *(const LAS f32x4*)(bp + 4); const float sc = blkid < 2 ? -0.6065306597126334f : 1.0f;
#pragma unroll
                for (int e = 0; e < 4; ++e) { v0[e] = sc * fsig(v0[e] + b0[e]); v1[e] = sc * fsig(v1[e] + b1[e]); }
            }
            v4u o; o.x = cvtpk(v0[0], v0[1]); o.y = cvtpk(v0[2], v0[3]); o.z = cvtpk(v1[0], v1[1]); o.w = cvtpk(v1[2], v1[3]);
            *(v4u*)(ob + (size_t)(16 * m) * NL + 32 * p) = o; }
}
__device__ __forceinline__ void phase_lora(Frame& F) {
    const bf16* z = (const bf16*)(F.ws + WS_Z); bf16* LO = (bf16*)(F.ws + WS_LORA); const bf16* WL = (const bf16*)(F.ws + WS_WLORA);
    const float* p_mu = KIN(I_MU); const float* p_w0 = KIN(I_W0); const float* p_a0 = KIN(I_A0);
    LAS float* LBI = (LAS float*)(F.lds + 15 * TILE);
    { const int i4 = F.tid * 4; *(LAS f32x4*)(LBI + i4) = *(const f32x4*)(p_w0 + i4); *(LAS f32x4*)(LBI + 2048 + i4) = *(const f32x4*)(p_a0 + i4); }
    __syncthreads();
    for (int unit = blockIdx.x; unit < ML / 64; unit += F.G) {
        int lane = F.lane; asm volatile("" : "+v"(lane));
        const int lr = lane & 15, g = lane >> 4, r0 = unit * 64;
#pragma unroll
        for (int gb = 0; gb < 6; gb += 3) {
            LoraARaw R0, R1, R2;
            const unsigned k0 = lora_aload(R0, z, p_mu, r0, gb, F.wave, lane), k1 = lora_aload(R1, z, p_mu, r0, gb + 1, F.wave, lane), k2 = lora_aload(R2, z, p_mu, r0, gb + 2, F.wave, lane);
            __builtin_amdgcn_sched_barrier(0);
            lora_astore(R0, k0, F.lds, gb, F.wave, lane); lora_astore(R1, k1, F.lds, gb + 1, F.wave, lane); lora_astore(R2, k2, F.lds, gb + 2, F.wave, lane);
        }
        __syncthreads();
        const float* weo = KIN(I_WEO); bf16* WEO = (bf16*)(F.ws + WS_WEOUT);
        LAS float* fscr = (LAS float*)(F.lds + 6 * TILE + F.wave * 8704);
        const int ft0 = (unit * NWAVES + F.wave) * 10;
        CvTile ft;
#define LORA_FILL_LOAD(p) do { if (SEAM_FILL) break; const int id0_ = ft0 + (p), id_ = id0_ < NE * 512 ? id0_ : 0; const int e_ = id_ >> 9, q_ = id_ & 511; cv_load(ft, weo + (size_t)e_ * D * D, D, 32 * (q_ & 31), q_ >> 5, lane); } while (0)
#define LORA_FILL_STORE(p) do { const int id_ = ft0 + (p); if (!SEAM_FILL && id_ < NE * 512) { const int e_ = id_ >> 9, q_ = id_ & 511; cv_to_lds(ft, fscr, lane); cv_store_bf16(fscr, WEO + (size_t)e_ * D * D, D, 32 * (q_ & 31), 64 * (q_ >> 5), lane); } } while (0)
        LoraB<2> b0, b1;
        lora_bload<2>(b0, WL, F.wave, lr, g);
#pragma unroll
        for (int i = 0; i < 8; i += 2) {
            lora_bload<2>(b1, WL, F.wave + 8 * (i + 1), lr, g); LORA_FILL_LOAD(i);
            lora_product<2>(b0, F.lds + ((F.wave + 8 * i) >> 4) * TILE, LO, r0, F.wave + 8 * i, lr, g, LBI);
            LORA_FILL_STORE(i);
            if (i + 2 < 8) lora_bload<2>(b0, WL, F.wave + 8 * (i + 2), lr, g);
            LORA_FILL_LOAD(i + 1);
            lora_product<2>(b1, F.lds + ((F.wave + 8 * (i + 1)) >> 4) * TILE, LO, r0, F.wave + 8 * (i + 1), lr, g, LBI);
            LORA_FILL_STORE(i + 1);
        }
        { LoraB<4> c0; lora_bload<4>(c0, WL, 64 + F.wave, lr, g); LORA_FILL_LOAD(8); lora_product<4>(c0, F.lds + 4 * TILE, LO, r0, 64 + F.wave, lr, g, LBI); LORA_FILL_STORE(8);
          lora_bload<4>(c0, WL, 72 + F.wave, lr, g); LORA_FILL_LOAD(9); lora_product<4>(c0, F.lds + 4 * TILE, LO, r0, 72 + F.wave, lr, g, LBI); LORA_FILL_STORE(9); }
#undef LORA_FILL_LOAD
#undef LORA_FILL_STORE
        __syncthreads();
    }
    for (int t = blockIdx.x; t < (MC / 64) * 32; t += F.G) {
        int lane = F.lane; asm volatile("" : "+v"(lane));
        const int lr = lane & 15, g = lane >> 4, r0 = ML + (t >> 5) * 64, q0 = 2 * (t & 31), gi = q0 >> 4;
        lora_atile(z, p_mu, F.lds, r0, gi, F.wave, lane);
        __syncthreads();
        if (F.wave < 2) { LoraB<2> b0; lora_bload<2>(b0, WL, q0 + F.wave, lr, g); lora_product<2>(b0, F.lds + gi * TILE, LO, r0, q0 + F.wave, lr, g, LBI); }
        __syncthreads();
    }
}

__device__ __forceinline__ void ss2_load(v4u& ra, v4u& rq, const unsigned char* PQ, size_t inst, int wv, int wave, int lane) {
    const unsigned char* pb = PQ + inst * 16384;
    ra = *(const v4u*)(pb + (size_t)((wave * 64 + lane) * 16));
    if (wave < 2) rq = *(const v4u*)(pb + 8192 + (size_t)((wv * 64 + lane) * 32 + 16 * wave));
}
__device__ __forceinline__ void phase_ss2(Frame& F) {
    const unsigned char* PQ = F.ws + WS_PQ; unsigned char* H0T = F.ws + WS_H0T;
    const int lane = F.lane, wave = F.wave, lr = lane & 15, g = lane >> 4;
    LAS unsigned char* ring = F.lds;
    constexpr int SLOT = 10240, NS = 4 + T / 64, DEPTH = 12;
    static_assert(NS % DEPTH == 0, "unrolled by DEPTH");
    for (int task = (int)blockIdx.x; task < 256; task += F.G) {
        const int chain = task >> 2, wv = task & 3, b = chain >> 5, h = (chain >> 1) & 15, d = chain & 1;
        f32x4 H[4]; zero4(H);
        v4u ra[DEPTH], rq[DEPTH];
#pragma unroll
        for (int k = 0; k < DEPTH; ++k) { rq[k] = (v4u){0u, 0u, 0u, 0u}; ss2_load(ra[k], rq[k], PQ, ss_pq(k, b, h, d), wv, wave, lane); }
        for (int step = 0; step < NS; step += DEPTH) {
#pragma unroll
            for (int k = 0; k < DEPTH; ++k) {
                const int st = step + k; LAS unsigned char* sl = ring + (st & 1) * SLOT;
                *(LAS v4u*)(sl + (wave * 64 + lane) * 16) = ra[k]; if (wave < 2) *(LAS v4u*)(sl + 8192 + (wave * 64 + lane) * 16) = rq[k];
                { const int nx = st + DEPTH < NS ? st + DEPTH : NS - 1; ss2_load(ra[k], rq[k], PQ, ss_pq(nx, b, h, d), wv, wave, lane); }
                __syncthreads();
                if (wave == 0) { SSIn cur;
#pragma unroll
                    for (int f = 0; f < 8; ++f) cur.a[f] = *(const LAS v4u*)(sl + (f * 64 + lane) * 16);
                    cur.q[0] = *(const LAS v4u*)(sl + 8192 + lane * 16); cur.q[1] = *(const LAS v4u*)(sl + 8192 + (64 + lane) * 16);
                    ss_step(H, cur, H0T, ss_inst(st, b, h, d), st >= 4, wv, lr, g); }
            }
        }
        __syncthreads();
    }
}

__device__ __forceinline__ void ss3_load(v4u& a0, v4u& a1, v2u& q, const unsigned char* PQ, size_t pq, int wv, int m, int lane) {
    const unsigned char* pb = PQ + pq * 16384;
    a0 = *(const v4u*)(pb + (size_t)(((2 * m) * 64 + lane) * 16)); a1 = *(const v4u*)(pb + (size_t)(((2 * m + 1) * 64 + lane) * 16));
    q = *(const v2u*)(pb + 8192 + (size_t)((wv * 64 + lane) * 32 + 8 * m));
}
__device__ __forceinline__ void phase_ss3(Frame& F) {
    const unsigned char* PQ = F.ws + WS_PQ; unsigned char* H0T = F.ws + WS_H0T;
    const int lane = F.lane, wave = F.wave, lr = lane & 15, g = lane >> 4, m = wave & 3;
    LAS unsigned char* xch = F.lds;
    constexpr int NS = 4 + T / 64, DEPTH = 12;
    static_assert(NS % DEPTH == 0, "unrolled by DEPTH");
    for (int task = (int)blockIdx.x; task < 256; task += F.G) {
        const int chain = task >> 2, wv = task & 3, b = chain >> 5, h = (chain >> 1) & 15, d = chain & 1;
        f32x4 H = {0.f, 0.f, 0.f, 0.f};
        v4u a0[DEPTH], a1[DEPTH]; v2u qv[DEPTH];
        if (wave < 4) {
#pragma unroll
            for (int k = 0; k < DEPTH; ++k) ss3_load(a0[k], a1[k], qv[k], PQ, ss_pq(k, b, h, d), wv, m, lane);
        }
        for (int step = 0; step < NS; step += DEPTH) {
#pragma unroll
            for (int k = 0; k < DEPTH; ++k) {
                const int st = step + k; LAS unsigned char* xs = xch + (st & 1) * 2048;
                if (wave < 4) {
                    const v2u pk = {cvtpk(H[0], H[1]), cvtpk(H[2], H[3])};
                    *(LAS v2u*)(xs + lane * 32 + 8 * m) = pk;
                    if (st >= 4) *(v2u*)(H0T + ss_inst(st, b, h, d) * 8192 + (size_t)((16 * wv + lr) * 64 + 16 * m + 4 * g) * 2) = pk;
                }
                __syncthreads();
                if (wave < 4) {
                    const v4u b0 = *(const LAS v4u*)(xs + lane * 32), b1 = *(const LAS v4u*)(xs + lane * 32 + 16);
                    f32x4 Hn = {bflo(qv[k].x), bfhi(qv[k].x), bflo(qv[k].y), bfhi(qv[k].y)};
                    Hn = CK_MFMA(__builtin_bit_cast(bf16x8, a0[k]), __builtin_bit_cast(bf16x8, b0), Hn);
                    Hn = CK_MFMA(__builtin_bit_cast(bf16x8, a1[k]), __builtin_bit_cast(bf16x8, b1), Hn);
                    H = Hn;
                    const int nx = st + DEPTH < NS ? st + DEPTH : NS - 1;
                    ss3_load(a0[k], a1[k], qv[k], PQ, ss_pq(nx, b, h, d), wv, m, lane);
                }
            }
        }
        __syncthreads();
    }
}
}
template <int PART>
__device__ __forceinline__ void phase_moe_weights(Frame& F) {
    LAS float* scr = (LAS float*)(F.lds + RING_OFF + F.wave * 16384);
    bf16* WEO = (bf16*)(F.ws + WS_WEOUT);
    constexpr int IT_IN = (D / 64) * (2048 / 32), IT_OUT = (D / 64) * (D / 32);
    if (PART == 0) {
        const float* wei = KIN(I_WEI);
        const int nstat = F.G * 7;
        int it = (int)blockIdx.x * 7 + F.wave - 1;
        while (it < NE * 128) {
            const int half = it & 1, r = it >> 1, e = r >> 6, n0 = 32 * (r & 63);
            const int c = n0 & 1023, rowbase = (c >> 7) * 256 + (n0 >= 1024 ? 128 : 0) + (c & 127);
            q8_item(wei + (size_t)e * D * 2048, 2048, n0, (signed char*)(F.ws + WS_WEIN) + (size_t)e * 2048 * D, (float*)(F.ws + MI_CSWEI) + (size_t)e * 2048, rowbase, scr, F.lane, 8 * half, 8 * half + 8);
            int nx = 0; if (F.lane == 0) nx = (int)__hip_atomic_fetch_add(F.ctl + CW_Q6, 1u, __ATOMIC_RELAXED, __HIP_MEMORY_SCOPE_AGENT);
            it = nstat + __builtin_amdgcn_readfirstlane(nx);
        }
    } else {
        const float* weo = KIN(I_WEO);
        for (int r = (int)blockIdx.x * 7 + F.wave - 1; r < NE * IT_OUT; r += F.G * 7) { const int e = r / IT_OUT, q = r % IT_OUT, kb = q / 32, n0 = 32 * (q % 32);
            transpose_item(weo + (size_t)e * D * D, D, 64 * kb, n0, WEO + (size_t)e * D * D, D, n0, scr, F.lane); }
    }
}

__device__ __forceinline__ void phase_x1_h2(Frame& F) {
    LAS float* LG = (LAS float*)(F.lds);
    LAS float* LA = LG + 2 * D; LAS float* LB = LA + 2 * D;
    const float* modp = (const float*)(F.ws + WS_MODP);
    for (int i = F.tid; i < 2 * D; i += NWAVES * 64) { const int v = i / D, j = i % D;
        LG[i] = mod_val(modp, KIN(I_BADA), v, 2048 + j) * KIN(I_NQM)[j];
        LA[i] = KIN(I_NPF)[j] * (1.0f + mod_val(modp, KIN(I_BADA), v, 4096 + j)); LB[i] = mod_val(modp, KIN(I_BADA), v, 3072 + j); }
    __syncthreads();
    const float* mix = (const float*)(F.ws + WS_MIX); float* x1 = (float*)(F.ws + WS_X1); bf16* h2 = (bf16*)(F.ws + WS_H2);
    for (int row = F.gw; row < ML; row += F.NGW) {
        const int vec = row >> 13;
        f32x4 m[4], x[4]; float s = 0.f;
#pragma unroll
        for (int j = 0; j < 4; ++j) { m[j] = *(const f32x4*)(mix + (size_t)row * D + 4 * F.lane + 256 * j); x[j] = *(const f32x4*)(KIN(I_X) + (size_t)row * D + 4 * F.lane + 256 * j);
            s += (m[j].x * m[j].x + m[j].y * m[j].y) + (m[j].z * m[j].z + m[j].w * m[j].w); }
        const float rstd = 1.0f / sqrtf(wave_sum(s) * (1.0f / D) + 1e-6f);
        float s2 = 0.f;
#pragma unroll
        for (int j = 0; j < 4; ++j) { const int c = 4 * F.lane + 256 * j; const f32x4 g = *(const LAS f32x4*)(LG + vec * D + c);
            x[j] = x[j] + g * (m[j] * rstd); *(f32x4*)(x1 + (size_t)row * D + c) = x[j];
            s2 += (x[j].x * x[j].x + x[j].y * x[j].y) + (x[j].z * x[j].z + x[j].w * x[j].w); }
        const float rstd2 = 1.0f / sqrtf(wave_sum(s2) * (1.0f / D) + 1e-6f);
        unsigned long long* o8 = (unsigned long long*)(h2 + (size_t)row * D) + F.lane;
        f32x4 hq[4]; float mx = 0.f;
#pragma unroll
        for (int j = 0; j < 4; ++j) { const int c = 4 * F.lane + 256 * j; const f32x4 a = *(const LAS f32x4*)(LA + vec * D + c), b = *(const LAS f32x4*)(LB + vec * D + c);
            const f32x4 h = x[j] * rstd2 * a + b; hq[j] = h;
            mx = fmaxf(mx, fmaxf(fmaxf(fabsf(h.x), fabsf(h.y)), fmaxf(fabsf(h.z), fabsf(h.w))));
            o8[64 * j] = (unsigned long long)pk2(h.x, h.y) | ((unsigned long long)pk2(h.z, h.w) << 32); }
        mx = wave_max(mx);
        const float iv = mx > 0.f ? 127.0f / mx : 0.f;
        if (F.lane == 0) ((float*)(F.ws + MI_RSH2))[row] = mx * (1.0f / 127.0f);
        unsigned* o4 = (unsigned*)(F.ws + WS_H2Q + (size_t)row * D) + F.lane;
#pragma unroll
        for (int j = 0; j < 4; ++j) o4[64 * j] = pack_q4(hq[j].x * iv, hq[j].y * iv, hq[j].z * iv, hq[j].w * iv);
    }
}

__device__ __forceinline__ void phase_route(Frame& F) {
    const float* LG = (const float*)(F.ws + WS_LOGIT);
    int* selE = (int*)(F.ws + MI_SELE); int* selP = (int*)(F.ws + MI_SELP); float* gate = (float*)(F.ws + MI_GATE);
    for (int task = F.gw; task < ML / 64; task += F.NGW) {
        const int row = task * 64 + F.lane;
        float v[NE];
#pragma unroll
        for (int q = 0; q < NE / 4; ++q) { const f32x4 x = *(const f32x4*)(LG + (size_t)row * 256 + 4 * q); const f32x4 bb = *(const f32x4*)(KIN(I_BR) + 4 * q);
            v[4 * q] = x.x + bb.x; v[4 * q + 1] = x.y + bb.y; v[4 * q + 2] = x.z + bb.z; v[4 * q + 3] = x.w + bb.w; }
        int se[4]; float sv[4];
#pragma unroll
        for (int k = 0; k < 4; ++k) { float best = -3.0e38f; int bi = 0;
#pragma unroll
            for (int e = 0; e < NE; ++e) if (v[e] > best) { best = v[e]; bi = e; }
#pragma unroll
            for (int e = 0; e < NE; ++e) v[e] = (e == bi) ? -3.0e38f : v[e];
            se[k] = bi; sv[k] = best; }
        float ex[4], sum = 0.f;
#pragma unroll
        for (int k = 0; k < 4; ++k) { ex[k] = __expf(sv[k] - sv[0]); sum += ex[k]; }
        const float inv = 1.0f / sum;
        int sp[4] = {0, 0, 0, 0};
        int myn = 0;
#pragma unroll
        for (int e = 0; e < NE; ++e) { const bool p = (se[0] == e) | (se[1] == e) | (se[2] == e) | (se[3] == e); const int n = __popcll(__ballot(p)); myn = (F.lane == e) ? n : myn; }
        int mybase = 0;
        if (F.lane < NE && myn > 0) mybase = (int)__hip_atomic_fetch_add(F.ctl + CW_CNT + 64 * F.lane, (unsigned)myn, __ATOMIC_RELAXED, __HIP_MEMORY_SCOPE_AGENT);
#pragma unroll
        for (int e = 0; e < NE; ++e) {
            const bool p = (se[0] == e) | (se[1] == e) | (se[2] == e) | (se[3] == e);
            const unsigned long long mask = __ballot(p);
            const int base = __shfl(mybase, e);
            const int pos = base + __popcll(mask & ((1ull << F.lane) - 1ull));
#pragma unroll
            for (int k = 0; k < 4; ++k) if (se[k] == e) sp[k] = pos;
        }
        *(int4*)(selE + (size_t)row * 4) = make_int4(se[0], se[1], se[2], se[3]);
        *(int4*)(selP + (size_t)row * 4) = make_int4(sp[0], sp[1], sp[2], sp[3]);
        *(f32x4*)(gate + (size_t)row * 4) = (f32x4){ex[0] * inv, ex[1] * inv, ex[2] * inv, ex[3] * inv};
    }
}

__device__ __forceinline__ void phase_x1h2_route(Frame& F) {
    constexpr int HS_STRIDE = 2064;
    LAS unsigned char* Hs = F.lds;
    LAS float* LG = (LAS float*)(F.lds + 132096);
    LAS float* LA = LG + D; LAS float* LB = LA + D;
    LAS float* LGT = (LAS float*)(F.lds + LDS_X_OFF);
    const float* modp = (const float*)(F.ws + WS_MODP);
    const bf16* mixb = (const bf16*)(F.ws + WS_MIX); bf16* x1b = (bf16*)(F.ws + WS_X1);
    const float* xin = KIN(I_X); const float* b_ada = KIN(I_BADA); const float* nqm = KIN(I_NQM); const float* npf = KIN(I_NPF);
    const bf16* WR = (const bf16*)(F.ws + WS_WROUT);
    int* selE = (int*)(F.ws + MI_SELE); int* selP = (int*)(F.ws + MI_SELP); float* gate = (float*)(F.ws + MI_GATE);
    for (int rb = blockIdx.x; rb < ML / 64; rb += F.G) {
        const int vec = (rb * 64) >> 13;
        __syncthreads();
        for (int i = F.tid; i < D; i += NWAVES * 64) {
            const int jj[3] = {2048 + i, 4096 + i, 3072 + i}; float mv[3]; mod_vals<3>(modp, b_ada, vec, jj, mv);
            LG[i] = mv[0] * nqm[i]; LA[i] = npf[i] * (1.0f + mv[1]); LB[i] = mv[2]; }
        __syncthreads();
#pragma unroll
        for (int r4 = 0; r4 < 8; r4 += 4) {
            v2u mq[4][4]; f32x4 xq[4][4];
#pragma unroll
            for (int k = 0; k < 4; ++k) { const int row = rb * 64 + F.wave * 8 + r4 + k;
#pragma unroll
                for (int j = 0; j < 4; ++j) { mq[k][j] = *(const v2u*)(mixb + (size_t)row * D + 4 * F.lane + 256 * j); xq[k][j] = *(const f32x4*)(xin + (size_t)row * D + 4 * F.lane + 256 * j); } }
            __builtin_amdgcn_sched_barrier(0);
#pragma unroll
            for (int k = 0; k < 4; ++k) {
                const int lrow = F.wave * 8 + r4 + k, row = rb * 64 + lrow;
                f32x4 m[4], x[4]; float s = 0.f;
#pragma unroll
                for (int j = 0; j < 4; ++j) { m[j] = (f32x4){bflo(mq[k][j].x), bfhi(mq[k][j].x), bflo(mq[k][j].y), bfhi(mq[k][j].y)}; x[j] = xq[k][j];
                    s += (m[j].x * m[j].x + m[j].y * m[j].y) + (m[j].z * m[j].z + m[j].w * m[j].w); }
                const float rstd = 1.0f / sqrtf(wave_sum(s) * (1.0f / D) + 1e-6f);
                float s2 = 0.f;
#pragma unroll
                for (int j = 0; j < 4; ++j) { const int c = 4 * F.lane + 256 * j; const f32x4 g = *(const LAS f32x4*)(LG + c);
                    x[j] = x[j] + g * (m[j] * rstd); *(v2u*)(x1b + (size_t)row * D + c) = (v2u){pk2(x[j].x, x[j].y), pk2(x[j].z, x[j].w)};
                    s2 += (x[j].x * x[j].x + x[j].y * x[j].y) + (x[j].z * x[j].z + x[j].w * x[j].w); }
                const float rstd2 = 1.0f / sqrtf(wave_sum(s2) * (1.0f / D) + 1e-6f);
                f32x4 hq[4]; float mx = 0.f;
#pragma unroll
                for (int j = 0; j < 4; ++j) { const int c = 4 * F.lane + 256 * j; const f32x4 a = *(const LAS f32x4*)(LA + c), b = *(const LAS f32x4*)(LB + c);
                    const f32x4 h = x[j] * rstd2 * a + b; hq[j] = h;
                    mx = fmaxf(mx, fmaxf(fmaxf(fabsf(h.x), fabsf(h.y)), fmaxf(fabsf(h.z), fabsf(h.w))));
                    *(LAS v2u*)(Hs + lrow * HS_STRIDE + c * 2) = (v2u){pk2(h.x, h.y), pk2(h.z, h.w)}; }
                mx = wave_max(mx);
                const float iv = mx > 0.f ? 127.0f / mx : 0.f;
                if (F.lane == 0) ((float*)(F.ws + MI_RSH2))[row] = mx * (1.0f / 127.0f);
                unsigned* o4 = (unsigned*)(F.ws + WS_H2Q + (size_t)row * D) + F.lane;
#pragma unroll
                for (int j = 0; j < 4; ++j) o4[64 * j] = pack_q4(hq[j].x * iv, hq[j].y * iv, hq[j].z * iv, hq[j].w * iv);
            }
        }
        __syncthreads();
        {
            const int rt = F.wave & 3, et = F.wave >> 2, lr = F.lane & 15, g = F.lane >> 4;
            typedef short bf16x8_t __attribute__((ext_vector_type(8)));
            f32x4 acc = {0.f, 0.f, 0.f, 0.f};
            const LAS unsigned char* ap = Hs + (16 * rt + lr) * HS_STRIDE + 16 * g; const bf16* bp = WR + (size_t)(16 * et + lr) * D + 8 * g;
#pragma unroll
            for (int sb = 0; sb < 32; sb += 16) {
                bf16x8_t bq[16];
#pragma unroll
                for (int s = 0; s < 16; ++s) bq[s] = *(const bf16x8_t*)(bp + 32 * (sb + s));
                __builtin_amdgcn_sched_barrier(0);
#pragma unroll
                for (int s = 0; s < 16; ++s) { const bf16x8_t a = *(const LAS bf16x8_t*)(ap + 64 * (sb + s)); acc = __builtin_amdgcn_mfma_f32_16x16x32_bf16(a, bq[s], acc, 0, 0, 0); }
            }
#pragma unroll
            for (int i = 0; i < 4; ++i) LGT[(16 * rt + 4 * g + i) * 33 + 16 * et + lr] = acc[i];
        }
        __syncthreads();
        if (F.wave == 0) {
            const int row = rb * 64 + F.lane;
            const float* br = KIN(I_BR);
            float v[NE];
#pragma unroll
            for (int e = 0; e < NE; ++e) v[e] = LGT[F.lane * 33 + e] + br[e];
            int se[4]; float sv[4];
#pragma unroll
            for (int k = 0; k < 4; ++k) { float best = -3.0e38f; int bi = 0;
#pragma unroll
                for (int e = 0; e < NE; ++e) if (v[e] > best) { best = v[e]; bi = e; }
#pragma unroll
                for (int e = 0; e < NE; ++e) v[e] = (e == bi) ? -3.0e38f : v[e];
                se[k] = bi; sv[k] = best; }
            float ex[4], sum = 0.f;
#pragma unroll
            for (int k = 0; k < 4; ++k) { ex[k] = __expf(sv[k] - sv[0]); sum += ex[k]; }
            const float inv = 1.0f / sum;
            int sp[4] = {0, 0, 0, 0};
            int myn = 0;
#pragma unroll
            for (int e = 0; e < NE; ++e) { const bool p = (se[0] == e) | (se[1] == e) | (se[2] == e) | (se[3] == e); const int n = __popcll(__ballot(p)); myn = (F.lane == e) ? n : myn; }
            int mybase = 0;
            if (F.lane < NE && myn > 0) mybase = (int)__hip_atomic_fetch_add(F.ctl + CW_CNT + 64 * F.lane, (unsigned)myn, __ATOMIC_RELAXED, __HIP_MEMORY_SCOPE_AGENT);
#pragma unroll
            for (int e = 0; e < NE; ++e) {
                const bool p = (se[0] == e) | (se[1] == e) | (se[2] == e) | (se[3] == e);
                const unsigned long long mask = __ballot(p);
                const int base = __shfl(mybase, e);
                const int pos = base + __popcll(mask & ((1ull << F.lane) - 1ull));
#pragma unroll
                for (int k = 0; k < 4; ++k) if (se[k] == e) sp[k] = pos;
            }
            *(int4*)(selE + (size_t)row * 4) = make_int4(se[0], se[1], se[2], se[3]);
            *(int4*)(selP + (size_t)row * 4) = make_int4(sp[0], sp[1], sp[2], sp[3]);
            *(f32x4*)(gate + (size_t)row * 4) = (f32x4){ex[0] * inv, ex[1] * inv, ex[2] * inv, ex[3] * inv};
        }
    }
    __syncthreads();
}

__device__ __forceinline__ void phase_scatter(Frame& F) {
    LAS int* PS = (LAS int*)(F.lds);
    if (F.wave == 0) {
        const int c = F.lane < NE ? (int)__hip_atomic_load(F.ctl + CW_CNT + 64 * F.lane, __ATOMIC_RELAXED, __HIP_MEMORY_SCOPE_AGENT) : 0;
        const int pc = (c + 255) / 256 * 256; int s = pc;
#pragma unroll
        for (int o = 1; o < 32; o <<= 1) { const int t = __shfl_up(s, o); s += (F.lane >= o) ? t : 0; }
        if (F.lane < NE) { PS[F.lane] = s - pc; PS[64 + F.lane] = c; }
        if (F.lane == NE - 1) PS[NE] = s; }
    __syncthreads();
    int* blkE = (int*)(F.ws + MI_BLKE);
    if (blockIdx.x == 0) {
        for (int b = F.tid; b < MAXBLK; b += NWAVES * 64) { int e = NE - 1;
            for (int q = 0; q < NE; ++q) if (b * 256 >= PS[q] && b * 256 < PS[q + 1]) e = q;
            blkE[b] = e; }
        if (F.tid == 0) blkE[MAXBLK] = PS[NE] / 256;
    }
    const int* selE = (const int*)(F.ws + MI_SELE); const int* selP = (const int*)(F.ws + MI_SELP); int* dest = (int*)(F.ws + MI_DEST);
    const unsigned char* h2q = F.ws + WS_H2Q; unsigned char* xb = F.ws + WS_XB; const float* rsh2 = (const float*)(F.ws + MI_RSH2); float* rsxb = (float*)(F.ws + MI_RSXB);
    for (int row0 = F.gw; row0 < ML; row0 += 8 * F.NGW) {
        int4 se[8], sp[8]; float rsc[8]; v4u av[8];
#pragma unroll
        for (int k = 0; k < 8; ++k) { const int row = row0 + k * F.NGW, rc = row < ML ? row : row0;
            se[k] = *(const int4*)(selE + (size_t)rc * 4); sp[k] = *(const int4*)(selP + (size_t)rc * 4); rsc[k] = rsh2[rc]; av[k] = *(const v4u*)(h2q + (size_t)rc * D + 16 * F.lane); }
        __builtin_amdgcn_sched_barrier(0);
#pragma unroll
        for (int k = 0; k < 8; ++k) { const int row = row0 + k * F.NGW;
            if (row < ML) {
                const int d0 = PS[se[k].x] + sp[k].x, d1 = PS[se[k].y] + sp[k].y, d2 = PS[se[k].z] + sp[k].z, d3 = PS[se[k].w] + sp[k].w;
                if (F.lane == 0) { *(int4*)(dest + (size_t)row * 4) = make_int4(d0, d1, d2, d3); rsxb[d0] = rsc[k]; rsxb[d1] = rsc[k]; rsxb[d2] = rsc[k]; rsxb[d3] = rsc[k]; }
                *(v4u*)(xb + (size_t)d0 * D + 16 * F.lane) = av[k]; *(v4u*)(xb + (size_t)d1 * D + 16 * F.lane) = av[k];
                *(v4u*)(xb + (size_t)d2 * D + 16 * F.lane) = av[k]; *(v4u*)(xb + (size_t)d3 * D + 16 * F.lane) = av[k]; } }
    }
    for (int p = F.gw; p < NE * 256; p += F.NGW) {
        const int e = p >> 8, r = p & 255, c = PS[64 + e], padded = (c + 255) / 256 * 256;
        if (c + r < padded) { unsigned char* dst = xb + (size_t)(PS[e] + c + r) * D; *(v4u*)(dst + 16 * F.lane) = (v4u){0u, 0u, 0u, 0u}; if (F.lane == 0) rsxb[PS[e] + c + r] = 0.f; }
    }
}

__device__ __forceinline__ void phase_combine(Frame& F) {
    LAS float* LG = (LAS float*)(F.lds);
    const float* modp = (const float*)(F.ws + WS_MODP);
    for (int i = F.tid; i < 2 * D; i += NWAVES * 64) { const int v = i / D, j = i % D; LG[i] = mod_val(modp, KIN(I_BADA), v, 5120 + j) * KIN(I_NQF)[j]; }
    __syncthreads();
    const int* dest = (const int*)(F.ws + MI_DEST); const float* gate = (const float*)(F.ws + MI_GATE);
    const bf16* y2 = (const bf16*)(F.ws + WS_Y2); const bf16* x1b = (const bf16*)(F.ws + WS_X1);
    for (int row0 = F.gw; row0 < ML; row0 += 8 * F.NGW) {
        const int rl = row0 + (F.lane & 7) * F.NGW, rlc = rl < ML ? rl : row0;
        const int4 ddl = *(const int4*)(dest + (size_t)rlc * 4); const f32x4 ggl = *(const f32x4*)(gate + (size_t)rlc * 4);
#pragma unroll
        for (int k2 = 0; k2 < 8; k2 += 2) {
            if (row0 + k2 * F.NGW >= ML) break;
            v4u t[2][4][2]; v4u xq[2][2];
#pragma unroll
            for (int u = 0; u < 2; ++u) { const int kk = k2 + u, row = row0 + kk * F.NGW, rc = row < ML ? row : row0;
                const int dk[4] = {__builtin_amdgcn_readlane(ddl.x, kk), __builtin_amdgcn_readlane(ddl.y, kk), __builtin_amdgcn_readlane(ddl.z, kk), __builtin_amdgcn_readlane(ddl.w, kk)};
#pragma unroll
                for (int k = 0; k < 4; ++k) { const bf16* yp = y2 + (size_t)dk[k] * D + 16 * F.lane; t[u][k][0] = *(const v4u*)yp; t[u][k][1] = *(const v4u*)(yp + 8); }
#pragma unroll
                for (int j = 0; j < 2; ++j) xq[u][j] = *(const v4u*)(x1b + (size_t)rc * D + 16 * F.lane + 8 * j); }
            __builtin_amdgcn_sched_barrier(0);
#pragma unroll
            for (int u = 0; u < 2; ++u) { const int kk = k2 + u, row = row0 + kk * F.NGW;
                if (row < ML) {
                    const int vec = row >> 13;
                    const float g0_ = ggl.x, g1_ = ggl.y, g2_ = ggl.z, g3_ = ggl.w;
                    const float gk[4] = {__int_as_float(__builtin_amdgcn_readlane(__float_as_int(g0_), kk)), __int_as_float(__builtin_amdgcn_readlane(__float_as_int(g1_), kk)),
                                         __int_as_float(__builtin_amdgcn_readlane(__float_as_int(g2_), kk)), __int_as_float(__builtin_amdgcn_readlane(__float_as_int(g3_), kk))};
                    float f[16];
#pragma unroll
                    for (int i = 0; i < 16; ++i) f[i] = 0.f;
#pragma unroll
                    for (int k = 0; k < 4; ++k) { const v4u a_ = t[u][k][0], b_ = t[u][k][1];
                        const float tt[16] = {bflo(a_.x), bfhi(a_.x), bflo(a_.y), bfhi(a_.y), bflo(a_.z), bfhi(a_.z), bflo(a_.w), bfhi(a_.w), bflo(b_.x), bfhi(b_.x), bflo(b_.y), bfhi(b_.y), bflo(b_.z), bfhi(b_.z), bflo(b_.w), bfhi(b_.w)};
#pragma unroll
                        for (int i = 0; i < 16; ++i) f[i] += gk[k] * tt[i]; }
                    float s = 0.f;
#pragma unroll
                    for (int i = 0; i < 16; ++i) s += f[i] * f[i];
                    const float rstd = 1.0f / sqrtf(wave_sum(s) * (1.0f / D) + 1e-6f);
                    float g[16], o[16]; ld16f_lds(LG + vec * D + 16 * F.lane, g);
#pragma unroll
                    for (int i = 0; i < 16; ++i) { const unsigned w_ = xq[u][i >> 3][(i >> 1) & 3]; o[i] = ((i & 1) ? bfhi(w_) : bflo(w_)) + g[i] * (f[i] * rstd); }
                    st16f(F.out + (size_t)row * D + 16 * F.lane, o);
                }
            }
        }
    }
}

constexpr int N_PHASES = 13;
#ifndef PROBE_MASK
#define PROBE_MASK 0
#endif
#ifndef STAGE_REP
#define STAGE_REP 0
#endif
#ifndef USE_FLAT_BAR
#define USE_FLAT_BAR 0
#endif
struct Args { const float* in[30]; float* out; unsigned char* ws; int ph_lo, ph_hi; };
__global__ void __launch_bounds__(NWAVES * 64, 2) fwd(Args args) {
    extern __shared__ __attribute__((aligned(16))) unsigned char lds[];
    Frame F;
    F.lds = (LAS unsigned char*)lds;
    F.MISC = (volatile LAS unsigned*)(F.lds + MISC_OFF);
    F.tid = threadIdx.x; F.lane = F.tid & 63; F.wave = __builtin_amdgcn_readfirstlane(F.tid >> 6);
    F.G = gridDim.x; F.gw = blockIdx.x * NWAVES + F.wave; F.NGW = F.G * NWAVES;
    F.ws = args.ws; F.ctl = (unsigned*)(args.ws + WS_CTL); F.out = args.out;
    for (int u = F.tid; u < (LDS_X_OFF - LDSCTL_OFF) / 4; u += NWAVES * 64) ((LAS unsigned*)(F.lds + LDSCTL_OFF))[u] = 0u;
    __syncthreads();
    const int lo = args.ph_lo, hi = args.ph_hi;
    const bool use_bar = (hi - lo) > 1;
    XcdBarrier bar; bar.bar = F.ctl + CW_BAR; bar.x = 0; bar.st = nullptr;
    unsigned xrank = 0u;
    if (use_bar && !USE_FLAT_BAR) { bar.x = xb_xcc_id(); bar.st = F.MISC + 8; if (threadIdx.x == 0) xrank = xb_add(&bar.bar[XB_XCNT(bar.x)], 1u); }
    F.vb = (int)blockIdx.x;
#define IN(k) (lo <= (k) && (k) < hi)
    unsigned fb_extra = 0u;
#define SEAM(k) do { if (IN(k) && IN((k) + 1)) { if (USE_FLAT_BAR) flat_barrier(F.ctl + CW_FB, (unsigned)((k) - lo + 1) + fb_extra); \
        else if (SEAM_FILL && (k) < 8) { xcd_barrier2_arrive(bar); seam_filler(F, (k)); xcd_barrier2_wait(bar); } else xcd_barrier2(bar); } \
    else { __syncthreads(); if (SEAM_FILL && (k) < 8) { seam_filler(F, (k)); __syncthreads(); } } } while (0)

#define DUP(k) ((PROBE_MASK >> (k)) & 1)
    if (IN(0)) { phase_prologue(F); if (DUP(0)) { __syncthreads(); phase_prologue(F); } SEAM(0); }
    if (use_bar && !USE_FLAT_BAR && IN(0) && IN(1)) {
        if (F.tid == 0) { bool ok = (F.G & 7) == 0;
            for (unsigned j = 0; j < 16; ++j) ok = ok && (xb_ld(&bar.bar[XB_XCNT(j)]) == (j < 8u ? (unsigned)(F.G >> 3) : 0u));
            F.MISC[12] = ok ? bar.x + 8u * xrank : blockIdx.x; }
        __syncthreads(); F.vb = (int)F.MISC[12];
    }
    if (DUP(20)) { for (int q = 0; q < 10; ++q) { if (USE_FLAT_BAR) { ++fb_extra; flat_barrier(F.ctl + CW_FB, 1u + fb_extra); } else xcd_barrier2(bar); } }
    if (IN(1)) { phase_hrows(F); if (DUP(1)) { __syncthreads(); phase_hrows(F); } SEAM(1); }
    if (IN(2)) {
        {         pg8::Gemm g{(const bf16*)(F.ws + WS_A0), (const bf16*)(F.ws + WS_WIN), MT, NZ, D}; pg8::StaticOrder S; S.init(MT, NZ, F.G, F.vb);
        pg8::EpiBf16I8 E{(bf16*)(F.ws + WS_Z), NZ, (const float*)(F.ws + MI_RSH), (const float*)(F.ws + MI_CSWIN)};
        pg8::gemm_phase_i8<pg8::EpiBf16I8, pg8::StaticOrder, true, true>(F.lds + RING_OFF, g, S, E); __syncthreads(); }
        if (DUP(2)) {         pg8::Gemm g{(const bf16*)(F.ws + WS_A0), (const bf16*)(F.ws + WS_WIN), MT, NZ, D}; pg8::StaticOrder S; S.init(MT, NZ, F.G, F.vb);
        pg8::EpiBf16I8 E{(bf16*)(F.ws + WS_Z), NZ, (const float*)(F.ws + MI_RSH), (const float*)(F.ws + MI_CSWIN)};
        pg8::gemm_phase_i8<pg8::EpiBf16I8, pg8::StaticOrder, true, true>(F.lds + RING_OFF, g, S, E); __syncthreads(); }
        SEAM(2); }
    if (IN(3)) { ck::phase_lora(F); SEAM(3); }
    if (IN(4)) { ck::phase_cp2(F); if (DUP(5)) { __syncthreads(); ck::phase_cp2(F); } if (DUP(22)) { __syncthreads(); ck::phase_lora(F); } SEAM(4); }
    if (IN(5)) { if (F.wave == 0) ck::phase_ss(F); if (DUP(23)) { __syncthreads(); ck::phase_ss3(F); } if (DUP(6)) { __syncthreads(); if (F.wave == 0) ck::phase_ss(F); else phase_moe_weights<0>(F); } if (DUP(17)) { __syncthreads(); if (F.wave == 0) ck::phase_ss(F); } SEAM(5); }
    if (IN(6)) { ck::phase_co2(F); if (DUP(7)) { __syncthreads(); ck::phase_co2(F); } SEAM(6); }
    if (IN(7)) {
        {         pg8::Gemm g{(const bf16*)(F.ws + WS_A0), (const bf16*)(F.ws + WS_WOUT), ML, D, D}; pg8::StaticOrder S; S.init(ML, D, F.G, F.vb);
        pg8::EpiBf16 E{(bf16*)(F.ws + WS_MIX), D, nullptr, 0};
        pg8::gemm_phase<pg8::EpiBf16, pg8::StaticOrder, true, true>(F.lds + RING_OFF, g, S, E);
        __syncthreads(); }
        if (DUP(8)) {         pg8::Gemm g{(const bf16*)(F.ws + WS_A0), (const bf16*)(F.ws + WS_WOUT), ML, D, D}; pg8::StaticOrder S; S.init(ML, D, F.G, F.vb);
        pg8::EpiBf16 E{(bf16*)(F.ws + WS_MIX), D, nullptr, 0};
        pg8::gemm_phase<pg8::EpiBf16, pg8::StaticOrder, true, true>(F.lds + RING_OFF, g, S, E);
        __syncthreads(); }
        SEAM(7); }
    if (IN(8)) { phase_x1h2_route(F); SEAM(8); }
    if (IN(9)) { phase_scatter(F); if (DUP(12)) { __syncthreads(); phase_scatter(F); } SEAM(9); }
    if (IN(10)) {
        {         const int* blkE = (const int*)(F.ws + MI_BLKE);
        pg8::Gemm g{(const bf16*)(F.ws + WS_XB), (const bf16*)(F.ws + WS_WEIN), NROWS, 2048, D};
        LAS int* BE = (LAS int*)(F.lds + RING_BYTES);
        for (int i = F.tid; i <= MAXBLK; i += NWAVES * 64) BE[i] = __hip_atomic_load(blkE + i, __ATOMIC_RELAXED, __HIP_MEMORY_SCOPE_AGENT);
        __syncthreads();
        pg8::MoeOrder<8> S{BE, BE[MAXBLK] * 8, F.G, F.vb};
        pg8::EpiSwigluI8 E{(bf16*)(F.ws + WS_ACT), KIN(I_BEI), (const float*)(F.ws + MI_RSXB), (const float*)(F.ws + MI_CSWEI)};
        pg8::gemm_phase_i8<pg8::EpiSwigluI8, pg8::MoeOrder<8>, true, true>(F.lds + RING_OFF, g, S, E); __syncthreads(); }
        if (DUP(13)) {         const int* blkE = (const int*)(F.ws + MI_BLKE);
        pg8::Gemm g{(const bf16*)(F.ws + WS_XB), (const bf16*)(F.ws + WS_WEIN), NROWS, 2048, D};
        LAS int* BE = (LAS int*)(F.lds + RING_BYTES);
        for (int i = F.tid; i <= MAXBLK; i += NWAVES * 64) BE[i] = __hip_atomic_load(blkE + i, __ATOMIC_RELAXED, __HIP_MEMORY_SCOPE_AGENT);
        __syncthreads();
        pg8::MoeOrder<8> S{BE, BE[MAXBLK] * 8, F.G, F.vb};
        pg8::EpiSwigluI8 E{(bf16*)(F.ws + WS_ACT), KIN(I_BEI), (const float*)(F.ws + MI_RSXB), (const float*)(F.ws + MI_CSWEI)};
        pg8::gemm_phase_i8<pg8::EpiSwigluI8, pg8::MoeOrder<8>, true, true>(F.lds + RING_OFF, g, S, E); __syncthreads(); }
        SEAM(10); }
    if (IN(11)) {
        {         const int* blkE = (const int*)(F.ws + MI_BLKE);
        pg8::Gemm g{(const bf16*)(F.ws + WS_ACT), (const bf16*)(F.ws + WS_WEOUT), NROWS, D, D};
        LAS int* BE = (LAS int*)(F.lds + RING_BYTES);
        for (int i = F.tid; i <= MAXBLK; i += NWAVES * 64) BE[i] = __hip_atomic_load(blkE + i, __ATOMIC_RELAXED, __HIP_MEMORY_SCOPE_AGENT);
        __syncthreads();
        pg8::MoeOrder<4> S{BE, BE[MAXBLK] * 4, F.G, F.vb};
        pg8::EpiBf16 E{(bf16*)(F.ws + WS_Y2), D, KIN(I_BEO), D};
        pg8::gemm_phase<pg8::EpiBf16, pg8::MoeOrder<4>, true, true>(F.lds + RING_OFF, g, S, E); __syncthreads(); }
        if (DUP(14)) {         const int* blkE = (const int*)(F.ws + MI_BLKE);
        pg8::Gemm g{(const bf16*)(F.ws + WS_ACT), (const bf16*)(F.ws + WS_WEOUT), NROWS, D, D};
        LAS int* BE = (LAS int*)(F.lds + RING_BYTES);
        for (int i = F.tid; i <= MAXBLK; i += NWAVES * 64) BE[i] = __hip_atomic_load(blkE + i, __ATOMIC_RELAXED, __HIP_MEMORY_SCOPE_AGENT);
        __syncthreads();
        pg8::MoeOrder<4> S{BE, BE[MAXBLK] * 4, F.G, F.vb};
        pg8::EpiBf16 E{(bf16*)(F.ws + WS_Y2), D, KIN(I_BEO), D};
        pg8::gemm_phase<pg8::EpiBf16, pg8::MoeOrder<4>, true, true>(F.lds + RING_OFF, g, S, E); __syncthreads(); }
        SEAM(11); }
    if (IN(12)) { phase_combine(F); if (DUP(15)) { __syncthreads(); phase_combine(F); } }
#undef IN
#undef SEAM
}

#ifndef MK_N_LAUNCHES
#define MK_N_LAUNCHES 1
#endif
extern "C" void kernel_launch(void* const* d_in, const int* in_sizes, int n_in, void* d_out, int out_size, void* d_ws, size_t ws_size, hipStream_t stream) {
    static int grid = 0;
    if (grid == 0) {
        if (n_in != 30 || out_size != ML * D || ws_size < WS_END) { fprintf(stderr, "kernel_launch: unexpected shapes (n_in %d out %d ws %zu, need %zu); nothing launched\n", n_in, out_size, ws_size, (size_t)WS_END); grid = -1; return; }
        int dev = 0, cus = 0, per_cu = 0;
        if (hipGetDevice(&dev) != hipSuccess || hipDeviceGetAttribute(&cus, hipDeviceAttributeMultiprocessorCount, dev) != hipSuccess) { grid = -1; return; }
        if (hipFuncSetAttribute((const void*)fwd, hipFuncAttributeMaxDynamicSharedMemorySize, LDS_BYTES) != hipSuccess) { fprintf(stderr, "kernel_launch: hipFuncSetAttribute failed\n"); grid = -1; return; }
        if (hipOccupancyMaxActiveBlocksPerMultiprocessor(&per_cu, (const void*)fwd, NWAVES * 64, LDS_BYTES) != hipSuccess || per_cu < 1)
            fprintf(stderr, "kernel_launch: note: occupancy query reports %d workgroups per CU\n", per_cu);
        (void)hipGetLastError();
        grid = cus;
    }
    if (grid < 0) return;
    if (hipMemsetAsync((char*)d_ws + WS_CTL, 0, CTL_ZERO_BYTES, stream) != hipSuccess) return;
    Args a{};
    for (int i = 0; i < 30; ++i) a.in[i] = (const float*)d_in[i];
    a.out = (float*)d_out; a.ws = (unsigned char*)d_ws;
    if (MK_N_LAUNCHES == 1) { a.ph_lo = 0; a.ph_hi = N_PHASES; hipLaunchKernelGGL(fwd, dim3(grid), dim3(NWAVES * 64), LDS_BYTES, stream, a); }
    else for (int p = 0; p < N_PHASES; ++p) { a.ph_lo = p; a.ph_hi = p + 1; hipLaunchKernelGGL(fwd, dim3(grid), dim3(NWAVES * 64), LDS_BYTES, stream, a); }
}
```

```cpp
#include <hip/hip_runtime.h>
#include <cstdio>
#include <cstdint>

namespace pg8 {
#define PG8_LAS __attribute__((address_space(3)))
typedef unsigned short bf16_t;
typedef short bf16x8 __attribute__((ext_vector_type(8)));
typedef float f32x4 __attribute__((ext_vector_type(4)));
typedef unsigned u32x4 __attribute__((ext_vector_type(4)));
constexpr int BM = 256, BK = 64, HALF = 128, HTB = HALF * BK * 2  , STAGE_BYTES = 8 * HTB, NXCD = 8, WGM = 8;

__host__ __device__ __forceinline__ int lds_byte(int r, int c) { const int st = (r >> 4) * 2 + (c >> 5), rr = r & 15, cc = c & 31, ob = rr * 64 + cc * 2; return st * 1024 + (ob ^ (((ob >> 9) & 1) << 5)); }
__host__ __device__ __forceinline__ void stage_rc(int b, int& R, int& C) { const int st = b / 1024, sb = b % 1024, swz = sb ^ (((sb >> 9) & 1) << 5); R = (st >> 1) * 16 + swz / 64; C = (st & 1) * 32 + (swz % 64) / 2; }
__host__ __device__ __forceinline__ int perm32(int rho) { const int n = rho >> 4, i = rho & 15; return 8 * (i >> 2) + 4 * n + (i & 3); }

struct Unit { int pm, pn, pb, e; };
struct Gemm { const bf16_t* A; const bf16_t* Bt; int M, N, K; };

struct StaticOrder {
    int nM, nN, nwg, G, c;
    __host__ __device__ void init(int M, int N, int G_, int c_) { nM = M / BM; nN = N / BM; nwg = nM * nN; G = G_; c = c_; }
    __host__ __device__ bool next(int i, Unit& u) const {
        const long L = (long)i * G + c; if (L >= nwg) return false;
        int wgid = (int)L; { const int q = nwg / NXCD, r = nwg % NXCD, xcd = wgid % NXCD, off = wgid / NXCD; wgid = (xcd < r ? xcd * (q + 1) : r * (q + 1) + (xcd - r) * q) + off; }
        const int nig = WGM * nN, gid = wgid / nig, fm = gid * WGM, gsz = (nM - fm) < WGM ? (nM - fm) : WGM;
        u.pm = fm + ((wgid % nig) % gsz); u.pn = (wgid % nig) / gsz; u.pb = u.pn; u.e = 0; return true;
    }
    __device__ __forceinline__ void a_ready(const Unit&) const {}
    __device__ __forceinline__ void done(const Unit&) const {}
};
template <int NT> struct MoeOrder {
    const PG8_LAS int* blk_e; int nunits, G, c;
    __device__ bool next(int i, Unit& u) const {
        int L;
        if ((G & 7) == 0 && ((G >> 3) % NT) == 0) { const int per = G >> 3, xcd = c & 7, k = c >> 3, bpx = per / NT;
            const int base = i * G, R = nunits - base;
            if (R > 0 && R < G && (R & 7) == 0) { const int rpx = R >> 3; if (k >= rpx) return false; L = base + xcd * rpx + k; }
            else L = ((i * 8 + xcd) * bpx + k / NT) * NT + (k % NT); }
        else L = i * G + c;
        if (L >= nunits) return false;
        const int blk = L / NT, pn = L % NT; const int e = blk_e[blk];
        u.pm = blk; u.pn = pn; u.pb = e * NT + pn; u.e = e; return true;
    }
    __device__ __forceinline__ void a_ready(const Unit&) const {}
    __device__ __forceinline__ void done(const Unit&) const {}
};

__device__ __forceinline__ unsigned cvt_pk_bf16(float lo, float hi) { unsigned r; asm volatile("v_cvt_pk_bf16_f32 %0, %1, %2" : "=v"(r) : "v"(lo), "v"(hi)); return r; }

struct EpiF32 {
    static constexpr bool PERM = false, AFTER_DRAIN = false; static constexpr int NSTORE = 32;
    float* C; int ldc;
    __device__ __forceinline__ void operator()(const f32x4 (&acc)[2][2][4][2], const Unit& u, int wr, int wc, int fr, int fq) const {
        const int row0 = u.pm * BM + wr * 64 + fr, col0 = u.pn * BM + wc * 32 + 4 * fq;
#pragma unroll
        for (int ai = 0; ai < 2; ++ai)
#pragma unroll
            for (int m = 0; m < 4; ++m) { float* rowp = C + (size_t)(row0 + ai * HALF + m * 16) * ldc + col0;
#pragma unroll
                for (int bj = 0; bj < 2; ++bj)
#pragma unroll
                    for (int n = 0; n < 2; ++n) __builtin_nontemporal_store(acc[ai][bj][m][n], (f32x4*)(rowp + bj * HALF + n * 16)); }
    }
};
struct EpiBf16 {
    static constexpr bool PERM = true, AFTER_DRAIN = false; static constexpr int NSTORE = 16;
    bf16_t* O; int ldc; const float* bias; int bias_estride;
    __device__ __forceinline__ void operator()(const f32x4 (&acc)[2][2][4][2], const Unit& u, int wr, int wc, int fr, int fq) const {
        const int row0 = u.pm * BM + wr * 64 + fr; const int col0 = u.pn * BM + wc * 32 + 8 * fq;
        const float* bp = bias ? bias + (size_t)u.e * bias_estride + col0 : nullptr;
        f32x4 bv[2][2];
#pragma unroll
        for (int bj = 0; bj < 2; ++bj)
#pragma unroll
            for (int n = 0; n < 2; ++n) bv[bj][n] = bp ? *(const f32x4*)(bp + bj * HALF + 4 * n) : (f32x4){0.f, 0.f, 0.f, 0.f};
#pragma unroll
        for (int ai = 0; ai < 2; ++ai)
#pragma unroll
            for (int m = 0; m < 4; ++m) { bf16_t* rowp = O + (size_t)(row0 + ai * HALF + m * 16) * ldc + col0;
#pragma unroll
                for (int bj = 0; bj < 2; ++bj) { const f32x4 v0 = acc[ai][bj][m][0] + bv[bj][0], v1 = acc[ai][bj][m][1] + bv[bj][1];
                    u32x4 w; w.x = cvt_pk_bf16(v0[0], v0[1]); w.y = cvt_pk_bf16(v0[2], v0[3]); w.z = cvt_pk_bf16(v1[0], v1[1]); w.w = cvt_pk_bf16(v1[2], v1[3]);
                    __builtin_nontemporal_store(w, (u32x4*)(rowp + bj * HALF)); } }
    }
};
struct EpiSwiglu {
    static constexpr bool PERM = true, AFTER_DRAIN = false; static constexpr int NSTORE = 8;
    bf16_t* O; const float* bias;
    __device__ __forceinline__ float act1(float g, float up) const {
        g = fminf(g, 7.0f); up = fminf(fmaxf(up, -7.0f), 7.0f);
        const float sg = 1.0f / (1.0f + __expf(-1.702f * g));
        return (up + 1.0f) * g * sg;
    }
    __device__ __forceinline__ void operator()(const f32x4 (&acc)[2][2][4][2], const Unit& u, int wr, int wc, int fr, int fq) const {
        const int row0 = u.pm * BM + wr * 64 + fr; const int col0 = u.pn * HALF + wc * 32 + 8 * fq;
        const float* bp = bias + (size_t)u.e * 2048 + col0;
        f32x4 bg[2], bu[2];
#pragma unroll
        for (int n = 0; n < 2; ++n) { bg[n] = *(const f32x4*)(bp + 4 * n); bu[n] = *(const f32x4*)(bp + 1024 + 4 * n); }
#pragma unroll
        for (int ai = 0; ai < 2; ++ai)
#pragma unroll
            for (int m = 0; m < 4; ++m) { bf16_t* rowp = O + (size_t)(row0 + ai * HALF + m * 16) * 1024 + col0;
                const f32x4 g0 = acc[ai][0][m][0] + bg[0], g1 = acc[ai][0][m][1] + bg[1], u0 = acc[ai][1][m][0] + bu[0], u1 = acc[ai][1][m][1] + bu[1];
                u32x4 w; w.x = cvt_pk_bf16(act1(g0[0], u0[0]), act1(g0[1], u0[1])); w.y = cvt_pk_bf16(act1(g0[2], u0[2]), act1(g0[3], u0[3]));
                w.z = cvt_pk_bf16(act1(g1[0], u1[0]), act1(g1[1], u1[1])); w.w = cvt_pk_bf16(act1(g1[2], u1[2]), act1(g1[3], u1[3]));
                __builtin_nontemporal_store(w, (u32x4*)rowp); }
    }
};


typedef int i32x4 __attribute__((ext_vector_type(4)));
struct EpiBf16I8 {
    static constexpr bool PERM = true, AFTER_DRAIN = false; static constexpr int NSTORE = 16;
    bf16_t* O; int ldc; const float* rs; const float* cs;
    __device__ __forceinline__ void operator()(const i32x4 (&acc)[2][2][4][2], const Unit& u, int wr, int wc, int fr, int fq) const {
        const int row0 = u.pm * BM + wr * 64 + fr; const int col0 = u.pn * BM + wc * 32 + 8 * fq;
        const float* cp = cs + (size_t)u.pb * BM + wc * 32 + 8 * fq;
        f32x4 cv[2][2]; float rsv[2][4];
#pragma unroll
        for (int bj = 0; bj < 2; ++bj)
#pragma unroll
            for (int n = 0; n < 2; ++n) cv[bj][n] = *(const f32x4*)(cp + bj * HALF + 4 * n);
#pragma unroll
        for (int ai = 0; ai < 2; ++ai)
#pragma unroll
            for (int m = 0; m < 4; ++m) rsv[ai][m] = rs[row0 + ai * HALF + m * 16];
#pragma unroll
        for (int ai = 0; ai < 2; ++ai)
#pragma unroll
            for (int m = 0; m < 4; ++m) { const int row = row0 + ai * HALF + m * 16; const float r = rsv[ai][m]; bf16_t* rowp = O + (size_t)row * ldc + col0;
#pragma unroll
                for (int bj = 0; bj < 2; ++bj) { const i32x4 a0 = acc[ai][bj][m][0], a1 = acc[ai][bj][m][1];
                    const f32x4 v0 = (f32x4){(float)a0[0], (float)a0[1], (float)a0[2], (float)a0[3]} * cv[bj][0] * r, v1 = (f32x4){(float)a1[0], (float)a1[1], (float)a1[2], (float)a1[3]} * cv[bj][1] * r;
                    u32x4 w; w.x = cvt_pk_bf16(v0[0], v0[1]); w.y = cvt_pk_bf16(v0[2], v0[3]); w.z = cvt_pk_bf16(v1[0], v1[1]); w.w = cvt_pk_bf16(v1[2], v1[3]);
                    __builtin_nontemporal_store(w, (u32x4*)(rowp + bj * HALF)); } }
    }
};
struct EpiSwigluI8 {
    static constexpr bool PERM = true, AFTER_DRAIN = false; static constexpr int NSTORE = 8;
    bf16_t* O; const float* bias; const float* rs; const float* cs;
    __device__ __forceinline__ float act1(float g, float up) const {
        g = fminf(g, 7.0f); up = fminf(fmaxf(up, -7.0f), 7.0f);
        const float sg = __builtin_amdgcn_rcpf(1.0f + __expf(-1.702f * g));
        return (up + 1.0f) * g * sg;
    }
    __device__ __forceinline__ void operator()(const i32x4 (&acc)[2][2][4][2], const Unit& u, int wr, int wc, int fr, int fq) const {
        const int row0 = u.pm * BM + wr * 64 + fr; const int col0 = u.pn * HALF + wc * 32 + 8 * fq;
        const float* bp = bias + (size_t)u.e * 2048 + col0;
        const float* cp = cs + (size_t)u.pb * BM + wc * 32 + 8 * fq;
        f32x4 bg[2], bu[2], cg[2], cu[2]; float rsv[2][4];
#pragma unroll
        for (int n = 0; n < 2; ++n) { bg[n] = *(const f32x4*)(bp + 4 * n); bu[n] = *(const f32x4*)(bp + 1024 + 4 * n); cg[n] = *(const f32x4*)(cp + 4 * n); cu[n] = *(const f32x4*)(cp + HALF + 4 * n); }
#pragma unroll
        for (int ai = 0; ai < 2; ++ai)
#pragma unroll
            for (int m = 0; m < 4; ++m) rsv[ai][m] = rs[row0 + ai * HALF + m * 16];
#pragma unroll
        for (int ai = 0; ai < 2; ++ai)
#pragma unroll
            for (int m = 0; m < 4; ++m) { const int row = row0 + ai * HALF + m * 16; const float r = rsv[ai][m]; bf16_t* rowp = O + (size_t)row * 1024 + col0;
                f32x4 g[2], up[2];
#pragma unroll
                for (int n = 0; n < 2; ++n) { const i32x4 ag = acc[ai][0][m][n], au = acc[ai][1][m][n];
                    g[n] = (f32x4){(float)ag[0], (float)ag[1], (float)ag[2], (float)ag[3]} * cg[n] * r + bg[n];
                    up[n] = (f32x4){(float)au[0], (float)au[1], (float)au[2], (float)au[3]} * cu[n] * r + bu[n]; }
                u32x4 w; w.x = cvt_pk_bf16(act1(g[0][0], up[0][0]), act1(g[0][1], up[0][1])); w.y = cvt_pk_bf16(act1(g[0][2], up[0][2]), act1(g[0][3], up[0][3]));
                w.z = cvt_pk_bf16(act1(g[1][0], up[1][0]), act1(g[1][1], up[1][1])); w.w = cvt_pk_bf16(act1(g[1][2], up[1][2]), act1(g[1][3], up[1][3]));
                __builtin_nontemporal_store(w, (u32x4*)rowp); }
    }
};
template <class Epi, class Sched, bool ALIGN_EPI = false, bool SP2 = false>
__device__ __forceinline__ void gemm_phase(PG8_LAS unsigned char* lds, const Gemm g, const Sched& S, const Epi& E) {
    const int tid = threadIdx.x, wid = __builtin_amdgcn_readfirstlane(tid >> 6), lane = tid & 63, wr = wid >> 2, wc = wid & 3, fr = lane & 15, fq = lane >> 4;
    const int K = g.K, nt = K / BK;
    unsigned voffA[2], voffB[2];
#pragma unroll
    for (int i = 0; i < 2; ++i) { int R, C; stage_rc(tid * 16 + i * 8192, R, C); const int Rb = Epi::PERM ? ((R & ~31) + perm32(R & 31)) : R;
        voffA[i] = (unsigned)(R * K + C) * 2u; voffB[i] = (unsigned)(Rb * K + C) * 2u; }
    const size_t kstep = (size_t)(BK * 2);
    const size_t hstep = (size_t)HALF * K * 2;
    const size_t tstep = 2 * hstep;
    const unsigned ldsw = (unsigned)wid * 1024u;
    const int aoff = lds_byte(wr * 64 + fr, fq * 8), boff = lds_byte(wc * 32 + fr, fq * 8);
#define PG8_SA(b, h) (((b) * 2 + (h)) * HTB)
#define PG8_SB(b, h) ((4 + (b) * 2 + (h)) * HTB)
#define PG8_STAGE(bufoff, gbase, voff) do { _Pragma("unroll") for (int _i = 0; _i < 2; ++_i) \
        __builtin_amdgcn_global_load_lds((const unsigned*)((const char*)(gbase) + (voff)[_i]), (PG8_LAS unsigned*)(lds + (bufoff) + ldsw + _i * 8192), 16, 0, 0); } while (0)
#define PG8_LDA(dst, b, h) do { _Pragma("unroll") for (int m = 0; m < 4; ++m) _Pragma("unroll") for (int k = 0; k < 2; ++k) dst[m][k] = *(const PG8_LAS bf16x8*)(lds + PG8_SA(b, h) + aoff + m * 2048 + k * 1024); } while (0)
#define PG8_LDB(dst, b, h) do { _Pragma("unroll") for (int n = 0; n < 2; ++n) _Pragma("unroll") for (int k = 0; k < 2; ++k) dst[n][k] = *(const PG8_LAS bf16x8*)(lds + PG8_SB(b, h) + boff + n * 2048 + k * 1024); } while (0)
#define PG8_MMA(ai, bj, At, Bt) do { __builtin_amdgcn_s_setprio(1); _Pragma("unroll") for (int m = 0; m < 4; ++m) _Pragma("unroll") for (int n = 0; n < 2; ++n) _Pragma("unroll") for (int k = 0; k < 2; ++k) \
        acc[ai][bj][m][n] = __builtin_amdgcn_mfma_f32_16x16x32_bf16(Bt[n][k], At[m][k], acc[ai][bj][m][n], 0, 0, 0); __builtin_amdgcn_s_setprio(0); } while (0)
#define PG8_WAIT_V(n) asm volatile("s_waitcnt vmcnt(" #n ")" ::: "memory")
#define PG8_WAIT_L(n) asm volatile("s_waitcnt lgkmcnt(" #n ")" ::: "memory")
#define PG8_WAIT_V8R(rx) asm volatile("s_waitcnt vmcnt(%1)\n\ts_cmp_lg_u32 %0, 0\n\ts_cbranch_scc1 .Lpg8w_%=\n\ts_waitcnt vmcnt(8)\n.Lpg8w_%=:" :: "s"(rx), "n"(8 + Epi::NSTORE) : "scc", "memory")
#define PG8_BAR __builtin_amdgcn_s_barrier()
#define PG8_SCHED __builtin_amdgcn_sched_barrier(0)
    Unit cur, nxt; int ui = 0;
    if (!S.next(0, cur)) return;
    f32x4 acc[2][2][4][2];
#pragma unroll
    for (int a = 0; a < 2; ++a)
#pragma unroll
        for (int b = 0; b < 2; ++b)
#pragma unroll
            for (int m = 0; m < 4; ++m)
#pragma unroll
                for (int n = 0; n < 2; ++n) acc[a][b][m][n] = (f32x4){0.f, 0.f, 0.f, 0.f};
    bf16x8 At[4][2], B0[2][2], B1[2][2];
    const char* cA = (const char*)g.A + (size_t)cur.pm * tstep; const char* cB = (const char*)g.Bt + (size_t)cur.pb * tstep;
    S.a_ready(cur);
    if constexpr (SP2) {
        PG8_STAGE(PG8_SB(0, 0), cB, voffB); PG8_STAGE(PG8_SB(0, 1), cB + hstep, voffB); PG8_STAGE(PG8_SA(0, 0), cA, voffA); PG8_STAGE(PG8_SA(0, 1), cA + hstep, voffA);
        if (wr == 1) PG8_BAR;
        PG8_WAIT_V(2); PG8_BAR;
        PG8_STAGE(PG8_SB(1, 0), cB + kstep, voffB); PG8_STAGE(PG8_SA(1, 0), cA + kstep, voffA); PG8_STAGE(PG8_SB(1, 1), cB + hstep + kstep, voffB);
        PG8_WAIT_V(6); PG8_BAR;
    } else {
        PG8_STAGE(PG8_SB(0, 0), cB, voffB); PG8_STAGE(PG8_SA(0, 0), cA, voffA); PG8_STAGE(PG8_SB(0, 1), cB + hstep, voffB); PG8_STAGE(PG8_SA(0, 1), cA + hstep, voffA);
        if (wr == 1) PG8_BAR;
        PG8_WAIT_V(4); PG8_BAR;
        PG8_STAGE(PG8_SB(1, 0), cB + kstep, voffB); PG8_STAGE(PG8_SA(1, 0), cA + kstep, voffA); PG8_STAGE(PG8_SB(1, 1), cB + hstep + kstep, voffB);
        PG8_WAIT_V(6); PG8_BAR;
    }
    for (;;) {
        const bool has_next = S.next(ui + 1, nxt);
        const char* nA = has_next ? (const char*)g.A + (size_t)nxt.pm * tstep : cA; const char* nB = has_next ? (const char*)g.Bt + (size_t)nxt.pb * tstep : cB;
        for (int t = 0; t < nt; t += 2) {
            const bool last = (t == nt - 2);
            const char* a1 = cA + (size_t)(t + 1) * kstep;
            const char* a2 = last ? nA : cA + (size_t)(t + 2) * kstep; const char* b2 = last ? nB : cB + (size_t)(t + 2) * kstep;
            const char* a3 = a2 + kstep; const char* b3 = b2 + kstep;
            if (last && has_next) S.a_ready(nxt);
            const int relax = __builtin_amdgcn_readfirstlane(((t == 0) && (ui > 0)) ? 1 : 0);
            if constexpr (SP2) {
            PG8_LDB(B0, 0, 0); PG8_LDB(B1, 0, 1); PG8_SCHED; PG8_LDA(At, 0, 0); PG8_STAGE(PG8_SA(1, 1), a1 + hstep, voffA);
            PG8_WAIT_V8R(relax); PG8_WAIT_L(0); PG8_BAR; PG8_MMA(0, 0, At, B0); PG8_MMA(0, 1, At, B1); PG8_BAR; PG8_SCHED;
            PG8_LDA(At, 0, 1); PG8_STAGE(PG8_SB(0, 0), b2, voffB); PG8_STAGE(PG8_SB(0, 1), b2 + hstep, voffB); PG8_STAGE(PG8_SA(0, 0), a2, voffA);
            PG8_WAIT_V8R(relax); PG8_WAIT_L(0); PG8_BAR; PG8_MMA(1, 0, At, B0); PG8_MMA(1, 1, At, B1); PG8_BAR; PG8_SCHED;
            PG8_LDB(B0, 1, 0); PG8_LDB(B1, 1, 1); PG8_SCHED; PG8_LDA(At, 1, 0); PG8_STAGE(PG8_SA(0, 1), a2 + hstep, voffA);
            PG8_WAIT_V(8); PG8_WAIT_L(0); PG8_BAR; PG8_MMA(0, 0, At, B0); PG8_MMA(0, 1, At, B1); PG8_BAR; PG8_SCHED;
            PG8_LDA(At, 1, 1); PG8_STAGE(PG8_SB(1, 0), b3, voffB); PG8_STAGE(PG8_SB(1, 1), b3 + hstep, voffB); PG8_STAGE(PG8_SA(1, 0), a3, voffA);
            PG8_WAIT_V(8); PG8_WAIT_L(0); PG8_BAR; PG8_MMA(1, 0, At, B0); PG8_MMA(1, 1, At, B1); PG8_BAR; PG8_SCHED;
            } else {
            PG8_LDB(B0, 0, 0); PG8_SCHED; PG8_LDA(At, 0, 0); PG8_STAGE(PG8_SA(1, 1), a1 + hstep, voffA);
            PG8_WAIT_L(8); PG8_BAR; PG8_WAIT_L(0); PG8_MMA(0, 0, At, B0); PG8_BAR; PG8_SCHED;
            PG8_LDB(B1, 0, 1); PG8_STAGE(PG8_SB(0, 0), b2, voffB);
            PG8_BAR; PG8_WAIT_L(0); PG8_MMA(0, 1, At, B1); PG8_BAR;
            PG8_LDA(At, 0, 1); PG8_STAGE(PG8_SA(0, 0), a2, voffA);
            PG8_BAR; PG8_WAIT_L(0); PG8_MMA(1, 0, At, B0); PG8_BAR; PG8_SCHED;
            PG8_STAGE(PG8_SB(0, 1), b2 + hstep, voffB);
            PG8_WAIT_V(6); PG8_BAR; PG8_MMA(1, 1, At, B1); PG8_BAR;
            PG8_LDB(B0, 1, 0); PG8_SCHED; PG8_LDA(At, 1, 0); PG8_STAGE(PG8_SA(0, 1), a2 + hstep, voffA);
            PG8_WAIT_L(8); PG8_BAR; PG8_WAIT_L(0); PG8_MMA(0, 0, At, B0); PG8_BAR; PG8_SCHED;
            PG8_LDB(B1, 1, 1); PG8_STAGE(PG8_SB(1, 0), b3, voffB);
            PG8_BAR; PG8_WAIT_L(0); PG8_MMA(0, 1, At, B1); PG8_BAR;
            PG8_LDA(At, 1, 1); PG8_STAGE(PG8_SA(1, 0), a3, voffA);
            PG8_BAR; PG8_WAIT_L(0); PG8_MMA(1, 0, At, B0); PG8_BAR; PG8_SCHED;
            PG8_STAGE(PG8_SB(1, 1), b3 + hstep, voffB);
            PG8_WAIT_V(6); PG8_BAR; PG8_MMA(1, 1, At, B1); PG8_BAR;
            }
        }
        if constexpr (ALIGN_EPI) { if (wr == 0) PG8_BAR; }
        if constexpr (!Epi::AFTER_DRAIN) { E(acc, cur, wr, wc, fr, fq); S.done(cur); }
        if (!has_next) break;
#pragma unroll
        for (int a = 0; a < 2; ++a)
#pragma unroll
            for (int b = 0; b < 2; ++b)
#pragma unroll
                for (int m = 0; m < 4; ++m)
#pragma unroll
                    for (int n = 0; n < 2; ++n) acc[a][b][m][n] = (f32x4){0.f, 0.f, 0.f, 0.f};
        cur = nxt; cA = nA; cB = nB; ++ui;
        if constexpr (ALIGN_EPI) { if (wr == 1) PG8_BAR; }
    }
    PG8_WAIT_V(0);
    if constexpr (!ALIGN_EPI) { if (wr == 0) PG8_BAR; }
    PG8_BAR;
    if constexpr (Epi::AFTER_DRAIN) { E.fused(acc, cur, wr, wc, fr, fq, lds, wid, lane); S.done(cur); }
#undef PG8_SA
#undef PG8_SB
#undef PG8_STAGE
#undef PG8_LDA
#undef PG8_LDB
#undef PG8_MMA
#undef PG8_WAIT_V
#undef PG8_WAIT_L
#undef PG8_WAIT_V8R
#undef PG8_BAR
#undef PG8_SCHED
}
template <class Epi, class Sched, bool ALIGN_EPI = false, bool SP2 = false>
__device__ __forceinline__ void gemm_phase_i8(PG8_LAS unsigned char* lds, const Gemm g, const Sched& S, const Epi& E) {
    const int tid = threadIdx.x, wid = __builtin_amdgcn_readfirstlane(tid >> 6), lane = tid & 63, wr = wid >> 2, wc = wid & 3, fr = lane & 15, fq = lane >> 4;
    const int K = g.K, nt = K / 128;
    unsigned voffA[2], voffB[2];
#pragma unroll
    for (int i = 0; i < 2; ++i) { int R, C; stage_rc(tid * 16 + i * 8192, R, C); const int Rb = Epi::PERM ? ((R & ~31) + perm32(R & 31)) : R;
        voffA[i] = (unsigned)(R * K + C * 2); voffB[i] = (unsigned)(Rb * K + C * 2); }
    const size_t kstep = (size_t)(BK * 2);
    const size_t hstep = (size_t)HALF * K;
    const size_t tstep = 2 * hstep;
    const unsigned ldsw = (unsigned)wid * 1024u;
    const int aoff = lds_byte(wr * 64 + fr, fq * 8), boff = lds_byte(wc * 32 + fr, fq * 8);
#define PG8_SA(b, h) (((b) * 2 + (h)) * HTB)
#define PG8_SB(b, h) ((4 + (b) * 2 + (h)) * HTB)
#define PG8_STAGE(bufoff, gbase, voff) do { _Pragma("unroll") for (int _i = 0; _i < 2; ++_i) \
        __builtin_amdgcn_global_load_lds((const unsigned*)((const char*)(gbase) + (voff)[_i]), (PG8_LAS unsigned*)(lds + (bufoff) + ldsw + _i * 8192), 16, 0, 0); } while (0)
#define PG8_LDA(dst, b, h) do { _Pragma("unroll") for (int m = 0; m < 4; ++m) _Pragma("unroll") for (int k = 0; k < 2; ++k) dst[m][k] = *(const PG8_LAS bf16x8*)(lds + PG8_SA(b, h) + aoff + m * 2048 + k * 1024); } while (0)
#define PG8_LDB(dst, b, h) do { _Pragma("unroll") for (int n = 0; n < 2; ++n) _Pragma("unroll") for (int k = 0; k < 2; ++k) dst[n][k] = *(const PG8_LAS bf16x8*)(lds + PG8_SB(b, h) + boff + n * 2048 + k * 1024); } while (0)
#define PG8_MMA(ai, bj, At, Bt) do { __builtin_amdgcn_s_setprio(1); _Pragma("unroll") for (int m = 0; m < 4; ++m) _Pragma("unroll") for (int n = 0; n < 2; ++n) _Pragma("unroll") for (int k = 0; k < 2; ++k) \
        acc[ai][bj][m][n] = __builtin_amdgcn_mfma_i32_16x16x64_i8(__builtin_bit_cast(i32x4, Bt[n][k]), __builtin_bit_cast(i32x4, At[m][k]), acc[ai][bj][m][n], 0, 0, 0); __builtin_amdgcn_s_setprio(0); } while (0)
#define PG8_WAIT_V(n) asm volatile("s_waitcnt vmcnt(" #n ")" ::: "memory")
#define PG8_WAIT_L(n) asm volatile("s_waitcnt lgkmcnt(" #n ")" ::: "memory")
#define PG8_WAIT_V8R(rx) asm volatile("s_waitcnt vmcnt(%1)\n\ts_cmp_lg_u32 %0, 0\n\ts_cbranch_scc1 .Lpg8w_%=\n\ts_waitcnt vmcnt(8)\n.Lpg8w_%=:" :: "s"(rx), "n"(8 + Epi::NSTORE) : "scc", "memory")
#define PG8_BAR __builtin_amdgcn_s_barrier()
#define PG8_SCHED __builtin_amdgcn_sched_barrier(0)
    Unit cur, nxt; int ui = 0;
    if (!S.next(0, cur)) return;
    i32x4 acc[2][2][4][2];
#pragma unroll
    for (int a = 0; a < 2; ++a)
#pragma unroll
        for (int b = 0; b < 2; ++b)
#pragma unroll
            for (int m = 0; m < 4; ++m)
#pragma unroll
                for (int n = 0; n < 2; ++n) acc[a][b][m][n] = (i32x4){0, 0, 0, 0};
    bf16x8 At[4][2], B0[2][2], B1[2][2];
    const char* cA = (const char*)g.A + (size_t)cur.pm * tstep; const char* cB = (const char*)g.Bt + (size_t)cur.pb * tstep;
    S.a_ready(cur);
    if constexpr (SP2) {
        PG8_STAGE(PG8_SB(0, 0), cB, voffB); PG8_STAGE(PG8_SB(0, 1), cB + hstep, voffB); PG8_STAGE(PG8_SA(0, 0), cA, voffA); PG8_STAGE(PG8_SA(0, 1), cA + hstep, voffA);
        if (wr == 1) PG8_BAR;
        PG8_WAIT_V(2); PG8_BAR;
        PG8_STAGE(PG8_SB(1, 0), cB + kstep, voffB); PG8_STAGE(PG8_SA(1, 0), cA + kstep, voffA); PG8_STAGE(PG8_SB(1, 1), cB + hstep + kstep, voffB);
        PG8_WAIT_V(6); PG8_BAR;
    } else {
        PG8_STAGE(PG8_SB(0, 0), cB, voffB); PG8_STAGE(PG8_SA(0, 0), cA, voffA); PG8_STAGE(PG8_SB(0, 1), cB + hstep, voffB); PG8_STAGE(PG8_SA(0, 1), cA + hstep, voffA);
        if (wr == 1) PG8_BAR;
        PG8_WAIT_V(4); PG8_BAR;
        PG8_STAGE(PG8_SB(1, 0), cB + kstep, voffB); PG8_STAGE(PG8_SA(1, 0), cA + kstep, voffA); PG8_STAGE(PG8_SB(1, 1), cB + hstep + kstep, voffB);
        PG8_WAIT_V(6); PG8_BAR;
    }
    for (;;) {
        const bool has_next = S.next(ui + 1, nxt);
        const char* nA = has_next ? (const char*)g.A + (size_t)nxt.pm * tstep : cA; const char* nB = has_next ? (const char*)g.Bt + (size_t)nxt.pb * tstep : cB;
        for (int t = 0; t < nt; t += 2) {
            const bool last = (t == nt - 2);
            const char* a1 = cA + (size_t)(t + 1) * kstep;
            const char* a2 = last ? nA : cA + (size_t)(t + 2) * kstep; const char* b2 = last ? nB : cB + (size_t)(t + 2) * kstep;
            const char* a3 = a2 + kstep; const char* b3 = b2 + kstep;
            if (last && has_next) S.a_ready(nxt);
            const int relax = __builtin_amdgcn_readfirstlane(((t == 0) && (ui > 0)) ? 1 : 0);
            if constexpr (SP2) {
            PG8_LDB(B0, 0, 0); PG8_LDB(B1, 0, 1); PG8_SCHED; PG8_LDA(At, 0, 0); PG8_STAGE(PG8_SA(1, 1), a1 + hstep, voffA);
            PG8_WAIT_V8R(relax); PG8_WAIT_L(0); PG8_BAR; PG8_MMA(0, 0, At, B0); PG8_MMA(0, 1, At, B1); PG8_BAR; PG8_SCHED;
            PG8_LDA(At, 0, 1); PG8_STAGE(PG8_SB(0, 0), b2, voffB); PG8_STAGE(PG8_SB(0, 1), b2 + hstep, voffB); PG8_STAGE(PG8_SA(0, 0), a2, voffA);
            PG8_WAIT_V8R(relax); PG8_WAIT_L(0); PG8_BAR; PG8_MMA(1, 0, At, B0); PG8_MMA(1, 1, At, B1); PG8_BAR; PG8_SCHED;
            PG8_LDB(B0, 1, 0); PG8_LDB(B1, 1, 1); PG8_SCHED; PG8_LDA(At, 1, 0); PG8_STAGE(PG8_SA(0, 1), a2 + hstep, voffA);
            PG8_WAIT_V(8); PG8_WAIT_L(0); PG8_BAR; PG8_MMA(0, 0, At, B0); PG8_MMA(0, 1, At, B1); PG8_BAR; PG8_SCHED;
            PG8_LDA(At, 1, 1); PG8_STAGE(PG8_SB(1, 0), b3, voffB); PG8_STAGE(PG8_SB(1, 1), b3 + hstep, voffB); PG8_STAGE(PG8_SA(1, 0), a3, voffA);
            PG8_WAIT_V(8); PG8_WAIT_L(0); PG8_BAR; PG8_MMA(1, 0, At, B0); PG8_MMA(1, 1, At, B1); PG8_BAR; PG8_SCHED;
            } else {
            PG8_LDB(B0, 0, 0); PG8_SCHED; PG8_LDA(At, 0, 0); PG8_STAGE(PG8_SA(1, 1), a1 + hstep, voffA);
            PG8_WAIT_L(8); PG8_BAR; PG8_WAIT_L(0); PG8_MMA(0, 0, At, B0); PG8_BAR; PG8_SCHED;
            PG8_LDB(B1, 0, 1); PG8_STAGE(PG8_SB(0, 0), b2, voffB);
            PG8_BAR; PG8_WAIT_L(0); PG8_MMA(0, 1, At, B1); PG8_BAR;
            PG8_LDA(At, 0, 1); PG8_STAGE(PG8_SA(0, 0), a2, voffA);
            PG8_BAR; PG8_WAIT_L(0); PG8_MMA(1, 0, At, B0); PG8_BAR; PG8_SCHED;
            PG8_STAGE(PG8_SB(0, 1), b2 + hstep, voffB);
            PG8_WAIT_V(6); PG8_BAR; PG8_MMA(1, 1, At, B1); PG8_BAR;
            PG8_LDB(B0, 1, 0); PG8_SCHED; PG8_LDA(At, 1, 0); PG8_STAGE(PG8_SA(0, 1), a2 + hstep, voffA);
            PG8_WAIT_L(8); PG8_BAR; PG8_WAIT_L(0); PG8_MMA(0, 0, At, B0); PG8_BAR; PG8_SCHED;
            PG8_LDB(B1, 1, 1); PG8_STAGE(PG8_SB(1, 0), b3, voffB);
            PG8_BAR; PG8_WAIT_L(0); PG8_MMA(0, 1, At, B1); PG8_BAR;
            PG8_LDA(At, 1, 1); PG8_STAGE(PG8_SA(1, 0), a3, voffA);
            PG8_BAR; PG8_WAIT_L(0); PG8_MMA(1, 0, At, B0); PG8_BAR; PG8_SCHED;
            PG8_STAGE(PG8_SB(1, 1), b3 + hstep, voffB);
            PG8_WAIT_V(6); PG8_BAR; PG8_MMA(1, 1, At, B1); PG8_BAR;
            }
        }
        if constexpr (ALIGN_EPI) { if (wr == 0) PG8_BAR; }
        if constexpr (!Epi::AFTER_DRAIN) { E(acc, cur, wr, wc, fr, fq); S.done(cur); }
        if (!has_next) break;
#pragma unroll
        for (int a = 0; a < 2; ++a)
#pragma unroll
            for (int b = 0; b < 2; ++b)
#pragma unroll
                for (int m = 0; m < 4; ++m)
#pragma unroll
                    for (int n = 0; n < 2; ++n) acc[a][b][m][n] = (i32x4){0, 0, 0, 0};
        cur = nxt; cA = nA; cB = nB; ++ui;
        if constexpr (ALIGN_EPI) { if (wr == 1) PG8_BAR; }
    }
    PG8_WAIT_V(0);
    if constexpr (!ALIGN_EPI) { if (wr == 0) PG8_BAR; }
    PG8_BAR;
    if constexpr (Epi::AFTER_DRAIN) { E.fused(acc, cur, wr, wc, fr, fq, lds, wid, lane); S.done(cur); }
#undef PG8_SA
#undef PG8_SB
#undef PG8_STAGE
#undef PG8_LDA
#undef PG8_LDB
#undef PG8_MMA
#undef PG8_WAIT_V
#undef PG8_WAIT_L
#undef PG8_WAIT_V8R
#undef PG8_BAR
#undef PG8_SCHED
}

}
#ifndef STAGE_REP
#define STAGE_REP 0
#endif

constexpr int NWAVES = 8;
#ifndef SEAM_FILL
#define SEAM_FILL 1
#endif
constexpr int D = 1024, BATCH = 2, T = 8192, TC = 256, NH = 16;
constexpr int ML = BATCH * T;
constexpr int MC = BATCH * TC;
constexpr int MT = ML + MC;
constexpr int N_IN = 8576, NZ = 8704;
constexpr int K_OFF = 0, V_OFF = 1024, DECAY_OFF = 2048, ICLR_OFF = 2176, STATE_COLS = 2304, R_OFF = 2304, GLORA_OFF = 3328, SHIFT_COLS = 3456;
constexpr int CONV_OFF = 3456, GATE_OFF = 6528;
constexpr int NE = 32, TOPK = 4, DFF = 1024;
constexpr int NL = 5120, KL = 384;
constexpr int MAXBLK = 288;
constexpr int NROWS = MAXBLK * 256;
constexpr int KSPLIT = 16;

constexpr size_t MiB = 1u << 20;
constexpr size_t WS_CTL = 0, CTL_ZERO_BYTES = 1 * MiB;
constexpr size_t WS_MODP = 1 * MiB;
constexpr size_t WS_WLORA = 3 * MiB;
constexpr size_t WS_WROUT = 7 * MiB;
constexpr size_t WS_WOUT = 8 * MiB;
constexpr size_t WS_WIN = 10 * MiB;
constexpr size_t WS_A0 = 28 * MiB;
constexpr size_t WS_MISC = 61 * MiB;
constexpr size_t WS_Z = 64 * MiB;
constexpr size_t WS_AL = 345 * MiB;
constexpr size_t WS_LORA = 358 * MiB;
constexpr size_t WS_SCAN = 523 * MiB;
constexpr size_t WS_Y = 886 * MiB;
constexpr size_t WS_END = 1014 * MiB;
constexpr size_t WS_PQ = WS_SCAN;
constexpr size_t WS_TKN = WS_PQ + 132 * MiB;
constexpr size_t WS_UPRE = WS_TKN + 66 * MiB;
constexpr size_t WS_H0T = WS_UPRE + 66 * MiB;
static_assert(WS_H0T + 64 * MiB <= WS_Y, "scan region");
constexpr size_t WS_MIX = WS_LORA, WS_X1 = WS_LORA + 64 * MiB, WS_H2 = WS_LORA + 128 * MiB;
constexpr size_t WS_LOGIT = WS_SCAN, WS_XB = WS_SCAN + 16 * MiB, WS_ACT = WS_XB + 144 * MiB;
constexpr size_t WS_Y2 = WS_Z, WS_WEIN = WS_Y, WS_WEOUT = WS_Y + 64 * MiB;
static_assert(WS_ACT + 144 * MiB <= WS_Y && WS_WEIN + 64 * MiB <= WS_WEOUT && WS_WEOUT + 64 * MiB <= WS_END, "late regions");
constexpr size_t MI_SELE = WS_MISC, MI_SELP = MI_SELE + (size_t)ML * 4 * 4, MI_GATE = MI_SELP + (size_t)ML * 4 * 4, MI_DEST = MI_GATE + (size_t)ML * 4 * 4, MI_BLKE = MI_DEST + (size_t)ML * 4 * 4;
constexpr size_t MI_RSH = MI_BLKE + 4096;
constexpr size_t MI_CSWIN = MI_RSH + (size_t)MT * 4;
constexpr size_t MI_RSH2 = MI_CSWIN + (size_t)NZ * 4;
constexpr size_t MI_RSXB = MI_RSH2 + (size_t)ML * 4;
constexpr size_t MI_CSWEI = MI_RSXB + (size_t)NROWS * 4;
constexpr size_t MI_BON = MI_CSWEI + (size_t)NE * 2048 * 4;
static_assert(MI_BON + (size_t)4096 * 64 * 4 <= WS_Z && MI_RSH % 16 == 0 && MI_CSWIN % 16 == 0 && MI_CSWEI % 16 == 0, "misc");
constexpr size_t WS_H2Q = WS_A0;
constexpr int CW_BAR = 4096;
constexpr int CW_CNT = 16384;
constexpr int CW_FB = 8192;
constexpr int CW_Q6 = CW_CNT + 64 * 40;

constexpr int RING_OFF = 0, RING_BYTES = 131072;
constexpr int LDSCTL_OFF = 147456, MISC_OFF = LDSCTL_OFF + 320;
constexpr int LDS_X_OFF = LDSCTL_OFF + 512;
constexpr int LDS_BYTES = 163840;

#define GAS __attribute__((address_space(1)))
#define LAS __attribute__((address_space(3)))
typedef unsigned short bf16;
typedef unsigned v4u __attribute__((ext_vector_type(4)));
typedef unsigned v2u __attribute__((ext_vector_type(2)));
typedef float f32x4 __attribute__((ext_vector_type(4)));
#define LDS_WAIT() asm volatile("s_waitcnt lgkmcnt(0)" ::: "memory")
#define VM_WAIT() asm volatile("s_waitcnt vmcnt(0)" ::: "memory")
__device__ __forceinline__ unsigned f2bf(float f) { unsigned u = __builtin_bit_cast(unsigned, f); return (u + 0x7fffu + ((u >> 16) & 1u)) >> 16; }
__device__ __forceinline__ unsigned pk2(float lo, float hi) { return f2bf(lo) | (f2bf(hi) << 16); }
typedef __bf16 bf16v2h_t __attribute__((ext_vector_type(2)));
__device__ __forceinline__ unsigned pk2h(float lo, float hi) { const bf16v2h_t v = {(__bf16)lo, (__bf16)hi}; return __builtin_bit_cast(unsigned, v); }
__device__ __forceinline__ float bflo(unsigned w) { return __builtin_bit_cast(float, w << 16); }
__device__ __forceinline__ float bfhi(unsigned w) { return __builtin_bit_cast(float, w & 0xffff0000u); }
__device__ __forceinline__ float bf1(bf16 h) { return __builtin_bit_cast(float, (unsigned)h << 16); }
__device__ __forceinline__ void ld16bf(const bf16* p, float (&o)[16]) {
    const v4u a = *(const v4u*)p, b = *(const v4u*)(p + 8);
    o[0] = bflo(a.x); o[1] = bfhi(a.x); o[2] = bflo(a.y); o[3] = bfhi(a.y); o[4] = bflo(a.z); o[5] = bfhi(a.z); o[6] = bflo(a.w); o[7] = bfhi(a.w);
    o[8] = bflo(b.x); o[9] = bfhi(b.x); o[10] = bflo(b.y); o[11] = bfhi(b.y); o[12] = bflo(b.z); o[13] = bfhi(b.z); o[14] = bflo(b.w); o[15] = bfhi(b.w);
}
__device__ __forceinline__ void st16bf(bf16* p, const float (&o)[16]) {
    v4u a, b; a.x = pk2(o[0], o[1]); a.y = pk2(o[2], o[3]); a.z = pk2(o[4], o[5]); a.w = pk2(o[6], o[7]);
    b.x = pk2(o[8], o[9]); b.y = pk2(o[10], o[11]); b.z = pk2(o[12], o[13]); b.w = pk2(o[14], o[15]);
    *(v4u*)p = a; *(v4u*)(p + 8) = b;
}
__device__ __forceinline__ void ld16f(const float* p, float (&o)[16]) {
#pragma unroll
    for (int q = 0; q < 4; ++q) { const f32x4 v = *(const f32x4*)(p + 4 * q); o[4 * q] = v.x; o[4 * q + 1] = v.y; o[4 * q + 2] = v.z; o[4 * q + 3] = v.w; }
}
__device__ __forceinline__ void ld16f_lds(const LAS float* p, float (&o)[16]) {
#pragma unroll
    for (int q = 0; q < 4; ++q) { const f32x4 v = *(const LAS f32x4*)(p + 4 * q); o[4 * q] = v.x; o[4 * q + 1] = v.y; o[4 * q + 2] = v.z; o[4 * q + 3] = v.w; }
}
__device__ __forceinline__ void st16f(float* p, const float (&o)[16]) {
#pragma unroll
    for (int q = 0; q < 4; ++q) *(f32x4*)(p + 4 * q) = (f32x4){o[4 * q], o[4 * q + 1], o[4 * q + 2], o[4 * q + 3]};
}
__device__ __forceinline__ float sigmoidf_(float x) { return 1.0f / (1.0f + __expf(-x)); }
__device__ __forceinline__ float wave_sum(float v) {
#pragma unroll
    for (int o = 1; o < 64; o <<= 1) v += __shfl_xor(v, o);
    return v;
}
__device__ __forceinline__ float wave_max(float v) {
#pragma unroll
    for (int o = 1; o < 64; o <<= 1) v = fmaxf(v, __shfl_xor(v, o));
    return v;
}
__device__ __forceinline__ unsigned pack_q4(float a, float b, float c, float d) {
    const int qa = __float2int_rn(a), qb = __float2int_rn(b), qc = __float2int_rn(c), qd = __float2int_rn(d);
    return (unsigned)(qa & 255) | ((unsigned)(qb & 255) << 8) | ((unsigned)(qc & 255) << 16) | ((unsigned)qd << 24);
}
__device__ __forceinline__ float quad_sum(float v) { v += __shfl_xor(v, 1); v += __shfl_xor(v, 2); return v; }

#define XB_TMO      128
#define XB_XCNT(j)  (256  + 64 * (j))
#define XB_XSUB(j)  (1280 + 64 * (j))
#define XB_XGEN(j)  (2304 + 64 * (j))
#define XB_TOP      3328
#define XB_TOPGEN   3392
#define XCD_BAR_WORDS 3456
#define XB_SPIN_CAP (1u << 18)

__device__ __forceinline__ unsigned xb_ld(unsigned* p)              { return __hip_atomic_load(p, __ATOMIC_RELAXED, __HIP_MEMORY_SCOPE_AGENT); }
__device__ __forceinline__ unsigned xb_add(unsigned* p, unsigned v) { return __hip_atomic_fetch_add(p, v, __ATOMIC_RELAXED, __HIP_MEMORY_SCOPE_AGENT); }
__device__ __forceinline__ unsigned xb_xcc_id() { return (unsigned)__builtin_amdgcn_s_getreg((3 << 11) | 20) & 0xFu; }
#define XB_SPIN(cond, bar) do { unsigned _sp = 0; while (cond) { __builtin_amdgcn_s_sleep(1); \
    if ((++_sp & 255u) == 0u) { if (xb_ld(&(bar)[XB_TMO])) break; if (_sp > XB_SPIN_CAP) { atomicAdd(&(bar)[XB_TMO], 1u); break; } } } } while (0)

struct XcdBarrier { unsigned* bar; unsigned x; volatile LAS unsigned* st; };

__device__ __forceinline__ XcdBarrier xcd_barrier_post(unsigned* bar, volatile LAS unsigned* st) {
    XcdBarrier b; b.bar = bar; b.x = xb_xcc_id(); b.st = st;
    if (threadIdx.x == 0) (void)xb_add(&bar[XB_XCNT(b.x)], 1u);
    return b;
}
__device__ __forceinline__ void xcd_barrier_complete(unsigned* bar, unsigned x, unsigned& nloc, unsigned& nx) {
    const unsigned G = gridDim.x * gridDim.y * gridDim.z;
    unsigned sum, cnt, mine, sp = 0u;
    for (;;) {
        sum = 0u; cnt = 0u; mine = 0u;
#pragma unroll
        for (unsigned j = 0; j < 16; ++j) { const unsigned c = xb_ld(&bar[XB_XCNT(j)]); sum += c; cnt += (c > 0u) ? 1u : 0u; mine = (j == x) ? c : mine; }
        if (sum == G) break;
        __builtin_amdgcn_s_sleep(1);
        if ((++sp & 255u) == 0u) { if (xb_ld(&bar[XB_TMO])) break; if (sp > XB_SPIN_CAP) { atomicAdd(&bar[XB_TMO], 1u); break; } }
    }
    nloc = mine > 0u ? mine : 1u; nx = cnt > 0u ? cnt : 1u;
}
__device__ __forceinline__ void xcd_barrier(const XcdBarrier& b) {
    asm volatile("s_waitcnt vmcnt(0)" ::: "memory");
    __syncthreads();
    if (threadIdx.x == 0) {
        unsigned* bar = b.bar;
        __builtin_amdgcn_s_waitcnt(0);
        unsigned nloc = b.st[0], nx = b.st[1];
        if (nloc == 0u) { xcd_barrier_complete(bar, b.x, nloc, nx); b.st[0] = nloc; b.st[1] = nx; }
        const unsigned old = xb_add(&bar[XB_XSUB(b.x)], 1u);
        const unsigned gen = old / nloc;
        if (old + 1u == (gen + 1u) * nloc) {
            __builtin_amdgcn_fence(__ATOMIC_RELEASE, "agent");
            asm volatile("s_waitcnt vmcnt(0)" ::: "memory");
            const unsigned og = xb_add(&bar[XB_TOP], 1u);
            const unsigned tg = og / nx;
            if (og + 1u == (tg + 1u) * nx) xb_add(&bar[XB_TOPGEN], 1u);
            else XB_SPIN(xb_ld(&bar[XB_TOPGEN]) == tg, bar);
            __builtin_amdgcn_fence(__ATOMIC_ACQUIRE, "agent");
            xb_add(&bar[XB_XGEN(b.x)], 1u);
            asm volatile("s_waitcnt vmcnt(0)" ::: "memory");
        } else {
            XB_SPIN(xb_ld(&bar[XB_XGEN(b.x)]) == gen, bar);
            __builtin_amdgcn_fence(__ATOMIC_ACQUIRE, "agent");
            asm volatile("s_waitcnt vmcnt(0)" ::: "memory");
        }
    }
    __syncthreads();
}

#define XB_DONE(j)  (3456 + 64 * (j))
__device__ __forceinline__ void xcd_barrier2(const XcdBarrier& b) {
    asm volatile("s_waitcnt vmcnt(0)" ::: "memory");
    __syncthreads();
    if (threadIdx.x == 0) {
        unsigned* bar = b.bar;
        __builtin_amdgcn_s_waitcnt(0);
        unsigned nloc = b.st[0], nx = b.st[1];
        if (nloc == 0u) { xcd_barrier_complete(bar, b.x, nloc, nx); b.st[0] = nloc; b.st[1] = nx; }
        const unsigned old = xb_add(&bar[XB_XSUB(b.x)], 1u);
        const unsigned gen = old / nloc;
        if (old + 1u == (gen + 1u) * nloc) {
            __builtin_amdgcn_fence(__ATOMIC_RELEASE, "agent");
            asm volatile("s_waitcnt vmcnt(0)" ::: "memory");
#pragma unroll
            for (unsigned j = 0; j < 16; ++j) (void)xb_add(&bar[XB_DONE(j)], 1u);
        }
        XB_SPIN(xb_ld(&bar[XB_DONE(b.x)]) < (gen + 1u) * nx, bar);
        __builtin_amdgcn_fence(__ATOMIC_ACQUIRE, "agent");
        asm volatile("s_waitcnt vmcnt(0)" ::: "memory");
    }
    __syncthreads();
}

__device__ __forceinline__ void xcd_barrier2_arrive(const XcdBarrier& b) {
    asm volatile("s_waitcnt vmcnt(0)" ::: "memory");
    __syncthreads();
    if (threadIdx.x == 0) {
        unsigned* bar = b.bar;
        __builtin_amdgcn_s_waitcnt(0);
        unsigned nloc = b.st[0], nx = b.st[1];
        if (nloc == 0u) { xcd_barrier_complete(bar, b.x, nloc, nx); b.st[0] = nloc; b.st[1] = nx; }
        const unsigned old = xb_add(&bar[XB_XSUB(b.x)], 1u);
        const unsigned gen = old / nloc;
        if (old + 1u == (gen + 1u) * nloc) {
            __builtin_amdgcn_fence(__ATOMIC_RELEASE, "agent");
            asm volatile("s_waitcnt vmcnt(0)" ::: "memory");
#pragma unroll
            for (unsigned j = 0; j < 16; ++j) (void)xb_add(&bar[XB_DONE(j)], 1u);
        }
        b.st[2] = gen;
    }
}
__device__ __forceinline__ void xcd_barrier2_wait(const XcdBarrier& b) {
    asm volatile("s_waitcnt vmcnt(0)" ::: "memory");
    if (threadIdx.x == 0) {
        unsigned* bar = b.bar;
        const unsigned gen = b.st[2], nx = b.st[1];
        XB_SPIN(xb_ld(&bar[XB_DONE(b.x)]) < (gen + 1u) * nx, bar);
        __builtin_amdgcn_fence(__ATOMIC_ACQUIRE, "agent");
        asm volatile("s_waitcnt vmcnt(0)" ::: "memory");
    }
    __syncthreads();
}

#define FB_WORD(j) (64 * (j))
#define FB_TMO 640
__device__ __forceinline__ void flat_barrier(unsigned* fb, unsigned epoch) {
    asm volatile("s_waitcnt vmcnt(0)" ::: "memory");
    __syncthreads();
    if (threadIdx.x == 0) {
        __builtin_amdgcn_s_waitcnt(0);
        __builtin_amdgcn_fence(__ATOMIC_RELEASE, "agent");
        asm volatile("s_waitcnt vmcnt(0)" ::: "memory");
        (void)xb_add(&fb[FB_WORD(blockIdx.x & 7u)], 1u);
        const unsigned want = epoch * gridDim.x; unsigned sp = 0u;
        for (;;) {
            unsigned s = 0u;
#pragma unroll
            for (int j = 0; j < 8; ++j) s += xb_ld(&fb[FB_WORD(j)]);
            if (s >= want) break;
            __builtin_amdgcn_s_sleep(1);
            if ((++sp & 255u) == 0u) { if (xb_ld(&fb[FB_TMO])) break; if (sp > XB_SPIN_CAP) { atomicAdd(&fb[FB_TMO], 1u); break; } }
        }
        __builtin_amdgcn_fence(__ATOMIC_ACQUIRE, "agent");
        asm volatile("s_waitcnt vmcnt(0)" ::: "memory");
    }
    __syncthreads();
}

struct Frame {
    LAS unsigned char* lds;
    volatile LAS unsigned* MISC;
    unsigned* ctl;
    int tid, lane, wave, G, gw, NGW, vb;
    float* out;
    unsigned char* ws;
};
enum { I_X = 0, I_C, I_CTX, I_CCTX, I_WADA, I_BADA, I_NPM, I_NQM, I_NPF, I_NQF, I_WIN, I_MU, I_W0, I_WDU, I_A0, I_WIU, I_KK, I_KA, I_RK, I_WGU, I_LNW, I_LNB, I_CONVW,
       I_WOUT, I_WR, I_BR, I_WEI, I_BEI, I_WEO, I_BEO };


typedef const float* fptr_t;
__device__ __forceinline__ fptr_t kin_ptr(int i) { const volatile __attribute__((address_space(4))) fptr_t* ka = (const volatile __attribute__((address_space(4))) fptr_t*)__builtin_amdgcn_kernarg_segment_ptr(); return ka[i]; }
#define KIN(i) kin_ptr(i)
__device__ __forceinline__ void transpose_item(const float* W, int N, int k0, int n0, bf16* WT, int ldk, int rowbase, LAS float* scr, int lane) {
#pragma unroll 8
    for (int i = 0; i < 32; ++i) { const int kk = 2 * i + (lane >> 5); scr[kk * 33 + (lane & 31)] = W[(size_t)(k0 + kk) * N + n0 + (lane & 31)]; }
    LDS_WAIT(); asm volatile("" ::: "memory");
    const int c = lane & 7;
#pragma unroll
    for (int j = 0; j < 4; ++j) { const int n = (lane >> 3) + 8 * j; const LAS float* s = scr + (8 * c) * 33 + n;
        v4u o; o.x = pk2(s[0 * 33], s[1 * 33]); o.y = pk2(s[2 * 33], s[3 * 33]); o.z = pk2(s[4 * 33], s[5 * 33]); o.w = pk2(s[6 * 33], s[7 * 33]);
        *(v4u*)(WT + (size_t)(rowbase + n) * ldk + k0 + 8 * c) = o; }
    LDS_WAIT(); asm volatile("" ::: "memory");
}

__device__ __forceinline__ unsigned pack_q4c(float a, float b, float c, float d) {
    const int qa = __float2int_rn(fminf(fmaxf(a, -127.f), 127.f)), qb = __float2int_rn(fminf(fmaxf(b, -127.f), 127.f)), qc = __float2int_rn(fminf(fmaxf(c, -127.f), 127.f)), qd = __float2int_rn(fminf(fmaxf(d, -127.f), 127.f));
    return (unsigned)(qa & 255) | ((unsigned)(qb & 255) << 8) | ((unsigned)(qc & 255) << 16) | ((unsigned)qd << 24);
}
__device__ __forceinline__ void q8_item(const float* W, int N, int n0, signed char* WT, float* cs, int rowbase, LAS float* scr, int lane, int kb0 = 0, int kb1 = 16) {
    const int r8 = lane >> 3, c4 = lane & 7;
    const float* p0 = W + (size_t)r8 * N + n0 + 4 * c4;
    f32x4 ss = {0.f, 0.f, 0.f, 0.f};
#pragma unroll
    for (int hb = 0; hb < 2; ++hb) {
        f32x4 v[16];
#pragma unroll
        for (int i = 0; i < 16; ++i) v[i] = *(const f32x4*)(p0 + (size_t)(8 * (16 * hb + i)) * N);
        __builtin_amdgcn_sched_barrier(0);
#pragma unroll
        for (int i = 0; i < 16; ++i) ss += v[i] * v[i];
    }
#pragma unroll
    for (int o = 8; o < 64; o <<= 1) { ss.x += __shfl_xor(ss.x, o); ss.y += __shfl_xor(ss.y, o); ss.z += __shfl_xor(ss.z, o); ss.w += __shfl_xor(ss.w, o); }
    if (lane < 8) {
#pragma unroll
        for (int q = 0; q < 4; ++q) { const float m = 6.0f * sqrtf(ss[q] * (1.0f / 256.0f)); cs[rowbase + 4 * lane + q] = m * (1.0f / 127.0f); scr[2112 + 4 * lane + q] = m > 0.f ? 127.0f / m : 0.f; } }
    LDS_WAIT(); asm volatile("" ::: "memory");
    f32x4 cur[8];
#pragma unroll
    for (int i = 0; i < 8; ++i) cur[i] = *(const f32x4*)(p0 + (size_t)(64 * kb0 + 8 * i) * N);
    for (int kb = kb0; kb < kb1; ++kb) {
        f32x4 nxt[8];
        const int kn = kb < kb1 - 1 ? kb + 1 : kb;
#pragma unroll
        for (int i = 0; i < 8; ++i) nxt[i] = *(const f32x4*)(p0 + (size_t)(64 * kn + 8 * i) * N);
#pragma unroll
        for (int i = 0; i < 8; ++i) { LAS float* s = scr + (r8 + 8 * i) * 33 + 4 * c4; s[0] = cur[i].x; s[1] = cur[i].y; s[2] = cur[i].z; s[3] = cur[i].w; }
        LDS_WAIT(); asm volatile("" ::: "memory");
        const int c = lane & 3;
#pragma unroll
        for (int j = 0; j < 2; ++j) { const int n = (lane >> 2) + 16 * j; const float iv = scr[2112 + n]; const LAS float* s = scr + (16 * c) * 33 + n;
            v4u o; o.x = pack_q4c(s[0] * iv, s[33] * iv, s[66] * iv, s[99] * iv); o.y = pack_q4c(s[132] * iv, s[165] * iv, s[198] * iv, s[231] * iv);
            o.z = pack_q4c(s[264] * iv, s[297] * iv, s[330] * iv, s[363] * iv); o.w = pack_q4c(s[396] * iv, s[429] * iv, s[462] * iv, s[495] * iv);
            *(v4u*)(WT + (size_t)(rowbase + n) * 1024 + 64 * kb + 16 * c) = o; }
        LDS_WAIT(); asm volatile("" ::: "memory");
#pragma unroll
        for (int i = 0; i < 8; ++i) cur[i] = nxt[i];
    }
}

struct CvTile { f32x4 v[8]; };
__device__ __forceinline__ void cv_load(CvTile& t, const float* W, int N, int n0, int kb, int lane) {
    const float* p0 = W + (size_t)(64 * kb + (lane >> 3)) * N + n0 + 4 * (lane & 7);
#pragma unroll
    for (int i = 0; i < 8; ++i) t.v[i] = *(const f32x4*)(p0 + (size_t)(8 * i) * N);
}
__device__ __forceinline__ void cv_to_lds(const CvTile& t, LAS float* scr, int lane) {
    const int r8 = lane >> 3, c4 = lane & 7;
#pragma unroll
    for (int i = 0; i < 8; ++i) { LAS float* s = scr + (r8 + 8 * i) * 33 + 4 * c4; s[0] = t.v[i].x; s[1] = t.v[i].y; s[2] = t.v[i].z; s[3] = t.v[i].w; }
    LDS_WAIT(); asm volatile("" ::: "memory");
}
__device__ __forceinline__ void cv_store_bf16(const LAS float* scr, bf16* WT, int ldk, int rowbase, int k0, int lane) {
    const int c = lane & 7;
#pragma unroll
    for (int j = 0; j < 4; ++j) { const int n = (lane >> 3) + 8 * j; const LAS float* s = scr + (8 * c) * 33 + n;
        v4u o; o.x = pk2h(s[0 * 33], s[1 * 33]); o.y = pk2h(s[2 * 33], s[3 * 33]); o.z = pk2h(s[4 * 33], s[5 * 33]); o.w = pk2h(s[6 * 33], s[7 * 33]);
        *(v4u*)(WT + (size_t)(rowbase + n) * ldk + k0 + 8 * c) = o; }
    LDS_WAIT(); asm volatile("" ::: "memory");
}
__device__ __forceinline__ unsigned q8_pack4(float a, float b, float c, float d) {
    const float M = 12582912.0f;
    const unsigned x0 = __builtin_bit_cast(unsigned, __builtin_amdgcn_fmed3f(a, -127.f, 127.f) + M), x1 = __builtin_bit_cast(unsigned, __builtin_amdgcn_fmed3f(b, -127.f, 127.f) + M);
    const unsigned x2 = __builtin_bit_cast(unsigned, __builtin_amdgcn_fmed3f(c, -127.f, 127.f) + M), x3 = __builtin_bit_cast(unsigned, __builtin_amdgcn_fmed3f(d, -127.f, 127.f) + M);
    return __builtin_amdgcn_perm(x1, x0, 0x0c0c0400u) | __builtin_amdgcn_perm(x3, x2, 0x04000c0cu);
}
__device__ __forceinline__ void cv_store_q8(const CvTile& t, LAS float* scr, signed char* WT, int rowbase, int kb, const float (&iv)[4], int lane) {
    LAS unsigned* img = (LAS unsigned*)scr;
    const int r8 = lane >> 3, c4 = lane & 7;
#pragma unroll
    for (int i = 0; i < 8; ++i) img[(r8 + 8 * i) * 9 + c4] = q8_pack4(t.v[i].x * iv[0], t.v[i].y * iv[1], t.v[i].z * iv[2], t.v[i].w * iv[3]);
    LDS_WAIT(); asm volatile("" ::: "memory");
    const int c = lane & 3;
#pragma unroll
    for (int j = 0; j < 2; ++j) { const int n = (lane >> 2) + 16 * j; const unsigned bs = (unsigned)(n & 3);
        const unsigned s01 = 0x0c0c0000u | bs | ((4u + bs) << 8), s23 = 0x00000c0cu | (bs << 16) | ((4u + bs) << 24);
        const LAS unsigned* s = img + (16 * c) * 9 + (n >> 2);
        v4u o;
        o.x = __builtin_amdgcn_perm(s[9], s[0], s01) | __builtin_amdgcn_perm(s[27], s[18], s23);
        o.y = __builtin_amdgcn_perm(s[45], s[36], s01) | __builtin_amdgcn_perm(s[63], s[54], s23);
        o.z = __builtin_amdgcn_perm(s[81], s[72], s01) | __builtin_amdgcn_perm(s[99], s[90], s23);
        o.w = __builtin_amdgcn_perm(s[117], s[108], s01) | __builtin_amdgcn_perm(s[135], s[126], s23);
        *(v4u*)(WT + (size_t)(rowbase + n) * 1024 + 64 * kb + 16 * c) = o; }
    LDS_WAIT(); asm volatile("" ::: "memory");
}
__device__ __forceinline__ void cv_scale_q8(const float* W, int N, int n0, float* cs, int rowbase, int lane, float (&iv)[4]) {
    const float* p0 = W + (size_t)(lane >> 3) * N + n0 + 4 * (lane & 7);
    f32x4 ss = {0.f, 0.f, 0.f, 0.f};
#pragma unroll
    for (int hb = 0; hb < 2; ++hb) {
        f32x4 v[16];
#pragma unroll
        for (int i = 0; i < 16; ++i) v[i] = *(const f32x4*)(p0 + (size_t)(8 * (16 * hb + i)) * N);
        __builtin_amdgcn_sched_barrier(0);
#pragma unroll
        for (int i = 0; i < 16; ++i) ss += v[i] * v[i];
    }
#pragma unroll
    for (int o = 8; o < 64; o <<= 1) { ss.x += __shfl_xor(ss.x, o); ss.y += __shfl_xor(ss.y, o); ss.z += __shfl_xor(ss.z, o); ss.w += __shfl_xor(ss.w, o); }
#pragma unroll
    for (int q = 0; q < 4; ++q) { const float m = 6.0f * sqrtf(ss[q] * (1.0f / 256.0f)); if (lane < 8) cs[rowbase + 4 * lane + q] = m * (1.0f / 127.0f); iv[q] = m > 0.f ? 127.0f / m : 0.f; }
}
__device__ __forceinline__ void wei_strip(int s, int& e, int& n0, int& rowbase) { e = s >> 6; n0 = 32 * (s & 63); const int c = n0 & 1023; rowbase = (c >> 7) * 256 + (n0 >= 1024 ? 128 : 0) + (c & 127); }

__device__ __forceinline__ void seam_filler(Frame& F, int s) {
    const int lane = F.lane;
    LAS float* scr = (LAS float*)(F.lds + F.wave * 16384);
    const float* wei = KIN(I_WEI); const float* weo = KIN(I_WEO);
    float* IV = (float*)(F.ws + WS_CTL) + 131072;
    for (int st = F.gw; st < NE * 64; st += F.NGW) {
        int e_, n0_, rb_; wei_strip(st, e_, n0_, rb_);
        const float* W = wei + (size_t)e_ * D * 2048;
        CvTile t0, t1; cv_load(t0, W, 2048, n0_, 2 * s, lane); cv_load(t1, W, 2048, n0_, 2 * s + 1, lane);
        float civ[4];
        if (s == 0) { cv_scale_q8(W, 2048, n0_, (float*)(F.ws + MI_CSWEI) + (size_t)e_ * 2048, rb_, lane, civ);
            if (lane < 8) *(f32x4*)(IV + (size_t)st * 32 + 4 * lane) = (f32x4){civ[0], civ[1], civ[2], civ[3]}; }
        else { const f32x4 v = *(const f32x4*)(IV + (size_t)st * 32 + 4 * (lane & 7)); civ[0] = v.x; civ[1] = v.y; civ[2] = v.z; civ[3] = v.w; }
        cv_store_q8(t0, scr, (signed char*)(F.ws + WS_WEIN) + (size_t)e_ * 2048 * D, rb_, 2 * s, civ, lane);
        cv_store_q8(t1, scr, (signed char*)(F.ws + WS_WEIN) + (size_t)e_ * 2048 * D, rb_, 2 * s + 1, civ, lane);
    }
    bf16* WEO = (bf16*)(F.ws + WS_WEOUT);
    for (int id = F.gw * 8 + s; id < NE * 512; id += F.NGW * 8) {
        const int e_ = id >> 9, q_ = id & 511;
        CvTile ft; cv_load(ft, weo + (size_t)e_ * D * D, D, 32 * (q_ & 31), q_ >> 5, lane);
        cv_to_lds(ft, scr, lane); cv_store_bf16(scr, WEO + (size_t)e_ * D * D, D, 32 * (q_ & 31), 64 * (q_ >> 5), lane);
    }
}

template <int N>
__device__ __forceinline__ void mod_vals(const float* modp, const float* b_ada, int vec, const int (&j)[N], float (&out)[N]) {
    float p[N][KSPLIT], s[N];
#pragma unroll
    for (int n = 0; n < N; ++n) { s[n] = b_ada[j[n]];
#pragma unroll
        for (int ks = 0; ks < KSPLIT; ++ks) p[n][ks] = modp[((size_t)ks * 3 + vec) * 6144 + j[n]]; }
    __builtin_amdgcn_sched_barrier(0);
#pragma unroll
    for (int n = 0; n < N; ++n) {
#pragma unroll
        for (int ks = 0; ks < KSPLIT; ++ks) s[n] += p[n][ks];
        out[n] = s[n]; }
}
__device__ __forceinline__ float mod_val(const float* modp, const float* b_ada, int vec, int j) { const int jj[1] = {j}; float o[1]; mod_vals<1>(modp, b_ada, vec, jj, o); return o[0]; }
__device__ __forceinline__ int nbr_row(int row, int j) {
    if (row < ML) { const int t = row & (T - 1), gc = t & 63, gr = t >> 6;
        if (j == 0) return gc > 0 ? row - 1 : -1; if (j == 1) return gc < 63 ? row + 1 : -1; if (j == 2) return gr > 0 ? row - 64 : -1; return gr < 127 ? row + 64 : -1; }
    const int tc = (row - ML) & (TC - 1);
    if ((j & 1) == 0) return tc > 0 ? row - 1 : -1; return tc < TC - 1 ? row + 1 : -1;
}
__device__ __forceinline__ void load_shift16(const bf16* z, int row, int col0, const LAS float* mu, float (&out)[16]) {
    float s[16]; ld16bf(z + (size_t)row * NZ + col0, s);
    float m[16]; ld16f_lds(mu, m);
#pragma unroll
    for (int j = 0; j < 4; ++j) {
        const int nr = nbr_row(row, j); float t[16];
        if (nr >= 0) ld16bf(z + (size_t)nr * NZ + col0, t); else {
#pragma unroll
            for (int i = 0; i < 16; ++i) t[i] = 0.f; }
#pragma unroll
        for (int i = j; i < 16; i += 4) out[i] = s[i] + m[i] * (t[i] - s[i]);
    }
}

__device__ __forceinline__ void phase_prologue(Frame& F) {
    LAS float* scr = (LAS float*)(F.lds + RING_OFF + F.wave * 16384);
    LAS float* sil = (LAS float*)(F.lds + LDS_X_OFF);
    for (int i = F.tid; i < 3 * D; i += NWAVES * 64) { const int v = i / D, j = i % D; const float c = v < 2 ? KIN(I_C)[v * D + j] : KIN(I_CCTX)[j]; sil[i] = c / (1.0f + __expf(-c)); }
    __syncthreads();
    bf16* WoutT = (bf16*)(F.ws + WS_WOUT);
    constexpr int IT_WIN = (N_IN / 32) * 4, IT_WOUT = (D / 64) * (D / 32), IT_ADA = 24 * KSPLIT;
    constexpr int NITEMS = IT_ADA + IT_WIN + IT_WOUT;
    float* modp = (float*)(F.ws + WS_MODP);
    for (int it = F.gw; it < NITEMS; it += F.NGW) {
        int r = it;
        if (r < IT_ADA) {
            const int cc = r % 24, ks = r / 24, col = cc * 256 + F.lane * 4;
            f32x4 a0 = {0.f, 0.f, 0.f, 0.f}, a1 = a0, a2 = a0;
            const float* wp = KIN(I_WADA) + (size_t)(ks * 64) * 6144 + col;
#pragma unroll 8
            for (int k = 0; k < 64; ++k) { const f32x4 w = *(const f32x4*)(wp + (size_t)k * 6144); const int kk = ks * 64 + k;
                a0 += w * sil[kk]; a1 += w * sil[D + kk]; a2 += w * sil[2 * D + kk]; }
            *(f32x4*)(modp + ((size_t)ks * 3 + 0) * 6144 + col) = a0; *(f32x4*)(modp + ((size_t)ks * 3 + 1) * 6144 + col) = a1; *(f32x4*)(modp + ((size_t)ks * 3 + 2) * 6144 + col) = a2;
            continue; }
        r -= IT_ADA;
        if (r < IT_WIN) { const int st = r >> 2, qq = r & 3; q8_item(KIN(I_WIN), N_IN, 32 * st, (signed char*)(F.ws + WS_WIN), (float*)(F.ws + MI_CSWIN), 32 * st, scr, F.lane, 4 * qq, 4 * qq + 4); continue; }
        r -= IT_WIN;
        { const int nb = D / 32, kb = r / nb, n0 = 32 * (r % nb); transpose_item(KIN(I_WOUT), D, 64 * kb, n0, WoutT, D, n0, scr, F.lane); }
    }
    const int gt = blockIdx.x * (NWAVES * 64) + F.tid, NGT = F.G * NWAVES * 64;
    for (int i = gt; i < (NZ - N_IN) * D / 16; i += NGT) *(v4u*)(F.ws + WS_WIN + (size_t)N_IN * D + (size_t)i * 16) = (v4u){0u, 0u, 0u, 0u};
    for (int i = gt; i < NZ - N_IN; i += NGT) ((float*)(F.ws + MI_CSWIN))[N_IN + i] = 0.f;
    bf16* WL = (bf16*)(F.ws + WS_WLORA);
    for (int i = gt; i < NL * (KL / 8); i += NGT) {
        const int c8 = i / NL, row = i % NL, blk = row >> 10, n = row & 1023, col = c8 * 8, g = col >> 6;
        const float* src = nullptr; int kofs = 0;
        if (blk < 2) { if (g == blk) { src = KIN(I_WDU) + (size_t)blk * 64 * D; kofs = col - 64 * blk; } }
        else if (blk < 4) { if (g == blk) { src = KIN(I_WIU) + (size_t)(blk - 2) * 64 * D; kofs = col - 64 * blk; } }
        else { if (g >= 4) { src = KIN(I_WGU); kofs = col - 256; } }
        v4u o = {0u, 0u, 0u, 0u};
        if (src) { float v[8];
#pragma unroll
            for (int q = 0; q < 8; ++q) v[q] = src[(size_t)(kofs + q) * D + n];
            o.x = pk2(v[0], v[1]); o.y = pk2(v[2], v[3]); o.z = pk2(v[4], v[5]); o.w = pk2(v[6], v[7]); }
        *(v4u*)(WL + (size_t)row * KL + col) = o;
    }
    bf16* WR = (bf16*)(F.ws + WS_WROUT);
    for (int i = gt; i < 256 * (D / 8); i += NGT) {
        const int row = i % 256, c8 = i / 256; v4u o = {0u, 0u, 0u, 0u};
        if (row < NE) { float v[8];
#pragma unroll
            for (int q = 0; q < 8; ++q) v[q] = KIN(I_WR)[(size_t)(c8 * 8 + q) * NE + row];
            o.x = pk2(v[0], v[1]); o.y = pk2(v[2], v[3]); o.z = pk2(v[4], v[5]); o.w = pk2(v[6], v[7]); }
        *(v4u*)(WR + (size_t)row * D + c8 * 8) = o;
    }
}

__device__ __forceinline__ void phase_hrows(Frame& F) {
    LAS float* LA = (LAS float*)(F.lds);
    LAS float* LB = LA + 3 * D;
    const float* modp = (const float*)(F.ws + WS_MODP);
    for (int i = F.tid; i < 3 * D; i += NWAVES * 64) { const int v = i / D, j = i % D;
        const int jj[2] = {1024 + j, j}; float mv[2]; mod_vals<2>(modp, KIN(I_BADA), v, jj, mv);
        LA[i] = KIN(I_NPM)[j] * (1.0f + mv[0]); LB[i] = mv[1]; }
    __syncthreads();
    signed char* A0q = (signed char*)(F.ws + WS_A0);
    for (int row0 = F.gw; row0 < MT; row0 += 4 * F.NGW) {
        f32x4 v[4][4];
#pragma unroll
        for (int k = 0; k < 4; ++k) { const int row = row0 + k * F.NGW, rc = row < MT ? row : row0;
            const float* xr = rc < ML ? KIN(I_X) + (size_t)rc * D : KIN(I_CTX) + (size_t)(rc - ML) * D;
#pragma unroll
            for (int j = 0; j < 4; ++j) v[k][j] = *(const f32x4*)(xr + 4 * F.lane + 256 * j); }
        __builtin_amdgcn_sched_barrier(0);
#pragma unroll
        for (int k = 0; k < 4; ++k) { const int row = row0 + k * F.NGW;
            if (row < MT) {
                const int vec = row < ML ? row >> 13 : 2;
                float s = 0.f;
#pragma unroll
                for (int j = 0; j < 4; ++j) s += (v[k][j].x * v[k][j].x + v[k][j].y * v[k][j].y) + (v[k][j].z * v[k][j].z + v[k][j].w * v[k][j].w);
                const float rstd = 1.0f / sqrtf(wave_sum(s) * (1.0f / D) + 1e-6f);
                f32x4 hq[4]; float mx = 0.f;
#pragma unroll
                for (int j = 0; j < 4; ++j) { const int c = 4 * F.lane + 256 * j; const f32x4 a = *(const LAS f32x4*)(LA + vec * D + c), b = *(const LAS f32x4*)(LB + vec * D + c);
                    hq[j] = v[k][j] * rstd * a + b; mx = fmaxf(mx, fmaxf(fmaxf(fabsf(hq[j].x), fabsf(hq[j].y)), fmaxf(fabsf(hq[j].z), fabsf(hq[j].w)))); }
                mx = wave_max(mx);
                const float iv = mx > 0.f ? 127.0f / mx : 0.f;
                if (F.lane == 0) ((float*)(F.ws + MI_RSH))[row] = mx * (1.0f / 127.0f);
                unsigned* o4 = (unsigned*)(A0q + (size_t)row * D) + F.lane;
#pragma unroll
                for (int j = 0; j < 4; ++j) o4[64 * j] = pack_q4(hq[j].x * iv, hq[j].y * iv, hq[j].z * iv, hq[j].w * iv);
            } }
    }
}

__device__ __forceinline__ void phase_lora_in(Frame& F) {
    const bf16* z = (const bf16*)(F.ws + WS_Z); bf16* AL = (bf16*)(F.ws + WS_AL);
    const int gt = blockIdx.x * (NWAVES * 64) + F.tid, NGT = F.G * NWAVES * 64;
    for (int i = gt; i < MT * (KL / 4); i += NGT) {
        const int row = i / (KL / 4), q = i % (KL / 4), j0 = 4 * q;
        const int zc = j0 < 256 ? DECAY_OFF + j0 : GLORA_OFF + (j0 - 256);
        float o[4];
        if (j0 >= 256 && row >= ML) { o[0] = o[1] = o[2] = o[3] = 0.f; }
        else {
            const uint2 sv = *(const uint2*)(z + (size_t)row * NZ + zc); const float s[4] = {bflo(sv.x), bfhi(sv.x), bflo(sv.y), bfhi(sv.y)};
#pragma unroll
            for (int j = 0; j < 4; ++j) { const int nr = nbr_row(row, j); float t = 0.f;
                if (nr >= 0) t = bf1(z[(size_t)nr * NZ + zc + j]);
                const float v = s[j] + KIN(I_MU)[zc + j] * (t - s[j]);
                o[j] = j0 < 128 ? tanhf(v) : (j0 < 256 ? v : sigmoidf_(v)); }
        }
        *(uint2*)(AL + (size_t)row * KL + j0) = make_uint2(pk2(o[0], o[1]), pk2(o[2], o[3]));
    }
}


namespace ck {
typedef short bf16x8 __attribute__((ext_vector_type(8)));
constexpr int TILE = 8192;
constexpr int NU_L = BATCH * (T / 64) * NH;
constexpr int NU_ALL = NU_L + BATCH * (TC / 64) * NH;
__device__ __forceinline__ int swz(int row) { return (row ^ (row >> 3)) & 7; }
__device__ __forceinline__ int toff(int row, int col) { return row * 128 + ((col * 2) ^ (swz(row) << 4)); }
__device__ __forceinline__ bf16x8 ldfrag(const LAS unsigned char* t, int row, int chunk) { return *(const LAS bf16x8*)(t + row * 128 + ((chunk ^ swz(row)) << 4)); }
typedef __bf16 bf16v2_t __attribute__((ext_vector_type(2)));
__device__ __forceinline__ unsigned cvtpk(float lo, float hi) { const bf16v2_t v = {(__bf16)lo, (__bf16)hi}; return __builtin_bit_cast(unsigned, v); }
#define CK_MFMA(a, b, c) __builtin_amdgcn_mfma_f32_16x16x32_bf16(a, b, c, 0, 0, 0)
template <bool MASKDIAG>
__device__ __forceinline__ void mm64(f32x4 (&acc)[4], const LAS unsigned char* Lt, const LAS unsigned char* Rt, int wq, int lane) {
    const int lr = lane & 15, g = lane >> 4;
    const bf16x8 l0 = ldfrag(Lt, 16 * wq + lr, g), l1 = ldfrag(Lt, 16 * wq + lr, 4 + g);
#pragma unroll
    for (int n = 0; n < 4; ++n) {
        bf16x8 r0 = ldfrag(Rt, 16 * n + lr, g), r1 = ldfrag(Rt, 16 * n + lr, 4 + g);
        if (MASKDIAG) { const bf16x8 zz = {0, 0, 0, 0, 0, 0, 0, 0}; if ((g >> 1) == n) r0 = zz; if (2 + (g >> 1) == n) r1 = zz; }
        acc[n] = CK_MFMA(l0, r0, acc[n]); acc[n] = CK_MFMA(l1, r1, acc[n]);
    }
}
__device__ __forceinline__ void zero4(f32x4 (&a)[4]) {
#pragma unroll
    for (int n = 0; n < 4; ++n) a[n] = (f32x4){0.f, 0.f, 0.f, 0.f};
}
__device__ __forceinline__ void storeT(LAS unsigned char* t, const f32x4 (&v)[4], int wq, int lane) {
    const int lr = lane & 15, g = lane >> 4;
#pragma unroll
    for (int n = 0; n < 4; ++n) *(LAS v2u*)(t + toff(16 * n + lr, 16 * wq + 4 * g)) = (v2u){cvtpk(v[n][0], v[n][1]), cvtpk(v[n][2], v[n][3])};
}
__device__ __forceinline__ void storeN(LAS unsigned char* t, const f32x4 (&v)[4], int wq, int lane) {
    const int lr = lane & 15, g = lane >> 4;
#pragma unroll
    for (int n = 0; n < 4; ++n)
#pragma unroll
        for (int i = 0; i < 4; ++i) *(LAS unsigned short*)(t + toff(16 * wq + 4 * g + i, 16 * n + lr)) = (unsigned short)f2bf(v[n][i]);
}
__device__ __forceinline__ void loadT(f32x4 (&v)[4], const LAS unsigned char* t, int wq, int lane) {
    const int lr = lane & 15, g = lane >> 4;
#pragma unroll
    for (int n = 0; n < 4; ++n) { const v2u w = *(const LAS v2u*)(t + toff(16 * n + lr, 16 * wq + 4 * g)); v[n] = (f32x4){bflo(w.x), bfhi(w.x), bflo(w.y), bfhi(w.y)}; }
}
__device__ __forceinline__ void unit_decode(int unit, int& b, int& h, int& rowbase) {
    if (unit < NU_L) { h = unit & 15; const int blk = (unit >> 4) & 127; b = unit >> 11; rowbase = b * T + blk * 64; }
    else { const int u = unit - NU_L; h = u & 15; const int cb = (u >> 4) & 3; b = u >> 6; rowbase = ML + b * TC + cb * 64; }
}
__device__ __forceinline__ void pack8(LAS unsigned char* t, int row, int chunk, const float (&v)[8], bool rev) {
    v4u o;
    if (!rev) { o.x = cvtpk(v[0], v[1]); o.y = cvtpk(v[2], v[3]); o.z = cvtpk(v[4], v[5]); o.w = cvtpk(v[6], v[7]); }
    else { o.x = cvtpk(v[7], v[6]); o.y = cvtpk(v[5], v[4]); o.z = cvtpk(v[3], v[2]); o.w = cvtpk(v[1], v[0]); }
    *(LAS v4u*)(t + row * 128 + ((chunk ^ swz(row)) << 4)) = o;
}

__device__ __forceinline__ void unpack8(const v4u p, float (&o)[8]) {
    o[0] = bflo(p.x); o[1] = bfhi(p.x); o[2] = bflo(p.y); o[3] = bfhi(p.y); o[4] = bflo(p.z); o[5] = bfhi(p.z); o[6] = bflo(p.w); o[7] = bfhi(p.w);
}
__device__ __forceinline__ void ld8f(const float* p, float (&o)[8]) {
    const f32x4 a = *(const f32x4*)p, b = *(const f32x4*)(p + 4); o[0] = a.x; o[1] = a.y; o[2] = a.z; o[3] = a.w; o[4] = b.x; o[5] = b.y; o[6] = b.z; o[7] = b.w;
}
__device__ __forceinline__ float fsig(float x) { return __builtin_amdgcn_rcpf(1.0f + __expf(-x)); }
template <bool IS_CO> struct EPre { v4u k[5], v[5], r[IS_CO ? 5 : 1], lo[4]; unsigned msk; };
template <bool IS_CO>
__device__ __forceinline__ void epre_load(EPre<IS_CO>& P, const bf16* z, const bf16* LO, int unit, int wave, int lane) {
    int b, h, rowbase; unit_decode(unit, b, h, rowbase);
    const int row = rowbase + 8 * wave + (lane >> 3), c0 = h * 64 + 8 * (lane & 7);
    const bf16* zr = z + (size_t)row * NZ;
    P.k[0] = *(const v4u*)(zr + K_OFF + c0); P.v[0] = *(const v4u*)(zr + V_OFF + c0); if (IS_CO) P.r[0] = *(const v4u*)(zr + R_OFF + c0);
    unsigned msk = 0u;
#pragma unroll
    for (int j = 0; j < 4; ++j) { const int nr = nbr_row(row, j); const bf16* zn = z + (size_t)(nr >= 0 ? nr : row) * NZ; msk |= (nr >= 0 ? 1u : 0u) << j;
        P.k[1 + j] = *(const v4u*)(zn + K_OFF + c0); P.v[1 + j] = *(const v4u*)(zn + V_OFF + c0);
        if (IS_CO) P.r[1 + j] = *(const v4u*)(zn + R_OFF + c0); }
    P.msk = msk;
    const bf16* lr_ = LO + (size_t)row * NL + c0;
    P.lo[0] = *(const v4u*)(lr_); P.lo[1] = *(const v4u*)(lr_ + 1024); P.lo[2] = *(const v4u*)(lr_ + 2048); P.lo[3] = *(const v4u*)(lr_ + 3072);
}
__device__ __forceinline__ void shift8(const v4u (&q)[5], const float* mu, float (&out)[8], unsigned msk = 15u) {
    const v4u zz = {0u, 0u, 0u, 0u};
    const v4u s = q[0], n0 = (msk & 1u) ? q[1] : zz, n1 = (msk & 2u) ? q[2] : zz, n2 = (msk & 4u) ? q[3] : zz, n3 = (msk & 8u) ? q[4] : zz;
    float m[8]; ld8f(mu, m);
    out[0] = bflo(s.x) + m[0] * (bflo(n0.x) - bflo(s.x)); out[1] = bfhi(s.x) + m[1] * (bfhi(n1.x) - bfhi(s.x));
    out[2] = bflo(s.y) + m[2] * (bflo(n2.y) - bflo(s.y)); out[3] = bfhi(s.y) + m[3] * (bfhi(n3.y) - bfhi(s.y));
    out[4] = bflo(s.z) + m[4] * (bflo(n0.z) - bflo(s.z)); out[5] = bfhi(s.z) + m[5] * (bfhi(n1.z) - bfhi(s.z));
    out[6] = bflo(s.w) + m[6] * (bflo(n2.w) - bflo(s.w)); out[7] = bfhi(s.w) + m[7] * (bfhi(n3.w) - bfhi(s.w));
}
__device__ __forceinline__ void ld8l(const LAS float* p, float (&o)[8]) {
    const f32x4 a = *(const LAS f32x4*)p, b = *(const LAS f32x4*)(p + 4); o[0] = a.x; o[1] = a.y; o[2] = a.z; o[3] = a.w; o[4] = b.x; o[5] = b.y; o[6] = b.z; o[7] = b.w;
}
__device__ __forceinline__ void shift8m(const v4u (&q)[5], const float (&m)[8], float (&out)[8], unsigned msk) {
    const v4u zz = {0u, 0u, 0u, 0u};
    const v4u s = q[0], n0 = (msk & 1u) ? q[1] : zz, n1 = (msk & 2u) ? q[2] : zz, n2 = (msk & 4u) ? q[3] : zz, n3 = (msk & 8u) ? q[4] : zz;
    out[0] = bflo(s.x) + m[0] * (bflo(n0.x) - bflo(s.x)); out[1] = bfhi(s.x) + m[1] * (bfhi(n1.x) - bfhi(s.x));
    out[2] = bflo(s.y) + m[2] * (bflo(n2.y) - bflo(s.y)); out[3] = bfhi(s.y) + m[3] * (bfhi(n3.y) - bfhi(s.y));
    out[4] = bflo(s.z) + m[4] * (bflo(n0.z) - bflo(s.z)); out[5] = bfhi(s.z) + m[5] * (bfhi(n1.z) - bfhi(s.z));
    out[6] = bflo(s.w) + m[6] * (bflo(n2.w) - bflo(s.w)); out[7] = bfhi(s.w) + m[7] * (bfhi(n3.w) - bfhi(s.w));
}
struct EPre2 { v4u k0, v0, r0; v2u kn[4], vn[4], rn[4]; v4u lo[4]; unsigned msk; };
__device__ __forceinline__ void epre2_load(EPre2& P, const bf16* z, const bf16* LO, int unit, int wave, int lane) {
    int b, h, rowbase; unit_decode(unit, b, h, rowbase);
    const int row = rowbase + 8 * wave + (lane >> 3), c0 = h * 64 + 8 * (lane & 7);
    const bf16* zr = z + (size_t)row * NZ;
    P.k0 = *(const v4u*)(zr + K_OFF + c0); P.v0 = *(const v4u*)(zr + V_OFF + c0); P.r0 = *(const v4u*)(zr + R_OFF + c0);
    unsigned msk = 0u;
#pragma unroll
    for (int j = 0; j < 4; ++j) { const int nr = nbr_row(row, j); const unsigned* zn = (const unsigned*)(z + (size_t)(nr >= 0 ? nr : row) * NZ + c0) + (j >> 1); msk |= (nr >= 0 ? 1u : 0u) << j;
        P.kn[j].x = zn[K_OFF / 2]; P.kn[j].y = zn[K_OFF / 2 + 2]; P.vn[j].x = zn[V_OFF / 2]; P.vn[j].y = zn[V_OFF / 2 + 2]; P.rn[j].x = zn[R_OFF / 2]; P.rn[j].y = zn[R_OFF / 2 + 2]; }
    P.msk = msk;
    const bf16* lr_ = LO + (size_t)row * NL + c0;
    P.lo[0] = *(const v4u*)(lr_); P.lo[1] = *(const v4u*)(lr_ + 1024); P.lo[2] = *(const v4u*)(lr_ + 2048); P.lo[3] = *(const v4u*)(lr_ + 3072);
}
__device__ __forceinline__ void shift8n(const v4u s, const v2u (&nb)[4], const float* mu, float (&out)[8], unsigned msk) {
    float m[8]; ld8f(mu, m);
    const float n0a = (msk & 1u) ? bflo(nb[0].x) : 0.f, n0b = (msk & 1u) ? bflo(nb[0].y) : 0.f, n1a = (msk & 2u) ? bfhi(nb[1].x) : 0.f, n1b = (msk & 2u) ? bfhi(nb[1].y) : 0.f;
    const float n2a = (msk & 4u) ? bflo(nb[2].x) : 0.f, n2b = (msk & 4u) ? bflo(nb[2].y) : 0.f, n3a = (msk & 8u) ? bfhi(nb[3].x) : 0.f, n3b = (msk & 8u) ? bfhi(nb[3].y) : 0.f;
    out[0] = bflo(s.x) + m[0] * (n0a - bflo(s.x)); out[1] = bfhi(s.x) + m[1] * (n1a - bfhi(s.x));
    out[2] = bflo(s.y) + m[2] * (n2a - bflo(s.y)); out[3] = bfhi(s.y) + m[3] * (n3a - bfhi(s.y));
    out[4] = bflo(s.z) + m[4] * (n0b - bflo(s.z)); out[5] = bfhi(s.z) + m[5] * (n1b - bfhi(s.z));
    out[6] = bflo(s.w) + m[6] * (n2b - bflo(s.w)); out[7] = bfhi(s.w) + m[7] * (n3b - bfhi(s.w));
}
__device__ __forceinline__ void putN(LAS unsigned char* t, int tau, int oct, const float (&v)[8]) {
    v4u o; o.x = cvtpk(v[0], v[1]); o.y = cvtpk(v[2], v[3]); o.z = cvtpk(v[4], v[5]); o.w = cvtpk(v[6], v[7]);
    *(LAS v4u*)(t + tau * 128 + ((oct ^ swz(tau)) << 4)) = o;
}
__device__ __forceinline__ void putT(LAS unsigned char* t, int tau, int ch0, const float (&v)[8]) {
#pragma unroll
    for (int i = 0; i < 8; ++i) *(LAS unsigned short*)(t + toff(ch0 + i, tau)) = (unsigned short)f2bf(v[i]);
}

template <bool IS_CO, bool STAGES = true>
__device__ __forceinline__ void phase_chunk(Frame& F) {
    const int wave = F.wave;
    const int dgrp = wave >> 2, wq = wave & 3;
    LAS unsigned char* tl = F.lds + dgrp * 9 * TILE;
#define SL(k) (tl + (k) * TILE)
    LAS float* SEG = (LAS float*)(F.lds + LDS_X_OFF);
    LAS float* GAM = SEG + 1024;
    LAS unsigned char* DIB = (LAS unsigned char*)(GAM + 128) + dgrp * 2048;
    LAS float* LW0 = (LAS float*)(F.lds + 7 * TILE);
    LAS float* LW1 = (LAS float*)(F.lds + 16 * TILE);
    const bf16* z = (const bf16*)(F.ws + WS_Z); const bf16* LO = (const bf16*)(F.ws + WS_LORA);
    unsigned char* PQ = F.ws + WS_PQ; unsigned char* TKN = F.ws + WS_TKN; unsigned char* UPRE = F.ws + WS_UPRE; unsigned char* H0T = F.ws + WS_H0T;
    bf16* MG = (bf16*)(F.ws + WS_A0);
    const float* p_mu = KIN(I_MU); const float* p_kk = KIN(I_KK); const float* p_ka = KIN(I_KA);
    const int NU = IS_CO ? NU_L : NU_ALL;
    EPre<IS_CO> PF;
    CvTile cvt; float civ[4] = {0.f, 0.f, 0.f, 0.f}; int cv_t = 0;
    const float* cv_w = KIN(I_WEI);
    LAS float* cv_scr = (LAS float*)(F.lds + wave * 16384);
    if ((int)blockIdx.x < NU) epre_load<IS_CO>(PF, z, LO, (int)blockIdx.x, wave, F.lane);
    for (int unit = blockIdx.x; unit < NU; unit += F.G) {
        int lane = F.lane; asm volatile("" : "+v"(lane));
        const int lr = lane & 15, g = lane >> 4;
        int b, h, rowbase; unit_decode(unit, b, h, rowbase);
        const int tok = 8 * wave + (lane >> 3), oct = lane & 7, ch0 = 8 * oct, c0 = h * 64 + ch0, row = rowbase + tok;
        float ks[8], vs[8], rs[8], kkp[8], lw0[8], lw1[8], kd0[8], kd1[8], a_0[8], a_1[8], ssq;
        {
            shift8(PF.k, p_mu + K_OFF + c0, ks, PF.msk);
            shift8(PF.v, p_mu + V_OFF + c0, vs, PF.msk);
            if (IS_CO) { v4u rr[5];
#pragma unroll
                for (int j = 0; j < 5; ++j) rr[j] = PF.r[IS_CO ? j : 0];
                shift8(rr, p_mu + R_OFF + c0, rs, PF.msk); }
            else {
#pragma unroll
                for (int i = 0; i < 8; ++i) rs[i] = 0.f; }
            float xw0[8], xw1[8], xa0[8], xa1[8];
            unpack8(PF.lo[0], xw0); unpack8(PF.lo[1], xw1); unpack8(PF.lo[2], xa0); unpack8(PF.lo[3], xa1);
            float kkk[8], kaa[8];
            ld8f(p_kk + c0, kkk); ld8f(p_ka + c0, kaa);
            float ss = 0.f;
#pragma unroll
            for (int i = 0; i < 8; ++i) {
                kkp[i] = ks[i] * kkk[i]; ss += kkp[i] * kkp[i];
                lw0[i] = xw0[i]; lw1[i] = xw1[i];
                a_0[i] = xa0[i]; a_1[i] = xa1[i];
                kd0[i] = ks[i] * (1.0f + (a_0[i] - 1.0f) * kaa[i]); kd1[i] = ks[i] * (1.0f + (a_1[i] - 1.0f) * kaa[i]);
                const int ch = ch0 + i, sw = tok ^ (4 * ((ch & 15) ^ (2 * (ch >> 4))));
                LW0[ch * 64 + sw] = lw0[i]; LW1[ch * 64 + sw] = lw1[i];
            }
            ss += __shfl_xor(ss, 1); ss += __shfl_xor(ss, 2); ss += __shfl_xor(ss, 4);
            ssq = ss;
        }
        __syncthreads();
        {
            const int ch2 = lane, seg = wave, sw = 4 * ((ch2 & 15) ^ (2 * (ch2 >> 4)));
            LAS f32x4* p0a = (LAS f32x4*)(LW0 + ch2 * 64 + ((8 * seg) ^ sw)); LAS f32x4* p0b = (LAS f32x4*)(LW0 + ch2 * 64 + ((8 * seg + 4) ^ sw));
            LAS f32x4* p1a = (LAS f32x4*)(LW1 + ch2 * 64 + ((8 * seg) ^ sw)); LAS f32x4* p1b = (LAS f32x4*)(LW1 + ch2 * 64 + ((8 * seg + 4) ^ sw));
            f32x4 a = *p0a, bq = *p0b, c = *p1a, d = *p1b;
            a.y += a.x; a.z += a.y; a.w += a.z; bq.x += a.w; bq.y += bq.x; bq.z += bq.y; bq.w += bq.z;
            d.z += d.w; d.y += d.z; d.x += d.y; c.w += d.x; c.z += c.w; c.y += c.z; c.x += c.y;
            SEG[seg * 64 + ch2] = bq.w; SEG[(8 + seg) * 64 + ch2] = c.x;
            __syncthreads();
            float off0 = 0.f, off1 = 0.f;
#pragma unroll
            for (int s2 = 0; s2 < 8; ++s2) { const float t0 = SEG[s2 * 64 + ch2], t1 = SEG[(8 + s2) * 64 + ch2]; off0 += (s2 < seg) ? t0 : 0.f; off1 += (s2 > seg) ? t1 : 0.f; }
            *p0a = a + off0; *p0b = bq + off0; *p1a = c + off1; *p1b = d + off1;
        }
        __syncthreads();
        {
            const float inv = 1.0f / fmaxf(sqrtf(ssq), 1e-12f);
            float t8[8], u8[8], w8[8];
            {
                LAS unsigned char* t0 = F.lds; const int tau = tok;
                float e1[8], ei[8];
#pragma unroll
                for (int i = 0; i < 8; ++i) { const int ch = ch0 + i; const float cm = LW0[ch * 64 + (tok ^ (4 * ((ch & 15) ^ (2 * (ch >> 4)))))]; e1[i] = __expf(cm); ei[i] = __builtin_amdgcn_rcpf(e1[i]); t8[i] = kkp[i] * inv * __expf(cm - lw0[i]); }
                if (tok == 63) {
#pragma unroll
                    for (int i = 0; i < 8; ++i) GAM[ch0 + i] = e1[i]; }
#pragma unroll
                for (int i = 0; i < 8; ++i) { u8[i] = kkp[i] * inv * a_0[i] * ei[i]; w8[i] = kd0[i] * ei[i]; }
                if (!IS_CO) { putN(t0 + 0 * TILE, tau, oct, t8); putT(t0 + 1 * TILE, tau, ch0, t8); putN(t0 + 2 * TILE, tau, oct, u8); putT(t0 + 3 * TILE, tau, ch0, u8);
                    putN(t0 + 4 * TILE, tau, oct, w8); putT(t0 + 5 * TILE, tau, ch0, w8); putT(t0 + 6 * TILE, tau, ch0, vs); }
                else {
#pragma unroll
                    for (int i = 0; i < 8; ++i) t8[i] = rs[i] * e1[i];
                    putN(t0 + 0 * TILE, tau, oct, w8); putN(t0 + 1 * TILE, tau, oct, u8); putN(t0 + 2 * TILE, tau, oct, t8); putT(t0 + 3 * TILE, tau, ch0, vs); }
            }
            {
                LAS unsigned char* t1 = F.lds + 9 * TILE; const int tau = 63 - tok;
                float e1[8], ei[8];
#pragma unroll
                for (int i = 0; i < 8; ++i) { const int ch = ch0 + i; const float cm = LW1[ch * 64 + (tok ^ (4 * ((ch & 15) ^ (2 * (ch >> 4)))))]; e1[i] = __expf(cm); ei[i] = __builtin_amdgcn_rcpf(e1[i]); t8[i] = kkp[i] * inv * __expf(cm - lw1[i]); }
                if (tok == 0) {
#pragma unroll
                    for (int i = 0; i < 8; ++i) GAM[64 + ch0 + i] = e1[i]; }
#pragma unroll
                for (int i = 0; i < 8; ++i) { u8[i] = kkp[i] * inv * a_1[i] * ei[i]; w8[i] = kd1[i] * ei[i]; }
                if (!IS_CO) { putN(t1 + 0 * TILE, tau, oct, t8); putT(t1 + 1 * TILE, tau, ch0, t8); putN(t1 + 2 * TILE, tau, oct, u8); putT(t1 + 3 * TILE, tau, ch0, u8);
                    putN(t1 + 4 * TILE, tau, oct, w8); putT(t1 + 5 * TILE, tau, ch0, w8); putT(t1 + 6 * TILE, tau, ch0, vs); }
                else {
#pragma unroll
                    for (int i = 0; i < 8; ++i) t8[i] = rs[i] * e1[i];
                    putN(t1 + 0 * TILE, tau, oct, w8); putN(t1 + 1 * TILE, tau, oct, u8); putN(t1 + 2 * TILE, tau, oct, t8); putT(t1 + 3 * TILE, tau, ch0, vs); }
            }
        }
        if (!STAGES) { __syncthreads(); continue; }
        const size_t inst = (size_t)unit * 2 + dgrp;
        const int t2 = (wq << 6) | lane;
        if (IS_CO) {
#pragma unroll
            for (int rep = 0; rep < 2; ++rep) { const int cidx = t2 + 256 * rep, row = cidx >> 3, ch = cidx & 7;
                const v4u a = *(const v4u*)(TKN + inst * 8192 + (size_t)(row * 64 + ch * 8) * 2), hh = *(const v4u*)(H0T + inst * 8192 + (size_t)(row * 64 + ch * 8) * 2);
                *(LAS v4u*)(SL(4) + row * 128 + ((ch ^ swz(row)) << 4)) = a; *(LAS v4u*)(SL(5) + row * 128 + ((ch ^ swz(row)) << 4)) = hh; }
        }
        v4u upre0 = {0u, 0u, 0u, 0u}, upre1 = upre0;
        if (IS_CO) { const unsigned char* up = UPRE + inst * 8192 + (size_t)((wq * 64 + lane) * 32); upre0 = *(const v4u*)up; upre1 = *(const v4u*)(up + 16); }
        if (unit + F.G < NU) epre_load<IS_CO>(PF, z, LO, unit + F.G, wave, lane);
        const int cv_strip = F.gw + (cv_t >> 4) * F.NGW, cv_kb = cv_t & 15;
        if (!IS_CO && cv_strip < NE * 64) { int e_, n0_, rb_; wei_strip(cv_strip, e_, n0_, rb_); cv_load(cvt, cv_w + (size_t)e_ * D * 2048, 2048, n0_, cv_kb, lane); }
        __syncthreads();
        f32x4 acc[4], acc2[4];
        if (!IS_CO) {
            zero4(acc); mm64<false>(acc, SL(2), SL(0), wq, lane);
            zero4(acc2); mm64<false>(acc2, SL(4), SL(0), wq, lane);
#pragma unroll
            for (int n = 0; n < 4; ++n)
#pragma unroll
                for (int q = 0; q < 4; ++q) { const bool lo = (16 * wq + 4 * g + q < 16 * n + lr); acc[n][q] = lo ? acc[n][q] : 0.f; acc2[n][q] = lo ? acc2[n][q] : 0.f; }
            storeT(SL(7), acc, wq, lane); storeT(SL(8), acc2, wq, lane);
            __syncthreads();
            zero4(acc); mm64<false>(acc, SL(8), SL(6), wq, lane); storeT(SL(0), acc, wq, lane);
            if (wq == 0) {
                const int bb = lane >> 4, jj = lane & 15;
                float X[16];
                X[0] = (jj == 0) ? 1.f : 0.f;
#pragma unroll
                for (int t = 1; t < 16; ++t) {
                    const int row = 16 * bb + t;
                    const v4u p0 = *(const LAS v4u*)(SL(7) + row * 128 + (((2 * bb) ^ swz(row)) << 4)), p1 = *(const LAS v4u*)(SL(7) + row * 128 + (((2 * bb + 1) ^ swz(row)) << 4));
                    float rw[16];
                    rw[0] = bflo(p0.x); rw[1] = bfhi(p0.x); rw[2] = bflo(p0.y); rw[3] = bfhi(p0.y); rw[4] = bflo(p0.z); rw[5] = bfhi(p0.z); rw[6] = bflo(p0.w); rw[7] = bfhi(p0.w);
                    rw[8] = bflo(p1.x); rw[9] = bfhi(p1.x); rw[10] = bflo(p1.y); rw[11] = bfhi(p1.y); rw[12] = bflo(p1.z); rw[13] = bfhi(p1.z); rw[14] = bflo(p1.w); rw[15] = bfhi(p1.w);
                    float xv = (t == jj) ? 1.f : 0.f;
#pragma unroll
                    for (int s = 0; s < t; ++s) xv -= rw[s] * X[s];
                    X[t] = xv;
                }
#pragma unroll
                for (int t = 0; t < 16; ++t) *(LAS unsigned short*)(DIB + (((bb * 16 + t) * 16 + jj) << 1)) = (unsigned short)f2bf(X[t]);
            }
            __syncthreads();
            {
                const bool isU = wq >= 2; const int cbase = 32 * (wq & 1);
                const LAS unsigned char* Rt = isU ? SL(0) : SL(1);
                LAS unsigned char* outT = isU ? SL(4) : SL(2);
#pragma unroll
                for (int ct = 0; ct < 2; ++ct) {
                    const int col = cbase + 16 * ct + lr;
                    f32x4 X[4];
#pragma unroll
                    for (int b = 0; b < 4; ++b) {
                        const v2u rwv = *(const LAS v2u*)(Rt + toff(col, 16 * b + 4 * g));
                        f32x4 Zt = {bflo(rwv.x), bfhi(rwv.x), bflo(rwv.y), bfhi(rwv.y)};
                        if (b >= 1) {
                            f32x4 Y = {0.f, 0.f, 0.f, 0.f};
#pragma unroll
                            for (int s = 0; s < (b + 1) / 2; ++s) {
                                v2u alo = {0u, 0u}, ahi = {0u, 0u};
                                if (2 * s < b) alo = *(const LAS v2u*)(SL(7) + toff(16 * b + lr, 32 * s + 4 * g));
                                if (2 * s + 1 < b) ahi = *(const LAS v2u*)(SL(7) + toff(16 * b + lr, 32 * s + 16 + 4 * g));
                                v4u bw = {cvtpk(X[2 * s][0], X[2 * s][1]), cvtpk(X[2 * s][2], X[2 * s][3]), 0u, 0u};
                                if (2 * s + 1 < b) { bw.z = cvtpk(X[2 * s + 1][0], X[2 * s + 1][1]); bw.w = cvtpk(X[2 * s + 1][2], X[2 * s + 1][3]); }
                                Y = CK_MFMA(__builtin_bit_cast(bf16x8, ((v4u){alo.x, alo.y, ahi.x, ahi.y})), __builtin_bit_cast(bf16x8, bw), Y);
                            }
                            Zt = Zt - Y;
                        }
                        const v2u dv = *(const LAS v2u*)(DIB + (((b * 16 + lr) * 16 + 4 * g) << 1));
                        const v4u bz = {cvtpk(Zt[0], Zt[1]), cvtpk(Zt[2], Zt[3]), 0u, 0u};
                        X[b] = CK_MFMA(__builtin_bit_cast(bf16x8, ((v4u){dv.x, dv.y, 0u, 0u})), __builtin_bit_cast(bf16x8, bz), ((f32x4){0.f, 0.f, 0.f, 0.f}));
                    }
#pragma unroll
                    for (int b = 0; b < 4; ++b) {
                        const v2u pk = {cvtpk(X[b][0], X[b][1]), cvtpk(X[b][2], X[b][3])};
                        *(LAS v2u*)(outT + toff(col, 16 * b + 4 * g)) = pk;
                        if (!isU) {
#pragma unroll
                            for (int q = 0; q < 4; ++q) *(LAS unsigned short*)(SL(8) + toff(16 * b + 4 * g + q, col)) = (unsigned short)f2bf(X[b][q]);
                        } else {
                            *(uint2*)(UPRE + inst * 8192 + (size_t)(((b * 64 + lane) * 4 + 2 * (wq & 1) + ct) * 8)) = make_uint2(pk.x, pk.y);
                        }
                    }
                }
            }
            __syncthreads();
            { zero4(acc); mm64<false>(acc, SL(2), SL(3), wq, lane);
              const int cstep_ = unit < NU_L ? 4 + (dgrp ? 127 - ((unit >> 4) & 127) : ((unit >> 4) & 127)) : (dgrp ? 3 - (((unit - NU_L) >> 4) & 3) : (((unit - NU_L) >> 4) & 3));
              unsigned char* pb = PQ + (size_t)(((b * 16 + h) * 2 + dgrp) * (4 + T / 64) + cstep_) * 16384;
#pragma unroll
              for (int n = 0; n < 4; ++n) { const int k = 16 * n + lr; const float gm = GAM[dgrp * 64 + k]; float p[4];
#pragma unroll
                  for (int q = 0; q < 4; ++q) p[q] = gm * (((16 * wq + 4 * g + q) == k ? 1.f : 0.f) - acc[n][q]);
                  *(uint2*)(pb + (size_t)(((n * 2 + (wq >> 1)) * 64 + lane) * 16 + (wq & 1) * 8)) = make_uint2(cvtpk(p[0], p[1]), cvtpk(p[2], p[3])); }
              zero4(acc); mm64<false>(acc, SL(5), SL(6), wq, lane); zero4(acc2); mm64<false>(acc2, SL(3), SL(4), wq, lane);
              const f32x4 gm4 = *(const LAS f32x4*)(GAM + dgrp * 64 + 16 * wq + 4 * g);
#pragma unroll
              for (int n = 0; n < 4; ++n) { const f32x4 qv = (acc[n] - acc2[n]) * gm4;
                  *(uint2*)(pb + 8192 + (size_t)(((n * 64 + lane) * 4 + wq) * 8)) = make_uint2(cvtpk(qv[0], qv[1]), cvtpk(qv[2], qv[3])); }
#pragma unroll
              for (int rep = 0; rep < 2; ++rep) { const int cidx = t2 + 256 * rep, row = cidx >> 3, ch = cidx & 7;
                  *(v4u*)(TKN + inst * 8192 + (size_t)(row * 64 + ch * 8) * 2) = *(const LAS v4u*)(SL(8) + row * 128 + ((ch ^ swz(row)) << 4)); }
            }
        } else {
            zero4(acc); mm64<false>(acc, SL(0), SL(2), wq, lane);
#pragma unroll
            for (int n = 0; n < 4; ++n)
#pragma unroll
                for (int q = 0; q < 4; ++q) acc[n][q] = (16 * wq + 4 * g + q <= 16 * n + lr) ? acc[n][q] : 0.f;
            storeT(SL(6), acc, wq, lane);
            zero4(acc); mm64<false>(acc, SL(1), SL(2), wq, lane);
#pragma unroll
            for (int n = 0; n < 4; ++n)
#pragma unroll
                for (int q = 0; q < 4; ++q) acc[n][q] = (16 * wq + 4 * g + q <= 16 * n + lr) ? -acc[n][q] : 0.f;
            storeT(SL(7), acc, wq, lane);
            { const v4u o0 = upre0, o1 = upre1;
              acc[0] = (f32x4){bflo(o0.x), bfhi(o0.x), bflo(o0.y), bfhi(o0.y)}; acc[1] = (f32x4){bflo(o0.z), bfhi(o0.z), bflo(o0.w), bfhi(o0.w)};
              acc[2] = (f32x4){bflo(o1.x), bfhi(o1.x), bflo(o1.y), bfhi(o1.y)}; acc[3] = (f32x4){bflo(o1.z), bfhi(o1.z), bflo(o1.w), bfhi(o1.w)}; }
            mm64<false>(acc, SL(4), SL(5), wq, lane);
            storeT(SL(8), acc, wq, lane);
            __syncthreads();
            zero4(acc); mm64<false>(acc, SL(2), SL(5), wq, lane); mm64<false>(acc, SL(6), SL(3), wq, lane); mm64<false>(acc, SL(7), SL(8), wq, lane);
            __syncthreads();
            { LAS float* Yf = (LAS float*)(tl);
#pragma unroll
              for (int n = 0; n < 4; ++n)
#pragma unroll
                  for (int q = 0; q < 4; ++q) { const int tau = 16 * wq + 4 * g + q; Yf[tau * 64 + ((16 * n + lr) ^ (4 * (tau & 15)))] = acc[n][q]; } }
            __syncthreads();
            { const LAS float* Y0 = (const LAS float*)(F.lds); const LAS float* Y1 = (const LAS float*)(F.lds + 9 * TILE);
              const int t = row & (T - 1);
              const bf16* zr = z + (size_t)row * NZ;
              const v4u zz = {0u, 0u, 0u, 0u};
              const v4u q_g = *(const v4u*)(LO + (size_t)row * NL + 4096 + c0);
              const v4u q_gb = *(const v4u*)(zr + CONV_OFF + c0), q_c0 = *(const v4u*)(zr + CONV_OFF + 1024 + c0), q_x0 = *(const v4u*)(zr + CONV_OFF + 2048 + c0);
              const v4u q_cm = t > 0 ? *(const v4u*)(zr - NZ + CONV_OFF + 1024 + c0) : zz, q_xm = t > 0 ? *(const v4u*)(zr - NZ + CONV_OFF + 2048 + c0) : zz;
              const v4u q_cp = t < T - 1 ? *(const v4u*)(zr + NZ + CONV_OFF + 1024 + c0) : zz, q_xp = t < T - 1 ? *(const v4u*)(zr + NZ + CONV_OFF + 2048 + c0) : zz;
              const v4u q_ga = *(const v4u*)(zr + GATE_OFF + c0), q_gr = *(const v4u*)(zr + GATE_OFF + 1024 + c0);
              float y[8];
              { const int s0 = 4 * (tok & 15), s1 = 4 * ((63 - tok) & 15);
                const f32x4 a0 = *(const LAS f32x4*)(Y0 + tok * 64 + (ch0 ^ s0)), a1 = *(const LAS f32x4*)(Y0 + tok * 64 + ((ch0 + 4) ^ s0));
                const f32x4 b0 = *(const LAS f32x4*)(Y1 + (63 - tok) * 64 + (ch0 ^ s1)), b1 = *(const LAS f32x4*)(Y1 + (63 - tok) * 64 + ((ch0 + 4) ^ s1));
                y[0] = a0.x + b0.x; y[1] = a0.y + b0.y; y[2] = a0.z + b0.z; y[3] = a0.w + b0.w; y[4] = a1.x + b1.x; y[5] = a1.y + b1.y; y[6] = a1.z + b1.z; y[7] = a1.w + b1.w; }
              float rk[8]; ld8f(KIN(I_RK) + c0, rk);
              float s1 = 0.f, s2 = 0.f, s3 = 0.f;
#pragma unroll
              for (int i = 0; i < 8; ++i) { s1 += y[i]; s2 += y[i] * y[i]; s3 += rs[i] * 0.5f * (kd0[i] + kd1[i]) * rk[i]; }
              s1 += __shfl_xor(s1, 1); s2 += __shfl_xor(s2, 1); s3 += __shfl_xor(s3, 1); s1 += __shfl_xor(s1, 2); s2 += __shfl_xor(s2, 2); s3 += __shfl_xor(s3, 2);
              s1 += __shfl_xor(s1, 4); s2 += __shfl_xor(s2, 4); s3 += __shfl_xor(s3, 4);
              const float S1 = s1, S2 = s2, S3 = s3;
              const float mean = S1 * (1.0f / 64.0f), var = fmaxf(S2 * (1.0f / 64.0f) - mean * mean, 0.f), rstd = __builtin_amdgcn_rsqf(var + 64e-5f);
              float lnw[8], lnb[8], cw0[8], cw1[8], cw2[8];
              ld8f(KIN(I_LNW) + c0, lnw); ld8f(KIN(I_LNB) + c0, lnb); ld8f(KIN(I_CONVW) + c0, cw0); ld8f(KIN(I_CONVW) + D + c0, cw1); ld8f(KIN(I_CONVW) + 2 * D + c0, cw2);
              float gg[8], gb[8], cc[8], xx[8], cm[8], xm[8], cp[8], xp[8], ga[8], gr[8];
              unpack8(q_g, gg); unpack8(q_gb, gb); unpack8(q_c0, cc); unpack8(q_x0, xx); unpack8(q_cm, cm); unpack8(q_xm, xm); unpack8(q_cp, cp); unpack8(q_xp, xp); unpack8(q_ga, ga); unpack8(q_gr, gr);
              float o[8];
#pragma unroll
              for (int i = 0; i < 8; ++i) {
                  const float yn = (y[i] - mean) * rstd * lnw[i] + lnb[i];
                  const float yr = (yn + S3 * vs[i]) * gg[i];
                  const float yc = gb[i] * (cw0[i] * (cm[i] * xm[i]) + cw1[i] * (cc[i] * xx[i]) + cw2[i] * (cp[i] * xp[i]));
                  o[i] = fsig(ga[i]) * yr + fsig(gr[i]) * yc;
              }
              v4u ov; ov.x = cvtpk(o[0], o[1]); ov.y = cvtpk(o[2], o[3]); ov.z = cvtpk(o[4], o[5]); ov.w = cvtpk(o[6], o[7]);
              *(v4u*)(MG + (size_t)row * D + c0) = ov;
            }
        }
        __syncthreads();
        if (!IS_CO) {
            if (cv_strip < NE * 64) { int e_, n0_, rb_; wei_strip(cv_strip, e_, n0_, rb_);
                if (cv_kb == 0) cv_scale_q8(cv_w + (size_t)e_ * D * 2048, 2048, n0_, (float*)(F.ws + MI_CSWEI) + (size_t)e_ * 2048, rb_, lane, civ);
                cv_store_q8(cvt, cv_scr, (signed char*)(F.ws + WS_WEIN) + (size_t)e_ * 2048 * D, rb_, cv_kb, civ, lane); }
            ++cv_t;
            __syncthreads();
        }
    }
    if (!IS_CO) {
        for (;;) { const int s_ = F.gw + (cv_t >> 4) * F.NGW, kb_ = cv_t & 15; if (s_ >= NE * 64) break;
            int e_, n0_, rb_; wei_strip(s_, e_, n0_, rb_);
            if (kb_ == 0) cv_scale_q8(cv_w + (size_t)e_ * D * 2048, 2048, n0_, (float*)(F.ws + MI_CSWEI) + (size_t)e_ * 2048, rb_, F.lane, civ);
            cv_load(cvt, cv_w + (size_t)e_ * D * 2048, 2048, n0_, kb_, F.lane);
            cv_store_q8(cvt, cv_scr, (signed char*)(F.ws + WS_WEIN) + (size_t)e_ * 2048 * D, rb_, kb_, civ, F.lane); ++cv_t; }
    }
#undef SL
}

typedef short s16x4 __attribute__((ext_vector_type(4)));
__device__ __forceinline__ bf16x8 ldfragT(const LAS unsigned char* t, int c, int ks, int lane) {
    const int g = lane >> 4, q = (lane & 15) >> 2, p = lane & 3;
    const int r0 = 32 * ks + 8 * g + q, r1 = r0 + 4;
    const s16x4 a = __builtin_amdgcn_ds_read_tr16_b64_v4i16((LAS s16x4*)(t + r0 * 128 + (((2 * c + (p >> 1)) ^ swz(r0)) << 4) + 8 * (p & 1)));
    const s16x4 b = __builtin_amdgcn_ds_read_tr16_b64_v4i16((LAS s16x4*)(t + r1 * 128 + (((2 * c + (p >> 1)) ^ swz(r1)) << 4) + 8 * (p & 1)));
    return (bf16x8){a[0], a[1], a[2], a[3], b[0], b[1], b[2], b[3]};
}
__device__ __forceinline__ f32x4 loadN_acc(const LAS unsigned char* t, int b, int ct, int lane) {
    const int g = lane >> 4, q = (lane & 15) >> 2, p = lane & 3;
    const int r0 = 16 * b + 4 * g + q;
    const s16x4 a = __builtin_amdgcn_ds_read_tr16_b64_v4i16((LAS s16x4*)(t + r0 * 128 + (((2 * ct + (p >> 1)) ^ swz(r0)) << 4) + 8 * (p & 1)));
    return (f32x4){bf1((bf16)a[0]), bf1((bf16)a[1]), bf1((bf16)a[2]), bf1((bf16)a[3])};
}
template <bool LT, bool RT>
__device__ __forceinline__ void mm64x(f32x4 (&acc)[4], const LAS unsigned char* Lt, const LAS unsigned char* Rt, int wq, int lane) {
    const int lr = lane & 15, g = lane >> 4;
    const bf16x8 l0 = LT ? ldfragT(Lt, wq, 0, lane) : ldfrag(Lt, 16 * wq + lr, g), l1 = LT ? ldfragT(Lt, wq, 1, lane) : ldfrag(Lt, 16 * wq + lr, 4 + g);
#pragma unroll
    for (int n = 0; n < 4; ++n) {
        const bf16x8 r0 = RT ? ldfragT(Rt, n, 0, lane) : ldfrag(Rt, 16 * n + lr, g), r1 = RT ? ldfragT(Rt, n, 1, lane) : ldfrag(Rt, 16 * n + lr, 4 + g);
        acc[n] = CK_MFMA(l0, r0, acc[n]); acc[n] = CK_MFMA(l1, r1, acc[n]);
    }
}

__device__ __forceinline__ void phase_cp2(Frame& F) {
    const int wave = F.wave;
    const int dgrp = wave >> 2, wq = wave & 3;
    LAS unsigned char* tl = F.lds + dgrp * 9 * TILE;
#define SL(k) (tl + (k) * TILE)
    LAS float* SEG = (LAS float*)(F.lds + LDS_X_OFF);
    LAS float* GAM = SEG + 1024;
    LAS unsigned char* DIB = (LAS unsigned char*)(GAM + 128) + dgrp * 2048;
    LAS float* LW0 = (LAS float*)(F.lds + 7 * TILE);
    LAS float* LW1 = (LAS float*)(F.lds + 16 * TILE);
    const bf16* z = (const bf16*)(F.ws + WS_Z); const bf16* LO = (const bf16*)(F.ws + WS_LORA);
    unsigned char* PQ = F.ws + WS_PQ; unsigned char* RHAT = F.ws + WS_TKN; unsigned char* YLOC = F.ws + WS_UPRE;
    float* BON = (float*)(F.ws + MI_BON);
    const float* p_mu = KIN(I_MU); const float* p_kk = KIN(I_KK); const float* p_ka = KIN(I_KA); const float* p_rk = KIN(I_RK);
    constexpr int NU = NU_ALL;
    LAS float* PRM = (LAS float*)(F.lds + LDS_X_OFF + 8704);
    int h_prm = -1;
    EPre<true> PF;
    CvTile cvt; float civ[4] = {0.f, 0.f, 0.f, 0.f}; int cv_t = 0;
    const float* cv_w = KIN(I_WEI);
    LAS float* cv_scr = (LAS float*)(F.lds + wave * 16384);
    if ((int)blockIdx.x < NU) epre_load<true>(PF, z, LO, (int)blockIdx.x, wave, F.lane);
    if (!SEAM_FILL && F.gw < NE * 64) { int e_, n0_, rb_; wei_strip(F.gw, e_, n0_, rb_);
        cv_scale_q8(cv_w + (size_t)e_ * D * 2048, 2048, n0_, (float*)(F.ws + MI_CSWEI) + (size_t)e_ * 2048, rb_, F.lane, civ); }
    asm volatile("" : "+v"(PF.k[0]), "+v"(PF.k[1]), "+v"(PF.k[2]), "+v"(PF.k[3]), "+v"(PF.k[4]), "+v"(PF.v[0]), "+v"(PF.v[1]), "+v"(PF.v[2]), "+v"(PF.v[3]), "+v"(PF.v[4]));
    asm volatile("" : "+v"(PF.r[0]), "+v"(PF.r[1]), "+v"(PF.r[2]), "+v"(PF.r[3]), "+v"(PF.r[4]), "+v"(PF.lo[0]), "+v"(PF.lo[1]), "+v"(PF.lo[2]), "+v"(PF.lo[3]));
    asm volatile("s_waitcnt vmcnt(0)" ::: "memory");
    for (int unit = blockIdx.x; unit < NU; unit += F.G) {
        int lane = F.lane; asm volatile("" : "+v"(lane));
        const int lr = lane & 15, g = lane >> 4;
        int b, h, rowbase; unit_decode(unit, b, h, rowbase);
        if (h != h_prm) {
            __syncthreads();
            if (F.tid < 96) { const int arr = F.tid >> 4, off = (F.tid & 15) * 4;
                const float* src = arr == 0 ? p_mu + K_OFF : arr == 1 ? p_mu + V_OFF : arr == 2 ? p_mu + R_OFF : arr == 3 ? p_kk : arr == 4 ? p_ka : p_rk;
                *(LAS f32x4*)(PRM + arr * 64 + off) = *(const f32x4*)(src + h * 64 + off); }
            __syncthreads(); h_prm = h; }
        const int tok = 8 * wave + (lane >> 3), oct = lane & 7, ch0 = 8 * oct, c0 = h * 64 + ch0;
        float ks[8], vs[8], rs[8], kkp[8], lw0[8], lw1[8], kd0[8], kd1[8], a_0[8], a_1[8], ssq;
        {
            { float m_[8]; ld8l(PRM + ch0, m_); shift8m(PF.k, m_, ks, PF.msk); ld8l(PRM + 64 + ch0, m_); shift8m(PF.v, m_, vs, PF.msk); ld8l(PRM + 128 + ch0, m_); shift8m(PF.r, m_, rs, PF.msk); }
            float kkk[8], kaa[8], rkk[8];
            unpack8(PF.lo[0], lw0); unpack8(PF.lo[1], lw1); unpack8(PF.lo[2], a_0); unpack8(PF.lo[3], a_1);
            ld8l(PRM + 192 + ch0, kkk); ld8l(PRM + 256 + ch0, kaa); ld8l(PRM + 320 + ch0, rkk);
            float ss = 0.f, bs = 0.f;
#pragma unroll
            for (int i = 0; i < 8; ++i) {
                kkp[i] = ks[i] * kkk[i]; ss += kkp[i] * kkp[i];
                kd0[i] = ks[i] * (1.0f + (a_0[i] - 1.0f) * kaa[i]); kd1[i] = ks[i] * (1.0f + (a_1[i] - 1.0f) * kaa[i]);
                bs += rs[i] * 0.5f * (kd0[i] + kd1[i]) * rkk[i];
                const int ch = ch0 + i, sw = tok ^ (4 * ((ch & 15) ^ (2 * (ch >> 4))));
                LW0[ch * 64 + sw] = lw0[i]; LW1[ch * 64 + sw] = lw1[i];
            }
            ss += __shfl_xor(ss, 1); bs += __shfl_xor(bs, 1); ss += __shfl_xor(ss, 2); bs += __shfl_xor(bs, 2); ss += __shfl_xor(ss, 4); bs += __shfl_xor(bs, 4);
            ssq = ss;
            if (oct == 0 && unit < NU_L) BON[(size_t)unit * 64 + tok] = bs;
        }
        __syncthreads();
        {
            const int ch2 = lane, seg = wave, sw = 4 * ((ch2 & 15) ^ (2 * (ch2 >> 4)));
            LAS f32x4* p0a = (LAS f32x4*)(LW0 + ch2 * 64 + ((8 * seg) ^ sw)); LAS f32x4* p0b = (LAS f32x4*)(LW0 + ch2 * 64 + ((8 * seg + 4) ^ sw));
            LAS f32x4* p1a = (LAS f32x4*)(LW1 + ch2 * 64 + ((8 * seg) ^ sw)); LAS f32x4* p1b = (LAS f32x4*)(LW1 + ch2 * 64 + ((8 * seg + 4) ^ sw));
            f32x4 a = *p0a, bq = *p0b, c = *p1a, d = *p1b;
            a.y += a.x; a.z += a.y; a.w += a.z; bq.x += a.w; bq.y += bq.x; bq.z += bq.y; bq.w += bq.z;
            d.z += d.w; d.y += d.z; d.x += d.y; c.w += d.x; c.z += c.w; c.y += c.z; c.x += c.y;
            SEG[seg * 64 + ch2] = bq.w; SEG[(8 + seg) * 64 + ch2] = c.x;
            __syncthreads();
            float off0 = 0.f, off1 = 0.f;
#pragma unroll
            for (int s2 = 0; s2 < 8; ++s2) { const float t0 = SEG[s2 * 64 + ch2], t1 = SEG[(8 + s2) * 64 + ch2]; off0 += (s2 < seg) ? t0 : 0.f; off1 += (s2 > seg) ? t1 : 0.f; }
            *p0a = a + off0; *p0b = bq + off0; *p1a = c + off1; *p1b = d + off1;
        }
        __syncthreads();
        {
            const float inv = 1.0f / fmaxf(sqrtf(ssq), 1e-12f);
            float t8[8], u8[8], w8[8], r8v[8];
            {
                LAS unsigned char* t0 = F.lds; const int tau = tok;
                float e1[8], ei[8];
#pragma unroll
                for (int i = 0; i < 8; ++i) { const int ch = ch0 + i; const float cm = LW0[ch * 64 + (tok ^ (4 * ((ch & 15) ^ (2 * (ch >> 4)))))]; e1[i] = __expf(cm); ei[i] = __builtin_amdgcn_rcpf(e1[i]); t8[i] = kkp[i] * inv * __expf(cm - lw0[i]); }
                if (tok == 63) {
#pragma unroll
                    for (int i = 0; i < 8; ++i) GAM[ch0 + i] = e1[i]; }
#pragma unroll
                for (int i = 0; i < 8; ++i) { u8[i] = kkp[i] * inv * a_0[i] * ei[i]; w8[i] = kd0[i] * ei[i]; r8v[i] = rs[i] * e1[i]; }
                putN(t0 + 0 * TILE, tau, oct, t8); putN(t0 + 1 * TILE, tau, oct, u8); putN(t0 + 2 * TILE, tau, oct, w8); putN(t0 + 3 * TILE, tau, oct, vs); putN(t0 + 4 * TILE, tau, oct, r8v);
            }
            {
                LAS unsigned char* t1 = F.lds + 9 * TILE; const int tau = 63 - tok;
                float e1[8], ei[8];
#pragma unroll
                for (int i = 0; i < 8; ++i) { const int ch = ch0 + i; const float cm = LW1[ch * 64 + (tok ^ (4 * ((ch & 15) ^ (2 * (ch >> 4)))))]; e1[i] = __expf(cm); ei[i] = __builtin_amdgcn_rcpf(e1[i]); t8[i] = kkp[i] * inv * __expf(cm - lw1[i]); }
                if (tok == 0) {
#pragma unroll
                    for (int i = 0; i < 8; ++i) GAM[64 + ch0 + i] = e1[i]; }
#pragma unroll
                for (int i = 0; i < 8; ++i) { u8[i] = kkp[i] * inv * a_1[i] * ei[i]; w8[i] = kd1[i] * ei[i]; r8v[i] = rs[i] * e1[i]; }
                putN(t1 + 0 * TILE, tau, oct, t8); putN(t1 + 1 * TILE, tau, oct, u8); putN(t1 + 2 * TILE, tau, oct, w8); putN(t1 + 3 * TILE, tau, oct, vs); putN(t1 + 4 * TILE, tau, oct, r8v);
            }
        }
        const size_t inst = (size_t)unit * 2 + dgrp;
        epre_load<true>(PF, z, LO, unit + F.G < NU ? unit + F.G : unit, wave, lane);
        const int cv_strip = F.gw + (cv_t >> 4) * F.NGW, cv_kb = cv_t & 15;
        if (!SEAM_FILL) { int e_, n0_, rb_; wei_strip(cv_strip < NE * 64 ? cv_strip : 0, e_, n0_, rb_); cv_load(cvt, cv_w + (size_t)e_ * D * 2048, 2048, n0_, cv_kb, lane); }
        __syncthreads();
        f32x4 acc[4], acc2[4];
        zero4(acc); mm64x<false, false>(acc, SL(1), SL(0), wq, lane);
        zero4(acc2); mm64x<false, false>(acc2, SL(2), SL(0), wq, lane);
#pragma unroll
        for (int n = 0; n < 4; ++n)
#pragma unroll
            for (int q = 0; q < 4; ++q) { const bool lo = (16 * wq + 4 * g + q < 16 * n + lr); acc[n][q] = lo ? acc[n][q] : 0.f; acc2[n][q] = lo ? acc2[n][q] : 0.f; }
        storeT(SL(5), acc, wq, lane); storeT(SL(6), acc2, wq, lane);
        __syncthreads();
        zero4(acc); mm64x<false, true>(acc, SL(6), SL(3), wq, lane); storeT(SL(7), acc, wq, lane);
        if (wq == 0) {
            const int bb = lane >> 4, jj = lane & 15;
            float X[16];
            X[0] = (jj == 0) ? 1.f : 0.f;
#pragma unroll
            for (int t = 1; t < 16; ++t) {
                const int row = 16 * bb + t;
                const v4u p0 = *(const LAS v4u*)(SL(5) + row * 128 + (((2 * bb) ^ swz(row)) << 4)), p1 = *(const LAS v4u*)(SL(5) + row * 128 + (((2 * bb + 1) ^ swz(row)) << 4));
                float rw[16];
                rw[0] = bflo(p0.x); rw[1] = bfhi(p0.x); rw[2] = bflo(p0.y); rw[3] = bfhi(p0.y); rw[4] = bflo(p0.z); rw[5] = bfhi(p0.z); rw[6] = bflo(p0.w); rw[7] = bfhi(p0.w);
                rw[8] = bflo(p1.x); rw[9] = bfhi(p1.x); rw[10] = bflo(p1.y); rw[11] = bfhi(p1.y); rw[12] = bflo(p1.z); rw[13] = bfhi(p1.z); rw[14] = bflo(p1.w); rw[15] = bfhi(p1.w);
                float xv = (t == jj) ? 1.f : 0.f;
#pragma unroll
                for (int s = 0; s < t; ++s) xv -= rw[s] * X[s];
                X[t] = xv;
            }
#pragma unroll
            for (int t = 0; t < 16; ++t) *(LAS unsigned short*)(DIB + (((bb * 16 + t) * 16 + jj) << 1)) = (unsigned short)f2bf(X[t]);
        }
        __syncthreads();
        {
            const bool isU = wq >= 2; const int cbase = 32 * (wq & 1);
            LAS unsigned char* outT = isU ? SL(6) : SL(8);
#pragma unroll
            for (int ct = 0; ct < 2; ++ct) {
                const int ctile = 2 * (wq & 1) + ct, col = cbase + 16 * ct + lr;
                f32x4 X[4];
#pragma unroll
                for (int b2 = 0; b2 < 4; ++b2) {
                    f32x4 Zt;
                    if (isU) { const v2u rwv = *(const LAS v2u*)(SL(7) + toff(col, 16 * b2 + 4 * g)); Zt = (f32x4){bflo(rwv.x), bfhi(rwv.x), bflo(rwv.y), bfhi(rwv.y)}; }
                    else Zt = loadN_acc(SL(0), b2, ctile, lane);
                    if (b2 >= 1) {
                        f32x4 Y = {0.f, 0.f, 0.f, 0.f};
#pragma unroll
                        for (int s = 0; s < (b2 + 1) / 2; ++s) {
                            v2u alo = {0u, 0u}, ahi = {0u, 0u};
                            if (2 * s < b2) alo = *(const LAS v2u*)(SL(5) + toff(16 * b2 + lr, 32 * s + 4 * g));
                            if (2 * s + 1 < b2) ahi = *(const LAS v2u*)(SL(5) + toff(16 * b2 + lr, 32 * s + 16 + 4 * g));
                            v4u bw = {cvtpk(X[2 * s][0], X[2 * s][1]), cvtpk(X[2 * s][2], X[2 * s][3]), 0u, 0u};
                            if (2 * s + 1 < b2) { bw.z = cvtpk(X[2 * s + 1][0], X[2 * s + 1][1]); bw.w = cvtpk(X[2 * s + 1][2], X[2 * s + 1][3]); }
                            Y = CK_MFMA(__builtin_bit_cast(bf16x8, ((v4u){alo.x, alo.y, ahi.x, ahi.y})), __builtin_bit_cast(bf16x8, bw), Y);
                        }
                        Zt = Zt - Y;
                    }
                    const v2u dv = *(const LAS v2u*)(DIB + (((b2 * 16 + lr) * 16 + 4 * g) << 1));
                    const v4u bz = {cvtpk(Zt[0], Zt[1]), cvtpk(Zt[2], Zt[3]), 0u, 0u};
                    X[b2] = CK_MFMA(__builtin_bit_cast(bf16x8, ((v4u){dv.x, dv.y, 0u, 0u})), __builtin_bit_cast(bf16x8, bz), ((f32x4){0.f, 0.f, 0.f, 0.f}));
                }
#pragma unroll
                for (int b2 = 0; b2 < 4; ++b2) *(LAS v2u*)(outT + toff(col, 16 * b2 + 4 * g)) = (v2u){cvtpk(X[b2][0], X[b2][1]), cvtpk(X[b2][2], X[b2][3])};
            }
        }
        __syncthreads();
        asm volatile("" : "+v"(PF.k[0]), "+v"(PF.k[1]), "+v"(PF.k[2]), "+v"(PF.k[3]), "+v"(PF.k[4]), "+v"(PF.v[0]), "+v"(PF.v[1]), "+v"(PF.v[2]), "+v"(PF.v[3]), "+v"(PF.v[4]));
        asm volatile("" : "+v"(PF.r[0]), "+v"(PF.r[1]), "+v"(PF.r[2]), "+v"(PF.r[3]), "+v"(PF.r[4]), "+v"(PF.lo[0]), "+v"(PF.lo[1]), "+v"(PF.lo[2]), "+v"(PF.lo[3]));
        if (!SEAM_FILL) asm volatile("" : "+v"(cvt.v[0]), "+v"(cvt.v[1]), "+v"(cvt.v[2]), "+v"(cvt.v[3]), "+v"(cvt.v[4]), "+v"(cvt.v[5]), "+v"(cvt.v[6]), "+v"(cvt.v[7]));
        {
            zero4(acc); mm64x<false, true>(acc, SL(8), SL(1), wq, lane);
            const int cstep_ = unit < NU_L ? 4 + (dgrp ? 127 - ((unit >> 4) & 127) : ((unit >> 4) & 127)) : (dgrp ? 3 - (((unit - NU_L) >> 4) & 3) : (((unit - NU_L) >> 4) & 3));
            unsigned char* pb = PQ + (size_t)(((b * 16 + h) * 2 + dgrp) * (4 + T / 64) + cstep_) * 16384;
#pragma unroll
            for (int n = 0; n < 4; ++n) { const int k = 16 * n + lr; const float gm = GAM[dgrp * 64 + k]; float p[4];
#pragma unroll
                for (int q = 0; q < 4; ++q) p[q] = gm * (((16 * wq + 4 * g + q) == k ? 1.f : 0.f) - acc[n][q]);
                *(uint2*)(pb + (size_t)(((n * 2 + (wq >> 1)) * 64 + lane) * 16 + (wq & 1) * 8)) = make_uint2(cvtpk(p[0], p[1]), cvtpk(p[2], p[3])); }
            zero4(acc); mm64x<true, true>(acc, SL(2), SL(3), wq, lane); zero4(acc2); mm64x<true, false>(acc2, SL(1), SL(6), wq, lane);
            const f32x4 gm4 = *(const LAS f32x4*)(GAM + dgrp * 64 + 16 * wq + 4 * g);
#pragma unroll
            for (int n = 0; n < 4; ++n) { const f32x4 qv = (acc[n] - acc2[n]) * gm4;
                *(uint2*)(pb + 8192 + (size_t)(((n * 64 + lane) * 4 + wq) * 8)) = make_uint2(cvtpk(qv[0], qv[1]), cvtpk(qv[2], qv[3])); }
            if (unit < NU_L) {
                zero4(acc); mm64x<false, false>(acc, SL(2), SL(4), wq, lane);
                zero4(acc2); mm64x<false, false>(acc2, SL(1), SL(4), wq, lane);
#pragma unroll
                for (int n = 0; n < 4; ++n)
#pragma unroll
                    for (int q = 0; q < 4; ++q) { const bool le = (16 * wq + 4 * g + q <= 16 * n + lr); acc[n][q] = le ? acc[n][q] : 0.f; acc2[n][q] = le ? -acc2[n][q] : 0.f; }
                storeT(SL(5), acc, wq, lane); storeT(SL(7), acc2, wq, lane);
            }
        }
        __syncthreads();
        if (unit < NU_L) {
            loadT(acc, SL(4), wq, lane);
            mm64x<false, false>(acc, SL(8), SL(7), wq, lane);
            unsigned char* rb = RHAT + inst * 8192;
#pragma unroll
            for (int n = 0; n < 4; ++n) *(uint2*)(rb + (size_t)((16 * n + lr) * 64 + 16 * wq + 4 * g) * 2) = make_uint2(cvtpk(acc[n][0], acc[n][1]), cvtpk(acc[n][2], acc[n][3]));
            zero4(acc2); mm64x<false, true>(acc2, SL(5), SL(3), wq, lane); mm64x<false, false>(acc2, SL(7), SL(6), wq, lane);
            unsigned char* yb = YLOC + inst * 8192 + (size_t)((wq * 64 + lane) * 32);
            v4u o0, o1; o0.x = cvtpk(acc2[0][0], acc2[0][1]); o0.y = cvtpk(acc2[0][2], acc2[0][3]); o0.z = cvtpk(acc2[1][0], acc2[1][1]); o0.w = cvtpk(acc2[1][2], acc2[1][3]);
            o1.x = cvtpk(acc2[2][0], acc2[2][1]); o1.y = cvtpk(acc2[2][2], acc2[2][3]); o1.z = cvtpk(acc2[3][0], acc2[3][1]); o1.w = cvtpk(acc2[3][2], acc2[3][3]);
            *(v4u*)yb = o0; *(v4u*)(yb + 16) = o1;
        }
        __syncthreads();
        if (!SEAM_FILL) {
            if (cv_strip < NE * 64) { int e_, n0_, rb_; wei_strip(cv_strip, e_, n0_, rb_);
                if (cv_kb == 0 && cv_t > 0) cv_scale_q8(cv_w + (size_t)e_ * D * 2048, 2048, n0_, (float*)(F.ws + MI_CSWEI) + (size_t)e_ * 2048, rb_, lane, civ);
                cv_store_q8(cvt, cv_scr, (signed char*)(F.ws + WS_WEIN) + (size_t)e_ * 2048 * D, rb_, cv_kb, civ, lane); }
            ++cv_t;
            __syncthreads();
        }
    }
    for (; !SEAM_FILL;) { const int s_ = F.gw + (cv_t >> 4) * F.NGW, kb_ = cv_t & 15; if (s_ >= NE * 64) break;
        int e_, n0_, rb_; wei_strip(s_, e_, n0_, rb_);
        if (kb_ == 0 && cv_t > 0) cv_scale_q8(cv_w + (size_t)e_ * D * 2048, 2048, n0_, (float*)(F.ws + MI_CSWEI) + (size_t)e_ * 2048, rb_, F.lane, civ);
        cv_load(cvt, cv_w + (size_t)e_ * D * 2048, 2048, n0_, kb_, F.lane);
        cv_store_q8(cvt, cv_scr, (signed char*)(F.ws + WS_WEIN) + (size_t)e_ * 2048 * D, rb_, kb_, civ, F.lane); ++cv_t; }
#undef SL
}

__device__ __forceinline__ void phase_co2(Frame& F) {
    const int wave = F.wave;
    const int dgrp = wave >> 2, wq = wave & 3;
    LAS unsigned char* tl = F.lds + dgrp * 9 * TILE;
#define SL(k) (tl + (k) * TILE)
    const bf16* z = (const bf16*)(F.ws + WS_Z); const bf16* LO = (const bf16*)(F.ws + WS_LORA);
    const unsigned char* RHAT = F.ws + WS_TKN; const unsigned char* YLOC = F.ws + WS_UPRE; const unsigned char* H0T = F.ws + WS_H0T;
    const float* BON = (const float*)(F.ws + MI_BON);
    bf16* MG = (bf16*)(F.ws + WS_A0);
    const float* p_mu = KIN(I_MU);
    LAS float* PRM = (LAS float*)(F.lds + LDS_X_OFF + 8704);
    LAS unsigned char* VR = F.lds + 4 * TILE;
    LAS float* PX = (LAS float*)(F.lds + 5 * TILE);
    int h_prm = -1;
    for (int unit = blockIdx.x; unit < NU_L; unit += F.G) {
        int lane = F.lane; asm volatile("" : "+v"(lane));
        const int lr = lane & 15, g = lane >> 4;
        int b, h, rowbase; unit_decode(unit, b, h, rowbase);
        if (h != h_prm) {
            __syncthreads();
            if (F.tid < 96) { const int arr = F.tid >> 4, off = (F.tid & 15) * 4;
                const float* src = arr == 0 ? p_mu + V_OFF : arr == 1 ? KIN(I_LNW) : arr == 2 ? KIN(I_LNB) : KIN(I_CONVW) + (arr - 3) * D;
                *(LAS f32x4*)(PRM + arr * 64 + off) = *(const f32x4*)(src + h * 64 + off); }
            __syncthreads(); h_prm = h; }
        const int tok = 8 * wave + (lane >> 3), oct = lane & 7, ch0 = 8 * oct, c0 = h * 64 + ch0, row = rowbase + tok;
        const size_t inst = (size_t)unit * 2 + dgrp;
        const int t2 = (wq << 6) | lane;
#pragma unroll
        for (int rep = 0; rep < 2; ++rep) { const int cidx = t2 + 256 * rep, r_ = cidx >> 3, ch = cidx & 7;
            const v4u a = *(const v4u*)(RHAT + inst * 8192 + (size_t)(r_ * 64 + ch * 8) * 2), hh = *(const v4u*)(H0T + inst * 8192 + (size_t)(r_ * 64 + ch * 8) * 2);
            *(LAS v4u*)(SL(0) + r_ * 128 + ((ch ^ swz(r_)) << 4)) = a; *(LAS v4u*)(SL(1) + r_ * 128 + ((ch ^ swz(r_)) << 4)) = hh; }
        f32x4 acc[4];
        { const unsigned char* yb = YLOC + inst * 8192 + (size_t)((wq * 64 + lane) * 32); const v4u o0 = *(const v4u*)yb, o1 = *(const v4u*)(yb + 16);
          acc[0] = (f32x4){bflo(o0.x), bfhi(o0.x), bflo(o0.y), bfhi(o0.y)}; acc[1] = (f32x4){bflo(o0.z), bfhi(o0.z), bflo(o0.w), bfhi(o0.w)};
          acc[2] = (f32x4){bflo(o1.x), bfhi(o1.x), bflo(o1.y), bfhi(o1.y)}; acc[3] = (f32x4){bflo(o1.z), bfhi(o1.z), bflo(o1.w), bfhi(o1.w)}; }
        const int t = row & (T - 1);
        const bf16* zr = z + (size_t)row * NZ;
        const v4u zz = {0u, 0u, 0u, 0u};
        const v4u qv0 = *(const v4u*)(zr + V_OFF + c0);
        unsigned vmsk = (tok > 0 ? 1u : 0u) | (tok < 63 ? 2u : 0u);
        v4u qvu, qvd;
        { const int nu = nbr_row(row, 2), nd = nbr_row(row, 3); vmsk |= (nu >= 0 ? 4u : 0u) | (nd >= 0 ? 8u : 0u);
          qvu = *(const v4u*)(z + (size_t)(nu >= 0 ? nu : row) * NZ + V_OFF + c0); qvd = *(const v4u*)(z + (size_t)(nd >= 0 ? nd : row) * NZ + V_OFF + c0); }
        const v4u q_g = *(const v4u*)(LO + (size_t)row * NL + 4096 + c0);
        const v4u q_gb = *(const v4u*)(zr + CONV_OFF + c0), q_c0 = *(const v4u*)(zr + CONV_OFF + 1024 + c0), q_x0 = *(const v4u*)(zr + CONV_OFF + 2048 + c0);
        const v4u q_ga = *(const v4u*)(zr + GATE_OFF + c0), q_gr = *(const v4u*)(zr + GATE_OFF + 1024 + c0);
        v4u q_cm = zz, q_xm = zz, q_cp = zz, q_xp = zz;
        if (tok == 0 && t > 0) { q_cm = *(const v4u*)(zr - NZ + CONV_OFF + 1024 + c0); q_xm = *(const v4u*)(zr - NZ + CONV_OFF + 2048 + c0); }
        if (tok == 63 && t < T - 1) { q_cp = *(const v4u*)(zr + NZ + CONV_OFF + 1024 + c0); q_xp = *(const v4u*)(zr + NZ + CONV_OFF + 2048 + c0); }
        const float S3 = BON[(size_t)unit * 64 + tok];
        float cc[8], xx[8];
        unpack8(q_c0, cc); unpack8(q_x0, xx);
#pragma unroll
        for (int i = 0; i < 8; ++i) cc[i] *= xx[i];
        *(LAS v4u*)(VR + tok * 128 + oct * 16) = qv0;
        *(LAS f32x4*)(PX + tok * 64 + ch0) = (f32x4){cc[0], cc[1], cc[2], cc[3]}; *(LAS f32x4*)(PX + tok * 64 + ch0 + 4) = (f32x4){cc[4], cc[5], cc[6], cc[7]};
        __syncthreads();
        mm64x<false, false>(acc, SL(0), SL(1), wq, lane);
        { LAS float* Yf = (LAS float*)(tl + 2 * TILE);
#pragma unroll
          for (int n = 0; n < 4; ++n)
#pragma unroll
              for (int q = 0; q < 4; ++q) { const int tau = 16 * wq + 4 * g + q; Yf[tau * 64 + ((16 * n + lr) ^ (4 * (tau & 15)))] = acc[n][q]; } }
        __syncthreads();
        { const LAS float* Y0 = (const LAS float*)(F.lds + 2 * TILE); const LAS float* Y1 = (const LAS float*)(F.lds + 11 * TILE);
          float y[8];
          { const int s0 = 4 * (tok & 15), s1 = 4 * ((63 - tok) & 15);
            const f32x4 a0 = *(const LAS f32x4*)(Y0 + tok * 64 + (ch0 ^ s0)), a1 = *(const LAS f32x4*)(Y0 + tok * 64 + ((ch0 + 4) ^ s0));
            const f32x4 b0 = *(const LAS f32x4*)(Y1 + (63 - tok) * 64 + (ch0 ^ s1)), b1 = *(const LAS f32x4*)(Y1 + (63 - tok) * 64 + ((ch0 + 4) ^ s1));
            y[0] = a0.x + b0.x; y[1] = a0.y + b0.y; y[2] = a0.z + b0.z; y[3] = a0.w + b0.w; y[4] = a1.x + b1.x; y[5] = a1.y + b1.y; y[6] = a1.z + b1.z; y[7] = a1.w + b1.w; }
          float s1 = 0.f, s2 = 0.f;
#pragma unroll
          for (int i = 0; i < 8; ++i) { s1 += y[i]; s2 += y[i] * y[i]; }
          s1 += __shfl_xor(s1, 1); s2 += __shfl_xor(s2, 1); s1 += __shfl_xor(s1, 2); s2 += __shfl_xor(s2, 2); s1 += __shfl_xor(s1, 4); s2 += __shfl_xor(s2, 4);
          const float mean = s1 * (1.0f / 64.0f), var = fmaxf(s2 * (1.0f / 64.0f) - mean * mean, 0.f), rstd = __builtin_amdgcn_rsqf(var + 64e-5f);
          float vs[8];
          { v4u q[5]; q[0] = qv0; q[1] = *(const LAS v4u*)(VR + (tok > 0 ? tok - 1 : tok) * 128 + oct * 16); q[2] = *(const LAS v4u*)(VR + (tok < 63 ? tok + 1 : tok) * 128 + oct * 16); q[3] = qvu; q[4] = qvd;
            float m_[8]; ld8l(PRM + ch0, m_); shift8m(q, m_, vs, vmsk); }
          float lnw[8], lnb[8], cw0[8], cw1[8], cw2[8];
          ld8l(PRM + 64 + ch0, lnw); ld8l(PRM + 128 + ch0, lnb); ld8l(PRM + 192 + ch0, cw0); ld8l(PRM + 256 + ch0, cw1); ld8l(PRM + 320 + ch0, cw2);
          float gg[8], gb[8], pm[8], pp[8], ga[8], gr[8];
          unpack8(q_g, gg); unpack8(q_gb, gb); unpack8(q_ga, ga); unpack8(q_gr, gr);
          if (tok > 0) ld8l(PX + (tok - 1) * 64 + ch0, pm); else { float c_[8], x_[8]; unpack8(q_cm, c_); unpack8(q_xm, x_);
#pragma unroll
              for (int i = 0; i < 8; ++i) pm[i] = c_[i] * x_[i]; }
          if (tok < 63) ld8l(PX + (tok + 1) * 64 + ch0, pp); else { float c_[8], x_[8]; unpack8(q_cp, c_); unpack8(q_xp, x_);
#pragma unroll
              for (int i = 0; i < 8; ++i) pp[i] = c_[i] * x_[i]; }
          float o[8];
#pragma unroll
          for (int i = 0; i < 8; ++i) {
              const float yn = (y[i] - mean) * rstd * lnw[i] + lnb[i];
              const float yr = (yn + S3 * vs[i]) * gg[i];
              const float yc = gb[i] * (cw0[i] * pm[i] + cw1[i] * cc[i] + cw2[i] * pp[i]);
              o[i] = fsig(ga[i]) * yr + fsig(gr[i]) * yc;
          }
          v4u ov; ov.x = cvtpk(o[0], o[1]); ov.y = cvtpk(o[2], o[3]); ov.z = cvtpk(o[4], o[5]); ov.w = cvtpk(o[6], o[7]);
          *(v4u*)(MG + (size_t)row * D + c0) = ov;
        }
        __syncthreads();
    }
#undef SL
}

struct SSIn { v4u a[8]; v4u q[2]; };
__device__ __forceinline__ size_t ss_pq(int step, int b, int h, int d) { return (size_t)(((b * 16 + h) * 2 + d) * (4 + T / 64) + step); }
__device__ __forceinline__ size_t ss_inst(int step, int b, int h, int d) {
    int unit;
    if (step < 4) { const int cb = d ? 3 - step : step; unit = NU_L + (b * 4 + cb) * 16 + h; }
    else { const int blk = d ? 127 - (step - 4) : step - 4; unit = (b * 128 + blk) * 16 + h; }
    return (size_t)unit * 2 + d;
}
__device__ __forceinline__ void ss_load(SSIn& I, const unsigned char* PQ, size_t inst, int wv, int lane) {
    const unsigned char* pb = PQ + inst * 16384;
#pragma unroll
    for (int f = 0; f < 8; ++f) I.a[f] = *(const v4u*)(pb + (size_t)((f * 64 + lane) * 16));
    I.q[0] = *(const v4u*)(pb + 8192 + (size_t)((wv * 64 + lane) * 32)); I.q[1] = *(const v4u*)(pb + 8192 + (size_t)((wv * 64 + lane) * 32 + 16));
}
__device__ __forceinline__ void ss_step(f32x4 (&H)[4], const SSIn& cur, unsigned char* H0T, size_t inst, bool store_h0, int wv, int lr, int g) {
    const unsigned p00 = cvtpk(H[0][0], H[0][1]), p01 = cvtpk(H[0][2], H[0][3]), p10 = cvtpk(H[1][0], H[1][1]), p11 = cvtpk(H[1][2], H[1][3]);
    const unsigned p20 = cvtpk(H[2][0], H[2][1]), p21 = cvtpk(H[2][2], H[2][3]), p30 = cvtpk(H[3][0], H[3][1]), p31 = cvtpk(H[3][2], H[3][3]);
    if (store_h0) { unsigned char* hb = H0T + inst * 8192 + (size_t)((16 * wv + lr) * 64 + 4 * g) * 2;
        *(uint2*)(hb) = make_uint2(p00, p01); *(uint2*)(hb + 32) = make_uint2(p10, p11); *(uint2*)(hb + 64) = make_uint2(p20, p21); *(uint2*)(hb + 96) = make_uint2(p30, p31); }
    const bf16x8 b0 = __builtin_bit_cast(bf16x8, ((v4u){p00, p01, p10, p11})), b1 = __builtin_bit_cast(bf16x8, ((v4u){p20, p21, p30, p31}));
    H[0] = (f32x4){bflo(cur.q[0].x), bfhi(cur.q[0].x), bflo(cur.q[0].y), bfhi(cur.q[0].y)}; H[1] = (f32x4){bflo(cur.q[0].z), bfhi(cur.q[0].z), bflo(cur.q[0].w), bfhi(cur.q[0].w)};
    H[2] = (f32x4){bflo(cur.q[1].x), bfhi(cur.q[1].x), bflo(cur.q[1].y), bfhi(cur.q[1].y)}; H[3] = (f32x4){bflo(cur.q[1].z), bfhi(cur.q[1].z), bflo(cur.q[1].w), bfhi(cur.q[1].w)};
#pragma unroll
    for (int m = 0; m < 4; ++m) { H[m] = CK_MFMA(__builtin_bit_cast(bf16x8, cur.a[2 * m]), b0, H[m]); H[m] = CK_MFMA(__builtin_bit_cast(bf16x8, cur.a[2 * m + 1]), b1, H[m]); }
}
__device__ __forceinline__ void phase_ss(Frame& F) {
    const unsigned char* PQ = F.ws + WS_PQ; unsigned char* H0T = F.ws + WS_H0T;
    const int lane = F.lane, lr = lane & 15, g = lane >> 4;
    for (int task = F.vb; task < 256; task += F.G) {
        const int chain = (task & 7) + 8 * (task >> 5), wv = (task >> 3) & 3, b = chain >> 5, h = (chain >> 1) & 15, d = chain & 1;
        f32x4 H[4]; zero4(H);
        constexpr int NS = 4 + T / 64;
        static_assert(NS % 4 == 0, "unrolled by four");
        SSIn b0, b1, b2, b3;
        ss_load(b0, PQ, ss_pq(0, b, h, d), wv, lane); ss_load(b1, PQ, ss_pq(1, b, h, d), wv, lane); ss_load(b2, PQ, ss_pq(2, b, h, d), wv, lane); ss_load(b3, PQ, ss_pq(3, b, h, d), wv, lane);
        for (int step = 0; step < NS; step += 4) {
            const int n0 = step + 4 < NS ? step + 4 : NS - 1, n1 = step + 5 < NS ? step + 5 : NS - 1, n2 = step + 6 < NS ? step + 6 : NS - 1, n3 = step + 7 < NS ? step + 7 : NS - 1;
            ss_step(H, b0, H0T, ss_inst(step, b, h, d), step >= 4, wv, lr, g);     ss_load(b0, PQ, ss_pq(n0, b, h, d), wv, lane);
            ss_step(H, b1, H0T, ss_inst(step + 1, b, h, d), step >= 4, wv, lr, g); ss_load(b1, PQ, ss_pq(n1, b, h, d), wv, lane);
            ss_step(H, b2, H0T, ss_inst(step + 2, b, h, d), step >= 4, wv, lr, g); ss_load(b2, PQ, ss_pq(n2, b, h, d), wv, lane);
            ss_step(H, b3, H0T, ss_inst(step + 3, b, h, d), step >= 4, wv, lr, g); ss_load(b3, PQ, ss_pq(n3, b, h, d), wv, lane);
        }
    }
}

struct LoraARaw { v4u q[5]; f32x4 m0, m1; };
__device__ __forceinline__ int lora_acol(int gi, int oct) { return (gi < 4 ? DECAY_OFF + 64 * gi : GLORA_OFF + 64 * (gi - 4)) + 8 * oct; }
__device__ __forceinline__ unsigned lora_aload(LoraARaw& R, const bf16* z, const float* p_mu, int r0, int gi, int wave, int lane) {
    const int tok = 8 * wave + (lane >> 3), oct = lane & 7, row = r0 + tok, col = lora_acol(gi, oct);
    R.q[0] = *(const v4u*)(z + (size_t)row * NZ + col);
    unsigned msk = 0u;
#pragma unroll
    for (int j = 0; j < 4; ++j) { const int nr = nbr_row(row, j); msk |= (nr >= 0 ? 1u : 0u) << j; R.q[1 + j] = *(const v4u*)(z + (size_t)(nr >= 0 ? nr : row) * NZ + col); }
    R.m0 = *(const f32x4*)(p_mu + col); R.m1 = *(const f32x4*)(p_mu + col + 4);
    return msk;
}
__device__ __forceinline__ void lora_astore(const LoraARaw& R, unsigned msk, LAS unsigned char* lds, int gi, int wave, int lane) {
    const int tok = 8 * wave + (lane >> 3), oct = lane & 7;
    const v4u zz = {0u, 0u, 0u, 0u};
    const v4u s = R.q[0], n0 = (msk & 1u) ? R.q[1] : zz, n1 = (msk & 2u) ? R.q[2] : zz, n2 = (msk & 4u) ? R.q[3] : zz, n3 = (msk & 8u) ? R.q[4] : zz;
    float v[8];
    v[0] = bflo(s.x) + R.m0.x * (bflo(n0.x) - bflo(s.x)); v[1] = bfhi(s.x) + R.m0.y * (bfhi(n1.x) - bfhi(s.x));
    v[2] = bflo(s.y) + R.m0.z * (bflo(n2.y) - bflo(s.y)); v[3] = bfhi(s.y) + R.m0.w * (bfhi(n3.y) - bfhi(s.y));
    v[4] = bflo(s.z) + R.m1.x * (bflo(n0.z) - bflo(s.z)); v[5] = bfhi(s.z) + R.m1.y * (bfhi(n1.z) - bfhi(s.z));
    v[6] = bflo(s.w) + R.m1.z * (bflo(n2.w) - bflo(s.w)); v[7] = bfhi(s.w) + R.m1.w * (bfhi(n3.w) - bfhi(s.w));
#pragma unroll
    for (int i = 0; i < 8; ++i) v[i] = gi < 2 ? 1.0f - 2.0f * __builtin_amdgcn_rcpf(1.0f + __expf(2.0f * v[i])) : (gi < 4 ? v[i] : fsig(v[i]));
    putN(lds + gi * TILE, tok, oct, v);
}
__device__ __forceinline__ void lora_atile(const bf16* z, const float* p_mu, LAS unsigned char* lds, int r0, int gi, int wave, int lane) {
    LoraARaw R; const unsigned msk = lora_aload(R, z, p_mu, r0, gi, wave, lane); lora_astore(R, msk, lds, gi, wave, lane);
}
template <int KS> struct LoraB { bf16x8 w[KS][4]; };
template <int KS>
__device__ __forceinline__ void lora_bload(LoraB<KS>& B, const bf16* WL, int q, int lr, int g) {
    const int blkid = q >> 4, h = q & 15;
    const bf16* wrow = WL + (size_t)(blkid * 1024 + h * 64 + 8 * (lr >> 2) + (lr & 3)) * KL + blkid * 64 + 8 * g;
#pragma unroll
    for (int s = 0; s < KS; ++s)
#pragma unroll
        for (int n = 0; n < 4; ++n) B.w[s][n] = *(const bf16x8*)(wrow + (size_t)(32 * (n >> 1) + 4 * (n & 1)) * KL + 32 * s);
}
template <int KS>
__device__ __forceinline__ void lora_product(const LoraB<KS>& B, const LAS unsigned char* At, bf16* LO, int r0, int q, int lr, int g, const LAS float* LBI) {
    const int blkid = q >> 4, h = q & 15;
    f32x4 acc[4][4];
#pragma unroll
    for (int n = 0; n < 4; ++n)
#pragma unroll
        for (int m = 0; m < 4; ++m) acc[n][m] = (f32x4){0.f, 0.f, 0.f, 0.f};
#pragma unroll
    for (int s = 0; s < KS; ++s) {
        bf16x8 af[4];
#pragma unroll
        for (int m = 0; m < 4; ++m) af[m] = ldfrag(At + (s >> 1) * TILE, 16 * m + lr, 4 * (s & 1) + g);
#pragma unroll
        for (int n = 0; n < 4; ++n)
#pragma unroll
            for (int m = 0; m < 4; ++m) acc[n][m] = CK_MFMA(B.w[s][n], af[m], acc[n][m]);
    }
    bf16* ob = LO + (size_t)(r0 + lr) * NL + blkid * 1024 + h * 64 + 8 * g;
#pragma unroll
    for (int m = 0; m < 4; ++m)
#pragma unroll
        for (int p = 0; p < 2; ++p) {
            f32x4 v0 = acc[2 * p][m], v1 = acc[2 * p + 1][m];
            if (KS == 2) {
                const LAS float* bp = LBI + blkid * 1024 + h * 64 + 8 * g + 32 * p; const f32x4 b0 = *(const LAS f32x4*)bp, b1 = *(const LAS f32x4*)(bp + 4); const float sc = blkid < 2 ? -0.6065306597126334f : 1.0f;
#pragma unroll
                for (int e = 0; e < 4; ++e) { v0[e] = sc * fsig(v0[e] + b0[e]); v1[e] = sc * fsig(v1[e] + b1[e]); }
            }
            v4u o; o.x = cvtpk(v0[0], v0[1]); o.y = cvtpk(v0[2], v0[3]); o.z = cvtpk(v1[0], v1[1]); o.w = cvtpk(v1[2], v1[3]);
            *(v4u*)(ob + (size_t)(16 * m) * NL + 32 * p) = o; }
}
__device__ __forceinline__ void phase_lora(Frame& F) {
    const bf16* z = (const bf16*)(F.ws + WS_Z); bf16* LO = (bf16*)(F.ws + WS_LORA); const bf16* WL = (const bf16*)(F.ws + WS_WLORA);
    const float* p_mu = KIN(I_MU); const float* p_w0 = KIN(I_W0); const float* p_a0 = KIN(I_A0);
    LAS float* LBI = (LAS float*)(F.lds + 15 * TILE);
    { const int i4 = F.tid * 4; *(LAS f32x4*)(LBI + i4) = *(const f32x4*)(p_w0 + i4); *(LAS f32x4*)(LBI + 2048 + i4) = *(const f32x4*)(p_a0 + i4); }
    __syncthreads();
    for (int unit = blockIdx.x; unit < ML / 64; unit += F.G) {
        int lane = F.lane; asm volatile("" : "+v"(lane));
        const int lr = lane & 15, g = lane >> 4, r0 = unit * 64;
#pragma unroll
        for (int gb = 0; gb < 6; gb += 3) {
            LoraARaw R0, R1, R2;
            const unsigned k0 = lora_aload(R0, z, p_mu, r0, gb, F.wave, lane), k1 = lora_aload(R1, z, p_mu, r0, gb + 1, F.wave, lane), k2 = lora_aload(R2, z, p_mu, r0, gb + 2, F.wave, lane);
            __builtin_amdgcn_sched_barrier(0);
            lora_astore(R0, k0, F.lds, gb, F.wave, lane); lora_astore(R1, k1, F.lds, gb + 1, F.wave, lane); lora_astore(R2, k2, F.lds, gb + 2, F.wave, lane);
        }
        __syncthreads();
        const float* weo = KIN(I_WEO); bf16* WEO = (bf16*)(F.ws + WS_WEOUT);
        LAS float* fscr = (LAS float*)(F.lds + 6 * TILE + F.wave * 8704);
        const int ft0 = (unit * NWAVES + F.wave) * 10;
        CvTile ft;
#define LORA_FILL_LOAD(p) do { if (SEAM_FILL) break; const int id0_ = ft0 + (p), id_ = id0_ < NE * 512 ? id0_ : 0; const int e_ = id_ >> 9, q_ = id_ & 511; cv_load(ft, weo + (size_t)e_ * D * D, D, 32 * (q_ & 31), q_ >> 5, lane); } while (0)
#define LORA_FILL_STORE(p) do { const int id_ = ft0 + (p); if (!SEAM_FILL && id_ < NE * 512) { const int e_ = id_ >> 9, q_ = id_ & 511; cv_to_lds(ft, fscr, lane); cv_store_bf16(fscr, WEO + (size_t)e_ * D * D, D, 32 * (q_ & 31), 64 * (q_ >> 5), lane); } } while (0)
        LoraB<2> b0, b1;
        lora_bload<2>(b0, WL, F.wave, lr, g);
#pragma unroll
        for (int i = 0; i < 8; i += 2) {
            lora_bload<2>(b1, WL, F.wave + 8 * (i + 1), lr, g); LORA_FILL_LOAD(i);
            lora_product<2>(b0, F.lds + ((F.wave + 8 * i) >> 4) * TILE, LO, r0, F.wave + 8 * i, lr, g, LBI);
            LORA_FILL_STORE(i);
            if (i + 2 < 8) lora_bload<2>(b0, WL, F.wave + 8 * (i + 2), lr, g);
            LORA_FILL_LOAD(i + 1);
            lora_product<2>(b1, F.lds + ((F.wave + 8 * (i + 1)) >> 4) * TILE, LO, r0, F.wave + 8 * (i + 1), lr, g, LBI);
            LORA_FILL_STORE(i + 1);
        }
        { LoraB<4> c0; lora_bload<4>(c0, WL, 64 + F.wave, lr, g); LORA_FILL_LOAD(8); lora_product<4>(c0, F.lds + 4 * TILE, LO, r0, 64 + F.wave, lr, g, LBI); LORA_FILL_STORE(8);
          lora_bload<4>(c0, WL, 72 + F.wave, lr, g); LORA_FILL_LOAD(9); lora_product<4>(c0, F.lds + 4 * TILE, LO, r0, 72 + F.wave, lr, g, LBI); LORA_FILL_STORE(9); }
#undef LORA_FILL_LOAD
#undef LORA_FILL_STORE
        __syncthreads();
    }
    for (int t = blockIdx.x; t < (MC / 64) * 32; t += F.G) {
        int lane = F.lane; asm volatile("" : "+v"(lane));
        const int lr = lane & 15, g = lane >> 4, r0 = ML + (t >> 5) * 64, q0 = 2 * (t & 31), gi = q0 >> 4;
        lora_atile(z, p_mu, F.lds, r0, gi, F.wave, lane);
        __syncthreads();
        if (F.wave < 2) { LoraB<2> b0; lora_bload<2>(b0, WL, q0 + F.wave, lr, g); lora_product<2>(b0, F.lds + gi * TILE, LO, r0, q0 + F.wave, lr, g, LBI); }
        __syncthreads();
    }
}

__device__ __forceinline__ void ss2_load(v4u& ra, v4u& rq, const unsigned char* PQ, size_t inst, int wv, int wave, int lane) {
    const unsigned char* pb = PQ + inst * 16384;
    ra = *(const v4u*)(pb + (size_t)((wave * 64 + lane) * 16));
    if (wave < 2) rq = *(const v4u*)(pb + 8192 + (size_t)((wv * 64 + lane) * 32 + 16 * wave));
}
__device__ __forceinline__ void phase_ss2(Frame& F) {
    const unsigned char* PQ = F.ws + WS_PQ; unsigned char* H0T = F.ws + WS_H0T;
    const int lane = F.lane, wave = F.wave, lr = lane & 15, g = lane >> 4;
    LAS unsigned char* ring = F.lds;
    constexpr int SLOT = 10240, NS = 4 + T / 64, DEPTH = 12;
    static_assert(NS % DEPTH == 0, "unrolled by DEPTH");
    for (int task = (int)blockIdx.x; task < 256; task += F.G) {
        const int chain = task >> 2, wv = task & 3, b = chain >> 5, h = (chain >> 1) & 15, d = chain & 1;
        f32x4 H[4]; zero4(H);
        v4u ra[DEPTH], rq[DEPTH];
#pragma unroll
        for (int k = 0; k < DEPTH; ++k) { rq[k] = (v4u){0u, 0u, 0u, 0u}; ss2_load(ra[k], rq[k], PQ, ss_pq(k, b, h, d), wv, wave, lane); }
        for (int step = 0; step < NS; step += DEPTH) {
#pragma unroll
            for (int k = 0; k < DEPTH; ++k) {
                const int st = step + k; LAS unsigned char* sl = ring + (st & 1) * SLOT;
                *(LAS v4u*)(sl + (wave * 64 + lane) * 16) = ra[k]; if (wave < 2) *(LAS v4u*)(sl + 8192 + (wave * 64 + lane) * 16) = rq[k];
                { const int nx = st + DEPTH < NS ? st + DEPTH : NS - 1; ss2_load(ra[k], rq[k], PQ, ss_pq(nx, b, h, d), wv, wave, lane); }
                __syncthreads();
                if (wave == 0) { SSIn cur;
#pragma unroll
                    for (int f = 0; f < 8; ++f) cur.a[f] = *(const LAS v4u*)(sl + (f * 64 + lane) * 16);
                    cur.q[0] = *(const LAS v4u*)(sl + 8192 + lane * 16); cur.q[1] = *(const LAS v4u*)(sl + 8192 + (64 + lane) * 16);
                    ss_step(H, cur, H0T, ss_inst(st, b, h, d), st >= 4, wv, lr, g); }
            }
        }
        __syncthreads();
    }
}

__device__ __forceinline__ void ss3_load(v4u& a0, v4u& a1, v2u& q, const unsigned char* PQ, size_t pq, int wv, int m, int lane) {
    const unsigned char* pb = PQ + pq * 16384;
    a0 = *(const v4u*)(pb + (size_t)(((2 * m) * 64 + lane) * 16)); a1 = *(const v4u*)(pb + (size_t)(((2 * m + 1) * 64 + lane) * 16));
    q = *(const v2u*)(pb + 8192 + (size_t)((wv * 64 + lane) * 32 + 8 * m));
}
__device__ __forceinline__ void phase_ss3(Frame& F) {
    const unsigned char* PQ = F.ws + WS_PQ; unsigned char* H0T = F.ws + WS_H0T;
    const int lane = F.lane, wave = F.wave, lr = lane & 15, g = lane >> 4, m = wave & 3;
    LAS unsigned char* xch = F.lds;
    constexpr int NS = 4 + T / 64, DEPTH = 12;
    static_assert(NS % DEPTH == 0, "unrolled by DEPTH");
    for (int task = (int)blockIdx.x; task < 256; task += F.G) {
        const int chain = task >> 2, wv = task & 3, b = chain >> 5, h = (chain >> 1) & 15, d = chain & 1;
        f32x4 H = {0.f, 0.f, 0.f, 0.f};
        v4u a0[DEPTH], a1[DEPTH]; v2u qv[DEPTH];
        if (wave < 4) {
#pragma unroll
            for (int k = 0; k < DEPTH; ++k) ss3_load(a0[k], a1[k], qv[k], PQ, ss_pq(k, b, h, d), wv, m, lane);
        }
        for (int step = 0; step < NS; step += DEPTH) {
#pragma unroll
            for (int k = 0; k < DEPTH; ++k) {
                const int st = step + k; LAS unsigned char* xs = xch + (st & 1) * 2048;
                if (wave < 4) {
                    const v2u pk = {cvtpk(H[0], H[1]), cvtpk(H[2], H[3])};
                    *(LAS v2u*)(xs + lane * 32 + 8 * m) = pk;
                    if (st >= 4) *(v2u*)(H0T + ss_inst(st, b, h, d) * 8192 + (size_t)((16 * wv + lr) * 64 + 16 * m + 4 * g) * 2) = pk;
                }
                __syncthreads();
                if (wave < 4) {
                    const v4u b0 = *(const LAS v4u*)(xs + lane * 32), b1 = *(const LAS v4u*)(xs + lane * 32 + 16);
                    f32x4 Hn = {bflo(qv[k].x), bfhi(qv[k].x), bflo(qv[k].y), bfhi(qv[k].y)};
                    Hn = CK_MFMA(__builtin_bit_cast(bf16x8, a0[k]), __builtin_bit_cast(bf16x8, b0), Hn);
                    Hn = CK_MFMA(__builtin_bit_cast(bf16x8, a1[k]), __builtin_bit_cast(bf16x8, b1), Hn);
                    H = Hn;
                    const int nx = st + DEPTH < NS ? st + DEPTH : NS - 1;
                    ss3_load(a0[k], a1[k], qv[k], PQ, ss_pq(nx, b, h, d), wv, m, lane);
                }
            }
        }
        __syncthreads();
    }
}
}
template <int PART>
__device__ __forceinline__ void phase_moe_weights(Frame& F) {
    LAS float* scr = (LAS float*)(F.lds + RING_OFF + F.wave * 16384);
    bf16* WEO = (bf16*)(F.ws + WS_WEOUT);
    constexpr int IT_IN = (D / 64) * (2048 / 32), IT_OUT = (D / 64) * (D / 32);
    if (PART == 0) {
        const float* wei = KIN(I_WEI);
        const int nstat = F.G * 7;
        int it = (int)blockIdx.x * 7 + F.wave - 1;
        while (it < NE * 128) {
            const int half = it & 1, r = it >> 1, e = r >> 6, n0 = 32 * (r & 63);
            const int c = n0 & 1023, rowbase = (c >> 7) * 256 + (n0 >= 1024 ? 128 : 0) + (c & 127);
            q8_item(wei + (size_t)e * D * 2048, 2048, n0, (signed char*)(F.ws + WS_WEIN) + (size_t)e * 2048 * D, (float*)(F.ws + MI_CSWEI) + (size_t)e * 2048, rowbase, scr, F.lane, 8 * half, 8 * half + 8);
            int nx = 0; if (F.lane == 0) nx = (int)__hip_atomic_fetch_add(F.ctl + CW_Q6, 1u, __ATOMIC_RELAXED, __HIP_MEMORY_SCOPE_AGENT);
            it = nstat + __builtin_amdgcn_readfirstlane(nx);
        }
    } else {
        const float* weo = KIN(I_WEO);
        for (int r = (int)blockIdx.x * 7 + F.wave - 1; r < NE * IT_OUT; r += F.G * 7) { const int e = r / IT_OUT, q = r % IT_OUT, kb = q / 32, n0 = 32 * (q % 32);
            transpose_item(weo + (size_t)e * D * D, D, 64 * kb, n0, WEO + (size_t)e * D * D, D, n0, scr, F.lane); }
    }
}

__device__ __forceinline__ void phase_x1_h2(Frame& F) {
    LAS float* LG = (LAS float*)(F.lds);
    LAS float* LA = LG + 2 * D; LAS float* LB = LA + 2 * D;
    const float* modp = (const float*)(F.ws + WS_MODP);
    for (int i = F.tid; i < 2 * D; i += NWAVES * 64) { const int v = i / D, j = i % D;
        LG[i] = mod_val(modp, KIN(I_BADA), v, 2048 + j) * KIN(I_NQM)[j];
        LA[i] = KIN(I_NPF)[j] * (1.0f + mod_val(modp, KIN(I_BADA), v, 4096 + j)); LB[i] = mod_val(modp, KIN(I_BADA), v, 3072 + j); }
    __syncthreads();
    const float* mix = (const float*)(F.ws + WS_MIX); float* x1 = (float*)(F.ws + WS_X1); bf16* h2 = (bf16*)(F.ws + WS_H2);
    for (int row = F.gw; row < ML; row += F.NGW) {
        const int vec = row >> 13;
        f32x4 m[4], x[4]; float s = 0.f;
#pragma unroll
        for (int j = 0; j < 4; ++j) { m[j] = *(const f32x4*)(mix + (size_t)row * D + 4 * F.lane + 256 * j); x[j] = *(const f32x4*)(KIN(I_X) + (size_t)row * D + 4 * F.lane + 256 * j);
            s += (m[j].x * m[j].x + m[j].y * m[j].y) + (m[j].z * m[j].z + m[j].w * m[j].w); }
        const float rstd = 1.0f / sqrtf(wave_sum(s) * (1.0f / D) + 1e-6f);
        float s2 = 0.f;
#pragma unroll
        for (int j = 0; j < 4; ++j) { const int c = 4 * F.lane + 256 * j; const f32x4 g = *(const LAS f32x4*)(LG + vec * D + c);
            x[j] = x[j] + g * (m[j] * rstd); *(f32x4*)(x1 + (size_t)row * D + c) = x[j];
            s2 += (x[j].x * x[j].x + x[j].y * x[j].y) + (x[j].z * x[j].z + x[j].w * x[j].w); }
        const float rstd2 = 1.0f / sqrtf(wave_sum(s2) * (1.0f / D) + 1e-6f);
        unsigned long long* o8 = (unsigned long long*)(h2 + (size_t)row * D) + F.lane;
        f32x4 hq[4]; float mx = 0.f;
#pragma unroll
        for (int j = 0; j < 4; ++j) { const int c = 4 * F.lane + 256 * j; const f32x4 a = *(const LAS f32x4*)(LA + vec * D + c), b = *(const LAS f32x4*)(LB + vec * D + c);
            const f32x4 h = x[j] * rstd2 * a + b; hq[j] = h;
            mx = fmaxf(mx, fmaxf(fmaxf(fabsf(h.x), fabsf(h.y)), fmaxf(fabsf(h.z), fabsf(h.w))));
            o8[64 * j] = (unsigned long long)pk2(h.x, h.y) | ((unsigned long long)pk2(h.z, h.w) << 32); }
        mx = wave_max(mx);
        const float iv = mx > 0.f ? 127.0f / mx : 0.f;
        if (F.lane == 0) ((float*)(F.ws + MI_RSH2))[row] = mx * (1.0f / 127.0f);
        unsigned* o4 = (unsigned*)(F.ws + WS_H2Q + (size_t)row * D) + F.lane;
#pragma unroll
        for (int j = 0; j < 4; ++j) o4[64 * j] = pack_q4(hq[j].x * iv, hq[j].y * iv, hq[j].z * iv, hq[j].w * iv);
    }
}

__device__ __forceinline__ void phase_route(Frame& F) {
    const float* LG = (const float*)(F.ws + WS_LOGIT);
    int* selE = (int*)(F.ws + MI_SELE); int* selP = (int*)(F.ws + MI_SELP); float* gate = (float*)(F.ws + MI_GATE);
    for (int task = F.gw; task < ML / 64; task += F.NGW) {
        const int row = task * 64 + F.lane;
        float v[NE];
#pragma unroll
        for (int q = 0; q < NE / 4; ++q) { const f32x4 x = *(const f32x4*)(LG + (size_t)row * 256 + 4 * q); const f32x4 bb = *(const f32x4*)(KIN(I_BR) + 4 * q);
            v[4 * q] = x.x + bb.x; v[4 * q + 1] = x.y + bb.y; v[4 * q + 2] = x.z + bb.z; v[4 * q + 3] = x.w + bb.w; }
        int se[4]; float sv[4];
#pragma unroll
        for (int k = 0; k < 4; ++k) { float best = -3.0e38f; int bi = 0;
#pragma unroll
            for (int e = 0; e < NE; ++e) if (v[e] > best) { best = v[e]; bi = e; }
#pragma unroll
            for (int e = 0; e < NE; ++e) v[e] = (e == bi) ? -3.0e38f : v[e];
            se[k] = bi; sv[k] = best; }
        float ex[4], sum = 0.f;
#pragma unroll
        for (int k = 0; k < 4; ++k) { ex[k] = __expf(sv[k] - sv[0]); sum += ex[k]; }
        const float inv = 1.0f / sum;
        int sp[4] = {0, 0, 0, 0};
        int myn = 0;
#pragma unroll
        for (int e = 0; e < NE; ++e) { const bool p = (se[0] == e) | (se[1] == e) | (se[2] == e) | (se[3] == e); const int n = __popcll(__ballot(p)); myn = (F.lane == e) ? n : myn; }
        int mybase = 0;
        if (F.lane < NE && myn > 0) mybase = (int)__hip_atomic_fetch_add(F.ctl + CW_CNT + 64 * F.lane, (unsigned)myn, __ATOMIC_RELAXED, __HIP_MEMORY_SCOPE_AGENT);
#pragma unroll
        for (int e = 0; e < NE; ++e) {
            const bool p = (se[0] == e) | (se[1] == e) | (se[2] == e) | (se[3] == e);
            const unsigned long long mask = __ballot(p);
            const int base = __shfl(mybase, e);
            const int pos = base + __popcll(mask & ((1ull << F.lane) - 1ull));
#pragma unroll
            for (int k = 0; k < 4; ++k) if (se[k] == e) sp[k] = pos;
        }
        *(int4*)(selE + (size_t)row * 4) = make_int4(se[0], se[1], se[2], se[3]);
        *(int4*)(selP + (size_t)row * 4) = make_int4(sp[0], sp[1], sp[2], sp[3]);
        *(f32x4*)(gate + (size_t)row * 4) = (f32x4){ex[0] * inv, ex[1] * inv, ex[2] * inv, ex[3] * inv};
    }
}

__device__ __forceinline__ void phase_x1h2_route(Frame& F) {
    constexpr int HS_STRIDE = 2064;
    LAS unsigned char* Hs = F.lds;
    LAS float* LG = (LAS float*)(F.lds + 132096);
    LAS float* LA = LG + D; LAS float* LB = LA + D;
    LAS float* LGT = (LAS float*)(F.lds + LDS_X_OFF);
    const float* modp = (const float*)(F.ws + WS_MODP);
    const bf16* mixb = (const bf16*)(F.ws + WS_MIX); bf16* x1b = (bf16*)(F.ws + WS_X1);
    const float* xin = KIN(I_X); const float* b_ada = KIN(I_BADA); const float* nqm = KIN(I_NQM); const float* npf = KIN(I_NPF);
    const bf16* WR = (const bf16*)(F.ws + WS_WROUT);
    int* selE = (int*)(F.ws + MI_SELE); int* selP = (int*)(F.ws + MI_SELP); float* gate = (float*)(F.ws + MI_GATE);
    for (int rb = blockIdx.x; rb < ML / 64; rb += F.G) {
        const int vec = (rb * 64) >> 13;
        __syncthreads();
        for (int i = F.tid; i < D; i += NWAVES * 64) {
            const int jj[3] = {2048 + i, 4096 + i, 3072 + i}; float mv[3]; mod_vals<3>(modp, b_ada, vec, jj, mv);
            LG[i] = mv[0] * nqm[i]; LA[i] = npf[i] * (1.0f + mv[1]); LB[i] = mv[2]; }
        __syncthreads();
#pragma unroll
        for (int r4 = 0; r4 < 8; r4 += 4) {
            v2u mq[4][4]; f32x4 xq[4][4];
#pragma unroll
            for (int k = 0; k < 4; ++k) { const int row = rb * 64 + F.wave * 8 + r4 + k;
#pragma unroll
                for (int j = 0; j < 4; ++j) { mq[k][j] = *(const v2u*)(mixb + (size_t)row * D + 4 * F.lane + 256 * j); xq[k][j] = *(const f32x4*)(xin + (size_t)row * D + 4 * F.lane + 256 * j); } }
            __builtin_amdgcn_sched_barrier(0);
#pragma unroll
            for (int k = 0; k < 4; ++k) {
                const int lrow = F.wave * 8 + r4 + k, row = rb * 64 + lrow;
                f32x4 m[4], x[4]; float s = 0.f;
#pragma unroll
                for (int j = 0; j < 4; ++j) { m[j] = (f32x4){bflo(mq[k][j].x), bfhi(mq[k][j].x), bflo(mq[k][j].y), bfhi(mq[k][j].y)}; x[j] = xq[k][j];
                    s += (m[j].x * m[j].x + m[j].y * m[j].y) + (m[j].z * m[j].z + m[j].w * m[j].w); }
                const float rstd = 1.0f / sqrtf(wave_sum(s) * (1.0f / D) + 1e-6f);
                float s2 = 0.f;
#pragma unroll
                for (int j = 0; j < 4; ++j) { const int c = 4 * F.lane + 256 * j; const f32x4 g = *(const LAS f32x4*)(LG + c);
                    x[j] = x[j] + g * (m[j] * rstd); *(v2u*)(x1b + (size_t)row * D + c) = (v2u){pk2(x[j].x, x[j].y), pk2(x[j].z, x[j].w)};
                    s2 += (x[j].x * x[j].x + x[j].y * x[j].y) + (x[j].z * x[j].z + x[j].w * x[j].w); }
                const float rstd2 = 1.0f / sqrtf(wave_sum(s2) * (1.0f / D) + 1e-6f);
                f32x4 hq[4]; float mx = 0.f;
#pragma unroll
                for (int j = 0; j < 4; ++j) { const int c = 4 * F.lane + 256 * j; const f32x4 a = *(const LAS f32x4*)(LA + c), b = *(const LAS f32x4*)(LB + c);
                    const f32x4 h = x[j] * rstd2 * a + b; hq[j] = h;
                    mx = fmaxf(mx, fmaxf(fmaxf(fabsf(h.x), fabsf(h.y)), fmaxf(fabsf(h.z), fabsf(h.w))));
                    *(LAS v2u*)(Hs + lrow * HS_STRIDE + c * 2) = (v2u){pk2(h.x, h.y), pk2(h.z, h.w)}; }
                mx = wave_max(mx);
                const float iv = mx > 0.f ? 127.0f / mx : 0.f;
                if (F.lane == 0) ((float*)(F.ws + MI_RSH2))[row] = mx * (1.0f / 127.0f);
                unsigned* o4 = (unsigned*)(F.ws + WS_H2Q + (size_t)row * D) + F.lane;
#pragma unroll
                for (int j = 0; j < 4; ++j) o4[64 * j] = pack_q4(hq[j].x * iv, hq[j].y * iv, hq[j].z * iv, hq[j].w * iv);
            }
        }
        __syncthreads();
        {
            const int rt = F.wave & 3, et = F.wave >> 2, lr = F.lane & 15, g = F.lane >> 4;
            typedef short bf16x8_t __attribute__((ext_vector_type(8)));
            f32x4 acc = {0.f, 0.f, 0.f, 0.f};
            const LAS unsigned char* ap = Hs + (16 * rt + lr) * HS_STRIDE + 16 * g; const bf16* bp = WR + (size_t)(16 * et + lr) * D + 8 * g;
#pragma unroll
            for (int sb = 0; sb < 32; sb += 16) {
                bf16x8_t bq[16];
#pragma unroll
                for (int s = 0; s < 16; ++s) bq[s] = *(const bf16x8_t*)(bp + 32 * (sb + s));
                __builtin_amdgcn_sched_barrier(0);
#pragma unroll
                for (int s = 0; s < 16; ++s) { const bf16x8_t a = *(const LAS bf16x8_t*)(ap + 64 * (sb + s)); acc = __builtin_amdgcn_mfma_f32_16x16x32_bf16(a, bq[s], acc, 0, 0, 0); }
            }
#pragma unroll
            for (int i = 0; i < 4; ++i) LGT[(16 * rt + 4 * g + i) * 33 + 16 * et + lr] = acc[i];
        }
        __syncthreads();
        if (F.wave == 0) {
            const int row = rb * 64 + F.lane;
            const float* br = KIN(I_BR);
            float v[NE];
#pragma unroll
            for (int e = 0; e < NE; ++e) v[e] = LGT[F.lane * 33 + e] + br[e];
            int se[4]; float sv[4];
#pragma unroll
            for (int k = 0; k < 4; ++k) { float best = -3.0e38f; int bi = 0;
#pragma unroll
                for (int e = 0; e < NE; ++e) if (v[e] > best) { best = v[e]; bi = e; }
#pragma unroll
                for (int e = 0; e < NE; ++e) v[e] = (e == bi) ? -3.0e38f : v[e];
                se[k] = bi; sv[k] = best; }
            float ex[4], sum = 0.f;
#pragma unroll
            for (int k = 0; k < 4; ++k) { ex[k] = __expf(sv[k] - sv[0]); sum += ex[k]; }
            const float inv = 1.0f / sum;
            int sp[4] = {0, 0, 0, 0};
            int myn = 0;
#pragma unroll
            for (int e = 0; e < NE; ++e) { const bool p = (se[0] == e) | (se[1] == e) | (se[2] == e) | (se[3] == e); const int n = __popcll(__ballot(p)); myn = (F.lane == e) ? n : myn; }
            int mybase = 0;
            if (F.lane < NE && myn > 0) mybase = (int)__hip_atomic_fetch_add(F.ctl + CW_CNT + 64 * F.lane, (unsigned)myn, __ATOMIC_RELAXED, __HIP_MEMORY_SCOPE_AGENT);
#pragma unroll
            for (int e = 0; e < NE; ++e) {
                const bool p = (se[0] == e) | (se[1] == e) | (se[2] == e) | (se[3] == e);
                const unsigned long long mask = __ballot(p);
                const int base = __shfl(mybase, e);
                const int pos = base + __popcll(mask & ((1ull << F.lane) - 1ull));
#pragma unroll
                for (int k = 0; k < 4; ++k) if (se[k] == e) sp[k] = pos;
            }
            *(int4*)(selE + (size_t)row * 4) = make_int4(se[0], se[1], se[2], se[3]);
            *(int4*)(selP + (size_t)row * 4) = make_int4(sp[0], sp[1], sp[2], sp[3]);
            *(f32x4*)(gate + (size_t)row * 4) = (f32x4){ex[0] * inv, ex[1] * inv, ex[2] * inv, ex[3] * inv};
        }
    }
    __syncthreads();
}

__device__ __forceinline__ void phase_scatter(Frame& F) {
    LAS int* PS = (LAS int*)(F.lds);
    if (F.wave == 0) {
        const int c = F.lane < NE ? (int)__hip_atomic_load(F.ctl + CW_CNT + 64 * F.lane, __ATOMIC_RELAXED, __HIP_MEMORY_SCOPE_AGENT) : 0;
        const int pc = (c + 255) / 256 * 256; int s = pc;
#pragma unroll
        for (int o = 1; o < 32; o <<= 1) { const int t = __shfl_up(s, o); s += (F.lane >= o) ? t : 0; }
        if (F.lane < NE) { PS[F.lane] = s - pc; PS[64 + F.lane] = c; }
        if (F.lane == NE - 1) PS[NE] = s; }
    __syncthreads();
    int* blkE = (int*)(F.ws + MI_BLKE);
    if (blockIdx.x == 0) {
        for (int b = F.tid; b < MAXBLK; b += NWAVES * 64) { int e = NE - 1;
            for (int q = 0; q < NE; ++q) if (b * 256 >= PS[q] && b * 256 < PS[q + 1]) e = q;
            blkE[b] = e; }
        if (F.tid == 0) blkE[MAXBLK] = PS[NE] / 256;
    }
    const int* selE = (const int*)(F.ws + MI_SELE); const int* selP = (const int*)(F.ws + MI_SELP); int* dest = (int*)(F.ws + MI_DEST);
    const unsigned char* h2q = F.ws + WS_H2Q; unsigned char* xb = F.ws + WS_XB; const float* rsh2 = (const float*)(F.ws + MI_RSH2); float* rsxb = (float*)(F.ws + MI_RSXB);
    for (int row0 = F.gw; row0 < ML; row0 += 8 * F.NGW) {
        int4 se[8], sp[8]; float rsc[8]; v4u av[8];
#pragma unroll
        for (int k = 0; k < 8; ++k) { const int row = row0 + k * F.NGW, rc = row < ML ? row : row0;
            se[k] = *(const int4*)(selE + (size_t)rc * 4); sp[k] = *(const int4*)(selP + (size_t)rc * 4); rsc[k] = rsh2[rc]; av[k] = *(const v4u*)(h2q + (size_t)rc * D + 16 * F.lane); }
        __builtin_amdgcn_sched_barrier(0);
#pragma unroll
        for (int k = 0; k < 8; ++k) { const int row = row0 + k * F.NGW;
            if (row < ML) {
                const int d0 = PS[se[k].x] + sp[k].x, d1 = PS[se[k].y] + sp[k].y, d2 = PS[se[k].z] + sp[k].z, d3 = PS[se[k].w] + sp[k].w;
                if (F.lane == 0) { *(int4*)(dest + (size_t)row * 4) = make_int4(d0, d1, d2, d3); rsxb[d0] = rsc[k]; rsxb[d1] = rsc[k]; rsxb[d2] = rsc[k]; rsxb[d3] = rsc[k]; }
                *(v4u*)(xb + (size_t)d0 * D + 16 * F.lane) = av[k]; *(v4u*)(xb + (size_t)d1 * D + 16 * F.lane) = av[k];
                *(v4u*)(xb + (size_t)d2 * D + 16 * F.lane) = av[k]; *(v4u*)(xb + (size_t)d3 * D + 16 * F.lane) = av[k]; } }
    }
    for (int p = F.gw; p < NE * 256; p += F.NGW) {
        const int e = p >> 8, r = p & 255, c = PS[64 + e], padded = (c + 255) / 256 * 256;
        if (c + r < padded) { unsigned char* dst = xb + (size_t)(PS[e] + c + r) * D; *(v4u*)(dst + 16 * F.lane) = (v4u){0u, 0u, 0u, 0u}; if (F.lane == 0) rsxb[PS[e] + c + r] = 0.f; }
    }
}

__device__ __forceinline__ void phase_combine(Frame& F) {
    LAS float* LG = (LAS float*)(F.lds);
    const float* modp = (const float*)(F.ws + WS_MODP);
    for (int i = F.tid; i < 2 * D; i += NWAVES * 64) { const int v = i / D, j = i % D; LG[i] = mod_val(modp, KIN(I_BADA), v, 5120 + j) * KIN(I_NQF)[j]; }
    __syncthreads();
    const int* dest = (const int*)(F.ws + MI_DEST); const float* gate = (const float*)(F.ws + MI_GATE);
    const bf16* y2 = (const bf16*)(F.ws + WS_Y2); const bf16* x1b = (const bf16*)(F.ws + WS_X1);
    for (int row0 = F.gw; row0 < ML; row0 += 8 * F.NGW) {
        const int rl = row0 + (F.lane & 7) * F.NGW, rlc = rl < ML ? rl : row0;
        const int4 ddl = *(const int4*)(dest + (size_t)rlc * 4); const f32x4 ggl = *(const f32x4*)(gate + (size_t)rlc * 4);
        v4u t[2][2][4][2]; v4u xq[2][2][2];
#define CMB_LOAD(buf, k2_) do { _Pragma("unroll") for (int u = 0; u < 2; ++u) { const int kk = (k2_) + u, row = row0 + kk * F.NGW, rc = row < ML ? row : row0; \
            const int dk[4] = {__builtin_amdgcn_readlane(ddl.x, kk), __builtin_amdgcn_readlane(ddl.y, kk), __builtin_amdgcn_readlane(ddl.z, kk), __builtin_amdgcn_readlane(ddl.w, kk)}; \
            _Pragma("unroll") for (int k = 0; k < 4; ++k) { const bf16* yp = y2 + (size_t)(row < ML ? dk[k] : 0) * D + 16 * F.lane; t[buf][u][k][0] = *(const v4u*)yp; t[buf][u][k][1] = *(const v4u*)(yp + 8); } \
            _Pragma("unroll") for (int j = 0; j < 2; ++j) xq[buf][u][j] = *(const v4u*)(x1b + (size_t)rc * D + 16 * F.lane + 8 * j); } } while (0)
        CMB_LOAD(0, 0);
#pragma unroll
        for (int k2 = 0; k2 < 8; k2 += 2) {
            const int cb = (k2 >> 1) & 1;
            if (k2 + 2 < 8) CMB_LOAD(cb ^ 1, k2 + 2);
            __builtin_amdgcn_sched_barrier(0);
#pragma unroll
            for (int u = 0; u < 2; ++u) { const int kk = k2 + u, row = row0 + kk * F.NGW;
                if (row < ML) {
                    const int vec = row >> 13;
                    const float g0_ = ggl.x, g1_ = ggl.y, g2_ = ggl.z, g3_ = ggl.w;
                    const float gk[4] = {__int_as_float(__builtin_amdgcn_readlane(__float_as_int(g0_), kk)), __int_as_float(__builtin_amdgcn_readlane(__float_as_int(g1_), kk)),
                                         __int_as_float(__builtin_amdgcn_readlane(__float_as_int(g2_), kk)), __int_as_float(__builtin_amdgcn_readlane(__float_as_int(g3_), kk))};
                    float f[16];
#pragma unroll
                    for (int i = 0; i < 16; ++i) f[i] = 0.f;
#pragma unroll
                    for (int k = 0; k < 4; ++k) { const v4u a_ = t[cb][u][k][0], b_ = t[cb][u][k][1];
                        const float tt[16] = {bflo(a_.x), bfhi(a_.x), bflo(a_.y), bfhi(a_.y), bflo(a_.z), bfhi(a_.z), bflo(a_.w), bfhi(a_.w), bflo(b_.x), bfhi(b_.x), bflo(b_.y), bfhi(b_.y), bflo(b_.z), bfhi(b_.z), bflo(b_.w), bfhi(b_.w)};
#pragma unroll
                        for (int i = 0; i < 16; ++i) f[i] += gk[k] * tt[i]; }
                    float s = 0.f;
#pragma unroll
                    for (int i = 0; i < 16; ++i) s += f[i] * f[i];
                    const float rstd = 1.0f / sqrtf(wave_sum(s) * (1.0f / D) + 1e-6f);
                    float g[16], o[16]; ld16f_lds(LG + vec * D + 16 * F.lane, g);
#pragma unroll
                    for (int i = 0; i < 16; ++i) { const unsigned w_ = xq[cb][u][i >> 3][(i >> 1) & 3]; o[i] = ((i & 1) ? bfhi(w_) : bflo(w_)) + g[i] * (f[i] * rstd); }
                    st16f(F.out + (size_t)row * D + 16 * F.lane, o);
                }
            }
        }
#undef CMB_LOAD
    }
}

constexpr int N_PHASES = 13;
#ifndef PROBE_MASK
#define PROBE_MASK 0
#endif
#ifndef STAGE_REP
#define STAGE_REP 0
#endif
#ifndef USE_FLAT_BAR
#define USE_FLAT_BAR 0
#endif
struct Args { const float* in[30]; float* out; unsigned char* ws; int ph_lo, ph_hi; };
__global__ void __launch_bounds__(NWAVES * 64, 2) fwd(Args args) {
    extern __shared__ __attribute__((aligned(16))) unsigned char lds[];
    Frame F;
    F.lds = (LAS unsigned char*)lds;
    F.MISC = (volatile LAS unsigned*)(F.lds + MISC_OFF);
    F.tid = threadIdx.x; F.lane = F.tid & 63; F.wave = __builtin_amdgcn_readfirstlane(F.tid >> 6);
    F.G = gridDim.x; F.gw = blockIdx.x * NWAVES + F.wave; F.NGW = F.G * NWAVES;
    F.ws = args.ws; F.ctl = (unsigned*)(args.ws + WS_CTL); F.out = args.out;
    for (int u = F.tid; u < (LDS_X_OFF - LDSCTL_OFF) / 4; u += NWAVES * 64) ((LAS unsigned*)(F.lds + LDSCTL_OFF))[u] = 0u;
    __syncthreads();
    const int lo = args.ph_lo, hi = args.ph_hi;
    const bool use_bar = (hi - lo) > 1;
    XcdBarrier bar; bar.bar = F.ctl + CW_BAR; bar.x = 0; bar.st = nullptr;
    unsigned xrank = 0u;
    if (use_bar && !USE_FLAT_BAR) { bar.x = xb_xcc_id(); bar.st = F.MISC + 8; if (threadIdx.x == 0) xrank = xb_add(&bar.bar[XB_XCNT(bar.x)], 1u); }
    F.vb = (int)blockIdx.x;
#define IN(k) (lo <= (k) && (k) < hi)
    unsigned fb_extra = 0u;
#define SEAM(k) do { if (IN(k) && IN((k) + 1)) { if (USE_FLAT_BAR) flat_barrier(F.ctl + CW_FB, (unsigned)((k) - lo + 1) + fb_extra); \
        else if (SEAM_FILL && (k) < 8) { xcd_barrier2_arrive(bar); seam_filler(F, (k)); xcd_barrier2_wait(bar); } else xcd_barrier2(bar); } \
    else { __syncthreads(); if (SEAM_FILL && (k) < 8) { seam_filler(F, (k)); __syncthreads(); } } } while (0)

#define DUP(k) ((PROBE_MASK >> (k)) & 1)
    if (IN(0)) { phase_prologue(F); if (DUP(0)) { __syncthreads(); phase_prologue(F); } SEAM(0); }
    if (use_bar && !USE_FLAT_BAR && IN(0) && IN(1)) {
        if (F.tid == 0) { bool ok = (F.G & 7) == 0;
            for (unsigned j = 0; j < 16; ++j) ok = ok && (xb_ld(&bar.bar[XB_XCNT(j)]) == (j < 8u ? (unsigned)(F.G >> 3) : 0u));
            F.MISC[12] = ok ? bar.x + 8u * xrank : blockIdx.x; }
        __syncthreads(); F.vb = (int)F.MISC[12];
    }
    if (DUP(20)) { for (int q = 0; q < 10; ++q) { if (USE_FLAT_BAR) { ++fb_extra; flat_barrier(F.ctl + CW_FB, 1u + fb_extra); } else xcd_barrier2(bar); } }
    if (IN(1)) { phase_hrows(F); if (DUP(1)) { __syncthreads(); phase_hrows(F); } SEAM(1); }
    if (IN(2)) {
        {         pg8::Gemm g{(const bf16*)(F.ws + WS_A0), (const bf16*)(F.ws + WS_WIN), MT, NZ, D}; pg8::StaticOrder S; S.init(MT, NZ, F.G, F.vb);
        pg8::EpiBf16I8 E{(bf16*)(F.ws + WS_Z), NZ, (const float*)(F.ws + MI_RSH), (const float*)(F.ws + MI_CSWIN)};
        pg8::gemm_phase_i8<pg8::EpiBf16I8, pg8::StaticOrder, true, true>(F.lds + RING_OFF, g, S, E); __syncthreads(); }
        if (DUP(2)) {         pg8::Gemm g{(const bf16*)(F.ws + WS_A0), (const bf16*)(F.ws + WS_WIN), MT, NZ, D}; pg8::StaticOrder S; S.init(MT, NZ, F.G, F.vb);
        pg8::EpiBf16I8 E{(bf16*)(F.ws + WS_Z), NZ, (const float*)(F.ws + MI_RSH), (const float*)(F.ws + MI_CSWIN)};
        pg8::gemm_phase_i8<pg8::EpiBf16I8, pg8::StaticOrder, true, true>(F.lds + RING_OFF, g, S, E); __syncthreads(); }
        SEAM(2); }
    if (IN(3)) { ck::phase_lora(F); SEAM(3); }
    if (IN(4)) { ck::phase_cp2(F); if (DUP(5)) { __syncthreads(); ck::phase_cp2(F); } if (DUP(22)) { __syncthreads(); ck::phase_lora(F); } SEAM(4); }
    if (IN(5)) { if (F.wave == 0) ck::phase_ss(F); if (DUP(23)) { __syncthreads(); ck::phase_ss3(F); } if (DUP(6)) { __syncthreads(); if (F.wave == 0) ck::phase_ss(F); else phase_moe_weights<0>(F); } if (DUP(17)) { __syncthreads(); if (F.wave == 0) ck::phase_ss(F); } SEAM(5); }
    if (IN(6)) { ck::phase_co2(F); if (DUP(7)) { __syncthreads(); ck::phase_co2(F); } SEAM(6); }
    if (IN(7)) {
        {         pg8::Gemm g{(const bf16*)(F.ws + WS_A0), (const bf16*)(F.ws + WS_WOUT), ML, D, D}; pg8::StaticOrder S; S.init(ML, D, F.G, F.vb);
        pg8::EpiBf16 E{(bf16*)(F.ws + WS_MIX), D, nullptr, 0};
        pg8::gemm_phase<pg8::EpiBf16, pg8::StaticOrder, true, true>(F.lds + RING_OFF, g, S, E);
        __syncthreads(); }
        if (DUP(8)) {         pg8::Gemm g{(const bf16*)(F.ws + WS_A0), (const bf16*)(F.ws + WS_WOUT), ML, D, D}; pg8::StaticOrder S; S.init(ML, D, F.G, F.vb);
        pg8::EpiBf16 E{(bf16*)(F.ws + WS_MIX), D, nullptr, 0};
        pg8::gemm_phase<pg8::EpiBf16, pg8::StaticOrder, true, true>(F.lds + RING_OFF, g, S, E);
        __syncthreads(); }
        SEAM(7); }
    if (IN(8)) { phase_x1h2_route(F); SEAM(8); }
    if (IN(9)) { phase_scatter(F); if (DUP(12)) { __syncthreads(); phase_scatter(F); } SEAM(9); }
    if (IN(10)) {
        {         const int* blkE = (const int*)(F.ws + MI_BLKE);
        pg8::Gemm g{(const bf16*)(F.ws + WS_XB), (const bf16*)(F.ws + WS_WEIN), NROWS, 2048, D};
        LAS int* BE = (LAS int*)(F.lds + RING_BYTES);
        for (int i = F.tid; i <= MAXBLK; i += NWAVES * 64) BE[i] = __hip_atomic_load(blkE + i, __ATOMIC_RELAXED, __HIP_MEMORY_SCOPE_AGENT);
        __syncthreads();
        pg8::MoeOrder<8> S{BE, BE[MAXBLK] * 8, F.G, F.vb};
        pg8::EpiSwigluI8 E{(bf16*)(F.ws + WS_ACT), KIN(I_BEI), (const float*)(F.ws + MI_RSXB), (const float*)(F.ws + MI_CSWEI)};
        pg8::gemm_phase_i8<pg8::EpiSwigluI8, pg8::MoeOrder<8>, true, true>(F.lds + RING_OFF, g, S, E); __syncthreads(); }
        if (DUP(13)) {         const int* blkE = (const int*)(F.ws + MI_BLKE);
        pg8::Gemm g{(const bf16*)(F.ws + WS_XB), (const bf16*)(F.ws + WS_WEIN), NROWS, 2048, D};
        LAS int* BE = (LAS int*)(F.lds + RING_BYTES);
        for (int i = F.tid; i <= MAXBLK; i += NWAVES * 64) BE[i] = __hip_atomic_load(blkE + i, __ATOMIC_RELAXED, __HIP_MEMORY_SCOPE_AGENT);
        __syncthreads();
        pg8::MoeOrder<8> S{BE, BE[MAXBLK] * 8, F.G, F.vb};
        pg8::EpiSwigluI8 E{(bf16*)(F.ws + WS_ACT), KIN(I_BEI), (const float*)(F.ws + MI_RSXB), (const float*)(F.ws + MI_CSWEI)};
        pg8::gemm_phase_i8<pg8::EpiSwigluI8, pg8::MoeOrder<8>, true, true>(F.lds + RING_OFF, g, S, E); __syncthreads(); }
        SEAM(10); }
    if (IN(11)) {
        {         const int* blkE = (const int*)(F.ws + MI_BLKE);
        pg8::Gemm g{(const bf16*)(F.ws + WS_ACT), (const bf16*)(F.ws + WS_WEOUT), NROWS, D, D};
        LAS int* BE = (LAS int*)(F.lds + RING_BYTES);
        for (int i = F.tid; i <= MAXBLK; i += NWAVES * 64) BE[i] = __hip_atomic_load(blkE + i, __ATOMIC_RELAXED, __HIP_MEMORY_SCOPE_AGENT);
        __syncthreads();
        pg8::MoeOrder<4> S{BE, BE[MAXBLK] * 4, F.G, F.vb};
        pg8::EpiBf16 E{(bf16*)(F.ws + WS_Y2), D, KIN(I_BEO), D};
        pg8::gemm_phase<pg8::EpiBf16, pg8::MoeOrder<4>, true, true>(F.lds + RING_OFF, g, S, E); __syncthreads(); }
        if (DUP(14)) {         const int* blkE = (const int*)(F.ws + MI_BLKE);
        pg8::Gemm g{(const bf16*)(F.ws + WS_ACT), (const bf16*)(F.ws + WS_WEOUT), NROWS, D, D};
        LAS int* BE = (LAS int*)(F.lds + RING_BYTES);
        for (int i = F.tid; i <= MAXBLK; i += NWAVES * 64) BE[i] = __hip_atomic_load(blkE + i, __ATOMIC_RELAXED, __HIP_MEMORY_SCOPE_AGENT);
        __syncthreads();
        pg8::MoeOrder<4> S{BE, BE[MAXBLK] * 4, F.G, F.vb};
        pg8::EpiBf16 E{(bf16*)(F.ws + WS_Y2), D, KIN(I_BEO), D};
        pg8::gemm_phase<pg8::EpiBf16, pg8::MoeOrder<4>, true, true>(F.lds + RING_OFF, g, S, E); __syncthreads(); }
        SEAM(11); }
    if (IN(12)) { phase_combine(F); if (DUP(15)) { __syncthreads(); phase_combine(F); } }
#undef IN
#undef SEAM
}

#ifndef MK_N_LAUNCHES
#define MK_N_LAUNCHES 1
#endif
extern "C" void kernel_launch(void* const* d_in, const int* in_sizes, int n_in, void* d_out, int out_size, void* d_ws, size_t ws_size, hipStream_t stream) {
    static int grid = 0;
    if (grid == 0) {
        if (n_in != 30 || out_size != ML * D || ws_size < WS_END) { fprintf(stderr, "kernel_launch: unexpected shapes (n_in %d out %d ws %zu, need %zu); nothing launched\n", n_in, out_size, ws_size, (size_t)WS_END); grid = -1; return; }
        int dev = 0, cus = 0, per_cu = 0;
        if (hipGetDevice(&dev) != hipSuccess || hipDeviceGetAttribute(&cus, hipDeviceAttributeMultiprocessorCount, dev) != hipSuccess) { grid = -1; return; }
        if (hipFuncSetAttribute((const void*)fwd, hipFuncAttributeMaxDynamicSharedMemorySize, LDS_BYTES) != hipSuccess) { fprintf(stderr, "kernel_launch: hipFuncSetAttribute failed\n"); grid = -1; return; }
        if (hipOccupancyMaxActiveBlocksPerMultiprocessor(&per_cu, (const void*)fwd, NWAVES * 64, LDS_BYTES) != hipSuccess || per_cu < 1)
            fprintf(stderr, "kernel_launch: note: occupancy query reports %d workgroups per CU\n", per_cu);
        (void)hipGetLastError();
        grid = cus;
    }
    if (grid < 0) return;
    if (hipMemsetAsync((char*)d_ws + WS_CTL, 0, CTL_ZERO_BYTES, stream) != hipSuccess) return;
    Args a{};
    for (int i = 0; i < 30; ++i) a.in[i] = (const float*)d_in[i];
    a.out = (float*)d_out; a.ws = (unsigned char*)d_ws;
    if (MK_N_LAUNCHES == 1) { a.ph_lo = 0; a.ph_hi = N_PHASES; hipLaunchKernelGGL(fwd, dim3(grid), dim3(NWAVES * 64), LDS_BYTES, stream, a); }
    else for (int p = 0; p < N_PHASES; ++p) { a.ph_lo = p; a.ph_hi = p + 1; hipLaunchKernelGGL(fwd, dim3(grid), dim3(NWAVES * 64), LDS_BYTES, stream, a); }
}
```

```cpp
#include <hip/hip_runtime.h>
#include <cstdio>
#include <cstdint>

namespace pg8 {
#define PG8_LAS __attribute__((address_space(3)))
typedef unsigned short bf16_t;
typedef short bf16x8 __attribute__((ext_vector_type(8)));
typedef float f32x4 __attribute__((ext_vector_type(4)));
typedef unsigned u32x4 __attribute__((ext_vector_type(4)));
constexpr int BM = 256, BK = 64, HALF = 128, HTB = HALF * BK * 2  , STAGE_BYTES = 8 * HTB, NXCD = 8, WGM = 8;

__host__ __device__ __forceinline__ int lds_byte(int r, int c) { const int st = (r >> 4) * 2 + (c >> 5), rr = r & 15, cc = c & 31, ob = rr * 64 + cc * 2; return st * 1024 + (ob ^ (((ob >> 9) & 1) << 5)); }
__host__ __device__ __forceinline__ void stage_rc(int b, int& R, int& C) { const int st = b / 1024, sb = b % 1024, swz = sb ^ (((sb >> 9) & 1) << 5); R = (st >> 1) * 16 + swz / 64; C = (st & 1) * 32 + (swz % 64) / 2; }
__host__ __device__ __forceinline__ int perm32(int rho) { const int n = rho >> 4, i = rho & 15; return 8 * (i >> 2) + 4 * n + (i & 3); }

struct Unit { int pm, pn, pb, e; };
struct Gemm { const bf16_t* A; const bf16_t* Bt; int M, N, K; };

struct StaticOrder {
    int nM, nN, nwg, G, c;
    __host__ __device__ void init(int M, int N, int G_, int c_) { nM = M / BM; nN = N / BM; nwg = nM * nN; G = G_; c = c_; }
    __host__ __device__ bool next(int i, Unit& u) const {
        const long L = (long)i * G + c; if (L >= nwg) return false;
        int wgid = (int)L; { const int q = nwg / NXCD, r = nwg % NXCD, xcd = wgid % NXCD, off = wgid / NXCD; wgid = (xcd < r ? xcd * (q + 1) : r * (q + 1) + (xcd - r) * q) + off; }
        const int nig = WGM * nN, gid = wgid / nig, fm = gid * WGM, gsz = (nM - fm) < WGM ? (nM - fm) : WGM;
        u.pm = fm + ((wgid % nig) % gsz); u.pn = (wgid % nig) / gsz; u.pb = u.pn; u.e = 0; return true;
    }
    __device__ __forceinline__ void a_ready(const Unit&) const {}
    __device__ __forceinline__ void done(const Unit&) const {}
};
template <int NT> struct MoeOrder {
    const PG8_LAS int* blk_e; int nunits, G, c;
    __device__ bool next(int i, Unit& u) const {
        int L;
        if ((G & 7) == 0 && ((G >> 3) % NT) == 0) { const int per = G >> 3, xcd = c & 7, k = c >> 3, bpx = per / NT;
            const int base = i * G, R = nunits - base;
            if (R > 0 && R < G && (R & 7) == 0) { const int rpx = R >> 3; if (k >= rpx) return false; L = base + xcd * rpx + k; }
            else L = ((i * 8 + xcd) * bpx + k / NT) * NT + (k % NT); }
        else L = i * G + c;
        if (L >= nunits) return false;
        const int blk = L / NT, pn = L % NT; const int e = blk_e[blk];
        u.pm = blk; u.pn = pn; u.pb = e * NT + pn; u.e = e; return true;
    }
    __device__ __forceinline__ void a_ready(const Unit&) const {}
    __device__ __forceinline__ void done(const Unit&) const {}
};

__device__ __forceinline__ unsigned cvt_pk_bf16(float lo, float hi) { unsigned r; asm volatile("v_cvt_pk_bf16_f32 %0, %1, %2" : "=v"(r) : "v"(lo), "v"(hi)); return r; }

struct EpiF32 {
    static constexpr bool PERM = false, AFTER_DRAIN = false; static constexpr int NSTORE = 32;
    float* C; int ldc;
    __device__ __forceinline__ void operator()(const f32x4 (&acc)[2][2][4][2], const Unit& u, int wr, int wc, int fr, int fq) const {
        const int row0 = u.pm * BM + wr * 64 + fr, col0 = u.pn * BM + wc * 32 + 4 * fq;
#pragma unroll
        for (int ai = 0; ai < 2; ++ai)
#pragma unroll
            for (int m = 0; m < 4; ++m) { float* rowp = C + (size_t)(row0 + ai * HALF + m * 16) * ldc + col0;
#pragma unroll
                for (int bj = 0; bj < 2; ++bj)
#pragma unroll
                    for (int n = 0; n < 2; ++n) __builtin_nontemporal_store(acc[ai][bj][m][n], (f32x4*)(rowp + bj * HALF + n * 16)); }
    }
};
struct EpiBf16 {
    static constexpr bool PERM = true, AFTER_DRAIN = false; static constexpr int NSTORE = 16;
    bf16_t* O; int ldc; const float* bias; int bias_estride;
    __device__ __forceinline__ void operator()(const f32x4 (&acc)[2][2][4][2], const Unit& u, int wr, int wc, int fr, int fq) const {
        const int row0 = u.pm * BM + wr * 64 + fr; const int col0 = u.pn * BM + wc * 32 + 8 * fq;
        const float* bp = bias ? bias + (size_t)u.e * bias_estride + col0 : nullptr;
        f32x4 bv[2][2];
#pragma unroll
        for (int bj = 0; bj < 2; ++bj)
#pragma unroll
            for (int n = 0; n < 2; ++n) bv[bj][n] = bp ? *(const f32x4*)(bp + bj * HALF + 4 * n) : (f32x4){0.f, 0.f, 0.f, 0.f};
#pragma unroll
        for (int ai = 0; ai < 2; ++ai)
#pragma unroll
            for (int m = 0; m < 4; ++m) { bf16_t* rowp = O + (size_t)(row0 + ai * HALF + m * 16) * ldc + col0;
#pragma unroll
                for (int bj = 0; bj < 2; ++bj) { const f32x4 v0 = acc[ai][bj][m][0] + bv[bj][0], v1 = acc[ai][bj][m][1] + bv[bj][1];
                    u32x4 w; w.x = cvt_pk_bf16(v0[0], v0[1]); w.y = cvt_pk_bf16(v0[2], v0[3]); w.z = cvt_pk_bf16(v1[0], v1[1]); w.w = cvt_pk_bf16(v1[2], v1[3]);
                    __builtin_nontemporal_store(w, (u32x4*)(rowp + bj * HALF)); } }
    }
};
struct EpiSwiglu {
    static constexpr bool PERM = true, AFTER_DRAIN = false; static constexpr int NSTORE = 8;
    bf16_t* O; const float* bias;
    __device__ __forceinline__ float act1(float g, float up) const {
        g = fminf(g, 7.0f); up = fminf(fmaxf(up, -7.0f), 7.0f);
        const float sg = 1.0f / (1.0f + __expf(-1.702f * g));
        return (up + 1.0f) * g * sg;
    }
    __device__ __forceinline__ void operator()(const f32x4 (&acc)[2][2][4][2], const Unit& u, int wr, int wc, int fr, int fq) const {
        const int row0 = u.pm * BM + wr * 64 + fr; const int col0 = u.pn * HALF + wc * 32 + 8 * fq;
        const float* bp = bias + (size_t)u.e * 2048 + col0;
        f32x4 bg[2], bu[2];
#pragma unroll
        for (int n = 0; n < 2; ++n) { bg[n] = *(const f32x4*)(bp + 4 * n); bu[n] = *(const f32x4*)(bp + 1024 + 4 * n); }
#pragma unroll
        for (int ai = 0; ai < 2; ++ai)
#pragma unroll
            for (int m = 0; m < 4; ++m) { bf16_t* rowp = O + (size_t)(row0 + ai * HALF + m * 16) * 1024 + col0;
                const f32x4 g0 = acc[ai][0][m][0] + bg[0], g1 = acc[ai][0][m][1] + bg[1], u0 = acc[ai][1][m][0] + bu[0], u1 = acc[ai][1][m][1] + bu[1];
                u32x4 w; w.x = cvt_pk_bf16(act1(g0[0], u0[0]), act1(g0[1], u0[1])); w.y = cvt_pk_bf16(act1(g0[2], u0[2]), act1(g0[3], u0[3]));
                w.z = cvt_pk_bf16(act1(g1[0], u1[0]), act1(g1[1], u1[1])); w.w = cvt_pk_bf16(act1(g1[2], u1[2]), act1(g1[3], u1[3]));
                __builtin_nontemporal_store(w, (u32x4*)rowp); }
    }
};


typedef int i32x4 __attribute__((ext_vector_type(4)));
struct EpiBf16I8 {
    static constexpr bool PERM = true, AFTER_DRAIN = false; static constexpr int NSTORE = 16;
    bf16_t* O; int ldc; const float* rs; const float* cs; PG8_LAS float* tab;
    static constexpr int TAB = 768;
    __device__ __forceinline__ void stage_dma(const Unit& u, int par, int wid, int lane) const {
        const float* src = wid < 4 ? rs + (size_t)u.pm * BM + wid * 64 + lane : cs + (size_t)u.pb * BM + (wid - 4) * 64 + lane;
        __builtin_amdgcn_global_load_lds((const unsigned*)src, (PG8_LAS unsigned*)(tab + par * TAB + wid * 64), 4, 0, 0); }
    __device__ __forceinline__ void stage_sync(const Unit& u, int par, int tid) const {
        if (tid < 256) tab[par * TAB + tid] = rs[(size_t)u.pm * BM + tid]; else tab[par * TAB + tid] = cs[(size_t)u.pb * BM + tid - 256]; }
    __device__ __forceinline__ void operator()(const i32x4 (&acc)[2][2][4][2], const Unit& u, int wr, int wc, int fr, int fq, int par) const {
        const int row0 = u.pm * BM + wr * 64 + fr; const int col0 = u.pn * BM + wc * 32 + 8 * fq;
        const PG8_LAS float* tp = tab + par * TAB;
        f32x4 cv[2][2]; float rsv[2][4];
#pragma unroll
        for (int bj = 0; bj < 2; ++bj)
#pragma unroll
            for (int n = 0; n < 2; ++n) cv[bj][n] = *(const PG8_LAS f32x4*)(tp + 256 + wc * 32 + 8 * fq + bj * HALF + 4 * n);
#pragma unroll
        for (int ai = 0; ai < 2; ++ai)
#pragma unroll
            for (int m = 0; m < 4; ++m) rsv[ai][m] = tp[wr * 64 + fr + ai * HALF + m * 16];
#pragma unroll
        for (int ai = 0; ai < 2; ++ai)
#pragma unroll
            for (int m = 0; m < 4; ++m) { const int row = row0 + ai * HALF + m * 16; const float r = rsv[ai][m]; bf16_t* rowp = O + (size_t)row * ldc + col0;
#pragma unroll
                for (int bj = 0; bj < 2; ++bj) { const i32x4 a0 = acc[ai][bj][m][0], a1 = acc[ai][bj][m][1];
                    const f32x4 v0 = (f32x4){(float)a0[0], (float)a0[1], (float)a0[2], (float)a0[3]} * cv[bj][0] * r, v1 = (f32x4){(float)a1[0], (float)a1[1], (float)a1[2], (float)a1[3]} * cv[bj][1] * r;
                    u32x4 w; w.x = cvt_pk_bf16(v0[0], v0[1]); w.y = cvt_pk_bf16(v0[2], v0[3]); w.z = cvt_pk_bf16(v1[0], v1[1]); w.w = cvt_pk_bf16(v1[2], v1[3]);
                    __builtin_nontemporal_store(w, (u32x4*)(rowp + bj * HALF)); } }
    }
};
struct EpiSwigluI8 {
    static constexpr bool PERM = true, AFTER_DRAIN = false; static constexpr int NSTORE = 8;
    bf16_t* O; const float* bias; const float* rs; const float* cs; PG8_LAS float* tab;
    static constexpr int TAB = 768;
    __device__ __forceinline__ void stage_dma(const Unit& u, int par, int wid, int lane) const {
        const float* src = wid < 4 ? rs + (size_t)u.pm * BM + wid * 64 + lane : cs + (size_t)u.pb * BM + (wid - 4) * 64 + lane;
        __builtin_amdgcn_global_load_lds((const unsigned*)src, (PG8_LAS unsigned*)(tab + par * TAB + wid * 64), 4, 0, 0);
        if (wid < 4) { const int i_ = wid * 64 + lane; const float* sb = bias + (size_t)u.e * 2048 + u.pn * HALF + (i_ & 127) + (i_ >= 128 ? 1024 : 0);
            __builtin_amdgcn_global_load_lds((const unsigned*)sb, (PG8_LAS unsigned*)(tab + par * TAB + 512 + wid * 64), 4, 0, 0); } }
    __device__ __forceinline__ void stage_sync(const Unit& u, int par, int tid) const {
        if (tid < 256) { tab[par * TAB + tid] = rs[(size_t)u.pm * BM + tid]; tab[par * TAB + 512 + tid] = bias[(size_t)u.e * 2048 + u.pn * HALF + (tid & 127) + (tid >= 128 ? 1024 : 0)]; }
        else tab[par * TAB + tid] = cs[(size_t)u.pb * BM + tid - 256]; }
    __device__ __forceinline__ float act1(float g, float up) const {
        g = fminf(g, 7.0f); up = fminf(fmaxf(up, -7.0f), 7.0f);
        const float sg = __builtin_amdgcn_rcpf(1.0f + __expf(-1.702f * g));
        return (up + 1.0f) * g * sg;
    }
    __device__ __forceinline__ void operator()(const i32x4 (&acc)[2][2][4][2], const Unit& u, int wr, int wc, int fr, int fq, int par) const {
        const int row0 = u.pm * BM + wr * 64 + fr; const int col0 = u.pn * HALF + wc * 32 + 8 * fq;
        const PG8_LAS float* tp = tab + par * TAB; const int cq = wc * 32 + 8 * fq;
        f32x4 bg[2], bu[2], cg[2], cu[2]; float rsv[2][4];
#pragma unroll
        for (int n = 0; n < 2; ++n) { bg[n] = *(const PG8_LAS f32x4*)(tp + 512 + cq + 4 * n); bu[n] = *(const PG8_LAS f32x4*)(tp + 640 + cq + 4 * n); cg[n] = *(const PG8_LAS f32x4*)(tp + 256 + cq + 4 * n); cu[n] = *(const PG8_LAS f32x4*)(tp + 256 + HALF + cq + 4 * n); }
#pragma unroll
        for (int ai = 0; ai < 2; ++ai)
#pragma unroll
            for (int m = 0; m < 4; ++m) rsv[ai][m] = tp[wr * 64 + fr + ai * HALF + m * 16];
#pragma unroll
        for (int ai = 0; ai < 2; ++ai)
#pragma unroll
            for (int m = 0; m < 4; ++m) { const int row = row0 + ai * HALF + m * 16; const float r = rsv[ai][m]; bf16_t* rowp = O + (size_t)row * 1024 + col0;
                f32x4 g[2], up[2];
#pragma unroll
                for (int n = 0; n < 2; ++n) { const i32x4 ag = acc[ai][0][m][n], au = acc[ai][1][m][n];
                    g[n] = (f32x4){(float)ag[0], (float)ag[1], (float)ag[2], (float)ag[3]} * cg[n] * r + bg[n];
                    up[n] = (f32x4){(float)au[0], (float)au[1], (float)au[2], (float)au[3]} * cu[n] * r + bu[n]; }
                u32x4 w; w.x = cvt_pk_bf16(act1(g[0][0], up[0][0]), act1(g[0][1], up[0][1])); w.y = cvt_pk_bf16(act1(g[0][2], up[0][2]), act1(g[0][3], up[0][3]));
                w.z = cvt_pk_bf16(act1(g[1][0], up[1][0]), act1(g[1][1], up[1][1])); w.w = cvt_pk_bf16(act1(g[1][2], up[1][2]), act1(g[1][3], up[1][3]));
                __builtin_nontemporal_store(w, (u32x4*)rowp); }
    }
};
template <class Epi, class Sched, bool ALIGN_EPI = false, bool SP2 = false>
__device__ __forceinline__ void gemm_phase(PG8_LAS unsigned char* lds, const Gemm g, const Sched& S, const Epi& E) {
    const int tid = threadIdx.x, wid = __builtin_amdgcn_readfirstlane(tid >> 6), lane = tid & 63, wr = wid >> 2, wc = wid & 3, fr = lane & 15, fq = lane >> 4;
    const int K = g.K, nt = K / BK;
    unsigned voffA[2], voffB[2];
#pragma unroll
    for (int i = 0; i < 2; ++i) { int R, C; stage_rc(tid * 16 + i * 8192, R, C); const int Rb = Epi::PERM ? ((R & ~31) + perm32(R & 31)) : R;
        voffA[i] = (unsigned)(R * K + C) * 2u; voffB[i] = (unsigned)(Rb * K + C) * 2u; }
    const size_t kstep = (size_t)(BK * 2);
    const size_t hstep = (size_t)HALF * K * 2;
    const size_t tstep = 2 * hstep;
    const unsigned ldsw = (unsigned)wid * 1024u;
    const int aoff = lds_byte(wr * 64 + fr, fq * 8), boff = lds_byte(wc * 32 + fr, fq * 8);
#define PG8_SA(b, h) (((b) * 2 + (h)) * HTB)
#define PG8_SB(b, h) ((4 + (b) * 2 + (h)) * HTB)
#define PG8_STAGE(bufoff, gbase, voff) do { _Pragma("unroll") for (int _i = 0; _i < 2; ++_i) \
        __builtin_amdgcn_global_load_lds((const unsigned*)((const char*)(gbase) + (voff)[_i]), (PG8_LAS unsigned*)(lds + (bufoff) + ldsw + _i * 8192), 16, 0, 0); } while (0)
#define PG8_LDA(dst, b, h) do { _Pragma("unroll") for (int m = 0; m < 4; ++m) _Pragma("unroll") for (int k = 0; k < 2; ++k) dst[m][k] = *(const PG8_LAS bf16x8*)(lds + PG8_SA(b, h) + aoff + m * 2048 + k * 1024); } while (0)
#define PG8_LDB(dst, b, h) do { _Pragma("unroll") for (int n = 0; n < 2; ++n) _Pragma("unroll") for (int k = 0; k < 2; ++k) dst[n][k] = *(const PG8_LAS bf16x8*)(lds + PG8_SB(b, h) + boff + n * 2048 + k * 1024); } while (0)
#define PG8_MMA(ai, bj, At, Bt) do { __builtin_amdgcn_s_setprio(1); _Pragma("unroll") for (int m = 0; m < 4; ++m) _Pragma("unroll") for (int n = 0; n < 2; ++n) _Pragma("unroll") for (int k = 0; k < 2; ++k) \
        acc[ai][bj][m][n] = __builtin_amdgcn_mfma_f32_16x16x32_bf16(Bt[n][k], At[m][k], acc[ai][bj][m][n], 0, 0, 0); __builtin_amdgcn_s_setprio(0); } while (0)
#define PG8_WAIT_V(n) asm volatile("s_waitcnt vmcnt(" #n ")" ::: "memory")
#define PG8_WAIT_L(n) asm volatile("s_waitcnt lgkmcnt(" #n ")" ::: "memory")
#define PG8_WAIT_V8R(rx) asm volatile("s_waitcnt vmcnt(%1)\n\ts_cmp_lg_u32 %0, 0\n\ts_cbranch_scc1 .Lpg8w_%=\n\ts_waitcnt vmcnt(8)\n.Lpg8w_%=:" :: "s"(rx), "n"(8 + Epi::NSTORE) : "scc", "memory")
#define PG8_BAR __builtin_amdgcn_s_barrier()
#define PG8_SCHED __builtin_amdgcn_sched_barrier(0)
    Unit cur, nxt; int ui = 0;
    if (!S.next(0, cur)) return;
    f32x4 acc[2][2][4][2];
#pragma unroll
    for (int a = 0; a < 2; ++a)
#pragma unroll
        for (int b = 0; b < 2; ++b)
#pragma unroll
            for (int m = 0; m < 4; ++m)
#pragma unroll
                for (int n = 0; n < 2; ++n) acc[a][b][m][n] = (f32x4){0.f, 0.f, 0.f, 0.f};
    bf16x8 At[4][2], B0[2][2], B1[2][2];
    const char* cA = (const char*)g.A + (size_t)cur.pm * tstep; const char* cB = (const char*)g.Bt + (size_t)cur.pb * tstep;
    S.a_ready(cur);
    if constexpr (SP2) {
        PG8_STAGE(PG8_SB(0, 0), cB, voffB); PG8_STAGE(PG8_SB(0, 1), cB + hstep, voffB); PG8_STAGE(PG8_SA(0, 0), cA, voffA); PG8_STAGE(PG8_SA(0, 1), cA + hstep, voffA);
        if (wr == 1) PG8_BAR;
        PG8_WAIT_V(2); PG8_BAR;
        PG8_STAGE(PG8_SB(1, 0), cB + kstep, voffB); PG8_STAGE(PG8_SA(1, 0), cA + kstep, voffA); PG8_STAGE(PG8_SB(1, 1), cB + hstep + kstep, voffB);
        PG8_WAIT_V(6); PG8_BAR;
    } else {
        PG8_STAGE(PG8_SB(0, 0), cB, voffB); PG8_STAGE(PG8_SA(0, 0), cA, voffA); PG8_STAGE(PG8_SB(0, 1), cB + hstep, voffB); PG8_STAGE(PG8_SA(0, 1), cA + hstep, voffA);
        if (wr == 1) PG8_BAR;
        PG8_WAIT_V(4); PG8_BAR;
        PG8_STAGE(PG8_SB(1, 0), cB + kstep, voffB); PG8_STAGE(PG8_SA(1, 0), cA + kstep, voffA); PG8_STAGE(PG8_SB(1, 1), cB + hstep + kstep, voffB);
        PG8_WAIT_V(6); PG8_BAR;
    }
    for (;;) {
        const bool has_next = S.next(ui + 1, nxt);
        const char* nA = has_next ? (const char*)g.A + (size_t)nxt.pm * tstep : cA; const char* nB = has_next ? (const char*)g.Bt + (size_t)nxt.pb * tstep : cB;
        for (int t = 0; t < nt; t += 2) {
            const bool last = (t == nt - 2);
            const char* a1 = cA + (size_t)(t + 1) * kstep;
            const char* a2 = last ? nA : cA + (size_t)(t + 2) * kstep; const char* b2 = last ? nB : cB + (size_t)(t + 2) * kstep;
            const char* a3 = a2 + kstep; const char* b3 = b2 + kstep;
            if (last && has_next) S.a_ready(nxt);
            const int relax = __builtin_amdgcn_readfirstlane(((t == 0) && (ui > 0)) ? 1 : 0);
            if constexpr (SP2) {
            PG8_LDB(B0, 0, 0); PG8_LDB(B1, 0, 1); PG8_SCHED; PG8_LDA(At, 0, 0); PG8_STAGE(PG8_SA(1, 1), a1 + hstep, voffA);
            PG8_WAIT_V8R(relax); PG8_WAIT_L(0); PG8_BAR; PG8_MMA(0, 0, At, B0); PG8_MMA(0, 1, At, B1); PG8_BAR; PG8_SCHED;
            PG8_LDA(At, 0, 1); PG8_STAGE(PG8_SB(0, 0), b2, voffB); PG8_STAGE(PG8_SB(0, 1), b2 + hstep, voffB); PG8_STAGE(PG8_SA(0, 0), a2, voffA);
            PG8_WAIT_V8R(relax); PG8_WAIT_L(0); PG8_BAR; PG8_MMA(1, 0, At, B0); PG8_MMA(1, 1, At, B1); PG8_BAR; PG8_SCHED;
            PG8_LDB(B0, 1, 0); PG8_LDB(B1, 1, 1); PG8_SCHED; PG8_LDA(At, 1, 0); PG8_STAGE(PG8_SA(0, 1), a2 + hstep, voffA);
            PG8_WAIT_V(8); PG8_WAIT_L(0); PG8_BAR; PG8_MMA(0, 0, At, B0); PG8_MMA(0, 1, At, B1); PG8_BAR; PG8_SCHED;
            PG8_LDA(At, 1, 1); PG8_STAGE(PG8_SB(1, 0), b3, voffB); PG8_STAGE(PG8_SB(1, 1), b3 + hstep, voffB); PG8_STAGE(PG8_SA(1, 0), a3, voffA);
            PG8_WAIT_V(8); PG8_WAIT_L(0); PG8_BAR; PG8_MMA(1, 0, At, B0); PG8_MMA(1, 1, At, B1); PG8_BAR; PG8_SCHED;
            } else {
            PG8_LDB(B0, 0, 0); PG8_SCHED; PG8_LDA(At, 0, 0); PG8_STAGE(PG8_SA(1, 1), a1 + hstep, voffA);
            PG8_WAIT_L(8); PG8_BAR; PG8_WAIT_L(0); PG8_MMA(0, 0, At, B0); PG8_BAR; PG8_SCHED;
            PG8_LDB(B1, 0, 1); PG8_STAGE(PG8_SB(0, 0), b2, voffB);
            PG8_BAR; PG8_WAIT_L(0); PG8_MMA(0, 1, At, B1); PG8_BAR;
            PG8_LDA(At, 0, 1); PG8_STAGE(PG8_SA(0, 0), a2, voffA);
            PG8_BAR; PG8_WAIT_L(0); PG8_MMA(1, 0, At, B0); PG8_BAR; PG8_SCHED;
            PG8_STAGE(PG8_SB(0, 1), b2 + hstep, voffB);
            PG8_WAIT_V(6); PG8_BAR; PG8_MMA(1, 1, At, B1); PG8_BAR;
            PG8_LDB(B0, 1, 0); PG8_SCHED; PG8_LDA(At, 1, 0); PG8_STAGE(PG8_SA(0, 1), a2 + hstep, voffA);
            PG8_WAIT_L(8); PG8_BAR; PG8_WAIT_L(0); PG8_MMA(0, 0, At, B0); PG8_BAR; PG8_SCHED;
            PG8_LDB(B1, 1, 1); PG8_STAGE(PG8_SB(1, 0), b3, voffB);
            PG8_BAR; PG8_WAIT_L(0); PG8_MMA(0, 1, At, B1); PG8_BAR;
            PG8_LDA(At, 1, 1); PG8_STAGE(PG8_SA(1, 0), a3, voffA);
            PG8_BAR; PG8_WAIT_L(0); PG8_MMA(1, 0, At, B0); PG8_BAR; PG8_SCHED;
            PG8_STAGE(PG8_SB(1, 1), b3 + hstep, voffB);
            PG8_WAIT_V(6); PG8_BAR; PG8_MMA(1, 1, At, B1); PG8_BAR;
            }
        }
        if constexpr (ALIGN_EPI) { if (wr == 0) PG8_BAR; }
        if constexpr (!Epi::AFTER_DRAIN) { E(acc, cur, wr, wc, fr, fq); S.done(cur); }
        if (!has_next) break;
#pragma unroll
        for (int a = 0; a < 2; ++a)
#pragma unroll
            for (int b = 0; b < 2; ++b)
#pragma unroll
                for (int m = 0; m < 4; ++m)
#pragma unroll
                    for (int n = 0; n < 2; ++n) acc[a][b][m][n] = (f32x4){0.f, 0.f, 0.f, 0.f};
        cur = nxt; cA = nA; cB = nB; ++ui;
        if constexpr (ALIGN_EPI) { if (wr == 1) PG8_BAR; }
    }
    PG8_WAIT_V(0);
    if constexpr (!ALIGN_EPI) { if (wr == 0) PG8_BAR; }
    PG8_BAR;
    if constexpr (Epi::AFTER_DRAIN) { E.fused(acc, cur, wr, wc, fr, fq, lds, wid, lane); S.done(cur); }
#undef PG8_SA
#undef PG8_SB
#undef PG8_STAGE
#undef PG8_LDA
#undef PG8_LDB
#undef PG8_MMA
#undef PG8_WAIT_V
#undef PG8_WAIT_L
#undef PG8_WAIT_V8R
#undef PG8_BAR
#undef PG8_SCHED
}
template <class Epi, class Sched, bool ALIGN_EPI = false, bool SP2 = false>
__device__ __forceinline__ void gemm_phase_i8(PG8_LAS unsigned char* lds, const Gemm g, const Sched& S, const Epi& E) {
    const int tid = threadIdx.x, wid = __builtin_amdgcn_readfirstlane(tid >> 6), lane = tid & 63, wr = wid >> 2, wc = wid & 3, fr = lane & 15, fq = lane >> 4;
    const int K = g.K, nt = K / 128;
    unsigned voffA[2], voffB[2];
#pragma unroll
    for (int i = 0; i < 2; ++i) { int R, C; stage_rc(tid * 16 + i * 8192, R, C); const int Rb = Epi::PERM ? ((R & ~31) + perm32(R & 31)) : R;
        voffA[i] = (unsigned)(R * K + C * 2); voffB[i] = (unsigned)(Rb * K + C * 2); }
    const size_t kstep = (size_t)(BK * 2);
    const size_t hstep = (size_t)HALF * K;
    const size_t tstep = 2 * hstep;
    const unsigned ldsw = (unsigned)wid * 1024u;
    const int aoff = lds_byte(wr * 64 + fr, fq * 8), boff = lds_byte(wc * 32 + fr, fq * 8);
#define PG8_SA(b, h) (((b) * 2 + (h)) * HTB)
#define PG8_SB(b, h) ((4 + (b) * 2 + (h)) * HTB)
#define PG8_STAGE(bufoff, gbase, voff) do { _Pragma("unroll") for (int _i = 0; _i < 2; ++_i) \
        __builtin_amdgcn_global_load_lds((const unsigned*)((const char*)(gbase) + (voff)[_i]), (PG8_LAS unsigned*)(lds + (bufoff) + ldsw + _i * 8192), 16, 0, 0); } while (0)
#define PG8_LDA(dst, b, h) do { _Pragma("unroll") for (int m = 0; m < 4; ++m) _Pragma("unroll") for (int k = 0; k < 2; ++k) dst[m][k] = *(const PG8_LAS bf16x8*)(lds + PG8_SA(b, h) + aoff + m * 2048 + k * 1024); } while (0)
#define PG8_LDB(dst, b, h) do { _Pragma("unroll") for (int n = 0; n < 2; ++n) _Pragma("unroll") for (int k = 0; k < 2; ++k) dst[n][k] = *(const PG8_LAS bf16x8*)(lds + PG8_SB(b, h) + boff + n * 2048 + k * 1024); } while (0)
#define PG8_MMA(ai, bj, At, Bt) do { __builtin_amdgcn_s_setprio(1); _Pragma("unroll") for (int m = 0; m < 4; ++m) _Pragma("unroll") for (int n = 0; n < 2; ++n) _Pragma("unroll") for (int k = 0; k < 2; ++k) \
        acc[ai][bj][m][n] = __builtin_amdgcn_mfma_i32_16x16x64_i8(__builtin_bit_cast(i32x4, Bt[n][k]), __builtin_bit_cast(i32x4, At[m][k]), acc[ai][bj][m][n], 0, 0, 0); __builtin_amdgcn_s_setprio(0); } while (0)
#define PG8_WAIT_V(n) asm volatile("s_waitcnt vmcnt(" #n ")" ::: "memory")
#define PG8_WAIT_L(n) asm volatile("s_waitcnt lgkmcnt(" #n ")" ::: "memory")
#define PG8_WAIT_V8R(rx) asm volatile("s_waitcnt vmcnt(%1)\n\ts_cmp_lg_u32 %0, 0\n\ts_cbranch_scc1 .Lpg8w_%=\n\ts_waitcnt vmcnt(8)\n.Lpg8w_%=:" :: "s"(rx), "n"(8 + Epi::NSTORE) : "scc", "memory")
#define PG8_BAR __builtin_amdgcn_s_barrier()
#define PG8_SCHED __builtin_amdgcn_sched_barrier(0)
    Unit cur, nxt; int ui = 0;
    if (!S.next(0, cur)) return;
    i32x4 acc[2][2][4][2];
#pragma unroll
    for (int a = 0; a < 2; ++a)
#pragma unroll
        for (int b = 0; b < 2; ++b)
#pragma unroll
            for (int m = 0; m < 4; ++m)
#pragma unroll
                for (int n = 0; n < 2; ++n) acc[a][b][m][n] = (i32x4){0, 0, 0, 0};
    bf16x8 At[4][2], B0[2][2], B1[2][2];
    const char* cA = (const char*)g.A + (size_t)cur.pm * tstep; const char* cB = (const char*)g.Bt + (size_t)cur.pb * tstep;
    S.a_ready(cur);
    E.stage_dma(cur, 0, wid, lane);
    if constexpr (SP2) {
        PG8_STAGE(PG8_SB(0, 0), cB, voffB); PG8_STAGE(PG8_SB(0, 1), cB + hstep, voffB); PG8_STAGE(PG8_SA(0, 0), cA, voffA); PG8_STAGE(PG8_SA(0, 1), cA + hstep, voffA);
        if (wr == 1) PG8_BAR;
        PG8_WAIT_V(2); PG8_BAR;
        PG8_STAGE(PG8_SB(1, 0), cB + kstep, voffB); PG8_STAGE(PG8_SA(1, 0), cA + kstep, voffA); PG8_STAGE(PG8_SB(1, 1), cB + hstep + kstep, voffB);
        PG8_WAIT_V(6); PG8_BAR;
    } else {
        PG8_STAGE(PG8_SB(0, 0), cB, voffB); PG8_STAGE(PG8_SA(0, 0), cA, voffA); PG8_STAGE(PG8_SB(0, 1), cB + hstep, voffB); PG8_STAGE(PG8_SA(0, 1), cA + hstep, voffA);
        if (wr == 1) PG8_BAR;
        PG8_WAIT_V(4); PG8_BAR;
        PG8_STAGE(PG8_SB(1, 0), cB + kstep, voffB); PG8_STAGE(PG8_SA(1, 0), cA + kstep, voffA); PG8_STAGE(PG8_SB(1, 1), cB + hstep + kstep, voffB);
        PG8_WAIT_V(6); PG8_BAR;
    }
    for (;;) {
        const bool has_next = S.next(ui + 1, nxt);
        const char* nA = has_next ? (const char*)g.A + (size_t)nxt.pm * tstep : cA; const char* nB = has_next ? (const char*)g.Bt + (size_t)nxt.pb * tstep : cB;
        if (has_next) E.stage_dma(nxt, (ui + 1) % 3, wid, lane);
        for (int t = 0; t < nt; t += 2) {
            const bool last = (t == nt - 2);
            const char* a1 = cA + (size_t)(t + 1) * kstep;
            const char* a2 = last ? nA : cA + (size_t)(t + 2) * kstep; const char* b2 = last ? nB : cB + (size_t)(t + 2) * kstep;
            const char* a3 = a2 + kstep; const char* b3 = b2 + kstep;
            if (last && has_next) S.a_ready(nxt);
            const int relax = __builtin_amdgcn_readfirstlane(((t == 0) && (ui > 0)) ? 1 : 0);
            if constexpr (SP2) {
            PG8_LDB(B0, 0, 0); PG8_LDB(B1, 0, 1); PG8_SCHED; PG8_LDA(At, 0, 0); PG8_STAGE(PG8_SA(1, 1), a1 + hstep, voffA);
            PG8_WAIT_V8R(relax); PG8_WAIT_L(0); PG8_BAR; PG8_MMA(0, 0, At, B0); PG8_MMA(0, 1, At, B1); PG8_BAR; PG8_SCHED;
            PG8_LDA(At, 0, 1); PG8_STAGE(PG8_SB(0, 0), b2, voffB); PG8_STAGE(PG8_SB(0, 1), b2 + hstep, voffB); PG8_STAGE(PG8_SA(0, 0), a2, voffA);
            PG8_WAIT_V8R(relax); PG8_WAIT_L(0); PG8_BAR; PG8_MMA(1, 0, At, B0); PG8_MMA(1, 1, At, B1); PG8_BAR; PG8_SCHED;
            PG8_LDB(B0, 1, 0); PG8_LDB(B1, 1, 1); PG8_SCHED; PG8_LDA(At, 1, 0); PG8_STAGE(PG8_SA(0, 1), a2 + hstep, voffA);
            PG8_WAIT_V(8); PG8_WAIT_L(0); PG8_BAR; PG8_MMA(0, 0, At, B0); PG8_MMA(0, 1, At, B1); PG8_BAR; PG8_SCHED;
            PG8_LDA(At, 1, 1); PG8_STAGE(PG8_SB(1, 0), b3, voffB); PG8_STAGE(PG8_SB(1, 1), b3 + hstep, voffB); PG8_STAGE(PG8_SA(1, 0), a3, voffA);
            PG8_WAIT_V(8); PG8_WAIT_L(0); PG8_BAR; PG8_MMA(1, 0, At, B0); PG8_MMA(1, 1, At, B1); PG8_BAR; PG8_SCHED;
            } else {
            PG8_LDB(B0, 0, 0); PG8_SCHED; PG8_LDA(At, 0, 0); PG8_STAGE(PG8_SA(1, 1), a1 + hstep, voffA);
            PG8_WAIT_L(8); PG8_BAR; PG8_WAIT_L(0); PG8_MMA(0, 0, At, B0); PG8_BAR; PG8_SCHED;
            PG8_LDB(B1, 0, 1); PG8_STAGE(PG8_SB(0, 0), b2, voffB);
            PG8_BAR; PG8_WAIT_L(0); PG8_MMA(0, 1, At, B1); PG8_BAR;
            PG8_LDA(At, 0, 1); PG8_STAGE(PG8_SA(0, 0), a2, voffA);
            PG8_BAR; PG8_WAIT_L(0); PG8_MMA(1, 0, At, B0); PG8_BAR; PG8_SCHED;
            PG8_STAGE(PG8_SB(0, 1), b2 + hstep, voffB);
            PG8_WAIT_V(6); PG8_BAR; PG8_MMA(1, 1, At, B1); PG8_BAR;
            PG8_LDB(B0, 1, 0); PG8_SCHED; PG8_LDA(At, 1, 0); PG8_STAGE(PG8_SA(0, 1), a2 + hstep, voffA);
            PG8_WAIT_L(8); PG8_BAR; PG8_WAIT_L(0); PG8_MMA(0, 0, At, B0); PG8_BAR; PG8_SCHED;
            PG8_LDB(B1, 1, 1); PG8_STAGE(PG8_SB(1, 0), b3, voffB);
            PG8_BAR; PG8_WAIT_L(0); PG8_MMA(0, 1, At, B1); PG8_BAR;
            PG8_LDA(At, 1, 1); PG8_STAGE(PG8_SA(1, 0), a3, voffA);
            PG8_BAR; PG8_WAIT_L(0); PG8_MMA(1, 0, At, B0); PG8_BAR; PG8_SCHED;
            PG8_STAGE(PG8_SB(1, 1), b3 + hstep, voffB);
            PG8_WAIT_V(6); PG8_BAR; PG8_MMA(1, 1, At, B1); PG8_BAR;
            }
        }
        if constexpr (ALIGN_EPI) { if (wr == 0) PG8_BAR; }
        if constexpr (!Epi::AFTER_DRAIN) { E(acc, cur, wr, wc, fr, fq, ui % 3); S.done(cur); }
        if (!has_next) break;
#pragma unroll
        for (int a = 0; a < 2; ++a)
#pragma unroll
            for (int b = 0; b < 2; ++b)
#pragma unroll
                for (int m = 0; m < 4; ++m)
#pragma unroll
                    for (int n = 0; n < 2; ++n) acc[a][b][m][n] = (i32x4){0, 0, 0, 0};
        cur = nxt; cA = nA; cB = nB; ++ui;
        if constexpr (ALIGN_EPI) { if (wr == 1) PG8_BAR; }
    }
    PG8_WAIT_V(0);
    if constexpr (!ALIGN_EPI) { if (wr == 0) PG8_BAR; }
    PG8_BAR;
    if constexpr (Epi::AFTER_DRAIN) { E.fused(acc, cur, wr, wc, fr, fq, lds, wid, lane); S.done(cur); }
#undef PG8_SA
#undef PG8_SB
#undef PG8_STAGE
#undef PG8_LDA
#undef PG8_LDB
#undef PG8_MMA
#undef PG8_WAIT_V
#undef PG8_WAIT_L
#undef PG8_WAIT_V8R
#undef PG8_BAR
#undef PG8_SCHED
}

}
#ifndef STAGE_REP
#define STAGE_REP 0
#endif

constexpr int NWAVES = 8;
#ifndef WEO_TAIL
#define WEO_TAIL 8192
#endif
#ifndef SSQ
#define SSQ 2
#endif
#ifndef SS_FILL_Q8
#define SS_FILL_Q8 0
#endif
#ifndef SS_FILL_WEO
#define SS_FILL_WEO 1
#endif
#ifndef SEAM_FILL
#define SEAM_FILL 1
#endif
constexpr int D = 1024, BATCH = 2, T = 8192, TC = 256, NH = 16;
constexpr int ML = BATCH * T;
constexpr int MC = BATCH * TC;
constexpr int MT = ML + MC;
constexpr int N_IN = 8576, NZ = 8704;
constexpr int K_OFF = 0, V_OFF = 1024, DECAY_OFF = 2048, ICLR_OFF = 2176, STATE_COLS = 2304, R_OFF = 2304, GLORA_OFF = 3328, SHIFT_COLS = 3456;
constexpr int CONV_OFF = 3456, GATE_OFF = 6528;
constexpr int NE = 32, TOPK = 4, DFF = 1024;
constexpr int NL = 5120, KL = 384;
constexpr int MAXBLK = 288;
constexpr int NROWS = MAXBLK * 256;
constexpr int KSPLIT = 16;

constexpr size_t MiB = 1u << 20;
constexpr size_t WS_CTL = 0, CTL_ZERO_BYTES = 96 * 1024;
constexpr size_t WS_MODP = 1 * MiB;
constexpr size_t WS_WLORA = 3 * MiB;
constexpr size_t WS_WROUT = 7 * MiB;
constexpr size_t WS_WOUT = 8 * MiB;
constexpr size_t WS_WIN = 10 * MiB;
constexpr size_t WS_A0 = 28 * MiB;
constexpr size_t WS_MISC = 61 * MiB;
constexpr size_t WS_Z = 64 * MiB;
constexpr size_t WS_AL = 345 * MiB;
constexpr size_t WS_LORA = 358 * MiB;
constexpr size_t WS_SCAN = 523 * MiB;
constexpr size_t WS_Y = 886 * MiB;
constexpr size_t WS_END = 1014 * MiB;
constexpr size_t WS_PQ = WS_SCAN;
constexpr size_t WS_TKN = WS_PQ + 132 * MiB;
constexpr size_t WS_UPRE = WS_TKN + 66 * MiB;
constexpr size_t WS_H0T = WS_UPRE + 66 * MiB;
static_assert(WS_H0T + 64 * MiB <= WS_Y, "scan region");
constexpr size_t WS_MIX = WS_LORA, WS_X1 = WS_LORA + 64 * MiB, WS_H2 = WS_LORA + 128 * MiB;
constexpr size_t WS_LOGIT = WS_SCAN, WS_XB = WS_SCAN + 16 * MiB, WS_ACT = WS_XB + 144 * MiB;
constexpr size_t WS_Y2 = WS_Z, WS_WEIN = WS_Y, WS_WEOUT = WS_Y + 64 * MiB;
static_assert(WS_ACT + 144 * MiB <= WS_Y && WS_WEIN + 64 * MiB <= WS_WEOUT && WS_WEOUT + 64 * MiB <= WS_END, "late regions");
constexpr size_t MI_SELE = WS_MISC, MI_SELP = MI_SELE + (size_t)ML * 4 * 4, MI_GATE = MI_SELP + (size_t)ML * 4 * 4, MI_DEST = MI_GATE + (size_t)ML * 4 * 4, MI_BLKE = MI_DEST + (size_t)ML * 4 * 4;
constexpr size_t MI_RSH = MI_BLKE + 4096;
constexpr size_t MI_CSWIN = MI_RSH + (size_t)MT * 4;
constexpr size_t MI_RSH2 = MI_CSWIN + (size_t)NZ * 4;
constexpr size_t MI_RSXB = MI_RSH2 + (size_t)ML * 4;
constexpr size_t MI_CSWEI = MI_RSXB + (size_t)NROWS * 4;
constexpr size_t MI_BON = MI_CSWEI + (size_t)NE * 2048 * 4;
static_assert(MI_BON + (size_t)4096 * 64 * 4 <= WS_Z && MI_RSH % 16 == 0 && MI_CSWIN % 16 == 0 && MI_CSWEI % 16 == 0, "misc");
constexpr size_t WS_H2Q = WS_A0;
constexpr int CW_BAR = 4096;
constexpr int CW_CNT = 16384;
constexpr int CW_FB = 8192;
constexpr int CW_Q6 = CW_CNT + 64 * 40;

constexpr int RING_OFF = 0, RING_BYTES = 131072;
constexpr int LDSCTL_OFF = 147456, MISC_OFF = LDSCTL_OFF + 320;
constexpr int LDS_X_OFF = LDSCTL_OFF + 512;
constexpr int LDS_BYTES = 163840;

#define GAS __attribute__((address_space(1)))
#define LAS __attribute__((address_space(3)))
typedef unsigned short bf16;
typedef unsigned v4u __attribute__((ext_vector_type(4)));
typedef unsigned v2u __attribute__((ext_vector_type(2)));
typedef float f32x4 __attribute__((ext_vector_type(4)));
#define LDS_WAIT() asm volatile("s_waitcnt lgkmcnt(0)" ::: "memory")
#define VM_WAIT() asm volatile("s_waitcnt vmcnt(0)" ::: "memory")
__device__ __forceinline__ unsigned f2bf(float f) { unsigned u = __builtin_bit_cast(unsigned, f); return (u + 0x7fffu + ((u >> 16) & 1u)) >> 16; }
__device__ __forceinline__ unsigned pk2(float lo, float hi) { return f2bf(lo) | (f2bf(hi) << 16); }
typedef __bf16 bf16v2h_t __attribute__((ext_vector_type(2)));
__device__ __forceinline__ unsigned pk2h(float lo, float hi) { const bf16v2h_t v = {(__bf16)lo, (__bf16)hi}; return __builtin_bit_cast(unsigned, v); }
__device__ __forceinline__ float bflo(unsigned w) { return __builtin_bit_cast(float, w << 16); }
__device__ __forceinline__ float bfhi(unsigned w) { return __builtin_bit_cast(float, w & 0xffff0000u); }
__device__ __forceinline__ float bf1(bf16 h) { return __builtin_bit_cast(float, (unsigned)h << 16); }
__device__ __forceinline__ void ld16bf(const bf16* p, float (&o)[16]) {
    const v4u a = *(const v4u*)p, b = *(const v4u*)(p + 8);
    o[0] = bflo(a.x); o[1] = bfhi(a.x); o[2] = bflo(a.y); o[3] = bfhi(a.y); o[4] = bflo(a.z); o[5] = bfhi(a.z); o[6] = bflo(a.w); o[7] = bfhi(a.w);
    o[8] = bflo(b.x); o[9] = bfhi(b.x); o[10] = bflo(b.y); o[11] = bfhi(b.y); o[12] = bflo(b.z); o[13] = bfhi(b.z); o[14] = bflo(b.w); o[15] = bfhi(b.w);
}
__device__ __forceinline__ void st16bf(bf16* p, const float (&o)[16]) {
    v4u a, b; a.x = pk2(o[0], o[1]); a.y = pk2(o[2], o[3]); a.z = pk2(o[4], o[5]); a.w = pk2(o[6], o[7]);
    b.x = pk2(o[8], o[9]); b.y = pk2(o[10], o[11]); b.z = pk2(o[12], o[13]); b.w = pk2(o[14], o[15]);
    *(v4u*)p = a; *(v4u*)(p + 8) = b;
}
__device__ __forceinline__ void ld16f(const float* p, float (&o)[16]) {
#pragma unroll
    for (int q = 0; q < 4; ++q) { const f32x4 v = *(const f32x4*)(p + 4 * q); o[4 * q] = v.x; o[4 * q + 1] = v.y; o[4 * q + 2] = v.z; o[4 * q + 3] = v.w; }
}
__device__ __forceinline__ void ld16f_lds(const LAS float* p, float (&o)[16]) {
#pragma unroll
    for (int q = 0; q < 4; ++q) { const f32x4 v = *(const LAS f32x4*)(p + 4 * q); o[4 * q] = v.x; o[4 * q + 1] = v.y; o[4 * q + 2] = v.z; o[4 * q + 3] = v.w; }
}
__device__ __forceinline__ void st16f(float* p, const float (&o)[16]) {
#pragma unroll
    for (int q = 0; q < 4; ++q) *(f32x4*)(p + 4 * q) = (f32x4){o[4 * q], o[4 * q + 1], o[4 * q + 2], o[4 * q + 3]};
}
#define NTL(p) __builtin_nontemporal_load(p)
__device__ __forceinline__ float sigmoidf_(float x) { return 1.0f / (1.0f + __expf(-x)); }
__device__ __forceinline__ float wave_sum(float v) {
#pragma unroll
    for (int o = 1; o < 64; o <<= 1) v += __shfl_xor(v, o);
    return v;
}
__device__ __forceinline__ float wave_max(float v) {
#pragma unroll
    for (int o = 1; o < 64; o <<= 1) v = fmaxf(v, __shfl_xor(v, o));
    return v;
}
__device__ __forceinline__ unsigned pack_q4(float a, float b, float c, float d) {
    const int qa = __float2int_rn(a), qb = __float2int_rn(b), qc = __float2int_rn(c), qd = __float2int_rn(d);
    return (unsigned)(qa & 255) | ((unsigned)(qb & 255) << 8) | ((unsigned)(qc & 255) << 16) | ((unsigned)qd << 24);
}
__device__ __forceinline__ float quad_sum(float v) { v += __shfl_xor(v, 1); v += __shfl_xor(v, 2); return v; }

#define XB_TMO      128
#define XB_XCNT(j)  (256  + 64 * (j))
#define XB_XSUB(j)  (1280 + 64 * (j))
#define XB_XGEN(j)  (2304 + 64 * (j))
#define XB_TOP      3328
#define XB_TOPGEN   3392
#define XCD_BAR_WORDS 3456
#define XB_SPIN_CAP (1u << 18)

__device__ __forceinline__ unsigned xb_ld(unsigned* p)              { return __hip_atomic_load(p, __ATOMIC_RELAXED, __HIP_MEMORY_SCOPE_AGENT); }
__device__ __forceinline__ unsigned xb_add(unsigned* p, unsigned v) { return __hip_atomic_fetch_add(p, v, __ATOMIC_RELAXED, __HIP_MEMORY_SCOPE_AGENT); }
__device__ __forceinline__ unsigned xb_xcc_id() { return (unsigned)__builtin_amdgcn_s_getreg((3 << 11) | 20) & 0xFu; }
#define XB_SPIN(cond, bar) do { unsigned _sp = 0; while (cond) { __builtin_amdgcn_s_sleep(1); \
    if ((++_sp & 255u) == 0u) { if (xb_ld(&(bar)[XB_TMO])) break; if (_sp > XB_SPIN_CAP) { atomicAdd(&(bar)[XB_TMO], 1u); break; } } } } while (0)

struct XcdBarrier { unsigned* bar; unsigned x; volatile LAS unsigned* st; };

__device__ __forceinline__ XcdBarrier xcd_barrier_post(unsigned* bar, volatile LAS unsigned* st) {
    XcdBarrier b; b.bar = bar; b.x = xb_xcc_id(); b.st = st;
    if (threadIdx.x == 0) (void)xb_add(&bar[XB_XCNT(b.x)], 1u);
    return b;
}
__device__ __forceinline__ void xcd_barrier_complete(unsigned* bar, unsigned x, unsigned& nloc, unsigned& nx) {
    const unsigned G = gridDim.x * gridDim.y * gridDim.z;
    unsigned sum, cnt, mine, sp = 0u;
    for (;;) {
        sum = 0u; cnt = 0u; mine = 0u;
#pragma unroll
        for (unsigned j = 0; j < 16; ++j) { const unsigned c = xb_ld(&bar[XB_XCNT(j)]); sum += c; cnt += (c > 0u) ? 1u : 0u; mine = (j == x) ? c : mine; }
        if (sum == G) break;
        __builtin_amdgcn_s_sleep(1);
        if ((++sp & 255u) == 0u) { if (xb_ld(&bar[XB_TMO])) break; if (sp > XB_SPIN_CAP) { atomicAdd(&bar[XB_TMO], 1u); break; } }
    }
    nloc = mine > 0u ? mine : 1u; nx = cnt > 0u ? cnt : 1u;
}
__device__ __forceinline__ void xcd_barrier(const XcdBarrier& b) {
    asm volatile("s_waitcnt vmcnt(0)" ::: "memory");
    __syncthreads();
    if (threadIdx.x == 0) {
        unsigned* bar = b.bar;
        __builtin_amdgcn_s_waitcnt(0);
        unsigned nloc = b.st[0], nx = b.st[1];
        if (nloc == 0u) { xcd_barrier_complete(bar, b.x, nloc, nx); b.st[0] = nloc; b.st[1] = nx; }
        const unsigned old = xb_add(&bar[XB_XSUB(b.x)], 1u);
        const unsigned gen = old / nloc;
        if (old + 1u == (gen + 1u) * nloc) {
            __builtin_amdgcn_fence(__ATOMIC_RELEASE, "agent");
            asm volatile("s_waitcnt vmcnt(0)" ::: "memory");
            const unsigned og = xb_add(&bar[XB_TOP], 1u);
            const unsigned tg = og / nx;
            if (og + 1u == (tg + 1u) * nx) xb_add(&bar[XB_TOPGEN], 1u);
            else XB_SPIN(xb_ld(&bar[XB_TOPGEN]) == tg, bar);
            __builtin_amdgcn_fence(__ATOMIC_ACQUIRE, "agent");
            xb_add(&bar[XB_XGEN(b.x)], 1u);
            asm volatile("s_waitcnt vmcnt(0)" ::: "memory");
        } else {
            XB_SPIN(xb_ld(&bar[XB_XGEN(b.x)]) == gen, bar);
            __builtin_amdgcn_fence(__ATOMIC_ACQUIRE, "agent");
            asm volatile("s_waitcnt vmcnt(0)" ::: "memory");
        }
    }
    __syncthreads();
}

#define XB_DONE(j)  (3456 + 64 * (j))
__device__ __forceinline__ void xcd_barrier2(const XcdBarrier& b) {
    asm volatile("s_waitcnt vmcnt(0)" ::: "memory");
    __syncthreads();
    if (threadIdx.x == 0) {
        unsigned* bar = b.bar;
        __builtin_amdgcn_s_waitcnt(0);
        unsigned nloc = b.st[0], nx = b.st[1];
        if (nloc == 0u) { xcd_barrier_complete(bar, b.x, nloc, nx); b.st[0] = nloc; b.st[1] = nx; }
        const unsigned old = xb_add(&bar[XB_XSUB(b.x)], 1u);
        const unsigned gen = old / nloc;
        if (old + 1u == (gen + 1u) * nloc) {
            __builtin_amdgcn_fence(__ATOMIC_RELEASE, "agent");
            asm volatile("s_waitcnt vmcnt(0)" ::: "memory");
#pragma unroll
            for (unsigned j = 0; j < 16; ++j) (void)xb_add(&bar[XB_DONE(j)], 1u);
        }
        XB_SPIN(xb_ld(&bar[XB_DONE(b.x)]) < (gen + 1u) * nx, bar);
        __builtin_amdgcn_fence(__ATOMIC_ACQUIRE, "agent");
        asm volatile("s_waitcnt vmcnt(0)" ::: "memory");
    }
    __syncthreads();
}

__device__ __forceinline__ void xcd_barrier2_arrive(const XcdBarrier& b) {
    asm volatile("s_waitcnt vmcnt(0)" ::: "memory");
    __syncthreads();
    if (threadIdx.x == 0) {
        unsigned* bar = b.bar;
        __builtin_amdgcn_s_waitcnt(0);
        unsigned nloc = b.st[0], nx = b.st[1];
        if (nloc == 0u) { xcd_barrier_complete(bar, b.x, nloc, nx); b.st[0] = nloc; b.st[1] = nx; }
        const unsigned old = xb_add(&bar[XB_XSUB(b.x)], 1u);
        const unsigned gen = old / nloc;
        if (old + 1u == (gen + 1u) * nloc) {
            __builtin_amdgcn_fence(__ATOMIC_RELEASE, "agent");
            asm volatile("s_waitcnt vmcnt(0)" ::: "memory");
#pragma unroll
            for (unsigned j = 0; j < 16; ++j) (void)xb_add(&bar[XB_DONE(j)], 1u);
        }
        b.st[2] = gen;
    }
}
__device__ __forceinline__ void xcd_barrier2_wait(const XcdBarrier& b) {
    asm volatile("s_waitcnt vmcnt(0)" ::: "memory");
    if (threadIdx.x == 0) {
        unsigned* bar = b.bar;
        const unsigned gen = b.st[2], nx = b.st[1];
        XB_SPIN(xb_ld(&bar[XB_DONE(b.x)]) < (gen + 1u) * nx, bar);
        __builtin_amdgcn_fence(__ATOMIC_ACQUIRE, "agent");
        asm volatile("s_waitcnt vmcnt(0)" ::: "memory");
    }
    __syncthreads();
}

#define FB_WORD(j) (64 * (j))
#define FB_TMO 640
__device__ __forceinline__ void flat_barrier(unsigned* fb, unsigned epoch) {
    asm volatile("s_waitcnt vmcnt(0)" ::: "memory");
    __syncthreads();
    if (threadIdx.x == 0) {
        __builtin_amdgcn_s_waitcnt(0);
        __builtin_amdgcn_fence(__ATOMIC_RELEASE, "agent");
        asm volatile("s_waitcnt vmcnt(0)" ::: "memory");
        (void)xb_add(&fb[FB_WORD(blockIdx.x & 7u)], 1u);
        const unsigned want = epoch * gridDim.x; unsigned sp = 0u;
        for (;;) {
            unsigned s = 0u;
#pragma unroll
            for (int j = 0; j < 8; ++j) s += xb_ld(&fb[FB_WORD(j)]);
            if (s >= want) break;
            __builtin_amdgcn_s_sleep(1);
            if ((++sp & 255u) == 0u) { if (xb_ld(&fb[FB_TMO])) break; if (sp > XB_SPIN_CAP) { atomicAdd(&fb[FB_TMO], 1u); break; } }
        }
        __builtin_amdgcn_fence(__ATOMIC_ACQUIRE, "agent");
        asm volatile("s_waitcnt vmcnt(0)" ::: "memory");
    }
    __syncthreads();
}

struct Frame {
    LAS unsigned char* lds;
    volatile LAS unsigned* MISC;
    unsigned* ctl;
    int pre8, pre12, pre3, pre4, pre6, pre11;
    int tid, lane, wave, G, gw, NGW, vb;
    float* out;
    unsigned char* ws;
};
enum { I_X = 0, I_C, I_CTX, I_CCTX, I_WADA, I_BADA, I_NPM, I_NQM, I_NPF, I_NQF, I_WIN, I_MU, I_W0, I_WDU, I_A0, I_WIU, I_KK, I_KA, I_RK, I_WGU, I_LNW, I_LNB, I_CONVW,
       I_WOUT, I_WR, I_BR, I_WEI, I_BEI, I_WEO, I_BEO };


typedef const float* fptr_t;
__device__ __forceinline__ fptr_t kin_ptr(int i) { const volatile __attribute__((address_space(4))) fptr_t* ka = (const volatile __attribute__((address_space(4))) fptr_t*)__builtin_amdgcn_kernarg_segment_ptr(); return ka[i]; }
#define KIN(i) kin_ptr(i)
__device__ __forceinline__ void transpose_item(const float* W, int N, int k0, int n0, bf16* WT, int ldk, int rowbase, LAS float* scr, int lane) {
#pragma unroll 8
    for (int i = 0; i < 32; ++i) { const int kk = 2 * i + (lane >> 5); scr[kk * 33 + (lane & 31)] = W[(size_t)(k0 + kk) * N + n0 + (lane & 31)]; }
    LDS_WAIT(); asm volatile("" ::: "memory");
    const int c = lane & 7;
#pragma unroll
    for (int j = 0; j < 4; ++j) { const int n = (lane >> 3) + 8 * j; const LAS float* s = scr + (8 * c) * 33 + n;
        v4u o; o.x = pk2(s[0 * 33], s[1 * 33]); o.y = pk2(s[2 * 33], s[3 * 33]); o.z = pk2(s[4 * 33], s[5 * 33]); o.w = pk2(s[6 * 33], s[7 * 33]);
        *(v4u*)(WT + (size_t)(rowbase + n) * ldk + k0 + 8 * c) = o; }
    LDS_WAIT(); asm volatile("" ::: "memory");
}

__device__ __forceinline__ unsigned pack_q4c(float a, float b, float c, float d) {
    const int qa = __float2int_rn(fminf(fmaxf(a, -127.f), 127.f)), qb = __float2int_rn(fminf(fmaxf(b, -127.f), 127.f)), qc = __float2int_rn(fminf(fmaxf(c, -127.f), 127.f)), qd = __float2int_rn(fminf(fmaxf(d, -127.f), 127.f));
    return (unsigned)(qa & 255) | ((unsigned)(qb & 255) << 8) | ((unsigned)(qc & 255) << 16) | ((unsigned)qd << 24);
}
__device__ __forceinline__ void q8_item(const float* W, int N, int n0, signed char* WT, float* cs, int rowbase, LAS float* scr, int lane, int kb0 = 0, int kb1 = 16) {
    const int r8 = lane >> 3, c4 = lane & 7;
    const float* p0 = W + (size_t)r8 * N + n0 + 4 * c4;
    f32x4 ss = {0.f, 0.f, 0.f, 0.f};
#pragma unroll
    for (int hb = 0; hb < 1; ++hb) {
        f32x4 v[16];
#pragma unroll
        for (int i = 0; i < 16; ++i) v[i] = NTL((const f32x4*)(p0 + (size_t)(8 * (16 * hb + i)) * N));
        __builtin_amdgcn_sched_barrier(0);
#pragma unroll
        for (int i = 0; i < 16; ++i) ss += v[i] * v[i];
    }
#pragma unroll
    for (int o = 8; o < 64; o <<= 1) { ss.x += __shfl_xor(ss.x, o); ss.y += __shfl_xor(ss.y, o); ss.z += __shfl_xor(ss.z, o); ss.w += __shfl_xor(ss.w, o); }
    if (lane < 8) {
#pragma unroll
        for (int q = 0; q < 4; ++q) { const float m = 6.0f * sqrtf(ss[q] * (1.0f / 128.0f)); cs[rowbase + 4 * lane + q] = m * (1.0f / 127.0f); scr[2112 + 4 * lane + q] = m > 0.f ? 127.0f / m : 0.f; } }
    LDS_WAIT(); asm volatile("" ::: "memory");
    f32x4 cur[8];
#pragma unroll
    for (int i = 0; i < 8; ++i) cur[i] = NTL((const f32x4*)(p0 + (size_t)(64 * kb0 + 8 * i) * N));
    for (int kb = kb0; kb < kb1; ++kb) {
        f32x4 nxt[8];
        const int kn = kb < kb1 - 1 ? kb + 1 : kb;
#pragma unroll
        for (int i = 0; i < 8; ++i) nxt[i] = NTL((const f32x4*)(p0 + (size_t)(64 * kn + 8 * i) * N));
#pragma unroll
        for (int i = 0; i < 8; ++i) { LAS float* s = scr + (r8 + 8 * i) * 33 + 4 * c4; s[0] = cur[i].x; s[1] = cur[i].y; s[2] = cur[i].z; s[3] = cur[i].w; }
        LDS_WAIT(); asm volatile("" ::: "memory");
        const int c = lane & 3;
#pragma unroll
        for (int j = 0; j < 2; ++j) { const int n = (lane >> 2) + 16 * j; const float iv = scr[2112 + n]; const LAS float* s = scr + (16 * c) * 33 + n;
            v4u o; o.x = pack_q4c(s[0] * iv, s[33] * iv, s[66] * iv, s[99] * iv); o.y = pack_q4c(s[132] * iv, s[165] * iv, s[198] * iv, s[231] * iv);
            o.z = pack_q4c(s[264] * iv, s[297] * iv, s[330] * iv, s[363] * iv); o.w = pack_q4c(s[396] * iv, s[429] * iv, s[462] * iv, s[495] * iv);
            *(v4u*)(WT + (size_t)(rowbase + n) * 1024 + 64 * kb + 16 * c) = o; }
        LDS_WAIT(); asm volatile("" ::: "memory");
#pragma unroll
        for (int i = 0; i < 8; ++i) cur[i] = nxt[i];
    }
}

struct CvTile { f32x4 v[8]; };
__device__ __forceinline__ void cv_load(CvTile& t, const float* W, int N, int n0, int kb, int lane) {
    const float* p0 = W + (size_t)(64 * kb + (lane >> 3)) * N + n0 + 4 * (lane & 7);
#pragma unroll
    for (int i = 0; i < 8; ++i) t.v[i] = NTL((const f32x4*)(p0 + (size_t)(8 * i) * N));
}
__device__ __forceinline__ void cv_to_lds(const CvTile& t, LAS float* scr, int lane) {
    const int r8 = lane >> 3, c4 = lane & 7;
#pragma unroll
    for (int i = 0; i < 8; ++i) { LAS float* s = scr + (r8 + 8 * i) * 33 + 4 * c4; s[0] = t.v[i].x; s[1] = t.v[i].y; s[2] = t.v[i].z; s[3] = t.v[i].w; }
    LDS_WAIT(); asm volatile("" ::: "memory");
}
__device__ __forceinline__ void cv_store_bf16(const LAS float* scr, bf16* WT, int ldk, int rowbase, int k0, int lane) {
    const int c = lane & 7;
#pragma unroll
    for (int j = 0; j < 4; ++j) { const int n = (lane >> 3) + 8 * j; const LAS float* s = scr + (8 * c) * 33 + n;
        v4u o; o.x = pk2h(s[0 * 33], s[1 * 33]); o.y = pk2h(s[2 * 33], s[3 * 33]); o.z = pk2h(s[4 * 33], s[5 * 33]); o.w = pk2h(s[6 * 33], s[7 * 33]);
        *(v4u*)(WT + (size_t)(rowbase + n) * ldk + k0 + 8 * c) = o; }
    LDS_WAIT(); asm volatile("" ::: "memory");
}
__device__ __forceinline__ unsigned q8_pack4(float a, float b, float c, float d) {
    const float M = 12582912.0f;
    const unsigned x0 = __builtin_bit_cast(unsigned, __builtin_amdgcn_fmed3f(a, -127.f, 127.f) + M), x1 = __builtin_bit_cast(unsigned, __builtin_amdgcn_fmed3f(b, -127.f, 127.f) + M);
    const unsigned x2 = __builtin_bit_cast(unsigned, __builtin_amdgcn_fmed3f(c, -127.f, 127.f) + M), x3 = __builtin_bit_cast(unsigned, __builtin_amdgcn_fmed3f(d, -127.f, 127.f) + M);
    return __builtin_amdgcn_perm(x1, x0, 0x0c0c0400u) | __builtin_amdgcn_perm(x3, x2, 0x04000c0cu);
}
__device__ __forceinline__ void cv_store_q8(const CvTile& t, LAS float* scr, signed char* WT, int rowbase, int kb, const float (&iv)[4], int lane) {
    LAS unsigned* img = (LAS unsigned*)scr;
    const int r8 = lane >> 3, c4 = lane & 7;
#pragma unroll
    for (int i = 0; i < 8; ++i) img[(r8 + 8 * i) * 9 + c4] = q8_pack4(t.v[i].x * iv[0], t.v[i].y * iv[1], t.v[i].z * iv[2], t.v[i].w * iv[3]);
    LDS_WAIT(); asm volatile("" ::: "memory");
    const int c = lane & 3;
#pragma unroll
    for (int j = 0; j < 2; ++j) { const int n = (lane >> 2) + 16 * j; const unsigned bs = (unsigned)(n & 3);
        const unsigned s01 = 0x0c0c0000u | bs | ((4u + bs) << 8), s23 = 0x00000c0cu | (bs << 16) | ((4u + bs) << 24);
        const LAS unsigned* s = img + (16 * c) * 9 + (n >> 2);
        v4u o;
        o.x = __builtin_amdgcn_perm(s[9], s[0], s01) | __builtin_amdgcn_perm(s[27], s[18], s23);
        o.y = __builtin_amdgcn_perm(s[45], s[36], s01) | __builtin_amdgcn_perm(s[63], s[54], s23);
        o.z = __builtin_amdgcn_perm(s[81], s[72], s01) | __builtin_amdgcn_perm(s[99], s[90], s23);
        o.w = __builtin_amdgcn_perm(s[117], s[108], s01) | __builtin_amdgcn_perm(s[135], s[126], s23);
        *(v4u*)(WT + (size_t)(rowbase + n) * 1024 + 64 * kb + 16 * c) = o; }
    LDS_WAIT(); asm volatile("" ::: "memory");
}
__device__ __forceinline__ void cv_scale_q8(const float* W, int N, int n0, float* cs, int rowbase, int lane, float (&iv)[4]) {
    const float* p0 = W + (size_t)(lane >> 3) * N + n0 + 4 * (lane & 7);
    f32x4 ss = {0.f, 0.f, 0.f, 0.f};
#pragma unroll
    for (int hb = 0; hb < 1; ++hb) {
        f32x4 v[16];
#pragma unroll
        for (int i = 0; i < 16; ++i) v[i] = NTL((const f32x4*)(p0 + (size_t)(8 * (16 * hb + i)) * N));
        __builtin_amdgcn_sched_barrier(0);
#pragma unroll
        for (int i = 0; i < 16; ++i) ss += v[i] * v[i];
    }
#pragma unroll
    for (int o = 8; o < 64; o <<= 1) { ss.x += __shfl_xor(ss.x, o); ss.y += __shfl_xor(ss.y, o); ss.z += __shfl_xor(ss.z, o); ss.w += __shfl_xor(ss.w, o); }
#pragma unroll
    for (int q = 0; q < 4; ++q) { const float m = 6.0f * sqrtf(ss[q] * (1.0f / 128.0f)); if (lane < 8) cs[rowbase + 4 * lane + q] = m * (1.0f / 127.0f); iv[q] = m > 0.f ? 127.0f / m : 0.f; }
}
__device__ __forceinline__ void wei_strip(int s, int& e, int& n0, int& rowbase) { e = s >> 6; n0 = 32 * (s & 63); const int c = n0 & 1023; rowbase = (c >> 7) * 256 + (n0 >= 1024 ? 128 : 0) + (c & 127); }

__device__ __forceinline__ void seam_filler(Frame& F, int s, int gwx, int tm = 3) {
    const int lane = F.lane;
    LAS float* scr = (LAS float*)(F.lds + F.wave * 16384);
    const float* wei = KIN(I_WEI); const float* weo = KIN(I_WEO);
    float* IV = (float*)(F.ws + WS_CTL) + 131072;
    for (int st = gwx; st < NE * 64; st += F.NGW) {
        int e_, n0_, rb_; wei_strip(st, e_, n0_, rb_);
        const float* W = wei + (size_t)e_ * D * 2048;
        if (2 * s >= 16 - SSQ) break;
        const int kt0 = SS_FILL_Q8 ? s : 2 * s, kt1 = SS_FILL_Q8 ? s : 2 * s + 1;
        CvTile t0, t1; if (tm & 1) cv_load(t0, W, 2048, n0_, kt0, lane); if (!SS_FILL_Q8 && (tm & 2)) cv_load(t1, W, 2048, n0_, kt1, lane);
        float civ[4];
        if (s == 0) { cv_scale_q8(W, 2048, n0_, (float*)(F.ws + MI_CSWEI) + (size_t)e_ * 2048, rb_, lane, civ);
            if (lane < 8) *(f32x4*)(IV + (size_t)st * 32 + 4 * lane) = (f32x4){civ[0], civ[1], civ[2], civ[3]}; }
        else { const f32x4 v = *(const f32x4*)(IV + (size_t)st * 32 + 4 * (lane & 7)); civ[0] = v.x; civ[1] = v.y; civ[2] = v.z; civ[3] = v.w; }
        if (tm & 1) cv_store_q8(t0, scr, (signed char*)(F.ws + WS_WEIN) + (size_t)e_ * 2048 * D, rb_, kt0, civ, lane);
        if (!SS_FILL_Q8 && (tm & 2)) cv_store_q8(t1, scr, (signed char*)(F.ws + WS_WEIN) + (size_t)e_ * 2048 * D, rb_, kt1, civ, lane);
    }
    bf16* WEO = (bf16*)(F.ws + WS_WEOUT);
    for (int id = gwx * 8 + s; !SS_FILL_WEO && id < NE * 512; id += F.NGW * 8) {
        const int e_ = id >> 9, q_ = id & 511;
        CvTile ft; cv_load(ft, weo + (size_t)e_ * D * D, D, 32 * (q_ & 31), q_ >> 5, lane);
        cv_to_lds(ft, scr, lane); cv_store_bf16(scr, WEO + (size_t)e_ * D * D, D, 32 * (q_ & 31), 64 * (q_ >> 5), lane);
    }
}

__device__ __forceinline__ void seam_fill_dispatch(Frame& F, int s, int c, int R, bool half = false) {
    if (R <= 0 || R >= F.G) { seam_filler(F, s, c * NWAVES + F.wave); return; }
    if (c < R) { if (half) seam_filler(F, s, c * NWAVES + F.wave, 1); return; }
    const int E = F.G - R;
    seam_filler(F, s, c * NWAVES + F.wave);
    for (int v = c - R; v < R; v += E) seam_filler(F, s, v * NWAVES + F.wave, half ? 2 : 3);
}

__device__ __forceinline__ void ss_filler(Frame& F) {
    const int lane = F.lane;
    LAS float* scr = (LAS float*)(F.lds + F.wave * 16384);
    const float* weo = KIN(I_WEO); bf16* WEO = (bf16*)(F.ws + WS_WEOUT);
    const float* wei = KIN(I_WEI); const float* IV = (const float*)(F.ws + WS_CTL) + 131072;
    const int w7 = (int)blockIdx.x * 7 + (F.wave - 1), n7 = F.G * 7;
    constexpr int TSS = NE * 512 - WEO_TAIL;
    const int NIT = TSS + NE * 64 * SSQ;
    CvTile cur, nxt;
    auto issue = [&](CvTile& t, int it) {
        if (it < TSS) { const int e_ = it >> 9, q_ = it & 511; cv_load(t, weo + (size_t)e_ * D * D, D, 32 * (q_ & 31), q_ >> 5, lane); }
        else { const int j = it - TSS, st = j / (SSQ > 0 ? SSQ : 1), kb = 16 - SSQ + j % (SSQ > 0 ? SSQ : 1); int e_, n0_, rb_; wei_strip(st, e_, n0_, rb_); cv_load(t, wei + (size_t)e_ * D * 2048, 2048, n0_, kb, lane); } };
    int it = w7;
    if (it < NIT) issue(cur, it);
    for (; it < NIT; it += n7) {
        const int itn = it + n7 < NIT ? it + n7 : it;
        issue(nxt, itn);
        if (it < TSS) { const int e_ = it >> 9, q_ = it & 511; cv_to_lds(cur, scr, lane); cv_store_bf16(scr, WEO + (size_t)e_ * D * D, D, 32 * (q_ & 31), 64 * (q_ >> 5), lane); }
        else { const int j = it - TSS, st = j / (SSQ > 0 ? SSQ : 1), kb = 16 - SSQ + j % (SSQ > 0 ? SSQ : 1); int e_, n0_, rb_; wei_strip(st, e_, n0_, rb_);
            const f32x4 v = *(const f32x4*)(IV + (size_t)st * 32 + 4 * (lane & 7)); const float civ[4] = {v.x, v.y, v.z, v.w};
            cv_store_q8(cur, scr, (signed char*)(F.ws + WS_WEIN) + (size_t)e_ * 2048 * D, rb_, kb, civ, lane); }
#pragma unroll
        for (int i = 0; i < 8; ++i) cur.v[i] = nxt.v[i];
    }
}

__device__ __forceinline__ void moe1_tail_fill(Frame& F, int nunits) {
    if (WEO_TAIL == 0) return;
    const int lane = F.lane;
    LAS float* scr = (LAS float*)(F.lds + F.wave * 16384);
    const float* weo = KIN(I_WEO); bf16* WEO = (bf16*)(F.ws + WS_WEOUT);
    const int R = nunits % F.G, xcd = F.vb & 7, k = F.vb >> 3;
    const bool split = (F.G & 7) == 0 && ((F.G >> 3) & 7) == 0 && R > 0 && (R & 7) == 0;
    int slot, nslot;
    if (split) { const int rpx = R >> 3; if (k < rpx) return; slot = ((k - rpx) * 8 + xcd) * NWAVES + F.wave; nslot = (F.G - R) * NWAVES; }
    else { slot = F.vb * NWAVES + F.wave; nslot = F.G * NWAVES; }
    constexpr int T0 = NE * 512 - WEO_TAIL;
    CvTile cur, nxt;
    int it = T0 + slot;
    if (it < NE * 512) { const int e_ = it >> 9, q_ = it & 511; cv_load(cur, weo + (size_t)e_ * D * D, D, 32 * (q_ & 31), q_ >> 5, lane); }
    for (; it < NE * 512; it += nslot) {
        const int itn = it + nslot < NE * 512 ? it + nslot : it;
        { const int e_ = itn >> 9, q_ = itn & 511; cv_load(nxt, weo + (size_t)e_ * D * D, D, 32 * (q_ & 31), q_ >> 5, lane); }
        { const int e_ = it >> 9, q_ = it & 511; cv_to_lds(cur, scr, lane); cv_store_bf16(scr, WEO + (size_t)e_ * D * D, D, 32 * (q_ & 31), 64 * (q_ >> 5), lane); }
#pragma unroll
        for (int i = 0; i < 8; ++i) cur.v[i] = nxt.v[i];
    }
}

template <int N>
__device__ __forceinline__ void mod_vals(const float* modp, const float* b_ada, int vec, const int (&j)[N], float (&out)[N]) {
    float p[N][KSPLIT], s[N];
#pragma unroll
    for (int n = 0; n < N; ++n) { s[n] = b_ada[j[n]];
#pragma unroll
        for (int ks = 0; ks < KSPLIT; ++ks) p[n][ks] = modp[((size_t)ks * 3 + vec) * 6144 + j[n]]; }
    __builtin_amdgcn_sched_barrier(0);
#pragma unroll
    for (int n = 0; n < N; ++n) {
#pragma unroll
        for (int ks = 0; ks < KSPLIT; ++ks) s[n] += p[n][ks];
        out[n] = s[n]; }
}
__device__ __forceinline__ float mod_val(const float* modp, const float* b_ada, int vec, int j) { const int jj[1] = {j}; float o[1]; mod_vals<1>(modp, b_ada, vec, jj, o); return o[0]; }
__device__ __forceinline__ int nbr_row(int row, int j) {
    if (row < ML) { const int t = row & (T - 1), gc = t & 63, gr = t >> 6;
        if (j == 0) return gc > 0 ? row - 1 : -1; if (j == 1) return gc < 63 ? row + 1 : -1; if (j == 2) return gr > 0 ? row - 64 : -1; return gr < 127 ? row + 64 : -1; }
    const int tc = (row - ML) & (TC - 1);
    if ((j & 1) == 0) return tc > 0 ? row - 1 : -1; return tc < TC - 1 ? row + 1 : -1;
}
__device__ __forceinline__ void load_shift16(const bf16* z, int row, int col0, const LAS float* mu, float (&out)[16]) {
    float s[16]; ld16bf(z + (size_t)row * NZ + col0, s);
    float m[16]; ld16f_lds(mu, m);
#pragma unroll
    for (int j = 0; j < 4; ++j) {
        const int nr = nbr_row(row, j); float t[16];
        if (nr >= 0) ld16bf(z + (size_t)nr * NZ + col0, t); else {
#pragma unroll
            for (int i = 0; i < 16; ++i) t[i] = 0.f; }
#pragma unroll
        for (int i = j; i < 16; i += 4) out[i] = s[i] + m[i] * (t[i] - s[i]);
    }
}

__device__ __forceinline__ void phase_prologue(Frame& F) {
    LAS float* scr = (LAS float*)(F.lds + RING_OFF + F.wave * 16384);
    LAS float* sil = (LAS float*)(F.lds + LDS_X_OFF);
    for (int i = F.tid; i < 3 * D; i += NWAVES * 64) { const int v = i / D, j = i % D; const float c = v < 2 ? KIN(I_C)[v * D + j] : KIN(I_CCTX)[j]; sil[i] = c / (1.0f + __expf(-c)); }
    __syncthreads();
    bf16* WoutT = (bf16*)(F.ws + WS_WOUT);
    constexpr int IT_WIN = (N_IN / 32) * 4, IT_WOUT = (D / 64) * (D / 32), IT_ADA = 24 * KSPLIT;
    constexpr int NITEMS = IT_ADA + IT_WIN + IT_WOUT;
    float* modp = (float*)(F.ws + WS_MODP);
    for (int it = F.gw; it < NITEMS; it += F.NGW) {
        int r = it;
        if (r < IT_ADA) {
            const int cc = r % 24, ks = r / 24, col = cc * 256 + F.lane * 4;
            f32x4 a0 = {0.f, 0.f, 0.f, 0.f}, a1 = a0, a2 = a0;
            const float* wp = KIN(I_WADA) + (size_t)(ks * 64) * 6144 + col;
#pragma unroll 1
            for (int kb = 0; kb < 64; kb += 16) {
                f32x4 w[16];
#pragma unroll
                for (int k = 0; k < 16; ++k) w[k] = NTL((const f32x4*)(wp + (size_t)(kb + k) * 6144));
                __builtin_amdgcn_sched_barrier(0);
#pragma unroll
                for (int k = 0; k < 16; ++k) { const int kk = ks * 64 + kb + k; a0 += w[k] * sil[kk]; a1 += w[k] * sil[D + kk]; a2 += w[k] * sil[2 * D + kk]; }
            }
            *(f32x4*)(modp + ((size_t)ks * 3 + 0) * 6144 + col) = a0; *(f32x4*)(modp + ((size_t)ks * 3 + 1) * 6144 + col) = a1; *(f32x4*)(modp + ((size_t)ks * 3 + 2) * 6144 + col) = a2;
            continue; }
        r -= IT_ADA;
        if (r < IT_WIN) { const int st = r >> 2, qq = r & 3; q8_item(KIN(I_WIN), N_IN, 32 * st, (signed char*)(F.ws + WS_WIN), (float*)(F.ws + MI_CSWIN), 32 * st, scr, F.lane, 4 * qq, 4 * qq + 4); continue; }
        r -= IT_WIN;
        { const int nb = D / 32, kb = r / nb, n0 = 32 * (r % nb); transpose_item(KIN(I_WOUT), D, 64 * kb, n0, WoutT, D, n0, scr, F.lane); }
    }
    const int gt = blockIdx.x * (NWAVES * 64) + F.tid, NGT = F.G * NWAVES * 64;
    for (int i = gt; i < (NZ - N_IN) * D / 16; i += NGT) *(v4u*)(F.ws + WS_WIN + (size_t)N_IN * D + (size_t)i * 16) = (v4u){0u, 0u, 0u, 0u};
    for (int i = gt; i < NZ - N_IN; i += NGT) ((float*)(F.ws + MI_CSWIN))[N_IN + i] = 0.f;
    bf16* WL = (bf16*)(F.ws + WS_WLORA);
    for (int i = gt; i < NL * (KL / 8); i += NGT) {
        const int c8 = i / NL, row = i % NL, blk = row >> 10, n = row & 1023, col = c8 * 8, g = col >> 6;
        const float* src = nullptr; int kofs = 0;
        if (blk < 2) { if (g == blk) { src = KIN(I_WDU) + (size_t)blk * 64 * D; kofs = col - 64 * blk; } }
        else if (blk < 4) { if (g == blk) { src = KIN(I_WIU) + (size_t)(blk - 2) * 64 * D; kofs = col - 64 * blk; } }
        else { if (g >= 4) { src = KIN(I_WGU); kofs = col - 256; } }
        v4u o = {0u, 0u, 0u, 0u};
        if (src) { float v[8];
#pragma unroll
            for (int q = 0; q < 8; ++q) v[q] = src[(size_t)(kofs + q) * D + n];
            o.x = pk2(v[0], v[1]); o.y = pk2(v[2], v[3]); o.z = pk2(v[4], v[5]); o.w = pk2(v[6], v[7]); }
        *(v4u*)(WL + (size_t)row * KL + col) = o;
    }
    bf16* WR = (bf16*)(F.ws + WS_WROUT);
    for (int i = gt; i < 256 * (D / 8); i += NGT) {
        const int row = i % 256, c8 = i / 256; v4u o = {0u, 0u, 0u, 0u};
        if (row < NE) { float v[8];
#pragma unroll
            for (int q = 0; q < 8; ++q) v[q] = KIN(I_WR)[(size_t)(c8 * 8 + q) * NE + row];
            o.x = pk2(v[0], v[1]); o.y = pk2(v[2], v[3]); o.z = pk2(v[4], v[5]); o.w = pk2(v[6], v[7]); }
        *(v4u*)(WR + (size_t)row * D + c8 * 8) = o;
    }
}

__device__ __forceinline__ void phase_hrows(Frame& F) {
    LAS float* LA = (LAS float*)(F.lds);
    LAS float* LB = LA + 3 * D;
    const float* modp = (const float*)(F.ws + WS_MODP);
    static_assert(D == 2 * NWAVES * 64, "two table entries per thread and vector");
#pragma unroll 1
    for (int v = 0; v < 3; ++v) {
        const int j0 = F.tid, j1 = F.tid + NWAVES * 64;
        const int jj[4] = {1024 + j0, j0, 1024 + j1, j1}; float mv[4]; mod_vals<4>(modp, KIN(I_BADA), v, jj, mv);
        LA[v * D + j0] = KIN(I_NPM)[j0] * (1.0f + mv[0]); LB[v * D + j0] = mv[1];
        LA[v * D + j1] = KIN(I_NPM)[j1] * (1.0f + mv[2]); LB[v * D + j1] = mv[3]; }
    __syncthreads();
    signed char* A0q = (signed char*)(F.ws + WS_A0);
    for (int row0 = F.gw; row0 < MT; row0 += 4 * F.NGW) {
        f32x4 v[4][4];
#pragma unroll
        for (int k = 0; k < 4; ++k) { const int row = row0 + k * F.NGW, rc = row < MT ? row : row0;
            const float* xr = rc < ML ? KIN(I_X) + (size_t)rc * D : KIN(I_CTX) + (size_t)(rc - ML) * D;
#pragma unroll
            for (int j = 0; j < 4; ++j) v[k][j] = NTL((const f32x4*)(xr + 4 * F.lane + 256 * j)); }
        __builtin_amdgcn_sched_barrier(0);
#pragma unroll
        for (int k = 0; k < 4; ++k) { const int row = row0 + k * F.NGW;
            if (row < MT) {
                const int vec = row < ML ? row >> 13 : 2;
                float s = 0.f;
#pragma unroll
                for (int j = 0; j < 4; ++j) s += (v[k][j].x * v[k][j].x + v[k][j].y * v[k][j].y) + (v[k][j].z * v[k][j].z + v[k][j].w * v[k][j].w);
                const float rstd = 1.0f / sqrtf(wave_sum(s) * (1.0f / D) + 1e-6f);
                f32x4 hq[4]; float mx = 0.f;
#pragma unroll
                for (int j = 0; j < 4; ++j) { const int c = 4 * F.lane + 256 * j; const f32x4 a = *(const LAS f32x4*)(LA + vec * D + c), b = *(const LAS f32x4*)(LB + vec * D + c);
                    hq[j] = v[k][j] * rstd * a + b; mx = fmaxf(mx, fmaxf(fmaxf(fabsf(hq[j].x), fabsf(hq[j].y)), fmaxf(fabsf(hq[j].z), fabsf(hq[j].w)))); }
                mx = wave_max(mx);
                const float iv = mx > 0.f ? 127.0f / mx : 0.f;
                if (F.lane == 0) ((float*)(F.ws + MI_RSH))[row] = mx * (1.0f / 127.0f);
                unsigned* o4 = (unsigned*)(A0q + (size_t)row * D) + F.lane;
#pragma unroll
                for (int j = 0; j < 4; ++j) o4[64 * j] = pack_q4(hq[j].x * iv, hq[j].y * iv, hq[j].z * iv, hq[j].w * iv);
            } }
    }
}

__device__ __forceinline__ void phase_lora_in(Frame& F) {
    const bf16* z = (const bf16*)(F.ws + WS_Z); bf16* AL = (bf16*)(F.ws + WS_AL);
    const int gt = blockIdx.x * (NWAVES * 64) + F.tid, NGT = F.G * NWAVES * 64;
    for (int i = gt; i < MT * (KL / 4); i += NGT) {
        const int row = i / (KL / 4), q = i % (KL / 4), j0 = 4 * q;
        const int zc = j0 < 256 ? DECAY_OFF + j0 : GLORA_OFF + (j0 - 256);
        float o[4];
        if (j0 >= 256 && row >= ML) { o[0] = o[1] = o[2] = o[3] = 0.f; }
        else {
            const uint2 sv = *(const uint2*)(z + (size_t)row * NZ + zc); const float s[4] = {bflo(sv.x), bfhi(sv.x), bflo(sv.y), bfhi(sv.y)};
#pragma unroll
            for (int j = 0; j < 4; ++j) { const int nr = nbr_row(row, j); float t = 0.f;
                if (nr >= 0) t = bf1(z[(size_t)nr * NZ + zc + j]);
                const float v = s[j] + KIN(I_MU)[zc + j] * (t - s[j]);
                o[j] = j0 < 128 ? tanhf(v) : (j0 < 256 ? v : sigmoidf_(v)); }
        }
        *(uint2*)(AL + (size_t)row * KL + j0) = make_uint2(pk2(o[0], o[1]), pk2(o[2], o[3]));
    }
}


namespace ck {
typedef short bf16x8 __attribute__((ext_vector_type(8)));
constexpr int TILE = 8192;
constexpr int NU_L = BATCH * (T / 64) * NH;
constexpr int NU_ALL = NU_L + BATCH * (TC / 64) * NH;
__device__ __forceinline__ int swz(int row) { return (row ^ (row >> 3)) & 7; }
__device__ __forceinline__ int toff(int row, int col) { return row * 128 + ((col * 2) ^ (swz(row) << 4)); }
__device__ __forceinline__ bf16x8 ldfrag(const LAS unsigned char* t, int row, int chunk) { return *(const LAS bf16x8*)(t + row * 128 + ((chunk ^ swz(row)) << 4)); }
typedef __bf16 bf16v2_t __attribute__((ext_vector_type(2)));
__device__ __forceinline__ unsigned cvtpk(float lo, float hi) { const bf16v2_t v = {(__bf16)lo, (__bf16)hi}; return __builtin_bit_cast(unsigned, v); }
#define CK_MFMA(a, b, c) __builtin_amdgcn_mfma_f32_16x16x32_bf16(a, b, c, 0, 0, 0)
template <bool MASKDIAG>
__device__ __forceinline__ void mm64(f32x4 (&acc)[4], const LAS unsigned char* Lt, const LAS unsigned char* Rt, int wq, int lane) {
    const int lr = lane & 15, g = lane >> 4;
    const bf16x8 l0 = ldfrag(Lt, 16 * wq + lr, g), l1 = ldfrag(Lt, 16 * wq + lr, 4 + g);
#pragma unroll
    for (int n = 0; n < 4; ++n) {
        bf16x8 r0 = ldfrag(Rt, 16 * n + lr, g), r1 = ldfrag(Rt, 16 * n + lr, 4 + g);
        if (MASKDIAG) { const bf16x8 zz = {0, 0, 0, 0, 0, 0, 0, 0}; if ((g >> 1) == n) r0 = zz; if (2 + (g >> 1) == n) r1 = zz; }
        acc[n] = CK_MFMA(l0, r0, acc[n]); acc[n] = CK_MFMA(l1, r1, acc[n]);
    }
}
__device__ __forceinline__ void zero4(f32x4 (&a)[4]) {
#pragma unroll
    for (int n = 0; n < 4; ++n) a[n] = (f32x4){0.f, 0.f, 0.f, 0.f};
}
__device__ __forceinline__ void storeT(LAS unsigned char* t, const f32x4 (&v)[4], int wq, int lane) {
    const int lr = lane & 15, g = lane >> 4;
#pragma unroll
    for (int n = 0; n < 4; ++n) *(LAS v2u*)(t + toff(16 * n + lr, 16 * wq + 4 * g)) = (v2u){cvtpk(v[n][0], v[n][1]), cvtpk(v[n][2], v[n][3])};
}
__device__ __forceinline__ void storeN(LAS unsigned char* t, const f32x4 (&v)[4], int wq, int lane) {
    const int lr = lane & 15, g = lane >> 4;
#pragma unroll
    for (int n = 0; n < 4; ++n)
#pragma unroll
        for (int i = 0; i < 4; ++i) *(LAS unsigned short*)(t + toff(16 * wq + 4 * g + i, 16 * n + lr)) = (unsigned short)f2bf(v[n][i]);
}
__device__ __forceinline__ void loadT(f32x4 (&v)[4], const LAS unsigned char* t, int wq, int lane) {
    const int lr = lane & 15, g = lane >> 4;
#pragma unroll
    for (int n = 0; n < 4; ++n) { const v2u w = *(const LAS v2u*)(t + toff(16 * n + lr, 16 * wq + 4 * g)); v[n] = (f32x4){bflo(w.x), bfhi(w.x), bflo(w.y), bfhi(w.y)}; }
}
__device__ __forceinline__ void unit_decode(int unit, int& b, int& h, int& rowbase) {
    if (unit < NU_L) { h = unit & 15; const int blk = (unit >> 4) & 127; b = unit >> 11; rowbase = b * T + blk * 64; }
    else { const int u = unit - NU_L; h = u & 15; const int cb = (u >> 4) & 3; b = u >> 6; rowbase = ML + b * TC + cb * 64; }
}
__device__ __forceinline__ void pack8(LAS unsigned char* t, int row, int chunk, const float (&v)[8], bool rev) {
    v4u o;
    if (!rev) { o.x = cvtpk(v[0], v[1]); o.y = cvtpk(v[2], v[3]); o.z = cvtpk(v[4], v[5]); o.w = cvtpk(v[6], v[7]); }
    else { o.x = cvtpk(v[7], v[6]); o.y = cvtpk(v[5], v[4]); o.z = cvtpk(v[3], v[2]); o.w = cvtpk(v[1], v[0]); }
    *(LAS v4u*)(t + row * 128 + ((chunk ^ swz(row)) << 4)) = o;
}

__device__ __forceinline__ void unpack8(const v4u p, float (&o)[8]) {
    o[0] = bflo(p.x); o[1] = bfhi(p.x); o[2] = bflo(p.y); o[3] = bfhi(p.y); o[4] = bflo(p.z); o[5] = bfhi(p.z); o[6] = bflo(p.w); o[7] = bfhi(p.w);
}
__device__ __forceinline__ void ld8f(const float* p, float (&o)[8]) {
    const f32x4 a = *(const f32x4*)p, b = *(const f32x4*)(p + 4); o[0] = a.x; o[1] = a.y; o[2] = a.z; o[3] = a.w; o[4] = b.x; o[5] = b.y; o[6] = b.z; o[7] = b.w;
}
__device__ __forceinline__ float fsig(float x) { return __builtin_amdgcn_rcpf(1.0f + __expf(-x)); }
template <bool IS_CO> struct EPre { v4u k[5], v[5], r[IS_CO ? 5 : 1], lo[4]; unsigned msk; };
template <bool IS_CO>
__device__ __forceinline__ void epre_load(EPre<IS_CO>& P, const bf16* z, const bf16* LO, int unit, int wave, int lane) {
    int b, h, rowbase; unit_decode(unit, b, h, rowbase);
    const int row = rowbase + 8 * wave + (lane >> 3), c0 = h * 64 + 8 * (lane & 7);
    const bf16* zr = z + (size_t)row * NZ;
    P.k[0] = *(const v4u*)(zr + K_OFF + c0); P.v[0] = *(const v4u*)(zr + V_OFF + c0); if (IS_CO) P.r[0] = *(const v4u*)(zr + R_OFF + c0);
    unsigned msk = 0u;
#pragma unroll
    for (int j = 0; j < 4; ++j) { const int nr = nbr_row(row, j); const bf16* zn = z + (size_t)(nr >= 0 ? nr : row) * NZ; msk |= (nr >= 0 ? 1u : 0u) << j;
        P.k[1 + j] = *(const v4u*)(zn + K_OFF + c0); P.v[1 + j] = *(const v4u*)(zn + V_OFF + c0);
        if (IS_CO) P.r[1 + j] = *(const v4u*)(zn + R_OFF + c0); }
    P.msk = msk;
    const bf16* lr_ = LO + (size_t)row * NL + c0;
    P.lo[0] = *(const v4u*)(lr_); P.lo[1] = *(const v4u*)(lr_ + 1024); P.lo[2] = *(const v4u*)(lr_ + 2048); P.lo[3] = *(const v4u*)(lr_ + 3072);
}
template <int PART>
__device__ __forceinline__ void epre_part(EPre<true>& P, const bf16* z, const bf16* LO, int unit, int wave, int lane) {
    int b, h, rowbase; unit_decode(unit, b, h, rowbase);
    const int row = rowbase + 8 * wave + (lane >> 3), c0 = h * 64 + 8 * (lane & 7);
    if (PART == 3) { const bf16* lr_ = LO + (size_t)row * NL + c0;
        P.lo[0] = NTL((const v4u*)(lr_)); P.lo[1] = NTL((const v4u*)(lr_ + 1024)); P.lo[2] = NTL((const v4u*)(lr_ + 2048)); P.lo[3] = NTL((const v4u*)(lr_ + 3072)); return; }
    const int off = PART == 0 ? K_OFF : (PART == 1 ? V_OFF : R_OFF);
    v4u (&dst)[5] = PART == 0 ? P.k : (PART == 1 ? P.v : P.r);
    dst[0] = *(const v4u*)(z + (size_t)row * NZ + off + c0);
    unsigned msk = 0u;
#pragma unroll
    for (int j = 0; j < 4; ++j) { const int nr = nbr_row(row, j); msk |= (nr >= 0 ? 1u : 0u) << j; dst[1 + j] = *(const v4u*)(z + (size_t)(nr >= 0 ? nr : row) * NZ + off + c0); }
    if (PART == 0) P.msk = msk;
}
__device__ __forceinline__ void shift8(const v4u (&q)[5], const float* mu, float (&out)[8], unsigned msk = 15u) {
    const v4u zz = {0u, 0u, 0u, 0u};
    const v4u s = q[0], n0 = (msk & 1u) ? q[1] : zz, n1 = (msk & 2u) ? q[2] : zz, n2 = (msk & 4u) ? q[3] : zz, n3 = (msk & 8u) ? q[4] : zz;
    float m[8]; ld8f(mu, m);
    out[0] = bflo(s.x) + m[0] * (bflo(n0.x) - bflo(s.x)); out[1] = bfhi(s.x) + m[1] * (bfhi(n1.x) - bfhi(s.x));
    out[2] = bflo(s.y) + m[2] * (bflo(n2.y) - bflo(s.y)); out[3] = bfhi(s.y) + m[3] * (bfhi(n3.y) - bfhi(s.y));
    out[4] = bflo(s.z) + m[4] * (bflo(n0.z) - bflo(s.z)); out[5] = bfhi(s.z) + m[5] * (bfhi(n1.z) - bfhi(s.z));
    out[6] = bflo(s.w) + m[6] * (bflo(n2.w) - bflo(s.w)); out[7] = bfhi(s.w) + m[7] * (bfhi(n3.w) - bfhi(s.w));
}
__device__ __forceinline__ void ld8l(const LAS float* p, float (&o)[8]) {
    const f32x4 a = *(const LAS f32x4*)p, b = *(const LAS f32x4*)(p + 4); o[0] = a.x; o[1] = a.y; o[2] = a.z; o[3] = a.w; o[4] = b.x; o[5] = b.y; o[6] = b.z; o[7] = b.w;
}
__device__ __forceinline__ void shift8m(const v4u (&q)[5], const float (&m)[8], float (&out)[8], unsigned msk) {
    const v4u zz = {0u, 0u, 0u, 0u};
    const v4u s = q[0], n0 = (msk & 1u) ? q[1] : zz, n1 = (msk & 2u) ? q[2] : zz, n2 = (msk & 4u) ? q[3] : zz, n3 = (msk & 8u) ? q[4] : zz;
    out[0] = bflo(s.x) + m[0] * (bflo(n0.x) - bflo(s.x)); out[1] = bfhi(s.x) + m[1] * (bfhi(n1.x) - bfhi(s.x));
    out[2] = bflo(s.y) + m[2] * (bflo(n2.y) - bflo(s.y)); out[3] = bfhi(s.y) + m[3] * (bfhi(n3.y) - bfhi(s.y));
    out[4] = bflo(s.z) + m[4] * (bflo(n0.z) - bflo(s.z)); out[5] = bfhi(s.z) + m[5] * (bfhi(n1.z) - bfhi(s.z));
    out[6] = bflo(s.w) + m[6] * (bflo(n2.w) - bflo(s.w)); out[7] = bfhi(s.w) + m[7] * (bfhi(n3.w) - bfhi(s.w));
}
struct EPre2 { v4u k0, v0, r0; v2u kn[4], vn[4], rn[4]; v4u lo[4]; unsigned msk; };
__device__ __forceinline__ void epre2_load(EPre2& P, const bf16* z, const bf16* LO, int unit, int wave, int lane) {
    int b, h, rowbase; unit_decode(unit, b, h, rowbase);
    const int row = rowbase + 8 * wave + (lane >> 3), c0 = h * 64 + 8 * (lane & 7);
    const bf16* zr = z + (size_t)row * NZ;
    P.k0 = *(const v4u*)(zr + K_OFF + c0); P.v0 = *(const v4u*)(zr + V_OFF + c0); P.r0 = *(const v4u*)(zr + R_OFF + c0);
    unsigned msk = 0u;
#pragma unroll
    for (int j = 0; j < 4; ++j) { const int nr = nbr_row(row, j); const unsigned* zn = (const unsigned*)(z + (size_t)(nr >= 0 ? nr : row) * NZ + c0) + (j >> 1); msk |= (nr >= 0 ? 1u : 0u) << j;
        P.kn[j].x = zn[K_OFF / 2]; P.kn[j].y = zn[K_OFF / 2 + 2]; P.vn[j].x = zn[V_OFF / 2]; P.vn[j].y = zn[V_OFF / 2 + 2]; P.rn[j].x = zn[R_OFF / 2]; P.rn[j].y = zn[R_OFF / 2 + 2]; }
    P.msk = msk;
    const bf16* lr_ = LO + (size_t)row * NL + c0;
    P.lo[0] = *(const v4u*)(lr_); P.lo[1] = *(const v4u*)(lr_ + 1024); P.lo[2] = *(const v4u*)(lr_ + 2048); P.lo[3] = *(const v4u*)(lr_ + 3072);
}
__device__ __forceinline__ void shift8n(const v4u s, const v2u (&nb)[4], const float* mu, float (&out)[8], unsigned msk) {
    float m[8]; ld8f(mu, m);
    const float n0a = (msk & 1u) ? bflo(nb[0].x) : 0.f, n0b = (msk & 1u) ? bflo(nb[0].y) : 0.f, n1a = (msk & 2u) ? bfhi(nb[1].x) : 0.f, n1b = (msk & 2u) ? bfhi(nb[1].y) : 0.f;
    const float n2a = (msk & 4u) ? bflo(nb[2].x) : 0.f, n2b = (msk & 4u) ? bflo(nb[2].y) : 0.f, n3a = (msk & 8u) ? bfhi(nb[3].x) : 0.f, n3b = (msk & 8u) ? bfhi(nb[3].y) : 0.f;
    out[0] = bflo(s.x) + m[0] * (n0a - bflo(s.x)); out[1] = bfhi(s.x) + m[1] * (n1a - bfhi(s.x));
    out[2] = bflo(s.y) + m[2] * (n2a - bflo(s.y)); out[3] = bfhi(s.y) + m[3] * (n3a - bfhi(s.y));
    out[4] = bflo(s.z) + m[4] * (n0b - bflo(s.z)); out[5] = bfhi(s.z) + m[5] * (n1b - bfhi(s.z));
    out[6] = bflo(s.w) + m[6] * (n2b - bflo(s.w)); out[7] = bfhi(s.w) + m[7] * (n3b - bfhi(s.w));
}
__device__ __forceinline__ void putN(LAS unsigned char* t, int tau, int oct, const float (&v)[8]) {
    v4u o; o.x = cvtpk(v[0], v[1]); o.y = cvtpk(v[2], v[3]); o.z = cvtpk(v[4], v[5]); o.w = cvtpk(v[6], v[7]);
    *(LAS v4u*)(t + tau * 128 + ((oct ^ swz(tau)) << 4)) = o;
}
__device__ __forceinline__ void putT(LAS unsigned char* t, int tau, int ch0, const float (&v)[8]) {
#pragma unroll
    for (int i = 0; i < 8; ++i) *(LAS unsigned short*)(t + toff(ch0 + i, tau)) = (unsigned short)f2bf(v[i]);
}

template <bool IS_CO, bool STAGES = true>
__device__ __forceinline__ void phase_chunk(Frame& F) {
    const int wave = F.wave;
    const int dgrp = wave >> 2, wq = wave & 3;
    LAS unsigned char* tl = F.lds + dgrp * 9 * TILE;
#define SL(k) (tl + (k) * TILE)
    LAS float* SEG = (LAS float*)(F.lds + LDS_X_OFF);
    LAS float* GAM = SEG + 1024;
    LAS unsigned char* DIB = (LAS unsigned char*)(GAM + 128) + dgrp * 2048;
    LAS float* LW0 = (LAS float*)(F.lds + 7 * TILE);
    LAS float* LW1 = (LAS float*)(F.lds + 16 * TILE);
    const bf16* z = (const bf16*)(F.ws + WS_Z); const bf16* LO = (const bf16*)(F.ws + WS_LORA);
    unsigned char* PQ = F.ws + WS_PQ; unsigned char* TKN = F.ws + WS_TKN; unsigned char* UPRE = F.ws + WS_UPRE; unsigned char* H0T = F.ws + WS_H0T;
    bf16* MG = (bf16*)(F.ws + WS_A0);
    const float* p_mu = KIN(I_MU); const float* p_kk = KIN(I_KK); const float* p_ka = KIN(I_KA);
    const int NU = IS_CO ? NU_L : NU_ALL;
    EPre<IS_CO> PF;
    CvTile cvt; float civ[4] = {0.f, 0.f, 0.f, 0.f}; int cv_t = 0;
    const float* cv_w = KIN(I_WEI);
    LAS float* cv_scr = (LAS float*)(F.lds + wave * 16384);
    if ((int)blockIdx.x < NU) epre_load<IS_CO>(PF, z, LO, (int)blockIdx.x, wave, F.lane);
    for (int unit = blockIdx.x; unit < NU; unit += F.G) {
        int lane = F.lane; asm volatile("" : "+v"(lane));
        const int lr = lane & 15, g = lane >> 4;
        int b, h, rowbase; unit_decode(unit, b, h, rowbase);
        const int tok = 8 * wave + (lane >> 3), oct = lane & 7, ch0 = 8 * oct, c0 = h * 64 + ch0, row = rowbase + tok;
        float ks[8], vs[8], rs[8], kkp[8], lw0[8], lw1[8], kd0[8], kd1[8], a_0[8], a_1[8], ssq;
        {
            shift8(PF.k, p_mu + K_OFF + c0, ks, PF.msk);
            shift8(PF.v, p_mu + V_OFF + c0, vs, PF.msk);
            if (IS_CO) { v4u rr[5];
#pragma unroll
                for (int j = 0; j < 5; ++j) rr[j] = PF.r[IS_CO ? j : 0];
                shift8(rr, p_mu + R_OFF + c0, rs, PF.msk); }
            else {
#pragma unroll
                for (int i = 0; i < 8; ++i) rs[i] = 0.f; }
            float xw0[8], xw1[8], xa0[8], xa1[8];
            unpack8(PF.lo[0], xw0); unpack8(PF.lo[1], xw1); unpack8(PF.lo[2], xa0); unpack8(PF.lo[3], xa1);
            float kkk[8], kaa[8];
            ld8f(p_kk + c0, kkk); ld8f(p_ka + c0, kaa);
            float ss = 0.f;
#pragma unroll
            for (int i = 0; i < 8; ++i) {
                kkp[i] = ks[i] * kkk[i]; ss += kkp[i] * kkp[i];
                lw0[i] = xw0[i]; lw1[i] = xw1[i];
                a_0[i] = xa0[i]; a_1[i] = xa1[i];
                kd0[i] = ks[i] * (1.0f + (a_0[i] - 1.0f) * kaa[i]); kd1[i] = ks[i] * (1.0f + (a_1[i] - 1.0f) * kaa[i]);
                const int ch = ch0 + i, sw = tok ^ (4 * ((ch & 15) ^ (2 * (ch >> 4))));
                LW0[ch * 64 + sw] = lw0[i]; LW1[ch * 64 + sw] = lw1[i];
            }
            ss += __shfl_xor(ss, 1); ss += __shfl_xor(ss, 2); ss += __shfl_xor(ss, 4);
            ssq = ss;
        }
        __syncthreads();
        {
            const int ch2 = lane, seg = wave, sw = 4 * ((ch2 & 15) ^ (2 * (ch2 >> 4)));
            LAS f32x4* p0a = (LAS f32x4*)(LW0 + ch2 * 64 + ((8 * seg) ^ sw)); LAS f32x4* p0b = (LAS f32x4*)(LW0 + ch2 * 64 + ((8 * seg + 4) ^ sw));
            LAS f32x4* p1a = (LAS f32x4*)(LW1 + ch2 * 64 + ((8 * seg) ^ sw)); LAS f32x4* p1b = (LAS f32x4*)(LW1 + ch2 * 64 + ((8 * seg + 4) ^ sw));
            f32x4 a = *p0a, bq = *p0b, c = *p1a, d = *p1b;
            a.y += a.x; a.z += a.y; a.w += a.z; bq.x += a.w; bq.y += bq.x; bq.z += bq.y; bq.w += bq.z;
            d.z += d.w; d.y += d.z; d.x += d.y; c.w += d.x; c.z += c.w; c.y += c.z; c.x += c.y;
            SEG[seg * 64 + ch2] = bq.w; SEG[(8 + seg) * 64 + ch2] = c.x;
            __syncthreads();
            float off0 = 0.f, off1 = 0.f;
#pragma unroll
            for (int s2 = 0; s2 < 8; ++s2) { const float t0 = SEG[s2 * 64 + ch2], t1 = SEG[(8 + s2) * 64 + ch2]; off0 += (s2 < seg) ? t0 : 0.f; off1 += (s2 > seg) ? t1 : 0.f; }
            *p0a = a + off0; *p0b = bq + off0; *p1a = c + off1; *p1b = d + off1;
        }
        __syncthreads();
        {
            const float inv = 1.0f / fmaxf(sqrtf(ssq), 1e-12f);
            float t8[8], u8[8], w8[8];
            {
                LAS unsigned char* t0 = F.lds; const int tau = tok;
                float e1[8], ei[8];
#pragma unroll
                for (int i = 0; i < 8; ++i) { const int ch = ch0 + i; const float cm = LW0[ch * 64 + (tok ^ (4 * ((ch & 15) ^ (2 * (ch >> 4)))))]; e1[i] = __expf(cm); ei[i] = __builtin_amdgcn_rcpf(e1[i]); t8[i] = kkp[i] * inv * __expf(cm - lw0[i]); }
                if (tok == 63) {
#pragma unroll
                    for (int i = 0; i < 8; ++i) GAM[ch0 + i] = e1[i]; }
#pragma unroll
                for (int i = 0; i < 8; ++i) { u8[i] = kkp[i] * inv * a_0[i] * ei[i]; w8[i] = kd0[i] * ei[i]; }
                if (!IS_CO) { putN(t0 + 0 * TILE, tau, oct, t8); putT(t0 + 1 * TILE, tau, ch0, t8); putN(t0 + 2 * TILE, tau, oct, u8); putT(t0 + 3 * TILE, tau, ch0, u8);
                    putN(t0 + 4 * TILE, tau, oct, w8); putT(t0 + 5 * TILE, tau, ch0, w8); putT(t0 + 6 * TILE, tau, ch0, vs); }
                else {
#pragma unroll
                    for (int i = 0; i < 8; ++i) t8[i] = rs[i] * e1[i];
                    putN(t0 + 0 * TILE, tau, oct, w8); putN(t0 + 1 * TILE, tau, oct, u8); putN(t0 + 2 * TILE, tau, oct, t8); putT(t0 + 3 * TILE, tau, ch0, vs); }
            }
            {
                LAS unsigned char* t1 = F.lds + 9 * TILE; const int tau = 63 - tok;
                float e1[8], ei[8];
#pragma unroll
                for (int i = 0; i < 8; ++i) { const int ch = ch0 + i; const float cm = LW1[ch * 64 + (tok ^ (4 * ((ch & 15) ^ (2 * (ch >> 4)))))]; e1[i] = __expf(cm); ei[i] = __builtin_amdgcn_rcpf(e1[i]); t8[i] = kkp[i] * inv * __expf(cm - lw1[i]); }
                if (tok == 0) {
#pragma unroll
                    for (int i = 0; i < 8; ++i) GAM[64 + ch0 + i] = e1[i]; }
#pragma unroll
                for (int i = 0; i < 8; ++i) { u8[i] = kkp[i] * inv * a_1[i] * ei[i]; w8[i] = kd1[i] * ei[i]; }
                if (!IS_CO) { putN(t1 + 0 * TILE, tau, oct, t8); putT(t1 + 1 * TILE, tau, ch0, t8); putN(t1 + 2 * TILE, tau, oct, u8); putT(t1 + 3 * TILE, tau, ch0, u8);
                    putN(t1 + 4 * TILE, tau, oct, w8); putT(t1 + 5 * TILE, tau, ch0, w8); putT(t1 + 6 * TILE, tau, ch0, vs); }
                else {
#pragma unroll
                    for (int i = 0; i < 8; ++i) t8[i] = rs[i] * e1[i];
                    putN(t1 + 0 * TILE, tau, oct, w8); putN(t1 + 1 * TILE, tau, oct, u8); putN(t1 + 2 * TILE, tau, oct, t8); putT(t1 + 3 * TILE, tau, ch0, vs); }
            }
        }
        if (!STAGES) { __syncthreads(); continue; }
        const size_t inst = (size_t)unit * 2 + dgrp;
        const int t2 = (wq << 6) | lane;
        if (IS_CO) {
#pragma unroll
            for (int rep = 0; rep < 2; ++rep) { const int cidx = t2 + 256 * rep, row = cidx >> 3, ch = cidx & 7;
                const v4u a = *(const v4u*)(TKN + inst * 8192 + (size_t)(row * 64 + ch * 8) * 2), hh = *(const v4u*)(H0T + inst * 8192 + (size_t)(row * 64 + ch * 8) * 2);
                *(LAS v4u*)(SL(4) + row * 128 + ((ch ^ swz(row)) << 4)) = a; *(LAS v4u*)(SL(5) + row * 128 + ((ch ^ swz(row)) << 4)) = hh; }
        }
        v4u upre0 = {0u, 0u, 0u, 0u}, upre1 = upre0;
        if (IS_CO) { const unsigned char* up = UPRE + inst * 8192 + (size_t)((wq * 64 + lane) * 32); upre0 = *(const v4u*)up; upre1 = *(const v4u*)(up + 16); }
        if (unit + F.G < NU) epre_load<IS_CO>(PF, z, LO, unit + F.G, wave, lane);
        const int cv_strip = F.gw + (cv_t >> 4) * F.NGW, cv_kb = cv_t & 15;
        if (!IS_CO && cv_strip < NE * 64) { int e_, n0_, rb_; wei_strip(cv_strip, e_, n0_, rb_); cv_load(cvt, cv_w + (size_t)e_ * D * 2048, 2048, n0_, cv_kb, lane); }
        __syncthreads();
        f32x4 acc[4], acc2[4];
        if (!IS_CO) {
            zero4(acc); mm64<false>(acc, SL(2), SL(0), wq, lane);
            zero4(acc2); mm64<false>(acc2, SL(4), SL(0), wq, lane);
#pragma unroll
            for (int n = 0; n < 4; ++n)
#pragma unroll
                for (int q = 0; q < 4; ++q) { const bool lo = (16 * wq + 4 * g + q < 16 * n + lr); acc[n][q] = lo ? acc[n][q] : 0.f; acc2[n][q] = lo ? acc2[n][q] : 0.f; }
            storeT(SL(7), acc, wq, lane); storeT(SL(8), acc2, wq, lane);
            __syncthreads();
            zero4(acc); mm64<false>(acc, SL(8), SL(6), wq, lane); storeT(SL(0), acc, wq, lane);
            if (wq == 0) {
                const int bb = lane >> 4, jj = lane & 15;
                float X[16];
                X[0] = (jj == 0) ? 1.f : 0.f;
#pragma unroll
                for (int t = 1; t < 16; ++t) {
                    const int row = 16 * bb + t;
                    const v4u p0 = *(const LAS v4u*)(SL(7) + row * 128 + (((2 * bb) ^ swz(row)) << 4)), p1 = *(const LAS v4u*)(SL(7) + row * 128 + (((2 * bb + 1) ^ swz(row)) << 4));
                    float rw[16];
                    rw[0] = bflo(p0.x); rw[1] = bfhi(p0.x); rw[2] = bflo(p0.y); rw[3] = bfhi(p0.y); rw[4] = bflo(p0.z); rw[5] = bfhi(p0.z); rw[6] = bflo(p0.w); rw[7] = bfhi(p0.w);
                    rw[8] = bflo(p1.x); rw[9] = bfhi(p1.x); rw[10] = bflo(p1.y); rw[11] = bfhi(p1.y); rw[12] = bflo(p1.z); rw[13] = bfhi(p1.z); rw[14] = bflo(p1.w); rw[15] = bfhi(p1.w);
                    float xv = (t == jj) ? 1.f : 0.f;
#pragma unroll
                    for (int s = 0; s < t; ++s) xv -= rw[s] * X[s];
                    X[t] = xv;
                }
#pragma unroll
                for (int t = 0; t < 16; ++t) *(LAS unsigned short*)(DIB + (((bb * 16 + t) * 16 + jj) << 1)) = (unsigned short)f2bf(X[t]);
            }
            __syncthreads();
            {
                const bool isU = wq >= 2; const int cbase = 32 * (wq & 1);
                const LAS unsigned char* Rt = isU ? SL(0) : SL(1);
                LAS unsigned char* outT = isU ? SL(4) : SL(2);
#pragma unroll
                for (int ct = 0; ct < 2; ++ct) {
                    const int col = cbase + 16 * ct + lr;
                    f32x4 X[4];
#pragma unroll
                    for (int b = 0; b < 4; ++b) {
                        const v2u rwv = *(const LAS v2u*)(Rt + toff(col, 16 * b + 4 * g));
                        f32x4 Zt = {bflo(rwv.x), bfhi(rwv.x), bflo(rwv.y), bfhi(rwv.y)};
                        if (b >= 1) {
                            f32x4 Y = {0.f, 0.f, 0.f, 0.f};
#pragma unroll
                            for (int s = 0; s < (b + 1) / 2; ++s) {
                                v2u alo = {0u, 0u}, ahi = {0u, 0u};
                                if (2 * s < b) alo = *(const LAS v2u*)(SL(7) + toff(16 * b + lr, 32 * s + 4 * g));
                                if (2 * s + 1 < b) ahi = *(const LAS v2u*)(SL(7) + toff(16 * b + lr, 32 * s + 16 + 4 * g));
                                v4u bw = {cvtpk(X[2 * s][0], X[2 * s][1]), cvtpk(X[2 * s][2], X[2 * s][3]), 0u, 0u};
                                if (2 * s + 1 < b) { bw.z = cvtpk(X[2 * s + 1][0], X[2 * s + 1][1]); bw.w = cvtpk(X[2 * s + 1][2], X[2 * s + 1][3]); }
                                Y = CK_MFMA(__builtin_bit_cast(bf16x8, ((v4u){alo.x, alo.y, ahi.x, ahi.y})), __builtin_bit_cast(bf16x8, bw), Y);
                            }
                            Zt = Zt - Y;
                        }
                        const v2u dv = *(const LAS v2u*)(DIB + (((b * 16 + lr) * 16 + 4 * g) << 1));
                        const v4u bz = {cvtpk(Zt[0], Zt[1]), cvtpk(Zt[2], Zt[3]), 0u, 0u};
                        X[b] = CK_MFMA(__builtin_bit_cast(bf16x8, ((v4u){dv.x, dv.y, 0u, 0u})), __builtin_bit_cast(bf16x8, bz), ((f32x4){0.f, 0.f, 0.f, 0.f}));
                    }
#pragma unroll
                    for (int b = 0; b < 4; ++b) {
                        const v2u pk = {cvtpk(X[b][0], X[b][1]), cvtpk(X[b][2], X[b][3])};
                        *(LAS v2u*)(outT + toff(col, 16 * b + 4 * g)) = pk;
                        if (!isU) {
#pragma unroll
                            for (int q = 0; q < 4; ++q) *(LAS unsigned short*)(SL(8) + toff(16 * b + 4 * g + q, col)) = (unsigned short)f2bf(X[b][q]);
                        } else {
                            *(uint2*)(UPRE + inst * 8192 + (size_t)(((b * 64 + lane) * 4 + 2 * (wq & 1) + ct) * 8)) = make_uint2(pk.x, pk.y);
                        }
                    }
                }
            }
            __syncthreads();
            { zero4(acc); mm64<false>(acc, SL(2), SL(3), wq, lane);
              const int cstep_ = unit < NU_L ? 4 + (dgrp ? 127 - ((unit >> 4) & 127) : ((unit >> 4) & 127)) : (dgrp ? 3 - (((unit - NU_L) >> 4) & 3) : (((unit - NU_L) >> 4) & 3));
              unsigned char* pb = PQ + (size_t)(((b * 16 + h) * 2 + dgrp) * (4 + T / 64) + cstep_) * 16384;
#pragma unroll
              for (int n = 0; n < 4; ++n) { const int k = 16 * n + lr; const float gm = GAM[dgrp * 64 + k]; float p[4];
#pragma unroll
                  for (int q = 0; q < 4; ++q) p[q] = gm * (((16 * wq + 4 * g + q) == k ? 1.f : 0.f) - acc[n][q]);
                  *(uint2*)(pb + (size_t)(((n * 2 + (wq >> 1)) * 64 + lane) * 16 + (wq & 1) * 8)) = make_uint2(cvtpk(p[0], p[1]), cvtpk(p[2], p[3])); }
              zero4(acc); mm64<false>(acc, SL(5), SL(6), wq, lane); zero4(acc2); mm64<false>(acc2, SL(3), SL(4), wq, lane);
              const f32x4 gm4 = *(const LAS f32x4*)(GAM + dgrp * 64 + 16 * wq + 4 * g);
#pragma unroll
              for (int n = 0; n < 4; ++n) { const f32x4 qv = (acc[n] - acc2[n]) * gm4;
                  *(uint2*)(pb + 8192 + (size_t)(((n * 64 + lane) * 4 + wq) * 8)) = make_uint2(cvtpk(qv[0], qv[1]), cvtpk(qv[2], qv[3])); }
#pragma unroll
              for (int rep = 0; rep < 2; ++rep) { const int cidx = t2 + 256 * rep, row = cidx >> 3, ch = cidx & 7;
                  *(v4u*)(TKN + inst * 8192 + (size_t)(row * 64 + ch * 8) * 2) = *(const LAS v4u*)(SL(8) + row * 128 + ((ch ^ swz(row)) << 4)); }
            }
        } else {
            zero4(acc); mm64<false>(acc, SL(0), SL(2), wq, lane);
#pragma unroll
            for (int n = 0; n < 4; ++n)
#pragma unroll
                for (int q = 0; q < 4; ++q) acc[n][q] = (16 * wq + 4 * g + q <= 16 * n + lr) ? acc[n][q] : 0.f;
            storeT(SL(6), acc, wq, lane);
            zero4(acc); mm64<false>(acc, SL(1), SL(2), wq, lane);
#pragma unroll
            for (int n = 0; n < 4; ++n)
#pragma unroll
                for (int q = 0; q < 4; ++q) acc[n][q] = (16 * wq + 4 * g + q <= 16 * n + lr) ? -acc[n][q] : 0.f;
            storeT(SL(7), acc, wq, lane);
            { const v4u o0 = upre0, o1 = upre1;
              acc[0] = (f32x4){bflo(o0.x), bfhi(o0.x), bflo(o0.y), bfhi(o0.y)}; acc[1] = (f32x4){bflo(o0.z), bfhi(o0.z), bflo(o0.w), bfhi(o0.w)};
              acc[2] = (f32x4){bflo(o1.x), bfhi(o1.x), bflo(o1.y), bfhi(o1.y)}; acc[3] = (f32x4){bflo(o1.z), bfhi(o1.z), bflo(o1.w), bfhi(o1.w)}; }
            mm64<false>(acc, SL(4), SL(5), wq, lane);
            storeT(SL(8), acc, wq, lane);
            __syncthreads();
            zero4(acc); mm64<false>(acc, SL(2), SL(5), wq, lane); mm64<false>(acc, SL(6), SL(3), wq, lane); mm64<false>(acc, SL(7), SL(8), wq, lane);
            __syncthreads();
            { LAS float* Yf = (LAS float*)(tl);
#pragma unroll
              for (int n = 0; n < 4; ++n)
#pragma unroll
                  for (int q = 0; q < 4; ++q) { const int tau = 16 * wq + 4 * g + q; Yf[tau * 64 + ((16 * n + lr) ^ (4 * (tau & 15)))] = acc[n][q]; } }
            __syncthreads();
            { const LAS float* Y0 = (const LAS float*)(F.lds); const LAS float* Y1 = (const LAS float*)(F.lds + 9 * TILE);
              const int t = row & (T - 1);
              const bf16* zr = z + (size_t)row * NZ;
              const v4u zz = {0u, 0u, 0u, 0u};
              const v4u q_g = *(const v4u*)(LO + (size_t)row * NL + 4096 + c0);
              const v4u q_gb = *(const v4u*)(zr + CONV_OFF + c0), q_c0 = *(const v4u*)(zr + CONV_OFF + 1024 + c0), q_x0 = *(const v4u*)(zr + CONV_OFF + 2048 + c0);
              const v4u q_cm = t > 0 ? *(const v4u*)(zr - NZ + CONV_OFF + 1024 + c0) : zz, q_xm = t > 0 ? *(const v4u*)(zr - NZ + CONV_OFF + 2048 + c0) : zz;
              const v4u q_cp = t < T - 1 ? *(const v4u*)(zr + NZ + CONV_OFF + 1024 + c0) : zz, q_xp = t < T - 1 ? *(const v4u*)(zr + NZ + CONV_OFF + 2048 + c0) : zz;
              const v4u q_ga = *(const v4u*)(zr + GATE_OFF + c0), q_gr = *(const v4u*)(zr + GATE_OFF + 1024 + c0);
              float y[8];
              { const int s0 = 4 * (tok & 15), s1 = 4 * ((63 - tok) & 15);
                const f32x4 a0 = *(const LAS f32x4*)(Y0 + tok * 64 + (ch0 ^ s0)), a1 = *(const LAS f32x4*)(Y0 + tok * 64 + ((ch0 + 4) ^ s0));
                const f32x4 b0 = *(const LAS f32x4*)(Y1 + (63 - tok) * 64 + (ch0 ^ s1)), b1 = *(const LAS f32x4*)(Y1 + (63 - tok) * 64 + ((ch0 + 4) ^ s1));
                y[0] = a0.x + b0.x; y[1] = a0.y + b0.y; y[2] = a0.z + b0.z; y[3] = a0.w + b0.w; y[4] = a1.x + b1.x; y[5] = a1.y + b1.y; y[6] = a1.z + b1.z; y[7] = a1.w + b1.w; }
              float rk[8]; ld8f(KIN(I_RK) + c0, rk);
              float s1 = 0.f, s2 = 0.f, s3 = 0.f;
#pragma unroll
              for (int i = 0; i < 8; ++i) { s1 += y[i]; s2 += y[i] * y[i]; s3 += rs[i] * 0.5f * (kd0[i] + kd1[i]) * rk[i]; }
              s1 += __shfl_xor(s1, 1); s2 += __shfl_xor(s2, 1); s3 += __shfl_xor(s3, 1); s1 += __shfl_xor(s1, 2); s2 += __shfl_xor(s2, 2); s3 += __shfl_xor(s3, 2);
              s1 += __shfl_xor(s1, 4); s2 += __shfl_xor(s2, 4); s3 += __shfl_xor(s3, 4);
              const float S1 = s1, S2 = s2, S3 = s3;
              const float mean = S1 * (1.0f / 64.0f), var = fmaxf(S2 * (1.0f / 64.0f) - mean * mean, 0.f), rstd = __builtin_amdgcn_rsqf(var + 64e-5f);
              float lnw[8], lnb[8], cw0[8], cw1[8], cw2[8];
              ld8f(KIN(I_LNW) + c0, lnw); ld8f(KIN(I_LNB) + c0, lnb); ld8f(KIN(I_CONVW) + c0, cw0); ld8f(KIN(I_CONVW) + D + c0, cw1); ld8f(KIN(I_CONVW) + 2 * D + c0, cw2);
              float gg[8], gb[8], cc[8], xx[8], cm[8], xm[8], cp[8], xp[8], ga[8], gr[8];
              unpack8(q_g, gg); unpack8(q_gb, gb); unpack8(q_c0, cc); unpack8(q_x0, xx); unpack8(q_cm, cm); unpack8(q_xm, xm); unpack8(q_cp, cp); unpack8(q_xp, xp); unpack8(q_ga, ga); unpack8(q_gr, gr);
              float o[8];
#pragma unroll
              for (int i = 0; i < 8; ++i) {
                  const float yn = (y[i] - mean) * rstd * lnw[i] + lnb[i];
                  const float yr = (yn + S3 * vs[i]) * gg[i];
                  const float yc = gb[i] * (cw0[i] * (cm[i] * xm[i]) + cw1[i] * (cc[i] * xx[i]) + cw2[i] * (cp[i] * xp[i]));
                  o[i] = fsig(ga[i]) * yr + fsig(gr[i]) * yc;
              }
              v4u ov; ov.x = cvtpk(o[0], o[1]); ov.y = cvtpk(o[2], o[3]); ov.z = cvtpk(o[4], o[5]); ov.w = cvtpk(o[6], o[7]);
              *(v4u*)(MG + (size_t)row * D + c0) = ov;
            }
        }
        __syncthreads();
        if (!IS_CO) {
            if (cv_strip < NE * 64) { int e_, n0_, rb_; wei_strip(cv_strip, e_, n0_, rb_);
                if (cv_kb == 0) cv_scale_q8(cv_w + (size_t)e_ * D * 2048, 2048, n0_, (float*)(F.ws + MI_CSWEI) + (size_t)e_ * 2048, rb_, lane, civ);
                cv_store_q8(cvt, cv_scr, (signed char*)(F.ws + WS_WEIN) + (size_t)e_ * 2048 * D, rb_, cv_kb, civ, lane); }
            ++cv_t;
            __syncthreads();
        }
    }
    if (!IS_CO) {
        for (;;) { const int s_ = F.gw + (cv_t >> 4) * F.NGW, kb_ = cv_t & 15; if (s_ >= NE * 64) break;
            int e_, n0_, rb_; wei_strip(s_, e_, n0_, rb_);
            if (kb_ == 0) cv_scale_q8(cv_w + (size_t)e_ * D * 2048, 2048, n0_, (float*)(F.ws + MI_CSWEI) + (size_t)e_ * 2048, rb_, F.lane, civ);
            cv_load(cvt, cv_w + (size_t)e_ * D * 2048, 2048, n0_, kb_, F.lane);
            cv_store_q8(cvt, cv_scr, (signed char*)(F.ws + WS_WEIN) + (size_t)e_ * 2048 * D, rb_, kb_, civ, F.lane); ++cv_t; }
    }
#undef SL
}

typedef short s16x4 __attribute__((ext_vector_type(4)));
__device__ __forceinline__ bf16x8 ldfragT(const LAS unsigned char* t, int c, int ks, int lane) {
    const int g = lane >> 4, q = (lane & 15) >> 2, p = lane & 3;
    const int r0 = 32 * ks + 8 * g + q, r1 = r0 + 4;
    const s16x4 a = __builtin_amdgcn_ds_read_tr16_b64_v4i16((LAS s16x4*)(t + r0 * 128 + (((2 * c + (p >> 1)) ^ swz(r0)) << 4) + 8 * (p & 1)));
    const s16x4 b = __builtin_amdgcn_ds_read_tr16_b64_v4i16((LAS s16x4*)(t + r1 * 128 + (((2 * c + (p >> 1)) ^ swz(r1)) << 4) + 8 * (p & 1)));
    return (bf16x8){a[0], a[1], a[2], a[3], b[0], b[1], b[2], b[3]};
}
__device__ __forceinline__ f32x4 loadN_acc(const LAS unsigned char* t, int b, int ct, int lane) {
    const int g = lane >> 4, q = (lane & 15) >> 2, p = lane & 3;
    const int r0 = 16 * b + 4 * g + q;
    const s16x4 a = __builtin_amdgcn_ds_read_tr16_b64_v4i16((LAS s16x4*)(t + r0 * 128 + (((2 * ct + (p >> 1)) ^ swz(r0)) << 4) + 8 * (p & 1)));
    return (f32x4){bf1((bf16)a[0]), bf1((bf16)a[1]), bf1((bf16)a[2]), bf1((bf16)a[3])};
}
template <bool LT, bool RT>
__device__ __forceinline__ void mm64x(f32x4 (&acc)[4], const LAS unsigned char* Lt, const LAS unsigned char* Rt, int wq, int lane) {
    const int lr = lane & 15, g = lane >> 4;
    const bf16x8 l0 = LT ? ldfragT(Lt, wq, 0, lane) : ldfrag(Lt, 16 * wq + lr, g), l1 = LT ? ldfragT(Lt, wq, 1, lane) : ldfrag(Lt, 16 * wq + lr, 4 + g);
#pragma unroll
    for (int n = 0; n < 4; ++n) {
        const bf16x8 r0 = RT ? ldfragT(Rt, n, 0, lane) : ldfrag(Rt, 16 * n + lr, g), r1 = RT ? ldfragT(Rt, n, 1, lane) : ldfrag(Rt, 16 * n + lr, 4 + g);
        acc[n] = CK_MFMA(l0, r0, acc[n]); acc[n] = CK_MFMA(l1, r1, acc[n]);
    }
}

__device__ __forceinline__ void cp2_param_table(Frame& F, int h) {
    LAS float* PRM = (LAS float*)(F.lds + LDS_X_OFF + 8704);
    const float* p_mu = KIN(I_MU); const float* p_kk = KIN(I_KK); const float* p_ka = KIN(I_KA); const float* p_rk = KIN(I_RK);
    if (F.tid < 96) { const int arr = F.tid >> 4, off = (F.tid & 15) * 4;
        const float* src = arr == 0 ? p_mu + K_OFF : arr == 1 ? p_mu + V_OFF : arr == 2 ? p_mu + R_OFF : arr == 3 ? p_kk : arr == 4 ? p_ka : p_rk;
        *(LAS f32x4*)(PRM + arr * 64 + off) = *(const f32x4*)(src + h * 64 + off); }
}
__device__ __forceinline__ void phase_cp2(Frame& F) {
    const int wave = F.wave;
    const int dgrp = wave >> 2, wq = wave & 3;
    LAS unsigned char* tl = F.lds + dgrp * 9 * TILE;
#define SL(k) (tl + (k) * TILE)
    LAS float* SEG = (LAS float*)(F.lds + LDS_X_OFF);
    LAS float* GAM = SEG + 1024;
    LAS unsigned char* DIB = (LAS unsigned char*)(GAM + 128) + dgrp * 2048;
    LAS float* LW0 = (LAS float*)(F.lds + 7 * TILE);
    LAS float* LW1 = (LAS float*)(F.lds + 16 * TILE);
    const bf16* z = (const bf16*)(F.ws + WS_Z); const bf16* LO = (const bf16*)(F.ws + WS_LORA);
    unsigned char* PQ = F.ws + WS_PQ; unsigned char* RHAT = F.ws + WS_TKN; unsigned char* YLOC = F.ws + WS_UPRE;
    float* BON = (float*)(F.ws + MI_BON);
    const float* p_mu = KIN(I_MU); const float* p_kk = KIN(I_KK); const float* p_ka = KIN(I_KA); const float* p_rk = KIN(I_RK);
    constexpr int NU = NU_ALL;
    LAS float* PRM = (LAS float*)(F.lds + LDS_X_OFF + 8704);
    int h_prm = F.pre4 ? ((int)blockIdx.x & 15) : -1;
    EPre<true> PF;
    CvTile cvt; float civ[4] = {0.f, 0.f, 0.f, 0.f}; int cv_t = 0;
    const float* cv_w = KIN(I_WEI);
    LAS float* cv_scr = (LAS float*)(F.lds + wave * 16384);
    if ((int)blockIdx.x < NU) epre_load<true>(PF, z, LO, (int)blockIdx.x, wave, F.lane);
    if (!SEAM_FILL && F.gw < NE * 64) { int e_, n0_, rb_; wei_strip(F.gw, e_, n0_, rb_);
        cv_scale_q8(cv_w + (size_t)e_ * D * 2048, 2048, n0_, (float*)(F.ws + MI_CSWEI) + (size_t)e_ * 2048, rb_, F.lane, civ); }
    asm volatile("" : "+v"(PF.k[0]), "+v"(PF.k[1]), "+v"(PF.k[2]), "+v"(PF.k[3]), "+v"(PF.k[4]), "+v"(PF.v[0]), "+v"(PF.v[1]), "+v"(PF.v[2]), "+v"(PF.v[3]), "+v"(PF.v[4]));
    asm volatile("" : "+v"(PF.r[0]), "+v"(PF.r[1]), "+v"(PF.r[2]), "+v"(PF.r[3]), "+v"(PF.r[4]), "+v"(PF.lo[0]), "+v"(PF.lo[1]), "+v"(PF.lo[2]), "+v"(PF.lo[3]));
    asm volatile("s_waitcnt vmcnt(0)" ::: "memory");
    for (int unit = blockIdx.x; unit < NU; unit += F.G) {
        int lane = F.lane; asm volatile("" : "+v"(lane));
        const int lr = lane & 15, g = lane >> 4;
        int b, h, rowbase; unit_decode(unit, b, h, rowbase);
        if (h != h_prm) {
            __syncthreads();
            if (F.tid < 96) { const int arr = F.tid >> 4, off = (F.tid & 15) * 4;
                const float* src = arr == 0 ? p_mu + K_OFF : arr == 1 ? p_mu + V_OFF : arr == 2 ? p_mu + R_OFF : arr == 3 ? p_kk : arr == 4 ? p_ka : p_rk;
                *(LAS f32x4*)(PRM + arr * 64 + off) = *(const f32x4*)(src + h * 64 + off); }
            __syncthreads(); h_prm = h; }
        const int tok = 8 * wave + (lane >> 3), oct = lane & 7, ch0 = 8 * oct, c0 = h * 64 + ch0;
        float ks[8], vs[8], rs[8], kkp[8], lw0[8], lw1[8], kd0[8], kd1[8], a_0[8], a_1[8], ssq;
        {
            { float m_[8]; ld8l(PRM + ch0, m_); shift8m(PF.k, m_, ks, PF.msk); ld8l(PRM + 64 + ch0, m_); shift8m(PF.v, m_, vs, PF.msk); ld8l(PRM + 128 + ch0, m_); shift8m(PF.r, m_, rs, PF.msk); }
            float kkk[8], kaa[8], rkk[8];
            unpack8(PF.lo[0], lw0); unpack8(PF.lo[1], lw1); unpack8(PF.lo[2], a_0); unpack8(PF.lo[3], a_1);
            ld8l(PRM + 192 + ch0, kkk); ld8l(PRM + 256 + ch0, kaa); ld8l(PRM + 320 + ch0, rkk);
            float ss = 0.f, bs = 0.f;
#pragma unroll
            for (int i = 0; i < 8; ++i) {
                kkp[i] = ks[i] * kkk[i]; ss += kkp[i] * kkp[i];
                kd0[i] = ks[i] * (1.0f + (a_0[i] - 1.0f) * kaa[i]); kd1[i] = ks[i] * (1.0f + (a_1[i] - 1.0f) * kaa[i]);
                bs += rs[i] * 0.5f * (kd0[i] + kd1[i]) * rkk[i];
                const int ch = ch0 + i, sw = tok ^ (4 * ((ch & 15) ^ (2 * (ch >> 4))));
                LW0[ch * 64 + sw] = lw0[i]; LW1[ch * 64 + sw] = lw1[i];
            }
            ss += __shfl_xor(ss, 1); bs += __shfl_xor(bs, 1); ss += __shfl_xor(ss, 2); bs += __shfl_xor(bs, 2); ss += __shfl_xor(ss, 4); bs += __shfl_xor(bs, 4);
            ssq = ss;
            if (oct == 0 && unit < NU_L) BON[(size_t)unit * 64 + tok] = bs;
        }
        const int unit_n = unit + F.G < NU ? unit + F.G : unit;
        epre_part<0>(PF, z, LO, unit_n, wave, lane);
        __syncthreads();
        {
            const int ch2 = lane, seg = wave, sw = 4 * ((ch2 & 15) ^ (2 * (ch2 >> 4)));
            LAS f32x4* p0a = (LAS f32x4*)(LW0 + ch2 * 64 + ((8 * seg) ^ sw)); LAS f32x4* p0b = (LAS f32x4*)(LW0 + ch2 * 64 + ((8 * seg + 4) ^ sw));
            LAS f32x4* p1a = (LAS f32x4*)(LW1 + ch2 * 64 + ((8 * seg) ^ sw)); LAS f32x4* p1b = (LAS f32x4*)(LW1 + ch2 * 64 + ((8 * seg + 4) ^ sw));
            f32x4 a = *p0a, bq = *p0b, c = *p1a, d = *p1b;
            a.y += a.x; a.z += a.y; a.w += a.z; bq.x += a.w; bq.y += bq.x; bq.z += bq.y; bq.w += bq.z;
            d.z += d.w; d.y += d.z; d.x += d.y; c.w += d.x; c.z += c.w; c.y += c.z; c.x += c.y;
            SEG[seg * 64 + ch2] = bq.w; SEG[(8 + seg) * 64 + ch2] = c.x;
            __syncthreads();
            float off0 = 0.f, off1 = 0.f;
#pragma unroll
            for (int s2 = 0; s2 < 8; ++s2) { const float t0 = SEG[s2 * 64 + ch2], t1 = SEG[(8 + s2) * 64 + ch2]; off0 += (s2 < seg) ? t0 : 0.f; off1 += (s2 > seg) ? t1 : 0.f; }
            *p0a = a + off0; *p0b = bq + off0; *p1a = c + off1; *p1b = d + off1;
        }
        epre_part<1>(PF, z, LO, unit_n, wave, lane);
        __syncthreads();
        {
            const float inv = 1.0f / fmaxf(sqrtf(ssq), 1e-12f);
            float t8[8], u8[8], w8[8], r8v[8];
            {
                LAS unsigned char* t0 = F.lds; const int tau = tok;
                float e1[8], ei[8];
#pragma unroll
                for (int i = 0; i < 8; ++i) { const int ch = ch0 + i; const float cm = LW0[ch * 64 + (tok ^ (4 * ((ch & 15) ^ (2 * (ch >> 4)))))]; e1[i] = __expf(cm); ei[i] = __builtin_amdgcn_rcpf(e1[i]); t8[i] = kkp[i] * inv * __expf(cm - lw0[i]); }
                if (tok == 63) {
#pragma unroll
                    for (int i = 0; i < 8; ++i) GAM[ch0 + i] = e1[i]; }
#pragma unroll
                for (int i = 0; i < 8; ++i) { u8[i] = kkp[i] * inv * a_0[i] * ei[i]; w8[i] = kd0[i] * ei[i]; r8v[i] = rs[i] * e1[i]; }
                putN(t0 + 0 * TILE, tau, oct, t8); putN(t0 + 1 * TILE, tau, oct, u8); putN(t0 + 2 * TILE, tau, oct, w8); putN(t0 + 3 * TILE, tau, oct, vs); putN(t0 + 4 * TILE, tau, oct, r8v);
            }
            {
                LAS unsigned char* t1 = F.lds + 9 * TILE; const int tau = 63 - tok;
                float e1[8], ei[8];
#pragma unroll
                for (int i = 0; i < 8; ++i) { const int ch = ch0 + i; const float cm = LW1[ch * 64 + (tok ^ (4 * ((ch & 15) ^ (2 * (ch >> 4)))))]; e1[i] = __expf(cm); ei[i] = __builtin_amdgcn_rcpf(e1[i]); t8[i] = kkp[i] * inv * __expf(cm - lw1[i]); }
                if (tok == 0) {
#pragma unroll
                    for (int i = 0; i < 8; ++i) GAM[64 + ch0 + i] = e1[i]; }
#pragma unroll
                for (int i = 0; i < 8; ++i) { u8[i] = kkp[i] * inv * a_1[i] * ei[i]; w8[i] = kd1[i] * ei[i]; r8v[i] = rs[i] * e1[i]; }
                putN(t1 + 0 * TILE, tau, oct, t8); putN(t1 + 1 * TILE, tau, oct, u8); putN(t1 + 2 * TILE, tau, oct, w8); putN(t1 + 3 * TILE, tau, oct, vs); putN(t1 + 4 * TILE, tau, oct, r8v);
            }
        }
        const size_t inst = (size_t)unit * 2 + dgrp;
        epre_part<2>(PF, z, LO, unit_n, wave, lane);
        const int cv_strip = F.gw + (cv_t >> 4) * F.NGW, cv_kb = cv_t & 15;
        if (!SEAM_FILL) { int e_, n0_, rb_; wei_strip(cv_strip < NE * 64 ? cv_strip : 0, e_, n0_, rb_); cv_load(cvt, cv_w + (size_t)e_ * D * 2048, 2048, n0_, cv_kb, lane); }
        __syncthreads();
        f32x4 acc[4], acc2[4];
        zero4(acc); mm64x<false, false>(acc, SL(1), SL(0), wq, lane);
        zero4(acc2); mm64x<false, false>(acc2, SL(2), SL(0), wq, lane);
#pragma unroll
        for (int n = 0; n < 4; ++n)
#pragma unroll
            for (int q = 0; q < 4; ++q) { const bool lo = (16 * wq + 4 * g + q < 16 * n + lr); acc[n][q] = lo ? acc[n][q] : 0.f; acc2[n][q] = lo ? acc2[n][q] : 0.f; }
        storeT(SL(5), acc, wq, lane); storeT(SL(6), acc2, wq, lane);
        epre_part<3>(PF, z, LO, unit_n, wave, lane);
        __syncthreads();
        zero4(acc); mm64x<false, true>(acc, SL(6), SL(3), wq, lane); storeT(SL(7), acc, wq, lane);
        if (wq == 0) {
            const int bb = lane >> 4, jj = lane & 15;
            float X[16];
            X[0] = (jj == 0) ? 1.f : 0.f;
#pragma unroll
            for (int t = 1; t < 16; ++t) {
                const int row = 16 * bb + t;
                const v4u p0 = *(const LAS v4u*)(SL(5) + row * 128 + (((2 * bb) ^ swz(row)) << 4)), p1 = *(const LAS v4u*)(SL(5) + row * 128 + (((2 * bb + 1) ^ swz(row)) << 4));
                float rw[16];
                rw[0] = bflo(p0.x); rw[1] = bfhi(p0.x); rw[2] = bflo(p0.y); rw[3] = bfhi(p0.y); rw[4] = bflo(p0.z); rw[5] = bfhi(p0.z); rw[6] = bflo(p0.w); rw[7] = bfhi(p0.w);
                rw[8] = bflo(p1.x); rw[9] = bfhi(p1.x); rw[10] = bflo(p1.y); rw[11] = bfhi(p1.y); rw[12] = bflo(p1.z); rw[13] = bfhi(p1.z); rw[14] = bflo(p1.w); rw[15] = bfhi(p1.w);
                float xv = (t == jj) ? 1.f : 0.f;
#pragma unroll
                for (int s = 0; s < t; ++s) xv -= rw[s] * X[s];
                X[t] = xv;
            }
#pragma unroll
            for (int t = 0; t < 16; ++t) *(LAS unsigned short*)(DIB + (((bb * 16 + t) * 16 + jj) << 1)) = (unsigned short)f2bf(X[t]);
        }
        __syncthreads();
        {
            const bool isU = wq >= 2; const int cbase = 32 * (wq & 1);
            LAS unsigned char* outT = isU ? SL(6) : SL(8);
#pragma unroll
            for (int ct = 0; ct < 2; ++ct) {
                const int ctile = 2 * (wq & 1) + ct, col = cbase + 16 * ct + lr;
                f32x4 X[4];
#pragma unroll
                for (int b2 = 0; b2 < 4; ++b2) {
                    f32x4 Zt;
                    if (isU) { const v2u rwv = *(const LAS v2u*)(SL(7) + toff(col, 16 * b2 + 4 * g)); Zt = (f32x4){bflo(rwv.x), bfhi(rwv.x), bflo(rwv.y), bfhi(rwv.y)}; }
                    else Zt = loadN_acc(SL(0), b2, ctile, lane);
                    if (b2 >= 1) {
                        f32x4 Y = {0.f, 0.f, 0.f, 0.f};
#pragma unroll
                        for (int s = 0; s < (b2 + 1) / 2; ++s) {
                            v2u alo = {0u, 0u}, ahi = {0u, 0u};
                            if (2 * s < b2) alo = *(const LAS v2u*)(SL(5) + toff(16 * b2 + lr, 32 * s + 4 * g));
                            if (2 * s + 1 < b2) ahi = *(const LAS v2u*)(SL(5) + toff(16 * b2 + lr, 32 * s + 16 + 4 * g));
                            v4u bw = {cvtpk(X[2 * s][0], X[2 * s][1]), cvtpk(X[2 * s][2], X[2 * s][3]), 0u, 0u};
                            if (2 * s + 1 < b2) { bw.z = cvtpk(X[2 * s + 1][0], X[2 * s + 1][1]); bw.w = cvtpk(X[2 * s + 1][2], X[2 * s + 1][3]); }
                            Y = CK_MFMA(__builtin_bit_cast(bf16x8, ((v4u){alo.x, alo.y, ahi.x, ahi.y})), __builtin_bit_cast(bf16x8, bw), Y);
                        }
                        Zt = Zt - Y;
                    }
                    const v2u dv = *(const LAS v2u*)(DIB + (((b2 * 16 + lr) * 16 + 4 * g) << 1));
                    const v4u bz = {cvtpk(Zt[0], Zt[1]), cvtpk(Zt[2], Zt[3]), 0u, 0u};
                    X[b2] = CK_MFMA(__builtin_bit_cast(bf16x8, ((v4u){dv.x, dv.y, 0u, 0u})), __builtin_bit_cast(bf16x8, bz), ((f32x4){0.f, 0.f, 0.f, 0.f}));
                }
#pragma unroll
                for (int b2 = 0; b2 < 4; ++b2) *(LAS v2u*)(outT + toff(col, 16 * b2 + 4 * g)) = (v2u){cvtpk(X[b2][0], X[b2][1]), cvtpk(X[b2][2], X[b2][3])};
            }
        }
        __syncthreads();
        asm volatile("" : "+v"(PF.k[0]), "+v"(PF.k[1]), "+v"(PF.k[2]), "+v"(PF.k[3]), "+v"(PF.k[4]), "+v"(PF.v[0]), "+v"(PF.v[1]), "+v"(PF.v[2]), "+v"(PF.v[3]), "+v"(PF.v[4]));
        asm volatile("" : "+v"(PF.r[0]), "+v"(PF.r[1]), "+v"(PF.r[2]), "+v"(PF.r[3]), "+v"(PF.r[4]), "+v"(PF.lo[0]), "+v"(PF.lo[1]), "+v"(PF.lo[2]), "+v"(PF.lo[3]));
        if (!SEAM_FILL) asm volatile("" : "+v"(cvt.v[0]), "+v"(cvt.v[1]), "+v"(cvt.v[2]), "+v"(cvt.v[3]), "+v"(cvt.v[4]), "+v"(cvt.v[5]), "+v"(cvt.v[6]), "+v"(cvt.v[7]));
        {
            zero4(acc); mm64x<false, true>(acc, SL(8), SL(1), wq, lane);
            const int cstep_ = unit < NU_L ? 4 + (dgrp ? 127 - ((unit >> 4) & 127) : ((unit >> 4) & 127)) : (dgrp ? 3 - (((unit - NU_L) >> 4) & 3) : (((unit - NU_L) >> 4) & 3));
            unsigned char* pb = PQ + (size_t)(((b * 16 + h) * 2 + dgrp) * (4 + T / 64) + cstep_) * 16384;
#pragma unroll
            for (int n = 0; n < 4; ++n) { const int k = 16 * n + lr; const float gm = GAM[dgrp * 64 + k]; float p[4];
#pragma unroll
                for (int q = 0; q < 4; ++q) p[q] = gm * (((16 * wq + 4 * g + q) == k ? 1.f : 0.f) - acc[n][q]);
                *(uint2*)(pb + (size_t)(((n * 2 + (wq >> 1)) * 64 + lane) * 16 + (wq & 1) * 8)) = make_uint2(cvtpk(p[0], p[1]), cvtpk(p[2], p[3])); }
            zero4(acc); mm64x<true, true>(acc, SL(2), SL(3), wq, lane); zero4(acc2); mm64x<true, false>(acc2, SL(1), SL(6), wq, lane);
            const f32x4 gm4 = *(const LAS f32x4*)(GAM + dgrp * 64 + 16 * wq + 4 * g);
#pragma unroll
            for (int n = 0; n < 4; ++n) { const f32x4 qv = (acc[n] - acc2[n]) * gm4;
                *(uint2*)(pb + 8192 + (size_t)(((n * 64 + lane) * 4 + wq) * 8)) = make_uint2(cvtpk(qv[0], qv[1]), cvtpk(qv[2], qv[3])); }
            if (unit < NU_L) {
                zero4(acc); mm64x<false, false>(acc, SL(2), SL(4), wq, lane);
                zero4(acc2); mm64x<false, false>(acc2, SL(1), SL(4), wq, lane);
#pragma unroll
                for (int n = 0; n < 4; ++n)
#pragma unroll
                    for (int q = 0; q < 4; ++q) { const bool le = (16 * wq + 4 * g + q <= 16 * n + lr); acc[n][q] = le ? acc[n][q] : 0.f; acc2[n][q] = le ? -acc2[n][q] : 0.f; }
                storeT(SL(5), acc, wq, lane); storeT(SL(7), acc2, wq, lane);
            }
        }
        __syncthreads();
        if (unit < NU_L) {
            loadT(acc, SL(4), wq, lane);
            mm64x<false, false>(acc, SL(8), SL(7), wq, lane);
            unsigned char* rb = RHAT + inst * 8192;
#pragma unroll
            for (int n = 0; n < 4; ++n) *(uint2*)(rb + (size_t)((16 * n + lr) * 64 + 16 * wq + 4 * g) * 2) = make_uint2(cvtpk(acc[n][0], acc[n][1]), cvtpk(acc[n][2], acc[n][3]));
            zero4(acc2); mm64x<false, true>(acc2, SL(5), SL(3), wq, lane); mm64x<false, false>(acc2, SL(7), SL(6), wq, lane);
            unsigned char* yb = YLOC + inst * 8192 + (size_t)((wq * 64 + lane) * 32);
            v4u o0, o1; o0.x = cvtpk(acc2[0][0], acc2[0][1]); o0.y = cvtpk(acc2[0][2], acc2[0][3]); o0.z = cvtpk(acc2[1][0], acc2[1][1]); o0.w = cvtpk(acc2[1][2], acc2[1][3]);
            o1.x = cvtpk(acc2[2][0], acc2[2][1]); o1.y = cvtpk(acc2[2][2], acc2[2][3]); o1.z = cvtpk(acc2[3][0], acc2[3][1]); o1.w = cvtpk(acc2[3][2], acc2[3][3]);
            *(v4u*)yb = o0; *(v4u*)(yb + 16) = o1;
        }
        __syncthreads();
        if (!SEAM_FILL) {
            if (cv_strip < NE * 64) { int e_, n0_, rb_; wei_strip(cv_strip, e_, n0_, rb_);
                if (cv_kb == 0 && cv_t > 0) cv_scale_q8(cv_w + (size_t)e_ * D * 2048, 2048, n0_, (float*)(F.ws + MI_CSWEI) + (size_t)e_ * 2048, rb_, lane, civ);
                cv_store_q8(cvt, cv_scr, (signed char*)(F.ws + WS_WEIN) + (size_t)e_ * 2048 * D, rb_, cv_kb, civ, lane); }
            ++cv_t;
            __syncthreads();
        }
    }
    for (; !SEAM_FILL;) { const int s_ = F.gw + (cv_t >> 4) * F.NGW, kb_ = cv_t & 15; if (s_ >= NE * 64) break;
        int e_, n0_, rb_; wei_strip(s_, e_, n0_, rb_);
        if (kb_ == 0 && cv_t > 0) cv_scale_q8(cv_w + (size_t)e_ * D * 2048, 2048, n0_, (float*)(F.ws + MI_CSWEI) + (size_t)e_ * 2048, rb_, F.lane, civ);
        cv_load(cvt, cv_w + (size_t)e_ * D * 2048, 2048, n0_, kb_, F.lane);
        cv_store_q8(cvt, cv_scr, (signed char*)(F.ws + WS_WEIN) + (size_t)e_ * 2048 * D, rb_, kb_, civ, F.lane); ++cv_t; }
#undef SL
}

__device__ __forceinline__ void co2_param_table(Frame& F, int h) {
    LAS float* PRM = (LAS float*)(F.lds + LDS_X_OFF + 8704); const float* p_mu = KIN(I_MU);
    if (F.tid < 96) { const int arr = F.tid >> 4, off = (F.tid & 15) * 4;
        const float* src = arr == 0 ? p_mu + V_OFF : arr == 1 ? KIN(I_LNW) : arr == 2 ? KIN(I_LNB) : KIN(I_CONVW) + (arr - 3) * D;
        *(LAS f32x4*)(PRM + arr * 64 + off) = *(const f32x4*)(src + h * 64 + off); }
}
__device__ __forceinline__ void phase_co2(Frame& F) {
    const int wave = F.wave;
    const int dgrp = wave >> 2, wq = wave & 3;
    LAS unsigned char* tl = F.lds + dgrp * 9 * TILE;
#define SL(k) (tl + (k) * TILE)
    const bf16* z = (const bf16*)(F.ws + WS_Z); const bf16* LO = (const bf16*)(F.ws + WS_LORA);
    const unsigned char* RHAT = F.ws + WS_TKN; const unsigned char* YLOC = F.ws + WS_UPRE; const unsigned char* H0T = F.ws + WS_H0T;
    const float* BON = (const float*)(F.ws + MI_BON);
    bf16* MG = (bf16*)(F.ws + WS_A0);
    const float* p_mu = KIN(I_MU);
    LAS float* PRM = (LAS float*)(F.lds + LDS_X_OFF + 8704);
    LAS unsigned char* VR = F.lds + 4 * TILE;
    LAS float* PX = (LAS float*)(F.lds + 5 * TILE);
    int h_prm = F.pre6 ? ((int)blockIdx.x & 15) : -1;
    for (int unit = blockIdx.x; unit < NU_L; unit += F.G) {
        int lane = F.lane; asm volatile("" : "+v"(lane));
        const int lr = lane & 15, g = lane >> 4;
        int b, h, rowbase; unit_decode(unit, b, h, rowbase);
        if (h != h_prm) {
            __syncthreads();
            if (F.tid < 96) { const int arr = F.tid >> 4, off = (F.tid & 15) * 4;
                const float* src = arr == 0 ? p_mu + V_OFF : arr == 1 ? KIN(I_LNW) : arr == 2 ? KIN(I_LNB) : KIN(I_CONVW) + (arr - 3) * D;
                *(LAS f32x4*)(PRM + arr * 64 + off) = *(const f32x4*)(src + h * 64 + off); }
            __syncthreads(); h_prm = h; }
        const int tok = 8 * wave + (lane >> 3), oct = lane & 7, ch0 = 8 * oct, c0 = h * 64 + ch0, row = rowbase + tok;
        const size_t inst = (size_t)unit * 2 + dgrp;
        const int t2 = (wq << 6) | lane;
#pragma unroll
        for (int rep = 0; rep < 2; ++rep) { const int cidx = t2 + 256 * rep, r_ = cidx >> 3, ch = cidx & 7;
            const v4u a = NTL((const v4u*)(RHAT + inst * 8192 + (size_t)(r_ * 64 + ch * 8) * 2)), hh = NTL((const v4u*)(H0T + inst * 8192 + (size_t)(r_ * 64 + ch * 8) * 2));
            *(LAS v4u*)(SL(0) + r_ * 128 + ((ch ^ swz(r_)) << 4)) = a; *(LAS v4u*)(SL(1) + r_ * 128 + ((ch ^ swz(r_)) << 4)) = hh; }
        f32x4 acc[4];
        { const unsigned char* yb = YLOC + inst * 8192 + (size_t)((wq * 64 + lane) * 32); const v4u o0 = NTL((const v4u*)yb), o1 = NTL((const v4u*)(yb + 16));
          acc[0] = (f32x4){bflo(o0.x), bfhi(o0.x), bflo(o0.y), bfhi(o0.y)}; acc[1] = (f32x4){bflo(o0.z), bfhi(o0.z), bflo(o0.w), bfhi(o0.w)};
          acc[2] = (f32x4){bflo(o1.x), bfhi(o1.x), bflo(o1.y), bfhi(o1.y)}; acc[3] = (f32x4){bflo(o1.z), bfhi(o1.z), bflo(o1.w), bfhi(o1.w)}; }
        const int t = row & (T - 1);
        const bf16* zr = z + (size_t)row * NZ;
        const v4u zz = {0u, 0u, 0u, 0u};
        __syncthreads();
        const v4u qv0 = *(const v4u*)(zr + V_OFF + c0);
        unsigned vmsk = (tok > 0 ? 1u : 0u) | (tok < 63 ? 2u : 0u);
        const v4u q_c0 = NTL((const v4u*)(zr + CONV_OFF + 1024 + c0)), q_x0 = NTL((const v4u*)(zr + CONV_OFF + 2048 + c0));
        const float S3 = BON[(size_t)unit * 64 + tok];
        v4u qvu, qvd;
        { const int nu = nbr_row(row, 2), nd = nbr_row(row, 3); vmsk |= (nu >= 0 ? 4u : 0u) | (nd >= 0 ? 8u : 0u);
          qvu = *(const v4u*)(z + (size_t)(nu >= 0 ? nu : row) * NZ + V_OFF + c0); qvd = *(const v4u*)(z + (size_t)(nd >= 0 ? nd : row) * NZ + V_OFF + c0); }
        const v4u q_g = NTL((const v4u*)(LO + (size_t)row * NL + 4096 + c0));
        const v4u q_gb = NTL((const v4u*)(zr + CONV_OFF + c0));
        const v4u q_ga = NTL((const v4u*)(zr + GATE_OFF + c0)), q_gr = NTL((const v4u*)(zr + GATE_OFF + 1024 + c0));
        v4u q_cm = zz, q_xm = zz, q_cp = zz, q_xp = zz;
        if (tok == 0 && t > 0) { q_cm = *(const v4u*)(zr - NZ + CONV_OFF + 1024 + c0); q_xm = *(const v4u*)(zr - NZ + CONV_OFF + 2048 + c0); }
        if (tok == 63 && t < T - 1) { q_cp = *(const v4u*)(zr + NZ + CONV_OFF + 1024 + c0); q_xp = *(const v4u*)(zr + NZ + CONV_OFF + 2048 + c0); }
        mm64x<false, false>(acc, SL(0), SL(1), wq, lane);
        { LAS float* Yf = (LAS float*)(tl + 2 * TILE);
#pragma unroll
          for (int n = 0; n < 4; ++n)
#pragma unroll
              for (int q = 0; q < 4; ++q) { const int tau = 16 * wq + 4 * g + q; Yf[tau * 64 + ((16 * n + lr) ^ (4 * (tau & 15)))] = acc[n][q]; } }
        float cc[8], xx[8];
        unpack8(q_c0, cc); unpack8(q_x0, xx);
#pragma unroll
        for (int i = 0; i < 8; ++i) cc[i] *= xx[i];
        *(LAS v4u*)(VR + tok * 128 + oct * 16) = qv0;
        *(LAS f32x4*)(PX + tok * 64 + ch0) = (f32x4){cc[0], cc[1], cc[2], cc[3]}; *(LAS f32x4*)(PX + tok * 64 + ch0 + 4) = (f32x4){cc[4], cc[5], cc[6], cc[7]};
        __syncthreads();
        { const LAS float* Y0 = (const LAS float*)(F.lds + 2 * TILE); const LAS float* Y1 = (const LAS float*)(F.lds + 11 * TILE);
          float y[8];
          { const int s0 = 4 * (tok & 15), s1 = 4 * ((63 - tok) & 15);
            const f32x4 a0 = *(const LAS f32x4*)(Y0 + tok * 64 + (ch0 ^ s0)), a1 = *(const LAS f32x4*)(Y0 + tok * 64 + ((ch0 + 4) ^ s0));
            const f32x4 b0 = *(const LAS f32x4*)(Y1 + (63 - tok) * 64 + (ch0 ^ s1)), b1 = *(const LAS f32x4*)(Y1 + (63 - tok) * 64 + ((ch0 + 4) ^ s1));
            y[0] = a0.x + b0.x; y[1] = a0.y + b0.y; y[2] = a0.z + b0.z; y[3] = a0.w + b0.w; y[4] = a1.x + b1.x; y[5] = a1.y + b1.y; y[6] = a1.z + b1.z; y[7] = a1.w + b1.w; }
          float s1 = 0.f, s2 = 0.f;
#pragma unroll
          for (int i = 0; i < 8; ++i) { s1 += y[i]; s2 += y[i] * y[i]; }
          s1 += __shfl_xor(s1, 1); s2 += __shfl_xor(s2, 1); s1 += __shfl_xor(s1, 2); s2 += __shfl_xor(s2, 2); s1 += __shfl_xor(s1, 4); s2 += __shfl_xor(s2, 4);
          const float mean = s1 * (1.0f / 64.0f), var = fmaxf(s2 * (1.0f / 64.0f) - mean * mean, 0.f), rstd = __builtin_amdgcn_rsqf(var + 64e-5f);
          float vs[8];
          { v4u q[5]; q[0] = qv0; q[1] = *(const LAS v4u*)(VR + (tok > 0 ? tok - 1 : tok) * 128 + oct * 16); q[2] = *(const LAS v4u*)(VR + (tok < 63 ? tok + 1 : tok) * 128 + oct * 16); q[3] = qvu; q[4] = qvd;
            float m_[8]; ld8l(PRM + ch0, m_); shift8m(q, m_, vs, vmsk); }
          float lnw[8], lnb[8], cw0[8], cw1[8], cw2[8];
          ld8l(PRM + 64 + ch0, lnw); ld8l(PRM + 128 + ch0, lnb); ld8l(PRM + 192 + ch0, cw0); ld8l(PRM + 256 + ch0, cw1); ld8l(PRM + 320 + ch0, cw2);
          float gg[8], gb[8], pm[8], pp[8], ga[8], gr[8];
          unpack8(q_g, gg); unpack8(q_gb, gb); unpack8(q_ga, ga); unpack8(q_gr, gr);
          if (tok > 0) ld8l(PX + (tok - 1) * 64 + ch0, pm); else { float c_[8], x_[8]; unpack8(q_cm, c_); unpack8(q_xm, x_);
#pragma unroll
              for (int i = 0; i < 8; ++i) pm[i] = c_[i] * x_[i]; }
          if (tok < 63) ld8l(PX + (tok + 1) * 64 + ch0, pp); else { float c_[8], x_[8]; unpack8(q_cp, c_); unpack8(q_xp, x_);
#pragma unroll
              for (int i = 0; i < 8; ++i) pp[i] = c_[i] * x_[i]; }
          float o[8];
#pragma unroll
          for (int i = 0; i < 8; ++i) {
              const float yn = (y[i] - mean) * rstd * lnw[i] + lnb[i];
              const float yr = (yn + S3 * vs[i]) * gg[i];
              const float yc = gb[i] * (cw0[i] * pm[i] + cw1[i] * cc[i] + cw2[i] * pp[i]);
              o[i] = fsig(ga[i]) * yr + fsig(gr[i]) * yc;
          }
          v4u ov; ov.x = cvtpk(o[0], o[1]); ov.y = cvtpk(o[2], o[3]); ov.z = cvtpk(o[4], o[5]); ov.w = cvtpk(o[6], o[7]);
          *(v4u*)(MG + (size_t)row * D + c0) = ov;
        }
    }
#undef SL
}

struct SSIn { v4u a[8]; v4u q[2]; };
__device__ __forceinline__ size_t ss_pq(int step, int b, int h, int d) { return (size_t)(((b * 16 + h) * 2 + d) * (4 + T / 64) + step); }
__device__ __forceinline__ size_t ss_inst(int step, int b, int h, int d) {
    int unit;
    if (step < 4) { const int cb = d ? 3 - step : step; unit = NU_L + (b * 4 + cb) * 16 + h; }
    else { const int blk = d ? 127 - (step - 4) : step - 4; unit = (b * 128 + blk) * 16 + h; }
    return (size_t)unit * 2 + d;
}
__device__ __forceinline__ void ss_load(SSIn& I, const unsigned char* PQ, size_t inst, int wv, int lane) {
    const unsigned char* pb = PQ + inst * 16384;
#pragma unroll
    for (int f = 0; f < 8; ++f) I.a[f] = *(const v4u*)(pb + (size_t)((f * 64 + lane) * 16));
    I.q[0] = NTL((const v4u*)(pb + 8192 + (size_t)((wv * 64 + lane) * 32))); I.q[1] = NTL((const v4u*)(pb + 8192 + (size_t)((wv * 64 + lane) * 32 + 16)));
}
__device__ __forceinline__ void ss_step(f32x4 (&H)[4], const SSIn& cur, unsigned char* H0T, size_t inst, bool store_h0, int wv, int lr, int g) {
    const unsigned p00 = cvtpk(H[0][0], H[0][1]), p01 = cvtpk(H[0][2], H[0][3]), p10 = cvtpk(H[1][0], H[1][1]), p11 = cvtpk(H[1][2], H[1][3]);
    const unsigned p20 = cvtpk(H[2][0], H[2][1]), p21 = cvtpk(H[2][2], H[2][3]), p30 = cvtpk(H[3][0], H[3][1]), p31 = cvtpk(H[3][2], H[3][3]);
    if (store_h0) { unsigned char* hb = H0T + inst * 8192 + (size_t)((16 * wv + lr) * 64 + 4 * g) * 2;
        *(uint2*)(hb) = make_uint2(p00, p01); *(uint2*)(hb + 32) = make_uint2(p10, p11); *(uint2*)(hb + 64) = make_uint2(p20, p21); *(uint2*)(hb + 96) = make_uint2(p30, p31); }
    const bf16x8 b0 = __builtin_bit_cast(bf16x8, ((v4u){p00, p01, p10, p11})), b1 = __builtin_bit_cast(bf16x8, ((v4u){p20, p21, p30, p31}));
    H[0] = (f32x4){bflo(cur.q[0].x), bfhi(cur.q[0].x), bflo(cur.q[0].y), bfhi(cur.q[0].y)}; H[1] = (f32x4){bflo(cur.q[0].z), bfhi(cur.q[0].z), bflo(cur.q[0].w), bfhi(cur.q[0].w)};
    H[2] = (f32x4){bflo(cur.q[1].x), bfhi(cur.q[1].x), bflo(cur.q[1].y), bfhi(cur.q[1].y)}; H[3] = (f32x4){bflo(cur.q[1].z), bfhi(cur.q[1].z), bflo(cur.q[1].w), bfhi(cur.q[1].w)};
#pragma unroll
    for (int m = 0; m < 4; ++m) { H[m] = CK_MFMA(__builtin_bit_cast(bf16x8, cur.a[2 * m]), b0, H[m]); H[m] = CK_MFMA(__builtin_bit_cast(bf16x8, cur.a[2 * m + 1]), b1, H[m]); }
}
__device__ __forceinline__ void phase_ss(Frame& F) {
    const unsigned char* PQ = F.ws + WS_PQ; unsigned char* H0T = F.ws + WS_H0T;
    const int lane = F.lane, lr = lane & 15, g = lane >> 4;
    for (int task = F.vb; task < 256; task += F.G) {
        const int chain = (task & 7) + 8 * (task >> 5), wv = (task >> 3) & 3, b = chain >> 5, h = (chain >> 1) & 15, d = chain & 1;
        f32x4 H[4]; zero4(H);
        constexpr int NS = 4 + T / 64;
        static_assert(NS % 4 == 0, "unrolled by four");
        SSIn b0, b1, b2, b3;
        ss_load(b0, PQ, ss_pq(0, b, h, d), wv, lane); ss_load(b1, PQ, ss_pq(1, b, h, d), wv, lane); ss_load(b2, PQ, ss_pq(2, b, h, d), wv, lane); ss_load(b3, PQ, ss_pq(3, b, h, d), wv, lane);
        for (int step = 0; step < NS; step += 4) {
            const int n0 = step + 4 < NS ? step + 4 : NS - 1, n1 = step + 5 < NS ? step + 5 : NS - 1, n2 = step + 6 < NS ? step + 6 : NS - 1, n3 = step + 7 < NS ? step + 7 : NS - 1;
            ss_step(H, b0, H0T, ss_inst(step, b, h, d), step >= 4, wv, lr, g);     ss_load(b0, PQ, ss_pq(n0, b, h, d), wv, lane);
            ss_step(H, b1, H0T, ss_inst(step + 1, b, h, d), step >= 4, wv, lr, g); ss_load(b1, PQ, ss_pq(n1, b, h, d), wv, lane);
            ss_step(H, b2, H0T, ss_inst(step + 2, b, h, d), step >= 4, wv, lr, g); ss_load(b2, PQ, ss_pq(n2, b, h, d), wv, lane);
            ss_step(H, b3, H0T, ss_inst(step + 3, b, h, d), step >= 4, wv, lr, g); ss_load(b3, PQ, ss_pq(n3, b, h, d), wv, lane);
        }
    }
}

struct LoraARaw { v4u q[5]; f32x4 m0, m1; };
__device__ __forceinline__ int lora_acol(int gi, int oct) { return (gi < 4 ? DECAY_OFF + 64 * gi : GLORA_OFF + 64 * (gi - 4)) + 8 * oct; }
__device__ __forceinline__ unsigned lora_aload(LoraARaw& R, const bf16* z, const float* p_mu, int r0, int gi, int wave, int lane) {
    const int tok = 8 * wave + (lane >> 3), oct = lane & 7, row = r0 + tok, col = lora_acol(gi, oct);
    R.q[0] = *(const v4u*)(z + (size_t)row * NZ + col);
    unsigned msk = 0u;
#pragma unroll
    for (int j = 0; j < 4; ++j) { const int nr = nbr_row(row, j); msk |= (nr >= 0 ? 1u : 0u) << j; R.q[1 + j] = *(const v4u*)(z + (size_t)(nr >= 0 ? nr : row) * NZ + col); }
    R.m0 = *(const f32x4*)(p_mu + col); R.m1 = *(const f32x4*)(p_mu + col + 4);
    return msk;
}
__device__ __forceinline__ void lora_astore(const LoraARaw& R, unsigned msk, LAS unsigned char* lds, int gi, int wave, int lane) {
    const int tok = 8 * wave + (lane >> 3), oct = lane & 7;
    const v4u zz = {0u, 0u, 0u, 0u};
    const v4u s = R.q[0], n0 = (msk & 1u) ? R.q[1] : zz, n1 = (msk & 2u) ? R.q[2] : zz, n2 = (msk & 4u) ? R.q[3] : zz, n3 = (msk & 8u) ? R.q[4] : zz;
    float v[8];
    v[0] = bflo(s.x) + R.m0.x * (bflo(n0.x) - bflo(s.x)); v[1] = bfhi(s.x) + R.m0.y * (bfhi(n1.x) - bfhi(s.x));
    v[2] = bflo(s.y) + R.m0.z * (bflo(n2.y) - bflo(s.y)); v[3] = bfhi(s.y) + R.m0.w * (bfhi(n3.y) - bfhi(s.y));
    v[4] = bflo(s.z) + R.m1.x * (bflo(n0.z) - bflo(s.z)); v[5] = bfhi(s.z) + R.m1.y * (bfhi(n1.z) - bfhi(s.z));
    v[6] = bflo(s.w) + R.m1.z * (bflo(n2.w) - bflo(s.w)); v[7] = bfhi(s.w) + R.m1.w * (bfhi(n3.w) - bfhi(s.w));
#pragma unroll
    for (int i = 0; i < 8; ++i) v[i] = gi < 2 ? 1.0f - 2.0f * __builtin_amdgcn_rcpf(1.0f + __expf(2.0f * v[i])) : (gi < 4 ? v[i] : fsig(v[i]));
    putN(lds + gi * TILE, tok, oct, v);
}
__device__ __forceinline__ void lora_atile(const bf16* z, const float* p_mu, LAS unsigned char* lds, int r0, int gi, int wave, int lane) {
    LoraARaw R; const unsigned msk = lora_aload(R, z, p_mu, r0, gi, wave, lane); lora_astore(R, msk, lds, gi, wave, lane);
}
template <int KS> struct LoraB { bf16x8 w[KS][4]; };
template <int KS>
__device__ __forceinline__ void lora_bload(LoraB<KS>& B, const bf16* WL, int q, int lr, int g) {
    const int blkid = q >> 4, h = q & 15;
    const bf16* wrow = WL + (size_t)(blkid * 1024 + h * 64 + 8 * (lr >> 2) + (lr & 3)) * KL + blkid * 64 + 8 * g;
#pragma unroll
    for (int s = 0; s < KS; ++s)
#pragma unroll
        for (int n = 0; n < 4; ++n) B.w[s][n] = *(const bf16x8*)(wrow + (size_t)(32 * (n >> 1) + 4 * (n & 1)) * KL + 32 * s);
}
template <int KS>
__device__ __forceinline__ void lora_product(const LoraB<KS>& B, const LAS unsigned char* At, bf16* LO, int r0, int q, int lr, int g, const LAS float* LBI) {
    const int blkid = q >> 4, h = q & 15;
    f32x4 acc[4][4];
#pragma unroll
    for (int n = 0; n < 4; ++n)
#pragma unroll
        for (int m = 0; m < 4; ++m) acc[n][m] = (f32x4){0.f, 0.f, 0.f, 0.f};
#pragma unroll
    for (int s = 0; s < KS; ++s) {
        bf16x8 af[4];
#pragma unroll
        for (int m = 0; m < 4; ++m) af[m] = ldfrag(At + (s >> 1) * TILE, 16 * m + lr, 4 * (s & 1) + g);
#pragma unroll
        for (int n = 0; n < 4; ++n)
#pragma unroll
            for (int m = 0; m < 4; ++m) acc[n][m] = CK_MFMA(B.w[s][n], af[m], acc[n][m]);
    }
    bf16* ob = LO + (size_t)(r0 + lr) * NL + blkid * 1024 + h * 64 + 8 * g;
#pragma unroll
    for (int m = 0; m < 4; ++m)
#pragma unroll
        for (int p = 0; p < 2; ++p) {
            f32x4 v0 = acc[2 * p][m], v1 = acc[2 * p + 1][m];
            if (KS == 2) {
                const LAS float* bp = LBI + blkid * 1024 + h * 64 + 8 * g + 32 * p; const f32x4 b0 = *(const LAS f32x4*)bp, b1 = *(const LAS f32x4*)(bp + 4); const float sc = blkid < 2 ? -0.6065306597126334f : 1.0f;
#pragma unroll
                for (int e = 0; e < 4; ++e) { v0[e] = sc * fsig(v0[e] + b0[e]); v1[e] = sc * fsig(v1[e] + b1[e]); }
            }
            v4u o; o.x = cvtpk(v0[0], v0[1]); o.y = cvtpk(v0[2], v0[3]); o.z = cvtpk(v1[0], v1[1]); o.w = cvtpk(v1[2], v1[3]);
            *(v4u*)(ob + (size_t)(16 * m) * NL + 32 * p) = o; }
}
__device__ __forceinline__ void lora_bias_table(Frame& F) {
    LAS float* LBI = (LAS float*)(F.lds + 15 * TILE); const float* p_w0 = KIN(I_W0); const float* p_a0 = KIN(I_A0);
    const int i4 = F.tid * 4; *(LAS f32x4*)(LBI + i4) = *(const f32x4*)(p_w0 + i4); *(LAS f32x4*)(LBI + 2048 + i4) = *(const f32x4*)(p_a0 + i4);
}
__device__ __forceinline__ void phase_lora(Frame& F) {
    const bf16* z = (const bf16*)(F.ws + WS_Z); bf16* LO = (bf16*)(F.ws + WS_LORA); const bf16* WL = (const bf16*)(F.ws + WS_WLORA);
    const float* p_mu = KIN(I_MU); const float* p_w0 = KIN(I_W0); const float* p_a0 = KIN(I_A0);
    LAS float* LBI = (LAS float*)(F.lds + 15 * TILE);
    if (!F.pre3) { lora_bias_table(F); __syncthreads(); }
    for (int unit = blockIdx.x; unit < ML / 64; unit += F.G) {
        int lane = F.lane; asm volatile("" : "+v"(lane));
        const int lr = lane & 15, g = lane >> 4, r0 = unit * 64;
#pragma unroll
        for (int gb = 0; gb < 6; gb += 3) {
            LoraARaw R0, R1, R2;
            const unsigned k0 = lora_aload(R0, z, p_mu, r0, gb, F.wave, lane), k1 = lora_aload(R1, z, p_mu, r0, gb + 1, F.wave, lane), k2 = lora_aload(R2, z, p_mu, r0, gb + 2, F.wave, lane);
            __builtin_amdgcn_sched_barrier(0);
            lora_astore(R0, k0, F.lds, gb, F.wave, lane); lora_astore(R1, k1, F.lds, gb + 1, F.wave, lane); lora_astore(R2, k2, F.lds, gb + 2, F.wave, lane);
        }
        __syncthreads();
        const float* weo = KIN(I_WEO); bf16* WEO = (bf16*)(F.ws + WS_WEOUT);
        LAS float* fscr = (LAS float*)(F.lds + 6 * TILE + F.wave * 8704);
        const int ft0 = (unit * NWAVES + F.wave) * 10;
        CvTile ft;
#define LORA_FILL_LOAD(p) do { if (SEAM_FILL) break; const int id0_ = ft0 + (p), id_ = id0_ < NE * 512 ? id0_ : 0; const int e_ = id_ >> 9, q_ = id_ & 511; cv_load(ft, weo + (size_t)e_ * D * D, D, 32 * (q_ & 31), q_ >> 5, lane); } while (0)
#define LORA_FILL_STORE(p) do { const int id_ = ft0 + (p); if (!SEAM_FILL && id_ < NE * 512) { const int e_ = id_ >> 9, q_ = id_ & 511; cv_to_lds(ft, fscr, lane); cv_store_bf16(fscr, WEO + (size_t)e_ * D * D, D, 32 * (q_ & 31), 64 * (q_ >> 5), lane); } } while (0)
        LoraB<2> b0, b1;
        lora_bload<2>(b0, WL, F.wave, lr, g);
#pragma unroll
        for (int i = 0; i < 8; i += 2) {
            lora_bload<2>(b1, WL, F.wave + 8 * (i + 1), lr, g); LORA_FILL_LOAD(i);
            lora_product<2>(b0, F.lds + ((F.wave + 8 * i) >> 4) * TILE, LO, r0, F.wave + 8 * i, lr, g, LBI);
            LORA_FILL_STORE(i);
            if (i + 2 < 8) lora_bload<2>(b0, WL, F.wave + 8 * (i + 2), lr, g);
            LORA_FILL_LOAD(i + 1);
            lora_product<2>(b1, F.lds + ((F.wave + 8 * (i + 1)) >> 4) * TILE, LO, r0, F.wave + 8 * (i + 1), lr, g, LBI);
            LORA_FILL_STORE(i + 1);
        }
        { LoraB<4> c0; lora_bload<4>(c0, WL, 64 + F.wave, lr, g); LORA_FILL_LOAD(8); lora_product<4>(c0, F.lds + 4 * TILE, LO, r0, 64 + F.wave, lr, g, LBI); LORA_FILL_STORE(8);
          lora_bload<4>(c0, WL, 72 + F.wave, lr, g); LORA_FILL_LOAD(9); lora_product<4>(c0, F.lds + 4 * TILE, LO, r0, 72 + F.wave, lr, g, LBI); LORA_FILL_STORE(9); }
#undef LORA_FILL_LOAD
#undef LORA_FILL_STORE
        __syncthreads();
    }
    for (int t = blockIdx.x; t < (MC / 64) * 32; t += F.G) {
        int lane = F.lane; asm volatile("" : "+v"(lane));
        const int lr = lane & 15, g = lane >> 4, r0 = ML + (t >> 5) * 64, q0 = 2 * (t & 31), gi = q0 >> 4;
        lora_atile(z, p_mu, F.lds, r0, gi, F.wave, lane);
        __syncthreads();
        if (F.wave < 2) { LoraB<2> b0; lora_bload<2>(b0, WL, q0 + F.wave, lr, g); lora_product<2>(b0, F.lds + gi * TILE, LO, r0, q0 + F.wave, lr, g, LBI); }
        __syncthreads();
    }
}

__device__ __forceinline__ void ss2_load(v4u& ra, v4u& rq, const unsigned char* PQ, size_t inst, int wv, int wave, int lane) {
    const unsigned char* pb = PQ + inst * 16384;
    ra = *(const v4u*)(pb + (size_t)((wave * 64 + lane) * 16));
    if (wave < 2) rq = *(const v4u*)(pb + 8192 + (size_t)((wv * 64 + lane) * 32 + 16 * wave));
}
__device__ __forceinline__ void phase_ss2(Frame& F) {
    const unsigned char* PQ = F.ws + WS_PQ; unsigned char* H0T = F.ws + WS_H0T;
    const int lane = F.lane, wave = F.wave, lr = lane & 15, g = lane >> 4;
    LAS unsigned char* ring = F.lds;
    constexpr int SLOT = 10240, NS = 4 + T / 64, DEPTH = 12;
    static_assert(NS % DEPTH == 0, "unrolled by DEPTH");
    for (int task = (int)blockIdx.x; task < 256; task += F.G) {
        const int chain = task >> 2, wv = task & 3, b = chain >> 5, h = (chain >> 1) & 15, d = chain & 1;
        f32x4 H[4]; zero4(H);
        v4u ra[DEPTH], rq[DEPTH];
#pragma unroll
        for (int k = 0; k < DEPTH; ++k) { rq[k] = (v4u){0u, 0u, 0u, 0u}; ss2_load(ra[k], rq[k], PQ, ss_pq(k, b, h, d), wv, wave, lane); }
        for (int step = 0; step < NS; step += DEPTH) {
#pragma unroll
            for (int k = 0; k < DEPTH; ++k) {
                const int st = step + k; LAS unsigned char* sl = ring + (st & 1) * SLOT;
                *(LAS v4u*)(sl + (wave * 64 + lane) * 16) = ra[k]; if (wave < 2) *(LAS v4u*)(sl + 8192 + (wave * 64 + lane) * 16) = rq[k];
                { const int nx = st + DEPTH < NS ? st + DEPTH : NS - 1; ss2_load(ra[k], rq[k], PQ, ss_pq(nx, b, h, d), wv, wave, lane); }
                __syncthreads();
                if (wave == 0) { SSIn cur;
#pragma unroll
                    for (int f = 0; f < 8; ++f) cur.a[f] = *(const LAS v4u*)(sl + (f * 64 + lane) * 16);
                    cur.q[0] = *(const LAS v4u*)(sl + 8192 + lane * 16); cur.q[1] = *(const LAS v4u*)(sl + 8192 + (64 + lane) * 16);
                    ss_step(H, cur, H0T, ss_inst(st, b, h, d), st >= 4, wv, lr, g); }
            }
        }
        __syncthreads();
    }
}

__device__ __forceinline__ void ss3_load(v4u& a0, v4u& a1, v2u& q, const unsigned char* PQ, size_t pq, int wv, int m, int lane) {
    const unsigned char* pb = PQ + pq * 16384;
    a0 = *(const v4u*)(pb + (size_t)(((2 * m) * 64 + lane) * 16)); a1 = *(const v4u*)(pb + (size_t)(((2 * m + 1) * 64 + lane) * 16));
    q = *(const v2u*)(pb + 8192 + (size_t)((wv * 64 + lane) * 32 + 8 * m));
}
__device__ __forceinline__ void phase_ss3(Frame& F) {
    const unsigned char* PQ = F.ws + WS_PQ; unsigned char* H0T = F.ws + WS_H0T;
    const int lane = F.lane, wave = F.wave, lr = lane & 15, g = lane >> 4, m = wave & 3;
    LAS unsigned char* xch = F.lds;
    constexpr int NS = 4 + T / 64, DEPTH = 12;
    static_assert(NS % DEPTH == 0, "unrolled by DEPTH");
    for (int task = (int)blockIdx.x; task < 256; task += F.G) {
        const int chain = task >> 2, wv = task & 3, b = chain >> 5, h = (chain >> 1) & 15, d = chain & 1;
        f32x4 H = {0.f, 0.f, 0.f, 0.f};
        v4u a0[DEPTH], a1[DEPTH]; v2u qv[DEPTH];
        if (wave < 4) {
#pragma unroll
            for (int k = 0; k < DEPTH; ++k) ss3_load(a0[k], a1[k], qv[k], PQ, ss_pq(k, b, h, d), wv, m, lane);
        }
        for (int step = 0; step < NS; step += DEPTH) {
#pragma unroll
            for (int k = 0; k < DEPTH; ++k) {
                const int st = step + k; LAS unsigned char* xs = xch + (st & 1) * 2048;
                if (wave < 4) {
                    const v2u pk = {cvtpk(H[0], H[1]), cvtpk(H[2], H[3])};
                    *(LAS v2u*)(xs + lane * 32 + 8 * m) = pk;
                    if (st >= 4) *(v2u*)(H0T + ss_inst(st, b, h, d) * 8192 + (size_t)((16 * wv + lr) * 64 + 16 * m + 4 * g) * 2) = pk;
                }
                __syncthreads();
                if (wave < 4) {
                    const v4u b0 = *(const LAS v4u*)(xs + lane * 32), b1 = *(const LAS v4u*)(xs + lane * 32 + 16);
                    f32x4 Hn = {bflo(qv[k].x), bfhi(qv[k].x), bflo(qv[k].y), bfhi(qv[k].y)};
                    Hn = CK_MFMA(__builtin_bit_cast(bf16x8, a0[k]), __builtin_bit_cast(bf16x8, b0), Hn);
                    Hn = CK_MFMA(__builtin_bit_cast(bf16x8, a1[k]), __builtin_bit_cast(bf16x8, b1), Hn);
                    H = Hn;
                    const int nx = st + DEPTH < NS ? st + DEPTH : NS - 1;
                    ss3_load(a0[k], a1[k], qv[k], PQ, ss_pq(nx, b, h, d), wv, m, lane);
                }
            }
        }
        __syncthreads();
    }
}
}
template <int PART>
__device__ __forceinline__ void phase_moe_weights(Frame& F) {
    LAS float* scr = (LAS float*)(F.lds + RING_OFF + F.wave * 16384);
    bf16* WEO = (bf16*)(F.ws + WS_WEOUT);
    constexpr int IT_IN = (D / 64) * (2048 / 32), IT_OUT = (D / 64) * (D / 32);
    if (PART == 0) {
        const float* wei = KIN(I_WEI);
        const int nstat = F.G * 7;
        int it = (int)blockIdx.x * 7 + F.wave - 1;
        while (it < NE * 128) {
            const int half = it & 1, r = it >> 1, e = r >> 6, n0 = 32 * (r & 63);
            const int c = n0 & 1023, rowbase = (c >> 7) * 256 + (n0 >= 1024 ? 128 : 0) + (c & 127);
            q8_item(wei + (size_t)e * D * 2048, 2048, n0, (signed char*)(F.ws + WS_WEIN) + (size_t)e * 2048 * D, (float*)(F.ws + MI_CSWEI) + (size_t)e * 2048, rowbase, scr, F.lane, 8 * half, 8 * half + 8);
            int nx = 0; if (F.lane == 0) nx = (int)__hip_atomic_fetch_add(F.ctl + CW_Q6, 1u, __ATOMIC_RELAXED, __HIP_MEMORY_SCOPE_AGENT);
            it = nstat + __builtin_amdgcn_readfirstlane(nx);
        }
    } else {
        const float* weo = KIN(I_WEO);
        for (int r = (int)blockIdx.x * 7 + F.wave - 1; r < NE * IT_OUT; r += F.G * 7) { const int e = r / IT_OUT, q = r % IT_OUT, kb = q / 32, n0 = 32 * (q % 32);
            transpose_item(weo + (size_t)e * D * D, D, 64 * kb, n0, WEO + (size_t)e * D * D, D, n0, scr, F.lane); }
    }
}

__device__ __forceinline__ void phase_x1_h2(Frame& F) {
    LAS float* LG = (LAS float*)(F.lds);
    LAS float* LA = LG + 2 * D; LAS float* LB = LA + 2 * D;
    const float* modp = (const float*)(F.ws + WS_MODP);
    for (int i = F.tid; i < 2 * D; i += NWAVES * 64) { const int v = i / D, j = i % D;
        LG[i] = mod_val(modp, KIN(I_BADA), v, 2048 + j) * KIN(I_NQM)[j];
        LA[i] = KIN(I_NPF)[j] * (1.0f + mod_val(modp, KIN(I_BADA), v, 4096 + j)); LB[i] = mod_val(modp, KIN(I_BADA), v, 3072 + j); }
    __syncthreads();
    const float* mix = (const float*)(F.ws + WS_MIX); float* x1 = (float*)(F.ws + WS_X1); bf16* h2 = (bf16*)(F.ws + WS_H2);
    for (int row = F.gw; row < ML; row += F.NGW) {
        const int vec = row >> 13;
        f32x4 m[4], x[4]; float s = 0.f;
#pragma unroll
        for (int j = 0; j < 4; ++j) { m[j] = *(const f32x4*)(mix + (size_t)row * D + 4 * F.lane + 256 * j); x[j] = *(const f32x4*)(KIN(I_X) + (size_t)row * D + 4 * F.lane + 256 * j);
            s += (m[j].x * m[j].x + m[j].y * m[j].y) + (m[j].z * m[j].z + m[j].w * m[j].w); }
        const float rstd = 1.0f / sqrtf(wave_sum(s) * (1.0f / D) + 1e-6f);
        float s2 = 0.f;
#pragma unroll
        for (int j = 0; j < 4; ++j) { const int c = 4 * F.lane + 256 * j; const f32x4 g = *(const LAS f32x4*)(LG + vec * D + c);
            x[j] = x[j] + g * (m[j] * rstd); *(f32x4*)(x1 + (size_t)row * D + c) = x[j];
            s2 += (x[j].x * x[j].x + x[j].y * x[j].y) + (x[j].z * x[j].z + x[j].w * x[j].w); }
        const float rstd2 = 1.0f / sqrtf(wave_sum(s2) * (1.0f / D) + 1e-6f);
        unsigned long long* o8 = (unsigned long long*)(h2 + (size_t)row * D) + F.lane;
        f32x4 hq[4]; float mx = 0.f;
#pragma unroll
        for (int j = 0; j < 4; ++j) { const int c = 4 * F.lane + 256 * j; const f32x4 a = *(const LAS f32x4*)(LA + vec * D + c), b = *(const LAS f32x4*)(LB + vec * D + c);
            const f32x4 h = x[j] * rstd2 * a + b; hq[j] = h;
            mx = fmaxf(mx, fmaxf(fmaxf(fabsf(h.x), fabsf(h.y)), fmaxf(fabsf(h.z), fabsf(h.w))));
            o8[64 * j] = (unsigned long long)pk2(h.x, h.y) | ((unsigned long long)pk2(h.z, h.w) << 32); }
        mx = wave_max(mx);
        const float iv = mx > 0.f ? 127.0f / mx : 0.f;
        if (F.lane == 0) ((float*)(F.ws + MI_RSH2))[row] = mx * (1.0f / 127.0f);
        unsigned* o4 = (unsigned*)(F.ws + WS_H2Q + (size_t)row * D) + F.lane;
#pragma unroll
        for (int j = 0; j < 4; ++j) o4[64 * j] = pack_q4(hq[j].x * iv, hq[j].y * iv, hq[j].z * iv, hq[j].w * iv);
    }
}

__device__ __forceinline__ void phase_route(Frame& F) {
    const float* LG = (const float*)(F.ws + WS_LOGIT);
    int* selE = (int*)(F.ws + MI_SELE); int* selP = (int*)(F.ws + MI_SELP); float* gate = (float*)(F.ws + MI_GATE);
    for (int task = F.gw; task < ML / 64; task += F.NGW) {
        const int row = task * 64 + F.lane;
        float v[NE];
#pragma unroll
        for (int q = 0; q < NE / 4; ++q) { const f32x4 x = *(const f32x4*)(LG + (size_t)row * 256 + 4 * q); const f32x4 bb = *(const f32x4*)(KIN(I_BR) + 4 * q);
            v[4 * q] = x.x + bb.x; v[4 * q + 1] = x.y + bb.y; v[4 * q + 2] = x.z + bb.z; v[4 * q + 3] = x.w + bb.w; }
        int se[4]; float sv[4];
#pragma unroll
        for (int k = 0; k < 4; ++k) { float best = -3.0e38f; int bi = 0;
#pragma unroll
            for (int e = 0; e < NE; ++e) if (v[e] > best) { best = v[e]; bi = e; }
#pragma unroll
            for (int e = 0; e < NE; ++e) v[e] = (e == bi) ? -3.0e38f : v[e];
            se[k] = bi; sv[k] = best; }
        float ex[4], sum = 0.f;
#pragma unroll
        for (int k = 0; k < 4; ++k) { ex[k] = __expf(sv[k] - sv[0]); sum += ex[k]; }
        const float inv = 1.0f / sum;
        int sp[4] = {0, 0, 0, 0};
        int myn = 0;
#pragma unroll
        for (int e = 0; e < NE; ++e) { const bool p = (se[0] == e) | (se[1] == e) | (se[2] == e) | (se[3] == e); const int n = __popcll(__ballot(p)); myn = (F.lane == e) ? n : myn; }
        int mybase = 0;
        if (F.lane < NE && myn > 0) mybase = (int)__hip_atomic_fetch_add(F.ctl + CW_CNT + 64 * F.lane, (unsigned)myn, __ATOMIC_RELAXED, __HIP_MEMORY_SCOPE_AGENT);
#pragma unroll
        for (int e = 0; e < NE; ++e) {
            const bool p = (se[0] == e) | (se[1] == e) | (se[2] == e) | (se[3] == e);
            const unsigned long long mask = __ballot(p);
            const int base = __shfl(mybase, e);
            const int pos = base + __popcll(mask & ((1ull << F.lane) - 1ull));
#pragma unroll
            for (int k = 0; k < 4; ++k) if (se[k] == e) sp[k] = pos;
        }
        *(int4*)(selE + (size_t)row * 4) = make_int4(se[0], se[1], se[2], se[3]);
        *(int4*)(selP + (size_t)row * 4) = make_int4(sp[0], sp[1], sp[2], sp[3]);
        *(f32x4*)(gate + (size_t)row * 4) = (f32x4){ex[0] * inv, ex[1] * inv, ex[2] * inv, ex[3] * inv};
    }
}

__device__ __forceinline__ void x1h2_tables(Frame& F, int vec) {
    LAS float* LG = (LAS float*)(F.lds + 132096); LAS float* LA = LG + D; LAS float* LB = LA + D;
    const float* modp = (const float*)(F.ws + WS_MODP); const float* b_ada = KIN(I_BADA); const float* nqm = KIN(I_NQM); const float* npf = KIN(I_NPF);
    for (int i = F.tid; i < D; i += NWAVES * 64) {
        const int jj[3] = {2048 + i, 4096 + i, 3072 + i}; float mv[3]; mod_vals<3>(modp, b_ada, vec, jj, mv);
        LG[i] = mv[0] * nqm[i]; LA[i] = npf[i] * (1.0f + mv[1]); LB[i] = mv[2]; }
}
__device__ __forceinline__ void phase_x1h2_route(Frame& F) {
    constexpr int HS_STRIDE = 2064;
    LAS unsigned char* Hs = F.lds;
    LAS float* LG = (LAS float*)(F.lds + 132096);
    LAS float* LA = LG + D; LAS float* LB = LA + D;
    LAS float* LGT = (LAS float*)(F.lds + LDS_X_OFF);
    const float* modp = (const float*)(F.ws + WS_MODP);
    const bf16* mixb = (const bf16*)(F.ws + WS_MIX); bf16* x1b = (bf16*)(F.ws + WS_X1);
    const float* xin = KIN(I_X); const float* b_ada = KIN(I_BADA); const float* nqm = KIN(I_NQM); const float* npf = KIN(I_NPF);
    const bf16* WR = (const bf16*)(F.ws + WS_WROUT);
    int* selE = (int*)(F.ws + MI_SELE); int* selP = (int*)(F.ws + MI_SELP); float* gate = (float*)(F.ws + MI_GATE);
    for (int rb = blockIdx.x; rb < ML / 64; rb += F.G) {
        const int vec = (rb * 64) >> 13;
        if (!(F.pre8 && rb == (int)blockIdx.x)) { __syncthreads(); x1h2_tables(F, vec); __syncthreads(); }
        v2u mq[2][2][4]; f32x4 xq[2][2][4];
#define X1_LOAD(buf, r2_) do { _Pragma("unroll") for (int k = 0; k < 2; ++k) { const int row = rb * 64 + F.wave * 8 + (r2_) + k; \
            _Pragma("unroll") for (int j = 0; j < 4; ++j) { mq[buf][k][j] = NTL((const v2u*)(mixb + (size_t)row * D + 4 * F.lane + 256 * j)); xq[buf][k][j] = NTL((const f32x4*)(xin + (size_t)row * D + 4 * F.lane + 256 * j)); } } } while (0)
        X1_LOAD(0, 0);
#pragma unroll
        for (int r4 = 0; r4 < 8; r4 += 2) {
            const int cb = (r4 >> 1) & 1;
            if (r4 + 2 < 8) X1_LOAD(cb ^ 1, r4 + 2);
            __builtin_amdgcn_sched_barrier(0);
#pragma unroll
            for (int k = 0; k < 2; ++k) {
                const int lrow = F.wave * 8 + r4 + k, row = rb * 64 + lrow;
                f32x4 m[4], x[4]; float s = 0.f;
#pragma unroll
                for (int j = 0; j < 4; ++j) { m[j] = (f32x4){bflo(mq[cb][k][j].x), bfhi(mq[cb][k][j].x), bflo(mq[cb][k][j].y), bfhi(mq[cb][k][j].y)}; x[j] = xq[cb][k][j];
                    s += (m[j].x * m[j].x + m[j].y * m[j].y) + (m[j].z * m[j].z + m[j].w * m[j].w); }
                const float rstd = 1.0f / sqrtf(wave_sum(s) * (1.0f / D) + 1e-6f);
                float s2 = 0.f;
#pragma unroll
                for (int j = 0; j < 4; ++j) { const int c = 4 * F.lane + 256 * j; const f32x4 g = *(const LAS f32x4*)(LG + c);
                    x[j] = x[j] + g * (m[j] * rstd); *(v2u*)(x1b + (size_t)row * D + c) = (v2u){pk2(x[j].x, x[j].y), pk2(x[j].z, x[j].w)};
                    s2 += (x[j].x * x[j].x + x[j].y * x[j].y) + (x[j].z * x[j].z + x[j].w * x[j].w); }
                const float rstd2 = 1.0f / sqrtf(wave_sum(s2) * (1.0f / D) + 1e-6f);
                f32x4 hq[4]; float mx = 0.f;
#pragma unroll
                for (int j = 0; j < 4; ++j) { const int c = 4 * F.lane + 256 * j; const f32x4 a = *(const LAS f32x4*)(LA + c), b = *(const LAS f32x4*)(LB + c);
                    const f32x4 h = x[j] * rstd2 * a + b; hq[j] = h;
                    mx = fmaxf(mx, fmaxf(fmaxf(fabsf(h.x), fabsf(h.y)), fmaxf(fabsf(h.z), fabsf(h.w))));
                    *(LAS v2u*)(Hs + lrow * HS_STRIDE + c * 2) = (v2u){pk2(h.x, h.y), pk2(h.z, h.w)}; }
                mx = wave_max(mx);
                const float iv = mx > 0.f ? 127.0f / mx : 0.f;
                if (F.lane == 0) ((float*)(F.ws + MI_RSH2))[row] = mx * (1.0f / 127.0f);
                unsigned* o4 = (unsigned*)(F.ws + WS_H2Q + (size_t)row * D) + F.lane;
#pragma unroll
                for (int j = 0; j < 4; ++j) o4[64 * j] = pack_q4(hq[j].x * iv, hq[j].y * iv, hq[j].z * iv, hq[j].w * iv);
            }
        }
#undef X1_LOAD
        typedef short bf16x8_t __attribute__((ext_vector_type(8)));
        bf16x8_t bq[32];
        { const int et_ = F.wave >> 2, lr_ = F.lane & 15, g_ = F.lane >> 4; const bf16* bp_ = WR + (size_t)(16 * et_ + lr_) * D + 8 * g_;
#pragma unroll
          for (int s = 0; s < 32; ++s) bq[s] = *(const bf16x8_t*)(bp_ + 32 * s); }
        __syncthreads();
        {
            const int rt = F.wave & 3, et = F.wave >> 2, lr = F.lane & 15, g = F.lane >> 4;
            f32x4 acc = {0.f, 0.f, 0.f, 0.f};
            const LAS unsigned char* ap = Hs + (16 * rt + lr) * HS_STRIDE + 16 * g;
#pragma unroll
            for (int s = 0; s < 32; ++s) { const bf16x8_t a = *(const LAS bf16x8_t*)(ap + 64 * s); acc = __builtin_amdgcn_mfma_f32_16x16x32_bf16(a, bq[s], acc, 0, 0, 0); }
#pragma unroll
            for (int i = 0; i < 4; ++i) LGT[(16 * rt + 4 * g + i) * 33 + 16 * et + lr] = acc[i];
        }
        __syncthreads();
        if (F.wave == 0) {
            const int row = rb * 64 + F.lane;
            const float* br = KIN(I_BR);
            float v[NE];
#pragma unroll
            for (int e = 0; e < NE; ++e) v[e] = LGT[F.lane * 33 + e] + br[e];
            int se[4]; float sv[4];
#pragma unroll
            for (int k = 0; k < 4; ++k) { float best = -3.0e38f; int bi = 0;
#pragma unroll
                for (int e = 0; e < NE; ++e) if (v[e] > best) { best = v[e]; bi = e; }
#pragma unroll
                for (int e = 0; e < NE; ++e) v[e] = (e == bi) ? -3.0e38f : v[e];
                se[k] = bi; sv[k] = best; }
            float ex[4], sum = 0.f;
#pragma unroll
            for (int k = 0; k < 4; ++k) { ex[k] = __expf(sv[k] - sv[0]); sum += ex[k]; }
            const float inv = 1.0f / sum;
            int sp[4] = {0, 0, 0, 0};
            int myn = 0;
#pragma unroll
            for (int e = 0; e < NE; ++e) { const bool p = (se[0] == e) | (se[1] == e) | (se[2] == e) | (se[3] == e); const int n = __popcll(__ballot(p)); myn = (F.lane == e) ? n : myn; }
            int mybase = 0;
            if (F.lane < NE && myn > 0) mybase = (int)__hip_atomic_fetch_add(F.ctl + CW_CNT + 64 * F.lane, (unsigned)myn, __ATOMIC_RELAXED, __HIP_MEMORY_SCOPE_AGENT);
#pragma unroll
            for (int e = 0; e < NE; ++e) {
                const bool p = (se[0] == e) | (se[1] == e) | (se[2] == e) | (se[3] == e);
                const unsigned long long mask = __ballot(p);
                const int base = __shfl(mybase, e);
                const int pos = base + __popcll(mask & ((1ull << F.lane) - 1ull));
#pragma unroll
                for (int k = 0; k < 4; ++k) if (se[k] == e) sp[k] = pos;
            }
            *(int4*)(selE + (size_t)row * 4) = make_int4(se[0], se[1], se[2], se[3]);
            *(int4*)(selP + (size_t)row * 4) = make_int4(sp[0], sp[1], sp[2], sp[3]);
            *(f32x4*)(gate + (size_t)row * 4) = (f32x4){ex[0] * inv, ex[1] * inv, ex[2] * inv, ex[3] * inv};
        }
    }
    __syncthreads();
}

__device__ __forceinline__ void phase_scatter(Frame& F) {
    LAS int* PS = (LAS int*)(F.lds);
    if (F.wave == 0) {
        const int c = F.lane < NE ? (int)__hip_atomic_load(F.ctl + CW_CNT + 64 * F.lane, __ATOMIC_RELAXED, __HIP_MEMORY_SCOPE_AGENT) : 0;
        const int pc = (c + 255) / 256 * 256; int s = pc;
#pragma unroll
        for (int o = 1; o < 32; o <<= 1) { const int t = __shfl_up(s, o); s += (F.lane >= o) ? t : 0; }
        if (F.lane < NE) { PS[F.lane] = s - pc; PS[64 + F.lane] = c; }
        if (F.lane == NE - 1) PS[NE] = s; }
    __syncthreads();
    int* blkE = (int*)(F.ws + MI_BLKE);
    if (blockIdx.x == 0) {
        for (int b = F.tid; b < MAXBLK; b += NWAVES * 64) { int e = NE - 1;
            for (int q = 0; q < NE; ++q) if (b * 256 >= PS[q] && b * 256 < PS[q + 1]) e = q;
            blkE[b] = e; }
        if (F.tid == 0) blkE[MAXBLK] = PS[NE] / 256;
    }
    const int* selE = (const int*)(F.ws + MI_SELE); const int* selP = (const int*)(F.ws + MI_SELP); int* dest = (int*)(F.ws + MI_DEST);
    const unsigned char* h2q = F.ws + WS_H2Q; unsigned char* xb = F.ws + WS_XB; const float* rsh2 = (const float*)(F.ws + MI_RSH2); float* rsxb = (float*)(F.ws + MI_RSXB);
    for (int row0 = F.gw; row0 < ML; row0 += 8 * F.NGW) {
        int4 se[8], sp[8]; float rsc[8]; v4u av[8];
#pragma unroll
        for (int k = 0; k < 8; ++k) { const int row = row0 + k * F.NGW, rc = row < ML ? row : row0;
            se[k] = *(const int4*)(selE + (size_t)rc * 4); sp[k] = *(const int4*)(selP + (size_t)rc * 4); rsc[k] = rsh2[rc]; av[k] = NTL((const v4u*)(h2q + (size_t)rc * D + 16 * F.lane)); }
        __builtin_amdgcn_sched_barrier(0);
#pragma unroll
        for (int k = 0; k < 8; ++k) { const int row = row0 + k * F.NGW;
            if (row < ML) {
                const int d0 = PS[se[k].x] + sp[k].x, d1 = PS[se[k].y] + sp[k].y, d2 = PS[se[k].z] + sp[k].z, d3 = PS[se[k].w] + sp[k].w;
                if (F.lane == 0) { *(int4*)(dest + (size_t)row * 4) = make_int4(d0, d1, d2, d3); rsxb[d0] = rsc[k]; rsxb[d1] = rsc[k]; rsxb[d2] = rsc[k]; rsxb[d3] = rsc[k]; }
                *(v4u*)(xb + (size_t)d0 * D + 16 * F.lane) = av[k]; *(v4u*)(xb + (size_t)d1 * D + 16 * F.lane) = av[k];
                *(v4u*)(xb + (size_t)d2 * D + 16 * F.lane) = av[k]; *(v4u*)(xb + (size_t)d3 * D + 16 * F.lane) = av[k]; } }
    }
    for (int p = F.gw; p < NE * 256; p += F.NGW) {
        const int e = p >> 8, r = p & 255, c = PS[64 + e], padded = (c + 255) / 256 * 256;
        if (c + r < padded) { unsigned char* dst = xb + (size_t)(PS[e] + c + r) * D; *(v4u*)(dst + 16 * F.lane) = (v4u){0u, 0u, 0u, 0u}; if (F.lane == 0) rsxb[PS[e] + c + r] = 0.f; }
    }
}

__device__ __forceinline__ void combine_tables(Frame& F) {
    LAS float* LG = (LAS float*)(F.lds);
    const float* modp = (const float*)(F.ws + WS_MODP);
    for (int i = F.tid; i < 2 * D; i += NWAVES * 64) { const int v = i / D, j = i % D; LG[i] = mod_val(modp, KIN(I_BADA), v, 5120 + j) * KIN(I_NQF)[j]; }
}
__device__ __forceinline__ void phase_combine(Frame& F) {
    LAS float* LG = (LAS float*)(F.lds);
    const float* modp = (const float*)(F.ws + WS_MODP);
    if (!F.pre12) { combine_tables(F); __syncthreads(); }
    const int* dest = (const int*)(F.ws + MI_DEST); const float* gate = (const float*)(F.ws + MI_GATE);
    const bf16* y2 = (const bf16*)(F.ws + WS_Y2); const bf16* x1b = (const bf16*)(F.ws + WS_X1);
    for (int row0 = F.gw; row0 < ML; row0 += 8 * F.NGW) {
        const int rl = row0 + (F.lane & 7) * F.NGW, rlc = rl < ML ? rl : row0;
        const int4 ddl = *(const int4*)(dest + (size_t)rlc * 4); const f32x4 ggl = *(const f32x4*)(gate + (size_t)rlc * 4);
        v4u t[2][2][4][2]; v4u xq[2][2][2];
#define CMB_LOAD(buf, k2_) do { _Pragma("unroll") for (int u = 0; u < 2; ++u) { const int kk = (k2_) + u, row = row0 + kk * F.NGW, rc = row < ML ? row : row0; \
            const int dk[4] = {__builtin_amdgcn_readlane(ddl.x, kk), __builtin_amdgcn_readlane(ddl.y, kk), __builtin_amdgcn_readlane(ddl.z, kk), __builtin_amdgcn_readlane(ddl.w, kk)}; \
            _Pragma("unroll") for (int k = 0; k < 4; ++k) { const bf16* yp = y2 + (size_t)(row < ML ? dk[k] : 0) * D + 16 * F.lane; t[buf][u][k][0] = NTL((const v4u*)yp); t[buf][u][k][1] = NTL((const v4u*)(yp + 8)); } \
            _Pragma("unroll") for (int j = 0; j < 2; ++j) xq[buf][u][j] = NTL((const v4u*)(x1b + (size_t)rc * D + 16 * F.lane + 8 * j)); } } while (0)
        CMB_LOAD(0, 0);
#pragma unroll
        for (int k2 = 0; k2 < 8; k2 += 2) {
            const int cb = (k2 >> 1) & 1;
            if (k2 + 2 < 8) CMB_LOAD(cb ^ 1, k2 + 2);
            __builtin_amdgcn_sched_barrier(0);
#pragma unroll
            for (int u = 0; u < 2; ++u) { const int kk = k2 + u, row = row0 + kk * F.NGW;
                if (row < ML) {
                    const int vec = row >> 13;
                    const float g0_ = ggl.x, g1_ = ggl.y, g2_ = ggl.z, g3_ = ggl.w;
                    const float gk[4] = {__int_as_float(__builtin_amdgcn_readlane(__float_as_int(g0_), kk)), __int_as_float(__builtin_amdgcn_readlane(__float_as_int(g1_), kk)),
                                         __int_as_float(__builtin_amdgcn_readlane(__float_as_int(g2_), kk)), __int_as_float(__builtin_amdgcn_readlane(__float_as_int(g3_), kk))};
                    float f[16];
#pragma unroll
                    for (int i = 0; i < 16; ++i) f[i] = 0.f;
#pragma unroll
                    for (int k = 0; k < 4; ++k) { const v4u a_ = t[cb][u][k][0], b_ = t[cb][u][k][1];
                        const float tt[16] = {bflo(a_.x), bfhi(a_.x), bflo(a_.y), bfhi(a_.y), bflo(a_.z), bfhi(a_.z), bflo(a_.w), bfhi(a_.w), bflo(b_.x), bfhi(b_.x), bflo(b_.y), bfhi(b_.y), bflo(b_.z), bfhi(b_.z), bflo(b_.w), bfhi(b_.w)};
#pragma unroll
                        for (int i = 0; i < 16; ++i) f[i] += gk[k] * tt[i]; }
                    float s = 0.f;
#pragma unroll
                    for (int i = 0; i < 16; ++i) s += f[i] * f[i];
                    const float rstd = 1.0f / sqrtf(wave_sum(s) * (1.0f / D) + 1e-6f);
                    float g[16], o[16]; ld16f_lds(LG + vec * D + 16 * F.lane, g);
#pragma unroll
                    for (int i = 0; i < 16; ++i) { const unsigned w_ = xq[cb][u][i >> 3][(i >> 1) & 3]; o[i] = ((i & 1) ? bfhi(w_) : bflo(w_)) + g[i] * (f[i] * rstd); }
                    st16f(F.out + (size_t)row * D + 16 * F.lane, o);
                }
            }
        }
#undef CMB_LOAD
    }
}

constexpr int N_PHASES = 13;
#ifndef PROBE_MASK
#define PROBE_MASK 0
#endif
#ifndef STAGE_REP
#define STAGE_REP 0
#endif
#ifndef USE_FLAT_BAR
#define USE_FLAT_BAR 0
#endif
struct Args { const float* in[30]; float* out; unsigned char* ws; int ph_lo, ph_hi; };
__global__ void __launch_bounds__(NWAVES * 64, 2) fwd(Args args) {
    extern __shared__ __attribute__((aligned(16))) unsigned char lds[];
    Frame F;
    F.lds = (LAS unsigned char*)lds;
    F.MISC = (volatile LAS unsigned*)(F.lds + MISC_OFF);
    F.tid = threadIdx.x; F.lane = F.tid & 63; F.wave = __builtin_amdgcn_readfirstlane(F.tid >> 6);
    F.G = gridDim.x; F.gw = blockIdx.x * NWAVES + F.wave; F.NGW = F.G * NWAVES; F.pre8 = 0; F.pre12 = 0; F.pre3 = 0; F.pre4 = 0; F.pre6 = 0; F.pre11 = 0;
    F.ws = args.ws; F.ctl = (unsigned*)(args.ws + WS_CTL); F.out = args.out;
    for (int u = F.tid; u < (LDS_X_OFF - LDSCTL_OFF) / 4; u += NWAVES * 64) ((LAS unsigned*)(F.lds + LDSCTL_OFF))[u] = 0u;
    __syncthreads();
    const int lo = args.ph_lo, hi = args.ph_hi;
    const bool use_bar = (hi - lo) > 1;
    XcdBarrier bar; bar.bar = F.ctl + CW_BAR; bar.x = 0; bar.st = nullptr;
    unsigned xrank = 0u;
    if (use_bar && !USE_FLAT_BAR) { bar.x = xb_xcc_id(); bar.st = F.MISC + 8; if (threadIdx.x == 0) xrank = xb_add(&bar.bar[XB_XCNT(bar.x)], 1u); }
    F.vb = (int)blockIdx.x;
#define IN(k) (lo <= (k) && (k) < hi)
    unsigned fb_extra = 0u;
#define SEAM(k) do { if (IN(k) && IN((k) + 1)) { if (USE_FLAT_BAR) flat_barrier(F.ctl + CW_FB, (unsigned)((k) - lo + 1) + fb_extra); \
        else if (SEAM_FILL && (k) < 8) { xcd_barrier2_arrive(bar); SEAM_FILL_CALL(k); SEAM_PRE_CALL(k); xcd_barrier2_wait(bar); } \
        else if ((k) == 11) { xcd_barrier2_arrive(bar); combine_tables(F); F.pre12 = 1; xcd_barrier2_wait(bar); } else xcd_barrier2(bar); } \
    else { __syncthreads(); if (SEAM_FILL && (k) < 8) { SEAM_FILL_CALL(k); __syncthreads(); } } } while (0)
#define SEAM_PRE_CALL(k) do { if ((k) == 7) { x1h2_tables(F, ((int)blockIdx.x * 64) >> 13); F.pre8 = 1; } \
    else if ((k) == 2) { __syncthreads(); ck::lora_bias_table(F); F.pre3 = 1; } \
    else if ((k) == 3) { ck::cp2_param_table(F, (int)blockIdx.x & 15); F.pre4 = 1; } \
    else if ((k) == 5) { ck::co2_param_table(F, (int)blockIdx.x & 15); F.pre6 = 1; } } while (0)
#define SEAM_FILL_CALL(k) do { if ((k) == 2) seam_fill_dispatch(F, 2, F.vb, ((MT / 256) * (NZ / 256)) % F.G, true); else if ((k) == 4) seam_fill_dispatch(F, 4, (int)blockIdx.x, ck::NU_ALL % F.G); else seam_filler(F, (k), F.gw); } while (0)

#define DUP(k) ((PROBE_MASK >> (k)) & 1)
    if (IN(0)) { phase_prologue(F); if (DUP(0)) { __syncthreads(); phase_prologue(F); } SEAM(0); }
    if (use_bar && !USE_FLAT_BAR && IN(0) && IN(1)) {
        if (F.tid == 0) { bool ok = (F.G & 7) == 0;
            for (unsigned j = 0; j < 16; ++j) ok = ok && (xb_ld(&bar.bar[XB_XCNT(j)]) == (j < 8u ? (unsigned)(F.G >> 3) : 0u));
            F.MISC[12] = ok ? bar.x + 8u * xrank : blockIdx.x; }
        __syncthreads(); F.vb = (int)F.MISC[12];
    }
    if (DUP(20)) { for (int q = 0; q < 10; ++q) { if (USE_FLAT_BAR) { ++fb_extra; flat_barrier(F.ctl + CW_FB, 1u + fb_extra); } else xcd_barrier2(bar); } }
    if (IN(1)) { phase_hrows(F); if (DUP(1)) { __syncthreads(); phase_hrows(F); } SEAM(1); }
    if (IN(2)) {
        {         pg8::Gemm g{(const bf16*)(F.ws + WS_A0), (const bf16*)(F.ws + WS_WIN), MT, NZ, D}; pg8::StaticOrder S; S.init(MT, NZ, F.G, F.vb);
        pg8::EpiBf16I8 E{(bf16*)(F.ws + WS_Z), NZ, (const float*)(F.ws + MI_RSH), (const float*)(F.ws + MI_CSWIN), (LAS float*)(F.lds + RING_BYTES + 2048)};
        pg8::gemm_phase_i8<pg8::EpiBf16I8, pg8::StaticOrder, true, true>(F.lds + RING_OFF, g, S, E); __syncthreads(); }
        if (DUP(2)) {         pg8::Gemm g{(const bf16*)(F.ws + WS_A0), (const bf16*)(F.ws + WS_WIN), MT, NZ, D}; pg8::StaticOrder S; S.init(MT, NZ, F.G, F.vb);
        pg8::EpiBf16I8 E{(bf16*)(F.ws + WS_Z), NZ, (const float*)(F.ws + MI_RSH), (const float*)(F.ws + MI_CSWIN), (LAS float*)(F.lds + RING_BYTES + 2048)};
        pg8::gemm_phase_i8<pg8::EpiBf16I8, pg8::StaticOrder, true, true>(F.lds + RING_OFF, g, S, E); __syncthreads(); }
        SEAM(2); }
    if (IN(3)) { ck::phase_lora(F); SEAM(3); }
    if (IN(4)) { ck::phase_cp2(F); if (DUP(5)) { __syncthreads(); ck::phase_cp2(F); } if (DUP(22)) { __syncthreads(); ck::phase_lora(F); } SEAM(4); }
    if (IN(5)) { if (F.wave == 0) ck::phase_ss(F); else if (SS_FILL_WEO) ss_filler(F); if (DUP(23)) { __syncthreads(); ck::phase_ss3(F); } if (DUP(6)) { __syncthreads(); if (F.wave == 0) ck::phase_ss(F); else phase_moe_weights<0>(F); } if (DUP(17)) { __syncthreads(); if (F.wave == 0) ck::phase_ss(F); } SEAM(5); }
    if (IN(6)) { ck::phase_co2(F); if (DUP(7)) { __syncthreads(); ck::phase_co2(F); } SEAM(6); }
    if (IN(7)) {
        {         pg8::Gemm g{(const bf16*)(F.ws + WS_A0), (const bf16*)(F.ws + WS_WOUT), ML, D, D}; pg8::StaticOrder S; S.init(ML, D, F.G, F.vb);
        pg8::EpiBf16 E{(bf16*)(F.ws + WS_MIX), D, nullptr, 0};
        pg8::gemm_phase<pg8::EpiBf16, pg8::StaticOrder, true, true>(F.lds + RING_OFF, g, S, E);
        __syncthreads(); }
        if (DUP(8)) {         pg8::Gemm g{(const bf16*)(F.ws + WS_A0), (const bf16*)(F.ws + WS_WOUT), ML, D, D}; pg8::StaticOrder S; S.init(ML, D, F.G, F.vb);
        pg8::EpiBf16 E{(bf16*)(F.ws + WS_MIX), D, nullptr, 0};
        pg8::gemm_phase<pg8::EpiBf16, pg8::StaticOrder, true, true>(F.lds + RING_OFF, g, S, E);
        __syncthreads(); }
        SEAM(7); }
    if (IN(8)) { phase_x1h2_route(F); SEAM(8); }
    if (IN(9)) { phase_scatter(F); if (DUP(12)) { __syncthreads(); phase_scatter(F); } SEAM(9); }
    if (IN(10)) {
        {         const int* blkE = (const int*)(F.ws + MI_BLKE);
        pg8::Gemm g{(const bf16*)(F.ws + WS_XB), (const bf16*)(F.ws + WS_WEIN), NROWS, 2048, D};
        LAS int* BE = (LAS int*)(F.lds + RING_BYTES);
        for (int i = F.tid; i <= MAXBLK; i += NWAVES * 64) BE[i] = __hip_atomic_load(blkE + i, __ATOMIC_RELAXED, __HIP_MEMORY_SCOPE_AGENT);
        __syncthreads();
        pg8::MoeOrder<8> S{BE, BE[MAXBLK] * 8, F.G, F.vb};
        pg8::EpiSwigluI8 E{(bf16*)(F.ws + WS_ACT), KIN(I_BEI), (const float*)(F.ws + MI_RSXB), (const float*)(F.ws + MI_CSWEI), (LAS float*)(F.lds + RING_BYTES + 2048)};
        pg8::gemm_phase_i8<pg8::EpiSwigluI8, pg8::MoeOrder<8>, true, true>(F.lds + RING_OFF, g, S, E); __syncthreads(); F.pre11 = (PROBE_MASK == 0) ? 1 : 0; moe1_tail_fill(F, S.nunits); }
        if (DUP(13)) {         const int* blkE = (const int*)(F.ws + MI_BLKE);
        pg8::Gemm g{(const bf16*)(F.ws + WS_XB), (const bf16*)(F.ws + WS_WEIN), NROWS, 2048, D};
        LAS int* BE = (LAS int*)(F.lds + RING_BYTES);
        for (int i = F.tid; i <= MAXBLK; i += NWAVES * 64) BE[i] = __hip_atomic_load(blkE + i, __ATOMIC_RELAXED, __HIP_MEMORY_SCOPE_AGENT);
        __syncthreads();
        pg8::MoeOrder<8> S{BE, BE[MAXBLK] * 8, F.G, F.vb};
        pg8::EpiSwigluI8 E{(bf16*)(F.ws + WS_ACT), KIN(I_BEI), (const float*)(F.ws + MI_RSXB), (const float*)(F.ws + MI_CSWEI), (LAS float*)(F.lds + RING_BYTES + 2048)};
        pg8::gemm_phase_i8<pg8::EpiSwigluI8, pg8::MoeOrder<8>, true, true>(F.lds + RING_OFF, g, S, E); __syncthreads(); }
        SEAM(10); }
    if (IN(11)) {
        {         const int* blkE = (const int*)(F.ws + MI_BLKE);
        pg8::Gemm g{(const bf16*)(F.ws + WS_ACT), (const bf16*)(F.ws + WS_WEOUT), NROWS, D, D};
        LAS int* BE = (LAS int*)(F.lds + RING_BYTES);
        if (!F.pre11) { for (int i = F.tid; i <= MAXBLK; i += NWAVES * 64) BE[i] = __hip_atomic_load(blkE + i, __ATOMIC_RELAXED, __HIP_MEMORY_SCOPE_AGENT);
            __syncthreads(); }
        pg8::MoeOrder<4> S{BE, BE[MAXBLK] * 4, F.G, F.vb};
        pg8::EpiBf16 E{(bf16*)(F.ws + WS_Y2), D, KIN(I_BEO), D};
        pg8::gemm_phase<pg8::EpiBf16, pg8::MoeOrder<4>, true, true>(F.lds + RING_OFF, g, S, E); __syncthreads(); }
        if (DUP(14)) {         const int* blkE = (const int*)(F.ws + MI_BLKE);
        pg8::Gemm g{(const bf16*)(F.ws + WS_ACT), (const bf16*)(F.ws + WS_WEOUT), NROWS, D, D};
        LAS int* BE = (LAS int*)(F.lds + RING_BYTES);
        for (int i = F.tid; i <= MAXBLK; i += NWAVES * 64) BE[i] = __hip_atomic_load(blkE + i, __ATOMIC_RELAXED, __HIP_MEMORY_SCOPE_AGENT);
        __syncthreads();
        pg8::MoeOrder<4> S{BE, BE[MAXBLK] * 4, F.G, F.vb};
        pg8::EpiBf16 E{(bf16*)(F.ws + WS_Y2), D, KIN(I_BEO), D};
        pg8::gemm_phase<pg8::EpiBf16, pg8::MoeOrder<4>, true, true>(F.lds + RING_OFF, g, S, E); __syncthreads(); }
        SEAM(11); }
    if (IN(12)) { phase_combine(F); if (DUP(15)) { __syncthreads(); phase_combine(F); } }
#undef IN
#undef SEAM
}

#ifndef MK_N_LAUNCHES
#define MK_N_LAUNCHES 1
#endif
extern "C" void kernel_launch(void* const* d_in, const int* in_sizes, int n_in, void* d_out, int out_size, void* d_ws, size_t ws_size, hipStream_t stream) {
    static int grid = 0;
    if (grid == 0) {
        if (n_in != 30 || out_size != ML * D || ws_size < WS_END) { fprintf(stderr, "kernel_launch: unexpected shapes (n_in %d out %d ws %zu, need %zu); nothing launched\n", n_in, out_size, ws_size, (size_t)WS_END); grid = -1; return; }
        int dev = 0, cus = 0, per_cu = 0;
        if (hipGetDevice(&dev) != hipSuccess || hipDeviceGetAttribute(&cus, hipDeviceAttributeMultiprocessorCount, dev) != hipSuccess) { grid = -1; return; }
        if (hipFuncSetAttribute((const void*)fwd, hipFuncAttributeMaxDynamicSharedMemorySize, LDS_BYTES) != hipSuccess) { fprintf(stderr, "kernel_launch: hipFuncSetAttribute failed\n"); grid = -1; return; }
        if (hipOccupancyMaxActiveBlocksPerMultiprocessor(&per_cu, (const void*)fwd, NWAVES * 64, LDS_BYTES) != hipSuccess || per_cu < 1)
            fprintf(stderr, "kernel_launch: note: occupancy query reports %d workgroups per CU\n", per_cu);
        (void)hipGetLastError();
        grid = cus;
    }
    if (grid < 0) return;
    if (hipMemsetAsync((char*)d_ws + WS_CTL, 0, CTL_ZERO_BYTES, stream) != hipSuccess) return;
    Args a{};
    for (int i = 0; i < 30; ++i) a.in[i] = (const float*)d_in[i];
    a.out = (float*)d_out; a.ws = (unsigned char*)d_ws;
    if (MK_N_LAUNCHES == 1) { a.ph_lo = 0; a.ph_hi = N_PHASES; hipLaunchKernelGGL(fwd, dim3(grid), dim3(NWAVES * 64), LDS_BYTES, stream, a); }
    else for (int p = 0; p < N_PHASES; ++p) { a.ph_lo = p; a.ph_hi = p + 1; hipLaunchKernelGGL(fwd, dim3(grid), dim3(NWAVES * 64), LDS_BYTES, stream, a); }
}
```
